# Optimizing an MI355X kernel written in HIP

```python
import jax, jax.numpy as jnp
from jax import lax
import numpy as np

D_MODEL = 1024
BATCH = 4
SEQ = 4096
DEPTH = 2

N_BRANCH = 4
BRANCH_W = 256
SGU_GROUPS = 4
SGU_GD = BRANCH_W // SGU_GROUPS
SGU_CHUNK = 128
ATT_HEADS = 4
ATT_HD = 64
IDX_HEADS = 8
IDX_HD = 64
TOPK_MAX = 256
QBLOCK = 128
ROPE_THETA = 10000.0
MLSTM_HEADS = 4
MLSTM_HD = 64
MLSTM_CHUNK = 128
CONV_WIDTH = 3
D_FF = 4 * D_MODEL
EPS = 1e-6

SPLIT_SIZES = (
    BRANCH_W, BRANCH_W,
    ATT_HEADS * ATT_HD, ATT_HEADS * ATT_HD, ATT_HEADS * ATT_HD,
    IDX_HEADS * IDX_HD, IDX_HD, IDX_HEADS,
    MLSTM_HEADS * MLSTM_HD, MLSTM_HEADS * MLSTM_HD, MLSTM_HEADS * MLSTM_HD, MLSTM_HEADS * MLSTM_HD,
    MLSTM_HEADS, MLSTM_HEADS,
    BRANCH_W, BRANCH_W, BRANCH_W,
    N_BRANCH * D_MODEL,
)
IN_W = sum(SPLIT_SIZES)

kernel_name = "hybrid_gated_parallel_mixers"


def rms_norm(x, g):
    xf = x.astype(jnp.float32)
    y = xf * lax.rsqrt(jnp.mean(xf * xf, axis=-1, keepdims=True) + EPS)
    return (y * g.astype(jnp.float32)).astype(x.dtype)


def layer_norm_nobias(x, g):
    xf = x.astype(jnp.float32)
    mu = jnp.mean(xf, axis=-1, keepdims=True)
    var = jnp.mean(jnp.square(xf - mu), axis=-1, keepdims=True)
    return ((xf - mu) * lax.rsqrt(var + EPS) * g.astype(jnp.float32)).astype(x.dtype)


def rotary(x, pos):
    d = x.shape[-1]
    half = d // 2
    inv = jnp.float32(ROPE_THETA) ** (-jnp.arange(half, dtype=jnp.float32) * 2.0 / d)
    ang = pos.astype(jnp.float32)[:, None] * inv[None, :]
    cos = jnp.cos(ang)[None, :, None, :]
    sin = jnp.sin(ang)[None, :, None, :]
    xf = x.astype(jnp.float32)
    x1, x2 = xf[..., :half], xf[..., half:]
    return jnp.concatenate([x1 * cos - x2 * sin, x2 * cos + x1 * sin], axis=-1).astype(x.dtype)


def sgu_mix(u, v, norm_g, w_s, b_s):
    bn, s, w = v.shape
    v = rms_norm(v, norm_g).reshape(bn, s // SGU_CHUNK, SGU_CHUNK, SGU_GROUPS, SGU_GD)
    mask = jnp.tril(jnp.ones((SGU_CHUNK, SGU_CHUNK), dtype=w_s.dtype))
    mixed = jnp.einsum('gts,bcsgd->bctgd', w_s * mask, v) + b_s.T[:, :, None]
    return u * mixed.reshape(bn, s, w)


def dsa_attention(q, k, v, q_idx, k_idx, w_idx):
    bn, s = q.shape[:2]
    n_sel = min(TOPK_MAX, s // 4)
    nb = s // QBLOCK
    kpos = jnp.arange(s)

    def to_blocks(a):
        return jnp.moveaxis(a.reshape((bn, nb, QBLOCK) + a.shape[2:]), 1, 0)

    def one_block(args):
        blk, qb, qib, wb = args
        tpos = blk * QBLOCK + jnp.arange(QBLOCK)
        rel = jax.nn.relu(jnp.einsum('bqhd,bsd->bqhs', qib, k_idx).astype(jnp.float32) * (IDX_HD ** -0.5))
        score = jnp.einsum('bqh,bqhs->bqs', wb.astype(jnp.float32) * (IDX_HEADS ** -0.5), rel)
        causal = kpos[None, :] <= tpos[:, None]
        score = jnp.where(causal[None], score, -jnp.inf)
        _, idx = lax.top_k(score, n_sel)
        valid = idx <= tpos[None, :, None]
        ks = jax.vmap(lambda a, i: a[i])(k, idx)
        vs = jax.vmap(lambda a, i: a[i])(v, idx)
        logits = jnp.einsum('bqhd,bqkhd->bhqk', qb, ks).astype(jnp.float32) * (ATT_HD ** -0.5)
        logits = jnp.where(valid[:, None], logits, -jnp.inf)
        p = jax.nn.softmax(logits, axis=-1).astype(vs.dtype)
        return jnp.einsum('bhqk,bqkhd->bqhd', p, vs)

    out = lax.map(one_block, (jnp.arange(nb), to_blocks(q), to_blocks(q_idx), to_blocks(w_idx)))
    return jnp.moveaxis(out, 0, 1).reshape(bn, s, -1)


def mlstm_chunkwise(q, k, v, i_pre, f_pre):
    bn, s, nh, d = q.shape
    nc = s // MLSTM_CHUNK
    L = MLSTM_CHUNK

    def chunks(a):
        a = a.astype(jnp.float32).reshape((bn, nc, L) + a.shape[2:])
        return jnp.moveaxis(a, (1, 3), (0, 2))

    xs = (chunks(q), chunks(k * (d ** -0.5)), chunks(v), chunks(i_pre), chunks(f_pre))
    tril = jnp.tril(jnp.ones((L, L), dtype=bool))

    def step(carry, inp):
        c_st, n_st, m_st = carry
        qc, kc, vc, ig, fg = inp
        b = jnp.cumsum(jax.nn.log_sigmoid(fg), axis=-1)
        dmat = jnp.where(tril, b[..., :, None] - b[..., None, :] + ig[..., None, :], -jnp.inf)
        inter = b + m_st[..., None]
        mj = jnp.maximum(inter, jnp.max(dmat, axis=-1))
        a = jnp.exp(dmat - mj[..., None]) * jnp.einsum('bhjd,bhsd->bhjs', qc, kc)
        w_inter = jnp.exp(inter - mj)
        num = w_inter[..., None] * jnp.einsum('bhjd,bhde->bhje', qc, c_st) + jnp.einsum('bhjs,bhse->bhje', a, vc)
        den = w_inter * jnp.einsum('bhjd,bhd->bhj', qc, n_st) + jnp.sum(a, axis=-1)
        h = num / jnp.maximum(jnp.abs(den), jnp.exp(-mj))[..., None]
        b_last = b[..., -1]
        m_new = mj[..., -1]
        wk = jnp.exp(b_last[..., None] - b + ig - m_new[..., None])
        decay = jnp.exp(b_last + m_st - m_new)
        c_new = decay[..., None, None] * c_st + jnp.einsum('bhs,bhsd,bhse->bhde', wk, kc, vc)
        n_new = decay[..., None] * n_st + jnp.einsum('bhs,bhsd->bhd', wk, kc)
        return (c_new, n_new, m_new), h

    init = (jnp.zeros((bn, nh, d, d), jnp.float32), jnp.zeros((bn, nh, d), jnp.float32),
            jnp.zeros((bn, nh), jnp.float32))
    _, hs = lax.scan(step, init, xs)
    return jnp.moveaxis(hs, (0, 2), (1, 3)).reshape(bn, s, nh, d)


def short_conv(b_gate, c_gate, x_in, w):
    z = c_gate * x_in
    y = lax.conv_general_dilated(z, w[:, None, :], window_strides=(1,), padding=[(CONV_WIDTH - 1, 0)],
                                 dimension_numbers=('NWC', 'WIO', 'NWC'), feature_group_count=z.shape[-1])
    return b_gate * y


def hybrid_mixer(h, pos, w_in, sgu_norm, sgu_w, sgu_b, q_norm, k_norm, kidx_norm,
                 i_bias, f_bias, mlstm_norm, conv_w, w_branch, w_out):
    bn, s, _ = h.shape
    proj = h @ w_in
    offsets = np.cumsum(SPLIT_SIZES)[:-1].tolist()
    (a_u, a_v, b_q, b_k, b_v, b_qi, b_ki, b_wi, c_q, c_k, c_v, c_o, c_i, c_f,
     d_b, d_c, d_x, g) = jnp.split(proj, offsets, axis=-1)

    def heads(a, nh):
        return a.reshape(bn, s, nh, -1)

    y_a = sgu_mix(jax.nn.gelu(a_u), jax.nn.gelu(a_v), sgu_norm, sgu_w, sgu_b)
    q = rotary(rms_norm(heads(b_q, ATT_HEADS), q_norm), pos)
    k = rotary(rms_norm(heads(b_k, ATT_HEADS), k_norm), pos)
    v = heads(b_v, ATT_HEADS)
    qi = rotary(heads(b_qi, IDX_HEADS), pos)
    ki = rotary(layer_norm_nobias(b_ki, kidx_norm)[:, :, None, :], pos)[:, :, 0, :]
    y_b = dsa_attention(q, k, v, qi, ki, b_wi)
    hc = mlstm_chunkwise(heads(c_q, MLSTM_HEADS), heads(c_k, MLSTM_HEADS), heads(c_v, MLSTM_HEADS),
                         c_i + i_bias, c_f + f_bias).astype(h.dtype)
    hc = rms_norm(hc, mlstm_norm.reshape(MLSTM_HEADS, MLSTM_HD)).reshape(bn, s, -1)
    y_c = jax.nn.sigmoid(c_o) * hc
    y_d = short_conv(d_b, d_c, d_x, conv_w)
    gates = jax.nn.sigmoid(g.reshape(bn, s, N_BRANCH, D_MODEL))
    merged = gates[:, :, 0] * (y_a @ w_branch[0])
    merged = merged + gates[:, :, 1] * (y_b @ w_branch[1])
    merged = merged + gates[:, :, 2] * (y_c @ w_branch[2])
    merged = merged + gates[:, :, 3] * (y_d @ w_branch[3])
    return merged @ w_out


def squared_relu_mlp(h, w_up, w_down):
    return jnp.square(jax.nn.relu(h @ w_up)) @ w_down


def setup_inputs(seed: int = 0) -> dict:
    key = jax.random.key(seed)
    ks = jax.random.split(key, 20)
    f32 = jnp.float32

    def nrm(k, shape, scale):
        return jax.random.normal(k, shape, f32) * scale

    def gain(k, shape):
        return 1.0 + 0.02 * jax.random.normal(k, shape, f32)

    f_bias = jnp.linspace(3.0, 6.0, MLSTM_HEADS, dtype=f32)[None, :] + 0.1 * jax.random.normal(ks[11], (DEPTH, MLSTM_HEADS), f32)
    return {
        "x": nrm(ks[0], (BATCH, SEQ, D_MODEL), 1.0),
        "ln_mix": gain(ks[1], (DEPTH, D_MODEL)),
        "w_in": nrm(ks[2], (DEPTH, D_MODEL, IN_W), D_MODEL ** -0.5),
        "sgu_norm": gain(ks[3], (DEPTH, BRANCH_W)),
        "sgu_w": nrm(ks[4], (DEPTH, SGU_GROUPS, SGU_CHUNK, SGU_CHUNK), SGU_CHUNK ** -0.5),
        "sgu_b": gain(ks[5], (DEPTH, SGU_GROUPS, SGU_CHUNK)),
        "q_norm": gain(ks[6], (DEPTH, ATT_HD)),
        "k_norm": gain(ks[7], (DEPTH, ATT_HD)),
        "kidx_norm": gain(ks[8], (DEPTH, IDX_HD)),
        "mlstm_i_bias": nrm(ks[10], (DEPTH, MLSTM_HEADS), 0.1),
        "mlstm_f_bias": f_bias,
        "mlstm_norm": gain(ks[12], (DEPTH, MLSTM_HEADS * MLSTM_HD)),
        "conv_w": nrm(ks[13], (DEPTH, CONV_WIDTH, BRANCH_W), CONV_WIDTH ** -0.5),
        "w_branch": nrm(ks[14], (DEPTH, N_BRANCH, BRANCH_W, D_MODEL), BRANCH_W ** -0.5),
        "w_out": nrm(ks[15], (DEPTH, D_MODEL, D_MODEL), D_MODEL ** -0.5),
        "ln_mlp": gain(ks[16], (DEPTH, D_MODEL)),
        "w_up": nrm(ks[17], (DEPTH, D_MODEL, D_FF), D_MODEL ** -0.5),
        "w_down": nrm(ks[18], (DEPTH, D_FF, D_MODEL), D_FF ** -0.5),
    }


def reference(x, ln_mix, w_in, sgu_norm, sgu_w, sgu_b, q_norm, k_norm, kidx_norm,
              mlstm_i_bias, mlstm_f_bias, mlstm_norm, conv_w, w_branch, w_out,
              ln_mlp, w_up, w_down):
    pos = jnp.arange(x.shape[1], dtype=jnp.int32)
    for l in range(DEPTH):
        h = rms_norm(x, ln_mix[l])
        x = x + hybrid_mixer(h, pos, w_in[l], sgu_norm[l], sgu_w[l], sgu_b[l], q_norm[l], k_norm[l],
                             kidx_norm[l], mlstm_i_bias[l], mlstm_f_bias[l], mlstm_norm[l],
                             conv_w[l], w_branch[l], w_out[l])
        h = rms_norm(x, ln_mlp[l])
        x = x + squared_relu_mlp(h, w_up[l], w_down[l])
    return x
```

```cpp
#include <hip/hip_runtime.h>
#include <cstdio>
#include <cstdint>
#include <cmath>

namespace nv {
constexpr int D = 1024, NB = 4, S = 4096, DEPTH = 2, FF = 4096, INW = 7760;
constexpr int O_AU = 0, O_AV = 256, O_BQ = 512, O_BK = 768, O_BV = 1024, O_QI = 1280, O_KI = 1792, O_WI = 1856,
              O_CQ = 1864, O_CK = 2120, O_CV = 2376, O_CO = 2632, O_CI = 2888, O_CF = 2892, O_DB = 2896, O_DC = 3152, O_DX = 3408, O_G = 3664;
constexpr float EPS = 1e-6f;

__device__ __forceinline__ float wsum(float v) {
#pragma unroll
    for (int o = 1; o < 64; o <<= 1) v += __shfl_xor(v, o);
    return v;
}
__device__ __forceinline__ float wmax(float v) {
#pragma unroll
    for (int o = 1; o < 64; o <<= 1) v = fmaxf(v, __shfl_xor(v, o));
    return v;
}
__device__ __forceinline__ float gelu_tanh(float x) { return 0.5f * x * (1.f + tanhf(0.7978845608028654f * (x + 0.044715f * x * x * x))); }
__device__ __forceinline__ float sigmoidf(float x) { return 1.f / (1.f + expf(-x)); }

__global__ void rmsnorm_rows(const float* x, const float* g, float* out, int M) {
    int row = blockIdx.x * 4 + (threadIdx.x >> 6), lane = threadIdx.x & 63;
    if (row >= M) return;
    const float* xr = x + (size_t)row * D; float s = 0.f; float v[16];
#pragma unroll
    for (int j = 0; j < 16; ++j) { v[j] = xr[lane + 64 * j]; s += v[j] * v[j]; }
    s = wsum(s); float r = rsqrtf(s / D + EPS);
#pragma unroll
    for (int j = 0; j < 16; ++j) out[(size_t)row * D + lane + 64 * j] = v[j] * r * g[lane + 64 * j];
}

template <int MODE>
__global__ void __launch_bounds__(256) gemm_f32(const float* A, int lda, const float* B, int ldb, float* C, int ldc, int M, int N, int K, const float* R, int ldr) {
    __shared__ float As[16][64 + 4], Bs[16][64 + 4];
    int tx = threadIdx.x & 15, ty = threadIdx.x >> 4, m0 = blockIdx.y * 64, n0 = blockIdx.x * 64;
    float acc[4][4] = {};
    for (int k0 = 0; k0 < K; k0 += 16) {
        for (int i = threadIdx.x; i < 64 * 16; i += 256) { int r = i >> 4, c = i & 15; As[c][r] = (m0 + r < M) ? A[(size_t)(m0 + r) * lda + k0 + c] : 0.f; }
        for (int i = threadIdx.x; i < 16 * 64; i += 256) { int r = i >> 6, c = i & 63; Bs[r][c] = (n0 + c < N) ? B[(size_t)(k0 + r) * ldb + n0 + c] : 0.f; }
        __syncthreads();
#pragma unroll
        for (int k = 0; k < 16; ++k) {
            float a[4], b[4];
#pragma unroll
            for (int i = 0; i < 4; ++i) { a[i] = As[k][ty * 4 + i]; b[i] = Bs[k][tx * 4 + i]; }
#pragma unroll
            for (int i = 0; i < 4; ++i)
#pragma unroll
                for (int j = 0; j < 4; ++j) acc[i][j] = fmaf(a[i], b[j], acc[i][j]);
        }
        __syncthreads();
    }
#pragma unroll
    for (int i = 0; i < 4; ++i)
#pragma unroll
        for (int j = 0; j < 4; ++j) {
            int m = m0 + ty * 4 + i, n = n0 + tx * 4 + j;
            if (m < M && n < N) {
                float v = acc[i][j];
                if (MODE == 1) v += R[(size_t)m * ldr + n];
                if (MODE == 2) { v = fmaxf(v, 0.f); v = v * v; }
                C[(size_t)m * ldc + n] = v;
            }
        }
}

__global__ void prep_rows(const float* P, const float* sgu_norm, const float* q_norm, const float* k_norm, const float* kidx_norm,
                          float* VN, float* Q, float* K, float* QI, float* KI) {
    int t = blockIdx.x * 4 + (threadIdx.x >> 6), lane = threadIdx.x & 63;
    const float* p = P + (size_t)t * INW;
    { float v[4]; float s = 0.f;
#pragma unroll
      for (int j = 0; j < 4; ++j) { v[j] = gelu_tanh(p[O_AV + lane + 64 * j]); s += v[j] * v[j]; }
      s = wsum(s); float r = rsqrtf(s / 256.f + EPS);
#pragma unroll
      for (int j = 0; j < 4; ++j) VN[(size_t)t * 256 + lane + 64 * j] = v[j] * r * sgu_norm[lane + 64 * j]; }
    const int i = lane & 31; const float inv = powf(10000.f, -(float)i * 2.0f / 64.f); const float ang = (float)t * inv; const float cs = cosf(ang), sn = sinf(ang);
    for (int h = 0; h < 4; ++h) {
        float q = p[O_BQ + h * 64 + lane], k = p[O_BK + h * 64 + lane];
        float rq = rsqrtf(wsum(q * q) / 64.f + EPS), rk = rsqrtf(wsum(k * k) / 64.f + EPS);
        q = q * rq * q_norm[lane]; k = k * rk * k_norm[lane];
        float qo = __shfl_xor(q, 32), ko = __shfl_xor(k, 32);
        float qr = lane < 32 ? q * cs - qo * sn : q * cs + qo * sn;
        float kr = lane < 32 ? k * cs - ko * sn : k * cs + ko * sn;
        Q[(size_t)t * 256 + h * 64 + lane] = qr; K[(size_t)t * 256 + h * 64 + lane] = kr;
    }
    for (int h = 0; h < 8; ++h) {
        float q = p[O_QI + h * 64 + lane]; float qo = __shfl_xor(q, 32);
        QI[(size_t)t * 512 + h * 64 + lane] = lane < 32 ? q * cs - qo * sn : q * cs + qo * sn;
    }
    { float k = p[O_KI + lane]; float mu = wsum(k) / 64.f; float d = k - mu; float var = wsum(d * d) / 64.f; k = d * rsqrtf(var + EPS) * kidx_norm[lane];
      float ko = __shfl_xor(k, 32); KI[(size_t)t * 64 + lane] = lane < 32 ? k * cs - ko * sn : k * cs + ko * sn; }
}

__global__ void sgu_naive(const float* P, const float* VN, const float* sgu_w, const float* sgu_b, float* Y) {
    int t = blockIdx.x, ch = threadIdx.x, g = ch >> 6, tl = t & 127, t0 = t - tl;
    float acc = 0.f;
    for (int sl = 0; sl <= tl; ++sl) acc = fmaf(sgu_w[((size_t)g * 128 + tl) * 128 + sl], VN[(size_t)(t0 + sl) * 256 + ch], acc);
    acc += sgu_b[g * 128 + tl];
    Y[(size_t)t * D + ch] = gelu_tanh(P[(size_t)t * INW + O_AU + ch]) * acc;
}

__device__ __forceinline__ unsigned fkey(float s) { unsigned u = __float_as_uint(s); return (u & 0x80000000u) ? ~u : (u | 0x80000000u); }

__global__ void __launch_bounds__(256) dsa_naive(const float* P, const float* Q, const float* K, const float* QI, const float* KI, float* Y) {
    __shared__ float sc[4096]; __shared__ float qi_s[512]; __shared__ float w_s[8]; __shared__ int sel[256]; __shared__ int cnt_s; __shared__ int red[4]; __shared__ float lg[4][256];
    const int t = blockIdx.x, n = t + 1, tid = threadIdx.x, lane = tid & 63, wv = tid >> 6;
    for (int i = tid; i < 512; i += 256) qi_s[i] = QI[(size_t)t * 512 + i];
    if (tid < 8) w_s[tid] = P[(size_t)t * INW + O_WI + tid] * 0.35355339059327373f;
    if (tid == 0) cnt_s = 0;
    __syncthreads();
    int nsel;
    if (n <= 256) { for (int i = tid; i < n; i += 256) sel[i] = i; nsel = n; __syncthreads(); }
    else {
        for (int s = tid; s < n; s += 256) {
            const float* kr = KI + (size_t)s * 64; float acc = 0.f;
            for (int h = 0; h < 8; ++h) { float d = 0.f;
                for (int e = 0; e < 64; ++e) d = fmaf(qi_s[h * 64 + e], kr[e], d);
                acc += w_s[h] * fmaxf(d * 0.125f, 0.f); }
            sc[s] = acc;
        }
        __syncthreads();
        unsigned T = 0u;
        for (int bit = 31; bit >= 0; --bit) {
            unsigned cand = T | (1u << bit); int c = 0;
            for (int s = tid; s < n; s += 256) c += (fkey(sc[s]) >= cand) ? 1 : 0;
            c = (int)wsum((float)c); if (lane == 0) red[wv] = c; __syncthreads();
            int tot = red[0] + red[1] + red[2] + red[3]; __syncthreads();
            if (tot >= 256) T = cand;
        }
        for (int s = tid; s < n; s += 256) if (fkey(sc[s]) > T) { int p = atomicAdd(&cnt_s, 1); sel[p] = s; }
        __syncthreads();
        if (tid == 0) { int c = cnt_s; for (int s = 0; s < n && c < 256; ++s) if (fkey(sc[s]) == T) sel[c++] = s; cnt_s = c; }
        __syncthreads();
        nsel = 256;
    }
    const int h = wv; const float q = Q[(size_t)t * 256 + h * 64 + lane];
    for (int j = 0; j < nsel; ++j) { float d = wsum(q * K[(size_t)sel[j] * 256 + h * 64 + lane]); if (lane == 0) lg[h][j] = d * 0.125f; }
    __syncthreads();
    float mx = -INFINITY; for (int j = lane; j < nsel; j += 64) mx = fmaxf(mx, lg[h][j]); mx = wmax(mx);
    float sm = 0.f; for (int j = lane; j < nsel; j += 64) sm += expf(lg[h][j] - mx); sm = wsum(sm);
    float o = 0.f; for (int j = 0; j < nsel; ++j) o = fmaf(expf(lg[h][j] - mx) / sm, P[(size_t)sel[j] * INW + O_BV + h * 64 + lane], o);
    Y[(size_t)t * D + 256 + h * 64 + lane] = o;
}

__global__ void __launch_bounds__(64) mlstm_naive(const float* P, const float* ibias, const float* fbias, const float* mnorm, float* Y) {
    const int h = blockIdx.x, e = threadIdx.x;
    float C[64];
#pragma unroll
    for (int d = 0; d < 64; ++d) C[d] = 0.f;
    float nn = 0.f; const float ib = ibias[h], fb = fbias[h], gn = mnorm[h * 64 + e];
    for (int t = 0; t < S; ++t) {
        const float* p = P + (size_t)t * INW;
        const float q = p[O_CQ + h * 64 + e], k = p[O_CK + h * 64 + e] * 0.125f, v = p[O_CV + h * 64 + e];
        const float ig = expf(p[O_CI + h] + ib), fg = sigmoidf(p[O_CF + h] + fb);
        float a0 = 0.f, a1 = 0.f, a2 = 0.f, a3 = 0.f; const float iv = ig * v;
#pragma unroll
        for (int d = 0; d < 64; d += 4) {
            C[d] = fmaf(fg, C[d], __shfl(k, d) * iv); a0 = fmaf(__shfl(q, d), C[d], a0);
            C[d + 1] = fmaf(fg, C[d + 1], __shfl(k, d + 1) * iv); a1 = fmaf(__shfl(q, d + 1), C[d + 1], a1);
            C[d + 2] = fmaf(fg, C[d + 2], __shfl(k, d + 2) * iv); a2 = fmaf(__shfl(q, d + 2), C[d + 2], a2);
            C[d + 3] = fmaf(fg, C[d + 3], __shfl(k, d + 3) * iv); a3 = fmaf(__shfl(q, d + 3), C[d + 3], a3);
        }
        nn = fmaf(fg, nn, ig * k);
        const float qn = wsum(q * nn); const float hv = ((a0 + a1) + (a2 + a3)) / fmaxf(fabsf(qn), 1.f);
        const float r = rsqrtf(wsum(hv * hv) / 64.f + EPS);
        Y[(size_t)t * D + 512 + h * 64 + e] = sigmoidf(p[O_CO + h * 64 + e]) * hv * r * gn;
    }
}

__global__ void conv_naive(const float* P, const float* cw, float* Y) {
    int t = blockIdx.x, c = threadIdx.x; float acc = 0.f;
#pragma unroll
    for (int j = 0; j < 3; ++j) { int tt = t - 2 + j; if (tt >= 0) acc = fmaf(cw[j * 256 + c], P[(size_t)tt * INW + O_DC + c] * P[(size_t)tt * INW + O_DX + c], acc); }
    Y[(size_t)t * D + 768 + c] = P[(size_t)t * INW + O_DB + c] * acc;
}

__global__ void merge_naive(const float* P, const float* BR, float* MG) {
    int t = blockIdx.x; for (int c = threadIdx.x; c < D; c += 256) { float a = 0.f;
#pragma unroll
        for (int n = 0; n < 4; ++n) a += sigmoidf(P[(size_t)t * INW + O_G + n * 1024 + c]) * BR[(size_t)t * 4096 + n * 1024 + c];
        MG[(size_t)t * D + c] = a; }
}
}

extern "C" void kernel_launch(void* const* d_in, const int* in_sizes, int n_in, void* d_out, int out_size, void* d_ws, size_t ws_size, hipStream_t stream) {
    using namespace nv;
    const float* x = (const float*)d_in[0]; const float* ln_mix = (const float*)d_in[1]; const float* w_in = (const float*)d_in[2];
    const float* sgu_norm = (const float*)d_in[3]; const float* sgu_w = (const float*)d_in[4]; const float* sgu_b = (const float*)d_in[5];
    const float* q_norm = (const float*)d_in[6]; const float* k_norm = (const float*)d_in[7]; const float* kidx_norm = (const float*)d_in[8];
    const float* i_bias = (const float*)d_in[9]; const float* f_bias = (const float*)d_in[10]; const float* mnorm = (const float*)d_in[11];
    const float* conv_w = (const float*)d_in[12]; const float* w_branch = (const float*)d_in[13]; const float* w_out = (const float*)d_in[14];
    const float* ln_mlp = (const float*)d_in[15]; const float* w_up = (const float*)d_in[16]; const float* w_down = (const float*)d_in[17];
    float* out = (float*)d_out; char* ws = (char*)d_ws; const size_t MiB = 1u << 20;
    float* H = (float*)(ws + 0);
    float* P = (float*)(ws + 16 * MiB);
    float* HID = (float*)(ws + 16 * MiB);
    float* Y = (float*)(ws + 138 * MiB);
    float* BR = (float*)(ws + 154 * MiB);
    float* MG = (float*)(ws + 218 * MiB);
    float* VN = (float*)(ws + 234 * MiB);
    float* Qb = (float*)(ws + 238 * MiB);
    float* Kb = (float*)(ws + 242 * MiB);
    float* QI = (float*)(ws + 246 * MiB);
    float* KI = (float*)(ws + 254 * MiB);
    hipMemcpyAsync(out, x, (size_t)NB * S * D * 4, hipMemcpyDeviceToDevice, stream);
    for (int l = 0; l < DEPTH; ++l) for (int b = 0; b < NB; ++b) {
        float* xb = out + (size_t)b * S * D;
        rmsnorm_rows<<<S / 4, 256, 0, stream>>>(xb, ln_mix + l * D, H, S);
        gemm_f32<0><<<dim3((INW + 63) / 64, S / 64), 256, 0, stream>>>(H, D, w_in + (size_t)l * D * INW, INW, P, INW, S, INW, D, nullptr, 0);
        prep_rows<<<S / 4, 256, 0, stream>>>(P, sgu_norm + l * 256, q_norm + l * 64, k_norm + l * 64, kidx_norm + l * 64, VN, Qb, Kb, QI, KI);
        sgu_naive<<<S, 256, 0, stream>>>(P, VN, sgu_w + (size_t)l * 4 * 128 * 128, sgu_b + l * 4 * 128, Y);
        dsa_naive<<<S, 256, 0, stream>>>(P, Qb, Kb, QI, KI, Y);
        mlstm_naive<<<4, 64, 0, stream>>>(P, i_bias + l * 4, f_bias + l * 4, mnorm + l * 256, Y);
        conv_naive<<<S, 256, 0, stream>>>(P, conv_w + l * 3 * 256, Y);
        for (int n = 0; n < 4; ++n)
            gemm_f32<0><<<dim3(D / 64, S / 64), 256, 0, stream>>>(Y + n * 256, D, w_branch + ((size_t)l * 4 + n) * 256 * D, D, BR + n * 1024, 4096, S, D, 256, nullptr, 0);
        merge_naive<<<S, 256, 0, stream>>>(P, BR, MG);
        gemm_f32<1><<<dim3(D / 64, S / 64), 256, 0, stream>>>(MG, D, w_out + (size_t)l * D * D, D, xb, D, S, D, D, xb, D);
        rmsnorm_rows<<<S / 4, 256, 0, stream>>>(xb, ln_mlp + l * D, H, S);
        gemm_f32<2><<<dim3(FF / 64, S / 64), 256, 0, stream>>>(H, D, w_up + (size_t)l * D * FF, FF, HID, FF, S, FF, D, nullptr, 0);
        gemm_f32<1><<<dim3(D / 64, S / 64), 256, 0, stream>>>(HID, FF, w_down + (size_t)l * FF * D, D, xb, D, S, D, FF, xb, D);
    }
}
```

```cpp
#define MK_MULTI 0
#include <hip/hip_runtime.h>
#include <hip/hip_cooperative_groups.h>
#include <cstdio>
#include <cstdint>
namespace cg = cooperative_groups;

#define LAS __attribute__((address_space(3)))
typedef unsigned short bf16_t;
typedef short bf16x8 __attribute__((ext_vector_type(8)));
typedef float f32x4 __attribute__((ext_vector_type(4)));
typedef float f32x2 __attribute__((ext_vector_type(2)));
typedef unsigned u32x4 __attribute__((ext_vector_type(4)));
typedef unsigned u32x2 __attribute__((ext_vector_type(2)));

constexpr int D = 1024, NB = 4, S = 4096, M = NB * S, DEPTH = 2, FF = 4096, INW = 7760;
constexpr int O_AU = 0, O_AV = 256, O_BQ = 512, O_BK = 768, O_BV = 1024, O_QI = 1280, O_KI = 1792, O_WI = 1856,
              O_CQ = 1864, O_CK = 2120, O_CV = 2376, O_CO = 2632, O_CI = 2888, O_CF = 2892, O_DB = 2896, O_DC = 3152, O_DX = 3408, O_G = 3664;
constexpr int PW = 3840;
constexpr int P_AU = 0, P_AV = 256, P_Q = 512, P_K = 768, P_V = 1024, P_QI = 1280, P_CQ = 1792, P_CK = 2048, P_CV = 2304, P_CO = 2560,
              P_DB = 2816, P_DC = 3072, P_DX = 3328, P_KI = 3584;
constexpr float EPS = 1e-6f;
constexpr int NWAVES = 8, NT = 512;

constexpr size_t MiB = 1u << 20;
constexpr size_t WS_CTL = 0;
constexpr size_t WS_COS = 1 * MiB, WS_SIN = 1 * MiB + 512 * 1024;
constexpr size_t WS_MISC = 2 * MiB;
constexpr size_t WS_SSQA = 3 * MiB, WS_SSQB = 4 * MiB;
constexpr size_t WS_WIN = 5 * MiB;
constexpr size_t WS_WG = WS_WIN + (size_t)PW * D * 2;
constexpr size_t WS_WBR = WS_WG + (size_t)4096 * D * 2;
constexpr size_t WS_WOUT = WS_WBR + (size_t)4 * 1024 * 256 * 2;
constexpr size_t WS_XG = 25 * MiB;
constexpr size_t WS_BIG = 57 * MiB;
constexpr size_t WS_Y = 185 * MiB;
constexpr size_t WS_WUP = WS_Y, WS_WDN = WS_Y + 8 * MiB;
constexpr size_t WS_MG = 217 * MiB;
constexpr size_t WS_MASK = WS_MG, WS_STATE = WS_MG + 8 * MiB;
constexpr size_t WS_END = 249 * MiB;
constexpr int STATE_STRIDE = 4224;
static_assert(WS_WOUT + (size_t)D * D * 2 <= WS_XG && WS_STATE + (size_t)512 * STATE_STRIDE * 4 <= WS_END && WS_END <= 256 * MiB, "d_ws map");

constexpr int LDS_BYTES = 155648;

__device__ __forceinline__ float bf2f(bf16_t v) { return __uint_as_float((unsigned)v << 16); }
__device__ __forceinline__ unsigned f2bf(float f) { unsigned u = __float_as_uint(f); return (u + 0x7fffu + ((u >> 16) & 1u)) >> 16; }
__device__ __forceinline__ unsigned pk2(float lo, float hi) { return f2bf(lo) | (f2bf(hi) << 16); }
__device__ __forceinline__ unsigned cvt_pk_bf16(float lo, float hi) { unsigned r; asm volatile("v_cvt_pk_bf16_f32 %0, %1, %2" : "=v"(r) : "v"(lo), "v"(hi)); return r; }
__device__ __forceinline__ float lo_bf(unsigned w) { return __uint_as_float(w << 16); }
__device__ __forceinline__ float hi_bf(unsigned w) { return __uint_as_float(w & 0xffff0000u); }
__device__ __forceinline__ float wave_sum(float v) {
#pragma unroll
    for (int o = 1; o < 64; o <<= 1) v += __shfl_xor(v, o);
    return v;
}
__device__ __forceinline__ float wave_max(float v) {
#pragma unroll
    for (int o = 1; o < 64; o <<= 1) v = fmaxf(v, __shfl_xor(v, o));
    return v;
}
__device__ __forceinline__ int wave_sum_i(int v) {
#pragma unroll
    for (int o = 1; o < 64; o <<= 1) v += __shfl_xor(v, o);
    return v;
}
__device__ __forceinline__ float sigmoid_f(float x) { return 1.f / (1.f + __expf(-x)); }
__device__ __forceinline__ float gelu_tanh_f(float x) { const float u = 0.7978845608028654f * (x + 0.044715f * x * x * x); return x / (1.f + __expf(-2.f * u)); }
__device__ __forceinline__ unsigned fkey(float s) { const unsigned u = __float_as_uint(s); return (u & 0x80000000u) ? ~u : (u | 0x80000000u); }

namespace pg8 {
constexpr int BM = 256, BK = 64, HALF = 128, HTB = HALF * BK * 2, STAGE_BYTES = 8 * HTB, NXCD = 8, WGM = 8;
__host__ __device__ __forceinline__ int lds_byte(int r, int c) { const int st = (r >> 4) * 2 + (c >> 5), rr = r & 15, cc = c & 31, ob = rr * 64 + cc * 2; return st * 1024 + (ob ^ (((ob >> 9) & 1) << 5)); }
__host__ __device__ __forceinline__ void stage_rc(int b, int& R, int& C) { const int st = b / 1024, sb = b % 1024, swz = sb ^ (((sb >> 9) & 1) << 5); R = (st >> 1) * 16 + swz / 64; C = (st & 1) * 32 + (swz % 64) / 2; }
__host__ __device__ __forceinline__ int perm32(int rho) { const int n = rho >> 4, i = rho & 15; return 8 * (i >> 2) + 4 * n + (i & 3); }

struct Unit { int pm, pn, z; };
template <int K_, int LDA_, int LDB_, unsigned APM_, unsigned AZ_, unsigned BPN_, unsigned BZ_> struct Gemm {
    const bf16_t* A; const bf16_t* Bt;
    static constexpr int K = K_, lda = LDA_, ldb = LDB_; static constexpr unsigned aPm = APM_, aZ = AZ_, bPn = BPN_, bZ = BZ_;
};
template <class G> __device__ __forceinline__ const char* pa(const G& g, const Unit& u) { return (const char*)g.A + (size_t)((unsigned)u.pm * G::aPm + (unsigned)u.z * G::aZ); }
template <class G> __device__ __forceinline__ const char* pb(const G& g, const Unit& u) { return (const char*)g.Bt + (size_t)((unsigned)u.pn * G::bPn + (unsigned)u.z * G::bZ); }

struct StaticOrder {
    int nM, nN, nwg, G, c;
    __host__ __device__ void init(int M_, int N_, int G_, int c_) { nM = M_ / BM; nN = N_ / BM; nwg = nM * nN; G = G_; c = c_; }
    __host__ __device__ bool next(int i, Unit& u) const {
        const long L = (long)i * G + c; if (L >= nwg) return false;
        int wgid = (int)L; { const int q = nwg / NXCD, r = nwg % NXCD, xcd = wgid % NXCD, off = wgid / NXCD; wgid = (xcd < r ? xcd * (q + 1) : r * (q + 1) + (xcd - r) * q) + off; }
        const int nig = WGM * nN, gid = wgid / nig, fm = gid * WGM, gsz = (nM - fm) < WGM ? (nM - fm) : WGM;
        u.pm = fm + ((wgid % nig) % gsz); u.pn = (wgid % nig) / gsz; u.z = 0; return true;
    }
};
template <int MODE> struct SuperOrder {
    StaticOrder so;
    __host__ __device__ void init(int G_, int c_) { so.init(M, 1024, G_, c_); }
    __host__ __device__ bool next(int i, Unit& u) const {
        Unit b; if (!so.next(i >> 2, b)) return false;
        const int sub = i & 3; u.pm = b.pm; if (MODE == 0) { u.pn = b.pn; u.z = sub; } else { u.pn = 4 * b.pn + sub; u.z = 0; } return true;
    }
};

template <class Epi, class Sched, bool ALIGN_EPI, class GemmT>
__device__ __forceinline__ void gemm_phase(LAS unsigned char* lds, const GemmT g, const Sched& S, const Epi& E, const int tid) {
    const int wid = __builtin_amdgcn_readfirstlane(tid >> 6), lane = tid & 63, wr = wid >> 2, wc = wid & 3, fr = lane & 15, fq = lane >> 4;
    constexpr int K = GemmT::K, nt = K / BK;
    unsigned voffA[2], voffB[2];
#pragma unroll
    for (int i = 0; i < 2; ++i) { int R, C; stage_rc(tid * 16 + i * 8192, R, C); const int Rb = Epi::PERM ? ((R & ~31) + perm32(R & 31)) : R;
        voffA[i] = (unsigned)(R * GemmT::lda + C) * 2u; voffB[i] = (unsigned)(Rb * GemmT::ldb + C) * 2u; }
    const size_t kstep = (size_t)(BK * 2);
    constexpr size_t hA = (size_t)HALF * GemmT::lda * 2, hB = (size_t)HALF * GemmT::ldb * 2;
    const unsigned ldsw = (unsigned)wid * 1024u;
    const int aoff = lds_byte(wr * 64 + fr, fq * 8), boff = lds_byte(wc * 32 + fr, fq * 8);
#define PG8_SA(b, h) (((b) * 2 + (h)) * HTB)
#define PG8_SB(b, h) ((4 + (b) * 2 + (h)) * HTB)
#define PG8_STAGE(bufoff, gbase, voff) do { _Pragma("unroll") for (int _i = 0; _i < 2; ++_i) \
        __builtin_amdgcn_global_load_lds((const unsigned*)((const char*)(gbase) + (voff)[_i]), (LAS unsigned*)(lds + (bufoff) + ldsw + _i * 8192), 16, 0, 0); } while (0)
#define PG8_LDA(dst, b, h) do { _Pragma("unroll") for (int m = 0; m < 4; ++m) _Pragma("unroll") for (int k = 0; k < 2; ++k) dst[m][k] = *(const LAS bf16x8*)(lds + PG8_SA(b, h) + aoff + m * 2048 + k * 1024); } while (0)
#define PG8_LDB(dst, b, h) do { _Pragma("unroll") for (int n = 0; n < 2; ++n) _Pragma("unroll") for (int k = 0; k < 2; ++k) dst[n][k] = *(const LAS bf16x8*)(lds + PG8_SB(b, h) + boff + n * 2048 + k * 1024); } while (0)
#define PG8_MMA(ai, bj, At, Bt) do { __builtin_amdgcn_s_setprio(1); _Pragma("unroll") for (int m = 0; m < 4; ++m) _Pragma("unroll") for (int n = 0; n < 2; ++n) _Pragma("unroll") for (int k = 0; k < 2; ++k) \
        acc[ai][bj][m][n] = __builtin_amdgcn_mfma_f32_16x16x32_bf16(Bt[n][k], At[m][k], acc[ai][bj][m][n], 0, 0, 0); __builtin_amdgcn_s_setprio(0); } while (0)
#define PG8_WAIT_V(n) asm volatile("s_waitcnt vmcnt(" #n ")" ::: "memory")
#define PG8_WAIT_L(n) asm volatile("s_waitcnt lgkmcnt(" #n ")" ::: "memory")
#define PG8_BAR __builtin_amdgcn_s_barrier()
#define PG8_SCHED __builtin_amdgcn_sched_barrier(0)
    Unit cur, nxt; int ui = 0;
    if (!S.next(0, cur)) return;
    f32x4 acc[2][2][4][2];
#pragma unroll
    for (int a = 0; a < 2; ++a)
#pragma unroll
        for (int b = 0; b < 2; ++b)
#pragma unroll
            for (int m = 0; m < 4; ++m)
#pragma unroll
                for (int n = 0; n < 2; ++n) acc[a][b][m][n] = (f32x4){0.f, 0.f, 0.f, 0.f};
    bf16x8 At[4][2], B0[2][2], B1[2][2];
    const char* cA = pa(g, cur); const char* cB = pb(g, cur);
    PG8_STAGE(PG8_SB(0, 0), cB, voffB); PG8_STAGE(PG8_SB(0, 1), cB + hB, voffB); PG8_STAGE(PG8_SA(0, 0), cA, voffA); PG8_STAGE(PG8_SA(0, 1), cA + hA, voffA);
    if (wr == 1) PG8_BAR;
    PG8_WAIT_V(2); PG8_BAR;
    PG8_STAGE(PG8_SB(1, 0), cB + kstep, voffB); PG8_STAGE(PG8_SA(1, 0), cA + kstep, voffA); PG8_STAGE(PG8_SB(1, 1), cB + hB + kstep, voffB);
    PG8_WAIT_V(6); PG8_BAR;
    for (;;) {
        const bool has_next = S.next(ui + 1, nxt);
        const char* nA = has_next ? pa(g, nxt) : cA; const char* nB = has_next ? pb(g, nxt) : cB;
#pragma unroll 1
        for (int t = 0; t < nt; t += 2) {
            const bool last = (t == nt - 2);
            const char* a1 = cA + (size_t)(t + 1) * kstep;
            const char* a2 = last ? nA : cA + (size_t)(t + 2) * kstep; const char* b2 = last ? nB : cB + (size_t)(t + 2) * kstep;
            const char* a3 = a2 + kstep; const char* b3 = b2 + kstep;
            PG8_LDB(B0, 0, 0); PG8_LDB(B1, 0, 1); PG8_SCHED; PG8_LDA(At, 0, 0); PG8_STAGE(PG8_SA(1, 1), a1 + hA, voffA);
            PG8_WAIT_V(8); PG8_WAIT_L(0); PG8_BAR; PG8_MMA(0, 0, At, B0); PG8_MMA(0, 1, At, B1); PG8_BAR; PG8_SCHED;
            PG8_LDA(At, 0, 1); PG8_STAGE(PG8_SB(0, 0), b2, voffB); PG8_STAGE(PG8_SB(0, 1), b2 + hB, voffB); PG8_STAGE(PG8_SA(0, 0), a2, voffA);
            PG8_WAIT_V(8); PG8_WAIT_L(0); PG8_BAR; PG8_MMA(1, 0, At, B0); PG8_MMA(1, 1, At, B1); PG8_BAR; PG8_SCHED;
            PG8_LDB(B0, 1, 0); PG8_LDB(B1, 1, 1); PG8_SCHED; PG8_LDA(At, 1, 0); PG8_STAGE(PG8_SA(0, 1), a2 + hA, voffA);
            PG8_WAIT_V(8); PG8_WAIT_L(0); PG8_BAR; PG8_MMA(0, 0, At, B0); PG8_MMA(0, 1, At, B1); PG8_BAR; PG8_SCHED;
            PG8_LDA(At, 1, 1); PG8_STAGE(PG8_SB(1, 0), b3, voffB); PG8_STAGE(PG8_SB(1, 1), b3 + hB, voffB); PG8_STAGE(PG8_SA(1, 0), a3, voffA);
            PG8_WAIT_V(8); PG8_WAIT_L(0); PG8_BAR; PG8_MMA(1, 0, At, B0); PG8_MMA(1, 1, At, B1); PG8_BAR; PG8_SCHED;
        }
        if constexpr (ALIGN_EPI) { if (wr == 0) PG8_BAR; }
        { int fr2 = fr, fq2 = fq; asm volatile("" : "+v"(fr2), "+v"(fq2)); E(acc, cur, wr, wc, fr2, fq2); }
        if (!has_next) break;
#pragma unroll
        for (int a = 0; a < 2; ++a)
#pragma unroll
            for (int b = 0; b < 2; ++b)
#pragma unroll
                for (int m = 0; m < 4; ++m)
#pragma unroll
                    for (int n = 0; n < 2; ++n) acc[a][b][m][n] = (f32x4){0.f, 0.f, 0.f, 0.f};
        cur = nxt; cA = nA; cB = nB; ++ui;
        if constexpr (ALIGN_EPI) { if (wr == 1) PG8_BAR; }
    }
    PG8_WAIT_V(0);
    if constexpr (!ALIGN_EPI) { if (wr == 0) PG8_BAR; }
    PG8_BAR;
#undef PG8_SA
#undef PG8_SB
#undef PG8_STAGE
#undef PG8_LDA
#undef PG8_LDB
#undef PG8_MMA
#undef PG8_WAIT_V
#undef PG8_WAIT_L
#undef PG8_BAR
#undef PG8_SCHED
}
}
namespace epi {
using pg8::Unit;
typedef f32x4 Acc[2][2][4][2];

__device__ __forceinline__ float row_scale(const float* ssq, int row) {
    const f32x4* sp = (const f32x4*)(ssq + (size_t)row * 16);
    const f32x4 a = sp[0], b = sp[1], c = sp[2], d = sp[3];
    const float t = ((a[0] + a[1]) + (a[2] + a[3])) + ((b[0] + b[1]) + (b[2] + b[3])) + ((c[0] + c[1]) + (c[2] + c[3])) + ((d[0] + d[1]) + (d[2] + d[3]));
    return rsqrtf(t * (1.0f / 1024.0f) + EPS);
}
__device__ __forceinline__ u32x4 pack8(const f32x4 a, const f32x4 b) { u32x4 w; w.x = cvt_pk_bf16(a[0], a[1]); w.y = cvt_pk_bf16(a[2], a[3]); w.z = cvt_pk_bf16(b[0], b[1]); w.w = cvt_pk_bf16(b[2], b[3]); return w; }

struct EpiProj {
    static constexpr bool PERM = true;
    bf16_t* P; float* misc; const float* ssq; const float* cs; const float* sn; const float* gt;
    __device__ __forceinline__ void operator()(const Acc& acc, const Unit& u, int wr, int wc, int fr, int fq) const {
        const int T = u.pn; const int row0 = u.pm * 256 + wr * 64 + fr;
        if (T == 2 || T == 3 || T == 5 || T == 6 || T == 14) {
            if (T == 14 && wc >= 2) return;
            if (T == 14 && wc == 1) {
                if (fq < 2) {
#pragma unroll
                    for (int ai = 0; ai < 2; ++ai)
#pragma unroll
                        for (int m = 0; m < 4; ++m) { const int row = row0 + ai * 128 + m * 16; const float rs = row_scale(ssq, row);
                            float* mp = misc + (size_t)row * 16 + 8 * fq; *(f32x4*)mp = acc[ai][0][m][0] * rs; *(f32x4*)(mp + 4) = acc[ai][0][m][1] * rs; }
                }
                return;
            }
            const int mode = (T == 14) ? 2 : (T <= 3 ? 1 : 0);
            const float* gp = gt + 64 * ((T == 2) ? 0 : (T == 3) ? 1 : 2);
            f32x4 g1[2], g2[2];
#pragma unroll
            for (int n = 0; n < 2; ++n) { if (mode) { g1[n] = *(const f32x4*)(gp + 8 * fq + 4 * n); g2[n] = *(const f32x4*)(gp + 32 + 8 * fq + 4 * n); } else { g1[n] = (f32x4){1.f, 1.f, 1.f, 1.f}; g2[n] = g1[n]; } }
#pragma unroll
            for (int ai = 0; ai < 2; ++ai)
#pragma unroll
                for (int m = 0; m < 4; ++m) {
                    const int row = row0 + ai * 128 + m * 16; const float rs = row_scale(ssq, row); const int pos = row & (S - 1);
                    f32x4 x1[2], x2[2];
#pragma unroll
                    for (int n = 0; n < 2; ++n) { x1[n] = acc[ai][0][m][n] * rs; x2[n] = acc[ai][1][m][n] * rs; }
                    if (mode == 2) {
                        float s = 0.f;
#pragma unroll
                        for (int n = 0; n < 2; ++n) s += (x1[n][0] + x1[n][1]) + (x1[n][2] + x1[n][3]) + (x2[n][0] + x2[n][1]) + (x2[n][2] + x2[n][3]);
                        s += __shfl_xor(s, 16); s += __shfl_xor(s, 32); const float mu = s * (1.f / 64.f);
#pragma unroll
                        for (int n = 0; n < 2; ++n) { x1[n] = x1[n] - mu; x2[n] = x2[n] - mu; }
                    }
                    if (mode) {
                        float q = 0.f;
#pragma unroll
                        for (int n = 0; n < 2; ++n) { const f32x4 a = x1[n] * x1[n], b = x2[n] * x2[n]; q += (a[0] + a[1]) + (a[2] + a[3]) + (b[0] + b[1]) + (b[2] + b[3]); }
                        q += __shfl_xor(q, 16); q += __shfl_xor(q, 32); const float rr = rsqrtf(q * (1.f / 64.f) + EPS);
#pragma unroll
                        for (int n = 0; n < 2; ++n) { x1[n] = x1[n] * rr * g1[n]; x2[n] = x2[n] * rr * g2[n]; }
                    }
                    f32x4 o1[2], o2[2];
#pragma unroll
                    for (int n = 0; n < 2; ++n) { const f32x4 c = *(const f32x4*)(cs + (size_t)pos * 32 + 8 * fq + 4 * n), s = *(const f32x4*)(sn + (size_t)pos * 32 + 8 * fq + 4 * n);
                        o1[n] = x1[n] * c - x2[n] * s; o2[n] = x2[n] * c + x1[n] * s; }
                    bf16_t* op = P + (size_t)row * PW + 256 * T + 64 * wc + 8 * fq;
                    *(u32x4*)op = pack8(o1[0], o1[1]); *(u32x4*)(op + 32) = pack8(o2[0], o2[1]);
                }
            return;
        }
        const int act = (T <= 1) ? 1 : 0; const float sc = (T == 8) ? 0.125f : 1.0f;
#pragma unroll
        for (int ai = 0; ai < 2; ++ai)
#pragma unroll
            for (int m = 0; m < 4; ++m) {
                const int row = row0 + ai * 128 + m * 16; const float rs = row_scale(ssq, row) * sc;
                bf16_t* op = P + (size_t)row * PW + 256 * T + 32 * wc + 8 * fq;
#pragma unroll
                for (int bj = 0; bj < 2; ++bj) { f32x4 v0 = acc[ai][bj][m][0] * rs, v1 = acc[ai][bj][m][1] * rs;
                    if (act) {
#pragma unroll
                        for (int e = 0; e < 4; ++e) { v0[e] = gelu_tanh_f(v0[e]); v1[e] = gelu_tanh_f(v1[e]); } }
                    *(u32x4*)(op + bj * 128) = pack8(v0, v1); }
            }
    }
};

struct EpiPlain {
    static constexpr bool PERM = true;
    bf16_t* O; int ldc; int zcols;
    __device__ __forceinline__ void operator()(const Acc& acc, const Unit& u, int wr, int wc, int fr, int fq) const {
        const int row0 = u.pm * 256 + wr * 64 + fr; const int col0 = u.z * zcols + u.pn * 256 + 32 * wc + 8 * fq;
#pragma unroll
        for (int ai = 0; ai < 2; ++ai)
#pragma unroll
            for (int m = 0; m < 4; ++m) { bf16_t* op = O + (size_t)(row0 + ai * 128 + m * 16) * ldc + col0;
#pragma unroll
                for (int bj = 0; bj < 2; ++bj) *(u32x4*)(op + bj * 128) = pack8(acc[ai][bj][m][0], acc[ai][bj][m][1]); }
    }
};

struct EpiGate {
    static constexpr bool PERM = true;
    bf16_t* MG; const bf16_t* BR; const float* ssq;
    __device__ __forceinline__ void operator()(const Acc& acc, const Unit& u, int wr, int wc, int fr, int fq) const {
        const int row0 = u.pm * 256 + wr * 64 + fr; const int ch0 = u.pn * 64 + 16 * wc + 4 * fq;
#pragma unroll
        for (int ai = 0; ai < 2; ++ai)
#pragma unroll
            for (int m = 0; m < 4; ++m) {
                const int row = row0 + ai * 128 + m * 16; const float rs = row_scale(ssq, row);
                const bf16_t* bp = BR + (size_t)row * 4096 + ch0; f32x4 o = (f32x4){0.f, 0.f, 0.f, 0.f};
#pragma unroll
                for (int bj = 0; bj < 2; ++bj)
#pragma unroll
                    for (int n = 0; n < 2; ++n) { const u32x2 w = *(const u32x2*)(bp + (2 * bj + n) * 1024); const f32x4 a = acc[ai][bj][m][n] * rs;
                        o[0] += sigmoid_f(a[0]) * lo_bf(w.x); o[1] += sigmoid_f(a[1]) * hi_bf(w.x); o[2] += sigmoid_f(a[2]) * lo_bf(w.y); o[3] += sigmoid_f(a[3]) * hi_bf(w.y); }
                u32x2 ow; ow.x = cvt_pk_bf16(o[0], o[1]); ow.y = cvt_pk_bf16(o[2], o[3]);
                *(u32x2*)(MG + (size_t)row * 1024 + ch0) = ow;
            }
    }
};

struct EpiResid {
    static constexpr bool PERM = true;
    const float* res; float* out; bf16_t* XG; const float* gain; float* ssq;
    __device__ __forceinline__ void operator()(const Acc& acc, const Unit& u, int wr, int wc, int fr, int fq) const {
        const int row0 = u.pm * 256 + wr * 64 + fr; const int col0 = u.pn * 256 + 32 * wc + 8 * fq;
        f32x4 gv[2][2];
#pragma unroll
        for (int bj = 0; bj < 2; ++bj)
#pragma unroll
            for (int n = 0; n < 2; ++n) gv[bj][n] = gain ? *(const f32x4*)(gain + col0 + bj * 128 + 4 * n) : (f32x4){1.f, 1.f, 1.f, 1.f};
#pragma unroll
        for (int ai = 0; ai < 2; ++ai)
#pragma unroll
            for (int m = 0; m < 4; ++m) {
                const int row = row0 + ai * 128 + m * 16; const size_t off = (size_t)row * 1024 + col0; float q = 0.f;
#pragma unroll
                for (int bj = 0; bj < 2; ++bj) {
                    const f32x4 r0 = *(const f32x4*)(res + off + bj * 128), r1 = *(const f32x4*)(res + off + bj * 128 + 4);
                    const f32x4 x0 = r0 + acc[ai][bj][m][0], x1 = r1 + acc[ai][bj][m][1];
                    *(f32x4*)(out + off + bj * 128) = x0; *(f32x4*)(out + off + bj * 128 + 4) = x1;
                    const f32x4 a = x0 * x0, b = x1 * x1; q += ((a[0] + a[1]) + (a[2] + a[3])) + ((b[0] + b[1]) + (b[2] + b[3]));
                    *(u32x4*)(XG + off + bj * 128) = pack8(x0 * gv[bj][0], x1 * gv[bj][1]);
                }
                q += __shfl_xor(q, 16); q += __shfl_xor(q, 32);
                if (fq == 0) ssq[(size_t)row * 16 + 4 * u.pn + wc] = q;
            }
    }
};

struct EpiUp {
    static constexpr bool PERM = true;
    bf16_t* H; const float* ssq;
    __device__ __forceinline__ void operator()(const Acc& acc, const Unit& u, int wr, int wc, int fr, int fq) const {
        const int row0 = u.pm * 256 + wr * 64 + fr; const int col0 = u.pn * 256 + 32 * wc + 8 * fq;
#pragma unroll
        for (int ai = 0; ai < 2; ++ai)
#pragma unroll
            for (int m = 0; m < 4; ++m) { const int row = row0 + ai * 128 + m * 16; const float rs = row_scale(ssq, row); bf16_t* op = H + (size_t)row * FF + col0;
#pragma unroll
                for (int bj = 0; bj < 2; ++bj) { f32x4 v0 = acc[ai][bj][m][0] * rs, v1 = acc[ai][bj][m][1] * rs;
#pragma unroll
                    for (int e = 0; e < 4; ++e) { v0[e] = fmaxf(v0[e], 0.f); v1[e] = fmaxf(v1[e], 0.f); }
                    *(u32x4*)(op + bj * 128) = pack8(v0 * v0, v1 * v1); } }
    }
};
}
struct Args {
    const float* in[18]; float* out; unsigned char* ws; int ph_lo, ph_hi; int coop, pad;
};
struct Frame { LAS unsigned char* lds; int tid, lane, wave, G, vcu; };
constexpr int PTR_OFF = LDS_BYTES - 512;
enum { I_X = 0, I_LN_MIX, I_W_IN, I_SGU_NORM, I_SGU_W, I_SGU_B, I_Q_NORM, I_K_NORM, I_KIDX_NORM, I_I_BIAS, I_F_BIAS, I_MNORM, I_CONV_W, I_W_BRANCH, I_W_OUT, I_LN_MLP, I_W_UP, I_W_DOWN, I_OUT, I_WS };
__device__ __forceinline__ unsigned char* ptr_at(const Frame& F, int i) { const LAS unsigned* p = (const LAS unsigned*)(F.lds + PTR_OFF) + 2 * i;
    const unsigned lo = __builtin_amdgcn_readfirstlane(p[0]), hi = __builtin_amdgcn_readfirstlane(p[1]); return (unsigned char*)(((unsigned long long)hi << 32) | lo); }
#define INP(i) ((const float*)ptr_at(F, (i)))
#define WSP(off) (ptr_at(F, I_WS) + (off))
constexpr size_t WS_GT = 512 * 1024;

__device__ __forceinline__ int win_src(int p) {
    const int T = p >> 8, q = p & 255, bj = q >> 7, wc = (q >> 5) & 3, j = q & 31, hd = 64 * wc + 32 * bj + j;
    switch (T) {
        case 0: return O_AU + q; case 1: return O_AV + q; case 2: return O_BQ + hd; case 3: return O_BK + hd; case 4: return O_BV + q;
        case 5: return O_QI + hd; case 6: return O_QI + 256 + hd; case 7: return O_CQ + q; case 8: return O_CK + q; case 9: return O_CV + q;
        case 10: return O_CO + q; case 11: return O_DB + q; case 12: return O_DC + q; case 13: return O_DX + q;
        default: break;
    }
    if (wc == 0) return O_KI + 32 * bj + j;
    if (wc == 1 && bj == 0 && j < 16) return j < 8 ? O_WI + j : (j < 12 ? O_CI + (j - 8) : O_CF + (j - 12));
    return -1;
}
__device__ __forceinline__ int wg_src(int p) {
    const int pn = p >> 8, q = p & 255, bj = q >> 7, wc = (q >> 5) & 3, fq = (q >> 3) & 3, n = (q >> 2) & 1, e = q & 3;
    return O_G + (2 * bj + n) * 1024 + 64 * pn + 16 * wc + 4 * fq + e;
}
template <int MAP>
__device__ __forceinline__ void conv_item(const float* W, int K, int srcN, bf16_t* WT, LAS float* scr, int item, int nrows, int lane) {
    const int nblk = nrows / 32, kb = item / nblk, nb = item % nblk, k0 = 64 * kb, n0 = 32 * nb;
    const int nn = n0 + (lane & 31); const int src = MAP == 0 ? nn : (MAP == 1 ? win_src(nn) : wg_src(nn));
#pragma unroll 8
    for (int i = 0; i < 32; ++i) { const int kk = 2 * i + (lane >> 5); scr[kk * 33 + (lane & 31)] = src >= 0 ? W[(size_t)(k0 + kk) * srcN + src] : 0.f; }
    asm volatile("s_waitcnt lgkmcnt(0)" ::: "memory");
    const int c = lane & 7;
#pragma unroll
    for (int j = 0; j < 4; ++j) { const int n = (lane >> 3) + 8 * j; const LAS float* s = scr + (8 * c) * 33 + n;
        u32x4 o; o.x = pk2(s[0 * 33], s[1 * 33]); o.y = pk2(s[2 * 33], s[3 * 33]); o.z = pk2(s[4 * 33], s[5 * 33]); o.w = pk2(s[6 * 33], s[7 * 33]);
        *(u32x4*)(WT + (size_t)(n0 + n) * K + k0 + 8 * c) = o; }
    asm volatile("s_waitcnt lgkmcnt(0)" ::: "memory");
}
__device__ __forceinline__ void convert_mix_weights(Frame& F, int l) {

    LAS float* scr = (LAS float*)(F.lds + F.wave * 16384);
    const int gw = F.vcu * NWAVES + F.wave, NGW = F.G * NWAVES;
    constexpr int I_WIN = (D / 64) * (PW / 32), I_WG = (D / 64) * (4096 / 32), I_BR = (256 / 64) * (1024 / 32), I_OUT = (D / 64) * (D / 32);
    constexpr int NIT = I_WIN + I_WG + 4 * I_BR + I_OUT;
    const float* win = INP(I_W_IN) + (size_t)l * D * INW;
    for (int it = gw; it < NIT; it += NGW) {
        int r = it;
        if (r < I_WIN) { conv_item<1>(win, D, INW, ((bf16_t*)WSP(WS_WIN)), scr, r, PW, F.lane); continue; } r -= I_WIN;
        if (r < I_WG) { conv_item<2>(win, D, INW, ((bf16_t*)WSP(WS_WG)), scr, r, 4096, F.lane); continue; } r -= I_WG;
        if (r < 4 * I_BR) { const int nb = r / I_BR; conv_item<0>(INP(I_W_BRANCH) + ((size_t)l * 4 + nb) * 256 * D, 256, D, ((bf16_t*)WSP(WS_WBR)) + (size_t)nb * 1024 * 256, scr, r % I_BR, 1024, F.lane); continue; } r -= 4 * I_BR;
        conv_item<0>(INP(I_W_OUT) + (size_t)l * D * D, D, D, ((bf16_t*)WSP(WS_WOUT)), scr, r, D, F.lane);
    }
}
__device__ __forceinline__ void convert_mlp_weights(Frame& F, int l) {

    LAS float* scr = (LAS float*)(F.lds + F.wave * 16384);
    const int gw = F.vcu * NWAVES + F.wave, NGW = F.G * NWAVES;
    constexpr int I_UP = (D / 64) * (FF / 32), I_DN = (FF / 64) * (D / 32);
    for (int it = gw; it < I_UP + I_DN; it += NGW) {
        if (it < I_UP) conv_item<0>(INP(I_W_UP) + (size_t)l * D * FF, D, FF, ((bf16_t*)WSP(WS_WUP)), scr, it, FF, F.lane);
        else conv_item<0>(INP(I_W_DOWN) + (size_t)l * FF * D, FF, D, ((bf16_t*)WSP(WS_WDN)), scr, it - I_UP, D, F.lane);
    }
}
__device__ __forceinline__ void prologue_rows(Frame& F) {
    float* COS = (float*)WSP(WS_COS); float* SIN = (float*)WSP(WS_SIN); float* SSQA = (float*)WSP(WS_SSQA); bf16_t* XG = (bf16_t*)WSP(WS_XG); const float* x = INP(I_X); const float* ln_mix = INP(I_LN_MIX);
    const int gt = F.vcu * NT + F.tid, NGT = F.G * NT;
    for (int i = gt; i < S * 32; i += NGT) { const int pos = i >> 5, k = i & 31; const float inv = powf(10000.f, -(float)k * 2.0f / 64.f); const float ang = (float)pos * inv; COS[i] = cosf(ang); SIN[i] = sinf(ang); }
    const int gw = F.vcu * NWAVES + F.wave, NGW = F.G * NWAVES;
    for (int m = gw; m < M; m += NGW) {
        const f32x4* xr = (const f32x4*)(x + (size_t)m * D) + F.lane; const f32x4* gr = (const f32x4*)ln_mix + F.lane;
        unsigned long long* o8 = (unsigned long long*)(XG + (size_t)m * D) + F.lane;
#pragma unroll
        for (int j = 0; j < 4; ++j) { const f32x4 v = xr[64 * j], g = gr[64 * j]; float s = (v[0] * v[0] + v[1] * v[1]) + (v[2] * v[2] + v[3] * v[3]);
            s += __shfl_xor(s, 1); s += __shfl_xor(s, 2); s += __shfl_xor(s, 4); s += __shfl_xor(s, 8);
            if ((F.lane & 15) == 0) SSQA[(size_t)m * 16 + 4 * j + (F.lane >> 4)] = s;
            o8[64 * j] = (unsigned long long)pk2(v[0] * g[0], v[1] * g[1]) | ((unsigned long long)pk2(v[2] * g[2], v[3] * g[3]) << 32); }
    }
}

__device__ __forceinline__ void sgu_simple(Frame& F, int l) {
    bf16_t* PROJ = (bf16_t*)WSP(WS_BIG); bf16_t* Y = (bf16_t*)WSP(WS_Y); const float* sgu_norm = INP(I_SGU_NORM); const float* sgu_w = INP(I_SGU_W); const float* sgu_b = INP(I_SGU_B);
    LAS float* r_s = (LAS float*)F.lds; LAS float* vn = r_s + 128;
    const float* gain = sgu_norm + l * 256; const float* sw = sgu_w + (size_t)l * 4 * 128 * 128; const float* sb = sgu_b + l * 4 * 128;
    for (int item = F.vcu; item < 512; item += F.G) {
        const int g = item & 3, m0 = (item >> 2) * 128;
        for (int i = 0; i < 16; ++i) { const int tok = F.wave * 16 + i; const u32x2 w = *(const u32x2*)(PROJ + (size_t)(m0 + tok) * PW + P_AV + 4 * F.lane);
            const float a = lo_bf(w.x), b = hi_bf(w.x), c = lo_bf(w.y), d = hi_bf(w.y); const float ss = wave_sum((a * a + b * b) + (c * c + d * d));
            if (F.lane == 0) r_s[tok] = rsqrtf(ss * (1.f / 256.f) + EPS); }
        __syncthreads();
        for (int idx = F.tid; idx < 8192; idx += NT) { const int s = idx >> 6, d = idx & 63; vn[idx] = bf2f(PROJ[(size_t)(m0 + s) * PW + P_AV + g * 64 + d]) * r_s[s] * gain[g * 64 + d]; }
        __syncthreads();
        const int d = F.tid & 63, tq = F.tid >> 6;
        for (int tl = tq; tl < 128; tl += 8) { const float* w = sw + ((size_t)g * 128 + tl) * 128; float acc = 0.f;
            for (int s = 0; s <= tl; ++s) acc = fmaf(w[s], vn[s * 64 + d], acc);
            acc += sb[g * 128 + tl];
            Y[(size_t)(m0 + tl) * D + g * 64 + d] = (bf16_t)f2bf(bf2f(PROJ[(size_t)(m0 + tl) * PW + P_AU + g * 64 + d]) * acc); }
        __syncthreads();
    }
}
__device__ __forceinline__ void conv_simple(Frame& F, int l) {
    bf16_t* PROJ = (bf16_t*)WSP(WS_BIG); bf16_t* Y = (bf16_t*)WSP(WS_Y); const float* conv_w = INP(I_CONV_W);
    const float* cw = conv_w + l * 3 * 256;
    for (int i = F.vcu * NT + F.tid; i < M * 256; i += F.G * NT) { const int m = i >> 8, c = i & 255, t = m & (S - 1); float acc = 0.f;
#pragma unroll
        for (int j = 0; j < 3; ++j) { const int tt = t - 2 + j; if (tt >= 0) { const size_t r = (size_t)(m - 2 + j) * PW; acc = fmaf(cw[j * 256 + c], bf2f(PROJ[r + P_DC + c]) * bf2f(PROJ[r + P_DX + c]), acc); } }
        Y[(size_t)m * D + 768 + c] = (bf16_t)f2bf(bf2f(PROJ[(size_t)m * PW + P_DB + c]) * acc); }
}
__device__ __forceinline__ void indexer_simple(Frame& F) {
    float* MISC = (float*)WSP(WS_MISC); unsigned* MASK = (unsigned*)WSP(WS_MASK); bf16_t* PROJ = (bf16_t*)WSP(WS_BIG);
    LAS float* sc = (LAS float*)F.lds; LAS int* red = (LAS int*)(sc + 4096); LAS unsigned* msk = (LAS unsigned*)(red + 16);
    for (int m = F.vcu; m < M; m += F.G) {
        const int t = m & (S - 1), b0 = m - t, n = t + 1;
        if (n <= 256) { if (F.tid < 128) { const int lo = 32 * F.tid; MASK[(size_t)m * 128 + F.tid] = (lo + 32 <= n) ? 0xffffffffu : (lo >= n ? 0u : ((1u << (n - lo)) - 1u)); } continue; }
        float qreg[8], wh[8];
#pragma unroll
        for (int h = 0; h < 8; ++h) { qreg[h] = bf2f(PROJ[(size_t)m * PW + P_QI + h * 64 + F.lane]); wh[h] = MISC[(size_t)m * 16 + h] * 0.35355339059327373f; }
        for (int s0 = 0; s0 < n; s0 += NT) {
            const int s = s0 + F.tid, sc_ = s < n ? s : n - 1; const u32x4* kr = (const u32x4*)(PROJ + (size_t)(b0 + sc_) * PW + P_KI);
            float kf[64];
#pragma unroll
            for (int i = 0; i < 8; ++i) { const u32x4 w = kr[i]; kf[8 * i] = lo_bf(w.x); kf[8 * i + 1] = hi_bf(w.x); kf[8 * i + 2] = lo_bf(w.y); kf[8 * i + 3] = hi_bf(w.y); kf[8 * i + 4] = lo_bf(w.z); kf[8 * i + 5] = hi_bf(w.z); kf[8 * i + 6] = lo_bf(w.w); kf[8 * i + 7] = hi_bf(w.w); }
            float acc = 0.f;
#pragma unroll
            for (int h = 0; h < 8; ++h) { float d0 = 0.f, d1 = 0.f;
#pragma unroll
                for (int e = 0; e < 64; e += 2) { d0 = fmaf(__builtin_bit_cast(float, __builtin_amdgcn_readlane(__builtin_bit_cast(int, qreg[h]), e)), kf[e], d0);
                                                   d1 = fmaf(__builtin_bit_cast(float, __builtin_amdgcn_readlane(__builtin_bit_cast(int, qreg[h]), e + 1)), kf[e + 1], d1); }
                acc += wh[h] * fmaxf((d0 + d1) * 0.125f, 0.f); }
            if (s < n) sc[s] = acc;
        }
        __syncthreads();
        unsigned Tk = 0u;
        for (int bit = 31; bit >= 0; --bit) {
            const unsigned cand = Tk | (1u << bit); int c = 0;
            for (int s = F.tid; s < n; s += NT) c += (fkey(sc[s]) >= cand) ? 1 : 0;
            c = wave_sum_i(c); if (F.lane == 0) red[F.wave] = c; __syncthreads();
            int tot = 0;
#pragma unroll
            for (int w = 0; w < 8; ++w) tot += red[w];
            __syncthreads();
            if (tot >= 256) Tk = cand;
        }
        int cg_ = 0, ce = 0;
        for (int s = F.tid; s < n; s += NT) { const unsigned k = fkey(sc[s]); cg_ += k > Tk ? 1 : 0; ce += k == Tk ? 1 : 0; }
        cg_ = wave_sum_i(cg_); ce = wave_sum_i(ce); if (F.lane == 0) { red[F.wave] = cg_; red[8 + F.wave] = ce; }
        if (F.tid < 128) msk[F.tid] = 0u;
        __syncthreads();
        int ngt = 0, neq = 0;
#pragma unroll
        for (int w = 0; w < 8; ++w) { ngt += red[w]; neq += red[8 + w]; }
        const bool all_eq = (ngt + neq == 256);
        for (int s = F.tid; s < n; s += NT) { const unsigned k = fkey(sc[s]); if (k > Tk || (all_eq && k == Tk)) atomicOr((unsigned*)&msk[s >> 5], 1u << (s & 31)); }
        __syncthreads();
        if (!all_eq && F.tid == 0) { int need = 256 - ngt; for (int s = 0; s < n && need > 0; ++s) if (fkey(sc[s]) == Tk) { msk[s >> 5] |= 1u << (s & 31); --need; } }
        __syncthreads();
        if (F.tid < 128) MASK[(size_t)m * 128 + F.tid] = msk[F.tid];
        __syncthreads();
    }
}
__device__ __forceinline__ void attn_simple(Frame& F) {
    unsigned* MASK = (unsigned*)WSP(WS_MASK); bf16_t* PROJ = (bf16_t*)WSP(WS_BIG); bf16_t* Y = (bf16_t*)WSP(WS_Y);
    LAS unsigned* msk = (LAS unsigned*)F.lds; LAS int* sel = (LAS int*)(msk + 128); LAS float* lg = (LAS float*)(sel + 256); LAS int* nsel = (LAS int*)(lg + 4 * 256);
    for (int m = F.vcu; m < M; m += F.G) {
        const int t = m & (S - 1), b0 = m - t;
        if (F.tid < 128) msk[F.tid] = MASK[(size_t)m * 128 + F.tid];
        __syncthreads();
        if (F.tid == 0) { int c = 0; for (int w = 0; w < 128; ++w) { unsigned bits = msk[w]; while (bits) { const int i = __builtin_ctz(bits); if (c < 256) sel[c] = 32 * w + i; ++c; bits &= bits - 1; } } nsel[0] = c < 256 ? c : 256; }
        __syncthreads();
        const int ns = nsel[0], h = F.wave & 3, part = F.wave >> 2;
        const float q = bf2f(PROJ[(size_t)m * PW + P_Q + h * 64 + F.lane]);
        for (int j = part; j < ns; j += 2) { const float d = wave_sum(q * bf2f(PROJ[(size_t)(b0 + sel[j]) * PW + P_K + h * 64 + F.lane])); if (F.lane == 0) lg[h * 256 + j] = d * 0.125f; }
        __syncthreads();
        if (F.wave < 4) {
            float mx = -INFINITY; for (int j = F.lane; j < ns; j += 64) mx = fmaxf(mx, lg[h * 256 + j]); mx = wave_max(mx);
            float sm = 0.f; for (int j = F.lane; j < ns; j += 64) sm += __expf(lg[h * 256 + j] - mx); sm = wave_sum(sm);
            float o = 0.f; for (int j = 0; j < ns; ++j) o = fmaf(__expf(lg[h * 256 + j] - mx), bf2f(PROJ[(size_t)(b0 + sel[j]) * PW + P_V + h * 64 + F.lane]), o);
            Y[(size_t)m * D + 256 + h * 64 + F.lane] = (bf16_t)f2bf(o / sm);
        }
        __syncthreads();
    }
}
__device__ __forceinline__ void mlstm1_simple(Frame& F, int l) {
    float* MISC = (float*)WSP(WS_MISC); float* STATE = (float*)WSP(WS_STATE); bf16_t* PROJ = (bf16_t*)WSP(WS_BIG); const float* i_bias = INP(I_I_BIAS); const float* f_bias = INP(I_F_BIAS);
    LAS float* bs = (LAS float*)F.lds; LAS float* ig = bs + 128; LAS float* wk = ig + 128; LAS float* kt = wk + 128; LAS float* vt = kt + 128 * 64;
    for (int item = F.vcu; item < 512; item += F.G) {
        const int bh = item >> 5, c = item & 31, b = bh >> 2, h = bh & 3, m0 = b * S + c * 128;
        if (F.tid < 128) { const float f = MISC[(size_t)(m0 + F.tid) * 16 + 12 + h] + f_bias[l * 4 + h]; bs[F.tid] = fminf(f, 0.f) - log1pf(__expf(-fabsf(f))); ig[F.tid] = MISC[(size_t)(m0 + F.tid) * 16 + 8 + h] + i_bias[l * 4 + h]; }
        for (int idx = F.tid; idx < 8192; idx += NT) { const int s = idx >> 6, d = idx & 63; kt[idx] = bf2f(PROJ[(size_t)(m0 + s) * PW + P_CK + h * 64 + d]); vt[idx] = bf2f(PROJ[(size_t)(m0 + s) * PW + P_CV + h * 64 + d]); }
        __syncthreads();
        if (F.tid == 0) { float a = 0.f; for (int s = 0; s < 128; ++s) { a += bs[s]; bs[s] = a; } }
        __syncthreads();
        const float B = bs[127];
        if (F.tid < 128) wk[F.tid] = __expf(B - bs[F.tid] + ig[F.tid]);
        __syncthreads();
        const int e = F.tid & 63, dq = F.tid >> 6; float acc[8];
#pragma unroll
        for (int i = 0; i < 8; ++i) acc[i] = 0.f;
        for (int s = 0; s < 128; ++s) { const float kv = wk[s] * vt[s * 64 + e];
#pragma unroll
            for (int i = 0; i < 8; ++i) acc[i] = fmaf(kt[s * 64 + dq * 8 + i], kv, acc[i]); }
        float* st = STATE + (size_t)item * STATE_STRIDE;
#pragma unroll
        for (int i = 0; i < 8; ++i) st[(dq * 8 + i) * 64 + e] = acc[i];
        if (F.tid < 64) { float a = 0.f; for (int s = 0; s < 128; ++s) a = fmaf(wk[s], kt[s * 64 + F.tid], a); st[4096 + F.tid] = a; }
        if (F.tid == 0) st[4160] = B;
        __syncthreads();
    }
}
__device__ __forceinline__ void mlstm2_simple(Frame& F, int l) {
    float* MISC = (float*)WSP(WS_MISC); float* STATE = (float*)WSP(WS_STATE); bf16_t* PROJ = (bf16_t*)WSP(WS_BIG); bf16_t* Y = (bf16_t*)WSP(WS_Y); const float* i_bias = INP(I_I_BIAS); const float* f_bias = INP(I_F_BIAS); const float* mnorm = INP(I_MNORM);
    LAS float* Cs = (LAS float*)F.lds; LAS float* ns = Cs + 4096; LAS float* bs = ns + 64; LAS float* ig = bs + 128; LAS float* A = ig + 128;
    LAS float* qt = A + 128 * 128; LAS float* kt = qt + 128 * 65;
    for (int item = F.vcu; item < 512; item += F.G) {
        const int bh = item >> 5, c = item & 31, b = bh >> 2, h = bh & 3, m0 = b * S + c * 128;
        { float Cv[8]; float nv = 0.f;
#pragma unroll
          for (int k = 0; k < 8; ++k) Cv[k] = 0.f;
          for (int cc = 0; cc < c; ++cc) { const float* st = STATE + (size_t)(bh * 32 + cc) * STATE_STRIDE; const float dec = __expf(st[4160]);
#pragma unroll
              for (int k = 0; k < 8; ++k) Cv[k] = fmaf(dec, Cv[k], st[F.tid + NT * k]);
              if (F.tid < 64) nv = fmaf(dec, nv, st[4096 + F.tid]); }
#pragma unroll
          for (int k = 0; k < 8; ++k) Cs[F.tid + NT * k] = Cv[k];
          if (F.tid < 64) ns[F.tid] = nv; }
        if (F.tid < 128) { const float f = MISC[(size_t)(m0 + F.tid) * 16 + 12 + h] + f_bias[l * 4 + h]; bs[F.tid] = fminf(f, 0.f) - log1pf(__expf(-fabsf(f))); ig[F.tid] = MISC[(size_t)(m0 + F.tid) * 16 + 8 + h] + i_bias[l * 4 + h]; }
        for (int idx = F.tid; idx < 8192; idx += NT) { const int s = idx >> 6, d = idx & 63; qt[s * 65 + d] = bf2f(PROJ[(size_t)(m0 + s) * PW + P_CQ + h * 64 + d]); kt[s * 65 + d] = bf2f(PROJ[(size_t)(m0 + s) * PW + P_CK + h * 64 + d]); }
        __syncthreads();
        if (F.tid == 0) { float a = 0.f; for (int s = 0; s < 128; ++s) { a += bs[s]; bs[s] = a; } }
        __syncthreads();
        { const int s = F.tid & 127, jq = F.tid >> 7;
          for (int j = jq; j < 128; j += 4) { float v = 0.f;
              if (s <= j) { float d = 0.f;
#pragma unroll 16
                  for (int k = 0; k < 64; ++k) d = fmaf(qt[j * 65 + k], kt[s * 65 + k], d);
                  v = __expf(bs[j] - bs[s] + ig[s]) * d; }
              A[j * 128 + s] = v; } }
        __syncthreads();
        LAS float* vt = kt;
        for (int idx = F.tid; idx < 8192; idx += NT) { const int s = idx >> 6, d = idx & 63; vt[idx] = bf2f(PROJ[(size_t)(m0 + s) * PW + P_CV + h * 64 + d]); }
        __syncthreads();
        const int e = F.lane; const float gn = mnorm[l * 256 + h * 64 + e];
        for (int j = F.wave; j < 128; j += 8) {
            float num = 0.f, qn = 0.f, sa = 0.f;
            for (int d = 0; d < 64; ++d) { const float qd = qt[j * 65 + d]; num = fmaf(qd, Cs[d * 64 + e], num); qn = fmaf(qd, ns[d], qn); }
            const float eb = __expf(bs[j]); num *= eb; qn *= eb;
            for (int s = 0; s <= j; ++s) { const float a = A[j * 128 + s]; num = fmaf(a, vt[s * 64 + e], num); sa += a; }
            const float hv = num / fmaxf(fabsf(qn + sa), 1.f);
            const float r = rsqrtf(wave_sum(hv * hv) * (1.f / 64.f) + EPS);
            const size_t row = (size_t)(m0 + j);
            Y[row * D + 512 + h * 64 + e] = (bf16_t)f2bf(sigmoid_f(bf2f(PROJ[row * PW + P_CO + h * 64 + e])) * hv * r * gn);
        }
        __syncthreads();
    }
}
#ifndef MK_MULTI
#define MK_MULTI 0
#endif
constexpr int N_PHASES = 1 + 8 * DEPTH;

__global__ void __launch_bounds__(NT, 2) mk_fwd(Args args) {
    extern __shared__ __attribute__((aligned(16))) unsigned char lds_raw[];
    Frame F;
    F.lds = (LAS unsigned char*)lds_raw; F.tid = threadIdx.x; F.lane = F.tid & 63; F.wave = __builtin_amdgcn_readfirstlane(F.tid >> 6);
    F.G = gridDim.x; { const int bx_ = blockIdx.x; F.vcu = (F.G % 8 == 0) ? (bx_ % 8) * (F.G / 8) + bx_ / 8 : bx_; }
    if (F.tid < 20) { const unsigned long long pv = F.tid < 18 ? (unsigned long long)args.in[F.tid < 18 ? F.tid : 0] : (F.tid == 18 ? (unsigned long long)args.out : (unsigned long long)args.ws);
        *(LAS unsigned long long*)(F.lds + PTR_OFF + 8 * F.tid) = pv; }
    __syncthreads();
    const int lo = args.ph_lo, hi = args.ph_hi; const bool coop = args.coop != 0;
#define RUN(k) (lo <= (k) && (k) < hi)
#define LAUNDER() asm volatile("" : "+v"(F.tid), "+v"(F.lane))
#define SEAM(k) do { if (coop && RUN(k) && RUN((k) + 1)) { cg::this_grid().sync(); } } while (0)
    const int bx = (int)blockIdx.x;

    if (RUN(0)) { LAUNDER(); convert_mix_weights(F, 0); prologue_rows(F);
        if (blockIdx.x == 0 && F.tid < DEPTH * 192) { const int l_ = F.tid / 192, r_ = F.tid % 192, w_ = r_ / 64, i_ = r_ % 64; ((float*)WSP(WS_GT))[F.tid] = INP(I_Q_NORM + w_)[l_ * 64 + i_]; } }
    SEAM(0);
#pragma unroll 1
    for (int l = 0; l < DEPTH; ++l) {
        const int pb = 1 + 8 * l;
        if (RUN(pb + 0)) { LAUNDER();
            pg8::Gemm<D, D, D, 256u * D * 2, 0, 256u * D * 2, 0> g{(const bf16_t*)WSP(WS_XG), (const bf16_t*)WSP(WS_WIN)};
            pg8::StaticOrder So; So.init(M, PW, F.G, bx);
            epi::EpiProj E{(bf16_t*)WSP(WS_BIG), (float*)WSP(WS_MISC), (const float*)WSP(WS_SSQA), (const float*)WSP(WS_COS), (const float*)WSP(WS_SIN), (const float*)WSP(WS_GT) + l * 192};
            pg8::gemm_phase<epi::EpiProj, pg8::StaticOrder, true>(F.lds, g, So, E, F.tid);
        }
        SEAM(pb + 0);
        if (RUN(pb + 1)) { LAUNDER(); sgu_simple(F, l); conv_simple(F, l); indexer_simple(F); mlstm1_simple(F, l); }
        SEAM(pb + 1);
        if (RUN(pb + 2)) { LAUNDER(); attn_simple(F); mlstm2_simple(F, l); }
        SEAM(pb + 2);
        if (RUN(pb + 3)) { LAUNDER();
            pg8::Gemm<256, D, 256, 256u * D * 2, 256u * 2, 256u * 256 * 2, 1024u * 256 * 2> g{(const bf16_t*)WSP(WS_Y), (const bf16_t*)WSP(WS_WBR)};
            pg8::SuperOrder<0> So; So.init(F.G, bx);
            epi::EpiPlain E{(bf16_t*)WSP(WS_BIG), 4096, 1024};
            pg8::gemm_phase<epi::EpiPlain, pg8::SuperOrder<0>, true>(F.lds, g, So, E, F.tid);
        }
        SEAM(pb + 3);
        if (RUN(pb + 4)) { LAUNDER();
            pg8::Gemm<D, D, D, 256u * D * 2, 0, 256u * D * 2, 0> g{(const bf16_t*)WSP(WS_XG), (const bf16_t*)WSP(WS_WG)};
            pg8::SuperOrder<1> So; So.init(F.G, bx);
            epi::EpiGate E{(bf16_t*)WSP(WS_MG), (const bf16_t*)WSP(WS_BIG), (const float*)WSP(WS_SSQA)};
            pg8::gemm_phase<epi::EpiGate, pg8::SuperOrder<1>, true>(F.lds, g, So, E, F.tid);
            __syncthreads();
            convert_mlp_weights(F, l);
        }
        SEAM(pb + 4);
        if (RUN(pb + 5)) { LAUNDER();
            pg8::Gemm<D, D, D, 256u * D * 2, 0, 256u * D * 2, 0> g{(const bf16_t*)WSP(WS_MG), (const bf16_t*)WSP(WS_WOUT)};
            pg8::StaticOrder So; So.init(M, D, F.G, bx);
            float* outp = (float*)ptr_at(F, I_OUT); epi::EpiResid E{l == 0 ? INP(I_X) : (const float*)outp, outp, (bf16_t*)WSP(WS_XG), INP(I_LN_MLP) + l * D, (float*)WSP(WS_SSQB)};
            pg8::gemm_phase<epi::EpiResid, pg8::StaticOrder, true>(F.lds, g, So, E, F.tid);
        }
        SEAM(pb + 5);
        if (RUN(pb + 6)) { LAUNDER();
            pg8::Gemm<D, D, D, 256u * D * 2, 0, 256u * D * 2, 0> g{(const bf16_t*)WSP(WS_XG), (const bf16_t*)WSP(WS_WUP)};
            pg8::StaticOrder So; So.init(M, FF, F.G, bx);
            epi::EpiUp E{(bf16_t*)WSP(WS_BIG), (const float*)WSP(WS_SSQB)};
            pg8::gemm_phase<epi::EpiUp, pg8::StaticOrder, true>(F.lds, g, So, E, F.tid);
            if (l + 1 < DEPTH) { __syncthreads(); convert_mix_weights(F, l + 1); }
        }
        SEAM(pb + 6);
        if (RUN(pb + 7)) { LAUNDER();
            pg8::Gemm<FF, FF, FF, 256u * FF * 2, 0, 256u * FF * 2, 0> g{(const bf16_t*)WSP(WS_BIG), (const bf16_t*)WSP(WS_WDN)};
            pg8::StaticOrder So; So.init(M, D, F.G, bx);
            float* outp = (float*)ptr_at(F, I_OUT); epi::EpiResid E{(const float*)outp, outp, (bf16_t*)WSP(WS_XG), (l + 1 < DEPTH) ? INP(I_LN_MIX) + (l + 1) * D : nullptr, (float*)WSP(WS_SSQA)};
            pg8::gemm_phase<epi::EpiResid, pg8::StaticOrder, true>(F.lds, g, So, E, F.tid);
        }
        SEAM(pb + 7);
    }
#undef RUN
#undef SEAM
}

extern "C" void kernel_launch(void* const* d_in, const int* in_sizes, int n_in, void* d_out, int out_size, void* d_ws, size_t ws_size, hipStream_t stream) {
    static int grid = 0;
    if (grid == 0) {
        if (n_in != 18 || in_sizes[0] != M * D || out_size != M * D || ws_size < WS_END) { fprintf(stderr, "kernel_launch: unexpected shapes (n_in %d, in0 %d, out %d, ws %zu)\n", n_in, n_in > 0 ? in_sizes[0] : -1, out_size, ws_size); grid = -1; return; }
        int dev = 0, cus = 0, per_cu = 0;
        if (hipGetDevice(&dev) != hipSuccess || hipDeviceGetAttribute(&cus, hipDeviceAttributeMultiprocessorCount, dev) != hipSuccess) { grid = -1; return; }
        if (hipFuncSetAttribute((const void*)mk_fwd, hipFuncAttributeMaxDynamicSharedMemorySize, LDS_BYTES) != hipSuccess) { fprintf(stderr, "kernel_launch: hipFuncSetAttribute failed\n"); grid = -1; return; }
        if (hipOccupancyMaxActiveBlocksPerMultiprocessor(&per_cu, (const void*)mk_fwd, NT, LDS_BYTES) != hipSuccess || per_cu < 1) { fprintf(stderr, "kernel_launch: occupancy query says %d\n", per_cu); (void)hipGetLastError(); per_cu = 1; }
        grid = cus;
    }
    if (grid < 0) return;
    Args a{};
    for (int i = 0; i < 18; ++i) a.in[i] = (const float*)d_in[i];
    a.out = (float*)d_out; a.ws = (unsigned char*)d_ws;
#if MK_MULTI
    for (int p = 0; p < N_PHASES; ++p) { a.ph_lo = p; a.ph_hi = p + 1; a.coop = 0; hipLaunchKernelGGL(mk_fwd, dim3(grid), dim3(NT), LDS_BYTES, stream, a); }
#else
    a.ph_lo = 0; a.ph_hi = N_PHASES; a.coop = 1;
    void* kargs[] = {&a};
    hipError_t e = hipLaunchCooperativeKernel((const void*)mk_fwd, dim3(grid), dim3(NT), kargs, LDS_BYTES, stream);
    if (e != hipSuccess) fprintf(stderr, "kernel_launch: cooperative launch failed: %s (grid %d)\n", hipGetErrorString(e), grid);
#endif
}
```

```cpp
#define MK_MULTI 0
#include <hip/hip_runtime.h>
#include <hip/hip_cooperative_groups.h>
#include <cstdio>
#include <cstdint>
namespace cg = cooperative_groups;

#define LAS __attribute__((address_space(3)))
typedef unsigned short bf16_t;
typedef short bf16x8 __attribute__((ext_vector_type(8)));
typedef float f32x4 __attribute__((ext_vector_type(4)));
typedef float f32x2 __attribute__((ext_vector_type(2)));
typedef unsigned u32x4 __attribute__((ext_vector_type(4)));
typedef unsigned u32x2 __attribute__((ext_vector_type(2)));

constexpr int D = 1024, NB = 4, S = 4096, M = NB * S, DEPTH = 2, FF = 4096, INW = 7760;
constexpr int O_AU = 0, O_AV = 256, O_BQ = 512, O_BK = 768, O_BV = 1024, O_QI = 1280, O_KI = 1792, O_WI = 1856,
              O_CQ = 1864, O_CK = 2120, O_CV = 2376, O_CO = 2632, O_CI = 2888, O_CF = 2892, O_DB = 2896, O_DC = 3152, O_DX = 3408, O_G = 3664;
constexpr int PW = 3840;
constexpr int P_AU = 0, P_AV = 256, P_Q = 512, P_K = 768, P_V = 1024, P_QI = 1280, P_CQ = 1792, P_CK = 2048, P_CV = 2304, P_CO = 2560,
              P_DB = 2816, P_DC = 3072, P_DX = 3328, P_KI = 3584;
constexpr float EPS = 1e-6f;
constexpr int NWAVES = 8, NT = 512;

constexpr size_t MiB = 1u << 20;
constexpr size_t WS_CTL = 0;
constexpr size_t WS_COS = 1 * MiB, WS_SIN = 1 * MiB + 512 * 1024;
constexpr size_t WS_MISC = 2 * MiB;
constexpr size_t WS_SSQA = 3 * MiB, WS_SSQB = 4 * MiB;
constexpr size_t WS_WIN = 5 * MiB;
constexpr size_t WS_WG = WS_WIN + (size_t)PW * D * 2;
constexpr size_t WS_WBR = WS_WG + (size_t)4096 * D * 2;
constexpr size_t WS_WOUT = WS_WBR + (size_t)4 * 1024 * 256 * 2;
constexpr size_t WS_XG = 25 * MiB;
constexpr size_t WS_BIG = 57 * MiB;
constexpr size_t WS_Y = 185 * MiB;
constexpr size_t WS_WUP = WS_Y, WS_WDN = WS_Y + 8 * MiB;
constexpr size_t WS_MG = 217 * MiB;
constexpr size_t WS_MASK = WS_MG, WS_STATE = WS_MG + 8 * MiB;
constexpr size_t WS_END = 249 * MiB;
constexpr int STATE_STRIDE = 4224;
static_assert(WS_WOUT + (size_t)D * D * 2 <= WS_XG && WS_STATE + (size_t)512 * STATE_STRIDE * 4 <= WS_END && WS_END <= 256 * MiB, "d_ws map");

constexpr int LDS_BYTES = 155648;

__device__ __forceinline__ float bf2f(bf16_t v) { return __uint_as_float((unsigned)v << 16); }
__device__ __forceinline__ unsigned f2bf(float f) { unsigned u = __float_as_uint(f); return (u + 0x7fffu + ((u >> 16) & 1u)) >> 16; }
__device__ __forceinline__ unsigned pk2(float lo, float hi) { return f2bf(lo) | (f2bf(hi) << 16); }
__device__ __forceinline__ unsigned cvt_pk_bf16(float lo, float hi) { unsigned r; asm volatile("v_cvt_pk_bf16_f32 %0, %1, %2" : "=v"(r) : "v"(lo), "v"(hi)); return r; }
__device__ __forceinline__ float lo_bf(unsigned w) { return __uint_as_float(w << 16); }
__device__ __forceinline__ float hi_bf(unsigned w) { return __uint_as_float(w & 0xffff0000u); }
__device__ __forceinline__ float wave_sum(float v) {
#pragma unroll
    for (int o = 1; o < 64; o <<= 1) v += __shfl_xor(v, o);
    return v;
}
__device__ __forceinline__ float wave_max(float v) {
#pragma unroll
    for (int o = 1; o < 64; o <<= 1) v = fmaxf(v, __shfl_xor(v, o));
    return v;
}
__device__ __forceinline__ int wave_sum_i(int v) {
#pragma unroll
    for (int o = 1; o < 64; o <<= 1) v += __shfl_xor(v, o);
    return v;
}
__device__ __forceinline__ float sigmoid_f(float x) { return 1.f / (1.f + __expf(-x)); }
__device__ __forceinline__ float gelu_tanh_f(float x) { const float u = 0.7978845608028654f * (x + 0.044715f * x * x * x); return x / (1.f + __expf(-2.f * u)); }
__device__ __forceinline__ unsigned fkey(float s) { const unsigned u = __float_as_uint(s); return (u & 0x80000000u) ? ~u : (u | 0x80000000u); }

namespace pg8 {
constexpr int BM = 256, BK = 64, HALF = 128, HTB = HALF * BK * 2, STAGE_BYTES = 8 * HTB, NXCD = 8, WGM = 8;
__host__ __device__ __forceinline__ int lds_byte(int r, int c) { const int st = (r >> 4) * 2 + (c >> 5), rr = r & 15, cc = c & 31, ob = rr * 64 + cc * 2; return st * 1024 + (ob ^ (((ob >> 9) & 1) << 5)); }
__host__ __device__ __forceinline__ void stage_rc(int b, int& R, int& C) { const int st = b / 1024, sb = b % 1024, swz = sb ^ (((sb >> 9) & 1) << 5); R = (st >> 1) * 16 + swz / 64; C = (st & 1) * 32 + (swz % 64) / 2; }
__host__ __device__ __forceinline__ int perm32(int rho) { const int n = rho >> 4, i = rho & 15; return 8 * (i >> 2) + 4 * n + (i & 3); }

struct Unit { int pm, pn, z; };
template <int K_, int LDA_, int LDB_, unsigned APM_, unsigned AZ_, unsigned BPN_, unsigned BZ_> struct Gemm {
    const bf16_t* A; const bf16_t* Bt;
    static constexpr int K = K_, lda = LDA_, ldb = LDB_; static constexpr unsigned aPm = APM_, aZ = AZ_, bPn = BPN_, bZ = BZ_;
};
template <class G> __device__ __forceinline__ const char* pa(const G& g, const Unit& u) { return (const char*)g.A + (size_t)((unsigned)u.pm * G::aPm + (unsigned)u.z * G::aZ); }
template <class G> __device__ __forceinline__ const char* pb(const G& g, const Unit& u) { return (const char*)g.Bt + (size_t)((unsigned)u.pn * G::bPn + (unsigned)u.z * G::bZ); }

struct StaticOrder {
    int nM, nN, nwg, G, c;
    __host__ __device__ void init(int M_, int N_, int G_, int c_) { nM = M_ / BM; nN = N_ / BM; nwg = nM * nN; G = G_; c = c_; }
    __host__ __device__ bool next(int i, Unit& u) const {
        const long L = (long)i * G + c; if (L >= nwg) return false;
        int wgid = (int)L; { const int q = nwg / NXCD, r = nwg % NXCD, xcd = wgid % NXCD, off = wgid / NXCD; wgid = (xcd < r ? xcd * (q + 1) : r * (q + 1) + (xcd - r) * q) + off; }
        const int nig = WGM * nN, gid = wgid / nig, fm = gid * WGM, gsz = (nM - fm) < WGM ? (nM - fm) : WGM;
        u.pm = fm + ((wgid % nig) % gsz); u.pn = (wgid % nig) / gsz; u.z = 0; return true;
    }
};
template <int MODE> struct SuperOrder {
    StaticOrder so;
    __host__ __device__ void init(int G_, int c_) { so.init(M, 1024, G_, c_); }
    __host__ __device__ bool next(int i, Unit& u) const {
        Unit b; if (!so.next(i >> 2, b)) return false;
        const int sub = i & 3; u.pm = b.pm; if (MODE == 0) { u.pn = b.pn; u.z = sub; } else { u.pn = 4 * b.pn + sub; u.z = 0; } return true;
    }
};

template <class Epi, class Sched, bool ALIGN_EPI, class GemmT>
__device__ __forceinline__ void gemm_phase(LAS unsigned char* lds, const GemmT g, const Sched& S, const Epi& E, const int tid) {
    const int wid = __builtin_amdgcn_readfirstlane(tid >> 6), lane = tid & 63, wr = wid >> 2, wc = wid & 3, fr = lane & 15, fq = lane >> 4;
    constexpr int K = GemmT::K, nt = K / BK;
    unsigned voffA[2], voffB[2];
#pragma unroll
    for (int i = 0; i < 2; ++i) { int R, C; stage_rc(tid * 16 + i * 8192, R, C); const int Rb = Epi::PERM ? ((R & ~31) + perm32(R & 31)) : R;
        voffA[i] = (unsigned)(R * GemmT::lda + C) * 2u; voffB[i] = (unsigned)(Rb * GemmT::ldb + C) * 2u; }
    const size_t kstep = (size_t)(BK * 2);
    constexpr size_t hA = (size_t)HALF * GemmT::lda * 2, hB = (size_t)HALF * GemmT::ldb * 2;
    const unsigned ldsw = (unsigned)wid * 1024u;
    const int aoff = lds_byte(wr * 64 + fr, fq * 8), boff = lds_byte(wc * 32 + fr, fq * 8);
#define PG8_SA(b, h) (((b) * 2 + (h)) * HTB)
#define PG8_SB(b, h) ((4 + (b) * 2 + (h)) * HTB)
#define PG8_STAGE(bufoff, gbase, voff) do { _Pragma("unroll") for (int _i = 0; _i < 2; ++_i) \
        __builtin_amdgcn_global_load_lds((const unsigned*)((const char*)(gbase) + (voff)[_i]), (LAS unsigned*)(lds + (bufoff) + ldsw + _i * 8192), 16, 0, 0); } while (0)
#define PG8_LDA(dst, b, h) do { _Pragma("unroll") for (int m = 0; m < 4; ++m) _Pragma("unroll") for (int k = 0; k < 2; ++k) dst[m][k] = *(const LAS bf16x8*)(lds + PG8_SA(b, h) + aoff + m * 2048 + k * 1024); } while (0)
#define PG8_LDB(dst, b, h) do { _Pragma("unroll") for (int n = 0; n < 2; ++n) _Pragma("unroll") for (int k = 0; k < 2; ++k) dst[n][k] = *(const LAS bf16x8*)(lds + PG8_SB(b, h) + boff + n * 2048 + k * 1024); } while (0)
#define PG8_MMA(ai, bj, At, Bt) do { __builtin_amdgcn_s_setprio(1); _Pragma("unroll") for (int m = 0; m < 4; ++m) _Pragma("unroll") for (int n = 0; n < 2; ++n) _Pragma("unroll") for (int k = 0; k < 2; ++k) \
        acc[ai][bj][m][n] = __builtin_amdgcn_mfma_f32_16x16x32_bf16(Bt[n][k], At[m][k], acc[ai][bj][m][n], 0, 0, 0); __builtin_amdgcn_s_setprio(0); } while (0)
#define PG8_WAIT_V(n) asm volatile("s_waitcnt vmcnt(" #n ")" ::: "memory")
#define PG8_WAIT_L(n) asm volatile("s_waitcnt lgkmcnt(" #n ")" ::: "memory")
#define PG8_BAR __builtin_amdgcn_s_barrier()
#define PG8_SCHED __builtin_amdgcn_sched_barrier(0)
    Unit cur, nxt; int ui = 0;
    if (!S.next(0, cur)) return;
    f32x4 acc[2][2][4][2];
#pragma unroll
    for (int a = 0; a < 2; ++a)
#pragma unroll
        for (int b = 0; b < 2; ++b)
#pragma unroll
            for (int m = 0; m < 4; ++m)
#pragma unroll
                for (int n = 0; n < 2; ++n) acc[a][b][m][n] = (f32x4){0.f, 0.f, 0.f, 0.f};
    bf16x8 At[4][2], B0[2][2], B1[2][2];
    const char* cA = pa(g, cur); const char* cB = pb(g, cur);
    PG8_STAGE(PG8_SB(0, 0), cB, voffB); PG8_STAGE(PG8_SB(0, 1), cB + hB, voffB); PG8_STAGE(PG8_SA(0, 0), cA, voffA); PG8_STAGE(PG8_SA(0, 1), cA + hA, voffA);
    if (wr == 1) PG8_BAR;
    PG8_WAIT_V(2); PG8_BAR;
    PG8_STAGE(PG8_SB(1, 0), cB + kstep, voffB); PG8_STAGE(PG8_SA(1, 0), cA + kstep, voffA); PG8_STAGE(PG8_SB(1, 1), cB + hB + kstep, voffB);
    PG8_WAIT_V(6); PG8_BAR;
    for (;;) {
        const bool has_next = S.next(ui + 1, nxt);
        const char* nA = has_next ? pa(g, nxt) : cA; const char* nB = has_next ? pb(g, nxt) : cB;
#pragma unroll 1
        for (int t = 0; t < nt; t += 2) {
            const bool last = (t == nt - 2);
            const char* a1 = cA + (size_t)(t + 1) * kstep;
            const char* a2 = last ? nA : cA + (size_t)(t + 2) * kstep; const char* b2 = last ? nB : cB + (size_t)(t + 2) * kstep;
            const char* a3 = a2 + kstep; const char* b3 = b2 + kstep;
            PG8_LDB(B0, 0, 0); PG8_LDB(B1, 0, 1); PG8_SCHED; PG8_LDA(At, 0, 0); PG8_STAGE(PG8_SA(1, 1), a1 + hA, voffA);
            PG8_WAIT_V(8); PG8_WAIT_L(0); PG8_BAR; PG8_MMA(0, 0, At, B0); PG8_MMA(0, 1, At, B1); PG8_BAR; PG8_SCHED;
            PG8_LDA(At, 0, 1); PG8_STAGE(PG8_SB(0, 0), b2, voffB); PG8_STAGE(PG8_SB(0, 1), b2 + hB, voffB); PG8_STAGE(PG8_SA(0, 0), a2, voffA);
            PG8_WAIT_V(8); PG8_WAIT_L(0); PG8_BAR; PG8_MMA(1, 0, At, B0); PG8_MMA(1, 1, At, B1); PG8_BAR; PG8_SCHED;
            PG8_LDB(B0, 1, 0); PG8_LDB(B1, 1, 1); PG8_SCHED; PG8_LDA(At, 1, 0); PG8_STAGE(PG8_SA(0, 1), a2 + hA, voffA);
            PG8_WAIT_V(8); PG8_WAIT_L(0); PG8_BAR; PG8_MMA(0, 0, At, B0); PG8_MMA(0, 1, At, B1); PG8_BAR; PG8_SCHED;
            PG8_LDA(At, 1, 1); PG8_STAGE(PG8_SB(1, 0), b3, voffB); PG8_STAGE(PG8_SB(1, 1), b3 + hB, voffB); PG8_STAGE(PG8_SA(1, 0), a3, voffA);
            PG8_WAIT_V(8); PG8_WAIT_L(0); PG8_BAR; PG8_MMA(1, 0, At, B0); PG8_MMA(1, 1, At, B1); PG8_BAR; PG8_SCHED;
        }
        if constexpr (ALIGN_EPI) { if (wr == 0) PG8_BAR; }
        { int fr2 = fr, fq2 = fq; asm volatile("" : "+v"(fr2), "+v"(fq2)); E(acc, cur, wr, wc, fr2, fq2); }
        if (!has_next) break;
#pragma unroll
        for (int a = 0; a < 2; ++a)
#pragma unroll
            for (int b = 0; b < 2; ++b)
#pragma unroll
                for (int m = 0; m < 4; ++m)
#pragma unroll
                    for (int n = 0; n < 2; ++n) acc[a][b][m][n] = (f32x4){0.f, 0.f, 0.f, 0.f};
        cur = nxt; cA = nA; cB = nB; ++ui;
        if constexpr (ALIGN_EPI) { if (wr == 1) PG8_BAR; }
    }
    PG8_WAIT_V(0);
    if constexpr (!ALIGN_EPI) { if (wr == 0) PG8_BAR; }
    PG8_BAR;
#undef PG8_SA
#undef PG8_SB
#undef PG8_STAGE
#undef PG8_LDA
#undef PG8_LDB
#undef PG8_MMA
#undef PG8_WAIT_V
#undef PG8_WAIT_L
#undef PG8_BAR
#undef PG8_SCHED
}
}
namespace epi {
using pg8::Unit;
typedef f32x4 Acc[2][2][4][2];

__device__ __forceinline__ float row_scale(const float* ssq, int row) {
    const f32x4* sp = (const f32x4*)(ssq + (size_t)row * 16);
    const f32x4 a = sp[0], b = sp[1], c = sp[2], d = sp[3];
    const float t = ((a[0] + a[1]) + (a[2] + a[3])) + ((b[0] + b[1]) + (b[2] + b[3])) + ((c[0] + c[1]) + (c[2] + c[3])) + ((d[0] + d[1]) + (d[2] + d[3]));
    return rsqrtf(t * (1.0f / 1024.0f) + EPS);
}
__device__ __forceinline__ u32x4 pack8(const f32x4 a, const f32x4 b) { u32x4 w; w.x = cvt_pk_bf16(a[0], a[1]); w.y = cvt_pk_bf16(a[2], a[3]); w.z = cvt_pk_bf16(b[0], b[1]); w.w = cvt_pk_bf16(b[2], b[3]); return w; }

struct EpiProj {
    static constexpr bool PERM = true;
    bf16_t* P; float* misc; const float* ssq; const float* cs; const float* sn; const float* gt;     bf16_t* VT;
    __device__ __forceinline__ void operator()(const Acc& acc, const Unit& u, int wr, int wc, int fr, int fq) const {
        const int T = u.pn; const int row0 = u.pm * 256 + wr * 64 + fr;
        if (T == 2 || T == 3 || T == 5 || T == 6 || T == 14) {
            if (T == 14 && wc >= 2) return;
            if (T == 14 && wc == 1) {
                if (fq < 2) {
#pragma unroll
                    for (int ai = 0; ai < 2; ++ai)
#pragma unroll
                        for (int m = 0; m < 4; ++m) { const int row = row0 + ai * 128 + m * 16; const float rs = row_scale(ssq, row);
                            float* mp = misc + (size_t)row * 16 + 8 * fq; *(f32x4*)mp = acc[ai][0][m][0] * rs; *(f32x4*)(mp + 4) = acc[ai][0][m][1] * rs; }
                }
                return;
            }
            const int mode = (T == 14) ? 2 : (T <= 3 ? 1 : 0);
            const float* gp = gt + 64 * ((T == 2) ? 0 : (T == 3) ? 1 : 2);
            f32x4 g1[2], g2[2];
#pragma unroll
            for (int n = 0; n < 2; ++n) { if (mode) { g1[n] = *(const f32x4*)(gp + 8 * fq + 4 * n); g2[n] = *(const f32x4*)(gp + 32 + 8 * fq + 4 * n); } else { g1[n] = (f32x4){1.f, 1.f, 1.f, 1.f}; g2[n] = g1[n]; } }
#pragma unroll
            for (int ai = 0; ai < 2; ++ai)
#pragma unroll
                for (int m = 0; m < 4; ++m) {
                    const int row = row0 + ai * 128 + m * 16; const float rs = row_scale(ssq, row); const int pos = row & (S - 1);
                    f32x4 x1[2], x2[2];
#pragma unroll
                    for (int n = 0; n < 2; ++n) { x1[n] = acc[ai][0][m][n] * rs; x2[n] = acc[ai][1][m][n] * rs; }
                    if (mode == 2) {
                        float s = 0.f;
#pragma unroll
                        for (int n = 0; n < 2; ++n) s += (x1[n][0] + x1[n][1]) + (x1[n][2] + x1[n][3]) + (x2[n][0] + x2[n][1]) + (x2[n][2] + x2[n][3]);
                        s += __shfl_xor(s, 16); s += __shfl_xor(s, 32); const float mu = s * (1.f / 64.f);
#pragma unroll
                        for (int n = 0; n < 2; ++n) { x1[n] = x1[n] - mu; x2[n] = x2[n] - mu; }
                    }
                    if (mode) {
                        float q = 0.f;
#pragma unroll
                        for (int n = 0; n < 2; ++n) { const f32x4 a = x1[n] * x1[n], b = x2[n] * x2[n]; q += (a[0] + a[1]) + (a[2] + a[3]) + (b[0] + b[1]) + (b[2] + b[3]); }
                        q += __shfl_xor(q, 16); q += __shfl_xor(q, 32); const float rr = rsqrtf(q * (1.f / 64.f) + EPS);
#pragma unroll
                        for (int n = 0; n < 2; ++n) { x1[n] = x1[n] * rr * g1[n]; x2[n] = x2[n] * rr * g2[n]; }
                    }
                    f32x4 o1[2], o2[2];
#pragma unroll
                    for (int n = 0; n < 2; ++n) { const f32x4 c = *(const f32x4*)(cs + (size_t)pos * 32 + 8 * fq + 4 * n), s = *(const f32x4*)(sn + (size_t)pos * 32 + 8 * fq + 4 * n);
                        o1[n] = x1[n] * c - x2[n] * s; o2[n] = x2[n] * c + x1[n] * s; }
                    bf16_t* op = P + (size_t)row * PW + 256 * T + 64 * wc + 8 * fq;
                    *(u32x4*)op = pack8(o1[0], o1[1]); *(u32x4*)(op + 32) = pack8(o2[0], o2[1]);
                }
            return;
        }
        const int act = (T <= 1) ? 1 : 0; const float sc = (T == 8) ? 0.125f : 1.0f;
#pragma unroll
        for (int ai = 0; ai < 2; ++ai)
#pragma unroll
            for (int m = 0; m < 4; ++m) {
                const int row = row0 + ai * 128 + m * 16; const float rs = row_scale(ssq, row) * sc;
                bf16_t* op = P + (size_t)row * PW + 256 * T + 32 * wc + 8 * fq;
#pragma unroll
                for (int bj = 0; bj < 2; ++bj) { f32x4 v0 = acc[ai][bj][m][0] * rs, v1 = acc[ai][bj][m][1] * rs;
                    if (act) {
#pragma unroll
                        for (int e = 0; e < 4; ++e) { v0[e] = gelu_tanh_f(v0[e]); v1[e] = gelu_tanh_f(v1[e]); } }
                    *(u32x4*)(op + bj * 128) = pack8(v0, v1);
                    if (T == 4) { bf16_t* vp = VT + ((size_t)((row >> 12) * 256 + bj * 128 + 32 * wc + 8 * fq)) * S + (row & (S - 1));
#pragma unroll
                        for (int e = 0; e < 4; ++e) { vp[(size_t)e * S] = (bf16_t)f2bf(v0[e]); vp[(size_t)(4 + e) * S] = (bf16_t)f2bf(v1[e]); } } }
            }
    }
};

struct EpiPlain {
    static constexpr bool PERM = true;
    bf16_t* O; int ldc; int zcols;
    __device__ __forceinline__ void operator()(const Acc& acc, const Unit& u, int wr, int wc, int fr, int fq) const {
        const int row0 = u.pm * 256 + wr * 64 + fr; const int col0 = u.z * zcols + u.pn * 256 + 32 * wc + 8 * fq;
#pragma unroll
        for (int ai = 0; ai < 2; ++ai)
#pragma unroll
            for (int m = 0; m < 4; ++m) { bf16_t* op = O + (size_t)(row0 + ai * 128 + m * 16) * ldc + col0;
#pragma unroll
                for (int bj = 0; bj < 2; ++bj) *(u32x4*)(op + bj * 128) = pack8(acc[ai][bj][m][0], acc[ai][bj][m][1]); }
    }
};

struct EpiGate {
    static constexpr bool PERM = true;
    bf16_t* MG; const bf16_t* BR; const float* ssq;
    __device__ __forceinline__ void operator()(const Acc& acc, const Unit& u, int wr, int wc, int fr, int fq) const {
        const int row0 = u.pm * 256 + wr * 64 + fr; const int ch0 = u.pn * 64 + 16 * wc + 4 * fq;
#pragma unroll
        for (int ai = 0; ai < 2; ++ai)
#pragma unroll
            for (int m = 0; m < 4; ++m) {
                const int row = row0 + ai * 128 + m * 16; const float rs = row_scale(ssq, row);
                const bf16_t* bp = BR + (size_t)row * 4096 + ch0; f32x4 o = (f32x4){0.f, 0.f, 0.f, 0.f};
#pragma unroll
                for (int bj = 0; bj < 2; ++bj)
#pragma unroll
                    for (int n = 0; n < 2; ++n) { const u32x2 w = *(const u32x2*)(bp + (2 * bj + n) * 1024); const f32x4 a = acc[ai][bj][m][n] * rs;
                        o[0] += sigmoid_f(a[0]) * lo_bf(w.x); o[1] += sigmoid_f(a[1]) * hi_bf(w.x); o[2] += sigmoid_f(a[2]) * lo_bf(w.y); o[3] += sigmoid_f(a[3]) * hi_bf(w.y); }
                u32x2 ow; ow.x = cvt_pk_bf16(o[0], o[1]); ow.y = cvt_pk_bf16(o[2], o[3]);
                *(u32x2*)(MG + (size_t)row * 1024 + ch0) = ow;
            }
    }
};

struct EpiResid {
    static constexpr bool PERM = true;
    const float* res; float* out; bf16_t* XG; const float* gain; float* ssq;
    __device__ __forceinline__ void operator()(const Acc& acc, const Unit& u, int wr, int wc, int fr, int fq) const {
        const int row0 = u.pm * 256 + wr * 64 + fr; const int col0 = u.pn * 256 + 32 * wc + 8 * fq;
        f32x4 gv[2][2];
#pragma unroll
        for (int bj = 0; bj < 2; ++bj)
#pragma unroll
            for (int n = 0; n < 2; ++n) gv[bj][n] = gain ? *(const f32x4*)(gain + col0 + bj * 128 + 4 * n) : (f32x4){1.f, 1.f, 1.f, 1.f};
#pragma unroll
        for (int ai = 0; ai < 2; ++ai)
#pragma unroll
            for (int m = 0; m < 4; ++m) {
                const int row = row0 + ai * 128 + m * 16; const size_t off = (size_t)row * 1024 + col0; float q = 0.f;
#pragma unroll
                for (int bj = 0; bj < 2; ++bj) {
                    const f32x4 r0 = *(const f32x4*)(res + off + bj * 128), r1 = *(const f32x4*)(res + off + bj * 128 + 4);
                    const f32x4 x0 = r0 + acc[ai][bj][m][0], x1 = r1 + acc[ai][bj][m][1];
                    *(f32x4*)(out + off + bj * 128) = x0; *(f32x4*)(out + off + bj * 128 + 4) = x1;
                    const f32x4 a = x0 * x0, b = x1 * x1; q += ((a[0] + a[1]) + (a[2] + a[3])) + ((b[0] + b[1]) + (b[2] + b[3]));
                    *(u32x4*)(XG + off + bj * 128) = pack8(x0 * gv[bj][0], x1 * gv[bj][1]);
                }
                q += __shfl_xor(q, 16); q += __shfl_xor(q, 32);
                if (fq == 0) ssq[(size_t)row * 16 + 4 * u.pn + wc] = q;
            }
    }
};

struct EpiUp {
    static constexpr bool PERM = true;
    bf16_t* H; const float* ssq;
    __device__ __forceinline__ void operator()(const Acc& acc, const Unit& u, int wr, int wc, int fr, int fq) const {
        const int row0 = u.pm * 256 + wr * 64 + fr; const int col0 = u.pn * 256 + 32 * wc + 8 * fq;
#pragma unroll
        for (int ai = 0; ai < 2; ++ai)
#pragma unroll
            for (int m = 0; m < 4; ++m) { const int row = row0 + ai * 128 + m * 16; const float rs = row_scale(ssq, row); bf16_t* op = H + (size_t)row * FF + col0;
#pragma unroll
                for (int bj = 0; bj < 2; ++bj) { f32x4 v0 = acc[ai][bj][m][0] * rs, v1 = acc[ai][bj][m][1] * rs;
#pragma unroll
                    for (int e = 0; e < 4; ++e) { v0[e] = fmaxf(v0[e], 0.f); v1[e] = fmaxf(v1[e], 0.f); }
                    *(u32x4*)(op + bj * 128) = pack8(v0 * v0, v1 * v1); } }
    }
};
}
struct Args {
    const float* in[18]; float* out; unsigned char* ws; int ph_lo, ph_hi; int coop, pad;
};
struct Frame { LAS unsigned char* lds; int tid, lane, wave, G, vcu; };
constexpr int PTR_OFF = LDS_BYTES - 512;
enum { I_X = 0, I_LN_MIX, I_W_IN, I_SGU_NORM, I_SGU_W, I_SGU_B, I_Q_NORM, I_K_NORM, I_KIDX_NORM, I_I_BIAS, I_F_BIAS, I_MNORM, I_CONV_W, I_W_BRANCH, I_W_OUT, I_LN_MLP, I_W_UP, I_W_DOWN, I_OUT, I_WS };
__device__ __forceinline__ unsigned char* ptr_at(const Frame& F, int i) { const LAS unsigned* p = (const LAS unsigned*)(F.lds + PTR_OFF) + 2 * i;
    const unsigned lo = __builtin_amdgcn_readfirstlane(p[0]), hi = __builtin_amdgcn_readfirstlane(p[1]); return (unsigned char*)(((unsigned long long)hi << 32) | lo); }
#define INP(i) ((const float*)ptr_at(F, (i)))
#define WSP(off) (ptr_at(F, I_WS) + (off))
constexpr size_t WS_GT = 512 * 1024;
__device__ __forceinline__ size_t maskt_idx(int m, int w) { const int b = m >> 12, t = m & (S - 1); return ((size_t)(b * 64 + (w >> 1)) * S + t) * 2 + (w & 1); }

__device__ __forceinline__ int win_src(int p) {
    const int T = p >> 8, q = p & 255, bj = q >> 7, wc = (q >> 5) & 3, j = q & 31, hd = 64 * wc + 32 * bj + j;
    switch (T) {
        case 0: return O_AU + q; case 1: return O_AV + q; case 2: return O_BQ + hd; case 3: return O_BK + hd; case 4: return O_BV + q;
        case 5: return O_QI + hd; case 6: return O_QI + 256 + hd; case 7: return O_CQ + q; case 8: return O_CK + q; case 9: return O_CV + q;
        case 10: return O_CO + q; case 11: return O_DB + q; case 12: return O_DC + q; case 13: return O_DX + q;
        default: break;
    }
    if (wc == 0) return O_KI + 32 * bj + j;
    if (wc == 1 && bj == 0 && j < 16) return j < 8 ? O_WI + j : (j < 12 ? O_CI + (j - 8) : O_CF + (j - 12));
    return -1;
}
__device__ __forceinline__ int wg_src(int p) {
    const int pn = p >> 8, q = p & 255, bj = q >> 7, wc = (q >> 5) & 3, fq = (q >> 3) & 3, n = (q >> 2) & 1, e = q & 3;
    return O_G + (2 * bj + n) * 1024 + 64 * pn + 16 * wc + 4 * fq + e;
}
template <int MAP>
__device__ __forceinline__ void conv_item(const float* W, int K, int srcN, bf16_t* WT, LAS float* scr, int item, int nrows, int lane) {
    const int nblk = nrows / 32, kb = item / nblk, nb = item % nblk, k0 = 64 * kb, n0 = 32 * nb;
    const int nn = n0 + (lane & 31); const int src = MAP == 0 ? nn : (MAP == 1 ? win_src(nn) : wg_src(nn));
#pragma unroll 8
    for (int i = 0; i < 32; ++i) { const int kk = 2 * i + (lane >> 5); scr[kk * 33 + (lane & 31)] = src >= 0 ? W[(size_t)(k0 + kk) * srcN + src] : 0.f; }
    asm volatile("s_waitcnt lgkmcnt(0)" ::: "memory");
    const int c = lane & 7;
#pragma unroll
    for (int j = 0; j < 4; ++j) { const int n = (lane >> 3) + 8 * j; const LAS float* s = scr + (8 * c) * 33 + n;
        u32x4 o; o.x = pk2(s[0 * 33], s[1 * 33]); o.y = pk2(s[2 * 33], s[3 * 33]); o.z = pk2(s[4 * 33], s[5 * 33]); o.w = pk2(s[6 * 33], s[7 * 33]);
        *(u32x4*)(WT + (size_t)(n0 + n) * K + k0 + 8 * c) = o; }
    asm volatile("s_waitcnt lgkmcnt(0)" ::: "memory");
}
__device__ __forceinline__ void convert_mix_weights(Frame& F, int l) {

    LAS float* scr = (LAS float*)(F.lds + F.wave * 16384);
    const int gw = F.vcu * NWAVES + F.wave, NGW = F.G * NWAVES;
    constexpr int I_WIN = (D / 64) * (PW / 32), I_WG = (D / 64) * (4096 / 32), I_BR = (256 / 64) * (1024 / 32), I_OUT = (D / 64) * (D / 32);
    constexpr int NIT = I_WIN + I_WG + 4 * I_BR + I_OUT;
    const float* win = INP(I_W_IN) + (size_t)l * D * INW;
    for (int it = gw; it < NIT; it += NGW) {
        int r = it;
        if (r < I_WIN) { conv_item<1>(win, D, INW, ((bf16_t*)WSP(WS_WIN)), scr, r, PW, F.lane); continue; } r -= I_WIN;
        if (r < I_WG) { conv_item<2>(win, D, INW, ((bf16_t*)WSP(WS_WG)), scr, r, 4096, F.lane); continue; } r -= I_WG;
        if (r < 4 * I_BR) { const int nb = r / I_BR; conv_item<0>(INP(I_W_BRANCH) + ((size_t)l * 4 + nb) * 256 * D, 256, D, ((bf16_t*)WSP(WS_WBR)) + (size_t)nb * 1024 * 256, scr, r % I_BR, 1024, F.lane); continue; } r -= 4 * I_BR;
        conv_item<0>(INP(I_W_OUT) + (size_t)l * D * D, D, D, ((bf16_t*)WSP(WS_WOUT)), scr, r, D, F.lane);
    }
}
__device__ __forceinline__ void convert_mlp_weights(Frame& F, int l) {

    LAS float* scr = (LAS float*)(F.lds + F.wave * 16384);
    const int gw = F.vcu * NWAVES + F.wave, NGW = F.G * NWAVES;
    constexpr int I_UP = (D / 64) * (FF / 32), I_DN = (FF / 64) * (D / 32);
    for (int it = gw; it < I_UP + I_DN; it += NGW) {
        if (it < I_UP) conv_item<0>(INP(I_W_UP) + (size_t)l * D * FF, D, FF, ((bf16_t*)WSP(WS_WUP)), scr, it, FF, F.lane);
        else conv_item<0>(INP(I_W_DOWN) + (size_t)l * FF * D, FF, D, ((bf16_t*)WSP(WS_WDN)), scr, it - I_UP, D, F.lane);
    }
}
__device__ __forceinline__ void prologue_rows(Frame& F) {
    float* COS = (float*)WSP(WS_COS); float* SIN = (float*)WSP(WS_SIN); float* SSQA = (float*)WSP(WS_SSQA); bf16_t* XG = (bf16_t*)WSP(WS_XG); const float* x = INP(I_X); const float* ln_mix = INP(I_LN_MIX);
    const int gt = F.vcu * NT + F.tid, NGT = F.G * NT;
    for (int i = gt; i < S * 32; i += NGT) { const int pos = i >> 5, k = i & 31; const float inv = powf(10000.f, -(float)k * 2.0f / 64.f); const float ang = (float)pos * inv; COS[i] = cosf(ang); SIN[i] = sinf(ang); }
    const int gw = F.vcu * NWAVES + F.wave, NGW = F.G * NWAVES;
    for (int m = gw; m < M; m += NGW) {
        const f32x4* xr = (const f32x4*)(x + (size_t)m * D) + F.lane; const f32x4* gr = (const f32x4*)ln_mix + F.lane;
        unsigned long long* o8 = (unsigned long long*)(XG + (size_t)m * D) + F.lane;
#pragma unroll
        for (int j = 0; j < 4; ++j) { const f32x4 v = xr[64 * j], g = gr[64 * j]; float s = (v[0] * v[0] + v[1] * v[1]) + (v[2] * v[2] + v[3] * v[3]);
            s += __shfl_xor(s, 1); s += __shfl_xor(s, 2); s += __shfl_xor(s, 4); s += __shfl_xor(s, 8);
            if ((F.lane & 15) == 0) SSQA[(size_t)m * 16 + 4 * j + (F.lane >> 4)] = s;
            o8[64 * j] = (unsigned long long)pk2(v[0] * g[0], v[1] * g[1]) | ((unsigned long long)pk2(v[2] * g[2], v[3] * g[3]) << 32); }
    }
}

__device__ __forceinline__ void sgu_simple(Frame& F, int l) {
    bf16_t* PROJ = (bf16_t*)WSP(WS_BIG); bf16_t* Y = (bf16_t*)WSP(WS_Y); const float* sgu_norm = INP(I_SGU_NORM); const float* sgu_w = INP(I_SGU_W); const float* sgu_b = INP(I_SGU_B);
    LAS float* r_s = (LAS float*)F.lds; LAS float* vn = r_s + 128;
    const float* gain = sgu_norm + l * 256; const float* sw = sgu_w + (size_t)l * 4 * 128 * 128; const float* sb = sgu_b + l * 4 * 128;
    for (int item = F.vcu; item < 512; item += F.G) {
        const int g = item & 3, m0 = (item >> 2) * 128;
        for (int i = 0; i < 16; ++i) { const int tok = F.wave * 16 + i; const u32x2 w = *(const u32x2*)(PROJ + (size_t)(m0 + tok) * PW + P_AV + 4 * F.lane);
            const float a = lo_bf(w.x), b = hi_bf(w.x), c = lo_bf(w.y), d = hi_bf(w.y); const float ss = wave_sum((a * a + b * b) + (c * c + d * d));
            if (F.lane == 0) r_s[tok] = rsqrtf(ss * (1.f / 256.f) + EPS); }
        __syncthreads();
        for (int idx = F.tid; idx < 8192; idx += NT) { const int s = idx >> 6, d = idx & 63; vn[idx] = bf2f(PROJ[(size_t)(m0 + s) * PW + P_AV + g * 64 + d]) * r_s[s] * gain[g * 64 + d]; }
        __syncthreads();
        const int d = F.tid & 63, tq = F.tid >> 6;
        for (int tl = tq; tl < 128; tl += 8) { const float* w = sw + ((size_t)g * 128 + tl) * 128; float acc = 0.f;
            for (int s = 0; s <= tl; ++s) acc = fmaf(w[s], vn[s * 64 + d], acc);
            acc += sb[g * 128 + tl];
            Y[(size_t)(m0 + tl) * D + g * 64 + d] = (bf16_t)f2bf(bf2f(PROJ[(size_t)(m0 + tl) * PW + P_AU + g * 64 + d]) * acc); }
        __syncthreads();
    }
}
__device__ __forceinline__ void conv_simple(Frame& F, int l) {
    bf16_t* PROJ = (bf16_t*)WSP(WS_BIG); bf16_t* Y = (bf16_t*)WSP(WS_Y); const float* conv_w = INP(I_CONV_W);
    const float* cw = conv_w + l * 3 * 256;
    for (int i = F.vcu * NT + F.tid; i < M * 256; i += F.G * NT) { const int m = i >> 8, c = i & 255, t = m & (S - 1); float acc = 0.f;
#pragma unroll
        for (int j = 0; j < 3; ++j) { const int tt = t - 2 + j; if (tt >= 0) { const size_t r = (size_t)(m - 2 + j) * PW; acc = fmaf(cw[j * 256 + c], bf2f(PROJ[r + P_DC + c]) * bf2f(PROJ[r + P_DX + c]), acc); } }
        Y[(size_t)m * D + 768 + c] = (bf16_t)f2bf(bf2f(PROJ[(size_t)m * PW + P_DB + c]) * acc); }
}
__device__ __forceinline__ void indexer_simple(Frame& F) {
    float* MISC = (float*)WSP(WS_MISC); unsigned* MASK = (unsigned*)WSP(WS_MASK); bf16_t* PROJ = (bf16_t*)WSP(WS_BIG);
    LAS float* sc = (LAS float*)F.lds; LAS int* red = (LAS int*)(sc + 4096); LAS unsigned* msk = (LAS unsigned*)(red + 16);
    for (int m = F.vcu; m < M; m += F.G) {
        const int t = m & (S - 1), b0 = m - t, n = t + 1;
        if (n <= 256) { if (F.tid < 128) { const int lo = 32 * F.tid; MASK[maskt_idx(m, F.tid)] = (lo + 32 <= n) ? 0xffffffffu : (lo >= n ? 0u : ((1u << (n - lo)) - 1u)); } continue; }
        float qreg[8], wh[8];
#pragma unroll
        for (int h = 0; h < 8; ++h) { qreg[h] = bf2f(PROJ[(size_t)m * PW + P_QI + h * 64 + F.lane]); wh[h] = MISC[(size_t)m * 16 + h] * 0.35355339059327373f; }
        for (int s0 = 0; s0 < n; s0 += NT) {
            const int s = s0 + F.tid, sc_ = s < n ? s : n - 1; const u32x4* kr = (const u32x4*)(PROJ + (size_t)(b0 + sc_) * PW + P_KI);
            float kf[64];
#pragma unroll
            for (int i = 0; i < 8; ++i) { const u32x4 w = kr[i]; kf[8 * i] = lo_bf(w.x); kf[8 * i + 1] = hi_bf(w.x); kf[8 * i + 2] = lo_bf(w.y); kf[8 * i + 3] = hi_bf(w.y); kf[8 * i + 4] = lo_bf(w.z); kf[8 * i + 5] = hi_bf(w.z); kf[8 * i + 6] = lo_bf(w.w); kf[8 * i + 7] = hi_bf(w.w); }
            float acc = 0.f;
#pragma unroll
            for (int h = 0; h < 8; ++h) { float d0 = 0.f, d1 = 0.f;
#pragma unroll
                for (int e = 0; e < 64; e += 2) { d0 = fmaf(__builtin_bit_cast(float, __builtin_amdgcn_readlane(__builtin_bit_cast(int, qreg[h]), e)), kf[e], d0);
                                                   d1 = fmaf(__builtin_bit_cast(float, __builtin_amdgcn_readlane(__builtin_bit_cast(int, qreg[h]), e + 1)), kf[e + 1], d1); }
                acc += wh[h] * fmaxf((d0 + d1) * 0.125f, 0.f); }
            if (s < n) sc[s] = acc;
        }
        __syncthreads();
        unsigned Tk = 0u;
        for (int bit = 31; bit >= 0; --bit) {
            const unsigned cand = Tk | (1u << bit); int c = 0;
            for (int s = F.tid; s < n; s += NT) c += (fkey(sc[s]) >= cand) ? 1 : 0;
            c = wave_sum_i(c); if (F.lane == 0) red[F.wave] = c; __syncthreads();
            int tot = 0;
#pragma unroll
            for (int w = 0; w < 8; ++w) tot += red[w];
            __syncthreads();
            if (tot >= 256) Tk = cand;
        }
        int cg_ = 0, ce = 0;
        for (int s = F.tid; s < n; s += NT) { const unsigned k = fkey(sc[s]); cg_ += k > Tk ? 1 : 0; ce += k == Tk ? 1 : 0; }
        cg_ = wave_sum_i(cg_); ce = wave_sum_i(ce); if (F.lane == 0) { red[F.wave] = cg_; red[8 + F.wave] = ce; }
        if (F.tid < 128) msk[F.tid] = 0u;
        __syncthreads();
        int ngt = 0, neq = 0;
#pragma unroll
        for (int w = 0; w < 8; ++w) { ngt += red[w]; neq += red[8 + w]; }
        const bool all_eq = (ngt + neq == 256);
        for (int s = F.tid; s < n; s += NT) { const unsigned k = fkey(sc[s]); if (k > Tk || (all_eq && k == Tk)) atomicOr((unsigned*)&msk[s >> 5], 1u << (s & 31)); }
        __syncthreads();
        if (!all_eq && F.tid == 0) { int need = 256 - ngt; for (int s = 0; s < n && need > 0; ++s) if (fkey(sc[s]) == Tk) { msk[s >> 5] |= 1u << (s & 31); --need; } }
        __syncthreads();
        if (F.tid < 128) MASK[maskt_idx(m, F.tid)] = msk[F.tid];
        __syncthreads();
    }
}
__device__ __forceinline__ void attn_simple(Frame& F) {
    unsigned* MASK = (unsigned*)WSP(WS_MASK); bf16_t* PROJ = (bf16_t*)WSP(WS_BIG); bf16_t* Y = (bf16_t*)WSP(WS_Y);
    LAS unsigned* msk = (LAS unsigned*)F.lds; LAS int* sel = (LAS int*)(msk + 128); LAS float* lg = (LAS float*)(sel + 256); LAS int* nsel = (LAS int*)(lg + 4 * 256);
    for (int m = F.vcu; m < M; m += F.G) {
        const int t = m & (S - 1), b0 = m - t;
        if (F.tid < 128) msk[F.tid] = MASK[maskt_idx(m, F.tid)];
        __syncthreads();
        if (F.tid == 0) { int c = 0; for (int w = 0; w < 128; ++w) { unsigned bits = msk[w]; while (bits) { const int i = __builtin_ctz(bits); if (c < 256) sel[c] = 32 * w + i; ++c; bits &= bits - 1; } } nsel[0] = c < 256 ? c : 256; }
        __syncthreads();
        const int ns = nsel[0], h = F.wave & 3, part = F.wave >> 2;
        const float q = bf2f(PROJ[(size_t)m * PW + P_Q + h * 64 + F.lane]);
        for (int j = part; j < ns; j += 2) { const float d = wave_sum(q * bf2f(PROJ[(size_t)(b0 + sel[j]) * PW + P_K + h * 64 + F.lane])); if (F.lane == 0) lg[h * 256 + j] = d * 0.125f; }
        __syncthreads();
        if (F.wave < 4) {
            float mx = -INFINITY; for (int j = F.lane; j < ns; j += 64) mx = fmaxf(mx, lg[h * 256 + j]); mx = wave_max(mx);
            float sm = 0.f; for (int j = F.lane; j < ns; j += 64) sm += __expf(lg[h * 256 + j] - mx); sm = wave_sum(sm);
            float o = 0.f; for (int j = 0; j < ns; ++j) o = fmaf(__expf(lg[h * 256 + j] - mx), bf2f(PROJ[(size_t)(b0 + sel[j]) * PW + P_V + h * 64 + F.lane]), o);
            Y[(size_t)m * D + 256 + h * 64 + F.lane] = (bf16_t)f2bf(o / sm);
        }
        __syncthreads();
    }
}
__device__ __forceinline__ void mlstm1_simple(Frame& F, int l) {
    float* MISC = (float*)WSP(WS_MISC); float* STATE = (float*)WSP(WS_STATE); bf16_t* PROJ = (bf16_t*)WSP(WS_BIG); const float* i_bias = INP(I_I_BIAS); const float* f_bias = INP(I_F_BIAS);
    LAS float* bs = (LAS float*)F.lds; LAS float* ig = bs + 128; LAS float* wk = ig + 128; LAS float* kt = wk + 128; LAS float* vt = kt + 128 * 64;
    for (int item = F.vcu; item < 512; item += F.G) {
        const int bh = item >> 5, c = item & 31, b = bh >> 2, h = bh & 3, m0 = b * S + c * 128;
        if (F.tid < 128) { const float f = MISC[(size_t)(m0 + F.tid) * 16 + 12 + h] + f_bias[l * 4 + h]; bs[F.tid] = fminf(f, 0.f) - log1pf(__expf(-fabsf(f))); ig[F.tid] = MISC[(size_t)(m0 + F.tid) * 16 + 8 + h] + i_bias[l * 4 + h]; }
        for (int idx = F.tid; idx < 8192; idx += NT) { const int s = idx >> 6, d = idx & 63; kt[idx] = bf2f(PROJ[(size_t)(m0 + s) * PW + P_CK + h * 64 + d]); vt[idx] = bf2f(PROJ[(size_t)(m0 + s) * PW + P_CV + h * 64 + d]); }
        __syncthreads();
        if (F.tid == 0) { float a = 0.f; for (int s = 0; s < 128; ++s) { a += bs[s]; bs[s] = a; } }
        __syncthreads();
        const float B = bs[127];
        if (F.tid < 128) wk[F.tid] = __expf(B - bs[F.tid] + ig[F.tid]);
        __syncthreads();
        const int e = F.tid & 63, dq = F.tid >> 6; float acc[8];
#pragma unroll
        for (int i = 0; i < 8; ++i) acc[i] = 0.f;
        for (int s = 0; s < 128; ++s) { const float kv = wk[s] * vt[s * 64 + e];
#pragma unroll
            for (int i = 0; i < 8; ++i) acc[i] = fmaf(kt[s * 64 + dq * 8 + i], kv, acc[i]); }
        float* st = STATE + (size_t)item * STATE_STRIDE;
#pragma unroll
        for (int i = 0; i < 8; ++i) st[(dq * 8 + i) * 64 + e] = acc[i];
        if (F.tid < 64) { float a = 0.f; for (int s = 0; s < 128; ++s) a = fmaf(wk[s], kt[s * 64 + F.tid], a); st[4096 + F.tid] = a; }
        if (F.tid == 0) st[4160] = B;
        __syncthreads();
    }
}
__device__ __forceinline__ void mlstm2_simple(Frame& F, int l) {
    float* MISC = (float*)WSP(WS_MISC); float* STATE = (float*)WSP(WS_STATE); bf16_t* PROJ = (bf16_t*)WSP(WS_BIG); bf16_t* Y = (bf16_t*)WSP(WS_Y); const float* i_bias = INP(I_I_BIAS); const float* f_bias = INP(I_F_BIAS); const float* mnorm = INP(I_MNORM);
    LAS float* Cs = (LAS float*)F.lds; LAS float* ns = Cs + 4096; LAS float* bs = ns + 64; LAS float* ig = bs + 128; LAS float* A = ig + 128;
    LAS float* qt = A + 128 * 128; LAS float* kt = qt + 128 * 65;
    for (int item = F.vcu; item < 512; item += F.G) {
        const int bh = item >> 5, c = item & 31, b = bh >> 2, h = bh & 3, m0 = b * S + c * 128;
        { float Cv[8]; float nv = 0.f;
#pragma unroll
          for (int k = 0; k < 8; ++k) Cv[k] = 0.f;
          for (int cc = 0; cc < c; ++cc) { const float* st = STATE + (size_t)(bh * 32 + cc) * STATE_STRIDE; const float dec = __expf(st[4160]);
#pragma unroll
              for (int k = 0; k < 8; ++k) Cv[k] = fmaf(dec, Cv[k], st[F.tid + NT * k]);
              if (F.tid < 64) nv = fmaf(dec, nv, st[4096 + F.tid]); }
#pragma unroll
          for (int k = 0; k < 8; ++k) Cs[F.tid + NT * k] = Cv[k];
          if (F.tid < 64) ns[F.tid] = nv; }
        if (F.tid < 128) { const float f = MISC[(size_t)(m0 + F.tid) * 16 + 12 + h] + f_bias[l * 4 + h]; bs[F.tid] = fminf(f, 0.f) - log1pf(__expf(-fabsf(f))); ig[F.tid] = MISC[(size_t)(m0 + F.tid) * 16 + 8 + h] + i_bias[l * 4 + h]; }
        for (int idx = F.tid; idx < 8192; idx += NT) { const int s = idx >> 6, d = idx & 63; qt[s * 65 + d] = bf2f(PROJ[(size_t)(m0 + s) * PW + P_CQ + h * 64 + d]); kt[s * 65 + d] = bf2f(PROJ[(size_t)(m0 + s) * PW + P_CK + h * 64 + d]); }
        __syncthreads();
        if (F.tid == 0) { float a = 0.f; for (int s = 0; s < 128; ++s) { a += bs[s]; bs[s] = a; } }
        __syncthreads();
        { const int s = F.tid & 127, jq = F.tid >> 7;
          for (int j = jq; j < 128; j += 4) { float v = 0.f;
              if (s <= j) { float d = 0.f;
#pragma unroll 16
                  for (int k = 0; k < 64; ++k) d = fmaf(qt[j * 65 + k], kt[s * 65 + k], d);
                  v = __expf(bs[j] - bs[s] + ig[s]) * d; }
              A[j * 128 + s] = v; } }
        __syncthreads();
        LAS float* vt = kt;
        for (int idx = F.tid; idx < 8192; idx += NT) { const int s = idx >> 6, d = idx & 63; vt[idx] = bf2f(PROJ[(size_t)(m0 + s) * PW + P_CV + h * 64 + d]); }
        __syncthreads();
        const int e = F.lane; const float gn = mnorm[l * 256 + h * 64 + e];
        for (int j = F.wave; j < 128; j += 8) {
            float num = 0.f, qn = 0.f, sa = 0.f;
            for (int d = 0; d < 64; ++d) { const float qd = qt[j * 65 + d]; num = fmaf(qd, Cs[d * 64 + e], num); qn = fmaf(qd, ns[d], qn); }
            const float eb = __expf(bs[j]); num *= eb; qn *= eb;
            for (int s = 0; s <= j; ++s) { const float a = A[j * 128 + s]; num = fmaf(a, vt[s * 64 + e], num); sa += a; }
            const float hv = num / fmaxf(fabsf(qn + sa), 1.f);
            const float r = rsqrtf(wave_sum(hv * hv) * (1.f / 64.f) + EPS);
            const size_t row = (size_t)(m0 + j);
            Y[row * D + 512 + h * 64 + e] = (bf16_t)f2bf(sigmoid_f(bf2f(PROJ[row * PW + P_CO + h * 64 + e])) * hv * r * gn);
        }
        __syncthreads();
    }
}
typedef float f32x16 __attribute__((ext_vector_type(16)));
constexpr size_t WS_VT = WS_BIG + 120 * MiB;
constexpr float LOG2E = 1.4426950408889634f;

__device__ __forceinline__ void attn_mfma(Frame& F, int l) {
    const unsigned long long* MASKT = (const unsigned long long*)WSP(WS_MASK); const bf16_t* PROJ = (const bf16_t*)WSP(WS_BIG); const bf16_t* VT = (const bf16_t*)WSP(WS_VT);
    bf16_t* Y = (bf16_t*)WSP(WS_Y); const float* gt = (const float*)WSP(WS_GT) + l * 192;
    const int lane = F.lane, r32 = lane & 31, hi = lane >> 5, grp = F.wave >> 2, w4 = F.wave & 3, lg = F.tid & 255;
    const float mq = wave_max(fabsf(gt[lane])), mk = wave_max(fabsf(gt[64 + lane]));
    const float c1 = 0.125f * LOG2E, c2 = 8.f * mq * mk * 1.01f * LOG2E;
    constexpr int ROWB = 144, TILEB = 64 * ROWB;
    LAS unsigned char* gb = F.lds + grp * 4 * TILEB;
    LAS float* comb = (LAS float*)(F.lds + 8 * TILEB);
    const int srow0 = lg >> 3, sc0 = lg & 7;
    for (int item = F.vcu; item < 256; item += F.G) {
        const int bh = item >> 4, sidx = item & 15, b = bh >> 2, h = bh & 3;
#pragma unroll 1
        for (int half = 0; half < 2; ++half) {
            const int qb = half == 0 ? sidx : 31 - sidx, q0 = qb * 128, ntl = qb + 1;
            const int qrow = b * S + q0 + w4 * 32 + r32, tq = q0 + w4 * 32 + r32;
            bf16x8 qf[4];
#pragma unroll
            for (int s = 0; s < 4; ++s) qf[s] = *(const bf16x8*)(PROJ + (size_t)qrow * PW + P_Q + h * 64 + 16 * s + 8 * hi);
            f32x16 o0, o1;
#pragma unroll
            for (int r = 0; r < 16; ++r) { o0[r] = 0.f; o1[r] = 0.f; }
            float lsum = 0.f;
            const bf16_t* kbase = PROJ + (size_t)(b * S + srow0) * PW + P_K + h * 64 + sc0 * 8;
            const bf16_t* vbase = VT + (size_t)(b * 256 + h * 64 + srow0) * S + sc0 * 8;
            const unsigned long long* mbase = MASKT + (size_t)(b * 64) * S + tq;
            u32x4 kr0, kr1, vr0, vr1; unsigned long long mw, mwn = 0ull;
            { const int t = grp; kr0 = *(const u32x4*)(kbase + (size_t)t * 64 * PW); kr1 = *(const u32x4*)(kbase + (size_t)(t * 64 + 32) * PW);
              vr0 = *(const u32x4*)(vbase + t * 64); vr1 = *(const u32x4*)(vbase + 32 * S + t * 64); mw = mbase[(size_t)t * S];
              LAS unsigned char* kb = gb; LAS unsigned char* vb = gb + TILEB;
              *(LAS u32x4*)(kb + srow0 * ROWB + sc0 * 16) = kr0; *(LAS u32x4*)(kb + (srow0 + 32) * ROWB + sc0 * 16) = kr1;
              *(LAS u32x4*)(vb + srow0 * ROWB + sc0 * 16) = vr0; *(LAS u32x4*)(vb + (srow0 + 32) * ROWB + sc0 * 16) = vr1; }
            __syncthreads();
#pragma unroll 1
            for (int i = 0; i < ntl; ++i) {
                const int cur = i & 1; const bool more = (i + 1 < ntl);
                if (more) { const int t = 2 * (i + 1) + grp; kr0 = *(const u32x4*)(kbase + (size_t)t * 64 * PW); kr1 = *(const u32x4*)(kbase + (size_t)(t * 64 + 32) * PW);
                    vr0 = *(const u32x4*)(vbase + t * 64); vr1 = *(const u32x4*)(vbase + 32 * S + t * 64); mwn = mbase[(size_t)t * S]; }
                const LAS unsigned char* kb = gb + cur * 2 * TILEB; const LAS unsigned char* vb = kb + TILEB;
                f32x16 p0, p1;
#pragma unroll
                for (int r = 0; r < 16; ++r) { p0[r] = 0.f; p1[r] = 0.f; }
#pragma unroll
                for (int s = 0; s < 4; ++s) {
                    const bf16x8 k0 = *(const LAS bf16x8*)(kb + r32 * ROWB + 32 * s + 16 * hi), k1 = *(const LAS bf16x8*)(kb + (32 + r32) * ROWB + 32 * s + 16 * hi);
                    p0 = __builtin_amdgcn_mfma_f32_32x32x16_bf16(k0, qf[s], p0, 0, 0, 0); p1 = __builtin_amdgcn_mfma_f32_32x32x16_bf16(k1, qf[s], p1, 0, 0, 0);
                }
                const unsigned sh0 = (unsigned)mw >> (4 * hi), sh1 = (unsigned)(mw >> 32) >> (4 * hi);
#pragma unroll
                for (int r = 0; r < 16; ++r) { const int cb = (r & 3) + 8 * (r >> 2);
                    const float e0 = __builtin_amdgcn_exp2f(p0[r] * c1 - c2), e1 = __builtin_amdgcn_exp2f(p1[r] * c1 - c2);
                    p0[r] = ((sh0 >> cb) & 1u) ? e0 : 0.f; p1[r] = ((sh1 >> cb) & 1u) ? e1 : 0.f; lsum += p0[r] + p1[r]; }
#pragma unroll
                for (int ks = 0; ks < 4; ++ks) {
                    u32x4 pw;
                    if (ks < 2) { pw.x = cvt_pk_bf16(p0[8 * ks + 0], p0[8 * ks + 1]); pw.y = cvt_pk_bf16(p0[8 * ks + 2], p0[8 * ks + 3]); pw.z = cvt_pk_bf16(p0[8 * ks + 4], p0[8 * ks + 5]); pw.w = cvt_pk_bf16(p0[8 * ks + 6], p0[8 * ks + 7]); }
                    else { const int k2 = ks - 2; pw.x = cvt_pk_bf16(p1[8 * k2 + 0], p1[8 * k2 + 1]); pw.y = cvt_pk_bf16(p1[8 * k2 + 2], p1[8 * k2 + 3]); pw.z = cvt_pk_bf16(p1[8 * k2 + 4], p1[8 * k2 + 5]); pw.w = cvt_pk_bf16(p1[8 * k2 + 6], p1[8 * k2 + 7]); }
                    const bf16x8 pf = __builtin_bit_cast(bf16x8, pw);
                    const int vo = 64 * (ks >> 1) + 32 * (ks & 1) + 8 * hi;
                    const u32x2 a0 = *(const LAS u32x2*)(vb + r32 * ROWB + vo), a1 = *(const LAS u32x2*)(vb + r32 * ROWB + vo + 16);
                    const u32x2 b0 = *(const LAS u32x2*)(vb + (32 + r32) * ROWB + vo), b1 = *(const LAS u32x2*)(vb + (32 + r32) * ROWB + vo + 16);
                    const u32x4 va = {a0.x, a0.y, a1.x, a1.y}, vb4 = {b0.x, b0.y, b1.x, b1.y};
                    o0 = __builtin_amdgcn_mfma_f32_32x32x16_bf16(__builtin_bit_cast(bf16x8, va), pf, o0, 0, 0, 0);
                    o1 = __builtin_amdgcn_mfma_f32_32x32x16_bf16(__builtin_bit_cast(bf16x8, vb4), pf, o1, 0, 0, 0);
                }
                if (more) { LAS unsigned char* kn = gb + (cur ^ 1) * 2 * TILEB; LAS unsigned char* vn = kn + TILEB;
                    *(LAS u32x4*)(kn + srow0 * ROWB + sc0 * 16) = kr0; *(LAS u32x4*)(kn + (srow0 + 32) * ROWB + sc0 * 16) = kr1;
                    *(LAS u32x4*)(vn + srow0 * ROWB + sc0 * 16) = vr0; *(LAS u32x4*)(vn + (srow0 + 32) * ROWB + sc0 * 16) = vr1; mw = mwn; }
                __syncthreads();
            }
            if (grp == 1) { LAS float* cw = comb + w4 * 33 * 64 + lane;
#pragma unroll
                for (int r = 0; r < 16; ++r) { cw[r * 64] = o0[r]; cw[(16 + r) * 64] = o1[r]; }
                cw[32 * 64] = lsum; }
            __syncthreads();
            if (grp == 0) { const LAS float* cw = comb + w4 * 33 * 64 + lane;
#pragma unroll
                for (int r = 0; r < 16; ++r) { o0[r] += cw[r * 64]; o1[r] += cw[(16 + r) * 64]; }
                lsum += cw[32 * 64]; lsum += __shfl_xor(lsum, 32); const float inv = 1.f / lsum;
                bf16_t* yp = Y + (size_t)qrow * D + 256 + h * 64 + 4 * hi;
#pragma unroll
                for (int g4 = 0; g4 < 4; ++g4) { u32x2 w0, w1;
                    w0.x = cvt_pk_bf16(o0[4 * g4] * inv, o0[4 * g4 + 1] * inv); w0.y = cvt_pk_bf16(o0[4 * g4 + 2] * inv, o0[4 * g4 + 3] * inv);
                    w1.x = cvt_pk_bf16(o1[4 * g4] * inv, o1[4 * g4 + 1] * inv); w1.y = cvt_pk_bf16(o1[4 * g4 + 2] * inv, o1[4 * g4 + 3] * inv);
                    *(u32x2*)(yp + 8 * g4) = w0; *(u32x2*)(yp + 32 + 8 * g4) = w1; } }
            __syncthreads();
        }
    }
}
#ifndef MK_MULTI
#define MK_MULTI 0
#endif
constexpr int N_PHASES = 1 + 8 * DEPTH;

__global__ void __launch_bounds__(NT, 2) mk_fwd(Args args) {
    extern __shared__ __attribute__((aligned(16))) unsigned char lds_raw[];
    Frame F;
    F.lds = (LAS unsigned char*)lds_raw; F.tid = threadIdx.x; F.lane = F.tid & 63; F.wave = __builtin_amdgcn_readfirstlane(F.tid >> 6);
    F.G = gridDim.x; { const int bx_ = blockIdx.x; F.vcu = (F.G % 8 == 0) ? (bx_ % 8) * (F.G / 8) + bx_ / 8 : bx_; }
    if (F.tid < 20) { const unsigned long long pv = F.tid < 18 ? (unsigned long long)args.in[F.tid < 18 ? F.tid : 0] : (F.tid == 18 ? (unsigned long long)args.out : (unsigned long long)args.ws);
        *(LAS unsigned long long*)(F.lds + PTR_OFF + 8 * F.tid) = pv; }
    __syncthreads();
    const int lo = args.ph_lo, hi = args.ph_hi; const bool coop = args.coop != 0;
#define RUN(k) (lo <= (k) && (k) < hi)
#define LAUNDER() asm volatile("" : "+v"(F.tid), "+v"(F.lane))
#define SEAM(k) do { if (coop && RUN(k) && RUN((k) + 1)) { cg::this_grid().sync(); } } while (0)
    const int bx = (int)blockIdx.x;

    if (RUN(0)) { LAUNDER(); convert_mix_weights(F, 0); prologue_rows(F);
        if (blockIdx.x == 0 && F.tid < DEPTH * 192) { const int l_ = F.tid / 192, r_ = F.tid % 192, w_ = r_ / 64, i_ = r_ % 64; ((float*)WSP(WS_GT))[F.tid] = INP(I_Q_NORM + w_)[l_ * 64 + i_]; } }
    SEAM(0);
#pragma unroll 1
    for (int l = 0; l < DEPTH; ++l) {
        const int pb = 1 + 8 * l;
        if (RUN(pb + 0)) { LAUNDER();
            pg8::Gemm<D, D, D, 256u * D * 2, 0, 256u * D * 2, 0> g{(const bf16_t*)WSP(WS_XG), (const bf16_t*)WSP(WS_WIN)};
            pg8::StaticOrder So; So.init(M, PW, F.G, bx);
            epi::EpiProj E{(bf16_t*)WSP(WS_BIG), (float*)WSP(WS_MISC), (const float*)WSP(WS_SSQA), (const float*)WSP(WS_COS), (const float*)WSP(WS_SIN), (const float*)WSP(WS_GT) + l * 192, (bf16_t*)WSP(WS_VT)};
            pg8::gemm_phase<epi::EpiProj, pg8::StaticOrder, true>(F.lds, g, So, E, F.tid);
        }
        SEAM(pb + 0);
        if (RUN(pb + 1)) { LAUNDER(); sgu_simple(F, l); conv_simple(F, l); indexer_simple(F); mlstm1_simple(F, l); }
        SEAM(pb + 1);
        if (RUN(pb + 2)) { LAUNDER(); attn_mfma(F, l); mlstm2_simple(F, l); }
        SEAM(pb + 2);
        if (RUN(pb + 3)) { LAUNDER();
            pg8::Gemm<256, D, 256, 256u * D * 2, 256u * 2, 256u * 256 * 2, 1024u * 256 * 2> g{(const bf16_t*)WSP(WS_Y), (const bf16_t*)WSP(WS_WBR)};
            pg8::SuperOrder<0> So; So.init(F.G, bx);
            epi::EpiPlain E{(bf16_t*)WSP(WS_BIG), 4096, 1024};
            pg8::gemm_phase<epi::EpiPlain, pg8::SuperOrder<0>, true>(F.lds, g, So, E, F.tid);
        }
        SEAM(pb + 3);
        if (RUN(pb + 4)) { LAUNDER();
            pg8::Gemm<D, D, D, 256u * D * 2, 0, 256u * D * 2, 0> g{(const bf16_t*)WSP(WS_XG), (const bf16_t*)WSP(WS_WG)};
            pg8::SuperOrder<1> So; So.init(F.G, bx);
            epi::EpiGate E{(bf16_t*)WSP(WS_MG), (const bf16_t*)WSP(WS_BIG), (const float*)WSP(WS_SSQA)};
            pg8::gemm_phase<epi::EpiGate, pg8::SuperOrder<1>, true>(F.lds, g, So, E, F.tid);
            __syncthreads();
            convert_mlp_weights(F, l);
        }
        SEAM(pb + 4);
        if (RUN(pb + 5)) { LAUNDER();
            pg8::Gemm<D, D, D, 256u * D * 2, 0, 256u * D * 2, 0> g{(const bf16_t*)WSP(WS_MG), (const bf16_t*)WSP(WS_WOUT)};
            pg8::StaticOrder So; So.init(M, D, F.G, bx);
            float* outp = (float*)ptr_at(F, I_OUT); epi::EpiResid E{l == 0 ? INP(I_X) : (const float*)outp, outp, (bf16_t*)WSP(WS_XG), INP(I_LN_MLP) + l * D, (float*)WSP(WS_SSQB)};
            pg8::gemm_phase<epi::EpiResid, pg8::StaticOrder, true>(F.lds, g, So, E, F.tid);
        }
        SEAM(pb + 5);
        if (RUN(pb + 6)) { LAUNDER();
            pg8::Gemm<D, D, D, 256u * D * 2, 0, 256u * D * 2, 0> g{(const bf16_t*)WSP(WS_XG), (const bf16_t*)WSP(WS_WUP)};
            pg8::StaticOrder So; So.init(M, FF, F.G, bx);
            epi::EpiUp E{(bf16_t*)WSP(WS_BIG), (const float*)WSP(WS_SSQB)};
            pg8::gemm_phase<epi::EpiUp, pg8::StaticOrder, true>(F.lds, g, So, E, F.tid);
            if (l + 1 < DEPTH) { __syncthreads(); convert_mix_weights(F, l + 1); }
        }
        SEAM(pb + 6);
        if (RUN(pb + 7)) { LAUNDER();
            pg8::Gemm<FF, FF, FF, 256u * FF * 2, 0, 256u * FF * 2, 0> g{(const bf16_t*)WSP(WS_BIG), (const bf16_t*)WSP(WS_WDN)};
            pg8::StaticOrder So; So.init(M, D, F.G, bx);
            float* outp = (float*)ptr_at(F, I_OUT); epi::EpiResid E{(const float*)outp, outp, (bf16_t*)WSP(WS_XG), (l + 1 < DEPTH) ? INP(I_LN_MIX) + (l + 1) * D : nullptr, (float*)WSP(WS_SSQA)};
            pg8::gemm_phase<epi::EpiResid, pg8::StaticOrder, true>(F.lds, g, So, E, F.tid);
        }
        SEAM(pb + 7);
    }
#undef RUN
#undef SEAM
}

extern "C" void kernel_launch(void* const* d_in, const int* in_sizes, int n_in, void* d_out, int out_size, void* d_ws, size_t ws_size, hipStream_t stream) {
    static int grid = 0;
    if (grid == 0) {
        if (n_in != 18 || in_sizes[0] != M * D || out_size != M * D || ws_size < WS_END) { fprintf(stderr, "kernel_launch: unexpected shapes (n_in %d, in0 %d, out %d, ws %zu)\n", n_in, n_in > 0 ? in_sizes[0] : -1, out_size, ws_size); grid = -1; return; }
        int dev = 0, cus = 0, per_cu = 0;
        if (hipGetDevice(&dev) != hipSuccess || hipDeviceGetAttribute(&cus, hipDeviceAttributeMultiprocessorCount, dev) != hipSuccess) { grid = -1; return; }
        if (hipFuncSetAttribute((const void*)mk_fwd, hipFuncAttributeMaxDynamicSharedMemorySize, LDS_BYTES) != hipSuccess) { fprintf(stderr, "kernel_launch: hipFuncSetAttribute failed\n"); grid = -1; return; }
        if (hipOccupancyMaxActiveBlocksPerMultiprocessor(&per_cu, (const void*)mk_fwd, NT, LDS_BYTES) != hipSuccess || per_cu < 1) { fprintf(stderr, "kernel_launch: occupancy query says %d\n", per_cu); (void)hipGetLastError(); per_cu = 1; }
        grid = cus;
    }
    if (grid < 0) return;
    Args a{};
    for (int i = 0; i < 18; ++i) a.in[i] = (const float*)d_in[i];
    a.out = (float*)d_out; a.ws = (unsigned char*)d_ws;
#if MK_MULTI
    for (int p = 0; p < N_PHASES; ++p) { a.ph_lo = p; a.ph_hi = p + 1; a.coop = 0; hipLaunchKernelGGL(mk_fwd, dim3(grid), dim3(NT), LDS_BYTES, stream, a); }
#else
    a.ph_lo = 0; a.ph_hi = N_PHASES; a.coop = 1;
    void* kargs[] = {&a};
    hipError_t e = hipLaunchCooperativeKernel((const void*)mk_fwd, dim3(grid), dim3(NT), kargs, LDS_BYTES, stream);
    if (e != hipSuccess) fprintf(stderr, "kernel_launch: cooperative launch failed: %s (grid %d)\n", hipGetErrorString(e), grid);
#endif
}
```

```cpp
#define MK_MULTI 0
#include <hip/hip_runtime.h>
#include <hip/hip_cooperative_groups.h>
#include <cstdio>
#include <cstdint>
namespace cg = cooperative_groups;

#define LAS __attribute__((address_space(3)))
typedef unsigned short bf16_t;
typedef short bf16x8 __attribute__((ext_vector_type(8)));
typedef float f32x4 __attribute__((ext_vector_type(4)));
typedef float f32x2 __attribute__((ext_vector_type(2)));
typedef unsigned u32x4 __attribute__((ext_vector_type(4)));
typedef unsigned u32x2 __attribute__((ext_vector_type(2)));

constexpr int D = 1024, NB = 4, S = 4096, M = NB * S, DEPTH = 2, FF = 4096, INW = 7760;
constexpr int O_AU = 0, O_AV = 256, O_BQ = 512, O_BK = 768, O_BV = 1024, O_QI = 1280, O_KI = 1792, O_WI = 1856,
              O_CQ = 1864, O_CK = 2120, O_CV = 2376, O_CO = 2632, O_CI = 2888, O_CF = 2892, O_DB = 2896, O_DC = 3152, O_DX = 3408, O_G = 3664;
constexpr int PW = 3840;
constexpr int P_AU = 0, P_AV = 256, P_Q = 512, P_K = 768, P_V = 1024, P_QI = 1280, P_CQ = 1792, P_CK = 2048, P_CV = 2304, P_CO = 2560,
              P_DB = 2816, P_DC = 3072, P_DX = 3328, P_KI = 3584;
constexpr float EPS = 1e-6f;
constexpr int NWAVES = 8, NT = 512;

constexpr size_t MiB = 1u << 20;
constexpr size_t WS_CTL = 0;
constexpr size_t WS_COS = 1 * MiB, WS_SIN = 1 * MiB + 512 * 1024;
constexpr size_t WS_MISC = 2 * MiB;
constexpr size_t WS_SSQA = 3 * MiB, WS_SSQB = 4 * MiB;
constexpr size_t WS_WIN = 5 * MiB;
constexpr size_t WS_WG = WS_WIN + (size_t)PW * D * 2;
constexpr size_t WS_WBR = WS_WG + (size_t)4096 * D * 2;
constexpr size_t WS_WOUT = WS_WBR + (size_t)4 * 1024 * 256 * 2;
constexpr size_t WS_XG = 25 * MiB;
constexpr size_t WS_BIG = 57 * MiB;
constexpr size_t WS_Y = 185 * MiB;
constexpr size_t WS_WUP = WS_Y, WS_WDN = WS_Y + 8 * MiB;
constexpr size_t WS_MG = 217 * MiB;
constexpr size_t WS_MASK = WS_MG, WS_STATE = WS_MG + 8 * MiB;
constexpr size_t WS_END = 249 * MiB;
constexpr int STATE_STRIDE = 4224;
static_assert(WS_WOUT + (size_t)D * D * 2 <= WS_XG && WS_STATE + (size_t)512 * STATE_STRIDE * 4 <= WS_END && WS_END <= 256 * MiB, "d_ws map");

constexpr int LDS_BYTES = 155648;

__device__ __forceinline__ float bf2f(bf16_t v) { return __uint_as_float((unsigned)v << 16); }
__device__ __forceinline__ unsigned f2bf(float f) { unsigned u = __float_as_uint(f); return (u + 0x7fffu + ((u >> 16) & 1u)) >> 16; }
__device__ __forceinline__ unsigned pk2(float lo, float hi) { return f2bf(lo) | (f2bf(hi) << 16); }
__device__ __forceinline__ unsigned cvt_pk_bf16(float lo, float hi) { unsigned r; asm volatile("v_cvt_pk_bf16_f32 %0, %1, %2" : "=v"(r) : "v"(lo), "v"(hi)); return r; }
__device__ __forceinline__ float lo_bf(unsigned w) { return __uint_as_float(w << 16); }
__device__ __forceinline__ float hi_bf(unsigned w) { return __uint_as_float(w & 0xffff0000u); }
__device__ __forceinline__ float wave_sum(float v) {
#pragma unroll
    for (int o = 1; o < 64; o <<= 1) v += __shfl_xor(v, o);
    return v;
}
__device__ __forceinline__ float wave_max(float v) {
#pragma unroll
    for (int o = 1; o < 64; o <<= 1) v = fmaxf(v, __shfl_xor(v, o));
    return v;
}
__device__ __forceinline__ int wave_sum_i(int v) {
#pragma unroll
    for (int o = 1; o < 64; o <<= 1) v += __shfl_xor(v, o);
    return v;
}
__device__ __forceinline__ float sigmoid_f(float x) { return 1.f / (1.f + __expf(-x)); }
__device__ __forceinline__ float gelu_tanh_f(float x) { const float u = 0.7978845608028654f * (x + 0.044715f * x * x * x); return x / (1.f + __expf(-2.f * u)); }
__device__ __forceinline__ unsigned fkey(float s) { const unsigned u = __float_as_uint(s); return (u & 0x80000000u) ? ~u : (u | 0x80000000u); }

namespace pg8 {
constexpr int BM = 256, BK = 64, HALF = 128, HTB = HALF * BK * 2, STAGE_BYTES = 8 * HTB, NXCD = 8, WGM = 8;
__host__ __device__ __forceinline__ int lds_byte(int r, int c) { const int st = (r >> 4) * 2 + (c >> 5), rr = r & 15, cc = c & 31, ob = rr * 64 + cc * 2; return st * 1024 + (ob ^ (((ob >> 9) & 1) << 5)); }
__host__ __device__ __forceinline__ void stage_rc(int b, int& R, int& C) { const int st = b / 1024, sb = b % 1024, swz = sb ^ (((sb >> 9) & 1) << 5); R = (st >> 1) * 16 + swz / 64; C = (st & 1) * 32 + (swz % 64) / 2; }
__host__ __device__ __forceinline__ int perm32(int rho) { const int n = rho >> 4, i = rho & 15; return 8 * (i >> 2) + 4 * n + (i & 3); }

struct Unit { int pm, pn, z; };
template <int K_, int LDA_, int LDB_, unsigned APM_, unsigned AZ_, unsigned BPN_, unsigned BZ_> struct Gemm {
    const bf16_t* A; const bf16_t* Bt;
    static constexpr int K = K_, lda = LDA_, ldb = LDB_; static constexpr unsigned aPm = APM_, aZ = AZ_, bPn = BPN_, bZ = BZ_;
};
template <class G> __device__ __forceinline__ const char* pa(const G& g, const Unit& u) { return (const char*)g.A + (size_t)((unsigned)u.pm * G::aPm + (unsigned)u.z * G::aZ); }
template <class G> __device__ __forceinline__ const char* pb(const G& g, const Unit& u) { return (const char*)g.Bt + (size_t)((unsigned)u.pn * G::bPn + (unsigned)u.z * G::bZ); }

struct StaticOrder {
    int nM, nN, nwg, G, c;
    __host__ __device__ void init(int M_, int N_, int G_, int c_) { nM = M_ / BM; nN = N_ / BM; nwg = nM * nN; G = G_; c = c_; }
    __host__ __device__ bool next(int i, Unit& u) const {
        const long L = (long)i * G + c; if (L >= nwg) return false;
        int wgid = (int)L; { const int q = nwg / NXCD, r = nwg % NXCD, xcd = wgid % NXCD, off = wgid / NXCD; wgid = (xcd < r ? xcd * (q + 1) : r * (q + 1) + (xcd - r) * q) + off; }
        const int nig = WGM * nN, gid = wgid / nig, fm = gid * WGM, gsz = (nM - fm) < WGM ? (nM - fm) : WGM;
        u.pm = fm + ((wgid % nig) % gsz); u.pn = (wgid % nig) / gsz; u.z = 0; return true;
    }
};
template <int MODE> struct SuperOrder {
    StaticOrder so;
    __host__ __device__ void init(int G_, int c_) { so.init(M, 1024, G_, c_); }
    __host__ __device__ bool next(int i, Unit& u) const {
        Unit b; if (!so.next(i >> 2, b)) return false;
        const int sub = i & 3; u.pm = b.pm; if (MODE == 0) { u.pn = b.pn; u.z = sub; } else { u.pn = 4 * b.pn + sub; u.z = 0; } return true;
    }
};

template <class Epi, class Sched, bool ALIGN_EPI, class GemmT>
__device__ __forceinline__ void gemm_phase(LAS unsigned char* lds, const GemmT g, const Sched& S, const Epi& E, const int tid) {
    const int wid = __builtin_amdgcn_readfirstlane(tid >> 6), lane = tid & 63, wr = wid >> 2, wc = wid & 3, fr = lane & 15, fq = lane >> 4;
    constexpr int K = GemmT::K, nt = K / BK;
    unsigned voffA[2], voffB[2];
#pragma unroll
    for (int i = 0; i < 2; ++i) { int R, C; stage_rc(tid * 16 + i * 8192, R, C); const int Rb = Epi::PERM ? ((R & ~31) + perm32(R & 31)) : R;
        voffA[i] = (unsigned)(R * GemmT::lda + C) * 2u; voffB[i] = (unsigned)(Rb * GemmT::ldb + C) * 2u; }
    const size_t kstep = (size_t)(BK * 2);
    constexpr size_t hA = (size_t)HALF * GemmT::lda * 2, hB = (size_t)HALF * GemmT::ldb * 2;
    const unsigned ldsw = (unsigned)wid * 1024u;
    const int aoff = lds_byte(wr * 64 + fr, fq * 8), boff = lds_byte(wc * 32 + fr, fq * 8);
#define PG8_SA(b, h) (((b) * 2 + (h)) * HTB)
#define PG8_SB(b, h) ((4 + (b) * 2 + (h)) * HTB)
#define PG8_STAGE(bufoff, gbase, voff) do { _Pragma("unroll") for (int _i = 0; _i < 2; ++_i) \
        __builtin_amdgcn_global_load_lds((const unsigned*)((const char*)(gbase) + (voff)[_i]), (LAS unsigned*)(lds + (bufoff) + ldsw + _i * 8192), 16, 0, 0); } while (0)
#define PG8_LDA(dst, b, h) do { _Pragma("unroll") for (int m = 0; m < 4; ++m) _Pragma("unroll") for (int k = 0; k < 2; ++k) dst[m][k] = *(const LAS bf16x8*)(lds + PG8_SA(b, h) + aoff + m * 2048 + k * 1024); } while (0)
#define PG8_LDB(dst, b, h) do { _Pragma("unroll") for (int n = 0; n < 2; ++n) _Pragma("unroll") for (int k = 0; k < 2; ++k) dst[n][k] = *(const LAS bf16x8*)(lds + PG8_SB(b, h) + boff + n * 2048 + k * 1024); } while (0)
#define PG8_MMA(ai, bj, At, Bt) do { __builtin_amdgcn_s_setprio(1); _Pragma("unroll") for (int m = 0; m < 4; ++m) _Pragma("unroll") for (int n = 0; n < 2; ++n) _Pragma("unroll") for (int k = 0; k < 2; ++k) \
        acc[ai][bj][m][n] = __builtin_amdgcn_mfma_f32_16x16x32_bf16(Bt[n][k], At[m][k], acc[ai][bj][m][n], 0, 0, 0); __builtin_amdgcn_s_setprio(0); } while (0)
#define PG8_WAIT_V(n) asm volatile("s_waitcnt vmcnt(" #n ")" ::: "memory")
#define PG8_WAIT_L(n) asm volatile("s_waitcnt lgkmcnt(" #n ")" ::: "memory")
#define PG8_BAR __builtin_amdgcn_s_barrier()
#define PG8_SCHED __builtin_amdgcn_sched_barrier(0)
    Unit cur, nxt; int ui = 0;
    if (!S.next(0, cur)) return;
    f32x4 acc[2][2][4][2];
#pragma unroll
    for (int a = 0; a < 2; ++a)
#pragma unroll
        for (int b = 0; b < 2; ++b)
#pragma unroll
            for (int m = 0; m < 4; ++m)
#pragma unroll
                for (int n = 0; n < 2; ++n) acc[a][b][m][n] = (f32x4){0.f, 0.f, 0.f, 0.f};
    bf16x8 At[4][2], B0[2][2], B1[2][2];
    const char* cA = pa(g, cur); const char* cB = pb(g, cur);
    PG8_STAGE(PG8_SB(0, 0), cB, voffB); PG8_STAGE(PG8_SB(0, 1), cB + hB, voffB); PG8_STAGE(PG8_SA(0, 0), cA, voffA); PG8_STAGE(PG8_SA(0, 1), cA + hA, voffA);
    if (wr == 1) PG8_BAR;
    PG8_WAIT_V(2); PG8_BAR;
    PG8_STAGE(PG8_SB(1, 0), cB + kstep, voffB); PG8_STAGE(PG8_SA(1, 0), cA + kstep, voffA); PG8_STAGE(PG8_SB(1, 1), cB + hB + kstep, voffB);
    PG8_WAIT_V(6); PG8_BAR;
    for (;;) {
        const bool has_next = S.next(ui + 1, nxt);
        const char* nA = has_next ? pa(g, nxt) : cA; const char* nB = has_next ? pb(g, nxt) : cB;
#pragma unroll 1
        for (int t = 0; t < nt; t += 2) {
            const bool last = (t == nt - 2);
            const char* a1 = cA + (size_t)(t + 1) * kstep;
            const char* a2 = last ? nA : cA + (size_t)(t + 2) * kstep; const char* b2 = last ? nB : cB + (size_t)(t + 2) * kstep;
            const char* a3 = a2 + kstep; const char* b3 = b2 + kstep;
            PG8_LDB(B0, 0, 0); PG8_LDB(B1, 0, 1); PG8_SCHED; PG8_LDA(At, 0, 0); PG8_STAGE(PG8_SA(1, 1), a1 + hA, voffA);
            PG8_WAIT_V(8); PG8_WAIT_L(0); PG8_BAR; PG8_MMA(0, 0, At, B0); PG8_MMA(0, 1, At, B1); PG8_BAR; PG8_SCHED;
            PG8_LDA(At, 0, 1); PG8_STAGE(PG8_SB(0, 0), b2, voffB); PG8_STAGE(PG8_SB(0, 1), b2 + hB, voffB); PG8_STAGE(PG8_SA(0, 0), a2, voffA);
            PG8_WAIT_V(8); PG8_WAIT_L(0); PG8_BAR; PG8_MMA(1, 0, At, B0); PG8_MMA(1, 1, At, B1); PG8_BAR; PG8_SCHED;
            PG8_LDB(B0, 1, 0); PG8_LDB(B1, 1, 1); PG8_SCHED; PG8_LDA(At, 1, 0); PG8_STAGE(PG8_SA(0, 1), a2 + hA, voffA);
            PG8_WAIT_V(8); PG8_WAIT_L(0); PG8_BAR; PG8_MMA(0, 0, At, B0); PG8_MMA(0, 1, At, B1); PG8_BAR; PG8_SCHED;
            PG8_LDA(At, 1, 1); PG8_STAGE(PG8_SB(1, 0), b3, voffB); PG8_STAGE(PG8_SB(1, 1), b3 + hB, voffB); PG8_STAGE(PG8_SA(1, 0), a3, voffA);
            PG8_WAIT_V(8); PG8_WAIT_L(0); PG8_BAR; PG8_MMA(1, 0, At, B0); PG8_MMA(1, 1, At, B1); PG8_BAR; PG8_SCHED;
        }
        if constexpr (ALIGN_EPI) { if (wr == 0) PG8_BAR; }
        { int fr2 = fr, fq2 = fq; asm volatile("" : "+v"(fr2), "+v"(fq2)); E(acc, cur, wr, wc, fr2, fq2); }
        if (!has_next) break;
#pragma unroll
        for (int a = 0; a < 2; ++a)
#pragma unroll
            for (int b = 0; b < 2; ++b)
#pragma unroll
                for (int m = 0; m < 4; ++m)
#pragma unroll
                    for (int n = 0; n < 2; ++n) acc[a][b][m][n] = (f32x4){0.f, 0.f, 0.f, 0.f};
        cur = nxt; cA = nA; cB = nB; ++ui;
        if constexpr (ALIGN_EPI) { if (wr == 1) PG8_BAR; }
    }
    PG8_WAIT_V(0);
    if constexpr (!ALIGN_EPI) { if (wr == 0) PG8_BAR; }
    PG8_BAR;
#undef PG8_SA
#undef PG8_SB
#undef PG8_STAGE
#undef PG8_LDA
#undef PG8_LDB
#undef PG8_MMA
#undef PG8_WAIT_V
#undef PG8_WAIT_L
#undef PG8_BAR
#undef PG8_SCHED
}
}
namespace epi {
using pg8::Unit;
typedef f32x4 Acc[2][2][4][2];

__device__ __forceinline__ float row_scale(const float* ssq, int row) {
    const f32x4* sp = (const f32x4*)(ssq + (size_t)row * 16);
    const f32x4 a = sp[0], b = sp[1], c = sp[2], d = sp[3];
    const float t = ((a[0] + a[1]) + (a[2] + a[3])) + ((b[0] + b[1]) + (b[2] + b[3])) + ((c[0] + c[1]) + (c[2] + c[3])) + ((d[0] + d[1]) + (d[2] + d[3]));
    return rsqrtf(t * (1.0f / 1024.0f) + EPS);
}
__device__ __forceinline__ u32x4 pack8(const f32x4 a, const f32x4 b) { u32x4 w; w.x = cvt_pk_bf16(a[0], a[1]); w.y = cvt_pk_bf16(a[2], a[3]); w.z = cvt_pk_bf16(b[0], b[1]); w.w = cvt_pk_bf16(b[2], b[3]); return w; }

struct EpiProj {
    static constexpr bool PERM = true;
    bf16_t* P; float* misc; const float* ssq; const float* cs; const float* sn; const float* gt;     bf16_t* VT;     bf16_t* KI;
    __device__ __forceinline__ void operator()(const Acc& acc, const Unit& u, int wr, int wc, int fr, int fq) const {
        const int T = u.pn; const int row0 = u.pm * 256 + wr * 64 + fr;
        if (T == 2 || T == 3 || T == 5 || T == 6 || T == 14) {
            if (T == 14 && wc >= 2) return;
            if (T == 14 && wc == 1) {
                if (fq < 2) {
#pragma unroll
                    for (int ai = 0; ai < 2; ++ai)
#pragma unroll
                        for (int m = 0; m < 4; ++m) { const int row = row0 + ai * 128 + m * 16; const float rs = row_scale(ssq, row);
                            float* mp = misc + (size_t)row * 16 + 8 * fq; *(f32x4*)mp = acc[ai][0][m][0] * rs; *(f32x4*)(mp + 4) = acc[ai][0][m][1] * rs; }
                }
                return;
            }
            const int mode = (T == 14) ? 2 : (T <= 3 ? 1 : 0);
            const float* gp = gt + 64 * ((T == 2) ? 0 : (T == 3) ? 1 : 2);
            f32x4 g1[2], g2[2];
#pragma unroll
            for (int n = 0; n < 2; ++n) { if (mode) { g1[n] = *(const f32x4*)(gp + 8 * fq + 4 * n); g2[n] = *(const f32x4*)(gp + 32 + 8 * fq + 4 * n); } else { g1[n] = (f32x4){1.f, 1.f, 1.f, 1.f}; g2[n] = g1[n]; } }
#pragma unroll
            for (int ai = 0; ai < 2; ++ai)
#pragma unroll
                for (int m = 0; m < 4; ++m) {
                    const int row = row0 + ai * 128 + m * 16; const float rs = row_scale(ssq, row); const int pos = row & (S - 1);
                    f32x4 x1[2], x2[2];
#pragma unroll
                    for (int n = 0; n < 2; ++n) { x1[n] = acc[ai][0][m][n] * rs; x2[n] = acc[ai][1][m][n] * rs; }
                    if (mode == 2) {
                        float s = 0.f;
#pragma unroll
                        for (int n = 0; n < 2; ++n) s += (x1[n][0] + x1[n][1]) + (x1[n][2] + x1[n][3]) + (x2[n][0] + x2[n][1]) + (x2[n][2] + x2[n][3]);
                        s += __shfl_xor(s, 16); s += __shfl_xor(s, 32); const float mu = s * (1.f / 64.f);
#pragma unroll
                        for (int n = 0; n < 2; ++n) { x1[n] = x1[n] - mu; x2[n] = x2[n] - mu; }
                    }
                    if (mode) {
                        float q = 0.f;
#pragma unroll
                        for (int n = 0; n < 2; ++n) { const f32x4 a = x1[n] * x1[n], b = x2[n] * x2[n]; q += (a[0] + a[1]) + (a[2] + a[3]) + (b[0] + b[1]) + (b[2] + b[3]); }
                        q += __shfl_xor(q, 16); q += __shfl_xor(q, 32); const float rr = rsqrtf(q * (1.f / 64.f) + EPS);
#pragma unroll
                        for (int n = 0; n < 2; ++n) { x1[n] = x1[n] * rr * g1[n]; x2[n] = x2[n] * rr * g2[n]; }
                    }
                    f32x4 o1[2], o2[2];
#pragma unroll
                    for (int n = 0; n < 2; ++n) { const f32x4 c = *(const f32x4*)(cs + (size_t)pos * 32 + 8 * fq + 4 * n), s = *(const f32x4*)(sn + (size_t)pos * 32 + 8 * fq + 4 * n);
                        o1[n] = x1[n] * c - x2[n] * s; o2[n] = x2[n] * c + x1[n] * s; }
                    bf16_t* op = P + (size_t)row * PW + 256 * T + 64 * wc + 8 * fq;
                    *(u32x4*)op = pack8(o1[0], o1[1]); *(u32x4*)(op + 32) = pack8(o2[0], o2[1]);
                    if (T == 14) { bf16_t* kp = KI + (size_t)row * 64 + 8 * fq; *(u32x4*)kp = pack8(o1[0], o1[1]); *(u32x4*)(kp + 32) = pack8(o2[0], o2[1]); }
                }
            return;
        }
        const int act = (T <= 1) ? 1 : 0; const float sc = (T == 8) ? 0.125f : 1.0f;
#pragma unroll
        for (int ai = 0; ai < 2; ++ai)
#pragma unroll
            for (int m = 0; m < 4; ++m) {
                const int row = row0 + ai * 128 + m * 16; const float rs = row_scale(ssq, row) * sc;
                bf16_t* op = P + (size_t)row * PW + 256 * T + 32 * wc + 8 * fq;
#pragma unroll
                for (int bj = 0; bj < 2; ++bj) { f32x4 v0 = acc[ai][bj][m][0] * rs, v1 = acc[ai][bj][m][1] * rs;
                    if (act) {
#pragma unroll
                        for (int e = 0; e < 4; ++e) { v0[e] = gelu_tanh_f(v0[e]); v1[e] = gelu_tanh_f(v1[e]); } }
                    *(u32x4*)(op + bj * 128) = pack8(v0, v1);
                    if (T == 4) { bf16_t* vp = VT + ((size_t)((row >> 12) * 256 + bj * 128 + 32 * wc + 8 * fq)) * S + (row & (S - 1));
#pragma unroll
                        for (int e = 0; e < 4; ++e) { vp[(size_t)e * S] = (bf16_t)f2bf(v0[e]); vp[(size_t)(4 + e) * S] = (bf16_t)f2bf(v1[e]); } } }
            }
    }
};

struct EpiPlain {
    static constexpr bool PERM = true;
    bf16_t* O; int ldc; int zcols;
    __device__ __forceinline__ void operator()(const Acc& acc, const Unit& u, int wr, int wc, int fr, int fq) const {
        const int row0 = u.pm * 256 + wr * 64 + fr; const int col0 = u.z * zcols + u.pn * 256 + 32 * wc + 8 * fq;
#pragma unroll
        for (int ai = 0; ai < 2; ++ai)
#pragma unroll
            for (int m = 0; m < 4; ++m) { bf16_t* op = O + (size_t)(row0 + ai * 128 + m * 16) * ldc + col0;
#pragma unroll
                for (int bj = 0; bj < 2; ++bj) *(u32x4*)(op + bj * 128) = pack8(acc[ai][bj][m][0], acc[ai][bj][m][1]); }
    }
};

struct EpiGate {
    static constexpr bool PERM = true;
    bf16_t* MG; const bf16_t* BR; const float* ssq;
    __device__ __forceinline__ void operator()(const Acc& acc, const Unit& u, int wr, int wc, int fr, int fq) const {
        const int row0 = u.pm * 256 + wr * 64 + fr; const int ch0 = u.pn * 64 + 16 * wc + 4 * fq;
#pragma unroll
        for (int ai = 0; ai < 2; ++ai)
#pragma unroll
            for (int m = 0; m < 4; ++m) {
                const int row = row0 + ai * 128 + m * 16; const float rs = row_scale(ssq, row);
                const bf16_t* bp = BR + (size_t)row * 4096 + ch0; f32x4 o = (f32x4){0.f, 0.f, 0.f, 0.f};
#pragma unroll
                for (int bj = 0; bj < 2; ++bj)
#pragma unroll
                    for (int n = 0; n < 2; ++n) { const u32x2 w = *(const u32x2*)(bp + (2 * bj + n) * 1024); const f32x4 a = acc[ai][bj][m][n] * rs;
                        o[0] += sigmoid_f(a[0]) * lo_bf(w.x); o[1] += sigmoid_f(a[1]) * hi_bf(w.x); o[2] += sigmoid_f(a[2]) * lo_bf(w.y); o[3] += sigmoid_f(a[3]) * hi_bf(w.y); }
                u32x2 ow; ow.x = cvt_pk_bf16(o[0], o[1]); ow.y = cvt_pk_bf16(o[2], o[3]);
                *(u32x2*)(MG + (size_t)row * 1024 + ch0) = ow;
            }
    }
};

struct EpiResid {
    static constexpr bool PERM = true;
    const float* res; float* out; bf16_t* XG; const float* gain; float* ssq;
    __device__ __forceinline__ void operator()(const Acc& acc, const Unit& u, int wr, int wc, int fr, int fq) const {
        const int row0 = u.pm * 256 + wr * 64 + fr; const int col0 = u.pn * 256 + 32 * wc + 8 * fq;
        f32x4 gv[2][2];
#pragma unroll
        for (int bj = 0; bj < 2; ++bj)
#pragma unroll
            for (int n = 0; n < 2; ++n) gv[bj][n] = gain ? *(const f32x4*)(gain + col0 + bj * 128 + 4 * n) : (f32x4){1.f, 1.f, 1.f, 1.f};
#pragma unroll
        for (int ai = 0; ai < 2; ++ai)
#pragma unroll
            for (int m = 0; m < 4; ++m) {
                const int row = row0 + ai * 128 + m * 16; const size_t off = (size_t)row * 1024 + col0; float q = 0.f;
#pragma unroll
                for (int bj = 0; bj < 2; ++bj) {
                    const f32x4 r0 = *(const f32x4*)(res + off + bj * 128), r1 = *(const f32x4*)(res + off + bj * 128 + 4);
                    const f32x4 x0 = r0 + acc[ai][bj][m][0], x1 = r1 + acc[ai][bj][m][1];
                    *(f32x4*)(out + off + bj * 128) = x0; *(f32x4*)(out + off + bj * 128 + 4) = x1;
                    const f32x4 a = x0 * x0, b = x1 * x1; q += ((a[0] + a[1]) + (a[2] + a[3])) + ((b[0] + b[1]) + (b[2] + b[3]));
                    *(u32x4*)(XG + off + bj * 128) = pack8(x0 * gv[bj][0], x1 * gv[bj][1]);
                }
                q += __shfl_xor(q, 16); q += __shfl_xor(q, 32);
                if (fq == 0) ssq[(size_t)row * 16 + 4 * u.pn + wc] = q;
            }
    }
};

struct EpiUp {
    static constexpr bool PERM = true;
    bf16_t* H; const float* ssq;
    __device__ __forceinline__ void operator()(const Acc& acc, const Unit& u, int wr, int wc, int fr, int fq) const {
        const int row0 = u.pm * 256 + wr * 64 + fr; const int col0 = u.pn * 256 + 32 * wc + 8 * fq;
#pragma unroll
        for (int ai = 0; ai < 2; ++ai)
#pragma unroll
            for (int m = 0; m < 4; ++m) { const int row = row0 + ai * 128 + m * 16; const float rs = row_scale(ssq, row); bf16_t* op = H + (size_t)row * FF + col0;
#pragma unroll
                for (int bj = 0; bj < 2; ++bj) { f32x4 v0 = acc[ai][bj][m][0] * rs, v1 = acc[ai][bj][m][1] * rs;
#pragma unroll
                    for (int e = 0; e < 4; ++e) { v0[e] = fmaxf(v0[e], 0.f); v1[e] = fmaxf(v1[e], 0.f); }
                    *(u32x4*)(op + bj * 128) = pack8(v0 * v0, v1 * v1); } }
    }
};
}
struct Args {
    const float* in[18]; float* out; unsigned char* ws; int ph_lo, ph_hi; int coop, pad;
};
struct Frame { LAS unsigned char* lds; int tid, lane, wave, G, vcu; };
constexpr int PTR_OFF = LDS_BYTES - 512;
enum { I_X = 0, I_LN_MIX, I_W_IN, I_SGU_NORM, I_SGU_W, I_SGU_B, I_Q_NORM, I_K_NORM, I_KIDX_NORM, I_I_BIAS, I_F_BIAS, I_MNORM, I_CONV_W, I_W_BRANCH, I_W_OUT, I_LN_MLP, I_W_UP, I_W_DOWN, I_OUT, I_WS };
__device__ __forceinline__ unsigned char* ptr_at(const Frame& F, int i) { const LAS unsigned* p = (const LAS unsigned*)(F.lds + PTR_OFF) + 2 * i;
    const unsigned lo = __builtin_amdgcn_readfirstlane(p[0]), hi = __builtin_amdgcn_readfirstlane(p[1]); return (unsigned char*)(((unsigned long long)hi << 32) | lo); }
#define INP(i) ((const float*)ptr_at(F, (i)))
#define WSP(off) (ptr_at(F, I_WS) + (off))
constexpr size_t WS_GT = 512 * 1024;
__device__ __forceinline__ size_t maskt_idx(int m, int w) { const int b = m >> 12, t = m & (S - 1); return ((size_t)(b * 64 + (w >> 1)) * S + t) * 2 + (w & 1); }

__device__ __forceinline__ int win_src(int p) {
    const int T = p >> 8, q = p & 255, bj = q >> 7, wc = (q >> 5) & 3, j = q & 31, hd = 64 * wc + 32 * bj + j;
    switch (T) {
        case 0: return O_AU + q; case 1: return O_AV + q; case 2: return O_BQ + hd; case 3: return O_BK + hd; case 4: return O_BV + q;
        case 5: return O_QI + hd; case 6: return O_QI + 256 + hd; case 7: return O_CQ + q; case 8: return O_CK + q; case 9: return O_CV + q;
        case 10: return O_CO + q; case 11: return O_DB + q; case 12: return O_DC + q; case 13: return O_DX + q;
        default: break;
    }
    if (wc == 0) return O_KI + 32 * bj + j;
    if (wc == 1 && bj == 0 && j < 16) return j < 8 ? O_WI + j : (j < 12 ? O_CI + (j - 8) : O_CF + (j - 12));
    return -1;
}
__device__ __forceinline__ int wg_src(int p) {
    const int pn = p >> 8, q = p & 255, bj = q >> 7, wc = (q >> 5) & 3, fq = (q >> 3) & 3, n = (q >> 2) & 1, e = q & 3;
    return O_G + (2 * bj + n) * 1024 + 64 * pn + 16 * wc + 4 * fq + e;
}
template <int MAP>
__device__ __forceinline__ void conv_item(const float* W, int K, int srcN, bf16_t* WT, LAS float* scr, int item, int nrows, int lane) {
    const int nblk = nrows / 32, kb = item / nblk, nb = item % nblk, k0 = 64 * kb, n0 = 32 * nb;
    const int nn = n0 + (lane & 31); const int src = MAP == 0 ? nn : (MAP == 1 ? win_src(nn) : wg_src(nn));
#pragma unroll 8
    for (int i = 0; i < 32; ++i) { const int kk = 2 * i + (lane >> 5); scr[kk * 33 + (lane & 31)] = src >= 0 ? W[(size_t)(k0 + kk) * srcN + src] : 0.f; }
    asm volatile("s_waitcnt lgkmcnt(0)" ::: "memory");
    const int c = lane & 7;
#pragma unroll
    for (int j = 0; j < 4; ++j) { const int n = (lane >> 3) + 8 * j; const LAS float* s = scr + (8 * c) * 33 + n;
        u32x4 o; o.x = pk2(s[0 * 33], s[1 * 33]); o.y = pk2(s[2 * 33], s[3 * 33]); o.z = pk2(s[4 * 33], s[5 * 33]); o.w = pk2(s[6 * 33], s[7 * 33]);
        *(u32x4*)(WT + (size_t)(n0 + n) * K + k0 + 8 * c) = o; }
    asm volatile("s_waitcnt lgkmcnt(0)" ::: "memory");
}
__device__ __forceinline__ void convert_mix_weights(Frame& F, int l) {

    LAS float* scr = (LAS float*)(F.lds + F.wave * 16384);
    const int gw = F.vcu * NWAVES + F.wave, NGW = F.G * NWAVES;
    constexpr int I_WIN = (D / 64) * (PW / 32), I_WG = (D / 64) * (4096 / 32), I_BR = (256 / 64) * (1024 / 32), I_OUT = (D / 64) * (D / 32);
    constexpr int NIT = I_WIN + I_WG + 4 * I_BR + I_OUT;
    const float* win = INP(I_W_IN) + (size_t)l * D * INW;
    for (int it = gw; it < NIT; it += NGW) {
        int r = it;
        if (r < I_WIN) { conv_item<1>(win, D, INW, ((bf16_t*)WSP(WS_WIN)), scr, r, PW, F.lane); continue; } r -= I_WIN;
        if (r < I_WG) { conv_item<2>(win, D, INW, ((bf16_t*)WSP(WS_WG)), scr, r, 4096, F.lane); continue; } r -= I_WG;
        if (r < 4 * I_BR) { const int nb = r / I_BR; conv_item<0>(INP(I_W_BRANCH) + ((size_t)l * 4 + nb) * 256 * D, 256, D, ((bf16_t*)WSP(WS_WBR)) + (size_t)nb * 1024 * 256, scr, r % I_BR, 1024, F.lane); continue; } r -= 4 * I_BR;
        conv_item<0>(INP(I_W_OUT) + (size_t)l * D * D, D, D, ((bf16_t*)WSP(WS_WOUT)), scr, r, D, F.lane);
    }
}
__device__ __forceinline__ void convert_mlp_weights(Frame& F, int l) {

    LAS float* scr = (LAS float*)(F.lds + F.wave * 16384);
    const int gw = F.vcu * NWAVES + F.wave, NGW = F.G * NWAVES;
    constexpr int I_UP = (D / 64) * (FF / 32), I_DN = (FF / 64) * (D / 32);
    for (int it = gw; it < I_UP + I_DN; it += NGW) {
        if (it < I_UP) conv_item<0>(INP(I_W_UP) + (size_t)l * D * FF, D, FF, ((bf16_t*)WSP(WS_WUP)), scr, it, FF, F.lane);
        else conv_item<0>(INP(I_W_DOWN) + (size_t)l * FF * D, FF, D, ((bf16_t*)WSP(WS_WDN)), scr, it - I_UP, D, F.lane);
    }
}
__device__ __forceinline__ void prologue_rows(Frame& F) {
    float* COS = (float*)WSP(WS_COS); float* SIN = (float*)WSP(WS_SIN); float* SSQA = (float*)WSP(WS_SSQA); bf16_t* XG = (bf16_t*)WSP(WS_XG); const float* x = INP(I_X); const float* ln_mix = INP(I_LN_MIX);
    const int gt = F.vcu * NT + F.tid, NGT = F.G * NT;
    for (int i = gt; i < S * 32; i += NGT) { const int pos = i >> 5, k = i & 31; const float inv = powf(10000.f, -(float)k * 2.0f / 64.f); const float ang = (float)pos * inv; COS[i] = cosf(ang); SIN[i] = sinf(ang); }
    const int gw = F.vcu * NWAVES + F.wave, NGW = F.G * NWAVES;
    for (int m = gw; m < M; m += NGW) {
        const f32x4* xr = (const f32x4*)(x + (size_t)m * D) + F.lane; const f32x4* gr = (const f32x4*)ln_mix + F.lane;
        unsigned long long* o8 = (unsigned long long*)(XG + (size_t)m * D) + F.lane;
#pragma unroll
        for (int j = 0; j < 4; ++j) { const f32x4 v = xr[64 * j], g = gr[64 * j]; float s = (v[0] * v[0] + v[1] * v[1]) + (v[2] * v[2] + v[3] * v[3]);
            s += __shfl_xor(s, 1); s += __shfl_xor(s, 2); s += __shfl_xor(s, 4); s += __shfl_xor(s, 8);
            if ((F.lane & 15) == 0) SSQA[(size_t)m * 16 + 4 * j + (F.lane >> 4)] = s;
            o8[64 * j] = (unsigned long long)pk2(v[0] * g[0], v[1] * g[1]) | ((unsigned long long)pk2(v[2] * g[2], v[3] * g[3]) << 32); }
    }
}

__device__ __forceinline__ void sgu_simple(Frame& F, int l) {
    bf16_t* PROJ = (bf16_t*)WSP(WS_BIG); bf16_t* Y = (bf16_t*)WSP(WS_Y); const float* sgu_norm = INP(I_SGU_NORM); const float* sgu_w = INP(I_SGU_W); const float* sgu_b = INP(I_SGU_B);
    LAS float* r_s = (LAS float*)F.lds; LAS float* vn = r_s + 128;
    const float* gain = sgu_norm + l * 256; const float* sw = sgu_w + (size_t)l * 4 * 128 * 128; const float* sb = sgu_b + l * 4 * 128;
    for (int item = F.vcu; item < 512; item += F.G) {
        const int g = item & 3, m0 = (item >> 2) * 128;
        for (int i = 0; i < 16; ++i) { const int tok = F.wave * 16 + i; const u32x2 w = *(const u32x2*)(PROJ + (size_t)(m0 + tok) * PW + P_AV + 4 * F.lane);
            const float a = lo_bf(w.x), b = hi_bf(w.x), c = lo_bf(w.y), d = hi_bf(w.y); const float ss = wave_sum((a * a + b * b) + (c * c + d * d));
            if (F.lane == 0) r_s[tok] = rsqrtf(ss * (1.f / 256.f) + EPS); }
        __syncthreads();
        for (int idx = F.tid; idx < 8192; idx += NT) { const int s = idx >> 6, d = idx & 63; vn[idx] = bf2f(PROJ[(size_t)(m0 + s) * PW + P_AV + g * 64 + d]) * r_s[s] * gain[g * 64 + d]; }
        __syncthreads();
        const int d = F.tid & 63, tq = F.tid >> 6;
        for (int tl = tq; tl < 128; tl += 8) { const float* w = sw + ((size_t)g * 128 + tl) * 128; float acc = 0.f;
            for (int s = 0; s <= tl; ++s) acc = fmaf(w[s], vn[s * 64 + d], acc);
            acc += sb[g * 128 + tl];
            Y[(size_t)(m0 + tl) * D + g * 64 + d] = (bf16_t)f2bf(bf2f(PROJ[(size_t)(m0 + tl) * PW + P_AU + g * 64 + d]) * acc); }
        __syncthreads();
    }
}
__device__ __forceinline__ void conv_simple(Frame& F, int l) {
    bf16_t* PROJ = (bf16_t*)WSP(WS_BIG); bf16_t* Y = (bf16_t*)WSP(WS_Y); const float* conv_w = INP(I_CONV_W);
    const float* cw = conv_w + l * 3 * 256;
    for (int i = F.vcu * NT + F.tid; i < M * 256; i += F.G * NT) { const int m = i >> 8, c = i & 255, t = m & (S - 1); float acc = 0.f;
#pragma unroll
        for (int j = 0; j < 3; ++j) { const int tt = t - 2 + j; if (tt >= 0) { const size_t r = (size_t)(m - 2 + j) * PW; acc = fmaf(cw[j * 256 + c], bf2f(PROJ[r + P_DC + c]) * bf2f(PROJ[r + P_DX + c]), acc); } }
        Y[(size_t)m * D + 768 + c] = (bf16_t)f2bf(bf2f(PROJ[(size_t)m * PW + P_DB + c]) * acc); }
}
__device__ __forceinline__ void indexer_simple(Frame& F) {
    float* MISC = (float*)WSP(WS_MISC); unsigned* MASK = (unsigned*)WSP(WS_MASK); bf16_t* PROJ = (bf16_t*)WSP(WS_BIG);
    LAS float* sc = (LAS float*)F.lds; LAS int* red = (LAS int*)(sc + 4096); LAS unsigned* msk = (LAS unsigned*)(red + 16);
    for (int m = F.vcu; m < M; m += F.G) {
        const int t = m & (S - 1), b0 = m - t, n = t + 1;
        if (n <= 256) { if (F.tid < 128) { const int lo = 32 * F.tid; MASK[maskt_idx(m, F.tid)] = (lo + 32 <= n) ? 0xffffffffu : (lo >= n ? 0u : ((1u << (n - lo)) - 1u)); } continue; }
        float qreg[8], wh[8];
#pragma unroll
        for (int h = 0; h < 8; ++h) { qreg[h] = bf2f(PROJ[(size_t)m * PW + P_QI + h * 64 + F.lane]); wh[h] = MISC[(size_t)m * 16 + h] * 0.35355339059327373f; }
        for (int s0 = 0; s0 < n; s0 += NT) {
            const int s = s0 + F.tid, sc_ = s < n ? s : n - 1; const u32x4* kr = (const u32x4*)(PROJ + (size_t)(b0 + sc_) * PW + P_KI);
            float kf[64];
#pragma unroll
            for (int i = 0; i < 8; ++i) { const u32x4 w = kr[i]; kf[8 * i] = lo_bf(w.x); kf[8 * i + 1] = hi_bf(w.x); kf[8 * i + 2] = lo_bf(w.y); kf[8 * i + 3] = hi_bf(w.y); kf[8 * i + 4] = lo_bf(w.z); kf[8 * i + 5] = hi_bf(w.z); kf[8 * i + 6] = lo_bf(w.w); kf[8 * i + 7] = hi_bf(w.w); }
            float acc = 0.f;
#pragma unroll
            for (int h = 0; h < 8; ++h) { float d0 = 0.f, d1 = 0.f;
#pragma unroll
                for (int e = 0; e < 64; e += 2) { d0 = fmaf(__builtin_bit_cast(float, __builtin_amdgcn_readlane(__builtin_bit_cast(int, qreg[h]), e)), kf[e], d0);
                                                   d1 = fmaf(__builtin_bit_cast(float, __builtin_amdgcn_readlane(__builtin_bit_cast(int, qreg[h]), e + 1)), kf[e + 1], d1); }
                acc += wh[h] * fmaxf((d0 + d1) * 0.125f, 0.f); }
            if (s < n) sc[s] = acc;
        }
        __syncthreads();
        unsigned Tk = 0u;
        for (int bit = 31; bit >= 0; --bit) {
            const unsigned cand = Tk | (1u << bit); int c = 0;
            for (int s = F.tid; s < n; s += NT) c += (fkey(sc[s]) >= cand) ? 1 : 0;
            c = wave_sum_i(c); if (F.lane == 0) red[F.wave] = c; __syncthreads();
            int tot = 0;
#pragma unroll
            for (int w = 0; w < 8; ++w) tot += red[w];
            __syncthreads();
            if (tot >= 256) Tk = cand;
        }
        int cg_ = 0, ce = 0;
        for (int s = F.tid; s < n; s += NT) { const unsigned k = fkey(sc[s]); cg_ += k > Tk ? 1 : 0; ce += k == Tk ? 1 : 0; }
        cg_ = wave_sum_i(cg_); ce = wave_sum_i(ce); if (F.lane == 0) { red[F.wave] = cg_; red[8 + F.wave] = ce; }
        if (F.tid < 128) msk[F.tid] = 0u;
        __syncthreads();
        int ngt = 0, neq = 0;
#pragma unroll
        for (int w = 0; w < 8; ++w) { ngt += red[w]; neq += red[8 + w]; }
        const bool all_eq = (ngt + neq == 256);
        for (int s = F.tid; s < n; s += NT) { const unsigned k = fkey(sc[s]); if (k > Tk || (all_eq && k == Tk)) atomicOr((unsigned*)&msk[s >> 5], 1u << (s & 31)); }
        __syncthreads();
        if (!all_eq && F.tid == 0) { int need = 256 - ngt; for (int s = 0; s < n && need > 0; ++s) if (fkey(sc[s]) == Tk) { msk[s >> 5] |= 1u << (s & 31); --need; } }
        __syncthreads();
        if (F.tid < 128) MASK[maskt_idx(m, F.tid)] = msk[F.tid];
        __syncthreads();
    }
}
__device__ __forceinline__ void attn_simple(Frame& F) {
    unsigned* MASK = (unsigned*)WSP(WS_MASK); bf16_t* PROJ = (bf16_t*)WSP(WS_BIG); bf16_t* Y = (bf16_t*)WSP(WS_Y);
    LAS unsigned* msk = (LAS unsigned*)F.lds; LAS int* sel = (LAS int*)(msk + 128); LAS float* lg = (LAS float*)(sel + 256); LAS int* nsel = (LAS int*)(lg + 4 * 256);
    for (int m = F.vcu; m < M; m += F.G) {
        const int t = m & (S - 1), b0 = m - t;
        if (F.tid < 128) msk[F.tid] = MASK[maskt_idx(m, F.tid)];
        __syncthreads();
        if (F.tid == 0) { int c = 0; for (int w = 0; w < 128; ++w) { unsigned bits = msk[w]; while (bits) { const int i = __builtin_ctz(bits); if (c < 256) sel[c] = 32 * w + i; ++c; bits &= bits - 1; } } nsel[0] = c < 256 ? c : 256; }
        __syncthreads();
        const int ns = nsel[0], h = F.wave & 3, part = F.wave >> 2;
        const float q = bf2f(PROJ[(size_t)m * PW + P_Q + h * 64 + F.lane]);
        for (int j = part; j < ns; j += 2) { const float d = wave_sum(q * bf2f(PROJ[(size_t)(b0 + sel[j]) * PW + P_K + h * 64 + F.lane])); if (F.lane == 0) lg[h * 256 + j] = d * 0.125f; }
        __syncthreads();
        if (F.wave < 4) {
            float mx = -INFINITY; for (int j = F.lane; j < ns; j += 64) mx = fmaxf(mx, lg[h * 256 + j]); mx = wave_max(mx);
            float sm = 0.f; for (int j = F.lane; j < ns; j += 64) sm += __expf(lg[h * 256 + j] - mx); sm = wave_sum(sm);
            float o = 0.f; for (int j = 0; j < ns; ++j) o = fmaf(__expf(lg[h * 256 + j] - mx), bf2f(PROJ[(size_t)(b0 + sel[j]) * PW + P_V + h * 64 + F.lane]), o);
            Y[(size_t)m * D + 256 + h * 64 + F.lane] = (bf16_t)f2bf(o / sm);
        }
        __syncthreads();
    }
}
__device__ __forceinline__ void mlstm1_simple(Frame& F, int l) {
    float* MISC = (float*)WSP(WS_MISC); float* STATE = (float*)WSP(WS_STATE); bf16_t* PROJ = (bf16_t*)WSP(WS_BIG); const float* i_bias = INP(I_I_BIAS); const float* f_bias = INP(I_F_BIAS);
    LAS float* bs = (LAS float*)F.lds; LAS float* ig = bs + 128; LAS float* wk = ig + 128; LAS float* kt = wk + 128; LAS float* vt = kt + 128 * 64;
    for (int item = F.vcu; item < 512; item += F.G) {
        const int bh = item >> 5, c = item & 31, b = bh >> 2, h = bh & 3, m0 = b * S + c * 128;
        if (F.tid < 128) { const float f = MISC[(size_t)(m0 + F.tid) * 16 + 12 + h] + f_bias[l * 4 + h]; bs[F.tid] = fminf(f, 0.f) - log1pf(__expf(-fabsf(f))); ig[F.tid] = MISC[(size_t)(m0 + F.tid) * 16 + 8 + h] + i_bias[l * 4 + h]; }
        for (int idx = F.tid; idx < 8192; idx += NT) { const int s = idx >> 6, d = idx & 63; kt[idx] = bf2f(PROJ[(size_t)(m0 + s) * PW + P_CK + h * 64 + d]); vt[idx] = bf2f(PROJ[(size_t)(m0 + s) * PW + P_CV + h * 64 + d]); }
        __syncthreads();
        if (F.tid == 0) { float a = 0.f; for (int s = 0; s < 128; ++s) { a += bs[s]; bs[s] = a; } }
        __syncthreads();
        const float B = bs[127];
        if (F.tid < 128) wk[F.tid] = __expf(B - bs[F.tid] + ig[F.tid]);
        __syncthreads();
        const int e = F.tid & 63, dq = F.tid >> 6; float acc[8];
#pragma unroll
        for (int i = 0; i < 8; ++i) acc[i] = 0.f;
        for (int s = 0; s < 128; ++s) { const float kv = wk[s] * vt[s * 64 + e];
#pragma unroll
            for (int i = 0; i < 8; ++i) acc[i] = fmaf(kt[s * 64 + dq * 8 + i], kv, acc[i]); }
        float* st = STATE + (size_t)item * STATE_STRIDE;
#pragma unroll
        for (int i = 0; i < 8; ++i) st[(dq * 8 + i) * 64 + e] = acc[i];
        if (F.tid < 64) { float a = 0.f; for (int s = 0; s < 128; ++s) a = fmaf(wk[s], kt[s * 64 + F.tid], a); st[4096 + F.tid] = a; }
        if (F.tid == 0) st[4160] = B;
        __syncthreads();
    }
}
__device__ __forceinline__ void mlstm2_simple(Frame& F, int l) {
    float* MISC = (float*)WSP(WS_MISC); float* STATE = (float*)WSP(WS_STATE); bf16_t* PROJ = (bf16_t*)WSP(WS_BIG); bf16_t* Y = (bf16_t*)WSP(WS_Y); const float* i_bias = INP(I_I_BIAS); const float* f_bias = INP(I_F_BIAS); const float* mnorm = INP(I_MNORM);
    LAS float* Cs = (LAS float*)F.lds; LAS float* ns = Cs + 4096; LAS float* bs = ns + 64; LAS float* ig = bs + 128; LAS float* A = ig + 128;
    LAS float* qt = A + 128 * 128; LAS float* kt = qt + 128 * 65;
    for (int item = F.vcu; item < 512; item += F.G) {
        const int bh = item >> 5, c = item & 31, b = bh >> 2, h = bh & 3, m0 = b * S + c * 128;
        { float Cv[8]; float nv = 0.f;
#pragma unroll
          for (int k = 0; k < 8; ++k) Cv[k] = 0.f;
          for (int cc = 0; cc < c; ++cc) { const float* st = STATE + (size_t)(bh * 32 + cc) * STATE_STRIDE; const float dec = __expf(st[4160]);
#pragma unroll
              for (int k = 0; k < 8; ++k) Cv[k] = fmaf(dec, Cv[k], st[F.tid + NT * k]);
              if (F.tid < 64) nv = fmaf(dec, nv, st[4096 + F.tid]); }
#pragma unroll
          for (int k = 0; k < 8; ++k) Cs[F.tid + NT * k] = Cv[k];
          if (F.tid < 64) ns[F.tid] = nv; }
        if (F.tid < 128) { const float f = MISC[(size_t)(m0 + F.tid) * 16 + 12 + h] + f_bias[l * 4 + h]; bs[F.tid] = fminf(f, 0.f) - log1pf(__expf(-fabsf(f))); ig[F.tid] = MISC[(size_t)(m0 + F.tid) * 16 + 8 + h] + i_bias[l * 4 + h]; }
        for (int idx = F.tid; idx < 8192; idx += NT) { const int s = idx >> 6, d = idx & 63; qt[s * 65 + d] = bf2f(PROJ[(size_t)(m0 + s) * PW + P_CQ + h * 64 + d]); kt[s * 65 + d] = bf2f(PROJ[(size_t)(m0 + s) * PW + P_CK + h * 64 + d]); }
        __syncthreads();
        if (F.tid == 0) { float a = 0.f; for (int s = 0; s < 128; ++s) { a += bs[s]; bs[s] = a; } }
        __syncthreads();
        { const int s = F.tid & 127, jq = F.tid >> 7;
          for (int j = jq; j < 128; j += 4) { float v = 0.f;
              if (s <= j) { float d = 0.f;
#pragma unroll 16
                  for (int k = 0; k < 64; ++k) d = fmaf(qt[j * 65 + k], kt[s * 65 + k], d);
                  v = __expf(bs[j] - bs[s] + ig[s]) * d; }
              A[j * 128 + s] = v; } }
        __syncthreads();
        LAS float* vt = kt;
        for (int idx = F.tid; idx < 8192; idx += NT) { const int s = idx >> 6, d = idx & 63; vt[idx] = bf2f(PROJ[(size_t)(m0 + s) * PW + P_CV + h * 64 + d]); }
        __syncthreads();
        const int e = F.lane; const float gn = mnorm[l * 256 + h * 64 + e];
        for (int j = F.wave; j < 128; j += 8) {
            float num = 0.f, qn = 0.f, sa = 0.f;
            for (int d = 0; d < 64; ++d) { const float qd = qt[j * 65 + d]; num = fmaf(qd, Cs[d * 64 + e], num); qn = fmaf(qd, ns[d], qn); }
            const float eb = __expf(bs[j]); num *= eb; qn *= eb;
            for (int s = 0; s <= j; ++s) { const float a = A[j * 128 + s]; num = fmaf(a, vt[s * 64 + e], num); sa += a; }
            const float hv = num / fmaxf(fabsf(qn + sa), 1.f);
            const float r = rsqrtf(wave_sum(hv * hv) * (1.f / 64.f) + EPS);
            const size_t row = (size_t)(m0 + j);
            Y[row * D + 512 + h * 64 + e] = (bf16_t)f2bf(sigmoid_f(bf2f(PROJ[row * PW + P_CO + h * 64 + e])) * hv * r * gn);
        }
        __syncthreads();
    }
}
typedef float f32x16 __attribute__((ext_vector_type(16)));
constexpr size_t WS_VT = WS_BIG + 120 * MiB;
constexpr float LOG2E = 1.4426950408889634f;

__device__ __forceinline__ void attn_mfma(Frame& F, int l) {
    const unsigned long long* MASKT = (const unsigned long long*)WSP(WS_MASK); const bf16_t* PROJ = (const bf16_t*)WSP(WS_BIG); const bf16_t* VT = (const bf16_t*)WSP(WS_VT);
    bf16_t* Y = (bf16_t*)WSP(WS_Y); const float* gt = (const float*)WSP(WS_GT) + l * 192;
    const int lane = F.lane, r32 = lane & 31, hi = lane >> 5, grp = F.wave >> 2, w4 = F.wave & 3, lg = F.tid & 255;
    const float mq = wave_max(fabsf(gt[lane])), mk = wave_max(fabsf(gt[64 + lane]));
    const float c1 = 0.125f * LOG2E, c2 = 8.f * mq * mk * 1.01f * LOG2E;
    constexpr int ROWB = 144, TILEB = 64 * ROWB;
    LAS unsigned char* gb = F.lds + grp * 4 * TILEB;
    LAS float* comb = (LAS float*)(F.lds + 8 * TILEB);
    const int srow0 = lg >> 3, sc0 = lg & 7;
    for (int item = F.vcu; item < 256; item += F.G) {
        const int bh = item >> 4, sidx = item & 15, b = bh >> 2, h = bh & 3;
#pragma unroll 1
        for (int half = 0; half < 2; ++half) {
            const int qb = half == 0 ? sidx : 31 - sidx, q0 = qb * 128, ntl = qb + 1;
            const int qrow = b * S + q0 + w4 * 32 + r32, tq = q0 + w4 * 32 + r32;
            bf16x8 qf[4];
#pragma unroll
            for (int s = 0; s < 4; ++s) qf[s] = *(const bf16x8*)(PROJ + (size_t)qrow * PW + P_Q + h * 64 + 16 * s + 8 * hi);
            f32x16 o0, o1;
#pragma unroll
            for (int r = 0; r < 16; ++r) { o0[r] = 0.f; o1[r] = 0.f; }
            float lsum = 0.f;
            const bf16_t* kbase = PROJ + (size_t)(b * S + srow0) * PW + P_K + h * 64 + sc0 * 8;
            const bf16_t* vbase = VT + (size_t)(b * 256 + h * 64 + srow0) * S + sc0 * 8;
            const unsigned long long* mbase = MASKT + (size_t)(b * 64) * S + tq;
            u32x4 kr0, kr1, vr0, vr1; unsigned long long mw, mwn = 0ull;
            { const int t = grp; kr0 = *(const u32x4*)(kbase + (size_t)t * 64 * PW); kr1 = *(const u32x4*)(kbase + (size_t)(t * 64 + 32) * PW);
              vr0 = *(const u32x4*)(vbase + t * 64); vr1 = *(const u32x4*)(vbase + 32 * S + t * 64); mw = mbase[(size_t)t * S];
              LAS unsigned char* kb = gb; LAS unsigned char* vb = gb + TILEB;
              *(LAS u32x4*)(kb + srow0 * ROWB + sc0 * 16) = kr0; *(LAS u32x4*)(kb + (srow0 + 32) * ROWB + sc0 * 16) = kr1;
              *(LAS u32x4*)(vb + srow0 * ROWB + sc0 * 16) = vr0; *(LAS u32x4*)(vb + (srow0 + 32) * ROWB + sc0 * 16) = vr1; }
            __syncthreads();
#pragma unroll 1
            for (int i = 0; i < ntl; ++i) {
                const int cur = i & 1; const bool more = (i + 1 < ntl);
                if (more) { const int t = 2 * (i + 1) + grp; kr0 = *(const u32x4*)(kbase + (size_t)t * 64 * PW); kr1 = *(const u32x4*)(kbase + (size_t)(t * 64 + 32) * PW);
                    vr0 = *(const u32x4*)(vbase + t * 64); vr1 = *(const u32x4*)(vbase + 32 * S + t * 64); mwn = mbase[(size_t)t * S]; }
                const LAS unsigned char* kb = gb + cur * 2 * TILEB; const LAS unsigned char* vb = kb + TILEB;
                f32x16 p0, p1;
#pragma unroll
                for (int r = 0; r < 16; ++r) { p0[r] = 0.f; p1[r] = 0.f; }
#pragma unroll
                for (int s = 0; s < 4; ++s) {
                    const bf16x8 k0 = *(const LAS bf16x8*)(kb + r32 * ROWB + 32 * s + 16 * hi), k1 = *(const LAS bf16x8*)(kb + (32 + r32) * ROWB + 32 * s + 16 * hi);
                    p0 = __builtin_amdgcn_mfma_f32_32x32x16_bf16(k0, qf[s], p0, 0, 0, 0); p1 = __builtin_amdgcn_mfma_f32_32x32x16_bf16(k1, qf[s], p1, 0, 0, 0);
                }
                const unsigned sh0 = (unsigned)mw >> (4 * hi), sh1 = (unsigned)(mw >> 32) >> (4 * hi);
#pragma unroll
                for (int r = 0; r < 16; ++r) { const int cb = (r & 3) + 8 * (r >> 2);
                    const float e0 = __builtin_amdgcn_exp2f(p0[r] * c1 - c2), e1 = __builtin_amdgcn_exp2f(p1[r] * c1 - c2);
                    p0[r] = ((sh0 >> cb) & 1u) ? e0 : 0.f; p1[r] = ((sh1 >> cb) & 1u) ? e1 : 0.f; lsum += p0[r] + p1[r]; }
#pragma unroll
                for (int ks = 0; ks < 4; ++ks) {
                    u32x4 pw;
                    if (ks < 2) { pw.x = cvt_pk_bf16(p0[8 * ks + 0], p0[8 * ks + 1]); pw.y = cvt_pk_bf16(p0[8 * ks + 2], p0[8 * ks + 3]); pw.z = cvt_pk_bf16(p0[8 * ks + 4], p0[8 * ks + 5]); pw.w = cvt_pk_bf16(p0[8 * ks + 6], p0[8 * ks + 7]); }
                    else { const int k2 = ks - 2; pw.x = cvt_pk_bf16(p1[8 * k2 + 0], p1[8 * k2 + 1]); pw.y = cvt_pk_bf16(p1[8 * k2 + 2], p1[8 * k2 + 3]); pw.z = cvt_pk_bf16(p1[8 * k2 + 4], p1[8 * k2 + 5]); pw.w = cvt_pk_bf16(p1[8 * k2 + 6], p1[8 * k2 + 7]); }
                    const bf16x8 pf = __builtin_bit_cast(bf16x8, pw);
                    const int vo = 64 * (ks >> 1) + 32 * (ks & 1) + 8 * hi;
                    const u32x2 a0 = *(const LAS u32x2*)(vb + r32 * ROWB + vo), a1 = *(const LAS u32x2*)(vb + r32 * ROWB + vo + 16);
                    const u32x2 b0 = *(const LAS u32x2*)(vb + (32 + r32) * ROWB + vo), b1 = *(const LAS u32x2*)(vb + (32 + r32) * ROWB + vo + 16);
                    const u32x4 va = {a0.x, a0.y, a1.x, a1.y}, vb4 = {b0.x, b0.y, b1.x, b1.y};
                    o0 = __builtin_amdgcn_mfma_f32_32x32x16_bf16(__builtin_bit_cast(bf16x8, va), pf, o0, 0, 0, 0);
                    o1 = __builtin_amdgcn_mfma_f32_32x32x16_bf16(__builtin_bit_cast(bf16x8, vb4), pf, o1, 0, 0, 0);
                }
                if (more) { LAS unsigned char* kn = gb + (cur ^ 1) * 2 * TILEB; LAS unsigned char* vn = kn + TILEB;
                    *(LAS u32x4*)(kn + srow0 * ROWB + sc0 * 16) = kr0; *(LAS u32x4*)(kn + (srow0 + 32) * ROWB + sc0 * 16) = kr1;
                    *(LAS u32x4*)(vn + srow0 * ROWB + sc0 * 16) = vr0; *(LAS u32x4*)(vn + (srow0 + 32) * ROWB + sc0 * 16) = vr1; mw = mwn; }
                __syncthreads();
            }
            if (grp == 1) { LAS float* cw = comb + w4 * 33 * 64 + lane;
#pragma unroll
                for (int r = 0; r < 16; ++r) { cw[r * 64] = o0[r]; cw[(16 + r) * 64] = o1[r]; }
                cw[32 * 64] = lsum; }
            __syncthreads();
            if (grp == 0) { const LAS float* cw = comb + w4 * 33 * 64 + lane;
#pragma unroll
                for (int r = 0; r < 16; ++r) { o0[r] += cw[r * 64]; o1[r] += cw[(16 + r) * 64]; }
                lsum += cw[32 * 64]; lsum += __shfl_xor(lsum, 32); const float inv = 1.f / lsum;
                bf16_t* yp = Y + (size_t)qrow * D + 256 + h * 64 + 4 * hi;
#pragma unroll
                for (int g4 = 0; g4 < 4; ++g4) { u32x2 w0, w1;
                    w0.x = cvt_pk_bf16(o0[4 * g4] * inv, o0[4 * g4 + 1] * inv); w0.y = cvt_pk_bf16(o0[4 * g4 + 2] * inv, o0[4 * g4 + 3] * inv);
                    w1.x = cvt_pk_bf16(o1[4 * g4] * inv, o1[4 * g4 + 1] * inv); w1.y = cvt_pk_bf16(o1[4 * g4 + 2] * inv, o1[4 * g4 + 3] * inv);
                    *(u32x2*)(yp + 8 * g4) = w0; *(u32x2*)(yp + 32 + 8 * g4) = w1; } }
            __syncthreads();
        }
    }
}

constexpr size_t WS_KI = 234 * MiB;
__device__ __forceinline__ void indexer_mfma(Frame& F) {
    const float* MISC = (const float*)WSP(WS_MISC); unsigned long long* MASKT = (unsigned long long*)WSP(WS_MASK); const bf16_t* PROJ = (const bf16_t*)WSP(WS_BIG); const bf16_t* KI = (const bf16_t*)WSP(WS_KI);
    LAS float* sc = (LAS float*)F.lds;
    const int lane = F.lane, r32 = lane & 31, hi = lane >> 5, wv = F.wave;
    for (int pi = F.vcu; pi < 1024; pi += F.G) {
        const int b = pi >> 8, pp = pi & 255;
#pragma unroll 1
        for (int half = 0; half < 2; ++half) {
            const int t0 = 8 * (half == 0 ? pp : 511 - pp), m0 = b * S + t0, tq = t0 + wv;
            unsigned long long myword = 0ull;
            if (t0 + 8 <= 256) {
                const int lo = 64 * lane; myword = (tq >= lo + 63) ? ~0ull : (tq < lo ? 0ull : ((2ull << (tq - lo)) - 1ull));
                MASKT[(size_t)(b * 64 + lane) * S + tq] = myword;
                continue;
            }
            const int nmax = t0 + 8, ntile = (nmax + 31) >> 5;
            bf16x8 qa[2][4]; float wq[2][4][4];
#pragma unroll
            for (int i = 0; i < 2; ++i) {
                const bf16_t* qp = PROJ + (size_t)(m0 + 4 * i + (r32 >> 3)) * PW + P_QI + (r32 & 7) * 64 + 8 * hi;
#pragma unroll
                for (int s = 0; s < 4; ++s) qa[i][s] = *(const bf16x8*)(qp + 16 * s);
#pragma unroll
                for (int qq = 0; qq < 4; ++qq) { const f32x4 w4 = *(const f32x4*)(MISC + (size_t)(m0 + 4 * i + qq) * 16 + 4 * hi);
#pragma unroll
                    for (int e = 0; e < 4; ++e) wq[i][qq][e] = w4[e] * (0.125f * 0.35355339059327373f); }
            }
            for (int j = wv; j < ntile; j += 8) {
                const int key = 32 * j + r32; const int krow = key < nmax ? key : nmax - 1;
                const bf16_t* kp = KI + (size_t)(b * S + krow) * 64 + 8 * hi;
                bf16x8 kb[4];
#pragma unroll
                for (int s = 0; s < 4; ++s) kb[s] = *(const bf16x8*)(kp + 16 * s);
#pragma unroll
                for (int i = 0; i < 2; ++i) {
                    f32x16 d;
#pragma unroll
                    for (int r = 0; r < 16; ++r) d[r] = 0.f;
#pragma unroll
                    for (int s = 0; s < 4; ++s) d = __builtin_amdgcn_mfma_f32_32x32x16_bf16(qa[i][s], kb[s], d, 0, 0, 0);
                    float part[4];
#pragma unroll
                    for (int qq = 0; qq < 4; ++qq) { float a = 0.f;
#pragma unroll
                        for (int e = 0; e < 4; ++e) a = fmaf(wq[i][qq][e], fmaxf(d[4 * qq + e], 0.f), a);
                        part[qq] = a; }
                    auto s01 = __builtin_amdgcn_permlane32_swap(__float_as_uint(part[0]), __float_as_uint(part[1]), false, false);
                    auto s23 = __builtin_amdgcn_permlane32_swap(__float_as_uint(part[2]), __float_as_uint(part[3]), false, false);
                    const float v01 = __uint_as_float(s01[0]) + __uint_as_float(s01[1]), v23 = __uint_as_float(s23[0]) + __uint_as_float(s23[1]);
                    const int qA = 4 * i + hi, qB = 4 * i + 2 + hi;
                    sc[qA * 4096 + key] = (key <= t0 + qA) ? v01 : -INFINITY;
                    sc[qB * 4096 + key] = (key <= t0 + qB) ? v23 : -INFINITY;
                }
            }
            __syncthreads();
            unsigned kk[64]; const int nvalid = 32 * ntile;
#pragma unroll
            for (int r = 0; r < 64; ++r) { const int idx = 64 * r + lane; kk[r] = (idx < nvalid) ? fkey(sc[wv * 4096 + (idx < nvalid ? idx : 0)]) : 0u; }
            const int nreg = (nvalid + 63) >> 6;
            unsigned Tk = 0u;
            for (int bit = 31; bit >= 0; --bit) {
                const unsigned cand = Tk | (1u << bit); int c = 0;
#pragma unroll
                for (int blk = 0; blk < 4; ++blk) if (nreg > 16 * blk) {
#pragma unroll
                    for (int r = 16 * blk; r < 16 * blk + 16; ++r) c += __builtin_popcountll(__ballot(kk[r] >= cand)); }
                if (c >= 256) Tk = cand;
            }
            int ngt = 0, neq = 0;
#pragma unroll
            for (int r = 0; r < 64; ++r) { ngt += __builtin_popcountll(__ballot(kk[r] > Tk)); neq += __builtin_popcountll(__ballot(kk[r] == Tk)); }
            const bool all_eq = (ngt + neq == 256); int need = 256 - ngt;
#pragma unroll
            for (int r = 0; r < 64; ++r) {
                unsigned long long wsel = __ballot(kk[r] > Tk), em = __ballot(kk[r] == Tk);
                if (all_eq) wsel |= em;
                else if (em != 0ull && need > 0) { int c = __builtin_popcountll(em); while (c > need) { em &= ~(1ull << (63 - __builtin_clzll(em))); --c; } need -= c; wsel |= em; }
                if (lane == r) myword = wsel;
            }
            MASKT[(size_t)(b * 64 + lane) * S + tq] = myword;
            __syncthreads();
        }
    }
}
#ifndef MK_MULTI
#define MK_MULTI 0
#endif
constexpr int N_PHASES = 1 + 8 * DEPTH;

__global__ void __launch_bounds__(NT, 2) mk_fwd(Args args) {
    extern __shared__ __attribute__((aligned(16))) unsigned char lds_raw[];
    Frame F;
    F.lds = (LAS unsigned char*)lds_raw; F.tid = threadIdx.x; F.lane = F.tid & 63; F.wave = __builtin_amdgcn_readfirstlane(F.tid >> 6);
    F.G = gridDim.x; { const int bx_ = blockIdx.x; F.vcu = (F.G % 8 == 0) ? (bx_ % 8) * (F.G / 8) + bx_ / 8 : bx_; }
    if (F.tid < 20) { const unsigned long long pv = F.tid < 18 ? (unsigned long long)args.in[F.tid < 18 ? F.tid : 0] : (F.tid == 18 ? (unsigned long long)args.out : (unsigned long long)args.ws);
        *(LAS unsigned long long*)(F.lds + PTR_OFF + 8 * F.tid) = pv; }
    __syncthreads();
    const int lo = args.ph_lo, hi = args.ph_hi; const bool coop = args.coop != 0;
#define RUN(k) (lo <= (k) && (k) < hi)
#define LAUNDER() asm volatile("" : "+v"(F.tid), "+v"(F.lane))
#define SEAM(k) do { if (coop && RUN(k) && RUN((k) + 1)) { cg::this_grid().sync(); } } while (0)
    const int bx = (int)blockIdx.x;

    if (RUN(0)) { LAUNDER(); convert_mix_weights(F, 0); prologue_rows(F);
        if (blockIdx.x == 0 && F.tid < DEPTH * 192) { const int l_ = F.tid / 192, r_ = F.tid % 192, w_ = r_ / 64, i_ = r_ % 64; ((float*)WSP(WS_GT))[F.tid] = INP(I_Q_NORM + w_)[l_ * 64 + i_]; } }
    SEAM(0);
#pragma unroll 1
    for (int l = 0; l < DEPTH; ++l) {
        const int pb = 1 + 8 * l;
        if (RUN(pb + 0)) { LAUNDER();
            pg8::Gemm<D, D, D, 256u * D * 2, 0, 256u * D * 2, 0> g{(const bf16_t*)WSP(WS_XG), (const bf16_t*)WSP(WS_WIN)};
            pg8::StaticOrder So; So.init(M, PW, F.G, bx);
            epi::EpiProj E{(bf16_t*)WSP(WS_BIG), (float*)WSP(WS_MISC), (const float*)WSP(WS_SSQA), (const float*)WSP(WS_COS), (const float*)WSP(WS_SIN), (const float*)WSP(WS_GT) + l * 192, (bf16_t*)WSP(WS_VT), (bf16_t*)WSP(WS_KI)};
            pg8::gemm_phase<epi::EpiProj, pg8::StaticOrder, true>(F.lds, g, So, E, F.tid);
        }
        SEAM(pb + 0);
        if (RUN(pb + 1)) { LAUNDER(); sgu_simple(F, l); conv_simple(F, l); indexer_mfma(F); mlstm1_simple(F, l); }
        SEAM(pb + 1);
        if (RUN(pb + 2)) { LAUNDER(); attn_mfma(F, l); mlstm2_simple(F, l); }
        SEAM(pb + 2);
        if (RUN(pb + 3)) { LAUNDER();
            pg8::Gemm<256, D, 256, 256u * D * 2, 256u * 2, 256u * 256 * 2, 1024u * 256 * 2> g{(const bf16_t*)WSP(WS_Y), (const bf16_t*)WSP(WS_WBR)};
            pg8::SuperOrder<0> So; So.init(F.G, bx);
            epi::EpiPlain E{(bf16_t*)WSP(WS_BIG), 4096, 1024};
            pg8::gemm_phase<epi::EpiPlain, pg8::SuperOrder<0>, true>(F.lds, g, So, E, F.tid);
        }
        SEAM(pb + 3);
        if (RUN(pb + 4)) { LAUNDER();
            pg8::Gemm<D, D, D, 256u * D * 2, 0, 256u * D * 2, 0> g{(const bf16_t*)WSP(WS_XG), (const bf16_t*)WSP(WS_WG)};
            pg8::SuperOrder<1> So; So.init(F.G, bx);
            epi::EpiGate E{(bf16_t*)WSP(WS_MG), (const bf16_t*)WSP(WS_BIG), (const float*)WSP(WS_SSQA)};
            pg8::gemm_phase<epi::EpiGate, pg8::SuperOrder<1>, true>(F.lds, g, So, E, F.tid);
            __syncthreads();
            convert_mlp_weights(F, l);
        }
        SEAM(pb + 4);
        if (RUN(pb + 5)) { LAUNDER();
            pg8::Gemm<D, D, D, 256u * D * 2, 0, 256u * D * 2, 0> g{(const bf16_t*)WSP(WS_MG), (const bf16_t*)WSP(WS_WOUT)};
            pg8::StaticOrder So; So.init(M, D, F.G, bx);
            float* outp = (float*)ptr_at(F, I_OUT); epi::EpiResid E{l == 0 ? INP(I_X) : (const float*)outp, outp, (bf16_t*)WSP(WS_XG), INP(I_LN_MLP) + l * D, (float*)WSP(WS_SSQB)};
            pg8::gemm_phase<epi::EpiResid, pg8::StaticOrder, true>(F.lds, g, So, E, F.tid);
        }
        SEAM(pb + 5);
        if (RUN(pb + 6)) { LAUNDER();
            pg8::Gemm<D, D, D, 256u * D * 2, 0, 256u * D * 2, 0> g{(const bf16_t*)WSP(WS_XG), (const bf16_t*)WSP(WS_WUP)};
            pg8::StaticOrder So; So.init(M, FF, F.G, bx);
            epi::EpiUp E{(bf16_t*)WSP(WS_BIG), (const float*)WSP(WS_SSQB)};
            pg8::gemm_phase<epi::EpiUp, pg8::StaticOrder, true>(F.lds, g, So, E, F.tid);
            if (l + 1 < DEPTH) { __syncthreads(); convert_mix_weights(F, l + 1); }
        }
        SEAM(pb + 6);
        if (RUN(pb + 7)) { LAUNDER();
            pg8::Gemm<FF, FF, FF, 256u * FF * 2, 0, 256u * FF * 2, 0> g{(const bf16_t*)WSP(WS_BIG), (const bf16_t*)WSP(WS_WDN)};
            pg8::StaticOrder So; So.init(M, D, F.G, bx);
            float* outp = (float*)ptr_at(F, I_OUT); epi::EpiResid E{(const float*)outp, outp, (bf16_t*)WSP(WS_XG), (l + 1 < DEPTH) ? INP(I_LN_MIX) + (l + 1) * D : nullptr, (float*)WSP(WS_SSQA)};
            pg8::gemm_phase<epi::EpiResid, pg8::StaticOrder, true>(F.lds, g, So, E, F.tid);
        }
        SEAM(pb + 7);
    }
#undef RUN
#undef SEAM
}

extern "C" void kernel_launch(void* const* d_in, const int* in_sizes, int n_in, void* d_out, int out_size, void* d_ws, size_t ws_size, hipStream_t stream) {
    static int grid = 0;
    if (grid == 0) {
        if (n_in != 18 || in_sizes[0] != M * D || out_size != M * D || ws_size < WS_END) { fprintf(stderr, "kernel_launch: unexpected shapes (n_in %d, in0 %d, out %d, ws %zu)\n", n_in, n_in > 0 ? in_sizes[0] : -1, out_size, ws_size); grid = -1; return; }
        int dev = 0, cus = 0, per_cu = 0;
        if (hipGetDevice(&dev) != hipSuccess || hipDeviceGetAttribute(&cus, hipDeviceAttributeMultiprocessorCount, dev) != hipSuccess) { grid = -1; return; }
        if (hipFuncSetAttribute((const void*)mk_fwd, hipFuncAttributeMaxDynamicSharedMemorySize, LDS_BYTES) != hipSuccess) { fprintf(stderr, "kernel_launch: hipFuncSetAttribute failed\n"); grid = -1; return; }
        if (hipOccupancyMaxActiveBlocksPerMultiprocessor(&per_cu, (const void*)mk_fwd, NT, LDS_BYTES) != hipSuccess || per_cu < 1) { fprintf(stderr, "kernel_launch: occupancy query says %d\n", per_cu); (void)hipGetLastError(); per_cu = 1; }
        grid = cus;
    }
    if (grid < 0) return;
    Args a{};
    for (int i = 0; i < 18; ++i) a.in[i] = (const float*)d_in[i];
    a.out = (float*)d_out; a.ws = (unsigned char*)d_ws;
#if MK_MULTI
    for (int p = 0; p < N_PHASES; ++p) { a.ph_lo = p; a.ph_hi = p + 1; a.coop = 0; hipLaunchKernelGGL(mk_fwd, dim3(grid), dim3(NT), LDS_BYTES, stream, a); }
#else
    a.ph_lo = 0; a.ph_hi = N_PHASES; a.coop = 1;
    void* kargs[] = {&a};
    hipError_t e = hipLaunchCooperativeKernel((const void*)mk_fwd, dim3(grid), dim3(NT), kargs, LDS_BYTES, stream);
    if (e != hipSuccess) fprintf(stderr, "kernel_launch: cooperative launch failed: %s (grid %d)\n", hipGetErrorString(e), grid);
#endif
}
```

```cpp
#define MK_MULTI 0
#include <hip/hip_runtime.h>
#include <hip/hip_cooperative_groups.h>
#include <cstdio>
#include <cstdint>
namespace cg = cooperative_groups;

#define LAS __attribute__((address_space(3)))
typedef unsigned short bf16_t;
typedef short bf16x8 __attribute__((ext_vector_type(8)));
typedef float f32x4 __attribute__((ext_vector_type(4)));
typedef float f32x2 __attribute__((ext_vector_type(2)));
typedef unsigned u32x4 __attribute__((ext_vector_type(4)));
typedef unsigned u32x2 __attribute__((ext_vector_type(2)));

constexpr int D = 1024, NB = 4, S = 4096, M = NB * S, DEPTH = 2, FF = 4096, INW = 7760;
constexpr int O_AU = 0, O_AV = 256, O_BQ = 512, O_BK = 768, O_BV = 1024, O_QI = 1280, O_KI = 1792, O_WI = 1856,
              O_CQ = 1864, O_CK = 2120, O_CV = 2376, O_CO = 2632, O_CI = 2888, O_CF = 2892, O_DB = 2896, O_DC = 3152, O_DX = 3408, O_G = 3664;
constexpr int PW = 3840;
constexpr int P_AU = 0, P_AV = 256, P_Q = 512, P_K = 768, P_V = 1024, P_QI = 1280, P_CQ = 1792, P_CK = 2048, P_CV = 2304, P_CO = 2560,
              P_DB = 2816, P_DC = 3072, P_DX = 3328, P_KI = 3584;
constexpr float EPS = 1e-6f;
constexpr int NWAVES = 8, NT = 512;

constexpr size_t MiB = 1u << 20;
constexpr size_t WS_CTL = 0;
constexpr size_t WS_COS = 1 * MiB, WS_SIN = 1 * MiB + 512 * 1024;
constexpr size_t WS_MISC = 2 * MiB;
constexpr size_t WS_SSQA = 3 * MiB, WS_SSQB = 4 * MiB;
constexpr size_t WS_WIN = 5 * MiB;
constexpr size_t WS_WG = WS_WIN + (size_t)PW * D * 2;
constexpr size_t WS_WBR = WS_WG + (size_t)4096 * D * 2;
constexpr size_t WS_WOUT = WS_WBR + (size_t)4 * 1024 * 256 * 2;
constexpr size_t WS_XG = 25 * MiB;
constexpr size_t WS_BIG = 57 * MiB;
constexpr size_t WS_Y = 185 * MiB;
constexpr size_t WS_WUP = WS_Y, WS_WDN = WS_Y + 8 * MiB;
constexpr size_t WS_MG = 217 * MiB;
constexpr size_t WS_MASK = WS_MG, WS_STATE = WS_MG + 8 * MiB;
constexpr size_t WS_END = 249 * MiB;
constexpr int STATE_STRIDE = 4224;
static_assert(WS_WOUT + (size_t)D * D * 2 <= WS_XG && WS_STATE + (size_t)512 * STATE_STRIDE * 4 <= WS_END && WS_END <= 256 * MiB, "d_ws map");

constexpr int LDS_BYTES = 155648;

__device__ __forceinline__ float bf2f(bf16_t v) { return __uint_as_float((unsigned)v << 16); }
__device__ __forceinline__ unsigned f2bf(float f) { unsigned u = __float_as_uint(f); return (u + 0x7fffu + ((u >> 16) & 1u)) >> 16; }
__device__ __forceinline__ unsigned pk2(float lo, float hi) { return f2bf(lo) | (f2bf(hi) << 16); }
__device__ __forceinline__ unsigned cvt_pk_bf16(float lo, float hi) { unsigned r; asm volatile("v_cvt_pk_bf16_f32 %0, %1, %2" : "=v"(r) : "v"(lo), "v"(hi)); return r; }
__device__ __forceinline__ float lo_bf(unsigned w) { return __uint_as_float(w << 16); }
__device__ __forceinline__ float hi_bf(unsigned w) { return __uint_as_float(w & 0xffff0000u); }
__device__ __forceinline__ float wave_sum(float v) {
#pragma unroll
    for (int o = 1; o < 64; o <<= 1) v += __shfl_xor(v, o);
    return v;
}
__device__ __forceinline__ float wave_max(float v) {
#pragma unroll
    for (int o = 1; o < 64; o <<= 1) v = fmaxf(v, __shfl_xor(v, o));
    return v;
}
__device__ __forceinline__ int wave_sum_i(int v) {
#pragma unroll
    for (int o = 1; o < 64; o <<= 1) v += __shfl_xor(v, o);
    return v;
}
__device__ __forceinline__ float sigmoid_f(float x) { return 1.f / (1.f + __expf(-x)); }
__device__ __forceinline__ float gelu_tanh_f(float x) { const float u = 0.7978845608028654f * (x + 0.044715f * x * x * x); return x / (1.f + __expf(-2.f * u)); }
__device__ __forceinline__ unsigned fkey(float s) { const unsigned u = __float_as_uint(s); return (u & 0x80000000u) ? ~u : (u | 0x80000000u); }

namespace pg8 {
constexpr int BM = 256, BK = 64, HALF = 128, HTB = HALF * BK * 2, STAGE_BYTES = 8 * HTB, NXCD = 8, WGM = 8;
__host__ __device__ __forceinline__ int lds_byte(int r, int c) { const int st = (r >> 4) * 2 + (c >> 5), rr = r & 15, cc = c & 31, ob = rr * 64 + cc * 2; return st * 1024 + (ob ^ (((ob >> 9) & 1) << 5)); }
__host__ __device__ __forceinline__ void stage_rc(int b, int& R, int& C) { const int st = b / 1024, sb = b % 1024, swz = sb ^ (((sb >> 9) & 1) << 5); R = (st >> 1) * 16 + swz / 64; C = (st & 1) * 32 + (swz % 64) / 2; }
__host__ __device__ __forceinline__ int perm32(int rho) { const int n = rho >> 4, i = rho & 15; return 8 * (i >> 2) + 4 * n + (i & 3); }

struct Unit { int pm, pn, z; };
template <int K_, int LDA_, int LDB_, unsigned APM_, unsigned AZ_, unsigned BPN_, unsigned BZ_> struct Gemm {
    const bf16_t* A; const bf16_t* Bt;
    static constexpr int K = K_, lda = LDA_, ldb = LDB_; static constexpr unsigned aPm = APM_, aZ = AZ_, bPn = BPN_, bZ = BZ_;
};
template <class G> __device__ __forceinline__ const char* pa(const G& g, const Unit& u) { return (const char*)g.A + (size_t)((unsigned)u.pm * G::aPm + (unsigned)u.z * G::aZ); }
template <class G> __device__ __forceinline__ const char* pb(const G& g, const Unit& u) { return (const char*)g.Bt + (size_t)((unsigned)u.pn * G::bPn + (unsigned)u.z * G::bZ); }

struct StaticOrder {
    int nM, nN, nwg, G, c;
    __host__ __device__ void init(int M_, int N_, int G_, int c_) { nM = M_ / BM; nN = N_ / BM; nwg = nM * nN; G = G_; c = c_; }
    __host__ __device__ bool next(int i, Unit& u) const {
        const long L = (long)i * G + c; if (L >= nwg) return false;
        int wgid = (int)L; { const int q = nwg / NXCD, r = nwg % NXCD, xcd = wgid % NXCD, off = wgid / NXCD; wgid = (xcd < r ? xcd * (q + 1) : r * (q + 1) + (xcd - r) * q) + off; }
        const int nig = WGM * nN, gid = wgid / nig, fm = gid * WGM, gsz = (nM - fm) < WGM ? (nM - fm) : WGM;
        u.pm = fm + ((wgid % nig) % gsz); u.pn = (wgid % nig) / gsz; u.z = 0; return true;
    }
};
template <int MODE> struct SuperOrder {
    StaticOrder so;
    __host__ __device__ void init(int G_, int c_) { so.init(M, 1024, G_, c_); }
    __host__ __device__ bool next(int i, Unit& u) const {
        Unit b; if (!so.next(i >> 2, b)) return false;
        const int sub = i & 3; u.pm = b.pm; if (MODE == 0) { u.pn = b.pn; u.z = sub; } else { u.pn = 4 * b.pn + sub; u.z = 0; } return true;
    }
};

template <class Epi, class Sched, bool ALIGN_EPI, class GemmT>
__device__ __forceinline__ void gemm_phase(LAS unsigned char* lds, const GemmT g, const Sched& S, const Epi& E, const int tid) {
    const int wid = __builtin_amdgcn_readfirstlane(tid >> 6), lane = tid & 63, wr = wid >> 2, wc = wid & 3, fr = lane & 15, fq = lane >> 4;
    constexpr int K = GemmT::K, nt = K / BK;
    unsigned voffA[2], voffB[2];
#pragma unroll
    for (int i = 0; i < 2; ++i) { int R, C; stage_rc(tid * 16 + i * 8192, R, C); const int Rb = Epi::PERM ? ((R & ~31) + perm32(R & 31)) : R;
        voffA[i] = (unsigned)(R * GemmT::lda + C) * 2u; voffB[i] = (unsigned)(Rb * GemmT::ldb + C) * 2u; }
    const size_t kstep = (size_t)(BK * 2);
    constexpr size_t hA = (size_t)HALF * GemmT::lda * 2, hB = (size_t)HALF * GemmT::ldb * 2;
    const unsigned ldsw = (unsigned)wid * 1024u;
    const int aoff = lds_byte(wr * 64 + fr, fq * 8), boff = lds_byte(wc * 32 + fr, fq * 8);
#define PG8_SA(b, h) (((b) * 2 + (h)) * HTB)
#define PG8_SB(b, h) ((4 + (b) * 2 + (h)) * HTB)
#define PG8_STAGE(bufoff, gbase, voff) do { _Pragma("unroll") for (int _i = 0; _i < 2; ++_i) \
        __builtin_amdgcn_global_load_lds((const unsigned*)((const char*)(gbase) + (voff)[_i]), (LAS unsigned*)(lds + (bufoff) + ldsw + _i * 8192), 16, 0, 0); } while (0)
#define PG8_LDA(dst, b, h) do { _Pragma("unroll") for (int m = 0; m < 4; ++m) _Pragma("unroll") for (int k = 0; k < 2; ++k) dst[m][k] = *(const LAS bf16x8*)(lds + PG8_SA(b, h) + aoff + m * 2048 + k * 1024); } while (0)
#define PG8_LDB(dst, b, h) do { _Pragma("unroll") for (int n = 0; n < 2; ++n) _Pragma("unroll") for (int k = 0; k < 2; ++k) dst[n][k] = *(const LAS bf16x8*)(lds + PG8_SB(b, h) + boff + n * 2048 + k * 1024); } while (0)
#define PG8_MMA(ai, bj, At, Bt) do { __builtin_amdgcn_s_setprio(1); _Pragma("unroll") for (int m = 0; m < 4; ++m) _Pragma("unroll") for (int n = 0; n < 2; ++n) _Pragma("unroll") for (int k = 0; k < 2; ++k) \
        acc[ai][bj][m][n] = __builtin_amdgcn_mfma_f32_16x16x32_bf16(Bt[n][k], At[m][k], acc[ai][bj][m][n], 0, 0, 0); __builtin_amdgcn_s_setprio(0); } while (0)
#define PG8_WAIT_V(n) asm volatile("s_waitcnt vmcnt(" #n ")" ::: "memory")
#define PG8_WAIT_L(n) asm volatile("s_waitcnt lgkmcnt(" #n ")" ::: "memory")
#define PG8_BAR __builtin_amdgcn_s_barrier()
#define PG8_SCHED __builtin_amdgcn_sched_barrier(0)
    Unit cur, nxt; int ui = 0;
    if (!S.next(0, cur)) return;
    f32x4 acc[2][2][4][2];
#pragma unroll
    for (int a = 0; a < 2; ++a)
#pragma unroll
        for (int b = 0; b < 2; ++b)
#pragma unroll
            for (int m = 0; m < 4; ++m)
#pragma unroll
                for (int n = 0; n < 2; ++n) acc[a][b][m][n] = (f32x4){0.f, 0.f, 0.f, 0.f};
    bf16x8 At[4][2], B0[2][2], B1[2][2];
    const char* cA = pa(g, cur); const char* cB = pb(g, cur);
    PG8_STAGE(PG8_SB(0, 0), cB, voffB); PG8_STAGE(PG8_SB(0, 1), cB + hB, voffB); PG8_STAGE(PG8_SA(0, 0), cA, voffA); PG8_STAGE(PG8_SA(0, 1), cA + hA, voffA);
    if (wr == 1) PG8_BAR;
    PG8_WAIT_V(2); PG8_BAR;
    PG8_STAGE(PG8_SB(1, 0), cB + kstep, voffB); PG8_STAGE(PG8_SA(1, 0), cA + kstep, voffA); PG8_STAGE(PG8_SB(1, 1), cB + hB + kstep, voffB);
    PG8_WAIT_V(6); PG8_BAR;
    for (;;) {
        const bool has_next = S.next(ui + 1, nxt);
        const char* nA = has_next ? pa(g, nxt) : cA; const char* nB = has_next ? pb(g, nxt) : cB;
#pragma unroll 1
        for (int t = 0; t < nt; t += 2) {
            const bool last = (t == nt - 2);
            const char* a1 = cA + (size_t)(t + 1) * kstep;
            const char* a2 = last ? nA : cA + (size_t)(t + 2) * kstep; const char* b2 = last ? nB : cB + (size_t)(t + 2) * kstep;
            const char* a3 = a2 + kstep; const char* b3 = b2 + kstep;
            PG8_LDB(B0, 0, 0); PG8_LDB(B1, 0, 1); PG8_SCHED; PG8_LDA(At, 0, 0); PG8_STAGE(PG8_SA(1, 1), a1 + hA, voffA);
            PG8_WAIT_V(8); PG8_WAIT_L(0); PG8_BAR; PG8_MMA(0, 0, At, B0); PG8_MMA(0, 1, At, B1); PG8_BAR; PG8_SCHED;
            PG8_LDA(At, 0, 1); PG8_STAGE(PG8_SB(0, 0), b2, voffB); PG8_STAGE(PG8_SB(0, 1), b2 + hB, voffB); PG8_STAGE(PG8_SA(0, 0), a2, voffA);
            PG8_WAIT_V(8); PG8_WAIT_L(0); PG8_BAR; PG8_MMA(1, 0, At, B0); PG8_MMA(1, 1, At, B1); PG8_BAR; PG8_SCHED;
            PG8_LDB(B0, 1, 0); PG8_LDB(B1, 1, 1); PG8_SCHED; PG8_LDA(At, 1, 0); PG8_STAGE(PG8_SA(0, 1), a2 + hA, voffA);
            PG8_WAIT_V(8); PG8_WAIT_L(0); PG8_BAR; PG8_MMA(0, 0, At, B0); PG8_MMA(0, 1, At, B1); PG8_BAR; PG8_SCHED;
            PG8_LDA(At, 1, 1); PG8_STAGE(PG8_SB(1, 0), b3, voffB); PG8_STAGE(PG8_SB(1, 1), b3 + hB, voffB); PG8_STAGE(PG8_SA(1, 0), a3, voffA);
            PG8_WAIT_V(8); PG8_WAIT_L(0); PG8_BAR; PG8_MMA(1, 0, At, B0); PG8_MMA(1, 1, At, B1); PG8_BAR; PG8_SCHED;
        }
        if constexpr (ALIGN_EPI) { if (wr == 0) PG8_BAR; }
        { int fr2 = fr, fq2 = fq; asm volatile("" : "+v"(fr2), "+v"(fq2)); E(acc, cur, wr, wc, fr2, fq2); }
        if (!has_next) break;
#pragma unroll
        for (int a = 0; a < 2; ++a)
#pragma unroll
            for (int b = 0; b < 2; ++b)
#pragma unroll
                for (int m = 0; m < 4; ++m)
#pragma unroll
                    for (int n = 0; n < 2; ++n) acc[a][b][m][n] = (f32x4){0.f, 0.f, 0.f, 0.f};
        cur = nxt; cA = nA; cB = nB; ++ui;
        if constexpr (ALIGN_EPI) { if (wr == 1) PG8_BAR; }
    }
    PG8_WAIT_V(0);
    if constexpr (!ALIGN_EPI) { if (wr == 0) PG8_BAR; }
    PG8_BAR;
#undef PG8_SA
#undef PG8_SB
#undef PG8_STAGE
#undef PG8_LDA
#undef PG8_LDB
#undef PG8_MMA
#undef PG8_WAIT_V
#undef PG8_WAIT_L
#undef PG8_BAR
#undef PG8_SCHED
}
}
namespace epi {
using pg8::Unit;
typedef f32x4 Acc[2][2][4][2];

__device__ __forceinline__ float row_scale(const float* ssq, int row) {
    const f32x4* sp = (const f32x4*)(ssq + (size_t)row * 16);
    const f32x4 a = sp[0], b = sp[1], c = sp[2], d = sp[3];
    const float t = ((a[0] + a[1]) + (a[2] + a[3])) + ((b[0] + b[1]) + (b[2] + b[3])) + ((c[0] + c[1]) + (c[2] + c[3])) + ((d[0] + d[1]) + (d[2] + d[3]));
    return rsqrtf(t * (1.0f / 1024.0f) + EPS);
}
__device__ __forceinline__ u32x4 pack8(const f32x4 a, const f32x4 b) { u32x4 w; w.x = cvt_pk_bf16(a[0], a[1]); w.y = cvt_pk_bf16(a[2], a[3]); w.z = cvt_pk_bf16(b[0], b[1]); w.w = cvt_pk_bf16(b[2], b[3]); return w; }

struct EpiProj {
    static constexpr bool PERM = true;
    bf16_t* P; float* misc; const float* ssq; const float* cs; const float* sn; const float* gt;     bf16_t* VT;     bf16_t* KI;
    __device__ __forceinline__ void operator()(const Acc& acc, const Unit& u, int wr, int wc, int fr, int fq) const {
        const int T = u.pn; const int row0 = u.pm * 256 + wr * 64 + fr;
        if (T == 2 || T == 3 || T == 5 || T == 6 || T == 14) {
            if (T == 14 && wc >= 2) return;
            if (T == 14 && wc == 1) {
                if (fq < 2) {
#pragma unroll
                    for (int ai = 0; ai < 2; ++ai)
#pragma unroll
                        for (int m = 0; m < 4; ++m) { const int row = row0 + ai * 128 + m * 16; const float rs = row_scale(ssq, row);
                            float* mp = misc + (size_t)row * 16 + 8 * fq; *(f32x4*)mp = acc[ai][0][m][0] * rs; *(f32x4*)(mp + 4) = acc[ai][0][m][1] * rs; }
                }
                return;
            }
            const int mode = (T == 14) ? 2 : (T <= 3 ? 1 : 0);
            const float* gp = gt + 64 * ((T == 2) ? 0 : (T == 3) ? 1 : 2);
            f32x4 g1[2], g2[2];
#pragma unroll
            for (int n = 0; n < 2; ++n) { if (mode) { g1[n] = *(const f32x4*)(gp + 8 * fq + 4 * n); g2[n] = *(const f32x4*)(gp + 32 + 8 * fq + 4 * n); } else { g1[n] = (f32x4){1.f, 1.f, 1.f, 1.f}; g2[n] = g1[n]; } }
#pragma unroll
            for (int ai = 0; ai < 2; ++ai)
#pragma unroll
                for (int m = 0; m < 4; ++m) {
                    const int row = row0 + ai * 128 + m * 16; const float rs = row_scale(ssq, row); const int pos = row & (S - 1);
                    f32x4 x1[2], x2[2];
#pragma unroll
                    for (int n = 0; n < 2; ++n) { x1[n] = acc[ai][0][m][n] * rs; x2[n] = acc[ai][1][m][n] * rs; }
                    if (mode == 2) {
                        float s = 0.f;
#pragma unroll
                        for (int n = 0; n < 2; ++n) s += (x1[n][0] + x1[n][1]) + (x1[n][2] + x1[n][3]) + (x2[n][0] + x2[n][1]) + (x2[n][2] + x2[n][3]);
                        s += __shfl_xor(s, 16); s += __shfl_xor(s, 32); const float mu = s * (1.f / 64.f);
#pragma unroll
                        for (int n = 0; n < 2; ++n) { x1[n] = x1[n] - mu; x2[n] = x2[n] - mu; }
                    }
                    if (mode) {
                        float q = 0.f;
#pragma unroll
                        for (int n = 0; n < 2; ++n) { const f32x4 a = x1[n] * x1[n], b = x2[n] * x2[n]; q += (a[0] + a[1]) + (a[2] + a[3]) + (b[0] + b[1]) + (b[2] + b[3]); }
                        q += __shfl_xor(q, 16); q += __shfl_xor(q, 32); const float rr = rsqrtf(q * (1.f / 64.f) + EPS);
#pragma unroll
                        for (int n = 0; n < 2; ++n) { x1[n] = x1[n] * rr * g1[n]; x2[n] = x2[n] * rr * g2[n]; }
                    }
                    f32x4 o1[2], o2[2];
#pragma unroll
                    for (int n = 0; n < 2; ++n) { const f32x4 c = *(const f32x4*)(cs + (size_t)pos * 32 + 8 * fq + 4 * n), s = *(const f32x4*)(sn + (size_t)pos * 32 + 8 * fq + 4 * n);
                        o1[n] = x1[n] * c - x2[n] * s; o2[n] = x2[n] * c + x1[n] * s; }
                    bf16_t* op = P + (size_t)row * PW + 256 * T + 64 * wc + 8 * fq;
                    *(u32x4*)op = pack8(o1[0], o1[1]); *(u32x4*)(op + 32) = pack8(o2[0], o2[1]);
                    if (T == 14) { bf16_t* kp = KI + (size_t)row * 64 + 8 * fq; *(u32x4*)kp = pack8(o1[0], o1[1]); *(u32x4*)(kp + 32) = pack8(o2[0], o2[1]); }
                }
            return;
        }
        const int act = (T <= 1) ? 1 : 0; const float sc = (T == 8) ? 0.125f : 1.0f;
#pragma unroll
        for (int ai = 0; ai < 2; ++ai)
#pragma unroll
            for (int m = 0; m < 4; ++m) {
                const int row = row0 + ai * 128 + m * 16; const float rs = row_scale(ssq, row) * sc;
                bf16_t* op = P + (size_t)row * PW + 256 * T + 32 * wc + 8 * fq;
#pragma unroll
                for (int bj = 0; bj < 2; ++bj) { f32x4 v0 = acc[ai][bj][m][0] * rs, v1 = acc[ai][bj][m][1] * rs;
                    if (act) {
#pragma unroll
                        for (int e = 0; e < 4; ++e) { v0[e] = gelu_tanh_f(v0[e]); v1[e] = gelu_tanh_f(v1[e]); } }
                    *(u32x4*)(op + bj * 128) = pack8(v0, v1);
                    if (T == 4) { bf16_t* vp = VT + ((size_t)((row >> 12) * 256 + bj * 128 + 32 * wc + 8 * fq)) * S + (row & (S - 1));
#pragma unroll
                        for (int e = 0; e < 4; ++e) { vp[(size_t)e * S] = (bf16_t)f2bf(v0[e]); vp[(size_t)(4 + e) * S] = (bf16_t)f2bf(v1[e]); } } }
            }
    }
};

struct EpiPlain {
    static constexpr bool PERM = true;
    bf16_t* O; int ldc; int zcols;
    __device__ __forceinline__ void operator()(const Acc& acc, const Unit& u, int wr, int wc, int fr, int fq) const {
        const int row0 = u.pm * 256 + wr * 64 + fr; const int col0 = u.z * zcols + u.pn * 256 + 32 * wc + 8 * fq;
#pragma unroll
        for (int ai = 0; ai < 2; ++ai)
#pragma unroll
            for (int m = 0; m < 4; ++m) { bf16_t* op = O + (size_t)(row0 + ai * 128 + m * 16) * ldc + col0;
#pragma unroll
                for (int bj = 0; bj < 2; ++bj) *(u32x4*)(op + bj * 128) = pack8(acc[ai][bj][m][0], acc[ai][bj][m][1]); }
    }
};

struct EpiGate {
    static constexpr bool PERM = true;
    bf16_t* MG; const bf16_t* BR; const float* ssq;
    __device__ __forceinline__ void operator()(const Acc& acc, const Unit& u, int wr, int wc, int fr, int fq) const {
        const int row0 = u.pm * 256 + wr * 64 + fr; const int ch0 = u.pn * 64 + 16 * wc + 4 * fq;
#pragma unroll
        for (int ai = 0; ai < 2; ++ai)
#pragma unroll
            for (int m = 0; m < 4; ++m) {
                const int row = row0 + ai * 128 + m * 16; const float rs = row_scale(ssq, row);
                const bf16_t* bp = BR + (size_t)row * 4096 + ch0; f32x4 o = (f32x4){0.f, 0.f, 0.f, 0.f};
#pragma unroll
                for (int bj = 0; bj < 2; ++bj)
#pragma unroll
                    for (int n = 0; n < 2; ++n) { const u32x2 w = *(const u32x2*)(bp + (2 * bj + n) * 1024); const f32x4 a = acc[ai][bj][m][n] * rs;
                        o[0] += sigmoid_f(a[0]) * lo_bf(w.x); o[1] += sigmoid_f(a[1]) * hi_bf(w.x); o[2] += sigmoid_f(a[2]) * lo_bf(w.y); o[3] += sigmoid_f(a[3]) * hi_bf(w.y); }
                u32x2 ow; ow.x = cvt_pk_bf16(o[0], o[1]); ow.y = cvt_pk_bf16(o[2], o[3]);
                *(u32x2*)(MG + (size_t)row * 1024 + ch0) = ow;
            }
    }
};

struct EpiResid {
    static constexpr bool PERM = true;
    const float* res; float* out; bf16_t* XG; const float* gain; float* ssq;
    __device__ __forceinline__ void operator()(const Acc& acc, const Unit& u, int wr, int wc, int fr, int fq) const {
        const int row0 = u.pm * 256 + wr * 64 + fr; const int col0 = u.pn * 256 + 32 * wc + 8 * fq;
        f32x4 gv[2][2];
#pragma unroll
        for (int bj = 0; bj < 2; ++bj)
#pragma unroll
            for (int n = 0; n < 2; ++n) gv[bj][n] = gain ? *(const f32x4*)(gain + col0 + bj * 128 + 4 * n) : (f32x4){1.f, 1.f, 1.f, 1.f};
#pragma unroll
        for (int ai = 0; ai < 2; ++ai)
#pragma unroll
            for (int m = 0; m < 4; ++m) {
                const int row = row0 + ai * 128 + m * 16; const size_t off = (size_t)row * 1024 + col0; float q = 0.f;
#pragma unroll
                for (int bj = 0; bj < 2; ++bj) {
                    const f32x4 r0 = *(const f32x4*)(res + off + bj * 128), r1 = *(const f32x4*)(res + off + bj * 128 + 4);
                    const f32x4 x0 = r0 + acc[ai][bj][m][0], x1 = r1 + acc[ai][bj][m][1];
                    *(f32x4*)(out + off + bj * 128) = x0; *(f32x4*)(out + off + bj * 128 + 4) = x1;
                    const f32x4 a = x0 * x0, b = x1 * x1; q += ((a[0] + a[1]) + (a[2] + a[3])) + ((b[0] + b[1]) + (b[2] + b[3]));
                    *(u32x4*)(XG + off + bj * 128) = pack8(x0 * gv[bj][0], x1 * gv[bj][1]);
                }
                q += __shfl_xor(q, 16); q += __shfl_xor(q, 32);
                if (fq == 0) ssq[(size_t)row * 16 + 4 * u.pn + wc] = q;
            }
    }
};

struct EpiUp {
    static constexpr bool PERM = true;
    bf16_t* H; const float* ssq;
    __device__ __forceinline__ void operator()(const Acc& acc, const Unit& u, int wr, int wc, int fr, int fq) const {
        const int row0 = u.pm * 256 + wr * 64 + fr; const int col0 = u.pn * 256 + 32 * wc + 8 * fq;
#pragma unroll
        for (int ai = 0; ai < 2; ++ai)
#pragma unroll
            for (int m = 0; m < 4; ++m) { const int row = row0 + ai * 128 + m * 16; const float rs = row_scale(ssq, row); bf16_t* op = H + (size_t)row * FF + col0;
#pragma unroll
                for (int bj = 0; bj < 2; ++bj) { f32x4 v0 = acc[ai][bj][m][0] * rs, v1 = acc[ai][bj][m][1] * rs;
#pragma unroll
                    for (int e = 0; e < 4; ++e) { v0[e] = fmaxf(v0[e], 0.f); v1[e] = fmaxf(v1[e], 0.f); }
                    *(u32x4*)(op + bj * 128) = pack8(v0 * v0, v1 * v1); } }
    }
};
}
struct Args {
    const float* in[18]; float* out; unsigned char* ws; int ph_lo, ph_hi; int coop, pad;
};
struct Frame { LAS unsigned char* lds; int tid, lane, wave, G, vcu; };
constexpr int PTR_OFF = LDS_BYTES - 512;
enum { I_X = 0, I_LN_MIX, I_W_IN, I_SGU_NORM, I_SGU_W, I_SGU_B, I_Q_NORM, I_K_NORM, I_KIDX_NORM, I_I_BIAS, I_F_BIAS, I_MNORM, I_CONV_W, I_W_BRANCH, I_W_OUT, I_LN_MLP, I_W_UP, I_W_DOWN, I_OUT, I_WS };
__device__ __forceinline__ unsigned char* ptr_at(const Frame& F, int i) { const LAS unsigned* p = (const LAS unsigned*)(F.lds + PTR_OFF) + 2 * i;
    const unsigned lo = __builtin_amdgcn_readfirstlane(p[0]), hi = __builtin_amdgcn_readfirstlane(p[1]); return (unsigned char*)(((unsigned long long)hi << 32) | lo); }
#define INP(i) ((const float*)ptr_at(F, (i)))
#define WSP(off) (ptr_at(F, I_WS) + (off))
constexpr size_t WS_GT = 512 * 1024;
__device__ __forceinline__ size_t maskt_idx(int m, int w) { const int b = m >> 12, t = m & (S - 1); return ((size_t)(b * 64 + (w >> 1)) * S + t) * 2 + (w & 1); }


#define XB_TMO      128
#define XB_XCNT(j)  (256  + 64 * (j))
#define XB_XSUB(j)  (1280 + 64 * (j))
#define XB_XGEN(j)  (2304 + 64 * (j))
#define XB_TOP      3328
#define XB_TOPGEN   3392
#define XCD_BAR_WORDS 3456
#define XB_SPIN_CAP (1u << 22)
constexpr size_t WS_BAR = 64 * 1024;
constexpr size_t CTL_ZERO_BYTES = 128 * 1024;
__device__ __forceinline__ unsigned xb_ld(unsigned* p)              { return __hip_atomic_load(p, __ATOMIC_RELAXED, __HIP_MEMORY_SCOPE_AGENT); }
__device__ __forceinline__ unsigned xb_add(unsigned* p, unsigned v) { return __hip_atomic_fetch_add(p, v, __ATOMIC_RELAXED, __HIP_MEMORY_SCOPE_AGENT); }
__device__ __forceinline__ unsigned xb_xcc_id() { return (unsigned)__builtin_amdgcn_s_getreg((3 << 11) | 20) & 0xFu; }
#define XB_SPIN(cond, bar) do { unsigned _sp = 0; while (cond) { __builtin_amdgcn_s_sleep(1); \
    if ((++_sp & 255u) == 0u) { if (xb_ld(&(bar)[XB_TMO])) break; if (_sp > XB_SPIN_CAP) { atomicAdd(&(bar)[XB_TMO], 1u); break; } } } } while (0)
struct XcdBarrier { unsigned* bar; unsigned x; volatile LAS unsigned* st; };
__device__ __forceinline__ XcdBarrier xcd_barrier_post(unsigned* bar, volatile LAS unsigned* st) {
    XcdBarrier b; b.bar = bar; b.x = xb_xcc_id(); b.st = st;
    if (threadIdx.x == 0) (void)xb_add(&bar[XB_XCNT(b.x)], 1u);
    return b;
}
__device__ __forceinline__ void xcd_barrier_complete(unsigned* bar, unsigned x, unsigned& nloc, unsigned& nx) {
    const unsigned G = gridDim.x * gridDim.y * gridDim.z;
    unsigned sum, cnt, mine, sp = 0u;
    for (;;) {
        sum = 0u; cnt = 0u; mine = 0u;
#pragma unroll
        for (unsigned j = 0; j < 16; ++j) { const unsigned c = xb_ld(&bar[XB_XCNT(j)]); sum += c; cnt += (c > 0u) ? 1u : 0u; mine = (j == x) ? c : mine; }
        if (sum == G) break;
        __builtin_amdgcn_s_sleep(1);
        if ((++sp & 255u) == 0u) { if (xb_ld(&bar[XB_TMO])) break; if (sp > XB_SPIN_CAP) { atomicAdd(&bar[XB_TMO], 1u); break; } }
    }
    nloc = mine > 0u ? mine : 1u; nx = cnt > 0u ? cnt : 1u;
}
__device__ __forceinline__ void xcd_barrier(const XcdBarrier& b) {
    asm volatile("s_waitcnt vmcnt(0)" ::: "memory");
    __syncthreads();
    if (threadIdx.x == 0) {
        unsigned* bar = b.bar;
        __builtin_amdgcn_s_waitcnt(0);
        unsigned nloc = b.st[0], nx = b.st[1];
        if (nloc == 0u) { xcd_barrier_complete(bar, b.x, nloc, nx); b.st[0] = nloc; b.st[1] = nx; }
        const unsigned old = xb_add(&bar[XB_XSUB(b.x)], 1u);
        const unsigned gen = old / nloc;
        if (old + 1u == (gen + 1u) * nloc) {
            __builtin_amdgcn_fence(__ATOMIC_RELEASE, "agent");
            asm volatile("s_waitcnt vmcnt(0)" ::: "memory");
            const unsigned og = xb_add(&bar[XB_TOP], 1u);
            const unsigned tg = og / nx;
            if (og + 1u == (tg + 1u) * nx) xb_add(&bar[XB_TOPGEN], 1u);
            else XB_SPIN(xb_ld(&bar[XB_TOPGEN]) == tg, bar);
            __builtin_amdgcn_fence(__ATOMIC_ACQUIRE, "agent");
            xb_add(&bar[XB_XGEN(b.x)], 1u);
            asm volatile("s_waitcnt vmcnt(0)" ::: "memory");
        } else {
            XB_SPIN(xb_ld(&bar[XB_XGEN(b.x)]) == gen, bar);
            __builtin_amdgcn_fence(__ATOMIC_ACQUIRE, "agent");
            asm volatile("s_waitcnt vmcnt(0)" ::: "memory");
        }
    }
    __syncthreads();
}

__device__ __forceinline__ int win_src(int p) {
    const int T = p >> 8, q = p & 255, bj = q >> 7, wc = (q >> 5) & 3, j = q & 31, hd = 64 * wc + 32 * bj + j;
    switch (T) {
        case 0: return O_AU + q; case 1: return O_AV + q; case 2: return O_BQ + hd; case 3: return O_BK + hd; case 4: return O_BV + q;
        case 5: return O_QI + hd; case 6: return O_QI + 256 + hd; case 7: return O_CQ + q; case 8: return O_CK + q; case 9: return O_CV + q;
        case 10: return O_CO + q; case 11: return O_DB + q; case 12: return O_DC + q; case 13: return O_DX + q;
        default: break;
    }
    if (wc == 0) return O_KI + 32 * bj + j;
    if (wc == 1 && bj == 0 && j < 16) return j < 8 ? O_WI + j : (j < 12 ? O_CI + (j - 8) : O_CF + (j - 12));
    return -1;
}
__device__ __forceinline__ int wg_src(int p) {
    const int pn = p >> 8, q = p & 255, bj = q >> 7, wc = (q >> 5) & 3, fq = (q >> 3) & 3, n = (q >> 2) & 1, e = q & 3;
    return O_G + (2 * bj + n) * 1024 + 64 * pn + 16 * wc + 4 * fq + e;
}
template <int MAP>
__device__ __forceinline__ void conv_item(const float* W, int K, int srcN, bf16_t* WT, LAS float* scr, int item, int nrows, int lane) {
    const int nblk = nrows / 32, kb = item / nblk, nb = item % nblk, k0 = 64 * kb, n0 = 32 * nb;
    const int nn = n0 + (lane & 31); const int src = MAP == 0 ? nn : (MAP == 1 ? win_src(nn) : wg_src(nn));
#pragma unroll 8
    for (int i = 0; i < 32; ++i) { const int kk = 2 * i + (lane >> 5); scr[kk * 33 + (lane & 31)] = src >= 0 ? W[(size_t)(k0 + kk) * srcN + src] : 0.f; }
    asm volatile("s_waitcnt lgkmcnt(0)" ::: "memory");
    const int c = lane & 7;
#pragma unroll
    for (int j = 0; j < 4; ++j) { const int n = (lane >> 3) + 8 * j; const LAS float* s = scr + (8 * c) * 33 + n;
        u32x4 o; o.x = pk2(s[0 * 33], s[1 * 33]); o.y = pk2(s[2 * 33], s[3 * 33]); o.z = pk2(s[4 * 33], s[5 * 33]); o.w = pk2(s[6 * 33], s[7 * 33]);
        *(u32x4*)(WT + (size_t)(n0 + n) * K + k0 + 8 * c) = o; }
    asm volatile("s_waitcnt lgkmcnt(0)" ::: "memory");
}
__device__ __forceinline__ void convert_mix_weights(Frame& F, int l) {

    LAS float* scr = (LAS float*)(F.lds + F.wave * 16384);
    const int gw = F.vcu * NWAVES + F.wave, NGW = F.G * NWAVES;
    constexpr int I_WIN = (D / 64) * (PW / 32), I_WG = (D / 64) * (4096 / 32), I_BR = (256 / 64) * (1024 / 32), I_OUT = (D / 64) * (D / 32);
    constexpr int NIT = I_WIN + I_WG + 4 * I_BR + I_OUT;
    const float* win = INP(I_W_IN) + (size_t)l * D * INW;
    for (int it = gw; it < NIT; it += NGW) {
        int r = it;
        if (r < I_WIN) { conv_item<1>(win, D, INW, ((bf16_t*)WSP(WS_WIN)), scr, r, PW, F.lane); continue; } r -= I_WIN;
        if (r < I_WG) { conv_item<2>(win, D, INW, ((bf16_t*)WSP(WS_WG)), scr, r, 4096, F.lane); continue; } r -= I_WG;
        if (r < 4 * I_BR) { const int nb = r / I_BR; conv_item<0>(INP(I_W_BRANCH) + ((size_t)l * 4 + nb) * 256 * D, 256, D, ((bf16_t*)WSP(WS_WBR)) + (size_t)nb * 1024 * 256, scr, r % I_BR, 1024, F.lane); continue; } r -= 4 * I_BR;
        conv_item<0>(INP(I_W_OUT) + (size_t)l * D * D, D, D, ((bf16_t*)WSP(WS_WOUT)), scr, r, D, F.lane);
    }
}
__device__ __forceinline__ void convert_mlp_weights(Frame& F, int l) {

    LAS float* scr = (LAS float*)(F.lds + F.wave * 16384);
    const int gw = F.vcu * NWAVES + F.wave, NGW = F.G * NWAVES;
    constexpr int I_UP = (D / 64) * (FF / 32), I_DN = (FF / 64) * (D / 32);
    for (int it = gw; it < I_UP + I_DN; it += NGW) {
        if (it < I_UP) conv_item<0>(INP(I_W_UP) + (size_t)l * D * FF, D, FF, ((bf16_t*)WSP(WS_WUP)), scr, it, FF, F.lane);
        else conv_item<0>(INP(I_W_DOWN) + (size_t)l * FF * D, FF, D, ((bf16_t*)WSP(WS_WDN)), scr, it - I_UP, D, F.lane);
    }
}
__device__ __forceinline__ void prologue_rows(Frame& F) {
    float* COS = (float*)WSP(WS_COS); float* SIN = (float*)WSP(WS_SIN); float* SSQA = (float*)WSP(WS_SSQA); bf16_t* XG = (bf16_t*)WSP(WS_XG); const float* x = INP(I_X); const float* ln_mix = INP(I_LN_MIX);
    const int gt = F.vcu * NT + F.tid, NGT = F.G * NT;
    for (int i = gt; i < S * 32; i += NGT) { const int pos = i >> 5, k = i & 31; const float inv = powf(10000.f, -(float)k * 2.0f / 64.f); const float ang = (float)pos * inv; COS[i] = cosf(ang); SIN[i] = sinf(ang); }
    const int gw = F.vcu * NWAVES + F.wave, NGW = F.G * NWAVES;
    for (int m = gw; m < M; m += NGW) {
        const f32x4* xr = (const f32x4*)(x + (size_t)m * D) + F.lane; const f32x4* gr = (const f32x4*)ln_mix + F.lane;
        unsigned long long* o8 = (unsigned long long*)(XG + (size_t)m * D) + F.lane;
#pragma unroll
        for (int j = 0; j < 4; ++j) { const f32x4 v = xr[64 * j], g = gr[64 * j]; float s = (v[0] * v[0] + v[1] * v[1]) + (v[2] * v[2] + v[3] * v[3]);
            s += __shfl_xor(s, 1); s += __shfl_xor(s, 2); s += __shfl_xor(s, 4); s += __shfl_xor(s, 8);
            if ((F.lane & 15) == 0) SSQA[(size_t)m * 16 + 4 * j + (F.lane >> 4)] = s;
            o8[64 * j] = (unsigned long long)pk2(v[0] * g[0], v[1] * g[1]) | ((unsigned long long)pk2(v[2] * g[2], v[3] * g[3]) << 32); }
    }
}

__device__ __forceinline__ void sgu_simple(Frame& F, int l) {
    bf16_t* PROJ = (bf16_t*)WSP(WS_BIG); bf16_t* Y = (bf16_t*)WSP(WS_Y); const float* sgu_norm = INP(I_SGU_NORM); const float* sgu_w = INP(I_SGU_W); const float* sgu_b = INP(I_SGU_B);
    LAS float* r_s = (LAS float*)F.lds; LAS float* vn = r_s + 128;
    const float* gain = sgu_norm + l * 256; const float* sw = sgu_w + (size_t)l * 4 * 128 * 128; const float* sb = sgu_b + l * 4 * 128;
    for (int item = F.vcu; item < 512; item += F.G) {
        const int g = item & 3, m0 = (item >> 2) * 128;
        for (int i = 0; i < 16; ++i) { const int tok = F.wave * 16 + i; const u32x2 w = *(const u32x2*)(PROJ + (size_t)(m0 + tok) * PW + P_AV + 4 * F.lane);
            const float a = lo_bf(w.x), b = hi_bf(w.x), c = lo_bf(w.y), d = hi_bf(w.y); const float ss = wave_sum((a * a + b * b) + (c * c + d * d));
            if (F.lane == 0) r_s[tok] = rsqrtf(ss * (1.f / 256.f) + EPS); }
        __syncthreads();
        for (int idx = F.tid; idx < 8192; idx += NT) { const int s = idx >> 6, d = idx & 63; vn[idx] = bf2f(PROJ[(size_t)(m0 + s) * PW + P_AV + g * 64 + d]) * r_s[s] * gain[g * 64 + d]; }
        __syncthreads();
        const int d = F.tid & 63, tq = F.tid >> 6;
        for (int tl = tq; tl < 128; tl += 8) { const float* w = sw + ((size_t)g * 128 + tl) * 128; float acc = 0.f;
            for (int s = 0; s <= tl; ++s) acc = fmaf(w[s], vn[s * 64 + d], acc);
            acc += sb[g * 128 + tl];
            Y[(size_t)(m0 + tl) * D + g * 64 + d] = (bf16_t)f2bf(bf2f(PROJ[(size_t)(m0 + tl) * PW + P_AU + g * 64 + d]) * acc); }
        __syncthreads();
    }
}
__device__ __forceinline__ void conv_simple(Frame& F, int l) {
    bf16_t* PROJ = (bf16_t*)WSP(WS_BIG); bf16_t* Y = (bf16_t*)WSP(WS_Y); const float* conv_w = INP(I_CONV_W);
    const float* cw = conv_w + l * 3 * 256;
    for (int i = F.vcu * NT + F.tid; i < M * 256; i += F.G * NT) { const int m = i >> 8, c = i & 255, t = m & (S - 1); float acc = 0.f;
#pragma unroll
        for (int j = 0; j < 3; ++j) { const int tt = t - 2 + j; if (tt >= 0) { const size_t r = (size_t)(m - 2 + j) * PW; acc = fmaf(cw[j * 256 + c], bf2f(PROJ[r + P_DC + c]) * bf2f(PROJ[r + P_DX + c]), acc); } }
        Y[(size_t)m * D + 768 + c] = (bf16_t)f2bf(bf2f(PROJ[(size_t)m * PW + P_DB + c]) * acc); }
}
__device__ __forceinline__ void indexer_simple(Frame& F) {
    float* MISC = (float*)WSP(WS_MISC); unsigned* MASK = (unsigned*)WSP(WS_MASK); bf16_t* PROJ = (bf16_t*)WSP(WS_BIG);
    LAS float* sc = (LAS float*)F.lds; LAS int* red = (LAS int*)(sc + 4096); LAS unsigned* msk = (LAS unsigned*)(red + 16);
    for (int m = F.vcu; m < M; m += F.G) {
        const int t = m & (S - 1), b0 = m - t, n = t + 1;
        if (n <= 256) { if (F.tid < 128) { const int lo = 32 * F.tid; MASK[maskt_idx(m, F.tid)] = (lo + 32 <= n) ? 0xffffffffu : (lo >= n ? 0u : ((1u << (n - lo)) - 1u)); } continue; }
        float qreg[8], wh[8];
#pragma unroll
        for (int h = 0; h < 8; ++h) { qreg[h] = bf2f(PROJ[(size_t)m * PW + P_QI + h * 64 + F.lane]); wh[h] = MISC[(size_t)m * 16 + h] * 0.35355339059327373f; }
        for (int s0 = 0; s0 < n; s0 += NT) {
            const int s = s0 + F.tid, sc_ = s < n ? s : n - 1; const u32x4* kr = (const u32x4*)(PROJ + (size_t)(b0 + sc_) * PW + P_KI);
            float kf[64];
#pragma unroll
            for (int i = 0; i < 8; ++i) { const u32x4 w = kr[i]; kf[8 * i] = lo_bf(w.x); kf[8 * i + 1] = hi_bf(w.x); kf[8 * i + 2] = lo_bf(w.y); kf[8 * i + 3] = hi_bf(w.y); kf[8 * i + 4] = lo_bf(w.z); kf[8 * i + 5] = hi_bf(w.z); kf[8 * i + 6] = lo_bf(w.w); kf[8 * i + 7] = hi_bf(w.w); }
            float acc = 0.f;
#pragma unroll
            for (int h = 0; h < 8; ++h) { float d0 = 0.f, d1 = 0.f;
#pragma unroll
                for (int e = 0; e < 64; e += 2) { d0 = fmaf(__builtin_bit_cast(float, __builtin_amdgcn_readlane(__builtin_bit_cast(int, qreg[h]), e)), kf[e], d0);
                                                   d1 = fmaf(__builtin_bit_cast(float, __builtin_amdgcn_readlane(__builtin_bit_cast(int, qreg[h]), e + 1)), kf[e + 1], d1); }
                acc += wh[h] * fmaxf((d0 + d1) * 0.125f, 0.f); }
            if (s < n) sc[s] = acc;
        }
        __syncthreads();
        unsigned Tk = 0u;
        for (int bit = 31; bit >= 0; --bit) {
            const unsigned cand = Tk | (1u << bit); int c = 0;
            for (int s = F.tid; s < n; s += NT) c += (fkey(sc[s]) >= cand) ? 1 : 0;
            c = wave_sum_i(c); if (F.lane == 0) red[F.wave] = c; __syncthreads();
            int tot = 0;
#pragma unroll
            for (int w = 0; w < 8; ++w) tot += red[w];
            __syncthreads();
            if (tot >= 256) Tk = cand;
        }
        int cg_ = 0, ce = 0;
        for (int s = F.tid; s < n; s += NT) { const unsigned k = fkey(sc[s]); cg_ += k > Tk ? 1 : 0; ce += k == Tk ? 1 : 0; }
        cg_ = wave_sum_i(cg_); ce = wave_sum_i(ce); if (F.lane == 0) { red[F.wave] = cg_; red[8 + F.wave] = ce; }
        if (F.tid < 128) msk[F.tid] = 0u;
        __syncthreads();
        int ngt = 0, neq = 0;
#pragma unroll
        for (int w = 0; w < 8; ++w) { ngt += red[w]; neq += red[8 + w]; }
        const bool all_eq = (ngt + neq == 256);
        for (int s = F.tid; s < n; s += NT) { const unsigned k = fkey(sc[s]); if (k > Tk || (all_eq && k == Tk)) atomicOr((unsigned*)&msk[s >> 5], 1u << (s & 31)); }
        __syncthreads();
        if (!all_eq && F.tid == 0) { int need = 256 - ngt; for (int s = 0; s < n && need > 0; ++s) if (fkey(sc[s]) == Tk) { msk[s >> 5] |= 1u << (s & 31); --need; } }
        __syncthreads();
        if (F.tid < 128) MASK[maskt_idx(m, F.tid)] = msk[F.tid];
        __syncthreads();
    }
}
__device__ __forceinline__ void attn_simple(Frame& F) {
    unsigned* MASK = (unsigned*)WSP(WS_MASK); bf16_t* PROJ = (bf16_t*)WSP(WS_BIG); bf16_t* Y = (bf16_t*)WSP(WS_Y);
    LAS unsigned* msk = (LAS unsigned*)F.lds; LAS int* sel = (LAS int*)(msk + 128); LAS float* lg = (LAS float*)(sel + 256); LAS int* nsel = (LAS int*)(lg + 4 * 256);
    for (int m = F.vcu; m < M; m += F.G) {
        const int t = m & (S - 1), b0 = m - t;
        if (F.tid < 128) msk[F.tid] = MASK[maskt_idx(m, F.tid)];
        __syncthreads();
        if (F.tid == 0) { int c = 0; for (int w = 0; w < 128; ++w) { unsigned bits = msk[w]; while (bits) { const int i = __builtin_ctz(bits); if (c < 256) sel[c] = 32 * w + i; ++c; bits &= bits - 1; } } nsel[0] = c < 256 ? c : 256; }
        __syncthreads();
        const int ns = nsel[0], h = F.wave & 3, part = F.wave >> 2;
        const float q = bf2f(PROJ[(size_t)m * PW + P_Q + h * 64 + F.lane]);
        for (int j = part; j < ns; j += 2) { const float d = wave_sum(q * bf2f(PROJ[(size_t)(b0 + sel[j]) * PW + P_K + h * 64 + F.lane])); if (F.lane == 0) lg[h * 256 + j] = d * 0.125f; }
        __syncthreads();
        if (F.wave < 4) {
            float mx = -INFINITY; for (int j = F.lane; j < ns; j += 64) mx = fmaxf(mx, lg[h * 256 + j]); mx = wave_max(mx);
            float sm = 0.f; for (int j = F.lane; j < ns; j += 64) sm += __expf(lg[h * 256 + j] - mx); sm = wave_sum(sm);
            float o = 0.f; for (int j = 0; j < ns; ++j) o = fmaf(__expf(lg[h * 256 + j] - mx), bf2f(PROJ[(size_t)(b0 + sel[j]) * PW + P_V + h * 64 + F.lane]), o);
            Y[(size_t)m * D + 256 + h * 64 + F.lane] = (bf16_t)f2bf(o / sm);
        }
        __syncthreads();
    }
}
__device__ __forceinline__ void mlstm1_simple(Frame& F, int l) {
    float* MISC = (float*)WSP(WS_MISC); float* STATE = (float*)WSP(WS_STATE); bf16_t* PROJ = (bf16_t*)WSP(WS_BIG); const float* i_bias = INP(I_I_BIAS); const float* f_bias = INP(I_F_BIAS);
    LAS float* bs = (LAS float*)F.lds; LAS float* ig = bs + 128; LAS float* wk = ig + 128; LAS float* kt = wk + 128; LAS float* vt = kt + 128 * 64;
    for (int item = F.vcu; item < 512; item += F.G) {
        const int bh = item >> 5, c = item & 31, b = bh >> 2, h = bh & 3, m0 = b * S + c * 128;
        if (F.tid < 128) { const float f = MISC[(size_t)(m0 + F.tid) * 16 + 12 + h] + f_bias[l * 4 + h]; bs[F.tid] = fminf(f, 0.f) - log1pf(__expf(-fabsf(f))); ig[F.tid] = MISC[(size_t)(m0 + F.tid) * 16 + 8 + h] + i_bias[l * 4 + h]; }
        for (int idx = F.tid; idx < 8192; idx += NT) { const int s = idx >> 6, d = idx & 63; kt[idx] = bf2f(PROJ[(size_t)(m0 + s) * PW + P_CK + h * 64 + d]); vt[idx] = bf2f(PROJ[(size_t)(m0 + s) * PW + P_CV + h * 64 + d]); }
        __syncthreads();
        if (F.tid == 0) { float a = 0.f; for (int s = 0; s < 128; ++s) { a += bs[s]; bs[s] = a; } }
        __syncthreads();
        const float B = bs[127];
        if (F.tid < 128) wk[F.tid] = __expf(B - bs[F.tid] + ig[F.tid]);
        __syncthreads();
        const int e = F.tid & 63, dq = F.tid >> 6; float acc[8];
#pragma unroll
        for (int i = 0; i < 8; ++i) acc[i] = 0.f;
        for (int s = 0; s < 128; ++s) { const float kv = wk[s] * vt[s * 64 + e];
#pragma unroll
            for (int i = 0; i < 8; ++i) acc[i] = fmaf(kt[s * 64 + dq * 8 + i], kv, acc[i]); }
        float* st = STATE + (size_t)item * STATE_STRIDE;
#pragma unroll
        for (int i = 0; i < 8; ++i) st[(dq * 8 + i) * 64 + e] = acc[i];
        if (F.tid < 64) { float a = 0.f; for (int s = 0; s < 128; ++s) a = fmaf(wk[s], kt[s * 64 + F.tid], a); st[4096 + F.tid] = a; }
        if (F.tid == 0) st[4160] = B;
        __syncthreads();
    }
}
__device__ __forceinline__ void mlstm2_simple(Frame& F, int l) {
    float* MISC = (float*)WSP(WS_MISC); float* STATE = (float*)WSP(WS_STATE); bf16_t* PROJ = (bf16_t*)WSP(WS_BIG); bf16_t* Y = (bf16_t*)WSP(WS_Y); const float* i_bias = INP(I_I_BIAS); const float* f_bias = INP(I_F_BIAS); const float* mnorm = INP(I_MNORM);
    LAS float* Cs = (LAS float*)F.lds; LAS float* ns = Cs + 4096; LAS float* bs = ns + 64; LAS float* ig = bs + 128; LAS float* A = ig + 128;
    LAS float* qt = A + 128 * 128; LAS float* kt = qt + 128 * 65;
    for (int item = F.vcu; item < 512; item += F.G) {
        const int bh = item >> 5, c = item & 31, b = bh >> 2, h = bh & 3, m0 = b * S + c * 128;
        { float Cv[8]; float nv = 0.f;
#pragma unroll
          for (int k = 0; k < 8; ++k) Cv[k] = 0.f;
          for (int cc = 0; cc < c; ++cc) { const float* st = STATE + (size_t)(bh * 32 + cc) * STATE_STRIDE; const float dec = __expf(st[4160]);
#pragma unroll
              for (int k = 0; k < 8; ++k) Cv[k] = fmaf(dec, Cv[k], st[F.tid + NT * k]);
              if (F.tid < 64) nv = fmaf(dec, nv, st[4096 + F.tid]); }
#pragma unroll
          for (int k = 0; k < 8; ++k) Cs[F.tid + NT * k] = Cv[k];
          if (F.tid < 64) ns[F.tid] = nv; }
        if (F.tid < 128) { const float f = MISC[(size_t)(m0 + F.tid) * 16 + 12 + h] + f_bias[l * 4 + h]; bs[F.tid] = fminf(f, 0.f) - log1pf(__expf(-fabsf(f))); ig[F.tid] = MISC[(size_t)(m0 + F.tid) * 16 + 8 + h] + i_bias[l * 4 + h]; }
        for (int idx = F.tid; idx < 8192; idx += NT) { const int s = idx >> 6, d = idx & 63; qt[s * 65 + d] = bf2f(PROJ[(size_t)(m0 + s) * PW + P_CQ + h * 64 + d]); kt[s * 65 + d] = bf2f(PROJ[(size_t)(m0 + s) * PW + P_CK + h * 64 + d]); }
        __syncthreads();
        if (F.tid == 0) { float a = 0.f; for (int s = 0; s < 128; ++s) { a += bs[s]; bs[s] = a; } }
        __syncthreads();
        { const int s = F.tid & 127, jq = F.tid >> 7;
          for (int j = jq; j < 128; j += 4) { float v = 0.f;
              if (s <= j) { float d = 0.f;
#pragma unroll 16
                  for (int k = 0; k < 64; ++k) d = fmaf(qt[j * 65 + k], kt[s * 65 + k], d);
                  v = __expf(bs[j] - bs[s] + ig[s]) * d; }
              A[j * 128 + s] = v; } }
        __syncthreads();
        LAS float* vt = kt;
        for (int idx = F.tid; idx < 8192; idx += NT) { const int s = idx >> 6, d = idx & 63; vt[idx] = bf2f(PROJ[(size_t)(m0 + s) * PW + P_CV + h * 64 + d]); }
        __syncthreads();
        const int e = F.lane; const float gn = mnorm[l * 256 + h * 64 + e];
        for (int j = F.wave; j < 128; j += 8) {
            float num = 0.f, qn = 0.f, sa = 0.f;
            for (int d = 0; d < 64; ++d) { const float qd = qt[j * 65 + d]; num = fmaf(qd, Cs[d * 64 + e], num); qn = fmaf(qd, ns[d], qn); }
            const float eb = __expf(bs[j]); num *= eb; qn *= eb;
            for (int s = 0; s <= j; ++s) { const float a = A[j * 128 + s]; num = fmaf(a, vt[s * 64 + e], num); sa += a; }
            const float hv = num / fmaxf(fabsf(qn + sa), 1.f);
            const float r = rsqrtf(wave_sum(hv * hv) * (1.f / 64.f) + EPS);
            const size_t row = (size_t)(m0 + j);
            Y[row * D + 512 + h * 64 + e] = (bf16_t)f2bf(sigmoid_f(bf2f(PROJ[row * PW + P_CO + h * 64 + e])) * hv * r * gn);
        }
        __syncthreads();
    }
}
typedef float f32x16 __attribute__((ext_vector_type(16)));
constexpr size_t WS_VT = WS_BIG + 120 * MiB;
constexpr float LOG2E = 1.4426950408889634f;

__device__ __forceinline__ void attn_mfma(Frame& F, int l) {
    const unsigned long long* MASKT = (const unsigned long long*)WSP(WS_MASK); const bf16_t* PROJ = (const bf16_t*)WSP(WS_BIG); const bf16_t* VT = (const bf16_t*)WSP(WS_VT);
    bf16_t* Y = (bf16_t*)WSP(WS_Y); const float* gt = (const float*)WSP(WS_GT) + l * 192;
    const int lane = F.lane, r32 = lane & 31, hi = lane >> 5, grp = F.wave >> 2, w4 = F.wave & 3, lg = F.tid & 255;
    const float mq = wave_max(fabsf(gt[lane])), mk = wave_max(fabsf(gt[64 + lane]));
    const float c1 = 0.125f * LOG2E, c2 = 8.f * mq * mk * 1.01f * LOG2E;
    constexpr int ROWB = 144, TILEB = 64 * ROWB;
    LAS unsigned char* gb = F.lds + grp * 4 * TILEB;
    LAS float* comb = (LAS float*)(F.lds + 8 * TILEB);
    const int srow0 = lg >> 3, sc0 = lg & 7;
    for (int item = F.vcu; item < 256; item += F.G) {
        const int bh = item >> 4, sidx = item & 15, b = bh >> 2, h = bh & 3;
#pragma unroll 1
        for (int half = 0; half < 2; ++half) {
            const int qb = half == 0 ? sidx : 31 - sidx, q0 = qb * 128, ntl = qb + 1;
            const int qrow = b * S + q0 + w4 * 32 + r32, tq = q0 + w4 * 32 + r32;
            bf16x8 qf[4];
#pragma unroll
            for (int s = 0; s < 4; ++s) qf[s] = *(const bf16x8*)(PROJ + (size_t)qrow * PW + P_Q + h * 64 + 16 * s + 8 * hi);
            f32x16 o0, o1;
#pragma unroll
            for (int r = 0; r < 16; ++r) { o0[r] = 0.f; o1[r] = 0.f; }
            float lsum = 0.f;
            const bf16_t* kbase = PROJ + (size_t)(b * S + srow0) * PW + P_K + h * 64 + sc0 * 8;
            const bf16_t* vbase = VT + (size_t)(b * 256 + h * 64 + srow0) * S + sc0 * 8;
            const unsigned long long* mbase = MASKT + (size_t)(b * 64) * S + tq;
            u32x4 kr0, kr1, vr0, vr1; unsigned long long mw, mwn = 0ull;
            { const int t = grp; kr0 = *(const u32x4*)(kbase + (size_t)t * 64 * PW); kr1 = *(const u32x4*)(kbase + (size_t)(t * 64 + 32) * PW);
              vr0 = *(const u32x4*)(vbase + t * 64); vr1 = *(const u32x4*)(vbase + 32 * S + t * 64); mw = mbase[(size_t)t * S];
              LAS unsigned char* kb = gb; LAS unsigned char* vb = gb + TILEB;
              *(LAS u32x4*)(kb + srow0 * ROWB + sc0 * 16) = kr0; *(LAS u32x4*)(kb + (srow0 + 32) * ROWB + sc0 * 16) = kr1;
              *(LAS u32x4*)(vb + srow0 * ROWB + sc0 * 16) = vr0; *(LAS u32x4*)(vb + (srow0 + 32) * ROWB + sc0 * 16) = vr1; }
            __syncthreads();
#pragma unroll 1
            for (int i = 0; i < ntl; ++i) {
                const int cur = i & 1; const bool more = (i + 1 < ntl);
                if (more) { const int t = 2 * (i + 1) + grp; kr0 = *(const u32x4*)(kbase + (size_t)t * 64 * PW); kr1 = *(const u32x4*)(kbase + (size_t)(t * 64 + 32) * PW);
                    vr0 = *(const u32x4*)(vbase + t * 64); vr1 = *(const u32x4*)(vbase + 32 * S + t * 64); mwn = mbase[(size_t)t * S]; }
                const LAS unsigned char* kb = gb + cur * 2 * TILEB; const LAS unsigned char* vb = kb + TILEB;
                f32x16 p0, p1;
#pragma unroll
                for (int r = 0; r < 16; ++r) { p0[r] = 0.f; p1[r] = 0.f; }
#pragma unroll
                for (int s = 0; s < 4; ++s) {
                    const bf16x8 k0 = *(const LAS bf16x8*)(kb + r32 * ROWB + 32 * s + 16 * hi), k1 = *(const LAS bf16x8*)(kb + (32 + r32) * ROWB + 32 * s + 16 * hi);
                    p0 = __builtin_amdgcn_mfma_f32_32x32x16_bf16(k0, qf[s], p0, 0, 0, 0); p1 = __builtin_amdgcn_mfma_f32_32x32x16_bf16(k1, qf[s], p1, 0, 0, 0);
                }
                const unsigned sh0 = (unsigned)mw >> (4 * hi), sh1 = (unsigned)(mw >> 32) >> (4 * hi);
#pragma unroll
                for (int r = 0; r < 16; ++r) { const int cb = (r & 3) + 8 * (r >> 2);
                    const float e0 = __builtin_amdgcn_exp2f(p0[r] * c1 - c2), e1 = __builtin_amdgcn_exp2f(p1[r] * c1 - c2);
                    p0[r] = ((sh0 >> cb) & 1u) ? e0 : 0.f; p1[r] = ((sh1 >> cb) & 1u) ? e1 : 0.f; lsum += p0[r] + p1[r]; }
#pragma unroll
                for (int ks = 0; ks < 4; ++ks) {
                    u32x4 pw;
                    if (ks < 2) { pw.x = cvt_pk_bf16(p0[8 * ks + 0], p0[8 * ks + 1]); pw.y = cvt_pk_bf16(p0[8 * ks + 2], p0[8 * ks + 3]); pw.z = cvt_pk_bf16(p0[8 * ks + 4], p0[8 * ks + 5]); pw.w = cvt_pk_bf16(p0[8 * ks + 6], p0[8 * ks + 7]); }
                    else { const int k2 = ks - 2; pw.x = cvt_pk_bf16(p1[8 * k2 + 0], p1[8 * k2 + 1]); pw.y = cvt_pk_bf16(p1[8 * k2 + 2], p1[8 * k2 + 3]); pw.z = cvt_pk_bf16(p1[8 * k2 + 4], p1[8 * k2 + 5]); pw.w = cvt_pk_bf16(p1[8 * k2 + 6], p1[8 * k2 + 7]); }
                    const bf16x8 pf = __builtin_bit_cast(bf16x8, pw);
                    const int vo = 64 * (ks >> 1) + 32 * (ks & 1) + 8 * hi;
                    const u32x2 a0 = *(const LAS u32x2*)(vb + r32 * ROWB + vo), a1 = *(const LAS u32x2*)(vb + r32 * ROWB + vo + 16);
                    const u32x2 b0 = *(const LAS u32x2*)(vb + (32 + r32) * ROWB + vo), b1 = *(const LAS u32x2*)(vb + (32 + r32) * ROWB + vo + 16);
                    const u32x4 va = {a0.x, a0.y, a1.x, a1.y}, vb4 = {b0.x, b0.y, b1.x, b1.y};
                    o0 = __builtin_amdgcn_mfma_f32_32x32x16_bf16(__builtin_bit_cast(bf16x8, va), pf, o0, 0, 0, 0);
                    o1 = __builtin_amdgcn_mfma_f32_32x32x16_bf16(__builtin_bit_cast(bf16x8, vb4), pf, o1, 0, 0, 0);
                }
                if (more) { LAS unsigned char* kn = gb + (cur ^ 1) * 2 * TILEB; LAS unsigned char* vn = kn + TILEB;
                    *(LAS u32x4*)(kn + srow0 * ROWB + sc0 * 16) = kr0; *(LAS u32x4*)(kn + (srow0 + 32) * ROWB + sc0 * 16) = kr1;
                    *(LAS u32x4*)(vn + srow0 * ROWB + sc0 * 16) = vr0; *(LAS u32x4*)(vn + (srow0 + 32) * ROWB + sc0 * 16) = vr1; mw = mwn; }
                __syncthreads();
            }
            if (grp == 1) { LAS float* cw = comb + w4 * 33 * 64 + lane;
#pragma unroll
                for (int r = 0; r < 16; ++r) { cw[r * 64] = o0[r]; cw[(16 + r) * 64] = o1[r]; }
                cw[32 * 64] = lsum; }
            __syncthreads();
            if (grp == 0) { const LAS float* cw = comb + w4 * 33 * 64 + lane;
#pragma unroll
                for (int r = 0; r < 16; ++r) { o0[r] += cw[r * 64]; o1[r] += cw[(16 + r) * 64]; }
                lsum += cw[32 * 64]; lsum += __shfl_xor(lsum, 32); const float inv = 1.f / lsum;
                bf16_t* yp = Y + (size_t)qrow * D + 256 + h * 64 + 4 * hi;
#pragma unroll
                for (int g4 = 0; g4 < 4; ++g4) { u32x2 w0, w1;
                    w0.x = cvt_pk_bf16(o0[4 * g4] * inv, o0[4 * g4 + 1] * inv); w0.y = cvt_pk_bf16(o0[4 * g4 + 2] * inv, o0[4 * g4 + 3] * inv);
                    w1.x = cvt_pk_bf16(o1[4 * g4] * inv, o1[4 * g4 + 1] * inv); w1.y = cvt_pk_bf16(o1[4 * g4 + 2] * inv, o1[4 * g4 + 3] * inv);
                    *(u32x2*)(yp + 8 * g4) = w0; *(u32x2*)(yp + 32 + 8 * g4) = w1; } }
            __syncthreads();
        }
    }
}

constexpr size_t WS_KI = 234 * MiB;
__device__ __forceinline__ void indexer_mfma(Frame& F) {
    const float* MISC = (const float*)WSP(WS_MISC); unsigned long long* MASKT = (unsigned long long*)WSP(WS_MASK); const bf16_t* PROJ = (const bf16_t*)WSP(WS_BIG); const bf16_t* KI = (const bf16_t*)WSP(WS_KI);
    LAS float* sc = (LAS float*)F.lds;
    const int lane = F.lane, r32 = lane & 31, hi = lane >> 5, wv = F.wave;
    for (int pi = F.vcu; pi < 1024; pi += F.G) {
        const int b = pi >> 8, pp = pi & 255;
#pragma unroll 1
        for (int half = 0; half < 2; ++half) {
            const int t0 = 8 * (half == 0 ? pp : 511 - pp), m0 = b * S + t0, tq = t0 + wv;
            unsigned long long myword = 0ull;
            if (t0 + 8 <= 256) {
                const int lo = 64 * lane; myword = (tq >= lo + 63) ? ~0ull : (tq < lo ? 0ull : ((2ull << (tq - lo)) - 1ull));
                MASKT[(size_t)(b * 64 + lane) * S + tq] = myword;
                continue;
            }
            const int nmax = t0 + 8, ntile = (nmax + 31) >> 5;
            bf16x8 qa[2][4]; float wq[2][4][4];
#pragma unroll
            for (int i = 0; i < 2; ++i) {
                const bf16_t* qp = PROJ + (size_t)(m0 + 4 * i + (r32 >> 3)) * PW + P_QI + (r32 & 7) * 64 + 8 * hi;
#pragma unroll
                for (int s = 0; s < 4; ++s) qa[i][s] = *(const bf16x8*)(qp + 16 * s);
#pragma unroll
                for (int qq = 0; qq < 4; ++qq) { const f32x4 w4 = *(const f32x4*)(MISC + (size_t)(m0 + 4 * i + qq) * 16 + 4 * hi);
#pragma unroll
                    for (int e = 0; e < 4; ++e) wq[i][qq][e] = w4[e] * (0.125f * 0.35355339059327373f); }
            }
            for (int j = wv; j < ntile; j += 8) {
                const int key = 32 * j + r32; const int krow = key < nmax ? key : nmax - 1;
                const bf16_t* kp = KI + (size_t)(b * S + krow) * 64 + 8 * hi;
                bf16x8 kb[4];
#pragma unroll
                for (int s = 0; s < 4; ++s) kb[s] = *(const bf16x8*)(kp + 16 * s);
#pragma unroll
                for (int i = 0; i < 2; ++i) {
                    f32x16 d;
#pragma unroll
                    for (int r = 0; r < 16; ++r) d[r] = 0.f;
#pragma unroll
                    for (int s = 0; s < 4; ++s) d = __builtin_amdgcn_mfma_f32_32x32x16_bf16(qa[i][s], kb[s], d, 0, 0, 0);
                    float part[4];
#pragma unroll
                    for (int qq = 0; qq < 4; ++qq) { float a = 0.f;
#pragma unroll
                        for (int e = 0; e < 4; ++e) a = fmaf(wq[i][qq][e], fmaxf(d[4 * qq + e], 0.f), a);
                        part[qq] = a; }
                    auto s01 = __builtin_amdgcn_permlane32_swap(__float_as_uint(part[0]), __float_as_uint(part[1]), false, false);
                    auto s23 = __builtin_amdgcn_permlane32_swap(__float_as_uint(part[2]), __float_as_uint(part[3]), false, false);
                    const float v01 = __uint_as_float(s01[0]) + __uint_as_float(s01[1]), v23 = __uint_as_float(s23[0]) + __uint_as_float(s23[1]);
                    const int qA = 4 * i + hi, qB = 4 * i + 2 + hi;
                    sc[qA * 4096 + key] = (key <= t0 + qA) ? v01 : -INFINITY;
                    sc[qB * 4096 + key] = (key <= t0 + qB) ? v23 : -INFINITY;
                }
            }
            __syncthreads();
            unsigned kk[64]; const int nvalid = 32 * ntile;
#pragma unroll
            for (int r = 0; r < 64; ++r) { const int idx = 64 * r + lane; kk[r] = (idx < nvalid) ? fkey(sc[wv * 4096 + (idx < nvalid ? idx : 0)]) : 0u; }
            const int nreg = (nvalid + 63) >> 6;
            unsigned Tk = 0u;
            for (int bit = 31; bit >= 0; --bit) {
                const unsigned cand = Tk | (1u << bit); int c = 0;
#pragma unroll
                for (int blk = 0; blk < 4; ++blk) if (nreg > 16 * blk) {
#pragma unroll
                    for (int r = 16 * blk; r < 16 * blk + 16; ++r) c += __builtin_popcountll(__ballot(kk[r] >= cand)); }
                if (c >= 256) Tk = cand;
            }
            int ngt = 0, neq = 0;
#pragma unroll
            for (int r = 0; r < 64; ++r) { ngt += __builtin_popcountll(__ballot(kk[r] > Tk)); neq += __builtin_popcountll(__ballot(kk[r] == Tk)); }
            const bool all_eq = (ngt + neq == 256); int need = 256 - ngt;
#pragma unroll
            for (int r = 0; r < 64; ++r) {
                unsigned long long wsel = __ballot(kk[r] > Tk), em = __ballot(kk[r] == Tk);
                if (all_eq) wsel |= em;
                else if (em != 0ull && need > 0) { int c = __builtin_popcountll(em); while (c > need) { em &= ~(1ull << (63 - __builtin_clzll(em))); --c; } need -= c; wsel |= em; }
                if (lane == r) myword = wsel;
            }
            MASKT[(size_t)(b * 64 + lane) * S + tq] = myword;
            __syncthreads();
        }
    }
}
#ifndef MK_MULTI
#define MK_MULTI 0
#endif
constexpr int N_PHASES = 1 + 8 * DEPTH;

__global__ void __launch_bounds__(NT, 2) mk_fwd(Args args) {
    extern __shared__ __attribute__((aligned(16))) unsigned char lds_raw[];
    Frame F;
    F.lds = (LAS unsigned char*)lds_raw; F.tid = threadIdx.x; F.lane = F.tid & 63; F.wave = __builtin_amdgcn_readfirstlane(F.tid >> 6);
    F.G = gridDim.x; { const int bx_ = blockIdx.x; F.vcu = (F.G % 8 == 0) ? (bx_ % 8) * (F.G / 8) + bx_ / 8 : bx_; }
    if (F.tid < 20) { const unsigned long long pv = F.tid < 18 ? (unsigned long long)args.in[F.tid < 18 ? F.tid : 0] : (F.tid == 18 ? (unsigned long long)args.out : (unsigned long long)args.ws);
        *(LAS unsigned long long*)(F.lds + PTR_OFF + 8 * F.tid) = pv; }
    if (F.tid < 2) *(LAS unsigned*)(F.lds + PTR_OFF + 256 + 4 * F.tid) = 0u;
    __syncthreads();
    XcdBarrier xbar; xbar.bar = (unsigned*)(args.ws + WS_BAR); xbar.x = 0; xbar.st = (volatile LAS unsigned*)(F.lds + PTR_OFF + 256);
    if (args.coop) xbar = xcd_barrier_post((unsigned*)(args.ws + WS_BAR), (volatile LAS unsigned*)(F.lds + PTR_OFF + 256));
    const int lo = args.ph_lo, hi = args.ph_hi; const bool coop = args.coop != 0;
#define RUN(k) (lo <= (k) && (k) < hi)
#define LAUNDER() asm volatile("" : "+v"(F.tid), "+v"(F.lane))
#define SEAM(k) do { if (coop && RUN(k) && RUN((k) + 1)) { if ((k) == 0) cg::this_grid().sync(); else xcd_barrier(xbar); } } while (0)
    const int bx = (int)blockIdx.x;

    if (RUN(0)) { LAUNDER(); convert_mix_weights(F, 0); prologue_rows(F);
        if (blockIdx.x == 0 && F.tid < DEPTH * 192) { const int l_ = F.tid / 192, r_ = F.tid % 192, w_ = r_ / 64, i_ = r_ % 64; ((float*)WSP(WS_GT))[F.tid] = INP(I_Q_NORM + w_)[l_ * 64 + i_]; } }
    SEAM(0);
#pragma unroll 1
    for (int l = 0; l < DEPTH; ++l) {
        const int pb = 1 + 8 * l;
        if (RUN(pb + 0)) { LAUNDER();
            pg8::Gemm<D, D, D, 256u * D * 2, 0, 256u * D * 2, 0> g{(const bf16_t*)WSP(WS_XG), (const bf16_t*)WSP(WS_WIN)};
            pg8::StaticOrder So; So.init(M, PW, F.G, bx);
            epi::EpiProj E{(bf16_t*)WSP(WS_BIG), (float*)WSP(WS_MISC), (const float*)WSP(WS_SSQA), (const float*)WSP(WS_COS), (const float*)WSP(WS_SIN), (const float*)WSP(WS_GT) + l * 192, (bf16_t*)WSP(WS_VT), (bf16_t*)WSP(WS_KI)};
            pg8::gemm_phase<epi::EpiProj, pg8::StaticOrder, true>(F.lds, g, So, E, F.tid);
        }
        SEAM(pb + 0);
        if (RUN(pb + 1)) { LAUNDER(); sgu_simple(F, l); conv_simple(F, l); indexer_mfma(F); mlstm1_simple(F, l); }
        SEAM(pb + 1);
        if (RUN(pb + 2)) { LAUNDER(); attn_mfma(F, l); mlstm2_simple(F, l); }
        SEAM(pb + 2);
        if (RUN(pb + 3)) { LAUNDER();
            pg8::Gemm<256, D, 256, 256u * D * 2, 256u * 2, 256u * 256 * 2, 1024u * 256 * 2> g{(const bf16_t*)WSP(WS_Y), (const bf16_t*)WSP(WS_WBR)};
            pg8::SuperOrder<0> So; So.init(F.G, bx);
            epi::EpiPlain E{(bf16_t*)WSP(WS_BIG), 4096, 1024};
            pg8::gemm_phase<epi::EpiPlain, pg8::SuperOrder<0>, true>(F.lds, g, So, E, F.tid);
        }
        SEAM(pb + 3);
        if (RUN(pb + 4)) { LAUNDER();
            pg8::Gemm<D, D, D, 256u * D * 2, 0, 256u * D * 2, 0> g{(const bf16_t*)WSP(WS_XG), (const bf16_t*)WSP(WS_WG)};
            pg8::SuperOrder<1> So; So.init(F.G, bx);
            epi::EpiGate E{(bf16_t*)WSP(WS_MG), (const bf16_t*)WSP(WS_BIG), (const float*)WSP(WS_SSQA)};
            pg8::gemm_phase<epi::EpiGate, pg8::SuperOrder<1>, true>(F.lds, g, So, E, F.tid);
            __syncthreads();
            convert_mlp_weights(F, l);
        }
        SEAM(pb + 4);
        if (RUN(pb + 5)) { LAUNDER();
            pg8::Gemm<D, D, D, 256u * D * 2, 0, 256u * D * 2, 0> g{(const bf16_t*)WSP(WS_MG), (const bf16_t*)WSP(WS_WOUT)};
            pg8::StaticOrder So; So.init(M, D, F.G, bx);
            float* outp = (float*)ptr_at(F, I_OUT); epi::EpiResid E{l == 0 ? INP(I_X) : (const float*)outp, outp, (bf16_t*)WSP(WS_XG), INP(I_LN_MLP) + l * D, (float*)WSP(WS_SSQB)};
            pg8::gemm_phase<epi::EpiResid, pg8::StaticOrder, true>(F.lds, g, So, E, F.tid);
        }
        SEAM(pb + 5);
        if (RUN(pb + 6)) { LAUNDER();
            pg8::Gemm<D, D, D, 256u * D * 2, 0, 256u * D * 2, 0> g{(const bf16_t*)WSP(WS_XG), (const bf16_t*)WSP(WS_WUP)};
            pg8::StaticOrder So; So.init(M, FF, F.G, bx);
            epi::EpiUp E{(bf16_t*)WSP(WS_BIG), (const float*)WSP(WS_SSQB)};
            pg8::gemm_phase<epi::EpiUp, pg8::StaticOrder, true>(F.lds, g, So, E, F.tid);
            if (l + 1 < DEPTH) { __syncthreads(); convert_mix_weights(F, l + 1); }
        }
        SEAM(pb + 6);
        if (RUN(pb + 7)) { LAUNDER();
            pg8::Gemm<FF, FF, FF, 256u * FF * 2, 0, 256u * FF * 2, 0> g{(const bf16_t*)WSP(WS_BIG), (const bf16_t*)WSP(WS_WDN)};
            pg8::StaticOrder So; So.init(M, D, F.G, bx);
            float* outp = (float*)ptr_at(F, I_OUT); epi::EpiResid E{(const float*)outp, outp, (bf16_t*)WSP(WS_XG), (l + 1 < DEPTH) ? INP(I_LN_MIX) + (l + 1) * D : nullptr, (float*)WSP(WS_SSQA)};
            pg8::gemm_phase<epi::EpiResid, pg8::StaticOrder, true>(F.lds, g, So, E, F.tid);
        }
        SEAM(pb + 7);
    }
#undef RUN
#undef SEAM
}

extern "C" void kernel_launch(void* const* d_in, const int* in_sizes, int n_in, void* d_out, int out_size, void* d_ws, size_t ws_size, hipStream_t stream) {
    static int grid = 0;
    if (grid == 0) {
        if (n_in != 18 || in_sizes[0] != M * D || out_size != M * D || ws_size < WS_END) { fprintf(stderr, "kernel_launch: unexpected shapes (n_in %d, in0 %d, out %d, ws %zu)\n", n_in, n_in > 0 ? in_sizes[0] : -1, out_size, ws_size); grid = -1; return; }
        int dev = 0, cus = 0, per_cu = 0;
        if (hipGetDevice(&dev) != hipSuccess || hipDeviceGetAttribute(&cus, hipDeviceAttributeMultiprocessorCount, dev) != hipSuccess) { grid = -1; return; }
        if (hipFuncSetAttribute((const void*)mk_fwd, hipFuncAttributeMaxDynamicSharedMemorySize, LDS_BYTES) != hipSuccess) { fprintf(stderr, "kernel_launch: hipFuncSetAttribute failed\n"); grid = -1; return; }
        if (hipOccupancyMaxActiveBlocksPerMultiprocessor(&per_cu, (const void*)mk_fwd, NT, LDS_BYTES) != hipSuccess || per_cu < 1) { fprintf(stderr, "kernel_launch: occupancy query says %d\n", per_cu); (void)hipGetLastError(); per_cu = 1; }
        grid = cus;
    }
    if (grid < 0) return;
    if (hipMemsetAsync((char*)d_ws + WS_CTL, 0, CTL_ZERO_BYTES, stream) != hipSuccess) { fprintf(stderr, "kernel_launch: memset failed\n"); return; }
    Args a{};
    for (int i = 0; i < 18; ++i) a.in[i] = (const float*)d_in[i];
    a.out = (float*)d_out; a.ws = (unsigned char*)d_ws;
#if MK_MULTI
    for (int p = 0; p < N_PHASES; ++p) { a.ph_lo = p; a.ph_hi = p + 1; a.coop = 0; hipLaunchKernelGGL(mk_fwd, dim3(grid), dim3(NT), LDS_BYTES, stream, a); }
#else
    a.ph_lo = 0; a.ph_hi = N_PHASES; a.coop = 1;
    void* kargs[] = {&a};
    hipError_t e = hipLaunchCooperativeKernel((const void*)mk_fwd, dim3(grid), dim3(NT), kargs, LDS_BYTES, stream);
    if (e != hipSuccess) fprintf(stderr, "kernel_launch: cooperative launch failed: %s (grid %d)\n", hipGetErrorString(e), grid);
#endif
}
```

```cpp
#define MK_MULTI 0
#include <hip/hip_runtime.h>
#include <hip/hip_cooperative_groups.h>
#include <cstdio>
#include <cstdint>
namespace cg = cooperative_groups;

#define LAS __attribute__((address_space(3)))
typedef unsigned short bf16_t;
typedef short bf16x8 __attribute__((ext_vector_type(8)));
typedef float f32x4 __attribute__((ext_vector_type(4)));
typedef float f32x2 __attribute__((ext_vector_type(2)));
typedef unsigned u32x4 __attribute__((ext_vector_type(4)));
typedef unsigned u32x2 __attribute__((ext_vector_type(2)));

constexpr int D = 1024, NB = 4, S = 4096, M = NB * S, DEPTH = 2, FF = 4096, INW = 7760;
constexpr int O_AU = 0, O_AV = 256, O_BQ = 512, O_BK = 768, O_BV = 1024, O_QI = 1280, O_KI = 1792, O_WI = 1856,
              O_CQ = 1864, O_CK = 2120, O_CV = 2376, O_CO = 2632, O_CI = 2888, O_CF = 2892, O_DB = 2896, O_DC = 3152, O_DX = 3408, O_G = 3664;
constexpr int PW = 3840;
constexpr int P_AU = 0, P_AV = 256, P_Q = 512, P_K = 768, P_V = 1024, P_QI = 1280, P_CQ = 1792, P_CK = 2048, P_CV = 2304, P_CO = 2560,
              P_DB = 2816, P_DC = 3072, P_DX = 3328, P_KI = 3584;
constexpr float EPS = 1e-6f;
constexpr int NWAVES = 8, NT = 512;

constexpr size_t MiB = 1u << 20;
constexpr size_t WS_CTL = 0;
constexpr size_t WS_COS = 1 * MiB, WS_SIN = 1 * MiB + 512 * 1024;
constexpr size_t WS_MISC = 2 * MiB;
constexpr size_t WS_SSQA = 3 * MiB, WS_SSQB = 4 * MiB;
constexpr size_t WS_WIN = 5 * MiB;
constexpr size_t WS_WG = WS_WIN + (size_t)PW * D * 2;
constexpr size_t WS_WBR = WS_WG + (size_t)4096 * D * 2;
constexpr size_t WS_WOUT = WS_WBR + (size_t)4 * 1024 * 256 * 2;
constexpr size_t WS_XG = 25 * MiB;
constexpr size_t WS_BIG = 57 * MiB;
constexpr size_t WS_Y = 185 * MiB;
constexpr size_t WS_WUP = WS_Y, WS_WDN = WS_Y + 8 * MiB;
constexpr size_t WS_MG = 217 * MiB;
constexpr size_t WS_MASK = WS_MG, WS_STATE = WS_MG + 8 * MiB;
constexpr size_t WS_END = 249 * MiB;
constexpr int STATE_STRIDE = 4224;
static_assert(WS_WOUT + (size_t)D * D * 2 <= WS_XG && WS_STATE + (size_t)512 * STATE_STRIDE * 4 <= WS_END && WS_END <= 256 * MiB, "d_ws map");

constexpr int LDS_BYTES = 155648;

__device__ __forceinline__ float bf2f(bf16_t v) { return __uint_as_float((unsigned)v << 16); }
__device__ __forceinline__ unsigned f2bf(float f) { unsigned u = __float_as_uint(f); return (u + 0x7fffu + ((u >> 16) & 1u)) >> 16; }
__device__ __forceinline__ unsigned pk2(float lo, float hi) { return f2bf(lo) | (f2bf(hi) << 16); }
__device__ __forceinline__ unsigned cvt_pk_bf16(float lo, float hi) { unsigned r; asm volatile("v_cvt_pk_bf16_f32 %0, %1, %2" : "=v"(r) : "v"(lo), "v"(hi)); return r; }
__device__ __forceinline__ float lo_bf(unsigned w) { return __uint_as_float(w << 16); }
__device__ __forceinline__ float hi_bf(unsigned w) { return __uint_as_float(w & 0xffff0000u); }
__device__ __forceinline__ float wave_sum(float v) {
#pragma unroll
    for (int o = 1; o < 64; o <<= 1) v += __shfl_xor(v, o);
    return v;
}
__device__ __forceinline__ float wave_max(float v) {
#pragma unroll
    for (int o = 1; o < 64; o <<= 1) v = fmaxf(v, __shfl_xor(v, o));
    return v;
}
__device__ __forceinline__ int wave_sum_i(int v) {
#pragma unroll
    for (int o = 1; o < 64; o <<= 1) v += __shfl_xor(v, o);
    return v;
}
__device__ __forceinline__ float sigmoid_f(float x) { return 1.f / (1.f + __expf(-x)); }
__device__ __forceinline__ float gelu_tanh_f(float x) { const float u = 0.7978845608028654f * (x + 0.044715f * x * x * x); return x / (1.f + __expf(-2.f * u)); }
__device__ __forceinline__ unsigned fkey(float s) { const unsigned u = __float_as_uint(s); return (u & 0x80000000u) ? ~u : (u | 0x80000000u); }

namespace pg8 {
constexpr int BM = 256, BK = 64, HALF = 128, HTB = HALF * BK * 2, STAGE_BYTES = 8 * HTB, NXCD = 8, WGM = 8;
__host__ __device__ __forceinline__ int lds_byte(int r, int c) { const int st = (r >> 4) * 2 + (c >> 5), rr = r & 15, cc = c & 31, ob = rr * 64 + cc * 2; return st * 1024 + (ob ^ (((ob >> 9) & 1) << 5)); }
__host__ __device__ __forceinline__ void stage_rc(int b, int& R, int& C) { const int st = b / 1024, sb = b % 1024, swz = sb ^ (((sb >> 9) & 1) << 5); R = (st >> 1) * 16 + swz / 64; C = (st & 1) * 32 + (swz % 64) / 2; }
__host__ __device__ __forceinline__ int perm32(int rho) { const int n = rho >> 4, i = rho & 15; return 8 * (i >> 2) + 4 * n + (i & 3); }

struct Unit { int pm, pn, z; };
template <int K_, int LDA_, int LDB_, unsigned APM_, unsigned AZ_, unsigned BPN_, unsigned BZ_> struct Gemm {
    const bf16_t* A; const bf16_t* Bt;
    static constexpr int K = K_, lda = LDA_, ldb = LDB_; static constexpr unsigned aPm = APM_, aZ = AZ_, bPn = BPN_, bZ = BZ_;
};
template <class G> __device__ __forceinline__ const char* pa(const G& g, const Unit& u) { return (const char*)g.A + (size_t)((unsigned)u.pm * G::aPm + (unsigned)u.z * G::aZ); }
template <class G> __device__ __forceinline__ const char* pb(const G& g, const Unit& u) { return (const char*)g.Bt + (size_t)((unsigned)u.pn * G::bPn + (unsigned)u.z * G::bZ); }

struct StaticOrder {
    int nM, nN, nwg, G, c;
    __host__ __device__ void init(int M_, int N_, int G_, int c_) { nM = M_ / BM; nN = N_ / BM; nwg = nM * nN; G = G_; c = c_; }
    __host__ __device__ bool next(int i, Unit& u) const {
        const long L = (long)i * G + c; if (L >= nwg) return false;
        int wgid = (int)L; { const int q = nwg / NXCD, r = nwg % NXCD, xcd = wgid % NXCD, off = wgid / NXCD; wgid = (xcd < r ? xcd * (q + 1) : r * (q + 1) + (xcd - r) * q) + off; }
        const int nig = WGM * nN, gid = wgid / nig, fm = gid * WGM, gsz = (nM - fm) < WGM ? (nM - fm) : WGM;
        u.pm = fm + ((wgid % nig) % gsz); u.pn = (wgid % nig) / gsz; u.z = 0; return true;
    }
};
template <int MODE> struct SuperOrder {
    StaticOrder so;
    __host__ __device__ void init(int G_, int c_) { so.init(M, 1024, G_, c_); }
    __host__ __device__ bool next(int i, Unit& u) const {
        Unit b; if (!so.next(i >> 2, b)) return false;
        const int sub = i & 3; u.pm = b.pm; if (MODE == 0) { u.pn = b.pn; u.z = sub; } else { u.pn = 4 * b.pn + sub; u.z = 0; } return true;
    }
};

template <class Epi, class Sched, bool ALIGN_EPI, class GemmT>
__device__ __forceinline__ void gemm_phase(LAS unsigned char* lds, const GemmT g, const Sched& S, const Epi& E, const int tid) {
    const int wid = __builtin_amdgcn_readfirstlane(tid >> 6), lane = tid & 63, wr = wid >> 2, wc = wid & 3, fr = lane & 15, fq = lane >> 4;
    constexpr int K = GemmT::K, nt = K / BK;
    unsigned voffA[2], voffB[2];
#pragma unroll
    for (int i = 0; i < 2; ++i) { int R, C; stage_rc(tid * 16 + i * 8192, R, C); const int Rb = Epi::PERM ? ((R & ~31) + perm32(R & 31)) : R;
        voffA[i] = (unsigned)(R * GemmT::lda + C) * 2u; voffB[i] = (unsigned)(Rb * GemmT::ldb + C) * 2u; }
    const size_t kstep = (size_t)(BK * 2);
    constexpr size_t hA = (size_t)HALF * GemmT::lda * 2, hB = (size_t)HALF * GemmT::ldb * 2;
    const unsigned ldsw = (unsigned)wid * 1024u;
    const int aoff = lds_byte(wr * 64 + fr, fq * 8), boff = lds_byte(wc * 32 + fr, fq * 8);
#define PG8_SA(b, h) (((b) * 2 + (h)) * HTB)
#define PG8_SB(b, h) ((4 + (b) * 2 + (h)) * HTB)
#define PG8_STAGE(bufoff, gbase, voff) do { _Pragma("unroll") for (int _i = 0; _i < 2; ++_i) \
        __builtin_amdgcn_global_load_lds((const unsigned*)((const char*)(gbase) + (voff)[_i]), (LAS unsigned*)(lds + (bufoff) + ldsw + _i * 8192), 16, 0, 0); } while (0)
#define PG8_LDA(dst, b, h) do { _Pragma("unroll") for (int m = 0; m < 4; ++m) _Pragma("unroll") for (int k = 0; k < 2; ++k) dst[m][k] = *(const LAS bf16x8*)(lds + PG8_SA(b, h) + aoff + m * 2048 + k * 1024); } while (0)
#define PG8_LDB(dst, b, h) do { _Pragma("unroll") for (int n = 0; n < 2; ++n) _Pragma("unroll") for (int k = 0; k < 2; ++k) dst[n][k] = *(const LAS bf16x8*)(lds + PG8_SB(b, h) + boff + n * 2048 + k * 1024); } while (0)
#define PG8_MMA(ai, bj, At, Bt) do { __builtin_amdgcn_s_setprio(1); _Pragma("unroll") for (int m = 0; m < 4; ++m) _Pragma("unroll") for (int n = 0; n < 2; ++n) _Pragma("unroll") for (int k = 0; k < 2; ++k) \
        acc[ai][bj][m][n] = __builtin_amdgcn_mfma_f32_16x16x32_bf16(Bt[n][k], At[m][k], acc[ai][bj][m][n], 0, 0, 0); __builtin_amdgcn_s_setprio(0); } while (0)
#define PG8_WAIT_V(n) asm volatile("s_waitcnt vmcnt(" #n ")" ::: "memory")
#define PG8_WAIT_L(n) asm volatile("s_waitcnt lgkmcnt(" #n ")" ::: "memory")
#define PG8_BAR __builtin_amdgcn_s_barrier()
#define PG8_SCHED __builtin_amdgcn_sched_barrier(0)
    Unit cur, nxt; int ui = 0;
    if (!S.next(0, cur)) return;
    f32x4 acc[2][2][4][2];
#pragma unroll
    for (int a = 0; a < 2; ++a)
#pragma unroll
        for (int b = 0; b < 2; ++b)
#pragma unroll
            for (int m = 0; m < 4; ++m)
#pragma unroll
                for (int n = 0; n < 2; ++n) acc[a][b][m][n] = (f32x4){0.f, 0.f, 0.f, 0.f};
    bf16x8 At[4][2], B0[2][2], B1[2][2];
    const char* cA = pa(g, cur); const char* cB = pb(g, cur);
    PG8_STAGE(PG8_SB(0, 0), cB, voffB); PG8_STAGE(PG8_SB(0, 1), cB + hB, voffB); PG8_STAGE(PG8_SA(0, 0), cA, voffA); PG8_STAGE(PG8_SA(0, 1), cA + hA, voffA);
    if (wr == 1) PG8_BAR;
    PG8_WAIT_V(2); PG8_BAR;
    PG8_STAGE(PG8_SB(1, 0), cB + kstep, voffB); PG8_STAGE(PG8_SA(1, 0), cA + kstep, voffA); PG8_STAGE(PG8_SB(1, 1), cB + hB + kstep, voffB);
    PG8_WAIT_V(6); PG8_BAR;
    for (;;) {
        const bool has_next = S.next(ui + 1, nxt);
        const char* nA = has_next ? pa(g, nxt) : cA; const char* nB = has_next ? pb(g, nxt) : cB;
#pragma unroll 1
        for (int t = 0; t < nt; t += 2) {
            const bool last = (t == nt - 2);
            const char* a1 = cA + (size_t)(t + 1) * kstep;
            const char* a2 = last ? nA : cA + (size_t)(t + 2) * kstep; const char* b2 = last ? nB : cB + (size_t)(t + 2) * kstep;
            const char* a3 = a2 + kstep; const char* b3 = b2 + kstep;
            PG8_LDB(B0, 0, 0); PG8_LDB(B1, 0, 1); PG8_SCHED; PG8_LDA(At, 0, 0); PG8_STAGE(PG8_SA(1, 1), a1 + hA, voffA);
            PG8_WAIT_V(8); PG8_WAIT_L(0); PG8_BAR; PG8_MMA(0, 0, At, B0); PG8_MMA(0, 1, At, B1); PG8_BAR; PG8_SCHED;
            PG8_LDA(At, 0, 1); PG8_STAGE(PG8_SB(0, 0), b2, voffB); PG8_STAGE(PG8_SB(0, 1), b2 + hB, voffB); PG8_STAGE(PG8_SA(0, 0), a2, voffA);
            PG8_WAIT_V(8); PG8_WAIT_L(0); PG8_BAR; PG8_MMA(1, 0, At, B0); PG8_MMA(1, 1, At, B1); PG8_BAR; PG8_SCHED;
            PG8_LDB(B0, 1, 0); PG8_LDB(B1, 1, 1); PG8_SCHED; PG8_LDA(At, 1, 0); PG8_STAGE(PG8_SA(0, 1), a2 + hA, voffA);
            PG8_WAIT_V(8); PG8_WAIT_L(0); PG8_BAR; PG8_MMA(0, 0, At, B0); PG8_MMA(0, 1, At, B1); PG8_BAR; PG8_SCHED;
            PG8_LDA(At, 1, 1); PG8_STAGE(PG8_SB(1, 0), b3, voffB); PG8_STAGE(PG8_SB(1, 1), b3 + hB, voffB); PG8_STAGE(PG8_SA(1, 0), a3, voffA);
            PG8_WAIT_V(8); PG8_WAIT_L(0); PG8_BAR; PG8_MMA(1, 0, At, B0); PG8_MMA(1, 1, At, B1); PG8_BAR; PG8_SCHED;
        }
        if constexpr (ALIGN_EPI) { if (wr == 0) PG8_BAR; }
        { int fr2 = fr, fq2 = fq; asm volatile("" : "+v"(fr2), "+v"(fq2)); E(acc, cur, wr, wc, fr2, fq2); }
        if (!has_next) break;
#pragma unroll
        for (int a = 0; a < 2; ++a)
#pragma unroll
            for (int b = 0; b < 2; ++b)
#pragma unroll
                for (int m = 0; m < 4; ++m)
#pragma unroll
                    for (int n = 0; n < 2; ++n) acc[a][b][m][n] = (f32x4){0.f, 0.f, 0.f, 0.f};
        cur = nxt; cA = nA; cB = nB; ++ui;
        if constexpr (ALIGN_EPI) { if (wr == 1) PG8_BAR; }
    }
    PG8_WAIT_V(0);
    if constexpr (!ALIGN_EPI) { if (wr == 0) PG8_BAR; }
    PG8_BAR;
#undef PG8_SA
#undef PG8_SB
#undef PG8_STAGE
#undef PG8_LDA
#undef PG8_LDB
#undef PG8_MMA
#undef PG8_WAIT_V
#undef PG8_WAIT_L
#undef PG8_BAR
#undef PG8_SCHED
}
}
namespace epi {
using pg8::Unit;
typedef f32x4 Acc[2][2][4][2];

__device__ __forceinline__ float row_scale(const float* ssq, int row) {
    const f32x4* sp = (const f32x4*)(ssq + (size_t)row * 16);
    const f32x4 a = sp[0], b = sp[1], c = sp[2], d = sp[3];
    const float t = ((a[0] + a[1]) + (a[2] + a[3])) + ((b[0] + b[1]) + (b[2] + b[3])) + ((c[0] + c[1]) + (c[2] + c[3])) + ((d[0] + d[1]) + (d[2] + d[3]));
    return rsqrtf(t * (1.0f / 1024.0f) + EPS);
}
__device__ __forceinline__ u32x4 pack8(const f32x4 a, const f32x4 b) { u32x4 w; w.x = cvt_pk_bf16(a[0], a[1]); w.y = cvt_pk_bf16(a[2], a[3]); w.z = cvt_pk_bf16(b[0], b[1]); w.w = cvt_pk_bf16(b[2], b[3]); return w; }

struct EpiProj {
    static constexpr bool PERM = true;
    bf16_t* P; float* misc; const float* ssq; const float* cs; const float* sn; const float* gt;     bf16_t* VT;     bf16_t* KI;     bf16_t* CVT;
    __device__ __forceinline__ void operator()(const Acc& acc, const Unit& u, int wr, int wc, int fr, int fq) const {
        const int T = u.pn; const int row0 = u.pm * 256 + wr * 64 + fr;
        if (T == 2 || T == 3 || T == 5 || T == 6 || T == 14) {
            if (T == 14 && wc >= 2) return;
            if (T == 14 && wc == 1) {
                if (fq < 2) {
#pragma unroll
                    for (int ai = 0; ai < 2; ++ai)
#pragma unroll
                        for (int m = 0; m < 4; ++m) { const int row = row0 + ai * 128 + m * 16; const float rs = row_scale(ssq, row);
                            float* mp = misc + (size_t)row * 16 + 8 * fq; *(f32x4*)mp = acc[ai][0][m][0] * rs; *(f32x4*)(mp + 4) = acc[ai][0][m][1] * rs; }
                }
                return;
            }
            const int mode = (T == 14) ? 2 : (T <= 3 ? 1 : 0);
            const float* gp = gt + 64 * ((T == 2) ? 0 : (T == 3) ? 1 : 2);
            f32x4 g1[2], g2[2];
#pragma unroll
            for (int n = 0; n < 2; ++n) { if (mode) { g1[n] = *(const f32x4*)(gp + 8 * fq + 4 * n); g2[n] = *(const f32x4*)(gp + 32 + 8 * fq + 4 * n); } else { g1[n] = (f32x4){1.f, 1.f, 1.f, 1.f}; g2[n] = g1[n]; } }
#pragma unroll
            for (int ai = 0; ai < 2; ++ai)
#pragma unroll
                for (int m = 0; m < 4; ++m) {
                    const int row = row0 + ai * 128 + m * 16; const float rs = row_scale(ssq, row); const int pos = row & (S - 1);
                    f32x4 x1[2], x2[2];
#pragma unroll
                    for (int n = 0; n < 2; ++n) { x1[n] = acc[ai][0][m][n] * rs; x2[n] = acc[ai][1][m][n] * rs; }
                    if (mode == 2) {
                        float s = 0.f;
#pragma unroll
                        for (int n = 0; n < 2; ++n) s += (x1[n][0] + x1[n][1]) + (x1[n][2] + x1[n][3]) + (x2[n][0] + x2[n][1]) + (x2[n][2] + x2[n][3]);
                        s += __shfl_xor(s, 16); s += __shfl_xor(s, 32); const float mu = s * (1.f / 64.f);
#pragma unroll
                        for (int n = 0; n < 2; ++n) { x1[n] = x1[n] - mu; x2[n] = x2[n] - mu; }
                    }
                    if (mode) {
                        float q = 0.f;
#pragma unroll
                        for (int n = 0; n < 2; ++n) { const f32x4 a = x1[n] * x1[n], b = x2[n] * x2[n]; q += (a[0] + a[1]) + (a[2] + a[3]) + (b[0] + b[1]) + (b[2] + b[3]); }
                        q += __shfl_xor(q, 16); q += __shfl_xor(q, 32); const float rr = rsqrtf(q * (1.f / 64.f) + EPS);
#pragma unroll
                        for (int n = 0; n < 2; ++n) { x1[n] = x1[n] * rr * g1[n]; x2[n] = x2[n] * rr * g2[n]; }
                    }
                    f32x4 o1[2], o2[2];
#pragma unroll
                    for (int n = 0; n < 2; ++n) { const f32x4 c = *(const f32x4*)(cs + (size_t)pos * 32 + 8 * fq + 4 * n), s = *(const f32x4*)(sn + (size_t)pos * 32 + 8 * fq + 4 * n);
                        o1[n] = x1[n] * c - x2[n] * s; o2[n] = x2[n] * c + x1[n] * s; }
                    bf16_t* op = P + (size_t)row * PW + 256 * T + 64 * wc + 8 * fq;
                    *(u32x4*)op = pack8(o1[0], o1[1]); *(u32x4*)(op + 32) = pack8(o2[0], o2[1]);
                    if (T == 14) { bf16_t* kp = KI + (size_t)row * 64 + 8 * fq; *(u32x4*)kp = pack8(o1[0], o1[1]); *(u32x4*)(kp + 32) = pack8(o2[0], o2[1]); }
                }
            return;
        }
        const int act = (T <= 1) ? 1 : 0; const float sc = (T == 8) ? 0.125f : 1.0f;
#pragma unroll
        for (int ai = 0; ai < 2; ++ai)
#pragma unroll
            for (int m = 0; m < 4; ++m) {
                const int row = row0 + ai * 128 + m * 16; const float rs = row_scale(ssq, row) * sc;
                bf16_t* op = P + (size_t)row * PW + 256 * T + 32 * wc + 8 * fq;
#pragma unroll
                for (int bj = 0; bj < 2; ++bj) { f32x4 v0 = acc[ai][bj][m][0] * rs, v1 = acc[ai][bj][m][1] * rs;
                    if (act) {
#pragma unroll
                        for (int e = 0; e < 4; ++e) { v0[e] = gelu_tanh_f(v0[e]); v1[e] = gelu_tanh_f(v1[e]); } }
                    *(u32x4*)(op + bj * 128) = pack8(v0, v1);
                    if (T == 4 || T == 9) { bf16_t* vp = (T == 4 ? VT : CVT) + ((size_t)((row >> 12) * 256 + bj * 128 + 32 * wc + 8 * fq)) * S + (row & (S - 1));
#pragma unroll
                        for (int e = 0; e < 4; ++e) { vp[(size_t)e * S] = (bf16_t)f2bf(v0[e]); vp[(size_t)(4 + e) * S] = (bf16_t)f2bf(v1[e]); } } }
            }
    }
};

struct EpiPlain {
    static constexpr bool PERM = true;
    bf16_t* O; int ldc; int zcols;
    __device__ __forceinline__ void operator()(const Acc& acc, const Unit& u, int wr, int wc, int fr, int fq) const {
        const int row0 = u.pm * 256 + wr * 64 + fr; const int col0 = u.z * zcols + u.pn * 256 + 32 * wc + 8 * fq;
#pragma unroll
        for (int ai = 0; ai < 2; ++ai)
#pragma unroll
            for (int m = 0; m < 4; ++m) { bf16_t* op = O + (size_t)(row0 + ai * 128 + m * 16) * ldc + col0;
#pragma unroll
                for (int bj = 0; bj < 2; ++bj) *(u32x4*)(op + bj * 128) = pack8(acc[ai][bj][m][0], acc[ai][bj][m][1]); }
    }
};

struct EpiGate {
    static constexpr bool PERM = true;
    bf16_t* MG; const bf16_t* BR; const float* ssq;
    __device__ __forceinline__ void operator()(const Acc& acc, const Unit& u, int wr, int wc, int fr, int fq) const {
        const int row0 = u.pm * 256 + wr * 64 + fr; const int ch0 = u.pn * 64 + 16 * wc + 4 * fq;
#pragma unroll
        for (int ai = 0; ai < 2; ++ai)
#pragma unroll
            for (int m = 0; m < 4; ++m) {
                const int row = row0 + ai * 128 + m * 16; const float rs = row_scale(ssq, row);
                const bf16_t* bp = BR + (size_t)row * 4096 + ch0; f32x4 o = (f32x4){0.f, 0.f, 0.f, 0.f};
#pragma unroll
                for (int bj = 0; bj < 2; ++bj)
#pragma unroll
                    for (int n = 0; n < 2; ++n) { const u32x2 w = *(const u32x2*)(bp + (2 * bj + n) * 1024); const f32x4 a = acc[ai][bj][m][n] * rs;
                        o[0] += sigmoid_f(a[0]) * lo_bf(w.x); o[1] += sigmoid_f(a[1]) * hi_bf(w.x); o[2] += sigmoid_f(a[2]) * lo_bf(w.y); o[3] += sigmoid_f(a[3]) * hi_bf(w.y); }
                u32x2 ow; ow.x = cvt_pk_bf16(o[0], o[1]); ow.y = cvt_pk_bf16(o[2], o[3]);
                *(u32x2*)(MG + (size_t)row * 1024 + ch0) = ow;
            }
    }
};

struct EpiResid {
    static constexpr bool PERM = true;
    const float* res; float* out; bf16_t* XG; const float* gain; float* ssq;
    __device__ __forceinline__ void operator()(const Acc& acc, const Unit& u, int wr, int wc, int fr, int fq) const {
        const int row0 = u.pm * 256 + wr * 64 + fr; const int col0 = u.pn * 256 + 32 * wc + 8 * fq;
        f32x4 gv[2][2];
#pragma unroll
        for (int bj = 0; bj < 2; ++bj)
#pragma unroll
            for (int n = 0; n < 2; ++n) gv[bj][n] = gain ? *(const f32x4*)(gain + col0 + bj * 128 + 4 * n) : (f32x4){1.f, 1.f, 1.f, 1.f};
#pragma unroll
        for (int ai = 0; ai < 2; ++ai)
#pragma unroll
            for (int m = 0; m < 4; ++m) {
                const int row = row0 + ai * 128 + m * 16; const size_t off = (size_t)row * 1024 + col0; float q = 0.f;
#pragma unroll
                for (int bj = 0; bj < 2; ++bj) {
                    const f32x4 r0 = *(const f32x4*)(res + off + bj * 128), r1 = *(const f32x4*)(res + off + bj * 128 + 4);
                    const f32x4 x0 = r0 + acc[ai][bj][m][0], x1 = r1 + acc[ai][bj][m][1];
                    *(f32x4*)(out + off + bj * 128) = x0; *(f32x4*)(out + off + bj * 128 + 4) = x1;
                    const f32x4 a = x0 * x0, b = x1 * x1; q += ((a[0] + a[1]) + (a[2] + a[3])) + ((b[0] + b[1]) + (b[2] + b[3]));
                    *(u32x4*)(XG + off + bj * 128) = pack8(x0 * gv[bj][0], x1 * gv[bj][1]);
                }
                q += __shfl_xor(q, 16); q += __shfl_xor(q, 32);
                if (fq == 0) ssq[(size_t)row * 16 + 4 * u.pn + wc] = q;
            }
    }
};

struct EpiUp {
    static constexpr bool PERM = true;
    bf16_t* H; const float* ssq;
    __device__ __forceinline__ void operator()(const Acc& acc, const Unit& u, int wr, int wc, int fr, int fq) const {
        const int row0 = u.pm * 256 + wr * 64 + fr; const int col0 = u.pn * 256 + 32 * wc + 8 * fq;
#pragma unroll
        for (int ai = 0; ai < 2; ++ai)
#pragma unroll
            for (int m = 0; m < 4; ++m) { const int row = row0 + ai * 128 + m * 16; const float rs = row_scale(ssq, row); bf16_t* op = H + (size_t)row * FF + col0;
#pragma unroll
                for (int bj = 0; bj < 2; ++bj) { f32x4 v0 = acc[ai][bj][m][0] * rs, v1 = acc[ai][bj][m][1] * rs;
#pragma unroll
                    for (int e = 0; e < 4; ++e) { v0[e] = fmaxf(v0[e], 0.f); v1[e] = fmaxf(v1[e], 0.f); }
                    *(u32x4*)(op + bj * 128) = pack8(v0 * v0, v1 * v1); } }
    }
};
}
struct Args {
    const float* in[18]; float* out; unsigned char* ws; int ph_lo, ph_hi; int coop, pad;
};
struct Frame { LAS unsigned char* lds; int tid, lane, wave, G, vcu; };
constexpr int PTR_OFF = LDS_BYTES - 512;
enum { I_X = 0, I_LN_MIX, I_W_IN, I_SGU_NORM, I_SGU_W, I_SGU_B, I_Q_NORM, I_K_NORM, I_KIDX_NORM, I_I_BIAS, I_F_BIAS, I_MNORM, I_CONV_W, I_W_BRANCH, I_W_OUT, I_LN_MLP, I_W_UP, I_W_DOWN, I_OUT, I_WS };
__device__ __forceinline__ unsigned char* ptr_at(const Frame& F, int i) { const LAS unsigned* p = (const LAS unsigned*)(F.lds + PTR_OFF) + 2 * i;
    const unsigned lo = __builtin_amdgcn_readfirstlane(p[0]), hi = __builtin_amdgcn_readfirstlane(p[1]); return (unsigned char*)(((unsigned long long)hi << 32) | lo); }
#define INP(i) ((const float*)ptr_at(F, (i)))
#define WSP(off) (ptr_at(F, I_WS) + (off))
constexpr size_t WS_GT = 512 * 1024;
__device__ __forceinline__ size_t maskt_idx(int m, int w) { const int b = m >> 12, t = m & (S - 1); return ((size_t)(b * 64 + (w >> 1)) * S + t) * 2 + (w & 1); }


#define XB_TMO      128
#define XB_XCNT(j)  (256  + 64 * (j))
#define XB_XSUB(j)  (1280 + 64 * (j))
#define XB_XGEN(j)  (2304 + 64 * (j))
#define XB_TOP      3328
#define XB_TOPGEN   3392
#define XCD_BAR_WORDS 3456
#define XB_SPIN_CAP (1u << 22)
constexpr size_t WS_BAR = 64 * 1024;
constexpr size_t CTL_ZERO_BYTES = 128 * 1024;
__device__ __forceinline__ unsigned xb_ld(unsigned* p)              { return __hip_atomic_load(p, __ATOMIC_RELAXED, __HIP_MEMORY_SCOPE_AGENT); }
__device__ __forceinline__ unsigned xb_add(unsigned* p, unsigned v) { return __hip_atomic_fetch_add(p, v, __ATOMIC_RELAXED, __HIP_MEMORY_SCOPE_AGENT); }
__device__ __forceinline__ unsigned xb_xcc_id() { return (unsigned)__builtin_amdgcn_s_getreg((3 << 11) | 20) & 0xFu; }
#define XB_SPIN(cond, bar) do { unsigned _sp = 0; while (cond) { __builtin_amdgcn_s_sleep(1); \
    if ((++_sp & 255u) == 0u) { if (xb_ld(&(bar)[XB_TMO])) break; if (_sp > XB_SPIN_CAP) { atomicAdd(&(bar)[XB_TMO], 1u); break; } } } } while (0)
struct XcdBarrier { unsigned* bar; unsigned x; volatile LAS unsigned* st; };
__device__ __forceinline__ XcdBarrier xcd_barrier_post(unsigned* bar, volatile LAS unsigned* st) {
    XcdBarrier b; b.bar = bar; b.x = xb_xcc_id(); b.st = st;
    if (threadIdx.x == 0) (void)xb_add(&bar[XB_XCNT(b.x)], 1u);
    return b;
}
__device__ __forceinline__ void xcd_barrier_complete(unsigned* bar, unsigned x, unsigned& nloc, unsigned& nx) {
    const unsigned G = gridDim.x * gridDim.y * gridDim.z;
    unsigned sum, cnt, mine, sp = 0u;
    for (;;) {
        sum = 0u; cnt = 0u; mine = 0u;
#pragma unroll
        for (unsigned j = 0; j < 16; ++j) { const unsigned c = xb_ld(&bar[XB_XCNT(j)]); sum += c; cnt += (c > 0u) ? 1u : 0u; mine = (j == x) ? c : mine; }
        if (sum == G) break;
        __builtin_amdgcn_s_sleep(1);
        if ((++sp & 255u) == 0u) { if (xb_ld(&bar[XB_TMO])) break; if (sp > XB_SPIN_CAP) { atomicAdd(&bar[XB_TMO], 1u); break; } }
    }
    nloc = mine > 0u ? mine : 1u; nx = cnt > 0u ? cnt : 1u;
}
__device__ __forceinline__ void xcd_barrier(const XcdBarrier& b) {
    asm volatile("s_waitcnt vmcnt(0)" ::: "memory");
    __syncthreads();
    if (threadIdx.x == 0) {
        unsigned* bar = b.bar;
        __builtin_amdgcn_s_waitcnt(0);
        unsigned nloc = b.st[0], nx = b.st[1];
        if (nloc == 0u) { xcd_barrier_complete(bar, b.x, nloc, nx); b.st[0] = nloc; b.st[1] = nx; }
        const unsigned old = xb_add(&bar[XB_XSUB(b.x)], 1u);
        const unsigned gen = old / nloc;
        if (old + 1u == (gen + 1u) * nloc) {
            __builtin_amdgcn_fence(__ATOMIC_RELEASE, "agent");
            asm volatile("s_waitcnt vmcnt(0)" ::: "memory");
            const unsigned og = xb_add(&bar[XB_TOP], 1u);
            const unsigned tg = og / nx;
            if (og + 1u == (tg + 1u) * nx) xb_add(&bar[XB_TOPGEN], 1u);
            else XB_SPIN(xb_ld(&bar[XB_TOPGEN]) == tg, bar);
            __builtin_amdgcn_fence(__ATOMIC_ACQUIRE, "agent");
            xb_add(&bar[XB_XGEN(b.x)], 1u);
            asm volatile("s_waitcnt vmcnt(0)" ::: "memory");
        } else {
            XB_SPIN(xb_ld(&bar[XB_XGEN(b.x)]) == gen, bar);
            __builtin_amdgcn_fence(__ATOMIC_ACQUIRE, "agent");
            asm volatile("s_waitcnt vmcnt(0)" ::: "memory");
        }
    }
    __syncthreads();
}

__device__ __forceinline__ int win_src(int p) {
    const int T = p >> 8, q = p & 255, bj = q >> 7, wc = (q >> 5) & 3, j = q & 31, hd = 64 * wc + 32 * bj + j;
    switch (T) {
        case 0: return O_AU + q; case 1: return O_AV + q; case 2: return O_BQ + hd; case 3: return O_BK + hd; case 4: return O_BV + q;
        case 5: return O_QI + hd; case 6: return O_QI + 256 + hd; case 7: return O_CQ + q; case 8: return O_CK + q; case 9: return O_CV + q;
        case 10: return O_CO + q; case 11: return O_DB + q; case 12: return O_DC + q; case 13: return O_DX + q;
        default: break;
    }
    if (wc == 0) return O_KI + 32 * bj + j;
    if (wc == 1 && bj == 0 && j < 16) return j < 8 ? O_WI + j : (j < 12 ? O_CI + (j - 8) : O_CF + (j - 12));
    return -1;
}
__device__ __forceinline__ int wg_src(int p) {
    const int pn = p >> 8, q = p & 255, bj = q >> 7, wc = (q >> 5) & 3, fq = (q >> 3) & 3, n = (q >> 2) & 1, e = q & 3;
    return O_G + (2 * bj + n) * 1024 + 64 * pn + 16 * wc + 4 * fq + e;
}
template <int MAP>
__device__ __forceinline__ void conv_item(const float* W, int K, int srcN, bf16_t* WT, LAS float* scr, int item, int nrows, int lane) {
    const int nblk = nrows / 32, kb = item / nblk, nb = item % nblk, k0 = 64 * kb, n0 = 32 * nb;
    const int nn = n0 + (lane & 31); const int src = MAP == 0 ? nn : (MAP == 1 ? win_src(nn) : wg_src(nn));
#pragma unroll 8
    for (int i = 0; i < 32; ++i) { const int kk = 2 * i + (lane >> 5); scr[kk * 33 + (lane & 31)] = src >= 0 ? W[(size_t)(k0 + kk) * srcN + src] : 0.f; }
    asm volatile("s_waitcnt lgkmcnt(0)" ::: "memory");
    const int c = lane & 7;
#pragma unroll
    for (int j = 0; j < 4; ++j) { const int n = (lane >> 3) + 8 * j; const LAS float* s = scr + (8 * c) * 33 + n;
        u32x4 o; o.x = pk2(s[0 * 33], s[1 * 33]); o.y = pk2(s[2 * 33], s[3 * 33]); o.z = pk2(s[4 * 33], s[5 * 33]); o.w = pk2(s[6 * 33], s[7 * 33]);
        *(u32x4*)(WT + (size_t)(n0 + n) * K + k0 + 8 * c) = o; }
    asm volatile("s_waitcnt lgkmcnt(0)" ::: "memory");
}
__device__ __forceinline__ void convert_mix_weights(Frame& F, int l) {

    LAS float* scr = (LAS float*)(F.lds + F.wave * 16384);
    const int gw = F.vcu * NWAVES + F.wave, NGW = F.G * NWAVES;
    constexpr int I_WIN = (D / 64) * (PW / 32), I_WG = (D / 64) * (4096 / 32), I_BR = (256 / 64) * (1024 / 32), I_OUT = (D / 64) * (D / 32);
    constexpr int NIT = I_WIN + I_WG + 4 * I_BR + I_OUT;
    const float* win = INP(I_W_IN) + (size_t)l * D * INW;
    for (int it = gw; it < NIT; it += NGW) {
        int r = it;
        if (r < I_WIN) { conv_item<1>(win, D, INW, ((bf16_t*)WSP(WS_WIN)), scr, r, PW, F.lane); continue; } r -= I_WIN;
        if (r < I_WG) { conv_item<2>(win, D, INW, ((bf16_t*)WSP(WS_WG)), scr, r, 4096, F.lane); continue; } r -= I_WG;
        if (r < 4 * I_BR) { const int nb = r / I_BR; conv_item<0>(INP(I_W_BRANCH) + ((size_t)l * 4 + nb) * 256 * D, 256, D, ((bf16_t*)WSP(WS_WBR)) + (size_t)nb * 1024 * 256, scr, r % I_BR, 1024, F.lane); continue; } r -= 4 * I_BR;
        conv_item<0>(INP(I_W_OUT) + (size_t)l * D * D, D, D, ((bf16_t*)WSP(WS_WOUT)), scr, r, D, F.lane);
    }
}
__device__ __forceinline__ void convert_mlp_weights(Frame& F, int l) {

    LAS float* scr = (LAS float*)(F.lds + F.wave * 16384);
    const int gw = F.vcu * NWAVES + F.wave, NGW = F.G * NWAVES;
    constexpr int I_UP = (D / 64) * (FF / 32), I_DN = (FF / 64) * (D / 32);
    for (int it = gw; it < I_UP + I_DN; it += NGW) {
        if (it < I_UP) conv_item<0>(INP(I_W_UP) + (size_t)l * D * FF, D, FF, ((bf16_t*)WSP(WS_WUP)), scr, it, FF, F.lane);
        else conv_item<0>(INP(I_W_DOWN) + (size_t)l * FF * D, FF, D, ((bf16_t*)WSP(WS_WDN)), scr, it - I_UP, D, F.lane);
    }
}
__device__ __forceinline__ void prologue_rows(Frame& F) {
    float* COS = (float*)WSP(WS_COS); float* SIN = (float*)WSP(WS_SIN); float* SSQA = (float*)WSP(WS_SSQA); bf16_t* XG = (bf16_t*)WSP(WS_XG); const float* x = INP(I_X); const float* ln_mix = INP(I_LN_MIX);
    const int gt = F.vcu * NT + F.tid, NGT = F.G * NT;
    for (int i = gt; i < S * 32; i += NGT) { const int pos = i >> 5, k = i & 31; const float inv = powf(10000.f, -(float)k * 2.0f / 64.f); const float ang = (float)pos * inv; COS[i] = cosf(ang); SIN[i] = sinf(ang); }
    const int gw = F.vcu * NWAVES + F.wave, NGW = F.G * NWAVES;
    for (int m = gw; m < M; m += NGW) {
        const f32x4* xr = (const f32x4*)(x + (size_t)m * D) + F.lane; const f32x4* gr = (const f32x4*)ln_mix + F.lane;
        unsigned long long* o8 = (unsigned long long*)(XG + (size_t)m * D) + F.lane;
#pragma unroll
        for (int j = 0; j < 4; ++j) { const f32x4 v = xr[64 * j], g = gr[64 * j]; float s = (v[0] * v[0] + v[1] * v[1]) + (v[2] * v[2] + v[3] * v[3]);
            s += __shfl_xor(s, 1); s += __shfl_xor(s, 2); s += __shfl_xor(s, 4); s += __shfl_xor(s, 8);
            if ((F.lane & 15) == 0) SSQA[(size_t)m * 16 + 4 * j + (F.lane >> 4)] = s;
            o8[64 * j] = (unsigned long long)pk2(v[0] * g[0], v[1] * g[1]) | ((unsigned long long)pk2(v[2] * g[2], v[3] * g[3]) << 32); }
    }
}

__device__ __forceinline__ void sgu_simple(Frame& F, int l) {
    bf16_t* PROJ = (bf16_t*)WSP(WS_BIG); bf16_t* Y = (bf16_t*)WSP(WS_Y); const float* sgu_norm = INP(I_SGU_NORM); const float* sgu_w = INP(I_SGU_W); const float* sgu_b = INP(I_SGU_B);
    LAS float* r_s = (LAS float*)F.lds; LAS float* vn = r_s + 128;
    const float* gain = sgu_norm + l * 256; const float* sw = sgu_w + (size_t)l * 4 * 128 * 128; const float* sb = sgu_b + l * 4 * 128;
    for (int item = F.vcu; item < 512; item += F.G) {
        const int g = item & 3, m0 = (item >> 2) * 128;
        for (int i = 0; i < 16; ++i) { const int tok = F.wave * 16 + i; const u32x2 w = *(const u32x2*)(PROJ + (size_t)(m0 + tok) * PW + P_AV + 4 * F.lane);
            const float a = lo_bf(w.x), b = hi_bf(w.x), c = lo_bf(w.y), d = hi_bf(w.y); const float ss = wave_sum((a * a + b * b) + (c * c + d * d));
            if (F.lane == 0) r_s[tok] = rsqrtf(ss * (1.f / 256.f) + EPS); }
        __syncthreads();
        for (int idx = F.tid; idx < 8192; idx += NT) { const int s = idx >> 6, d = idx & 63; vn[idx] = bf2f(PROJ[(size_t)(m0 + s) * PW + P_AV + g * 64 + d]) * r_s[s] * gain[g * 64 + d]; }
        __syncthreads();
        const int d = F.tid & 63, tq = F.tid >> 6;
        for (int tl = tq; tl < 128; tl += 8) { const float* w = sw + ((size_t)g * 128 + tl) * 128; float acc = 0.f;
            for (int s = 0; s <= tl; ++s) acc = fmaf(w[s], vn[s * 64 + d], acc);
            acc += sb[g * 128 + tl];
            Y[(size_t)(m0 + tl) * D + g * 64 + d] = (bf16_t)f2bf(bf2f(PROJ[(size_t)(m0 + tl) * PW + P_AU + g * 64 + d]) * acc); }
        __syncthreads();
    }
}
__device__ __forceinline__ void conv_simple(Frame& F, int l) {
    bf16_t* PROJ = (bf16_t*)WSP(WS_BIG); bf16_t* Y = (bf16_t*)WSP(WS_Y); const float* conv_w = INP(I_CONV_W);
    const float* cw = conv_w + l * 3 * 256;
    for (int i = F.vcu * NT + F.tid; i < M * 256; i += F.G * NT) { const int m = i >> 8, c = i & 255, t = m & (S - 1); float acc = 0.f;
#pragma unroll
        for (int j = 0; j < 3; ++j) { const int tt = t - 2 + j; if (tt >= 0) { const size_t r = (size_t)(m - 2 + j) * PW; acc = fmaf(cw[j * 256 + c], bf2f(PROJ[r + P_DC + c]) * bf2f(PROJ[r + P_DX + c]), acc); } }
        Y[(size_t)m * D + 768 + c] = (bf16_t)f2bf(bf2f(PROJ[(size_t)m * PW + P_DB + c]) * acc); }
}
__device__ __forceinline__ void indexer_simple(Frame& F) {
    float* MISC = (float*)WSP(WS_MISC); unsigned* MASK = (unsigned*)WSP(WS_MASK); bf16_t* PROJ = (bf16_t*)WSP(WS_BIG);
    LAS float* sc = (LAS float*)F.lds; LAS int* red = (LAS int*)(sc + 4096); LAS unsigned* msk = (LAS unsigned*)(red + 16);
    for (int m = F.vcu; m < M; m += F.G) {
        const int t = m & (S - 1), b0 = m - t, n = t + 1;
        if (n <= 256) { if (F.tid < 128) { const int lo = 32 * F.tid; MASK[maskt_idx(m, F.tid)] = (lo + 32 <= n) ? 0xffffffffu : (lo >= n ? 0u : ((1u << (n - lo)) - 1u)); } continue; }
        float qreg[8], wh[8];
#pragma unroll
        for (int h = 0; h < 8; ++h) { qreg[h] = bf2f(PROJ[(size_t)m * PW + P_QI + h * 64 + F.lane]); wh[h] = MISC[(size_t)m * 16 + h] * 0.35355339059327373f; }
        for (int s0 = 0; s0 < n; s0 += NT) {
            const int s = s0 + F.tid, sc_ = s < n ? s : n - 1; const u32x4* kr = (const u32x4*)(PROJ + (size_t)(b0 + sc_) * PW + P_KI);
            float kf[64];
#pragma unroll
            for (int i = 0; i < 8; ++i) { const u32x4 w = kr[i]; kf[8 * i] = lo_bf(w.x); kf[8 * i + 1] = hi_bf(w.x); kf[8 * i + 2] = lo_bf(w.y); kf[8 * i + 3] = hi_bf(w.y); kf[8 * i + 4] = lo_bf(w.z); kf[8 * i + 5] = hi_bf(w.z); kf[8 * i + 6] = lo_bf(w.w); kf[8 * i + 7] = hi_bf(w.w); }
            float acc = 0.f;
#pragma unroll
            for (int h = 0; h < 8; ++h) { float d0 = 0.f, d1 = 0.f;
#pragma unroll
                for (int e = 0; e < 64; e += 2) { d0 = fmaf(__builtin_bit_cast(float, __builtin_amdgcn_readlane(__builtin_bit_cast(int, qreg[h]), e)), kf[e], d0);
                                                   d1 = fmaf(__builtin_bit_cast(float, __builtin_amdgcn_readlane(__builtin_bit_cast(int, qreg[h]), e + 1)), kf[e + 1], d1); }
                acc += wh[h] * fmaxf((d0 + d1) * 0.125f, 0.f); }
            if (s < n) sc[s] = acc;
        }
        __syncthreads();
        unsigned Tk = 0u;
        for (int bit = 31; bit >= 0; --bit) {
            const unsigned cand = Tk | (1u << bit); int c = 0;
            for (int s = F.tid; s < n; s += NT) c += (fkey(sc[s]) >= cand) ? 1 : 0;
            c = wave_sum_i(c); if (F.lane == 0) red[F.wave] = c; __syncthreads();
            int tot = 0;
#pragma unroll
            for (int w = 0; w < 8; ++w) tot += red[w];
            __syncthreads();
            if (tot >= 256) Tk = cand;
        }
        int cg_ = 0, ce = 0;
        for (int s = F.tid; s < n; s += NT) { const unsigned k = fkey(sc[s]); cg_ += k > Tk ? 1 : 0; ce += k == Tk ? 1 : 0; }
        cg_ = wave_sum_i(cg_); ce = wave_sum_i(ce); if (F.lane == 0) { red[F.wave] = cg_; red[8 + F.wave] = ce; }
        if (F.tid < 128) msk[F.tid] = 0u;
        __syncthreads();
        int ngt = 0, neq = 0;
#pragma unroll
        for (int w = 0; w < 8; ++w) { ngt += red[w]; neq += red[8 + w]; }
        const bool all_eq = (ngt + neq == 256);
        for (int s = F.tid; s < n; s += NT) { const unsigned k = fkey(sc[s]); if (k > Tk || (all_eq && k == Tk)) atomicOr((unsigned*)&msk[s >> 5], 1u << (s & 31)); }
        __syncthreads();
        if (!all_eq && F.tid == 0) { int need = 256 - ngt; for (int s = 0; s < n && need > 0; ++s) if (fkey(sc[s]) == Tk) { msk[s >> 5] |= 1u << (s & 31); --need; } }
        __syncthreads();
        if (F.tid < 128) MASK[maskt_idx(m, F.tid)] = msk[F.tid];
        __syncthreads();
    }
}
__device__ __forceinline__ void attn_simple(Frame& F) {
    unsigned* MASK = (unsigned*)WSP(WS_MASK); bf16_t* PROJ = (bf16_t*)WSP(WS_BIG); bf16_t* Y = (bf16_t*)WSP(WS_Y);
    LAS unsigned* msk = (LAS unsigned*)F.lds; LAS int* sel = (LAS int*)(msk + 128); LAS float* lg = (LAS float*)(sel + 256); LAS int* nsel = (LAS int*)(lg + 4 * 256);
    for (int m = F.vcu; m < M; m += F.G) {
        const int t = m & (S - 1), b0 = m - t;
        if (F.tid < 128) msk[F.tid] = MASK[maskt_idx(m, F.tid)];
        __syncthreads();
        if (F.tid == 0) { int c = 0; for (int w = 0; w < 128; ++w) { unsigned bits = msk[w]; while (bits) { const int i = __builtin_ctz(bits); if (c < 256) sel[c] = 32 * w + i; ++c; bits &= bits - 1; } } nsel[0] = c < 256 ? c : 256; }
        __syncthreads();
        const int ns = nsel[0], h = F.wave & 3, part = F.wave >> 2;
        const float q = bf2f(PROJ[(size_t)m * PW + P_Q + h * 64 + F.lane]);
        for (int j = part; j < ns; j += 2) { const float d = wave_sum(q * bf2f(PROJ[(size_t)(b0 + sel[j]) * PW + P_K + h * 64 + F.lane])); if (F.lane == 0) lg[h * 256 + j] = d * 0.125f; }
        __syncthreads();
        if (F.wave < 4) {
            float mx = -INFINITY; for (int j = F.lane; j < ns; j += 64) mx = fmaxf(mx, lg[h * 256 + j]); mx = wave_max(mx);
            float sm = 0.f; for (int j = F.lane; j < ns; j += 64) sm += __expf(lg[h * 256 + j] - mx); sm = wave_sum(sm);
            float o = 0.f; for (int j = 0; j < ns; ++j) o = fmaf(__expf(lg[h * 256 + j] - mx), bf2f(PROJ[(size_t)(b0 + sel[j]) * PW + P_V + h * 64 + F.lane]), o);
            Y[(size_t)m * D + 256 + h * 64 + F.lane] = (bf16_t)f2bf(o / sm);
        }
        __syncthreads();
    }
}
__device__ __forceinline__ void mlstm1_simple(Frame& F, int l) {
    float* MISC = (float*)WSP(WS_MISC); float* STATE = (float*)WSP(WS_STATE); bf16_t* PROJ = (bf16_t*)WSP(WS_BIG); const float* i_bias = INP(I_I_BIAS); const float* f_bias = INP(I_F_BIAS);
    LAS float* bs = (LAS float*)F.lds; LAS float* ig = bs + 128; LAS float* wk = ig + 128; LAS float* kt = wk + 128; LAS float* vt = kt + 128 * 64;
    for (int item = F.vcu; item < 512; item += F.G) {
        const int bh = item >> 5, c = item & 31, b = bh >> 2, h = bh & 3, m0 = b * S + c * 128;
        if (F.tid < 128) { const float f = MISC[(size_t)(m0 + F.tid) * 16 + 12 + h] + f_bias[l * 4 + h]; bs[F.tid] = fminf(f, 0.f) - log1pf(__expf(-fabsf(f))); ig[F.tid] = MISC[(size_t)(m0 + F.tid) * 16 + 8 + h] + i_bias[l * 4 + h]; }
        for (int idx = F.tid; idx < 8192; idx += NT) { const int s = idx >> 6, d = idx & 63; kt[idx] = bf2f(PROJ[(size_t)(m0 + s) * PW + P_CK + h * 64 + d]); vt[idx] = bf2f(PROJ[(size_t)(m0 + s) * PW + P_CV + h * 64 + d]); }
        __syncthreads();
        if (F.tid == 0) { float a = 0.f; for (int s = 0; s < 128; ++s) { a += bs[s]; bs[s] = a; } }
        __syncthreads();
        const float B = bs[127];
        if (F.tid < 128) wk[F.tid] = __expf(B - bs[F.tid] + ig[F.tid]);
        __syncthreads();
        const int e = F.tid & 63, dq = F.tid >> 6; float acc[8];
#pragma unroll
        for (int i = 0; i < 8; ++i) acc[i] = 0.f;
        for (int s = 0; s < 128; ++s) { const float kv = wk[s] * vt[s * 64 + e];
#pragma unroll
            for (int i = 0; i < 8; ++i) acc[i] = fmaf(kt[s * 64 + dq * 8 + i], kv, acc[i]); }
        float* st = STATE + (size_t)item * STATE_STRIDE;
#pragma unroll
        for (int i = 0; i < 8; ++i) st[e * 64 + dq * 8 + i] = acc[i];
        if (F.tid < 64) { float a = 0.f; for (int s = 0; s < 128; ++s) a = fmaf(wk[s], kt[s * 64 + F.tid], a); st[4096 + F.tid] = a; }
        if (F.tid == 0) st[4160] = B;
        __syncthreads();
    }
}
__device__ __forceinline__ void mlstm2_simple(Frame& F, int l) {
    float* MISC = (float*)WSP(WS_MISC); float* STATE = (float*)WSP(WS_STATE); bf16_t* PROJ = (bf16_t*)WSP(WS_BIG); bf16_t* Y = (bf16_t*)WSP(WS_Y); const float* i_bias = INP(I_I_BIAS); const float* f_bias = INP(I_F_BIAS); const float* mnorm = INP(I_MNORM);
    LAS float* Cs = (LAS float*)F.lds; LAS float* ns = Cs + 4096; LAS float* bs = ns + 64; LAS float* ig = bs + 128; LAS float* A = ig + 128;
    LAS float* qt = A + 128 * 128; LAS float* kt = qt + 128 * 65;
    for (int item = F.vcu; item < 512; item += F.G) {
        const int bh = item >> 5, c = item & 31, b = bh >> 2, h = bh & 3, m0 = b * S + c * 128;
        { float Cv[8]; float nv = 0.f;
#pragma unroll
          for (int k = 0; k < 8; ++k) Cv[k] = 0.f;
          for (int cc = 0; cc < c; ++cc) { const float* st = STATE + (size_t)(bh * 32 + cc) * STATE_STRIDE; const float dec = __expf(st[4160]);
#pragma unroll
              for (int k = 0; k < 8; ++k) Cv[k] = fmaf(dec, Cv[k], st[F.tid + NT * k]);
              if (F.tid < 64) nv = fmaf(dec, nv, st[4096 + F.tid]); }
#pragma unroll
          for (int k = 0; k < 8; ++k) Cs[F.tid + NT * k] = Cv[k];
          if (F.tid < 64) ns[F.tid] = nv; }
        if (F.tid < 128) { const float f = MISC[(size_t)(m0 + F.tid) * 16 + 12 + h] + f_bias[l * 4 + h]; bs[F.tid] = fminf(f, 0.f) - log1pf(__expf(-fabsf(f))); ig[F.tid] = MISC[(size_t)(m0 + F.tid) * 16 + 8 + h] + i_bias[l * 4 + h]; }
        for (int idx = F.tid; idx < 8192; idx += NT) { const int s = idx >> 6, d = idx & 63; qt[s * 65 + d] = bf2f(PROJ[(size_t)(m0 + s) * PW + P_CQ + h * 64 + d]); kt[s * 65 + d] = bf2f(PROJ[(size_t)(m0 + s) * PW + P_CK + h * 64 + d]); }
        __syncthreads();
        if (F.tid == 0) { float a = 0.f; for (int s = 0; s < 128; ++s) { a += bs[s]; bs[s] = a; } }
        __syncthreads();
        { const int s = F.tid & 127, jq = F.tid >> 7;
          for (int j = jq; j < 128; j += 4) { float v = 0.f;
              if (s <= j) { float d = 0.f;
#pragma unroll 16
                  for (int k = 0; k < 64; ++k) d = fmaf(qt[j * 65 + k], kt[s * 65 + k], d);
                  v = __expf(bs[j] - bs[s] + ig[s]) * d; }
              A[j * 128 + s] = v; } }
        __syncthreads();
        LAS float* vt = kt;
        for (int idx = F.tid; idx < 8192; idx += NT) { const int s = idx >> 6, d = idx & 63; vt[idx] = bf2f(PROJ[(size_t)(m0 + s) * PW + P_CV + h * 64 + d]); }
        __syncthreads();
        const int e = F.lane; const float gn = mnorm[l * 256 + h * 64 + e];
        for (int j = F.wave; j < 128; j += 8) {
            float num = 0.f, qn = 0.f, sa = 0.f;
            for (int d = 0; d < 64; ++d) { const float qd = qt[j * 65 + d]; num = fmaf(qd, Cs[d * 64 + e], num); qn = fmaf(qd, ns[d], qn); }
            const float eb = __expf(bs[j]); num *= eb; qn *= eb;
            for (int s = 0; s <= j; ++s) { const float a = A[j * 128 + s]; num = fmaf(a, vt[s * 64 + e], num); sa += a; }
            const float hv = num / fmaxf(fabsf(qn + sa), 1.f);
            const float r = rsqrtf(wave_sum(hv * hv) * (1.f / 64.f) + EPS);
            const size_t row = (size_t)(m0 + j);
            Y[row * D + 512 + h * 64 + e] = (bf16_t)f2bf(sigmoid_f(bf2f(PROJ[row * PW + P_CO + h * 64 + e])) * hv * r * gn);
        }
        __syncthreads();
    }
}
typedef float f32x16 __attribute__((ext_vector_type(16)));
constexpr size_t WS_VT = WS_BIG + 120 * MiB;
constexpr float LOG2E = 1.4426950408889634f;

__device__ __forceinline__ void attn_mfma(Frame& F, int l) {
    const unsigned long long* MASKT = (const unsigned long long*)WSP(WS_MASK); const bf16_t* PROJ = (const bf16_t*)WSP(WS_BIG); const bf16_t* VT = (const bf16_t*)WSP(WS_VT);
    bf16_t* Y = (bf16_t*)WSP(WS_Y); const float* gt = (const float*)WSP(WS_GT) + l * 192;
    const int lane = F.lane, r32 = lane & 31, hi = lane >> 5, grp = F.wave >> 2, w4 = F.wave & 3, lg = F.tid & 255;
    const float mq = wave_max(fabsf(gt[lane])), mk = wave_max(fabsf(gt[64 + lane]));
    const float c1 = 0.125f * LOG2E, c2 = 8.f * mq * mk * 1.01f * LOG2E;
    constexpr int ROWB = 144, TILEB = 64 * ROWB;
    LAS unsigned char* gb = F.lds + grp * 4 * TILEB;
    LAS float* comb = (LAS float*)(F.lds + 8 * TILEB);
    const int srow0 = lg >> 3, sc0 = lg & 7;
    for (int item = F.vcu; item < 256; item += F.G) {
        const int bh = item >> 4, sidx = item & 15, b = bh >> 2, h = bh & 3;
#pragma unroll 1
        for (int half = 0; half < 2; ++half) {
            const int qb = half == 0 ? sidx : 31 - sidx, q0 = qb * 128, ntl = qb + 1;
            const int qrow = b * S + q0 + w4 * 32 + r32, tq = q0 + w4 * 32 + r32;
            bf16x8 qf[4];
#pragma unroll
            for (int s = 0; s < 4; ++s) qf[s] = *(const bf16x8*)(PROJ + (size_t)qrow * PW + P_Q + h * 64 + 16 * s + 8 * hi);
            f32x16 o0, o1;
#pragma unroll
            for (int r = 0; r < 16; ++r) { o0[r] = 0.f; o1[r] = 0.f; }
            float lsum = 0.f;
            const bf16_t* kbase = PROJ + (size_t)(b * S + srow0) * PW + P_K + h * 64 + sc0 * 8;
            const bf16_t* vbase = VT + (size_t)(b * 256 + h * 64 + srow0) * S + sc0 * 8;
            const unsigned long long* mbase = MASKT + (size_t)(b * 64) * S + tq;
            u32x4 kr0, kr1, vr0, vr1; unsigned long long mw, mwn = 0ull;
            { const int t = grp; kr0 = *(const u32x4*)(kbase + (size_t)t * 64 * PW); kr1 = *(const u32x4*)(kbase + (size_t)(t * 64 + 32) * PW);
              vr0 = *(const u32x4*)(vbase + t * 64); vr1 = *(const u32x4*)(vbase + 32 * S + t * 64); mw = mbase[(size_t)t * S];
              LAS unsigned char* kb = gb; LAS unsigned char* vb = gb + TILEB;
              *(LAS u32x4*)(kb + srow0 * ROWB + sc0 * 16) = kr0; *(LAS u32x4*)(kb + (srow0 + 32) * ROWB + sc0 * 16) = kr1;
              *(LAS u32x4*)(vb + srow0 * ROWB + sc0 * 16) = vr0; *(LAS u32x4*)(vb + (srow0 + 32) * ROWB + sc0 * 16) = vr1; }
            __syncthreads();
#pragma unroll 1
            for (int i = 0; i < ntl; ++i) {
                const int cur = i & 1; const bool more = (i + 1 < ntl);
                if (more) { const int t = 2 * (i + 1) + grp; kr0 = *(const u32x4*)(kbase + (size_t)t * 64 * PW); kr1 = *(const u32x4*)(kbase + (size_t)(t * 64 + 32) * PW);
                    vr0 = *(const u32x4*)(vbase + t * 64); vr1 = *(const u32x4*)(vbase + 32 * S + t * 64); mwn = mbase[(size_t)t * S]; }
                const LAS unsigned char* kb = gb + cur * 2 * TILEB; const LAS unsigned char* vb = kb + TILEB;
                f32x16 p0, p1;
#pragma unroll
                for (int r = 0; r < 16; ++r) { p0[r] = 0.f; p1[r] = 0.f; }
#pragma unroll
                for (int s = 0; s < 4; ++s) {
                    const bf16x8 k0 = *(const LAS bf16x8*)(kb + r32 * ROWB + 32 * s + 16 * hi), k1 = *(const LAS bf16x8*)(kb + (32 + r32) * ROWB + 32 * s + 16 * hi);
                    p0 = __builtin_amdgcn_mfma_f32_32x32x16_bf16(k0, qf[s], p0, 0, 0, 0); p1 = __builtin_amdgcn_mfma_f32_32x32x16_bf16(k1, qf[s], p1, 0, 0, 0);
                }
                const unsigned sh0 = (unsigned)mw >> (4 * hi), sh1 = (unsigned)(mw >> 32) >> (4 * hi);
#pragma unroll
                for (int r = 0; r < 16; ++r) { const int cb = (r & 3) + 8 * (r >> 2);
                    const float e0 = __builtin_amdgcn_exp2f(p0[r] * c1 - c2), e1 = __builtin_amdgcn_exp2f(p1[r] * c1 - c2);
                    p0[r] = ((sh0 >> cb) & 1u) ? e0 : 0.f; p1[r] = ((sh1 >> cb) & 1u) ? e1 : 0.f; lsum += p0[r] + p1[r]; }
#pragma unroll
                for (int ks = 0; ks < 4; ++ks) {
                    u32x4 pw;
                    if (ks < 2) { pw.x = cvt_pk_bf16(p0[8 * ks + 0], p0[8 * ks + 1]); pw.y = cvt_pk_bf16(p0[8 * ks + 2], p0[8 * ks + 3]); pw.z = cvt_pk_bf16(p0[8 * ks + 4], p0[8 * ks + 5]); pw.w = cvt_pk_bf16(p0[8 * ks + 6], p0[8 * ks + 7]); }
                    else { const int k2 = ks - 2; pw.x = cvt_pk_bf16(p1[8 * k2 + 0], p1[8 * k2 + 1]); pw.y = cvt_pk_bf16(p1[8 * k2 + 2], p1[8 * k2 + 3]); pw.z = cvt_pk_bf16(p1[8 * k2 + 4], p1[8 * k2 + 5]); pw.w = cvt_pk_bf16(p1[8 * k2 + 6], p1[8 * k2 + 7]); }
                    const bf16x8 pf = __builtin_bit_cast(bf16x8, pw);
                    const int vo = 64 * (ks >> 1) + 32 * (ks & 1) + 8 * hi;
                    const u32x2 a0 = *(const LAS u32x2*)(vb + r32 * ROWB + vo), a1 = *(const LAS u32x2*)(vb + r32 * ROWB + vo + 16);
                    const u32x2 b0 = *(const LAS u32x2*)(vb + (32 + r32) * ROWB + vo), b1 = *(const LAS u32x2*)(vb + (32 + r32) * ROWB + vo + 16);
                    const u32x4 va = {a0.x, a0.y, a1.x, a1.y}, vb4 = {b0.x, b0.y, b1.x, b1.y};
                    o0 = __builtin_amdgcn_mfma_f32_32x32x16_bf16(__builtin_bit_cast(bf16x8, va), pf, o0, 0, 0, 0);
                    o1 = __builtin_amdgcn_mfma_f32_32x32x16_bf16(__builtin_bit_cast(bf16x8, vb4), pf, o1, 0, 0, 0);
                }
                if (more) { LAS unsigned char* kn = gb + (cur ^ 1) * 2 * TILEB; LAS unsigned char* vn = kn + TILEB;
                    *(LAS u32x4*)(kn + srow0 * ROWB + sc0 * 16) = kr0; *(LAS u32x4*)(kn + (srow0 + 32) * ROWB + sc0 * 16) = kr1;
                    *(LAS u32x4*)(vn + srow0 * ROWB + sc0 * 16) = vr0; *(LAS u32x4*)(vn + (srow0 + 32) * ROWB + sc0 * 16) = vr1; mw = mwn; }
                __syncthreads();
            }
            if (grp == 1) { LAS float* cw = comb + w4 * 33 * 64 + lane;
#pragma unroll
                for (int r = 0; r < 16; ++r) { cw[r * 64] = o0[r]; cw[(16 + r) * 64] = o1[r]; }
                cw[32 * 64] = lsum; }
            __syncthreads();
            if (grp == 0) { const LAS float* cw = comb + w4 * 33 * 64 + lane;
#pragma unroll
                for (int r = 0; r < 16; ++r) { o0[r] += cw[r * 64]; o1[r] += cw[(16 + r) * 64]; }
                lsum += cw[32 * 64]; lsum += __shfl_xor(lsum, 32); const float inv = 1.f / lsum;
                bf16_t* yp = Y + (size_t)qrow * D + 256 + h * 64 + 4 * hi;
#pragma unroll
                for (int g4 = 0; g4 < 4; ++g4) { u32x2 w0, w1;
                    w0.x = cvt_pk_bf16(o0[4 * g4] * inv, o0[4 * g4 + 1] * inv); w0.y = cvt_pk_bf16(o0[4 * g4 + 2] * inv, o0[4 * g4 + 3] * inv);
                    w1.x = cvt_pk_bf16(o1[4 * g4] * inv, o1[4 * g4 + 1] * inv); w1.y = cvt_pk_bf16(o1[4 * g4 + 2] * inv, o1[4 * g4 + 3] * inv);
                    *(u32x2*)(yp + 8 * g4) = w0; *(u32x2*)(yp + 32 + 8 * g4) = w1; } }
            __syncthreads();
        }
    }
}

constexpr size_t WS_KI = 234 * MiB;
template <int J, unsigned MSK>
__device__ __forceinline__ void tr_stage(unsigned (&a)[32]) {
#pragma unroll
    for (int k = 0; k < 32; ++k) if ((k & J) == 0) { const unsigned t = (a[k] ^ (a[k + J] >> J)) & MSK; a[k] ^= t; a[k + J] ^= (t << J); }
}
__device__ __forceinline__ void transpose32(unsigned (&a)[32]) {
    tr_stage<16, 0x0000FFFFu>(a); tr_stage<8, 0x00FF00FFu>(a); tr_stage<4, 0x0F0F0F0Fu>(a); tr_stage<2, 0x33333333u>(a); tr_stage<1, 0x55555555u>(a);
}
__device__ __forceinline__ int wave_total_i(int v) {
    v += __builtin_amdgcn_update_dpp(0, v, 0x111, 0xf, 0xf, false);
    v += __builtin_amdgcn_update_dpp(0, v, 0x112, 0xf, 0xf, false);
    v += __builtin_amdgcn_update_dpp(0, v, 0x114, 0xf, 0xf, false);
    v += __builtin_amdgcn_update_dpp(0, v, 0x118, 0xf, 0xf, false);
    v += __builtin_amdgcn_update_dpp(0, v, 0x142, 0xa, 0xf, false);
    v += __builtin_amdgcn_update_dpp(0, v, 0x143, 0xc, 0xf, false);
    return __builtin_amdgcn_readlane(v, 63);
}
__device__ __forceinline__ void indexer_mfma(Frame& F) {
    const float* MISC = (const float*)WSP(WS_MISC); unsigned long long* MASKT = (unsigned long long*)WSP(WS_MASK); const bf16_t* PROJ = (const bf16_t*)WSP(WS_BIG); const bf16_t* KI = (const bf16_t*)WSP(WS_KI);
    LAS float* sc = (LAS float*)F.lds;
    const int lane = F.lane, r32 = lane & 31, hi = lane >> 5, wv = F.wave;
    for (int pi = F.vcu; pi < 1024; pi += F.G) {
        const int b = pi >> 8, pp = pi & 255;
#pragma unroll 1
        for (int half = 0; half < 2; ++half) {
            const int t0 = 8 * (half == 0 ? pp : 511 - pp), m0 = b * S + t0, tq = t0 + wv;
            unsigned long long myword = 0ull;
            if (t0 + 8 <= 256) {
                const int lo = 64 * lane; myword = (tq >= lo + 63) ? ~0ull : (tq < lo ? 0ull : ((2ull << (tq - lo)) - 1ull));
                MASKT[(size_t)(b * 64 + lane) * S + tq] = myword;
                continue;
            }
            const int nmax = t0 + 8, ntile = (nmax + 31) >> 5;
            bf16x8 qa[2][4]; float wq[2][4][4];
#pragma unroll
            for (int i = 0; i < 2; ++i) {
                const bf16_t* qp = PROJ + (size_t)(m0 + 4 * i + (r32 >> 3)) * PW + P_QI + (r32 & 7) * 64 + 8 * hi;
#pragma unroll
                for (int s = 0; s < 4; ++s) qa[i][s] = *(const bf16x8*)(qp + 16 * s);
#pragma unroll
                for (int qq = 0; qq < 4; ++qq) { const f32x4 w4 = *(const f32x4*)(MISC + (size_t)(m0 + 4 * i + qq) * 16 + 4 * hi);
#pragma unroll
                    for (int e = 0; e < 4; ++e) wq[i][qq][e] = w4[e] * (0.125f * 0.35355339059327373f); }
            }
            bf16x8 kbn[4];
            { const int key = 32 * wv + r32; const int krow = key < nmax ? key : nmax - 1; const bf16_t* kp = KI + (size_t)(b * S + krow) * 64 + 8 * hi;
#pragma unroll
              for (int s = 0; s < 4; ++s) kbn[s] = *(const bf16x8*)(kp + 16 * s); }
            for (int j = wv; j < ntile; j += 8) {
                const int key = 32 * j + r32;
                bf16x8 kb[4];
#pragma unroll
                for (int s = 0; s < 4; ++s) kb[s] = kbn[s];
                { const int keyn = key + 256; const int krow = keyn < nmax ? keyn : nmax - 1; const bf16_t* kp = KI + (size_t)(b * S + krow) * 64 + 8 * hi;
#pragma unroll
                  for (int s = 0; s < 4; ++s) kbn[s] = *(const bf16x8*)(kp + 16 * s); }
#pragma unroll
                for (int i = 0; i < 2; ++i) {
                    f32x16 d;
#pragma unroll
                    for (int r = 0; r < 16; ++r) d[r] = 0.f;
#pragma unroll
                    for (int s = 0; s < 4; ++s) d = __builtin_amdgcn_mfma_f32_32x32x16_bf16(qa[i][s], kb[s], d, 0, 0, 0);
                    float part[4];
#pragma unroll
                    for (int qq = 0; qq < 4; ++qq) { float a = 0.f;
#pragma unroll
                        for (int e = 0; e < 4; ++e) a = fmaf(wq[i][qq][e], fmaxf(d[4 * qq + e], 0.f), a);
                        part[qq] = a; }
                    auto s01 = __builtin_amdgcn_permlane32_swap(__float_as_uint(part[0]), __float_as_uint(part[1]), false, false);
                    auto s23 = __builtin_amdgcn_permlane32_swap(__float_as_uint(part[2]), __float_as_uint(part[3]), false, false);
                    const float v01 = __uint_as_float(s01[0]) + __uint_as_float(s01[1]), v23 = __uint_as_float(s23[0]) + __uint_as_float(s23[1]);
                    const int qA = 4 * i + hi, qB = 4 * i + 2 + hi;
                    sc[qA * 4096 + key] = (key <= t0 + qA) ? v01 : -INFINITY;
                    sc[qB * 4096 + key] = (key <= t0 + qB) ? v23 : -INFINITY;
                }
            }
            __syncthreads();
            const int nvalid = 32 * ntile; const LAS float* srow = sc + wv * 4096 + lane;
            unsigned pa[32], pb[32];
#pragma unroll
            for (int r = 0; r < 32; ++r) { const float v = srow[64 * r]; pa[r] = (64 * r + lane < nvalid) ? fkey(v) : 0u; }
            transpose32(pa);
            const bool two = nvalid > 2048;
            if (two) {
#pragma unroll
                for (int r = 0; r < 32; ++r) { const float v = srow[64 * (32 + r)]; pb[r] = (64 * (32 + r) + lane < nvalid) ? fkey(v) : 0u; }
                transpose32(pb);
            } else {
#pragma unroll
                for (int r = 0; r < 32; ++r) pb[r] = 0u;
            }
            unsigned aA = ~0u, aB = ~0u, Tk = 0u; int base = 0;
#pragma unroll
            for (int bit = 31; bit >= 0; --bit) {
                const unsigned wa = pa[31 - bit], wb = pb[31 - bit];
                const int tot = wave_total_i(__builtin_popcount(wa & aA) + __builtin_popcount(wb & aB));
                const bool take = (base + tot >= 256);
                const unsigned flip = take ? 0u : ~0u;
                aA &= (wa ^ flip); aB &= (wb ^ flip);
                if (take) Tk |= (1u << bit); else base += tot;
            }
            const int ngt = base, neq = wave_total_i(__builtin_popcount(aA) + __builtin_popcount(aB));
            if (ngt + neq == 256) {
#pragma unroll
                for (int r = 0; r < 64; ++r) { const float v = srow[64 * r]; const unsigned k = (64 * r + lane < nvalid) ? fkey(v) : 0u;
                    const unsigned long long wsel = __ballot(k >= Tk); if (lane == r) myword = wsel; }
            } else {
                int need = 256 - ngt;
#pragma unroll 1
                for (int r = 0; r < 64; ++r) { const float v = srow[64 * r]; const unsigned k = (64 * r + lane < nvalid) ? fkey(v) : 0u;
                    unsigned long long wsel = __ballot(k > Tk), em = __ballot(k == Tk);
                    if (em != 0ull && need > 0) { int c = __builtin_popcountll(em); while (c > need) { em &= ~(1ull << (63 - __builtin_clzll(em))); --c; } need -= c; wsel |= em; }
                    if (lane == r) myword = wsel; }
            }
            MASKT[(size_t)(b * 64 + lane) * S + tq] = myword;
            __syncthreads();
        }
    }
}

constexpr size_t WS_CVT = 236 * MiB;
__device__ __forceinline__ void mlstm2_mfma(Frame& F, int l) {
    const float* MISC = (const float*)WSP(WS_MISC); const float* STATE = (const float*)WSP(WS_STATE); const bf16_t* PROJ = (const bf16_t*)WSP(WS_BIG); const bf16_t* CVT = (const bf16_t*)WSP(WS_CVT);
    bf16_t* Y = (bf16_t*)WSP(WS_Y); const float* i_bias = INP(I_I_BIAS); const float* f_bias = INP(I_F_BIAS); const float* mnorm = INP(I_MNORM);
    const int lane = F.lane, r32 = lane & 31, hi = lane >> 5, grp = F.wave >> 2, w4 = F.wave & 3, lg = F.tid & 255;
    constexpr int KROWB = 144, VROWB = 272, GB = 49152;
    LAS unsigned char* gb = F.lds + grp * GB;
    LAS float* bc = (LAS float*)gb;
    LAS float* gs = bc + 128;
    LAS float* npv = gs + 128;
    LAS float* wsum = npv + 64;
    LAS unsigned char* ct = gb + 2048;
    LAS unsigned char* kt = ct + 9216;
    LAS unsigned char* vt = kt + 18432;
    for (int it0 = 2 * F.vcu; it0 < 512; it0 += 2 * F.G) {
        const int item = it0 + grp, bh = item >> 5, c = item & 31, b = bh >> 2, h = bh & 3, m0 = b * S + c * 128;
        if (lg < 128) { const float f = MISC[(size_t)(m0 + lg) * 16 + 12 + h] + f_bias[l * 4 + h]; bc[lg] = fminf(f, 0.f) - log1pf(__expf(-fabsf(f))); gs[lg] = MISC[(size_t)(m0 + lg) * 16 + 8 + h] + i_bias[l * 4 + h]; }
        if (lg >= 128 && lg < 160) { const int cc = lg - 128; wsum[cc] = (cc < c) ? STATE[(size_t)(bh * 32 + cc) * STATE_STRIDE + 4160] : 0.f; }
        __syncthreads();
        if (lg < 64) {
            float a0 = bc[2 * lane], a1 = bc[2 * lane + 1]; float s = a0 + a1;
#pragma unroll
            for (int o = 1; o < 64; o <<= 1) { const float t = __shfl_up(s, o); if (lane >= o) s += t; }
            const float ex = s - (a0 + a1); const float i0 = gs[2 * lane], i1 = gs[2 * lane + 1];
            bc[2 * lane] = ex + a0; bc[2 * lane + 1] = s; gs[2 * lane] = i0 - (ex + a0); gs[2 * lane + 1] = i1 - s;
            float w = (lane < 32) ? wsum[lane] : 0.f; float suf = w;
#pragma unroll
            for (int o = 1; o < 32; o <<= 1) { const float t = __shfl_down(suf, o); if (lane + o < 32) suf += t; }
            if (lane < 32) wsum[lane] = suf - w;
        }
        __syncthreads();
        { f32x4 a4[4]; float nv = 0.f;
#pragma unroll
          for (int k = 0; k < 4; ++k) a4[k] = (f32x4){0.f, 0.f, 0.f, 0.f};
          for (int cc = 0; cc < c; ++cc) { const float* st = STATE + (size_t)(bh * 32 + cc) * STATE_STRIDE; const float wgt = __expf(wsum[cc]);
#pragma unroll
              for (int k = 0; k < 4; ++k) { const f32x4 v = *(const f32x4*)(st + 4 * (lg + 256 * k)); a4[k] = a4[k] + v * wgt; }
              if (lg < 64) nv = fmaf(wgt, st[4096 + lg], nv); }
#pragma unroll
          for (int k = 0; k < 4; ++k) { const int idx = 4 * (lg + 256 * k), e = idx >> 6, d = idx & 63; u32x2 w; w.x = cvt_pk_bf16(a4[k][0], a4[k][1]); w.y = cvt_pk_bf16(a4[k][2], a4[k][3]); *(LAS u32x2*)(ct + e * KROWB + d * 2) = w; }
          if (lg < 64) npv[lg] = nv; }
#pragma unroll
        for (int k = 0; k < 4; ++k) { const int id = lg + 256 * k, row = id >> 3, ch = id & 7;
            *(LAS u32x4*)(kt + row * KROWB + ch * 16) = *(const u32x4*)(PROJ + (size_t)(m0 + row) * PW + P_CK + h * 64 + ch * 8);
            const int vrow = id >> 4, vch = id & 15;
            *(LAS u32x4*)(vt + vrow * VROWB + vch * 16) = *(const u32x4*)(CVT + (size_t)(b * 256 + h * 64 + vrow) * S + c * 128 + vch * 8); }
        __syncthreads();
        const int j = 32 * w4 + r32, qrow = m0 + j;
        bf16x8 qf[4];
#pragma unroll
        for (int s = 0; s < 4; ++s) qf[s] = *(const bf16x8*)(PROJ + (size_t)qrow * PW + P_CQ + h * 64 + 16 * s + 8 * hi);
        const float bj = bc[j], eb = __expf(bj);
        float qn = 0.f;
#pragma unroll
        for (int s = 0; s < 4; ++s) { const u32x4 w = __builtin_bit_cast(u32x4, qf[s]); const LAS float* np = npv + 16 * s + 8 * hi;
            qn += lo_bf(w.x) * np[0] + hi_bf(w.x) * np[1] + lo_bf(w.y) * np[2] + hi_bf(w.y) * np[3] + lo_bf(w.z) * np[4] + hi_bf(w.z) * np[5] + lo_bf(w.w) * np[6] + hi_bf(w.w) * np[7]; }
        qn += __shfl_xor(qn, 32); qn *= eb;
        f32x16 n0, n1;
#pragma unroll
        for (int r = 0; r < 16; ++r) { n0[r] = 0.f; n1[r] = 0.f; }
#pragma unroll
        for (int ks = 0; ks < 4; ++ks) { const bf16x8 c0 = *(const LAS bf16x8*)(ct + r32 * KROWB + 32 * ks + 16 * hi), c1 = *(const LAS bf16x8*)(ct + (32 + r32) * KROWB + 32 * ks + 16 * hi);
            n0 = __builtin_amdgcn_mfma_f32_32x32x16_bf16(c0, qf[ks], n0, 0, 0, 0); n1 = __builtin_amdgcn_mfma_f32_32x32x16_bf16(c1, qf[ks], n1, 0, 0, 0); }
#pragma unroll
        for (int r = 0; r < 16; ++r) { n0[r] *= eb; n1[r] *= eb; }
        float sa = 0.f;
#pragma unroll 1
        for (int st = 0; st <= w4; ++st) {
            f32x16 p;
#pragma unroll
            for (int r = 0; r < 16; ++r) p[r] = 0.f;
#pragma unroll
            for (int ks = 0; ks < 4; ++ks) { const bf16x8 kf = *(const LAS bf16x8*)(kt + (32 * st + r32) * KROWB + 32 * ks + 16 * hi); p = __builtin_amdgcn_mfma_f32_32x32x16_bf16(kf, qf[ks], p, 0, 0, 0); }
#pragma unroll
            for (int r = 0; r < 16; ++r) { const int s = 32 * st + (r & 3) + 8 * (r >> 2) + 4 * hi; const float a = (s <= j) ? __expf(bj + gs[s]) * p[r] : 0.f; p[r] = a; sa += a; }
#pragma unroll
            for (int k2 = 0; k2 < 2; ++k2) {
                u32x4 pw; pw.x = cvt_pk_bf16(p[8 * k2 + 0], p[8 * k2 + 1]); pw.y = cvt_pk_bf16(p[8 * k2 + 2], p[8 * k2 + 3]); pw.z = cvt_pk_bf16(p[8 * k2 + 4], p[8 * k2 + 5]); pw.w = cvt_pk_bf16(p[8 * k2 + 6], p[8 * k2 + 7]);
                const bf16x8 pf = __builtin_bit_cast(bf16x8, pw);
                const int vo = (32 * st + 16 * k2 + 4 * hi) * 2;
                const u32x2 a0 = *(const LAS u32x2*)(vt + r32 * VROWB + vo), a1 = *(const LAS u32x2*)(vt + r32 * VROWB + vo + 16);
                const u32x2 b0 = *(const LAS u32x2*)(vt + (32 + r32) * VROWB + vo), b1 = *(const LAS u32x2*)(vt + (32 + r32) * VROWB + vo + 16);
                const u32x4 va = {a0.x, a0.y, a1.x, a1.y}, vb4 = {b0.x, b0.y, b1.x, b1.y};
                n0 = __builtin_amdgcn_mfma_f32_32x32x16_bf16(__builtin_bit_cast(bf16x8, va), pf, n0, 0, 0, 0);
                n1 = __builtin_amdgcn_mfma_f32_32x32x16_bf16(__builtin_bit_cast(bf16x8, vb4), pf, n1, 0, 0, 0);
            }
        }
        sa += __shfl_xor(sa, 32);
        const float inv = 1.f / fmaxf(fabsf(qn + sa), 1.f);
        float ss = 0.f;
#pragma unroll
        for (int r = 0; r < 16; ++r) { n0[r] *= inv; n1[r] *= inv; ss += n0[r] * n0[r] + n1[r] * n1[r]; }
        ss += __shfl_xor(ss, 32); const float rr = rsqrtf(ss * (1.f / 64.f) + EPS);
        const float* gp = mnorm + l * 256 + h * 64 + 4 * hi; const bf16_t* op = PROJ + (size_t)qrow * PW + P_CO + h * 64 + 4 * hi; bf16_t* yp = Y + (size_t)qrow * D + 512 + h * 64 + 4 * hi;
#pragma unroll
        for (int g4 = 0; g4 < 4; ++g4) {
            const f32x4 ga = *(const f32x4*)(gp + 8 * g4), gb4 = *(const f32x4*)(gp + 32 + 8 * g4);
            const u32x2 oa = *(const u32x2*)(op + 8 * g4), ob = *(const u32x2*)(op + 32 + 8 * g4);
            u32x2 w0, w1;
            w0.x = cvt_pk_bf16(sigmoid_f(lo_bf(oa.x)) * n0[4 * g4] * rr * ga[0], sigmoid_f(hi_bf(oa.x)) * n0[4 * g4 + 1] * rr * ga[1]);
            w0.y = cvt_pk_bf16(sigmoid_f(lo_bf(oa.y)) * n0[4 * g4 + 2] * rr * ga[2], sigmoid_f(hi_bf(oa.y)) * n0[4 * g4 + 3] * rr * ga[3]);
            w1.x = cvt_pk_bf16(sigmoid_f(lo_bf(ob.x)) * n1[4 * g4] * rr * gb4[0], sigmoid_f(hi_bf(ob.x)) * n1[4 * g4 + 1] * rr * gb4[1]);
            w1.y = cvt_pk_bf16(sigmoid_f(lo_bf(ob.y)) * n1[4 * g4 + 2] * rr * gb4[2], sigmoid_f(hi_bf(ob.y)) * n1[4 * g4 + 3] * rr * gb4[3]);
            *(u32x2*)(yp + 8 * g4) = w0; *(u32x2*)(yp + 32 + 8 * g4) = w1;
        }
        __syncthreads();
    }
}
#ifndef MK_MULTI
#define MK_MULTI 0
#endif
constexpr int N_PHASES = 1 + 8 * DEPTH;

__global__ void __launch_bounds__(NT, 2) mk_fwd(Args args) {
    extern __shared__ __attribute__((aligned(16))) unsigned char lds_raw[];
    Frame F;
    F.lds = (LAS unsigned char*)lds_raw; F.tid = threadIdx.x; F.lane = F.tid & 63; F.wave = __builtin_amdgcn_readfirstlane(F.tid >> 6);
    F.G = gridDim.x; { const int bx_ = blockIdx.x; F.vcu = (F.G % 8 == 0) ? (bx_ % 8) * (F.G / 8) + bx_ / 8 : bx_; }
    if (F.tid < 20) { const unsigned long long pv = F.tid < 18 ? (unsigned long long)args.in[F.tid < 18 ? F.tid : 0] : (F.tid == 18 ? (unsigned long long)args.out : (unsigned long long)args.ws);
        *(LAS unsigned long long*)(F.lds + PTR_OFF + 8 * F.tid) = pv; }
    if (F.tid < 2) *(LAS unsigned*)(F.lds + PTR_OFF + 256 + 4 * F.tid) = 0u;
    __syncthreads();
    XcdBarrier xbar; xbar.bar = (unsigned*)(args.ws + WS_BAR); xbar.x = 0; xbar.st = (volatile LAS unsigned*)(F.lds + PTR_OFF + 256);
    if (args.coop) xbar = xcd_barrier_post((unsigned*)(args.ws + WS_BAR), (volatile LAS unsigned*)(F.lds + PTR_OFF + 256));
    const int lo = args.ph_lo, hi = args.ph_hi; const bool coop = args.coop != 0;
#define RUN(k) (lo <= (k) && (k) < hi)
#define LAUNDER() asm volatile("" : "+v"(F.tid), "+v"(F.lane))
#define SEAM(k) do { if (coop && RUN(k) && RUN((k) + 1)) { if ((k) == 0) cg::this_grid().sync(); else xcd_barrier(xbar); } } while (0)
    const int bx = (int)blockIdx.x;

    if (RUN(0)) { LAUNDER(); convert_mix_weights(F, 0); prologue_rows(F);
        if (blockIdx.x == 0 && F.tid < DEPTH * 192) { const int l_ = F.tid / 192, r_ = F.tid % 192, w_ = r_ / 64, i_ = r_ % 64; ((float*)WSP(WS_GT))[F.tid] = INP(I_Q_NORM + w_)[l_ * 64 + i_]; } }
    SEAM(0);
#pragma unroll 1
    for (int l = 0; l < DEPTH; ++l) {
        const int pb = 1 + 8 * l;
        if (RUN(pb + 0)) { LAUNDER();
            pg8::Gemm<D, D, D, 256u * D * 2, 0, 256u * D * 2, 0> g{(const bf16_t*)WSP(WS_XG), (const bf16_t*)WSP(WS_WIN)};
            pg8::StaticOrder So; So.init(M, PW, F.G, bx);
            epi::EpiProj E{(bf16_t*)WSP(WS_BIG), (float*)WSP(WS_MISC), (const float*)WSP(WS_SSQA), (const float*)WSP(WS_COS), (const float*)WSP(WS_SIN), (const float*)WSP(WS_GT) + l * 192, (bf16_t*)WSP(WS_VT), (bf16_t*)WSP(WS_KI), (bf16_t*)WSP(WS_CVT)};
            pg8::gemm_phase<epi::EpiProj, pg8::StaticOrder, true>(F.lds, g, So, E, F.tid);
        }
        SEAM(pb + 0);
        if (RUN(pb + 1)) { LAUNDER(); sgu_simple(F, l); conv_simple(F, l); indexer_mfma(F); mlstm1_simple(F, l); }
        SEAM(pb + 1);
        if (RUN(pb + 2)) { LAUNDER(); attn_mfma(F, l); mlstm2_mfma(F, l); }
        SEAM(pb + 2);
        if (RUN(pb + 3)) { LAUNDER();
            pg8::Gemm<256, D, 256, 256u * D * 2, 256u * 2, 256u * 256 * 2, 1024u * 256 * 2> g{(const bf16_t*)WSP(WS_Y), (const bf16_t*)WSP(WS_WBR)};
            pg8::SuperOrder<0> So; So.init(F.G, bx);
            epi::EpiPlain E{(bf16_t*)WSP(WS_BIG), 4096, 1024};
            pg8::gemm_phase<epi::EpiPlain, pg8::SuperOrder<0>, true>(F.lds, g, So, E, F.tid);
        }
        SEAM(pb + 3);
        if (RUN(pb + 4)) { LAUNDER();
            pg8::Gemm<D, D, D, 256u * D * 2, 0, 256u * D * 2, 0> g{(const bf16_t*)WSP(WS_XG), (const bf16_t*)WSP(WS_WG)};
            pg8::SuperOrder<1> So; So.init(F.G, bx);
            epi::EpiGate E{(bf16_t*)WSP(WS_MG), (const bf16_t*)WSP(WS_BIG), (const float*)WSP(WS_SSQA)};
            pg8::gemm_phase<epi::EpiGate, pg8::SuperOrder<1>, true>(F.lds, g, So, E, F.tid);
            __syncthreads();
            convert_mlp_weights(F, l);
        }
        SEAM(pb + 4);
        if (RUN(pb + 5)) { LAUNDER();
            pg8::Gemm<D, D, D, 256u * D * 2, 0, 256u * D * 2, 0> g{(const bf16_t*)WSP(WS_MG), (const bf16_t*)WSP(WS_WOUT)};
            pg8::StaticOrder So; So.init(M, D, F.G, bx);
            float* outp = (float*)ptr_at(F, I_OUT); epi::EpiResid E{l == 0 ? INP(I_X) : (const float*)outp, outp, (bf16_t*)WSP(WS_XG), INP(I_LN_MLP) + l * D, (float*)WSP(WS_SSQB)};
            pg8::gemm_phase<epi::EpiResid, pg8::StaticOrder, true>(F.lds, g, So, E, F.tid);
        }
        SEAM(pb + 5);
        if (RUN(pb + 6)) { LAUNDER();
            pg8::Gemm<D, D, D, 256u * D * 2, 0, 256u * D * 2, 0> g{(const bf16_t*)WSP(WS_XG), (const bf16_t*)WSP(WS_WUP)};
            pg8::StaticOrder So; So.init(M, FF, F.G, bx);
            epi::EpiUp E{(bf16_t*)WSP(WS_BIG), (const float*)WSP(WS_SSQB)};
            pg8::gemm_phase<epi::EpiUp, pg8::StaticOrder, true>(F.lds, g, So, E, F.tid);
            if (l + 1 < DEPTH) { __syncthreads(); convert_mix_weights(F, l + 1); }
        }
        SEAM(pb + 6);
        if (RUN(pb + 7)) { LAUNDER();
            pg8::Gemm<FF, FF, FF, 256u * FF * 2, 0, 256u * FF * 2, 0> g{(const bf16_t*)WSP(WS_BIG), (const bf16_t*)WSP(WS_WDN)};
            pg8::StaticOrder So; So.init(M, D, F.G, bx);
            float* outp = (float*)ptr_at(F, I_OUT); epi::EpiResid E{(const float*)outp, outp, (bf16_t*)WSP(WS_XG), (l + 1 < DEPTH) ? INP(I_LN_MIX) + (l + 1) * D : nullptr, (float*)WSP(WS_SSQA)};
            pg8::gemm_phase<epi::EpiResid, pg8::StaticOrder, true>(F.lds, g, So, E, F.tid);
        }
        SEAM(pb + 7);
    }
#undef RUN
#undef SEAM
}

extern "C" void kernel_launch(void* const* d_in, const int* in_sizes, int n_in, void* d_out, int out_size, void* d_ws, size_t ws_size, hipStream_t stream) {
    static int grid = 0;
    if (grid == 0) {
        if (n_in != 18 || in_sizes[0] != M * D || out_size != M * D || ws_size < WS_END) { fprintf(stderr, "kernel_launch: unexpected shapes (n_in %d, in0 %d, out %d, ws %zu)\n", n_in, n_in > 0 ? in_sizes[0] : -1, out_size, ws_size); grid = -1; return; }
        int dev = 0, cus = 0, per_cu = 0;
        if (hipGetDevice(&dev) != hipSuccess || hipDeviceGetAttribute(&cus, hipDeviceAttributeMultiprocessorCount, dev) != hipSuccess) { grid = -1; return; }
        if (hipFuncSetAttribute((const void*)mk_fwd, hipFuncAttributeMaxDynamicSharedMemorySize, LDS_BYTES) != hipSuccess) { fprintf(stderr, "kernel_launch: hipFuncSetAttribute failed\n"); grid = -1; return; }
        if (hipOccupancyMaxActiveBlocksPerMultiprocessor(&per_cu, (const void*)mk_fwd, NT, LDS_BYTES) != hipSuccess || per_cu < 1) { fprintf(stderr, "kernel_launch: occupancy query says %d\n", per_cu); (void)hipGetLastError(); per_cu = 1; }
        grid = cus;
    }
    if (grid < 0) return;
    if (hipMemsetAsync((char*)d_ws + WS_CTL, 0, CTL_ZERO_BYTES, stream) != hipSuccess) { fprintf(stderr, "kernel_launch: memset failed\n"); return; }
    Args a{};
    for (int i = 0; i < 18; ++i) a.in[i] = (const float*)d_in[i];
    a.out = (float*)d_out; a.ws = (unsigned char*)d_ws;
#if MK_MULTI
    for (int p = 0; p < N_PHASES; ++p) { a.ph_lo = p; a.ph_hi = p + 1; a.coop = 0; hipLaunchKernelGGL(mk_fwd, dim3(grid), dim3(NT), LDS_BYTES, stream, a); }
#else
    a.ph_lo = 0; a.ph_hi = N_PHASES; a.coop = 1;
    void* kargs[] = {&a};
    hipError_t e = hipLaunchCooperativeKernel((const void*)mk_fwd, dim3(grid), dim3(NT), kargs, LDS_BYTES, stream);
    if (e != hipSuccess) fprintf(stderr, "kernel_launch: cooperative launch failed: %s (grid %d)\n", hipGetErrorString(e), grid);
#endif
}
```

```cpp
#define MK_MULTI 0
#include <hip/hip_runtime.h>
#include <hip/hip_cooperative_groups.h>
#include <cstdio>
#include <cstdint>
namespace cg = cooperative_groups;

#define LAS __attribute__((address_space(3)))
typedef unsigned short bf16_t;
typedef short bf16x8 __attribute__((ext_vector_type(8)));
typedef float f32x4 __attribute__((ext_vector_type(4)));
typedef float f32x2 __attribute__((ext_vector_type(2)));
typedef unsigned u32x4 __attribute__((ext_vector_type(4)));
typedef unsigned u32x2 __attribute__((ext_vector_type(2)));

constexpr int D = 1024, NB = 4, S = 4096, M = NB * S, DEPTH = 2, FF = 4096, INW = 7760;
constexpr int O_AU = 0, O_AV = 256, O_BQ = 512, O_BK = 768, O_BV = 1024, O_QI = 1280, O_KI = 1792, O_WI = 1856,
              O_CQ = 1864, O_CK = 2120, O_CV = 2376, O_CO = 2632, O_CI = 2888, O_CF = 2892, O_DB = 2896, O_DC = 3152, O_DX = 3408, O_G = 3664;
constexpr int PW = 3840;
constexpr int P_AU = 0, P_AV = 256, P_Q = 512, P_K = 768, P_V = 1024, P_QI = 1280, P_CQ = 1792, P_CK = 2048, P_CV = 2304, P_CO = 2560,
              P_DB = 2816, P_DC = 3072, P_DX = 3328, P_KI = 3584;
constexpr float EPS = 1e-6f;
constexpr int NWAVES = 8, NT = 512;

constexpr size_t MiB = 1u << 20;
constexpr size_t WS_CTL = 0;
constexpr size_t WS_COS = 1 * MiB, WS_SIN = 1 * MiB + 512 * 1024;
constexpr size_t WS_MISC = 2 * MiB;
constexpr size_t WS_SSQA = 3 * MiB, WS_SSQB = 4 * MiB;
constexpr size_t WS_WIN = 5 * MiB;
constexpr size_t WS_WG = WS_WIN + (size_t)PW * D * 2;
constexpr size_t WS_WBR = WS_WG + (size_t)4096 * D * 2;
constexpr size_t WS_WOUT = WS_WBR + (size_t)4 * 1024 * 256 * 2;
constexpr size_t WS_XG = 25 * MiB;
constexpr size_t WS_BIG = 57 * MiB;
constexpr size_t WS_Y = 185 * MiB;
constexpr size_t WS_WUP = WS_Y, WS_WDN = WS_Y + 8 * MiB;
constexpr size_t WS_MG = 217 * MiB;
constexpr size_t WS_MASK = WS_MG, WS_STATE = WS_MG + 8 * MiB;
constexpr size_t WS_END = 249 * MiB;
constexpr int STATE_STRIDE = 4224;
static_assert(WS_WOUT + (size_t)D * D * 2 <= WS_XG && WS_STATE + (size_t)512 * STATE_STRIDE * 4 <= WS_END && WS_END <= 256 * MiB, "d_ws map");

constexpr int LDS_BYTES = 155648;

__device__ __forceinline__ float bf2f(bf16_t v) { return __uint_as_float((unsigned)v << 16); }
__device__ __forceinline__ unsigned f2bf(float f) { unsigned u = __float_as_uint(f); return (u + 0x7fffu + ((u >> 16) & 1u)) >> 16; }
__device__ __forceinline__ unsigned pk2(float lo, float hi) { return f2bf(lo) | (f2bf(hi) << 16); }
__device__ __forceinline__ unsigned cvt_pk_bf16(float lo, float hi) { unsigned r; asm volatile("v_cvt_pk_bf16_f32 %0, %1, %2" : "=v"(r) : "v"(lo), "v"(hi)); return r; }
__device__ __forceinline__ float lo_bf(unsigned w) { return __uint_as_float(w << 16); }
__device__ __forceinline__ float hi_bf(unsigned w) { return __uint_as_float(w & 0xffff0000u); }
__device__ __forceinline__ float wave_sum(float v) {
#pragma unroll
    for (int o = 1; o < 64; o <<= 1) v += __shfl_xor(v, o);
    return v;
}
__device__ __forceinline__ float wave_max(float v) {
#pragma unroll
    for (int o = 1; o < 64; o <<= 1) v = fmaxf(v, __shfl_xor(v, o));
    return v;
}
__device__ __forceinline__ int wave_sum_i(int v) {
#pragma unroll
    for (int o = 1; o < 64; o <<= 1) v += __shfl_xor(v, o);
    return v;
}
__device__ __forceinline__ float sigmoid_f(float x) { return __builtin_amdgcn_rcpf(1.f + __builtin_amdgcn_exp2f(-1.4426950408889634f * x)); }
__device__ __forceinline__ float gelu_tanh_f(float x) { const float u = 0.7978845608028654f * (x + 0.044715f * x * x * x); return x * __builtin_amdgcn_rcpf(1.f + __builtin_amdgcn_exp2f(-2.8853900817779268f * u)); }
__device__ __forceinline__ unsigned fkey(float s) { const unsigned u = __float_as_uint(s); return (u & 0x80000000u) ? ~u : (u | 0x80000000u); }

namespace pg8 {
constexpr int BM = 256, BK = 64, HALF = 128, HTB = HALF * BK * 2, STAGE_BYTES = 8 * HTB, NXCD = 8, WGM = 8;
__host__ __device__ __forceinline__ int lds_byte(int r, int c) { const int st = (r >> 4) * 2 + (c >> 5), rr = r & 15, cc = c & 31, ob = rr * 64 + cc * 2; return st * 1024 + (ob ^ (((ob >> 9) & 1) << 5)); }
__host__ __device__ __forceinline__ void stage_rc(int b, int& R, int& C) { const int st = b / 1024, sb = b % 1024, swz = sb ^ (((sb >> 9) & 1) << 5); R = (st >> 1) * 16 + swz / 64; C = (st & 1) * 32 + (swz % 64) / 2; }
__host__ __device__ __forceinline__ int perm32(int rho) { const int n = rho >> 4, i = rho & 15; return 8 * (i >> 2) + 4 * n + (i & 3); }

struct Unit { int pm, pn, z; };
template <int K_, int LDA_, int LDB_, unsigned APM_, unsigned AZ_, unsigned BPN_, unsigned BZ_> struct Gemm {
    const bf16_t* A; const bf16_t* Bt;
    static constexpr int K = K_, lda = LDA_, ldb = LDB_; static constexpr unsigned aPm = APM_, aZ = AZ_, bPn = BPN_, bZ = BZ_;
};
template <class G> __device__ __forceinline__ const char* pa(const G& g, const Unit& u) { return (const char*)g.A + (size_t)((unsigned)u.pm * G::aPm + (unsigned)u.z * G::aZ); }
template <class G> __device__ __forceinline__ const char* pb(const G& g, const Unit& u) { return (const char*)g.Bt + (size_t)((unsigned)u.pn * G::bPn + (unsigned)u.z * G::bZ); }

struct StaticOrder {
    int nM, nN, nwg, G, c;
    __host__ __device__ void init(int M_, int N_, int G_, int c_) { nM = M_ / BM; nN = N_ / BM; nwg = nM * nN; G = G_; c = c_; }
    __host__ __device__ bool next(int i, Unit& u) const {
        const long L = (long)i * G + c; if (L >= nwg) return false;
        int wgid = (int)L; { const int q = nwg / NXCD, r = nwg % NXCD, xcd = wgid % NXCD, off = wgid / NXCD; wgid = (xcd < r ? xcd * (q + 1) : r * (q + 1) + (xcd - r) * q) + off; }
        const int nig = WGM * nN, gid = wgid / nig, fm = gid * WGM, gsz = (nM - fm) < WGM ? (nM - fm) : WGM;
        u.pm = fm + ((wgid % nig) % gsz); u.pn = (wgid % nig) / gsz; u.z = 0; return true;
    }
};
template <int MODE> struct SuperOrder {
    StaticOrder so;
    __host__ __device__ void init(int G_, int c_) { so.init(M, 1024, G_, c_); }
    __host__ __device__ bool next(int i, Unit& u) const {
        Unit b; if (!so.next(i >> 2, b)) return false;
        const int sub = i & 3; u.pm = b.pm; if (MODE == 0) { u.pn = b.pn; u.z = sub; } else { u.pn = 4 * b.pn + sub; u.z = 0; } return true;
    }
};

template <class Epi, class Sched, bool ALIGN_EPI, class GemmT>
__device__ __forceinline__ void gemm_phase(LAS unsigned char* lds, const GemmT g, const Sched& S, const Epi& E, const int tid) {
    const int wid = __builtin_amdgcn_readfirstlane(tid >> 6), lane = tid & 63, wr = wid >> 2, wc = wid & 3, fr = lane & 15, fq = lane >> 4;
    constexpr int K = GemmT::K, nt = K / BK;
    unsigned voffA[2], voffB[2];
#pragma unroll
    for (int i = 0; i < 2; ++i) { int R, C; stage_rc(tid * 16 + i * 8192, R, C); const int Rb = Epi::PERM ? ((R & ~31) + perm32(R & 31)) : R;
        voffA[i] = (unsigned)(R * GemmT::lda + C) * 2u; voffB[i] = (unsigned)(Rb * GemmT::ldb + C) * 2u; }
    const size_t kstep = (size_t)(BK * 2);
    constexpr size_t hA = (size_t)HALF * GemmT::lda * 2, hB = (size_t)HALF * GemmT::ldb * 2;
    const unsigned ldsw = (unsigned)wid * 1024u;
    const int aoff = lds_byte(wr * 64 + fr, fq * 8), boff = lds_byte(wc * 32 + fr, fq * 8);
#define PG8_SA(b, h) (((b) * 2 + (h)) * HTB)
#define PG8_SB(b, h) ((4 + (b) * 2 + (h)) * HTB)
#define PG8_STAGE(bufoff, gbase, voff) do { _Pragma("unroll") for (int _i = 0; _i < 2; ++_i) \
        __builtin_amdgcn_global_load_lds((const unsigned*)((const char*)(gbase) + (voff)[_i]), (LAS unsigned*)(lds + (bufoff) + ldsw + _i * 8192), 16, 0, 0); } while (0)
#define PG8_LDA(dst, b, h) do { _Pragma("unroll") for (int m = 0; m < 4; ++m) _Pragma("unroll") for (int k = 0; k < 2; ++k) dst[m][k] = *(const LAS bf16x8*)(lds + PG8_SA(b, h) + aoff + m * 2048 + k * 1024); } while (0)
#define PG8_LDB(dst, b, h) do { _Pragma("unroll") for (int n = 0; n < 2; ++n) _Pragma("unroll") for (int k = 0; k < 2; ++k) dst[n][k] = *(const LAS bf16x8*)(lds + PG8_SB(b, h) + boff + n * 2048 + k * 1024); } while (0)
#define PG8_MMA(ai, bj, At, Bt) do { __builtin_amdgcn_s_setprio(1); _Pragma("unroll") for (int m = 0; m < 4; ++m) _Pragma("unroll") for (int n = 0; n < 2; ++n) _Pragma("unroll") for (int k = 0; k < 2; ++k) \
        acc[ai][bj][m][n] = __builtin_amdgcn_mfma_f32_16x16x32_bf16(Bt[n][k], At[m][k], acc[ai][bj][m][n], 0, 0, 0); __builtin_amdgcn_s_setprio(0); } while (0)
#define PG8_WAIT_V(n) asm volatile("s_waitcnt vmcnt(" #n ")" ::: "memory")
#define PG8_WAIT_L(n) asm volatile("s_waitcnt lgkmcnt(" #n ")" ::: "memory")
#define PG8_BAR __builtin_amdgcn_s_barrier()
#define PG8_SCHED __builtin_amdgcn_sched_barrier(0)
    Unit cur, nxt; int ui = 0;
    if (!S.next(0, cur)) return;
    f32x4 acc[2][2][4][2];
#pragma unroll
    for (int a = 0; a < 2; ++a)
#pragma unroll
        for (int b = 0; b < 2; ++b)
#pragma unroll
            for (int m = 0; m < 4; ++m)
#pragma unroll
                for (int n = 0; n < 2; ++n) acc[a][b][m][n] = (f32x4){0.f, 0.f, 0.f, 0.f};
    bf16x8 At[4][2], B0[2][2], B1[2][2];
    const char* cA = pa(g, cur); const char* cB = pb(g, cur);
    PG8_STAGE(PG8_SB(0, 0), cB, voffB); PG8_STAGE(PG8_SB(0, 1), cB + hB, voffB); PG8_STAGE(PG8_SA(0, 0), cA, voffA); PG8_STAGE(PG8_SA(0, 1), cA + hA, voffA);
    if (wr == 1) PG8_BAR;
    PG8_WAIT_V(2); PG8_BAR;
    PG8_STAGE(PG8_SB(1, 0), cB + kstep, voffB); PG8_STAGE(PG8_SA(1, 0), cA + kstep, voffA); PG8_STAGE(PG8_SB(1, 1), cB + hB + kstep, voffB);
    PG8_WAIT_V(6); PG8_BAR;
    for (;;) {
        const bool has_next = S.next(ui + 1, nxt);
        const char* nA = has_next ? pa(g, nxt) : cA; const char* nB = has_next ? pb(g, nxt) : cB;
#pragma unroll 1
        for (int t = 0; t < nt; t += 2) {
            const bool last = (t == nt - 2);
            const char* a1 = cA + (size_t)(t + 1) * kstep;
            const char* a2 = last ? nA : cA + (size_t)(t + 2) * kstep; const char* b2 = last ? nB : cB + (size_t)(t + 2) * kstep;
            const char* a3 = a2 + kstep; const char* b3 = b2 + kstep;
            PG8_LDB(B0, 0, 0); PG8_LDB(B1, 0, 1); PG8_SCHED; PG8_LDA(At, 0, 0); PG8_STAGE(PG8_SA(1, 1), a1 + hA, voffA);
            PG8_WAIT_V(8); PG8_WAIT_L(0); PG8_BAR; PG8_MMA(0, 0, At, B0); PG8_MMA(0, 1, At, B1); PG8_BAR; PG8_SCHED;
            PG8_LDA(At, 0, 1); PG8_STAGE(PG8_SB(0, 0), b2, voffB); PG8_STAGE(PG8_SB(0, 1), b2 + hB, voffB); PG8_STAGE(PG8_SA(0, 0), a2, voffA);
            PG8_WAIT_V(8); PG8_WAIT_L(0); PG8_BAR; PG8_MMA(1, 0, At, B0); PG8_MMA(1, 1, At, B1); PG8_BAR; PG8_SCHED;
            PG8_LDB(B0, 1, 0); PG8_LDB(B1, 1, 1); PG8_SCHED; PG8_LDA(At, 1, 0); PG8_STAGE(PG8_SA(0, 1), a2 + hA, voffA);
            PG8_WAIT_V(8); PG8_WAIT_L(0); PG8_BAR; PG8_MMA(0, 0, At, B0); PG8_MMA(0, 1, At, B1); PG8_BAR; PG8_SCHED;
            PG8_LDA(At, 1, 1); PG8_STAGE(PG8_SB(1, 0), b3, voffB); PG8_STAGE(PG8_SB(1, 1), b3 + hB, voffB); PG8_STAGE(PG8_SA(1, 0), a3, voffA);
            PG8_WAIT_V(8); PG8_WAIT_L(0); PG8_BAR; PG8_MMA(1, 0, At, B0); PG8_MMA(1, 1, At, B1); PG8_BAR; PG8_SCHED;
        }
        if constexpr (ALIGN_EPI) { if (wr == 0) PG8_BAR; }
        { int fr2 = fr, fq2 = fq; asm volatile("" : "+v"(fr2), "+v"(fq2)); E(acc, cur, wr, wc, fr2, fq2); }
        if (!has_next) break;
#pragma unroll
        for (int a = 0; a < 2; ++a)
#pragma unroll
            for (int b = 0; b < 2; ++b)
#pragma unroll
                for (int m = 0; m < 4; ++m)
#pragma unroll
                    for (int n = 0; n < 2; ++n) acc[a][b][m][n] = (f32x4){0.f, 0.f, 0.f, 0.f};
        cur = nxt; cA = nA; cB = nB; ++ui;
        if constexpr (ALIGN_EPI) { if (wr == 1) PG8_BAR; }
    }
    PG8_WAIT_V(0);
    if constexpr (!ALIGN_EPI) { if (wr == 0) PG8_BAR; }
    PG8_BAR;
#undef PG8_SA
#undef PG8_SB
#undef PG8_STAGE
#undef PG8_LDA
#undef PG8_LDB
#undef PG8_MMA
#undef PG8_WAIT_V
#undef PG8_WAIT_L
#undef PG8_BAR
#undef PG8_SCHED
}
}
namespace epi {
using pg8::Unit;
typedef f32x4 Acc[2][2][4][2];

__device__ __forceinline__ float row_scale(const float* ssq, int row) {
    const f32x4* sp = (const f32x4*)(ssq + (size_t)row * 16);
    const f32x4 a = sp[0], b = sp[1], c = sp[2], d = sp[3];
    const float t = ((a[0] + a[1]) + (a[2] + a[3])) + ((b[0] + b[1]) + (b[2] + b[3])) + ((c[0] + c[1]) + (c[2] + c[3])) + ((d[0] + d[1]) + (d[2] + d[3]));
    return rsqrtf(t * (1.0f / 1024.0f) + EPS);
}
__device__ __forceinline__ u32x4 pack8(const f32x4 a, const f32x4 b) { u32x4 w; w.x = cvt_pk_bf16(a[0], a[1]); w.y = cvt_pk_bf16(a[2], a[3]); w.z = cvt_pk_bf16(b[0], b[1]); w.w = cvt_pk_bf16(b[2], b[3]); return w; }

struct EpiProj {
    static constexpr bool PERM = true;
    bf16_t* P; float* misc; const float* ssq; const float* cs; const float* sn; const float* gt;     bf16_t* VT;     bf16_t* KI;     bf16_t* CVT;     float* ssqv;
    __device__ __forceinline__ void operator()(const Acc& acc, const Unit& u, int wr, int wc, int fr, int fq) const {
        const int T = u.pn; const int row0 = u.pm * 256 + wr * 64 + fr;
        if (T == 2 || T == 3 || T == 5 || T == 6 || T == 14) {
            if (T == 14 && wc >= 2) return;
            if (T == 14 && wc == 1) {
                if (fq < 2) {
#pragma unroll
                    for (int ai = 0; ai < 2; ++ai)
#pragma unroll
                        for (int m = 0; m < 4; ++m) { const int row = row0 + ai * 128 + m * 16; const float rs = row_scale(ssq, row);
                            float* mp = misc + (size_t)row * 16 + 8 * fq; *(f32x4*)mp = acc[ai][0][m][0] * rs; *(f32x4*)(mp + 4) = acc[ai][0][m][1] * rs; }
                }
                return;
            }
            const int mode = (T == 14) ? 2 : (T <= 3 ? 1 : 0);
            const float* gp = gt + 64 * ((T == 2) ? 0 : (T == 3) ? 1 : 2);
            f32x4 g1[2], g2[2];
#pragma unroll
            for (int n = 0; n < 2; ++n) { if (mode) { g1[n] = *(const f32x4*)(gp + 8 * fq + 4 * n); g2[n] = *(const f32x4*)(gp + 32 + 8 * fq + 4 * n); } else { g1[n] = (f32x4){1.f, 1.f, 1.f, 1.f}; g2[n] = g1[n]; } }
#pragma unroll
            for (int ai = 0; ai < 2; ++ai)
#pragma unroll
                for (int m = 0; m < 4; ++m) {
                    const int row = row0 + ai * 128 + m * 16; const float rs = row_scale(ssq, row); const int pos = row & (S - 1);
                    f32x4 x1[2], x2[2];
#pragma unroll
                    for (int n = 0; n < 2; ++n) { x1[n] = acc[ai][0][m][n] * rs; x2[n] = acc[ai][1][m][n] * rs; }
                    if (mode == 2) {
                        float s = 0.f;
#pragma unroll
                        for (int n = 0; n < 2; ++n) s += (x1[n][0] + x1[n][1]) + (x1[n][2] + x1[n][3]) + (x2[n][0] + x2[n][1]) + (x2[n][2] + x2[n][3]);
                        s += __shfl_xor(s, 16); s += __shfl_xor(s, 32); const float mu = s * (1.f / 64.f);
#pragma unroll
                        for (int n = 0; n < 2; ++n) { x1[n] = x1[n] - mu; x2[n] = x2[n] - mu; }
                    }
                    if (mode) {
                        float q = 0.f;
#pragma unroll
                        for (int n = 0; n < 2; ++n) { const f32x4 a = x1[n] * x1[n], b = x2[n] * x2[n]; q += (a[0] + a[1]) + (a[2] + a[3]) + (b[0] + b[1]) + (b[2] + b[3]); }
                        q += __shfl_xor(q, 16); q += __shfl_xor(q, 32); const float rr = rsqrtf(q * (1.f / 64.f) + EPS);
#pragma unroll
                        for (int n = 0; n < 2; ++n) { x1[n] = x1[n] * rr * g1[n]; x2[n] = x2[n] * rr * g2[n]; }
                    }
                    f32x4 o1[2], o2[2];
#pragma unroll
                    for (int n = 0; n < 2; ++n) { const f32x4 c = *(const f32x4*)(cs + (size_t)pos * 32 + 8 * fq + 4 * n), s = *(const f32x4*)(sn + (size_t)pos * 32 + 8 * fq + 4 * n);
                        o1[n] = x1[n] * c - x2[n] * s; o2[n] = x2[n] * c + x1[n] * s; }
                    bf16_t* op = P + (size_t)row * PW + 256 * T + 64 * wc + 8 * fq;
                    *(u32x4*)op = pack8(o1[0], o1[1]); *(u32x4*)(op + 32) = pack8(o2[0], o2[1]);
                    if (T == 14) { bf16_t* kp = KI + (size_t)row * 64 + 8 * fq; *(u32x4*)kp = pack8(o1[0], o1[1]); *(u32x4*)(kp + 32) = pack8(o2[0], o2[1]); }
                }
            return;
        }
        const int act = (T <= 1) ? 1 : 0; const float sc = (T == 8) ? 0.125f : 1.0f;
#pragma unroll
        for (int ai = 0; ai < 2; ++ai)
#pragma unroll
            for (int m = 0; m < 4; ++m) {
                const int row = row0 + ai * 128 + m * 16; const float rs = row_scale(ssq, row) * sc;
                bf16_t* op = P + (size_t)row * PW + 256 * T + 32 * wc + 8 * fq; float qv = 0.f;
#pragma unroll
                for (int bj = 0; bj < 2; ++bj) { f32x4 v0 = acc[ai][bj][m][0] * rs, v1 = acc[ai][bj][m][1] * rs;
                    if (act) {
#pragma unroll
                        for (int e = 0; e < 4; ++e) { v0[e] = gelu_tanh_f(v0[e]); v1[e] = gelu_tanh_f(v1[e]); }
                        const f32x4 a2 = v0 * v0, b2 = v1 * v1; qv += ((a2[0] + a2[1]) + (a2[2] + a2[3])) + ((b2[0] + b2[1]) + (b2[2] + b2[3])); }
                    *(u32x4*)(op + bj * 128) = pack8(v0, v1);
                    if (T == 4 || T == 9) { bf16_t* vp = (T == 4 ? VT : CVT) + ((size_t)((row >> 12) * 256 + bj * 128 + 32 * wc + 8 * fq)) * S + (row & (S - 1));
#pragma unroll
                        for (int e = 0; e < 4; ++e) { vp[(size_t)e * S] = (bf16_t)f2bf(v0[e]); vp[(size_t)(4 + e) * S] = (bf16_t)f2bf(v1[e]); } } }
                if (T == 1) { qv += __shfl_xor(qv, 16); qv += __shfl_xor(qv, 32); if (fq == 0) ssqv[(size_t)row * 4 + wc] = qv; }
            }
    }
};

struct EpiPlain {
    static constexpr bool PERM = true;
    bf16_t* O; int ldc; int zcols;
    __device__ __forceinline__ void operator()(const Acc& acc, const Unit& u, int wr, int wc, int fr, int fq) const {
        const int row0 = u.pm * 256 + wr * 64 + fr; const int col0 = u.z * zcols + u.pn * 256 + 32 * wc + 8 * fq;
#pragma unroll
        for (int ai = 0; ai < 2; ++ai)
#pragma unroll
            for (int m = 0; m < 4; ++m) { bf16_t* op = O + (size_t)(row0 + ai * 128 + m * 16) * ldc + col0;
#pragma unroll
                for (int bj = 0; bj < 2; ++bj) *(u32x4*)(op + bj * 128) = pack8(acc[ai][bj][m][0], acc[ai][bj][m][1]); }
    }
};

struct EpiGate {
    static constexpr bool PERM = true;
    bf16_t* MG; const bf16_t* BR; const float* ssq;
    __device__ __forceinline__ void operator()(const Acc& acc, const Unit& u, int wr, int wc, int fr, int fq) const {
        const int row0 = u.pm * 256 + wr * 64 + fr; const int ch0 = u.pn * 64 + 16 * wc + 4 * fq;
#pragma unroll
        for (int ai = 0; ai < 2; ++ai)
#pragma unroll
            for (int m = 0; m < 4; ++m) {
                const int row = row0 + ai * 128 + m * 16; const float rs = row_scale(ssq, row);
                const bf16_t* bp = BR + (size_t)row * 4096 + ch0; f32x4 o = (f32x4){0.f, 0.f, 0.f, 0.f};
#pragma unroll
                for (int bj = 0; bj < 2; ++bj)
#pragma unroll
                    for (int n = 0; n < 2; ++n) { const u32x2 w = *(const u32x2*)(bp + (2 * bj + n) * 1024); const f32x4 a = acc[ai][bj][m][n] * rs;
                        o[0] += sigmoid_f(a[0]) * lo_bf(w.x); o[1] += sigmoid_f(a[1]) * hi_bf(w.x); o[2] += sigmoid_f(a[2]) * lo_bf(w.y); o[3] += sigmoid_f(a[3]) * hi_bf(w.y); }
                u32x2 ow; ow.x = cvt_pk_bf16(o[0], o[1]); ow.y = cvt_pk_bf16(o[2], o[3]);
                *(u32x2*)(MG + (size_t)row * 1024 + ch0) = ow;
            }
    }
};

struct EpiResid {
    static constexpr bool PERM = true;
    const float* res; float* out; bf16_t* XG; const float* gain; float* ssq;
    __device__ __forceinline__ void operator()(const Acc& acc, const Unit& u, int wr, int wc, int fr, int fq) const {
        const int row0 = u.pm * 256 + wr * 64 + fr; const int col0 = u.pn * 256 + 32 * wc + 8 * fq;
        f32x4 gv[2][2];
#pragma unroll
        for (int bj = 0; bj < 2; ++bj)
#pragma unroll
            for (int n = 0; n < 2; ++n) gv[bj][n] = gain ? *(const f32x4*)(gain + col0 + bj * 128 + 4 * n) : (f32x4){1.f, 1.f, 1.f, 1.f};
#pragma unroll
        for (int ai = 0; ai < 2; ++ai)
#pragma unroll
            for (int m = 0; m < 4; ++m) {
                const int row = row0 + ai * 128 + m * 16; const size_t off = (size_t)row * 1024 + col0; float q = 0.f;
#pragma unroll
                for (int bj = 0; bj < 2; ++bj) {
                    const f32x4 r0 = *(const f32x4*)(res + off + bj * 128), r1 = *(const f32x4*)(res + off + bj * 128 + 4);
                    const f32x4 x0 = r0 + acc[ai][bj][m][0], x1 = r1 + acc[ai][bj][m][1];
                    *(f32x4*)(out + off + bj * 128) = x0; *(f32x4*)(out + off + bj * 128 + 4) = x1;
                    const f32x4 a = x0 * x0, b = x1 * x1; q += ((a[0] + a[1]) + (a[2] + a[3])) + ((b[0] + b[1]) + (b[2] + b[3]));
                    *(u32x4*)(XG + off + bj * 128) = pack8(x0 * gv[bj][0], x1 * gv[bj][1]);
                }
                q += __shfl_xor(q, 16); q += __shfl_xor(q, 32);
                if (fq == 0) ssq[(size_t)row * 16 + 4 * u.pn + wc] = q;
            }
    }
};

struct EpiUp {
    static constexpr bool PERM = true;
    bf16_t* H; const float* ssq;
    __device__ __forceinline__ void operator()(const Acc& acc, const Unit& u, int wr, int wc, int fr, int fq) const {
        const int row0 = u.pm * 256 + wr * 64 + fr; const int col0 = u.pn * 256 + 32 * wc + 8 * fq;
#pragma unroll
        for (int ai = 0; ai < 2; ++ai)
#pragma unroll
            for (int m = 0; m < 4; ++m) { const int row = row0 + ai * 128 + m * 16; const float rs = row_scale(ssq, row); bf16_t* op = H + (size_t)row * FF + col0;
#pragma unroll
                for (int bj = 0; bj < 2; ++bj) { f32x4 v0 = acc[ai][bj][m][0] * rs, v1 = acc[ai][bj][m][1] * rs;
#pragma unroll
                    for (int e = 0; e < 4; ++e) { v0[e] = fmaxf(v0[e], 0.f); v1[e] = fmaxf(v1[e], 0.f); }
                    *(u32x4*)(op + bj * 128) = pack8(v0 * v0, v1 * v1); } }
    }
};
}
struct Args {
    const float* in[18]; float* out; unsigned char* ws; int ph_lo, ph_hi; int coop, pad;
};
struct Frame { LAS unsigned char* lds; int tid, lane, wave, G, vcu; };
constexpr int PTR_OFF = LDS_BYTES - 512;
enum { I_X = 0, I_LN_MIX, I_W_IN, I_SGU_NORM, I_SGU_W, I_SGU_B, I_Q_NORM, I_K_NORM, I_KIDX_NORM, I_I_BIAS, I_F_BIAS, I_MNORM, I_CONV_W, I_W_BRANCH, I_W_OUT, I_LN_MLP, I_W_UP, I_W_DOWN, I_OUT, I_WS };
__device__ __forceinline__ unsigned char* ptr_at(const Frame& F, int i) { const LAS unsigned* p = (const LAS unsigned*)(F.lds + PTR_OFF) + 2 * i;
    const unsigned lo = __builtin_amdgcn_readfirstlane(p[0]), hi = __builtin_amdgcn_readfirstlane(p[1]); return (unsigned char*)(((unsigned long long)hi << 32) | lo); }
#define INP(i) ((const float*)ptr_at(F, (i)))
#define WSP(off) (ptr_at(F, I_WS) + (off))
constexpr size_t WS_GT = 512 * 1024;
__device__ __forceinline__ size_t maskt_idx(int m, int w) { const int b = m >> 12, t = m & (S - 1); return ((size_t)(b * 64 + (w >> 1)) * S + t) * 2 + (w & 1); }


#define XB_TMO      128
#define XB_XCNT(j)  (256  + 64 * (j))
#define XB_XSUB(j)  (1280 + 64 * (j))
#define XB_XGEN(j)  (2304 + 64 * (j))
#define XB_TOP      3328
#define XB_TOPGEN   3392
#define XCD_BAR_WORDS 3456
#define XB_SPIN_CAP (1u << 22)
constexpr size_t WS_BAR = 64 * 1024;
constexpr size_t CTL_ZERO_BYTES = 128 * 1024;
__device__ __forceinline__ unsigned xb_ld(unsigned* p)              { return __hip_atomic_load(p, __ATOMIC_RELAXED, __HIP_MEMORY_SCOPE_AGENT); }
__device__ __forceinline__ unsigned xb_add(unsigned* p, unsigned v) { return __hip_atomic_fetch_add(p, v, __ATOMIC_RELAXED, __HIP_MEMORY_SCOPE_AGENT); }
__device__ __forceinline__ unsigned xb_xcc_id() { return (unsigned)__builtin_amdgcn_s_getreg((3 << 11) | 20) & 0xFu; }
#define XB_SPIN(cond, bar) do { unsigned _sp = 0; while (cond) { __builtin_amdgcn_s_sleep(1); \
    if ((++_sp & 255u) == 0u) { if (xb_ld(&(bar)[XB_TMO])) break; if (_sp > XB_SPIN_CAP) { atomicAdd(&(bar)[XB_TMO], 1u); break; } } } } while (0)
struct XcdBarrier { unsigned* bar; unsigned x; volatile LAS unsigned* st; };
__device__ __forceinline__ XcdBarrier xcd_barrier_post(unsigned* bar, volatile LAS unsigned* st) {
    XcdBarrier b; b.bar = bar; b.x = xb_xcc_id(); b.st = st;
    if (threadIdx.x == 0) (void)xb_add(&bar[XB_XCNT(b.x)], 1u);
    return b;
}
__device__ __forceinline__ void xcd_barrier_complete(unsigned* bar, unsigned x, unsigned& nloc, unsigned& nx) {
    const unsigned G = gridDim.x * gridDim.y * gridDim.z;
    unsigned sum, cnt, mine, sp = 0u;
    for (;;) {
        sum = 0u; cnt = 0u; mine = 0u;
#pragma unroll
        for (unsigned j = 0; j < 16; ++j) { const unsigned c = xb_ld(&bar[XB_XCNT(j)]); sum += c; cnt += (c > 0u) ? 1u : 0u; mine = (j == x) ? c : mine; }
        if (sum == G) break;
        __builtin_amdgcn_s_sleep(1);
        if ((++sp & 255u) == 0u) { if (xb_ld(&bar[XB_TMO])) break; if (sp > XB_SPIN_CAP) { atomicAdd(&bar[XB_TMO], 1u); break; } }
    }
    nloc = mine > 0u ? mine : 1u; nx = cnt > 0u ? cnt : 1u;
}
__device__ __forceinline__ void xcd_barrier(const XcdBarrier& b) {
    asm volatile("s_waitcnt vmcnt(0)" ::: "memory");
    __syncthreads();
    if (threadIdx.x == 0) {
        unsigned* bar = b.bar;
        __builtin_amdgcn_s_waitcnt(0);
        unsigned nloc = b.st[0], nx = b.st[1];
        if (nloc == 0u) { xcd_barrier_complete(bar, b.x, nloc, nx); b.st[0] = nloc; b.st[1] = nx; }
        const unsigned old = xb_add(&bar[XB_XSUB(b.x)], 1u);
        const unsigned gen = old / nloc;
        if (old + 1u == (gen + 1u) * nloc) {
            __builtin_amdgcn_fence(__ATOMIC_RELEASE, "agent");
            asm volatile("s_waitcnt vmcnt(0)" ::: "memory");
            const unsigned og = xb_add(&bar[XB_TOP], 1u);
            const unsigned tg = og / nx;
            if (og + 1u == (tg + 1u) * nx) xb_add(&bar[XB_TOPGEN], 1u);
            else XB_SPIN(xb_ld(&bar[XB_TOPGEN]) == tg, bar);
            __builtin_amdgcn_fence(__ATOMIC_ACQUIRE, "agent");
            xb_add(&bar[XB_XGEN(b.x)], 1u);
            asm volatile("s_waitcnt vmcnt(0)" ::: "memory");
        } else {
            XB_SPIN(xb_ld(&bar[XB_XGEN(b.x)]) == gen, bar);
            __builtin_amdgcn_fence(__ATOMIC_ACQUIRE, "agent");
            asm volatile("s_waitcnt vmcnt(0)" ::: "memory");
        }
    }
    __syncthreads();
}

__device__ __forceinline__ int win_src(int p) {
    const int T = p >> 8, q = p & 255, bj = q >> 7, wc = (q >> 5) & 3, j = q & 31, hd = 64 * wc + 32 * bj + j;
    switch (T) {
        case 0: return O_AU + q; case 1: return O_AV + q; case 2: return O_BQ + hd; case 3: return O_BK + hd; case 4: return O_BV + q;
        case 5: return O_QI + hd; case 6: return O_QI + 256 + hd; case 7: return O_CQ + q; case 8: return O_CK + q; case 9: return O_CV + q;
        case 10: return O_CO + q; case 11: return O_DB + q; case 12: return O_DC + q; case 13: return O_DX + q;
        default: break;
    }
    if (wc == 0) return O_KI + 32 * bj + j;
    if (wc == 1 && bj == 0 && j < 16) return j < 8 ? O_WI + j : (j < 12 ? O_CI + (j - 8) : O_CF + (j - 12));
    return -1;
}
__device__ __forceinline__ int wg_src(int p) {
    const int pn = p >> 8, q = p & 255, bj = q >> 7, wc = (q >> 5) & 3, fq = (q >> 3) & 3, n = (q >> 2) & 1, e = q & 3;
    return O_G + (2 * bj + n) * 1024 + 64 * pn + 16 * wc + 4 * fq + e;
}
template <int MAP>
__device__ __forceinline__ void conv_item(const float* W, int K, int srcN, bf16_t* WT, LAS float* scr, int item, int nrows, int lane) {
    const int nblk = nrows / 32, kb = item / nblk, nb = item % nblk, k0 = 64 * kb, n0 = 32 * nb;
    const int nn = n0 + (lane & 31); const int src = MAP == 0 ? nn : (MAP == 1 ? win_src(nn) : wg_src(nn));
#pragma unroll 8
    for (int i = 0; i < 32; ++i) { const int kk = 2 * i + (lane >> 5); scr[kk * 33 + (lane & 31)] = src >= 0 ? W[(size_t)(k0 + kk) * srcN + src] : 0.f; }
    asm volatile("s_waitcnt lgkmcnt(0)" ::: "memory");
    const int c = lane & 7;
#pragma unroll
    for (int j = 0; j < 4; ++j) { const int n = (lane >> 3) + 8 * j; const LAS float* s = scr + (8 * c) * 33 + n;
        u32x4 o; o.x = pk2(s[0 * 33], s[1 * 33]); o.y = pk2(s[2 * 33], s[3 * 33]); o.z = pk2(s[4 * 33], s[5 * 33]); o.w = pk2(s[6 * 33], s[7 * 33]);
        *(u32x4*)(WT + (size_t)(n0 + n) * K + k0 + 8 * c) = o; }
    asm volatile("s_waitcnt lgkmcnt(0)" ::: "memory");
}
__device__ __forceinline__ void convert_mix_weights(Frame& F, int l) {

    LAS float* scr = (LAS float*)(F.lds + F.wave * 16384);
    const int gw = F.vcu * NWAVES + F.wave, NGW = F.G * NWAVES;
    constexpr int I_WIN = (D / 64) * (PW / 32), I_WG = (D / 64) * (4096 / 32), I_BR = (256 / 64) * (1024 / 32), I_OUT = (D / 64) * (D / 32);
    constexpr int NIT = I_WIN + I_WG + 4 * I_BR + I_OUT;
    const float* win = INP(I_W_IN) + (size_t)l * D * INW;
    for (int it = gw; it < NIT; it += NGW) {
        int r = it;
        if (r < I_WIN) { conv_item<1>(win, D, INW, ((bf16_t*)WSP(WS_WIN)), scr, r, PW, F.lane); continue; } r -= I_WIN;
        if (r < I_WG) { conv_item<2>(win, D, INW, ((bf16_t*)WSP(WS_WG)), scr, r, 4096, F.lane); continue; } r -= I_WG;
        if (r < 4 * I_BR) { const int nb = r / I_BR; conv_item<0>(INP(I_W_BRANCH) + ((size_t)l * 4 + nb) * 256 * D, 256, D, ((bf16_t*)WSP(WS_WBR)) + (size_t)nb * 1024 * 256, scr, r % I_BR, 1024, F.lane); continue; } r -= 4 * I_BR;
        conv_item<0>(INP(I_W_OUT) + (size_t)l * D * D, D, D, ((bf16_t*)WSP(WS_WOUT)), scr, r, D, F.lane);
    }
}
__device__ __forceinline__ void convert_mlp_weights(Frame& F, int l) {

    LAS float* scr = (LAS float*)(F.lds + F.wave * 16384);
    const int gw = F.vcu * NWAVES + F.wave, NGW = F.G * NWAVES;
    constexpr int I_UP = (D / 64) * (FF / 32), I_DN = (FF / 64) * (D / 32);
    for (int it = gw; it < I_UP + I_DN; it += NGW) {
        if (it < I_UP) conv_item<0>(INP(I_W_UP) + (size_t)l * D * FF, D, FF, ((bf16_t*)WSP(WS_WUP)), scr, it, FF, F.lane);
        else conv_item<0>(INP(I_W_DOWN) + (size_t)l * FF * D, FF, D, ((bf16_t*)WSP(WS_WDN)), scr, it - I_UP, D, F.lane);
    }
}
__device__ __forceinline__ void prologue_rows(Frame& F) {
    float* COS = (float*)WSP(WS_COS); float* SIN = (float*)WSP(WS_SIN); float* SSQA = (float*)WSP(WS_SSQA); bf16_t* XG = (bf16_t*)WSP(WS_XG); const float* x = INP(I_X); const float* ln_mix = INP(I_LN_MIX);
    const int gt = F.vcu * NT + F.tid, NGT = F.G * NT;
    for (int i = gt; i < S * 32; i += NGT) { const int pos = i >> 5, k = i & 31; const float inv = powf(10000.f, -(float)k * 2.0f / 64.f); const float ang = (float)pos * inv; COS[i] = cosf(ang); SIN[i] = sinf(ang); }
    const int gw = F.vcu * NWAVES + F.wave, NGW = F.G * NWAVES;
    for (int m = gw; m < M; m += NGW) {
        const f32x4* xr = (const f32x4*)(x + (size_t)m * D) + F.lane; const f32x4* gr = (const f32x4*)ln_mix + F.lane;
        unsigned long long* o8 = (unsigned long long*)(XG + (size_t)m * D) + F.lane;
#pragma unroll
        for (int j = 0; j < 4; ++j) { const f32x4 v = xr[64 * j], g = gr[64 * j]; float s = (v[0] * v[0] + v[1] * v[1]) + (v[2] * v[2] + v[3] * v[3]);
            s += __shfl_xor(s, 1); s += __shfl_xor(s, 2); s += __shfl_xor(s, 4); s += __shfl_xor(s, 8);
            if ((F.lane & 15) == 0) SSQA[(size_t)m * 16 + 4 * j + (F.lane >> 4)] = s;
            o8[64 * j] = (unsigned long long)pk2(v[0] * g[0], v[1] * g[1]) | ((unsigned long long)pk2(v[2] * g[2], v[3] * g[3]) << 32); }
    }
}

__device__ __forceinline__ void sgu_simple(Frame& F, int l) {
    bf16_t* PROJ = (bf16_t*)WSP(WS_BIG); bf16_t* Y = (bf16_t*)WSP(WS_Y); const float* sgu_norm = INP(I_SGU_NORM); const float* sgu_w = INP(I_SGU_W); const float* sgu_b = INP(I_SGU_B);
    LAS float* r_s = (LAS float*)F.lds; LAS float* vn = r_s + 128;
    const float* gain = sgu_norm + l * 256; const float* sw = sgu_w + (size_t)l * 4 * 128 * 128; const float* sb = sgu_b + l * 4 * 128;
    for (int item = F.vcu; item < 512; item += F.G) {
        const int g = item & 3, m0 = (item >> 2) * 128;
        for (int i = 0; i < 16; ++i) { const int tok = F.wave * 16 + i; const u32x2 w = *(const u32x2*)(PROJ + (size_t)(m0 + tok) * PW + P_AV + 4 * F.lane);
            const float a = lo_bf(w.x), b = hi_bf(w.x), c = lo_bf(w.y), d = hi_bf(w.y); const float ss = wave_sum((a * a + b * b) + (c * c + d * d));
            if (F.lane == 0) r_s[tok] = rsqrtf(ss * (1.f / 256.f) + EPS); }
        __syncthreads();
        for (int idx = F.tid; idx < 8192; idx += NT) { const int s = idx >> 6, d = idx & 63; vn[idx] = bf2f(PROJ[(size_t)(m0 + s) * PW + P_AV + g * 64 + d]) * r_s[s] * gain[g * 64 + d]; }
        __syncthreads();
        const int d = F.tid & 63, tq = F.tid >> 6;
        for (int tl = tq; tl < 128; tl += 8) { const float* w = sw + ((size_t)g * 128 + tl) * 128; float acc = 0.f;
            for (int s = 0; s <= tl; ++s) acc = fmaf(w[s], vn[s * 64 + d], acc);
            acc += sb[g * 128 + tl];
            Y[(size_t)(m0 + tl) * D + g * 64 + d] = (bf16_t)f2bf(bf2f(PROJ[(size_t)(m0 + tl) * PW + P_AU + g * 64 + d]) * acc); }
        __syncthreads();
    }
}
__device__ __forceinline__ void conv_simple(Frame& F, int l) {
    bf16_t* PROJ = (bf16_t*)WSP(WS_BIG); bf16_t* Y = (bf16_t*)WSP(WS_Y); const float* conv_w = INP(I_CONV_W);
    const float* cw = conv_w + l * 3 * 256;
    for (int i = F.vcu * NT + F.tid; i < M * 256; i += F.G * NT) { const int m = i >> 8, c = i & 255, t = m & (S - 1); float acc = 0.f;
#pragma unroll
        for (int j = 0; j < 3; ++j) { const int tt = t - 2 + j; if (tt >= 0) { const size_t r = (size_t)(m - 2 + j) * PW; acc = fmaf(cw[j * 256 + c], bf2f(PROJ[r + P_DC + c]) * bf2f(PROJ[r + P_DX + c]), acc); } }
        Y[(size_t)m * D + 768 + c] = (bf16_t)f2bf(bf2f(PROJ[(size_t)m * PW + P_DB + c]) * acc); }
}
__device__ __forceinline__ void indexer_simple(Frame& F) {
    float* MISC = (float*)WSP(WS_MISC); unsigned* MASK = (unsigned*)WSP(WS_MASK); bf16_t* PROJ = (bf16_t*)WSP(WS_BIG);
    LAS float* sc = (LAS float*)F.lds; LAS int* red = (LAS int*)(sc + 4096); LAS unsigned* msk = (LAS unsigned*)(red + 16);
    for (int m = F.vcu; m < M; m += F.G) {
        const int t = m & (S - 1), b0 = m - t, n = t + 1;
        if (n <= 256) { if (F.tid < 128) { const int lo = 32 * F.tid; MASK[maskt_idx(m, F.tid)] = (lo + 32 <= n) ? 0xffffffffu : (lo >= n ? 0u : ((1u << (n - lo)) - 1u)); } continue; }
        float qreg[8], wh[8];
#pragma unroll
        for (int h = 0; h < 8; ++h) { qreg[h] = bf2f(PROJ[(size_t)m * PW + P_QI + h * 64 + F.lane]); wh[h] = MISC[(size_t)m * 16 + h] * 0.35355339059327373f; }
        for (int s0 = 0; s0 < n; s0 += NT) {
            const int s = s0 + F.tid, sc_ = s < n ? s : n - 1; const u32x4* kr = (const u32x4*)(PROJ + (size_t)(b0 + sc_) * PW + P_KI);
            float kf[64];
#pragma unroll
            for (int i = 0; i < 8; ++i) { const u32x4 w = kr[i]; kf[8 * i] = lo_bf(w.x); kf[8 * i + 1] = hi_bf(w.x); kf[8 * i + 2] = lo_bf(w.y); kf[8 * i + 3] = hi_bf(w.y); kf[8 * i + 4] = lo_bf(w.z); kf[8 * i + 5] = hi_bf(w.z); kf[8 * i + 6] = lo_bf(w.w); kf[8 * i + 7] = hi_bf(w.w); }
            float acc = 0.f;
#pragma unroll
            for (int h = 0; h < 8; ++h) { float d0 = 0.f, d1 = 0.f;
#pragma unroll
                for (int e = 0; e < 64; e += 2) { d0 = fmaf(__builtin_bit_cast(float, __builtin_amdgcn_readlane(__builtin_bit_cast(int, qreg[h]), e)), kf[e], d0);
                                                   d1 = fmaf(__builtin_bit_cast(float, __builtin_amdgcn_readlane(__builtin_bit_cast(int, qreg[h]), e + 1)), kf[e + 1], d1); }
                acc += wh[h] * fmaxf((d0 + d1) * 0.125f, 0.f); }
            if (s < n) sc[s] = acc;
        }
        __syncthreads();
        unsigned Tk = 0u;
        for (int bit = 31; bit >= 0; --bit) {
            const unsigned cand = Tk | (1u << bit); int c = 0;
            for (int s = F.tid; s < n; s += NT) c += (fkey(sc[s]) >= cand) ? 1 : 0;
            c = wave_sum_i(c); if (F.lane == 0) red[F.wave] = c; __syncthreads();
            int tot = 0;
#pragma unroll
            for (int w = 0; w < 8; ++w) tot += red[w];
            __syncthreads();
            if (tot >= 256) Tk = cand;
        }
        int cg_ = 0, ce = 0;
        for (int s = F.tid; s < n; s += NT) { const unsigned k = fkey(sc[s]); cg_ += k > Tk ? 1 : 0; ce += k == Tk ? 1 : 0; }
        cg_ = wave_sum_i(cg_); ce = wave_sum_i(ce); if (F.lane == 0) { red[F.wave] = cg_; red[8 + F.wave] = ce; }
        if (F.tid < 128) msk[F.tid] = 0u;
        __syncthreads();
        int ngt = 0, neq = 0;
#pragma unroll
        for (int w = 0; w < 8; ++w) { ngt += red[w]; neq += red[8 + w]; }
        const bool all_eq = (ngt + neq == 256);
        for (int s = F.tid; s < n; s += NT) { const unsigned k = fkey(sc[s]); if (k > Tk || (all_eq && k == Tk)) atomicOr((unsigned*)&msk[s >> 5], 1u << (s & 31)); }
        __syncthreads();
        if (!all_eq && F.tid == 0) { int need = 256 - ngt; for (int s = 0; s < n && need > 0; ++s) if (fkey(sc[s]) == Tk) { msk[s >> 5] |= 1u << (s & 31); --need; } }
        __syncthreads();
        if (F.tid < 128) MASK[maskt_idx(m, F.tid)] = msk[F.tid];
        __syncthreads();
    }
}
__device__ __forceinline__ void attn_simple(Frame& F) {
    unsigned* MASK = (unsigned*)WSP(WS_MASK); bf16_t* PROJ = (bf16_t*)WSP(WS_BIG); bf16_t* Y = (bf16_t*)WSP(WS_Y);
    LAS unsigned* msk = (LAS unsigned*)F.lds; LAS int* sel = (LAS int*)(msk + 128); LAS float* lg = (LAS float*)(sel + 256); LAS int* nsel = (LAS int*)(lg + 4 * 256);
    for (int m = F.vcu; m < M; m += F.G) {
        const int t = m & (S - 1), b0 = m - t;
        if (F.tid < 128) msk[F.tid] = MASK[maskt_idx(m, F.tid)];
        __syncthreads();
        if (F.tid == 0) { int c = 0; for (int w = 0; w < 128; ++w) { unsigned bits = msk[w]; while (bits) { const int i = __builtin_ctz(bits); if (c < 256) sel[c] = 32 * w + i; ++c; bits &= bits - 1; } } nsel[0] = c < 256 ? c : 256; }
        __syncthreads();
        const int ns = nsel[0], h = F.wave & 3, part = F.wave >> 2;
        const float q = bf2f(PROJ[(size_t)m * PW + P_Q + h * 64 + F.lane]);
        for (int j = part; j < ns; j += 2) { const float d = wave_sum(q * bf2f(PROJ[(size_t)(b0 + sel[j]) * PW + P_K + h * 64 + F.lane])); if (F.lane == 0) lg[h * 256 + j] = d * 0.125f; }
        __syncthreads();
        if (F.wave < 4) {
            float mx = -INFINITY; for (int j = F.lane; j < ns; j += 64) mx = fmaxf(mx, lg[h * 256 + j]); mx = wave_max(mx);
            float sm = 0.f; for (int j = F.lane; j < ns; j += 64) sm += __expf(lg[h * 256 + j] - mx); sm = wave_sum(sm);
            float o = 0.f; for (int j = 0; j < ns; ++j) o = fmaf(__expf(lg[h * 256 + j] - mx), bf2f(PROJ[(size_t)(b0 + sel[j]) * PW + P_V + h * 64 + F.lane]), o);
            Y[(size_t)m * D + 256 + h * 64 + F.lane] = (bf16_t)f2bf(o / sm);
        }
        __syncthreads();
    }
}
__device__ __forceinline__ void mlstm1_simple(Frame& F, int l) {
    float* MISC = (float*)WSP(WS_MISC); float* STATE = (float*)WSP(WS_STATE); bf16_t* PROJ = (bf16_t*)WSP(WS_BIG); const float* i_bias = INP(I_I_BIAS); const float* f_bias = INP(I_F_BIAS);
    LAS float* bs = (LAS float*)F.lds; LAS float* ig = bs + 128; LAS float* wk = ig + 128; LAS float* kt = wk + 128; LAS float* vt = kt + 128 * 64;
    for (int item = F.vcu; item < 512; item += F.G) {
        const int bh = item >> 5, c = item & 31, b = bh >> 2, h = bh & 3, m0 = b * S + c * 128;
        if (F.tid < 128) { const float f = MISC[(size_t)(m0 + F.tid) * 16 + 12 + h] + f_bias[l * 4 + h]; bs[F.tid] = fminf(f, 0.f) - log1pf(__expf(-fabsf(f))); ig[F.tid] = MISC[(size_t)(m0 + F.tid) * 16 + 8 + h] + i_bias[l * 4 + h]; }
        for (int idx = F.tid; idx < 8192; idx += NT) { const int s = idx >> 6, d = idx & 63; kt[idx] = bf2f(PROJ[(size_t)(m0 + s) * PW + P_CK + h * 64 + d]); vt[idx] = bf2f(PROJ[(size_t)(m0 + s) * PW + P_CV + h * 64 + d]); }
        __syncthreads();
        if (F.tid == 0) { float a = 0.f; for (int s = 0; s < 128; ++s) { a += bs[s]; bs[s] = a; } }
        __syncthreads();
        const float B = bs[127];
        if (F.tid < 128) wk[F.tid] = __expf(B - bs[F.tid] + ig[F.tid]);
        __syncthreads();
        const int e = F.tid & 63, dq = F.tid >> 6; float acc[8];
#pragma unroll
        for (int i = 0; i < 8; ++i) acc[i] = 0.f;
        for (int s = 0; s < 128; ++s) { const float kv = wk[s] * vt[s * 64 + e];
#pragma unroll
            for (int i = 0; i < 8; ++i) acc[i] = fmaf(kt[s * 64 + dq * 8 + i], kv, acc[i]); }
        float* st = STATE + (size_t)item * STATE_STRIDE;
#pragma unroll
        for (int i = 0; i < 8; ++i) st[e * 64 + dq * 8 + i] = acc[i];
        if (F.tid < 64) { float a = 0.f; for (int s = 0; s < 128; ++s) a = fmaf(wk[s], kt[s * 64 + F.tid], a); st[4096 + F.tid] = a; }
        if (F.tid == 0) st[4160] = B;
        __syncthreads();
    }
}
__device__ __forceinline__ void mlstm2_simple(Frame& F, int l) {
    float* MISC = (float*)WSP(WS_MISC); float* STATE = (float*)WSP(WS_STATE); bf16_t* PROJ = (bf16_t*)WSP(WS_BIG); bf16_t* Y = (bf16_t*)WSP(WS_Y); const float* i_bias = INP(I_I_BIAS); const float* f_bias = INP(I_F_BIAS); const float* mnorm = INP(I_MNORM);
    LAS float* Cs = (LAS float*)F.lds; LAS float* ns = Cs + 4096; LAS float* bs = ns + 64; LAS float* ig = bs + 128; LAS float* A = ig + 128;
    LAS float* qt = A + 128 * 128; LAS float* kt = qt + 128 * 65;
    for (int item = F.vcu; item < 512; item += F.G) {
        const int bh = item >> 5, c = item & 31, b = bh >> 2, h = bh & 3, m0 = b * S + c * 128;
        { float Cv[8]; float nv = 0.f;
#pragma unroll
          for (int k = 0; k < 8; ++k) Cv[k] = 0.f;
          for (int cc = 0; cc < c; ++cc) { const float* st = STATE + (size_t)(bh * 32 + cc) * STATE_STRIDE; const float dec = __expf(st[4160]);
#pragma unroll
              for (int k = 0; k < 8; ++k) Cv[k] = fmaf(dec, Cv[k], st[F.tid + NT * k]);
              if (F.tid < 64) nv = fmaf(dec, nv, st[4096 + F.tid]); }
#pragma unroll
          for (int k = 0; k < 8; ++k) Cs[F.tid + NT * k] = Cv[k];
          if (F.tid < 64) ns[F.tid] = nv; }
        if (F.tid < 128) { const float f = MISC[(size_t)(m0 + F.tid) * 16 + 12 + h] + f_bias[l * 4 + h]; bs[F.tid] = fminf(f, 0.f) - log1pf(__expf(-fabsf(f))); ig[F.tid] = MISC[(size_t)(m0 + F.tid) * 16 + 8 + h] + i_bias[l * 4 + h]; }
        for (int idx = F.tid; idx < 8192; idx += NT) { const int s = idx >> 6, d = idx & 63; qt[s * 65 + d] = bf2f(PROJ[(size_t)(m0 + s) * PW + P_CQ + h * 64 + d]); kt[s * 65 + d] = bf2f(PROJ[(size_t)(m0 + s) * PW + P_CK + h * 64 + d]); }
        __syncthreads();
        if (F.tid == 0) { float a = 0.f; for (int s = 0; s < 128; ++s) { a += bs[s]; bs[s] = a; } }
        __syncthreads();
        { const int s = F.tid & 127, jq = F.tid >> 7;
          for (int j = jq; j < 128; j += 4) { float v = 0.f;
              if (s <= j) { float d = 0.f;
#pragma unroll 16
                  for (int k = 0; k < 64; ++k) d = fmaf(qt[j * 65 + k], kt[s * 65 + k], d);
                  v = __expf(bs[j] - bs[s] + ig[s]) * d; }
              A[j * 128 + s] = v; } }
        __syncthreads();
        LAS float* vt = kt;
        for (int idx = F.tid; idx < 8192; idx += NT) { const int s = idx >> 6, d = idx & 63; vt[idx] = bf2f(PROJ[(size_t)(m0 + s) * PW + P_CV + h * 64 + d]); }
        __syncthreads();
        const int e = F.lane; const float gn = mnorm[l * 256 + h * 64 + e];
        for (int j = F.wave; j < 128; j += 8) {
            float num = 0.f, qn = 0.f, sa = 0.f;
            for (int d = 0; d < 64; ++d) { const float qd = qt[j * 65 + d]; num = fmaf(qd, Cs[d * 64 + e], num); qn = fmaf(qd, ns[d], qn); }
            const float eb = __expf(bs[j]); num *= eb; qn *= eb;
            for (int s = 0; s <= j; ++s) { const float a = A[j * 128 + s]; num = fmaf(a, vt[s * 64 + e], num); sa += a; }
            const float hv = num / fmaxf(fabsf(qn + sa), 1.f);
            const float r = rsqrtf(wave_sum(hv * hv) * (1.f / 64.f) + EPS);
            const size_t row = (size_t)(m0 + j);
            Y[row * D + 512 + h * 64 + e] = (bf16_t)f2bf(sigmoid_f(bf2f(PROJ[row * PW + P_CO + h * 64 + e])) * hv * r * gn);
        }
        __syncthreads();
    }
}
typedef float f32x16 __attribute__((ext_vector_type(16)));
constexpr size_t WS_VT = WS_BIG + 120 * MiB;
constexpr float LOG2E = 1.4426950408889634f;

__device__ __forceinline__ void attn_mfma(Frame& F, int l) {
    const unsigned long long* MASKT = (const unsigned long long*)WSP(WS_MASK); const bf16_t* PROJ = (const bf16_t*)WSP(WS_BIG); const bf16_t* VT = (const bf16_t*)WSP(WS_VT);
    bf16_t* Y = (bf16_t*)WSP(WS_Y); const float* gt = (const float*)WSP(WS_GT) + l * 192;
    const int lane = F.lane, r32 = lane & 31, hi = lane >> 5, grp = F.wave >> 2, w4 = F.wave & 3, lg = F.tid & 255;
    const float mq = wave_max(fabsf(gt[lane])), mk = wave_max(fabsf(gt[64 + lane]));
    const float c1 = 0.125f * LOG2E, c2 = 8.f * mq * mk * 1.01f * LOG2E;
    constexpr int ROWB = 144, TILEB = 64 * ROWB;
    LAS unsigned char* gb = F.lds + grp * 4 * TILEB;
    LAS float* comb = (LAS float*)(F.lds + 8 * TILEB);
    const int srow0 = lg >> 3, sc0 = lg & 7;
    for (int item = F.vcu; item < 256; item += F.G) {
        const int bh = item >> 4, sidx = item & 15, b = bh >> 2, h = bh & 3;
#pragma unroll 1
        for (int half = 0; half < 2; ++half) {
            const int qb = half == 0 ? sidx : 31 - sidx, q0 = qb * 128, ntl = qb + 1;
            const int qrow = b * S + q0 + w4 * 32 + r32, tq = q0 + w4 * 32 + r32;
            bf16x8 qf[4];
#pragma unroll
            for (int s = 0; s < 4; ++s) qf[s] = *(const bf16x8*)(PROJ + (size_t)qrow * PW + P_Q + h * 64 + 16 * s + 8 * hi);
            f32x16 o0, o1;
#pragma unroll
            for (int r = 0; r < 16; ++r) { o0[r] = 0.f; o1[r] = 0.f; }
            float lsum = 0.f;
            const bf16_t* kbase = PROJ + (size_t)(b * S + srow0) * PW + P_K + h * 64 + sc0 * 8;
            const bf16_t* vbase = VT + (size_t)(b * 256 + h * 64 + srow0) * S + sc0 * 8;
            const unsigned long long* mbase = MASKT + (size_t)(b * 64) * S + tq;
            u32x4 kr0, kr1, vr0, vr1; unsigned long long mw, mwn = 0ull;
            { const int t = grp; kr0 = *(const u32x4*)(kbase + (size_t)t * 64 * PW); kr1 = *(const u32x4*)(kbase + (size_t)(t * 64 + 32) * PW);
              vr0 = *(const u32x4*)(vbase + t * 64); vr1 = *(const u32x4*)(vbase + 32 * S + t * 64); mw = mbase[(size_t)t * S];
              LAS unsigned char* kb = gb; LAS unsigned char* vb = gb + TILEB;
              *(LAS u32x4*)(kb + srow0 * ROWB + sc0 * 16) = kr0; *(LAS u32x4*)(kb + (srow0 + 32) * ROWB + sc0 * 16) = kr1;
              *(LAS u32x4*)(vb + srow0 * ROWB + sc0 * 16) = vr0; *(LAS u32x4*)(vb + (srow0 + 32) * ROWB + sc0 * 16) = vr1; }
            __syncthreads();
#pragma unroll 1
            for (int i = 0; i < ntl; ++i) {
                const int cur = i & 1; const bool more = (i + 1 < ntl);
                if (more) { const int t = 2 * (i + 1) + grp; kr0 = *(const u32x4*)(kbase + (size_t)t * 64 * PW); kr1 = *(const u32x4*)(kbase + (size_t)(t * 64 + 32) * PW);
                    vr0 = *(const u32x4*)(vbase + t * 64); vr1 = *(const u32x4*)(vbase + 32 * S + t * 64); mwn = mbase[(size_t)t * S]; }
                const LAS unsigned char* kb = gb + cur * 2 * TILEB; const LAS unsigned char* vb = kb + TILEB;
                f32x16 p0, p1;
#pragma unroll
                for (int r = 0; r < 16; ++r) { p0[r] = 0.f; p1[r] = 0.f; }
#pragma unroll
                for (int s = 0; s < 4; ++s) {
                    const bf16x8 k0 = *(const LAS bf16x8*)(kb + r32 * ROWB + 32 * s + 16 * hi), k1 = *(const LAS bf16x8*)(kb + (32 + r32) * ROWB + 32 * s + 16 * hi);
                    p0 = __builtin_amdgcn_mfma_f32_32x32x16_bf16(k0, qf[s], p0, 0, 0, 0); p1 = __builtin_amdgcn_mfma_f32_32x32x16_bf16(k1, qf[s], p1, 0, 0, 0);
                }
                const unsigned sh0 = (unsigned)mw >> (4 * hi), sh1 = (unsigned)(mw >> 32) >> (4 * hi);
#pragma unroll
                for (int r = 0; r < 16; ++r) { const int cb = (r & 3) + 8 * (r >> 2);
                    const float e0 = __builtin_amdgcn_exp2f(p0[r] * c1 - c2), e1 = __builtin_amdgcn_exp2f(p1[r] * c1 - c2);
                    p0[r] = ((sh0 >> cb) & 1u) ? e0 : 0.f; p1[r] = ((sh1 >> cb) & 1u) ? e1 : 0.f; lsum += p0[r] + p1[r]; }
#pragma unroll
                for (int ks = 0; ks < 4; ++ks) {
                    u32x4 pw;
                    if (ks < 2) { pw.x = cvt_pk_bf16(p0[8 * ks + 0], p0[8 * ks + 1]); pw.y = cvt_pk_bf16(p0[8 * ks + 2], p0[8 * ks + 3]); pw.z = cvt_pk_bf16(p0[8 * ks + 4], p0[8 * ks + 5]); pw.w = cvt_pk_bf16(p0[8 * ks + 6], p0[8 * ks + 7]); }
                    else { const int k2 = ks - 2; pw.x = cvt_pk_bf16(p1[8 * k2 + 0], p1[8 * k2 + 1]); pw.y = cvt_pk_bf16(p1[8 * k2 + 2], p1[8 * k2 + 3]); pw.z = cvt_pk_bf16(p1[8 * k2 + 4], p1[8 * k2 + 5]); pw.w = cvt_pk_bf16(p1[8 * k2 + 6], p1[8 * k2 + 7]); }
                    const bf16x8 pf = __builtin_bit_cast(bf16x8, pw);
                    const int vo = 64 * (ks >> 1) + 32 * (ks & 1) + 8 * hi;
                    const u32x2 a0 = *(const LAS u32x2*)(vb + r32 * ROWB + vo), a1 = *(const LAS u32x2*)(vb + r32 * ROWB + vo + 16);
                    const u32x2 b0 = *(const LAS u32x2*)(vb + (32 + r32) * ROWB + vo), b1 = *(const LAS u32x2*)(vb + (32 + r32) * ROWB + vo + 16);
                    const u32x4 va = {a0.x, a0.y, a1.x, a1.y}, vb4 = {b0.x, b0.y, b1.x, b1.y};
                    o0 = __builtin_amdgcn_mfma_f32_32x32x16_bf16(__builtin_bit_cast(bf16x8, va), pf, o0, 0, 0, 0);
                    o1 = __builtin_amdgcn_mfma_f32_32x32x16_bf16(__builtin_bit_cast(bf16x8, vb4), pf, o1, 0, 0, 0);
                }
                if (more) { LAS unsigned char* kn = gb + (cur ^ 1) * 2 * TILEB; LAS unsigned char* vn = kn + TILEB;
                    *(LAS u32x4*)(kn + srow0 * ROWB + sc0 * 16) = kr0; *(LAS u32x4*)(kn + (srow0 + 32) * ROWB + sc0 * 16) = kr1;
                    *(LAS u32x4*)(vn + srow0 * ROWB + sc0 * 16) = vr0; *(LAS u32x4*)(vn + (srow0 + 32) * ROWB + sc0 * 16) = vr1; mw = mwn; }
                __syncthreads();
            }
            if (grp == 1) { LAS float* cw = comb + w4 * 33 * 64 + lane;
#pragma unroll
                for (int r = 0; r < 16; ++r) { cw[r * 64] = o0[r]; cw[(16 + r) * 64] = o1[r]; }
                cw[32 * 64] = lsum; }
            __syncthreads();
            if (grp == 0) { const LAS float* cw = comb + w4 * 33 * 64 + lane;
#pragma unroll
                for (int r = 0; r < 16; ++r) { o0[r] += cw[r * 64]; o1[r] += cw[(16 + r) * 64]; }
                lsum += cw[32 * 64]; lsum += __shfl_xor(lsum, 32); const float inv = 1.f / lsum;
                bf16_t* yp = Y + (size_t)qrow * D + 256 + h * 64 + 4 * hi;
#pragma unroll
                for (int g4 = 0; g4 < 4; ++g4) { u32x2 w0, w1;
                    w0.x = cvt_pk_bf16(o0[4 * g4] * inv, o0[4 * g4 + 1] * inv); w0.y = cvt_pk_bf16(o0[4 * g4 + 2] * inv, o0[4 * g4 + 3] * inv);
                    w1.x = cvt_pk_bf16(o1[4 * g4] * inv, o1[4 * g4 + 1] * inv); w1.y = cvt_pk_bf16(o1[4 * g4 + 2] * inv, o1[4 * g4 + 3] * inv);
                    *(u32x2*)(yp + 8 * g4) = w0; *(u32x2*)(yp + 32 + 8 * g4) = w1; } }
            __syncthreads();
        }
    }
}

constexpr size_t WS_KI = 234 * MiB;
template <int J, unsigned MSK>
__device__ __forceinline__ void tr_stage(unsigned (&a)[32]) {
#pragma unroll
    for (int k = 0; k < 32; ++k) if ((k & J) == 0) { const unsigned t = (a[k] ^ (a[k + J] >> J)) & MSK; a[k] ^= t; a[k + J] ^= (t << J); }
}
__device__ __forceinline__ void transpose32(unsigned (&a)[32]) {
    tr_stage<16, 0x0000FFFFu>(a); tr_stage<8, 0x00FF00FFu>(a); tr_stage<4, 0x0F0F0F0Fu>(a); tr_stage<2, 0x33333333u>(a); tr_stage<1, 0x55555555u>(a);
}
__device__ __forceinline__ int wave_total_i(int v) {
    v += __builtin_amdgcn_update_dpp(0, v, 0x111, 0xf, 0xf, false);
    v += __builtin_amdgcn_update_dpp(0, v, 0x112, 0xf, 0xf, false);
    v += __builtin_amdgcn_update_dpp(0, v, 0x114, 0xf, 0xf, false);
    v += __builtin_amdgcn_update_dpp(0, v, 0x118, 0xf, 0xf, false);
    v += __builtin_amdgcn_update_dpp(0, v, 0x142, 0xa, 0xf, false);
    v += __builtin_amdgcn_update_dpp(0, v, 0x143, 0xc, 0xf, false);
    return __builtin_amdgcn_readlane(v, 63);
}
__device__ __forceinline__ void indexer_mfma(Frame& F) {
    const float* MISC = (const float*)WSP(WS_MISC); unsigned long long* MASKT = (unsigned long long*)WSP(WS_MASK); const bf16_t* PROJ = (const bf16_t*)WSP(WS_BIG); const bf16_t* KI = (const bf16_t*)WSP(WS_KI);
    LAS float* sc = (LAS float*)F.lds;
    const int lane = F.lane, r32 = lane & 31, hi = lane >> 5, wv = F.wave;
    for (int pi = F.vcu; pi < 1024; pi += F.G) {
        const int b = pi >> 8, pp = pi & 255;
#pragma unroll 1
        for (int half = 0; half < 2; ++half) {
            const int t0 = 8 * (half == 0 ? pp : 511 - pp), m0 = b * S + t0, tq = t0 + wv;
            unsigned long long myword = 0ull;
            if (t0 + 8 <= 256) {
                const int lo = 64 * lane; myword = (tq >= lo + 63) ? ~0ull : (tq < lo ? 0ull : ((2ull << (tq - lo)) - 1ull));
                MASKT[(size_t)(b * 64 + lane) * S + tq] = myword;
                continue;
            }
            const int nmax = t0 + 8, ntile = (nmax + 31) >> 5;
            bf16x8 qa[2][4]; float wq[2][4][4];
#pragma unroll
            for (int i = 0; i < 2; ++i) {
                const bf16_t* qp = PROJ + (size_t)(m0 + 4 * i + (r32 >> 3)) * PW + P_QI + (r32 & 7) * 64 + 8 * hi;
#pragma unroll
                for (int s = 0; s < 4; ++s) qa[i][s] = *(const bf16x8*)(qp + 16 * s);
#pragma unroll
                for (int qq = 0; qq < 4; ++qq) { const f32x4 w4 = *(const f32x4*)(MISC + (size_t)(m0 + 4 * i + qq) * 16 + 4 * hi);
#pragma unroll
                    for (int e = 0; e < 4; ++e) wq[i][qq][e] = w4[e] * (0.125f * 0.35355339059327373f); }
            }
            bf16x8 kring[4][4];
#define IDX_LOADK(u_, j_) do { const int key_ = 32 * (j_) + r32; const int krow_ = key_ < nmax ? key_ : nmax - 1; const bf16_t* kp_ = KI + (size_t)(b * S + krow_) * 64 + 8 * hi; \
    _Pragma("unroll") for (int s_ = 0; s_ < 4; ++s_) kring[u_][s_] = *(const bf16x8*)(kp_ + 16 * s_); } while (0)
#pragma unroll
            for (int u = 0; u < 4; ++u) IDX_LOADK(u, wv + 8 * u);
            for (int jb = wv; jb < ntile; jb += 32) {
#pragma unroll
                for (int u = 0; u < 4; ++u) {
                    const int j = jb + 8 * u;
                    if (j < ntile) {
                        const int key = 32 * j + r32;
                        bf16x8 kb[4];
#pragma unroll
                        for (int s = 0; s < 4; ++s) kb[s] = kring[u][s];
                        IDX_LOADK(u, j + 32);
#pragma unroll
                        for (int i = 0; i < 2; ++i) {
                            f32x16 d;
#pragma unroll
                            for (int r = 0; r < 16; ++r) d[r] = 0.f;
#pragma unroll
                            for (int s = 0; s < 4; ++s) d = __builtin_amdgcn_mfma_f32_32x32x16_bf16(qa[i][s], kb[s], d, 0, 0, 0);
                            float part[4];
#pragma unroll
                            for (int qq = 0; qq < 4; ++qq) { float a = 0.f;
#pragma unroll
                                for (int e = 0; e < 4; ++e) a = fmaf(wq[i][qq][e], fmaxf(d[4 * qq + e], 0.f), a);
                                part[qq] = a; }
                            auto s01 = __builtin_amdgcn_permlane32_swap(__float_as_uint(part[0]), __float_as_uint(part[1]), false, false);
                            auto s23 = __builtin_amdgcn_permlane32_swap(__float_as_uint(part[2]), __float_as_uint(part[3]), false, false);
                            const float v01 = __uint_as_float(s01[0]) + __uint_as_float(s01[1]), v23 = __uint_as_float(s23[0]) + __uint_as_float(s23[1]);
                            const int qA = 4 * i + hi, qB = 4 * i + 2 + hi;
                            sc[qA * 4096 + key] = (key <= t0 + qA) ? v01 : -INFINITY;
                            sc[qB * 4096 + key] = (key <= t0 + qB) ? v23 : -INFINITY;
                        }
                    }
                }
            }
#undef IDX_LOADK
            __syncthreads();
            const int nvalid = 32 * ntile; const LAS float* srow = sc + wv * 4096 + lane;
            unsigned pa[32], pb[32];
#pragma unroll
            for (int r = 0; r < 32; ++r) { const float v = srow[64 * r]; pa[r] = fkey(v) & (unsigned)((64 * r + lane - nvalid) >> 31); }
            transpose32(pa);
            const bool two = nvalid > 2048;
            if (two) {
#pragma unroll
                for (int r = 0; r < 32; ++r) { const float v = srow[64 * (32 + r)]; pb[r] = fkey(v) & (unsigned)((64 * (32 + r) + lane - nvalid) >> 31); }
                transpose32(pb);
            } else {
#pragma unroll
                for (int r = 0; r < 32; ++r) pb[r] = 0u;
            }
            unsigned aA = ~0u, aB = ~0u, Tk = 0u; int base = 0;
#pragma unroll
            for (int bit = 31; bit >= 0; --bit) {
                const unsigned wa = pa[31 - bit], wb = pb[31 - bit];
                const int tot = wave_total_i(__builtin_popcount(wa & aA) + __builtin_popcount(wb & aB));
                const bool take = (base + tot >= 256);
                const unsigned flip = take ? 0u : ~0u;
                aA &= (wa ^ flip); aB &= (wb ^ flip);
                if (take) Tk |= (1u << bit); else base += tot;
            }
            const int ngt = base, neq = wave_total_i(__builtin_popcount(aA) + __builtin_popcount(aB));
            if (ngt + neq == 256) {
#pragma unroll
                for (int r = 0; r < 64; ++r) { const float v = srow[64 * r]; const unsigned k = fkey(v) & (unsigned)((64 * r + lane - nvalid) >> 31);
                    const unsigned long long wsel = __ballot(k >= Tk); if (lane == r) myword = wsel; }
            } else {
                int need = 256 - ngt;
#pragma unroll 1
                for (int r = 0; r < 64; ++r) { const float v = srow[64 * r]; const unsigned k = fkey(v) & (unsigned)((64 * r + lane - nvalid) >> 31);
                    unsigned long long wsel = __ballot(k > Tk), em = __ballot(k == Tk);
                    if (em != 0ull && need > 0) { int c = __builtin_popcountll(em); while (c > need) { em &= ~(1ull << (63 - __builtin_clzll(em))); --c; } need -= c; wsel |= em; }
                    if (lane == r) myword = wsel; }
            }
            MASKT[(size_t)(b * 64 + lane) * S + tq] = myword;
            __syncthreads();
        }
    }
}

constexpr size_t WS_CVT = 236 * MiB;
__device__ __forceinline__ void mlstm2_mfma(Frame& F, int l) {
    const float* MISC = (const float*)WSP(WS_MISC); const float* STATE = (const float*)WSP(WS_STATE); const bf16_t* PROJ = (const bf16_t*)WSP(WS_BIG); const bf16_t* CVT = (const bf16_t*)WSP(WS_CVT);
    bf16_t* Y = (bf16_t*)WSP(WS_Y); const float* i_bias = INP(I_I_BIAS); const float* f_bias = INP(I_F_BIAS); const float* mnorm = INP(I_MNORM);
    const int lane = F.lane, r32 = lane & 31, hi = lane >> 5, grp = F.wave >> 2, w4 = F.wave & 3, lg = F.tid & 255;
    constexpr int KROWB = 144, VROWB = 272, GB = 49152;
    LAS unsigned char* gb = F.lds + grp * GB;
    LAS float* bc = (LAS float*)gb;
    LAS float* gs = bc + 128;
    LAS float* npv = gs + 128;
    LAS float* wsum = npv + 64;
    LAS unsigned char* ct = gb + 2048;
    LAS unsigned char* kt = ct + 9216;
    LAS unsigned char* vt = kt + 18432;
    for (int it0 = 2 * F.vcu; it0 < 512; it0 += 2 * F.G) {
        const int item = it0 + grp, bh = item >> 5, c = item & 31, b = bh >> 2, h = bh & 3, m0 = b * S + c * 128;
        if (lg < 128) { const float f = MISC[(size_t)(m0 + lg) * 16 + 12 + h] + f_bias[l * 4 + h]; bc[lg] = fminf(f, 0.f) - log1pf(__expf(-fabsf(f))); gs[lg] = MISC[(size_t)(m0 + lg) * 16 + 8 + h] + i_bias[l * 4 + h]; }
        if (lg >= 128 && lg < 160) { const int cc = lg - 128; wsum[cc] = (cc < c) ? STATE[(size_t)(bh * 32 + cc) * STATE_STRIDE + 4160] : 0.f; }
        __syncthreads();
        if (lg < 64) {
            float a0 = bc[2 * lane], a1 = bc[2 * lane + 1]; float s = a0 + a1;
#pragma unroll
            for (int o = 1; o < 64; o <<= 1) { const float t = __shfl_up(s, o); if (lane >= o) s += t; }
            const float ex = s - (a0 + a1); const float i0 = gs[2 * lane], i1 = gs[2 * lane + 1];
            bc[2 * lane] = ex + a0; bc[2 * lane + 1] = s; gs[2 * lane] = i0 - (ex + a0); gs[2 * lane + 1] = i1 - s;
            float w = (lane < 32) ? wsum[lane] : 0.f; float suf = w;
#pragma unroll
            for (int o = 1; o < 32; o <<= 1) { const float t = __shfl_down(suf, o); if (lane + o < 32) suf += t; }
            if (lane < 32) wsum[lane] = suf - w;
        }
        __syncthreads();
        { f32x4 a4[4]; float nv = 0.f;
#pragma unroll
          for (int k = 0; k < 4; ++k) a4[k] = (f32x4){0.f, 0.f, 0.f, 0.f};
          for (int cc = 0; cc < c; ++cc) { const float* st = STATE + (size_t)(bh * 32 + cc) * STATE_STRIDE; const float wgt = __expf(wsum[cc]);
#pragma unroll
              for (int k = 0; k < 4; ++k) { const f32x4 v = *(const f32x4*)(st + 4 * (lg + 256 * k)); a4[k] = a4[k] + v * wgt; }
              if (lg < 64) nv = fmaf(wgt, st[4096 + lg], nv); }
#pragma unroll
          for (int k = 0; k < 4; ++k) { const int idx = 4 * (lg + 256 * k), e = idx >> 6, d = idx & 63; u32x2 w; w.x = cvt_pk_bf16(a4[k][0], a4[k][1]); w.y = cvt_pk_bf16(a4[k][2], a4[k][3]); *(LAS u32x2*)(ct + e * KROWB + d * 2) = w; }
          if (lg < 64) npv[lg] = nv; }
#pragma unroll
        for (int k = 0; k < 4; ++k) { const int id = lg + 256 * k, row = id >> 3, ch = id & 7;
            *(LAS u32x4*)(kt + row * KROWB + ch * 16) = *(const u32x4*)(PROJ + (size_t)(m0 + row) * PW + P_CK + h * 64 + ch * 8);
            const int vrow = id >> 4, vch = id & 15;
            *(LAS u32x4*)(vt + vrow * VROWB + vch * 16) = *(const u32x4*)(CVT + (size_t)(b * 256 + h * 64 + vrow) * S + c * 128 + vch * 8); }
        __syncthreads();
        const int j = 32 * w4 + r32, qrow = m0 + j;
        bf16x8 qf[4];
#pragma unroll
        for (int s = 0; s < 4; ++s) qf[s] = *(const bf16x8*)(PROJ + (size_t)qrow * PW + P_CQ + h * 64 + 16 * s + 8 * hi);
        const float bj = bc[j], eb = __expf(bj);
        float qn = 0.f;
#pragma unroll
        for (int s = 0; s < 4; ++s) { const u32x4 w = __builtin_bit_cast(u32x4, qf[s]); const LAS float* np = npv + 16 * s + 8 * hi;
            qn += lo_bf(w.x) * np[0] + hi_bf(w.x) * np[1] + lo_bf(w.y) * np[2] + hi_bf(w.y) * np[3] + lo_bf(w.z) * np[4] + hi_bf(w.z) * np[5] + lo_bf(w.w) * np[6] + hi_bf(w.w) * np[7]; }
        qn += __shfl_xor(qn, 32); qn *= eb;
        f32x16 n0, n1;
#pragma unroll
        for (int r = 0; r < 16; ++r) { n0[r] = 0.f; n1[r] = 0.f; }
#pragma unroll
        for (int ks = 0; ks < 4; ++ks) { const bf16x8 c0 = *(const LAS bf16x8*)(ct + r32 * KROWB + 32 * ks + 16 * hi), c1 = *(const LAS bf16x8*)(ct + (32 + r32) * KROWB + 32 * ks + 16 * hi);
            n0 = __builtin_amdgcn_mfma_f32_32x32x16_bf16(c0, qf[ks], n0, 0, 0, 0); n1 = __builtin_amdgcn_mfma_f32_32x32x16_bf16(c1, qf[ks], n1, 0, 0, 0); }
#pragma unroll
        for (int r = 0; r < 16; ++r) { n0[r] *= eb; n1[r] *= eb; }
        float sa = 0.f;
#pragma unroll 1
        for (int st = 0; st <= w4; ++st) {
            f32x16 p;
#pragma unroll
            for (int r = 0; r < 16; ++r) p[r] = 0.f;
#pragma unroll
            for (int ks = 0; ks < 4; ++ks) { const bf16x8 kf = *(const LAS bf16x8*)(kt + (32 * st + r32) * KROWB + 32 * ks + 16 * hi); p = __builtin_amdgcn_mfma_f32_32x32x16_bf16(kf, qf[ks], p, 0, 0, 0); }
#pragma unroll
            for (int r = 0; r < 16; ++r) { const int s = 32 * st + (r & 3) + 8 * (r >> 2) + 4 * hi; const float a = (s <= j) ? __expf(bj + gs[s]) * p[r] : 0.f; p[r] = a; sa += a; }
#pragma unroll
            for (int k2 = 0; k2 < 2; ++k2) {
                u32x4 pw; pw.x = cvt_pk_bf16(p[8 * k2 + 0], p[8 * k2 + 1]); pw.y = cvt_pk_bf16(p[8 * k2 + 2], p[8 * k2 + 3]); pw.z = cvt_pk_bf16(p[8 * k2 + 4], p[8 * k2 + 5]); pw.w = cvt_pk_bf16(p[8 * k2 + 6], p[8 * k2 + 7]);
                const bf16x8 pf = __builtin_bit_cast(bf16x8, pw);
                const int vo = (32 * st + 16 * k2 + 4 * hi) * 2;
                const u32x2 a0 = *(const LAS u32x2*)(vt + r32 * VROWB + vo), a1 = *(const LAS u32x2*)(vt + r32 * VROWB + vo + 16);
                const u32x2 b0 = *(const LAS u32x2*)(vt + (32 + r32) * VROWB + vo), b1 = *(const LAS u32x2*)(vt + (32 + r32) * VROWB + vo + 16);
                const u32x4 va = {a0.x, a0.y, a1.x, a1.y}, vb4 = {b0.x, b0.y, b1.x, b1.y};
                n0 = __builtin_amdgcn_mfma_f32_32x32x16_bf16(__builtin_bit_cast(bf16x8, va), pf, n0, 0, 0, 0);
                n1 = __builtin_amdgcn_mfma_f32_32x32x16_bf16(__builtin_bit_cast(bf16x8, vb4), pf, n1, 0, 0, 0);
            }
        }
        sa += __shfl_xor(sa, 32);
        const float inv = 1.f / fmaxf(fabsf(qn + sa), 1.f);
        float ss = 0.f;
#pragma unroll
        for (int r = 0; r < 16; ++r) { n0[r] *= inv; n1[r] *= inv; ss += n0[r] * n0[r] + n1[r] * n1[r]; }
        ss += __shfl_xor(ss, 32); const float rr = rsqrtf(ss * (1.f / 64.f) + EPS);
        const float* gp = mnorm + l * 256 + h * 64 + 4 * hi; const bf16_t* op = PROJ + (size_t)qrow * PW + P_CO + h * 64 + 4 * hi; bf16_t* yp = Y + (size_t)qrow * D + 512 + h * 64 + 4 * hi;
#pragma unroll
        for (int g4 = 0; g4 < 4; ++g4) {
            const f32x4 ga = *(const f32x4*)(gp + 8 * g4), gb4 = *(const f32x4*)(gp + 32 + 8 * g4);
            const u32x2 oa = *(const u32x2*)(op + 8 * g4), ob = *(const u32x2*)(op + 32 + 8 * g4);
            u32x2 w0, w1;
            w0.x = cvt_pk_bf16(sigmoid_f(lo_bf(oa.x)) * n0[4 * g4] * rr * ga[0], sigmoid_f(hi_bf(oa.x)) * n0[4 * g4 + 1] * rr * ga[1]);
            w0.y = cvt_pk_bf16(sigmoid_f(lo_bf(oa.y)) * n0[4 * g4 + 2] * rr * ga[2], sigmoid_f(hi_bf(oa.y)) * n0[4 * g4 + 3] * rr * ga[3]);
            w1.x = cvt_pk_bf16(sigmoid_f(lo_bf(ob.x)) * n1[4 * g4] * rr * gb4[0], sigmoid_f(hi_bf(ob.x)) * n1[4 * g4 + 1] * rr * gb4[1]);
            w1.y = cvt_pk_bf16(sigmoid_f(lo_bf(ob.y)) * n1[4 * g4 + 2] * rr * gb4[2], sigmoid_f(hi_bf(ob.y)) * n1[4 * g4 + 3] * rr * gb4[3]);
            *(u32x2*)(yp + 8 * g4) = w0; *(u32x2*)(yp + 32 + 8 * g4) = w1;
        }
        __syncthreads();
    }
}

constexpr size_t WS_SSQV = 244 * MiB;
__device__ __forceinline__ void sgu_mfma(Frame& F, int l) {
    const bf16_t* PROJ = (const bf16_t*)WSP(WS_BIG); bf16_t* Y = (bf16_t*)WSP(WS_Y); const float* SSQV = (const float*)WSP(WS_SSQV);
    const float* gain = INP(I_SGU_NORM) + l * 256; const float* sw = INP(I_SGU_W) + (size_t)l * 4 * 128 * 128; const float* sb = INP(I_SGU_B) + l * 4 * 128;
    const int lane = F.lane, r32 = lane & 31, hi = lane >> 5, dt = F.wave & 1, tt = F.wave >> 1;
    constexpr int VROWB = 272;
    LAS float* r_s = (LAS float*)F.lds;
    LAS unsigned char* vt = F.lds + 512;
    for (int item = F.vcu; item < 512; item += F.G) {
        const int g = item & 3, m0 = (item >> 2) * 128;
        if (F.tid < 128) { const f32x4 q = *(const f32x4*)(SSQV + (size_t)(m0 + F.tid) * 4); r_s[F.tid] = rsqrtf(((q[0] + q[1]) + (q[2] + q[3])) * (1.f / 256.f) + EPS); }
        __syncthreads();
#pragma unroll
        for (int k = 0; k < 2; ++k) { const int id = F.tid + 512 * k, s = id >> 3, d0 = (id & 7) * 8; const float rs = r_s[s];
            const u32x4 w = *(const u32x4*)(PROJ + (size_t)(m0 + s) * PW + P_AV + g * 64 + d0);
            const float v[8] = {lo_bf(w.x), hi_bf(w.x), lo_bf(w.y), hi_bf(w.y), lo_bf(w.z), hi_bf(w.z), lo_bf(w.w), hi_bf(w.w)};
#pragma unroll
            for (int i = 0; i < 8; ++i) *(LAS bf16_t*)(vt + (d0 + i) * VROWB + s * 2) = (bf16_t)f2bf(v[i] * rs); }
        __syncthreads();
        f32x16 acc;
#pragma unroll
        for (int r = 0; r < 16; ++r) acc[r] = 0.f;
        const int t = 32 * tt + r32; const float* wrow = sw + ((size_t)g * 128 + t) * 128;
#pragma unroll 1
        for (int ks = 0; ks < 2 * (tt + 1); ++ks) {
            const bf16x8 af = *(const LAS bf16x8*)(vt + (32 * dt + r32) * VROWB + (16 * ks + 8 * hi) * 2);
            const int s0 = 16 * ks + 8 * hi; const f32x4 w0 = *(const f32x4*)(wrow + s0), w1 = *(const f32x4*)(wrow + s0 + 4);
            u32x4 bw; bw.x = cvt_pk_bf16(s0 + 0 <= t ? w0[0] : 0.f, s0 + 1 <= t ? w0[1] : 0.f); bw.y = cvt_pk_bf16(s0 + 2 <= t ? w0[2] : 0.f, s0 + 3 <= t ? w0[3] : 0.f);
            bw.z = cvt_pk_bf16(s0 + 4 <= t ? w1[0] : 0.f, s0 + 5 <= t ? w1[1] : 0.f); bw.w = cvt_pk_bf16(s0 + 6 <= t ? w1[2] : 0.f, s0 + 7 <= t ? w1[3] : 0.f);
            acc = __builtin_amdgcn_mfma_f32_32x32x16_bf16(af, __builtin_bit_cast(bf16x8, bw), acc, 0, 0, 0);
        }
        const float bias = sb[g * 128 + t]; const size_t row = (size_t)(m0 + t);
        const float* gp = gain + g * 64 + 32 * dt + 4 * hi; const bf16_t* up = PROJ + row * PW + P_AU + g * 64 + 32 * dt + 4 * hi; bf16_t* yp = Y + row * D + g * 64 + 32 * dt + 4 * hi;
#pragma unroll
        for (int g4 = 0; g4 < 4; ++g4) { const f32x4 gv = *(const f32x4*)(gp + 8 * g4); const u32x2 uw = *(const u32x2*)(up + 8 * g4); u32x2 ow;
            ow.x = cvt_pk_bf16(lo_bf(uw.x) * (gv[0] * acc[4 * g4] + bias), hi_bf(uw.x) * (gv[1] * acc[4 * g4 + 1] + bias));
            ow.y = cvt_pk_bf16(lo_bf(uw.y) * (gv[2] * acc[4 * g4 + 2] + bias), hi_bf(uw.y) * (gv[3] * acc[4 * g4 + 3] + bias));
            *(u32x2*)(yp + 8 * g4) = ow; }
        __syncthreads();
    }
}

__device__ __forceinline__ void mlstm1_mfma(Frame& F, int l) {
    const float* MISC = (const float*)WSP(WS_MISC); float* STATE = (float*)WSP(WS_STATE); const bf16_t* PROJ = (const bf16_t*)WSP(WS_BIG); const bf16_t* CVT = (const bf16_t*)WSP(WS_CVT);
    const float* i_bias = INP(I_I_BIAS); const float* f_bias = INP(I_F_BIAS);
    const int lane = F.lane, r32 = lane & 31, hi = lane >> 5, grp = F.wave >> 2, w4 = F.wave & 3, et = w4 & 1, dt = w4 >> 1, lg = F.tid & 255;
    constexpr int KROWB = 144, GB = 20480;
    LAS unsigned char* gb = F.lds + grp * GB;
    LAS float* bc = (LAS float*)gb; LAS float* wk = bc + 128; LAS unsigned char* kt = gb + 1024;
    for (int it0 = 2 * F.vcu; it0 < 512; it0 += 2 * F.G) {
        const int item = it0 + grp, bh = item >> 5, c = item & 31, b = bh >> 2, h = bh & 3, m0 = b * S + c * 128;
        if (lg < 128) { const float f = MISC[(size_t)(m0 + lg) * 16 + 12 + h] + f_bias[l * 4 + h]; bc[lg] = fminf(f, 0.f) - log1pf(__expf(-fabsf(f))); wk[lg] = MISC[(size_t)(m0 + lg) * 16 + 8 + h] + i_bias[l * 4 + h]; }
        __syncthreads();
        if (lg < 64) { const float a0 = bc[2 * lane], a1 = bc[2 * lane + 1]; float s = a0 + a1;
#pragma unroll
            for (int o = 1; o < 64; o <<= 1) { const float t = __shfl_up(s, o); if (lane >= o) s += t; }
            const float tot = __shfl(s, 63), ex = s - (a0 + a1);
            wk[2 * lane] = __expf(tot - (ex + a0) + wk[2 * lane]); wk[2 * lane + 1] = __expf(tot - s + wk[2 * lane + 1]);
            if (lane == 0) bc[0] = tot; }
        __syncthreads();
        const float Bc = bc[0];
#pragma unroll
        for (int k = 0; k < 4; ++k) { const int id = lg + 256 * k, s = id >> 3, ch = id & 7; const float ws_ = wk[s];
            const u32x4 w = *(const u32x4*)(PROJ + (size_t)(m0 + s) * PW + P_CK + h * 64 + ch * 8); u32x4 o;
            o.x = cvt_pk_bf16(lo_bf(w.x) * ws_, hi_bf(w.x) * ws_); o.y = cvt_pk_bf16(lo_bf(w.y) * ws_, hi_bf(w.y) * ws_); o.z = cvt_pk_bf16(lo_bf(w.z) * ws_, hi_bf(w.z) * ws_); o.w = cvt_pk_bf16(lo_bf(w.w) * ws_, hi_bf(w.w) * ws_);
            *(LAS u32x4*)(kt + s * KROWB + ch * 16) = o; }
        __syncthreads();
        f32x16 acc;
#pragma unroll
        for (int r = 0; r < 16; ++r) acc[r] = 0.f;
        float nsum = 0.f;
        const bf16_t* vp = CVT + (size_t)(b * 256 + h * 64 + 32 * et + r32) * S + c * 128 + 8 * hi;
        bf16x8 af[8];
#pragma unroll
        for (int ks = 0; ks < 8; ++ks) af[ks] = *(const bf16x8*)(vp + 16 * ks);
#pragma unroll
        for (int ks = 0; ks < 8; ++ks) {
            const LAS unsigned char* kp = kt + (16 * ks + 8 * hi) * KROWB + (32 * dt + r32) * 2; unsigned e8[8];
#pragma unroll
            for (int jj = 0; jj < 8; ++jj) e8[jj] = *(const LAS bf16_t*)(kp + jj * KROWB);
            u32x4 bw; bw.x = e8[0] | (e8[1] << 16); bw.y = e8[2] | (e8[3] << 16); bw.z = e8[4] | (e8[5] << 16); bw.w = e8[6] | (e8[7] << 16);
#pragma unroll
            for (int jj = 0; jj < 8; ++jj) nsum += __uint_as_float(e8[jj] << 16);
            acc = __builtin_amdgcn_mfma_f32_32x32x16_bf16(af[ks], __builtin_bit_cast(bf16x8, bw), acc, 0, 0, 0);
        }
        float* st = STATE + (size_t)item * STATE_STRIDE;
#pragma unroll
        for (int r = 0; r < 16; ++r) st[(32 * et + (r & 3) + 8 * (r >> 2) + 4 * hi) * 64 + 32 * dt + r32] = acc[r];
        nsum += __shfl_xor(nsum, 32);
        if (et == 0 && hi == 0) st[4096 + 32 * dt + r32] = nsum;
        if (lg == 0) st[4160] = Bc;
        __syncthreads();
    }
}
#ifndef MK_MULTI
#define MK_MULTI 0
#endif
constexpr int N_PHASES = 1 + 8 * DEPTH;

__global__ void __launch_bounds__(NT, 2) mk_fwd(Args args) {
    extern __shared__ __attribute__((aligned(16))) unsigned char lds_raw[];
    Frame F;
    F.lds = (LAS unsigned char*)lds_raw; F.tid = threadIdx.x; F.lane = F.tid & 63; F.wave = __builtin_amdgcn_readfirstlane(F.tid >> 6);
    F.G = gridDim.x; { const int bx_ = blockIdx.x; F.vcu = (F.G % 8 == 0) ? (bx_ % 8) * (F.G / 8) + bx_ / 8 : bx_; }
    if (F.tid < 20) { const unsigned long long pv = F.tid < 18 ? (unsigned long long)args.in[F.tid < 18 ? F.tid : 0] : (F.tid == 18 ? (unsigned long long)args.out : (unsigned long long)args.ws);
        *(LAS unsigned long long*)(F.lds + PTR_OFF + 8 * F.tid) = pv; }
    if (F.tid < 2) *(LAS unsigned*)(F.lds + PTR_OFF + 256 + 4 * F.tid) = 0u;
    __syncthreads();
    XcdBarrier xbar; xbar.bar = (unsigned*)(args.ws + WS_BAR); xbar.x = 0; xbar.st = (volatile LAS unsigned*)(F.lds + PTR_OFF + 256);
    if (args.coop) xbar = xcd_barrier_post((unsigned*)(args.ws + WS_BAR), (volatile LAS unsigned*)(F.lds + PTR_OFF + 256));
    const int lo = args.ph_lo, hi = args.ph_hi; const bool coop = args.coop != 0;
#define RUN(k) (lo <= (k) && (k) < hi)
#define LAUNDER() asm volatile("" : "+v"(F.tid), "+v"(F.lane))
#define SEAM(k) do { if (coop && RUN(k) && RUN((k) + 1)) { if ((k) == 0) cg::this_grid().sync(); else xcd_barrier(xbar); } } while (0)
    const int bx = (int)blockIdx.x;

    if (RUN(0)) { LAUNDER(); convert_mix_weights(F, 0); prologue_rows(F);
        if (blockIdx.x == 0 && F.tid < DEPTH * 192) { const int l_ = F.tid / 192, r_ = F.tid % 192, w_ = r_ / 64, i_ = r_ % 64; ((float*)WSP(WS_GT))[F.tid] = INP(I_Q_NORM + w_)[l_ * 64 + i_]; } }
    SEAM(0);
#pragma unroll 1
    for (int l = 0; l < DEPTH; ++l) {
        const int pb = 1 + 8 * l;
        if (RUN(pb + 0)) { LAUNDER();
            pg8::Gemm<D, D, D, 256u * D * 2, 0, 256u * D * 2, 0> g{(const bf16_t*)WSP(WS_XG), (const bf16_t*)WSP(WS_WIN)};
            pg8::StaticOrder So; So.init(M, PW, F.G, bx);
            epi::EpiProj E{(bf16_t*)WSP(WS_BIG), (float*)WSP(WS_MISC), (const float*)WSP(WS_SSQA), (const float*)WSP(WS_COS), (const float*)WSP(WS_SIN), (const float*)WSP(WS_GT) + l * 192, (bf16_t*)WSP(WS_VT), (bf16_t*)WSP(WS_KI), (bf16_t*)WSP(WS_CVT), (float*)WSP(WS_SSQV)};
            pg8::gemm_phase<epi::EpiProj, pg8::StaticOrder, true>(F.lds, g, So, E, F.tid);
        }
        SEAM(pb + 0);
        if (RUN(pb + 1)) { LAUNDER(); sgu_mfma(F, l); conv_simple(F, l); indexer_mfma(F); mlstm1_mfma(F, l); }
        SEAM(pb + 1);
        if (RUN(pb + 2)) { LAUNDER(); attn_mfma(F, l); mlstm2_mfma(F, l); }
        SEAM(pb + 2);
        if (RUN(pb + 3)) { LAUNDER();
            pg8::Gemm<256, D, 256, 256u * D * 2, 256u * 2, 256u * 256 * 2, 1024u * 256 * 2> g{(const bf16_t*)WSP(WS_Y), (const bf16_t*)WSP(WS_WBR)};
            pg8::SuperOrder<0> So; So.init(F.G, bx);
            epi::EpiPlain E{(bf16_t*)WSP(WS_BIG), 4096, 1024};
            pg8::gemm_phase<epi::EpiPlain, pg8::SuperOrder<0>, true>(F.lds, g, So, E, F.tid);
        }
        SEAM(pb + 3);
        if (RUN(pb + 4)) { LAUNDER();
            pg8::Gemm<D, D, D, 256u * D * 2, 0, 256u * D * 2, 0> g{(const bf16_t*)WSP(WS_XG), (const bf16_t*)WSP(WS_WG)};
            pg8::SuperOrder<1> So; So.init(F.G, bx);
            epi::EpiGate E{(bf16_t*)WSP(WS_MG), (const bf16_t*)WSP(WS_BIG), (const float*)WSP(WS_SSQA)};
            pg8::gemm_phase<epi::EpiGate, pg8::SuperOrder<1>, true>(F.lds, g, So, E, F.tid);
            __syncthreads();
            convert_mlp_weights(F, l);
        }
        SEAM(pb + 4);
        if (RUN(pb + 5)) { LAUNDER();
            pg8::Gemm<D, D, D, 256u * D * 2, 0, 256u * D * 2, 0> g{(const bf16_t*)WSP(WS_MG), (const bf16_t*)WSP(WS_WOUT)};
            pg8::StaticOrder So; So.init(M, D, F.G, bx);
            float* outp = (float*)ptr_at(F, I_OUT); epi::EpiResid E{l == 0 ? INP(I_X) : (const float*)outp, outp, (bf16_t*)WSP(WS_XG), INP(I_LN_MLP) + l * D, (float*)WSP(WS_SSQB)};
            pg8::gemm_phase<epi::EpiResid, pg8::StaticOrder, true>(F.lds, g, So, E, F.tid);
        }
        SEAM(pb + 5);
        if (RUN(pb + 6)) { LAUNDER();
            pg8::Gemm<D, D, D, 256u * D * 2, 0, 256u * D * 2, 0> g{(const bf16_t*)WSP(WS_XG), (const bf16_t*)WSP(WS_WUP)};
            pg8::StaticOrder So; So.init(M, FF, F.G, bx);
            epi::EpiUp E{(bf16_t*)WSP(WS_BIG), (const float*)WSP(WS_SSQB)};
            pg8::gemm_phase<epi::EpiUp, pg8::StaticOrder, true>(F.lds, g, So, E, F.tid);
            if (l + 1 < DEPTH) { __syncthreads(); convert_mix_weights(F, l + 1); }
        }
        SEAM(pb + 6);
        if (RUN(pb + 7)) { LAUNDER();
            pg8::Gemm<FF, FF, FF, 256u * FF * 2, 0, 256u * FF * 2, 0> g{(const bf16_t*)WSP(WS_BIG), (const bf16_t*)WSP(WS_WDN)};
            pg8::StaticOrder So; So.init(M, D, F.G, bx);
            float* outp = (float*)ptr_at(F, I_OUT); epi::EpiResid E{(const float*)outp, outp, (bf16_t*)WSP(WS_XG), (l + 1 < DEPTH) ? INP(I_LN_MIX) + (l + 1) * D : nullptr, (float*)WSP(WS_SSQA)};
            pg8::gemm_phase<epi::EpiResid, pg8::StaticOrder, true>(F.lds, g, So, E, F.tid);
        }
        SEAM(pb + 7);
    }
#undef RUN
#undef SEAM
}

extern "C" void kernel_launch(void* const* d_in, const int* in_sizes, int n_in, void* d_out, int out_size, void* d_ws, size_t ws_size, hipStream_t stream) {
    static int grid = 0;
    if (grid == 0) {
        if (n_in != 18 || in_sizes[0] != M * D || out_size != M * D || ws_size < WS_END) { fprintf(stderr, "kernel_launch: unexpected shapes (n_in %d, in0 %d, out %d, ws %zu)\n", n_in, n_in > 0 ? in_sizes[0] : -1, out_size, ws_size); grid = -1; return; }
        int dev = 0, cus = 0, per_cu = 0;
        if (hipGetDevice(&dev) != hipSuccess || hipDeviceGetAttribute(&cus, hipDeviceAttributeMultiprocessorCount, dev) != hipSuccess) { grid = -1; return; }
        if (hipFuncSetAttribute((const void*)mk_fwd, hipFuncAttributeMaxDynamicSharedMemorySize, LDS_BYTES) != hipSuccess) { fprintf(stderr, "kernel_launch: hipFuncSetAttribute failed\n"); grid = -1; return; }
        if (hipOccupancyMaxActiveBlocksPerMultiprocessor(&per_cu, (const void*)mk_fwd, NT, LDS_BYTES) != hipSuccess || per_cu < 1) { fprintf(stderr, "kernel_launch: occupancy query says %d\n", per_cu); (void)hipGetLastError(); per_cu = 1; }
        grid = cus;
    }
    if (grid < 0) return;
    if (hipMemsetAsync((char*)d_ws + WS_CTL, 0, CTL_ZERO_BYTES, stream) != hipSuccess) { fprintf(stderr, "kernel_launch: memset failed\n"); return; }
    Args a{};
    for (int i = 0; i < 18; ++i) a.in[i] = (const float*)d_in[i];
    a.out = (float*)d_out; a.ws = (unsigned char*)d_ws;
#if MK_MULTI
    for (int p = 0; p < N_PHASES; ++p) { a.ph_lo = p; a.ph_hi = p + 1; a.coop = 0; hipLaunchKernelGGL(mk_fwd, dim3(grid), dim3(NT), LDS_BYTES, stream, a); }
#else
    a.ph_lo = 0; a.ph_hi = N_PHASES; a.coop = 1;
    void* kargs[] = {&a};
    hipError_t e = hipLaunchCooperativeKernel((const void*)mk_fwd, dim3(grid), dim3(NT), kargs, LDS_BYTES, stream);
    if (e != hipSuccess) fprintf(stderr, "kernel_launch: cooperative launch failed: %s (grid %d)\n", hipGetErrorString(e), grid);
#endif
}
```

```cpp
#define MK_MULTI 0
#include <hip/hip_runtime.h>
#include <hip/hip_cooperative_groups.h>
#include <cstdio>
#include <cstdint>
namespace cg = cooperative_groups;

#define LAS __attribute__((address_space(3)))
typedef unsigned short bf16_t;
typedef short bf16x8 __attribute__((ext_vector_type(8)));
typedef float f32x4 __attribute__((ext_vector_type(4)));
typedef float f32x2 __attribute__((ext_vector_type(2)));
typedef unsigned u32x4 __attribute__((ext_vector_type(4)));
typedef unsigned u32x2 __attribute__((ext_vector_type(2)));

constexpr int D = 1024, NB = 4, S = 4096, M = NB * S, DEPTH = 2, FF = 4096, INW = 7760;
constexpr int O_AU = 0, O_AV = 256, O_BQ = 512, O_BK = 768, O_BV = 1024, O_QI = 1280, O_KI = 1792, O_WI = 1856,
              O_CQ = 1864, O_CK = 2120, O_CV = 2376, O_CO = 2632, O_CI = 2888, O_CF = 2892, O_DB = 2896, O_DC = 3152, O_DX = 3408, O_G = 3664;
constexpr int PW = 3840;
constexpr int P_AU = 0, P_AV = 256, P_Q = 512, P_K = 768, P_V = 1024, P_QI = 1280, P_CQ = 1792, P_CK = 2048, P_CV = 2304, P_CO = 2560,
              P_DB = 2816, P_DC = 3072, P_DX = 3328, P_KI = 3584;
constexpr float EPS = 1e-6f;
constexpr int NWAVES = 8, NT = 512;

constexpr size_t MiB = 1u << 20;
constexpr size_t WS_CTL = 0;
constexpr size_t WS_COS = 1 * MiB, WS_SIN = 1 * MiB + 512 * 1024;
constexpr size_t WS_MISC = 2 * MiB;
constexpr size_t WS_SSQA = 3 * MiB, WS_SSQB = 4 * MiB;
constexpr size_t WS_WIN = 5 * MiB;
constexpr size_t WS_WG = WS_WIN + (size_t)PW * D * 2;
constexpr size_t WS_WBR = WS_WG + (size_t)4096 * D * 2;
constexpr size_t WS_WOUT = WS_WBR + (size_t)4 * 1024 * 256 * 2;
constexpr size_t WS_XG = 25 * MiB;
constexpr size_t WS_BIG = 57 * MiB;
constexpr size_t WS_Y = 185 * MiB;
constexpr size_t WS_WUP = WS_Y, WS_WDN = WS_Y + 8 * MiB;
constexpr size_t WS_MG = 217 * MiB;
constexpr size_t WS_MASK = WS_MG, WS_STATE = WS_MG + 8 * MiB;
constexpr size_t WS_END = 249 * MiB;
constexpr int STATE_STRIDE = 4224;
static_assert(WS_WOUT + (size_t)D * D * 2 <= WS_XG && WS_STATE + (size_t)512 * STATE_STRIDE * 4 <= WS_END && WS_END <= 256 * MiB, "d_ws map");

constexpr int LDS_BYTES = 155648;

__device__ __forceinline__ float bf2f(bf16_t v) { return __uint_as_float((unsigned)v << 16); }
__device__ __forceinline__ unsigned f2bf(float f) { unsigned u = __float_as_uint(f); return (u + 0x7fffu + ((u >> 16) & 1u)) >> 16; }
__device__ __forceinline__ unsigned pk2(float lo, float hi) { return f2bf(lo) | (f2bf(hi) << 16); }
__device__ __forceinline__ unsigned cvt_pk_bf16(float lo, float hi) { unsigned r; asm volatile("v_cvt_pk_bf16_f32 %0, %1, %2" : "=v"(r) : "v"(lo), "v"(hi)); return r; }
__device__ __forceinline__ float lo_bf(unsigned w) { return __uint_as_float(w << 16); }
__device__ __forceinline__ float hi_bf(unsigned w) { return __uint_as_float(w & 0xffff0000u); }
__device__ __forceinline__ float wave_sum(float v) {
#pragma unroll
    for (int o = 1; o < 64; o <<= 1) v += __shfl_xor(v, o);
    return v;
}
__device__ __forceinline__ float wave_max(float v) {
#pragma unroll
    for (int o = 1; o < 64; o <<= 1) v = fmaxf(v, __shfl_xor(v, o));
    return v;
}
__device__ __forceinline__ int wave_sum_i(int v) {
#pragma unroll
    for (int o = 1; o < 64; o <<= 1) v += __shfl_xor(v, o);
    return v;
}
__device__ __forceinline__ float sigmoid_f(float x) { return __builtin_amdgcn_rcpf(1.f + __builtin_amdgcn_exp2f(-1.4426950408889634f * x)); }
__device__ __forceinline__ float gelu_tanh_f(float x) { const float u = 0.7978845608028654f * (x + 0.044715f * x * x * x); return x * __builtin_amdgcn_rcpf(1.f + __builtin_amdgcn_exp2f(-2.8853900817779268f * u)); }
__device__ __forceinline__ unsigned fkey(float s) { const unsigned u = __float_as_uint(s); return (u & 0x80000000u) ? ~u : (u | 0x80000000u); }

namespace pg8 {
constexpr int BM = 256, BK = 64, HALF = 128, HTB = HALF * BK * 2, STAGE_BYTES = 8 * HTB, NXCD = 8, WGM = 8;
__host__ __device__ __forceinline__ int lds_byte(int r, int c) { const int st = (r >> 4) * 2 + (c >> 5), rr = r & 15, cc = c & 31, ob = rr * 64 + cc * 2; return st * 1024 + (ob ^ (((ob >> 9) & 1) << 5)); }
__host__ __device__ __forceinline__ void stage_rc(int b, int& R, int& C) { const int st = b / 1024, sb = b % 1024, swz = sb ^ (((sb >> 9) & 1) << 5); R = (st >> 1) * 16 + swz / 64; C = (st & 1) * 32 + (swz % 64) / 2; }
__host__ __device__ __forceinline__ int perm32(int rho) { const int n = rho >> 4, i = rho & 15; return 8 * (i >> 2) + 4 * n + (i & 3); }

struct Unit { int pm, pn, z; };
template <int K_, int LDA_, int LDB_, unsigned APM_, unsigned AZ_, unsigned BPN_, unsigned BZ_> struct Gemm {
    const bf16_t* A; const bf16_t* Bt;
    static constexpr int K = K_, lda = LDA_, ldb = LDB_; static constexpr unsigned aPm = APM_, aZ = AZ_, bPn = BPN_, bZ = BZ_;
};
template <class G> __device__ __forceinline__ const char* pa(const G& g, const Unit& u) { return (const char*)g.A + (size_t)((unsigned)u.pm * G::aPm + (unsigned)u.z * G::aZ); }
template <class G> __device__ __forceinline__ const char* pb(const G& g, const Unit& u) { return (const char*)g.Bt + (size_t)((unsigned)u.pn * G::bPn + (unsigned)u.z * G::bZ); }

struct StaticOrder {
    int nM, nN, nwg, G, c;
    __host__ __device__ void init(int M_, int N_, int G_, int c_) { nM = M_ / BM; nN = N_ / BM; nwg = nM * nN; G = G_; c = c_; }
    __host__ __device__ bool next(int i, Unit& u) const {
        const long L = (long)i * G + c; if (L >= nwg) return false;
        int wgid = (int)L; { const int q = nwg / NXCD, r = nwg % NXCD, xcd = wgid % NXCD, off = wgid / NXCD; wgid = (xcd < r ? xcd * (q + 1) : r * (q + 1) + (xcd - r) * q) + off; }
        const int nig = WGM * nN, gid = wgid / nig, fm = gid * WGM, gsz = (nM - fm) < WGM ? (nM - fm) : WGM;
        u.pm = fm + ((wgid % nig) % gsz); u.pn = (wgid % nig) / gsz; u.z = 0; return true;
    }
};
template <int MODE> struct SuperOrder {
    StaticOrder so;
    __host__ __device__ void init(int G_, int c_) { so.init(M, 1024, G_, c_); }
    __host__ __device__ bool next(int i, Unit& u) const {
        Unit b; if (!so.next(i >> 2, b)) return false;
        const int sub = i & 3; u.pm = b.pm; if (MODE == 0) { u.pn = b.pn; u.z = sub; } else { u.pn = 4 * b.pn + sub; u.z = 0; } return true;
    }
};

template <class Epi, class Sched, bool ALIGN_EPI, class GemmT>
__device__ __forceinline__ void gemm_phase(LAS unsigned char* lds, const GemmT g, const Sched& S, const Epi& E, const int tid) {
    const int wid = __builtin_amdgcn_readfirstlane(tid >> 6), lane = tid & 63, wr = wid >> 2, wc = wid & 3, fr = lane & 15, fq = lane >> 4;
    constexpr int K = GemmT::K, nt = K / BK;
    unsigned voffA[2], voffB[2];
#pragma unroll
    for (int i = 0; i < 2; ++i) { int R, C; stage_rc(tid * 16 + i * 8192, R, C); const int Rb = Epi::PERM ? ((R & ~31) + perm32(R & 31)) : R;
        voffA[i] = (unsigned)(R * GemmT::lda + C) * 2u; voffB[i] = (unsigned)(Rb * GemmT::ldb + C) * 2u; }
    const size_t kstep = (size_t)(BK * 2);
    constexpr size_t hA = (size_t)HALF * GemmT::lda * 2, hB = (size_t)HALF * GemmT::ldb * 2;
    const unsigned ldsw = (unsigned)wid * 1024u;
    const int aoff = lds_byte(wr * 64 + fr, fq * 8), boff = lds_byte(wc * 32 + fr, fq * 8);
#define PG8_SA(b, h) (((b) * 2 + (h)) * HTB)
#define PG8_SB(b, h) ((4 + (b) * 2 + (h)) * HTB)
#define PG8_STAGE(bufoff, gbase, voff) do { _Pragma("unroll") for (int _i = 0; _i < 2; ++_i) \
        __builtin_amdgcn_global_load_lds((const unsigned*)((const char*)(gbase) + (voff)[_i]), (LAS unsigned*)(lds + (bufoff) + ldsw + _i * 8192), 16, 0, 0); } while (0)
#define PG8_LDA(dst, b, h) do { _Pragma("unroll") for (int m = 0; m < 4; ++m) _Pragma("unroll") for (int k = 0; k < 2; ++k) dst[m][k] = *(const LAS bf16x8*)(lds + PG8_SA(b, h) + aoff + m * 2048 + k * 1024); } while (0)
#define PG8_LDB(dst, b, h) do { _Pragma("unroll") for (int n = 0; n < 2; ++n) _Pragma("unroll") for (int k = 0; k < 2; ++k) dst[n][k] = *(const LAS bf16x8*)(lds + PG8_SB(b, h) + boff + n * 2048 + k * 1024); } while (0)
#define PG8_MMA(ai, bj, At, Bt) do { __builtin_amdgcn_s_setprio(1); _Pragma("unroll") for (int m = 0; m < 4; ++m) _Pragma("unroll") for (int n = 0; n < 2; ++n) _Pragma("unroll") for (int k = 0; k < 2; ++k) \
        acc[ai][bj][m][n] = __builtin_amdgcn_mfma_f32_16x16x32_bf16(Bt[n][k], At[m][k], acc[ai][bj][m][n], 0, 0, 0); __builtin_amdgcn_s_setprio(0); } while (0)
#define PG8_WAIT_V(n) asm volatile("s_waitcnt vmcnt(" #n ")" ::: "memory")
#define PG8_WAIT_L(n) asm volatile("s_waitcnt lgkmcnt(" #n ")" ::: "memory")
#define PG8_BAR __builtin_amdgcn_s_barrier()
#define PG8_SCHED __builtin_amdgcn_sched_barrier(0)
    Unit cur, nxt; int ui = 0;
    if (!S.next(0, cur)) return;
    f32x4 acc[2][2][4][2];
#pragma unroll
    for (int a = 0; a < 2; ++a)
#pragma unroll
        for (int b = 0; b < 2; ++b)
#pragma unroll
            for (int m = 0; m < 4; ++m)
#pragma unroll
                for (int n = 0; n < 2; ++n) acc[a][b][m][n] = (f32x4){0.f, 0.f, 0.f, 0.f};
    bf16x8 At[4][2], B0[2][2], B1[2][2];
    const char* cA = pa(g, cur); const char* cB = pb(g, cur);
    PG8_STAGE(PG8_SB(0, 0), cB, voffB); PG8_STAGE(PG8_SB(0, 1), cB + hB, voffB); PG8_STAGE(PG8_SA(0, 0), cA, voffA); PG8_STAGE(PG8_SA(0, 1), cA + hA, voffA);
    if (wr == 1) PG8_BAR;
    PG8_WAIT_V(2); PG8_BAR;
    PG8_STAGE(PG8_SB(1, 0), cB + kstep, voffB); PG8_STAGE(PG8_SA(1, 0), cA + kstep, voffA); PG8_STAGE(PG8_SB(1, 1), cB + hB + kstep, voffB);
    PG8_WAIT_V(6); PG8_BAR;
    for (;;) {
        const bool has_next = S.next(ui + 1, nxt);
        const char* nA = has_next ? pa(g, nxt) : cA; const char* nB = has_next ? pb(g, nxt) : cB;
#pragma unroll 1
        for (int t = 0; t < nt; t += 2) {
            const bool last = (t == nt - 2);
            const char* a1 = cA + (size_t)(t + 1) * kstep;
            const char* a2 = last ? nA : cA + (size_t)(t + 2) * kstep; const char* b2 = last ? nB : cB + (size_t)(t + 2) * kstep;
            const char* a3 = a2 + kstep; const char* b3 = b2 + kstep;
            PG8_LDB(B0, 0, 0); PG8_LDB(B1, 0, 1); PG8_SCHED; PG8_LDA(At, 0, 0); PG8_STAGE(PG8_SA(1, 1), a1 + hA, voffA);
            PG8_WAIT_V(8); PG8_WAIT_L(0); PG8_BAR; PG8_MMA(0, 0, At, B0); PG8_MMA(0, 1, At, B1); PG8_BAR; PG8_SCHED;
            PG8_LDA(At, 0, 1); PG8_STAGE(PG8_SB(0, 0), b2, voffB); PG8_STAGE(PG8_SB(0, 1), b2 + hB, voffB); PG8_STAGE(PG8_SA(0, 0), a2, voffA);
            PG8_WAIT_V(8); PG8_WAIT_L(0); PG8_BAR; PG8_MMA(1, 0, At, B0); PG8_MMA(1, 1, At, B1); PG8_BAR; PG8_SCHED;
            PG8_LDB(B0, 1, 0); PG8_LDB(B1, 1, 1); PG8_SCHED; PG8_LDA(At, 1, 0); PG8_STAGE(PG8_SA(0, 1), a2 + hA, voffA);
            PG8_WAIT_V(8); PG8_WAIT_L(0); PG8_BAR; PG8_MMA(0, 0, At, B0); PG8_MMA(0, 1, At, B1); PG8_BAR; PG8_SCHED;
            PG8_LDA(At, 1, 1); PG8_STAGE(PG8_SB(1, 0), b3, voffB); PG8_STAGE(PG8_SB(1, 1), b3 + hB, voffB); PG8_STAGE(PG8_SA(1, 0), a3, voffA);
            PG8_WAIT_V(8); PG8_WAIT_L(0); PG8_BAR; PG8_MMA(1, 0, At, B0); PG8_MMA(1, 1, At, B1); PG8_BAR; PG8_SCHED;
        }
        if constexpr (ALIGN_EPI) { if (wr == 0) PG8_BAR; }
        { int fr2 = fr, fq2 = fq; asm volatile("" : "+v"(fr2), "+v"(fq2)); E(acc, cur, wr, wc, fr2, fq2); }
        if (!has_next) break;
#pragma unroll
        for (int a = 0; a < 2; ++a)
#pragma unroll
            for (int b = 0; b < 2; ++b)
#pragma unroll
                for (int m = 0; m < 4; ++m)
#pragma unroll
                    for (int n = 0; n < 2; ++n) acc[a][b][m][n] = (f32x4){0.f, 0.f, 0.f, 0.f};
        cur = nxt; cA = nA; cB = nB; ++ui;
        if constexpr (ALIGN_EPI) { if (wr == 1) PG8_BAR; }
    }
    PG8_WAIT_V(0);
    if constexpr (!ALIGN_EPI) { if (wr == 0) PG8_BAR; }
    PG8_BAR;
#undef PG8_SA
#undef PG8_SB
#undef PG8_STAGE
#undef PG8_LDA
#undef PG8_LDB
#undef PG8_MMA
#undef PG8_WAIT_V
#undef PG8_WAIT_L
#undef PG8_BAR
#undef PG8_SCHED
}
}
namespace epi {
using pg8::Unit;
typedef f32x4 Acc[2][2][4][2];

__device__ __forceinline__ float row_scale(const float* ssq, int row) {
    const f32x4* sp = (const f32x4*)(ssq + (size_t)row * 16);
    const f32x4 a = sp[0], b = sp[1], c = sp[2], d = sp[3];
    const float t = ((a[0] + a[1]) + (a[2] + a[3])) + ((b[0] + b[1]) + (b[2] + b[3])) + ((c[0] + c[1]) + (c[2] + c[3])) + ((d[0] + d[1]) + (d[2] + d[3]));
    return rsqrtf(t * (1.0f / 1024.0f) + EPS);
}
__device__ __forceinline__ u32x4 pack8(const f32x4 a, const f32x4 b) { u32x4 w; w.x = cvt_pk_bf16(a[0], a[1]); w.y = cvt_pk_bf16(a[2], a[3]); w.z = cvt_pk_bf16(b[0], b[1]); w.w = cvt_pk_bf16(b[2], b[3]); return w; }

struct EpiProj {
    static constexpr bool PERM = true;
    bf16_t* P; float* misc; const float* ssq; const float* cs; const float* sn; const float* gt;     bf16_t* VT;     bf16_t* KI;     bf16_t* CVT;     float* ssqv;
    __device__ __forceinline__ void operator()(const Acc& acc, const Unit& u, int wr, int wc, int fr, int fq) const {
        const int T = u.pn; const int row0 = u.pm * 256 + wr * 64 + fr;
        if (T == 2 || T == 3 || T == 5 || T == 6 || T == 14) {
            if (T == 14 && wc >= 2) return;
            if (T == 14 && wc == 1) {
                if (fq < 2) {
#pragma unroll
                    for (int ai = 0; ai < 2; ++ai)
#pragma unroll
                        for (int m = 0; m < 4; ++m) { const int row = row0 + ai * 128 + m * 16; const float rs = row_scale(ssq, row);
                            float* mp = misc + (size_t)row * 16 + 8 * fq; *(f32x4*)mp = acc[ai][0][m][0] * rs; *(f32x4*)(mp + 4) = acc[ai][0][m][1] * rs; }
                }
                return;
            }
            const int mode = (T == 14) ? 2 : (T <= 3 ? 1 : 0);
            const float* gp = gt + 64 * ((T == 2) ? 0 : (T == 3) ? 1 : 2);
            f32x4 g1[2], g2[2];
#pragma unroll
            for (int n = 0; n < 2; ++n) { if (mode) { g1[n] = *(const f32x4*)(gp + 8 * fq + 4 * n); g2[n] = *(const f32x4*)(gp + 32 + 8 * fq + 4 * n); } else { g1[n] = (f32x4){1.f, 1.f, 1.f, 1.f}; g2[n] = g1[n]; } }
#pragma unroll
            for (int ai = 0; ai < 2; ++ai)
#pragma unroll
                for (int m = 0; m < 4; ++m) {
                    const int row = row0 + ai * 128 + m * 16; const float rs = row_scale(ssq, row); const int pos = row & (S - 1);
                    f32x4 x1[2], x2[2];
#pragma unroll
                    for (int n = 0; n < 2; ++n) { x1[n] = acc[ai][0][m][n] * rs; x2[n] = acc[ai][1][m][n] * rs; }
                    if (mode == 2) {
                        float s = 0.f;
#pragma unroll
                        for (int n = 0; n < 2; ++n) s += (x1[n][0] + x1[n][1]) + (x1[n][2] + x1[n][3]) + (x2[n][0] + x2[n][1]) + (x2[n][2] + x2[n][3]);
                        s += __shfl_xor(s, 16); s += __shfl_xor(s, 32); const float mu = s * (1.f / 64.f);
#pragma unroll
                        for (int n = 0; n < 2; ++n) { x1[n] = x1[n] - mu; x2[n] = x2[n] - mu; }
                    }
                    if (mode) {
                        float q = 0.f;
#pragma unroll
                        for (int n = 0; n < 2; ++n) { const f32x4 a = x1[n] * x1[n], b = x2[n] * x2[n]; q += (a[0] + a[1]) + (a[2] + a[3]) + (b[0] + b[1]) + (b[2] + b[3]); }
                        q += __shfl_xor(q, 16); q += __shfl_xor(q, 32); const float rr = rsqrtf(q * (1.f / 64.f) + EPS);
#pragma unroll
                        for (int n = 0; n < 2; ++n) { x1[n] = x1[n] * rr * g1[n]; x2[n] = x2[n] * rr * g2[n]; }
                    }
                    f32x4 o1[2], o2[2];
#pragma unroll
                    for (int n = 0; n < 2; ++n) { const f32x4 c = *(const f32x4*)(cs + (size_t)pos * 32 + 8 * fq + 4 * n), s = *(const f32x4*)(sn + (size_t)pos * 32 + 8 * fq + 4 * n);
                        o1[n] = x1[n] * c - x2[n] * s; o2[n] = x2[n] * c + x1[n] * s; }
                    bf16_t* op = P + (size_t)row * PW + 256 * T + 64 * wc + 8 * fq;
                    *(u32x4*)op = pack8(o1[0], o1[1]); *(u32x4*)(op + 32) = pack8(o2[0], o2[1]);
                    if (T == 14) { bf16_t* kp = KI + (size_t)row * 64 + 8 * fq; *(u32x4*)kp = pack8(o1[0], o1[1]); *(u32x4*)(kp + 32) = pack8(o2[0], o2[1]); }
                }
            return;
        }
        const int act = (T <= 1) ? 1 : 0; const float sc = (T == 8) ? 0.125f : 1.0f;
#pragma unroll
        for (int ai = 0; ai < 2; ++ai)
#pragma unroll
            for (int m = 0; m < 4; ++m) {
                const int row = row0 + ai * 128 + m * 16; const float rs = row_scale(ssq, row) * sc;
                bf16_t* op = P + (size_t)row * PW + 256 * T + 32 * wc + 8 * fq; float qv = 0.f;
#pragma unroll
                for (int bj = 0; bj < 2; ++bj) { f32x4 v0 = acc[ai][bj][m][0] * rs, v1 = acc[ai][bj][m][1] * rs;
                    if (act) {
#pragma unroll
                        for (int e = 0; e < 4; ++e) { v0[e] = gelu_tanh_f(v0[e]); v1[e] = gelu_tanh_f(v1[e]); }
                        const f32x4 a2 = v0 * v0, b2 = v1 * v1; qv += ((a2[0] + a2[1]) + (a2[2] + a2[3])) + ((b2[0] + b2[1]) + (b2[2] + b2[3])); }
                    *(u32x4*)(op + bj * 128) = pack8(v0, v1);
                    if (T == 4 || T == 9) { bf16_t* vp = (T == 4 ? VT : CVT) + ((size_t)((row >> 12) * 256 + bj * 128 + 32 * wc + 8 * fq)) * S + (row & (S - 1));
#pragma unroll
                        for (int e = 0; e < 4; ++e) { vp[(size_t)e * S] = (bf16_t)f2bf(v0[e]); vp[(size_t)(4 + e) * S] = (bf16_t)f2bf(v1[e]); } } }
                if (T == 1) { qv += __shfl_xor(qv, 16); qv += __shfl_xor(qv, 32); if (fq == 0) ssqv[(size_t)row * 4 + wc] = qv; }
            }
    }
};

struct EpiPlain {
    static constexpr bool PERM = true;
    bf16_t* O; int ldc; int zcols;
    __device__ __forceinline__ void operator()(const Acc& acc, const Unit& u, int wr, int wc, int fr, int fq) const {
        const int row0 = u.pm * 256 + wr * 64 + fr; const int col0 = u.z * zcols + u.pn * 256 + 32 * wc + 8 * fq;
#pragma unroll
        for (int ai = 0; ai < 2; ++ai)
#pragma unroll
            for (int m = 0; m < 4; ++m) { bf16_t* op = O + (size_t)(row0 + ai * 128 + m * 16) * ldc + col0;
#pragma unroll
                for (int bj = 0; bj < 2; ++bj) *(u32x4*)(op + bj * 128) = pack8(acc[ai][bj][m][0], acc[ai][bj][m][1]); }
    }
};

struct EpiGate {
    static constexpr bool PERM = true;
    bf16_t* MG; const bf16_t* BR; const float* ssq;
    __device__ __forceinline__ void operator()(const Acc& acc, const Unit& u, int wr, int wc, int fr, int fq) const {
        const int row0 = u.pm * 256 + wr * 64 + fr; const int ch0 = u.pn * 64 + 16 * wc + 4 * fq;
#pragma unroll
        for (int ai = 0; ai < 2; ++ai)
#pragma unroll
            for (int m = 0; m < 4; ++m) {
                const int row = row0 + ai * 128 + m * 16; const float rs = row_scale(ssq, row);
                const bf16_t* bp = BR + (size_t)row * 4096 + ch0; f32x4 o = (f32x4){0.f, 0.f, 0.f, 0.f};
#pragma unroll
                for (int bj = 0; bj < 2; ++bj)
#pragma unroll
                    for (int n = 0; n < 2; ++n) { const u32x2 w = *(const u32x2*)(bp + (2 * bj + n) * 1024); const f32x4 a = acc[ai][bj][m][n] * rs;
                        o[0] += sigmoid_f(a[0]) * lo_bf(w.x); o[1] += sigmoid_f(a[1]) * hi_bf(w.x); o[2] += sigmoid_f(a[2]) * lo_bf(w.y); o[3] += sigmoid_f(a[3]) * hi_bf(w.y); }
                u32x2 ow; ow.x = cvt_pk_bf16(o[0], o[1]); ow.y = cvt_pk_bf16(o[2], o[3]);
                *(u32x2*)(MG + (size_t)row * 1024 + ch0) = ow;
            }
    }
};

struct EpiResid {
    static constexpr bool PERM = true;
    const float* res; float* out; bf16_t* XG; const float* gain; float* ssq;
    __device__ __forceinline__ void operator()(const Acc& acc, const Unit& u, int wr, int wc, int fr, int fq) const {
        const int row0 = u.pm * 256 + wr * 64 + fr; const int col0 = u.pn * 256 + 32 * wc + 8 * fq;
        f32x4 gv[2][2];
#pragma unroll
        for (int bj = 0; bj < 2; ++bj)
#pragma unroll
            for (int n = 0; n < 2; ++n) gv[bj][n] = gain ? *(const f32x4*)(gain + col0 + bj * 128 + 4 * n) : (f32x4){1.f, 1.f, 1.f, 1.f};
#pragma unroll
        for (int ai = 0; ai < 2; ++ai)
#pragma unroll
            for (int m = 0; m < 4; ++m) {
                const int row = row0 + ai * 128 + m * 16; const size_t off = (size_t)row * 1024 + col0; float q = 0.f;
#pragma unroll
                for (int bj = 0; bj < 2; ++bj) {
                    const f32x4 r0 = *(const f32x4*)(res + off + bj * 128), r1 = *(const f32x4*)(res + off + bj * 128 + 4);
                    const f32x4 x0 = r0 + acc[ai][bj][m][0], x1 = r1 + acc[ai][bj][m][1];
                    *(f32x4*)(out + off + bj * 128) = x0; *(f32x4*)(out + off + bj * 128 + 4) = x1;
                    const f32x4 a = x0 * x0, b = x1 * x1; q += ((a[0] + a[1]) + (a[2] + a[3])) + ((b[0] + b[1]) + (b[2] + b[3]));
                    *(u32x4*)(XG + off + bj * 128) = pack8(x0 * gv[bj][0], x1 * gv[bj][1]);
                }
                q += __shfl_xor(q, 16); q += __shfl_xor(q, 32);
                if (fq == 0) ssq[(size_t)row * 16 + 4 * u.pn + wc] = q;
            }
    }
};

struct EpiUp {
    static constexpr bool PERM = true;
    bf16_t* H; const float* ssq;
    __device__ __forceinline__ void operator()(const Acc& acc, const Unit& u, int wr, int wc, int fr, int fq) const {
        const int row0 = u.pm * 256 + wr * 64 + fr; const int col0 = u.pn * 256 + 32 * wc + 8 * fq;
#pragma unroll
        for (int ai = 0; ai < 2; ++ai)
#pragma unroll
            for (int m = 0; m < 4; ++m) { const int row = row0 + ai * 128 + m * 16; const float rs = row_scale(ssq, row); bf16_t* op = H + (size_t)row * FF + col0;
#pragma unroll
                for (int bj = 0; bj < 2; ++bj) { f32x4 v0 = acc[ai][bj][m][0] * rs, v1 = acc[ai][bj][m][1] * rs;
#pragma unroll
                    for (int e = 0; e < 4; ++e) { v0[e] = fmaxf(v0[e], 0.f); v1[e] = fmaxf(v1[e], 0.f); }
                    *(u32x4*)(op + bj * 128) = pack8(v0 * v0, v1 * v1); } }
    }
};
}
struct Args {
    const float* in[18]; float* out; unsigned char* ws; int ph_lo, ph_hi; int coop, pad;
};
struct Frame { LAS unsigned char* lds; int tid, lane, wave, G, vcu; };
constexpr int PTR_OFF = LDS_BYTES - 512;
enum { I_X = 0, I_LN_MIX, I_W_IN, I_SGU_NORM, I_SGU_W, I_SGU_B, I_Q_NORM, I_K_NORM, I_KIDX_NORM, I_I_BIAS, I_F_BIAS, I_MNORM, I_CONV_W, I_W_BRANCH, I_W_OUT, I_LN_MLP, I_W_UP, I_W_DOWN, I_OUT, I_WS };
__device__ __forceinline__ unsigned char* ptr_at(const Frame& F, int i) { const LAS unsigned* p = (const LAS unsigned*)(F.lds + PTR_OFF) + 2 * i;
    const unsigned lo = __builtin_amdgcn_readfirstlane(p[0]), hi = __builtin_amdgcn_readfirstlane(p[1]);
    typedef __attribute__((address_space(1))) unsigned char* gptr_t;
    return (unsigned char*)(gptr_t)(((unsigned long long)hi << 32) | lo); }
#define INP(i) ((const float*)ptr_at(F, (i)))
#define WSP(off) (ptr_at(F, I_WS) + (off))
constexpr size_t WS_GT = 512 * 1024;
__device__ __forceinline__ size_t maskt_idx(int m, int w) { const int b = m >> 12, t = m & (S - 1); return ((size_t)(b * 64 + (w >> 1)) * S + t) * 2 + (w & 1); }


#define XB_TMO      128
#define XB_XCNT(j)  (256  + 64 * (j))
#define XB_XSUB(j)  (1280 + 64 * (j))
#define XB_XGEN(j)  (2304 + 64 * (j))
#define XB_TOP      3328
#define XB_TOPGEN   3392
#define XCD_BAR_WORDS 3456
#define XB_SPIN_CAP (1u << 22)
constexpr size_t WS_BAR = 64 * 1024;
constexpr size_t CTL_ZERO_BYTES = 128 * 1024;
__device__ __forceinline__ unsigned xb_ld(unsigned* p)              { return __hip_atomic_load(p, __ATOMIC_RELAXED, __HIP_MEMORY_SCOPE_AGENT); }
__device__ __forceinline__ unsigned xb_add(unsigned* p, unsigned v) { return __hip_atomic_fetch_add(p, v, __ATOMIC_RELAXED, __HIP_MEMORY_SCOPE_AGENT); }
__device__ __forceinline__ unsigned xb_xcc_id() { return (unsigned)__builtin_amdgcn_s_getreg((3 << 11) | 20) & 0xFu; }
#define XB_SPIN(cond, bar) do { unsigned _sp = 0; while (cond) { __builtin_amdgcn_s_sleep(1); \
    if ((++_sp & 255u) == 0u) { if (xb_ld(&(bar)[XB_TMO])) break; if (_sp > XB_SPIN_CAP) { atomicAdd(&(bar)[XB_TMO], 1u); break; } } } } while (0)
struct XcdBarrier { unsigned* bar; unsigned x; volatile LAS unsigned* st; };
__device__ __forceinline__ XcdBarrier xcd_barrier_post(unsigned* bar, volatile LAS unsigned* st) {
    XcdBarrier b; b.bar = bar; b.x = xb_xcc_id(); b.st = st;
    if (threadIdx.x == 0) (void)xb_add(&bar[XB_XCNT(b.x)], 1u);
    return b;
}
__device__ __forceinline__ void xcd_barrier_complete(unsigned* bar, unsigned x, unsigned& nloc, unsigned& nx) {
    const unsigned G = gridDim.x * gridDim.y * gridDim.z;
    unsigned sum, cnt, mine, sp = 0u;
    for (;;) {
        sum = 0u; cnt = 0u; mine = 0u;
#pragma unroll
        for (unsigned j = 0; j < 16; ++j) { const unsigned c = xb_ld(&bar[XB_XCNT(j)]); sum += c; cnt += (c > 0u) ? 1u : 0u; mine = (j == x) ? c : mine; }
        if (sum == G) break;
        __builtin_amdgcn_s_sleep(1);
        if ((++sp & 255u) == 0u) { if (xb_ld(&bar[XB_TMO])) break; if (sp > XB_SPIN_CAP) { atomicAdd(&bar[XB_TMO], 1u); break; } }
    }
    nloc = mine > 0u ? mine : 1u; nx = cnt > 0u ? cnt : 1u;
}
__device__ __forceinline__ void xcd_barrier(const XcdBarrier& b) {
    asm volatile("s_waitcnt vmcnt(0)" ::: "memory");
    __syncthreads();
    if (threadIdx.x == 0) {
        unsigned* bar = b.bar;
        __builtin_amdgcn_s_waitcnt(0);
        unsigned nloc = b.st[0], nx = b.st[1];
        if (nloc == 0u) { xcd_barrier_complete(bar, b.x, nloc, nx); b.st[0] = nloc; b.st[1] = nx; }
        const unsigned old = xb_add(&bar[XB_XSUB(b.x)], 1u);
        const unsigned gen = old / nloc;
        if (old + 1u == (gen + 1u) * nloc) {
            __builtin_amdgcn_fence(__ATOMIC_RELEASE, "agent");
            asm volatile("s_waitcnt vmcnt(0)" ::: "memory");
            const unsigned og = xb_add(&bar[XB_TOP], 1u);
            const unsigned tg = og / nx;
            if (og + 1u == (tg + 1u) * nx) xb_add(&bar[XB_TOPGEN], 1u);
            else XB_SPIN(xb_ld(&bar[XB_TOPGEN]) == tg, bar);
            __builtin_amdgcn_fence(__ATOMIC_ACQUIRE, "agent");
            xb_add(&bar[XB_XGEN(b.x)], 1u);
            asm volatile("s_waitcnt vmcnt(0)" ::: "memory");
        } else {
            XB_SPIN(xb_ld(&bar[XB_XGEN(b.x)]) == gen, bar);
            __builtin_amdgcn_fence(__ATOMIC_ACQUIRE, "agent");
            asm volatile("s_waitcnt vmcnt(0)" ::: "memory");
        }
    }
    __syncthreads();
}

__device__ __forceinline__ int win_src(int p) {
    const int T = p >> 8, q = p & 255, bj = q >> 7, wc = (q >> 5) & 3, j = q & 31, hd = 64 * wc + 32 * bj + j;
    switch (T) {
        case 0: return O_AU + q; case 1: return O_AV + q; case 2: return O_BQ + hd; case 3: return O_BK + hd; case 4: return O_BV + q;
        case 5: return O_QI + hd; case 6: return O_QI + 256 + hd; case 7: return O_CQ + q; case 8: return O_CK + q; case 9: return O_CV + q;
        case 10: return O_CO + q; case 11: return O_DB + q; case 12: return O_DC + q; case 13: return O_DX + q;
        default: break;
    }
    if (wc == 0) return O_KI + 32 * bj + j;
    if (wc == 1 && bj == 0 && j < 16) return j < 8 ? O_WI + j : (j < 12 ? O_CI + (j - 8) : O_CF + (j - 12));
    return -1;
}
__device__ __forceinline__ int wg_src(int p) {
    const int pn = p >> 8, q = p & 255, bj = q >> 7, wc = (q >> 5) & 3, fq = (q >> 3) & 3, n = (q >> 2) & 1, e = q & 3;
    return O_G + (2 * bj + n) * 1024 + 64 * pn + 16 * wc + 4 * fq + e;
}
template <int MAP>
__device__ __forceinline__ void conv_item(const float* W, int K, int srcN, bf16_t* WT, LAS float* scr, int item, int nrows, int lane) {
    const int nblk = nrows / 32, kb = item / nblk, nb = item % nblk, k0 = 64 * kb, n0 = 32 * nb;
    const int nn = n0 + (lane & 31); const int src = MAP == 0 ? nn : (MAP == 1 ? win_src(nn) : wg_src(nn));
    float wv_[32]; const float* wp_ = W + (size_t)(k0 + (lane >> 5)) * srcN + (src >= 0 ? src : 0);
#pragma unroll
    for (int i = 0; i < 32; ++i) wv_[i] = __builtin_nontemporal_load(wp_ + (size_t)(2 * i) * srcN);
#pragma unroll
    for (int i = 0; i < 32; ++i) scr[(2 * i + (lane >> 5)) * 33 + (lane & 31)] = src >= 0 ? wv_[i] : 0.f;
    asm volatile("s_waitcnt lgkmcnt(0)" ::: "memory");
    const int c = lane & 7;
#pragma unroll
    for (int j = 0; j < 4; ++j) { const int n = (lane >> 3) + 8 * j; const LAS float* s = scr + (8 * c) * 33 + n;
        u32x4 o; o.x = pk2(s[0 * 33], s[1 * 33]); o.y = pk2(s[2 * 33], s[3 * 33]); o.z = pk2(s[4 * 33], s[5 * 33]); o.w = pk2(s[6 * 33], s[7 * 33]);
        *(u32x4*)(WT + (size_t)(n0 + n) * K + k0 + 8 * c) = o; }
    asm volatile("s_waitcnt lgkmcnt(0)" ::: "memory");
}
__device__ __forceinline__ void convert_mix_weights(Frame& F, int l) {

    LAS float* scr = (LAS float*)(F.lds + F.wave * 16384);
    const int gw = F.vcu * NWAVES + F.wave, NGW = F.G * NWAVES;
    constexpr int I_WIN = (D / 64) * (PW / 32), I_WG = (D / 64) * (4096 / 32), I_BR = (256 / 64) * (1024 / 32), I_OUT = (D / 64) * (D / 32);
    constexpr int NIT = I_WIN + I_WG + 4 * I_BR + I_OUT;
    const float* win = INP(I_W_IN) + (size_t)l * D * INW;
    for (int it = gw; it < NIT; it += NGW) {
        int r = it;
        if (r < I_WIN) { conv_item<1>(win, D, INW, ((bf16_t*)WSP(WS_WIN)), scr, r, PW, F.lane); continue; } r -= I_WIN;
        if (r < I_WG) { conv_item<2>(win, D, INW, ((bf16_t*)WSP(WS_WG)), scr, r, 4096, F.lane); continue; } r -= I_WG;
        if (r < 4 * I_BR) { const int nb = r / I_BR; conv_item<0>(INP(I_W_BRANCH) + ((size_t)l * 4 + nb) * 256 * D, 256, D, ((bf16_t*)WSP(WS_WBR)) + (size_t)nb * 1024 * 256, scr, r % I_BR, 1024, F.lane); continue; } r -= 4 * I_BR;
        conv_item<0>(INP(I_W_OUT) + (size_t)l * D * D, D, D, ((bf16_t*)WSP(WS_WOUT)), scr, r, D, F.lane);
    }
}
__device__ __forceinline__ void convert_mlp_weights(Frame& F, int l) {

    LAS float* scr = (LAS float*)(F.lds + F.wave * 16384);
    const int gw = F.vcu * NWAVES + F.wave, NGW = F.G * NWAVES;
    constexpr int I_UP = (D / 64) * (FF / 32), I_DN = (FF / 64) * (D / 32);
    for (int it = gw; it < I_UP + I_DN; it += NGW) {
        if (it < I_UP) conv_item<0>(INP(I_W_UP) + (size_t)l * D * FF, D, FF, ((bf16_t*)WSP(WS_WUP)), scr, it, FF, F.lane);
        else conv_item<0>(INP(I_W_DOWN) + (size_t)l * FF * D, FF, D, ((bf16_t*)WSP(WS_WDN)), scr, it - I_UP, D, F.lane);
    }
}
__device__ __forceinline__ void prologue_rows(Frame& F) {
    float* COS = (float*)WSP(WS_COS); float* SIN = (float*)WSP(WS_SIN); float* SSQA = (float*)WSP(WS_SSQA); bf16_t* XG = (bf16_t*)WSP(WS_XG); const float* x = INP(I_X); const float* ln_mix = INP(I_LN_MIX);
    const int gt = F.vcu * NT + F.tid, NGT = F.G * NT;
    for (int i = gt; i < S * 32; i += NGT) { const int pos = i >> 5, k = i & 31; const float inv = powf(10000.f, -(float)k * 2.0f / 64.f); const float ang = (float)pos * inv; COS[i] = cosf(ang); SIN[i] = sinf(ang); }
    const int gw = F.vcu * NWAVES + F.wave, NGW = F.G * NWAVES;
    for (int m = gw; m < M; m += NGW) {
        const f32x4* xr = (const f32x4*)(x + (size_t)m * D) + F.lane; const f32x4* gr = (const f32x4*)ln_mix + F.lane;
        unsigned long long* o8 = (unsigned long long*)(XG + (size_t)m * D) + F.lane;
#pragma unroll
        for (int j = 0; j < 4; ++j) { const f32x4 v = xr[64 * j], g = gr[64 * j]; float s = (v[0] * v[0] + v[1] * v[1]) + (v[2] * v[2] + v[3] * v[3]);
            s += __shfl_xor(s, 1); s += __shfl_xor(s, 2); s += __shfl_xor(s, 4); s += __shfl_xor(s, 8);
            if ((F.lane & 15) == 0) SSQA[(size_t)m * 16 + 4 * j + (F.lane >> 4)] = s;
            o8[64 * j] = (unsigned long long)pk2(v[0] * g[0], v[1] * g[1]) | ((unsigned long long)pk2(v[2] * g[2], v[3] * g[3]) << 32); }
    }
}

__device__ __forceinline__ void sgu_simple(Frame& F, int l) {
    bf16_t* PROJ = (bf16_t*)WSP(WS_BIG); bf16_t* Y = (bf16_t*)WSP(WS_Y); const float* sgu_norm = INP(I_SGU_NORM); const float* sgu_w = INP(I_SGU_W); const float* sgu_b = INP(I_SGU_B);
    LAS float* r_s = (LAS float*)F.lds; LAS float* vn = r_s + 128;
    const float* gain = sgu_norm + l * 256; const float* sw = sgu_w + (size_t)l * 4 * 128 * 128; const float* sb = sgu_b + l * 4 * 128;
    for (int item = F.vcu; item < 512; item += F.G) {
        const int g = item & 3, m0 = (item >> 2) * 128;
        for (int i = 0; i < 16; ++i) { const int tok = F.wave * 16 + i; const u32x2 w = *(const u32x2*)(PROJ + (size_t)(m0 + tok) * PW + P_AV + 4 * F.lane);
            const float a = lo_bf(w.x), b = hi_bf(w.x), c = lo_bf(w.y), d = hi_bf(w.y); const float ss = wave_sum((a * a + b * b) + (c * c + d * d));
            if (F.lane == 0) r_s[tok] = rsqrtf(ss * (1.f / 256.f) + EPS); }
        __syncthreads();
        for (int idx = F.tid; idx < 8192; idx += NT) { const int s = idx >> 6, d = idx & 63; vn[idx] = bf2f(PROJ[(size_t)(m0 + s) * PW + P_AV + g * 64 + d]) * r_s[s] * gain[g * 64 + d]; }
        __syncthreads();
        const int d = F.tid & 63, tq = F.tid >> 6;
        for (int tl = tq; tl < 128; tl += 8) { const float* w = sw + ((size_t)g * 128 + tl) * 128; float acc = 0.f;
            for (int s = 0; s <= tl; ++s) acc = fmaf(w[s], vn[s * 64 + d], acc);
            acc += sb[g * 128 + tl];
            Y[(size_t)(m0 + tl) * D + g * 64 + d] = (bf16_t)f2bf(bf2f(PROJ[(size_t)(m0 + tl) * PW + P_AU + g * 64 + d]) * acc); }
        __syncthreads();
    }
}
__device__ __forceinline__ void conv_simple(Frame& F, int l) {
    bf16_t* PROJ = (bf16_t*)WSP(WS_BIG); bf16_t* Y = (bf16_t*)WSP(WS_Y); const float* conv_w = INP(I_CONV_W);
    const float* cw = conv_w + l * 3 * 256;
    for (int i = F.vcu * NT + F.tid; i < M * 256; i += F.G * NT) { const int m = i >> 8, c = i & 255, t = m & (S - 1); float acc = 0.f;
#pragma unroll
        for (int j = 0; j < 3; ++j) { const int tt = t - 2 + j; if (tt >= 0) { const size_t r = (size_t)(m - 2 + j) * PW; acc = fmaf(cw[j * 256 + c], bf2f(PROJ[r + P_DC + c]) * bf2f(PROJ[r + P_DX + c]), acc); } }
        Y[(size_t)m * D + 768 + c] = (bf16_t)f2bf(bf2f(PROJ[(size_t)m * PW + P_DB + c]) * acc); }
}
__device__ __forceinline__ void indexer_simple(Frame& F) {
    float* MISC = (float*)WSP(WS_MISC); unsigned* MASK = (unsigned*)WSP(WS_MASK); bf16_t* PROJ = (bf16_t*)WSP(WS_BIG);
    LAS float* sc = (LAS float*)F.lds; LAS int* red = (LAS int*)(sc + 4096); LAS unsigned* msk = (LAS unsigned*)(red + 16);
    for (int m = F.vcu; m < M; m += F.G) {
        const int t = m & (S - 1), b0 = m - t, n = t + 1;
        if (n <= 256) { if (F.tid < 128) { const int lo = 32 * F.tid; MASK[maskt_idx(m, F.tid)] = (lo + 32 <= n) ? 0xffffffffu : (lo >= n ? 0u : ((1u << (n - lo)) - 1u)); } continue; }
        float qreg[8], wh[8];
#pragma unroll
        for (int h = 0; h < 8; ++h) { qreg[h] = bf2f(PROJ[(size_t)m * PW + P_QI + h * 64 + F.lane]); wh[h] = MISC[(size_t)m * 16 + h] * 0.35355339059327373f; }
        for (int s0 = 0; s0 < n; s0 += NT) {
            const int s = s0 + F.tid, sc_ = s < n ? s : n - 1; const u32x4* kr = (const u32x4*)(PROJ + (size_t)(b0 + sc_) * PW + P_KI);
            float kf[64];
#pragma unroll
            for (int i = 0; i < 8; ++i) { const u32x4 w = kr[i]; kf[8 * i] = lo_bf(w.x); kf[8 * i + 1] = hi_bf(w.x); kf[8 * i + 2] = lo_bf(w.y); kf[8 * i + 3] = hi_bf(w.y); kf[8 * i + 4] = lo_bf(w.z); kf[8 * i + 5] = hi_bf(w.z); kf[8 * i + 6] = lo_bf(w.w); kf[8 * i + 7] = hi_bf(w.w); }
            float acc = 0.f;
#pragma unroll
            for (int h = 0; h < 8; ++h) { float d0 = 0.f, d1 = 0.f;
#pragma unroll
                for (int e = 0; e < 64; e += 2) { d0 = fmaf(__builtin_bit_cast(float, __builtin_amdgcn_readlane(__builtin_bit_cast(int, qreg[h]), e)), kf[e], d0);
                                                   d1 = fmaf(__builtin_bit_cast(float, __builtin_amdgcn_readlane(__builtin_bit_cast(int, qreg[h]), e + 1)), kf[e + 1], d1); }
                acc += wh[h] * fmaxf((d0 + d1) * 0.125f, 0.f); }
            if (s < n) sc[s] = acc;
        }
        __syncthreads();
        unsigned Tk = 0u;
        for (int bit = 31; bit >= 0; --bit) {
            const unsigned cand = Tk | (1u << bit); int c = 0;
            for (int s = F.tid; s < n; s += NT) c += (fkey(sc[s]) >= cand) ? 1 : 0;
            c = wave_sum_i(c); if (F.lane == 0) red[F.wave] = c; __syncthreads();
            int tot = 0;
#pragma unroll
            for (int w = 0; w < 8; ++w) tot += red[w];
            __syncthreads();
            if (tot >= 256) Tk = cand;
        }
        int cg_ = 0, ce = 0;
        for (int s = F.tid; s < n; s += NT) { const unsigned k = fkey(sc[s]); cg_ += k > Tk ? 1 : 0; ce += k == Tk ? 1 : 0; }
        cg_ = wave_sum_i(cg_); ce = wave_sum_i(ce); if (F.lane == 0) { red[F.wave] = cg_; red[8 + F.wave] = ce; }
        if (F.tid < 128) msk[F.tid] = 0u;
        __syncthreads();
        int ngt = 0, neq = 0;
#pragma unroll
        for (int w = 0; w < 8; ++w) { ngt += red[w]; neq += red[8 + w]; }
        const bool all_eq = (ngt + neq == 256);
        for (int s = F.tid; s < n; s += NT) { const unsigned k = fkey(sc[s]); if (k > Tk || (all_eq && k == Tk)) atomicOr((unsigned*)&msk[s >> 5], 1u << (s & 31)); }
        __syncthreads();
        if (!all_eq && F.tid == 0) { int need = 256 - ngt; for (int s = 0; s < n && need > 0; ++s) if (fkey(sc[s]) == Tk) { msk[s >> 5] |= 1u << (s & 31); --need; } }
        __syncthreads();
        if (F.tid < 128) MASK[maskt_idx(m, F.tid)] = msk[F.tid];
        __syncthreads();
    }
}
__device__ __forceinline__ void attn_simple(Frame& F) {
    unsigned* MASK = (unsigned*)WSP(WS_MASK); bf16_t* PROJ = (bf16_t*)WSP(WS_BIG); bf16_t* Y = (bf16_t*)WSP(WS_Y);
    LAS unsigned* msk = (LAS unsigned*)F.lds; LAS int* sel = (LAS int*)(msk + 128); LAS float* lg = (LAS float*)(sel + 256); LAS int* nsel = (LAS int*)(lg + 4 * 256);
    for (int m = F.vcu; m < M; m += F.G) {
        const int t = m & (S - 1), b0 = m - t;
        if (F.tid < 128) msk[F.tid] = MASK[maskt_idx(m, F.tid)];
        __syncthreads();
        if (F.tid == 0) { int c = 0; for (int w = 0; w < 128; ++w) { unsigned bits = msk[w]; while (bits) { const int i = __builtin_ctz(bits); if (c < 256) sel[c] = 32 * w + i; ++c; bits &= bits - 1; } } nsel[0] = c < 256 ? c : 256; }
        __syncthreads();
        const int ns = nsel[0], h = F.wave & 3, part = F.wave >> 2;
        const float q = bf2f(PROJ[(size_t)m * PW + P_Q + h * 64 + F.lane]);
        for (int j = part; j < ns; j += 2) { const float d = wave_sum(q * bf2f(PROJ[(size_t)(b0 + sel[j]) * PW + P_K + h * 64 + F.lane])); if (F.lane == 0) lg[h * 256 + j] = d * 0.125f; }
        __syncthreads();
        if (F.wave < 4) {
            float mx = -INFINITY; for (int j = F.lane; j < ns; j += 64) mx = fmaxf(mx, lg[h * 256 + j]); mx = wave_max(mx);
            float sm = 0.f; for (int j = F.lane; j < ns; j += 64) sm += __expf(lg[h * 256 + j] - mx); sm = wave_sum(sm);
            float o = 0.f; for (int j = 0; j < ns; ++j) o = fmaf(__expf(lg[h * 256 + j] - mx), bf2f(PROJ[(size_t)(b0 + sel[j]) * PW + P_V + h * 64 + F.lane]), o);
            Y[(size_t)m * D + 256 + h * 64 + F.lane] = (bf16_t)f2bf(o / sm);
        }
        __syncthreads();
    }
}
__device__ __forceinline__ void mlstm1_simple(Frame& F, int l) {
    float* MISC = (float*)WSP(WS_MISC); float* STATE = (float*)WSP(WS_STATE); bf16_t* PROJ = (bf16_t*)WSP(WS_BIG); const float* i_bias = INP(I_I_BIAS); const float* f_bias = INP(I_F_BIAS);
    LAS float* bs = (LAS float*)F.lds; LAS float* ig = bs + 128; LAS float* wk = ig + 128; LAS float* kt = wk + 128; LAS float* vt = kt + 128 * 64;
    for (int item = F.vcu; item < 512; item += F.G) {
        const int bh = item >> 5, c = item & 31, b = bh >> 2, h = bh & 3, m0 = b * S + c * 128;
        if (F.tid < 128) { const float f = MISC[(size_t)(m0 + F.tid) * 16 + 12 + h] + f_bias[l * 4 + h]; bs[F.tid] = fminf(f, 0.f) - log1pf(__expf(-fabsf(f))); ig[F.tid] = MISC[(size_t)(m0 + F.tid) * 16 + 8 + h] + i_bias[l * 4 + h]; }
        for (int idx = F.tid; idx < 8192; idx += NT) { const int s = idx >> 6, d = idx & 63; kt[idx] = bf2f(PROJ[(size_t)(m0 + s) * PW + P_CK + h * 64 + d]); vt[idx] = bf2f(PROJ[(size_t)(m0 + s) * PW + P_CV + h * 64 + d]); }
        __syncthreads();
        if (F.tid == 0) { float a = 0.f; for (int s = 0; s < 128; ++s) { a += bs[s]; bs[s] = a; } }
        __syncthreads();
        const float B = bs[127];
        if (F.tid < 128) wk[F.tid] = __expf(B - bs[F.tid] + ig[F.tid]);
        __syncthreads();
        const int e = F.tid & 63, dq = F.tid >> 6; float acc[8];
#pragma unroll
        for (int i = 0; i < 8; ++i) acc[i] = 0.f;
        for (int s = 0; s < 128; ++s) { const float kv = wk[s] * vt[s * 64 + e];
#pragma unroll
            for (int i = 0; i < 8; ++i) acc[i] = fmaf(kt[s * 64 + dq * 8 + i], kv, acc[i]); }
        float* st = STATE + (size_t)item * STATE_STRIDE;
#pragma unroll
        for (int i = 0; i < 8; ++i) st[e * 64 + dq * 8 + i] = acc[i];
        if (F.tid < 64) { float a = 0.f; for (int s = 0; s < 128; ++s) a = fmaf(wk[s], kt[s * 64 + F.tid], a); st[4096 + F.tid] = a; }
        if (F.tid == 0) st[4160] = B;
        __syncthreads();
    }
}
__device__ __forceinline__ void mlstm2_simple(Frame& F, int l) {
    float* MISC = (float*)WSP(WS_MISC); float* STATE = (float*)WSP(WS_STATE); bf16_t* PROJ = (bf16_t*)WSP(WS_BIG); bf16_t* Y = (bf16_t*)WSP(WS_Y); const float* i_bias = INP(I_I_BIAS); const float* f_bias = INP(I_F_BIAS); const float* mnorm = INP(I_MNORM);
    LAS float* Cs = (LAS float*)F.lds; LAS float* ns = Cs + 4096; LAS float* bs = ns + 64; LAS float* ig = bs + 128; LAS float* A = ig + 128;
    LAS float* qt = A + 128 * 128; LAS float* kt = qt + 128 * 65;
    for (int item = F.vcu; item < 512; item += F.G) {
        const int bh = item >> 5, c = item & 31, b = bh >> 2, h = bh & 3, m0 = b * S + c * 128;
        { float Cv[8]; float nv = 0.f;
#pragma unroll
          for (int k = 0; k < 8; ++k) Cv[k] = 0.f;
          for (int cc = 0; cc < c; ++cc) { const float* st = STATE + (size_t)(bh * 32 + cc) * STATE_STRIDE; const float dec = __expf(st[4160]);
#pragma unroll
              for (int k = 0; k < 8; ++k) Cv[k] = fmaf(dec, Cv[k], st[F.tid + NT * k]);
              if (F.tid < 64) nv = fmaf(dec, nv, st[4096 + F.tid]); }
#pragma unroll
          for (int k = 0; k < 8; ++k) Cs[F.tid + NT * k] = Cv[k];
          if (F.tid < 64) ns[F.tid] = nv; }
        if (F.tid < 128) { const float f = MISC[(size_t)(m0 + F.tid) * 16 + 12 + h] + f_bias[l * 4 + h]; bs[F.tid] = fminf(f, 0.f) - log1pf(__expf(-fabsf(f))); ig[F.tid] = MISC[(size_t)(m0 + F.tid) * 16 + 8 + h] + i_bias[l * 4 + h]; }
        for (int idx = F.tid; idx < 8192; idx += NT) { const int s = idx >> 6, d = idx & 63; qt[s * 65 + d] = bf2f(PROJ[(size_t)(m0 + s) * PW + P_CQ + h * 64 + d]); kt[s * 65 + d] = bf2f(PROJ[(size_t)(m0 + s) * PW + P_CK + h * 64 + d]); }
        __syncthreads();
        if (F.tid == 0) { float a = 0.f; for (int s = 0; s < 128; ++s) { a += bs[s]; bs[s] = a; } }
        __syncthreads();
        { const int s = F.tid & 127, jq = F.tid >> 7;
          for (int j = jq; j < 128; j += 4) { float v = 0.f;
              if (s <= j) { float d = 0.f;
#pragma unroll 16
                  for (int k = 0; k < 64; ++k) d = fmaf(qt[j * 65 + k], kt[s * 65 + k], d);
                  v = __expf(bs[j] - bs[s] + ig[s]) * d; }
              A[j * 128 + s] = v; } }
        __syncthreads();
        LAS float* vt = kt;
        for (int idx = F.tid; idx < 8192; idx += NT) { const int s = idx >> 6, d = idx & 63; vt[idx] = bf2f(PROJ[(size_t)(m0 + s) * PW + P_CV + h * 64 + d]); }
        __syncthreads();
        const int e = F.lane; const float gn = mnorm[l * 256 + h * 64 + e];
        for (int j = F.wave; j < 128; j += 8) {
            float num = 0.f, qn = 0.f, sa = 0.f;
            for (int d = 0; d < 64; ++d) { const float qd = qt[j * 65 + d]; num = fmaf(qd, Cs[d * 64 + e], num); qn = fmaf(qd, ns[d], qn); }
            const float eb = __expf(bs[j]); num *= eb; qn *= eb;
            for (int s = 0; s <= j; ++s) { const float a = A[j * 128 + s]; num = fmaf(a, vt[s * 64 + e], num); sa += a; }
            const float hv = num / fmaxf(fabsf(qn + sa), 1.f);
            const float r = rsqrtf(wave_sum(hv * hv) * (1.f / 64.f) + EPS);
            const size_t row = (size_t)(m0 + j);
            Y[row * D + 512 + h * 64 + e] = (bf16_t)f2bf(sigmoid_f(bf2f(PROJ[row * PW + P_CO + h * 64 + e])) * hv * r * gn);
        }
        __syncthreads();
    }
}
typedef float f32x16 __attribute__((ext_vector_type(16)));
constexpr size_t WS_VT = WS_BIG + 120 * MiB;
constexpr float LOG2E = 1.4426950408889634f;

__device__ __forceinline__ void attn_mfma(Frame& F, int l) {
    const unsigned long long* MASKT = (const unsigned long long*)WSP(WS_MASK); const bf16_t* PROJ = (const bf16_t*)WSP(WS_BIG); const bf16_t* VT = (const bf16_t*)WSP(WS_VT);
    bf16_t* Y = (bf16_t*)WSP(WS_Y); const float* gt = (const float*)WSP(WS_GT) + l * 192;
    const int lane = F.lane, r32 = lane & 31, hi = lane >> 5, grp = F.wave >> 2, w4 = F.wave & 3, lg = F.tid & 255;
    const float mq = wave_max(fabsf(gt[lane])), mk = wave_max(fabsf(gt[64 + lane]));
    const float c1 = 0.125f * LOG2E, c2 = 8.f * mq * mk * 1.01f * LOG2E;
    constexpr int ROWB = 144, TILEB = 64 * ROWB;
    LAS unsigned char* gb = F.lds + grp * 4 * TILEB;
    LAS float* comb = (LAS float*)(F.lds + 8 * TILEB);
    const int srow0 = lg >> 3, sc0 = lg & 7;
    for (int item = F.vcu; item < 256; item += F.G) {
        const int bh = item >> 4, sidx = item & 15, b = bh >> 2, h = bh & 3;
#pragma unroll 1
        for (int half = 0; half < 2; ++half) {
            const int qb = half == 0 ? sidx : 31 - sidx, q0 = qb * 128, ntl = qb + 1;
            const int qrow = b * S + q0 + w4 * 32 + r32, tq = q0 + w4 * 32 + r32;
            bf16x8 qf[4];
#pragma unroll
            for (int s = 0; s < 4; ++s) qf[s] = *(const bf16x8*)(PROJ + (size_t)qrow * PW + P_Q + h * 64 + 16 * s + 8 * hi);
            f32x16 o0, o1;
#pragma unroll
            for (int r = 0; r < 16; ++r) { o0[r] = 0.f; o1[r] = 0.f; }
            float lsum = 0.f;
            const bf16_t* kbase = PROJ + (size_t)(b * S + srow0) * PW + P_K + h * 64 + sc0 * 8;
            const bf16_t* vbase = VT + (size_t)(b * 256 + h * 64 + srow0) * S + sc0 * 8;
            const unsigned long long* mbase = MASKT + (size_t)(b * 64) * S + tq;
            u32x4 kr0, kr1, vr0, vr1; unsigned long long mw, mwn = 0ull;
            { const int t = grp; kr0 = *(const u32x4*)(kbase + (size_t)t * 64 * PW); kr1 = *(const u32x4*)(kbase + (size_t)(t * 64 + 32) * PW);
              vr0 = *(const u32x4*)(vbase + t * 64); vr1 = *(const u32x4*)(vbase + 32 * S + t * 64); mw = mbase[(size_t)t * S];
              LAS unsigned char* kb = gb; LAS unsigned char* vb = gb + TILEB;
              *(LAS u32x4*)(kb + srow0 * ROWB + sc0 * 16) = kr0; *(LAS u32x4*)(kb + (srow0 + 32) * ROWB + sc0 * 16) = kr1;
              *(LAS u32x4*)(vb + srow0 * ROWB + sc0 * 16) = vr0; *(LAS u32x4*)(vb + (srow0 + 32) * ROWB + sc0 * 16) = vr1; }
            __syncthreads();
#pragma unroll 1
            for (int i = 0; i < ntl; ++i) {
                const int cur = i & 1; const bool more = (i + 1 < ntl);
                if (more) { const int t = 2 * (i + 1) + grp; kr0 = *(const u32x4*)(kbase + (size_t)t * 64 * PW); kr1 = *(const u32x4*)(kbase + (size_t)(t * 64 + 32) * PW);
                    vr0 = *(const u32x4*)(vbase + t * 64); vr1 = *(const u32x4*)(vbase + 32 * S + t * 64); mwn = mbase[(size_t)t * S]; }
                const LAS unsigned char* kb = gb + cur * 2 * TILEB; const LAS unsigned char* vb = kb + TILEB;
                f32x16 p0, p1;
#pragma unroll
                for (int r = 0; r < 16; ++r) { p0[r] = 0.f; p1[r] = 0.f; }
#pragma unroll
                for (int s = 0; s < 4; ++s) {
                    const bf16x8 k0 = *(const LAS bf16x8*)(kb + r32 * ROWB + 32 * s + 16 * hi), k1 = *(const LAS bf16x8*)(kb + (32 + r32) * ROWB + 32 * s + 16 * hi);
                    p0 = __builtin_amdgcn_mfma_f32_32x32x16_bf16(k0, qf[s], p0, 0, 0, 0); p1 = __builtin_amdgcn_mfma_f32_32x32x16_bf16(k1, qf[s], p1, 0, 0, 0);
                }
                const unsigned sh0 = (unsigned)mw >> (4 * hi), sh1 = (unsigned)(mw >> 32) >> (4 * hi);
#pragma unroll
                for (int r = 0; r < 16; ++r) { const int cb = (r & 3) + 8 * (r >> 2);
                    const float e0 = __builtin_amdgcn_exp2f(p0[r] * c1 - c2), e1 = __builtin_amdgcn_exp2f(p1[r] * c1 - c2);
                    p0[r] = ((sh0 >> cb) & 1u) ? e0 : 0.f; p1[r] = ((sh1 >> cb) & 1u) ? e1 : 0.f; lsum += p0[r] + p1[r]; }
#pragma unroll
                for (int ks = 0; ks < 4; ++ks) {
                    u32x4 pw;
                    if (ks < 2) { pw.x = cvt_pk_bf16(p0[8 * ks + 0], p0[8 * ks + 1]); pw.y = cvt_pk_bf16(p0[8 * ks + 2], p0[8 * ks + 3]); pw.z = cvt_pk_bf16(p0[8 * ks + 4], p0[8 * ks + 5]); pw.w = cvt_pk_bf16(p0[8 * ks + 6], p0[8 * ks + 7]); }
                    else { const int k2 = ks - 2; pw.x = cvt_pk_bf16(p1[8 * k2 + 0], p1[8 * k2 + 1]); pw.y = cvt_pk_bf16(p1[8 * k2 + 2], p1[8 * k2 + 3]); pw.z = cvt_pk_bf16(p1[8 * k2 + 4], p1[8 * k2 + 5]); pw.w = cvt_pk_bf16(p1[8 * k2 + 6], p1[8 * k2 + 7]); }
                    const bf16x8 pf = __builtin_bit_cast(bf16x8, pw);
                    const int vo = 64 * (ks >> 1) + 32 * (ks & 1) + 8 * hi;
                    const u32x2 a0 = *(const LAS u32x2*)(vb + r32 * ROWB + vo), a1 = *(const LAS u32x2*)(vb + r32 * ROWB + vo + 16);
                    const u32x2 b0 = *(const LAS u32x2*)(vb + (32 + r32) * ROWB + vo), b1 = *(const LAS u32x2*)(vb + (32 + r32) * ROWB + vo + 16);
                    const u32x4 va = {a0.x, a0.y, a1.x, a1.y}, vb4 = {b0.x, b0.y, b1.x, b1.y};
                    o0 = __builtin_amdgcn_mfma_f32_32x32x16_bf16(__builtin_bit_cast(bf16x8, va), pf, o0, 0, 0, 0);
                    o1 = __builtin_amdgcn_mfma_f32_32x32x16_bf16(__builtin_bit_cast(bf16x8, vb4), pf, o1, 0, 0, 0);
                }
                if (more) { LAS unsigned char* kn = gb + (cur ^ 1) * 2 * TILEB; LAS unsigned char* vn = kn + TILEB;
                    *(LAS u32x4*)(kn + srow0 * ROWB + sc0 * 16) = kr0; *(LAS u32x4*)(kn + (srow0 + 32) * ROWB + sc0 * 16) = kr1;
                    *(LAS u32x4*)(vn + srow0 * ROWB + sc0 * 16) = vr0; *(LAS u32x4*)(vn + (srow0 + 32) * ROWB + sc0 * 16) = vr1; mw = mwn; }
                __syncthreads();
            }
            if (grp == 1) { LAS float* cw = comb + w4 * 33 * 64 + lane;
#pragma unroll
                for (int r = 0; r < 16; ++r) { cw[r * 64] = o0[r]; cw[(16 + r) * 64] = o1[r]; }
                cw[32 * 64] = lsum; }
            __syncthreads();
            if (grp == 0) { const LAS float* cw = comb + w4 * 33 * 64 + lane;
#pragma unroll
                for (int r = 0; r < 16; ++r) { o0[r] += cw[r * 64]; o1[r] += cw[(16 + r) * 64]; }
                lsum += cw[32 * 64]; lsum += __shfl_xor(lsum, 32); const float inv = 1.f / lsum;
                bf16_t* yp = Y + (size_t)qrow * D + 256 + h * 64 + 4 * hi;
#pragma unroll
                for (int g4 = 0; g4 < 4; ++g4) { u32x2 w0, w1;
                    w0.x = cvt_pk_bf16(o0[4 * g4] * inv, o0[4 * g4 + 1] * inv); w0.y = cvt_pk_bf16(o0[4 * g4 + 2] * inv, o0[4 * g4 + 3] * inv);
                    w1.x = cvt_pk_bf16(o1[4 * g4] * inv, o1[4 * g4 + 1] * inv); w1.y = cvt_pk_bf16(o1[4 * g4 + 2] * inv, o1[4 * g4 + 3] * inv);
                    *(u32x2*)(yp + 8 * g4) = w0; *(u32x2*)(yp + 32 + 8 * g4) = w1; } }
            __syncthreads();
        }
    }
}

constexpr size_t WS_KI = 234 * MiB;
template <int J, unsigned MSK>
__device__ __forceinline__ void tr_stage(unsigned (&a)[32]) {
#pragma unroll
    for (int k = 0; k < 32; ++k) if ((k & J) == 0) { const unsigned t = (a[k] ^ (a[k + J] >> J)) & MSK; a[k] ^= t; a[k + J] ^= (t << J); }
}
__device__ __forceinline__ void transpose32(unsigned (&a)[32]) {
    tr_stage<16, 0x0000FFFFu>(a); tr_stage<8, 0x00FF00FFu>(a); tr_stage<4, 0x0F0F0F0Fu>(a); tr_stage<2, 0x33333333u>(a); tr_stage<1, 0x55555555u>(a);
}
__device__ __forceinline__ int wave_total_i(int v) {
    v += __builtin_amdgcn_update_dpp(0, v, 0x111, 0xf, 0xf, false);
    v += __builtin_amdgcn_update_dpp(0, v, 0x112, 0xf, 0xf, false);
    v += __builtin_amdgcn_update_dpp(0, v, 0x114, 0xf, 0xf, false);
    v += __builtin_amdgcn_update_dpp(0, v, 0x118, 0xf, 0xf, false);
    v += __builtin_amdgcn_update_dpp(0, v, 0x142, 0xa, 0xf, false);
    v += __builtin_amdgcn_update_dpp(0, v, 0x143, 0xc, 0xf, false);
    return __builtin_amdgcn_readlane(v, 63);
}
__device__ __forceinline__ void indexer_mfma(Frame& F) {
    const float* MISC = (const float*)WSP(WS_MISC); unsigned long long* MASKT = (unsigned long long*)WSP(WS_MASK); const bf16_t* PROJ = (const bf16_t*)WSP(WS_BIG); const bf16_t* KI = (const bf16_t*)WSP(WS_KI);
    LAS float* sc = (LAS float*)F.lds;
    const int lane = F.lane, r32 = lane & 31, hi = lane >> 5, wv = F.wave;
    for (int pi = F.vcu; pi < 1024; pi += F.G) {
        const int b = pi >> 8, pp = pi & 255;
#pragma unroll 1
        for (int half = 0; half < 2; ++half) {
            const int t0 = 8 * (half == 0 ? pp : 511 - pp), m0 = b * S + t0, tq = t0 + wv;
            unsigned long long myword = 0ull;
            if (t0 + 8 <= 256) {
                const int lo = 64 * lane; myword = (tq >= lo + 63) ? ~0ull : (tq < lo ? 0ull : ((2ull << (tq - lo)) - 1ull));
                MASKT[(size_t)(b * 64 + lane) * S + tq] = myword;
                continue;
            }
            const int nmax = t0 + 8, ntile = (nmax + 31) >> 5;
            bf16x8 qa[2][4]; float wq[2][4][4];
#pragma unroll
            for (int i = 0; i < 2; ++i) {
                const bf16_t* qp = PROJ + (size_t)(m0 + 4 * i + (r32 >> 3)) * PW + P_QI + (r32 & 7) * 64 + 8 * hi;
#pragma unroll
                for (int s = 0; s < 4; ++s) qa[i][s] = *(const bf16x8*)(qp + 16 * s);
#pragma unroll
                for (int qq = 0; qq < 4; ++qq) { const f32x4 w4 = *(const f32x4*)(MISC + (size_t)(m0 + 4 * i + qq) * 16 + 4 * hi);
#pragma unroll
                    for (int e = 0; e < 4; ++e) wq[i][qq][e] = w4[e] * (0.125f * 0.35355339059327373f); }
            }
            bf16x8 kring[4][4];
#define IDX_LOADK(u_, j_) do { const int key_ = 32 * (j_) + r32; const int krow_ = key_ < nmax ? key_ : nmax - 1; const bf16_t* kp_ = KI + (size_t)(b * S + krow_) * 64 + 8 * hi; \
    _Pragma("unroll") for (int s_ = 0; s_ < 4; ++s_) kring[u_][s_] = *(const bf16x8*)(kp_ + 16 * s_); } while (0)
#pragma unroll
            for (int u = 0; u < 4; ++u) IDX_LOADK(u, wv + 8 * u);
            for (int jb = wv; jb < ntile; jb += 32) {
#pragma unroll
                for (int u = 0; u < 4; ++u) {
                    const int j = jb + 8 * u;
                    if (j < ntile) {
                        const int key = 32 * j + r32;
                        bf16x8 kb[4];
#pragma unroll
                        for (int s = 0; s < 4; ++s) kb[s] = kring[u][s];
                        IDX_LOADK(u, j + 32);
#pragma unroll
                        for (int i = 0; i < 2; ++i) {
                            f32x16 d;
#pragma unroll
                            for (int r = 0; r < 16; ++r) d[r] = 0.f;
#pragma unroll
                            for (int s = 0; s < 4; ++s) d = __builtin_amdgcn_mfma_f32_32x32x16_bf16(qa[i][s], kb[s], d, 0, 0, 0);
                            float part[4];
#pragma unroll
                            for (int qq = 0; qq < 4; ++qq) { float a = 0.f;
#pragma unroll
                                for (int e = 0; e < 4; ++e) a = fmaf(wq[i][qq][e], fmaxf(d[4 * qq + e], 0.f), a);
                                part[qq] = a; }
                            auto s01 = __builtin_amdgcn_permlane32_swap(__float_as_uint(part[0]), __float_as_uint(part[1]), false, false);
                            auto s23 = __builtin_amdgcn_permlane32_swap(__float_as_uint(part[2]), __float_as_uint(part[3]), false, false);
                            const float v01 = __uint_as_float(s01[0]) + __uint_as_float(s01[1]), v23 = __uint_as_float(s23[0]) + __uint_as_float(s23[1]);
                            const int qA = 4 * i + hi, qB = 4 * i + 2 + hi;
                            sc[qA * 4096 + key] = (key <= t0 + qA) ? v01 : -INFINITY;
                            sc[qB * 4096 + key] = (key <= t0 + qB) ? v23 : -INFINITY;
                        }
                    }
                }
            }
#undef IDX_LOADK
            __syncthreads();
            const int nvalid = 32 * ntile; const LAS float* srow = sc + wv * 4096 + lane;
            unsigned pa[32], pb[32];
#pragma unroll
            for (int r = 0; r < 32; ++r) { const float v = srow[64 * r]; pa[r] = fkey(v) & (unsigned)((64 * r + lane - nvalid) >> 31); }
            transpose32(pa);
            const bool two = nvalid > 2048;
            if (two) {
#pragma unroll
                for (int r = 0; r < 32; ++r) { const float v = srow[64 * (32 + r)]; pb[r] = fkey(v) & (unsigned)((64 * (32 + r) + lane - nvalid) >> 31); }
                transpose32(pb);
            } else {
#pragma unroll
                for (int r = 0; r < 32; ++r) pb[r] = 0u;
            }
            unsigned aA = ~0u, aB = ~0u, Tk = 0u; int base = 0;
#pragma unroll
            for (int bit = 31; bit >= 0; --bit) {
                const unsigned wa = pa[31 - bit], wb = pb[31 - bit];
                const int tot = wave_total_i(__builtin_popcount(wa & aA) + __builtin_popcount(wb & aB));
                const bool take = (base + tot >= 256);
                const unsigned flip = take ? 0u : ~0u;
                aA &= (wa ^ flip); aB &= (wb ^ flip);
                if (take) Tk |= (1u << bit); else base += tot;
            }
            const int ngt = base, neq = wave_total_i(__builtin_popcount(aA) + __builtin_popcount(aB));
            if (ngt + neq == 256) {
#pragma unroll
                for (int r = 0; r < 64; ++r) { const float v = srow[64 * r]; const unsigned k = fkey(v) & (unsigned)((64 * r + lane - nvalid) >> 31);
                    const unsigned long long wsel = __ballot(k >= Tk); if (lane == r) myword = wsel; }
            } else {
                int need = 256 - ngt;
#pragma unroll 1
                for (int r = 0; r < 64; ++r) { const float v = srow[64 * r]; const unsigned k = fkey(v) & (unsigned)((64 * r + lane - nvalid) >> 31);
                    unsigned long long wsel = __ballot(k > Tk), em = __ballot(k == Tk);
                    if (em != 0ull && need > 0) { int c = __builtin_popcountll(em); while (c > need) { em &= ~(1ull << (63 - __builtin_clzll(em))); --c; } need -= c; wsel |= em; }
                    if (lane == r) myword = wsel; }
            }
            MASKT[(size_t)(b * 64 + lane) * S + tq] = myword;
            __syncthreads();
        }
    }
}

constexpr size_t WS_CVT = 236 * MiB;
__device__ __forceinline__ void mlstm2_mfma(Frame& F, int l) {
    const float* MISC = (const float*)WSP(WS_MISC); const float* STATE = (const float*)WSP(WS_STATE); const bf16_t* PROJ = (const bf16_t*)WSP(WS_BIG); const bf16_t* CVT = (const bf16_t*)WSP(WS_CVT);
    bf16_t* Y = (bf16_t*)WSP(WS_Y); const float* i_bias = INP(I_I_BIAS); const float* f_bias = INP(I_F_BIAS); const float* mnorm = INP(I_MNORM);
    const int lane = F.lane, r32 = lane & 31, hi = lane >> 5, grp = F.wave >> 2, w4 = F.wave & 3, lg = F.tid & 255;
    constexpr int KROWB = 144, VROWB = 272, GB = 49152;
    LAS unsigned char* gb = F.lds + grp * GB;
    LAS float* bc = (LAS float*)gb;
    LAS float* gs = bc + 128;
    LAS float* npv = gs + 128;
    LAS float* wsum = npv + 64;
    LAS unsigned char* ct = gb + 2048;
    LAS unsigned char* kt = ct + 9216;
    LAS unsigned char* vt = kt + 18432;
    for (int it0 = 2 * F.vcu; it0 < 512; it0 += 2 * F.G) {
        const int item = it0 + grp, bh = item >> 5, c = item & 31, b = bh >> 2, h = bh & 3, m0 = b * S + c * 128;
        if (lg < 128) { const float f = MISC[(size_t)(m0 + lg) * 16 + 12 + h] + f_bias[l * 4 + h]; bc[lg] = fminf(f, 0.f) - log1pf(__expf(-fabsf(f))); gs[lg] = MISC[(size_t)(m0 + lg) * 16 + 8 + h] + i_bias[l * 4 + h]; }
        if (lg >= 128 && lg < 160) { const int cc = lg - 128; wsum[cc] = (cc < c) ? STATE[(size_t)(bh * 32 + cc) * STATE_STRIDE + 4160] : 0.f; }
        __syncthreads();
        if (lg < 64) {
            float a0 = bc[2 * lane], a1 = bc[2 * lane + 1]; float s = a0 + a1;
#pragma unroll
            for (int o = 1; o < 64; o <<= 1) { const float t = __shfl_up(s, o); if (lane >= o) s += t; }
            const float ex = s - (a0 + a1); const float i0 = gs[2 * lane], i1 = gs[2 * lane + 1];
            bc[2 * lane] = ex + a0; bc[2 * lane + 1] = s; gs[2 * lane] = i0 - (ex + a0); gs[2 * lane + 1] = i1 - s;
            float w = (lane < 32) ? wsum[lane] : 0.f; float suf = w;
#pragma unroll
            for (int o = 1; o < 32; o <<= 1) { const float t = __shfl_down(suf, o); if (lane + o < 32) suf += t; }
            if (lane < 32) wsum[lane] = suf - w;
        }
        __syncthreads();
        { f32x4 a4[4]; float nv = 0.f;
#pragma unroll
          for (int k = 0; k < 4; ++k) a4[k] = (f32x4){0.f, 0.f, 0.f, 0.f};
          for (int cc = 0; cc < c; ++cc) { const float* st = STATE + (size_t)(bh * 32 + cc) * STATE_STRIDE; const float wgt = __expf(wsum[cc]);
#pragma unroll
              for (int k = 0; k < 4; ++k) { const f32x4 v = *(const f32x4*)(st + 4 * (lg + 256 * k)); a4[k] = a4[k] + v * wgt; }
              if (lg < 64) nv = fmaf(wgt, st[4096 + lg], nv); }
#pragma unroll
          for (int k = 0; k < 4; ++k) { const int idx = 4 * (lg + 256 * k), e = idx >> 6, d = idx & 63; u32x2 w; w.x = cvt_pk_bf16(a4[k][0], a4[k][1]); w.y = cvt_pk_bf16(a4[k][2], a4[k][3]); *(LAS u32x2*)(ct + e * KROWB + d * 2) = w; }
          if (lg < 64) npv[lg] = nv; }
#pragma unroll
        for (int k = 0; k < 4; ++k) { const int id = lg + 256 * k, row = id >> 3, ch = id & 7;
            *(LAS u32x4*)(kt + row * KROWB + ch * 16) = *(const u32x4*)(PROJ + (size_t)(m0 + row) * PW + P_CK + h * 64 + ch * 8);
            const int vrow = id >> 4, vch = id & 15;
            *(LAS u32x4*)(vt + vrow * VROWB + vch * 16) = *(const u32x4*)(CVT + (size_t)(b * 256 + h * 64 + vrow) * S + c * 128 + vch * 8); }
        __syncthreads();
        const int j = 32 * w4 + r32, qrow = m0 + j;
        bf16x8 qf[4];
#pragma unroll
        for (int s = 0; s < 4; ++s) qf[s] = *(const bf16x8*)(PROJ + (size_t)qrow * PW + P_CQ + h * 64 + 16 * s + 8 * hi);
        const float bj = bc[j], eb = __expf(bj);
        float qn = 0.f;
#pragma unroll
        for (int s = 0; s < 4; ++s) { const u32x4 w = __builtin_bit_cast(u32x4, qf[s]); const LAS float* np = npv + 16 * s + 8 * hi;
            qn += lo_bf(w.x) * np[0] + hi_bf(w.x) * np[1] + lo_bf(w.y) * np[2] + hi_bf(w.y) * np[3] + lo_bf(w.z) * np[4] + hi_bf(w.z) * np[5] + lo_bf(w.w) * np[6] + hi_bf(w.w) * np[7]; }
        qn += __shfl_xor(qn, 32); qn *= eb;
        f32x16 n0, n1;
#pragma unroll
        for (int r = 0; r < 16; ++r) { n0[r] = 0.f; n1[r] = 0.f; }
#pragma unroll
        for (int ks = 0; ks < 4; ++ks) { const bf16x8 c0 = *(const LAS bf16x8*)(ct + r32 * KROWB + 32 * ks + 16 * hi), c1 = *(const LAS bf16x8*)(ct + (32 + r32) * KROWB + 32 * ks + 16 * hi);
            n0 = __builtin_amdgcn_mfma_f32_32x32x16_bf16(c0, qf[ks], n0, 0, 0, 0); n1 = __builtin_amdgcn_mfma_f32_32x32x16_bf16(c1, qf[ks], n1, 0, 0, 0); }
#pragma unroll
        for (int r = 0; r < 16; ++r) { n0[r] *= eb; n1[r] *= eb; }
        float sa = 0.f;
#pragma unroll 1
        for (int st = 0; st <= w4; ++st) {
            f32x16 p;
#pragma unroll
            for (int r = 0; r < 16; ++r) p[r] = 0.f;
#pragma unroll
            for (int ks = 0; ks < 4; ++ks) { const bf16x8 kf = *(const LAS bf16x8*)(kt + (32 * st + r32) * KROWB + 32 * ks + 16 * hi); p = __builtin_amdgcn_mfma_f32_32x32x16_bf16(kf, qf[ks], p, 0, 0, 0); }
#pragma unroll
            for (int r = 0; r < 16; ++r) { const int s = 32 * st + (r & 3) + 8 * (r >> 2) + 4 * hi; const float a = (s <= j) ? __expf(bj + gs[s]) * p[r] : 0.f; p[r] = a; sa += a; }
#pragma unroll
            for (int k2 = 0; k2 < 2; ++k2) {
                u32x4 pw; pw.x = cvt_pk_bf16(p[8 * k2 + 0], p[8 * k2 + 1]); pw.y = cvt_pk_bf16(p[8 * k2 + 2], p[8 * k2 + 3]); pw.z = cvt_pk_bf16(p[8 * k2 + 4], p[8 * k2 + 5]); pw.w = cvt_pk_bf16(p[8 * k2 + 6], p[8 * k2 + 7]);
                const bf16x8 pf = __builtin_bit_cast(bf16x8, pw);
                const int vo = (32 * st + 16 * k2 + 4 * hi) * 2;
                const u32x2 a0 = *(const LAS u32x2*)(vt + r32 * VROWB + vo), a1 = *(const LAS u32x2*)(vt + r32 * VROWB + vo + 16);
                const u32x2 b0 = *(const LAS u32x2*)(vt + (32 + r32) * VROWB + vo), b1 = *(const LAS u32x2*)(vt + (32 + r32) * VROWB + vo + 16);
                const u32x4 va = {a0.x, a0.y, a1.x, a1.y}, vb4 = {b0.x, b0.y, b1.x, b1.y};
                n0 = __builtin_amdgcn_mfma_f32_32x32x16_bf16(__builtin_bit_cast(bf16x8, va), pf, n0, 0, 0, 0);
                n1 = __builtin_amdgcn_mfma_f32_32x32x16_bf16(__builtin_bit_cast(bf16x8, vb4), pf, n1, 0, 0, 0);
            }
        }
        sa += __shfl_xor(sa, 32);
        const float inv = 1.f / fmaxf(fabsf(qn + sa), 1.f);
        float ss = 0.f;
#pragma unroll
        for (int r = 0; r < 16; ++r) { n0[r] *= inv; n1[r] *= inv; ss += n0[r] * n0[r] + n1[r] * n1[r]; }
        ss += __shfl_xor(ss, 32); const float rr = rsqrtf(ss * (1.f / 64.f) + EPS);
        const float* gp = mnorm + l * 256 + h * 64 + 4 * hi; const bf16_t* op = PROJ + (size_t)qrow * PW + P_CO + h * 64 + 4 * hi; bf16_t* yp = Y + (size_t)qrow * D + 512 + h * 64 + 4 * hi;
#pragma unroll
        for (int g4 = 0; g4 < 4; ++g4) {
            const f32x4 ga = *(const f32x4*)(gp + 8 * g4), gb4 = *(const f32x4*)(gp + 32 + 8 * g4);
            const u32x2 oa = *(const u32x2*)(op + 8 * g4), ob = *(const u32x2*)(op + 32 + 8 * g4);
            u32x2 w0, w1;
            w0.x = cvt_pk_bf16(sigmoid_f(lo_bf(oa.x)) * n0[4 * g4] * rr * ga[0], sigmoid_f(hi_bf(oa.x)) * n0[4 * g4 + 1] * rr * ga[1]);
            w0.y = cvt_pk_bf16(sigmoid_f(lo_bf(oa.y)) * n0[4 * g4 + 2] * rr * ga[2], sigmoid_f(hi_bf(oa.y)) * n0[4 * g4 + 3] * rr * ga[3]);
            w1.x = cvt_pk_bf16(sigmoid_f(lo_bf(ob.x)) * n1[4 * g4] * rr * gb4[0], sigmoid_f(hi_bf(ob.x)) * n1[4 * g4 + 1] * rr * gb4[1]);
            w1.y = cvt_pk_bf16(sigmoid_f(lo_bf(ob.y)) * n1[4 * g4 + 2] * rr * gb4[2], sigmoid_f(hi_bf(ob.y)) * n1[4 * g4 + 3] * rr * gb4[3]);
            *(u32x2*)(yp + 8 * g4) = w0; *(u32x2*)(yp + 32 + 8 * g4) = w1;
        }
        __syncthreads();
    }
}

constexpr size_t WS_SSQV = 244 * MiB;
__device__ __forceinline__ void sgu_mfma(Frame& F, int l) {
    const bf16_t* PROJ = (const bf16_t*)WSP(WS_BIG); bf16_t* Y = (bf16_t*)WSP(WS_Y); const float* SSQV = (const float*)WSP(WS_SSQV);
    const float* gain = INP(I_SGU_NORM) + l * 256; const float* sw = INP(I_SGU_W) + (size_t)l * 4 * 128 * 128; const float* sb = INP(I_SGU_B) + l * 4 * 128;
    const int lane = F.lane, r32 = lane & 31, hi = lane >> 5, dt = F.wave & 1, tt = F.wave >> 1;
    constexpr int VROWB = 272;
    LAS float* r_s = (LAS float*)F.lds;
    LAS unsigned char* vt = F.lds + 512;
    for (int item = F.vcu; item < 512; item += F.G) {
        const int g = item & 3, m0 = (item >> 2) * 128;
        if (F.tid < 128) { const f32x4 q = *(const f32x4*)(SSQV + (size_t)(m0 + F.tid) * 4); r_s[F.tid] = rsqrtf(((q[0] + q[1]) + (q[2] + q[3])) * (1.f / 256.f) + EPS); }
        __syncthreads();
#pragma unroll
        for (int k = 0; k < 2; ++k) { const int id = F.tid + 512 * k, s = id >> 3, d0 = (id & 7) * 8; const float rs = r_s[s];
            const u32x4 w = *(const u32x4*)(PROJ + (size_t)(m0 + s) * PW + P_AV + g * 64 + d0);
            const float v[8] = {lo_bf(w.x), hi_bf(w.x), lo_bf(w.y), hi_bf(w.y), lo_bf(w.z), hi_bf(w.z), lo_bf(w.w), hi_bf(w.w)};
#pragma unroll
            for (int i = 0; i < 8; ++i) *(LAS bf16_t*)(vt + (d0 + i) * VROWB + s * 2) = (bf16_t)f2bf(v[i] * rs); }
        __syncthreads();
        f32x16 acc;
#pragma unroll
        for (int r = 0; r < 16; ++r) acc[r] = 0.f;
        const int t = 32 * tt + r32; const float* wrow = sw + ((size_t)g * 128 + t) * 128;
#pragma unroll 1
        for (int ks = 0; ks < 2 * (tt + 1); ++ks) {
            const bf16x8 af = *(const LAS bf16x8*)(vt + (32 * dt + r32) * VROWB + (16 * ks + 8 * hi) * 2);
            const int s0 = 16 * ks + 8 * hi; const f32x4 w0 = *(const f32x4*)(wrow + s0), w1 = *(const f32x4*)(wrow + s0 + 4);
            u32x4 bw; bw.x = cvt_pk_bf16(s0 + 0 <= t ? w0[0] : 0.f, s0 + 1 <= t ? w0[1] : 0.f); bw.y = cvt_pk_bf16(s0 + 2 <= t ? w0[2] : 0.f, s0 + 3 <= t ? w0[3] : 0.f);
            bw.z = cvt_pk_bf16(s0 + 4 <= t ? w1[0] : 0.f, s0 + 5 <= t ? w1[1] : 0.f); bw.w = cvt_pk_bf16(s0 + 6 <= t ? w1[2] : 0.f, s0 + 7 <= t ? w1[3] : 0.f);
            acc = __builtin_amdgcn_mfma_f32_32x32x16_bf16(af, __builtin_bit_cast(bf16x8, bw), acc, 0, 0, 0);
        }
        const float bias = sb[g * 128 + t]; const size_t row = (size_t)(m0 + t);
        const float* gp = gain + g * 64 + 32 * dt + 4 * hi; const bf16_t* up = PROJ + row * PW + P_AU + g * 64 + 32 * dt + 4 * hi; bf16_t* yp = Y + row * D + g * 64 + 32 * dt + 4 * hi;
#pragma unroll
        for (int g4 = 0; g4 < 4; ++g4) { const f32x4 gv = *(const f32x4*)(gp + 8 * g4); const u32x2 uw = *(const u32x2*)(up + 8 * g4); u32x2 ow;
            ow.x = cvt_pk_bf16(lo_bf(uw.x) * (gv[0] * acc[4 * g4] + bias), hi_bf(uw.x) * (gv[1] * acc[4 * g4 + 1] + bias));
            ow.y = cvt_pk_bf16(lo_bf(uw.y) * (gv[2] * acc[4 * g4 + 2] + bias), hi_bf(uw.y) * (gv[3] * acc[4 * g4 + 3] + bias));
            *(u32x2*)(yp + 8 * g4) = ow; }
        __syncthreads();
    }
}

__device__ __forceinline__ void mlstm1_mfma(Frame& F, int l) {
    const float* MISC = (const float*)WSP(WS_MISC); float* STATE = (float*)WSP(WS_STATE); const bf16_t* PROJ = (const bf16_t*)WSP(WS_BIG); const bf16_t* CVT = (const bf16_t*)WSP(WS_CVT);
    const float* i_bias = INP(I_I_BIAS); const float* f_bias = INP(I_F_BIAS);
    const int lane = F.lane, r32 = lane & 31, hi = lane >> 5, grp = F.wave >> 2, w4 = F.wave & 3, et = w4 & 1, dt = w4 >> 1, lg = F.tid & 255;
    constexpr int KROWB = 144, GB = 20480;
    LAS unsigned char* gb = F.lds + grp * GB;
    LAS float* bc = (LAS float*)gb; LAS float* wk = bc + 128; LAS unsigned char* kt = gb + 1024;
    for (int it0 = 2 * F.vcu; it0 < 512; it0 += 2 * F.G) {
        const int item = it0 + grp, bh = item >> 5, c = item & 31, b = bh >> 2, h = bh & 3, m0 = b * S + c * 128;
        if (lg < 128) { const float f = MISC[(size_t)(m0 + lg) * 16 + 12 + h] + f_bias[l * 4 + h]; bc[lg] = fminf(f, 0.f) - log1pf(__expf(-fabsf(f))); wk[lg] = MISC[(size_t)(m0 + lg) * 16 + 8 + h] + i_bias[l * 4 + h]; }
        __syncthreads();
        if (lg < 64) { const float a0 = bc[2 * lane], a1 = bc[2 * lane + 1]; float s = a0 + a1;
#pragma unroll
            for (int o = 1; o < 64; o <<= 1) { const float t = __shfl_up(s, o); if (lane >= o) s += t; }
            const float tot = __shfl(s, 63), ex = s - (a0 + a1);
            wk[2 * lane] = __expf(tot - (ex + a0) + wk[2 * lane]); wk[2 * lane + 1] = __expf(tot - s + wk[2 * lane + 1]);
            if (lane == 0) bc[0] = tot; }
        __syncthreads();
        const float Bc = bc[0];
#pragma unroll
        for (int k = 0; k < 4; ++k) { const int id = lg + 256 * k, s = id >> 3, ch = id & 7; const float ws_ = wk[s];
            const u32x4 w = *(const u32x4*)(PROJ + (size_t)(m0 + s) * PW + P_CK + h * 64 + ch * 8); u32x4 o;
            o.x = cvt_pk_bf16(lo_bf(w.x) * ws_, hi_bf(w.x) * ws_); o.y = cvt_pk_bf16(lo_bf(w.y) * ws_, hi_bf(w.y) * ws_); o.z = cvt_pk_bf16(lo_bf(w.z) * ws_, hi_bf(w.z) * ws_); o.w = cvt_pk_bf16(lo_bf(w.w) * ws_, hi_bf(w.w) * ws_);
            *(LAS u32x4*)(kt + s * KROWB + ch * 16) = o; }
        __syncthreads();
        f32x16 acc;
#pragma unroll
        for (int r = 0; r < 16; ++r) acc[r] = 0.f;
        float nsum = 0.f;
        const bf16_t* vp = CVT + (size_t)(b * 256 + h * 64 + 32 * et + r32) * S + c * 128 + 8 * hi;
        bf16x8 af[8];
#pragma unroll
        for (int ks = 0; ks < 8; ++ks) af[ks] = *(const bf16x8*)(vp + 16 * ks);
#pragma unroll
        for (int ks = 0; ks < 8; ++ks) {
            const LAS unsigned char* kp = kt + (16 * ks + 8 * hi) * KROWB + (32 * dt + r32) * 2; unsigned e8[8];
#pragma unroll
            for (int jj = 0; jj < 8; ++jj) e8[jj] = *(const LAS bf16_t*)(kp + jj * KROWB);
            u32x4 bw; bw.x = e8[0] | (e8[1] << 16); bw.y = e8[2] | (e8[3] << 16); bw.z = e8[4] | (e8[5] << 16); bw.w = e8[6] | (e8[7] << 16);
#pragma unroll
            for (int jj = 0; jj < 8; ++jj) nsum += __uint_as_float(e8[jj] << 16);
            acc = __builtin_amdgcn_mfma_f32_32x32x16_bf16(af[ks], __builtin_bit_cast(bf16x8, bw), acc, 0, 0, 0);
        }
        float* st = STATE + (size_t)item * STATE_STRIDE;
#pragma unroll
        for (int r = 0; r < 16; ++r) st[(32 * et + (r & 3) + 8 * (r >> 2) + 4 * hi) * 64 + 32 * dt + r32] = acc[r];
        nsum += __shfl_xor(nsum, 32);
        if (et == 0 && hi == 0) st[4096 + 32 * dt + r32] = nsum;
        if (lg == 0) st[4160] = Bc;
        __syncthreads();
    }
}
#ifndef MK_MULTI
#define MK_MULTI 0
#endif
constexpr int N_PHASES = 1 + 8 * DEPTH;

__global__ void __launch_bounds__(NT, 2) mk_fwd(Args args) {
    extern __shared__ __attribute__((aligned(16))) unsigned char lds_raw[];
    Frame F;
    F.lds = (LAS unsigned char*)lds_raw; F.tid = threadIdx.x; F.lane = F.tid & 63; F.wave = __builtin_amdgcn_readfirstlane(F.tid >> 6);
    F.G = gridDim.x; { const int bx_ = blockIdx.x; F.vcu = (F.G % 8 == 0) ? (bx_ % 8) * (F.G / 8) + bx_ / 8 : bx_; }
    if (F.tid < 20) { const unsigned long long pv = F.tid < 18 ? (unsigned long long)args.in[F.tid < 18 ? F.tid : 0] : (F.tid == 18 ? (unsigned long long)args.out : (unsigned long long)args.ws);
        *(LAS unsigned long long*)(F.lds + PTR_OFF + 8 * F.tid) = pv; }
    if (F.tid < 2) *(LAS unsigned*)(F.lds + PTR_OFF + 256 + 4 * F.tid) = 0u;
    __syncthreads();
    XcdBarrier xbar; xbar.bar = (unsigned*)(args.ws + WS_BAR); xbar.x = 0; xbar.st = (volatile LAS unsigned*)(F.lds + PTR_OFF + 256);
    if (args.coop) xbar = xcd_barrier_post((unsigned*)(args.ws + WS_BAR), (volatile LAS unsigned*)(F.lds + PTR_OFF + 256));
    const int lo = args.ph_lo, hi = args.ph_hi; const bool coop = args.coop != 0;
#define RUN(k) (lo <= (k) && (k) < hi)
#define LAUNDER() asm volatile("" : "+v"(F.tid), "+v"(F.lane))
#define SEAM(k) do { if (coop && RUN(k) && RUN((k) + 1)) { if ((k) == 0) cg::this_grid().sync(); else xcd_barrier(xbar); } } while (0)
    const int bx = (int)blockIdx.x;

    if (RUN(0)) { LAUNDER(); convert_mix_weights(F, 0); prologue_rows(F);
        if (blockIdx.x == 0 && F.tid < DEPTH * 192) { const int l_ = F.tid / 192, r_ = F.tid % 192, w_ = r_ / 64, i_ = r_ % 64; ((float*)WSP(WS_GT))[F.tid] = INP(I_Q_NORM + w_)[l_ * 64 + i_]; } }
    SEAM(0);
#pragma unroll 1
    for (int l = 0; l < DEPTH; ++l) {
        const int pb = 1 + 8 * l;
        if (RUN(pb + 0)) { LAUNDER();
            pg8::Gemm<D, D, D, 256u * D * 2, 0, 256u * D * 2, 0> g{(const bf16_t*)WSP(WS_XG), (const bf16_t*)WSP(WS_WIN)};
            pg8::StaticOrder So; So.init(M, PW, F.G, bx);
            epi::EpiProj E{(bf16_t*)WSP(WS_BIG), (float*)WSP(WS_MISC), (const float*)WSP(WS_SSQA), (const float*)WSP(WS_COS), (const float*)WSP(WS_SIN), (const float*)WSP(WS_GT) + l * 192, (bf16_t*)WSP(WS_VT), (bf16_t*)WSP(WS_KI), (bf16_t*)WSP(WS_CVT), (float*)WSP(WS_SSQV)};
            pg8::gemm_phase<epi::EpiProj, pg8::StaticOrder, true>(F.lds, g, So, E, F.tid);
        }
        SEAM(pb + 0);
        if (RUN(pb + 1)) { LAUNDER(); sgu_mfma(F, l); conv_simple(F, l); indexer_mfma(F); mlstm1_mfma(F, l); }
        SEAM(pb + 1);
        if (RUN(pb + 2)) { LAUNDER(); attn_mfma(F, l); mlstm2_mfma(F, l); }
        SEAM(pb + 2);
        if (RUN(pb + 3)) { LAUNDER();
            pg8::Gemm<256, D, 256, 256u * D * 2, 256u * 2, 256u * 256 * 2, 1024u * 256 * 2> g{(const bf16_t*)WSP(WS_Y), (const bf16_t*)WSP(WS_WBR)};
            pg8::SuperOrder<0> So; So.init(F.G, bx);
            epi::EpiPlain E{(bf16_t*)WSP(WS_BIG), 4096, 1024};
            pg8::gemm_phase<epi::EpiPlain, pg8::SuperOrder<0>, true>(F.lds, g, So, E, F.tid);
        }
        if (coop && RUN(pb + 3) && RUN(pb + 4)) { asm volatile("s_waitcnt vmcnt(0)" ::: "memory"); __syncthreads(); __builtin_amdgcn_fence(__ATOMIC_ACQUIRE, "agent"); asm volatile("s_waitcnt vmcnt(0)" ::: "memory"); __syncthreads(); }
        if (RUN(pb + 4)) { LAUNDER();
            pg8::Gemm<D, D, D, 256u * D * 2, 0, 256u * D * 2, 0> g{(const bf16_t*)WSP(WS_XG), (const bf16_t*)WSP(WS_WG)};
            pg8::SuperOrder<1> So; So.init(F.G, bx);
            epi::EpiGate E{(bf16_t*)WSP(WS_MG), (const bf16_t*)WSP(WS_BIG), (const float*)WSP(WS_SSQA)};
            pg8::gemm_phase<epi::EpiGate, pg8::SuperOrder<1>, true>(F.lds, g, So, E, F.tid);
        }
        SEAM(pb + 4);
        if (RUN(pb + 5)) { LAUNDER();
            pg8::Gemm<D, D, D, 256u * D * 2, 0, 256u * D * 2, 0> g{(const bf16_t*)WSP(WS_MG), (const bf16_t*)WSP(WS_WOUT)};
            pg8::StaticOrder So; So.init(M, D, F.G, bx);
            float* outp = (float*)ptr_at(F, I_OUT); epi::EpiResid E{l == 0 ? INP(I_X) : (const float*)outp, outp, (bf16_t*)WSP(WS_XG), INP(I_LN_MLP) + l * D, (float*)WSP(WS_SSQB)};
            pg8::gemm_phase<epi::EpiResid, pg8::StaticOrder, true>(F.lds, g, So, E, F.tid);
            __syncthreads();
            convert_mlp_weights(F, l);
        }
        SEAM(pb + 5);
        if (RUN(pb + 6)) { LAUNDER();
            pg8::Gemm<D, D, D, 256u * D * 2, 0, 256u * D * 2, 0> g{(const bf16_t*)WSP(WS_XG), (const bf16_t*)WSP(WS_WUP)};
            pg8::StaticOrder So; So.init(M, FF, F.G, bx);
            epi::EpiUp E{(bf16_t*)WSP(WS_BIG), (const float*)WSP(WS_SSQB)};
            pg8::gemm_phase<epi::EpiUp, pg8::StaticOrder, true>(F.lds, g, So, E, F.tid);
            if (l + 1 < DEPTH) { __syncthreads(); convert_mix_weights(F, l + 1); }
        }
        SEAM(pb + 6);
        if (RUN(pb + 7)) { LAUNDER();
            pg8::Gemm<FF, FF, FF, 256u * FF * 2, 0, 256u * FF * 2, 0> g{(const bf16_t*)WSP(WS_BIG), (const bf16_t*)WSP(WS_WDN)};
            pg8::StaticOrder So; So.init(M, D, F.G, bx);
            float* outp = (float*)ptr_at(F, I_OUT); epi::EpiResid E{(const float*)outp, outp, (bf16_t*)WSP(WS_XG), (l + 1 < DEPTH) ? INP(I_LN_MIX) + (l + 1) * D : nullptr, (float*)WSP(WS_SSQA)};
            pg8::gemm_phase<epi::EpiResid, pg8::StaticOrder, true>(F.lds, g, So, E, F.tid);
        }
        SEAM(pb + 7);
    }
#undef RUN
#undef SEAM
}

extern "C" void kernel_launch(void* const* d_in, const int* in_sizes, int n_in, void* d_out, int out_size, void* d_ws, size_t ws_size, hipStream_t stream) {
    static int grid = 0;
    if (grid == 0) {
        if (n_in != 18 || in_sizes[0] != M * D || out_size != M * D || ws_size < WS_END) { fprintf(stderr, "kernel_launch: unexpected shapes (n_in %d, in0 %d, out %d, ws %zu)\n", n_in, n_in > 0 ? in_sizes[0] : -1, out_size, ws_size); grid = -1; return; }
        int dev = 0, cus = 0, per_cu = 0;
        if (hipGetDevice(&dev) != hipSuccess || hipDeviceGetAttribute(&cus, hipDeviceAttributeMultiprocessorCount, dev) != hipSuccess) { grid = -1; return; }
        if (hipFuncSetAttribute((const void*)mk_fwd, hipFuncAttributeMaxDynamicSharedMemorySize, LDS_BYTES) != hipSuccess) { fprintf(stderr, "kernel_launch: hipFuncSetAttribute failed\n"); grid = -1; return; }
        if (hipOccupancyMaxActiveBlocksPerMultiprocessor(&per_cu, (const void*)mk_fwd, NT, LDS_BYTES) != hipSuccess || per_cu < 1) { fprintf(stderr, "kernel_launch: occupancy query says %d\n", per_cu); (void)hipGetLastError(); per_cu = 1; }
        grid = cus;
    }
    if (grid < 0) return;
    if (hipMemsetAsync((char*)d_ws + WS_CTL, 0, CTL_ZERO_BYTES, stream) != hipSuccess) { fprintf(stderr, "kernel_launch: memset failed\n"); return; }
    Args a{};
    for (int i = 0; i < 18; ++i) a.in[i] = (const float*)d_in[i];
    a.out = (float*)d_out; a.ws = (unsigned char*)d_ws;
#if MK_MULTI
    for (int p = 0; p < N_PHASES; ++p) { a.ph_lo = p; a.ph_hi = p + 1; a.coop = 0; hipLaunchKernelGGL(mk_fwd, dim3(grid), dim3(NT), LDS_BYTES, stream, a); }
#else
    a.ph_lo = 0; a.ph_hi = N_PHASES; a.coop = 1;
    void* kargs[] = {&a};
    hipError_t e = hipLaunchCooperativeKernel((const void*)mk_fwd, dim3(grid), dim3(NT), kargs, LDS_BYTES, stream);
    if (e != hipSuccess) fprintf(stderr, "kernel_launch: cooperative launch failed: %s (grid %d)\n", hipGetErrorString(e), grid);
#endif
}
```

```cpp
#define MK_MULTI 0
#include <hip/hip_runtime.h>
#include <hip/hip_cooperative_groups.h>
#include <cstdio>
#include <cstdint>
namespace cg = cooperative_groups;

#define LAS __attribute__((address_space(3)))
typedef unsigned short bf16_t;
typedef short bf16x8 __attribute__((ext_vector_type(8)));
typedef float f32x4 __attribute__((ext_vector_type(4)));
typedef float f32x2 __attribute__((ext_vector_type(2)));
typedef unsigned u32x4 __attribute__((ext_vector_type(4)));
typedef unsigned u32x2 __attribute__((ext_vector_type(2)));

constexpr int D = 1024, NB = 4, S = 4096, M = NB * S, DEPTH = 2, FF = 4096, INW = 7760;
constexpr int O_AU = 0, O_AV = 256, O_BQ = 512, O_BK = 768, O_BV = 1024, O_QI = 1280, O_KI = 1792, O_WI = 1856,
              O_CQ = 1864, O_CK = 2120, O_CV = 2376, O_CO = 2632, O_CI = 2888, O_CF = 2892, O_DB = 2896, O_DC = 3152, O_DX = 3408, O_G = 3664;
constexpr int PW = 3840;
constexpr int P_AU = 0, P_AV = 256, P_Q = 512, P_K = 768, P_V = 1024, P_QI = 1280, P_CQ = 1792, P_CK = 2048, P_CV = 2304, P_CO = 2560,
              P_DB = 2816, P_DC = 3072, P_DX = 3328, P_KI = 3584;
constexpr float EPS = 1e-6f;
constexpr int NWAVES = 8, NT = 512;

constexpr size_t MiB = 1u << 20;
constexpr size_t WS_CTL = 0;
constexpr size_t WS_COS = 1 * MiB, WS_SIN = 1 * MiB + 512 * 1024;
constexpr size_t WS_MISC = 2 * MiB;
constexpr size_t WS_SSQA = 3 * MiB, WS_SSQB = 4 * MiB;
constexpr size_t WS_WIN = 5 * MiB;
constexpr size_t WS_WG = WS_WIN + (size_t)PW * D * 2;
constexpr size_t WS_WBR = WS_WG + (size_t)4096 * D * 2;
constexpr size_t WS_WOUT = WS_WBR + (size_t)4 * 1024 * 256 * 2;
constexpr size_t WS_XG = 25 * MiB;
constexpr size_t WS_BIG = 57 * MiB;
constexpr size_t WS_Y = 185 * MiB;
constexpr size_t WS_WUP = WS_Y, WS_WDN = WS_Y + 8 * MiB;
constexpr size_t WS_MG = 217 * MiB;
constexpr size_t WS_MASK = WS_MG, WS_STATE = WS_MG + 8 * MiB;
constexpr size_t WS_END = 249 * MiB;
constexpr int STATE_STRIDE = 4224;
static_assert(WS_WOUT + (size_t)D * D * 2 <= WS_XG && WS_STATE + (size_t)512 * STATE_STRIDE * 4 <= WS_END && WS_END <= 256 * MiB, "d_ws map");

constexpr int LDS_BYTES = 155648;

__device__ __forceinline__ float bf2f(bf16_t v) { return __uint_as_float((unsigned)v << 16); }
__device__ __forceinline__ unsigned f2bf(float f) { unsigned u = __float_as_uint(f); return (u + 0x7fffu + ((u >> 16) & 1u)) >> 16; }
__device__ __forceinline__ unsigned pk2(float lo, float hi) { return f2bf(lo) | (f2bf(hi) << 16); }
typedef __bf16 bf16x2_t __attribute__((ext_vector_type(2)));
__device__ __forceinline__ unsigned cvt_pk_bf16(float lo, float hi) { const f32x2 v = {lo, hi}; return __builtin_bit_cast(unsigned, __builtin_convertvector(v, bf16x2_t)); }
__device__ __forceinline__ float lo_bf(unsigned w) { return __uint_as_float(w << 16); }
__device__ __forceinline__ float hi_bf(unsigned w) { return __uint_as_float(w & 0xffff0000u); }
__device__ __forceinline__ float wave_sum(float v) {
#pragma unroll
    for (int o = 1; o < 64; o <<= 1) v += __shfl_xor(v, o);
    return v;
}
__device__ __forceinline__ float wave_max(float v) {
#pragma unroll
    for (int o = 1; o < 64; o <<= 1) v = fmaxf(v, __shfl_xor(v, o));
    return v;
}
__device__ __forceinline__ int wave_sum_i(int v) {
#pragma unroll
    for (int o = 1; o < 64; o <<= 1) v += __shfl_xor(v, o);
    return v;
}
__device__ __forceinline__ float sigmoid_f(float x) { return __builtin_amdgcn_rcpf(1.f + __builtin_amdgcn_exp2f(-1.4426950408889634f * x)); }
__device__ __forceinline__ float gelu_tanh_f(float x) { const float u = 0.7978845608028654f * (x + 0.044715f * x * x * x); return x * __builtin_amdgcn_rcpf(1.f + __builtin_amdgcn_exp2f(-2.8853900817779268f * u)); }
__device__ __forceinline__ unsigned fkey(float s) { const unsigned u = __float_as_uint(s); return (u & 0x80000000u) ? ~u : (u | 0x80000000u); }

namespace pg8 {
constexpr int BM = 256, BK = 64, HALF = 128, HTB = HALF * BK * 2, STAGE_BYTES = 8 * HTB, NXCD = 8, WGM = 8;
__host__ __device__ __forceinline__ int lds_byte(int r, int c) { const int st = (r >> 4) * 2 + (c >> 5), rr = r & 15, cc = c & 31, ob = rr * 64 + cc * 2; return st * 1024 + (ob ^ (((ob >> 9) & 1) << 5)); }
__host__ __device__ __forceinline__ void stage_rc(int b, int& R, int& C) { const int st = b / 1024, sb = b % 1024, swz = sb ^ (((sb >> 9) & 1) << 5); R = (st >> 1) * 16 + swz / 64; C = (st & 1) * 32 + (swz % 64) / 2; }
__host__ __device__ __forceinline__ int perm32(int rho) { const int n = rho >> 4, i = rho & 15; return 8 * (i >> 2) + 4 * n + (i & 3); }

struct Unit { int pm, pn, z; };
template <int K_, int LDA_, int LDB_, unsigned APM_, unsigned AZ_, unsigned BPN_, unsigned BZ_> struct Gemm {
    const bf16_t* A; const bf16_t* Bt;
    static constexpr int K = K_, lda = LDA_, ldb = LDB_; static constexpr unsigned aPm = APM_, aZ = AZ_, bPn = BPN_, bZ = BZ_;
};
template <class G> __device__ __forceinline__ const char* pa(const G& g, const Unit& u) { return (const char*)g.A + (size_t)((unsigned)u.pm * G::aPm + (unsigned)u.z * G::aZ); }
template <class G> __device__ __forceinline__ const char* pb(const G& g, const Unit& u) { return (const char*)g.Bt + (size_t)((unsigned)u.pn * G::bPn + (unsigned)u.z * G::bZ); }

struct StaticOrder {
    int nM, nN, nwg, G, c;
    __host__ __device__ void init(int M_, int N_, int G_, int c_) { nM = M_ / BM; nN = N_ / BM; nwg = nM * nN; G = G_; c = c_; }
    __host__ __device__ bool next(int i, Unit& u) const {
        const long L = (long)i * G + c; if (L >= nwg) return false;
        int wgid = (int)L; { const int q = nwg / NXCD, r = nwg % NXCD, xcd = wgid % NXCD, off = wgid / NXCD; wgid = (xcd < r ? xcd * (q + 1) : r * (q + 1) + (xcd - r) * q) + off; }
        const int nig = WGM * nN, gid = wgid / nig, fm = gid * WGM, gsz = (nM - fm) < WGM ? (nM - fm) : WGM;
        u.pm = fm + ((wgid % nig) % gsz); u.pn = (wgid % nig) / gsz; u.z = 0; return true;
    }
};
template <int MODE> struct SuperOrder {
    StaticOrder so;
    __host__ __device__ void init(int G_, int c_) { so.init(M, 1024, G_, c_); }
    __host__ __device__ bool next(int i, Unit& u) const {
        Unit b; if (!so.next(i >> 2, b)) return false;
        const int sub = i & 3; u.pm = b.pm; if (MODE == 0) { u.pn = b.pn; u.z = sub; } else { u.pn = 4 * b.pn + sub; u.z = 0; } return true;
    }
};

template <class Epi, class Sched, bool ALIGN_EPI, class GemmT>
__device__ __forceinline__ void gemm_phase(LAS unsigned char* lds, const GemmT g, const Sched& S, const Epi& E, const int tid) {
    const int wid = __builtin_amdgcn_readfirstlane(tid >> 6), lane = tid & 63, wr = wid >> 2, wc = wid & 3, fr = lane & 15, fq = lane >> 4;
    constexpr int K = GemmT::K, nt = K / BK;
    unsigned voffA[2], voffB[2];
#pragma unroll
    for (int i = 0; i < 2; ++i) { int R, C; stage_rc(tid * 16 + i * 8192, R, C); const int Rb = Epi::PERM ? ((R & ~31) + perm32(R & 31)) : R;
        voffA[i] = (unsigned)(R * GemmT::lda + C) * 2u; voffB[i] = (unsigned)(Rb * GemmT::ldb + C) * 2u; }
    const size_t kstep = (size_t)(BK * 2);
    constexpr size_t hA = (size_t)HALF * GemmT::lda * 2, hB = (size_t)HALF * GemmT::ldb * 2;
    const unsigned ldsw = (unsigned)wid * 1024u;
    const int aoff = lds_byte(wr * 64 + fr, fq * 8), boff = lds_byte(wc * 32 + fr, fq * 8);
#define PG8_SA(b, h) (((b) * 2 + (h)) * HTB)
#define PG8_SB(b, h) ((4 + (b) * 2 + (h)) * HTB)
#define PG8_STAGE(bufoff, gbase, voff) do { _Pragma("unroll") for (int _i = 0; _i < 2; ++_i) \
        __builtin_amdgcn_global_load_lds((const unsigned*)((const char*)(gbase) + (voff)[_i]), (LAS unsigned*)(lds + (bufoff) + ldsw + _i * 8192), 16, 0, 0); } while (0)
#define PG8_LDA(dst, b, h) do { _Pragma("unroll") for (int m = 0; m < 4; ++m) _Pragma("unroll") for (int k = 0; k < 2; ++k) dst[m][k] = *(const LAS bf16x8*)(lds + PG8_SA(b, h) + aoff + m * 2048 + k * 1024); } while (0)
#define PG8_LDB(dst, b, h) do { _Pragma("unroll") for (int n = 0; n < 2; ++n) _Pragma("unroll") for (int k = 0; k < 2; ++k) dst[n][k] = *(const LAS bf16x8*)(lds + PG8_SB(b, h) + boff + n * 2048 + k * 1024); } while (0)
#define PG8_MMA(ai, bj, At, Bt) do { __builtin_amdgcn_s_setprio(1); _Pragma("unroll") for (int m = 0; m < 4; ++m) _Pragma("unroll") for (int n = 0; n < 2; ++n) _Pragma("unroll") for (int k = 0; k < 2; ++k) \
        acc[ai][bj][m][n] = __builtin_amdgcn_mfma_f32_16x16x32_bf16(Bt[n][k], At[m][k], acc[ai][bj][m][n], 0, 0, 0); __builtin_amdgcn_s_setprio(0); } while (0)
#define PG8_WAIT_V(n) asm volatile("s_waitcnt vmcnt(" #n ")" ::: "memory")
#define PG8_WAIT_L(n) asm volatile("s_waitcnt lgkmcnt(" #n ")" ::: "memory")
#define PG8_BAR __builtin_amdgcn_s_barrier()
#define PG8_SCHED __builtin_amdgcn_sched_barrier(0)
    Unit cur, nxt; int ui = 0;
    if (!S.next(0, cur)) return;
    f32x4 acc[2][2][4][2];
#pragma unroll
    for (int a = 0; a < 2; ++a)
#pragma unroll
        for (int b = 0; b < 2; ++b)
#pragma unroll
            for (int m = 0; m < 4; ++m)
#pragma unroll
                for (int n = 0; n < 2; ++n) acc[a][b][m][n] = (f32x4){0.f, 0.f, 0.f, 0.f};
    bf16x8 At[4][2], B0[2][2], B1[2][2];
    const char* cA = pa(g, cur); const char* cB = pb(g, cur);
    PG8_STAGE(PG8_SB(0, 0), cB, voffB); PG8_STAGE(PG8_SB(0, 1), cB + hB, voffB); PG8_STAGE(PG8_SA(0, 0), cA, voffA); PG8_STAGE(PG8_SA(0, 1), cA + hA, voffA);
    if (wr == 1) PG8_BAR;
    PG8_WAIT_V(2); PG8_BAR;
    PG8_STAGE(PG8_SB(1, 0), cB + kstep, voffB); PG8_STAGE(PG8_SA(1, 0), cA + kstep, voffA); PG8_STAGE(PG8_SB(1, 1), cB + hB + kstep, voffB);
    PG8_WAIT_V(6); PG8_BAR;
    for (;;) {
        const bool has_next = S.next(ui + 1, nxt);
        const char* nA = has_next ? pa(g, nxt) : cA; const char* nB = has_next ? pb(g, nxt) : cB;
#pragma unroll 1
        for (int t = 0; t < nt; t += 2) {
            const bool last = (t == nt - 2);
            const char* a1 = cA + (size_t)(t + 1) * kstep;
            const char* a2 = last ? nA : cA + (size_t)(t + 2) * kstep; const char* b2 = last ? nB : cB + (size_t)(t + 2) * kstep;
            const char* a3 = a2 + kstep; const char* b3 = b2 + kstep;
            PG8_LDB(B0, 0, 0); PG8_LDB(B1, 0, 1); PG8_SCHED; PG8_LDA(At, 0, 0); PG8_STAGE(PG8_SA(1, 1), a1 + hA, voffA);
            PG8_WAIT_V(8); PG8_WAIT_L(0); PG8_BAR; PG8_MMA(0, 0, At, B0); PG8_MMA(0, 1, At, B1); PG8_BAR; PG8_SCHED;
            PG8_LDA(At, 0, 1); PG8_STAGE(PG8_SB(0, 0), b2, voffB); PG8_STAGE(PG8_SB(0, 1), b2 + hB, voffB); PG8_STAGE(PG8_SA(0, 0), a2, voffA);
            PG8_WAIT_V(8); PG8_WAIT_L(0); PG8_BAR; PG8_MMA(1, 0, At, B0); PG8_MMA(1, 1, At, B1); PG8_BAR; PG8_SCHED;
            PG8_LDB(B0, 1, 0); PG8_LDB(B1, 1, 1); PG8_SCHED; PG8_LDA(At, 1, 0); PG8_STAGE(PG8_SA(0, 1), a2 + hA, voffA);
            PG8_WAIT_V(8); PG8_WAIT_L(0); PG8_BAR; PG8_MMA(0, 0, At, B0); PG8_MMA(0, 1, At, B1); PG8_BAR; PG8_SCHED;
            PG8_LDA(At, 1, 1); PG8_STAGE(PG8_SB(1, 0), b3, voffB); PG8_STAGE(PG8_SB(1, 1), b3 + hB, voffB); PG8_STAGE(PG8_SA(1, 0), a3, voffA);
            PG8_WAIT_V(8); PG8_WAIT_L(0); PG8_BAR; PG8_MMA(1, 0, At, B0); PG8_MMA(1, 1, At, B1); PG8_BAR; PG8_SCHED;
        }
        if constexpr (ALIGN_EPI) { if (wr == 0) PG8_BAR; }
        { int fr2 = fr, fq2 = fq; asm volatile("" : "+v"(fr2), "+v"(fq2)); E(acc, cur, wr, wc, fr2, fq2); }
        if (!has_next) break;
#pragma unroll
        for (int a = 0; a < 2; ++a)
#pragma unroll
            for (int b = 0; b < 2; ++b)
#pragma unroll
                for (int m = 0; m < 4; ++m)
#pragma unroll
                    for (int n = 0; n < 2; ++n) acc[a][b][m][n] = (f32x4){0.f, 0.f, 0.f, 0.f};
        cur = nxt; cA = nA; cB = nB; ++ui;
        if constexpr (ALIGN_EPI) { if (wr == 1) PG8_BAR; }
    }
    PG8_WAIT_V(0);
    if constexpr (!ALIGN_EPI) { if (wr == 0) PG8_BAR; }
    PG8_BAR;
#undef PG8_SA
#undef PG8_SB
#undef PG8_STAGE
#undef PG8_LDA
#undef PG8_LDB
#undef PG8_MMA
#undef PG8_WAIT_V
#undef PG8_WAIT_L
#undef PG8_BAR
#undef PG8_SCHED
}
}
namespace epi {
using pg8::Unit;
typedef f32x4 Acc[2][2][4][2];

__device__ __forceinline__ float row_scale(const float* rs, int row) { return rs[row]; }
__device__ __forceinline__ u32x4 pack8(const f32x4 a, const f32x4 b) { u32x4 w; w.x = cvt_pk_bf16(a[0], a[1]); w.y = cvt_pk_bf16(a[2], a[3]); w.z = cvt_pk_bf16(b[0], b[1]); w.w = cvt_pk_bf16(b[2], b[3]); return w; }

struct EpiProj {
    static constexpr bool PERM = true;
    bf16_t* P; float* misc; const float* ssq; const float* cs; const float* sn; const float* gt;     bf16_t* VT;     bf16_t* KI;     bf16_t* CVT;     float* ssqv;
    __device__ __forceinline__ void operator()(const Acc& acc, const Unit& u, int wr, int wc, int fr, int fq) const {
        const int T = u.pn; const int row0 = u.pm * 256 + wr * 64 + fr;
        if (T == 2 || T == 3 || T == 5 || T == 6 || T == 14) {
            if (T == 14 && wc >= 2) return;
            if (T == 14 && wc == 1) {
                if (fq < 2) {
#pragma unroll
                    for (int ai = 0; ai < 2; ++ai)
#pragma unroll
                        for (int m = 0; m < 4; ++m) { const int row = row0 + ai * 128 + m * 16; const float rs = row_scale(ssq, row);
                            float* mp = misc + (size_t)row * 16 + 8 * fq; *(f32x4*)mp = acc[ai][0][m][0] * rs; *(f32x4*)(mp + 4) = acc[ai][0][m][1] * rs; }
                }
                return;
            }
            const int mode = (T == 14) ? 2 : (T <= 3 ? 1 : 0);
            const float* gp = gt + 64 * ((T == 2) ? 0 : (T == 3) ? 1 : 2);
            f32x4 g1[2], g2[2];
#pragma unroll
            for (int n = 0; n < 2; ++n) { if (mode) { g1[n] = *(const f32x4*)(gp + 8 * fq + 4 * n); g2[n] = *(const f32x4*)(gp + 32 + 8 * fq + 4 * n); } else { g1[n] = (f32x4){1.f, 1.f, 1.f, 1.f}; g2[n] = g1[n]; } }
#pragma unroll
            for (int ai = 0; ai < 2; ++ai)
#pragma unroll
                for (int m = 0; m < 4; ++m) {
                    const int row = row0 + ai * 128 + m * 16; const float rs = row_scale(ssq, row); const int pos = row & (S - 1);
                    f32x4 x1[2], x2[2];
#pragma unroll
                    for (int n = 0; n < 2; ++n) { x1[n] = acc[ai][0][m][n] * rs; x2[n] = acc[ai][1][m][n] * rs; }
                    if (mode == 2) {
                        float s = 0.f;
#pragma unroll
                        for (int n = 0; n < 2; ++n) s += (x1[n][0] + x1[n][1]) + (x1[n][2] + x1[n][3]) + (x2[n][0] + x2[n][1]) + (x2[n][2] + x2[n][3]);
                        s += __shfl_xor(s, 16); s += __shfl_xor(s, 32); const float mu = s * (1.f / 64.f);
#pragma unroll
                        for (int n = 0; n < 2; ++n) { x1[n] = x1[n] - mu; x2[n] = x2[n] - mu; }
                    }
                    if (mode) {
                        float q = 0.f;
#pragma unroll
                        for (int n = 0; n < 2; ++n) { const f32x4 a = x1[n] * x1[n], b = x2[n] * x2[n]; q += (a[0] + a[1]) + (a[2] + a[3]) + (b[0] + b[1]) + (b[2] + b[3]); }
                        q += __shfl_xor(q, 16); q += __shfl_xor(q, 32); const float rr = rsqrtf(q * (1.f / 64.f) + EPS);
#pragma unroll
                        for (int n = 0; n < 2; ++n) { x1[n] = x1[n] * rr * g1[n]; x2[n] = x2[n] * rr * g2[n]; }
                    }
                    f32x4 o1[2], o2[2];
#pragma unroll
                    for (int n = 0; n < 2; ++n) { const f32x4 c = *(const f32x4*)(cs + (size_t)pos * 32 + 8 * fq + 4 * n), s = *(const f32x4*)(sn + (size_t)pos * 32 + 8 * fq + 4 * n);
                        o1[n] = x1[n] * c - x2[n] * s; o2[n] = x2[n] * c + x1[n] * s; }
                    bf16_t* op = P + (size_t)row * PW + 256 * T + 64 * wc + 8 * fq;
                    *(u32x4*)op = pack8(o1[0], o1[1]); *(u32x4*)(op + 32) = pack8(o2[0], o2[1]);
                    if (T == 14) { bf16_t* kp = KI + (size_t)row * 64 + 8 * fq; *(u32x4*)kp = pack8(o1[0], o1[1]); *(u32x4*)(kp + 32) = pack8(o2[0], o2[1]); }
                }
            return;
        }
        const int act = (T <= 1) ? 1 : 0; const float sc = (T == 8) ? 0.125f : 1.0f;
#pragma unroll
        for (int ai = 0; ai < 2; ++ai)
#pragma unroll
            for (int m = 0; m < 4; ++m) {
                const int row = row0 + ai * 128 + m * 16; const float rs = row_scale(ssq, row) * sc;
                bf16_t* op = P + (size_t)row * PW + 256 * T + 32 * wc + 8 * fq; float qv = 0.f;
#pragma unroll
                for (int bj = 0; bj < 2; ++bj) { f32x4 v0 = acc[ai][bj][m][0] * rs, v1 = acc[ai][bj][m][1] * rs;
                    if (act) {
#pragma unroll
                        for (int e = 0; e < 4; ++e) { v0[e] = gelu_tanh_f(v0[e]); v1[e] = gelu_tanh_f(v1[e]); }
                        const f32x4 a2 = v0 * v0, b2 = v1 * v1; qv += ((a2[0] + a2[1]) + (a2[2] + a2[3])) + ((b2[0] + b2[1]) + (b2[2] + b2[3])); }
                    *(u32x4*)(op + bj * 128) = pack8(v0, v1);
                    if (T == 4 || T == 9) { bf16_t* vp = (T == 4 ? VT : CVT) + ((size_t)((row >> 12) * 256 + bj * 128 + 32 * wc + 8 * fq)) * S + (row & (S - 1));
#pragma unroll
                        for (int e = 0; e < 4; ++e) { vp[(size_t)e * S] = (bf16_t)f2bf(v0[e]); vp[(size_t)(4 + e) * S] = (bf16_t)f2bf(v1[e]); } } }
                if (T == 1) { qv += __shfl_xor(qv, 16); qv += __shfl_xor(qv, 32); if (fq == 0) ssqv[(size_t)row * 4 + wc] = qv; }
            }
    }
};

struct EpiPlain {
    static constexpr bool PERM = true;
    bf16_t* O; int ldc; int zcols;
    __device__ __forceinline__ void operator()(const Acc& acc, const Unit& u, int wr, int wc, int fr, int fq) const {
        const int row0 = u.pm * 256 + wr * 64 + fr; const int col0 = u.z * zcols + u.pn * 256 + 32 * wc + 8 * fq;
#pragma unroll
        for (int ai = 0; ai < 2; ++ai)
#pragma unroll
            for (int m = 0; m < 4; ++m) { bf16_t* op = O + (size_t)(row0 + ai * 128 + m * 16) * ldc + col0;
#pragma unroll
                for (int bj = 0; bj < 2; ++bj) *(u32x4*)(op + bj * 128) = pack8(acc[ai][bj][m][0], acc[ai][bj][m][1]); }
    }
};

struct EpiGate {
    static constexpr bool PERM = true;
    bf16_t* MG; const bf16_t* BR; const float* ssq;
    __device__ __forceinline__ void operator()(const Acc& acc, const Unit& u, int wr, int wc, int fr, int fq) const {
        const int row0 = u.pm * 256 + wr * 64 + fr; const int ch0 = u.pn * 64 + 16 * wc + 4 * fq;
#pragma unroll
        for (int ai = 0; ai < 2; ++ai)
#pragma unroll
            for (int m = 0; m < 4; ++m) {
                const int row = row0 + ai * 128 + m * 16; const float rs = row_scale(ssq, row);
                const bf16_t* bp = BR + (size_t)row * 4096 + ch0; f32x4 o = (f32x4){0.f, 0.f, 0.f, 0.f};
#pragma unroll
                for (int bj = 0; bj < 2; ++bj)
#pragma unroll
                    for (int n = 0; n < 2; ++n) { const u32x2 w = *(const u32x2*)(bp + (2 * bj + n) * 1024); const f32x4 a = acc[ai][bj][m][n] * rs;
                        o[0] += sigmoid_f(a[0]) * lo_bf(w.x); o[1] += sigmoid_f(a[1]) * hi_bf(w.x); o[2] += sigmoid_f(a[2]) * lo_bf(w.y); o[3] += sigmoid_f(a[3]) * hi_bf(w.y); }
                u32x2 ow; ow.x = cvt_pk_bf16(o[0], o[1]); ow.y = cvt_pk_bf16(o[2], o[3]);
                *(u32x2*)(MG + (size_t)row * 1024 + ch0) = ow;
            }
    }
};

struct EpiResid {
    static constexpr bool PERM = true;
    const float* res; float* out; bf16_t* XG; const float* gain; float* ssq;
    __device__ __forceinline__ void operator()(const Acc& acc, const Unit& u, int wr, int wc, int fr, int fq) const {
        const int row0 = u.pm * 256 + wr * 64 + fr; const int col0 = u.pn * 256 + 32 * wc + 8 * fq;
        f32x4 gv[2][2];
#pragma unroll
        for (int bj = 0; bj < 2; ++bj)
#pragma unroll
            for (int n = 0; n < 2; ++n) gv[bj][n] = gain ? *(const f32x4*)(gain + col0 + bj * 128 + 4 * n) : (f32x4){1.f, 1.f, 1.f, 1.f};
#pragma unroll
        for (int ai = 0; ai < 2; ++ai)
#pragma unroll
            for (int m = 0; m < 4; ++m) {
                const int row = row0 + ai * 128 + m * 16; const size_t off = (size_t)row * 1024 + col0; float q = 0.f;
#pragma unroll
                for (int bj = 0; bj < 2; ++bj) {
                    const f32x4 r0 = *(const f32x4*)(res + off + bj * 128), r1 = *(const f32x4*)(res + off + bj * 128 + 4);
                    const f32x4 x0 = r0 + acc[ai][bj][m][0], x1 = r1 + acc[ai][bj][m][1];
                    *(f32x4*)(out + off + bj * 128) = x0; *(f32x4*)(out + off + bj * 128 + 4) = x1;
                    const f32x4 a = x0 * x0, b = x1 * x1; q += ((a[0] + a[1]) + (a[2] + a[3])) + ((b[0] + b[1]) + (b[2] + b[3]));
                    *(u32x4*)(XG + off + bj * 128) = pack8(x0 * gv[bj][0], x1 * gv[bj][1]);
                }
                q += __shfl_xor(q, 16); q += __shfl_xor(q, 32);
                if (fq == 0) ssq[(size_t)row * 16 + 4 * u.pn + wc] = q;
            }
    }
};

struct EpiUp {
    static constexpr bool PERM = true;
    bf16_t* H; const float* ssq;
    __device__ __forceinline__ void operator()(const Acc& acc, const Unit& u, int wr, int wc, int fr, int fq) const {
        const int row0 = u.pm * 256 + wr * 64 + fr; const int col0 = u.pn * 256 + 32 * wc + 8 * fq;
#pragma unroll
        for (int ai = 0; ai < 2; ++ai)
#pragma unroll
            for (int m = 0; m < 4; ++m) { const int row = row0 + ai * 128 + m * 16; const float rs = row_scale(ssq, row); bf16_t* op = H + (size_t)row * FF + col0;
#pragma unroll
                for (int bj = 0; bj < 2; ++bj) { f32x4 v0 = acc[ai][bj][m][0] * rs, v1 = acc[ai][bj][m][1] * rs;
#pragma unroll
                    for (int e = 0; e < 4; ++e) { v0[e] = fmaxf(v0[e], 0.f); v1[e] = fmaxf(v1[e], 0.f); }
                    *(u32x4*)(op + bj * 128) = pack8(v0 * v0, v1 * v1); } }
    }
};
}
struct Args {
    const float* in[18]; float* out; unsigned char* ws; int ph_lo, ph_hi; int coop, pad;
};
struct Frame { LAS unsigned char* lds; int tid, lane, wave, G, vcu; };
constexpr int PTR_OFF = LDS_BYTES - 512;
enum { I_X = 0, I_LN_MIX, I_W_IN, I_SGU_NORM, I_SGU_W, I_SGU_B, I_Q_NORM, I_K_NORM, I_KIDX_NORM, I_I_BIAS, I_F_BIAS, I_MNORM, I_CONV_W, I_W_BRANCH, I_W_OUT, I_LN_MLP, I_W_UP, I_W_DOWN, I_OUT, I_WS };
__device__ __forceinline__ unsigned char* ptr_at(const Frame& F, int i) { const LAS unsigned* p = (const LAS unsigned*)(F.lds + PTR_OFF) + 2 * i;
    const unsigned lo = __builtin_amdgcn_readfirstlane(p[0]), hi = __builtin_amdgcn_readfirstlane(p[1]);
    typedef __attribute__((address_space(1))) unsigned char* gptr_t;
    return (unsigned char*)(gptr_t)(((unsigned long long)hi << 32) | lo); }
#define INP(i) ((const float*)ptr_at(F, (i)))
#define WSP(off) (ptr_at(F, I_WS) + (off))
constexpr size_t WS_GT = 512 * 1024;
constexpr size_t WS_RSA = 256 * 1024, WS_RSB = 320 * 1024;
__device__ __forceinline__ size_t maskt_idx(int m, int w) { const int b = m >> 12, t = m & (S - 1); return ((size_t)(b * 64 + (w >> 1)) * S + t) * 2 + (w & 1); }


#define XB_TMO      128
#define XB_XCNT(j)  (256  + 64 * (j))
#define XB_XSUB(j)  (1280 + 64 * (j))
#define XB_XGEN(j)  (2304 + 64 * (j))
#define XB_TOP      3328
#define XB_TOPGEN   3392
#define XCD_BAR_WORDS 3456
#define XB_SPIN_CAP (1u << 22)
constexpr size_t WS_BAR = 64 * 1024;
constexpr size_t CTL_ZERO_BYTES = 128 * 1024;
__device__ __forceinline__ unsigned xb_ld(unsigned* p)              { return __hip_atomic_load(p, __ATOMIC_RELAXED, __HIP_MEMORY_SCOPE_AGENT); }
__device__ __forceinline__ unsigned xb_add(unsigned* p, unsigned v) { return __hip_atomic_fetch_add(p, v, __ATOMIC_RELAXED, __HIP_MEMORY_SCOPE_AGENT); }
__device__ __forceinline__ unsigned xb_xcc_id() { return (unsigned)__builtin_amdgcn_s_getreg((3 << 11) | 20) & 0xFu; }
#define XB_SPIN(cond, bar) do { unsigned _sp = 0; while (cond) { __builtin_amdgcn_s_sleep(1); \
    if ((++_sp & 255u) == 0u) { if (xb_ld(&(bar)[XB_TMO])) break; if (_sp > XB_SPIN_CAP) { atomicAdd(&(bar)[XB_TMO], 1u); break; } } } } while (0)
struct XcdBarrier { unsigned* bar; unsigned x; volatile LAS unsigned* st; };
__device__ __forceinline__ XcdBarrier xcd_barrier_post(unsigned* bar, volatile LAS unsigned* st) {
    XcdBarrier b; b.bar = bar; b.x = xb_xcc_id(); b.st = st;
    if (threadIdx.x == 0) (void)xb_add(&bar[XB_XCNT(b.x)], 1u);
    return b;
}
__device__ __forceinline__ void xcd_barrier_complete(unsigned* bar, unsigned x, unsigned& nloc, unsigned& nx) {
    const unsigned G = gridDim.x * gridDim.y * gridDim.z;
    unsigned sum, cnt, mine, sp = 0u;
    for (;;) {
        sum = 0u; cnt = 0u; mine = 0u;
#pragma unroll
        for (unsigned j = 0; j < 16; ++j) { const unsigned c = xb_ld(&bar[XB_XCNT(j)]); sum += c; cnt += (c > 0u) ? 1u : 0u; mine = (j == x) ? c : mine; }
        if (sum == G) break;
        __builtin_amdgcn_s_sleep(1);
        if ((++sp & 255u) == 0u) { if (xb_ld(&bar[XB_TMO])) break; if (sp > XB_SPIN_CAP) { atomicAdd(&bar[XB_TMO], 1u); break; } }
    }
    nloc = mine > 0u ? mine : 1u; nx = cnt > 0u ? cnt : 1u;
}
__device__ __forceinline__ void xcd_barrier(const XcdBarrier& b) {
    asm volatile("s_waitcnt vmcnt(0)" ::: "memory");
    __syncthreads();
    if (threadIdx.x == 0) {
        unsigned* bar = b.bar;
        __builtin_amdgcn_s_waitcnt(0);
        unsigned nloc = b.st[0], nx = b.st[1];
        if (nloc == 0u) { xcd_barrier_complete(bar, b.x, nloc, nx); b.st[0] = nloc; b.st[1] = nx; }
        const unsigned old = xb_add(&bar[XB_XSUB(b.x)], 1u);
        const unsigned gen = old / nloc;
        if (old + 1u == (gen + 1u) * nloc) {
            __builtin_amdgcn_fence(__ATOMIC_RELEASE, "agent");
            asm volatile("s_waitcnt vmcnt(0)" ::: "memory");
            const unsigned og = xb_add(&bar[XB_TOP], 1u);
            const unsigned tg = og / nx;
            if (og + 1u == (tg + 1u) * nx) xb_add(&bar[XB_TOPGEN], 1u);
            else XB_SPIN(xb_ld(&bar[XB_TOPGEN]) == tg, bar);
            __builtin_amdgcn_fence(__ATOMIC_ACQUIRE, "agent");
            xb_add(&bar[XB_XGEN(b.x)], 1u);
            asm volatile("s_waitcnt vmcnt(0)" ::: "memory");
        } else {
            XB_SPIN(xb_ld(&bar[XB_XGEN(b.x)]) == gen, bar);
            __builtin_amdgcn_fence(__ATOMIC_ACQUIRE, "agent");
            asm volatile("s_waitcnt vmcnt(0)" ::: "memory");
        }
    }
    __syncthreads();
}

__device__ __forceinline__ int win_src(int p) {
    const int T = p >> 8, q = p & 255, bj = q >> 7, wc = (q >> 5) & 3, j = q & 31, hd = 64 * wc + 32 * bj + j;
    switch (T) {
        case 0: return O_AU + q; case 1: return O_AV + q; case 2: return O_BQ + hd; case 3: return O_BK + hd; case 4: return O_BV + q;
        case 5: return O_QI + hd; case 6: return O_QI + 256 + hd; case 7: return O_CQ + q; case 8: return O_CK + q; case 9: return O_CV + q;
        case 10: return O_CO + q; case 11: return O_DB + q; case 12: return O_DC + q; case 13: return O_DX + q;
        default: break;
    }
    if (wc == 0) return O_KI + 32 * bj + j;
    if (wc == 1 && bj == 0 && j < 16) return j < 8 ? O_WI + j : (j < 12 ? O_CI + (j - 8) : O_CF + (j - 12));
    return -1;
}
__device__ __forceinline__ int wg_src(int p) {
    const int pn = p >> 8, q = p & 255, bj = q >> 7, wc = (q >> 5) & 3, fq = (q >> 3) & 3, n = (q >> 2) & 1, e = q & 3;
    return O_G + (2 * bj + n) * 1024 + 64 * pn + 16 * wc + 4 * fq + e;
}
template <int MAP>
__device__ __forceinline__ void conv_item(const float* W, int K, int srcN, bf16_t* WT, LAS float* scr, int item, int nrows, int lane) {
    const int nblk = nrows / 32, kb = item / nblk, nb = item % nblk, k0 = 64 * kb, n0 = 32 * nb;
    const int nn = n0 + (lane & 31); const int src = MAP == 0 ? nn : (MAP == 1 ? win_src(nn) : wg_src(nn));
    float wv_[32]; const float* wp_ = W + (size_t)(k0 + (lane >> 5)) * srcN + (src >= 0 ? src : 0);
#pragma unroll
    for (int i = 0; i < 32; ++i) wv_[i] = __builtin_nontemporal_load(wp_ + (size_t)(2 * i) * srcN);
#pragma unroll
    for (int i = 0; i < 32; ++i) scr[(2 * i + (lane >> 5)) * 33 + (lane & 31)] = src >= 0 ? wv_[i] : 0.f;
    asm volatile("s_waitcnt lgkmcnt(0)" ::: "memory");
    const int c = lane & 7;
#pragma unroll
    for (int j = 0; j < 4; ++j) { const int n = (lane >> 3) + 8 * j; const LAS float* s = scr + (8 * c) * 33 + n;
        u32x4 o; o.x = pk2(s[0 * 33], s[1 * 33]); o.y = pk2(s[2 * 33], s[3 * 33]); o.z = pk2(s[4 * 33], s[5 * 33]); o.w = pk2(s[6 * 33], s[7 * 33]);
        *(u32x4*)(WT + (size_t)(n0 + n) * K + k0 + 8 * c) = o; }
    asm volatile("s_waitcnt lgkmcnt(0)" ::: "memory");
}
__device__ __forceinline__ void convert_mix_weights(Frame& F, int l) {

    LAS float* scr = (LAS float*)(F.lds + F.wave * 16384);
    const int gw = F.vcu * NWAVES + F.wave, NGW = F.G * NWAVES;
    constexpr int I_WIN = (D / 64) * (PW / 32), I_WG = (D / 64) * (4096 / 32), I_BR = (256 / 64) * (1024 / 32), I_OUT = (D / 64) * (D / 32);
    constexpr int NIT = I_WIN + I_WG + 4 * I_BR + I_OUT;
    const float* win = INP(I_W_IN) + (size_t)l * D * INW;
    for (int it = gw; it < NIT; it += NGW) {
        int r = it;
        if (r < I_WIN) { conv_item<1>(win, D, INW, ((bf16_t*)WSP(WS_WIN)), scr, r, PW, F.lane); continue; } r -= I_WIN;
        if (r < I_WG) { conv_item<2>(win, D, INW, ((bf16_t*)WSP(WS_WG)), scr, r, 4096, F.lane); continue; } r -= I_WG;
        if (r < 4 * I_BR) { const int nb = r / I_BR; conv_item<0>(INP(I_W_BRANCH) + ((size_t)l * 4 + nb) * 256 * D, 256, D, ((bf16_t*)WSP(WS_WBR)) + (size_t)nb * 1024 * 256, scr, r % I_BR, 1024, F.lane); continue; } r -= 4 * I_BR;
        conv_item<0>(INP(I_W_OUT) + (size_t)l * D * D, D, D, ((bf16_t*)WSP(WS_WOUT)), scr, r, D, F.lane);
    }
}
__device__ __forceinline__ void convert_mlp_weights(Frame& F, int l) {

    LAS float* scr = (LAS float*)(F.lds + F.wave * 16384);
    const int gw = F.vcu * NWAVES + F.wave, NGW = F.G * NWAVES;
    constexpr int I_UP = (D / 64) * (FF / 32), I_DN = (FF / 64) * (D / 32);
    for (int it = gw; it < I_UP + I_DN; it += NGW) {
        if (it < I_UP) conv_item<0>(INP(I_W_UP) + (size_t)l * D * FF, D, FF, ((bf16_t*)WSP(WS_WUP)), scr, it, FF, F.lane);
        else conv_item<0>(INP(I_W_DOWN) + (size_t)l * FF * D, FF, D, ((bf16_t*)WSP(WS_WDN)), scr, it - I_UP, D, F.lane);
    }
}
__device__ __forceinline__ void prologue_rows(Frame& F) {
    float* COS = (float*)WSP(WS_COS); float* SIN = (float*)WSP(WS_SIN); float* SSQA = (float*)WSP(WS_SSQA); bf16_t* XG = (bf16_t*)WSP(WS_XG); const float* x = INP(I_X); const float* ln_mix = INP(I_LN_MIX);
    const int gt = F.vcu * NT + F.tid, NGT = F.G * NT;
    for (int i = gt; i < S * 32; i += NGT) { const int pos = i >> 5, k = i & 31; const float inv = powf(10000.f, -(float)k * 2.0f / 64.f); const float ang = (float)pos * inv; COS[i] = cosf(ang); SIN[i] = sinf(ang); }
    const int gw = F.vcu * NWAVES + F.wave, NGW = F.G * NWAVES;
    for (int m = gw; m < M; m += NGW) {
        const f32x4* xr = (const f32x4*)(x + (size_t)m * D) + F.lane; const f32x4* gr = (const f32x4*)ln_mix + F.lane;
        unsigned long long* o8 = (unsigned long long*)(XG + (size_t)m * D) + F.lane; float tot = 0.f;
#pragma unroll
        for (int j = 0; j < 4; ++j) { const f32x4 v = xr[64 * j], g = gr[64 * j]; float s = (v[0] * v[0] + v[1] * v[1]) + (v[2] * v[2] + v[3] * v[3]);
            s += __shfl_xor(s, 1); s += __shfl_xor(s, 2); s += __shfl_xor(s, 4); s += __shfl_xor(s, 8);
            tot += s;
            o8[64 * j] = (unsigned long long)pk2(v[0] * g[0], v[1] * g[1]) | ((unsigned long long)pk2(v[2] * g[2], v[3] * g[3]) << 32); }
        tot += __shfl_xor(tot, 16); tot += __shfl_xor(tot, 32);
        if (F.lane == 0) ((float*)WSP(WS_RSA))[m] = rsqrtf(tot * (1.f / 1024.f) + EPS);
    }
}
__device__ __forceinline__ void finalize_rs(Frame& F, size_t ssq_off, size_t rs_off) {
    const float* ssq = (const float*)WSP(ssq_off); float* rs = (float*)WSP(rs_off);
    for (int row = F.vcu * NT + F.tid; row < M; row += F.G * NT) { const f32x4* sp = (const f32x4*)(ssq + (size_t)row * 16); const f32x4 a = sp[0], b = sp[1], c = sp[2], d = sp[3];
        const float t = ((a[0] + a[1]) + (a[2] + a[3])) + ((b[0] + b[1]) + (b[2] + b[3])) + ((c[0] + c[1]) + (c[2] + c[3])) + ((d[0] + d[1]) + (d[2] + d[3]));
        rs[row] = rsqrtf(t * (1.0f / 1024.0f) + EPS); }
}

__device__ __forceinline__ void sgu_simple(Frame& F, int l) {
    bf16_t* PROJ = (bf16_t*)WSP(WS_BIG); bf16_t* Y = (bf16_t*)WSP(WS_Y); const float* sgu_norm = INP(I_SGU_NORM); const float* sgu_w = INP(I_SGU_W); const float* sgu_b = INP(I_SGU_B);
    LAS float* r_s = (LAS float*)F.lds; LAS float* vn = r_s + 128;
    const float* gain = sgu_norm + l * 256; const float* sw = sgu_w + (size_t)l * 4 * 128 * 128; const float* sb = sgu_b + l * 4 * 128;
    for (int item = F.vcu; item < 512; item += F.G) {
        const int g = item & 3, m0 = (item >> 2) * 128;
        for (int i = 0; i < 16; ++i) { const int tok = F.wave * 16 + i; const u32x2 w = *(const u32x2*)(PROJ + (size_t)(m0 + tok) * PW + P_AV + 4 * F.lane);
            const float a = lo_bf(w.x), b = hi_bf(w.x), c = lo_bf(w.y), d = hi_bf(w.y); const float ss = wave_sum((a * a + b * b) + (c * c + d * d));
            if (F.lane == 0) r_s[tok] = rsqrtf(ss * (1.f / 256.f) + EPS); }
        __syncthreads();
        for (int idx = F.tid; idx < 8192; idx += NT) { const int s = idx >> 6, d = idx & 63; vn[idx] = bf2f(PROJ[(size_t)(m0 + s) * PW + P_AV + g * 64 + d]) * r_s[s] * gain[g * 64 + d]; }
        __syncthreads();
        const int d = F.tid & 63, tq = F.tid >> 6;
        for (int tl = tq; tl < 128; tl += 8) { const float* w = sw + ((size_t)g * 128 + tl) * 128; float acc = 0.f;
            for (int s = 0; s <= tl; ++s) acc = fmaf(w[s], vn[s * 64 + d], acc);
            acc += sb[g * 128 + tl];
            Y[(size_t)(m0 + tl) * D + g * 64 + d] = (bf16_t)f2bf(bf2f(PROJ[(size_t)(m0 + tl) * PW + P_AU + g * 64 + d]) * acc); }
        __syncthreads();
    }
}
__device__ __forceinline__ void conv_simple(Frame& F, int l) {
    bf16_t* PROJ = (bf16_t*)WSP(WS_BIG); bf16_t* Y = (bf16_t*)WSP(WS_Y); const float* conv_w = INP(I_CONV_W);
    const float* cw = conv_w + l * 3 * 256;
    for (int i = F.vcu * NT + F.tid; i < M * 32; i += F.G * NT) { const int m = i >> 5, c = (i & 31) * 8, t = m & (S - 1); float acc[8];
#pragma unroll
        for (int e = 0; e < 8; ++e) acc[e] = 0.f;
#pragma unroll
        for (int j = 0; j < 3; ++j) { const int tt = t - 2 + j; if (tt >= 0) { const size_t r = (size_t)(m - 2 + j) * PW; const u32x4 a = *(const u32x4*)(PROJ + r + P_DC + c), x = *(const u32x4*)(PROJ + r + P_DX + c);
                const f32x4 w0 = *(const f32x4*)(cw + j * 256 + c), w1 = *(const f32x4*)(cw + j * 256 + c + 4);
                acc[0] = fmaf(w0[0], lo_bf(a.x) * lo_bf(x.x), acc[0]); acc[1] = fmaf(w0[1], hi_bf(a.x) * hi_bf(x.x), acc[1]); acc[2] = fmaf(w0[2], lo_bf(a.y) * lo_bf(x.y), acc[2]); acc[3] = fmaf(w0[3], hi_bf(a.y) * hi_bf(x.y), acc[3]);
                acc[4] = fmaf(w1[0], lo_bf(a.z) * lo_bf(x.z), acc[4]); acc[5] = fmaf(w1[1], hi_bf(a.z) * hi_bf(x.z), acc[5]); acc[6] = fmaf(w1[2], lo_bf(a.w) * lo_bf(x.w), acc[6]); acc[7] = fmaf(w1[3], hi_bf(a.w) * hi_bf(x.w), acc[7]); } }
        const u32x4 bq = *(const u32x4*)(PROJ + (size_t)m * PW + P_DB + c); u32x4 o;
        o.x = cvt_pk_bf16(lo_bf(bq.x) * acc[0], hi_bf(bq.x) * acc[1]); o.y = cvt_pk_bf16(lo_bf(bq.y) * acc[2], hi_bf(bq.y) * acc[3]); o.z = cvt_pk_bf16(lo_bf(bq.z) * acc[4], hi_bf(bq.z) * acc[5]); o.w = cvt_pk_bf16(lo_bf(bq.w) * acc[6], hi_bf(bq.w) * acc[7]);
        *(u32x4*)(Y + (size_t)m * D + 768 + c) = o; }
}
__device__ __forceinline__ void indexer_simple(Frame& F) {
    float* MISC = (float*)WSP(WS_MISC); unsigned* MASK = (unsigned*)WSP(WS_MASK); bf16_t* PROJ = (bf16_t*)WSP(WS_BIG);
    LAS float* sc = (LAS float*)F.lds; LAS int* red = (LAS int*)(sc + 4096); LAS unsigned* msk = (LAS unsigned*)(red + 16);
    for (int m = F.vcu; m < M; m += F.G) {
        const int t = m & (S - 1), b0 = m - t, n = t + 1;
        if (n <= 256) { if (F.tid < 128) { const int lo = 32 * F.tid; MASK[maskt_idx(m, F.tid)] = (lo + 32 <= n) ? 0xffffffffu : (lo >= n ? 0u : ((1u << (n - lo)) - 1u)); } continue; }
        float qreg[8], wh[8];
#pragma unroll
        for (int h = 0; h < 8; ++h) { qreg[h] = bf2f(PROJ[(size_t)m * PW + P_QI + h * 64 + F.lane]); wh[h] = MISC[(size_t)m * 16 + h] * 0.35355339059327373f; }
        for (int s0 = 0; s0 < n; s0 += NT) {
            const int s = s0 + F.tid, sc_ = s < n ? s : n - 1; const u32x4* kr = (const u32x4*)(PROJ + (size_t)(b0 + sc_) * PW + P_KI);
            float kf[64];
#pragma unroll
            for (int i = 0; i < 8; ++i) { const u32x4 w = kr[i]; kf[8 * i] = lo_bf(w.x); kf[8 * i + 1] = hi_bf(w.x); kf[8 * i + 2] = lo_bf(w.y); kf[8 * i + 3] = hi_bf(w.y); kf[8 * i + 4] = lo_bf(w.z); kf[8 * i + 5] = hi_bf(w.z); kf[8 * i + 6] = lo_bf(w.w); kf[8 * i + 7] = hi_bf(w.w); }
            float acc = 0.f;
#pragma unroll
            for (int h = 0; h < 8; ++h) { float d0 = 0.f, d1 = 0.f;
#pragma unroll
                for (int e = 0; e < 64; e += 2) { d0 = fmaf(__builtin_bit_cast(float, __builtin_amdgcn_readlane(__builtin_bit_cast(int, qreg[h]), e)), kf[e], d0);
                                                   d1 = fmaf(__builtin_bit_cast(float, __builtin_amdgcn_readlane(__builtin_bit_cast(int, qreg[h]), e + 1)), kf[e + 1], d1); }
                acc += wh[h] * fmaxf((d0 + d1) * 0.125f, 0.f); }
            if (s < n) sc[s] = acc;
        }
        __syncthreads();
        unsigned Tk = 0u;
        for (int bit = 31; bit >= 0; --bit) {
            const unsigned cand = Tk | (1u << bit); int c = 0;
            for (int s = F.tid; s < n; s += NT) c += (fkey(sc[s]) >= cand) ? 1 : 0;
            c = wave_sum_i(c); if (F.lane == 0) red[F.wave] = c; __syncthreads();
            int tot = 0;
#pragma unroll
            for (int w = 0; w < 8; ++w) tot += red[w];
            __syncthreads();
            if (tot >= 256) Tk = cand;
        }
        int cg_ = 0, ce = 0;
        for (int s = F.tid; s < n; s += NT) { const unsigned k = fkey(sc[s]); cg_ += k > Tk ? 1 : 0; ce += k == Tk ? 1 : 0; }
        cg_ = wave_sum_i(cg_); ce = wave_sum_i(ce); if (F.lane == 0) { red[F.wave] = cg_; red[8 + F.wave] = ce; }
        if (F.tid < 128) msk[F.tid] = 0u;
        __syncthreads();
        int ngt = 0, neq = 0;
#pragma unroll
        for (int w = 0; w < 8; ++w) { ngt += red[w]; neq += red[8 + w]; }
        const bool all_eq = (ngt + neq == 256);
        for (int s = F.tid; s < n; s += NT) { const unsigned k = fkey(sc[s]); if (k > Tk || (all_eq && k == Tk)) atomicOr((unsigned*)&msk[s >> 5], 1u << (s & 31)); }
        __syncthreads();
        if (!all_eq && F.tid == 0) { int need = 256 - ngt; for (int s = 0; s < n && need > 0; ++s) if (fkey(sc[s]) == Tk) { msk[s >> 5] |= 1u << (s & 31); --need; } }
        __syncthreads();
        if (F.tid < 128) MASK[maskt_idx(m, F.tid)] = msk[F.tid];
        __syncthreads();
    }
}
__device__ __forceinline__ void attn_simple(Frame& F) {
    unsigned* MASK = (unsigned*)WSP(WS_MASK); bf16_t* PROJ = (bf16_t*)WSP(WS_BIG); bf16_t* Y = (bf16_t*)WSP(WS_Y);
    LAS unsigned* msk = (LAS unsigned*)F.lds; LAS int* sel = (LAS int*)(msk + 128); LAS float* lg = (LAS float*)(sel + 256); LAS int* nsel = (LAS int*)(lg + 4 * 256);
    for (int m = F.vcu; m < M; m += F.G) {
        const int t = m & (S - 1), b0 = m - t;
        if (F.tid < 128) msk[F.tid] = MASK[maskt_idx(m, F.tid)];
        __syncthreads();
        if (F.tid == 0) { int c = 0; for (int w = 0; w < 128; ++w) { unsigned bits = msk[w]; while (bits) { const int i = __builtin_ctz(bits); if (c < 256) sel[c] = 32 * w + i; ++c; bits &= bits - 1; } } nsel[0] = c < 256 ? c : 256; }
        __syncthreads();
        const int ns = nsel[0], h = F.wave & 3, part = F.wave >> 2;
        const float q = bf2f(PROJ[(size_t)m * PW + P_Q + h * 64 + F.lane]);
        for (int j = part; j < ns; j += 2) { const float d = wave_sum(q * bf2f(PROJ[(size_t)(b0 + sel[j]) * PW + P_K + h * 64 + F.lane])); if (F.lane == 0) lg[h * 256 + j] = d * 0.125f; }
        __syncthreads();
        if (F.wave < 4) {
            float mx = -INFINITY; for (int j = F.lane; j < ns; j += 64) mx = fmaxf(mx, lg[h * 256 + j]); mx = wave_max(mx);
            float sm = 0.f; for (int j = F.lane; j < ns; j += 64) sm += __expf(lg[h * 256 + j] - mx); sm = wave_sum(sm);
            float o = 0.f; for (int j = 0; j < ns; ++j) o = fmaf(__expf(lg[h * 256 + j] - mx), bf2f(PROJ[(size_t)(b0 + sel[j]) * PW + P_V + h * 64 + F.lane]), o);
            Y[(size_t)m * D + 256 + h * 64 + F.lane] = (bf16_t)f2bf(o / sm);
        }
        __syncthreads();
    }
}
__device__ __forceinline__ void mlstm1_simple(Frame& F, int l) {
    float* MISC = (float*)WSP(WS_MISC); float* STATE = (float*)WSP(WS_STATE); bf16_t* PROJ = (bf16_t*)WSP(WS_BIG); const float* i_bias = INP(I_I_BIAS); const float* f_bias = INP(I_F_BIAS);
    LAS float* bs = (LAS float*)F.lds; LAS float* ig = bs + 128; LAS float* wk = ig + 128; LAS float* kt = wk + 128; LAS float* vt = kt + 128 * 64;
    for (int item = F.vcu; item < 512; item += F.G) {
        const int bh = item >> 5, c = item & 31, b = bh >> 2, h = bh & 3, m0 = b * S + c * 128;
        if (F.tid < 128) { const float f = MISC[(size_t)(m0 + F.tid) * 16 + 12 + h] + f_bias[l * 4 + h]; bs[F.tid] = fminf(f, 0.f) - log1pf(__expf(-fabsf(f))); ig[F.tid] = MISC[(size_t)(m0 + F.tid) * 16 + 8 + h] + i_bias[l * 4 + h]; }
        for (int idx = F.tid; idx < 8192; idx += NT) { const int s = idx >> 6, d = idx & 63; kt[idx] = bf2f(PROJ[(size_t)(m0 + s) * PW + P_CK + h * 64 + d]); vt[idx] = bf2f(PROJ[(size_t)(m0 + s) * PW + P_CV + h * 64 + d]); }
        __syncthreads();
        if (F.tid == 0) { float a = 0.f; for (int s = 0; s < 128; ++s) { a += bs[s]; bs[s] = a; } }
        __syncthreads();
        const float B = bs[127];
        if (F.tid < 128) wk[F.tid] = __expf(B - bs[F.tid] + ig[F.tid]);
        __syncthreads();
        const int e = F.tid & 63, dq = F.tid >> 6; float acc[8];
#pragma unroll
        for (int i = 0; i < 8; ++i) acc[i] = 0.f;
        for (int s = 0; s < 128; ++s) { const float kv = wk[s] * vt[s * 64 + e];
#pragma unroll
            for (int i = 0; i < 8; ++i) acc[i] = fmaf(kt[s * 64 + dq * 8 + i], kv, acc[i]); }
        float* st = STATE + (size_t)item * STATE_STRIDE;
#pragma unroll
        for (int i = 0; i < 8; ++i) st[e * 64 + dq * 8 + i] = acc[i];
        if (F.tid < 64) { float a = 0.f; for (int s = 0; s < 128; ++s) a = fmaf(wk[s], kt[s * 64 + F.tid], a); st[4096 + F.tid] = a; }
        if (F.tid == 0) st[4160] = B;
        __syncthreads();
    }
}
__device__ __forceinline__ void mlstm2_simple(Frame& F, int l) {
    float* MISC = (float*)WSP(WS_MISC); float* STATE = (float*)WSP(WS_STATE); bf16_t* PROJ = (bf16_t*)WSP(WS_BIG); bf16_t* Y = (bf16_t*)WSP(WS_Y); const float* i_bias = INP(I_I_BIAS); const float* f_bias = INP(I_F_BIAS); const float* mnorm = INP(I_MNORM);
    LAS float* Cs = (LAS float*)F.lds; LAS float* ns = Cs + 4096; LAS float* bs = ns + 64; LAS float* ig = bs + 128; LAS float* A = ig + 128;
    LAS float* qt = A + 128 * 128; LAS float* kt = qt + 128 * 65;
    for (int item = F.vcu; item < 512; item += F.G) {
        const int bh = item >> 5, c = item & 31, b = bh >> 2, h = bh & 3, m0 = b * S + c * 128;
        { float Cv[8]; float nv = 0.f;
#pragma unroll
          for (int k = 0; k < 8; ++k) Cv[k] = 0.f;
          for (int cc = 0; cc < c; ++cc) { const float* st = STATE + (size_t)(bh * 32 + cc) * STATE_STRIDE; const float dec = __expf(st[4160]);
#pragma unroll
              for (int k = 0; k < 8; ++k) Cv[k] = fmaf(dec, Cv[k], st[F.tid + NT * k]);
              if (F.tid < 64) nv = fmaf(dec, nv, st[4096 + F.tid]); }
#pragma unroll
          for (int k = 0; k < 8; ++k) Cs[F.tid + NT * k] = Cv[k];
          if (F.tid < 64) ns[F.tid] = nv; }
        if (F.tid < 128) { const float f = MISC[(size_t)(m0 + F.tid) * 16 + 12 + h] + f_bias[l * 4 + h]; bs[F.tid] = fminf(f, 0.f) - log1pf(__expf(-fabsf(f))); ig[F.tid] = MISC[(size_t)(m0 + F.tid) * 16 + 8 + h] + i_bias[l * 4 + h]; }
        for (int idx = F.tid; idx < 8192; idx += NT) { const int s = idx >> 6, d = idx & 63; qt[s * 65 + d] = bf2f(PROJ[(size_t)(m0 + s) * PW + P_CQ + h * 64 + d]); kt[s * 65 + d] = bf2f(PROJ[(size_t)(m0 + s) * PW + P_CK + h * 64 + d]); }
        __syncthreads();
        if (F.tid == 0) { float a = 0.f; for (int s = 0; s < 128; ++s) { a += bs[s]; bs[s] = a; } }
        __syncthreads();
        { const int s = F.tid & 127, jq = F.tid >> 7;
          for (int j = jq; j < 128; j += 4) { float v = 0.f;
              if (s <= j) { float d = 0.f;
#pragma unroll 16
                  for (int k = 0; k < 64; ++k) d = fmaf(qt[j * 65 + k], kt[s * 65 + k], d);
                  v = __expf(bs[j] - bs[s] + ig[s]) * d; }
              A[j * 128 + s] = v; } }
        __syncthreads();
        LAS float* vt = kt;
        for (int idx = F.tid; idx < 8192; idx += NT) { const int s = idx >> 6, d = idx & 63; vt[idx] = bf2f(PROJ[(size_t)(m0 + s) * PW + P_CV + h * 64 + d]); }
        __syncthreads();
        const int e = F.lane; const float gn = mnorm[l * 256 + h * 64 + e];
        for (int j = F.wave; j < 128; j += 8) {
            float num = 0.f, qn = 0.f, sa = 0.f;
            for (int d = 0; d < 64; ++d) { const float qd = qt[j * 65 + d]; num = fmaf(qd, Cs[d * 64 + e], num); qn = fmaf(qd, ns[d], qn); }
            const float eb = __expf(bs[j]); num *= eb; qn *= eb;
            for (int s = 0; s <= j; ++s) { const float a = A[j * 128 + s]; num = fmaf(a, vt[s * 64 + e], num); sa += a; }
            const float hv = num / fmaxf(fabsf(qn + sa), 1.f);
            const float r = rsqrtf(wave_sum(hv * hv) * (1.f / 64.f) + EPS);
            const size_t row = (size_t)(m0 + j);
            Y[row * D + 512 + h * 64 + e] = (bf16_t)f2bf(sigmoid_f(bf2f(PROJ[row * PW + P_CO + h * 64 + e])) * hv * r * gn);
        }
        __syncthreads();
    }
}
typedef float f32x16 __attribute__((ext_vector_type(16)));
constexpr size_t WS_VT = WS_BIG + 120 * MiB;
constexpr float LOG2E = 1.4426950408889634f;

__device__ __forceinline__ void attn_mfma(Frame& F, int l) {
    const unsigned long long* MASKT = (const unsigned long long*)WSP(WS_MASK); const bf16_t* PROJ = (const bf16_t*)WSP(WS_BIG); const bf16_t* VT = (const bf16_t*)WSP(WS_VT);
    bf16_t* Y = (bf16_t*)WSP(WS_Y); const float* gt = (const float*)WSP(WS_GT) + l * 192;
    const int lane = F.lane, r32 = lane & 31, hi = lane >> 5, grp = F.wave >> 2, w4 = F.wave & 3, lg = F.tid & 255;
    const float mq = wave_max(fabsf(gt[lane])), mk = wave_max(fabsf(gt[64 + lane]));
    const float c1 = 0.125f * LOG2E, c2 = 8.f * mq * mk * 1.01f * LOG2E;
    constexpr int ROWB = 144, TILEB = 64 * ROWB;
    LAS unsigned char* gb = F.lds + grp * 4 * TILEB;
    LAS float* comb = (LAS float*)(F.lds + 8 * TILEB);
    const int srow0 = lg >> 3, sc0 = lg & 7;
    for (int item = F.vcu; item < 256; item += F.G) {
        const int bh = item >> 4, sidx = item & 15, b = bh >> 2, h = bh & 3;
#pragma unroll 1
        for (int half = 0; half < 2; ++half) {
            const int qb = half == 0 ? sidx : 31 - sidx, q0 = qb * 128, ntl = qb + 1;
            const int qrow = b * S + q0 + w4 * 32 + r32, tq = q0 + w4 * 32 + r32;
            bf16x8 qf[4];
#pragma unroll
            for (int s = 0; s < 4; ++s) qf[s] = *(const bf16x8*)(PROJ + (size_t)qrow * PW + P_Q + h * 64 + 16 * s + 8 * hi);
            f32x16 o0, o1;
#pragma unroll
            for (int r = 0; r < 16; ++r) { o0[r] = 0.f; o1[r] = 0.f; }
            float lsum = 0.f;
            const bf16_t* kbase = PROJ + (size_t)(b * S + srow0) * PW + P_K + h * 64 + sc0 * 8;
            const bf16_t* vbase = VT + (size_t)(b * 256 + h * 64 + srow0) * S + sc0 * 8;
            const unsigned long long* mbase = MASKT + (size_t)(b * 64) * S + tq;
            u32x4 ka0, ka1, va0, va1, kb0, kb1, vb0, vb1; unsigned long long mwa = 0ull, mwb = 0ull;
#define ATT_LOAD(K0, K1, V0, V1, MW, t_) do { const int t__ = (t_); K0 = *(const u32x4*)(kbase + (size_t)t__ * 64 * PW); K1 = *(const u32x4*)(kbase + (size_t)(t__ * 64 + 32) * PW); \
    V0 = *(const u32x4*)(vbase + t__ * 64); V1 = *(const u32x4*)(vbase + 32 * S + t__ * 64); MW = mbase[(size_t)t__ * S]; } while (0)
#define ATT_STORE(K0, K1, V0, V1, buf_) do { LAS unsigned char* kn_ = gb + (buf_) * 2 * TILEB; LAS unsigned char* vn_ = kn_ + TILEB; \
    *(LAS u32x4*)(kn_ + srow0 * ROWB + sc0 * 16) = K0; *(LAS u32x4*)(kn_ + (srow0 + 32) * ROWB + sc0 * 16) = K1; \
    *(LAS u32x4*)(vn_ + srow0 * ROWB + sc0 * 16) = V0; *(LAS u32x4*)(vn_ + (srow0 + 32) * ROWB + sc0 * 16) = V1; } while (0)
#define ATT_COMPUTE(cur_, MW) do { \
                const LAS unsigned char* kb = gb + (cur_) * 2 * TILEB; const LAS unsigned char* vb = kb + TILEB; \
                f32x16 p0, p1; \
                _Pragma("unroll") for (int r = 0; r < 16; ++r) { p0[r] = 0.f; p1[r] = 0.f; } \
                _Pragma("unroll") for (int s = 0; s < 4; ++s) { \
                    const bf16x8 k0 = *(const LAS bf16x8*)(kb + r32 * ROWB + 32 * s + 16 * hi), k1 = *(const LAS bf16x8*)(kb + (32 + r32) * ROWB + 32 * s + 16 * hi); \
                    p0 = __builtin_amdgcn_mfma_f32_32x32x16_bf16(k0, qf[s], p0, 0, 0, 0); p1 = __builtin_amdgcn_mfma_f32_32x32x16_bf16(k1, qf[s], p1, 0, 0, 0); } \
                const unsigned sh0 = (unsigned)(MW) >> (4 * hi), sh1 = (unsigned)((MW) >> 32) >> (4 * hi); \
                _Pragma("unroll") for (int r = 0; r < 16; ++r) { const int cb = (r & 3) + 8 * (r >> 2); \
                    const float e0 = __builtin_amdgcn_exp2f(p0[r] * c1 - c2), e1 = __builtin_amdgcn_exp2f(p1[r] * c1 - c2); \
                    p0[r] = __uint_as_float(__float_as_uint(e0) & (unsigned)__builtin_amdgcn_sbfe((int)sh0, cb, 1)); p1[r] = __uint_as_float(__float_as_uint(e1) & (unsigned)__builtin_amdgcn_sbfe((int)sh1, cb, 1)); lsum += p0[r] + p1[r]; } \
                _Pragma("unroll") for (int ks = 0; ks < 4; ++ks) { \
                    u32x4 pw; \
                    if (ks < 2) { pw.x = cvt_pk_bf16(p0[8 * ks + 0], p0[8 * ks + 1]); pw.y = cvt_pk_bf16(p0[8 * ks + 2], p0[8 * ks + 3]); pw.z = cvt_pk_bf16(p0[8 * ks + 4], p0[8 * ks + 5]); pw.w = cvt_pk_bf16(p0[8 * ks + 6], p0[8 * ks + 7]); } \
                    else { const int k2 = ks - 2; pw.x = cvt_pk_bf16(p1[8 * k2 + 0], p1[8 * k2 + 1]); pw.y = cvt_pk_bf16(p1[8 * k2 + 2], p1[8 * k2 + 3]); pw.z = cvt_pk_bf16(p1[8 * k2 + 4], p1[8 * k2 + 5]); pw.w = cvt_pk_bf16(p1[8 * k2 + 6], p1[8 * k2 + 7]); } \
                    const bf16x8 pf = __builtin_bit_cast(bf16x8, pw); \
                    const int vo = 64 * (ks >> 1) + 32 * (ks & 1) + 8 * hi; \
                    const u32x2 a0 = *(const LAS u32x2*)(vb + r32 * ROWB + vo), a1 = *(const LAS u32x2*)(vb + r32 * ROWB + vo + 16); \
                    const u32x2 b0 = *(const LAS u32x2*)(vb + (32 + r32) * ROWB + vo), b1 = *(const LAS u32x2*)(vb + (32 + r32) * ROWB + vo + 16); \
                    const u32x4 va = {a0.x, a0.y, a1.x, a1.y}, vb4 = {b0.x, b0.y, b1.x, b1.y}; \
                    o0 = __builtin_amdgcn_mfma_f32_32x32x16_bf16(__builtin_bit_cast(bf16x8, va), pf, o0, 0, 0, 0); \
                    o1 = __builtin_amdgcn_mfma_f32_32x32x16_bf16(__builtin_bit_cast(bf16x8, vb4), pf, o1, 0, 0, 0); } \
            } while (0)
            ATT_LOAD(ka0, ka1, va0, va1, mwa, grp);
            if (ntl > 1) ATT_LOAD(kb0, kb1, vb0, vb1, mwb, 2 + grp);
            ATT_STORE(ka0, ka1, va0, va1, 0);
            __syncthreads();
#pragma unroll 1
            for (int i = 0; i < ntl; i += 2) {
                const unsigned long long mw0 = mwa;
                if (i + 2 < ntl) ATT_LOAD(ka0, ka1, va0, va1, mwa, 2 * (i + 2) + grp);
                ATT_COMPUTE(0, mw0);
                if (i + 1 < ntl) ATT_STORE(kb0, kb1, vb0, vb1, 1);
                __syncthreads();
                if (i + 1 < ntl) {
                    const unsigned long long mw1 = mwb;
                    if (i + 3 < ntl) ATT_LOAD(kb0, kb1, vb0, vb1, mwb, 2 * (i + 3) + grp);
                    ATT_COMPUTE(1, mw1);
                    if (i + 2 < ntl) ATT_STORE(ka0, ka1, va0, va1, 0);
                    __syncthreads();
                }
            }
#undef ATT_LOAD
#undef ATT_STORE
#undef ATT_COMPUTE
            if (grp == 1) { LAS float* cw = comb + w4 * 33 * 64 + lane;
#pragma unroll
                for (int r = 0; r < 16; ++r) { cw[r * 64] = o0[r]; cw[(16 + r) * 64] = o1[r]; }
                cw[32 * 64] = lsum; }
            __syncthreads();
            if (grp == 0) { const LAS float* cw = comb + w4 * 33 * 64 + lane;
#pragma unroll
                for (int r = 0; r < 16; ++r) { o0[r] += cw[r * 64]; o1[r] += cw[(16 + r) * 64]; }
                lsum += cw[32 * 64]; lsum += __shfl_xor(lsum, 32); const float inv = 1.f / lsum;
                bf16_t* yp = Y + (size_t)qrow * D + 256 + h * 64 + 4 * hi;
#pragma unroll
                for (int g4 = 0; g4 < 4; ++g4) { u32x2 w0, w1;
                    w0.x = cvt_pk_bf16(o0[4 * g4] * inv, o0[4 * g4 + 1] * inv); w0.y = cvt_pk_bf16(o0[4 * g4 + 2] * inv, o0[4 * g4 + 3] * inv);
                    w1.x = cvt_pk_bf16(o1[4 * g4] * inv, o1[4 * g4 + 1] * inv); w1.y = cvt_pk_bf16(o1[4 * g4 + 2] * inv, o1[4 * g4 + 3] * inv);
                    *(u32x2*)(yp + 8 * g4) = w0; *(u32x2*)(yp + 32 + 8 * g4) = w1; } }
            __syncthreads();
        }
    }
}

constexpr size_t WS_KI = 234 * MiB;
template <int J, unsigned MSK>
__device__ __forceinline__ void tr_stage(unsigned (&a)[32]) {
#pragma unroll
    for (int k = 0; k < 32; ++k) if ((k & J) == 0) { const unsigned t = (a[k] ^ (a[k + J] >> J)) & MSK; a[k] ^= t; a[k + J] ^= (t << J); }
}
__device__ __forceinline__ void transpose32(unsigned (&a)[32]) {
    tr_stage<16, 0x0000FFFFu>(a); tr_stage<8, 0x00FF00FFu>(a); tr_stage<4, 0x0F0F0F0Fu>(a); tr_stage<2, 0x33333333u>(a); tr_stage<1, 0x55555555u>(a);
}
__device__ __forceinline__ int wave_total_i(int v) {
    v += __builtin_amdgcn_update_dpp(0, v, 0x111, 0xf, 0xf, false);
    v += __builtin_amdgcn_update_dpp(0, v, 0x112, 0xf, 0xf, false);
    v += __builtin_amdgcn_update_dpp(0, v, 0x114, 0xf, 0xf, false);
    v += __builtin_amdgcn_update_dpp(0, v, 0x118, 0xf, 0xf, false);
    v += __builtin_amdgcn_update_dpp(0, v, 0x142, 0xa, 0xf, false);
    v += __builtin_amdgcn_update_dpp(0, v, 0x143, 0xc, 0xf, false);
    return __builtin_amdgcn_readlane(v, 63);
}
__device__ __forceinline__ void indexer_mfma(Frame& F) {
    const float* MISC = (const float*)WSP(WS_MISC); unsigned long long* MASKT = (unsigned long long*)WSP(WS_MASK); const bf16_t* PROJ = (const bf16_t*)WSP(WS_BIG); const bf16_t* KI = (const bf16_t*)WSP(WS_KI);
    LAS float* sc = (LAS float*)F.lds;
    const int lane = F.lane, r32 = lane & 31, hi = lane >> 5, wv = F.wave;
    for (int pi = F.vcu; pi < 1024; pi += F.G) {
        const int b = pi >> 8, pp = pi & 255;
#pragma unroll 1
        for (int half = 0; half < 2; ++half) {
            const int t0 = 8 * (half == 0 ? pp : 511 - pp), m0 = b * S + t0, tq = t0 + wv;
            unsigned long long myword = 0ull;
            if (t0 + 8 <= 256) {
                const int lo = 64 * lane; myword = (tq >= lo + 63) ? ~0ull : (tq < lo ? 0ull : ((2ull << (tq - lo)) - 1ull));
                MASKT[(size_t)(b * 64 + lane) * S + tq] = myword;
                continue;
            }
            const int nmax = t0 + 8, ntile = (nmax + 31) >> 5;
            bf16x8 qa[2][4]; float wq[2][4][4];
#pragma unroll
            for (int i = 0; i < 2; ++i) {
                const bf16_t* qp = PROJ + (size_t)(m0 + 4 * i + (r32 >> 3)) * PW + P_QI + (r32 & 7) * 64 + 8 * hi;
#pragma unroll
                for (int s = 0; s < 4; ++s) qa[i][s] = *(const bf16x8*)(qp + 16 * s);
#pragma unroll
                for (int qq = 0; qq < 4; ++qq) { const f32x4 w4 = *(const f32x4*)(MISC + (size_t)(m0 + 4 * i + qq) * 16 + 4 * hi);
#pragma unroll
                    for (int e = 0; e < 4; ++e) wq[i][qq][e] = w4[e] * (0.125f * 0.35355339059327373f); }
            }
            bf16x8 kring[4][4];
#define IDX_LOADK(u_, j_) do { const int key_ = 32 * (j_) + r32; const int krow_ = key_ < nmax ? key_ : nmax - 1; const bf16_t* kp_ = KI + (size_t)(b * S + krow_) * 64 + 8 * hi; \
    _Pragma("unroll") for (int s_ = 0; s_ < 4; ++s_) kring[u_][s_] = *(const bf16x8*)(kp_ + 16 * s_); } while (0)
#pragma unroll
            for (int u = 0; u < 4; ++u) IDX_LOADK(u, wv + 8 * u);
            for (int jb = wv; jb < ntile; jb += 32) {
#pragma unroll
                for (int u = 0; u < 4; ++u) {
                    const int j = jb + 8 * u;
                    if (j < ntile) {
                        const int key = 32 * j + r32;
                        bf16x8 kb[4];
#pragma unroll
                        for (int s = 0; s < 4; ++s) kb[s] = kring[u][s];
                        IDX_LOADK(u, j + 32);
#pragma unroll
                        for (int i = 0; i < 2; ++i) {
                            f32x16 d;
#pragma unroll
                            for (int r = 0; r < 16; ++r) d[r] = 0.f;
#pragma unroll
                            for (int s = 0; s < 4; ++s) d = __builtin_amdgcn_mfma_f32_32x32x16_bf16(qa[i][s], kb[s], d, 0, 0, 0);
                            float part[4];
#pragma unroll
                            for (int qq = 0; qq < 4; ++qq) { float a = 0.f;
#pragma unroll
                                for (int e = 0; e < 4; ++e) a = fmaf(wq[i][qq][e], fmaxf(d[4 * qq + e], 0.f), a);
                                part[qq] = a; }
                            auto s01 = __builtin_amdgcn_permlane32_swap(__float_as_uint(part[0]), __float_as_uint(part[1]), false, false);
                            auto s23 = __builtin_amdgcn_permlane32_swap(__float_as_uint(part[2]), __float_as_uint(part[3]), false, false);
                            const float v01 = __uint_as_float(s01[0]) + __uint_as_float(s01[1]), v23 = __uint_as_float(s23[0]) + __uint_as_float(s23[1]);
                            const int qA = 4 * i + hi, qB = 4 * i + 2 + hi;
                            sc[qA * 4096 + key] = (key <= t0 + qA) ? v01 : -INFINITY;
                            sc[qB * 4096 + key] = (key <= t0 + qB) ? v23 : -INFINITY;
                        }
                    }
                }
            }
#undef IDX_LOADK
            __syncthreads();
            const int nvalid = 32 * ntile; const LAS float* srow = sc + wv * 4096 + lane;
            unsigned pa[32], pb[32];
#pragma unroll
            for (int r = 0; r < 32; ++r) { const float v = srow[64 * r]; pa[r] = fkey(v) & (unsigned)((64 * r + lane - nvalid) >> 31); }
            transpose32(pa);
            const bool two = nvalid > 2048;
            if (two) {
#pragma unroll
                for (int r = 0; r < 32; ++r) { const float v = srow[64 * (32 + r)]; pb[r] = fkey(v) & (unsigned)((64 * (32 + r) + lane - nvalid) >> 31); }
                transpose32(pb);
            } else {
#pragma unroll
                for (int r = 0; r < 32; ++r) pb[r] = 0u;
            }
            unsigned aA = ~0u, aB = ~0u, Tk = 0u; int base = 0;
#pragma unroll
            for (int bit = 31; bit >= 0; --bit) {
                const unsigned wa = pa[31 - bit], wb = pb[31 - bit];
                const int tot = wave_total_i(__builtin_popcount(wa & aA) + __builtin_popcount(wb & aB));
                const bool take = (base + tot >= 256);
                const unsigned flip = take ? 0u : ~0u;
                aA &= (wa ^ flip); aB &= (wb ^ flip);
                if (take) Tk |= (1u << bit); else base += tot;
            }
            const int ngt = base, neq = wave_total_i(__builtin_popcount(aA) + __builtin_popcount(aB));
            if (ngt + neq == 256) {
#pragma unroll
                for (int r = 0; r < 64; ++r) { const float v = srow[64 * r]; const unsigned k = fkey(v) & (unsigned)((64 * r + lane - nvalid) >> 31);
                    const unsigned long long wsel = __ballot(k >= Tk); if (lane == r) myword = wsel; }
            } else {
                int need = 256 - ngt;
#pragma unroll 1
                for (int r = 0; r < 64; ++r) { const float v = srow[64 * r]; const unsigned k = fkey(v) & (unsigned)((64 * r + lane - nvalid) >> 31);
                    unsigned long long wsel = __ballot(k > Tk), em = __ballot(k == Tk);
                    if (em != 0ull && need > 0) { int c = __builtin_popcountll(em); while (c > need) { em &= ~(1ull << (63 - __builtin_clzll(em))); --c; } need -= c; wsel |= em; }
                    if (lane == r) myword = wsel; }
            }
            MASKT[(size_t)(b * 64 + lane) * S + tq] = myword;
            __syncthreads();
        }
    }
}

constexpr size_t WS_CVT = 236 * MiB;
__device__ __forceinline__ void mlstm2_mfma(Frame& F, int l) {
    const float* MISC = (const float*)WSP(WS_MISC); const float* STATE = (const float*)WSP(WS_STATE); const bf16_t* PROJ = (const bf16_t*)WSP(WS_BIG); const bf16_t* CVT = (const bf16_t*)WSP(WS_CVT);
    bf16_t* Y = (bf16_t*)WSP(WS_Y); const float* i_bias = INP(I_I_BIAS); const float* f_bias = INP(I_F_BIAS); const float* mnorm = INP(I_MNORM);
    const int lane = F.lane, r32 = lane & 31, hi = lane >> 5, grp = F.wave >> 2, w4 = F.wave & 3, lg = F.tid & 255;
    constexpr int KROWB = 144, VROWB = 272, GB = 49152;
    LAS unsigned char* gb = F.lds + grp * GB;
    LAS float* bc = (LAS float*)gb;
    LAS float* gs = bc + 128;
    LAS float* npv = gs + 128;
    LAS float* wsum = npv + 64;
    LAS unsigned char* ct = gb + 2048;
    LAS unsigned char* kt = ct + 9216;
    LAS unsigned char* vt = kt + 18432;
    for (int it0 = 2 * F.vcu; it0 < 512; it0 += 2 * F.G) {
        const int item = it0 + grp, bh = item >> 5, c = item & 31, b = bh >> 2, h = bh & 3, m0 = b * S + c * 128;
        if (lg < 128) { const float f = MISC[(size_t)(m0 + lg) * 16 + 12 + h] + f_bias[l * 4 + h]; bc[lg] = fminf(f, 0.f) - log1pf(__expf(-fabsf(f))); gs[lg] = MISC[(size_t)(m0 + lg) * 16 + 8 + h] + i_bias[l * 4 + h]; }
        if (lg >= 128 && lg < 160) { const int cc = lg - 128; wsum[cc] = (cc < c) ? STATE[(size_t)(bh * 32 + cc) * STATE_STRIDE + 4160] : 0.f; }
        __syncthreads();
        if (lg < 64) {
            float a0 = bc[2 * lane], a1 = bc[2 * lane + 1]; float s = a0 + a1;
#pragma unroll
            for (int o = 1; o < 64; o <<= 1) { const float t = __shfl_up(s, o); if (lane >= o) s += t; }
            const float ex = s - (a0 + a1); const float i0 = gs[2 * lane], i1 = gs[2 * lane + 1];
            bc[2 * lane] = ex + a0; bc[2 * lane + 1] = s; gs[2 * lane] = i0 - (ex + a0); gs[2 * lane + 1] = i1 - s;
            float w = (lane < 32) ? wsum[lane] : 0.f; float suf = w;
#pragma unroll
            for (int o = 1; o < 32; o <<= 1) { const float t = __shfl_down(suf, o); if (lane + o < 32) suf += t; }
            if (lane < 32) wsum[lane] = suf - w;
        }
        __syncthreads();
        { f32x4 a4[4]; float nv = 0.f;
#pragma unroll
          for (int k = 0; k < 4; ++k) a4[k] = (f32x4){0.f, 0.f, 0.f, 0.f};
          for (int cc = 0; cc < c; ++cc) { const float* st = STATE + (size_t)(bh * 32 + cc) * STATE_STRIDE; const float wgt = __expf(wsum[cc]);
#pragma unroll
              for (int k = 0; k < 4; ++k) { const f32x4 v = *(const f32x4*)(st + 4 * (lg + 256 * k)); a4[k] = a4[k] + v * wgt; }
              if (lg < 64) nv = fmaf(wgt, st[4096 + lg], nv); }
#pragma unroll
          for (int k = 0; k < 4; ++k) { const int idx = 4 * (lg + 256 * k), e = idx >> 6, d = idx & 63; u32x2 w; w.x = cvt_pk_bf16(a4[k][0], a4[k][1]); w.y = cvt_pk_bf16(a4[k][2], a4[k][3]); *(LAS u32x2*)(ct + e * KROWB + d * 2) = w; }
          if (lg < 64) npv[lg] = nv; }
#pragma unroll
        for (int k = 0; k < 4; ++k) { const int id = lg + 256 * k, row = id >> 3, ch = id & 7;
            *(LAS u32x4*)(kt + row * KROWB + ch * 16) = *(const u32x4*)(PROJ + (size_t)(m0 + row) * PW + P_CK + h * 64 + ch * 8);
            const int vrow = id >> 4, vch = id & 15;
            *(LAS u32x4*)(vt + vrow * VROWB + vch * 16) = *(const u32x4*)(CVT + (size_t)(b * 256 + h * 64 + vrow) * S + c * 128 + vch * 8); }
        __syncthreads();
        const int j = 32 * w4 + r32, qrow = m0 + j;
        bf16x8 qf[4];
#pragma unroll
        for (int s = 0; s < 4; ++s) qf[s] = *(const bf16x8*)(PROJ + (size_t)qrow * PW + P_CQ + h * 64 + 16 * s + 8 * hi);
        const float bj = bc[j], eb = __expf(bj);
        float qn = 0.f;
#pragma unroll
        for (int s = 0; s < 4; ++s) { const u32x4 w = __builtin_bit_cast(u32x4, qf[s]); const LAS float* np = npv + 16 * s + 8 * hi;
            qn += lo_bf(w.x) * np[0] + hi_bf(w.x) * np[1] + lo_bf(w.y) * np[2] + hi_bf(w.y) * np[3] + lo_bf(w.z) * np[4] + hi_bf(w.z) * np[5] + lo_bf(w.w) * np[6] + hi_bf(w.w) * np[7]; }
        qn += __shfl_xor(qn, 32); qn *= eb;
        f32x16 n0, n1;
#pragma unroll
        for (int r = 0; r < 16; ++r) { n0[r] = 0.f; n1[r] = 0.f; }
#pragma unroll
        for (int ks = 0; ks < 4; ++ks) { const bf16x8 c0 = *(const LAS bf16x8*)(ct + r32 * KROWB + 32 * ks + 16 * hi), c1 = *(const LAS bf16x8*)(ct + (32 + r32) * KROWB + 32 * ks + 16 * hi);
            n0 = __builtin_amdgcn_mfma_f32_32x32x16_bf16(c0, qf[ks], n0, 0, 0, 0); n1 = __builtin_amdgcn_mfma_f32_32x32x16_bf16(c1, qf[ks], n1, 0, 0, 0); }
#pragma unroll
        for (int r = 0; r < 16; ++r) { n0[r] *= eb; n1[r] *= eb; }
        float sa = 0.f;
#pragma unroll 1
        for (int st = 0; st <= w4; ++st) {
            f32x16 p;
#pragma unroll
            for (int r = 0; r < 16; ++r) p[r] = 0.f;
#pragma unroll
            for (int ks = 0; ks < 4; ++ks) { const bf16x8 kf = *(const LAS bf16x8*)(kt + (32 * st + r32) * KROWB + 32 * ks + 16 * hi); p = __builtin_amdgcn_mfma_f32_32x32x16_bf16(kf, qf[ks], p, 0, 0, 0); }
#pragma unroll
            for (int r = 0; r < 16; ++r) { const int s = 32 * st + (r & 3) + 8 * (r >> 2) + 4 * hi; const float a = (s <= j) ? __expf(bj + gs[s]) * p[r] : 0.f; p[r] = a; sa += a; }
#pragma unroll
            for (int k2 = 0; k2 < 2; ++k2) {
                u32x4 pw; pw.x = cvt_pk_bf16(p[8 * k2 + 0], p[8 * k2 + 1]); pw.y = cvt_pk_bf16(p[8 * k2 + 2], p[8 * k2 + 3]); pw.z = cvt_pk_bf16(p[8 * k2 + 4], p[8 * k2 + 5]); pw.w = cvt_pk_bf16(p[8 * k2 + 6], p[8 * k2 + 7]);
                const bf16x8 pf = __builtin_bit_cast(bf16x8, pw);
                const int vo = (32 * st + 16 * k2 + 4 * hi) * 2;
                const u32x2 a0 = *(const LAS u32x2*)(vt + r32 * VROWB + vo), a1 = *(const LAS u32x2*)(vt + r32 * VROWB + vo + 16);
                const u32x2 b0 = *(const LAS u32x2*)(vt + (32 + r32) * VROWB + vo), b1 = *(const LAS u32x2*)(vt + (32 + r32) * VROWB + vo + 16);
                const u32x4 va = {a0.x, a0.y, a1.x, a1.y}, vb4 = {b0.x, b0.y, b1.x, b1.y};
                n0 = __builtin_amdgcn_mfma_f32_32x32x16_bf16(__builtin_bit_cast(bf16x8, va), pf, n0, 0, 0, 0);
                n1 = __builtin_amdgcn_mfma_f32_32x32x16_bf16(__builtin_bit_cast(bf16x8, vb4), pf, n1, 0, 0, 0);
            }
        }
        sa += __shfl_xor(sa, 32);
        const float inv = 1.f / fmaxf(fabsf(qn + sa), 1.f);
        float ss = 0.f;
#pragma unroll
        for (int r = 0; r < 16; ++r) { n0[r] *= inv; n1[r] *= inv; ss += n0[r] * n0[r] + n1[r] * n1[r]; }
        ss += __shfl_xor(ss, 32); const float rr = rsqrtf(ss * (1.f / 64.f) + EPS);
        const float* gp = mnorm + l * 256 + h * 64 + 4 * hi; const bf16_t* op = PROJ + (size_t)qrow * PW + P_CO + h * 64 + 4 * hi; bf16_t* yp = Y + (size_t)qrow * D + 512 + h * 64 + 4 * hi;
#pragma unroll
        for (int g4 = 0; g4 < 4; ++g4) {
            const f32x4 ga = *(const f32x4*)(gp + 8 * g4), gb4 = *(const f32x4*)(gp + 32 + 8 * g4);
            const u32x2 oa = *(const u32x2*)(op + 8 * g4), ob = *(const u32x2*)(op + 32 + 8 * g4);
            u32x2 w0, w1;
            w0.x = cvt_pk_bf16(sigmoid_f(lo_bf(oa.x)) * n0[4 * g4] * rr * ga[0], sigmoid_f(hi_bf(oa.x)) * n0[4 * g4 + 1] * rr * ga[1]);
            w0.y = cvt_pk_bf16(sigmoid_f(lo_bf(oa.y)) * n0[4 * g4 + 2] * rr * ga[2], sigmoid_f(hi_bf(oa.y)) * n0[4 * g4 + 3] * rr * ga[3]);
            w1.x = cvt_pk_bf16(sigmoid_f(lo_bf(ob.x)) * n1[4 * g4] * rr * gb4[0], sigmoid_f(hi_bf(ob.x)) * n1[4 * g4 + 1] * rr * gb4[1]);
            w1.y = cvt_pk_bf16(sigmoid_f(lo_bf(ob.y)) * n1[4 * g4 + 2] * rr * gb4[2], sigmoid_f(hi_bf(ob.y)) * n1[4 * g4 + 3] * rr * gb4[3]);
            *(u32x2*)(yp + 8 * g4) = w0; *(u32x2*)(yp + 32 + 8 * g4) = w1;
        }
        __syncthreads();
    }
}

constexpr size_t WS_SSQV = 244 * MiB;
__device__ __forceinline__ void sgu_mfma(Frame& F, int l) {
    const bf16_t* PROJ = (const bf16_t*)WSP(WS_BIG); bf16_t* Y = (bf16_t*)WSP(WS_Y); const float* SSQV = (const float*)WSP(WS_SSQV);
    const float* gain = INP(I_SGU_NORM) + l * 256; const float* sw = INP(I_SGU_W) + (size_t)l * 4 * 128 * 128; const float* sb = INP(I_SGU_B) + l * 4 * 128;
    const int lane = F.lane, r32 = lane & 31, hi = lane >> 5, dt = F.wave & 1, tt = F.wave >> 1;
    constexpr int VROWB = 272;
    LAS float* r_s = (LAS float*)F.lds;
    LAS unsigned char* vt = F.lds + 512;
    for (int item = F.vcu; item < 512; item += F.G) {
        const int g = item & 3, m0 = (item >> 2) * 128;
        if (F.tid < 128) { const f32x4 q = *(const f32x4*)(SSQV + (size_t)(m0 + F.tid) * 4); r_s[F.tid] = rsqrtf(((q[0] + q[1]) + (q[2] + q[3])) * (1.f / 256.f) + EPS); }
        __syncthreads();
#pragma unroll
        for (int k = 0; k < 2; ++k) { const int id = F.tid + 512 * k, s = id >> 3, d0 = (id & 7) * 8; const float rs = r_s[s];
            const u32x4 w = *(const u32x4*)(PROJ + (size_t)(m0 + s) * PW + P_AV + g * 64 + d0);
            const float v[8] = {lo_bf(w.x), hi_bf(w.x), lo_bf(w.y), hi_bf(w.y), lo_bf(w.z), hi_bf(w.z), lo_bf(w.w), hi_bf(w.w)};
#pragma unroll
            for (int i = 0; i < 8; ++i) *(LAS bf16_t*)(vt + (d0 + i) * VROWB + s * 2) = (bf16_t)f2bf(v[i] * rs); }
        __syncthreads();
        f32x16 acc;
#pragma unroll
        for (int r = 0; r < 16; ++r) acc[r] = 0.f;
        const int t = 32 * tt + r32; const float* wrow = sw + ((size_t)g * 128 + t) * 128;
#pragma unroll 1
        for (int ks = 0; ks < 2 * (tt + 1); ++ks) {
            const bf16x8 af = *(const LAS bf16x8*)(vt + (32 * dt + r32) * VROWB + (16 * ks + 8 * hi) * 2);
            const int s0 = 16 * ks + 8 * hi; const f32x4 w0 = *(const f32x4*)(wrow + s0), w1 = *(const f32x4*)(wrow + s0 + 4);
            u32x4 bw; bw.x = cvt_pk_bf16(s0 + 0 <= t ? w0[0] : 0.f, s0 + 1 <= t ? w0[1] : 0.f); bw.y = cvt_pk_bf16(s0 + 2 <= t ? w0[2] : 0.f, s0 + 3 <= t ? w0[3] : 0.f);
            bw.z = cvt_pk_bf16(s0 + 4 <= t ? w1[0] : 0.f, s0 + 5 <= t ? w1[1] : 0.f); bw.w = cvt_pk_bf16(s0 + 6 <= t ? w1[2] : 0.f, s0 + 7 <= t ? w1[3] : 0.f);
            acc = __builtin_amdgcn_mfma_f32_32x32x16_bf16(af, __builtin_bit_cast(bf16x8, bw), acc, 0, 0, 0);
        }
        const float bias = sb[g * 128 + t]; const size_t row = (size_t)(m0 + t);
        const float* gp = gain + g * 64 + 32 * dt + 4 * hi; const bf16_t* up = PROJ + row * PW + P_AU + g * 64 + 32 * dt + 4 * hi; bf16_t* yp = Y + row * D + g * 64 + 32 * dt + 4 * hi;
#pragma unroll
        for (int g4 = 0; g4 < 4; ++g4) { const f32x4 gv = *(const f32x4*)(gp + 8 * g4); const u32x2 uw = *(const u32x2*)(up + 8 * g4); u32x2 ow;
            ow.x = cvt_pk_bf16(lo_bf(uw.x) * (gv[0] * acc[4 * g4] + bias), hi_bf(uw.x) * (gv[1] * acc[4 * g4 + 1] + bias));
            ow.y = cvt_pk_bf16(lo_bf(uw.y) * (gv[2] * acc[4 * g4 + 2] + bias), hi_bf(uw.y) * (gv[3] * acc[4 * g4 + 3] + bias));
            *(u32x2*)(yp + 8 * g4) = ow; }
        __syncthreads();
    }
}

__device__ __forceinline__ void mlstm1_mfma(Frame& F, int l) {
    const float* MISC = (const float*)WSP(WS_MISC); float* STATE = (float*)WSP(WS_STATE); const bf16_t* PROJ = (const bf16_t*)WSP(WS_BIG); const bf16_t* CVT = (const bf16_t*)WSP(WS_CVT);
    const float* i_bias = INP(I_I_BIAS); const float* f_bias = INP(I_F_BIAS);
    const int lane = F.lane, r32 = lane & 31, hi = lane >> 5, grp = F.wave >> 2, w4 = F.wave & 3, et = w4 & 1, dt = w4 >> 1, lg = F.tid & 255;
    constexpr int KROWB = 144, GB = 20480;
    LAS unsigned char* gb = F.lds + grp * GB;
    LAS float* bc = (LAS float*)gb; LAS float* wk = bc + 128; LAS unsigned char* kt = gb + 1024;
    for (int it0 = 2 * F.vcu; it0 < 512; it0 += 2 * F.G) {
        const int item = it0 + grp, bh = item >> 5, c = item & 31, b = bh >> 2, h = bh & 3, m0 = b * S + c * 128;
        if (lg < 128) { const float f = MISC[(size_t)(m0 + lg) * 16 + 12 + h] + f_bias[l * 4 + h]; bc[lg] = fminf(f, 0.f) - log1pf(__expf(-fabsf(f))); wk[lg] = MISC[(size_t)(m0 + lg) * 16 + 8 + h] + i_bias[l * 4 + h]; }
        __syncthreads();
        if (lg < 64) { const float a0 = bc[2 * lane], a1 = bc[2 * lane + 1]; float s = a0 + a1;
#pragma unroll
            for (int o = 1; o < 64; o <<= 1) { const float t = __shfl_up(s, o); if (lane >= o) s += t; }
            const float tot = __shfl(s, 63), ex = s - (a0 + a1);
            wk[2 * lane] = __expf(tot - (ex + a0) + wk[2 * lane]); wk[2 * lane + 1] = __expf(tot - s + wk[2 * lane + 1]);
            if (lane == 0) bc[0] = tot; }
        __syncthreads();
        const float Bc = bc[0];
#pragma unroll
        for (int k = 0; k < 4; ++k) { const int id = lg + 256 * k, s = id >> 3, ch = id & 7; const float ws_ = wk[s];
            const u32x4 w = *(const u32x4*)(PROJ + (size_t)(m0 + s) * PW + P_CK + h * 64 + ch * 8); u32x4 o;
            o.x = cvt_pk_bf16(lo_bf(w.x) * ws_, hi_bf(w.x) * ws_); o.y = cvt_pk_bf16(lo_bf(w.y) * ws_, hi_bf(w.y) * ws_); o.z = cvt_pk_bf16(lo_bf(w.z) * ws_, hi_bf(w.z) * ws_); o.w = cvt_pk_bf16(lo_bf(w.w) * ws_, hi_bf(w.w) * ws_);
            *(LAS u32x4*)(kt + s * KROWB + ch * 16) = o; }
        __syncthreads();
        f32x16 acc;
#pragma unroll
        for (int r = 0; r < 16; ++r) acc[r] = 0.f;
        float nsum = 0.f;
        const bf16_t* vp = CVT + (size_t)(b * 256 + h * 64 + 32 * et + r32) * S + c * 128 + 8 * hi;
        bf16x8 af[8];
#pragma unroll
        for (int ks = 0; ks < 8; ++ks) af[ks] = *(const bf16x8*)(vp + 16 * ks);
#pragma unroll
        for (int ks = 0; ks < 8; ++ks) {
            const LAS unsigned char* kp = kt + (16 * ks + 8 * hi) * KROWB + (32 * dt + r32) * 2; unsigned e8[8];
#pragma unroll
            for (int jj = 0; jj < 8; ++jj) e8[jj] = *(const LAS bf16_t*)(kp + jj * KROWB);
            u32x4 bw; bw.x = e8[0] | (e8[1] << 16); bw.y = e8[2] | (e8[3] << 16); bw.z = e8[4] | (e8[5] << 16); bw.w = e8[6] | (e8[7] << 16);
#pragma unroll
            for (int jj = 0; jj < 8; ++jj) nsum += __uint_as_float(e8[jj] << 16);
            acc = __builtin_amdgcn_mfma_f32_32x32x16_bf16(af[ks], __builtin_bit_cast(bf16x8, bw), acc, 0, 0, 0);
        }
        float* st = STATE + (size_t)item * STATE_STRIDE;
#pragma unroll
        for (int r = 0; r < 16; ++r) st[(32 * et + (r & 3) + 8 * (r >> 2) + 4 * hi) * 64 + 32 * dt + r32] = acc[r];
        nsum += __shfl_xor(nsum, 32);
        if (et == 0 && hi == 0) st[4096 + 32 * dt + r32] = nsum;
        if (lg == 0) st[4160] = Bc;
        __syncthreads();
    }
}
#ifndef MK_MULTI
#define MK_MULTI 0
#endif
constexpr int N_PHASES = 1 + 10 * DEPTH;

__global__ void __launch_bounds__(NT, 2) mk_fwd(Args args) {
    extern __shared__ __attribute__((aligned(16))) unsigned char lds_raw[];
    Frame F;
    F.lds = (LAS unsigned char*)lds_raw; F.tid = threadIdx.x; F.lane = F.tid & 63; F.wave = __builtin_amdgcn_readfirstlane(F.tid >> 6);
    F.G = gridDim.x; { const int bx_ = blockIdx.x; F.vcu = (F.G % 8 == 0) ? (bx_ % 8) * (F.G / 8) + bx_ / 8 : bx_; }
    if (F.tid < 20) { const unsigned long long pv = F.tid < 18 ? (unsigned long long)args.in[F.tid < 18 ? F.tid : 0] : (F.tid == 18 ? (unsigned long long)args.out : (unsigned long long)args.ws);
        *(LAS unsigned long long*)(F.lds + PTR_OFF + 8 * F.tid) = pv; }
    if (F.tid < 2) *(LAS unsigned*)(F.lds + PTR_OFF + 256 + 4 * F.tid) = 0u;
    __syncthreads();
    XcdBarrier xbar; xbar.bar = (unsigned*)(args.ws + WS_BAR); xbar.x = 0; xbar.st = (volatile LAS unsigned*)(F.lds + PTR_OFF + 256);
    if (args.coop) xbar = xcd_barrier_post((unsigned*)(args.ws + WS_BAR), (volatile LAS unsigned*)(F.lds + PTR_OFF + 256));
    const int lo = args.ph_lo, hi = args.ph_hi; const bool coop = args.coop != 0;
#define RUN(k) (lo <= (k) && (k) < hi)
#define LAUNDER() asm volatile("" : "+v"(F.tid), "+v"(F.lane))
#define SEAM(k) do { if (coop && RUN(k) && RUN((k) + 1)) { if ((k) == 0) cg::this_grid().sync(); else xcd_barrier(xbar); } } while (0)
    const int bx = (int)blockIdx.x;

    if (RUN(0)) { LAUNDER(); convert_mix_weights(F, 0); prologue_rows(F);
        if (blockIdx.x == 0 && F.tid < DEPTH * 192) { const int l_ = F.tid / 192, r_ = F.tid % 192, w_ = r_ / 64, i_ = r_ % 64; ((float*)WSP(WS_GT))[F.tid] = INP(I_Q_NORM + w_)[l_ * 64 + i_]; } }
    SEAM(0);
#pragma unroll 1
    for (int l = 0; l < DEPTH; ++l) {
        const int pb = 1 + 10 * l;
        if (RUN(pb + 0)) { LAUNDER();
            pg8::Gemm<D, D, D, 256u * D * 2, 0, 256u * D * 2, 0> g{(const bf16_t*)WSP(WS_XG), (const bf16_t*)WSP(WS_WIN)};
            pg8::StaticOrder So; So.init(M, PW, F.G, bx);
            epi::EpiProj E{(bf16_t*)WSP(WS_BIG), (float*)WSP(WS_MISC), (const float*)WSP(WS_RSA), (const float*)WSP(WS_COS), (const float*)WSP(WS_SIN), (const float*)WSP(WS_GT) + l * 192, (bf16_t*)WSP(WS_VT), (bf16_t*)WSP(WS_KI), (bf16_t*)WSP(WS_CVT), (float*)WSP(WS_SSQV)};
            pg8::gemm_phase<epi::EpiProj, pg8::StaticOrder, true>(F.lds, g, So, E, F.tid);
        }
        SEAM(pb + 0);
        if (RUN(pb + 1)) { LAUNDER(); sgu_mfma(F, l); conv_simple(F, l); indexer_mfma(F); mlstm1_mfma(F, l); }
        SEAM(pb + 1);
        if (RUN(pb + 2)) { LAUNDER(); attn_mfma(F, l); mlstm2_mfma(F, l); }
        SEAM(pb + 2);
        if (RUN(pb + 3)) { LAUNDER();
            pg8::Gemm<256, D, 256, 256u * D * 2, 256u * 2, 256u * 256 * 2, 1024u * 256 * 2> g{(const bf16_t*)WSP(WS_Y), (const bf16_t*)WSP(WS_WBR)};
            pg8::SuperOrder<0> So; So.init(F.G, bx);
            epi::EpiPlain E{(bf16_t*)WSP(WS_BIG), 4096, 1024};
            pg8::gemm_phase<epi::EpiPlain, pg8::SuperOrder<0>, true>(F.lds, g, So, E, F.tid);
        }
        if (coop && RUN(pb + 3) && RUN(pb + 4)) { asm volatile("s_waitcnt vmcnt(0)" ::: "memory"); __syncthreads(); __builtin_amdgcn_fence(__ATOMIC_ACQUIRE, "agent"); asm volatile("s_waitcnt vmcnt(0)" ::: "memory"); __syncthreads(); }
        if (RUN(pb + 4)) { LAUNDER();
            pg8::Gemm<D, D, D, 256u * D * 2, 0, 256u * D * 2, 0> g{(const bf16_t*)WSP(WS_XG), (const bf16_t*)WSP(WS_WG)};
            pg8::SuperOrder<1> So; So.init(F.G, bx);
            epi::EpiGate E{(bf16_t*)WSP(WS_MG), (const bf16_t*)WSP(WS_BIG), (const float*)WSP(WS_RSA)};
            pg8::gemm_phase<epi::EpiGate, pg8::SuperOrder<1>, true>(F.lds, g, So, E, F.tid);
        }
        SEAM(pb + 4);
        if (RUN(pb + 5)) { LAUNDER();
            pg8::Gemm<D, D, D, 256u * D * 2, 0, 256u * D * 2, 0> g{(const bf16_t*)WSP(WS_MG), (const bf16_t*)WSP(WS_WOUT)};
            pg8::StaticOrder So; So.init(M, D, F.G, bx);
            float* outp = (float*)ptr_at(F, I_OUT); epi::EpiResid E{l == 0 ? INP(I_X) : (const float*)outp, outp, (bf16_t*)WSP(WS_XG), INP(I_LN_MLP) + l * D, (float*)WSP(WS_SSQB)};
            pg8::gemm_phase<epi::EpiResid, pg8::StaticOrder, true>(F.lds, g, So, E, F.tid);
            __syncthreads();
            convert_mlp_weights(F, l);
        }
        SEAM(pb + 5);
        if (RUN(pb + 6)) { LAUNDER(); finalize_rs(F, WS_SSQB, WS_RSB); }
        SEAM(pb + 6);
        if (RUN(pb + 7)) { LAUNDER();
            pg8::Gemm<D, D, D, 256u * D * 2, 0, 256u * D * 2, 0> g{(const bf16_t*)WSP(WS_XG), (const bf16_t*)WSP(WS_WUP)};
            pg8::StaticOrder So; So.init(M, FF, F.G, bx);
            epi::EpiUp E{(bf16_t*)WSP(WS_BIG), (const float*)WSP(WS_RSB)};
            pg8::gemm_phase<epi::EpiUp, pg8::StaticOrder, true>(F.lds, g, So, E, F.tid);
            if (l + 1 < DEPTH) { __syncthreads(); convert_mix_weights(F, l + 1); }
        }
        SEAM(pb + 7);
        if (RUN(pb + 8)) { LAUNDER();
            pg8::Gemm<FF, FF, FF, 256u * FF * 2, 0, 256u * FF * 2, 0> g{(const bf16_t*)WSP(WS_BIG), (const bf16_t*)WSP(WS_WDN)};
            pg8::StaticOrder So; So.init(M, D, F.G, bx);
            float* outp = (float*)ptr_at(F, I_OUT); epi::EpiResid E{(const float*)outp, outp, (bf16_t*)WSP(WS_XG), (l + 1 < DEPTH) ? INP(I_LN_MIX) + (l + 1) * D : nullptr, (float*)WSP(WS_SSQA)};
            pg8::gemm_phase<epi::EpiResid, pg8::StaticOrder, true>(F.lds, g, So, E, F.tid);
        }
        SEAM(pb + 8);
        if (RUN(pb + 9)) { LAUNDER(); if (l + 1 < DEPTH) finalize_rs(F, WS_SSQA, WS_RSA); }
        SEAM(pb + 9);
    }
#undef RUN
#undef SEAM
}

extern "C" void kernel_launch(void* const* d_in, const int* in_sizes, int n_in, void* d_out, int out_size, void* d_ws, size_t ws_size, hipStream_t stream) {
    static int grid = 0;
    if (grid == 0) {
        if (n_in != 18 || in_sizes[0] != M * D || out_size != M * D || ws_size < WS_END) { fprintf(stderr, "kernel_launch: unexpected shapes (n_in %d, in0 %d, out %d, ws %zu)\n", n_in, n_in > 0 ? in_sizes[0] : -1, out_size, ws_size); grid = -1; return; }
        int dev = 0, cus = 0, per_cu = 0;
        if (hipGetDevice(&dev) != hipSuccess || hipDeviceGetAttribute(&cus, hipDeviceAttributeMultiprocessorCount, dev) != hipSuccess) { grid = -1; return; }
        if (hipFuncSetAttribute((const void*)mk_fwd, hipFuncAttributeMaxDynamicSharedMemorySize, LDS_BYTES) != hipSuccess) { fprintf(stderr, "kernel_launch: hipFuncSetAttribute failed\n"); grid = -1; return; }
        if (hipOccupancyMaxActiveBlocksPerMultiprocessor(&per_cu, (const void*)mk_fwd, NT, LDS_BYTES) != hipSuccess || per_cu < 1) { fprintf(stderr, "kernel_launch: occupancy query says %d\n", per_cu); (void)hipGetLastError(); per_cu = 1; }
        grid = cus;
    }
    if (grid < 0) return;
    if (hipMemsetAsync((char*)d_ws + WS_CTL, 0, CTL_ZERO_BYTES, stream) != hipSuccess) { fprintf(stderr, "kernel_launch: memset failed\n"); return; }
    Args a{};
    for (int i = 0; i < 18; ++i) a.in[i] = (const float*)d_in[i];
    a.out = (float*)d_out; a.ws = (unsigned char*)d_ws;
#if MK_MULTI
    for (int p = 0; p < N_PHASES; ++p) { a.ph_lo = p; a.ph_hi = p + 1; a.coop = 0; hipLaunchKernelGGL(mk_fwd, dim3(grid), dim3(NT), LDS_BYTES, stream, a); }
#else
    a.ph_lo = 0; a.ph_hi = N_PHASES - 1; a.coop = 1;
    void* kargs[] = {&a};
    hipError_t e = hipLaunchCooperativeKernel((const void*)mk_fwd, dim3(grid), dim3(NT), kargs, LDS_BYTES, stream);
    if (e != hipSuccess) fprintf(stderr, "kernel_launch: cooperative launch failed: %s (grid %d)\n", hipGetErrorString(e), grid);
#endif
}
```

```cpp
#define MK_MULTI 0
#include <hip/hip_runtime.h>
#include <hip/hip_cooperative_groups.h>
#include <cstdio>
#include <cstdint>
namespace cg = cooperative_groups;

#define LAS __attribute__((address_space(3)))
typedef unsigned short bf16_t;
typedef short bf16x8 __attribute__((ext_vector_type(8)));
typedef float f32x4 __attribute__((ext_vector_type(4)));
typedef float f32x2 __attribute__((ext_vector_type(2)));
typedef unsigned u32x4 __attribute__((ext_vector_type(4)));
typedef unsigned u32x2 __attribute__((ext_vector_type(2)));

constexpr int D = 1024, NB = 4, S = 4096, M = NB * S, DEPTH = 2, FF = 4096, INW = 7760;
constexpr int O_AU = 0, O_AV = 256, O_BQ = 512, O_BK = 768, O_BV = 1024, O_QI = 1280, O_KI = 1792, O_WI = 1856,
              O_CQ = 1864, O_CK = 2120, O_CV = 2376, O_CO = 2632, O_CI = 2888, O_CF = 2892, O_DB = 2896, O_DC = 3152, O_DX = 3408, O_G = 3664;
constexpr int PW = 3840;
constexpr int P_AU = 0, P_AV = 256, P_Q = 512, P_K = 768, P_V = 1024, P_QI = 1280, P_CQ = 1792, P_CK = 2048, P_CV = 2304, P_CO = 2560,
              P_DB = 2816, P_DC = 3072, P_DX = 3328, P_KI = 3584;
constexpr float EPS = 1e-6f;
constexpr int NWAVES = 8, NT = 512;

constexpr size_t MiB = 1u << 20;
constexpr size_t WS_CTL = 0;
constexpr size_t WS_COS = 1 * MiB, WS_SIN = 1 * MiB + 512 * 1024;
constexpr size_t WS_MISC = 2 * MiB;
constexpr size_t WS_SSQA = 3 * MiB, WS_SSQB = 4 * MiB;
constexpr size_t WS_WIN = 5 * MiB;
constexpr size_t WS_WG = WS_WIN + (size_t)PW * D * 2;
constexpr size_t WS_WBR = WS_WG + (size_t)4096 * D * 2;
constexpr size_t WS_WOUT = WS_WBR + (size_t)4 * 1024 * 256 * 2;
constexpr size_t WS_XG = 25 * MiB;
constexpr size_t WS_BIG = 57 * MiB;
constexpr size_t WS_Y = 185 * MiB;
constexpr size_t WS_WUP = WS_Y, WS_WDN = WS_Y + 8 * MiB;
constexpr size_t WS_MG = 217 * MiB;
constexpr size_t WS_MASK = WS_MG, WS_STATE = WS_MG + 8 * MiB;
constexpr size_t WS_END = 249 * MiB;
constexpr int STATE_STRIDE = 4224;
static_assert(WS_WOUT + (size_t)D * D * 2 <= WS_XG && WS_STATE + (size_t)512 * STATE_STRIDE * 4 <= WS_END && WS_END <= 256 * MiB, "d_ws map");

constexpr int LDS_BYTES = 155648;

__device__ __forceinline__ float bf2f(bf16_t v) { return __uint_as_float((unsigned)v << 16); }
__device__ __forceinline__ unsigned f2bf(float f) { unsigned u = __float_as_uint(f); return (u + 0x7fffu + ((u >> 16) & 1u)) >> 16; }
__device__ __forceinline__ unsigned pk2(float lo, float hi) { return f2bf(lo) | (f2bf(hi) << 16); }
typedef __bf16 bf16x2_t __attribute__((ext_vector_type(2)));
__device__ __forceinline__ unsigned cvt_pk_bf16(float lo, float hi) { const f32x2 v = {lo, hi}; return __builtin_bit_cast(unsigned, __builtin_convertvector(v, bf16x2_t)); }
__device__ __forceinline__ float lo_bf(unsigned w) { return __uint_as_float(w << 16); }
__device__ __forceinline__ float hi_bf(unsigned w) { return __uint_as_float(w & 0xffff0000u); }
__device__ __forceinline__ float wave_sum(float v) {
#pragma unroll
    for (int o = 1; o < 64; o <<= 1) v += __shfl_xor(v, o);
    return v;
}
__device__ __forceinline__ float wave_max(float v) {
#pragma unroll
    for (int o = 1; o < 64; o <<= 1) v = fmaxf(v, __shfl_xor(v, o));
    return v;
}
__device__ __forceinline__ int wave_sum_i(int v) {
#pragma unroll
    for (int o = 1; o < 64; o <<= 1) v += __shfl_xor(v, o);
    return v;
}
__device__ __forceinline__ float sigmoid_f(float x) { return __builtin_amdgcn_rcpf(1.f + __builtin_amdgcn_exp2f(-1.4426950408889634f * x)); }
__device__ __forceinline__ float gelu_tanh_f(float x) { const float u = 0.7978845608028654f * (x + 0.044715f * x * x * x); return x * __builtin_amdgcn_rcpf(1.f + __builtin_amdgcn_exp2f(-2.8853900817779268f * u)); }
__device__ __forceinline__ unsigned fkey(float s) { const unsigned u = __float_as_uint(s); return (u & 0x80000000u) ? ~u : (u | 0x80000000u); }

namespace pg8 {
constexpr int BM = 256, BK = 64, HALF = 128, HTB = HALF * BK * 2, STAGE_BYTES = 8 * HTB, NXCD = 8, WGM = 8;
__host__ __device__ __forceinline__ int lds_byte(int r, int c) { const int st = (r >> 4) * 2 + (c >> 5), rr = r & 15, cc = c & 31, ob = rr * 64 + cc * 2; return st * 1024 + (ob ^ (((ob >> 9) & 1) << 5)); }
__host__ __device__ __forceinline__ void stage_rc(int b, int& R, int& C) { const int st = b / 1024, sb = b % 1024, swz = sb ^ (((sb >> 9) & 1) << 5); R = (st >> 1) * 16 + swz / 64; C = (st & 1) * 32 + (swz % 64) / 2; }
__host__ __device__ __forceinline__ int perm32(int rho) { const int n = rho >> 4, i = rho & 15; return 8 * (i >> 2) + 4 * n + (i & 3); }

struct Unit { int pm, pn, z; };
template <int K_, int LDA_, int LDB_, unsigned APM_, unsigned AZ_, unsigned BPN_, unsigned BZ_> struct Gemm {
    const bf16_t* A; const bf16_t* Bt;
    static constexpr int K = K_, lda = LDA_, ldb = LDB_; static constexpr unsigned aPm = APM_, aZ = AZ_, bPn = BPN_, bZ = BZ_;
};
template <class G> __device__ __forceinline__ const char* pa(const G& g, const Unit& u) { return (const char*)g.A + (size_t)((unsigned)u.pm * G::aPm + (unsigned)u.z * G::aZ); }
template <class G> __device__ __forceinline__ const char* pb(const G& g, const Unit& u) { return (const char*)g.Bt + (size_t)((unsigned)u.pn * G::bPn + (unsigned)u.z * G::bZ); }

struct StaticOrder {
    int nM, nN, nwg, G, c;
    __host__ __device__ void init(int M_, int N_, int G_, int c_) { nM = M_ / BM; nN = N_ / BM; nwg = nM * nN; G = G_; c = c_; }
    __host__ __device__ bool next(int i, Unit& u) const {
        const long L = (long)i * G + c; if (L >= nwg) return false;
        int wgid = (int)L; { const int q = nwg / NXCD, r = nwg % NXCD, xcd = wgid % NXCD, off = wgid / NXCD; wgid = (xcd < r ? xcd * (q + 1) : r * (q + 1) + (xcd - r) * q) + off; }
        const int nig = WGM * nN, gid = wgid / nig, fm = gid * WGM, gsz = (nM - fm) < WGM ? (nM - fm) : WGM;
        u.pm = fm + ((wgid % nig) % gsz); u.pn = (wgid % nig) / gsz; u.z = 0; return true;
    }
};
template <int MODE> struct SuperOrder {
    StaticOrder so;
    __host__ __device__ void init(int G_, int c_) { so.init(M, 1024, G_, c_); }
    __host__ __device__ bool next(int i, Unit& u) const {
        Unit b; if (!so.next(i >> 2, b)) return false;
        const int sub = i & 3; u.pm = b.pm; if (MODE == 0) { u.pn = b.pn; u.z = sub; } else { u.pn = 4 * b.pn + sub; u.z = 0; } return true;
    }
};

template <class Epi, class Sched, bool ALIGN_EPI, class GemmT>
__device__ __forceinline__ void gemm_phase(LAS unsigned char* lds, const GemmT g, const Sched& S, const Epi& E, const int tid) {
    const int wid = __builtin_amdgcn_readfirstlane(tid >> 6), lane = tid & 63, wr = wid >> 2, wc = wid & 3, fr = lane & 15, fq = lane >> 4;
    constexpr int K = GemmT::K, nt = K / BK;
    unsigned voffA[2], voffB[2];
#pragma unroll
    for (int i = 0; i < 2; ++i) { int R, C; stage_rc(tid * 16 + i * 8192, R, C); const int Rb = Epi::PERM ? ((R & ~31) + perm32(R & 31)) : R;
        voffA[i] = (unsigned)(R * GemmT::lda + C) * 2u; voffB[i] = (unsigned)(Rb * GemmT::ldb + C) * 2u; }
    const size_t kstep = (size_t)(BK * 2);
    constexpr size_t hA = (size_t)HALF * GemmT::lda * 2, hB = (size_t)HALF * GemmT::ldb * 2;
    const unsigned ldsw = (unsigned)wid * 1024u;
    const int aoff = lds_byte(wr * 64 + fr, fq * 8), boff = lds_byte(wc * 32 + fr, fq * 8);
#define PG8_SA(b, h) (((b) * 2 + (h)) * HTB)
#define PG8_SB(b, h) ((4 + (b) * 2 + (h)) * HTB)
#define PG8_STAGE(bufoff, gbase, voff) do { _Pragma("unroll") for (int _i = 0; _i < 2; ++_i) \
        __builtin_amdgcn_global_load_lds((const unsigned*)((const char*)(gbase) + (voff)[_i]), (LAS unsigned*)(lds + (bufoff) + ldsw + _i * 8192), 16, 0, 0); } while (0)
#define PG8_LDA(dst, b, h) do { _Pragma("unroll") for (int m = 0; m < 4; ++m) _Pragma("unroll") for (int k = 0; k < 2; ++k) dst[m][k] = *(const LAS bf16x8*)(lds + PG8_SA(b, h) + aoff + m * 2048 + k * 1024); } while (0)
#define PG8_LDB(dst, b, h) do { _Pragma("unroll") for (int n = 0; n < 2; ++n) _Pragma("unroll") for (int k = 0; k < 2; ++k) dst[n][k] = *(const LAS bf16x8*)(lds + PG8_SB(b, h) + boff + n * 2048 + k * 1024); } while (0)
#define PG8_MMA(ai, bj, At, Bt) do { __builtin_amdgcn_s_setprio(1); _Pragma("unroll") for (int m = 0; m < 4; ++m) _Pragma("unroll") for (int n = 0; n < 2; ++n) _Pragma("unroll") for (int k = 0; k < 2; ++k) \
        acc[ai][bj][m][n] = __builtin_amdgcn_mfma_f32_16x16x32_bf16(Bt[n][k], At[m][k], acc[ai][bj][m][n], 0, 0, 0); __builtin_amdgcn_s_setprio(0); } while (0)
#define PG8_WAIT_V(n) asm volatile("s_waitcnt vmcnt(" #n ")" ::: "memory")
#define PG8_WAIT_L(n) asm volatile("s_waitcnt lgkmcnt(" #n ")" ::: "memory")
#define PG8_BAR __builtin_amdgcn_s_barrier()
#define PG8_SCHED __builtin_amdgcn_sched_barrier(0)
    Unit cur, nxt; int ui = 0;
    if (!S.next(0, cur)) return;
    f32x4 acc[2][2][4][2];
#pragma unroll
    for (int a = 0; a < 2; ++a)
#pragma unroll
        for (int b = 0; b < 2; ++b)
#pragma unroll
            for (int m = 0; m < 4; ++m)
#pragma unroll
                for (int n = 0; n < 2; ++n) acc[a][b][m][n] = (f32x4){0.f, 0.f, 0.f, 0.f};
    bf16x8 At[4][2], B0[2][2], B1[2][2];
    const char* cA = pa(g, cur); const char* cB = pb(g, cur);
    PG8_STAGE(PG8_SB(0, 0), cB, voffB); PG8_STAGE(PG8_SB(0, 1), cB + hB, voffB); PG8_STAGE(PG8_SA(0, 0), cA, voffA); PG8_STAGE(PG8_SA(0, 1), cA + hA, voffA);
    if (wr == 1) PG8_BAR;
    PG8_WAIT_V(2); PG8_BAR;
    PG8_STAGE(PG8_SB(1, 0), cB + kstep, voffB); PG8_STAGE(PG8_SA(1, 0), cA + kstep, voffA); PG8_STAGE(PG8_SB(1, 1), cB + hB + kstep, voffB);
    PG8_WAIT_V(6); PG8_BAR;
    for (;;) {
        const bool has_next = S.next(ui + 1, nxt);
        const char* nA = has_next ? pa(g, nxt) : cA; const char* nB = has_next ? pb(g, nxt) : cB;
#pragma unroll 1
        for (int t = 0; t < nt; t += 2) {
            const bool last = (t == nt - 2);
            const char* a1 = cA + (size_t)(t + 1) * kstep;
            const char* a2 = last ? nA : cA + (size_t)(t + 2) * kstep; const char* b2 = last ? nB : cB + (size_t)(t + 2) * kstep;
            const char* a3 = a2 + kstep; const char* b3 = b2 + kstep;
            PG8_LDB(B0, 0, 0); PG8_LDB(B1, 0, 1); PG8_SCHED; PG8_LDA(At, 0, 0); PG8_STAGE(PG8_SA(1, 1), a1 + hA, voffA);
            PG8_WAIT_V(8); PG8_WAIT_L(0); PG8_BAR; PG8_MMA(0, 0, At, B0); PG8_MMA(0, 1, At, B1); PG8_BAR; PG8_SCHED;
            PG8_LDA(At, 0, 1); PG8_STAGE(PG8_SB(0, 0), b2, voffB); PG8_STAGE(PG8_SB(0, 1), b2 + hB, voffB); PG8_STAGE(PG8_SA(0, 0), a2, voffA);
            PG8_WAIT_V(8); PG8_WAIT_L(0); PG8_BAR; PG8_MMA(1, 0, At, B0); PG8_MMA(1, 1, At, B1); PG8_BAR; PG8_SCHED;
            PG8_LDB(B0, 1, 0); PG8_LDB(B1, 1, 1); PG8_SCHED; PG8_LDA(At, 1, 0); PG8_STAGE(PG8_SA(0, 1), a2 + hA, voffA);
            PG8_WAIT_V(8); PG8_WAIT_L(0); PG8_BAR; PG8_MMA(0, 0, At, B0); PG8_MMA(0, 1, At, B1); PG8_BAR; PG8_SCHED;
            PG8_LDA(At, 1, 1); PG8_STAGE(PG8_SB(1, 0), b3, voffB); PG8_STAGE(PG8_SB(1, 1), b3 + hB, voffB); PG8_STAGE(PG8_SA(1, 0), a3, voffA);
            PG8_WAIT_V(8); PG8_WAIT_L(0); PG8_BAR; PG8_MMA(1, 0, At, B0); PG8_MMA(1, 1, At, B1); PG8_BAR; PG8_SCHED;
        }
        if constexpr (ALIGN_EPI) { if (wr == 0) PG8_BAR; }
        { int fr2 = fr, fq2 = fq; asm volatile("" : "+v"(fr2), "+v"(fq2)); E(acc, cur, wr, wc, fr2, fq2); }
        if (!has_next) break;
#pragma unroll
        for (int a = 0; a < 2; ++a)
#pragma unroll
            for (int b = 0; b < 2; ++b)
#pragma unroll
                for (int m = 0; m < 4; ++m)
#pragma unroll
                    for (int n = 0; n < 2; ++n) acc[a][b][m][n] = (f32x4){0.f, 0.f, 0.f, 0.f};
        cur = nxt; cA = nA; cB = nB; ++ui;
        if constexpr (ALIGN_EPI) { if (wr == 1) PG8_BAR; }
    }
    PG8_WAIT_V(0);
    if constexpr (!ALIGN_EPI) { if (wr == 0) PG8_BAR; }
    PG8_BAR;
#undef PG8_SA
#undef PG8_SB
#undef PG8_STAGE
#undef PG8_LDA
#undef PG8_LDB
#undef PG8_MMA
#undef PG8_WAIT_V
#undef PG8_WAIT_L
#undef PG8_BAR
#undef PG8_SCHED
}
}
namespace epi {
using pg8::Unit;
typedef f32x4 Acc[2][2][4][2];

__device__ __forceinline__ float row_scale(const float* rs, int row) { return rs[row]; }
__device__ __forceinline__ u32x4 pack8(const f32x4 a, const f32x4 b) { u32x4 w; w.x = cvt_pk_bf16(a[0], a[1]); w.y = cvt_pk_bf16(a[2], a[3]); w.z = cvt_pk_bf16(b[0], b[1]); w.w = cvt_pk_bf16(b[2], b[3]); return w; }

struct EpiProj {
    static constexpr bool PERM = true;
    bf16_t* P; float* misc; const float* ssq; const float* cs; const float* sn; const float* gt;     bf16_t* VT;     bf16_t* KI;     bf16_t* CVT;     float* ssqv;
    __device__ __forceinline__ void operator()(const Acc& acc, const Unit& u, int wr, int wc, int fr, int fq) const {
        const int T = u.pn; const int row0 = u.pm * 256 + wr * 64 + fr;
        if (T == 2 || T == 3 || T == 5 || T == 6 || T == 14) {
            if (T == 14 && wc >= 2) return;
            if (T == 14 && wc == 1) {
                if (fq < 2) {
#pragma unroll
                    for (int ai = 0; ai < 2; ++ai)
#pragma unroll
                        for (int m = 0; m < 4; ++m) { const int row = row0 + ai * 128 + m * 16; const float rs = row_scale(ssq, row);
                            float* mp = misc + (size_t)row * 16 + 8 * fq; *(f32x4*)mp = acc[ai][0][m][0] * rs; *(f32x4*)(mp + 4) = acc[ai][0][m][1] * rs; }
                }
                return;
            }
            const int mode = (T == 14) ? 2 : (T <= 3 ? 1 : 0);
            const float* gp = gt + 64 * ((T == 2) ? 0 : (T == 3) ? 1 : 2);
            f32x4 g1[2], g2[2];
#pragma unroll
            for (int n = 0; n < 2; ++n) { if (mode) { g1[n] = *(const f32x4*)(gp + 8 * fq + 4 * n); g2[n] = *(const f32x4*)(gp + 32 + 8 * fq + 4 * n); } else { g1[n] = (f32x4){1.f, 1.f, 1.f, 1.f}; g2[n] = g1[n]; } }
#pragma unroll
            for (int ai = 0; ai < 2; ++ai)
#pragma unroll
                for (int m = 0; m < 4; ++m) {
                    const int row = row0 + ai * 128 + m * 16; const float rs = row_scale(ssq, row); const int pos = row & (S - 1);
                    f32x4 x1[2], x2[2];
#pragma unroll
                    for (int n = 0; n < 2; ++n) { x1[n] = acc[ai][0][m][n] * rs; x2[n] = acc[ai][1][m][n] * rs; }
                    if (mode == 2) {
                        float s = 0.f;
#pragma unroll
                        for (int n = 0; n < 2; ++n) s += (x1[n][0] + x1[n][1]) + (x1[n][2] + x1[n][3]) + (x2[n][0] + x2[n][1]) + (x2[n][2] + x2[n][3]);
                        s += __shfl_xor(s, 16); s += __shfl_xor(s, 32); const float mu = s * (1.f / 64.f);
#pragma unroll
                        for (int n = 0; n < 2; ++n) { x1[n] = x1[n] - mu; x2[n] = x2[n] - mu; }
                    }
                    if (mode) {
                        float q = 0.f;
#pragma unroll
                        for (int n = 0; n < 2; ++n) { const f32x4 a = x1[n] * x1[n], b = x2[n] * x2[n]; q += (a[0] + a[1]) + (a[2] + a[3]) + (b[0] + b[1]) + (b[2] + b[3]); }
                        q += __shfl_xor(q, 16); q += __shfl_xor(q, 32); const float rr = rsqrtf(q * (1.f / 64.f) + EPS);
#pragma unroll
                        for (int n = 0; n < 2; ++n) { x1[n] = x1[n] * rr * g1[n]; x2[n] = x2[n] * rr * g2[n]; }
                    }
                    f32x4 o1[2], o2[2];
#pragma unroll
                    for (int n = 0; n < 2; ++n) { const f32x4 c = *(const f32x4*)(cs + (size_t)pos * 32 + 8 * fq + 4 * n), s = *(const f32x4*)(sn + (size_t)pos * 32 + 8 * fq + 4 * n);
                        o1[n] = x1[n] * c - x2[n] * s; o2[n] = x2[n] * c + x1[n] * s; }
                    bf16_t* op = P + (size_t)row * PW + 256 * T + 64 * wc + 8 * fq;
                    *(u32x4*)op = pack8(o1[0], o1[1]); *(u32x4*)(op + 32) = pack8(o2[0], o2[1]);
                    if (T == 14) { bf16_t* kp = KI + (size_t)row * 64 + 8 * fq; *(u32x4*)kp = pack8(o1[0], o1[1]); *(u32x4*)(kp + 32) = pack8(o2[0], o2[1]); }
                }
            return;
        }
        const int act = (T <= 1) ? 1 : 0; const float sc = (T == 8) ? 0.125f : 1.0f;
#pragma unroll
        for (int ai = 0; ai < 2; ++ai)
#pragma unroll
            for (int m = 0; m < 4; ++m) {
                const int row = row0 + ai * 128 + m * 16; const float rs = row_scale(ssq, row) * sc;
                bf16_t* op = P + (size_t)row * PW + 256 * T + 32 * wc + 8 * fq; float qv = 0.f;
#pragma unroll
                for (int bj = 0; bj < 2; ++bj) { f32x4 v0 = acc[ai][bj][m][0] * rs, v1 = acc[ai][bj][m][1] * rs;
                    if (act) {
#pragma unroll
                        for (int e = 0; e < 4; ++e) { v0[e] = gelu_tanh_f(v0[e]); v1[e] = gelu_tanh_f(v1[e]); }
                        const f32x4 a2 = v0 * v0, b2 = v1 * v1; qv += ((a2[0] + a2[1]) + (a2[2] + a2[3])) + ((b2[0] + b2[1]) + (b2[2] + b2[3])); }
                    *(u32x4*)(op + bj * 128) = pack8(v0, v1);
                    if (T == 4 || T == 9) { bf16_t* vp = (T == 4 ? VT : CVT) + ((size_t)((row >> 12) * 256 + bj * 128 + 32 * wc + 8 * fq)) * S + (row & (S - 1));
#pragma unroll
                        for (int e = 0; e < 4; ++e) { vp[(size_t)e * S] = (bf16_t)f2bf(v0[e]); vp[(size_t)(4 + e) * S] = (bf16_t)f2bf(v1[e]); } } }
                if (T == 1) { qv += __shfl_xor(qv, 16); qv += __shfl_xor(qv, 32); if (fq == 0) ssqv[(size_t)row * 4 + wc] = qv; }
            }
    }
};

struct EpiPlain {
    static constexpr bool PERM = true;
    bf16_t* O; int ldc; int zcols;
    __device__ __forceinline__ void operator()(const Acc& acc, const Unit& u, int wr, int wc, int fr, int fq) const {
        const int row0 = u.pm * 256 + wr * 64 + fr; const int col0 = u.z * zcols + u.pn * 256 + 32 * wc + 8 * fq;
#pragma unroll
        for (int ai = 0; ai < 2; ++ai)
#pragma unroll
            for (int m = 0; m < 4; ++m) { bf16_t* op = O + (size_t)(row0 + ai * 128 + m * 16) * ldc + col0;
#pragma unroll
                for (int bj = 0; bj < 2; ++bj) *(u32x4*)(op + bj * 128) = pack8(acc[ai][bj][m][0], acc[ai][bj][m][1]); }
    }
};

struct EpiGate {
    static constexpr bool PERM = true;
    bf16_t* MG; const bf16_t* BR; const float* ssq;
    __device__ __forceinline__ void operator()(const Acc& acc, const Unit& u, int wr, int wc, int fr, int fq) const {
        const int row0 = u.pm * 256 + wr * 64 + fr; const int ch0 = u.pn * 64 + 16 * wc + 4 * fq;
#pragma unroll
        for (int ai = 0; ai < 2; ++ai)
#pragma unroll
            for (int m = 0; m < 4; ++m) {
                const int row = row0 + ai * 128 + m * 16; const float rs = row_scale(ssq, row);
                const bf16_t* bp = BR + (size_t)row * 4096 + ch0; f32x4 o = (f32x4){0.f, 0.f, 0.f, 0.f};
#pragma unroll
                for (int bj = 0; bj < 2; ++bj)
#pragma unroll
                    for (int n = 0; n < 2; ++n) { const u32x2 w = *(const u32x2*)(bp + (2 * bj + n) * 1024); const f32x4 a = acc[ai][bj][m][n] * rs;
                        o[0] += sigmoid_f(a[0]) * lo_bf(w.x); o[1] += sigmoid_f(a[1]) * hi_bf(w.x); o[2] += sigmoid_f(a[2]) * lo_bf(w.y); o[3] += sigmoid_f(a[3]) * hi_bf(w.y); }
                u32x2 ow; ow.x = cvt_pk_bf16(o[0], o[1]); ow.y = cvt_pk_bf16(o[2], o[3]);
                *(u32x2*)(MG + (size_t)row * 1024 + ch0) = ow;
            }
    }
};

struct EpiResid {
    static constexpr bool PERM = true;
    const float* resf; bf16_t* X; float* outf; float* ssq;
    __device__ __forceinline__ void operator()(const Acc& acc, const Unit& u, int wr, int wc, int fr, int fq) const {
        const int row0 = u.pm * 256 + wr * 64 + fr; const int col0 = u.pn * 256 + 32 * wc + 8 * fq;
#pragma unroll
        for (int ai = 0; ai < 2; ++ai)
#pragma unroll
            for (int m = 0; m < 4; ++m) {
                const int row = row0 + ai * 128 + m * 16; const size_t off = (size_t)row * 1024 + col0; float q = 0.f;
#pragma unroll
                for (int bj = 0; bj < 2; ++bj) {
                    f32x4 r0, r1;
                    if (resf) { r0 = *(const f32x4*)(resf + off + bj * 128); r1 = *(const f32x4*)(resf + off + bj * 128 + 4); }
                    else { const u32x4 w = *(const u32x4*)(X + off + bj * 128); r0 = (f32x4){lo_bf(w.x), hi_bf(w.x), lo_bf(w.y), hi_bf(w.y)}; r1 = (f32x4){lo_bf(w.z), hi_bf(w.z), lo_bf(w.w), hi_bf(w.w)}; }
                    const f32x4 x0 = r0 + acc[ai][bj][m][0], x1 = r1 + acc[ai][bj][m][1];
                    if (outf) { *(f32x4*)(outf + off + bj * 128) = x0; *(f32x4*)(outf + off + bj * 128 + 4) = x1; }
                    else {
                        const f32x4 a = x0 * x0, b = x1 * x1; q += ((a[0] + a[1]) + (a[2] + a[3])) + ((b[0] + b[1]) + (b[2] + b[3]));
                        *(u32x4*)(X + off + bj * 128) = pack8(x0, x1); }
                }
                if (!outf) { q += __shfl_xor(q, 16); q += __shfl_xor(q, 32); if (fq == 0) ssq[(size_t)row * 16 + 4 * u.pn + wc] = q; }
            }
    }
};

struct EpiUp {
    static constexpr bool PERM = true;
    bf16_t* H; const float* ssq;
    __device__ __forceinline__ void operator()(const Acc& acc, const Unit& u, int wr, int wc, int fr, int fq) const {
        const int row0 = u.pm * 256 + wr * 64 + fr; const int col0 = u.pn * 256 + 32 * wc + 8 * fq;
#pragma unroll
        for (int ai = 0; ai < 2; ++ai)
#pragma unroll
            for (int m = 0; m < 4; ++m) { const int row = row0 + ai * 128 + m * 16; const float rs = row_scale(ssq, row); bf16_t* op = H + (size_t)row * FF + col0;
#pragma unroll
                for (int bj = 0; bj < 2; ++bj) { f32x4 v0 = acc[ai][bj][m][0] * rs, v1 = acc[ai][bj][m][1] * rs;
#pragma unroll
                    for (int e = 0; e < 4; ++e) { v0[e] = fmaxf(v0[e], 0.f); v1[e] = fmaxf(v1[e], 0.f); }
                    *(u32x4*)(op + bj * 128) = pack8(v0 * v0, v1 * v1); } }
    }
};
}
struct Args {
    const float* in[18]; float* out; unsigned char* ws; int ph_lo, ph_hi; int coop, pad;
};
struct Frame { LAS unsigned char* lds; int tid, lane, wave, G, vcu; };
constexpr int PTR_OFF = LDS_BYTES - 512;
enum { I_X = 0, I_LN_MIX, I_W_IN, I_SGU_NORM, I_SGU_W, I_SGU_B, I_Q_NORM, I_K_NORM, I_KIDX_NORM, I_I_BIAS, I_F_BIAS, I_MNORM, I_CONV_W, I_W_BRANCH, I_W_OUT, I_LN_MLP, I_W_UP, I_W_DOWN, I_OUT, I_WS };
__device__ __forceinline__ unsigned char* ptr_at(const Frame& F, int i) { const LAS unsigned* p = (const LAS unsigned*)(F.lds + PTR_OFF) + 2 * i;
    const unsigned lo = __builtin_amdgcn_readfirstlane(p[0]), hi = __builtin_amdgcn_readfirstlane(p[1]);
    typedef __attribute__((address_space(1))) unsigned char* gptr_t;
    return (unsigned char*)(gptr_t)(((unsigned long long)hi << 32) | lo); }
#define INP(i) ((const float*)ptr_at(F, (i)))
#define WSP(off) (ptr_at(F, I_WS) + (off))
constexpr size_t WS_GT = 512 * 1024;
constexpr size_t WS_RSA = 256 * 1024, WS_RSB = 320 * 1024;
__device__ __forceinline__ size_t maskt_idx(int m, int w) { const int b = m >> 12, t = m & (S - 1); return ((size_t)(b * 64 + (w >> 1)) * S + t) * 2 + (w & 1); }


#define XB_TMO      128
#define XB_XCNT(j)  (256  + 64 * (j))
#define XB_XSUB(j)  (1280 + 64 * (j))
#define XB_XGEN(j)  (2304 + 64 * (j))
#define XB_TOP      3328
#define XB_TOPGEN   3392
#define XCD_BAR_WORDS 3456
#define XB_SPIN_CAP (1u << 22)
constexpr size_t WS_BAR = 64 * 1024;
constexpr size_t CTL_ZERO_BYTES = 128 * 1024;
__device__ __forceinline__ unsigned xb_ld(unsigned* p)              { return __hip_atomic_load(p, __ATOMIC_RELAXED, __HIP_MEMORY_SCOPE_AGENT); }
__device__ __forceinline__ unsigned xb_add(unsigned* p, unsigned v) { return __hip_atomic_fetch_add(p, v, __ATOMIC_RELAXED, __HIP_MEMORY_SCOPE_AGENT); }
__device__ __forceinline__ unsigned xb_xcc_id() { return (unsigned)__builtin_amdgcn_s_getreg((3 << 11) | 20) & 0xFu; }
#define XB_SPIN(cond, bar) do { unsigned _sp = 0; while (cond) { __builtin_amdgcn_s_sleep(1); \
    if ((++_sp & 255u) == 0u) { if (xb_ld(&(bar)[XB_TMO])) break; if (_sp > XB_SPIN_CAP) { atomicAdd(&(bar)[XB_TMO], 1u); break; } } } } while (0)
struct XcdBarrier { unsigned* bar; unsigned x; volatile LAS unsigned* st; };
__device__ __forceinline__ XcdBarrier xcd_barrier_post(unsigned* bar, volatile LAS unsigned* st) {
    XcdBarrier b; b.bar = bar; b.x = xb_xcc_id(); b.st = st;
    if (threadIdx.x == 0) (void)xb_add(&bar[XB_XCNT(b.x)], 1u);
    return b;
}
__device__ __forceinline__ void xcd_barrier_complete(unsigned* bar, unsigned x, unsigned& nloc, unsigned& nx) {
    const unsigned G = gridDim.x * gridDim.y * gridDim.z;
    unsigned sum, cnt, mine, sp = 0u;
    for (;;) {
        sum = 0u; cnt = 0u; mine = 0u;
#pragma unroll
        for (unsigned j = 0; j < 16; ++j) { const unsigned c = xb_ld(&bar[XB_XCNT(j)]); sum += c; cnt += (c > 0u) ? 1u : 0u; mine = (j == x) ? c : mine; }
        if (sum == G) break;
        __builtin_amdgcn_s_sleep(1);
        if ((++sp & 255u) == 0u) { if (xb_ld(&bar[XB_TMO])) break; if (sp > XB_SPIN_CAP) { atomicAdd(&bar[XB_TMO], 1u); break; } }
    }
    nloc = mine > 0u ? mine : 1u; nx = cnt > 0u ? cnt : 1u;
}
__device__ __forceinline__ void xcd_barrier(const XcdBarrier& b) {
    asm volatile("s_waitcnt vmcnt(0)" ::: "memory");
    __syncthreads();
    if (threadIdx.x == 0) {
        unsigned* bar = b.bar;
        __builtin_amdgcn_s_waitcnt(0);
        unsigned nloc = b.st[0], nx = b.st[1];
        if (nloc == 0u) { xcd_barrier_complete(bar, b.x, nloc, nx); b.st[0] = nloc; b.st[1] = nx; }
        const unsigned old = xb_add(&bar[XB_XSUB(b.x)], 1u);
        const unsigned gen = old / nloc;
        if (old + 1u == (gen + 1u) * nloc) {
            __builtin_amdgcn_fence(__ATOMIC_RELEASE, "agent");
            asm volatile("s_waitcnt vmcnt(0)" ::: "memory");
            const unsigned og = xb_add(&bar[XB_TOP], 1u);
            const unsigned tg = og / nx;
            if (og + 1u == (tg + 1u) * nx) xb_add(&bar[XB_TOPGEN], 1u);
            else XB_SPIN(xb_ld(&bar[XB_TOPGEN]) == tg, bar);
            __builtin_amdgcn_fence(__ATOMIC_ACQUIRE, "agent");
            xb_add(&bar[XB_XGEN(b.x)], 1u);
            asm volatile("s_waitcnt vmcnt(0)" ::: "memory");
        } else {
            XB_SPIN(xb_ld(&bar[XB_XGEN(b.x)]) == gen, bar);
            __builtin_amdgcn_fence(__ATOMIC_ACQUIRE, "agent");
            asm volatile("s_waitcnt vmcnt(0)" ::: "memory");
        }
    }
    __syncthreads();
}

__device__ __forceinline__ int win_src(int p) {
    const int T = p >> 8, q = p & 255, bj = q >> 7, wc = (q >> 5) & 3, j = q & 31, hd = 64 * wc + 32 * bj + j;
    switch (T) {
        case 0: return O_AU + q; case 1: return O_AV + q; case 2: return O_BQ + hd; case 3: return O_BK + hd; case 4: return O_BV + q;
        case 5: return O_QI + hd; case 6: return O_QI + 256 + hd; case 7: return O_CQ + q; case 8: return O_CK + q; case 9: return O_CV + q;
        case 10: return O_CO + q; case 11: return O_DB + q; case 12: return O_DC + q; case 13: return O_DX + q;
        default: break;
    }
    if (wc == 0) return O_KI + 32 * bj + j;
    if (wc == 1 && bj == 0 && j < 16) return j < 8 ? O_WI + j : (j < 12 ? O_CI + (j - 8) : O_CF + (j - 12));
    return -1;
}
__device__ __forceinline__ int wg_src(int p) {
    const int pn = p >> 8, q = p & 255, bj = q >> 7, wc = (q >> 5) & 3, fq = (q >> 3) & 3, n = (q >> 2) & 1, e = q & 3;
    return O_G + (2 * bj + n) * 1024 + 64 * pn + 16 * wc + 4 * fq + e;
}
template <int MAP>
__device__ __forceinline__ void conv_item(const float* W, int K, int srcN, bf16_t* WT, LAS float* scr, int item, int nrows, int lane, const float* gain = nullptr) {
    const int nblk = nrows / 32, kb = item / nblk, nb = item % nblk, k0 = 64 * kb, n0 = 32 * nb;
    const int nn = n0 + (lane & 31); const int src = MAP == 0 ? nn : (MAP == 1 ? win_src(nn) : wg_src(nn));
    float wv_[32]; const float* wp_ = W + (size_t)(k0 + (lane >> 5)) * srcN + (src >= 0 ? src : 0);
#pragma unroll
    for (int i = 0; i < 32; ++i) wv_[i] = __builtin_nontemporal_load(wp_ + (size_t)(2 * i) * srcN);
#pragma unroll
    for (int i = 0; i < 32; ++i) scr[(2 * i + (lane >> 5)) * 33 + (lane & 31)] = src >= 0 ? (gain ? wv_[i] * gain[k0 + 2 * i + (lane >> 5)] : wv_[i]) : 0.f;
    asm volatile("s_waitcnt lgkmcnt(0)" ::: "memory");
    const int c = lane & 7;
#pragma unroll
    for (int j = 0; j < 4; ++j) { const int n = (lane >> 3) + 8 * j; const LAS float* s = scr + (8 * c) * 33 + n;
        u32x4 o; o.x = pk2(s[0 * 33], s[1 * 33]); o.y = pk2(s[2 * 33], s[3 * 33]); o.z = pk2(s[4 * 33], s[5 * 33]); o.w = pk2(s[6 * 33], s[7 * 33]);
        *(u32x4*)(WT + (size_t)(n0 + n) * K + k0 + 8 * c) = o; }
    asm volatile("s_waitcnt lgkmcnt(0)" ::: "memory");
}
__device__ __forceinline__ void convert_mix_weights(Frame& F, int l) {

    LAS float* scr = (LAS float*)(F.lds + F.wave * 16384);
    const int gw = F.vcu * NWAVES + F.wave, NGW = F.G * NWAVES;
    constexpr int I_WIN = (D / 64) * (PW / 32), I_WG = (D / 64) * (4096 / 32), I_BR = (256 / 64) * (1024 / 32), I_OUT = (D / 64) * (D / 32);
    constexpr int NIT = I_WIN + I_WG + 4 * I_BR + I_OUT;
    const float* win = INP(I_W_IN) + (size_t)l * D * INW; const float* gmix = INP(I_LN_MIX) + l * D;
    for (int it = gw; it < NIT; it += NGW) {
        int r = it;
        if (r < I_WIN) { conv_item<1>(win, D, INW, ((bf16_t*)WSP(WS_WIN)), scr, r, PW, F.lane, gmix); continue; } r -= I_WIN;
        if (r < I_WG) { conv_item<2>(win, D, INW, ((bf16_t*)WSP(WS_WG)), scr, r, 4096, F.lane, gmix); continue; } r -= I_WG;
        if (r < 4 * I_BR) { const int nb = r / I_BR; conv_item<0>(INP(I_W_BRANCH) + ((size_t)l * 4 + nb) * 256 * D, 256, D, ((bf16_t*)WSP(WS_WBR)) + (size_t)nb * 1024 * 256, scr, r % I_BR, 1024, F.lane); continue; } r -= 4 * I_BR;
        conv_item<0>(INP(I_W_OUT) + (size_t)l * D * D, D, D, ((bf16_t*)WSP(WS_WOUT)), scr, r, D, F.lane);
    }
}
__device__ __forceinline__ void convert_mlp_weights(Frame& F, int l) {

    LAS float* scr = (LAS float*)(F.lds + F.wave * 16384);
    const int gw = F.vcu * NWAVES + F.wave, NGW = F.G * NWAVES;
    constexpr int I_UP = (D / 64) * (FF / 32), I_DN = (FF / 64) * (D / 32);
    for (int it = gw; it < I_UP + I_DN; it += NGW) {
        if (it < I_UP) conv_item<0>(INP(I_W_UP) + (size_t)l * D * FF, D, FF, ((bf16_t*)WSP(WS_WUP)), scr, it, FF, F.lane, INP(I_LN_MLP) + l * D);
        else conv_item<0>(INP(I_W_DOWN) + (size_t)l * FF * D, FF, D, ((bf16_t*)WSP(WS_WDN)), scr, it - I_UP, D, F.lane);
    }
}
__device__ __forceinline__ void prologue_rows(Frame& F) {
    float* COS = (float*)WSP(WS_COS); float* SIN = (float*)WSP(WS_SIN); float* SSQA = (float*)WSP(WS_SSQA); bf16_t* XG = (bf16_t*)WSP(WS_XG); const float* x = INP(I_X); const float* ln_mix = INP(I_LN_MIX);
    const int gt = F.vcu * NT + F.tid, NGT = F.G * NT;
    for (int i = gt; i < S * 32; i += NGT) { const int pos = i >> 5, k = i & 31; const float inv = powf(10000.f, -(float)k * 2.0f / 64.f); const float ang = (float)pos * inv; COS[i] = cosf(ang); SIN[i] = sinf(ang); }
    const int gw = F.vcu * NWAVES + F.wave, NGW = F.G * NWAVES;
    for (int m = gw; m < M; m += NGW) {
        const f32x4* xr = (const f32x4*)(x + (size_t)m * D) + F.lane;
        unsigned long long* o8 = (unsigned long long*)(XG + (size_t)m * D) + F.lane; float tot = 0.f;
#pragma unroll
        for (int j = 0; j < 4; ++j) { const f32x4 v = xr[64 * j]; float s = (v[0] * v[0] + v[1] * v[1]) + (v[2] * v[2] + v[3] * v[3]);
            s += __shfl_xor(s, 1); s += __shfl_xor(s, 2); s += __shfl_xor(s, 4); s += __shfl_xor(s, 8);
            tot += s;
            o8[64 * j] = (unsigned long long)pk2(v[0], v[1]) | ((unsigned long long)pk2(v[2], v[3]) << 32); }
        tot += __shfl_xor(tot, 16); tot += __shfl_xor(tot, 32);
        if (F.lane == 0) ((float*)WSP(WS_RSA))[m] = rsqrtf(tot * (1.f / 1024.f) + EPS);
    }
}
__device__ __forceinline__ void finalize_rs(Frame& F, size_t ssq_off, size_t rs_off) {
    const float* ssq = (const float*)WSP(ssq_off); float* rs = (float*)WSP(rs_off);
    for (int row = F.vcu * NT + F.tid; row < M; row += F.G * NT) { const f32x4* sp = (const f32x4*)(ssq + (size_t)row * 16); const f32x4 a = sp[0], b = sp[1], c = sp[2], d = sp[3];
        const float t = ((a[0] + a[1]) + (a[2] + a[3])) + ((b[0] + b[1]) + (b[2] + b[3])) + ((c[0] + c[1]) + (c[2] + c[3])) + ((d[0] + d[1]) + (d[2] + d[3]));
        rs[row] = rsqrtf(t * (1.0f / 1024.0f) + EPS); }
}

__device__ __forceinline__ void sgu_simple(Frame& F, int l) {
    bf16_t* PROJ = (bf16_t*)WSP(WS_BIG); bf16_t* Y = (bf16_t*)WSP(WS_Y); const float* sgu_norm = INP(I_SGU_NORM); const float* sgu_w = INP(I_SGU_W); const float* sgu_b = INP(I_SGU_B);
    LAS float* r_s = (LAS float*)F.lds; LAS float* vn = r_s + 128;
    const float* gain = sgu_norm + l * 256; const float* sw = sgu_w + (size_t)l * 4 * 128 * 128; const float* sb = sgu_b + l * 4 * 128;
    for (int item = F.vcu; item < 512; item += F.G) {
        const int g = item & 3, m0 = (item >> 2) * 128;
        for (int i = 0; i < 16; ++i) { const int tok = F.wave * 16 + i; const u32x2 w = *(const u32x2*)(PROJ + (size_t)(m0 + tok) * PW + P_AV + 4 * F.lane);
            const float a = lo_bf(w.x), b = hi_bf(w.x), c = lo_bf(w.y), d = hi_bf(w.y); const float ss = wave_sum((a * a + b * b) + (c * c + d * d));
            if (F.lane == 0) r_s[tok] = rsqrtf(ss * (1.f / 256.f) + EPS); }
        __syncthreads();
        for (int idx = F.tid; idx < 8192; idx += NT) { const int s = idx >> 6, d = idx & 63; vn[idx] = bf2f(PROJ[(size_t)(m0 + s) * PW + P_AV + g * 64 + d]) * r_s[s] * gain[g * 64 + d]; }
        __syncthreads();
        const int d = F.tid & 63, tq = F.tid >> 6;
        for (int tl = tq; tl < 128; tl += 8) { const float* w = sw + ((size_t)g * 128 + tl) * 128; float acc = 0.f;
            for (int s = 0; s <= tl; ++s) acc = fmaf(w[s], vn[s * 64 + d], acc);
            acc += sb[g * 128 + tl];
            Y[(size_t)(m0 + tl) * D + g * 64 + d] = (bf16_t)f2bf(bf2f(PROJ[(size_t)(m0 + tl) * PW + P_AU + g * 64 + d]) * acc); }
        __syncthreads();
    }
}
__device__ __forceinline__ void conv_simple(Frame& F, int l) {
    bf16_t* PROJ = (bf16_t*)WSP(WS_BIG); bf16_t* Y = (bf16_t*)WSP(WS_Y); const float* conv_w = INP(I_CONV_W);
    const float* cw = conv_w + l * 3 * 256;
    for (int i = F.vcu * NT + F.tid; i < M * 32; i += F.G * NT) { const int m = i >> 5, c = (i & 31) * 8, t = m & (S - 1); float acc[8];
#pragma unroll
        for (int e = 0; e < 8; ++e) acc[e] = 0.f;
#pragma unroll
        for (int j = 0; j < 3; ++j) { const int tt = t - 2 + j; if (tt >= 0) { const size_t r = (size_t)(m - 2 + j) * PW; const u32x4 a = *(const u32x4*)(PROJ + r + P_DC + c), x = *(const u32x4*)(PROJ + r + P_DX + c);
                const f32x4 w0 = *(const f32x4*)(cw + j * 256 + c), w1 = *(const f32x4*)(cw + j * 256 + c + 4);
                acc[0] = fmaf(w0[0], lo_bf(a.x) * lo_bf(x.x), acc[0]); acc[1] = fmaf(w0[1], hi_bf(a.x) * hi_bf(x.x), acc[1]); acc[2] = fmaf(w0[2], lo_bf(a.y) * lo_bf(x.y), acc[2]); acc[3] = fmaf(w0[3], hi_bf(a.y) * hi_bf(x.y), acc[3]);
                acc[4] = fmaf(w1[0], lo_bf(a.z) * lo_bf(x.z), acc[4]); acc[5] = fmaf(w1[1], hi_bf(a.z) * hi_bf(x.z), acc[5]); acc[6] = fmaf(w1[2], lo_bf(a.w) * lo_bf(x.w), acc[6]); acc[7] = fmaf(w1[3], hi_bf(a.w) * hi_bf(x.w), acc[7]); } }
        const u32x4 bq = *(const u32x4*)(PROJ + (size_t)m * PW + P_DB + c); u32x4 o;
        o.x = cvt_pk_bf16(lo_bf(bq.x) * acc[0], hi_bf(bq.x) * acc[1]); o.y = cvt_pk_bf16(lo_bf(bq.y) * acc[2], hi_bf(bq.y) * acc[3]); o.z = cvt_pk_bf16(lo_bf(bq.z) * acc[4], hi_bf(bq.z) * acc[5]); o.w = cvt_pk_bf16(lo_bf(bq.w) * acc[6], hi_bf(bq.w) * acc[7]);
        *(u32x4*)(Y + (size_t)m * D + 768 + c) = o; }
}
__device__ __forceinline__ void indexer_simple(Frame& F) {
    float* MISC = (float*)WSP(WS_MISC); unsigned* MASK = (unsigned*)WSP(WS_MASK); bf16_t* PROJ = (bf16_t*)WSP(WS_BIG);
    LAS float* sc = (LAS float*)F.lds; LAS int* red = (LAS int*)(sc + 4096); LAS unsigned* msk = (LAS unsigned*)(red + 16);
    for (int m = F.vcu; m < M; m += F.G) {
        const int t = m & (S - 1), b0 = m - t, n = t + 1;
        if (n <= 256) { if (F.tid < 128) { const int lo = 32 * F.tid; MASK[maskt_idx(m, F.tid)] = (lo + 32 <= n) ? 0xffffffffu : (lo >= n ? 0u : ((1u << (n - lo)) - 1u)); } continue; }
        float qreg[8], wh[8];
#pragma unroll
        for (int h = 0; h < 8; ++h) { qreg[h] = bf2f(PROJ[(size_t)m * PW + P_QI + h * 64 + F.lane]); wh[h] = MISC[(size_t)m * 16 + h] * 0.35355339059327373f; }
        for (int s0 = 0; s0 < n; s0 += NT) {
            const int s = s0 + F.tid, sc_ = s < n ? s : n - 1; const u32x4* kr = (const u32x4*)(PROJ + (size_t)(b0 + sc_) * PW + P_KI);
            float kf[64];
#pragma unroll
            for (int i = 0; i < 8; ++i) { const u32x4 w = kr[i]; kf[8 * i] = lo_bf(w.x); kf[8 * i + 1] = hi_bf(w.x); kf[8 * i + 2] = lo_bf(w.y); kf[8 * i + 3] = hi_bf(w.y); kf[8 * i + 4] = lo_bf(w.z); kf[8 * i + 5] = hi_bf(w.z); kf[8 * i + 6] = lo_bf(w.w); kf[8 * i + 7] = hi_bf(w.w); }
            float acc = 0.f;
#pragma unroll
            for (int h = 0; h < 8; ++h) { float d0 = 0.f, d1 = 0.f;
#pragma unroll
                for (int e = 0; e < 64; e += 2) { d0 = fmaf(__builtin_bit_cast(float, __builtin_amdgcn_readlane(__builtin_bit_cast(int, qreg[h]), e)), kf[e], d0);
                                                   d1 = fmaf(__builtin_bit_cast(float, __builtin_amdgcn_readlane(__builtin_bit_cast(int, qreg[h]), e + 1)), kf[e + 1], d1); }
                acc += wh[h] * fmaxf((d0 + d1) * 0.125f, 0.f); }
            if (s < n) sc[s] = acc;
        }
        __syncthreads();
        unsigned Tk = 0u;
        for (int bit = 31; bit >= 0; --bit) {
            const unsigned cand = Tk | (1u << bit); int c = 0;
            for (int s = F.tid; s < n; s += NT) c += (fkey(sc[s]) >= cand) ? 1 : 0;
            c = wave_sum_i(c); if (F.lane == 0) red[F.wave] = c; __syncthreads();
            int tot = 0;
#pragma unroll
            for (int w = 0; w < 8; ++w) tot += red[w];
            __syncthreads();
            if (tot >= 256) Tk = cand;
        }
        int cg_ = 0, ce = 0;
        for (int s = F.tid; s < n; s += NT) { const unsigned k = fkey(sc[s]); cg_ += k > Tk ? 1 : 0; ce += k == Tk ? 1 : 0; }
        cg_ = wave_sum_i(cg_); ce = wave_sum_i(ce); if (F.lane == 0) { red[F.wave] = cg_; red[8 + F.wave] = ce; }
        if (F.tid < 128) msk[F.tid] = 0u;
        __syncthreads();
        int ngt = 0, neq = 0;
#pragma unroll
        for (int w = 0; w < 8; ++w) { ngt += red[w]; neq += red[8 + w]; }
        const bool all_eq = (ngt + neq == 256);
        for (int s = F.tid; s < n; s += NT) { const unsigned k = fkey(sc[s]); if (k > Tk || (all_eq && k == Tk)) atomicOr((unsigned*)&msk[s >> 5], 1u << (s & 31)); }
        __syncthreads();
        if (!all_eq && F.tid == 0) { int need = 256 - ngt; for (int s = 0; s < n && need > 0; ++s) if (fkey(sc[s]) == Tk) { msk[s >> 5] |= 1u << (s & 31); --need; } }
        __syncthreads();
        if (F.tid < 128) MASK[maskt_idx(m, F.tid)] = msk[F.tid];
        __syncthreads();
    }
}
__device__ __forceinline__ void attn_simple(Frame& F) {
    unsigned* MASK = (unsigned*)WSP(WS_MASK); bf16_t* PROJ = (bf16_t*)WSP(WS_BIG); bf16_t* Y = (bf16_t*)WSP(WS_Y);
    LAS unsigned* msk = (LAS unsigned*)F.lds; LAS int* sel = (LAS int*)(msk + 128); LAS float* lg = (LAS float*)(sel + 256); LAS int* nsel = (LAS int*)(lg + 4 * 256);
    for (int m = F.vcu; m < M; m += F.G) {
        const int t = m & (S - 1), b0 = m - t;
        if (F.tid < 128) msk[F.tid] = MASK[maskt_idx(m, F.tid)];
        __syncthreads();
        if (F.tid == 0) { int c = 0; for (int w = 0; w < 128; ++w) { unsigned bits = msk[w]; while (bits) { const int i = __builtin_ctz(bits); if (c < 256) sel[c] = 32 * w + i; ++c; bits &= bits - 1; } } nsel[0] = c < 256 ? c : 256; }
        __syncthreads();
        const int ns = nsel[0], h = F.wave & 3, part = F.wave >> 2;
        const float q = bf2f(PROJ[(size_t)m * PW + P_Q + h * 64 + F.lane]);
        for (int j = part; j < ns; j += 2) { const float d = wave_sum(q * bf2f(PROJ[(size_t)(b0 + sel[j]) * PW + P_K + h * 64 + F.lane])); if (F.lane == 0) lg[h * 256 + j] = d * 0.125f; }
        __syncthreads();
        if (F.wave < 4) {
            float mx = -INFINITY; for (int j = F.lane; j < ns; j += 64) mx = fmaxf(mx, lg[h * 256 + j]); mx = wave_max(mx);
            float sm = 0.f; for (int j = F.lane; j < ns; j += 64) sm += __expf(lg[h * 256 + j] - mx); sm = wave_sum(sm);
            float o = 0.f; for (int j = 0; j < ns; ++j) o = fmaf(__expf(lg[h * 256 + j] - mx), bf2f(PROJ[(size_t)(b0 + sel[j]) * PW + P_V + h * 64 + F.lane]), o);
            Y[(size_t)m * D + 256 + h * 64 + F.lane] = (bf16_t)f2bf(o / sm);
        }
        __syncthreads();
    }
}
__device__ __forceinline__ void mlstm1_simple(Frame& F, int l) {
    float* MISC = (float*)WSP(WS_MISC); float* STATE = (float*)WSP(WS_STATE); bf16_t* PROJ = (bf16_t*)WSP(WS_BIG); const float* i_bias = INP(I_I_BIAS); const float* f_bias = INP(I_F_BIAS);
    LAS float* bs = (LAS float*)F.lds; LAS float* ig = bs + 128; LAS float* wk = ig + 128; LAS float* kt = wk + 128; LAS float* vt = kt + 128 * 64;
    for (int item = F.vcu; item < 512; item += F.G) {
        const int bh = item >> 5, c = item & 31, b = bh >> 2, h = bh & 3, m0 = b * S + c * 128;
        if (F.tid < 128) { const float f = MISC[(size_t)(m0 + F.tid) * 16 + 12 + h] + f_bias[l * 4 + h]; bs[F.tid] = fminf(f, 0.f) - log1pf(__expf(-fabsf(f))); ig[F.tid] = MISC[(size_t)(m0 + F.tid) * 16 + 8 + h] + i_bias[l * 4 + h]; }
        for (int idx = F.tid; idx < 8192; idx += NT) { const int s = idx >> 6, d = idx & 63; kt[idx] = bf2f(PROJ[(size_t)(m0 + s) * PW + P_CK + h * 64 + d]); vt[idx] = bf2f(PROJ[(size_t)(m0 + s) * PW + P_CV + h * 64 + d]); }
        __syncthreads();
        if (F.tid == 0) { float a = 0.f; for (int s = 0; s < 128; ++s) { a += bs[s]; bs[s] = a; } }
        __syncthreads();
        const float B = bs[127];
        if (F.tid < 128) wk[F.tid] = __expf(B - bs[F.tid] + ig[F.tid]);
        __syncthreads();
        const int e = F.tid & 63, dq = F.tid >> 6; float acc[8];
#pragma unroll
        for (int i = 0; i < 8; ++i) acc[i] = 0.f;
        for (int s = 0; s < 128; ++s) { const float kv = wk[s] * vt[s * 64 + e];
#pragma unroll
            for (int i = 0; i < 8; ++i) acc[i] = fmaf(kt[s * 64 + dq * 8 + i], kv, acc[i]); }
        float* st = STATE + (size_t)item * STATE_STRIDE;
#pragma unroll
        for (int i = 0; i < 8; ++i) st[e * 64 + dq * 8 + i] = acc[i];
        if (F.tid < 64) { float a = 0.f; for (int s = 0; s < 128; ++s) a = fmaf(wk[s], kt[s * 64 + F.tid], a); st[4096 + F.tid] = a; }
        if (F.tid == 0) st[4160] = B;
        __syncthreads();
    }
}
__device__ __forceinline__ void mlstm2_simple(Frame& F, int l) {
    float* MISC = (float*)WSP(WS_MISC); float* STATE = (float*)WSP(WS_STATE); bf16_t* PROJ = (bf16_t*)WSP(WS_BIG); bf16_t* Y = (bf16_t*)WSP(WS_Y); const float* i_bias = INP(I_I_BIAS); const float* f_bias = INP(I_F_BIAS); const float* mnorm = INP(I_MNORM);
    LAS float* Cs = (LAS float*)F.lds; LAS float* ns = Cs + 4096; LAS float* bs = ns + 64; LAS float* ig = bs + 128; LAS float* A = ig + 128;
    LAS float* qt = A + 128 * 128; LAS float* kt = qt + 128 * 65;
    for (int item = F.vcu; item < 512; item += F.G) {
        const int bh = item >> 5, c = item & 31, b = bh >> 2, h = bh & 3, m0 = b * S + c * 128;
        { float Cv[8]; float nv = 0.f;
#pragma unroll
          for (int k = 0; k < 8; ++k) Cv[k] = 0.f;
          for (int cc = 0; cc < c; ++cc) { const float* st = STATE + (size_t)(bh * 32 + cc) * STATE_STRIDE; const float dec = __expf(st[4160]);
#pragma unroll
              for (int k = 0; k < 8; ++k) Cv[k] = fmaf(dec, Cv[k], st[F.tid + NT * k]);
              if (F.tid < 64) nv = fmaf(dec, nv, st[4096 + F.tid]); }
#pragma unroll
          for (int k = 0; k < 8; ++k) Cs[F.tid + NT * k] = Cv[k];
          if (F.tid < 64) ns[F.tid] = nv; }
        if (F.tid < 128) { const float f = MISC[(size_t)(m0 + F.tid) * 16 + 12 + h] + f_bias[l * 4 + h]; bs[F.tid] = fminf(f, 0.f) - log1pf(__expf(-fabsf(f))); ig[F.tid] = MISC[(size_t)(m0 + F.tid) * 16 + 8 + h] + i_bias[l * 4 + h]; }
        for (int idx = F.tid; idx < 8192; idx += NT) { const int s = idx >> 6, d = idx & 63; qt[s * 65 + d] = bf2f(PROJ[(size_t)(m0 + s) * PW + P_CQ + h * 64 + d]); kt[s * 65 + d] = bf2f(PROJ[(size_t)(m0 + s) * PW + P_CK + h * 64 + d]); }
        __syncthreads();
        if (F.tid == 0) { float a = 0.f; for (int s = 0; s < 128; ++s) { a += bs[s]; bs[s] = a; } }
        __syncthreads();
        { const int s = F.tid & 127, jq = F.tid >> 7;
          for (int j = jq; j < 128; j += 4) { float v = 0.f;
              if (s <= j) { float d = 0.f;
#pragma unroll 16
                  for (int k = 0; k < 64; ++k) d = fmaf(qt[j * 65 + k], kt[s * 65 + k], d);
                  v = __expf(bs[j] - bs[s] + ig[s]) * d; }
              A[j * 128 + s] = v; } }
        __syncthreads();
        LAS float* vt = kt;
        for (int idx = F.tid; idx < 8192; idx += NT) { const int s = idx >> 6, d = idx & 63; vt[idx] = bf2f(PROJ[(size_t)(m0 + s) * PW + P_CV + h * 64 + d]); }
        __syncthreads();
        const int e = F.lane; const float gn = mnorm[l * 256 + h * 64 + e];
        for (int j = F.wave; j < 128; j += 8) {
            float num = 0.f, qn = 0.f, sa = 0.f;
            for (int d = 0; d < 64; ++d) { const float qd = qt[j * 65 + d]; num = fmaf(qd, Cs[d * 64 + e], num); qn = fmaf(qd, ns[d], qn); }
            const float eb = __expf(bs[j]); num *= eb; qn *= eb;
            for (int s = 0; s <= j; ++s) { const float a = A[j * 128 + s]; num = fmaf(a, vt[s * 64 + e], num); sa += a; }
            const float hv = num / fmaxf(fabsf(qn + sa), 1.f);
            const float r = rsqrtf(wave_sum(hv * hv) * (1.f / 64.f) + EPS);
            const size_t row = (size_t)(m0 + j);
            Y[row * D + 512 + h * 64 + e] = (bf16_t)f2bf(sigmoid_f(bf2f(PROJ[row * PW + P_CO + h * 64 + e])) * hv * r * gn);
        }
        __syncthreads();
    }
}
typedef float f32x16 __attribute__((ext_vector_type(16)));
constexpr size_t WS_VT = WS_BIG + 120 * MiB;
constexpr float LOG2E = 1.4426950408889634f;

__device__ __forceinline__ void attn_mfma(Frame& F, int l) {
    const unsigned long long* MASKT = (const unsigned long long*)WSP(WS_MASK); const bf16_t* PROJ = (const bf16_t*)WSP(WS_BIG); const bf16_t* VT = (const bf16_t*)WSP(WS_VT);
    bf16_t* Y = (bf16_t*)WSP(WS_Y); const float* gt = (const float*)WSP(WS_GT) + l * 192;
    const int lane = F.lane, r32 = lane & 31, hi = lane >> 5, grp = F.wave >> 2, w4 = F.wave & 3, lg = F.tid & 255;
    const float mq = wave_max(fabsf(gt[lane])), mk = wave_max(fabsf(gt[64 + lane]));
    const float c1 = 0.125f * LOG2E, c2 = 8.f * mq * mk * 1.01f * LOG2E;
    constexpr int ROWB = 144, TILEB = 64 * ROWB;
    LAS unsigned char* gb = F.lds + grp * 4 * TILEB;
    LAS float* comb = (LAS float*)(F.lds + 8 * TILEB);
    const int srow0 = lg >> 3, sc0 = lg & 7;
    for (int item = F.vcu; item < 256; item += F.G) {
        const int bh = item >> 4, sidx = item & 15, b = bh >> 2, h = bh & 3;
#pragma unroll 1
        for (int half = 0; half < 2; ++half) {
            const int qb = half == 0 ? sidx : 31 - sidx, q0 = qb * 128, ntl = qb + 1;
            const int qrow = b * S + q0 + w4 * 32 + r32, tq = q0 + w4 * 32 + r32;
            bf16x8 qf[4];
#pragma unroll
            for (int s = 0; s < 4; ++s) qf[s] = *(const bf16x8*)(PROJ + (size_t)qrow * PW + P_Q + h * 64 + 16 * s + 8 * hi);
            f32x16 o0, o1;
#pragma unroll
            for (int r = 0; r < 16; ++r) { o0[r] = 0.f; o1[r] = 0.f; }
            float lsum = 0.f;
            const bf16_t* kbase = PROJ + (size_t)(b * S + srow0) * PW + P_K + h * 64 + sc0 * 8;
            const bf16_t* vbase = VT + (size_t)(b * 256 + h * 64 + srow0) * S + sc0 * 8;
            const unsigned long long* mbase = MASKT + (size_t)(b * 64) * S + tq;
            u32x4 ka0, ka1, va0, va1, kb0, kb1, vb0, vb1; unsigned long long mwa = 0ull, mwb = 0ull;
#define ATT_LOAD(K0, K1, V0, V1, MW, t_) do { const int t__ = (t_); K0 = *(const u32x4*)(kbase + (size_t)t__ * 64 * PW); K1 = *(const u32x4*)(kbase + (size_t)(t__ * 64 + 32) * PW); \
    V0 = *(const u32x4*)(vbase + t__ * 64); V1 = *(const u32x4*)(vbase + 32 * S + t__ * 64); MW = mbase[(size_t)t__ * S]; } while (0)
#define ATT_STORE(K0, K1, V0, V1, buf_) do { LAS unsigned char* kn_ = gb + (buf_) * 2 * TILEB; LAS unsigned char* vn_ = kn_ + TILEB; \
    *(LAS u32x4*)(kn_ + srow0 * ROWB + sc0 * 16) = K0; *(LAS u32x4*)(kn_ + (srow0 + 32) * ROWB + sc0 * 16) = K1; \
    *(LAS u32x4*)(vn_ + srow0 * ROWB + sc0 * 16) = V0; *(LAS u32x4*)(vn_ + (srow0 + 32) * ROWB + sc0 * 16) = V1; } while (0)
#define ATT_COMPUTE(cur_, MW) do { \
                const LAS unsigned char* kb = gb + (cur_) * 2 * TILEB; const LAS unsigned char* vb = kb + TILEB; \
                f32x16 p0, p1; \
                _Pragma("unroll") for (int r = 0; r < 16; ++r) { p0[r] = 0.f; p1[r] = 0.f; } \
                _Pragma("unroll") for (int s = 0; s < 4; ++s) { \
                    const bf16x8 k0 = *(const LAS bf16x8*)(kb + r32 * ROWB + 32 * s + 16 * hi), k1 = *(const LAS bf16x8*)(kb + (32 + r32) * ROWB + 32 * s + 16 * hi); \
                    p0 = __builtin_amdgcn_mfma_f32_32x32x16_bf16(k0, qf[s], p0, 0, 0, 0); p1 = __builtin_amdgcn_mfma_f32_32x32x16_bf16(k1, qf[s], p1, 0, 0, 0); } \
                const unsigned sh0 = (unsigned)(MW) >> (4 * hi), sh1 = (unsigned)((MW) >> 32) >> (4 * hi); \
                _Pragma("unroll") for (int r = 0; r < 16; ++r) { const int cb = (r & 3) + 8 * (r >> 2); \
                    const float e0 = __builtin_amdgcn_exp2f(p0[r] * c1 - c2), e1 = __builtin_amdgcn_exp2f(p1[r] * c1 - c2); \
                    p0[r] = __uint_as_float(__float_as_uint(e0) & (unsigned)__builtin_amdgcn_sbfe((int)sh0, cb, 1)); p1[r] = __uint_as_float(__float_as_uint(e1) & (unsigned)__builtin_amdgcn_sbfe((int)sh1, cb, 1)); lsum += p0[r] + p1[r]; } \
                _Pragma("unroll") for (int ks = 0; ks < 4; ++ks) { \
                    u32x4 pw; \
                    if (ks < 2) { pw.x = cvt_pk_bf16(p0[8 * ks + 0], p0[8 * ks + 1]); pw.y = cvt_pk_bf16(p0[8 * ks + 2], p0[8 * ks + 3]); pw.z = cvt_pk_bf16(p0[8 * ks + 4], p0[8 * ks + 5]); pw.w = cvt_pk_bf16(p0[8 * ks + 6], p0[8 * ks + 7]); } \
                    else { const int k2 = ks - 2; pw.x = cvt_pk_bf16(p1[8 * k2 + 0], p1[8 * k2 + 1]); pw.y = cvt_pk_bf16(p1[8 * k2 + 2], p1[8 * k2 + 3]); pw.z = cvt_pk_bf16(p1[8 * k2 + 4], p1[8 * k2 + 5]); pw.w = cvt_pk_bf16(p1[8 * k2 + 6], p1[8 * k2 + 7]); } \
                    const bf16x8 pf = __builtin_bit_cast(bf16x8, pw); \
                    const int vo = 64 * (ks >> 1) + 32 * (ks & 1) + 8 * hi; \
                    const u32x2 a0 = *(const LAS u32x2*)(vb + r32 * ROWB + vo), a1 = *(const LAS u32x2*)(vb + r32 * ROWB + vo + 16); \
                    const u32x2 b0 = *(const LAS u32x2*)(vb + (32 + r32) * ROWB + vo), b1 = *(const LAS u32x2*)(vb + (32 + r32) * ROWB + vo + 16); \
                    const u32x4 va = {a0.x, a0.y, a1.x, a1.y}, vb4 = {b0.x, b0.y, b1.x, b1.y}; \
                    o0 = __builtin_amdgcn_mfma_f32_32x32x16_bf16(__builtin_bit_cast(bf16x8, va), pf, o0, 0, 0, 0); \
                    o1 = __builtin_amdgcn_mfma_f32_32x32x16_bf16(__builtin_bit_cast(bf16x8, vb4), pf, o1, 0, 0, 0); } \
            } while (0)
            ATT_LOAD(ka0, ka1, va0, va1, mwa, grp);
            if (ntl > 1) ATT_LOAD(kb0, kb1, vb0, vb1, mwb, 2 + grp);
            ATT_STORE(ka0, ka1, va0, va1, 0);
            __syncthreads();
#pragma unroll 1
            for (int i = 0; i < ntl; i += 2) {
                const unsigned long long mw0 = mwa;
                if (i + 2 < ntl) ATT_LOAD(ka0, ka1, va0, va1, mwa, 2 * (i + 2) + grp);
                ATT_COMPUTE(0, mw0);
                if (i + 1 < ntl) ATT_STORE(kb0, kb1, vb0, vb1, 1);
                __syncthreads();
                if (i + 1 < ntl) {
                    const unsigned long long mw1 = mwb;
                    if (i + 3 < ntl) ATT_LOAD(kb0, kb1, vb0, vb1, mwb, 2 * (i + 3) + grp);
                    ATT_COMPUTE(1, mw1);
                    if (i + 2 < ntl) ATT_STORE(ka0, ka1, va0, va1, 0);
                    __syncthreads();
                }
            }
#undef ATT_LOAD
#undef ATT_STORE
#undef ATT_COMPUTE
            if (grp == 1) { LAS float* cw = comb + w4 * 33 * 64 + lane;
#pragma unroll
                for (int r = 0; r < 16; ++r) { cw[r * 64] = o0[r]; cw[(16 + r) * 64] = o1[r]; }
                cw[32 * 64] = lsum; }
            __syncthreads();
            if (grp == 0) { const LAS float* cw = comb + w4 * 33 * 64 + lane;
#pragma unroll
                for (int r = 0; r < 16; ++r) { o0[r] += cw[r * 64]; o1[r] += cw[(16 + r) * 64]; }
                lsum += cw[32 * 64]; lsum += __shfl_xor(lsum, 32); const float inv = 1.f / lsum;
                bf16_t* yp = Y + (size_t)qrow * D + 256 + h * 64 + 4 * hi;
#pragma unroll
                for (int g4 = 0; g4 < 4; ++g4) { u32x2 w0, w1;
                    w0.x = cvt_pk_bf16(o0[4 * g4] * inv, o0[4 * g4 + 1] * inv); w0.y = cvt_pk_bf16(o0[4 * g4 + 2] * inv, o0[4 * g4 + 3] * inv);
                    w1.x = cvt_pk_bf16(o1[4 * g4] * inv, o1[4 * g4 + 1] * inv); w1.y = cvt_pk_bf16(o1[4 * g4 + 2] * inv, o1[4 * g4 + 3] * inv);
                    *(u32x2*)(yp + 8 * g4) = w0; *(u32x2*)(yp + 32 + 8 * g4) = w1; } }
            __syncthreads();
        }
    }
}

constexpr size_t WS_KI = 234 * MiB;
template <int J, unsigned MSK>
__device__ __forceinline__ void tr_stage(unsigned (&a)[32]) {
#pragma unroll
    for (int k = 0; k < 32; ++k) if ((k & J) == 0) { const unsigned t = (a[k] ^ (a[k + J] >> J)) & MSK; a[k] ^= t; a[k + J] ^= (t << J); }
}
__device__ __forceinline__ void transpose32(unsigned (&a)[32]) {
    tr_stage<16, 0x0000FFFFu>(a); tr_stage<8, 0x00FF00FFu>(a); tr_stage<4, 0x0F0F0F0Fu>(a); tr_stage<2, 0x33333333u>(a); tr_stage<1, 0x55555555u>(a);
}
__device__ __forceinline__ int wave_total_i(int v) {
    v += __builtin_amdgcn_update_dpp(0, v, 0x111, 0xf, 0xf, false);
    v += __builtin_amdgcn_update_dpp(0, v, 0x112, 0xf, 0xf, false);
    v += __builtin_amdgcn_update_dpp(0, v, 0x114, 0xf, 0xf, false);
    v += __builtin_amdgcn_update_dpp(0, v, 0x118, 0xf, 0xf, false);
    v += __builtin_amdgcn_update_dpp(0, v, 0x142, 0xa, 0xf, false);
    v += __builtin_amdgcn_update_dpp(0, v, 0x143, 0xc, 0xf, false);
    return __builtin_amdgcn_readlane(v, 63);
}
__device__ __forceinline__ void indexer_mfma(Frame& F) {
    const float* MISC = (const float*)WSP(WS_MISC); unsigned long long* MASKT = (unsigned long long*)WSP(WS_MASK); const bf16_t* PROJ = (const bf16_t*)WSP(WS_BIG); const bf16_t* KI = (const bf16_t*)WSP(WS_KI);
    LAS float* sc = (LAS float*)F.lds;
    const int lane = F.lane, r32 = lane & 31, hi = lane >> 5, wv = F.wave;
    for (int pi = F.vcu; pi < 1024; pi += F.G) {
        const int b = pi >> 8, pp = pi & 255;
#pragma unroll 1
        for (int half = 0; half < 2; ++half) {
            const int t0 = 8 * (half == 0 ? pp : 511 - pp), m0 = b * S + t0, tq = t0 + wv;
            unsigned long long myword = 0ull;
            if (t0 + 8 <= 256) {
                const int lo = 64 * lane; myword = (tq >= lo + 63) ? ~0ull : (tq < lo ? 0ull : ((2ull << (tq - lo)) - 1ull));
                MASKT[(size_t)(b * 64 + lane) * S + tq] = myword;
                continue;
            }
            const int nmax = t0 + 8, ntile = (nmax + 31) >> 5;
            bf16x8 qa[2][4]; float wq[2][4][4];
#pragma unroll
            for (int i = 0; i < 2; ++i) {
                const bf16_t* qp = PROJ + (size_t)(m0 + 4 * i + (r32 >> 3)) * PW + P_QI + (r32 & 7) * 64 + 8 * hi;
#pragma unroll
                for (int s = 0; s < 4; ++s) qa[i][s] = *(const bf16x8*)(qp + 16 * s);
#pragma unroll
                for (int qq = 0; qq < 4; ++qq) { const f32x4 w4 = *(const f32x4*)(MISC + (size_t)(m0 + 4 * i + qq) * 16 + 4 * hi);
#pragma unroll
                    for (int e = 0; e < 4; ++e) wq[i][qq][e] = w4[e] * (0.125f * 0.35355339059327373f); }
            }
            bf16x8 kring[4][4];
#define IDX_LOADK(u_, j_) do { const int key_ = 32 * (j_) + r32; const int krow_ = key_ < nmax ? key_ : nmax - 1; const bf16_t* kp_ = KI + (size_t)(b * S + krow_) * 64 + 8 * hi; \
    _Pragma("unroll") for (int s_ = 0; s_ < 4; ++s_) kring[u_][s_] = *(const bf16x8*)(kp_ + 16 * s_); } while (0)
#pragma unroll
            for (int u = 0; u < 4; ++u) IDX_LOADK(u, wv + 8 * u);
            for (int jb = wv; jb < ntile; jb += 32) {
#pragma unroll
                for (int u = 0; u < 4; ++u) {
                    const int j = jb + 8 * u;
                    if (j < ntile) {
                        const int key = 32 * j + r32;
                        bf16x8 kb[4];
#pragma unroll
                        for (int s = 0; s < 4; ++s) kb[s] = kring[u][s];
                        IDX_LOADK(u, j + 32);
#pragma unroll
                        for (int i = 0; i < 2; ++i) {
                            f32x16 d;
#pragma unroll
                            for (int r = 0; r < 16; ++r) d[r] = 0.f;
#pragma unroll
                            for (int s = 0; s < 4; ++s) d = __builtin_amdgcn_mfma_f32_32x32x16_bf16(qa[i][s], kb[s], d, 0, 0, 0);
                            float part[4];
#pragma unroll
                            for (int qq = 0; qq < 4; ++qq) { float a = 0.f;
#pragma unroll
                                for (int e = 0; e < 4; ++e) a = fmaf(wq[i][qq][e], fmaxf(d[4 * qq + e], 0.f), a);
                                part[qq] = a; }
                            auto s01 = __builtin_amdgcn_permlane32_swap(__float_as_uint(part[0]), __float_as_uint(part[1]), false, false);
                            auto s23 = __builtin_amdgcn_permlane32_swap(__float_as_uint(part[2]), __float_as_uint(part[3]), false, false);
                            const float v01 = __uint_as_float(s01[0]) + __uint_as_float(s01[1]), v23 = __uint_as_float(s23[0]) + __uint_as_float(s23[1]);
                            const int qA = 4 * i + hi, qB = 4 * i + 2 + hi;
                            sc[qA * 4096 + key] = (key <= t0 + qA) ? v01 : -INFINITY;
                            sc[qB * 4096 + key] = (key <= t0 + qB) ? v23 : -INFINITY;
                        }
                    }
                }
            }
#undef IDX_LOADK
            __syncthreads();
            const int nvalid = 32 * ntile; const LAS float* srow = sc + wv * 4096 + lane;
            unsigned pa[32], pb[32];
#pragma unroll
            for (int r = 0; r < 32; ++r) { const float v = srow[64 * r]; pa[r] = fkey(v) & (unsigned)((64 * r + lane - nvalid) >> 31); }
            transpose32(pa);
            const bool two = nvalid > 2048;
            if (two) {
#pragma unroll
                for (int r = 0; r < 32; ++r) { const float v = srow[64 * (32 + r)]; pb[r] = fkey(v) & (unsigned)((64 * (32 + r) + lane - nvalid) >> 31); }
                transpose32(pb);
            } else {
#pragma unroll
                for (int r = 0; r < 32; ++r) pb[r] = 0u;
            }
            unsigned aA = ~0u, aB = ~0u, Tk = 0u; int base = 0;
#pragma unroll
            for (int bit = 31; bit >= 0; --bit) {
                const unsigned wa = pa[31 - bit], wb = pb[31 - bit];
                const int tot = wave_total_i(__builtin_popcount(wa & aA) + __builtin_popcount(wb & aB));
                const bool take = (base + tot >= 256);
                const unsigned flip = take ? 0u : ~0u;
                aA &= (wa ^ flip); aB &= (wb ^ flip);
                if (take) Tk |= (1u << bit); else base += tot;
            }
            const int ngt = base, neq = wave_total_i(__builtin_popcount(aA) + __builtin_popcount(aB));
            if (ngt + neq == 256) {
#pragma unroll
                for (int r = 0; r < 64; ++r) { const float v = srow[64 * r]; const unsigned k = fkey(v) & (unsigned)((64 * r + lane - nvalid) >> 31);
                    const unsigned long long wsel = __ballot(k >= Tk); if (lane == r) myword = wsel; }
            } else {
                int need = 256 - ngt;
#pragma unroll 1
                for (int r = 0; r < 64; ++r) { const float v = srow[64 * r]; const unsigned k = fkey(v) & (unsigned)((64 * r + lane - nvalid) >> 31);
                    unsigned long long wsel = __ballot(k > Tk), em = __ballot(k == Tk);
                    if (em != 0ull && need > 0) { int c = __builtin_popcountll(em); while (c > need) { em &= ~(1ull << (63 - __builtin_clzll(em))); --c; } need -= c; wsel |= em; }
                    if (lane == r) myword = wsel; }
            }
            MASKT[(size_t)(b * 64 + lane) * S + tq] = myword;
            __syncthreads();
        }
    }
}

constexpr size_t WS_CVT = 236 * MiB;
__device__ __forceinline__ void mlstm2_mfma(Frame& F, int l) {
    const float* MISC = (const float*)WSP(WS_MISC); const float* STATE = (const float*)WSP(WS_STATE); const bf16_t* PROJ = (const bf16_t*)WSP(WS_BIG); const bf16_t* CVT = (const bf16_t*)WSP(WS_CVT);
    bf16_t* Y = (bf16_t*)WSP(WS_Y); const float* i_bias = INP(I_I_BIAS); const float* f_bias = INP(I_F_BIAS); const float* mnorm = INP(I_MNORM);
    const int lane = F.lane, r32 = lane & 31, hi = lane >> 5, grp = F.wave >> 2, w4 = F.wave & 3, lg = F.tid & 255;
    constexpr int KROWB = 144, VROWB = 272, GB = 49152;
    LAS unsigned char* gb = F.lds + grp * GB;
    LAS float* bc = (LAS float*)gb;
    LAS float* gs = bc + 128;
    LAS float* npv = gs + 128;
    LAS float* wsum = npv + 64;
    LAS unsigned char* ct = gb + 2048;
    LAS unsigned char* kt = ct + 9216;
    LAS unsigned char* vt = kt + 18432;
    for (int it0 = 2 * F.vcu; it0 < 512; it0 += 2 * F.G) {
        const int item = it0 + grp, bh = item >> 5, c = item & 31, b = bh >> 2, h = bh & 3, m0 = b * S + c * 128;
        if (lg < 128) { const float f = MISC[(size_t)(m0 + lg) * 16 + 12 + h] + f_bias[l * 4 + h]; bc[lg] = fminf(f, 0.f) - log1pf(__expf(-fabsf(f))); gs[lg] = MISC[(size_t)(m0 + lg) * 16 + 8 + h] + i_bias[l * 4 + h]; }
        if (lg >= 128 && lg < 160) { const int cc = lg - 128; wsum[cc] = (cc < c) ? STATE[(size_t)(bh * 32 + cc) * STATE_STRIDE + 4160] : 0.f; }
        __syncthreads();
        if (lg < 64) {
            float a0 = bc[2 * lane], a1 = bc[2 * lane + 1]; float s = a0 + a1;
#pragma unroll
            for (int o = 1; o < 64; o <<= 1) { const float t = __shfl_up(s, o); if (lane >= o) s += t; }
            const float ex = s - (a0 + a1); const float i0 = gs[2 * lane], i1 = gs[2 * lane + 1];
            bc[2 * lane] = ex + a0; bc[2 * lane + 1] = s; gs[2 * lane] = i0 - (ex + a0); gs[2 * lane + 1] = i1 - s;
            float w = (lane < 32) ? wsum[lane] : 0.f; float suf = w;
#pragma unroll
            for (int o = 1; o < 32; o <<= 1) { const float t = __shfl_down(suf, o); if (lane + o < 32) suf += t; }
            if (lane < 32) wsum[lane] = suf - w;
        }
        __syncthreads();
        { f32x4 a4[4]; float nv = 0.f;
#pragma unroll
          for (int k = 0; k < 4; ++k) a4[k] = (f32x4){0.f, 0.f, 0.f, 0.f};
          for (int cc = 0; cc < c; ++cc) { const float* st = STATE + (size_t)(bh * 32 + cc) * STATE_STRIDE; const float wgt = __expf(wsum[cc]);
#pragma unroll
              for (int k = 0; k < 4; ++k) { const f32x4 v = *(const f32x4*)(st + 4 * (lg + 256 * k)); a4[k] = a4[k] + v * wgt; }
              if (lg < 64) nv = fmaf(wgt, st[4096 + lg], nv); }
#pragma unroll
          for (int k = 0; k < 4; ++k) { const int idx = 4 * (lg + 256 * k), e = idx >> 6, d = idx & 63; u32x2 w; w.x = cvt_pk_bf16(a4[k][0], a4[k][1]); w.y = cvt_pk_bf16(a4[k][2], a4[k][3]); *(LAS u32x2*)(ct + e * KROWB + d * 2) = w; }
          if (lg < 64) npv[lg] = nv; }
#pragma unroll
        for (int k = 0; k < 4; ++k) { const int id = lg + 256 * k, row = id >> 3, ch = id & 7;
            *(LAS u32x4*)(kt + row * KROWB + ch * 16) = *(const u32x4*)(PROJ + (size_t)(m0 + row) * PW + P_CK + h * 64 + ch * 8);
            const int vrow = id >> 4, vch = id & 15;
            *(LAS u32x4*)(vt + vrow * VROWB + vch * 16) = *(const u32x4*)(CVT + (size_t)(b * 256 + h * 64 + vrow) * S + c * 128 + vch * 8); }
        __syncthreads();
        const int j = 32 * w4 + r32, qrow = m0 + j;
        bf16x8 qf[4];
#pragma unroll
        for (int s = 0; s < 4; ++s) qf[s] = *(const bf16x8*)(PROJ + (size_t)qrow * PW + P_CQ + h * 64 + 16 * s + 8 * hi);
        const float bj = bc[j], eb = __expf(bj);
        float qn = 0.f;
#pragma unroll
        for (int s = 0; s < 4; ++s) { const u32x4 w = __builtin_bit_cast(u32x4, qf[s]); const LAS float* np = npv + 16 * s + 8 * hi;
            qn += lo_bf(w.x) * np[0] + hi_bf(w.x) * np[1] + lo_bf(w.y) * np[2] + hi_bf(w.y) * np[3] + lo_bf(w.z) * np[4] + hi_bf(w.z) * np[5] + lo_bf(w.w) * np[6] + hi_bf(w.w) * np[7]; }
        qn += __shfl_xor(qn, 32); qn *= eb;
        f32x16 n0, n1;
#pragma unroll
        for (int r = 0; r < 16; ++r) { n0[r] = 0.f; n1[r] = 0.f; }
#pragma unroll
        for (int ks = 0; ks < 4; ++ks) { const bf16x8 c0 = *(const LAS bf16x8*)(ct + r32 * KROWB + 32 * ks + 16 * hi), c1 = *(const LAS bf16x8*)(ct + (32 + r32) * KROWB + 32 * ks + 16 * hi);
            n0 = __builtin_amdgcn_mfma_f32_32x32x16_bf16(c0, qf[ks], n0, 0, 0, 0); n1 = __builtin_amdgcn_mfma_f32_32x32x16_bf16(c1, qf[ks], n1, 0, 0, 0); }
#pragma unroll
        for (int r = 0; r < 16; ++r) { n0[r] *= eb; n1[r] *= eb; }
        float sa = 0.f;
#pragma unroll 1
        for (int st = 0; st <= w4; ++st) {
            f32x16 p;
#pragma unroll
            for (int r = 0; r < 16; ++r) p[r] = 0.f;
#pragma unroll
            for (int ks = 0; ks < 4; ++ks) { const bf16x8 kf = *(const LAS bf16x8*)(kt + (32 * st + r32) * KROWB + 32 * ks + 16 * hi); p = __builtin_amdgcn_mfma_f32_32x32x16_bf16(kf, qf[ks], p, 0, 0, 0); }
#pragma unroll
            for (int r = 0; r < 16; ++r) { const int s = 32 * st + (r & 3) + 8 * (r >> 2) + 4 * hi; const float a = (s <= j) ? __expf(bj + gs[s]) * p[r] : 0.f; p[r] = a; sa += a; }
#pragma unroll
            for (int k2 = 0; k2 < 2; ++k2) {
                u32x4 pw; pw.x = cvt_pk_bf16(p[8 * k2 + 0], p[8 * k2 + 1]); pw.y = cvt_pk_bf16(p[8 * k2 + 2], p[8 * k2 + 3]); pw.z = cvt_pk_bf16(p[8 * k2 + 4], p[8 * k2 + 5]); pw.w = cvt_pk_bf16(p[8 * k2 + 6], p[8 * k2 + 7]);
                const bf16x8 pf = __builtin_bit_cast(bf16x8, pw);
                const int vo = (32 * st + 16 * k2 + 4 * hi) * 2;
                const u32x2 a0 = *(const LAS u32x2*)(vt + r32 * VROWB + vo), a1 = *(const LAS u32x2*)(vt + r32 * VROWB + vo + 16);
                const u32x2 b0 = *(const LAS u32x2*)(vt + (32 + r32) * VROWB + vo), b1 = *(const LAS u32x2*)(vt + (32 + r32) * VROWB + vo + 16);
                const u32x4 va = {a0.x, a0.y, a1.x, a1.y}, vb4 = {b0.x, b0.y, b1.x, b1.y};
                n0 = __builtin_amdgcn_mfma_f32_32x32x16_bf16(__builtin_bit_cast(bf16x8, va), pf, n0, 0, 0, 0);
                n1 = __builtin_amdgcn_mfma_f32_32x32x16_bf16(__builtin_bit_cast(bf16x8, vb4), pf, n1, 0, 0, 0);
            }
        }
        sa += __shfl_xor(sa, 32);
        const float inv = 1.f / fmaxf(fabsf(qn + sa), 1.f);
        float ss = 0.f;
#pragma unroll
        for (int r = 0; r < 16; ++r) { n0[r] *= inv; n1[r] *= inv; ss += n0[r] * n0[r] + n1[r] * n1[r]; }
        ss += __shfl_xor(ss, 32); const float rr = rsqrtf(ss * (1.f / 64.f) + EPS);
        const float* gp = mnorm + l * 256 + h * 64 + 4 * hi; const bf16_t* op = PROJ + (size_t)qrow * PW + P_CO + h * 64 + 4 * hi; bf16_t* yp = Y + (size_t)qrow * D + 512 + h * 64 + 4 * hi;
#pragma unroll
        for (int g4 = 0; g4 < 4; ++g4) {
            const f32x4 ga = *(const f32x4*)(gp + 8 * g4), gb4 = *(const f32x4*)(gp + 32 + 8 * g4);
            const u32x2 oa = *(const u32x2*)(op + 8 * g4), ob = *(const u32x2*)(op + 32 + 8 * g4);
            u32x2 w0, w1;
            w0.x = cvt_pk_bf16(sigmoid_f(lo_bf(oa.x)) * n0[4 * g4] * rr * ga[0], sigmoid_f(hi_bf(oa.x)) * n0[4 * g4 + 1] * rr * ga[1]);
            w0.y = cvt_pk_bf16(sigmoid_f(lo_bf(oa.y)) * n0[4 * g4 + 2] * rr * ga[2], sigmoid_f(hi_bf(oa.y)) * n0[4 * g4 + 3] * rr * ga[3]);
            w1.x = cvt_pk_bf16(sigmoid_f(lo_bf(ob.x)) * n1[4 * g4] * rr * gb4[0], sigmoid_f(hi_bf(ob.x)) * n1[4 * g4 + 1] * rr * gb4[1]);
            w1.y = cvt_pk_bf16(sigmoid_f(lo_bf(ob.y)) * n1[4 * g4 + 2] * rr * gb4[2], sigmoid_f(hi_bf(ob.y)) * n1[4 * g4 + 3] * rr * gb4[3]);
            *(u32x2*)(yp + 8 * g4) = w0; *(u32x2*)(yp + 32 + 8 * g4) = w1;
        }
        __syncthreads();
    }
}

constexpr size_t WS_SSQV = 244 * MiB;
__device__ __forceinline__ void sgu_mfma(Frame& F, int l) {
    const bf16_t* PROJ = (const bf16_t*)WSP(WS_BIG); bf16_t* Y = (bf16_t*)WSP(WS_Y); const float* SSQV = (const float*)WSP(WS_SSQV);
    const float* gain = INP(I_SGU_NORM) + l * 256; const float* sw = INP(I_SGU_W) + (size_t)l * 4 * 128 * 128; const float* sb = INP(I_SGU_B) + l * 4 * 128;
    const int lane = F.lane, r32 = lane & 31, hi = lane >> 5, dt = F.wave & 1, tt = F.wave >> 1;
    constexpr int VROWB = 272;
    LAS float* r_s = (LAS float*)F.lds;
    LAS unsigned char* vt = F.lds + 512;
    for (int item = F.vcu; item < 512; item += F.G) {
        const int g = item & 3, m0 = (item >> 2) * 128;
        if (F.tid < 128) { const f32x4 q = *(const f32x4*)(SSQV + (size_t)(m0 + F.tid) * 4); r_s[F.tid] = rsqrtf(((q[0] + q[1]) + (q[2] + q[3])) * (1.f / 256.f) + EPS); }
        __syncthreads();
#pragma unroll
        for (int k = 0; k < 2; ++k) { const int id = F.tid + 512 * k, s = id >> 3, d0 = (id & 7) * 8; const float rs = r_s[s];
            const u32x4 w = *(const u32x4*)(PROJ + (size_t)(m0 + s) * PW + P_AV + g * 64 + d0);
            const float v[8] = {lo_bf(w.x), hi_bf(w.x), lo_bf(w.y), hi_bf(w.y), lo_bf(w.z), hi_bf(w.z), lo_bf(w.w), hi_bf(w.w)};
#pragma unroll
            for (int i = 0; i < 8; ++i) *(LAS bf16_t*)(vt + (d0 + i) * VROWB + s * 2) = (bf16_t)f2bf(v[i] * rs); }
        __syncthreads();
        f32x16 acc;
#pragma unroll
        for (int r = 0; r < 16; ++r) acc[r] = 0.f;
        const int t = 32 * tt + r32; const float* wrow = sw + ((size_t)g * 128 + t) * 128;
#pragma unroll 1
        for (int ks = 0; ks < 2 * (tt + 1); ++ks) {
            const bf16x8 af = *(const LAS bf16x8*)(vt + (32 * dt + r32) * VROWB + (16 * ks + 8 * hi) * 2);
            const int s0 = 16 * ks + 8 * hi; const f32x4 w0 = *(const f32x4*)(wrow + s0), w1 = *(const f32x4*)(wrow + s0 + 4);
            u32x4 bw; bw.x = cvt_pk_bf16(s0 + 0 <= t ? w0[0] : 0.f, s0 + 1 <= t ? w0[1] : 0.f); bw.y = cvt_pk_bf16(s0 + 2 <= t ? w0[2] : 0.f, s0 + 3 <= t ? w0[3] : 0.f);
            bw.z = cvt_pk_bf16(s0 + 4 <= t ? w1[0] : 0.f, s0 + 5 <= t ? w1[1] : 0.f); bw.w = cvt_pk_bf16(s0 + 6 <= t ? w1[2] : 0.f, s0 + 7 <= t ? w1[3] : 0.f);
            acc = __builtin_amdgcn_mfma_f32_32x32x16_bf16(af, __builtin_bit_cast(bf16x8, bw), acc, 0, 0, 0);
        }
        const float bias = sb[g * 128 + t]; const size_t row = (size_t)(m0 + t);
        const float* gp = gain + g * 64 + 32 * dt + 4 * hi; const bf16_t* up = PROJ + row * PW + P_AU + g * 64 + 32 * dt + 4 * hi; bf16_t* yp = Y + row * D + g * 64 + 32 * dt + 4 * hi;
#pragma unroll
        for (int g4 = 0; g4 < 4; ++g4) { const f32x4 gv = *(const f32x4*)(gp + 8 * g4); const u32x2 uw = *(const u32x2*)(up + 8 * g4); u32x2 ow;
            ow.x = cvt_pk_bf16(lo_bf(uw.x) * (gv[0] * acc[4 * g4] + bias), hi_bf(uw.x) * (gv[1] * acc[4 * g4 + 1] + bias));
            ow.y = cvt_pk_bf16(lo_bf(uw.y) * (gv[2] * acc[4 * g4 + 2] + bias), hi_bf(uw.y) * (gv[3] * acc[4 * g4 + 3] + bias));
            *(u32x2*)(yp + 8 * g4) = ow; }
        __syncthreads();
    }
}

__device__ __forceinline__ void mlstm1_mfma(Frame& F, int l) {
    const float* MISC = (const float*)WSP(WS_MISC); float* STATE = (float*)WSP(WS_STATE); const bf16_t* PROJ = (const bf16_t*)WSP(WS_BIG); const bf16_t* CVT = (const bf16_t*)WSP(WS_CVT);
    const float* i_bias = INP(I_I_BIAS); const float* f_bias = INP(I_F_BIAS);
    const int lane = F.lane, r32 = lane & 31, hi = lane >> 5, grp = F.wave >> 2, w4 = F.wave & 3, et = w4 & 1, dt = w4 >> 1, lg = F.tid & 255;
    constexpr int KROWB = 144, GB = 20480;
    LAS unsigned char* gb = F.lds + grp * GB;
    LAS float* bc = (LAS float*)gb; LAS float* wk = bc + 128; LAS unsigned char* kt = gb + 1024;
    for (int it0 = 2 * F.vcu; it0 < 512; it0 += 2 * F.G) {
        const int item = it0 + grp, bh = item >> 5, c = item & 31, b = bh >> 2, h = bh & 3, m0 = b * S + c * 128;
        if (lg < 128) { const float f = MISC[(size_t)(m0 + lg) * 16 + 12 + h] + f_bias[l * 4 + h]; bc[lg] = fminf(f, 0.f) - log1pf(__expf(-fabsf(f))); wk[lg] = MISC[(size_t)(m0 + lg) * 16 + 8 + h] + i_bias[l * 4 + h]; }
        __syncthreads();
        if (lg < 64) { const float a0 = bc[2 * lane], a1 = bc[2 * lane + 1]; float s = a0 + a1;
#pragma unroll
            for (int o = 1; o < 64; o <<= 1) { const float t = __shfl_up(s, o); if (lane >= o) s += t; }
            const float tot = __shfl(s, 63), ex = s - (a0 + a1);
            wk[2 * lane] = __expf(tot - (ex + a0) + wk[2 * lane]); wk[2 * lane + 1] = __expf(tot - s + wk[2 * lane + 1]);
            if (lane == 0) bc[0] = tot; }
        __syncthreads();
        const float Bc = bc[0];
#pragma unroll
        for (int k = 0; k < 4; ++k) { const int id = lg + 256 * k, s = id >> 3, ch = id & 7; const float ws_ = wk[s];
            const u32x4 w = *(const u32x4*)(PROJ + (size_t)(m0 + s) * PW + P_CK + h * 64 + ch * 8); u32x4 o;
            o.x = cvt_pk_bf16(lo_bf(w.x) * ws_, hi_bf(w.x) * ws_); o.y = cvt_pk_bf16(lo_bf(w.y) * ws_, hi_bf(w.y) * ws_); o.z = cvt_pk_bf16(lo_bf(w.z) * ws_, hi_bf(w.z) * ws_); o.w = cvt_pk_bf16(lo_bf(w.w) * ws_, hi_bf(w.w) * ws_);
            *(LAS u32x4*)(kt + s * KROWB + ch * 16) = o; }
        __syncthreads();
        f32x16 acc;
#pragma unroll
        for (int r = 0; r < 16; ++r) acc[r] = 0.f;
        float nsum = 0.f;
        const bf16_t* vp = CVT + (size_t)(b * 256 + h * 64 + 32 * et + r32) * S + c * 128 + 8 * hi;
        bf16x8 af[8];
#pragma unroll
        for (int ks = 0; ks < 8; ++ks) af[ks] = *(const bf16x8*)(vp + 16 * ks);
#pragma unroll
        for (int ks = 0; ks < 8; ++ks) {
            const LAS unsigned char* kp = kt + (16 * ks + 8 * hi) * KROWB + (32 * dt + r32) * 2; unsigned e8[8];
#pragma unroll
            for (int jj = 0; jj < 8; ++jj) e8[jj] = *(const LAS bf16_t*)(kp + jj * KROWB);
            u32x4 bw; bw.x = e8[0] | (e8[1] << 16); bw.y = e8[2] | (e8[3] << 16); bw.z = e8[4] | (e8[5] << 16); bw.w = e8[6] | (e8[7] << 16);
#pragma unroll
            for (int jj = 0; jj < 8; ++jj) nsum += __uint_as_float(e8[jj] << 16);
            acc = __builtin_amdgcn_mfma_f32_32x32x16_bf16(af[ks], __builtin_bit_cast(bf16x8, bw), acc, 0, 0, 0);
        }
        float* st = STATE + (size_t)item * STATE_STRIDE;
#pragma unroll
        for (int r = 0; r < 16; ++r) st[(32 * et + (r & 3) + 8 * (r >> 2) + 4 * hi) * 64 + 32 * dt + r32] = acc[r];
        nsum += __shfl_xor(nsum, 32);
        if (et == 0 && hi == 0) st[4096 + 32 * dt + r32] = nsum;
        if (lg == 0) st[4160] = Bc;
        __syncthreads();
    }
}
#ifndef MK_MULTI
#define MK_MULTI 0
#endif
constexpr int N_PHASES = 1 + 10 * DEPTH;

__global__ void __launch_bounds__(NT, 2) mk_fwd(Args args) {
    extern __shared__ __attribute__((aligned(16))) unsigned char lds_raw[];
    Frame F;
    F.lds = (LAS unsigned char*)lds_raw; F.tid = threadIdx.x; F.lane = F.tid & 63; F.wave = __builtin_amdgcn_readfirstlane(F.tid >> 6);
    F.G = gridDim.x; { const int bx_ = blockIdx.x; F.vcu = (F.G % 8 == 0) ? (bx_ % 8) * (F.G / 8) + bx_ / 8 : bx_; }
    if (F.tid < 20) { const unsigned long long pv = F.tid < 18 ? (unsigned long long)args.in[F.tid < 18 ? F.tid : 0] : (F.tid == 18 ? (unsigned long long)args.out : (unsigned long long)args.ws);
        *(LAS unsigned long long*)(F.lds + PTR_OFF + 8 * F.tid) = pv; }
    if (F.tid < 2) *(LAS unsigned*)(F.lds + PTR_OFF + 256 + 4 * F.tid) = 0u;
    __syncthreads();
    XcdBarrier xbar; xbar.bar = (unsigned*)(args.ws + WS_BAR); xbar.x = 0; xbar.st = (volatile LAS unsigned*)(F.lds + PTR_OFF + 256);
    if (args.coop) xbar = xcd_barrier_post((unsigned*)(args.ws + WS_BAR), (volatile LAS unsigned*)(F.lds + PTR_OFF + 256));
    const int lo = args.ph_lo, hi = args.ph_hi; const bool coop = args.coop != 0;
#define RUN(k) (lo <= (k) && (k) < hi)
#define LAUNDER() asm volatile("" : "+v"(F.tid), "+v"(F.lane))
#define SEAM(k) do { if (coop && RUN(k) && RUN((k) + 1)) { if ((k) == 0) cg::this_grid().sync(); else xcd_barrier(xbar); } } while (0)
    const int bx = (int)blockIdx.x;

    if (RUN(0)) { LAUNDER(); convert_mix_weights(F, 0); prologue_rows(F);
        if (blockIdx.x == 0 && F.tid < DEPTH * 192) { const int l_ = F.tid / 192, r_ = F.tid % 192, w_ = r_ / 64, i_ = r_ % 64; ((float*)WSP(WS_GT))[F.tid] = INP(I_Q_NORM + w_)[l_ * 64 + i_]; } }
    SEAM(0);
#pragma unroll 1
    for (int l = 0; l < DEPTH; ++l) {
        const int pb = 1 + 10 * l;
        if (RUN(pb + 0)) { LAUNDER();
            pg8::Gemm<D, D, D, 256u * D * 2, 0, 256u * D * 2, 0> g{(const bf16_t*)WSP(WS_XG), (const bf16_t*)WSP(WS_WIN)};
            pg8::StaticOrder So; So.init(M, PW, F.G, bx);
            epi::EpiProj E{(bf16_t*)WSP(WS_BIG), (float*)WSP(WS_MISC), (const float*)WSP(WS_RSA), (const float*)WSP(WS_COS), (const float*)WSP(WS_SIN), (const float*)WSP(WS_GT) + l * 192, (bf16_t*)WSP(WS_VT), (bf16_t*)WSP(WS_KI), (bf16_t*)WSP(WS_CVT), (float*)WSP(WS_SSQV)};
            pg8::gemm_phase<epi::EpiProj, pg8::StaticOrder, true>(F.lds, g, So, E, F.tid);
        }
        SEAM(pb + 0);
        if (RUN(pb + 1)) { LAUNDER(); sgu_mfma(F, l); conv_simple(F, l); indexer_mfma(F); mlstm1_mfma(F, l); }
        SEAM(pb + 1);
        if (RUN(pb + 2)) { LAUNDER(); attn_mfma(F, l); mlstm2_mfma(F, l); }
        SEAM(pb + 2);
        if (RUN(pb + 3)) { LAUNDER();
            pg8::Gemm<256, D, 256, 256u * D * 2, 256u * 2, 256u * 256 * 2, 1024u * 256 * 2> g{(const bf16_t*)WSP(WS_Y), (const bf16_t*)WSP(WS_WBR)};
            pg8::SuperOrder<0> So; So.init(F.G, bx);
            epi::EpiPlain E{(bf16_t*)WSP(WS_BIG), 4096, 1024};
            pg8::gemm_phase<epi::EpiPlain, pg8::SuperOrder<0>, true>(F.lds, g, So, E, F.tid);
        }
        if (coop && RUN(pb + 3) && RUN(pb + 4)) { asm volatile("s_waitcnt vmcnt(0)" ::: "memory"); __syncthreads(); __builtin_amdgcn_fence(__ATOMIC_ACQUIRE, "agent"); asm volatile("s_waitcnt vmcnt(0)" ::: "memory"); __syncthreads(); }
        if (RUN(pb + 4)) { LAUNDER();
            pg8::Gemm<D, D, D, 256u * D * 2, 0, 256u * D * 2, 0> g{(const bf16_t*)WSP(WS_XG), (const bf16_t*)WSP(WS_WG)};
            pg8::SuperOrder<1> So; So.init(F.G, bx);
            epi::EpiGate E{(bf16_t*)WSP(WS_MG), (const bf16_t*)WSP(WS_BIG), (const float*)WSP(WS_RSA)};
            pg8::gemm_phase<epi::EpiGate, pg8::SuperOrder<1>, true>(F.lds, g, So, E, F.tid);
        }
        SEAM(pb + 4);
        if (RUN(pb + 5)) { LAUNDER();
            pg8::Gemm<D, D, D, 256u * D * 2, 0, 256u * D * 2, 0> g{(const bf16_t*)WSP(WS_MG), (const bf16_t*)WSP(WS_WOUT)};
            pg8::StaticOrder So; So.init(M, D, F.G, bx);
            epi::EpiResid E{l == 0 ? INP(I_X) : nullptr, (bf16_t*)WSP(WS_XG), nullptr, (float*)WSP(WS_SSQB)};
            pg8::gemm_phase<epi::EpiResid, pg8::StaticOrder, true>(F.lds, g, So, E, F.tid);
            __syncthreads();
            convert_mlp_weights(F, l);
        }
        SEAM(pb + 5);
        if (RUN(pb + 6)) { LAUNDER(); finalize_rs(F, WS_SSQB, WS_RSB); }
        SEAM(pb + 6);
        if (RUN(pb + 7)) { LAUNDER();
            pg8::Gemm<D, D, D, 256u * D * 2, 0, 256u * D * 2, 0> g{(const bf16_t*)WSP(WS_XG), (const bf16_t*)WSP(WS_WUP)};
            pg8::StaticOrder So; So.init(M, FF, F.G, bx);
            epi::EpiUp E{(bf16_t*)WSP(WS_BIG), (const float*)WSP(WS_RSB)};
            pg8::gemm_phase<epi::EpiUp, pg8::StaticOrder, true>(F.lds, g, So, E, F.tid);
            if (l + 1 < DEPTH) { __syncthreads(); convert_mix_weights(F, l + 1); }
        }
        SEAM(pb + 7);
        if (RUN(pb + 8)) { LAUNDER();
            pg8::Gemm<FF, FF, FF, 256u * FF * 2, 0, 256u * FF * 2, 0> g{(const bf16_t*)WSP(WS_BIG), (const bf16_t*)WSP(WS_WDN)};
            pg8::StaticOrder So; So.init(M, D, F.G, bx);
            epi::EpiResid E{nullptr, (bf16_t*)WSP(WS_XG), (l + 1 < DEPTH) ? nullptr : (float*)ptr_at(F, I_OUT), (float*)WSP(WS_SSQA)};
            pg8::gemm_phase<epi::EpiResid, pg8::StaticOrder, true>(F.lds, g, So, E, F.tid);
        }
        SEAM(pb + 8);
        if (RUN(pb + 9)) { LAUNDER(); if (l + 1 < DEPTH) finalize_rs(F, WS_SSQA, WS_RSA); }
        SEAM(pb + 9);
    }
#undef RUN
#undef SEAM
}

extern "C" void kernel_launch(void* const* d_in, const int* in_sizes, int n_in, void* d_out, int out_size, void* d_ws, size_t ws_size, hipStream_t stream) {
    static int grid = 0;
    if (grid == 0) {
        if (n_in != 18 || in_sizes[0] != M * D || out_size != M * D || ws_size < WS_END) { fprintf(stderr, "kernel_launch: unexpected shapes (n_in %d, in0 %d, out %d, ws %zu)\n", n_in, n_in > 0 ? in_sizes[0] : -1, out_size, ws_size); grid = -1; return; }
        int dev = 0, cus = 0, per_cu = 0;
        if (hipGetDevice(&dev) != hipSuccess || hipDeviceGetAttribute(&cus, hipDeviceAttributeMultiprocessorCount, dev) != hipSuccess) { grid = -1; return; }
        if (hipFuncSetAttribute((const void*)mk_fwd, hipFuncAttributeMaxDynamicSharedMemorySize, LDS_BYTES) != hipSuccess) { fprintf(stderr, "kernel_launch: hipFuncSetAttribute failed\n"); grid = -1; return; }
        if (hipOccupancyMaxActiveBlocksPerMultiprocessor(&per_cu, (const void*)mk_fwd, NT, LDS_BYTES) != hipSuccess || per_cu < 1) { fprintf(stderr, "kernel_launch: occupancy query says %d\n", per_cu); (void)hipGetLastError(); per_cu = 1; }
        grid = cus;
    }
    if (grid < 0) return;
    if (hipMemsetAsync((char*)d_ws + WS_CTL, 0, CTL_ZERO_BYTES, stream) != hipSuccess) { fprintf(stderr, "kernel_launch: memset failed\n"); return; }
    Args a{};
    for (int i = 0; i < 18; ++i) a.in[i] = (const float*)d_in[i];
    a.out = (float*)d_out; a.ws = (unsigned char*)d_ws;
#if MK_MULTI
    for (int p = 0; p < N_PHASES; ++p) { a.ph_lo = p; a.ph_hi = p + 1; a.coop = 0; hipLaunchKernelGGL(mk_fwd, dim3(grid), dim3(NT), LDS_BYTES, stream, a); }
#else
    a.ph_lo = 0; a.ph_hi = N_PHASES - 1; a.coop = 1;
    void* kargs[] = {&a};
    hipError_t e = hipLaunchCooperativeKernel((const void*)mk_fwd, dim3(grid), dim3(NT), kargs, LDS_BYTES, stream);
    if (e != hipSuccess) fprintf(stderr, "kernel_launch: cooperative launch failed: %s (grid %d)\n", hipGetErrorString(e), grid);
#endif
}
```

```cpp
#define MK_MULTI 0
#include <hip/hip_runtime.h>
#include <hip/hip_cooperative_groups.h>
#include <cstdio>
#include <cstdint>
namespace cg = cooperative_groups;

#define LAS __attribute__((address_space(3)))
typedef unsigned short bf16_t;
typedef short bf16x8 __attribute__((ext_vector_type(8)));
typedef float f32x4 __attribute__((ext_vector_type(4)));
typedef float f32x2 __attribute__((ext_vector_type(2)));
typedef unsigned u32x4 __attribute__((ext_vector_type(4)));
typedef unsigned u32x2 __attribute__((ext_vector_type(2)));

constexpr int D = 1024, NB = 4, S = 4096, M = NB * S, DEPTH = 2, FF = 4096, INW = 7760;
constexpr int O_AU = 0, O_AV = 256, O_BQ = 512, O_BK = 768, O_BV = 1024, O_QI = 1280, O_KI = 1792, O_WI = 1856,
              O_CQ = 1864, O_CK = 2120, O_CV = 2376, O_CO = 2632, O_CI = 2888, O_CF = 2892, O_DB = 2896, O_DC = 3152, O_DX = 3408, O_G = 3664;
constexpr int PW = 3840;
constexpr int P_AU = 0, P_AV = 256, P_Q = 512, P_K = 768, P_V = 1024, P_QI = 1280, P_CQ = 1792, P_CK = 2048, P_CV = 2304, P_CO = 2560,
              P_DB = 2816, P_DC = 3072, P_DX = 3328, P_KI = 3584;
constexpr float EPS = 1e-6f;
constexpr int NWAVES = 8, NT = 512;

constexpr size_t MiB = 1u << 20;
constexpr size_t WS_CTL = 0;
constexpr size_t WS_COS = 1 * MiB, WS_SIN = 1 * MiB + 512 * 1024;
constexpr size_t WS_MISC = 2 * MiB;
constexpr size_t WS_SSQA = 3 * MiB, WS_SSQB = 4 * MiB;
constexpr size_t WS_WIN = 5 * MiB;
constexpr size_t WS_WG = WS_WIN + (size_t)PW * D * 2;
constexpr size_t WS_WBR = WS_WG + (size_t)4096 * D * 2;
constexpr size_t WS_WOUT = WS_WBR + (size_t)4 * 1024 * 256 * 2;
constexpr size_t WS_XG = 25 * MiB;
constexpr size_t WS_BIG = 57 * MiB;
constexpr size_t WS_Y = 185 * MiB;
constexpr size_t WS_WUP = WS_Y, WS_WDN = WS_Y + 8 * MiB;
constexpr size_t WS_MG = 217 * MiB;
constexpr size_t WS_MASK = WS_MG, WS_STATE = WS_MG + 8 * MiB;
constexpr size_t WS_END = 249 * MiB;
constexpr int STATE_STRIDE = 4224;
static_assert(WS_WOUT + (size_t)D * D * 2 <= WS_XG && WS_STATE + (size_t)512 * STATE_STRIDE * 4 <= WS_END && WS_END <= 256 * MiB, "d_ws map");

constexpr int LDS_BYTES = 155648;

__device__ __forceinline__ float bf2f(bf16_t v) { return __uint_as_float((unsigned)v << 16); }
__device__ __forceinline__ unsigned f2bf(float f) { unsigned u = __float_as_uint(f); return (u + 0x7fffu + ((u >> 16) & 1u)) >> 16; }
__device__ __forceinline__ unsigned pk2(float lo, float hi) { return f2bf(lo) | (f2bf(hi) << 16); }
typedef __bf16 bf16x2_t __attribute__((ext_vector_type(2)));
__device__ __forceinline__ unsigned cvt_pk_bf16(float lo, float hi) { const f32x2 v = {lo, hi}; return __builtin_bit_cast(unsigned, __builtin_convertvector(v, bf16x2_t)); }
__device__ __forceinline__ float lo_bf(unsigned w) { return __uint_as_float(w << 16); }
__device__ __forceinline__ float hi_bf(unsigned w) { return __uint_as_float(w & 0xffff0000u); }
__device__ __forceinline__ float wave_sum(float v) {
#pragma unroll
    for (int o = 1; o < 64; o <<= 1) v += __shfl_xor(v, o);
    return v;
}
__device__ __forceinline__ float wave_max(float v) {
#pragma unroll
    for (int o = 1; o < 64; o <<= 1) v = fmaxf(v, __shfl_xor(v, o));
    return v;
}
__device__ __forceinline__ int wave_sum_i(int v) {
#pragma unroll
    for (int o = 1; o < 64; o <<= 1) v += __shfl_xor(v, o);
    return v;
}
__device__ __forceinline__ float sigmoid_f(float x) { return __builtin_amdgcn_rcpf(1.f + __builtin_amdgcn_exp2f(-1.4426950408889634f * x)); }
__device__ __forceinline__ float gelu_tanh_f(float x) { const float u = 0.7978845608028654f * (x + 0.044715f * x * x * x); return x * __builtin_amdgcn_rcpf(1.f + __builtin_amdgcn_exp2f(-2.8853900817779268f * u)); }
__device__ __forceinline__ unsigned fkey(float s) { const unsigned u = __float_as_uint(s); return (u & 0x80000000u) ? ~u : (u | 0x80000000u); }

namespace pg8 {
constexpr int BM = 256, BK = 64, HALF = 128, HTB = HALF * BK * 2, STAGE_BYTES = 8 * HTB, NXCD = 8, WGM = 8;
__host__ __device__ __forceinline__ int lds_byte(int r, int c) { const int st = (r >> 4) * 2 + (c >> 5), rr = r & 15, cc = c & 31, ob = rr * 64 + cc * 2; return st * 1024 + (ob ^ (((ob >> 9) & 1) << 5)); }
__host__ __device__ __forceinline__ void stage_rc(int b, int& R, int& C) { const int st = b / 1024, sb = b % 1024, swz = sb ^ (((sb >> 9) & 1) << 5); R = (st >> 1) * 16 + swz / 64; C = (st & 1) * 32 + (swz % 64) / 2; }
__host__ __device__ __forceinline__ int perm32(int rho) { const int n = rho >> 4, i = rho & 15; return 8 * (i >> 2) + 4 * n + (i & 3); }

struct Unit { int pm, pn, z; };
template <int K_, int LDA_, int LDB_, unsigned APM_, unsigned AZ_, unsigned BPN_, unsigned BZ_> struct Gemm {
    const bf16_t* A; const bf16_t* Bt;
    static constexpr int K = K_, lda = LDA_, ldb = LDB_; static constexpr unsigned aPm = APM_, aZ = AZ_, bPn = BPN_, bZ = BZ_;
};
template <class G> __device__ __forceinline__ const char* pa(const G& g, const Unit& u) { return (const char*)g.A + (size_t)((unsigned)u.pm * G::aPm + (unsigned)u.z * G::aZ); }
template <class G> __device__ __forceinline__ const char* pb(const G& g, const Unit& u) { return (const char*)g.Bt + (size_t)((unsigned)u.pn * G::bPn + (unsigned)u.z * G::bZ); }

struct StaticOrder {
    int nM, nN, nwg, G, c;
    __host__ __device__ void init(int M_, int N_, int G_, int c_) { nM = M_ / BM; nN = N_ / BM; nwg = nM * nN; G = G_; c = c_; }
    __host__ __device__ bool next(int i, Unit& u) const {
        const long L = (long)i * G + c; if (L >= nwg) return false;
        int wgid = (int)L; { const int q = nwg / NXCD, r = nwg % NXCD, xcd = wgid % NXCD, off = wgid / NXCD; wgid = (xcd < r ? xcd * (q + 1) : r * (q + 1) + (xcd - r) * q) + off; }
        const int nig = WGM * nN, gid = wgid / nig, fm = gid * WGM, gsz = (nM - fm) < WGM ? (nM - fm) : WGM;
        u.pm = fm + ((wgid % nig) % gsz); u.pn = (wgid % nig) / gsz; u.z = 0; return true;
    }
};
template <int MODE> struct SuperOrder {
    StaticOrder so;
    __host__ __device__ void init(int G_, int c_) { so.init(M, 1024, G_, c_); }
    __host__ __device__ bool next(int i, Unit& u) const {
        Unit b; if (!so.next(i >> 2, b)) return false;
        const int sub = i & 3; u.pm = b.pm; if (MODE == 0) { u.pn = b.pn; u.z = sub; } else { u.pn = 4 * b.pn + sub; u.z = 0; } return true;
    }
};

template <class Epi, class Sched, bool ALIGN_EPI, class GemmT>
__device__ __forceinline__ void gemm_phase(LAS unsigned char* lds, const GemmT g, const Sched& S, const Epi& E, const int tid) {
    const int wid = __builtin_amdgcn_readfirstlane(tid >> 6), lane = tid & 63, wr = wid >> 2, wc = wid & 3, fr = lane & 15, fq = lane >> 4;
    constexpr int K = GemmT::K, nt = K / BK;
    unsigned voffA[2], voffB[2];
#pragma unroll
    for (int i = 0; i < 2; ++i) { int R, C; stage_rc(tid * 16 + i * 8192, R, C); const int Rb = Epi::PERM ? ((R & ~31) + perm32(R & 31)) : R;
        voffA[i] = (unsigned)(R * GemmT::lda + C) * 2u; voffB[i] = (unsigned)(Rb * GemmT::ldb + C) * 2u; }
    const size_t kstep = (size_t)(BK * 2);
    constexpr size_t hA = (size_t)HALF * GemmT::lda * 2, hB = (size_t)HALF * GemmT::ldb * 2;
    const unsigned ldsw = (unsigned)wid * 1024u;
    const int aoff = lds_byte(wr * 64 + fr, fq * 8), boff = lds_byte(wc * 32 + fr, fq * 8);
#define PG8_SA(b, h) (((b) * 2 + (h)) * HTB)
#define PG8_SB(b, h) ((4 + (b) * 2 + (h)) * HTB)
#define PG8_STAGE(bufoff, gbase, voff) do { _Pragma("unroll") for (int _i = 0; _i < 2; ++_i) \
        __builtin_amdgcn_global_load_lds((const unsigned*)((const char*)(gbase) + (voff)[_i]), (LAS unsigned*)(lds + (bufoff) + ldsw + _i * 8192), 16, 0, 0); } while (0)
#define PG8_LDA(dst, b, h) do { _Pragma("unroll") for (int m = 0; m < 4; ++m) _Pragma("unroll") for (int k = 0; k < 2; ++k) dst[m][k] = *(const LAS bf16x8*)(lds + PG8_SA(b, h) + aoff + m * 2048 + k * 1024); } while (0)
#define PG8_LDB(dst, b, h) do { _Pragma("unroll") for (int n = 0; n < 2; ++n) _Pragma("unroll") for (int k = 0; k < 2; ++k) dst[n][k] = *(const LAS bf16x8*)(lds + PG8_SB(b, h) + boff + n * 2048 + k * 1024); } while (0)
#define PG8_MMA(ai, bj, At, Bt) do { __builtin_amdgcn_s_setprio(1); _Pragma("unroll") for (int m = 0; m < 4; ++m) _Pragma("unroll") for (int n = 0; n < 2; ++n) _Pragma("unroll") for (int k = 0; k < 2; ++k) \
        acc[ai][bj][m][n] = __builtin_amdgcn_mfma_f32_16x16x32_bf16(Bt[n][k], At[m][k], acc[ai][bj][m][n], 0, 0, 0); __builtin_amdgcn_s_setprio(0); } while (0)
#define PG8_WAIT_V(n) asm volatile("s_waitcnt vmcnt(" #n ")" ::: "memory")
#define PG8_WAIT_L(n) asm volatile("s_waitcnt lgkmcnt(" #n ")" ::: "memory")
#define PG8_BAR __builtin_amdgcn_s_barrier()
#define PG8_SCHED __builtin_amdgcn_sched_barrier(0)
    Unit cur, nxt; int ui = 0;
    if (!S.next(0, cur)) return;
    f32x4 acc[2][2][4][2];
#pragma unroll
    for (int a = 0; a < 2; ++a)
#pragma unroll
        for (int b = 0; b < 2; ++b)
#pragma unroll
            for (int m = 0; m < 4; ++m)
#pragma unroll
                for (int n = 0; n < 2; ++n) acc[a][b][m][n] = (f32x4){0.f, 0.f, 0.f, 0.f};
    bf16x8 At[4][2], B0[2][2], B1[2][2];
    const char* cA = pa(g, cur); const char* cB = pb(g, cur);
    PG8_STAGE(PG8_SB(0, 0), cB, voffB); PG8_STAGE(PG8_SB(0, 1), cB + hB, voffB); PG8_STAGE(PG8_SA(0, 0), cA, voffA); PG8_STAGE(PG8_SA(0, 1), cA + hA, voffA);
    if (wr == 1) PG8_BAR;
    PG8_WAIT_V(2); PG8_BAR;
    PG8_STAGE(PG8_SB(1, 0), cB + kstep, voffB); PG8_STAGE(PG8_SA(1, 0), cA + kstep, voffA); PG8_STAGE(PG8_SB(1, 1), cB + hB + kstep, voffB);
    PG8_WAIT_V(6); PG8_BAR;
    for (;;) {
        const bool has_next = S.next(ui + 1, nxt);
        const char* nA = has_next ? pa(g, nxt) : cA; const char* nB = has_next ? pb(g, nxt) : cB;
#pragma unroll 1
        for (int t = 0; t < nt; t += 2) {
            const bool last = (t == nt - 2);
            const char* a1 = cA + (size_t)(t + 1) * kstep;
            const char* a2 = last ? nA : cA + (size_t)(t + 2) * kstep; const char* b2 = last ? nB : cB + (size_t)(t + 2) * kstep;
            const char* a3 = a2 + kstep; const char* b3 = b2 + kstep;
            PG8_LDB(B0, 0, 0); PG8_LDB(B1, 0, 1); PG8_SCHED; PG8_LDA(At, 0, 0); PG8_STAGE(PG8_SA(1, 1), a1 + hA, voffA);
            PG8_WAIT_V(8); PG8_WAIT_L(0); PG8_BAR; PG8_MMA(0, 0, At, B0); PG8_MMA(0, 1, At, B1); PG8_BAR; PG8_SCHED;
            PG8_LDA(At, 0, 1); PG8_STAGE(PG8_SB(0, 0), b2, voffB); PG8_STAGE(PG8_SB(0, 1), b2 + hB, voffB); PG8_STAGE(PG8_SA(0, 0), a2, voffA);
            PG8_WAIT_V(8); PG8_WAIT_L(0); PG8_BAR; PG8_MMA(1, 0, At, B0); PG8_MMA(1, 1, At, B1); PG8_BAR; PG8_SCHED;
            PG8_LDB(B0, 1, 0); PG8_LDB(B1, 1, 1); PG8_SCHED; PG8_LDA(At, 1, 0); PG8_STAGE(PG8_SA(0, 1), a2 + hA, voffA);
            PG8_WAIT_V(8); PG8_WAIT_L(0); PG8_BAR; PG8_MMA(0, 0, At, B0); PG8_MMA(0, 1, At, B1); PG8_BAR; PG8_SCHED;
            PG8_LDA(At, 1, 1); PG8_STAGE(PG8_SB(1, 0), b3, voffB); PG8_STAGE(PG8_SB(1, 1), b3 + hB, voffB); PG8_STAGE(PG8_SA(1, 0), a3, voffA);
            PG8_WAIT_V(8); PG8_WAIT_L(0); PG8_BAR; PG8_MMA(1, 0, At, B0); PG8_MMA(1, 1, At, B1); PG8_BAR; PG8_SCHED;
        }
        if constexpr (ALIGN_EPI) { if (wr == 0) PG8_BAR; }
        { int fr2 = fr, fq2 = fq; asm volatile("" : "+v"(fr2), "+v"(fq2)); E(acc, cur, wr, wc, fr2, fq2); }
        if (!has_next) break;
#pragma unroll
        for (int a = 0; a < 2; ++a)
#pragma unroll
            for (int b = 0; b < 2; ++b)
#pragma unroll
                for (int m = 0; m < 4; ++m)
#pragma unroll
                    for (int n = 0; n < 2; ++n) acc[a][b][m][n] = (f32x4){0.f, 0.f, 0.f, 0.f};
        cur = nxt; cA = nA; cB = nB; ++ui;
        if constexpr (ALIGN_EPI) { if (wr == 1) PG8_BAR; }
    }
    PG8_WAIT_V(0);
    if constexpr (!ALIGN_EPI) { if (wr == 0) PG8_BAR; }
    PG8_BAR;
#undef PG8_SA
#undef PG8_SB
#undef PG8_STAGE
#undef PG8_LDA
#undef PG8_LDB
#undef PG8_MMA
#undef PG8_WAIT_V
#undef PG8_WAIT_L
#undef PG8_BAR
#undef PG8_SCHED
}
}
namespace epi {
using pg8::Unit;
typedef f32x4 Acc[2][2][4][2];

__device__ __forceinline__ float row_scale(const float* rs, int row) { return rs[row]; }
__device__ __forceinline__ u32x4 pack8(const f32x4 a, const f32x4 b) { u32x4 w; w.x = cvt_pk_bf16(a[0], a[1]); w.y = cvt_pk_bf16(a[2], a[3]); w.z = cvt_pk_bf16(b[0], b[1]); w.w = cvt_pk_bf16(b[2], b[3]); return w; }

struct EpiProj {
    static constexpr bool PERM = true;
    bf16_t* P; float* misc; const float* ssq; const float* cs; const float* sn; const float* gt;     bf16_t* VT;     bf16_t* KI;     bf16_t* CVT;     float* ssqv;
    __device__ __forceinline__ void operator()(const Acc& acc, const Unit& u, int wr, int wc, int fr, int fq) const {
        const int T = u.pn; const int row0 = u.pm * 256 + wr * 64 + fr;
        if (T == 2 || T == 3 || T == 5 || T == 6 || T == 14) {
            if (T == 14 && wc >= 2) return;
            if (T == 14 && wc == 1) {
                if (fq < 2) {
#pragma unroll
                    for (int ai = 0; ai < 2; ++ai)
#pragma unroll
                        for (int m = 0; m < 4; ++m) { const int row = row0 + ai * 128 + m * 16; const float rs = row_scale(ssq, row);
                            float* mp = misc + (size_t)row * 16 + 8 * fq; *(f32x4*)mp = acc[ai][0][m][0] * rs; *(f32x4*)(mp + 4) = acc[ai][0][m][1] * rs; }
                }
                return;
            }
            const int mode = (T == 14) ? 2 : (T <= 3 ? 1 : 0);
            const float* gp = gt + 64 * ((T == 2) ? 0 : (T == 3) ? 1 : 2);
            f32x4 g1[2], g2[2];
#pragma unroll
            for (int n = 0; n < 2; ++n) { if (mode) { g1[n] = *(const f32x4*)(gp + 8 * fq + 4 * n); g2[n] = *(const f32x4*)(gp + 32 + 8 * fq + 4 * n); } else { g1[n] = (f32x4){1.f, 1.f, 1.f, 1.f}; g2[n] = g1[n]; } }
#pragma unroll
            for (int ai = 0; ai < 2; ++ai)
#pragma unroll
                for (int m = 0; m < 4; ++m) {
                    const int row = row0 + ai * 128 + m * 16; const float rs = row_scale(ssq, row); const int pos = row & (S - 1);
                    f32x4 x1[2], x2[2];
#pragma unroll
                    for (int n = 0; n < 2; ++n) { x1[n] = acc[ai][0][m][n] * rs; x2[n] = acc[ai][1][m][n] * rs; }
                    if (mode == 2) {
                        float s = 0.f;
#pragma unroll
                        for (int n = 0; n < 2; ++n) s += (x1[n][0] + x1[n][1]) + (x1[n][2] + x1[n][3]) + (x2[n][0] + x2[n][1]) + (x2[n][2] + x2[n][3]);
                        s += __shfl_xor(s, 16); s += __shfl_xor(s, 32); const float mu = s * (1.f / 64.f);
#pragma unroll
                        for (int n = 0; n < 2; ++n) { x1[n] = x1[n] - mu; x2[n] = x2[n] - mu; }
                    }
                    if (mode) {
                        float q = 0.f;
#pragma unroll
                        for (int n = 0; n < 2; ++n) { const f32x4 a = x1[n] * x1[n], b = x2[n] * x2[n]; q += (a[0] + a[1]) + (a[2] + a[3]) + (b[0] + b[1]) + (b[2] + b[3]); }
                        q += __shfl_xor(q, 16); q += __shfl_xor(q, 32); const float rr = rsqrtf(q * (1.f / 64.f) + EPS);
#pragma unroll
                        for (int n = 0; n < 2; ++n) { x1[n] = x1[n] * rr * g1[n]; x2[n] = x2[n] * rr * g2[n]; }
                    }
                    f32x4 o1[2], o2[2];
#pragma unroll
                    for (int n = 0; n < 2; ++n) { const f32x4 c = *(const f32x4*)(cs + (size_t)pos * 32 + 8 * fq + 4 * n), s = *(const f32x4*)(sn + (size_t)pos * 32 + 8 * fq + 4 * n);
                        o1[n] = x1[n] * c - x2[n] * s; o2[n] = x2[n] * c + x1[n] * s; }
                    bf16_t* op = P + (size_t)row * PW + 256 * T + 64 * wc + 8 * fq;
                    *(u32x4*)op = pack8(o1[0], o1[1]); *(u32x4*)(op + 32) = pack8(o2[0], o2[1]);
                    if (T == 14) {
                        bf16_t* kp = KI + ((size_t)((row >> 5) * 4 + (fq >> 1)) * 64 + (fq & 1) * 32 + (row & 31)) * 8; *(u32x4*)kp = pack8(o1[0], o1[1]); *(u32x4*)(kp + 2 * 64 * 8) = pack8(o2[0], o2[1]); }
                }
            return;
        }
        const int act = (T <= 1) ? 1 : 0; const float sc = (T == 8) ? 0.125f : 1.0f;
#pragma unroll
        for (int ai = 0; ai < 2; ++ai)
#pragma unroll
            for (int m = 0; m < 4; ++m) {
                const int row = row0 + ai * 128 + m * 16; const float rs = row_scale(ssq, row) * sc;
                bf16_t* op = P + (size_t)row * PW + 256 * T + 32 * wc + 8 * fq; float qv = 0.f;
#pragma unroll
                for (int bj = 0; bj < 2; ++bj) { f32x4 v0 = acc[ai][bj][m][0] * rs, v1 = acc[ai][bj][m][1] * rs;
                    if (act) {
#pragma unroll
                        for (int e = 0; e < 4; ++e) { v0[e] = gelu_tanh_f(v0[e]); v1[e] = gelu_tanh_f(v1[e]); }
                        const f32x4 a2 = v0 * v0, b2 = v1 * v1; qv += ((a2[0] + a2[1]) + (a2[2] + a2[3])) + ((b2[0] + b2[1]) + (b2[2] + b2[3])); }
                    *(u32x4*)(op + bj * 128) = pack8(v0, v1);
                    if (T == 4 || T == 9) { bf16_t* vp = (T == 4 ? VT : CVT) + ((size_t)((row >> 12) * 256 + bj * 128 + 32 * wc + 8 * fq)) * S + (row & (S - 1));
#pragma unroll
                        for (int e = 0; e < 4; ++e) { vp[(size_t)e * S] = (bf16_t)f2bf(v0[e]); vp[(size_t)(4 + e) * S] = (bf16_t)f2bf(v1[e]); } } }
                if (T == 1) { qv += __shfl_xor(qv, 16); qv += __shfl_xor(qv, 32); if (fq == 0) ssqv[(size_t)row * 4 + wc] = qv; }
            }
    }
};

struct EpiPlain {
    static constexpr bool PERM = true;
    bf16_t* O; int ldc; int zcols;
    __device__ __forceinline__ void operator()(const Acc& acc, const Unit& u, int wr, int wc, int fr, int fq) const {
        const int row0 = u.pm * 256 + wr * 64 + fr; const int col0 = u.z * zcols + u.pn * 256 + 32 * wc + 8 * fq;
#pragma unroll
        for (int ai = 0; ai < 2; ++ai)
#pragma unroll
            for (int m = 0; m < 4; ++m) { bf16_t* op = O + (size_t)(row0 + ai * 128 + m * 16) * ldc + col0;
#pragma unroll
                for (int bj = 0; bj < 2; ++bj) *(u32x4*)(op + bj * 128) = pack8(acc[ai][bj][m][0], acc[ai][bj][m][1]); }
    }
};

struct EpiGate {
    static constexpr bool PERM = true;
    bf16_t* MG; const bf16_t* BR; const float* ssq;
    __device__ __forceinline__ void operator()(const Acc& acc, const Unit& u, int wr, int wc, int fr, int fq) const {
        const int row0 = u.pm * 256 + wr * 64 + fr; const int ch0 = u.pn * 64 + 16 * wc + 4 * fq;
        float rsv[8];
#pragma unroll
        for (int i = 0; i < 8; ++i) rsv[i] = ssq[row0 + (i >> 2) * 128 + (i & 3) * 16];
#pragma unroll
        for (int ai = 0; ai < 2; ++ai) {
            u32x2 bw[4][4];
#pragma unroll
            for (int m = 0; m < 4; ++m)
#pragma unroll
                for (int nb = 0; nb < 4; ++nb) bw[m][nb] = *(const u32x2*)(BR + (size_t)(row0 + ai * 128 + m * 16) * 4096 + ch0 + nb * 1024);
#pragma unroll
            for (int m = 0; m < 4; ++m) {
                const int row = row0 + ai * 128 + m * 16; const float rs = rsv[ai * 4 + m]; f32x4 o = (f32x4){0.f, 0.f, 0.f, 0.f};
#pragma unroll
                for (int bj = 0; bj < 2; ++bj)
#pragma unroll
                    for (int n = 0; n < 2; ++n) { const u32x2 w = bw[m][2 * bj + n]; const f32x4 a = acc[ai][bj][m][n] * rs;
                        o[0] += sigmoid_f(a[0]) * lo_bf(w.x); o[1] += sigmoid_f(a[1]) * hi_bf(w.x); o[2] += sigmoid_f(a[2]) * lo_bf(w.y); o[3] += sigmoid_f(a[3]) * hi_bf(w.y); }
                u32x2 ow; ow.x = cvt_pk_bf16(o[0], o[1]); ow.y = cvt_pk_bf16(o[2], o[3]);
                *(u32x2*)(MG + (size_t)row * 1024 + ch0) = ow;
            }
        }
    }
};

struct EpiResid {
    static constexpr bool PERM = true;
    const float* resf; bf16_t* X; float* outf; float* ssq;
    __device__ __forceinline__ void operator()(const Acc& acc, const Unit& u, int wr, int wc, int fr, int fq) const {
        const int row0 = u.pm * 256 + wr * 64 + fr; const int col0 = u.pn * 256 + 32 * wc + 8 * fq;
#pragma unroll
        for (int ai = 0; ai < 2; ++ai) {
            f32x4 r[4][2][2];
            if (resf) {
#pragma unroll
                for (int m = 0; m < 4; ++m)
#pragma unroll
                    for (int bj = 0; bj < 2; ++bj) { const float* rp = resf + (size_t)(row0 + ai * 128 + m * 16) * 1024 + col0 + bj * 128; r[m][bj][0] = *(const f32x4*)rp; r[m][bj][1] = *(const f32x4*)(rp + 4); }
            } else {
                u32x4 w[4][2];
#pragma unroll
                for (int m = 0; m < 4; ++m)
#pragma unroll
                    for (int bj = 0; bj < 2; ++bj) w[m][bj] = *(const u32x4*)(X + (size_t)(row0 + ai * 128 + m * 16) * 1024 + col0 + bj * 128);
#pragma unroll
                for (int m = 0; m < 4; ++m)
#pragma unroll
                    for (int bj = 0; bj < 2; ++bj) { const u32x4 q = w[m][bj]; r[m][bj][0] = (f32x4){lo_bf(q.x), hi_bf(q.x), lo_bf(q.y), hi_bf(q.y)}; r[m][bj][1] = (f32x4){lo_bf(q.z), hi_bf(q.z), lo_bf(q.w), hi_bf(q.w)}; }
            }
#pragma unroll
            for (int m = 0; m < 4; ++m) {
                const int row = row0 + ai * 128 + m * 16; const size_t off = (size_t)row * 1024 + col0; float q = 0.f;
#pragma unroll
                for (int bj = 0; bj < 2; ++bj) {
                    const f32x4 x0 = r[m][bj][0] + acc[ai][bj][m][0], x1 = r[m][bj][1] + acc[ai][bj][m][1];
                    if (outf) { *(f32x4*)(outf + off + bj * 128) = x0; *(f32x4*)(outf + off + bj * 128 + 4) = x1; }
                    else {
                        const f32x4 a = x0 * x0, b = x1 * x1; q += ((a[0] + a[1]) + (a[2] + a[3])) + ((b[0] + b[1]) + (b[2] + b[3]));
                        *(u32x4*)(X + off + bj * 128) = pack8(x0, x1); }
                }
                if (!outf) { q += __shfl_xor(q, 16); q += __shfl_xor(q, 32); if (fq == 0) ssq[(size_t)row * 16 + 4 * u.pn + wc] = q; }
            }
        }
    }
};

struct EpiUp {
    static constexpr bool PERM = true;
    bf16_t* H; const float* ssq;
    __device__ __forceinline__ void operator()(const Acc& acc, const Unit& u, int wr, int wc, int fr, int fq) const {
        const int row0 = u.pm * 256 + wr * 64 + fr; const int col0 = u.pn * 256 + 32 * wc + 8 * fq;
        float rsv[8];
#pragma unroll
        for (int i = 0; i < 8; ++i) rsv[i] = ssq[row0 + (i >> 2) * 128 + (i & 3) * 16];
#pragma unroll
        for (int ai = 0; ai < 2; ++ai)
#pragma unroll
            for (int m = 0; m < 4; ++m) { const int row = row0 + ai * 128 + m * 16; const float rs = rsv[ai * 4 + m]; bf16_t* op = H + (size_t)row * FF + col0;
#pragma unroll
                for (int bj = 0; bj < 2; ++bj) { f32x4 v0 = acc[ai][bj][m][0] * rs, v1 = acc[ai][bj][m][1] * rs;
#pragma unroll
                    for (int e = 0; e < 4; ++e) { v0[e] = fmaxf(v0[e], 0.f); v1[e] = fmaxf(v1[e], 0.f); }
                    *(u32x4*)(op + bj * 128) = pack8(v0 * v0, v1 * v1); } }
    }
};
}
struct Args {
    const float* in[18]; float* out; unsigned char* ws; int ph_lo, ph_hi; int coop, pad;
};
struct Frame { LAS unsigned char* lds; int tid, lane, wave, G, vcu; };
constexpr int PTR_OFF = LDS_BYTES - 512;
enum { I_X = 0, I_LN_MIX, I_W_IN, I_SGU_NORM, I_SGU_W, I_SGU_B, I_Q_NORM, I_K_NORM, I_KIDX_NORM, I_I_BIAS, I_F_BIAS, I_MNORM, I_CONV_W, I_W_BRANCH, I_W_OUT, I_LN_MLP, I_W_UP, I_W_DOWN, I_OUT, I_WS };
__device__ __forceinline__ unsigned char* ptr_at(const Frame& F, int i) { const LAS unsigned* p = (const LAS unsigned*)(F.lds + PTR_OFF) + 2 * i;
    const unsigned lo = __builtin_amdgcn_readfirstlane(p[0]), hi = __builtin_amdgcn_readfirstlane(p[1]);
    typedef __attribute__((address_space(1))) unsigned char* gptr_t;
    return (unsigned char*)(gptr_t)(((unsigned long long)hi << 32) | lo); }
#define INP(i) ((const float*)ptr_at(F, (i)))
#define WSP(off) (ptr_at(F, I_WS) + (off))
constexpr size_t WS_GT = 512 * 1024;
constexpr size_t WS_RSA = 256 * 1024, WS_RSB = 320 * 1024;
__device__ __forceinline__ size_t maskt_idx(int m, int w) { const int b = m >> 12, t = m & (S - 1); return ((size_t)(b * 64 + (w >> 1)) * S + t) * 2 + (w & 1); }


#define XB_TMO      128
#define XB_XCNT(j)  (256  + 64 * (j))
#define XB_XSUB(j)  (1280 + 64 * (j))
#define XB_XGEN(j)  (2304 + 64 * (j))
#define XB_TOP      3328
#define XB_TOPGEN   3392
#define XCD_BAR_WORDS 3456
#define XB_SPIN_CAP (1u << 22)
constexpr size_t WS_BAR = 64 * 1024;
constexpr size_t CTL_ZERO_BYTES = 128 * 1024;
__device__ __forceinline__ unsigned xb_ld(unsigned* p)              { return __hip_atomic_load(p, __ATOMIC_RELAXED, __HIP_MEMORY_SCOPE_AGENT); }
__device__ __forceinline__ unsigned xb_add(unsigned* p, unsigned v) { return __hip_atomic_fetch_add(p, v, __ATOMIC_RELAXED, __HIP_MEMORY_SCOPE_AGENT); }
__device__ __forceinline__ unsigned xb_xcc_id() { return (unsigned)__builtin_amdgcn_s_getreg((3 << 11) | 20) & 0xFu; }
#define XB_SPIN(cond, bar) do { unsigned _sp = 0; while (cond) { __builtin_amdgcn_s_sleep(1); \
    if ((++_sp & 255u) == 0u) { if (xb_ld(&(bar)[XB_TMO])) break; if (_sp > XB_SPIN_CAP) { atomicAdd(&(bar)[XB_TMO], 1u); break; } } } } while (0)
struct XcdBarrier { unsigned* bar; unsigned x; volatile LAS unsigned* st; };
__device__ __forceinline__ XcdBarrier xcd_barrier_post(unsigned* bar, volatile LAS unsigned* st) {
    XcdBarrier b; b.bar = bar; b.x = xb_xcc_id(); b.st = st;
    if (threadIdx.x == 0) (void)xb_add(&bar[XB_XCNT(b.x)], 1u);
    return b;
}
__device__ __forceinline__ void xcd_barrier_complete(unsigned* bar, unsigned x, unsigned& nloc, unsigned& nx) {
    const unsigned G = gridDim.x * gridDim.y * gridDim.z;
    unsigned sum, cnt, mine, sp = 0u;
    for (;;) {
        sum = 0u; cnt = 0u; mine = 0u;
#pragma unroll
        for (unsigned j = 0; j < 16; ++j) { const unsigned c = xb_ld(&bar[XB_XCNT(j)]); sum += c; cnt += (c > 0u) ? 1u : 0u; mine = (j == x) ? c : mine; }
        if (sum == G) break;
        __builtin_amdgcn_s_sleep(1);
        if ((++sp & 255u) == 0u) { if (xb_ld(&bar[XB_TMO])) break; if (sp > XB_SPIN_CAP) { atomicAdd(&bar[XB_TMO], 1u); break; } }
    }
    nloc = mine > 0u ? mine : 1u; nx = cnt > 0u ? cnt : 1u;
}
__device__ __forceinline__ void xcd_barrier(const XcdBarrier& b) {
    asm volatile("s_waitcnt vmcnt(0)" ::: "memory");
    __syncthreads();
    if (threadIdx.x == 0) {
        unsigned* bar = b.bar;
        __builtin_amdgcn_s_waitcnt(0);
        unsigned nloc = b.st[0], nx = b.st[1];
        if (nloc == 0u) { xcd_barrier_complete(bar, b.x, nloc, nx); b.st[0] = nloc; b.st[1] = nx; }
        const unsigned old = xb_add(&bar[XB_XSUB(b.x)], 1u);
        const unsigned gen = old / nloc;
        if (old + 1u == (gen + 1u) * nloc) {
            __builtin_amdgcn_fence(__ATOMIC_RELEASE, "agent");
            asm volatile("s_waitcnt vmcnt(0)" ::: "memory");
            const unsigned og = xb_add(&bar[XB_TOP], 1u);
            const unsigned tg = og / nx;
            if (og + 1u == (tg + 1u) * nx) xb_add(&bar[XB_TOPGEN], 1u);
            else XB_SPIN(xb_ld(&bar[XB_TOPGEN]) == tg, bar);
            __builtin_amdgcn_fence(__ATOMIC_ACQUIRE, "agent");
            xb_add(&bar[XB_XGEN(b.x)], 1u);
            asm volatile("s_waitcnt vmcnt(0)" ::: "memory");
        } else {
            XB_SPIN(xb_ld(&bar[XB_XGEN(b.x)]) == gen, bar);
            __builtin_amdgcn_fence(__ATOMIC_ACQUIRE, "agent");
            asm volatile("s_waitcnt vmcnt(0)" ::: "memory");
        }
    }
    __syncthreads();
}

__device__ __forceinline__ int win_src(int p) {
    const int T = p >> 8, q = p & 255, bj = q >> 7, wc = (q >> 5) & 3, j = q & 31, hd = 64 * wc + 32 * bj + j;
    switch (T) {
        case 0: return O_AU + q; case 1: return O_AV + q; case 2: return O_BQ + hd; case 3: return O_BK + hd; case 4: return O_BV + q;
        case 5: return O_QI + hd; case 6: return O_QI + 256 + hd; case 7: return O_CQ + q; case 8: return O_CK + q; case 9: return O_CV + q;
        case 10: return O_CO + q; case 11: return O_DB + q; case 12: return O_DC + q; case 13: return O_DX + q;
        default: break;
    }
    if (wc == 0) return O_KI + 32 * bj + j;
    if (wc == 1 && bj == 0 && j < 16) return j < 8 ? O_WI + j : (j < 12 ? O_CI + (j - 8) : O_CF + (j - 12));
    return -1;
}
__device__ __forceinline__ int wg_src(int p) {
    const int pn = p >> 8, q = p & 255, bj = q >> 7, wc = (q >> 5) & 3, fq = (q >> 3) & 3, n = (q >> 2) & 1, e = q & 3;
    return O_G + (2 * bj + n) * 1024 + 64 * pn + 16 * wc + 4 * fq + e;
}
template <int MAP>
__device__ __forceinline__ void conv_item(const float* W, int K, int srcN, bf16_t* WT, LAS float* scr, int item, int nrows, int lane, const float* gain = nullptr) {
    const int nblk = nrows / 32, kb = item / nblk, nb = item % nblk, k0 = 64 * kb, n0 = 32 * nb;
    const int nn = n0 + (lane & 31); const int src = MAP == 0 ? nn : (MAP == 1 ? win_src(nn) : wg_src(nn));
    float wv_[32]; const float* wp_ = W + (size_t)(k0 + (lane >> 5)) * srcN + (src >= 0 ? src : 0);
#pragma unroll
    for (int i = 0; i < 32; ++i) wv_[i] = __builtin_nontemporal_load(wp_ + (size_t)(2 * i) * srcN);
#pragma unroll
    for (int i = 0; i < 32; ++i) scr[(2 * i + (lane >> 5)) * 33 + (lane & 31)] = src >= 0 ? (gain ? wv_[i] * gain[k0 + 2 * i + (lane >> 5)] : wv_[i]) : 0.f;
    asm volatile("s_waitcnt lgkmcnt(0)" ::: "memory");
    const int c = lane & 7;
#pragma unroll
    for (int j = 0; j < 4; ++j) { const int n = (lane >> 3) + 8 * j; const LAS float* s = scr + (8 * c) * 33 + n;
        u32x4 o; o.x = pk2(s[0 * 33], s[1 * 33]); o.y = pk2(s[2 * 33], s[3 * 33]); o.z = pk2(s[4 * 33], s[5 * 33]); o.w = pk2(s[6 * 33], s[7 * 33]);
        *(u32x4*)(WT + (size_t)(n0 + n) * K + k0 + 8 * c) = o; }
    asm volatile("s_waitcnt lgkmcnt(0)" ::: "memory");
}
__device__ __forceinline__ void convert_mix_weights(Frame& F, int l) {

    LAS float* scr = (LAS float*)(F.lds + F.wave * 16384);
    const int gw = F.vcu * NWAVES + F.wave, NGW = F.G * NWAVES;
    constexpr int I_WIN = (D / 64) * (PW / 32), I_WG = (D / 64) * (4096 / 32), I_BR = (256 / 64) * (1024 / 32), I_OUT = (D / 64) * (D / 32);
    constexpr int NIT = I_WIN + I_WG + 4 * I_BR + I_OUT;
    const float* win = INP(I_W_IN) + (size_t)l * D * INW; const float* gmix = INP(I_LN_MIX) + l * D;
    for (int it = gw; it < NIT; it += NGW) {
        int r = it;
        if (r < I_WIN) { conv_item<1>(win, D, INW, ((bf16_t*)WSP(WS_WIN)), scr, r, PW, F.lane, gmix); continue; } r -= I_WIN;
        if (r < I_WG) { conv_item<2>(win, D, INW, ((bf16_t*)WSP(WS_WG)), scr, r, 4096, F.lane, gmix); continue; } r -= I_WG;
        if (r < 4 * I_BR) { const int nb = r / I_BR; conv_item<0>(INP(I_W_BRANCH) + ((size_t)l * 4 + nb) * 256 * D, 256, D, ((bf16_t*)WSP(WS_WBR)) + (size_t)nb * 1024 * 256, scr, r % I_BR, 1024, F.lane); continue; } r -= 4 * I_BR;
        conv_item<0>(INP(I_W_OUT) + (size_t)l * D * D, D, D, ((bf16_t*)WSP(WS_WOUT)), scr, r, D, F.lane);
    }
}
__device__ __forceinline__ void convert_mlp_weights(Frame& F, int l) {

    LAS float* scr = (LAS float*)(F.lds + F.wave * 16384);
    const int gw = F.vcu * NWAVES + F.wave, NGW = F.G * NWAVES;
    constexpr int I_UP = (D / 64) * (FF / 32), I_DN = (FF / 64) * (D / 32);
    for (int it = gw; it < I_UP + I_DN; it += NGW) {
        if (it < I_UP) conv_item<0>(INP(I_W_UP) + (size_t)l * D * FF, D, FF, ((bf16_t*)WSP(WS_WUP)), scr, it, FF, F.lane, INP(I_LN_MLP) + l * D);
        else conv_item<0>(INP(I_W_DOWN) + (size_t)l * FF * D, FF, D, ((bf16_t*)WSP(WS_WDN)), scr, it - I_UP, D, F.lane);
    }
}
__device__ __forceinline__ void prologue_rows(Frame& F) {
    float* COS = (float*)WSP(WS_COS); float* SIN = (float*)WSP(WS_SIN); float* SSQA = (float*)WSP(WS_SSQA); bf16_t* XG = (bf16_t*)WSP(WS_XG); const float* x = INP(I_X); const float* ln_mix = INP(I_LN_MIX);
    const int gt = F.vcu * NT + F.tid, NGT = F.G * NT;
    for (int i = gt; i < S * 32; i += NGT) { const int pos = i >> 5, k = i & 31; const float inv = powf(10000.f, -(float)k * 2.0f / 64.f); const float ang = (float)pos * inv; COS[i] = cosf(ang); SIN[i] = sinf(ang); }
    const int gw = F.vcu * NWAVES + F.wave, NGW = F.G * NWAVES;
    float* rsa = (float*)WSP(WS_RSA);
    for (int m0 = gw * 4; m0 < M; m0 += NGW * 4) {
        f32x4 v[4][4];
#pragma unroll
        for (int r = 0; r < 4; ++r)
#pragma unroll
            for (int j = 0; j < 4; ++j) v[r][j] = __builtin_nontemporal_load((const f32x4*)(x + (size_t)(m0 + r) * D) + F.lane + 64 * j);
#pragma unroll
        for (int r = 0; r < 4; ++r) { float s = 0.f; unsigned long long* o8 = (unsigned long long*)(XG + (size_t)(m0 + r) * D) + F.lane;
#pragma unroll
            for (int j = 0; j < 4; ++j) { const f32x4 w = v[r][j]; s += (w[0] * w[0] + w[1] * w[1]) + (w[2] * w[2] + w[3] * w[3]);
                o8[64 * j] = (unsigned long long)pk2(w[0], w[1]) | ((unsigned long long)pk2(w[2], w[3]) << 32); }
            s = wave_sum(s);
            if (F.lane == 0) rsa[m0 + r] = rsqrtf(s * (1.f / 1024.f) + EPS); }
    }
}
__device__ __forceinline__ void finalize_rs(Frame& F, size_t ssq_off, size_t rs_off) {
    const float* ssq = (const float*)WSP(ssq_off); float* rs = (float*)WSP(rs_off);
    for (int row = F.vcu * NT + F.tid; row < M; row += F.G * NT) { const f32x4* sp = (const f32x4*)(ssq + (size_t)row * 16); const f32x4 a = sp[0], b = sp[1], c = sp[2], d = sp[3];
        const float t = ((a[0] + a[1]) + (a[2] + a[3])) + ((b[0] + b[1]) + (b[2] + b[3])) + ((c[0] + c[1]) + (c[2] + c[3])) + ((d[0] + d[1]) + (d[2] + d[3]));
        rs[row] = rsqrtf(t * (1.0f / 1024.0f) + EPS); }
}

__device__ __forceinline__ void sgu_simple(Frame& F, int l) {
    bf16_t* PROJ = (bf16_t*)WSP(WS_BIG); bf16_t* Y = (bf16_t*)WSP(WS_Y); const float* sgu_norm = INP(I_SGU_NORM); const float* sgu_w = INP(I_SGU_W); const float* sgu_b = INP(I_SGU_B);
    LAS float* r_s = (LAS float*)F.lds; LAS float* vn = r_s + 128;
    const float* gain = sgu_norm + l * 256; const float* sw = sgu_w + (size_t)l * 4 * 128 * 128; const float* sb = sgu_b + l * 4 * 128;
    for (int item = F.vcu; item < 512; item += F.G) {
        const int g = item & 3, m0 = (item >> 2) * 128;
        for (int i = 0; i < 16; ++i) { const int tok = F.wave * 16 + i; const u32x2 w = *(const u32x2*)(PROJ + (size_t)(m0 + tok) * PW + P_AV + 4 * F.lane);
            const float a = lo_bf(w.x), b = hi_bf(w.x), c = lo_bf(w.y), d = hi_bf(w.y); const float ss = wave_sum((a * a + b * b) + (c * c + d * d));
            if (F.lane == 0) r_s[tok] = rsqrtf(ss * (1.f / 256.f) + EPS); }
        __syncthreads();
        for (int idx = F.tid; idx < 8192; idx += NT) { const int s = idx >> 6, d = idx & 63; vn[idx] = bf2f(PROJ[(size_t)(m0 + s) * PW + P_AV + g * 64 + d]) * r_s[s] * gain[g * 64 + d]; }
        __syncthreads();
        const int d = F.tid & 63, tq = F.tid >> 6;
        for (int tl = tq; tl < 128; tl += 8) { const float* w = sw + ((size_t)g * 128 + tl) * 128; float acc = 0.f;
            for (int s = 0; s <= tl; ++s) acc = fmaf(w[s], vn[s * 64 + d], acc);
            acc += sb[g * 128 + tl];
            Y[(size_t)(m0 + tl) * D + g * 64 + d] = (bf16_t)f2bf(bf2f(PROJ[(size_t)(m0 + tl) * PW + P_AU + g * 64 + d]) * acc); }
        __syncthreads();
    }
}
__device__ __forceinline__ void conv_simple(Frame& F, int l) {
    bf16_t* PROJ = (bf16_t*)WSP(WS_BIG); bf16_t* Y = (bf16_t*)WSP(WS_Y); const float* conv_w = INP(I_CONV_W);
    const float* cw = conv_w + l * 3 * 256;
    for (int i = F.vcu * NT + F.tid; i < M * 32; i += F.G * NT) { const int m = i >> 5, c = (i & 31) * 8, t = m & (S - 1); float acc[8];
#pragma unroll
        for (int e = 0; e < 8; ++e) acc[e] = 0.f;
#pragma unroll
        for (int j = 0; j < 3; ++j) { const int tt = t - 2 + j; if (tt >= 0) { const size_t r = (size_t)(m - 2 + j) * PW; const u32x4 a = *(const u32x4*)(PROJ + r + P_DC + c), x = *(const u32x4*)(PROJ + r + P_DX + c);
                const f32x4 w0 = *(const f32x4*)(cw + j * 256 + c), w1 = *(const f32x4*)(cw + j * 256 + c + 4);
                acc[0] = fmaf(w0[0], lo_bf(a.x) * lo_bf(x.x), acc[0]); acc[1] = fmaf(w0[1], hi_bf(a.x) * hi_bf(x.x), acc[1]); acc[2] = fmaf(w0[2], lo_bf(a.y) * lo_bf(x.y), acc[2]); acc[3] = fmaf(w0[3], hi_bf(a.y) * hi_bf(x.y), acc[3]);
                acc[4] = fmaf(w1[0], lo_bf(a.z) * lo_bf(x.z), acc[4]); acc[5] = fmaf(w1[1], hi_bf(a.z) * hi_bf(x.z), acc[5]); acc[6] = fmaf(w1[2], lo_bf(a.w) * lo_bf(x.w), acc[6]); acc[7] = fmaf(w1[3], hi_bf(a.w) * hi_bf(x.w), acc[7]); } }
        const u32x4 bq = *(const u32x4*)(PROJ + (size_t)m * PW + P_DB + c); u32x4 o;
        o.x = cvt_pk_bf16(lo_bf(bq.x) * acc[0], hi_bf(bq.x) * acc[1]); o.y = cvt_pk_bf16(lo_bf(bq.y) * acc[2], hi_bf(bq.y) * acc[3]); o.z = cvt_pk_bf16(lo_bf(bq.z) * acc[4], hi_bf(bq.z) * acc[5]); o.w = cvt_pk_bf16(lo_bf(bq.w) * acc[6], hi_bf(bq.w) * acc[7]);
        *(u32x4*)(Y + (size_t)m * D + 768 + c) = o; }
}
__device__ __forceinline__ void indexer_simple(Frame& F) {
    float* MISC = (float*)WSP(WS_MISC); unsigned* MASK = (unsigned*)WSP(WS_MASK); bf16_t* PROJ = (bf16_t*)WSP(WS_BIG);
    LAS float* sc = (LAS float*)F.lds; LAS int* red = (LAS int*)(sc + 4096); LAS unsigned* msk = (LAS unsigned*)(red + 16);
    for (int m = F.vcu; m < M; m += F.G) {
        const int t = m & (S - 1), b0 = m - t, n = t + 1;
        if (n <= 256) { if (F.tid < 128) { const int lo = 32 * F.tid; MASK[maskt_idx(m, F.tid)] = (lo + 32 <= n) ? 0xffffffffu : (lo >= n ? 0u : ((1u << (n - lo)) - 1u)); } continue; }
        float qreg[8], wh[8];
#pragma unroll
        for (int h = 0; h < 8; ++h) { qreg[h] = bf2f(PROJ[(size_t)m * PW + P_QI + h * 64 + F.lane]); wh[h] = MISC[(size_t)m * 16 + h] * 0.35355339059327373f; }
        for (int s0 = 0; s0 < n; s0 += NT) {
            const int s = s0 + F.tid, sc_ = s < n ? s : n - 1; const u32x4* kr = (const u32x4*)(PROJ + (size_t)(b0 + sc_) * PW + P_KI);
            float kf[64];
#pragma unroll
            for (int i = 0; i < 8; ++i) { const u32x4 w = kr[i]; kf[8 * i] = lo_bf(w.x); kf[8 * i + 1] = hi_bf(w.x); kf[8 * i + 2] = lo_bf(w.y); kf[8 * i + 3] = hi_bf(w.y); kf[8 * i + 4] = lo_bf(w.z); kf[8 * i + 5] = hi_bf(w.z); kf[8 * i + 6] = lo_bf(w.w); kf[8 * i + 7] = hi_bf(w.w); }
            float acc = 0.f;
#pragma unroll
            for (int h = 0; h < 8; ++h) { float d0 = 0.f, d1 = 0.f;
#pragma unroll
                for (int e = 0; e < 64; e += 2) { d0 = fmaf(__builtin_bit_cast(float, __builtin_amdgcn_readlane(__builtin_bit_cast(int, qreg[h]), e)), kf[e], d0);
                                                   d1 = fmaf(__builtin_bit_cast(float, __builtin_amdgcn_readlane(__builtin_bit_cast(int, qreg[h]), e + 1)), kf[e + 1], d1); }
                acc += wh[h] * fmaxf((d0 + d1) * 0.125f, 0.f); }
            if (s < n) sc[s] = acc;
        }
        __syncthreads();
        unsigned Tk = 0u;
        for (int bit = 31; bit >= 0; --bit) {
            const unsigned cand = Tk | (1u << bit); int c = 0;
            for (int s = F.tid; s < n; s += NT) c += (fkey(sc[s]) >= cand) ? 1 : 0;
            c = wave_sum_i(c); if (F.lane == 0) red[F.wave] = c; __syncthreads();
            int tot = 0;
#pragma unroll
            for (int w = 0; w < 8; ++w) tot += red[w];
            __syncthreads();
            if (tot >= 256) Tk = cand;
        }
        int cg_ = 0, ce = 0;
        for (int s = F.tid; s < n; s += NT) { const unsigned k = fkey(sc[s]); cg_ += k > Tk ? 1 : 0; ce += k == Tk ? 1 : 0; }
        cg_ = wave_sum_i(cg_); ce = wave_sum_i(ce); if (F.lane == 0) { red[F.wave] = cg_; red[8 + F.wave] = ce; }
        if (F.tid < 128) msk[F.tid] = 0u;
        __syncthreads();
        int ngt = 0, neq = 0;
#pragma unroll
        for (int w = 0; w < 8; ++w) { ngt += red[w]; neq += red[8 + w]; }
        const bool all_eq = (ngt + neq == 256);
        for (int s = F.tid; s < n; s += NT) { const unsigned k = fkey(sc[s]); if (k > Tk || (all_eq && k == Tk)) atomicOr((unsigned*)&msk[s >> 5], 1u << (s & 31)); }
        __syncthreads();
        if (!all_eq && F.tid == 0) { int need = 256 - ngt; for (int s = 0; s < n && need > 0; ++s) if (fkey(sc[s]) == Tk) { msk[s >> 5] |= 1u << (s & 31); --need; } }
        __syncthreads();
        if (F.tid < 128) MASK[maskt_idx(m, F.tid)] = msk[F.tid];
        __syncthreads();
    }
}
__device__ __forceinline__ void attn_simple(Frame& F) {
    unsigned* MASK = (unsigned*)WSP(WS_MASK); bf16_t* PROJ = (bf16_t*)WSP(WS_BIG); bf16_t* Y = (bf16_t*)WSP(WS_Y);
    LAS unsigned* msk = (LAS unsigned*)F.lds; LAS int* sel = (LAS int*)(msk + 128); LAS float* lg = (LAS float*)(sel + 256); LAS int* nsel = (LAS int*)(lg + 4 * 256);
    for (int m = F.vcu; m < M; m += F.G) {
        const int t = m & (S - 1), b0 = m - t;
        if (F.tid < 128) msk[F.tid] = MASK[maskt_idx(m, F.tid)];
        __syncthreads();
        if (F.tid == 0) { int c = 0; for (int w = 0; w < 128; ++w) { unsigned bits = msk[w]; while (bits) { const int i = __builtin_ctz(bits); if (c < 256) sel[c] = 32 * w + i; ++c; bits &= bits - 1; } } nsel[0] = c < 256 ? c : 256; }
        __syncthreads();
        const int ns = nsel[0], h = F.wave & 3, part = F.wave >> 2;
        const float q = bf2f(PROJ[(size_t)m * PW + P_Q + h * 64 + F.lane]);
        for (int j = part; j < ns; j += 2) { const float d = wave_sum(q * bf2f(PROJ[(size_t)(b0 + sel[j]) * PW + P_K + h * 64 + F.lane])); if (F.lane == 0) lg[h * 256 + j] = d * 0.125f; }
        __syncthreads();
        if (F.wave < 4) {
            float mx = -INFINITY; for (int j = F.lane; j < ns; j += 64) mx = fmaxf(mx, lg[h * 256 + j]); mx = wave_max(mx);
            float sm = 0.f; for (int j = F.lane; j < ns; j += 64) sm += __expf(lg[h * 256 + j] - mx); sm = wave_sum(sm);
            float o = 0.f; for (int j = 0; j < ns; ++j) o = fmaf(__expf(lg[h * 256 + j] - mx), bf2f(PROJ[(size_t)(b0 + sel[j]) * PW + P_V + h * 64 + F.lane]), o);
            Y[(size_t)m * D + 256 + h * 64 + F.lane] = (bf16_t)f2bf(o / sm);
        }
        __syncthreads();
    }
}
__device__ __forceinline__ void mlstm1_simple(Frame& F, int l) {
    float* MISC = (float*)WSP(WS_MISC); float* STATE = (float*)WSP(WS_STATE); bf16_t* PROJ = (bf16_t*)WSP(WS_BIG); const float* i_bias = INP(I_I_BIAS); const float* f_bias = INP(I_F_BIAS);
    LAS float* bs = (LAS float*)F.lds; LAS float* ig = bs + 128; LAS float* wk = ig + 128; LAS float* kt = wk + 128; LAS float* vt = kt + 128 * 64;
    for (int item = F.vcu; item < 512; item += F.G) {
        const int bh = item >> 5, c = item & 31, b = bh >> 2, h = bh & 3, m0 = b * S + c * 128;
        if (F.tid < 128) { const float f = MISC[(size_t)(m0 + F.tid) * 16 + 12 + h] + f_bias[l * 4 + h]; bs[F.tid] = fminf(f, 0.f) - log1pf(__expf(-fabsf(f))); ig[F.tid] = MISC[(size_t)(m0 + F.tid) * 16 + 8 + h] + i_bias[l * 4 + h]; }
        for (int idx = F.tid; idx < 8192; idx += NT) { const int s = idx >> 6, d = idx & 63; kt[idx] = bf2f(PROJ[(size_t)(m0 + s) * PW + P_CK + h * 64 + d]); vt[idx] = bf2f(PROJ[(size_t)(m0 + s) * PW + P_CV + h * 64 + d]); }
        __syncthreads();
        if (F.tid == 0) { float a = 0.f; for (int s = 0; s < 128; ++s) { a += bs[s]; bs[s] = a; } }
        __syncthreads();
        const float B = bs[127];
        if (F.tid < 128) wk[F.tid] = __expf(B - bs[F.tid] + ig[F.tid]);
        __syncthreads();
        const int e = F.tid & 63, dq = F.tid >> 6; float acc[8];
#pragma unroll
        for (int i = 0; i < 8; ++i) acc[i] = 0.f;
        for (int s = 0; s < 128; ++s) { const float kv = wk[s] * vt[s * 64 + e];
#pragma unroll
            for (int i = 0; i < 8; ++i) acc[i] = fmaf(kt[s * 64 + dq * 8 + i], kv, acc[i]); }
        float* st = STATE + (size_t)item * STATE_STRIDE;
#pragma unroll
        for (int i = 0; i < 8; ++i) st[e * 64 + dq * 8 + i] = acc[i];
        if (F.tid < 64) { float a = 0.f; for (int s = 0; s < 128; ++s) a = fmaf(wk[s], kt[s * 64 + F.tid], a); st[4096 + F.tid] = a; }
        if (F.tid == 0) st[4160] = B;
        __syncthreads();
    }
}
__device__ __forceinline__ void mlstm2_simple(Frame& F, int l) {
    float* MISC = (float*)WSP(WS_MISC); float* STATE = (float*)WSP(WS_STATE); bf16_t* PROJ = (bf16_t*)WSP(WS_BIG); bf16_t* Y = (bf16_t*)WSP(WS_Y); const float* i_bias = INP(I_I_BIAS); const float* f_bias = INP(I_F_BIAS); const float* mnorm = INP(I_MNORM);
    LAS float* Cs = (LAS float*)F.lds; LAS float* ns = Cs + 4096; LAS float* bs = ns + 64; LAS float* ig = bs + 128; LAS float* A = ig + 128;
    LAS float* qt = A + 128 * 128; LAS float* kt = qt + 128 * 65;
    for (int item = F.vcu; item < 512; item += F.G) {
        const int bh = item >> 5, c = item & 31, b = bh >> 2, h = bh & 3, m0 = b * S + c * 128;
        { float Cv[8]; float nv = 0.f;
#pragma unroll
          for (int k = 0; k < 8; ++k) Cv[k] = 0.f;
          for (int cc = 0; cc < c; ++cc) { const float* st = STATE + (size_t)(bh * 32 + cc) * STATE_STRIDE; const float dec = __expf(st[4160]);
#pragma unroll
              for (int k = 0; k < 8; ++k) Cv[k] = fmaf(dec, Cv[k], st[F.tid + NT * k]);
              if (F.tid < 64) nv = fmaf(dec, nv, st[4096 + F.tid]); }
#pragma unroll
          for (int k = 0; k < 8; ++k) Cs[F.tid + NT * k] = Cv[k];
          if (F.tid < 64) ns[F.tid] = nv; }
        if (F.tid < 128) { const float f = MISC[(size_t)(m0 + F.tid) * 16 + 12 + h] + f_bias[l * 4 + h]; bs[F.tid] = fminf(f, 0.f) - log1pf(__expf(-fabsf(f))); ig[F.tid] = MISC[(size_t)(m0 + F.tid) * 16 + 8 + h] + i_bias[l * 4 + h]; }
        for (int idx = F.tid; idx < 8192; idx += NT) { const int s = idx >> 6, d = idx & 63; qt[s * 65 + d] = bf2f(PROJ[(size_t)(m0 + s) * PW + P_CQ + h * 64 + d]); kt[s * 65 + d] = bf2f(PROJ[(size_t)(m0 + s) * PW + P_CK + h * 64 + d]); }
        __syncthreads();
        if (F.tid == 0) { float a = 0.f; for (int s = 0; s < 128; ++s) { a += bs[s]; bs[s] = a; } }
        __syncthreads();
        { const int s = F.tid & 127, jq = F.tid >> 7;
          for (int j = jq; j < 128; j += 4) { float v = 0.f;
              if (s <= j) { float d = 0.f;
#pragma unroll 16
                  for (int k = 0; k < 64; ++k) d = fmaf(qt[j * 65 + k], kt[s * 65 + k], d);
                  v = __expf(bs[j] - bs[s] + ig[s]) * d; }
              A[j * 128 + s] = v; } }
        __syncthreads();
        LAS float* vt = kt;
        for (int idx = F.tid; idx < 8192; idx += NT) { const int s = idx >> 6, d = idx & 63; vt[idx] = bf2f(PROJ[(size_t)(m0 + s) * PW + P_CV + h * 64 + d]); }
        __syncthreads();
        const int e = F.lane; const float gn = mnorm[l * 256 + h * 64 + e];
        for (int j = F.wave; j < 128; j += 8) {
            float num = 0.f, qn = 0.f, sa = 0.f;
            for (int d = 0; d < 64; ++d) { const float qd = qt[j * 65 + d]; num = fmaf(qd, Cs[d * 64 + e], num); qn = fmaf(qd, ns[d], qn); }
            const float eb = __expf(bs[j]); num *= eb; qn *= eb;
            for (int s = 0; s <= j; ++s) { const float a = A[j * 128 + s]; num = fmaf(a, vt[s * 64 + e], num); sa += a; }
            const float hv = num / fmaxf(fabsf(qn + sa), 1.f);
            const float r = rsqrtf(wave_sum(hv * hv) * (1.f / 64.f) + EPS);
            const size_t row = (size_t)(m0 + j);
            Y[row * D + 512 + h * 64 + e] = (bf16_t)f2bf(sigmoid_f(bf2f(PROJ[row * PW + P_CO + h * 64 + e])) * hv * r * gn);
        }
        __syncthreads();
    }
}
typedef float f32x16 __attribute__((ext_vector_type(16)));
constexpr size_t WS_VT = WS_BIG + 120 * MiB;
constexpr float LOG2E = 1.4426950408889634f;

__device__ __forceinline__ void attn_mfma(Frame& F, int l) {
    const unsigned long long* MASKT = (const unsigned long long*)WSP(WS_MASK); const bf16_t* PROJ = (const bf16_t*)WSP(WS_BIG); const bf16_t* VT = (const bf16_t*)WSP(WS_VT);
    bf16_t* Y = (bf16_t*)WSP(WS_Y); const float* gt = (const float*)WSP(WS_GT) + l * 192;
    const int lane = F.lane, r32 = lane & 31, hi = lane >> 5, grp = F.wave >> 2, w4 = F.wave & 3, lg = F.tid & 255;
    const float mq = wave_max(fabsf(gt[lane])), mk = wave_max(fabsf(gt[64 + lane]));
    const float c1 = 0.125f * LOG2E, c2 = 8.f * mq * mk * 1.01f * LOG2E;
    constexpr int ROWB = 144, TILEB = 64 * ROWB;
    LAS unsigned char* gb = F.lds + grp * 4 * TILEB;
    LAS float* comb = (LAS float*)(F.lds + 8 * TILEB);
    const int srow0 = lg >> 3, sc0 = lg & 7;
    for (int item = F.vcu; item < 256; item += F.G) {
        const int bh = item >> 4, sidx = item & 15, b = bh >> 2, h = bh & 3;
#pragma unroll 1
        for (int half = 0; half < 2; ++half) {
            const int qb = half == 0 ? sidx : 31 - sidx, q0 = qb * 128, ntl = qb + 1;
            const int qrow = b * S + q0 + w4 * 32 + r32, tq = q0 + w4 * 32 + r32;
            bf16x8 qf[4];
#pragma unroll
            for (int s = 0; s < 4; ++s) qf[s] = *(const bf16x8*)(PROJ + (size_t)qrow * PW + P_Q + h * 64 + 16 * s + 8 * hi);
            f32x16 o0, o1;
#pragma unroll
            for (int r = 0; r < 16; ++r) { o0[r] = 0.f; o1[r] = 0.f; }
            float lsum = 0.f;
            const bf16_t* kbase = PROJ + (size_t)(b * S + srow0) * PW + P_K + h * 64 + sc0 * 8;
            const bf16_t* vbase = VT + (size_t)(b * 256 + h * 64 + srow0) * S + sc0 * 8;
            const unsigned long long* mbase = MASKT + (size_t)(b * 64) * S + tq;
            u32x4 ka0, ka1, va0, va1, kb0, kb1, vb0, vb1; unsigned long long mwa = 0ull, mwb = 0ull;
#define ATT_LOAD(K0, K1, V0, V1, MW, t_) do { const int t__ = (t_); K0 = *(const u32x4*)(kbase + (size_t)t__ * 64 * PW); K1 = *(const u32x4*)(kbase + (size_t)(t__ * 64 + 32) * PW); \
    V0 = *(const u32x4*)(vbase + t__ * 64); V1 = *(const u32x4*)(vbase + 32 * S + t__ * 64); MW = mbase[(size_t)t__ * S]; } while (0)
#define ATT_STORE(K0, K1, V0, V1, buf_) do { LAS unsigned char* kn_ = gb + (buf_) * 2 * TILEB; LAS unsigned char* vn_ = kn_ + TILEB; \
    *(LAS u32x4*)(kn_ + srow0 * ROWB + sc0 * 16) = K0; *(LAS u32x4*)(kn_ + (srow0 + 32) * ROWB + sc0 * 16) = K1; \
    *(LAS u32x4*)(vn_ + srow0 * ROWB + sc0 * 16) = V0; *(LAS u32x4*)(vn_ + (srow0 + 32) * ROWB + sc0 * 16) = V1; } while (0)
#define ATT_COMPUTE(cur_, MW) do { \
                const LAS unsigned char* kb = gb + (cur_) * 2 * TILEB; const LAS unsigned char* vb = kb + TILEB; \
                f32x16 p0, p1; \
                _Pragma("unroll") for (int r = 0; r < 16; ++r) { p0[r] = 0.f; p1[r] = 0.f; } \
                _Pragma("unroll") for (int s = 0; s < 4; ++s) { \
                    const bf16x8 k0 = *(const LAS bf16x8*)(kb + r32 * ROWB + 32 * s + 16 * hi), k1 = *(const LAS bf16x8*)(kb + (32 + r32) * ROWB + 32 * s + 16 * hi); \
                    p0 = __builtin_amdgcn_mfma_f32_32x32x16_bf16(k0, qf[s], p0, 0, 0, 0); p1 = __builtin_amdgcn_mfma_f32_32x32x16_bf16(k1, qf[s], p1, 0, 0, 0); } \
                const unsigned sh0 = (unsigned)(MW) >> (4 * hi), sh1 = (unsigned)((MW) >> 32) >> (4 * hi); \
                _Pragma("unroll") for (int r = 0; r < 16; ++r) { const int cb = (r & 3) + 8 * (r >> 2); \
                    const float e0 = __builtin_amdgcn_exp2f(p0[r] * c1 - c2), e1 = __builtin_amdgcn_exp2f(p1[r] * c1 - c2); \
                    p0[r] = __uint_as_float(__float_as_uint(e0) & (unsigned)__builtin_amdgcn_sbfe((int)sh0, cb, 1)); p1[r] = __uint_as_float(__float_as_uint(e1) & (unsigned)__builtin_amdgcn_sbfe((int)sh1, cb, 1)); lsum += p0[r] + p1[r]; } \
                _Pragma("unroll") for (int ks = 0; ks < 4; ++ks) { \
                    u32x4 pw; \
                    if (ks < 2) { pw.x = cvt_pk_bf16(p0[8 * ks + 0], p0[8 * ks + 1]); pw.y = cvt_pk_bf16(p0[8 * ks + 2], p0[8 * ks + 3]); pw.z = cvt_pk_bf16(p0[8 * ks + 4], p0[8 * ks + 5]); pw.w = cvt_pk_bf16(p0[8 * ks + 6], p0[8 * ks + 7]); } \
                    else { const int k2 = ks - 2; pw.x = cvt_pk_bf16(p1[8 * k2 + 0], p1[8 * k2 + 1]); pw.y = cvt_pk_bf16(p1[8 * k2 + 2], p1[8 * k2 + 3]); pw.z = cvt_pk_bf16(p1[8 * k2 + 4], p1[8 * k2 + 5]); pw.w = cvt_pk_bf16(p1[8 * k2 + 6], p1[8 * k2 + 7]); } \
                    const bf16x8 pf = __builtin_bit_cast(bf16x8, pw); \
                    const int vo = 64 * (ks >> 1) + 32 * (ks & 1) + 8 * hi; \
                    const u32x2 a0 = *(const LAS u32x2*)(vb + r32 * ROWB + vo), a1 = *(const LAS u32x2*)(vb + r32 * ROWB + vo + 16); \
                    const u32x2 b0 = *(const LAS u32x2*)(vb + (32 + r32) * ROWB + vo), b1 = *(const LAS u32x2*)(vb + (32 + r32) * ROWB + vo + 16); \
                    const u32x4 va = {a0.x, a0.y, a1.x, a1.y}, vb4 = {b0.x, b0.y, b1.x, b1.y}; \
                    o0 = __builtin_amdgcn_mfma_f32_32x32x16_bf16(__builtin_bit_cast(bf16x8, va), pf, o0, 0, 0, 0); \
                    o1 = __builtin_amdgcn_mfma_f32_32x32x16_bf16(__builtin_bit_cast(bf16x8, vb4), pf, o1, 0, 0, 0); } \
            } while (0)
            ATT_LOAD(ka0, ka1, va0, va1, mwa, grp);
            if (ntl > 1) ATT_LOAD(kb0, kb1, vb0, vb1, mwb, 2 + grp);
            ATT_STORE(ka0, ka1, va0, va1, 0);
            __syncthreads();
#pragma unroll 1
            for (int i = 0; i < ntl; i += 2) {
                const unsigned long long mw0 = mwa;
                if (i + 2 < ntl) ATT_LOAD(ka0, ka1, va0, va1, mwa, 2 * (i + 2) + grp);
                ATT_COMPUTE(0, mw0);
                if (i + 1 < ntl) ATT_STORE(kb0, kb1, vb0, vb1, 1);
                __syncthreads();
                if (i + 1 < ntl) {
                    const unsigned long long mw1 = mwb;
                    if (i + 3 < ntl) ATT_LOAD(kb0, kb1, vb0, vb1, mwb, 2 * (i + 3) + grp);
                    ATT_COMPUTE(1, mw1);
                    if (i + 2 < ntl) ATT_STORE(ka0, ka1, va0, va1, 0);
                    __syncthreads();
                }
            }
#undef ATT_LOAD
#undef ATT_STORE
#undef ATT_COMPUTE
            if (grp == 1) { LAS float* cw = comb + w4 * 33 * 64 + lane;
#pragma unroll
                for (int r = 0; r < 16; ++r) { cw[r * 64] = o0[r]; cw[(16 + r) * 64] = o1[r]; }
                cw[32 * 64] = lsum; }
            __syncthreads();
            if (grp == 0) { const LAS float* cw = comb + w4 * 33 * 64 + lane;
#pragma unroll
                for (int r = 0; r < 16; ++r) { o0[r] += cw[r * 64]; o1[r] += cw[(16 + r) * 64]; }
                lsum += cw[32 * 64]; lsum += __shfl_xor(lsum, 32); const float inv = 1.f / lsum;
                bf16_t* yp = Y + (size_t)qrow * D + 256 + h * 64 + 4 * hi;
#pragma unroll
                for (int g4 = 0; g4 < 4; ++g4) { u32x2 w0, w1;
                    w0.x = cvt_pk_bf16(o0[4 * g4] * inv, o0[4 * g4 + 1] * inv); w0.y = cvt_pk_bf16(o0[4 * g4 + 2] * inv, o0[4 * g4 + 3] * inv);
                    w1.x = cvt_pk_bf16(o1[4 * g4] * inv, o1[4 * g4 + 1] * inv); w1.y = cvt_pk_bf16(o1[4 * g4 + 2] * inv, o1[4 * g4 + 3] * inv);
                    *(u32x2*)(yp + 8 * g4) = w0; *(u32x2*)(yp + 32 + 8 * g4) = w1; } }
            __syncthreads();
        }
    }
}

constexpr size_t WS_KI = 234 * MiB;
template <int J, unsigned MSK>
__device__ __forceinline__ void tr_stage(unsigned (&a)[32]) {
#pragma unroll
    for (int k = 0; k < 32; ++k) if ((k & J) == 0) { const unsigned t = (a[k] ^ (a[k + J] >> J)) & MSK; a[k] ^= t; a[k + J] ^= (t << J); }
}
__device__ __forceinline__ void transpose32(unsigned (&a)[32]) {
    tr_stage<16, 0x0000FFFFu>(a); tr_stage<8, 0x00FF00FFu>(a); tr_stage<4, 0x0F0F0F0Fu>(a); tr_stage<2, 0x33333333u>(a); tr_stage<1, 0x55555555u>(a);
}
__device__ __forceinline__ int wave_total_i(int v) {
    v += __builtin_amdgcn_update_dpp(0, v, 0x111, 0xf, 0xf, false);
    v += __builtin_amdgcn_update_dpp(0, v, 0x112, 0xf, 0xf, false);
    v += __builtin_amdgcn_update_dpp(0, v, 0x114, 0xf, 0xf, false);
    v += __builtin_amdgcn_update_dpp(0, v, 0x118, 0xf, 0xf, false);
    v += __builtin_amdgcn_update_dpp(0, v, 0x142, 0xa, 0xf, false);
    v += __builtin_amdgcn_update_dpp(0, v, 0x143, 0xc, 0xf, false);
    return __builtin_amdgcn_readlane(v, 63);
}
__device__ __forceinline__ void indexer_mfma(Frame& F) {
    const float* MISC = (const float*)WSP(WS_MISC); unsigned long long* MASKT = (unsigned long long*)WSP(WS_MASK); const bf16_t* PROJ = (const bf16_t*)WSP(WS_BIG); const bf16_t* KI = (const bf16_t*)WSP(WS_KI);
    LAS unsigned short* sc16 = (LAS unsigned short*)F.lds;
    const int lane = F.lane, r32 = lane & 31, hi = lane >> 5, wv = F.wave;
    for (int pi = F.vcu; pi < 1024; pi += F.G) {
        const int b = pi >> 8, pp = pi & 255;
#pragma unroll 1
        for (int half = 0; half < 2; ++half) {
            const int t0 = 8 * (half == 0 ? pp : 511 - pp), m0 = b * S + t0, tq = t0 + wv;
            unsigned long long myword = 0ull;
            if (t0 + 8 <= 256) {
                const int lo = 64 * lane; myword = (tq >= lo + 63) ? ~0ull : (tq < lo ? 0ull : ((2ull << (tq - lo)) - 1ull));
                MASKT[(size_t)(b * 64 + lane) * S + tq] = myword;
                continue;
            }
            const int nmax = t0 + 8, ntile = (nmax + 31) >> 5;
            bf16x8 qa[2][4]; float wq[2][4][4];
#pragma unroll
            for (int i = 0; i < 2; ++i) {
                const bf16_t* qp = PROJ + (size_t)(m0 + 4 * i + (r32 >> 3)) * PW + P_QI + (r32 & 7) * 64 + 8 * hi;
#pragma unroll
                for (int s = 0; s < 4; ++s) qa[i][s] = *(const bf16x8*)(qp + 16 * s);
#pragma unroll
                for (int qq = 0; qq < 4; ++qq) { const f32x4 w4 = *(const f32x4*)(MISC + (size_t)(m0 + 4 * i + qq) * 16 + 4 * hi);
#pragma unroll
                    for (int e = 0; e < 4; ++e) wq[i][qq][e] = w4[e] * (0.125f * 0.35355339059327373f); }
            }
            bf16x8 kring[4][4];
#define IDX_LOADK(u_, j_) do { const int jt_ = (j_) < ntile ? (j_) : ntile - 1; const bf16_t* kp_ = KI + ((size_t)((b * S >> 5) + jt_) * 4 * 64 + lane) * 8; \
    _Pragma("unroll") for (int s_ = 0; s_ < 4; ++s_) kring[u_][s_] = *(const bf16x8*)(kp_ + s_ * 64 * 8); } while (0)
#pragma unroll
            for (int u = 0; u < 4; ++u) IDX_LOADK(u, wv + 8 * u);
            for (int jb = wv; jb < ntile; jb += 32) {
#pragma unroll
                for (int u = 0; u < 4; ++u) {
                    const int j = jb + 8 * u;
                    if (j < ntile) {
                        const int key = 32 * j + r32;
                        bf16x8 kb[4];
#pragma unroll
                        for (int s = 0; s < 4; ++s) kb[s] = kring[u][s];
                        IDX_LOADK(u, j + 32);
#pragma unroll
                        for (int i = 0; i < 2; ++i) {
                            f32x16 d;
#pragma unroll
                            for (int r = 0; r < 16; ++r) d[r] = 0.f;
#pragma unroll
                            for (int s = 0; s < 4; ++s) d = __builtin_amdgcn_mfma_f32_32x32x16_bf16(qa[i][s], kb[s], d, 0, 0, 0);
                            float part[4];
#pragma unroll
                            for (int qq = 0; qq < 4; ++qq) { float a = 0.f;
#pragma unroll
                                for (int e = 0; e < 4; ++e) a = fmaf(wq[i][qq][e], fmaxf(d[4 * qq + e], 0.f), a);
                                part[qq] = a; }
                            auto s01 = __builtin_amdgcn_permlane32_swap(__float_as_uint(part[0]), __float_as_uint(part[1]), false, false);
                            auto s23 = __builtin_amdgcn_permlane32_swap(__float_as_uint(part[2]), __float_as_uint(part[3]), false, false);
                            const float v01 = __uint_as_float(s01[0]) + __uint_as_float(s01[1]), v23 = __uint_as_float(s23[0]) + __uint_as_float(s23[1]);
                            const int qA = 4 * i + hi, qB = 4 * i + 2 + hi;
                            const int kpos = ((key & 2047) << 1) + (key >> 11);
                            sc16[qA * 4096 + kpos] = __builtin_bit_cast(unsigned short, (_Float16)((key <= t0 + qA) ? v01 : -INFINITY));
                            sc16[qB * 4096 + kpos] = __builtin_bit_cast(unsigned short, (_Float16)((key <= t0 + qB) ? v23 : -INFINITY));
                        }
                    }
                }
            }
#undef IDX_LOADK
            __syncthreads();
            const int nvalid = 32 * ntile; const LAS unsigned* srow = (const LAS unsigned*)F.lds + wv * 2048 + lane;
            unsigned kk[32], kc[32];
#pragma unroll
            for (int r = 0; r < 32; ++r) { const unsigned w = srow[64 * r]; const unsigned sg = (w & 0x80008000u) >> 15; const unsigned k = w ^ (((sg << 16) - sg) | 0x80008000u);
                const unsigned vm = ((unsigned)((64 * r + lane - nvalid) >> 31) & 0xFFFFu) | ((unsigned)((2048 + 64 * r + lane - nvalid) >> 31) & 0xFFFF0000u);
                kc[r] = k & vm; kk[r] = kc[r]; }
            transpose32(kk);
            unsigned aA = ~0u, aB = ~0u, Tk = 0u; int base = 0;
#pragma unroll
            for (int bit = 15; bit >= 0; --bit) {
                const unsigned wa = kk[31 - bit], wb = kk[15 - bit];
                const int tot = wave_total_i(__builtin_popcount(wa & aA) + __builtin_popcount(wb & aB));
                const bool take = (base + tot >= 256);
                const unsigned flip = take ? 0u : ~0u;
                aA &= (wa ^ flip); aB &= (wb ^ flip);
                if (take) Tk |= (1u << bit); else base += tot;
            }
            const int ngt = base, neq = wave_total_i(__builtin_popcount(aA) + __builtin_popcount(aB));
            if (ngt + neq == 256) {
#pragma unroll
                for (int r = 0; r < 32; ++r) { const unsigned long long wlo = __ballot((kc[r] & 0xFFFFu) >= Tk), whi = __ballot((kc[r] >> 16) >= Tk);
                    if (lane == r) myword = wlo; if (lane == 32 + r) myword = whi; }
            } else {
                int need = 256 - ngt;
#pragma unroll
                for (int hf = 0; hf < 2; ++hf)
#pragma unroll
                    for (int r = 0; r < 32; ++r) { const unsigned k = hf ? (kc[r] >> 16) : (kc[r] & 0xFFFFu);
                        unsigned long long wsel = __ballot(k > Tk), em = __ballot(k == Tk); int c = __builtin_popcountll(em);
                        if (c > need) { while (c > need) { em &= ~(1ull << (63 - __builtin_clzll(em))); --c; } }
                        need -= c; wsel |= em;
                        if (lane == 32 * hf + r) myword = wsel; }
            }
            MASKT[(size_t)(b * 64 + lane) * S + tq] = myword;
            __syncthreads();
        }
    }
}

constexpr size_t WS_CVT = 236 * MiB;
__device__ __forceinline__ void mlstm2_mfma(Frame& F, int l) {
    const float* MISC = (const float*)WSP(WS_MISC); const float* STATE = (const float*)WSP(WS_STATE); const bf16_t* PROJ = (const bf16_t*)WSP(WS_BIG); const bf16_t* CVT = (const bf16_t*)WSP(WS_CVT);
    bf16_t* Y = (bf16_t*)WSP(WS_Y); const float* i_bias = INP(I_I_BIAS); const float* f_bias = INP(I_F_BIAS); const float* mnorm = INP(I_MNORM);
    const int lane = F.lane, r32 = lane & 31, hi = lane >> 5, grp = F.wave >> 2, w4 = F.wave & 3, lg = F.tid & 255;
    constexpr int KROWB = 144, VROWB = 272, GB = 49152;
    LAS unsigned char* gb = F.lds + grp * GB;
    LAS float* bc = (LAS float*)gb;
    LAS float* gs = bc + 128;
    LAS float* npv = gs + 128;
    LAS float* wsum = npv + 64;
    LAS unsigned char* ct = gb + 2048;
    LAS unsigned char* kt = ct + 9216;
    LAS unsigned char* vt = kt + 18432;
    for (int it0 = 2 * F.vcu; it0 < 512; it0 += 2 * F.G) {
        const int item = it0 + grp, bh = item >> 5, c = item & 31, b = bh >> 2, h = bh & 3, m0 = b * S + c * 128;
        if (lg < 128) { const float f = MISC[(size_t)(m0 + lg) * 16 + 12 + h] + f_bias[l * 4 + h]; bc[lg] = fminf(f, 0.f) - log1pf(__expf(-fabsf(f))); gs[lg] = MISC[(size_t)(m0 + lg) * 16 + 8 + h] + i_bias[l * 4 + h]; }
        if (lg >= 128 && lg < 160) { const int cc = lg - 128; wsum[cc] = (cc < c) ? STATE[(size_t)(bh * 32 + cc) * STATE_STRIDE + 4160] : 0.f; }
        __syncthreads();
        if (lg < 64) {
            float a0 = bc[2 * lane], a1 = bc[2 * lane + 1]; float s = a0 + a1;
#pragma unroll
            for (int o = 1; o < 64; o <<= 1) { const float t = __shfl_up(s, o); if (lane >= o) s += t; }
            const float ex = s - (a0 + a1); const float i0 = gs[2 * lane], i1 = gs[2 * lane + 1];
            bc[2 * lane] = ex + a0; bc[2 * lane + 1] = s; gs[2 * lane] = i0 - (ex + a0); gs[2 * lane + 1] = i1 - s;
            float w = (lane < 32) ? wsum[lane] : 0.f; float suf = w;
#pragma unroll
            for (int o = 1; o < 32; o <<= 1) { const float t = __shfl_down(suf, o); if (lane + o < 32) suf += t; }
            if (lane < 32) wsum[lane] = suf - w;
        }
        __syncthreads();
        { f32x4 a4[4]; float nv = 0.f;
#pragma unroll
          for (int k = 0; k < 4; ++k) a4[k] = (f32x4){0.f, 0.f, 0.f, 0.f};
          for (int cc = 0; cc < c; ++cc) { const float* st = STATE + (size_t)(bh * 32 + cc) * STATE_STRIDE; const float wgt = __expf(wsum[cc]);
#pragma unroll
              for (int k = 0; k < 4; ++k) { const f32x4 v = *(const f32x4*)(st + 4 * (lg + 256 * k)); a4[k] = a4[k] + v * wgt; }
              if (lg < 64) nv = fmaf(wgt, st[4096 + lg], nv); }
#pragma unroll
          for (int k = 0; k < 4; ++k) { const int idx = 4 * (lg + 256 * k), e = idx >> 6, d = idx & 63; u32x2 w; w.x = cvt_pk_bf16(a4[k][0], a4[k][1]); w.y = cvt_pk_bf16(a4[k][2], a4[k][3]); *(LAS u32x2*)(ct + e * KROWB + d * 2) = w; }
          if (lg < 64) npv[lg] = nv; }
#pragma unroll
        for (int k = 0; k < 4; ++k) { const int id = lg + 256 * k, row = id >> 3, ch = id & 7;
            *(LAS u32x4*)(kt + row * KROWB + ch * 16) = *(const u32x4*)(PROJ + (size_t)(m0 + row) * PW + P_CK + h * 64 + ch * 8);
            const int vrow = id >> 4, vch = id & 15;
            *(LAS u32x4*)(vt + vrow * VROWB + vch * 16) = *(const u32x4*)(CVT + (size_t)(b * 256 + h * 64 + vrow) * S + c * 128 + vch * 8); }
        __syncthreads();
        const int j = 32 * w4 + r32, qrow = m0 + j;
        bf16x8 qf[4];
#pragma unroll
        for (int s = 0; s < 4; ++s) qf[s] = *(const bf16x8*)(PROJ + (size_t)qrow * PW + P_CQ + h * 64 + 16 * s + 8 * hi);
        const float bj = bc[j], eb = __expf(bj);
        float qn = 0.f;
#pragma unroll
        for (int s = 0; s < 4; ++s) { const u32x4 w = __builtin_bit_cast(u32x4, qf[s]); const LAS float* np = npv + 16 * s + 8 * hi;
            qn += lo_bf(w.x) * np[0] + hi_bf(w.x) * np[1] + lo_bf(w.y) * np[2] + hi_bf(w.y) * np[3] + lo_bf(w.z) * np[4] + hi_bf(w.z) * np[5] + lo_bf(w.w) * np[6] + hi_bf(w.w) * np[7]; }
        qn += __shfl_xor(qn, 32); qn *= eb;
        f32x16 n0, n1;
#pragma unroll
        for (int r = 0; r < 16; ++r) { n0[r] = 0.f; n1[r] = 0.f; }
#pragma unroll
        for (int ks = 0; ks < 4; ++ks) { const bf16x8 c0 = *(const LAS bf16x8*)(ct + r32 * KROWB + 32 * ks + 16 * hi), c1 = *(const LAS bf16x8*)(ct + (32 + r32) * KROWB + 32 * ks + 16 * hi);
            n0 = __builtin_amdgcn_mfma_f32_32x32x16_bf16(c0, qf[ks], n0, 0, 0, 0); n1 = __builtin_amdgcn_mfma_f32_32x32x16_bf16(c1, qf[ks], n1, 0, 0, 0); }
#pragma unroll
        for (int r = 0; r < 16; ++r) { n0[r] *= eb; n1[r] *= eb; }
        float sa = 0.f;
#pragma unroll 1
        for (int st = 0; st <= w4; ++st) {
            f32x16 p;
#pragma unroll
            for (int r = 0; r < 16; ++r) p[r] = 0.f;
#pragma unroll
            for (int ks = 0; ks < 4; ++ks) { const bf16x8 kf = *(const LAS bf16x8*)(kt + (32 * st + r32) * KROWB + 32 * ks + 16 * hi); p = __builtin_amdgcn_mfma_f32_32x32x16_bf16(kf, qf[ks], p, 0, 0, 0); }
#pragma unroll
            for (int r = 0; r < 16; ++r) { const int s = 32 * st + (r & 3) + 8 * (r >> 2) + 4 * hi; const float a = (s <= j) ? __expf(bj + gs[s]) * p[r] : 0.f; p[r] = a; sa += a; }
#pragma unroll
            for (int k2 = 0; k2 < 2; ++k2) {
                u32x4 pw; pw.x = cvt_pk_bf16(p[8 * k2 + 0], p[8 * k2 + 1]); pw.y = cvt_pk_bf16(p[8 * k2 + 2], p[8 * k2 + 3]); pw.z = cvt_pk_bf16(p[8 * k2 + 4], p[8 * k2 + 5]); pw.w = cvt_pk_bf16(p[8 * k2 + 6], p[8 * k2 + 7]);
                const bf16x8 pf = __builtin_bit_cast(bf16x8, pw);
                const int vo = (32 * st + 16 * k2 + 4 * hi) * 2;
                const u32x2 a0 = *(const LAS u32x2*)(vt + r32 * VROWB + vo), a1 = *(const LAS u32x2*)(vt + r32 * VROWB + vo + 16);
                const u32x2 b0 = *(const LAS u32x2*)(vt + (32 + r32) * VROWB + vo), b1 = *(const LAS u32x2*)(vt + (32 + r32) * VROWB + vo + 16);
                const u32x4 va = {a0.x, a0.y, a1.x, a1.y}, vb4 = {b0.x, b0.y, b1.x, b1.y};
                n0 = __builtin_amdgcn_mfma_f32_32x32x16_bf16(__builtin_bit_cast(bf16x8, va), pf, n0, 0, 0, 0);
                n1 = __builtin_amdgcn_mfma_f32_32x32x16_bf16(__builtin_bit_cast(bf16x8, vb4), pf, n1, 0, 0, 0);
            }
        }
        sa += __shfl_xor(sa, 32);
        const float inv = 1.f / fmaxf(fabsf(qn + sa), 1.f);
        float ss = 0.f;
#pragma unroll
        for (int r = 0; r < 16; ++r) { n0[r] *= inv; n1[r] *= inv; ss += n0[r] * n0[r] + n1[r] * n1[r]; }
        ss += __shfl_xor(ss, 32); const float rr = rsqrtf(ss * (1.f / 64.f) + EPS);
        const float* gp = mnorm + l * 256 + h * 64 + 4 * hi; const bf16_t* op = PROJ + (size_t)qrow * PW + P_CO + h * 64 + 4 * hi; bf16_t* yp = Y + (size_t)qrow * D + 512 + h * 64 + 4 * hi;
#pragma unroll
        for (int g4 = 0; g4 < 4; ++g4) {
            const f32x4 ga = *(const f32x4*)(gp + 8 * g4), gb4 = *(const f32x4*)(gp + 32 + 8 * g4);
            const u32x2 oa = *(const u32x2*)(op + 8 * g4), ob = *(const u32x2*)(op + 32 + 8 * g4);
            u32x2 w0, w1;
            w0.x = cvt_pk_bf16(sigmoid_f(lo_bf(oa.x)) * n0[4 * g4] * rr * ga[0], sigmoid_f(hi_bf(oa.x)) * n0[4 * g4 + 1] * rr * ga[1]);
            w0.y = cvt_pk_bf16(sigmoid_f(lo_bf(oa.y)) * n0[4 * g4 + 2] * rr * ga[2], sigmoid_f(hi_bf(oa.y)) * n0[4 * g4 + 3] * rr * ga[3]);
            w1.x = cvt_pk_bf16(sigmoid_f(lo_bf(ob.x)) * n1[4 * g4] * rr * gb4[0], sigmoid_f(hi_bf(ob.x)) * n1[4 * g4 + 1] * rr * gb4[1]);
            w1.y = cvt_pk_bf16(sigmoid_f(lo_bf(ob.y)) * n1[4 * g4 + 2] * rr * gb4[2], sigmoid_f(hi_bf(ob.y)) * n1[4 * g4 + 3] * rr * gb4[3]);
            *(u32x2*)(yp + 8 * g4) = w0; *(u32x2*)(yp + 32 + 8 * g4) = w1;
        }
        __syncthreads();
    }
}

constexpr size_t WS_SSQV = 244 * MiB;
__device__ __forceinline__ void sgu_mfma(Frame& F, int l) {
    const bf16_t* PROJ = (const bf16_t*)WSP(WS_BIG); bf16_t* Y = (bf16_t*)WSP(WS_Y); const float* SSQV = (const float*)WSP(WS_SSQV);
    const float* gain = INP(I_SGU_NORM) + l * 256; const float* sw = INP(I_SGU_W) + (size_t)l * 4 * 128 * 128; const float* sb = INP(I_SGU_B) + l * 4 * 128;
    const int lane = F.lane, r32 = lane & 31, hi = lane >> 5, dt = F.wave & 1, tt = F.wave >> 1;
    constexpr int VROWB = 272;
    LAS float* r_s = (LAS float*)F.lds;
    LAS unsigned char* vt = F.lds + 512;
    for (int item = F.vcu; item < 512; item += F.G) {
        const int g = item & 3, m0 = (item >> 2) * 128;
        if (F.tid < 128) { const f32x4 q = *(const f32x4*)(SSQV + (size_t)(m0 + F.tid) * 4); r_s[F.tid] = rsqrtf(((q[0] + q[1]) + (q[2] + q[3])) * (1.f / 256.f) + EPS); }
        __syncthreads();
#pragma unroll
        for (int k = 0; k < 2; ++k) { const int id = F.tid + 512 * k, s = id >> 3, d0 = (id & 7) * 8; const float rs = r_s[s];
            const u32x4 w = *(const u32x4*)(PROJ + (size_t)(m0 + s) * PW + P_AV + g * 64 + d0);
            const float v[8] = {lo_bf(w.x), hi_bf(w.x), lo_bf(w.y), hi_bf(w.y), lo_bf(w.z), hi_bf(w.z), lo_bf(w.w), hi_bf(w.w)};
#pragma unroll
            for (int i = 0; i < 8; ++i) *(LAS bf16_t*)(vt + (d0 + i) * VROWB + s * 2) = (bf16_t)f2bf(v[i] * rs); }
        __syncthreads();
        f32x16 acc;
#pragma unroll
        for (int r = 0; r < 16; ++r) acc[r] = 0.f;
        const int t = 32 * tt + r32; const float* wrow = sw + ((size_t)g * 128 + t) * 128;
#pragma unroll 1
        for (int ks = 0; ks < 2 * (tt + 1); ++ks) {
            const bf16x8 af = *(const LAS bf16x8*)(vt + (32 * dt + r32) * VROWB + (16 * ks + 8 * hi) * 2);
            const int s0 = 16 * ks + 8 * hi; const f32x4 w0 = *(const f32x4*)(wrow + s0), w1 = *(const f32x4*)(wrow + s0 + 4);
            u32x4 bw; bw.x = cvt_pk_bf16(s0 + 0 <= t ? w0[0] : 0.f, s0 + 1 <= t ? w0[1] : 0.f); bw.y = cvt_pk_bf16(s0 + 2 <= t ? w0[2] : 0.f, s0 + 3 <= t ? w0[3] : 0.f);
            bw.z = cvt_pk_bf16(s0 + 4 <= t ? w1[0] : 0.f, s0 + 5 <= t ? w1[1] : 0.f); bw.w = cvt_pk_bf16(s0 + 6 <= t ? w1[2] : 0.f, s0 + 7 <= t ? w1[3] : 0.f);
            acc = __builtin_amdgcn_mfma_f32_32x32x16_bf16(af, __builtin_bit_cast(bf16x8, bw), acc, 0, 0, 0);
        }
        const float bias = sb[g * 128 + t]; const size_t row = (size_t)(m0 + t);
        const float* gp = gain + g * 64 + 32 * dt + 4 * hi; const bf16_t* up = PROJ + row * PW + P_AU + g * 64 + 32 * dt + 4 * hi; bf16_t* yp = Y + row * D + g * 64 + 32 * dt + 4 * hi;
#pragma unroll
        for (int g4 = 0; g4 < 4; ++g4) { const f32x4 gv = *(const f32x4*)(gp + 8 * g4); const u32x2 uw = *(const u32x2*)(up + 8 * g4); u32x2 ow;
            ow.x = cvt_pk_bf16(lo_bf(uw.x) * (gv[0] * acc[4 * g4] + bias), hi_bf(uw.x) * (gv[1] * acc[4 * g4 + 1] + bias));
            ow.y = cvt_pk_bf16(lo_bf(uw.y) * (gv[2] * acc[4 * g4 + 2] + bias), hi_bf(uw.y) * (gv[3] * acc[4 * g4 + 3] + bias));
            *(u32x2*)(yp + 8 * g4) = ow; }
        __syncthreads();
    }
}

__device__ __forceinline__ void mlstm1_mfma(Frame& F, int l) {
    const float* MISC = (const float*)WSP(WS_MISC); float* STATE = (float*)WSP(WS_STATE); const bf16_t* PROJ = (const bf16_t*)WSP(WS_BIG); const bf16_t* CVT = (const bf16_t*)WSP(WS_CVT);
    const float* i_bias = INP(I_I_BIAS); const float* f_bias = INP(I_F_BIAS);
    const int lane = F.lane, r32 = lane & 31, hi = lane >> 5, grp = F.wave >> 2, w4 = F.wave & 3, et = w4 & 1, dt = w4 >> 1, lg = F.tid & 255;
    constexpr int KROWB = 144, GB = 20480;
    LAS unsigned char* gb = F.lds + grp * GB;
    LAS float* bc = (LAS float*)gb; LAS float* wk = bc + 128; LAS unsigned char* kt = gb + 1024;
    for (int it0 = 2 * F.vcu; it0 < 512; it0 += 2 * F.G) {
        const int item = it0 + grp, bh = item >> 5, c = item & 31, b = bh >> 2, h = bh & 3, m0 = b * S + c * 128;
        if (lg < 128) { const float f = MISC[(size_t)(m0 + lg) * 16 + 12 + h] + f_bias[l * 4 + h]; bc[lg] = fminf(f, 0.f) - log1pf(__expf(-fabsf(f))); wk[lg] = MISC[(size_t)(m0 + lg) * 16 + 8 + h] + i_bias[l * 4 + h]; }
        __syncthreads();
        if (lg < 64) { const float a0 = bc[2 * lane], a1 = bc[2 * lane + 1]; float s = a0 + a1;
#pragma unroll
            for (int o = 1; o < 64; o <<= 1) { const float t = __shfl_up(s, o); if (lane >= o) s += t; }
            const float tot = __shfl(s, 63), ex = s - (a0 + a1);
            wk[2 * lane] = __expf(tot - (ex + a0) + wk[2 * lane]); wk[2 * lane + 1] = __expf(tot - s + wk[2 * lane + 1]);
            if (lane == 0) bc[0] = tot; }
        __syncthreads();
        const float Bc = bc[0];
#pragma unroll
        for (int k = 0; k < 4; ++k) { const int id = lg + 256 * k, s = id >> 3, ch = id & 7; const float ws_ = wk[s];
            const u32x4 w = *(const u32x4*)(PROJ + (size_t)(m0 + s) * PW + P_CK + h * 64 + ch * 8); u32x4 o;
            o.x = cvt_pk_bf16(lo_bf(w.x) * ws_, hi_bf(w.x) * ws_); o.y = cvt_pk_bf16(lo_bf(w.y) * ws_, hi_bf(w.y) * ws_); o.z = cvt_pk_bf16(lo_bf(w.z) * ws_, hi_bf(w.z) * ws_); o.w = cvt_pk_bf16(lo_bf(w.w) * ws_, hi_bf(w.w) * ws_);
            *(LAS u32x4*)(kt + s * KROWB + ch * 16) = o; }
        __syncthreads();
        f32x16 acc;
#pragma unroll
        for (int r = 0; r < 16; ++r) acc[r] = 0.f;
        float nsum = 0.f;
        const bf16_t* vp = CVT + (size_t)(b * 256 + h * 64 + 32 * et + r32) * S + c * 128 + 8 * hi;
        bf16x8 af[8];
#pragma unroll
        for (int ks = 0; ks < 8; ++ks) af[ks] = *(const bf16x8*)(vp + 16 * ks);
#pragma unroll
        for (int ks = 0; ks < 8; ++ks) {
            const LAS unsigned char* kp = kt + (16 * ks + 8 * hi) * KROWB + (32 * dt + r32) * 2; unsigned e8[8];
#pragma unroll
            for (int jj = 0; jj < 8; ++jj) e8[jj] = *(const LAS bf16_t*)(kp + jj * KROWB);
            u32x4 bw; bw.x = e8[0] | (e8[1] << 16); bw.y = e8[2] | (e8[3] << 16); bw.z = e8[4] | (e8[5] << 16); bw.w = e8[6] | (e8[7] << 16);
#pragma unroll
            for (int jj = 0; jj < 8; ++jj) nsum += __uint_as_float(e8[jj] << 16);
            acc = __builtin_amdgcn_mfma_f32_32x32x16_bf16(af[ks], __builtin_bit_cast(bf16x8, bw), acc, 0, 0, 0);
        }
        float* st = STATE + (size_t)item * STATE_STRIDE;
#pragma unroll
        for (int r = 0; r < 16; ++r) st[(32 * et + (r & 3) + 8 * (r >> 2) + 4 * hi) * 64 + 32 * dt + r32] = acc[r];
        nsum += __shfl_xor(nsum, 32);
        if (et == 0 && hi == 0) st[4096 + 32 * dt + r32] = nsum;
        if (lg == 0) st[4160] = Bc;
        __syncthreads();
    }
}
#ifndef MK_MULTI
#define MK_MULTI 0
#endif
constexpr int N_PHASES = 1 + 10 * DEPTH;

__global__ void __launch_bounds__(NT, 2) mk_fwd(Args args) {
    extern __shared__ __attribute__((aligned(16))) unsigned char lds_raw[];
    Frame F;
    F.lds = (LAS unsigned char*)lds_raw; F.tid = threadIdx.x; F.lane = F.tid & 63; F.wave = __builtin_amdgcn_readfirstlane(F.tid >> 6);
    F.G = gridDim.x; { const int bx_ = blockIdx.x; F.vcu = (F.G % 8 == 0) ? (bx_ % 8) * (F.G / 8) + bx_ / 8 : bx_; }
    if (F.tid < 20) { const unsigned long long pv = F.tid < 18 ? (unsigned long long)args.in[F.tid < 18 ? F.tid : 0] : (F.tid == 18 ? (unsigned long long)args.out : (unsigned long long)args.ws);
        *(LAS unsigned long long*)(F.lds + PTR_OFF + 8 * F.tid) = pv; }
    if (F.tid < 2) *(LAS unsigned*)(F.lds + PTR_OFF + 256 + 4 * F.tid) = 0u;
    __syncthreads();
#if MK_MULTI
    int bx = (int)blockIdx.x;
    const int lo = args.ph_lo, hi = args.ph_hi; const bool coop = args.coop != 0;
#else
    int bx = (int)blockIdx.x;
    constexpr int lo = 0, hi = N_PHASES - 1; constexpr bool coop = true;
    if (F.tid == 0) (void)xb_add(&((unsigned*)(args.ws + WS_BAR))[XB_XCNT(xb_xcc_id())], 1u);
#endif
#define XBAR_NOW() XcdBarrier{(unsigned*)WSP(WS_BAR), xb_xcc_id(), (volatile LAS unsigned*)(F.lds + PTR_OFF + 256)}
#define RUN(k) (lo <= (k) && (k) < hi)
#define LAUNDER() asm volatile("" : "+v"(F.tid), "+v"(F.lane), "+s"(F.G), "+s"(F.vcu), "+s"(F.wave), "+s"(bx), "+s"(F.lds))
#ifndef MK_SKEW_SLEEP
#define MK_SKEW_SLEEP 0
#endif
#define SKEW() do { if (coop) { for (unsigned s_ = ((unsigned)blockIdx.x >> 3) & 3u; s_ > 0; --s_) __builtin_amdgcn_s_sleep(MK_SKEW_SLEEP); } } while (0)
#define SEAM(k) do { if (coop && RUN(k) && RUN((k) + 1)) { if ((k) == 0) cg::this_grid().sync(); else { const XcdBarrier xb_ = XBAR_NOW(); xcd_barrier(xb_); } } } while (0)

    if (RUN(0)) { LAUNDER(); convert_mix_weights(F, 0); prologue_rows(F);
        if (blockIdx.x == 0 && F.tid < DEPTH * 192) { const int l_ = F.tid / 192, r_ = F.tid % 192, w_ = r_ / 64, i_ = r_ % 64; ((float*)WSP(WS_GT))[F.tid] = INP(I_Q_NORM + w_)[l_ * 64 + i_]; } }
    SEAM(0);
#pragma unroll 1
    for (int l = 0; l < DEPTH; ++l) {
        const int pb = 1 + 10 * l;
        if (RUN(pb + 0)) { LAUNDER(); SKEW();
            pg8::Gemm<D, D, D, 256u * D * 2, 0, 256u * D * 2, 0> g{(const bf16_t*)WSP(WS_XG), (const bf16_t*)WSP(WS_WIN)};
            pg8::StaticOrder So; So.init(M, PW, F.G, bx);
            epi::EpiProj E{(bf16_t*)WSP(WS_BIG), (float*)WSP(WS_MISC), (const float*)WSP(WS_RSA), (const float*)WSP(WS_COS), (const float*)WSP(WS_SIN), (const float*)WSP(WS_GT) + l * 192, (bf16_t*)WSP(WS_VT), (bf16_t*)WSP(WS_KI), (bf16_t*)WSP(WS_CVT), (float*)WSP(WS_SSQV)};
            pg8::gemm_phase<epi::EpiProj, pg8::StaticOrder, true>(F.lds, g, So, E, F.tid);
        }
        SEAM(pb + 0);
        if (RUN(pb + 1)) { LAUNDER(); sgu_mfma(F, l); conv_simple(F, l); indexer_mfma(F); mlstm1_mfma(F, l); }
        SEAM(pb + 1);
        if (RUN(pb + 2)) { LAUNDER(); attn_mfma(F, l); mlstm2_mfma(F, l); }
        SEAM(pb + 2);
        if (RUN(pb + 3)) { LAUNDER(); SKEW();
            pg8::Gemm<256, D, 256, 256u * D * 2, 256u * 2, 256u * 256 * 2, 1024u * 256 * 2> g{(const bf16_t*)WSP(WS_Y), (const bf16_t*)WSP(WS_WBR)};
            pg8::SuperOrder<0> So; So.init(F.G, bx);
            epi::EpiPlain E{(bf16_t*)WSP(WS_BIG), 4096, 1024};
            pg8::gemm_phase<epi::EpiPlain, pg8::SuperOrder<0>, true>(F.lds, g, So, E, F.tid);
        }
        if (coop && RUN(pb + 3) && RUN(pb + 4)) { asm volatile("s_waitcnt vmcnt(0)" ::: "memory"); __syncthreads(); __builtin_amdgcn_fence(__ATOMIC_ACQUIRE, "agent"); asm volatile("s_waitcnt vmcnt(0)" ::: "memory"); __syncthreads(); }
        if (RUN(pb + 4)) { LAUNDER();
            pg8::Gemm<D, D, D, 256u * D * 2, 0, 256u * D * 2, 0> g{(const bf16_t*)WSP(WS_XG), (const bf16_t*)WSP(WS_WG)};
            pg8::SuperOrder<1> So; So.init(F.G, bx);
            epi::EpiGate E{(bf16_t*)WSP(WS_MG), (const bf16_t*)WSP(WS_BIG), (const float*)WSP(WS_RSA)};
            pg8::gemm_phase<epi::EpiGate, pg8::SuperOrder<1>, true>(F.lds, g, So, E, F.tid);
        }
        SEAM(pb + 4);
        if (RUN(pb + 5)) { LAUNDER();
            pg8::Gemm<D, D, D, 256u * D * 2, 0, 256u * D * 2, 0> g{(const bf16_t*)WSP(WS_MG), (const bf16_t*)WSP(WS_WOUT)};
            pg8::StaticOrder So; So.init(M, D, F.G, bx);
            epi::EpiResid E{l == 0 ? INP(I_X) : nullptr, (bf16_t*)WSP(WS_XG), nullptr, (float*)WSP(WS_SSQB)};
            pg8::gemm_phase<epi::EpiResid, pg8::StaticOrder, true>(F.lds, g, So, E, F.tid);
            __syncthreads();
            convert_mlp_weights(F, l);
        }
        SEAM(pb + 5);
        if (RUN(pb + 6)) { LAUNDER(); finalize_rs(F, WS_SSQB, WS_RSB); }
        SEAM(pb + 6);
        if (RUN(pb + 7)) { LAUNDER(); SKEW();
            pg8::Gemm<D, D, D, 256u * D * 2, 0, 256u * D * 2, 0> g{(const bf16_t*)WSP(WS_XG), (const bf16_t*)WSP(WS_WUP)};
            pg8::StaticOrder So; So.init(M, FF, F.G, bx);
            epi::EpiUp E{(bf16_t*)WSP(WS_BIG), (const float*)WSP(WS_RSB)};
            pg8::gemm_phase<epi::EpiUp, pg8::StaticOrder, true>(F.lds, g, So, E, F.tid);
            if (l + 1 < DEPTH) { __syncthreads(); convert_mix_weights(F, l + 1); }
        }
        SEAM(pb + 7);
        if (RUN(pb + 8)) { LAUNDER();
            pg8::Gemm<FF, FF, FF, 256u * FF * 2, 0, 256u * FF * 2, 0> g{(const bf16_t*)WSP(WS_BIG), (const bf16_t*)WSP(WS_WDN)};
            pg8::StaticOrder So; So.init(M, D, F.G, bx);
            epi::EpiResid E{nullptr, (bf16_t*)WSP(WS_XG), (l + 1 < DEPTH) ? nullptr : (float*)ptr_at(F, I_OUT), (float*)WSP(WS_SSQA)};
            pg8::gemm_phase<epi::EpiResid, pg8::StaticOrder, true>(F.lds, g, So, E, F.tid);
        }
        SEAM(pb + 8);
        if (RUN(pb + 9)) { LAUNDER(); if (l + 1 < DEPTH) finalize_rs(F, WS_SSQA, WS_RSA); }
        SEAM(pb + 9);
    }
#undef RUN
#undef SEAM
}

extern "C" void kernel_launch(void* const* d_in, const int* in_sizes, int n_in, void* d_out, int out_size, void* d_ws, size_t ws_size, hipStream_t stream) {
    static int grid = 0;
    if (grid == 0) {
        if (n_in != 18 || in_sizes[0] != M * D || out_size != M * D || ws_size < WS_END) { fprintf(stderr, "kernel_launch: unexpected shapes (n_in %d, in0 %d, out %d, ws %zu)\n", n_in, n_in > 0 ? in_sizes[0] : -1, out_size, ws_size); grid = -1; return; }
        int dev = 0, cus = 0, per_cu = 0;
        if (hipGetDevice(&dev) != hipSuccess || hipDeviceGetAttribute(&cus, hipDeviceAttributeMultiprocessorCount, dev) != hipSuccess) { grid = -1; return; }
        if (hipFuncSetAttribute((const void*)mk_fwd, hipFuncAttributeMaxDynamicSharedMemorySize, LDS_BYTES) != hipSuccess) { fprintf(stderr, "kernel_launch: hipFuncSetAttribute failed\n"); grid = -1; return; }
        if (hipOccupancyMaxActiveBlocksPerMultiprocessor(&per_cu, (const void*)mk_fwd, NT, LDS_BYTES) != hipSuccess || per_cu < 1) { fprintf(stderr, "kernel_launch: occupancy query says %d\n", per_cu); (void)hipGetLastError(); per_cu = 1; }
        grid = cus;
    }
    if (grid < 0) return;
    if (hipMemsetAsync((char*)d_ws + WS_CTL, 0, CTL_ZERO_BYTES, stream) != hipSuccess) { fprintf(stderr, "kernel_launch: memset failed\n"); return; }
    Args a{};
    for (int i = 0; i < 18; ++i) a.in[i] = (const float*)d_in[i];
    a.out = (float*)d_out; a.ws = (unsigned char*)d_ws;
#if MK_MULTI
    for (int p = 0; p < N_PHASES; ++p) { a.ph_lo = p; a.ph_hi = p + 1; a.coop = 0; hipLaunchKernelGGL(mk_fwd, dim3(grid), dim3(NT), LDS_BYTES, stream, a); }
#else
    a.ph_lo = 0; a.ph_hi = N_PHASES - 1; a.coop = 1;
    void* kargs[] = {&a};
    hipError_t e = hipLaunchCooperativeKernel((const void*)mk_fwd, dim3(grid), dim3(NT), kargs, LDS_BYTES, stream);
    if (e != hipSuccess) fprintf(stderr, "kernel_launch: cooperative launch failed: %s (grid %d)\n", hipGetErrorString(e), grid);
#endif
}
```

```cpp
#define MK_MULTI 0
#include <hip/hip_runtime.h>
#include <hip/hip_cooperative_groups.h>
#include <cstdio>
#include <cstdint>
namespace cg = cooperative_groups;

#define LAS __attribute__((address_space(3)))
typedef unsigned short bf16_t;
typedef short bf16x8 __attribute__((ext_vector_type(8)));
typedef float f32x4 __attribute__((ext_vector_type(4)));
typedef float f32x2 __attribute__((ext_vector_type(2)));
typedef unsigned u32x4 __attribute__((ext_vector_type(4)));
typedef unsigned u32x2 __attribute__((ext_vector_type(2)));

constexpr int D = 1024, NB = 4, S = 4096, M = NB * S, DEPTH = 2, FF = 4096, INW = 7760;
constexpr int O_AU = 0, O_AV = 256, O_BQ = 512, O_BK = 768, O_BV = 1024, O_QI = 1280, O_KI = 1792, O_WI = 1856,
              O_CQ = 1864, O_CK = 2120, O_CV = 2376, O_CO = 2632, O_CI = 2888, O_CF = 2892, O_DB = 2896, O_DC = 3152, O_DX = 3408, O_G = 3664;
constexpr int PW = 3840;
constexpr int P_AU = 0, P_AV = 256, P_Q = 512, P_K = 768, P_V = 1024, P_QI = 1280, P_CQ = 1792, P_CK = 2048, P_CV = 2304, P_CO = 2560,
              P_DB = 2816, P_DC = 3072, P_DX = 3328, P_KI = 3584;
constexpr float EPS = 1e-6f;
constexpr int NWAVES = 8, NT = 512;

constexpr size_t MiB = 1u << 20;
constexpr size_t WS_CTL = 0;
constexpr size_t WS_COS = 1 * MiB, WS_SIN = 1 * MiB + 512 * 1024;
constexpr size_t WS_MISC = 2 * MiB;
constexpr size_t WS_SSQA = 3 * MiB, WS_SSQB = 4 * MiB;
constexpr size_t WS_WIN = 5 * MiB;
constexpr size_t WS_WG = WS_WIN + (size_t)PW * D * 2;
constexpr size_t WS_WBR = WS_WG + (size_t)4096 * D * 2;
constexpr size_t WS_WOUT = WS_WBR + (size_t)4 * 1024 * 256 * 2;
constexpr size_t WS_XG = 25 * MiB;
constexpr size_t WS_BIG = 57 * MiB;
constexpr size_t WS_Y = 185 * MiB;
constexpr size_t WS_WUP = WS_Y, WS_WDN = WS_Y + 8 * MiB;
constexpr size_t WS_MG = 217 * MiB;
constexpr size_t WS_MASK = WS_MG, WS_STATE = WS_MG + 8 * MiB;
constexpr size_t WS_END = 249 * MiB;
constexpr int STATE_STRIDE = 4224;
static_assert(WS_WOUT + (size_t)D * D * 2 <= WS_XG && WS_STATE + (size_t)512 * STATE_STRIDE * 4 <= WS_END && WS_END <= 256 * MiB, "d_ws map");

constexpr int LDS_BYTES = 155648;

__device__ __forceinline__ float bf2f(bf16_t v) { return __uint_as_float((unsigned)v << 16); }
__device__ __forceinline__ unsigned f2bf(float f) { unsigned u = __float_as_uint(f); return (u + 0x7fffu + ((u >> 16) & 1u)) >> 16; }
__device__ __forceinline__ unsigned pk2(float lo, float hi) { return f2bf(lo) | (f2bf(hi) << 16); }
typedef __bf16 bf16x2_t __attribute__((ext_vector_type(2)));
__device__ __forceinline__ unsigned cvt_pk_bf16(float lo, float hi) { const f32x2 v = {lo, hi}; return __builtin_bit_cast(unsigned, __builtin_convertvector(v, bf16x2_t)); }
__device__ __forceinline__ float lo_bf(unsigned w) { return __uint_as_float(w << 16); }
__device__ __forceinline__ float hi_bf(unsigned w) { return __uint_as_float(w & 0xffff0000u); }
__device__ __forceinline__ float wave_sum(float v) {
#pragma unroll
    for (int o = 1; o < 64; o <<= 1) v += __shfl_xor(v, o);
    return v;
}
__device__ __forceinline__ float wave_max(float v) {
#pragma unroll
    for (int o = 1; o < 64; o <<= 1) v = fmaxf(v, __shfl_xor(v, o));
    return v;
}
__device__ __forceinline__ int wave_sum_i(int v) {
#pragma unroll
    for (int o = 1; o < 64; o <<= 1) v += __shfl_xor(v, o);
    return v;
}
__device__ __forceinline__ float sigmoid_f(float x) { return __builtin_amdgcn_rcpf(1.f + __builtin_amdgcn_exp2f(-1.4426950408889634f * x)); }
__device__ __forceinline__ float gelu_tanh_f(float x) { const float u = 0.7978845608028654f * (x + 0.044715f * x * x * x); return x * __builtin_amdgcn_rcpf(1.f + __builtin_amdgcn_exp2f(-2.8853900817779268f * u)); }
__device__ __forceinline__ unsigned fkey(float s) { const unsigned u = __float_as_uint(s); return (u & 0x80000000u) ? ~u : (u | 0x80000000u); }

namespace pg8 {
constexpr int BM = 256, BK = 64, HALF = 128, HTB = HALF * BK * 2, STAGE_BYTES = 8 * HTB, NXCD = 8, WGM = 8;
__host__ __device__ __forceinline__ int lds_byte(int r, int c) { const int st = (r >> 4) * 2 + (c >> 5), rr = r & 15, cc = c & 31, ob = rr * 64 + cc * 2; return st * 1024 + (ob ^ (((ob >> 9) & 1) << 5)); }
__host__ __device__ __forceinline__ void stage_rc(int b, int& R, int& C) { const int st = b / 1024, sb = b % 1024, swz = sb ^ (((sb >> 9) & 1) << 5); R = (st >> 1) * 16 + swz / 64; C = (st & 1) * 32 + (swz % 64) / 2; }
__host__ __device__ __forceinline__ int perm32(int rho) { const int n = rho >> 4, i = rho & 15; return 8 * (i >> 2) + 4 * n + (i & 3); }

struct Unit { int pm, pn, z; };
template <int K_, int LDA_, int LDB_, unsigned APM_, unsigned AZ_, unsigned BPN_, unsigned BZ_> struct Gemm {
    const bf16_t* A; const bf16_t* Bt;
    static constexpr int K = K_, lda = LDA_, ldb = LDB_; static constexpr unsigned aPm = APM_, aZ = AZ_, bPn = BPN_, bZ = BZ_;
};
template <class G> __device__ __forceinline__ const char* pa(const G& g, const Unit& u) { return (const char*)g.A + (size_t)((unsigned)u.pm * G::aPm + (unsigned)u.z * G::aZ); }
template <class G> __device__ __forceinline__ const char* pb(const G& g, const Unit& u) { return (const char*)g.Bt + (size_t)((unsigned)u.pn * G::bPn + (unsigned)u.z * G::bZ); }

struct StaticOrder {
    int nM, nN, nwg, G, c;
    __host__ __device__ void init(int M_, int N_, int G_, int c_) { nM = M_ / BM; nN = N_ / BM; nwg = nM * nN; G = G_; c = c_; }
    __host__ __device__ bool next(int i, Unit& u) const {
        const long L = (long)i * G + c; if (L >= nwg) return false;
        int wgid = (int)L; { const int q = nwg / NXCD, r = nwg % NXCD, xcd = wgid % NXCD, off = wgid / NXCD; wgid = (xcd < r ? xcd * (q + 1) : r * (q + 1) + (xcd - r) * q) + off; }
        const int nig = WGM * nN, gid = wgid / nig, fm = gid * WGM, gsz = (nM - fm) < WGM ? (nM - fm) : WGM;
        u.pm = fm + ((wgid % nig) % gsz); u.pn = (wgid % nig) / gsz; u.z = 0; return true;
    }
};
template <int MODE> struct SuperOrder {
    StaticOrder so;
    __host__ __device__ void init(int G_, int c_) { so.init(M, 1024, G_, c_); }
    __host__ __device__ bool next(int i, Unit& u) const {
        Unit b; if (!so.next(i >> 2, b)) return false;
        const int sub = i & 3; u.pm = b.pm; if (MODE == 0) { u.pn = b.pn; u.z = sub; } else { u.pn = 4 * b.pn + sub; u.z = 0; } return true;
    }
};

template <class Epi, class Sched, bool ALIGN_EPI, class GemmT>
__device__ __forceinline__ void gemm_phase(LAS unsigned char* lds, const GemmT g, const Sched& S, const Epi& E, const int tid) {
    const int wid = __builtin_amdgcn_readfirstlane(tid >> 6), lane = tid & 63, wr = wid >> 2, wc = wid & 3, fr = lane & 15, fq = lane >> 4;
    constexpr int K = GemmT::K, nt = K / BK;
    unsigned voffA[2], voffB[2];
#pragma unroll
    for (int i = 0; i < 2; ++i) { int R, C; stage_rc(tid * 16 + i * 8192, R, C); const int Rb = Epi::PERM ? ((R & ~31) + perm32(R & 31)) : R;
        voffA[i] = (unsigned)(R * GemmT::lda + C) * 2u; voffB[i] = (unsigned)(Rb * GemmT::ldb + C) * 2u; }
    const size_t kstep = (size_t)(BK * 2);
    constexpr size_t hA = (size_t)HALF * GemmT::lda * 2, hB = (size_t)HALF * GemmT::ldb * 2;
    const unsigned ldsw = (unsigned)wid * 1024u;
    const int aoff = lds_byte(wr * 64 + fr, fq * 8), boff = lds_byte(wc * 32 + fr, fq * 8);
#define PG8_SA(b, h) (((b) * 2 + (h)) * HTB)
#define PG8_SB(b, h) ((4 + (b) * 2 + (h)) * HTB)
#define PG8_STAGE(bufoff, gbase, voff) do { _Pragma("unroll") for (int _i = 0; _i < 2; ++_i) \
        __builtin_amdgcn_global_load_lds((const unsigned*)((const char*)(gbase) + (voff)[_i]), (LAS unsigned*)(lds + (bufoff) + ldsw + _i * 8192), 16, 0, 0); } while (0)
#define PG8_LDA(dst, b, h) do { _Pragma("unroll") for (int m = 0; m < 4; ++m) _Pragma("unroll") for (int k = 0; k < 2; ++k) dst[m][k] = *(const LAS bf16x8*)(lds + PG8_SA(b, h) + aoff + m * 2048 + k * 1024); } while (0)
#define PG8_LDB(dst, b, h) do { _Pragma("unroll") for (int n = 0; n < 2; ++n) _Pragma("unroll") for (int k = 0; k < 2; ++k) dst[n][k] = *(const LAS bf16x8*)(lds + PG8_SB(b, h) + boff + n * 2048 + k * 1024); } while (0)
#define PG8_MMA(ai, bj, At, Bt) do { __builtin_amdgcn_s_setprio(1); _Pragma("unroll") for (int m = 0; m < 4; ++m) _Pragma("unroll") for (int n = 0; n < 2; ++n) _Pragma("unroll") for (int k = 0; k < 2; ++k) \
        acc[ai][bj][m][n] = __builtin_amdgcn_mfma_f32_16x16x32_bf16(Bt[n][k], At[m][k], acc[ai][bj][m][n], 0, 0, 0); __builtin_amdgcn_s_setprio(0); } while (0)
#define PG8_WAIT_V(n) asm volatile("s_waitcnt vmcnt(" #n ")" ::: "memory")
#define PG8_WAIT_L(n) asm volatile("s_waitcnt lgkmcnt(" #n ")" ::: "memory")
#define PG8_BAR __builtin_amdgcn_s_barrier()
#define PG8_SCHED __builtin_amdgcn_sched_barrier(0)
    Unit cur, nxt; int ui = 0;
    if (!S.next(0, cur)) return;
    f32x4 acc[2][2][4][2];
#pragma unroll
    for (int a = 0; a < 2; ++a)
#pragma unroll
        for (int b = 0; b < 2; ++b)
#pragma unroll
            for (int m = 0; m < 4; ++m)
#pragma unroll
                for (int n = 0; n < 2; ++n) acc[a][b][m][n] = (f32x4){0.f, 0.f, 0.f, 0.f};
    bf16x8 At[4][2], B0[2][2], B1[2][2];
    const char* cA = pa(g, cur); const char* cB = pb(g, cur);
    PG8_STAGE(PG8_SB(0, 0), cB, voffB); PG8_STAGE(PG8_SB(0, 1), cB + hB, voffB); PG8_STAGE(PG8_SA(0, 0), cA, voffA); PG8_STAGE(PG8_SA(0, 1), cA + hA, voffA);
    if (wr == 1) PG8_BAR;
    PG8_WAIT_V(2); PG8_BAR;
    PG8_STAGE(PG8_SB(1, 0), cB + kstep, voffB); PG8_STAGE(PG8_SA(1, 0), cA + kstep, voffA); PG8_STAGE(PG8_SB(1, 1), cB + hB + kstep, voffB);
    PG8_WAIT_V(6); PG8_BAR;
    for (;;) {
        const bool has_next = S.next(ui + 1, nxt);
        const char* nA = has_next ? pa(g, nxt) : cA; const char* nB = has_next ? pb(g, nxt) : cB;
#pragma unroll 1
        for (int t = 0; t < nt; t += 2) {
            const bool last = (t == nt - 2);
            const char* a1 = cA + (size_t)(t + 1) * kstep;
            const char* a2 = last ? nA : cA + (size_t)(t + 2) * kstep; const char* b2 = last ? nB : cB + (size_t)(t + 2) * kstep;
            const char* a3 = a2 + kstep; const char* b3 = b2 + kstep;
            PG8_LDB(B0, 0, 0); PG8_LDB(B1, 0, 1); PG8_SCHED; PG8_LDA(At, 0, 0); PG8_STAGE(PG8_SA(1, 1), a1 + hA, voffA);
            PG8_WAIT_V(8); PG8_WAIT_L(0); PG8_BAR; PG8_MMA(0, 0, At, B0); PG8_MMA(0, 1, At, B1); PG8_BAR; PG8_SCHED;
            PG8_LDA(At, 0, 1); PG8_STAGE(PG8_SB(0, 0), b2, voffB); PG8_STAGE(PG8_SB(0, 1), b2 + hB, voffB); PG8_STAGE(PG8_SA(0, 0), a2, voffA);
            PG8_WAIT_V(8); PG8_WAIT_L(0); PG8_BAR; PG8_MMA(1, 0, At, B0); PG8_MMA(1, 1, At, B1); PG8_BAR; PG8_SCHED;
            PG8_LDB(B0, 1, 0); PG8_LDB(B1, 1, 1); PG8_SCHED; PG8_LDA(At, 1, 0); PG8_STAGE(PG8_SA(0, 1), a2 + hA, voffA);
            PG8_WAIT_V(8); PG8_WAIT_L(0); PG8_BAR; PG8_MMA(0, 0, At, B0); PG8_MMA(0, 1, At, B1); PG8_BAR; PG8_SCHED;
            PG8_LDA(At, 1, 1); PG8_STAGE(PG8_SB(1, 0), b3, voffB); PG8_STAGE(PG8_SB(1, 1), b3 + hB, voffB); PG8_STAGE(PG8_SA(1, 0), a3, voffA);
            PG8_WAIT_V(8); PG8_WAIT_L(0); PG8_BAR; PG8_MMA(1, 0, At, B0); PG8_MMA(1, 1, At, B1); PG8_BAR; PG8_SCHED;
        }
        if constexpr (ALIGN_EPI) { if (wr == 0) PG8_BAR; }
        { int fr2 = fr, fq2 = fq; asm volatile("" : "+v"(fr2), "+v"(fq2)); E(acc, cur, wr, wc, fr2, fq2); }
        if (!has_next) break;
#pragma unroll
        for (int a = 0; a < 2; ++a)
#pragma unroll
            for (int b = 0; b < 2; ++b)
#pragma unroll
                for (int m = 0; m < 4; ++m)
#pragma unroll
                    for (int n = 0; n < 2; ++n) acc[a][b][m][n] = (f32x4){0.f, 0.f, 0.f, 0.f};
        cur = nxt; cA = nA; cB = nB; ++ui;
        if constexpr (ALIGN_EPI) { if (wr == 1) PG8_BAR; }
    }
    PG8_WAIT_V(0);
    if constexpr (!ALIGN_EPI) { if (wr == 0) PG8_BAR; }
    PG8_BAR;
#undef PG8_SA
#undef PG8_SB
#undef PG8_STAGE
#undef PG8_LDA
#undef PG8_LDB
#undef PG8_MMA
#undef PG8_WAIT_V
#undef PG8_WAIT_L
#undef PG8_BAR
#undef PG8_SCHED
}
}
namespace epi {
using pg8::Unit;
typedef f32x4 Acc[2][2][4][2];

__device__ __forceinline__ float row_scale(const float* rs, int row) { return rs[row]; }
__device__ __forceinline__ u32x4 pack8(const f32x4 a, const f32x4 b) { u32x4 w; w.x = cvt_pk_bf16(a[0], a[1]); w.y = cvt_pk_bf16(a[2], a[3]); w.z = cvt_pk_bf16(b[0], b[1]); w.w = cvt_pk_bf16(b[2], b[3]); return w; }

struct EpiProj {
    static constexpr bool PERM = true;
    bf16_t* P; float* misc; const float* ssq; const float* cs; const float* sn; const float* gt;     bf16_t* VT;     bf16_t* KI;     bf16_t* CVT;     float* ssqv;
    __device__ __forceinline__ void operator()(const Acc& acc, const Unit& u, int wr, int wc, int fr, int fq) const {
        const int T = u.pn; const int row0 = u.pm * 256 + wr * 64 + fr;
        if (T == 2 || T == 3 || T == 5 || T == 6 || T == 14) {
            if (T == 14 && wc >= 2) return;
            if (T == 14 && wc == 1) {
                if (fq < 2) {
#pragma unroll
                    for (int ai = 0; ai < 2; ++ai)
#pragma unroll
                        for (int m = 0; m < 4; ++m) { const int row = row0 + ai * 128 + m * 16; const float rs = row_scale(ssq, row);
                            float* mp = misc + (size_t)row * 16 + 8 * fq; *(f32x4*)mp = acc[ai][0][m][0] * rs; *(f32x4*)(mp + 4) = acc[ai][0][m][1] * rs; }
                }
                return;
            }
            const int mode = (T == 14) ? 2 : (T <= 3 ? 1 : 0);
            const float* gp = gt + 64 * ((T == 2) ? 0 : (T == 3) ? 1 : 2);
            f32x4 g1[2], g2[2];
#pragma unroll
            for (int n = 0; n < 2; ++n) { if (mode) { g1[n] = *(const f32x4*)(gp + 8 * fq + 4 * n); g2[n] = *(const f32x4*)(gp + 32 + 8 * fq + 4 * n); } else { g1[n] = (f32x4){1.f, 1.f, 1.f, 1.f}; g2[n] = g1[n]; } }
#pragma unroll
            for (int ai = 0; ai < 2; ++ai)
#pragma unroll
                for (int m = 0; m < 4; ++m) {
                    const int row = row0 + ai * 128 + m * 16; const float rs = row_scale(ssq, row); const int pos = row & (S - 1);
                    f32x4 x1[2], x2[2];
#pragma unroll
                    for (int n = 0; n < 2; ++n) { x1[n] = acc[ai][0][m][n] * rs; x2[n] = acc[ai][1][m][n] * rs; }
                    if (mode == 2) {
                        float s = 0.f;
#pragma unroll
                        for (int n = 0; n < 2; ++n) s += (x1[n][0] + x1[n][1]) + (x1[n][2] + x1[n][3]) + (x2[n][0] + x2[n][1]) + (x2[n][2] + x2[n][3]);
                        s += __shfl_xor(s, 16); s += __shfl_xor(s, 32); const float mu = s * (1.f / 64.f);
#pragma unroll
                        for (int n = 0; n < 2; ++n) { x1[n] = x1[n] - mu; x2[n] = x2[n] - mu; }
                    }
                    if (mode) {
                        float q = 0.f;
#pragma unroll
                        for (int n = 0; n < 2; ++n) { const f32x4 a = x1[n] * x1[n], b = x2[n] * x2[n]; q += (a[0] + a[1]) + (a[2] + a[3]) + (b[0] + b[1]) + (b[2] + b[3]); }
                        q += __shfl_xor(q, 16); q += __shfl_xor(q, 32); const float rr = rsqrtf(q * (1.f / 64.f) + EPS);
#pragma unroll
                        for (int n = 0; n < 2; ++n) { x1[n] = x1[n] * rr * g1[n]; x2[n] = x2[n] * rr * g2[n]; }
                        if (T == 2) {
#pragma unroll
                            for (int n = 0; n < 2; ++n) { x1[n] = x1[n] * (0.125f * 1.4426950408889634f); x2[n] = x2[n] * (0.125f * 1.4426950408889634f); } }
                    }
                    f32x4 o1[2], o2[2];
#pragma unroll
                    for (int n = 0; n < 2; ++n) { const f32x4 c = *(const f32x4*)(cs + (size_t)pos * 32 + 8 * fq + 4 * n), s = *(const f32x4*)(sn + (size_t)pos * 32 + 8 * fq + 4 * n);
                        o1[n] = x1[n] * c - x2[n] * s; o2[n] = x2[n] * c + x1[n] * s; }
                    bf16_t* op = P + (size_t)row * PW + 256 * T + 64 * wc + 8 * fq;
                    *(u32x4*)op = pack8(o1[0], o1[1]); *(u32x4*)(op + 32) = pack8(o2[0], o2[1]);
                    if (T == 14) {
                        bf16_t* kp = KI + ((size_t)((row >> 5) * 4 + (fq >> 1)) * 64 + (fq & 1) * 32 + (row & 31)) * 8; *(u32x4*)kp = pack8(o1[0], o1[1]); *(u32x4*)(kp + 2 * 64 * 8) = pack8(o2[0], o2[1]); }
                }
            return;
        }
        const int act = (T <= 1) ? 1 : 0; const float sc = (T == 8) ? 0.125f : 1.0f;
#pragma unroll
        for (int ai = 0; ai < 2; ++ai)
#pragma unroll
            for (int m = 0; m < 4; ++m) {
                const int row = row0 + ai * 128 + m * 16; const float rs = row_scale(ssq, row) * sc;
                bf16_t* op = P + (size_t)row * PW + 256 * T + 32 * wc + 8 * fq; float qv = 0.f;
#pragma unroll
                for (int bj = 0; bj < 2; ++bj) { f32x4 v0 = acc[ai][bj][m][0] * rs, v1 = acc[ai][bj][m][1] * rs;
                    if (act) {
#pragma unroll
                        for (int e = 0; e < 4; ++e) { v0[e] = gelu_tanh_f(v0[e]); v1[e] = gelu_tanh_f(v1[e]); }
                        const f32x4 a2 = v0 * v0, b2 = v1 * v1; qv += ((a2[0] + a2[1]) + (a2[2] + a2[3])) + ((b2[0] + b2[1]) + (b2[2] + b2[3])); }
                    *(u32x4*)(op + bj * 128) = pack8(v0, v1);
                    if (T == 4 || T == 9) { bf16_t* vp = (T == 4 ? VT : CVT) + ((size_t)((row >> 12) * 256 + bj * 128 + 32 * wc + 8 * fq)) * S + (row & (S - 1));
#pragma unroll
                        for (int e = 0; e < 4; ++e) { vp[(size_t)e * S] = (bf16_t)f2bf(v0[e]); vp[(size_t)(4 + e) * S] = (bf16_t)f2bf(v1[e]); } } }
                if (T == 1) { qv += __shfl_xor(qv, 16); qv += __shfl_xor(qv, 32); if (fq == 0) ssqv[(size_t)row * 4 + wc] = qv; }
            }
    }
};

struct EpiPlain {
    static constexpr bool PERM = true;
    bf16_t* O; int ldc; int zcols;
    __device__ __forceinline__ void operator()(const Acc& acc, const Unit& u, int wr, int wc, int fr, int fq) const {
        const int row0 = u.pm * 256 + wr * 64 + fr; const int col0 = u.z * zcols + u.pn * 256 + 32 * wc + 8 * fq;
#pragma unroll
        for (int ai = 0; ai < 2; ++ai)
#pragma unroll
            for (int m = 0; m < 4; ++m) { bf16_t* op = O + (size_t)(row0 + ai * 128 + m * 16) * ldc + col0;
#pragma unroll
                for (int bj = 0; bj < 2; ++bj) *(u32x4*)(op + bj * 128) = pack8(acc[ai][bj][m][0], acc[ai][bj][m][1]); }
    }
};

struct EpiGate {
    static constexpr bool PERM = true;
    bf16_t* MG; const bf16_t* BR; const float* ssq;
    __device__ __forceinline__ void operator()(const Acc& acc, const Unit& u, int wr, int wc, int fr, int fq) const {
        const int row0 = u.pm * 256 + wr * 64 + fr; const int ch0 = u.pn * 64 + 16 * wc + 4 * fq;
        float rsv[8];
#pragma unroll
        for (int i = 0; i < 8; ++i) rsv[i] = ssq[row0 + (i >> 2) * 128 + (i & 3) * 16];
#pragma unroll
        for (int ai = 0; ai < 2; ++ai) {
            u32x2 bw[4][4];
#pragma unroll
            for (int m = 0; m < 4; ++m)
#pragma unroll
                for (int nb = 0; nb < 4; ++nb) bw[m][nb] = *(const u32x2*)(BR + (size_t)(row0 + ai * 128 + m * 16) * 4096 + ch0 + nb * 1024);
#pragma unroll
            for (int m = 0; m < 4; ++m) {
                const int row = row0 + ai * 128 + m * 16; const float rs = rsv[ai * 4 + m]; f32x4 o = (f32x4){0.f, 0.f, 0.f, 0.f};
#pragma unroll
                for (int bj = 0; bj < 2; ++bj)
#pragma unroll
                    for (int n = 0; n < 2; ++n) { const u32x2 w = bw[m][2 * bj + n]; const f32x4 a = acc[ai][bj][m][n] * rs;
                        o[0] += sigmoid_f(a[0]) * lo_bf(w.x); o[1] += sigmoid_f(a[1]) * hi_bf(w.x); o[2] += sigmoid_f(a[2]) * lo_bf(w.y); o[3] += sigmoid_f(a[3]) * hi_bf(w.y); }
                u32x2 ow; ow.x = cvt_pk_bf16(o[0], o[1]); ow.y = cvt_pk_bf16(o[2], o[3]);
                *(u32x2*)(MG + (size_t)row * 1024 + ch0) = ow;
            }
        }
    }
};

struct EpiResid {
    static constexpr bool PERM = true;
    const float* resf; bf16_t* X; float* outf; float* ssq;
    __device__ __forceinline__ void operator()(const Acc& acc, const Unit& u, int wr, int wc, int fr, int fq) const {
        const int row0 = u.pm * 256 + wr * 64 + fr; const int col0 = u.pn * 256 + 32 * wc + 8 * fq;
#pragma unroll
        for (int ai = 0; ai < 2; ++ai) {
            f32x4 r[4][2][2];
            if (resf) {
#pragma unroll
                for (int m = 0; m < 4; ++m)
#pragma unroll
                    for (int bj = 0; bj < 2; ++bj) { const float* rp = resf + (size_t)(row0 + ai * 128 + m * 16) * 1024 + col0 + bj * 128; r[m][bj][0] = *(const f32x4*)rp; r[m][bj][1] = *(const f32x4*)(rp + 4); }
            } else {
                u32x4 w[4][2];
#pragma unroll
                for (int m = 0; m < 4; ++m)
#pragma unroll
                    for (int bj = 0; bj < 2; ++bj) w[m][bj] = *(const u32x4*)(X + (size_t)(row0 + ai * 128 + m * 16) * 1024 + col0 + bj * 128);
#pragma unroll
                for (int m = 0; m < 4; ++m)
#pragma unroll
                    for (int bj = 0; bj < 2; ++bj) { const u32x4 q = w[m][bj]; r[m][bj][0] = (f32x4){lo_bf(q.x), hi_bf(q.x), lo_bf(q.y), hi_bf(q.y)}; r[m][bj][1] = (f32x4){lo_bf(q.z), hi_bf(q.z), lo_bf(q.w), hi_bf(q.w)}; }
            }
#pragma unroll
            for (int m = 0; m < 4; ++m) {
                const int row = row0 + ai * 128 + m * 16; const size_t off = (size_t)row * 1024 + col0; float q = 0.f;
#pragma unroll
                for (int bj = 0; bj < 2; ++bj) {
                    const f32x4 x0 = r[m][bj][0] + acc[ai][bj][m][0], x1 = r[m][bj][1] + acc[ai][bj][m][1];
                    if (outf) { *(f32x4*)(outf + off + bj * 128) = x0; *(f32x4*)(outf + off + bj * 128 + 4) = x1; }
                    else {
                        const f32x4 a = x0 * x0, b = x1 * x1; q += ((a[0] + a[1]) + (a[2] + a[3])) + ((b[0] + b[1]) + (b[2] + b[3]));
                        *(u32x4*)(X + off + bj * 128) = pack8(x0, x1); }
                }
                if (!outf) { q += __shfl_xor(q, 16); q += __shfl_xor(q, 32); if (fq == 0) ssq[(size_t)row * 16 + 4 * u.pn + wc] = q; }
            }
        }
    }
};

struct EpiUp {
    static constexpr bool PERM = true;
    bf16_t* H; const float* ssq;
    __device__ __forceinline__ void operator()(const Acc& acc, const Unit& u, int wr, int wc, int fr, int fq) const {
        const int row0 = u.pm * 256 + wr * 64 + fr; const int col0 = u.pn * 256 + 32 * wc + 8 * fq;
        float rsv[8];
#pragma unroll
        for (int i = 0; i < 8; ++i) rsv[i] = ssq[row0 + (i >> 2) * 128 + (i & 3) * 16];
#pragma unroll
        for (int ai = 0; ai < 2; ++ai)
#pragma unroll
            for (int m = 0; m < 4; ++m) { const int row = row0 + ai * 128 + m * 16; const float rs = rsv[ai * 4 + m]; bf16_t* op = H + (size_t)row * FF + col0;
#pragma unroll
                for (int bj = 0; bj < 2; ++bj) { f32x4 v0 = acc[ai][bj][m][0] * rs, v1 = acc[ai][bj][m][1] * rs;
#pragma unroll
                    for (int e = 0; e < 4; ++e) { v0[e] = fmaxf(v0[e], 0.f); v1[e] = fmaxf(v1[e], 0.f); }
                    *(u32x4*)(op + bj * 128) = pack8(v0 * v0, v1 * v1); } }
    }
};
}
struct Args {
    const float* in[18]; float* out; unsigned char* ws; int ph_lo, ph_hi; int coop, pad;
};
struct Frame { LAS unsigned char* lds; int tid, lane, wave, G, vcu; };
constexpr int PTR_OFF = LDS_BYTES - 512;
enum { I_X = 0, I_LN_MIX, I_W_IN, I_SGU_NORM, I_SGU_W, I_SGU_B, I_Q_NORM, I_K_NORM, I_KIDX_NORM, I_I_BIAS, I_F_BIAS, I_MNORM, I_CONV_W, I_W_BRANCH, I_W_OUT, I_LN_MLP, I_W_UP, I_W_DOWN, I_OUT, I_WS };
__device__ __forceinline__ unsigned char* ptr_at(const Frame& F, int i) { const LAS unsigned* p = (const LAS unsigned*)(F.lds + PTR_OFF) + 2 * i;
    const unsigned lo = __builtin_amdgcn_readfirstlane(p[0]), hi = __builtin_amdgcn_readfirstlane(p[1]);
    typedef __attribute__((address_space(1))) unsigned char* gptr_t;
    return (unsigned char*)(gptr_t)(((unsigned long long)hi << 32) | lo); }
#define INP(i) ((const float*)ptr_at(F, (i)))
#define WSP(off) (ptr_at(F, I_WS) + (off))
constexpr size_t WS_GT = 512 * 1024;
constexpr size_t WS_RSA = 256 * 1024, WS_RSB = 320 * 1024;
__device__ __forceinline__ size_t maskt_idx(int m, int w) { const int b = m >> 12, t = m & (S - 1); return ((size_t)(b * 64 + (w >> 1)) * S + t) * 2 + (w & 1); }


#define XB_TMO      128
#define XB_XCNT(j)  (256  + 64 * (j))
#define XB_XSUB(j)  (1280 + 64 * (j))
#define XB_XGEN(j)  (2304 + 64 * (j))
#define XB_TOP      3328
#define XB_TOPGEN   3392
#define XCD_BAR_WORDS 3456
#define XB_SPIN_CAP (1u << 22)
constexpr size_t WS_BAR = 64 * 1024;
constexpr size_t CTL_ZERO_BYTES = 128 * 1024;
__device__ __forceinline__ unsigned xb_ld(unsigned* p)              { return __hip_atomic_load(p, __ATOMIC_RELAXED, __HIP_MEMORY_SCOPE_AGENT); }
__device__ __forceinline__ unsigned xb_add(unsigned* p, unsigned v) { return __hip_atomic_fetch_add(p, v, __ATOMIC_RELAXED, __HIP_MEMORY_SCOPE_AGENT); }
__device__ __forceinline__ unsigned xb_xcc_id() { return (unsigned)__builtin_amdgcn_s_getreg((3 << 11) | 20) & 0xFu; }
#define XB_SPIN(cond, bar) do { unsigned _sp = 0; while (cond) { __builtin_amdgcn_s_sleep(1); \
    if ((++_sp & 255u) == 0u) { if (xb_ld(&(bar)[XB_TMO])) break; if (_sp > XB_SPIN_CAP) { atomicAdd(&(bar)[XB_TMO], 1u); break; } } } } while (0)
struct XcdBarrier { unsigned* bar; unsigned x; volatile LAS unsigned* st; };
__device__ __forceinline__ XcdBarrier xcd_barrier_post(unsigned* bar, volatile LAS unsigned* st) {
    XcdBarrier b; b.bar = bar; b.x = xb_xcc_id(); b.st = st;
    if (threadIdx.x == 0) (void)xb_add(&bar[XB_XCNT(b.x)], 1u);
    return b;
}
__device__ __forceinline__ void xcd_barrier_complete(unsigned* bar, unsigned x, unsigned& nloc, unsigned& nx) {
    const unsigned G = gridDim.x * gridDim.y * gridDim.z;
    unsigned sum, cnt, mine, sp = 0u;
    for (;;) {
        sum = 0u; cnt = 0u; mine = 0u;
#pragma unroll
        for (unsigned j = 0; j < 16; ++j) { const unsigned c = xb_ld(&bar[XB_XCNT(j)]); sum += c; cnt += (c > 0u) ? 1u : 0u; mine = (j == x) ? c : mine; }
        if (sum == G) break;
        __builtin_amdgcn_s_sleep(1);
        if ((++sp & 255u) == 0u) { if (xb_ld(&bar[XB_TMO])) break; if (sp > XB_SPIN_CAP) { atomicAdd(&bar[XB_TMO], 1u); break; } }
    }
    nloc = mine > 0u ? mine : 1u; nx = cnt > 0u ? cnt : 1u;
}
__device__ __forceinline__ void xcd_barrier(const XcdBarrier& b) {
    asm volatile("s_waitcnt vmcnt(0)" ::: "memory");
    __syncthreads();
    if (threadIdx.x == 0) {
        unsigned* bar = b.bar;
        __builtin_amdgcn_s_waitcnt(0);
        unsigned nloc = b.st[0], nx = b.st[1];
        if (nloc == 0u) { xcd_barrier_complete(bar, b.x, nloc, nx); b.st[0] = nloc; b.st[1] = nx; }
        const unsigned old = xb_add(&bar[XB_XSUB(b.x)], 1u);
        const unsigned gen = old / nloc;
        if (old + 1u == (gen + 1u) * nloc) {
            __builtin_amdgcn_fence(__ATOMIC_RELEASE, "agent");
            asm volatile("s_waitcnt vmcnt(0)" ::: "memory");
            const unsigned og = xb_add(&bar[XB_TOP], 1u);
            const unsigned tg = og / nx;
            if (og + 1u == (tg + 1u) * nx) xb_add(&bar[XB_TOPGEN], 1u);
            else XB_SPIN(xb_ld(&bar[XB_TOPGEN]) == tg, bar);
            __builtin_amdgcn_fence(__ATOMIC_ACQUIRE, "agent");
            xb_add(&bar[XB_XGEN(b.x)], 1u);
            asm volatile("s_waitcnt vmcnt(0)" ::: "memory");
        } else {
            XB_SPIN(xb_ld(&bar[XB_XGEN(b.x)]) == gen, bar);
            __builtin_amdgcn_fence(__ATOMIC_ACQUIRE, "agent");
            asm volatile("s_waitcnt vmcnt(0)" ::: "memory");
        }
    }
    __syncthreads();
}

__device__ __forceinline__ int win_src(int p) {
    const int T = p >> 8, q = p & 255, bj = q >> 7, wc = (q >> 5) & 3, j = q & 31, hd = 64 * wc + 32 * bj + j;
    switch (T) {
        case 0: return O_AU + q; case 1: return O_AV + q; case 2: return O_BQ + hd; case 3: return O_BK + hd; case 4: return O_BV + q;
        case 5: return O_QI + hd; case 6: return O_QI + 256 + hd; case 7: return O_CQ + q; case 8: return O_CK + q; case 9: return O_CV + q;
        case 10: return O_CO + q; case 11: return O_DB + q; case 12: return O_DC + q; case 13: return O_DX + q;
        default: break;
    }
    if (wc == 0) return O_KI + 32 * bj + j;
    if (wc == 1 && bj == 0 && j < 16) return j < 8 ? O_WI + j : (j < 12 ? O_CI + (j - 8) : O_CF + (j - 12));
    return -1;
}
__device__ __forceinline__ int wg_src(int p) {
    const int pn = p >> 8, q = p & 255, bj = q >> 7, wc = (q >> 5) & 3, fq = (q >> 3) & 3, n = (q >> 2) & 1, e = q & 3;
    return O_G + (2 * bj + n) * 1024 + 64 * pn + 16 * wc + 4 * fq + e;
}
template <int MAP>
__device__ __forceinline__ void conv_item(const float* W, int K, int srcN, bf16_t* WT, LAS float* scr, int item, int nrows, int lane, const float* gain = nullptr) {
    const int nblk = nrows / 32, kb = item / nblk, nb = item % nblk, k0 = 64 * kb, n0 = 32 * nb;
    const int nn = n0 + (lane & 31); const int src = MAP == 0 ? nn : (MAP == 1 ? win_src(nn) : wg_src(nn));
    float wv_[32]; const float* wp_ = W + (size_t)(k0 + (lane >> 5)) * srcN + (src >= 0 ? src : 0);
#pragma unroll
    for (int i = 0; i < 32; ++i) wv_[i] = __builtin_nontemporal_load(wp_ + (size_t)(2 * i) * srcN);
#pragma unroll
    for (int i = 0; i < 32; ++i) scr[(2 * i + (lane >> 5)) * 33 + (lane & 31)] = src >= 0 ? (gain ? wv_[i] * gain[k0 + 2 * i + (lane >> 5)] : wv_[i]) : 0.f;
    asm volatile("s_waitcnt lgkmcnt(0)" ::: "memory");
    const int c = lane & 7;
#pragma unroll
    for (int j = 0; j < 4; ++j) { const int n = (lane >> 3) + 8 * j; const LAS float* s = scr + (8 * c) * 33 + n;
        u32x4 o; o.x = pk2(s[0 * 33], s[1 * 33]); o.y = pk2(s[2 * 33], s[3 * 33]); o.z = pk2(s[4 * 33], s[5 * 33]); o.w = pk2(s[6 * 33], s[7 * 33]);
        *(u32x4*)(WT + (size_t)(n0 + n) * K + k0 + 8 * c) = o; }
    asm volatile("s_waitcnt lgkmcnt(0)" ::: "memory");
}
__device__ __forceinline__ void convert_mix_weights(Frame& F, int l) {

    LAS float* scr = (LAS float*)(F.lds + F.wave * 16384);
    const int gw = F.vcu * NWAVES + F.wave, NGW = F.G * NWAVES;
    constexpr int I_WIN = (D / 64) * (PW / 32), I_WG = (D / 64) * (4096 / 32), I_BR = (256 / 64) * (1024 / 32), I_OUT = (D / 64) * (D / 32);
    constexpr int NIT = I_WIN + I_WG + 4 * I_BR + I_OUT;
    const float* win = INP(I_W_IN) + (size_t)l * D * INW; const float* gmix = INP(I_LN_MIX) + l * D;
    for (int it = gw; it < NIT; it += NGW) {
        int r = it;
        if (r < I_WIN) { conv_item<1>(win, D, INW, ((bf16_t*)WSP(WS_WIN)), scr, r, PW, F.lane, gmix); continue; } r -= I_WIN;
        if (r < I_WG) { conv_item<2>(win, D, INW, ((bf16_t*)WSP(WS_WG)), scr, r, 4096, F.lane, gmix); continue; } r -= I_WG;
        if (r < 4 * I_BR) { const int nb = r / I_BR; conv_item<0>(INP(I_W_BRANCH) + ((size_t)l * 4 + nb) * 256 * D, 256, D, ((bf16_t*)WSP(WS_WBR)) + (size_t)nb * 1024 * 256, scr, r % I_BR, 1024, F.lane); continue; } r -= 4 * I_BR;
        conv_item<0>(INP(I_W_OUT) + (size_t)l * D * D, D, D, ((bf16_t*)WSP(WS_WOUT)), scr, r, D, F.lane);
    }
}
__device__ __forceinline__ void convert_mlp_weights(Frame& F, int l) {

    LAS float* scr = (LAS float*)(F.lds + F.wave * 16384);
    const int gw = F.vcu * NWAVES + F.wave, NGW = F.G * NWAVES;
    constexpr int I_UP = (D / 64) * (FF / 32), I_DN = (FF / 64) * (D / 32);
    for (int it = gw; it < I_UP + I_DN; it += NGW) {
        if (it < I_UP) conv_item<0>(INP(I_W_UP) + (size_t)l * D * FF, D, FF, ((bf16_t*)WSP(WS_WUP)), scr, it, FF, F.lane, INP(I_LN_MLP) + l * D);
        else conv_item<0>(INP(I_W_DOWN) + (size_t)l * FF * D, FF, D, ((bf16_t*)WSP(WS_WDN)), scr, it - I_UP, D, F.lane);
    }
}
__device__ __forceinline__ void prologue_rows(Frame& F) {
    float* COS = (float*)WSP(WS_COS); float* SIN = (float*)WSP(WS_SIN); float* SSQA = (float*)WSP(WS_SSQA); bf16_t* XG = (bf16_t*)WSP(WS_XG); const float* x = INP(I_X); const float* ln_mix = INP(I_LN_MIX);
    const int gt = F.vcu * NT + F.tid, NGT = F.G * NT;
    for (int i = gt; i < S * 32; i += NGT) { const int pos = i >> 5, k = i & 31; const float inv = powf(10000.f, -(float)k * 2.0f / 64.f); const float ang = (float)pos * inv; COS[i] = cosf(ang); SIN[i] = sinf(ang); }
    const int gw = F.vcu * NWAVES + F.wave, NGW = F.G * NWAVES;
    float* rsa = (float*)WSP(WS_RSA);
    for (int m0 = gw * 4; m0 < M; m0 += NGW * 4) {
        f32x4 v[4][4];
#pragma unroll
        for (int r = 0; r < 4; ++r)
#pragma unroll
            for (int j = 0; j < 4; ++j) v[r][j] = __builtin_nontemporal_load((const f32x4*)(x + (size_t)(m0 + r) * D) + F.lane + 64 * j);
#pragma unroll
        for (int r = 0; r < 4; ++r) { float s = 0.f; unsigned long long* o8 = (unsigned long long*)(XG + (size_t)(m0 + r) * D) + F.lane;
#pragma unroll
            for (int j = 0; j < 4; ++j) { const f32x4 w = v[r][j]; s += (w[0] * w[0] + w[1] * w[1]) + (w[2] * w[2] + w[3] * w[3]);
                o8[64 * j] = (unsigned long long)pk2(w[0], w[1]) | ((unsigned long long)pk2(w[2], w[3]) << 32); }
            s = wave_sum(s);
            if (F.lane == 0) rsa[m0 + r] = rsqrtf(s * (1.f / 1024.f) + EPS); }
    }
}
__device__ __forceinline__ void finalize_rs(Frame& F, size_t ssq_off, size_t rs_off) {
    const float* ssq = (const float*)WSP(ssq_off); float* rs = (float*)WSP(rs_off);
    for (int row = F.vcu * NT + F.tid; row < M; row += F.G * NT) { const f32x4* sp = (const f32x4*)(ssq + (size_t)row * 16); const f32x4 a = sp[0], b = sp[1], c = sp[2], d = sp[3];
        const float t = ((a[0] + a[1]) + (a[2] + a[3])) + ((b[0] + b[1]) + (b[2] + b[3])) + ((c[0] + c[1]) + (c[2] + c[3])) + ((d[0] + d[1]) + (d[2] + d[3]));
        rs[row] = rsqrtf(t * (1.0f / 1024.0f) + EPS); }
}

__device__ __forceinline__ void sgu_simple(Frame& F, int l) {
    bf16_t* PROJ = (bf16_t*)WSP(WS_BIG); bf16_t* Y = (bf16_t*)WSP(WS_Y); const float* sgu_norm = INP(I_SGU_NORM); const float* sgu_w = INP(I_SGU_W); const float* sgu_b = INP(I_SGU_B);
    LAS float* r_s = (LAS float*)F.lds; LAS float* vn = r_s + 128;
    const float* gain = sgu_norm + l * 256; const float* sw = sgu_w + (size_t)l * 4 * 128 * 128; const float* sb = sgu_b + l * 4 * 128;
    for (int item = F.vcu; item < 512; item += F.G) {
        const int g = item & 3, m0 = (item >> 2) * 128;
        for (int i = 0; i < 16; ++i) { const int tok = F.wave * 16 + i; const u32x2 w = *(const u32x2*)(PROJ + (size_t)(m0 + tok) * PW + P_AV + 4 * F.lane);
            const float a = lo_bf(w.x), b = hi_bf(w.x), c = lo_bf(w.y), d = hi_bf(w.y); const float ss = wave_sum((a * a + b * b) + (c * c + d * d));
            if (F.lane == 0) r_s[tok] = rsqrtf(ss * (1.f / 256.f) + EPS); }
        __syncthreads();
        for (int idx = F.tid; idx < 8192; idx += NT) { const int s = idx >> 6, d = idx & 63; vn[idx] = bf2f(PROJ[(size_t)(m0 + s) * PW + P_AV + g * 64 + d]) * r_s[s] * gain[g * 64 + d]; }
        __syncthreads();
        const int d = F.tid & 63, tq = F.tid >> 6;
        for (int tl = tq; tl < 128; tl += 8) { const float* w = sw + ((size_t)g * 128 + tl) * 128; float acc = 0.f;
            for (int s = 0; s <= tl; ++s) acc = fmaf(w[s], vn[s * 64 + d], acc);
            acc += sb[g * 128 + tl];
            Y[(size_t)(m0 + tl) * D + g * 64 + d] = (bf16_t)f2bf(bf2f(PROJ[(size_t)(m0 + tl) * PW + P_AU + g * 64 + d]) * acc); }
        __syncthreads();
    }
}
__device__ __forceinline__ void conv_simple(Frame& F, int l) {
    bf16_t* PROJ = (bf16_t*)WSP(WS_BIG); bf16_t* Y = (bf16_t*)WSP(WS_Y); const float* conv_w = INP(I_CONV_W);
    const float* cw = conv_w + l * 3 * 256;
    for (int i = F.vcu * NT + F.tid; i < M * 32; i += F.G * NT) { const int m = i >> 5, c = (i & 31) * 8, t = m & (S - 1); float acc[8];
#pragma unroll
        for (int e = 0; e < 8; ++e) acc[e] = 0.f;
#pragma unroll
        for (int j = 0; j < 3; ++j) { const int tt = t - 2 + j; if (tt >= 0) { const size_t r = (size_t)(m - 2 + j) * PW; const u32x4 a = *(const u32x4*)(PROJ + r + P_DC + c), x = *(const u32x4*)(PROJ + r + P_DX + c);
                const f32x4 w0 = *(const f32x4*)(cw + j * 256 + c), w1 = *(const f32x4*)(cw + j * 256 + c + 4);
                acc[0] = fmaf(w0[0], lo_bf(a.x) * lo_bf(x.x), acc[0]); acc[1] = fmaf(w0[1], hi_bf(a.x) * hi_bf(x.x), acc[1]); acc[2] = fmaf(w0[2], lo_bf(a.y) * lo_bf(x.y), acc[2]); acc[3] = fmaf(w0[3], hi_bf(a.y) * hi_bf(x.y), acc[3]);
                acc[4] = fmaf(w1[0], lo_bf(a.z) * lo_bf(x.z), acc[4]); acc[5] = fmaf(w1[1], hi_bf(a.z) * hi_bf(x.z), acc[5]); acc[6] = fmaf(w1[2], lo_bf(a.w) * lo_bf(x.w), acc[6]); acc[7] = fmaf(w1[3], hi_bf(a.w) * hi_bf(x.w), acc[7]); } }
        const u32x4 bq = *(const u32x4*)(PROJ + (size_t)m * PW + P_DB + c); u32x4 o;
        o.x = cvt_pk_bf16(lo_bf(bq.x) * acc[0], hi_bf(bq.x) * acc[1]); o.y = cvt_pk_bf16(lo_bf(bq.y) * acc[2], hi_bf(bq.y) * acc[3]); o.z = cvt_pk_bf16(lo_bf(bq.z) * acc[4], hi_bf(bq.z) * acc[5]); o.w = cvt_pk_bf16(lo_bf(bq.w) * acc[6], hi_bf(bq.w) * acc[7]);
        *(u32x4*)(Y + (size_t)m * D + 768 + c) = o; }
}
__device__ __forceinline__ void indexer_simple(Frame& F) {
    float* MISC = (float*)WSP(WS_MISC); unsigned* MASK = (unsigned*)WSP(WS_MASK); bf16_t* PROJ = (bf16_t*)WSP(WS_BIG);
    LAS float* sc = (LAS float*)F.lds; LAS int* red = (LAS int*)(sc + 4096); LAS unsigned* msk = (LAS unsigned*)(red + 16);
    for (int m = F.vcu; m < M; m += F.G) {
        const int t = m & (S - 1), b0 = m - t, n = t + 1;
        if (n <= 256) { if (F.tid < 128) { const int lo = 32 * F.tid; MASK[maskt_idx(m, F.tid)] = (lo + 32 <= n) ? 0xffffffffu : (lo >= n ? 0u : ((1u << (n - lo)) - 1u)); } continue; }
        float qreg[8], wh[8];
#pragma unroll
        for (int h = 0; h < 8; ++h) { qreg[h] = bf2f(PROJ[(size_t)m * PW + P_QI + h * 64 + F.lane]); wh[h] = MISC[(size_t)m * 16 + h] * 0.35355339059327373f; }
        for (int s0 = 0; s0 < n; s0 += NT) {
            const int s = s0 + F.tid, sc_ = s < n ? s : n - 1; const u32x4* kr = (const u32x4*)(PROJ + (size_t)(b0 + sc_) * PW + P_KI);
            float kf[64];
#pragma unroll
            for (int i = 0; i < 8; ++i) { const u32x4 w = kr[i]; kf[8 * i] = lo_bf(w.x); kf[8 * i + 1] = hi_bf(w.x); kf[8 * i + 2] = lo_bf(w.y); kf[8 * i + 3] = hi_bf(w.y); kf[8 * i + 4] = lo_bf(w.z); kf[8 * i + 5] = hi_bf(w.z); kf[8 * i + 6] = lo_bf(w.w); kf[8 * i + 7] = hi_bf(w.w); }
            float acc = 0.f;
#pragma unroll
            for (int h = 0; h < 8; ++h) { float d0 = 0.f, d1 = 0.f;
#pragma unroll
                for (int e = 0; e < 64; e += 2) { d0 = fmaf(__builtin_bit_cast(float, __builtin_amdgcn_readlane(__builtin_bit_cast(int, qreg[h]), e)), kf[e], d0);
                                                   d1 = fmaf(__builtin_bit_cast(float, __builtin_amdgcn_readlane(__builtin_bit_cast(int, qreg[h]), e + 1)), kf[e + 1], d1); }
                acc += wh[h] * fmaxf((d0 + d1) * 0.125f, 0.f); }
            if (s < n) sc[s] = acc;
        }
        __syncthreads();
        unsigned Tk = 0u;
        for (int bit = 31; bit >= 0; --bit) {
            const unsigned cand = Tk | (1u << bit); int c = 0;
            for (int s = F.tid; s < n; s += NT) c += (fkey(sc[s]) >= cand) ? 1 : 0;
            c = wave_sum_i(c); if (F.lane == 0) red[F.wave] = c; __syncthreads();
            int tot = 0;
#pragma unroll
            for (int w = 0; w < 8; ++w) tot += red[w];
            __syncthreads();
            if (tot >= 256) Tk = cand;
        }
        int cg_ = 0, ce = 0;
        for (int s = F.tid; s < n; s += NT) { const unsigned k = fkey(sc[s]); cg_ += k > Tk ? 1 : 0; ce += k == Tk ? 1 : 0; }
        cg_ = wave_sum_i(cg_); ce = wave_sum_i(ce); if (F.lane == 0) { red[F.wave] = cg_; red[8 + F.wave] = ce; }
        if (F.tid < 128) msk[F.tid] = 0u;
        __syncthreads();
        int ngt = 0, neq = 0;
#pragma unroll
        for (int w = 0; w < 8; ++w) { ngt += red[w]; neq += red[8 + w]; }
        const bool all_eq = (ngt + neq == 256);
        for (int s = F.tid; s < n; s += NT) { const unsigned k = fkey(sc[s]); if (k > Tk || (all_eq && k == Tk)) atomicOr((unsigned*)&msk[s >> 5], 1u << (s & 31)); }
        __syncthreads();
        if (!all_eq && F.tid == 0) { int need = 256 - ngt; for (int s = 0; s < n && need > 0; ++s) if (fkey(sc[s]) == Tk) { msk[s >> 5] |= 1u << (s & 31); --need; } }
        __syncthreads();
        if (F.tid < 128) MASK[maskt_idx(m, F.tid)] = msk[F.tid];
        __syncthreads();
    }
}
__device__ __forceinline__ void attn_simple(Frame& F) {
    unsigned* MASK = (unsigned*)WSP(WS_MASK); bf16_t* PROJ = (bf16_t*)WSP(WS_BIG); bf16_t* Y = (bf16_t*)WSP(WS_Y);
    LAS unsigned* msk = (LAS unsigned*)F.lds; LAS int* sel = (LAS int*)(msk + 128); LAS float* lg = (LAS float*)(sel + 256); LAS int* nsel = (LAS int*)(lg + 4 * 256);
    for (int m = F.vcu; m < M; m += F.G) {
        const int t = m & (S - 1), b0 = m - t;
        if (F.tid < 128) msk[F.tid] = MASK[maskt_idx(m, F.tid)];
        __syncthreads();
        if (F.tid == 0) { int c = 0; for (int w = 0; w < 128; ++w) { unsigned bits = msk[w]; while (bits) { const int i = __builtin_ctz(bits); if (c < 256) sel[c] = 32 * w + i; ++c; bits &= bits - 1; } } nsel[0] = c < 256 ? c : 256; }
        __syncthreads();
        const int ns = nsel[0], h = F.wave & 3, part = F.wave >> 2;
        const float q = bf2f(PROJ[(size_t)m * PW + P_Q + h * 64 + F.lane]);
        for (int j = part; j < ns; j += 2) { const float d = wave_sum(q * bf2f(PROJ[(size_t)(b0 + sel[j]) * PW + P_K + h * 64 + F.lane])); if (F.lane == 0) lg[h * 256 + j] = d * 0.125f; }
        __syncthreads();
        if (F.wave < 4) {
            float mx = -INFINITY; for (int j = F.lane; j < ns; j += 64) mx = fmaxf(mx, lg[h * 256 + j]); mx = wave_max(mx);
            float sm = 0.f; for (int j = F.lane; j < ns; j += 64) sm += __expf(lg[h * 256 + j] - mx); sm = wave_sum(sm);
            float o = 0.f; for (int j = 0; j < ns; ++j) o = fmaf(__expf(lg[h * 256 + j] - mx), bf2f(PROJ[(size_t)(b0 + sel[j]) * PW + P_V + h * 64 + F.lane]), o);
            Y[(size_t)m * D + 256 + h * 64 + F.lane] = (bf16_t)f2bf(o / sm);
        }
        __syncthreads();
    }
}
__device__ __forceinline__ void mlstm1_simple(Frame& F, int l) {
    float* MISC = (float*)WSP(WS_MISC); float* STATE = (float*)WSP(WS_STATE); bf16_t* PROJ = (bf16_t*)WSP(WS_BIG); const float* i_bias = INP(I_I_BIAS); const float* f_bias = INP(I_F_BIAS);
    LAS float* bs = (LAS float*)F.lds; LAS float* ig = bs + 128; LAS float* wk = ig + 128; LAS float* kt = wk + 128; LAS float* vt = kt + 128 * 64;
    for (int item = F.vcu; item < 512; item += F.G) {
        const int bh = item >> 5, c = item & 31, b = bh >> 2, h = bh & 3, m0 = b * S + c * 128;
        if (F.tid < 128) { const float f = MISC[(size_t)(m0 + F.tid) * 16 + 12 + h] + f_bias[l * 4 + h]; bs[F.tid] = fminf(f, 0.f) - log1pf(__expf(-fabsf(f))); ig[F.tid] = MISC[(size_t)(m0 + F.tid) * 16 + 8 + h] + i_bias[l * 4 + h]; }
        for (int idx = F.tid; idx < 8192; idx += NT) { const int s = idx >> 6, d = idx & 63; kt[idx] = bf2f(PROJ[(size_t)(m0 + s) * PW + P_CK + h * 64 + d]); vt[idx] = bf2f(PROJ[(size_t)(m0 + s) * PW + P_CV + h * 64 + d]); }
        __syncthreads();
        if (F.tid == 0) { float a = 0.f; for (int s = 0; s < 128; ++s) { a += bs[s]; bs[s] = a; } }
        __syncthreads();
        const float B = bs[127];
        if (F.tid < 128) wk[F.tid] = __expf(B - bs[F.tid] + ig[F.tid]);
        __syncthreads();
        const int e = F.tid & 63, dq = F.tid >> 6; float acc[8];
#pragma unroll
        for (int i = 0; i < 8; ++i) acc[i] = 0.f;
        for (int s = 0; s < 128; ++s) { const float kv = wk[s] * vt[s * 64 + e];
#pragma unroll
            for (int i = 0; i < 8; ++i) acc[i] = fmaf(kt[s * 64 + dq * 8 + i], kv, acc[i]); }
        float* st = STATE + (size_t)item * STATE_STRIDE;
#pragma unroll
        for (int i = 0; i < 8; ++i) st[e * 64 + dq * 8 + i] = acc[i];
        if (F.tid < 64) { float a = 0.f; for (int s = 0; s < 128; ++s) a = fmaf(wk[s], kt[s * 64 + F.tid], a); st[4096 + F.tid] = a; }
        if (F.tid == 0) st[4160] = B;
        __syncthreads();
    }
}
__device__ __forceinline__ void mlstm2_simple(Frame& F, int l) {
    float* MISC = (float*)WSP(WS_MISC); float* STATE = (float*)WSP(WS_STATE); bf16_t* PROJ = (bf16_t*)WSP(WS_BIG); bf16_t* Y = (bf16_t*)WSP(WS_Y); const float* i_bias = INP(I_I_BIAS); const float* f_bias = INP(I_F_BIAS); const float* mnorm = INP(I_MNORM);
    LAS float* Cs = (LAS float*)F.lds; LAS float* ns = Cs + 4096; LAS float* bs = ns + 64; LAS float* ig = bs + 128; LAS float* A = ig + 128;
    LAS float* qt = A + 128 * 128; LAS float* kt = qt + 128 * 65;
    for (int item = F.vcu; item < 512; item += F.G) {
        const int bh = item >> 5, c = item & 31, b = bh >> 2, h = bh & 3, m0 = b * S + c * 128;
        { float Cv[8]; float nv = 0.f;
#pragma unroll
          for (int k = 0; k < 8; ++k) Cv[k] = 0.f;
          for (int cc = 0; cc < c; ++cc) { const float* st = STATE + (size_t)(bh * 32 + cc) * STATE_STRIDE; const float dec = __expf(st[4160]);
#pragma unroll
              for (int k = 0; k < 8; ++k) Cv[k] = fmaf(dec, Cv[k], st[F.tid + NT * k]);
              if (F.tid < 64) nv = fmaf(dec, nv, st[4096 + F.tid]); }
#pragma unroll
          for (int k = 0; k < 8; ++k) Cs[F.tid + NT * k] = Cv[k];
          if (F.tid < 64) ns[F.tid] = nv; }
        if (F.tid < 128) { const float f = MISC[(size_t)(m0 + F.tid) * 16 + 12 + h] + f_bias[l * 4 + h]; bs[F.tid] = fminf(f, 0.f) - log1pf(__expf(-fabsf(f))); ig[F.tid] = MISC[(size_t)(m0 + F.tid) * 16 + 8 + h] + i_bias[l * 4 + h]; }
        for (int idx = F.tid; idx < 8192; idx += NT) { const int s = idx >> 6, d = idx & 63; qt[s * 65 + d] = bf2f(PROJ[(size_t)(m0 + s) * PW + P_CQ + h * 64 + d]); kt[s * 65 + d] = bf2f(PROJ[(size_t)(m0 + s) * PW + P_CK + h * 64 + d]); }
        __syncthreads();
        if (F.tid == 0) { float a = 0.f; for (int s = 0; s < 128; ++s) { a += bs[s]; bs[s] = a; } }
        __syncthreads();
        { const int s = F.tid & 127, jq = F.tid >> 7;
          for (int j = jq; j < 128; j += 4) { float v = 0.f;
              if (s <= j) { float d = 0.f;
#pragma unroll 16
                  for (int k = 0; k < 64; ++k) d = fmaf(qt[j * 65 + k], kt[s * 65 + k], d);
                  v = __expf(bs[j] - bs[s] + ig[s]) * d; }
              A[j * 128 + s] = v; } }
        __syncthreads();
        LAS float* vt = kt;
        for (int idx = F.tid; idx < 8192; idx += NT) { const int s = idx >> 6, d = idx & 63; vt[idx] = bf2f(PROJ[(size_t)(m0 + s) * PW + P_CV + h * 64 + d]); }
        __syncthreads();
        const int e = F.lane; const float gn = mnorm[l * 256 + h * 64 + e];
        for (int j = F.wave; j < 128; j += 8) {
            float num = 0.f, qn = 0.f, sa = 0.f;
            for (int d = 0; d < 64; ++d) { const float qd = qt[j * 65 + d]; num = fmaf(qd, Cs[d * 64 + e], num); qn = fmaf(qd, ns[d], qn); }
            const float eb = __expf(bs[j]); num *= eb; qn *= eb;
            for (int s = 0; s <= j; ++s) { const float a = A[j * 128 + s]; num = fmaf(a, vt[s * 64 + e], num); sa += a; }
            const float hv = num / fmaxf(fabsf(qn + sa), 1.f);
            const float r = rsqrtf(wave_sum(hv * hv) * (1.f / 64.f) + EPS);
            const size_t row = (size_t)(m0 + j);
            Y[row * D + 512 + h * 64 + e] = (bf16_t)f2bf(sigmoid_f(bf2f(PROJ[row * PW + P_CO + h * 64 + e])) * hv * r * gn);
        }
        __syncthreads();
    }
}
typedef float f32x16 __attribute__((ext_vector_type(16)));
constexpr size_t WS_VT = WS_BIG + 120 * MiB;
constexpr float LOG2E = 1.4426950408889634f;

template <int R> struct AttExp {
    static __device__ __forceinline__ void run(f32x16& p0, f32x16& p1, unsigned sh0, unsigned sh1, float& lsum) {
        constexpr int CB = (R & 3) + 8 * (R >> 2);
        int m0, m1; asm("v_bfe_i32 %0, %1, %2, 1" : "=v"(m0) : "v"(sh0), "n"(CB)); asm("v_bfe_i32 %0, %1, %2, 1" : "=v"(m1) : "v"(sh1), "n"(CB));
        p0[R] = __uint_as_float(__float_as_uint(__builtin_amdgcn_exp2f(p0[R])) & (unsigned)m0); p1[R] = __uint_as_float(__float_as_uint(__builtin_amdgcn_exp2f(p1[R])) & (unsigned)m1);
        lsum += p0[R] + p1[R];
        AttExp<R + 1>::run(p0, p1, sh0, sh1, lsum);
    }
};
template <> struct AttExp<16> { static __device__ __forceinline__ void run(f32x16&, f32x16&, unsigned, unsigned, float&) {} };

__device__ __forceinline__ void attn_mfma(Frame& F, int l) {
    const unsigned long long* MASKT = (const unsigned long long*)WSP(WS_MASK); const bf16_t* PROJ = (const bf16_t*)WSP(WS_BIG); const bf16_t* VT = (const bf16_t*)WSP(WS_VT);
    bf16_t* Y = (bf16_t*)WSP(WS_Y); const float* gt = (const float*)WSP(WS_GT) + l * 192;
    const int lane = F.lane, r32 = lane & 31, hi = lane >> 5, grp = F.wave >> 2, w4 = F.wave & 3, lg = F.tid & 255;
    const float mq = wave_max(fabsf(gt[lane])), mk = wave_max(fabsf(gt[64 + lane]));
    const float c2 = 8.f * mq * mk * 1.01f * LOG2E;
    constexpr int ROWB = 144, TILEB = 64 * ROWB;
    LAS unsigned char* gb = F.lds + grp * 4 * TILEB;
    LAS float* comb = (LAS float*)(F.lds + 8 * TILEB);
    const int srow0 = lg >> 3, sc0 = lg & 7;
    for (int item = F.vcu; item < 256; item += F.G) {
        const int bh = item >> 4, sidx = item & 15, b = bh >> 2, h = bh & 3;
#pragma unroll 1
        for (int half = 0; half < 2; ++half) {
            const int qb = half == 0 ? sidx : 31 - sidx, q0 = qb * 128, ntl = qb + 1;
            const int qrow = b * S + q0 + w4 * 32 + r32, tq = q0 + w4 * 32 + r32;
            bf16x8 qf[4];
#pragma unroll
            for (int s = 0; s < 4; ++s) qf[s] = *(const bf16x8*)(PROJ + (size_t)qrow * PW + P_Q + h * 64 + 16 * s + 8 * hi);
            f32x16 o0, o1;
#pragma unroll
            for (int r = 0; r < 16; ++r) { o0[r] = 0.f; o1[r] = 0.f; }
            float lsum = 0.f;
            const bf16_t* kbase = PROJ + (size_t)(b * S + srow0) * PW + P_K + h * 64 + sc0 * 8;
            const bf16_t* vbase = VT + (size_t)(b * 256 + h * 64 + srow0) * S + sc0 * 8;
            const unsigned long long* mbase = MASKT + (size_t)(b * 64) * S + tq;
            u32x4 ka0, ka1, va0, va1, kb0, kb1, vb0, vb1; unsigned long long mwa = 0ull, mwb = 0ull;
#define ATT_LOAD(K0, K1, V0, V1, MW, t_) do { const int t__ = (t_); K0 = *(const u32x4*)(kbase + (size_t)t__ * 64 * PW); K1 = *(const u32x4*)(kbase + (size_t)(t__ * 64 + 32) * PW); \
    V0 = *(const u32x4*)(vbase + t__ * 64); V1 = *(const u32x4*)(vbase + 32 * S + t__ * 64); MW = mbase[(size_t)t__ * S]; } while (0)
#define ATT_STORE(K0, K1, V0, V1, buf_) do { LAS unsigned char* kn_ = gb + (buf_) * 2 * TILEB; LAS unsigned char* vn_ = kn_ + TILEB; \
    *(LAS u32x4*)(kn_ + srow0 * ROWB + sc0 * 16) = K0; *(LAS u32x4*)(kn_ + (srow0 + 32) * ROWB + sc0 * 16) = K1; \
    *(LAS u32x4*)(vn_ + srow0 * ROWB + sc0 * 16) = V0; *(LAS u32x4*)(vn_ + (srow0 + 32) * ROWB + sc0 * 16) = V1; } while (0)
#define ATT_COMPUTE(cur_, MW) do { \
                const LAS unsigned char* kb = gb + (cur_) * 2 * TILEB; const LAS unsigned char* vb = kb + TILEB; \
                f32x16 p0, p1; \
                _Pragma("unroll") for (int r = 0; r < 16; ++r) { p0[r] = -c2; p1[r] = -c2; }     \
                _Pragma("unroll") for (int s = 0; s < 4; ++s) { \
                    const bf16x8 k0 = *(const LAS bf16x8*)(kb + r32 * ROWB + 32 * s + 16 * hi), k1 = *(const LAS bf16x8*)(kb + (32 + r32) * ROWB + 32 * s + 16 * hi); \
                    p0 = __builtin_amdgcn_mfma_f32_32x32x16_bf16(k0, qf[s], p0, 0, 0, 0); p1 = __builtin_amdgcn_mfma_f32_32x32x16_bf16(k1, qf[s], p1, 0, 0, 0); } \
                const unsigned sh0 = (unsigned)(MW) >> (4 * hi), sh1 = (unsigned)((MW) >> 32) >> (4 * hi); \
                AttExp<0>::run(p0, p1, sh0, sh1, lsum); \
                _Pragma("unroll") for (int ks = 0; ks < 4; ++ks) { \
                    u32x4 pw; \
                    if (ks < 2) { pw.x = cvt_pk_bf16(p0[8 * ks + 0], p0[8 * ks + 1]); pw.y = cvt_pk_bf16(p0[8 * ks + 2], p0[8 * ks + 3]); pw.z = cvt_pk_bf16(p0[8 * ks + 4], p0[8 * ks + 5]); pw.w = cvt_pk_bf16(p0[8 * ks + 6], p0[8 * ks + 7]); } \
                    else { const int k2 = ks - 2; pw.x = cvt_pk_bf16(p1[8 * k2 + 0], p1[8 * k2 + 1]); pw.y = cvt_pk_bf16(p1[8 * k2 + 2], p1[8 * k2 + 3]); pw.z = cvt_pk_bf16(p1[8 * k2 + 4], p1[8 * k2 + 5]); pw.w = cvt_pk_bf16(p1[8 * k2 + 6], p1[8 * k2 + 7]); } \
                    const bf16x8 pf = __builtin_bit_cast(bf16x8, pw); \
                    const int vo = 64 * (ks >> 1) + 32 * (ks & 1) + 8 * hi; \
                    const u32x2 a0 = *(const LAS u32x2*)(vb + r32 * ROWB + vo), a1 = *(const LAS u32x2*)(vb + r32 * ROWB + vo + 16); \
                    const u32x2 b0 = *(const LAS u32x2*)(vb + (32 + r32) * ROWB + vo), b1 = *(const LAS u32x2*)(vb + (32 + r32) * ROWB + vo + 16); \
                    const u32x4 va = {a0.x, a0.y, a1.x, a1.y}, vb4 = {b0.x, b0.y, b1.x, b1.y}; \
                    o0 = __builtin_amdgcn_mfma_f32_32x32x16_bf16(__builtin_bit_cast(bf16x8, va), pf, o0, 0, 0, 0); \
                    o1 = __builtin_amdgcn_mfma_f32_32x32x16_bf16(__builtin_bit_cast(bf16x8, vb4), pf, o1, 0, 0, 0); } \
            } while (0)
            ATT_LOAD(ka0, ka1, va0, va1, mwa, grp);
            if (ntl > 1) ATT_LOAD(kb0, kb1, vb0, vb1, mwb, 2 + grp);
            ATT_STORE(ka0, ka1, va0, va1, 0);
            __syncthreads();
#pragma unroll 1
            for (int i = 0; i < ntl; i += 2) {
                const unsigned long long mw0 = mwa;
                if (i + 2 < ntl) ATT_LOAD(ka0, ka1, va0, va1, mwa, 2 * (i + 2) + grp);
                ATT_COMPUTE(0, mw0);
                if (i + 1 < ntl) ATT_STORE(kb0, kb1, vb0, vb1, 1);
                __syncthreads();
                if (i + 1 < ntl) {
                    const unsigned long long mw1 = mwb;
                    if (i + 3 < ntl) ATT_LOAD(kb0, kb1, vb0, vb1, mwb, 2 * (i + 3) + grp);
                    ATT_COMPUTE(1, mw1);
                    if (i + 2 < ntl) ATT_STORE(ka0, ka1, va0, va1, 0);
                    __syncthreads();
                }
            }
#undef ATT_LOAD
#undef ATT_STORE
#undef ATT_COMPUTE
            if (grp == 1) { LAS float* cw = comb + w4 * 33 * 64 + lane;
#pragma unroll
                for (int r = 0; r < 16; ++r) { cw[r * 64] = o0[r]; cw[(16 + r) * 64] = o1[r]; }
                cw[32 * 64] = lsum; }
            __syncthreads();
            if (grp == 0) { const LAS float* cw = comb + w4 * 33 * 64 + lane;
#pragma unroll
                for (int r = 0; r < 16; ++r) { o0[r] += cw[r * 64]; o1[r] += cw[(16 + r) * 64]; }
                lsum += cw[32 * 64]; lsum += __shfl_xor(lsum, 32); const float inv = 1.f / lsum;
                bf16_t* yp = Y + (size_t)qrow * D + 256 + h * 64 + 4 * hi;
#pragma unroll
                for (int g4 = 0; g4 < 4; ++g4) { u32x2 w0, w1;
                    w0.x = cvt_pk_bf16(o0[4 * g4] * inv, o0[4 * g4 + 1] * inv); w0.y = cvt_pk_bf16(o0[4 * g4 + 2] * inv, o0[4 * g4 + 3] * inv);
                    w1.x = cvt_pk_bf16(o1[4 * g4] * inv, o1[4 * g4 + 1] * inv); w1.y = cvt_pk_bf16(o1[4 * g4 + 2] * inv, o1[4 * g4 + 3] * inv);
                    *(u32x2*)(yp + 8 * g4) = w0; *(u32x2*)(yp + 32 + 8 * g4) = w1; } }
            __syncthreads();
        }
    }
}

constexpr size_t WS_KI = 234 * MiB;
template <int J, unsigned MSK>
__device__ __forceinline__ void tr_stage(unsigned (&a)[32]) {
#pragma unroll
    for (int k = 0; k < 32; ++k) if ((k & J) == 0) { const unsigned t = (a[k] ^ (a[k + J] >> J)) & MSK; a[k] ^= t; a[k + J] ^= (t << J); }
}
__device__ __forceinline__ void transpose32(unsigned (&a)[32]) {
    tr_stage<16, 0x0000FFFFu>(a); tr_stage<8, 0x00FF00FFu>(a); tr_stage<4, 0x0F0F0F0Fu>(a); tr_stage<2, 0x33333333u>(a); tr_stage<1, 0x55555555u>(a);
}
__device__ __forceinline__ int wave_total_i(int v) {
    v += __builtin_amdgcn_update_dpp(0, v, 0x111, 0xf, 0xf, false);
    v += __builtin_amdgcn_update_dpp(0, v, 0x112, 0xf, 0xf, false);
    v += __builtin_amdgcn_update_dpp(0, v, 0x114, 0xf, 0xf, false);
    v += __builtin_amdgcn_update_dpp(0, v, 0x118, 0xf, 0xf, false);
    v += __builtin_amdgcn_update_dpp(0, v, 0x142, 0xa, 0xf, false);
    v += __builtin_amdgcn_update_dpp(0, v, 0x143, 0xc, 0xf, false);
    return __builtin_amdgcn_readlane(v, 63);
}
__device__ __forceinline__ void indexer_mfma(Frame& F) {
    const float* MISC = (const float*)WSP(WS_MISC); unsigned long long* MASKT = (unsigned long long*)WSP(WS_MASK); const bf16_t* PROJ = (const bf16_t*)WSP(WS_BIG); const bf16_t* KI = (const bf16_t*)WSP(WS_KI);
    LAS unsigned short* sc16 = (LAS unsigned short*)F.lds;
    const int lane = F.lane, r32 = lane & 31, hi = lane >> 5, wv = F.wave;
    for (int pi = F.vcu; pi < 1024; pi += F.G) {
        const int b = pi >> 8, pp = pi & 255;
#pragma unroll 1
        for (int half = 0; half < 2; ++half) {
            const int t0 = 8 * (half == 0 ? pp : 511 - pp), m0 = b * S + t0, tq = t0 + wv;
            unsigned long long myword = 0ull;
            if (t0 + 8 <= 256) {
                const int lo = 64 * lane; myword = (tq >= lo + 63) ? ~0ull : (tq < lo ? 0ull : ((2ull << (tq - lo)) - 1ull));
                MASKT[(size_t)(b * 64 + lane) * S + tq] = myword;
                continue;
            }
            const int nmax = t0 + 8, ntile = (nmax + 31) >> 5;
            bf16x8 qa[2][4]; float wq[2][4][4];
#pragma unroll
            for (int i = 0; i < 2; ++i) {
                const bf16_t* qp = PROJ + (size_t)(m0 + 4 * i + (r32 >> 3)) * PW + P_QI + (r32 & 7) * 64 + 8 * hi;
#pragma unroll
                for (int s = 0; s < 4; ++s) qa[i][s] = *(const bf16x8*)(qp + 16 * s);
#pragma unroll
                for (int qq = 0; qq < 4; ++qq) { const f32x4 w4 = *(const f32x4*)(MISC + (size_t)(m0 + 4 * i + qq) * 16 + 4 * hi);
#pragma unroll
                    for (int e = 0; e < 4; ++e) wq[i][qq][e] = w4[e] * (0.125f * 0.35355339059327373f); }
            }
            bf16x8 kring[4][4];
#define IDX_LOADK(u_, j_) do { const int jt_ = (j_) < ntile ? (j_) : ntile - 1; const bf16_t* kp_ = KI + ((size_t)((b * S >> 5) + jt_) * 4 * 64 + lane) * 8; \
    _Pragma("unroll") for (int s_ = 0; s_ < 4; ++s_) kring[u_][s_] = *(const bf16x8*)(kp_ + s_ * 64 * 8); } while (0)
#pragma unroll
            for (int u = 0; u < 4; ++u) IDX_LOADK(u, wv + 8 * u);
            for (int jb = wv; jb < ntile; jb += 32) {
#pragma unroll
                for (int u = 0; u < 4; ++u) {
                    const int j = jb + 8 * u;
                    if (j < ntile) {
                        const int key = 32 * j + r32;
                        bf16x8 kb[4];
#pragma unroll
                        for (int s = 0; s < 4; ++s) kb[s] = kring[u][s];
                        IDX_LOADK(u, j + 32);
#pragma unroll
                        for (int i = 0; i < 2; ++i) {
                            f32x16 d;
#pragma unroll
                            for (int r = 0; r < 16; ++r) d[r] = 0.f;
#pragma unroll
                            for (int s = 0; s < 4; ++s) d = __builtin_amdgcn_mfma_f32_32x32x16_bf16(qa[i][s], kb[s], d, 0, 0, 0);
                            float part[4];
#pragma unroll
                            for (int qq = 0; qq < 4; ++qq) { float a = 0.f;
#pragma unroll
                                for (int e = 0; e < 4; ++e) a = fmaf(wq[i][qq][e], fmaxf(d[4 * qq + e], 0.f), a);
                                part[qq] = a; }
                            auto s01 = __builtin_amdgcn_permlane32_swap(__float_as_uint(part[0]), __float_as_uint(part[1]), false, false);
                            auto s23 = __builtin_amdgcn_permlane32_swap(__float_as_uint(part[2]), __float_as_uint(part[3]), false, false);
                            const float v01 = __uint_as_float(s01[0]) + __uint_as_float(s01[1]), v23 = __uint_as_float(s23[0]) + __uint_as_float(s23[1]);
                            const int qA = 4 * i + hi, qB = 4 * i + 2 + hi;
                            const int kpos = ((key & 2047) << 1) + (key >> 11);
                            sc16[qA * 4096 + kpos] = __builtin_bit_cast(unsigned short, (_Float16)((key <= t0 + qA) ? v01 : -INFINITY));
                            sc16[qB * 4096 + kpos] = __builtin_bit_cast(unsigned short, (_Float16)((key <= t0 + qB) ? v23 : -INFINITY));
                        }
                    }
                }
            }
#undef IDX_LOADK
            __syncthreads();
            const int nvalid = 32 * ntile; const LAS unsigned* srow = (const LAS unsigned*)F.lds + wv * 2048 + lane;
            unsigned kk[32], kc[32];
#pragma unroll
            for (int r = 0; r < 32; ++r) { const unsigned w = srow[64 * r]; const unsigned sg = (w & 0x80008000u) >> 15; const unsigned k = w ^ (((sg << 16) - sg) | 0x80008000u);
                const unsigned vm = ((unsigned)((64 * r + lane - nvalid) >> 31) & 0xFFFFu) | ((unsigned)((2048 + 64 * r + lane - nvalid) >> 31) & 0xFFFF0000u);
                kc[r] = k & vm; kk[r] = kc[r]; }
            transpose32(kk);
            unsigned aA = ~0u, aB = ~0u, Tk = 0u; int base = 0;
#pragma unroll
            for (int bit = 15; bit >= 0; --bit) {
                const unsigned wa = kk[31 - bit], wb = kk[15 - bit];
                const int tot = wave_total_i(__builtin_popcount(wa & aA) + __builtin_popcount(wb & aB));
                const bool take = (base + tot >= 256);
                const unsigned flip = take ? 0u : ~0u;
                aA &= (wa ^ flip); aB &= (wb ^ flip);
                if (take) Tk |= (1u << bit); else base += tot;
            }
            const int ngt = base, neq = wave_total_i(__builtin_popcount(aA) + __builtin_popcount(aB));
            if (ngt + neq == 256) {
#pragma unroll
                for (int r = 0; r < 32; ++r) { const unsigned long long wlo = __ballot((kc[r] & 0xFFFFu) >= Tk), whi = __ballot((kc[r] >> 16) >= Tk);
                    if (lane == r) myword = wlo; if (lane == 32 + r) myword = whi; }
            } else {
                int need = 256 - ngt;
#pragma unroll
                for (int hf = 0; hf < 2; ++hf)
#pragma unroll
                    for (int r = 0; r < 32; ++r) { const unsigned k = hf ? (kc[r] >> 16) : (kc[r] & 0xFFFFu);
                        unsigned long long wsel = __ballot(k > Tk), em = __ballot(k == Tk); int c = __builtin_popcountll(em);
                        if (c > need) { while (c > need) { em &= ~(1ull << (63 - __builtin_clzll(em))); --c; } }
                        need -= c; wsel |= em;
                        if (lane == 32 * hf + r) myword = wsel; }
            }
            MASKT[(size_t)(b * 64 + lane) * S + tq] = myword;
            __syncthreads();
        }
    }
}

constexpr size_t WS_CVT = 236 * MiB;
__device__ __forceinline__ void mlstm2_mfma(Frame& F, int l) {
    const float* MISC = (const float*)WSP(WS_MISC); const float* STATE = (const float*)WSP(WS_STATE); const bf16_t* PROJ = (const bf16_t*)WSP(WS_BIG); const bf16_t* CVT = (const bf16_t*)WSP(WS_CVT);
    bf16_t* Y = (bf16_t*)WSP(WS_Y); const float* i_bias = INP(I_I_BIAS); const float* f_bias = INP(I_F_BIAS); const float* mnorm = INP(I_MNORM);
    const int lane = F.lane, r32 = lane & 31, hi = lane >> 5, grp = F.wave >> 2, w4 = F.wave & 3, lg = F.tid & 255;
    constexpr int KROWB = 144, VROWB = 272, GB = 49152;
    LAS unsigned char* gb = F.lds + grp * GB;
    LAS float* bc = (LAS float*)gb;
    LAS float* gs = bc + 128;
    LAS float* npv = gs + 128;
    LAS float* wsum = npv + 64;
    LAS unsigned char* ct = gb + 2048;
    LAS unsigned char* kt = ct + 9216;
    LAS unsigned char* vt = kt + 18432;
    for (int it0 = 2 * F.vcu; it0 < 512; it0 += 2 * F.G) {
        const int item = it0 + grp, bh = item >> 5, c = item & 31, b = bh >> 2, h = bh & 3, m0 = b * S + c * 128;
        if (lg < 128) { const float f = MISC[(size_t)(m0 + lg) * 16 + 12 + h] + f_bias[l * 4 + h]; bc[lg] = fminf(f, 0.f) - log1pf(__expf(-fabsf(f))); gs[lg] = MISC[(size_t)(m0 + lg) * 16 + 8 + h] + i_bias[l * 4 + h]; }
        if (lg >= 128 && lg < 160) { const int cc = lg - 128; wsum[cc] = (cc < c) ? STATE[(size_t)(bh * 32 + cc) * STATE_STRIDE + 4160] : 0.f; }
        __syncthreads();
        if (lg < 64) {
            float a0 = bc[2 * lane], a1 = bc[2 * lane + 1]; float s = a0 + a1;
#pragma unroll
            for (int o = 1; o < 64; o <<= 1) { const float t = __shfl_up(s, o); if (lane >= o) s += t; }
            const float ex = s - (a0 + a1); const float i0 = gs[2 * lane], i1 = gs[2 * lane + 1];
            bc[2 * lane] = ex + a0; bc[2 * lane + 1] = s; gs[2 * lane] = i0 - (ex + a0); gs[2 * lane + 1] = i1 - s;
            float w = (lane < 32) ? wsum[lane] : 0.f; float suf = w;
#pragma unroll
            for (int o = 1; o < 32; o <<= 1) { const float t = __shfl_down(suf, o); if (lane + o < 32) suf += t; }
            if (lane < 32) wsum[lane] = suf - w;
        }
        __syncthreads();
        { f32x4 a4[4]; float nv = 0.f;
#pragma unroll
          for (int k = 0; k < 4; ++k) a4[k] = (f32x4){0.f, 0.f, 0.f, 0.f};
          for (int cc = 0; cc < c; ++cc) { const float* st = STATE + (size_t)(bh * 32 + cc) * STATE_STRIDE; const float wgt = __expf(wsum[cc]);
#pragma unroll
              for (int k = 0; k < 4; ++k) { const f32x4 v = *(const f32x4*)(st + 4 * (lg + 256 * k)); a4[k] = a4[k] + v * wgt; }
              if (lg < 64) nv = fmaf(wgt, st[4096 + lg], nv); }
#pragma unroll
          for (int k = 0; k < 4; ++k) { const int idx = 4 * (lg + 256 * k), e = idx >> 6, d = idx & 63; u32x2 w; w.x = cvt_pk_bf16(a4[k][0], a4[k][1]); w.y = cvt_pk_bf16(a4[k][2], a4[k][3]); *(LAS u32x2*)(ct + e * KROWB + d * 2) = w; }
          if (lg < 64) npv[lg] = nv; }
#pragma unroll
        for (int k = 0; k < 4; ++k) { const int id = lg + 256 * k, row = id >> 3, ch = id & 7;
            *(LAS u32x4*)(kt + row * KROWB + ch * 16) = *(const u32x4*)(PROJ + (size_t)(m0 + row) * PW + P_CK + h * 64 + ch * 8);
            const int vrow = id >> 4, vch = id & 15;
            *(LAS u32x4*)(vt + vrow * VROWB + vch * 16) = *(const u32x4*)(CVT + (size_t)(b * 256 + h * 64 + vrow) * S + c * 128 + vch * 8); }
        __syncthreads();
        const int j = 32 * w4 + r32, qrow = m0 + j;
        bf16x8 qf[4];
#pragma unroll
        for (int s = 0; s < 4; ++s) qf[s] = *(const bf16x8*)(PROJ + (size_t)qrow * PW + P_CQ + h * 64 + 16 * s + 8 * hi);
        const float bj = bc[j], eb = __expf(bj);
        float qn = 0.f;
#pragma unroll
        for (int s = 0; s < 4; ++s) { const u32x4 w = __builtin_bit_cast(u32x4, qf[s]); const LAS float* np = npv + 16 * s + 8 * hi;
            qn += lo_bf(w.x) * np[0] + hi_bf(w.x) * np[1] + lo_bf(w.y) * np[2] + hi_bf(w.y) * np[3] + lo_bf(w.z) * np[4] + hi_bf(w.z) * np[5] + lo_bf(w.w) * np[6] + hi_bf(w.w) * np[7]; }
        qn += __shfl_xor(qn, 32); qn *= eb;
        f32x16 n0, n1;
#pragma unroll
        for (int r = 0; r < 16; ++r) { n0[r] = 0.f; n1[r] = 0.f; }
#pragma unroll
        for (int ks = 0; ks < 4; ++ks) { const bf16x8 c0 = *(const LAS bf16x8*)(ct + r32 * KROWB + 32 * ks + 16 * hi), c1 = *(const LAS bf16x8*)(ct + (32 + r32) * KROWB + 32 * ks + 16 * hi);
            n0 = __builtin_amdgcn_mfma_f32_32x32x16_bf16(c0, qf[ks], n0, 0, 0, 0); n1 = __builtin_amdgcn_mfma_f32_32x32x16_bf16(c1, qf[ks], n1, 0, 0, 0); }
#pragma unroll
        for (int r = 0; r < 16; ++r) { n0[r] *= eb; n1[r] *= eb; }
        float sa = 0.f;
#pragma unroll 1
        for (int st = 0; st <= w4; ++st) {
            f32x16 p;
#pragma unroll
            for (int r = 0; r < 16; ++r) p[r] = 0.f;
#pragma unroll
            for (int ks = 0; ks < 4; ++ks) { const bf16x8 kf = *(const LAS bf16x8*)(kt + (32 * st + r32) * KROWB + 32 * ks + 16 * hi); p = __builtin_amdgcn_mfma_f32_32x32x16_bf16(kf, qf[ks], p, 0, 0, 0); }
#pragma unroll
            for (int r = 0; r < 16; ++r) { const int s = 32 * st + (r & 3) + 8 * (r >> 2) + 4 * hi; const float a = (s <= j) ? __expf(bj + gs[s]) * p[r] : 0.f; p[r] = a; sa += a; }
#pragma unroll
            for (int k2 = 0; k2 < 2; ++k2) {
                u32x4 pw; pw.x = cvt_pk_bf16(p[8 * k2 + 0], p[8 * k2 + 1]); pw.y = cvt_pk_bf16(p[8 * k2 + 2], p[8 * k2 + 3]); pw.z = cvt_pk_bf16(p[8 * k2 + 4], p[8 * k2 + 5]); pw.w = cvt_pk_bf16(p[8 * k2 + 6], p[8 * k2 + 7]);
                const bf16x8 pf = __builtin_bit_cast(bf16x8, pw);
                const int vo = (32 * st + 16 * k2 + 4 * hi) * 2;
                const u32x2 a0 = *(const LAS u32x2*)(vt + r32 * VROWB + vo), a1 = *(const LAS u32x2*)(vt + r32 * VROWB + vo + 16);
                const u32x2 b0 = *(const LAS u32x2*)(vt + (32 + r32) * VROWB + vo), b1 = *(const LAS u32x2*)(vt + (32 + r32) * VROWB + vo + 16);
                const u32x4 va = {a0.x, a0.y, a1.x, a1.y}, vb4 = {b0.x, b0.y, b1.x, b1.y};
                n0 = __builtin_amdgcn_mfma_f32_32x32x16_bf16(__builtin_bit_cast(bf16x8, va), pf, n0, 0, 0, 0);
                n1 = __builtin_amdgcn_mfma_f32_32x32x16_bf16(__builtin_bit_cast(bf16x8, vb4), pf, n1, 0, 0, 0);
            }
        }
        sa += __shfl_xor(sa, 32);
        const float inv = 1.f / fmaxf(fabsf(qn + sa), 1.f);
        float ss = 0.f;
#pragma unroll
        for (int r = 0; r < 16; ++r) { n0[r] *= inv; n1[r] *= inv; ss += n0[r] * n0[r] + n1[r] * n1[r]; }
        ss += __shfl_xor(ss, 32); const float rr = rsqrtf(ss * (1.f / 64.f) + EPS);
        const float* gp = mnorm + l * 256 + h * 64 + 4 * hi; const bf16_t* op = PROJ + (size_t)qrow * PW + P_CO + h * 64 + 4 * hi; bf16_t* yp = Y + (size_t)qrow * D + 512 + h * 64 + 4 * hi;
#pragma unroll
        for (int g4 = 0; g4 < 4; ++g4) {
            const f32x4 ga = *(const f32x4*)(gp + 8 * g4), gb4 = *(const f32x4*)(gp + 32 + 8 * g4);
            const u32x2 oa = *(const u32x2*)(op + 8 * g4), ob = *(const u32x2*)(op + 32 + 8 * g4);
            u32x2 w0, w1;
            w0.x = cvt_pk_bf16(sigmoid_f(lo_bf(oa.x)) * n0[4 * g4] * rr * ga[0], sigmoid_f(hi_bf(oa.x)) * n0[4 * g4 + 1] * rr * ga[1]);
            w0.y = cvt_pk_bf16(sigmoid_f(lo_bf(oa.y)) * n0[4 * g4 + 2] * rr * ga[2], sigmoid_f(hi_bf(oa.y)) * n0[4 * g4 + 3] * rr * ga[3]);
            w1.x = cvt_pk_bf16(sigmoid_f(lo_bf(ob.x)) * n1[4 * g4] * rr * gb4[0], sigmoid_f(hi_bf(ob.x)) * n1[4 * g4 + 1] * rr * gb4[1]);
            w1.y = cvt_pk_bf16(sigmoid_f(lo_bf(ob.y)) * n1[4 * g4 + 2] * rr * gb4[2], sigmoid_f(hi_bf(ob.y)) * n1[4 * g4 + 3] * rr * gb4[3]);
            *(u32x2*)(yp + 8 * g4) = w0; *(u32x2*)(yp + 32 + 8 * g4) = w1;
        }
        __syncthreads();
    }
}

constexpr size_t WS_SSQV = 244 * MiB;
__device__ __forceinline__ void sgu_mfma(Frame& F, int l) {
    const bf16_t* PROJ = (const bf16_t*)WSP(WS_BIG); bf16_t* Y = (bf16_t*)WSP(WS_Y); const float* SSQV = (const float*)WSP(WS_SSQV);
    const float* gain = INP(I_SGU_NORM) + l * 256; const float* sw = INP(I_SGU_W) + (size_t)l * 4 * 128 * 128; const float* sb = INP(I_SGU_B) + l * 4 * 128;
    const int lane = F.lane, r32 = lane & 31, hi = lane >> 5, dt = F.wave & 1, tt = F.wave >> 1;
    constexpr int VROWB = 272;
    LAS float* r_s = (LAS float*)F.lds;
    LAS unsigned char* vt = F.lds + 512;
    for (int item = F.vcu; item < 512; item += F.G) {
        const int g = item & 3, m0 = (item >> 2) * 128;
        if (F.tid < 128) { const f32x4 q = *(const f32x4*)(SSQV + (size_t)(m0 + F.tid) * 4); r_s[F.tid] = rsqrtf(((q[0] + q[1]) + (q[2] + q[3])) * (1.f / 256.f) + EPS); }
        __syncthreads();
#pragma unroll
        for (int k = 0; k < 2; ++k) { const int id = F.tid + 512 * k, s = id >> 3, d0 = (id & 7) * 8; const float rs = r_s[s];
            const u32x4 w = *(const u32x4*)(PROJ + (size_t)(m0 + s) * PW + P_AV + g * 64 + d0);
            const float v[8] = {lo_bf(w.x), hi_bf(w.x), lo_bf(w.y), hi_bf(w.y), lo_bf(w.z), hi_bf(w.z), lo_bf(w.w), hi_bf(w.w)};
#pragma unroll
            for (int i = 0; i < 8; ++i) *(LAS bf16_t*)(vt + (d0 + i) * VROWB + s * 2) = (bf16_t)f2bf(v[i] * rs); }
        __syncthreads();
        f32x16 acc;
#pragma unroll
        for (int r = 0; r < 16; ++r) acc[r] = 0.f;
        const int t = 32 * tt + r32; const float* wrow = sw + ((size_t)g * 128 + t) * 128;
#pragma unroll 1
        for (int ks = 0; ks < 2 * (tt + 1); ++ks) {
            const bf16x8 af = *(const LAS bf16x8*)(vt + (32 * dt + r32) * VROWB + (16 * ks + 8 * hi) * 2);
            const int s0 = 16 * ks + 8 * hi; const f32x4 w0 = *(const f32x4*)(wrow + s0), w1 = *(const f32x4*)(wrow + s0 + 4);
            u32x4 bw; bw.x = cvt_pk_bf16(s0 + 0 <= t ? w0[0] : 0.f, s0 + 1 <= t ? w0[1] : 0.f); bw.y = cvt_pk_bf16(s0 + 2 <= t ? w0[2] : 0.f, s0 + 3 <= t ? w0[3] : 0.f);
            bw.z = cvt_pk_bf16(s0 + 4 <= t ? w1[0] : 0.f, s0 + 5 <= t ? w1[1] : 0.f); bw.w = cvt_pk_bf16(s0 + 6 <= t ? w1[2] : 0.f, s0 + 7 <= t ? w1[3] : 0.f);
            acc = __builtin_amdgcn_mfma_f32_32x32x16_bf16(af, __builtin_bit_cast(bf16x8, bw), acc, 0, 0, 0);
        }
        const float bias = sb[g * 128 + t]; const size_t row = (size_t)(m0 + t);
        const float* gp = gain + g * 64 + 32 * dt + 4 * hi; const bf16_t* up = PROJ + row * PW + P_AU + g * 64 + 32 * dt + 4 * hi; bf16_t* yp = Y + row * D + g * 64 + 32 * dt + 4 * hi;
#pragma unroll
        for (int g4 = 0; g4 < 4; ++g4) { const f32x4 gv = *(const f32x4*)(gp + 8 * g4); const u32x2 uw = *(const u32x2*)(up + 8 * g4); u32x2 ow;
            ow.x = cvt_pk_bf16(lo_bf(uw.x) * (gv[0] * acc[4 * g4] + bias), hi_bf(uw.x) * (gv[1] * acc[4 * g4 + 1] + bias));
            ow.y = cvt_pk_bf16(lo_bf(uw.y) * (gv[2] * acc[4 * g4 + 2] + bias), hi_bf(uw.y) * (gv[3] * acc[4 * g4 + 3] + bias));
            *(u32x2*)(yp + 8 * g4) = ow; }
        __syncthreads();
    }
}

__device__ __forceinline__ void mlstm1_mfma(Frame& F, int l) {
    const float* MISC = (const float*)WSP(WS_MISC); float* STATE = (float*)WSP(WS_STATE); const bf16_t* PROJ = (const bf16_t*)WSP(WS_BIG); const bf16_t* CVT = (const bf16_t*)WSP(WS_CVT);
    const float* i_bias = INP(I_I_BIAS); const float* f_bias = INP(I_F_BIAS);
    const int lane = F.lane, r32 = lane & 31, hi = lane >> 5, grp = F.wave >> 2, w4 = F.wave & 3, et = w4 & 1, dt = w4 >> 1, lg = F.tid & 255;
    constexpr int KROWB = 144, GB = 20480;
    LAS unsigned char* gb = F.lds + grp * GB;
    LAS float* bc = (LAS float*)gb; LAS float* wk = bc + 128; LAS unsigned char* kt = gb + 1024;
    for (int it0 = 2 * F.vcu; it0 < 512; it0 += 2 * F.G) {
        const int item = it0 + grp, bh = item >> 5, c = item & 31, b = bh >> 2, h = bh & 3, m0 = b * S + c * 128;
        if (lg < 128) { const float f = MISC[(size_t)(m0 + lg) * 16 + 12 + h] + f_bias[l * 4 + h]; bc[lg] = fminf(f, 0.f) - log1pf(__expf(-fabsf(f))); wk[lg] = MISC[(size_t)(m0 + lg) * 16 + 8 + h] + i_bias[l * 4 + h]; }
        __syncthreads();
        if (lg < 64) { const float a0 = bc[2 * lane], a1 = bc[2 * lane + 1]; float s = a0 + a1;
#pragma unroll
            for (int o = 1; o < 64; o <<= 1) { const float t = __shfl_up(s, o); if (lane >= o) s += t; }
            const float tot = __shfl(s, 63), ex = s - (a0 + a1);
            wk[2 * lane] = __expf(tot - (ex + a0) + wk[2 * lane]); wk[2 * lane + 1] = __expf(tot - s + wk[2 * lane + 1]);
            if (lane == 0) bc[0] = tot; }
        __syncthreads();
        const float Bc = bc[0];
#pragma unroll
        for (int k = 0; k < 4; ++k) { const int id = lg + 256 * k, s = id >> 3, ch = id & 7; const float ws_ = wk[s];
            const u32x4 w = *(const u32x4*)(PROJ + (size_t)(m0 + s) * PW + P_CK + h * 64 + ch * 8); u32x4 o;
            o.x = cvt_pk_bf16(lo_bf(w.x) * ws_, hi_bf(w.x) * ws_); o.y = cvt_pk_bf16(lo_bf(w.y) * ws_, hi_bf(w.y) * ws_); o.z = cvt_pk_bf16(lo_bf(w.z) * ws_, hi_bf(w.z) * ws_); o.w = cvt_pk_bf16(lo_bf(w.w) * ws_, hi_bf(w.w) * ws_);
            *(LAS u32x4*)(kt + s * KROWB + ch * 16) = o; }
        __syncthreads();
        f32x16 acc;
#pragma unroll
        for (int r = 0; r < 16; ++r) acc[r] = 0.f;
        float nsum = 0.f;
        const bf16_t* vp = CVT + (size_t)(b * 256 + h * 64 + 32 * et + r32) * S + c * 128 + 8 * hi;
        bf16x8 af[8];
#pragma unroll
        for (int ks = 0; ks < 8; ++ks) af[ks] = *(const bf16x8*)(vp + 16 * ks);
#pragma unroll
        for (int ks = 0; ks < 8; ++ks) {
            const LAS unsigned char* kp = kt + (16 * ks + 8 * hi) * KROWB + (32 * dt + r32) * 2; unsigned e8[8];
#pragma unroll
            for (int jj = 0; jj < 8; ++jj) e8[jj] = *(const LAS bf16_t*)(kp + jj * KROWB);
            u32x4 bw; bw.x = e8[0] | (e8[1] << 16); bw.y = e8[2] | (e8[3] << 16); bw.z = e8[4] | (e8[5] << 16); bw.w = e8[6] | (e8[7] << 16);
#pragma unroll
            for (int jj = 0; jj < 8; ++jj) nsum += __uint_as_float(e8[jj] << 16);
            acc = __builtin_amdgcn_mfma_f32_32x32x16_bf16(af[ks], __builtin_bit_cast(bf16x8, bw), acc, 0, 0, 0);
        }
        float* st = STATE + (size_t)item * STATE_STRIDE;
#pragma unroll
        for (int r = 0; r < 16; ++r) st[(32 * et + (r & 3) + 8 * (r >> 2) + 4 * hi) * 64 + 32 * dt + r32] = acc[r];
        nsum += __shfl_xor(nsum, 32);
        if (et == 0 && hi == 0) st[4096 + 32 * dt + r32] = nsum;
        if (lg == 0) st[4160] = Bc;
        __syncthreads();
    }
}
#ifndef MK_MULTI
#define MK_MULTI 0
#endif
constexpr int N_PHASES = 1 + 10 * DEPTH;

__global__ void __launch_bounds__(NT, 2) mk_fwd(Args args) {
    extern __shared__ __attribute__((aligned(16))) unsigned char lds_raw[];
    Frame F;
    F.lds = (LAS unsigned char*)lds_raw; F.tid = threadIdx.x; F.lane = F.tid & 63; F.wave = __builtin_amdgcn_readfirstlane(F.tid >> 6);
    F.G = gridDim.x; { const int bx_ = blockIdx.x; F.vcu = (F.G % 8 == 0) ? (bx_ % 8) * (F.G / 8) + bx_ / 8 : bx_; }
    if (F.tid < 20) { const unsigned long long pv = F.tid < 18 ? (unsigned long long)args.in[F.tid < 18 ? F.tid : 0] : (F.tid == 18 ? (unsigned long long)args.out : (unsigned long long)args.ws);
        *(LAS unsigned long long*)(F.lds + PTR_OFF + 8 * F.tid) = pv; }
    if (F.tid < 2) *(LAS unsigned*)(F.lds + PTR_OFF + 256 + 4 * F.tid) = 0u;
    __syncthreads();
#if MK_MULTI
    int bx = (int)blockIdx.x;
    const int lo = args.ph_lo, hi = args.ph_hi; const bool coop = args.coop != 0;
#else
    int bx = (int)blockIdx.x;
    constexpr int lo = 0, hi = N_PHASES - 1; constexpr bool coop = true;
    if (F.tid == 0) (void)xb_add(&((unsigned*)(args.ws + WS_BAR))[XB_XCNT(xb_xcc_id())], 1u);
#endif
#define XBAR_NOW() XcdBarrier{(unsigned*)WSP(WS_BAR), xb_xcc_id(), (volatile LAS unsigned*)(F.lds + PTR_OFF + 256)}
#define RUN(k) (lo <= (k) && (k) < hi)
#define LAUNDER() asm volatile("" : "+v"(F.tid), "+v"(F.lane), "+s"(F.G), "+s"(F.vcu), "+s"(F.wave), "+s"(bx), "+s"(F.lds))
#ifndef MK_SKEW_SLEEP
#define MK_SKEW_SLEEP 0
#endif
#define SKEW() do { if (coop) { for (unsigned s_ = ((unsigned)blockIdx.x >> 3) & 3u; s_ > 0; --s_) __builtin_amdgcn_s_sleep(MK_SKEW_SLEEP); } } while (0)
#define SEAM(k) do { if (coop && RUN(k) && RUN((k) + 1)) { if ((k) == 0) cg::this_grid().sync(); else { const XcdBarrier xb_ = XBAR_NOW(); xcd_barrier(xb_); } } } while (0)

    if (RUN(0)) { LAUNDER(); convert_mix_weights(F, 0); prologue_rows(F);
        if (blockIdx.x == 0 && F.tid < DEPTH * 192) { const int l_ = F.tid / 192, r_ = F.tid % 192, w_ = r_ / 64, i_ = r_ % 64; ((float*)WSP(WS_GT))[F.tid] = INP(I_Q_NORM + w_)[l_ * 64 + i_]; } }
    SEAM(0);
#pragma unroll 1
    for (int l = 0; l < DEPTH; ++l) {
        const int pb = 1 + 10 * l;
        if (RUN(pb + 0)) { LAUNDER(); SKEW();
            pg8::Gemm<D, D, D, 256u * D * 2, 0, 256u * D * 2, 0> g{(const bf16_t*)WSP(WS_XG), (const bf16_t*)WSP(WS_WIN)};
            pg8::StaticOrder So; So.init(M, PW, F.G, bx);
            epi::EpiProj E{(bf16_t*)WSP(WS_BIG), (float*)WSP(WS_MISC), (const float*)WSP(WS_RSA), (const float*)WSP(WS_COS), (const float*)WSP(WS_SIN), (const float*)WSP(WS_GT) + l * 192, (bf16_t*)WSP(WS_VT), (bf16_t*)WSP(WS_KI), (bf16_t*)WSP(WS_CVT), (float*)WSP(WS_SSQV)};
            pg8::gemm_phase<epi::EpiProj, pg8::StaticOrder, true>(F.lds, g, So, E, F.tid);
        }
        SEAM(pb + 0);
        if (RUN(pb + 1)) { LAUNDER(); sgu_mfma(F, l); conv_simple(F, l); indexer_mfma(F); mlstm1_mfma(F, l); }
        SEAM(pb + 1);
        if (RUN(pb + 2)) { LAUNDER(); attn_mfma(F, l); mlstm2_mfma(F, l); }
        SEAM(pb + 2);
        if (RUN(pb + 3)) { LAUNDER(); SKEW();
            pg8::Gemm<256, D, 256, 256u * D * 2, 256u * 2, 256u * 256 * 2, 1024u * 256 * 2> g{(const bf16_t*)WSP(WS_Y), (const bf16_t*)WSP(WS_WBR)};
            pg8::SuperOrder<0> So; So.init(F.G, bx);
            epi::EpiPlain E{(bf16_t*)WSP(WS_BIG), 4096, 1024};
            pg8::gemm_phase<epi::EpiPlain, pg8::SuperOrder<0>, true>(F.lds, g, So, E, F.tid);
        }
        if (coop && RUN(pb + 3) && RUN(pb + 4)) { asm volatile("s_waitcnt vmcnt(0)" ::: "memory"); __syncthreads(); __builtin_amdgcn_fence(__ATOMIC_ACQUIRE, "agent"); asm volatile("s_waitcnt vmcnt(0)" ::: "memory"); __syncthreads(); }
        if (RUN(pb + 4)) { LAUNDER();
            pg8::Gemm<D, D, D, 256u * D * 2, 0, 256u * D * 2, 0> g{(const bf16_t*)WSP(WS_XG), (const bf16_t*)WSP(WS_WG)};
            pg8::SuperOrder<1> So; So.init(F.G, bx);
            epi::EpiGate E{(bf16_t*)WSP(WS_MG), (const bf16_t*)WSP(WS_BIG), (const float*)WSP(WS_RSA)};
            pg8::gemm_phase<epi::EpiGate, pg8::SuperOrder<1>, true>(F.lds, g, So, E, F.tid);
        }
        SEAM(pb + 4);
        if (RUN(pb + 5)) { LAUNDER();
            pg8::Gemm<D, D, D, 256u * D * 2, 0, 256u * D * 2, 0> g{(const bf16_t*)WSP(WS_MG), (const bf16_t*)WSP(WS_WOUT)};
            pg8::StaticOrder So; So.init(M, D, F.G, bx);
            epi::EpiResid E{l == 0 ? INP(I_X) : nullptr, (bf16_t*)WSP(WS_XG), nullptr, (float*)WSP(WS_SSQB)};
            pg8::gemm_phase<epi::EpiResid, pg8::StaticOrder, true>(F.lds, g, So, E, F.tid);
            __syncthreads();
            convert_mlp_weights(F, l);
        }
        SEAM(pb + 5);
        if (RUN(pb + 6)) { LAUNDER(); finalize_rs(F, WS_SSQB, WS_RSB); }
        SEAM(pb + 6);
        if (RUN(pb + 7)) { LAUNDER(); SKEW();
            pg8::Gemm<D, D, D, 256u * D * 2, 0, 256u * D * 2, 0> g{(const bf16_t*)WSP(WS_XG), (const bf16_t*)WSP(WS_WUP)};
            pg8::StaticOrder So; So.init(M, FF, F.G, bx);
            epi::EpiUp E{(bf16_t*)WSP(WS_BIG), (const float*)WSP(WS_RSB)};
            pg8::gemm_phase<epi::EpiUp, pg8::StaticOrder, true>(F.lds, g, So, E, F.tid);
            if (l + 1 < DEPTH) { __syncthreads(); convert_mix_weights(F, l + 1); }
        }
        SEAM(pb + 7);
        if (RUN(pb + 8)) { LAUNDER();
            pg8::Gemm<FF, FF, FF, 256u * FF * 2, 0, 256u * FF * 2, 0> g{(const bf16_t*)WSP(WS_BIG), (const bf16_t*)WSP(WS_WDN)};
            pg8::StaticOrder So; So.init(M, D, F.G, bx);
            epi::EpiResid E{nullptr, (bf16_t*)WSP(WS_XG), (l + 1 < DEPTH) ? nullptr : (float*)ptr_at(F, I_OUT), (float*)WSP(WS_SSQA)};
            pg8::gemm_phase<epi::EpiResid, pg8::StaticOrder, true>(F.lds, g, So, E, F.tid);
        }
        SEAM(pb + 8);
        if (RUN(pb + 9)) { LAUNDER(); if (l + 1 < DEPTH) finalize_rs(F, WS_SSQA, WS_RSA); }
        SEAM(pb + 9);
    }
#undef RUN
#undef SEAM
}

extern "C" void kernel_launch(void* const* d_in, const int* in_sizes, int n_in, void* d_out, int out_size, void* d_ws, size_t ws_size, hipStream_t stream) {
    static int grid = 0;
    if (grid == 0) {
        if (n_in != 18 || in_sizes[0] != M * D || out_size != M * D || ws_size < WS_END) { fprintf(stderr, "kernel_launch: unexpected shapes (n_in %d, in0 %d, out %d, ws %zu)\n", n_in, n_in > 0 ? in_sizes[0] : -1, out_size, ws_size); grid = -1; return; }
        int dev = 0, cus = 0, per_cu = 0;
        if (hipGetDevice(&dev) != hipSuccess || hipDeviceGetAttribute(&cus, hipDeviceAttributeMultiprocessorCount, dev) != hipSuccess) { grid = -1; return; }
        if (hipFuncSetAttribute((const void*)mk_fwd, hipFuncAttributeMaxDynamicSharedMemorySize, LDS_BYTES) != hipSuccess) { fprintf(stderr, "kernel_launch: hipFuncSetAttribute failed\n"); grid = -1; return; }
        if (hipOccupancyMaxActiveBlocksPerMultiprocessor(&per_cu, (const void*)mk_fwd, NT, LDS_BYTES) != hipSuccess || per_cu < 1) { fprintf(stderr, "kernel_launch: occupancy query says %d\n", per_cu); (void)hipGetLastError(); per_cu = 1; }
        grid = cus;
    }
    if (grid < 0) return;
    if (hipMemsetAsync((char*)d_ws + WS_CTL, 0, CTL_ZERO_BYTES, stream) != hipSuccess) { fprintf(stderr, "kernel_launch: memset failed\n"); return; }
    Args a{};
    for (int i = 0; i < 18; ++i) a.in[i] = (const float*)d_in[i];
    a.out = (float*)d_out; a.ws = (unsigned char*)d_ws;
#if MK_MULTI
    for (int p = 0; p < N_PHASES; ++p) { a.ph_lo = p; a.ph_hi = p + 1; a.coop = 0; hipLaunchKernelGGL(mk_fwd, dim3(grid), dim3(NT), LDS_BYTES, stream, a); }
#else
    a.ph_lo = 0; a.ph_hi = N_PHASES - 1; a.coop = 1;
    void* kargs[] = {&a};
    hipError_t e = hipLaunchCooperativeKernel((const void*)mk_fwd, dim3(grid), dim3(NT), kargs, LDS_BYTES, stream);
    if (e != hipSuccess) fprintf(stderr, "kernel_launch: cooperative launch failed: %s (grid %d)\n", hipGetErrorString(e), grid);
#endif
}
```

```cpp
#include <hip/hip_runtime.h>
#define MK_MULTI 0
#include <hip/hip_cooperative_groups.h>
#include <cstdio>
#include <cstdint>
namespace cg = cooperative_groups;

#define LAS __attribute__((address_space(3)))
typedef unsigned short bf16_t;
typedef short bf16x8 __attribute__((ext_vector_type(8)));
typedef float f32x4 __attribute__((ext_vector_type(4)));
typedef float f32x2 __attribute__((ext_vector_type(2)));
typedef unsigned u32x4 __attribute__((ext_vector_type(4)));
typedef unsigned u32x2 __attribute__((ext_vector_type(2)));
typedef int i32x4 __attribute__((ext_vector_type(4)));
typedef int i32x8 __attribute__((ext_vector_type(8)));

constexpr int D = 1024, NB = 4, S = 4096, M = NB * S, DEPTH = 2, FF = 4096, INW = 7760;
constexpr int O_AU = 0, O_AV = 256, O_BQ = 512, O_BK = 768, O_BV = 1024, O_QI = 1280, O_KI = 1792, O_WI = 1856,
              O_CQ = 1864, O_CK = 2120, O_CV = 2376, O_CO = 2632, O_CI = 2888, O_CF = 2892, O_DB = 2896, O_DC = 3152, O_DX = 3408, O_G = 3664;
constexpr int PW = 3840;
constexpr int P_AU = 0, P_AV = 256, P_Q = 512, P_K = 768, P_V = 1024, P_QI = 1280, P_CQ = 1792, P_CK = 2048, P_CV = 2304, P_CO = 2560,
              P_DB = 2816, P_DC = 3072, P_DX = 3328, P_KI = 3584;
constexpr float EPS = 1e-6f;
constexpr int NWAVES = 8, NT = 512;

constexpr size_t MiB = 1u << 20;
constexpr size_t WS_CTL = 0;
constexpr size_t WS_COS = 1 * MiB, WS_SIN = 1 * MiB + 512 * 1024;
constexpr size_t WS_MISC = 2 * MiB;
constexpr size_t WS_SSQA = 3 * MiB, WS_SSQB = 4 * MiB;
constexpr size_t WS_WIN = 5 * MiB;
constexpr size_t WS_WG = WS_WIN + (size_t)PW * D * 2;
constexpr size_t WS_WBR = WS_WG + (size_t)4096 * D * 2;
constexpr size_t WS_WOUT = WS_WBR + (size_t)4 * 1024 * 256 * 2;
constexpr size_t WS_XG = 25 * MiB;
constexpr size_t WS_BIG = 57 * MiB;
constexpr size_t WS_Y = 185 * MiB;
constexpr size_t WS_WUP = WS_Y, WS_WDN = WS_Y + 8 * MiB;
constexpr size_t WS_MG = 217 * MiB;
constexpr size_t WS_MASK = WS_MG, WS_STATE = WS_MG + 8 * MiB;
constexpr size_t WS_END = 249 * MiB;
constexpr int STATE_STRIDE = 4224;
static_assert(WS_WOUT + (size_t)D * D * 2 <= WS_XG && WS_STATE + (size_t)512 * STATE_STRIDE * 4 <= WS_END && WS_END <= 256 * MiB, "d_ws map");

constexpr size_t OUT_X8 = 0;
constexpr size_t OUT_WG8 = 16 * MiB;
constexpr float WG8_SCALE = 64.f;
constexpr int LDS_BYTES = 155648;

__device__ __forceinline__ float bf2f(bf16_t v) { return __uint_as_float((unsigned)v << 16); }
__device__ __forceinline__ unsigned f2bf(float f) { unsigned u = __float_as_uint(f); return (u + 0x7fffu + ((u >> 16) & 1u)) >> 16; }
__device__ __forceinline__ unsigned pk2(float lo, float hi) { return f2bf(lo) | (f2bf(hi) << 16); }
typedef __bf16 bf16x2_t __attribute__((ext_vector_type(2)));
__device__ __forceinline__ unsigned cvt_pk_bf16(float lo, float hi) { const f32x2 v = {lo, hi}; return __builtin_bit_cast(unsigned, __builtin_convertvector(v, bf16x2_t)); }
__device__ __forceinline__ unsigned pk4_fp8(float a, float b, float c, float d) { int w = __builtin_amdgcn_cvt_pk_fp8_f32(a, b, 0, false); w = __builtin_amdgcn_cvt_pk_fp8_f32(c, d, w, true); return (unsigned)w; }
__device__ __forceinline__ float lo_bf(unsigned w) { return __uint_as_float(w << 16); }
__device__ __forceinline__ float hi_bf(unsigned w) { return __uint_as_float(w & 0xffff0000u); }
__device__ __forceinline__ float wave_sum(float v) {
#pragma unroll
    for (int o = 1; o < 64; o <<= 1) v += __shfl_xor(v, o);
    return v;
}
__device__ __forceinline__ float wave_max(float v) {
#pragma unroll
    for (int o = 1; o < 64; o <<= 1) v = fmaxf(v, __shfl_xor(v, o));
    return v;
}
__device__ __forceinline__ int wave_sum_i(int v) {
#pragma unroll
    for (int o = 1; o < 64; o <<= 1) v += __shfl_xor(v, o);
    return v;
}
__device__ __forceinline__ float sigmoid_f(float x) { return __builtin_amdgcn_rcpf(1.f + __builtin_amdgcn_exp2f(-1.4426950408889634f * x)); }
__device__ __forceinline__ float gelu_tanh_f(float x) { const float u = 0.7978845608028654f * (x + 0.044715f * x * x * x); return x * __builtin_amdgcn_rcpf(1.f + __builtin_amdgcn_exp2f(-2.8853900817779268f * u)); }
__device__ __forceinline__ float relu_f(float x) { const int b = __builtin_bit_cast(int, x); return __builtin_bit_cast(float, b > 0 ? b : 0); }
__device__ __forceinline__ unsigned fkey(float s) { const unsigned u = __float_as_uint(s); return (u & 0x80000000u) ? ~u : (u | 0x80000000u); }

__device__ __forceinline__ void st16(void* p, const u32x4 v, const bool wt) { if (wt) asm volatile("global_store_dwordx4 %0, %1, off sc1\n\ts_nop 1" :: "v"(p), "v"(v) : "memory"); else *(u32x4*)p = v; }

namespace pg8 {
constexpr int BM = 256, BK = 64, HALF = 128, HTB = HALF * BK * 2, STAGE_BYTES = 8 * HTB, NXCD = 8, WGM = 8, RS_OFF = STAGE_BYTES;
__host__ __device__ __forceinline__ int lds_byte(int r, int c) { const int st = (r >> 4) * 2 + (c >> 5), rr = r & 15, cc = c & 31, ob = rr * 64 + cc * 2; return st * 1024 + (ob ^ (((ob >> 9) & 1) << 5)); }
__host__ __device__ __forceinline__ void stage_rc(int b, int& R, int& C) { const int st = b / 1024, sb = b % 1024, swz = sb ^ (((sb >> 9) & 1) << 5); R = (st >> 1) * 16 + swz / 64; C = (st & 1) * 32 + (swz % 64) / 2; }
__host__ __device__ __forceinline__ int perm32(int rho) { const int n = rho >> 4, i = rho & 15; return 8 * (i >> 2) + 4 * n + (i & 3); }

struct Unit { int pm, pn, z; };
template <int K_, int LDA_, int LDB_, unsigned APM_, unsigned AZ_, unsigned BPN_, unsigned BZ_, int ESZ_ = 2> struct Gemm {
    const void* A; const void* Bt;
    static constexpr int K = K_, lda = LDA_, ldb = LDB_, esz = ESZ_; static constexpr unsigned aPm = APM_, aZ = AZ_, bPn = BPN_, bZ = BZ_;
};
template <class G> __device__ __forceinline__ const char* pa(const G& g, const Unit& u) { return (const char*)g.A + (size_t)((unsigned)u.pm * G::aPm + (unsigned)u.z * G::aZ); }
template <class G> __device__ __forceinline__ const char* pb(const G& g, const Unit& u) { return (const char*)g.Bt + (size_t)((unsigned)u.pn * G::bPn + (unsigned)u.z * G::bZ); }

struct StaticOrder {
    int nM, nN, nwg, G, c;
    __host__ __device__ void init(int M_, int N_, int G_, int c_) { nM = M_ / BM; nN = N_ / BM; nwg = nM * nN; G = G_; c = c_; }
    __host__ __device__ bool next(int i, Unit& u) const {
        const long L = (long)i * G + c; if (L >= nwg) return false;
        int wgid = (int)L; { const int q = nwg / NXCD, r = nwg % NXCD, xcd = wgid % NXCD, off = wgid / NXCD; wgid = (xcd < r ? xcd * (q + 1) : r * (q + 1) + (xcd - r) * q) + off; }
        const int nig = WGM * nN, gid = wgid / nig, fm = gid * WGM, gsz = (nM - fm) < WGM ? (nM - fm) : WGM;
        u.pm = fm + ((wgid % nig) % gsz); u.pn = (wgid % nig) / gsz; u.z = 0; return true;
    }
};
template <int MODE> struct SuperOrder {
    StaticOrder so;
    __host__ __device__ void init(int G_, int c_) { so.init(M, 1024, G_, c_); }
    __host__ __device__ bool next(int i, Unit& u) const {
        Unit b; if (!so.next(i >> 2, b)) return false;
        const int sub = i & 3; u.pm = b.pm; if (MODE == 0) { u.pn = b.pn; u.z = sub; } else { u.pn = 4 * b.pn + sub; u.z = 0; } return true;
    }
};

template <class Epi, class Sched, bool ALIGN_EPI, class GemmT>
__device__ __forceinline__ void gemm_phase(LAS unsigned char* lds, const GemmT g, const Sched& S, const Epi& E, const int tid) {
    const int wid = __builtin_amdgcn_readfirstlane(tid >> 6), lane = tid & 63, wr = wid >> 2, wc = wid & 3, fr = lane & 15, fq = lane >> 4;
    constexpr int K = GemmT::K, ESZ = GemmT::esz, nt = K * ESZ / (BK * 2);
    unsigned voffA[2], voffB[2];
#pragma unroll
    for (int i = 0; i < 2; ++i) { int R, C; stage_rc(tid * 16 + i * 8192, R, C); const int Rb = Epi::PERM ? ((R & ~31) + perm32(R & 31)) : R;
        voffA[i] = (unsigned)(R * GemmT::lda * ESZ + C * 2); voffB[i] = (unsigned)(Rb * GemmT::ldb * ESZ + C * 2); }
    const size_t kstep = (size_t)(BK * 2);
    constexpr size_t hA = (size_t)HALF * GemmT::lda * ESZ, hB = (size_t)HALF * GemmT::ldb * ESZ;
    const unsigned ldsw = (unsigned)wid * 1024u;
    constexpr int FCOL = (ESZ == 2) ? 8 : 16, KOFF = (ESZ == 2) ? 1024 : 16;
    const int aoff = lds_byte(wr * 64 + fr, fq * FCOL), boff = lds_byte(wc * 32 + fr, fq * FCOL);
    int one_scale = 0x7f7f7f7f; asm volatile("" : "+v"(one_scale));
#define PG8_SA(b, h) (((b) * 2 + (h)) * HTB)
#define PG8_SB(b, h) ((4 + (b) * 2 + (h)) * HTB)
#define PG8_STAGE(bufoff, gbase, voff) do { _Pragma("unroll") for (int _i = 0; _i < 2; ++_i) \
        __builtin_amdgcn_global_load_lds((const unsigned*)((const char*)(gbase) + (voff)[_i]), (LAS unsigned*)(lds + (bufoff) + ldsw + _i * 8192), 16, 0, 0); } while (0)
#define PG8_LDA(dst, b, h) do { _Pragma("unroll") for (int m = 0; m < 4; ++m) _Pragma("unroll") for (int k = 0; k < 2; ++k) dst[m][k] = *(const LAS bf16x8*)(lds + PG8_SA(b, h) + aoff + m * 2048 + k * KOFF); } while (0)
#define PG8_LDB(dst, b, h) do { _Pragma("unroll") for (int n = 0; n < 2; ++n) _Pragma("unroll") for (int k = 0; k < 2; ++k) dst[n][k] = *(const LAS bf16x8*)(lds + PG8_SB(b, h) + boff + n * 2048 + k * KOFF); } while (0)
#define PG8_MMA(ai, bj, At, Bt) do { __builtin_amdgcn_s_setprio(1); _Pragma("unroll") for (int m = 0; m < 4; ++m) _Pragma("unroll") for (int n = 0; n < 2; ++n) { \
        if constexpr (ESZ == 2) { _Pragma("unroll") for (int k = 0; k < 2; ++k) acc[ai][bj][m][n] = __builtin_amdgcn_mfma_f32_16x16x32_bf16(Bt[n][k], At[m][k], acc[ai][bj][m][n], 0, 0, 0); } \
        else { const i32x8 a8_ = __builtin_shufflevector(__builtin_bit_cast(i32x4, At[m][0]), __builtin_bit_cast(i32x4, At[m][1]), 0, 1, 2, 3, 4, 5, 6, 7), b8_ = __builtin_shufflevector(__builtin_bit_cast(i32x4, Bt[n][0]), __builtin_bit_cast(i32x4, Bt[n][1]), 0, 1, 2, 3, 4, 5, 6, 7); \
              \
            asm volatile("v_mfma_scale_f32_16x16x128_f8f6f4 %0, %1, %2, %0, %3, %3 op_sel_hi:[0,0,0]" : "+v"(acc[ai][bj][m][n]) : "v"(b8_), "v"(a8_), "v"(one_scale)); } } \
        __builtin_amdgcn_s_setprio(0); } while (0)
#define PG8_WAIT_V(n) asm volatile("s_waitcnt vmcnt(" #n ")" ::: "memory")
#define PG8_WAIT_L(n) asm volatile("s_waitcnt lgkmcnt(" #n ")" ::: "memory")
#define PG8_BAR __builtin_amdgcn_s_barrier()
#define PG8_SCHED __builtin_amdgcn_sched_barrier(0)
#define PG8_WAIT_VN(n) asm volatile("s_waitcnt vmcnt(%0)" :: "n"(n) : "memory")
    constexpr int RSN = Epi::RS ? 1 : 0, WN1 = 8 + RSN, WN2 = 8 + RSN + Epi::VM_MIN;
#define PG8_WAIT_SEL do { if (wsel == 0) PG8_WAIT_V(8); else if (wsel == 1) PG8_WAIT_VN(WN1); else PG8_WAIT_VN(WN2); } while (0)
#define PG8_RS(slot, pm_) do { if constexpr (Epi::RS) { int l2_ = lane; asm volatile("" : "+v"(l2_));     \
        __builtin_amdgcn_global_load_lds((const unsigned*)(E.ssq + (pm_) * 256 + (wid & 3) * 64 + l2_), (LAS unsigned*)(lds + RS_OFF + (slot) * 1024 + (wid & 3) * 256), 4, 0, 0); } } while (0)
    Unit cur, nxt; int ui = 0;
    if (!S.next(0, cur)) return;
    f32x4 acc[2][2][4][2];
#pragma unroll
    for (int a = 0; a < 2; ++a)
#pragma unroll
        for (int b = 0; b < 2; ++b)
#pragma unroll
            for (int m = 0; m < 4; ++m)
#pragma unroll
                for (int n = 0; n < 2; ++n) acc[a][b][m][n] = (f32x4){0.f, 0.f, 0.f, 0.f};
    bf16x8 At[4][2], B0[2][2], B1[2][2];
    const char* cA = pa(g, cur); const char* cB = pb(g, cur);
    PG8_RS(0, cur.pm);
    PG8_STAGE(PG8_SB(0, 0), cB, voffB); PG8_STAGE(PG8_SB(0, 1), cB + hB, voffB); PG8_STAGE(PG8_SA(0, 0), cA, voffA); PG8_STAGE(PG8_SA(0, 1), cA + hA, voffA);
    if (wr == 1) PG8_BAR;
    PG8_WAIT_V(2); PG8_BAR;
    PG8_STAGE(PG8_SB(1, 0), cB + kstep, voffB); PG8_STAGE(PG8_SA(1, 0), cA + kstep, voffA); PG8_STAGE(PG8_SB(1, 1), cB + hB + kstep, voffB);
    PG8_WAIT_V(6); PG8_BAR;
    int wsel = 0;
    for (;;) {
        const bool has_next = S.next(ui + 1, nxt);
        const char* nA = has_next ? pa(g, nxt) : cA; const char* nB = has_next ? pb(g, nxt) : cB;
        asm volatile(".p2align 8");
#pragma unroll 1
        for (int t = 0; t < nt; t += 2) {
            const bool last = (t == nt - 2);
            const char* a1 = cA + (size_t)(t + 1) * kstep;
            const char* a2 = last ? nA : cA + (size_t)(t + 2) * kstep; const char* b2 = last ? nB : cB + (size_t)(t + 2) * kstep;
            const char* a3 = a2 + kstep; const char* b3 = b2 + kstep;
            PG8_LDB(B0, 0, 0); PG8_LDB(B1, 0, 1); PG8_SCHED; PG8_LDA(At, 0, 0); if (wsel == 0) PG8_STAGE(PG8_SA(1, 1), a1 + hA, voffA);
            PG8_WAIT_SEL; PG8_WAIT_L(0); PG8_BAR; PG8_MMA(0, 0, At, B0); PG8_MMA(0, 1, At, B1); PG8_BAR; PG8_SCHED;
            PG8_LDA(At, 0, 1); PG8_STAGE(PG8_SB(0, 0), b2, voffB); PG8_STAGE(PG8_SB(0, 1), b2 + hB, voffB); PG8_STAGE(PG8_SA(0, 0), a2, voffA);
            PG8_WAIT_SEL; PG8_WAIT_L(0); PG8_BAR; PG8_MMA(1, 0, At, B0); PG8_MMA(1, 1, At, B1); PG8_BAR; PG8_SCHED;
            PG8_LDB(B0, 1, 0); PG8_LDB(B1, 1, 1); PG8_SCHED; PG8_LDA(At, 1, 0); PG8_STAGE(PG8_SA(0, 1), a2 + hA, voffA);
            PG8_WAIT_SEL; PG8_WAIT_L(0); PG8_BAR; PG8_MMA(0, 0, At, B0); PG8_MMA(0, 1, At, B1); PG8_BAR; PG8_SCHED;
            PG8_LDA(At, 1, 1); PG8_STAGE(PG8_SB(1, 0), b3, voffB); PG8_STAGE(PG8_SB(1, 1), b3 + hB, voffB); PG8_STAGE(PG8_SA(1, 0), a3, voffA);
            PG8_WAIT_V(8); PG8_WAIT_L(0); PG8_BAR; PG8_MMA(1, 0, At, B0); PG8_MMA(1, 1, At, B1); PG8_BAR; PG8_SCHED;
            wsel = 0;
        }
        if (has_next) { PG8_STAGE(PG8_SA(1, 1), nA + kstep + hA, voffA); PG8_RS((ui + 1) & 1, nxt.pm); }
        asm volatile("" ::: "memory"); PG8_SCHED;
        if constexpr (ALIGN_EPI) { if (wr == 0) PG8_BAR; }
        int eops;
        { int fr2 = fr, fq2 = fq; asm volatile("" : "+v"(fr2), "+v"(fq2)); eops = E(acc, cur, wr, wc, fr2, fq2, (const LAS float*)(lds + RS_OFF + (ui & 1) * 1024), !has_next); }
        if (!has_next) break;
        wsel = (eops >= Epi::VM_MIN) ? 2 : 1;
#pragma unroll
        for (int a = 0; a < 2; ++a)
#pragma unroll
            for (int b = 0; b < 2; ++b)
#pragma unroll
                for (int m = 0; m < 4; ++m)
#pragma unroll
                    for (int n = 0; n < 2; ++n) acc[a][b][m][n] = (f32x4){0.f, 0.f, 0.f, 0.f};
        cur = nxt; cA = nA; cB = nB; ++ui;
        if constexpr (ALIGN_EPI) { if (wr == 1) PG8_BAR; }
    }
    PG8_WAIT_V(0);
    if constexpr (!ALIGN_EPI) { if (wr == 0) PG8_BAR; }
    PG8_BAR;
#undef PG8_SA
#undef PG8_SB
#undef PG8_STAGE
#undef PG8_LDA
#undef PG8_LDB
#undef PG8_MMA
#undef PG8_WAIT_V
#undef PG8_WAIT_VN
#undef PG8_WAIT_SEL
#undef PG8_RS
#undef PG8_WAIT_L
#undef PG8_BAR
#undef PG8_SCHED
}
}
namespace epi {
using pg8::Unit;
typedef f32x4 Acc[2][2][4][2];

__device__ __forceinline__ float row_scale(const float* rs, int row) { return rs[row]; }
__device__ __forceinline__ u32x4 pack8(const f32x4 a, const f32x4 b) { u32x4 w; w.x = cvt_pk_bf16(a[0], a[1]); w.y = cvt_pk_bf16(a[2], a[3]); w.z = cvt_pk_bf16(b[0], b[1]); w.w = cvt_pk_bf16(b[2], b[3]); return w; }

struct EpiProj {
    static constexpr bool PERM = true, RS = true; static constexpr int VM_MIN = 16;
    bf16_t* P; float* misc; const float* ssq; const float* cs; const float* sn; const float* gt;     bf16_t* VT;     bf16_t* KI;     bf16_t* CVT;     float* ssqv;
    __device__ __forceinline__ int operator()(const Acc& acc, const Unit& u, int wr, int wc, int fr, int fq, const LAS float* rsl, const bool lastu) const {
        const int T = u.pn; const int row0 = u.pm * 256 + wr * 64 + fr;
        float rsv[8];
#pragma unroll
        for (int i = 0; i < 8; ++i) rsv[i] = rsl[wr * 64 + fr + (i >> 2) * 128 + (i & 3) * 16];
        if (T == 2 || T == 3 || T == 5 || T == 6 || T == 14) {
            if (T == 14 && wc >= 2) return 0;
            if (T == 14 && wc == 1) {
                if (fq < 2) {
#pragma unroll
                    for (int ai = 0; ai < 2; ++ai)
#pragma unroll
                        for (int m = 0; m < 4; ++m) { const int row = row0 + ai * 128 + m * 16; const float rs = rsv[ai * 4 + m];
                            float* mp = misc + (size_t)row * 16 + 8 * fq; *(f32x4*)mp = acc[ai][0][m][0] * rs; *(f32x4*)(mp + 4) = acc[ai][0][m][1] * rs; }
                }
                return 16;
            }
            const int mode = (T == 14) ? 2 : (T <= 3 ? 1 : 0);
            const float* gp = gt + 64 * ((T == 2) ? 0 : (T == 3) ? 1 : 2);
            f32x4 g1[2], g2[2];
#pragma unroll
            for (int n = 0; n < 2; ++n) { if (mode) { g1[n] = *(const f32x4*)(gp + 8 * fq + 4 * n); g2[n] = *(const f32x4*)(gp + 32 + 8 * fq + 4 * n); } else { g1[n] = (f32x4){1.f, 1.f, 1.f, 1.f}; g2[n] = g1[n]; } }
#pragma unroll
            for (int ai = 0; ai < 2; ++ai) {
#pragma unroll
                for (int m = 0; m < 4; ++m) {
                    const int row = row0 + ai * 128 + m * 16; const float rs = rsv[ai * 4 + m];
                    f32x4 x1[2], x2[2];
#pragma unroll
                    for (int n = 0; n < 2; ++n) { x1[n] = acc[ai][0][m][n] * rs; x2[n] = acc[ai][1][m][n] * rs; }
                    if (mode == 2) {
                        float s = 0.f;
#pragma unroll
                        for (int n = 0; n < 2; ++n) s += (x1[n][0] + x1[n][1]) + (x1[n][2] + x1[n][3]) + (x2[n][0] + x2[n][1]) + (x2[n][2] + x2[n][3]);
                        s += __shfl_xor(s, 16); s += __shfl_xor(s, 32); const float mu = s * (1.f / 64.f);
#pragma unroll
                        for (int n = 0; n < 2; ++n) { x1[n] = x1[n] - mu; x2[n] = x2[n] - mu; }
                    }
                    if (mode) {
                        float q = 0.f;
#pragma unroll
                        for (int n = 0; n < 2; ++n) { const f32x4 a = x1[n] * x1[n], b = x2[n] * x2[n]; q += (a[0] + a[1]) + (a[2] + a[3]) + (b[0] + b[1]) + (b[2] + b[3]); }
                        q += __shfl_xor(q, 16); q += __shfl_xor(q, 32); const float rr = rsqrtf(q * (1.f / 64.f) + EPS);
#pragma unroll
                        for (int n = 0; n < 2; ++n) { x1[n] = x1[n] * rr * g1[n]; x2[n] = x2[n] * rr * g2[n]; }
                        if (T == 2) {
#pragma unroll
                            for (int n = 0; n < 2; ++n) { x1[n] = x1[n] * (0.125f * 1.4426950408889634f); x2[n] = x2[n] * (0.125f * 1.4426950408889634f); } }
                    }
                    f32x4 o1[2], o2[2];
#pragma unroll
                    for (int n = 0; n < 2; ++n) { const int pos = row & (S - 1); const f32x4 c = *(const f32x4*)(cs + (size_t)pos * 32 + 8 * fq + 4 * n), s = *(const f32x4*)(sn + (size_t)pos * 32 + 8 * fq + 4 * n);
                        o1[n] = x1[n] * c - x2[n] * s; o2[n] = x2[n] * c + x1[n] * s; }
                    bf16_t* op = P + (size_t)row * PW + 256 * T + 64 * wc + 8 * fq;
                    *(u32x4*)op = pack8(o1[0], o1[1]); *(u32x4*)(op + 32) = pack8(o2[0], o2[1]);
                    if (T == 14) {
                        bf16_t* kp = KI + ((size_t)((row >> 5) * 4 + (fq >> 1)) * 64 + (fq & 1) * 32 + (row & 31)) * 8; *(u32x4*)kp = pack8(o1[0], o1[1]); *(u32x4*)(kp + 2 * 64 * 8) = pack8(o2[0], o2[1]); }
                }
            }
            return 16;
        }
        const int act = (T <= 1) ? 1 : 0; const float sc = (T == 8) ? 0.125f : 1.0f;
#pragma unroll
        for (int ai = 0; ai < 2; ++ai)
#pragma unroll
            for (int m = 0; m < 4; ++m) {
                const int row = row0 + ai * 128 + m * 16; const float rs = rsv[ai * 4 + m] * sc;
                bf16_t* op = P + (size_t)row * PW + 256 * T + 32 * wc + 8 * fq; float qv = 0.f;
#pragma unroll
                for (int bj = 0; bj < 2; ++bj) { f32x4 v0 = acc[ai][bj][m][0] * rs, v1 = acc[ai][bj][m][1] * rs;
                    if (act) {
#pragma unroll
                        for (int e = 0; e < 4; ++e) { v0[e] = gelu_tanh_f(v0[e]); v1[e] = gelu_tanh_f(v1[e]); }
                        const f32x4 a2 = v0 * v0, b2 = v1 * v1; qv += ((a2[0] + a2[1]) + (a2[2] + a2[3])) + ((b2[0] + b2[1]) + (b2[2] + b2[3])); }
                    *(u32x4*)(op + bj * 128) = pack8(v0, v1);
                    if (T == 4 || T == 9) { bf16_t* vp = (T == 4 ? VT : CVT) + ((size_t)((row >> 12) * 256 + bj * 128 + 32 * wc + 8 * fq)) * S + (row & (S - 1));
#pragma unroll
                        for (int e = 0; e < 4; ++e) { vp[(size_t)e * S] = (bf16_t)f2bf(v0[e]); vp[(size_t)(4 + e) * S] = (bf16_t)f2bf(v1[e]); } } }
                if (T == 1) { qv += __shfl_xor(qv, 16); qv += __shfl_xor(qv, 32); if (fq == 0) ssqv[(size_t)row * 4 + wc] = qv; }
            }
        return 16;
    }
};

struct EpiPlain {
    static constexpr bool PERM = true, RS = false; static constexpr int VM_MIN = 16;
    bf16_t* O; int ldc; int zcols;
    __device__ __forceinline__ int operator()(const Acc& acc, const Unit& u, int wr, int wc, int fr, int fq, const LAS float*, const bool lastu) const {
        const int row0 = u.pm * 256 + wr * 64 + fr; const int col0 = u.z * zcols + u.pn * 256 + 32 * wc + 8 * fq;
#pragma unroll
        for (int ai = 0; ai < 2; ++ai)
#pragma unroll
            for (int m = 0; m < 4; ++m) { bf16_t* op = O + (size_t)(row0 + ai * 128 + m * 16) * ldc + col0;
#pragma unroll
                for (int bj = 0; bj < 2; ++bj) *(u32x4*)(op + bj * 128) = pack8(acc[ai][bj][m][0], acc[ai][bj][m][1]); }
        return 16;
    }
};

struct EpiGate {
    static constexpr bool PERM = true, RS = true; static constexpr int VM_MIN = 40;
    bf16_t* MG; const bf16_t* BR; const float* ssq;
    __device__ __forceinline__ int operator()(const Acc& acc, const Unit& u, int wr, int wc, int fr, int fq, const LAS float* rsl, const bool lastu) const {
        const int row0 = u.pm * 256 + wr * 64 + fr; const int ch0 = u.pn * 64 + 16 * wc + 4 * fq;
        float rsv[8];
#pragma unroll
        for (int i = 0; i < 8; ++i) rsv[i] = rsl[wr * 64 + fr + (i >> 2) * 128 + (i & 3) * 16] * (1.0f / WG8_SCALE);
#pragma unroll
        for (int ai = 0; ai < 2; ++ai) {
            u32x2 bw[4][4];
#pragma unroll
            for (int m = 0; m < 4; ++m)
#pragma unroll
                for (int nb = 0; nb < 4; ++nb) bw[m][nb] = *(const u32x2*)(BR + (size_t)(row0 + ai * 128 + m * 16) * 4096 + ch0 + nb * 1024);
#pragma unroll
            for (int m = 0; m < 4; ++m) {
                const int row = row0 + ai * 128 + m * 16; const float rs = rsv[ai * 4 + m]; f32x4 o = (f32x4){0.f, 0.f, 0.f, 0.f};
#pragma unroll
                for (int bj = 0; bj < 2; ++bj)
#pragma unroll
                    for (int n = 0; n < 2; ++n) { const u32x2 w = bw[m][2 * bj + n]; const f32x4 a = acc[ai][bj][m][n] * rs;
                        o[0] += sigmoid_f(a[0]) * lo_bf(w.x); o[1] += sigmoid_f(a[1]) * hi_bf(w.x); o[2] += sigmoid_f(a[2]) * lo_bf(w.y); o[3] += sigmoid_f(a[3]) * hi_bf(w.y); }
                u32x2 ow; ow.x = cvt_pk_bf16(o[0], o[1]); ow.y = cvt_pk_bf16(o[2], o[3]);
                *(u32x2*)(MG + (size_t)row * 1024 + ch0) = ow;
            }
        }
        return 40;
    }
};

struct EpiResid {
    static constexpr bool PERM = true, RS = false; static constexpr int VM_MIN = 0;
    const float* resf; bf16_t* X; float* outf; float* ssq; unsigned char* x8;
    __device__ __forceinline__ int operator()(const Acc& acc, const Unit& u, int wr, int wc, int fr, int fq, const LAS float*, const bool lastu) const {
        const int row0 = u.pm * 256 + wr * 64 + fr; const int col0 = u.pn * 256 + 32 * wc + 8 * fq;
#pragma unroll
        for (int ai = 0; ai < 2; ++ai) {
            f32x4 r[4][2][2];
            if (resf) {
#pragma unroll
                for (int m = 0; m < 4; ++m)
#pragma unroll
                    for (int bj = 0; bj < 2; ++bj) { const float* rp = resf + (size_t)(row0 + ai * 128 + m * 16) * 1024 + col0 + bj * 128; r[m][bj][0] = *(const f32x4*)rp; r[m][bj][1] = *(const f32x4*)(rp + 4); }
            } else {
                u32x4 w[4][2];
#pragma unroll
                for (int m = 0; m < 4; ++m)
#pragma unroll
                    for (int bj = 0; bj < 2; ++bj) w[m][bj] = *(const u32x4*)(X + (size_t)(row0 + ai * 128 + m * 16) * 1024 + col0 + bj * 128);
#pragma unroll
                for (int m = 0; m < 4; ++m)
#pragma unroll
                    for (int bj = 0; bj < 2; ++bj) { const u32x4 q = w[m][bj]; r[m][bj][0] = (f32x4){lo_bf(q.x), hi_bf(q.x), lo_bf(q.y), hi_bf(q.y)}; r[m][bj][1] = (f32x4){lo_bf(q.z), hi_bf(q.z), lo_bf(q.w), hi_bf(q.w)}; }
            }
#pragma unroll
            for (int m = 0; m < 4; ++m) {
                const int row = row0 + ai * 128 + m * 16; const size_t off = (size_t)row * 1024 + col0; float q = 0.f;
#pragma unroll
                for (int bj = 0; bj < 2; ++bj) {
                    const f32x4 x0 = r[m][bj][0] + acc[ai][bj][m][0], x1 = r[m][bj][1] + acc[ai][bj][m][1];
                    if (outf) { *(f32x4*)(outf + off + bj * 128) = x0; *(f32x4*)(outf + off + bj * 128 + 4) = x1; }
                    else {
                        const f32x4 a = x0 * x0, b = x1 * x1; q += ((a[0] + a[1]) + (a[2] + a[3])) + ((b[0] + b[1]) + (b[2] + b[3]));
                        *(u32x4*)(X + off + bj * 128) = pack8(x0, x1);
                        if (x8) { u32x2 q8; q8.x = pk4_fp8(x0[0], x0[1], x0[2], x0[3]); q8.y = pk4_fp8(x1[0], x1[1], x1[2], x1[3]); *(u32x2*)(x8 + off + bj * 128) = q8; } }
                }
                if (!outf) { q += __shfl_xor(q, 16); q += __shfl_xor(q, 32); if (fq == 0) ssq[(size_t)row * 16 + 4 * u.pn + wc] = q; }
            }
        }
        return 0;
    }
};

struct EpiUp {
    static constexpr bool PERM = true, RS = true; static constexpr int VM_MIN = 16;
    bf16_t* H; const float* ssq;
    __device__ __forceinline__ int operator()(const Acc& acc, const Unit& u, int wr, int wc, int fr, int fq, const LAS float* rsl, const bool lastu) const {
        const int row0 = u.pm * 256 + wr * 64 + fr; const int col0 = u.pn * 256 + 32 * wc + 8 * fq;
        float rsv[8];
#pragma unroll
        for (int i = 0; i < 8; ++i) rsv[i] = rsl[wr * 64 + fr + (i >> 2) * 128 + (i & 3) * 16];
#pragma unroll
        for (int ai = 0; ai < 2; ++ai)
#pragma unroll
            for (int m = 0; m < 4; ++m) { const int row = row0 + ai * 128 + m * 16; const float rs = rsv[ai * 4 + m]; bf16_t* op = H + (size_t)row * FF + col0;
#pragma unroll
                for (int bj = 0; bj < 2; ++bj) { f32x4 v0 = acc[ai][bj][m][0] * rs, v1 = acc[ai][bj][m][1] * rs;
#pragma unroll
                    for (int e = 0; e < 4; ++e) { v0[e] = relu_f(v0[e]); v1[e] = relu_f(v1[e]); }
                    st16(op + bj * 128, pack8(v0 * v0, v1 * v1), lastu); } }
        return 16;
    }
};
}
struct Args {
    const float* in[18]; float* out; unsigned char* ws; int ph_lo, ph_hi; int coop, pad;
};
struct Frame { LAS unsigned char* lds; int tid, wave, G, vcu; };
constexpr int PTR_OFF = LDS_BYTES - 512;
enum { I_X = 0, I_LN_MIX, I_W_IN, I_SGU_NORM, I_SGU_W, I_SGU_B, I_Q_NORM, I_K_NORM, I_KIDX_NORM, I_I_BIAS, I_F_BIAS, I_MNORM, I_CONV_W, I_W_BRANCH, I_W_OUT, I_LN_MLP, I_W_UP, I_W_DOWN, I_OUT, I_WS };
__device__ __forceinline__ unsigned char* ptr_at(const Frame& F, int i) { const LAS unsigned* p = (const LAS unsigned*)(F.lds + PTR_OFF) + 2 * i;
    const unsigned lo = __builtin_amdgcn_readfirstlane(p[0]), hi = __builtin_amdgcn_readfirstlane(p[1]);
    typedef __attribute__((address_space(1))) unsigned char* gptr_t;
    return (unsigned char*)(gptr_t)(((unsigned long long)hi << 32) | lo); }
#define INP(i) ((const float*)ptr_at(F, (i)))
#define WSP(off) (ptr_at(F, I_WS) + (off))
constexpr size_t WS_GT = 512 * 1024;
constexpr size_t WS_RSA = 256 * 1024, WS_RSB = 320 * 1024;
__device__ __forceinline__ size_t maskt_idx(int m, int w) { const int b = m >> 12, t = m & (S - 1); return ((size_t)(b * 64 + (w >> 1)) * S + t) * 2 + (w & 1); }


#define XB_TMO      128
#define XB_XCNT(j)  (256  + 64 * (j))
#define XB_XSUB(j)  (1280 + 64 * (j))
#define XB_XGEN(j)  (2304 + 64 * (j))
#define XB_TOP      3328
#define XB_TOPGEN   3392
#define XCD_BAR_WORDS 3456
#define XB_SPIN_CAP (1u << 22)
constexpr size_t WS_BAR = 64 * 1024;
constexpr size_t CTL_ZERO_BYTES = 128 * 1024;
__device__ __forceinline__ unsigned xb_ld(unsigned* p)              { return __hip_atomic_load(p, __ATOMIC_RELAXED, __HIP_MEMORY_SCOPE_AGENT); }
__device__ __forceinline__ unsigned xb_add(unsigned* p, unsigned v) { return __hip_atomic_fetch_add(p, v, __ATOMIC_RELAXED, __HIP_MEMORY_SCOPE_AGENT); }
__device__ __forceinline__ unsigned xb_xcc_id() { return (unsigned)__builtin_amdgcn_s_getreg((3 << 11) | 20) & 0xFu; }
#define XB_SPIN(cond, bar) do { unsigned _sp = 0; while (cond) { __builtin_amdgcn_s_sleep(1); \
    if ((++_sp & 255u) == 0u) { if (xb_ld(&(bar)[XB_TMO])) break; if (_sp > XB_SPIN_CAP) { atomicAdd(&(bar)[XB_TMO], 1u); break; } } } } while (0)
struct XcdBarrier { unsigned* bar; unsigned x; volatile LAS unsigned* st; };
__device__ __forceinline__ XcdBarrier xcd_barrier_post(unsigned* bar, volatile LAS unsigned* st) {
    XcdBarrier b; b.bar = bar; b.x = xb_xcc_id(); b.st = st;
    if (threadIdx.x == 0) (void)xb_add(&bar[XB_XCNT(b.x)], 1u);
    return b;
}
__device__ __forceinline__ void xcd_barrier_complete(unsigned* bar, unsigned x, unsigned& nloc, unsigned& nx) {
    const unsigned G = gridDim.x * gridDim.y * gridDim.z;
    unsigned sum, cnt, mine, sp = 0u;
    for (;;) {
        sum = 0u; cnt = 0u; mine = 0u;
#pragma unroll
        for (unsigned j = 0; j < 16; ++j) { const unsigned c = xb_ld(&bar[XB_XCNT(j)]); sum += c; cnt += (c > 0u) ? 1u : 0u; mine = (j == x) ? c : mine; }
        if (sum == G) break;
        __builtin_amdgcn_s_sleep(1);
        if ((++sp & 255u) == 0u) { if (xb_ld(&bar[XB_TMO])) break; if (sp > XB_SPIN_CAP) { atomicAdd(&bar[XB_TMO], 1u); break; } }
    }
    nloc = mine > 0u ? mine : 1u; nx = cnt > 0u ? cnt : 1u;
}
__device__ __forceinline__ void xcd_barrier(const XcdBarrier& b) {
    asm volatile("s_waitcnt vmcnt(0)" ::: "memory");
    __syncthreads();
    if (threadIdx.x == 0) {
        unsigned* bar = b.bar;
        __builtin_amdgcn_s_waitcnt(0);
        unsigned nloc = b.st[0], nx = b.st[1];
        if (nloc == 0u) { xcd_barrier_complete(bar, b.x, nloc, nx); b.st[0] = nloc; b.st[1] = nx; }
        const unsigned old = xb_add(&bar[XB_XSUB(b.x)], 1u);
        const unsigned gen = old / nloc;
        if (old + 1u == (gen + 1u) * nloc) {
            __builtin_amdgcn_fence(__ATOMIC_RELEASE, "agent");
            asm volatile("s_waitcnt vmcnt(0)" ::: "memory");
            const unsigned og = xb_add(&bar[XB_TOP], 1u);
            const unsigned tg = og / nx;
            if (og + 1u == (tg + 1u) * nx) xb_add(&bar[XB_TOPGEN], 1u);
            else XB_SPIN(xb_ld(&bar[XB_TOPGEN]) == tg, bar);
            __builtin_amdgcn_fence(__ATOMIC_ACQUIRE, "agent");
            xb_add(&bar[XB_XGEN(b.x)], 1u);
            asm volatile("s_waitcnt vmcnt(0)" ::: "memory");
        } else {
            XB_SPIN(xb_ld(&bar[XB_XGEN(b.x)]) == gen, bar);
            __builtin_amdgcn_fence(__ATOMIC_ACQUIRE, "agent");
            asm volatile("s_waitcnt vmcnt(0)" ::: "memory");
        }
    }
    __syncthreads();
}

__device__ __forceinline__ int win_src(int p) {
    const int T = p >> 8, q = p & 255, bj = q >> 7, wc = (q >> 5) & 3, j = q & 31, hd = 64 * wc + 32 * bj + j;
    switch (T) {
        case 0: return O_AU + q; case 1: return O_AV + q; case 2: return O_BQ + hd; case 3: return O_BK + hd; case 4: return O_BV + q;
        case 5: return O_QI + hd; case 6: return O_QI + 256 + hd; case 7: return O_CQ + q; case 8: return O_CK + q; case 9: return O_CV + q;
        case 10: return O_CO + q; case 11: return O_DB + q; case 12: return O_DC + q; case 13: return O_DX + q;
        default: break;
    }
    if (wc == 0) return O_KI + 32 * bj + j;
    if (wc == 1 && bj == 0 && j < 16) return j < 8 ? O_WI + j : (j < 12 ? O_CI + (j - 8) : O_CF + (j - 12));
    return -1;
}
__device__ __forceinline__ int wg_src(int p) {
    const int pn = p >> 8, q = p & 255, bj = q >> 7, wc = (q >> 5) & 3, fq = (q >> 3) & 3, n = (q >> 2) & 1, e = q & 3;
    return O_G + (2 * bj + n) * 1024 + 64 * pn + 16 * wc + 4 * fq + e;
}
template <int MAP>
__device__ __forceinline__ void conv_item(const float* W, int K, int srcN, bf16_t* WT, LAS float* scr, int item, int nrows, int lane, const float* gain = nullptr) {
    const int nblk = nrows / 32, kb = item / nblk, nb = item % nblk, k0 = 64 * kb, n0 = 32 * nb;
    const int nn = n0 + (lane & 31); const int src = MAP == 0 ? nn : (MAP == 1 ? win_src(nn) : wg_src(nn));
    float wv_[32]; const float* wp_ = W + (size_t)(k0 + (lane >> 5)) * srcN + (src >= 0 ? src : 0);
#pragma unroll
    for (int i = 0; i < 32; ++i) wv_[i] = __builtin_nontemporal_load(wp_ + (size_t)(2 * i) * srcN);
#pragma unroll
    for (int i = 0; i < 32; ++i) scr[(2 * i + (lane >> 5)) * 33 + (lane & 31)] = src >= 0 ? (gain ? wv_[i] * gain[k0 + 2 * i + (lane >> 5)] : wv_[i]) : 0.f;
    asm volatile("s_waitcnt lgkmcnt(0)" ::: "memory");
    const int c = lane & 7;
#pragma unroll
    for (int j = 0; j < 4; ++j) { const int n = (lane >> 3) + 8 * j; const LAS float* s = scr + (8 * c) * 33 + n;
        u32x4 o; o.x = pk2(s[0 * 33], s[1 * 33]); o.y = pk2(s[2 * 33], s[3 * 33]); o.z = pk2(s[4 * 33], s[5 * 33]); o.w = pk2(s[6 * 33], s[7 * 33]);
        *(u32x4*)(WT + (size_t)(n0 + n) * K + k0 + 8 * c) = o; }
    asm volatile("s_waitcnt lgkmcnt(0)" ::: "memory");
}
template <int MAP>
__device__ __forceinline__ void conv_item8(const float* W, int K, int srcN, unsigned char* WT8, LAS float* scr, int item, int nrows, int lane, const float* gain, float scale) {
    const int nblk = nrows / 32, kb = item / nblk, nb = item % nblk, k0 = 64 * kb, n0 = 32 * nb;
    const int nn = n0 + (lane & 31); const int src = MAP == 0 ? nn : (MAP == 1 ? win_src(nn) : wg_src(nn));
    float wv_[32]; const float* wp_ = W + (size_t)(k0 + (lane >> 5)) * srcN + (src >= 0 ? src : 0);
#pragma unroll
    for (int i = 0; i < 32; ++i) wv_[i] = __builtin_nontemporal_load(wp_ + (size_t)(2 * i) * srcN);
#pragma unroll
    for (int i = 0; i < 32; ++i) scr[(2 * i + (lane >> 5)) * 33 + (lane & 31)] = src >= 0 ? wv_[i] * gain[k0 + 2 * i + (lane >> 5)] * scale : 0.f;
    asm volatile("s_waitcnt lgkmcnt(0)" ::: "memory");
    const int c = lane & 7;
#pragma unroll
    for (int j = 0; j < 4; ++j) { const int n = (lane >> 3) + 8 * j; const LAS float* s = scr + (8 * c) * 33 + n;
        u32x2 o; o.x = pk4_fp8(s[0 * 33], s[1 * 33], s[2 * 33], s[3 * 33]); o.y = pk4_fp8(s[4 * 33], s[5 * 33], s[6 * 33], s[7 * 33]);
        *(u32x2*)(WT8 + (size_t)(n0 + n) * K + k0 + 8 * c) = o; }
    asm volatile("s_waitcnt lgkmcnt(0)" ::: "memory");
}
__device__ __forceinline__ void convert_mix_weights(Frame& F, int l) {

    LAS float* scr = (LAS float*)(F.lds + F.wave * 16384);
    const int gw = F.vcu * NWAVES + F.wave, NGW = F.G * NWAVES;
    constexpr int I_WIN = (D / 64) * (PW / 32), I_WG = (D / 64) * (4096 / 32), I_BR = (256 / 64) * (1024 / 32), I_WO = (D / 64) * (D / 32);
    constexpr int NIT = I_WIN + I_WG + 4 * I_BR + I_WO;
    const float* win = INP(I_W_IN) + (size_t)l * D * INW; const float* gmix = INP(I_LN_MIX) + l * D;
    for (int it = gw; it < NIT; it += NGW) {
        int r = it;
        if (r < I_WIN) { conv_item<1>(win, D, INW, ((bf16_t*)WSP(WS_WIN)), scr, r, PW, (F.tid & 63), gmix); continue; } r -= I_WIN;
        if (r < I_WG) { conv_item8<2>(win, D, INW, ptr_at(F, I_OUT) + OUT_WG8 + (size_t)l * 4 * MiB, scr, r, 4096, (F.tid & 63), gmix, WG8_SCALE); continue; } r -= I_WG;
        if (r < 4 * I_BR) { const int nb = r / I_BR; conv_item<0>(INP(I_W_BRANCH) + ((size_t)l * 4 + nb) * 256 * D, 256, D, ((bf16_t*)WSP(WS_WBR)) + (size_t)nb * 1024 * 256, scr, r % I_BR, 1024, (F.tid & 63)); continue; } r -= 4 * I_BR;
        conv_item<0>(INP(I_W_OUT) + (size_t)l * D * D, D, D, ((bf16_t*)WSP(WS_WOUT)), scr, r, D, (F.tid & 63));
    }
}
__device__ __forceinline__ void convert_mlp_weights(Frame& F, int l) {

    LAS float* scr = (LAS float*)(F.lds + F.wave * 16384);
    const int gw = F.vcu * NWAVES + F.wave, NGW = F.G * NWAVES;
    constexpr int I_UP = (D / 64) * (FF / 32), I_DN = (FF / 64) * (D / 32);
    for (int it = gw; it < I_UP + I_DN; it += NGW) {
        if (it < I_UP) conv_item<0>(INP(I_W_UP) + (size_t)l * D * FF, D, FF, ((bf16_t*)WSP(WS_WUP)), scr, it, FF, (F.tid & 63), INP(I_LN_MLP) + l * D);
        else conv_item<0>(INP(I_W_DOWN) + (size_t)l * FF * D, FF, D, ((bf16_t*)WSP(WS_WDN)), scr, it - I_UP, D, (F.tid & 63));
    }
}
__device__ __forceinline__ void prologue_rows(Frame& F) {
    float* COS = (float*)WSP(WS_COS); float* SIN = (float*)WSP(WS_SIN); float* SSQA = (float*)WSP(WS_SSQA); bf16_t* XG = (bf16_t*)WSP(WS_XG); const float* x = INP(I_X); const float* ln_mix = INP(I_LN_MIX);
    const int gt = F.vcu * NT + F.tid, NGT = F.G * NT;
    for (int i = gt; i < S * 32; i += NGT) { const int pos = i >> 5, k = i & 31; const float inv = powf(10000.f, -(float)k * 2.0f / 64.f); const float ang = (float)pos * inv; COS[i] = cosf(ang); SIN[i] = sinf(ang); }
    const int gw = F.vcu * NWAVES + F.wave, NGW = F.G * NWAVES;
    float* rsa = (float*)WSP(WS_RSA); unsigned char* x8p = ptr_at(F, I_OUT) + OUT_X8;
    for (int m0 = gw * 4; m0 < M; m0 += NGW * 4) {
        f32x4 v[4][4];
#pragma unroll
        for (int r = 0; r < 4; ++r)
#pragma unroll
            for (int j = 0; j < 4; ++j) v[r][j] = __builtin_nontemporal_load((const f32x4*)(x + (size_t)(m0 + r) * D) + (F.tid & 63) + 64 * j);
#pragma unroll
        for (int r = 0; r < 4; ++r) { float s = 0.f; unsigned long long* o8 = (unsigned long long*)(XG + (size_t)(m0 + r) * D) + (F.tid & 63);
#pragma unroll
            for (int j = 0; j < 4; ++j) { const f32x4 w = v[r][j]; s += (w[0] * w[0] + w[1] * w[1]) + (w[2] * w[2] + w[3] * w[3]);
                o8[64 * j] = (unsigned long long)pk2(w[0], w[1]) | ((unsigned long long)pk2(w[2], w[3]) << 32);
                ((unsigned*)(x8p + (size_t)(m0 + r) * D))[(F.tid & 63) + 64 * j] = pk4_fp8(w[0], w[1], w[2], w[3]); }
            s = wave_sum(s);
            if ((F.tid & 63) == 0) rsa[m0 + r] = rsqrtf(s * (1.f / 1024.f) + EPS); }
    }
}
__device__ __forceinline__ void finalize_rs(Frame& F, size_t ssq_off, size_t rs_off) {
    const float* ssq = (const float*)WSP(ssq_off); float* rs = (float*)WSP(rs_off);
    for (int row = F.vcu * NT + F.tid; row < M; row += F.G * NT) { const f32x4* sp = (const f32x4*)(ssq + (size_t)row * 16); const f32x4 a = sp[0], b = sp[1], c = sp[2], d = sp[3];
        const float t = ((a[0] + a[1]) + (a[2] + a[3])) + ((b[0] + b[1]) + (b[2] + b[3])) + ((c[0] + c[1]) + (c[2] + c[3])) + ((d[0] + d[1]) + (d[2] + d[3]));
        rs[row] = rsqrtf(t * (1.0f / 1024.0f) + EPS); }
}

__device__ __forceinline__ void conv_simple(Frame& F, int l) {
    bf16_t* PROJ = (bf16_t*)WSP(WS_BIG); bf16_t* Y = (bf16_t*)WSP(WS_Y); const float* conv_w = INP(I_CONV_W);
    const float* cw = conv_w + l * 3 * 256;
    for (int i = F.vcu * NT + F.tid; i < M * 32; i += F.G * NT) { const int m = i >> 5, c = (i & 31) * 8, t = m & (S - 1); float acc[8];
#pragma unroll
        for (int e = 0; e < 8; ++e) acc[e] = 0.f;
#pragma unroll
        for (int j = 0; j < 3; ++j) { const int tt = t - 2 + j; if (tt >= 0) { const size_t r = (size_t)(m - 2 + j) * PW; const u32x4 a = *(const u32x4*)(PROJ + r + P_DC + c), x = *(const u32x4*)(PROJ + r + P_DX + c);
                const f32x4 w0 = *(const f32x4*)(cw + j * 256 + c), w1 = *(const f32x4*)(cw + j * 256 + c + 4);
                acc[0] = fmaf(w0[0], lo_bf(a.x) * lo_bf(x.x), acc[0]); acc[1] = fmaf(w0[1], hi_bf(a.x) * hi_bf(x.x), acc[1]); acc[2] = fmaf(w0[2], lo_bf(a.y) * lo_bf(x.y), acc[2]); acc[3] = fmaf(w0[3], hi_bf(a.y) * hi_bf(x.y), acc[3]);
                acc[4] = fmaf(w1[0], lo_bf(a.z) * lo_bf(x.z), acc[4]); acc[5] = fmaf(w1[1], hi_bf(a.z) * hi_bf(x.z), acc[5]); acc[6] = fmaf(w1[2], lo_bf(a.w) * lo_bf(x.w), acc[6]); acc[7] = fmaf(w1[3], hi_bf(a.w) * hi_bf(x.w), acc[7]); } }
        const u32x4 bq = *(const u32x4*)(PROJ + (size_t)m * PW + P_DB + c); u32x4 o;
        o.x = cvt_pk_bf16(lo_bf(bq.x) * acc[0], hi_bf(bq.x) * acc[1]); o.y = cvt_pk_bf16(lo_bf(bq.y) * acc[2], hi_bf(bq.y) * acc[3]); o.z = cvt_pk_bf16(lo_bf(bq.z) * acc[4], hi_bf(bq.z) * acc[5]); o.w = cvt_pk_bf16(lo_bf(bq.w) * acc[6], hi_bf(bq.w) * acc[7]);
        *(u32x4*)(Y + (size_t)m * D + 768 + c) = o; }
}
typedef float f32x16 __attribute__((ext_vector_type(16)));
constexpr size_t WS_VT = WS_BIG + 120 * MiB;
constexpr float LOG2E = 1.4426950408889634f;

template <int R> struct AttExp {
    static __device__ __forceinline__ void run(f32x16& p0, f32x16& p1, unsigned sh0, unsigned sh1, float& lsum) {
        constexpr int CB = (R & 3) + 8 * (R >> 2);
        int m0, m1; asm("v_bfe_i32 %0, %1, %2, 1" : "=v"(m0) : "v"(sh0), "n"(CB)); asm("v_bfe_i32 %0, %1, %2, 1" : "=v"(m1) : "v"(sh1), "n"(CB));
        p0[R] = __uint_as_float(__float_as_uint(__builtin_amdgcn_exp2f(p0[R])) & (unsigned)m0); p1[R] = __uint_as_float(__float_as_uint(__builtin_amdgcn_exp2f(p1[R])) & (unsigned)m1);
        lsum += p0[R] + p1[R];
        AttExp<R + 1>::run(p0, p1, sh0, sh1, lsum);
    }
};
template <> struct AttExp<16> { static __device__ __forceinline__ void run(f32x16&, f32x16&, unsigned, unsigned, float&) {} };

__device__ __forceinline__ void attn_mfma(Frame& F, int l) {
    const unsigned long long* MASKT = (const unsigned long long*)WSP(WS_MASK); const bf16_t* PROJ = (const bf16_t*)WSP(WS_BIG); const bf16_t* VT = (const bf16_t*)WSP(WS_VT);
    bf16_t* Y = (bf16_t*)WSP(WS_Y); const float* gt = (const float*)WSP(WS_GT) + l * 192;
    const int lane = (F.tid & 63), r32 = lane & 31, hi = lane >> 5, grp = F.wave >> 2, w4 = F.wave & 3, lg = F.tid & 255;
    const float mq = wave_max(fabsf(gt[lane])), mk = wave_max(fabsf(gt[64 + lane]));
    const float c2 = 8.f * mq * mk * 1.01f * LOG2E;
    constexpr int ROWB = 144, TILEB = 64 * ROWB;
    LAS unsigned char* gb = F.lds + grp * 4 * TILEB;
    LAS float* comb = (LAS float*)(F.lds + 8 * TILEB);
    const int srow0 = lg >> 3, sc0 = lg & 7;
    for (int item = F.vcu; item < 256; item += F.G) {
        const int bh = item >> 4, sidx = item & 15, b = bh >> 2, h = bh & 3;
#pragma unroll 1
        for (int half = 0; half < 2; ++half) {
            const int qb = half == 0 ? sidx : 31 - sidx, q0 = qb * 128, ntl = qb + 1;
            const int qrow = b * S + q0 + w4 * 32 + r32, tq = q0 + w4 * 32 + r32;
            bf16x8 qf[4];
#pragma unroll
            for (int s = 0; s < 4; ++s) qf[s] = *(const bf16x8*)(PROJ + (size_t)qrow * PW + P_Q + h * 64 + 16 * s + 8 * hi);
            f32x16 o0, o1;
#pragma unroll
            for (int r = 0; r < 16; ++r) { o0[r] = 0.f; o1[r] = 0.f; }
            float lsum = 0.f;
            const bf16_t* kbase = PROJ + (size_t)(b * S + srow0) * PW + P_K + h * 64 + sc0 * 8;
            const bf16_t* vbase = VT + (size_t)(b * 256 + h * 64 + srow0) * S + sc0 * 8;
            const unsigned long long* mbase = MASKT + (size_t)(b * 64) * S + tq;
            u32x4 ka0, ka1, va0, va1, kb0, kb1, vb0, vb1; unsigned long long mwa = 0ull, mwb = 0ull;
#define ATT_LOAD(K0, K1, V0, V1, MW, t_) do { const int t__ = (t_); K0 = *(const u32x4*)(kbase + (size_t)t__ * 64 * PW); K1 = *(const u32x4*)(kbase + (size_t)(t__ * 64 + 32) * PW); \
    V0 = *(const u32x4*)(vbase + t__ * 64); V1 = *(const u32x4*)(vbase + 32 * S + t__ * 64); MW = mbase[(size_t)t__ * S]; } while (0)
#define ATT_STORE(K0, K1, V0, V1, buf_) do { LAS unsigned char* kn_ = gb + (buf_) * 2 * TILEB; LAS unsigned char* vn_ = kn_ + TILEB; \
    *(LAS u32x4*)(kn_ + srow0 * ROWB + sc0 * 16) = K0; *(LAS u32x4*)(kn_ + (srow0 + 32) * ROWB + sc0 * 16) = K1; \
    *(LAS u32x4*)(vn_ + srow0 * ROWB + sc0 * 16) = V0; *(LAS u32x4*)(vn_ + (srow0 + 32) * ROWB + sc0 * 16) = V1; } while (0)
#define ATT_COMPUTE(cur_, MW) do { \
                const LAS unsigned char* kb = gb + (cur_) * 2 * TILEB; const LAS unsigned char* vb = kb + TILEB; \
                f32x16 p0, p1; \
                _Pragma("unroll") for (int r = 0; r < 16; ++r) { p0[r] = -c2; p1[r] = -c2; }     \
                _Pragma("unroll") for (int s = 0; s < 4; ++s) { \
                    const bf16x8 k0 = *(const LAS bf16x8*)(kb + r32 * ROWB + 32 * s + 16 * hi), k1 = *(const LAS bf16x8*)(kb + (32 + r32) * ROWB + 32 * s + 16 * hi); \
                    p0 = __builtin_amdgcn_mfma_f32_32x32x16_bf16(k0, qf[s], p0, 0, 0, 0); p1 = __builtin_amdgcn_mfma_f32_32x32x16_bf16(k1, qf[s], p1, 0, 0, 0); } \
                const unsigned sh0 = (unsigned)(MW) >> (4 * hi), sh1 = (unsigned)((MW) >> 32) >> (4 * hi); \
                AttExp<0>::run(p0, p1, sh0, sh1, lsum); \
                _Pragma("unroll") for (int ks = 0; ks < 4; ++ks) { \
                    u32x4 pw; \
                    if (ks < 2) { pw.x = cvt_pk_bf16(p0[8 * ks + 0], p0[8 * ks + 1]); pw.y = cvt_pk_bf16(p0[8 * ks + 2], p0[8 * ks + 3]); pw.z = cvt_pk_bf16(p0[8 * ks + 4], p0[8 * ks + 5]); pw.w = cvt_pk_bf16(p0[8 * ks + 6], p0[8 * ks + 7]); } \
                    else { const int k2 = ks - 2; pw.x = cvt_pk_bf16(p1[8 * k2 + 0], p1[8 * k2 + 1]); pw.y = cvt_pk_bf16(p1[8 * k2 + 2], p1[8 * k2 + 3]); pw.z = cvt_pk_bf16(p1[8 * k2 + 4], p1[8 * k2 + 5]); pw.w = cvt_pk_bf16(p1[8 * k2 + 6], p1[8 * k2 + 7]); } \
                    const bf16x8 pf = __builtin_bit_cast(bf16x8, pw); \
                    const int vo = 64 * (ks >> 1) + 32 * (ks & 1) + 8 * hi; \
                    const u32x2 a0 = *(const LAS u32x2*)(vb + r32 * ROWB + vo), a1 = *(const LAS u32x2*)(vb + r32 * ROWB + vo + 16); \
                    const u32x2 b0 = *(const LAS u32x2*)(vb + (32 + r32) * ROWB + vo), b1 = *(const LAS u32x2*)(vb + (32 + r32) * ROWB + vo + 16); \
                    const u32x4 va = {a0.x, a0.y, a1.x, a1.y}, vb4 = {b0.x, b0.y, b1.x, b1.y}; \
                    o0 = __builtin_amdgcn_mfma_f32_32x32x16_bf16(__builtin_bit_cast(bf16x8, va), pf, o0, 0, 0, 0); \
                    o1 = __builtin_amdgcn_mfma_f32_32x32x16_bf16(__builtin_bit_cast(bf16x8, vb4), pf, o1, 0, 0, 0); } \
            } while (0)
            ATT_LOAD(ka0, ka1, va0, va1, mwa, grp);
            if (ntl > 1) ATT_LOAD(kb0, kb1, vb0, vb1, mwb, 2 + grp);
            ATT_STORE(ka0, ka1, va0, va1, 0);
            __syncthreads();
            asm volatile(".p2align 8");
#pragma unroll 1
            for (int i = 0; i < ntl; i += 2) {
                const unsigned long long mw0 = mwa;
                if (i + 2 < ntl) ATT_LOAD(ka0, ka1, va0, va1, mwa, 2 * (i + 2) + grp);
                ATT_COMPUTE(0, mw0);
                if (i + 1 < ntl) ATT_STORE(kb0, kb1, vb0, vb1, 1);
                __syncthreads();
                if (i + 1 < ntl) {
                    const unsigned long long mw1 = mwb;
                    if (i + 3 < ntl) ATT_LOAD(kb0, kb1, vb0, vb1, mwb, 2 * (i + 3) + grp);
                    ATT_COMPUTE(1, mw1);
                    if (i + 2 < ntl) ATT_STORE(ka0, ka1, va0, va1, 0);
                    __syncthreads();
                }
            }
#undef ATT_LOAD
#undef ATT_STORE
#undef ATT_COMPUTE
            if (grp == 1) { LAS float* cw = comb + w4 * 33 * 64 + lane;
#pragma unroll
                for (int r = 0; r < 16; ++r) { cw[r * 64] = o0[r]; cw[(16 + r) * 64] = o1[r]; }
                cw[32 * 64] = lsum; }
            __syncthreads();
            if (grp == 0) { const LAS float* cw = comb + w4 * 33 * 64 + lane;
#pragma unroll
                for (int r = 0; r < 16; ++r) { o0[r] += cw[r * 64]; o1[r] += cw[(16 + r) * 64]; }
                lsum += cw[32 * 64]; lsum += __shfl_xor(lsum, 32); const float inv = 1.f / lsum;
                bf16_t* yp = Y + (size_t)qrow * D + 256 + h * 64 + 4 * hi;
#pragma unroll
                for (int g4 = 0; g4 < 4; ++g4) { u32x2 w0, w1;
                    w0.x = cvt_pk_bf16(o0[4 * g4] * inv, o0[4 * g4 + 1] * inv); w0.y = cvt_pk_bf16(o0[4 * g4 + 2] * inv, o0[4 * g4 + 3] * inv);
                    w1.x = cvt_pk_bf16(o1[4 * g4] * inv, o1[4 * g4 + 1] * inv); w1.y = cvt_pk_bf16(o1[4 * g4 + 2] * inv, o1[4 * g4 + 3] * inv);
                    *(u32x2*)(yp + 8 * g4) = w0; *(u32x2*)(yp + 32 + 8 * g4) = w1; } }
            __syncthreads();
        }
    }
}

constexpr size_t WS_KI = 234 * MiB;
template <int J, unsigned MSK>
__device__ __forceinline__ void tr_stage(unsigned (&a)[32]) {
#pragma unroll
    for (int k = 0; k < 32; ++k) if ((k & J) == 0) { const unsigned t = (a[k] ^ (a[k + J] >> J)) & MSK; a[k] ^= t; a[k + J] ^= (t << J); }
}
__device__ __forceinline__ void transpose32(unsigned (&a)[32]) {
    tr_stage<16, 0x0000FFFFu>(a); tr_stage<8, 0x00FF00FFu>(a); tr_stage<4, 0x0F0F0F0Fu>(a); tr_stage<2, 0x33333333u>(a); tr_stage<1, 0x55555555u>(a);
}
__device__ __forceinline__ int wave_total_i(int v) {
    v += __builtin_amdgcn_update_dpp(0, v, 0x111, 0xf, 0xf, false);
    v += __builtin_amdgcn_update_dpp(0, v, 0x112, 0xf, 0xf, false);
    v += __builtin_amdgcn_update_dpp(0, v, 0x114, 0xf, 0xf, false);
    v += __builtin_amdgcn_update_dpp(0, v, 0x118, 0xf, 0xf, false);
    v += __builtin_amdgcn_update_dpp(0, v, 0x142, 0xa, 0xf, false);
    v += __builtin_amdgcn_update_dpp(0, v, 0x143, 0xc, 0xf, false);
    return __builtin_amdgcn_readlane(v, 63);
}
__device__ __forceinline__ void idx_score(Frame& F, const int b, const int t0, LAS unsigned short* sc16, const int sw) {
    if (t0 + 8 <= 256) return;
    const float* MISC = (const float*)WSP(WS_MISC); const bf16_t* PROJ = (const bf16_t*)WSP(WS_BIG); const bf16_t* KI = (const bf16_t*)WSP(WS_KI);
    const int lane = (F.tid & 63), r32 = lane & 31, hi = lane >> 5, m0 = b * S + t0;
    const int nmax = t0 + 8, ntile = (nmax + 31) >> 5;
    bf16x8 qa[2][4], wsel[2][2];
#pragma unroll
    for (int i = 0; i < 2; ++i) {
        const bf16_t* qp = PROJ + (size_t)(m0 + 4 * i + (r32 >> 3)) * PW + P_QI + (r32 & 7) * 64 + 8 * hi;
#pragma unroll
        for (int s = 0; s < 4; ++s) { qa[i][s] = *(const bf16x8*)(qp + 16 * s); asm volatile("" : "+v"(qa[i][s])); }
    }
    { const int qrow = r32 & 7; const f32x4 w4 = *(const f32x4*)(MISC + (size_t)(m0 + qrow) * 16 + 4 * hi);
      const float sc_ = 0.125f * 0.35355339059327373f; const unsigned p01 = cvt_pk_bf16(w4[0] * sc_, w4[1] * sc_), p23 = cvt_pk_bf16(w4[2] * sc_, w4[3] * sc_);
#pragma unroll
      for (int i = 0; i < 2; ++i)
#pragma unroll
          for (int s = 0; s < 2; ++s) { const bool mine = (r32 < 8) && ((qrow >> 2) == i) && (((qrow & 3) >> 1) == s); const bool upper = (qrow & 1) != 0;
              u32x4 f; f.x = (mine && !upper) ? p01 : 0u; f.y = (mine && !upper) ? p23 : 0u; f.z = (mine && upper) ? p01 : 0u; f.w = (mine && upper) ? p23 : 0u;
              asm volatile("" : "+v"(f));
              wsel[i][s] = __builtin_bit_cast(bf16x8, f); } }
    bf16x8 kring[2][4];
    const bf16_t* kbase_ = KI + ((size_t)(b * S >> 5) * 4 * 64 + lane) * 8;
#define IDX_LOADK(u_, j_) do { const int jt_ = (j_) < ntile ? (j_) : ntile - 1; const bf16_t* kp_ = kbase_ + (unsigned)jt_ * 2048u; \
    _Pragma("unroll") for (int s_ = 0; s_ < 4; ++s_) kring[u_][s_] = *(const bf16x8*)(kp_ + s_ * 64 * 8); } while (0)
#pragma unroll
    for (int u = 0; u < 2; ++u) IDX_LOADK(u, sw + 4 * u);
    f32x16 dd[2][2];
#define IDX_DSTEP(slot_, par_, s_) do { _Pragma("unroll") for (int i_ = 0; i_ < 2; ++i_) dd[par_][i_] = __builtin_amdgcn_mfma_f32_32x32x16_bf16(qa[i_][s_], kring[slot_][s_], dd[par_][i_], 0, 0, 0); } while (0)
#define IDX_WSTEP(par_, i_, s_) do { u32x4 rw_; const f32x16& d_ = dd[par_][i_]; \
        rw_.x = cvt_pk_bf16(relu_f(d_[8 * (s_) + 0]), relu_f(d_[8 * (s_) + 1])); rw_.y = cvt_pk_bf16(relu_f(d_[8 * (s_) + 2]), relu_f(d_[8 * (s_) + 3])); \
        rw_.z = cvt_pk_bf16(relu_f(d_[8 * (s_) + 4]), relu_f(d_[8 * (s_) + 5])); rw_.w = cvt_pk_bf16(relu_f(d_[8 * (s_) + 6]), relu_f(d_[8 * (s_) + 7])); \
        outv = __builtin_amdgcn_mfma_f32_32x32x16_bf16(wsel[i_][s_], __builtin_bit_cast(bf16x8, rw_), outv, 0, 0, 0); } while (0)
#pragma unroll
    for (int i = 0; i < 2; ++i)
#pragma unroll
        for (int r = 0; r < 16; ++r) dd[0][i][r] = 0.f;
#pragma unroll
    for (int s = 0; s < 4; ++s) IDX_DSTEP(0, 0, s);
    __builtin_amdgcn_sched_barrier(0);
    IDX_LOADK(0, sw + 8);
    __builtin_amdgcn_sched_barrier(0);
    asm volatile(".p2align 8");
    for (int jb = sw; jb < ntile; jb += 8) {
#pragma unroll
        for (int u = 0; u < 2; ++u) {
            const int j = jb + 4 * u;
            const int key = 32 * j + r32;
            f32x16 outv;
#pragma unroll
            for (int r = 0; r < 16; ++r) { outv[r] = 0.f; dd[(u + 1) & 1][0][r] = 0.f; dd[(u + 1) & 1][1][r] = 0.f; }
            IDX_DSTEP((u + 1) & 1, (u + 1) & 1, 0); IDX_WSTEP(u & 1, 0, 0);
            IDX_DSTEP((u + 1) & 1, (u + 1) & 1, 1); IDX_WSTEP(u & 1, 0, 1);
            IDX_DSTEP((u + 1) & 1, (u + 1) & 1, 2); IDX_WSTEP(u & 1, 1, 0);
            IDX_DSTEP((u + 1) & 1, (u + 1) & 1, 3); IDX_WSTEP(u & 1, 1, 1);
            __builtin_amdgcn_sched_barrier(0);
            IDX_LOADK((u + 1) & 1, j + 4 + 8);
            __builtin_amdgcn_sched_barrier(0);
            if (j < ntile) {
                const int kpos = ((key & 2047) << 1) + (key >> 11);
#pragma unroll
                for (int qq = 0; qq < 4; ++qq) { const int qx = 4 * hi + qq;
                    sc16[qx * 4096 + kpos] = __builtin_bit_cast(unsigned short, (_Float16)((key <= t0 + qx) ? outv[qq] : -INFINITY)); }
            }
        }
    }
#undef IDX_DSTEP
#undef IDX_WSTEP
#undef IDX_LOADK
}
__device__ __forceinline__ void idx_select(Frame& F, const int b, const int t0, const LAS unsigned short* sc16, const int qw) {
    unsigned long long* MASKT = (unsigned long long*)WSP(WS_MASK);
    const int lane = (F.tid & 63);
    if (t0 + 8 <= 256) {
#pragma unroll
        for (int qi = 0; qi < 2; ++qi) { const int tq = t0 + qw + 4 * qi; const int lo = 64 * lane;
            MASKT[(size_t)(b * 64 + lane) * S + tq] = (tq >= lo + 63) ? ~0ull : (tq < lo ? 0ull : ((2ull << (tq - lo)) - 1ull)); }
        return;
    }
    const int nmax = t0 + 8, ntile = (nmax + 31) >> 5, nvalid = 32 * ntile;
    unsigned kk[2][32];
#define IDX_KEY(dst_, srow_, r_) do { const unsigned w_ = (srow_)[64 * (r_)]; const unsigned sg_ = (w_ & 0x80008000u) >> 15; const unsigned k_ = w_ ^ (((sg_ << 16) - sg_) | 0x80008000u); \
        const unsigned vm_ = ((unsigned)((64 * (r_) + lane - nvalid) >> 31) & 0xFFFFu) | ((unsigned)((2048 + 64 * (r_) + lane - nvalid) >> 31) & 0xFFFF0000u); dst_ = k_ & vm_; } while (0)
#pragma unroll
    for (int qi = 0; qi < 2; ++qi) { const LAS unsigned* srow = (const LAS unsigned*)sc16 + (qw + 4 * qi) * 2048 + lane;
#pragma unroll
        for (int r = 0; r < 32; ++r) IDX_KEY(kk[qi][r], srow, r); }
    transpose32(kk[0]); transpose32(kk[1]);
    unsigned aA[2] = {~0u, ~0u}, aB[2] = {~0u, ~0u}, Tk[2] = {0u, 0u}; int base[2] = {0, 0};
#pragma unroll
    for (int bit = 15; bit >= 0; --bit) {
#pragma unroll
        for (int qi = 0; qi < 2; ++qi) {
            const unsigned wa = kk[qi][31 - bit], wb = kk[qi][15 - bit];
            const int tot = wave_total_i(__builtin_popcount(wa & aA[qi]) + __builtin_popcount(wb & aB[qi]));
            const bool take = (base[qi] + tot >= 256);
            const unsigned flip = take ? 0u : ~0u;
            aA[qi] &= (wa ^ flip); aB[qi] &= (wb ^ flip);
            if (take) Tk[qi] |= (1u << bit); else base[qi] += tot;
        }
    }
#pragma unroll 1
    for (int qi = 0; qi < 2; ++qi) {
        const int tq = t0 + qw + 4 * qi; unsigned long long myword = 0ull; const unsigned T = qi ? Tk[1] : Tk[0];
        const int ngt = qi ? base[1] : base[0], neq = wave_total_i(__builtin_popcount(qi ? aA[1] : aA[0]) + __builtin_popcount(qi ? aB[1] : aB[0]));
        const LAS unsigned* srow = (const LAS unsigned*)sc16 + (qw + 4 * qi) * 2048 + lane;
        unsigned kc[32];
#pragma unroll
        for (int r = 0; r < 32; ++r) IDX_KEY(kc[r], srow, r);
        if (ngt + neq == 256) {
#pragma unroll
            for (int r = 0; r < 32; ++r) { const unsigned long long wlo = __ballot((kc[r] & 0xFFFFu) >= T); if (lane == r) myword = wlo; }
            if (nvalid > 2048) {
#pragma unroll
                for (int r = 0; r < 32; ++r) { const unsigned long long whi = __ballot((kc[r] >> 16) >= T); if (lane == 32 + r) myword = whi; } }
        } else {
            int need = 256 - ngt;
#pragma unroll
            for (int hf = 0; hf < 2; ++hf) if (hf == 0 || nvalid > 2048)
#pragma unroll
                for (int r = 0; r < 32; ++r) { const unsigned k = hf ? (kc[r] >> 16) : (kc[r] & 0xFFFFu);
                    unsigned long long wsel = __ballot(k > T), em = __ballot(k == T); int c = __builtin_popcountll(em);
                    if (c > need) { while (c > need) { em &= ~(1ull << (63 - __builtin_clzll(em))); --c; } }
                    need -= c; wsel |= em;
                    if (lane == 32 * hf + r) myword = wsel; }
        }
        MASKT[(size_t)(b * 64 + lane) * S + tq] = myword;
    }
#undef IDX_KEY
}
__device__ __forceinline__ void indexer_mfma(Frame& F) {
    const int wv = F.wave;
    const int npi = (1024 - F.vcu + F.G - 1) / F.G, n = 2 * npi;
#define IDX_UNIT(idx_, b_, t0_) const int pi_##b_ = F.vcu + ((idx_) < npi ? (idx_) : (idx_) - npi) * F.G; const int b_ = pi_##b_ >> 8; const int t0_ = 8 * ((idx_) < npi ? 511 - (pi_##b_ & 255) : (pi_##b_ & 255))
    if (wv < 4) { IDX_UNIT(0, b0, t00); idx_score(F, b0, t00, (LAS unsigned short*)F.lds, wv); }
    __syncthreads();
#pragma unroll 1
    for (int u = 0; u < n; ++u) {
        if (wv < 4) { if (u + 1 < n) { IDX_UNIT(u + 1, b1, t01); idx_score(F, b1, t01, (LAS unsigned short*)(F.lds + ((u + 1) & 1) * 65536), wv); } }
        else { IDX_UNIT(u, b2, t02); idx_select(F, b2, t02, (const LAS unsigned short*)(F.lds + (u & 1) * 65536), wv - 4);
#ifdef MK_PROBE_SEL2
            asm volatile("" ::: "memory"); idx_select(F, b2, t02, (const LAS unsigned short*)(F.lds + (u & 1) * 65536), wv - 4);
#endif
        }
        __syncthreads();
    }
#undef IDX_UNIT
}

constexpr size_t WS_CVT = 236 * MiB;
__device__ __forceinline__ void mlstm2_mfma(Frame& F, int l) {
    const float* MISC = (const float*)WSP(WS_MISC); const float* STATE = (const float*)WSP(WS_STATE); const bf16_t* PROJ = (const bf16_t*)WSP(WS_BIG); const bf16_t* CVT = (const bf16_t*)WSP(WS_CVT);
    bf16_t* Y = (bf16_t*)WSP(WS_Y); const float* i_bias = INP(I_I_BIAS); const float* f_bias = INP(I_F_BIAS); const float* mnorm = INP(I_MNORM);
    const int lane = (F.tid & 63), r32 = lane & 31, hi = lane >> 5, grp = F.wave >> 2, w4 = F.wave & 3, lg = F.tid & 255;
    constexpr int KROWB = 144, VROWB = 272, GB = 49152;
    LAS unsigned char* gb = F.lds + grp * GB;
    LAS float* bc = (LAS float*)gb;
    LAS float* gs = bc + 128;
    LAS float* npv = gs + 128;
    LAS float* wsum = npv + 64;
    LAS unsigned char* ct = gb + 2048;
    LAS unsigned char* kt = ct + 9216;
    LAS unsigned char* vt = kt + 18432;
    for (int it0 = 2 * F.vcu; it0 < 512; it0 += 2 * F.G) {
        const int item = it0 + grp, bh = item >> 5, c = item & 31, b = bh >> 2, h = bh & 3, m0 = b * S + c * 128;
        if (lg < 128) { const float f = MISC[(size_t)(m0 + lg) * 16 + 12 + h] + f_bias[l * 4 + h]; bc[lg] = fminf(f, 0.f) - log1pf(__expf(-fabsf(f))); gs[lg] = MISC[(size_t)(m0 + lg) * 16 + 8 + h] + i_bias[l * 4 + h]; }
        if (lg >= 128 && lg < 160) { const int cc = lg - 128; wsum[cc] = (cc < c) ? STATE[(size_t)(bh * 32 + cc) * STATE_STRIDE + 4160] : 0.f; }
        __syncthreads();
        if (lg < 64) {
            float a0 = bc[2 * lane], a1 = bc[2 * lane + 1]; float s = a0 + a1;
#pragma unroll
            for (int o = 1; o < 64; o <<= 1) { const float t = __shfl_up(s, o); if (lane >= o) s += t; }
            const float ex = s - (a0 + a1); const float i0 = gs[2 * lane], i1 = gs[2 * lane + 1];
            bc[2 * lane] = ex + a0; bc[2 * lane + 1] = s; gs[2 * lane] = i0 - (ex + a0); gs[2 * lane + 1] = i1 - s;
            float w = (lane < 32) ? wsum[lane] : 0.f; float suf = w;
#pragma unroll
            for (int o = 1; o < 32; o <<= 1) { const float t = __shfl_down(suf, o); if (lane + o < 32) suf += t; }
            if (lane < 32) wsum[lane] = suf - w;
        }
        __syncthreads();
        { f32x4 a4[4]; float nv = 0.f;
#pragma unroll
          for (int k = 0; k < 4; ++k) a4[k] = (f32x4){0.f, 0.f, 0.f, 0.f};
          for (int cc = 0; cc < c; ++cc) { const float* st = STATE + (size_t)(bh * 32 + cc) * STATE_STRIDE; const float wgt = __expf(wsum[cc]);
#pragma unroll
              for (int k = 0; k < 4; ++k) { const f32x4 v = *(const f32x4*)(st + 4 * (lg + 256 * k)); a4[k] = a4[k] + v * wgt; }
              if (lg < 64) nv = fmaf(wgt, st[4096 + lg], nv); }
#pragma unroll
          for (int k = 0; k < 4; ++k) { const int idx = 4 * (lg + 256 * k), e = idx >> 6, d = idx & 63; u32x2 w; w.x = cvt_pk_bf16(a4[k][0], a4[k][1]); w.y = cvt_pk_bf16(a4[k][2], a4[k][3]); *(LAS u32x2*)(ct + e * KROWB + d * 2) = w; }
          if (lg < 64) npv[lg] = nv; }
#pragma unroll
        for (int k = 0; k < 4; ++k) { const int id = lg + 256 * k, row = id >> 3, ch = id & 7;
            *(LAS u32x4*)(kt + row * KROWB + ch * 16) = *(const u32x4*)(PROJ + (size_t)(m0 + row) * PW + P_CK + h * 64 + ch * 8);
            const int vrow = id >> 4, vch = id & 15;
            *(LAS u32x4*)(vt + vrow * VROWB + vch * 16) = *(const u32x4*)(CVT + (size_t)(b * 256 + h * 64 + vrow) * S + c * 128 + vch * 8); }
        __syncthreads();
        const int j = 32 * w4 + r32, qrow = m0 + j;
        bf16x8 qf[4];
#pragma unroll
        for (int s = 0; s < 4; ++s) qf[s] = *(const bf16x8*)(PROJ + (size_t)qrow * PW + P_CQ + h * 64 + 16 * s + 8 * hi);
        const float bj = bc[j], eb = __expf(bj);
        float qn = 0.f;
#pragma unroll
        for (int s = 0; s < 4; ++s) { const u32x4 w = __builtin_bit_cast(u32x4, qf[s]); const LAS float* np = npv + 16 * s + 8 * hi;
            qn += lo_bf(w.x) * np[0] + hi_bf(w.x) * np[1] + lo_bf(w.y) * np[2] + hi_bf(w.y) * np[3] + lo_bf(w.z) * np[4] + hi_bf(w.z) * np[5] + lo_bf(w.w) * np[6] + hi_bf(w.w) * np[7]; }
        qn += __shfl_xor(qn, 32); qn *= eb;
        f32x16 n0, n1;
#pragma unroll
        for (int r = 0; r < 16; ++r) { n0[r] = 0.f; n1[r] = 0.f; }
#pragma unroll
        for (int ks = 0; ks < 4; ++ks) { const bf16x8 c0 = *(const LAS bf16x8*)(ct + r32 * KROWB + 32 * ks + 16 * hi), c1 = *(const LAS bf16x8*)(ct + (32 + r32) * KROWB + 32 * ks + 16 * hi);
            n0 = __builtin_amdgcn_mfma_f32_32x32x16_bf16(c0, qf[ks], n0, 0, 0, 0); n1 = __builtin_amdgcn_mfma_f32_32x32x16_bf16(c1, qf[ks], n1, 0, 0, 0); }
#pragma unroll
        for (int r = 0; r < 16; ++r) { n0[r] *= eb; n1[r] *= eb; }
        float sa = 0.f;
#pragma unroll 1
        for (int st = 0; st <= w4; ++st) {
            f32x16 p;
#pragma unroll
            for (int r = 0; r < 16; ++r) p[r] = 0.f;
#pragma unroll
            for (int ks = 0; ks < 4; ++ks) { const bf16x8 kf = *(const LAS bf16x8*)(kt + (32 * st + r32) * KROWB + 32 * ks + 16 * hi); p = __builtin_amdgcn_mfma_f32_32x32x16_bf16(kf, qf[ks], p, 0, 0, 0); }
#pragma unroll
            for (int r = 0; r < 16; ++r) { const int s = 32 * st + (r & 3) + 8 * (r >> 2) + 4 * hi; const float a = (s <= j) ? __expf(bj + gs[s]) * p[r] : 0.f; p[r] = a; sa += a; }
#pragma unroll
            for (int k2 = 0; k2 < 2; ++k2) {
                u32x4 pw; pw.x = cvt_pk_bf16(p[8 * k2 + 0], p[8 * k2 + 1]); pw.y = cvt_pk_bf16(p[8 * k2 + 2], p[8 * k2 + 3]); pw.z = cvt_pk_bf16(p[8 * k2 + 4], p[8 * k2 + 5]); pw.w = cvt_pk_bf16(p[8 * k2 + 6], p[8 * k2 + 7]);
                const bf16x8 pf = __builtin_bit_cast(bf16x8, pw);
                const int vo = (32 * st + 16 * k2 + 4 * hi) * 2;
                const u32x2 a0 = *(const LAS u32x2*)(vt + r32 * VROWB + vo), a1 = *(const LAS u32x2*)(vt + r32 * VROWB + vo + 16);
                const u32x2 b0 = *(const LAS u32x2*)(vt + (32 + r32) * VROWB + vo), b1 = *(const LAS u32x2*)(vt + (32 + r32) * VROWB + vo + 16);
                const u32x4 va = {a0.x, a0.y, a1.x, a1.y}, vb4 = {b0.x, b0.y, b1.x, b1.y};
                n0 = __builtin_amdgcn_mfma_f32_32x32x16_bf16(__builtin_bit_cast(bf16x8, va), pf, n0, 0, 0, 0);
                n1 = __builtin_amdgcn_mfma_f32_32x32x16_bf16(__builtin_bit_cast(bf16x8, vb4), pf, n1, 0, 0, 0);
            }
        }
        sa += __shfl_xor(sa, 32);
        const float inv = 1.f / fmaxf(fabsf(qn + sa), 1.f);
        float ss = 0.f;
#pragma unroll
        for (int r = 0; r < 16; ++r) { n0[r] *= inv; n1[r] *= inv; ss += n0[r] * n0[r] + n1[r] * n1[r]; }
        ss += __shfl_xor(ss, 32); const float rr = rsqrtf(ss * (1.f / 64.f) + EPS);
        const float* gp = mnorm + l * 256 + h * 64 + 4 * hi; const bf16_t* op = PROJ + (size_t)qrow * PW + P_CO + h * 64 + 4 * hi; bf16_t* yp = Y + (size_t)qrow * D + 512 + h * 64 + 4 * hi;
#pragma unroll
        for (int g4 = 0; g4 < 4; ++g4) {
            const f32x4 ga = *(const f32x4*)(gp + 8 * g4), gb4 = *(const f32x4*)(gp + 32 + 8 * g4);
            const u32x2 oa = *(const u32x2*)(op + 8 * g4), ob = *(const u32x2*)(op + 32 + 8 * g4);
            u32x2 w0, w1;
            w0.x = cvt_pk_bf16(sigmoid_f(lo_bf(oa.x)) * n0[4 * g4] * rr * ga[0], sigmoid_f(hi_bf(oa.x)) * n0[4 * g4 + 1] * rr * ga[1]);
            w0.y = cvt_pk_bf16(sigmoid_f(lo_bf(oa.y)) * n0[4 * g4 + 2] * rr * ga[2], sigmoid_f(hi_bf(oa.y)) * n0[4 * g4 + 3] * rr * ga[3]);
            w1.x = cvt_pk_bf16(sigmoid_f(lo_bf(ob.x)) * n1[4 * g4] * rr * gb4[0], sigmoid_f(hi_bf(ob.x)) * n1[4 * g4 + 1] * rr * gb4[1]);
            w1.y = cvt_pk_bf16(sigmoid_f(lo_bf(ob.y)) * n1[4 * g4 + 2] * rr * gb4[2], sigmoid_f(hi_bf(ob.y)) * n1[4 * g4 + 3] * rr * gb4[3]);
            *(u32x2*)(yp + 8 * g4) = w0; *(u32x2*)(yp + 32 + 8 * g4) = w1;
        }
        __syncthreads();
    }
}

constexpr size_t WS_SSQV = 244 * MiB;
__device__ __forceinline__ void sgu_mfma(Frame& F, int l) {
    const bf16_t* PROJ = (const bf16_t*)WSP(WS_BIG); bf16_t* Y = (bf16_t*)WSP(WS_Y); const float* SSQV = (const float*)WSP(WS_SSQV);
    const float* gain = INP(I_SGU_NORM) + l * 256; const float* sw = INP(I_SGU_W) + (size_t)l * 4 * 128 * 128; const float* sb = INP(I_SGU_B) + l * 4 * 128;
    const int lane = (F.tid & 63), r32 = lane & 31, hi = lane >> 5, dt = F.wave & 1, tt = F.wave >> 1;
    constexpr int VROWB = 272;
    LAS float* r_s = (LAS float*)F.lds;
    LAS unsigned char* vt = F.lds + 512;
    for (int item = F.vcu; item < 512; item += F.G) {
        const int g = item & 3, m0 = (item >> 2) * 128;
        if (F.tid < 128) { const f32x4 q = *(const f32x4*)(SSQV + (size_t)(m0 + F.tid) * 4); r_s[F.tid] = rsqrtf(((q[0] + q[1]) + (q[2] + q[3])) * (1.f / 256.f) + EPS); }
        __syncthreads();
#pragma unroll
        for (int k = 0; k < 2; ++k) { const int id = F.tid + 512 * k, s = id >> 3, d0 = (id & 7) * 8; const float rs = r_s[s];
            const u32x4 w = *(const u32x4*)(PROJ + (size_t)(m0 + s) * PW + P_AV + g * 64 + d0);
            const float v[8] = {lo_bf(w.x), hi_bf(w.x), lo_bf(w.y), hi_bf(w.y), lo_bf(w.z), hi_bf(w.z), lo_bf(w.w), hi_bf(w.w)};
#pragma unroll
            for (int i = 0; i < 8; ++i) *(LAS bf16_t*)(vt + (d0 + i) * VROWB + s * 2) = (bf16_t)f2bf(v[i] * rs); }
        __syncthreads();
        f32x16 acc;
#pragma unroll
        for (int r = 0; r < 16; ++r) acc[r] = 0.f;
        const int t = 32 * tt + r32; const float* wrow = sw + ((size_t)g * 128 + t) * 128;
#pragma unroll 1
        for (int ks = 0; ks < 2 * (tt + 1); ++ks) {
            const bf16x8 af = *(const LAS bf16x8*)(vt + (32 * dt + r32) * VROWB + (16 * ks + 8 * hi) * 2);
            const int s0 = 16 * ks + 8 * hi; const f32x4 w0 = *(const f32x4*)(wrow + s0), w1 = *(const f32x4*)(wrow + s0 + 4);
            u32x4 bw; bw.x = cvt_pk_bf16(s0 + 0 <= t ? w0[0] : 0.f, s0 + 1 <= t ? w0[1] : 0.f); bw.y = cvt_pk_bf16(s0 + 2 <= t ? w0[2] : 0.f, s0 + 3 <= t ? w0[3] : 0.f);
            bw.z = cvt_pk_bf16(s0 + 4 <= t ? w1[0] : 0.f, s0 + 5 <= t ? w1[1] : 0.f); bw.w = cvt_pk_bf16(s0 + 6 <= t ? w1[2] : 0.f, s0 + 7 <= t ? w1[3] : 0.f);
            acc = __builtin_amdgcn_mfma_f32_32x32x16_bf16(af, __builtin_bit_cast(bf16x8, bw), acc, 0, 0, 0);
        }
        const float bias = sb[g * 128 + t]; const size_t row = (size_t)(m0 + t);
        const float* gp = gain + g * 64 + 32 * dt + 4 * hi; const bf16_t* up = PROJ + row * PW + P_AU + g * 64 + 32 * dt + 4 * hi; bf16_t* yp = Y + row * D + g * 64 + 32 * dt + 4 * hi;
#pragma unroll
        for (int g4 = 0; g4 < 4; ++g4) { const f32x4 gv = *(const f32x4*)(gp + 8 * g4); const u32x2 uw = *(const u32x2*)(up + 8 * g4); u32x2 ow;
            ow.x = cvt_pk_bf16(lo_bf(uw.x) * (gv[0] * acc[4 * g4] + bias), hi_bf(uw.x) * (gv[1] * acc[4 * g4 + 1] + bias));
            ow.y = cvt_pk_bf16(lo_bf(uw.y) * (gv[2] * acc[4 * g4 + 2] + bias), hi_bf(uw.y) * (gv[3] * acc[4 * g4 + 3] + bias));
            *(u32x2*)(yp + 8 * g4) = ow; }
        __syncthreads();
    }
}

__device__ __forceinline__ void mlstm1_mfma(Frame& F, int l) {
    const float* MISC = (const float*)WSP(WS_MISC); float* STATE = (float*)WSP(WS_STATE); const bf16_t* PROJ = (const bf16_t*)WSP(WS_BIG); const bf16_t* CVT = (const bf16_t*)WSP(WS_CVT);
    const float* i_bias = INP(I_I_BIAS); const float* f_bias = INP(I_F_BIAS);
    const int lane = (F.tid & 63), r32 = lane & 31, hi = lane >> 5, grp = F.wave >> 2, w4 = F.wave & 3, et = w4 & 1, dt = w4 >> 1, lg = F.tid & 255;
    constexpr int KROWB = 144, GB = 20480;
    LAS unsigned char* gb = F.lds + grp * GB;
    LAS float* bc = (LAS float*)gb; LAS float* wk = bc + 128; LAS unsigned char* kt = gb + 1024;
    for (int it0 = 2 * F.vcu; it0 < 512; it0 += 2 * F.G) {
        const int item = it0 + grp, bh = item >> 5, c = item & 31, b = bh >> 2, h = bh & 3, m0 = b * S + c * 128;
        if (lg < 128) { const float f = MISC[(size_t)(m0 + lg) * 16 + 12 + h] + f_bias[l * 4 + h]; bc[lg] = fminf(f, 0.f) - log1pf(__expf(-fabsf(f))); wk[lg] = MISC[(size_t)(m0 + lg) * 16 + 8 + h] + i_bias[l * 4 + h]; }
        __syncthreads();
        if (lg < 64) { const float a0 = bc[2 * lane], a1 = bc[2 * lane + 1]; float s = a0 + a1;
#pragma unroll
            for (int o = 1; o < 64; o <<= 1) { const float t = __shfl_up(s, o); if (lane >= o) s += t; }
            const float tot = __shfl(s, 63), ex = s - (a0 + a1);
            wk[2 * lane] = __expf(tot - (ex + a0) + wk[2 * lane]); wk[2 * lane + 1] = __expf(tot - s + wk[2 * lane + 1]);
            if (lane == 0) bc[0] = tot; }
        __syncthreads();
        const float Bc = bc[0];
#pragma unroll
        for (int k = 0; k < 4; ++k) { const int id = lg + 256 * k, s = id >> 3, ch = id & 7; const float ws_ = wk[s];
            const u32x4 w = *(const u32x4*)(PROJ + (size_t)(m0 + s) * PW + P_CK + h * 64 + ch * 8); u32x4 o;
            o.x = cvt_pk_bf16(lo_bf(w.x) * ws_, hi_bf(w.x) * ws_); o.y = cvt_pk_bf16(lo_bf(w.y) * ws_, hi_bf(w.y) * ws_); o.z = cvt_pk_bf16(lo_bf(w.z) * ws_, hi_bf(w.z) * ws_); o.w = cvt_pk_bf16(lo_bf(w.w) * ws_, hi_bf(w.w) * ws_);
            *(LAS u32x4*)(kt + s * KROWB + ch * 16) = o; }
        __syncthreads();
        f32x16 acc;
#pragma unroll
        for (int r = 0; r < 16; ++r) acc[r] = 0.f;
        float nsum = 0.f;
        const bf16_t* vp = CVT + (size_t)(b * 256 + h * 64 + 32 * et + r32) * S + c * 128 + 8 * hi;
        bf16x8 af[8];
#pragma unroll
        for (int ks = 0; ks < 8; ++ks) af[ks] = *(const bf16x8*)(vp + 16 * ks);
#pragma unroll
        for (int ks = 0; ks < 8; ++ks) {
            const LAS unsigned char* kp = kt + (16 * ks + 8 * hi) * KROWB + (32 * dt + r32) * 2; unsigned e8[8];
#pragma unroll
            for (int jj = 0; jj < 8; ++jj) e8[jj] = *(const LAS bf16_t*)(kp + jj * KROWB);
            u32x4 bw; bw.x = e8[0] | (e8[1] << 16); bw.y = e8[2] | (e8[3] << 16); bw.z = e8[4] | (e8[5] << 16); bw.w = e8[6] | (e8[7] << 16);
#pragma unroll
            for (int jj = 0; jj < 8; ++jj) nsum += __uint_as_float(e8[jj] << 16);
            acc = __builtin_amdgcn_mfma_f32_32x32x16_bf16(af[ks], __builtin_bit_cast(bf16x8, bw), acc, 0, 0, 0);
        }
        float* st = STATE + (size_t)item * STATE_STRIDE;
#pragma unroll
        for (int r = 0; r < 16; ++r) st[(32 * et + (r & 3) + 8 * (r >> 2) + 4 * hi) * 64 + 32 * dt + r32] = acc[r];
        nsum += __shfl_xor(nsum, 32);
        if (et == 0 && hi == 0) st[4096 + 32 * dt + r32] = nsum;
        if (lg == 0) st[4160] = Bc;
        __syncthreads();
    }
}
#ifndef MK_MULTI
#define MK_MULTI 0
#endif
constexpr int N_PHASES = 1 + 10 * DEPTH;

__global__ void __launch_bounds__(NT, 2) mk_fwd(Args args) {
    extern __shared__ __attribute__((aligned(16))) unsigned char lds_raw[];
    Frame F;
    F.lds = (LAS unsigned char*)lds_raw; F.tid = threadIdx.x; F.wave = __builtin_amdgcn_readfirstlane(F.tid >> 6);
    F.G = gridDim.x; { const int bx_ = blockIdx.x; F.vcu = (F.G % 8 == 0) ? (bx_ % 8) * (F.G / 8) + bx_ / 8 : bx_; }
    if (F.tid < 20) { const unsigned long long pv = F.tid < 18 ? (unsigned long long)args.in[F.tid < 18 ? F.tid : 0] : (F.tid == 18 ? (unsigned long long)args.out : (unsigned long long)args.ws);
        *(LAS unsigned long long*)(F.lds + PTR_OFF + 8 * F.tid) = pv; }
    if (F.tid < 2) *(LAS unsigned*)(F.lds + PTR_OFF + 256 + 4 * F.tid) = 0u;
    __syncthreads();
#if MK_MULTI
    int bx = (int)blockIdx.x;
    const int lo = args.ph_lo, hi = args.ph_hi; const bool coop = args.coop != 0;
#else
    int bx = (int)blockIdx.x;
    constexpr int lo = 0, hi = N_PHASES - 1; constexpr bool coop = true;
    if (F.tid == 0) (void)xb_add(&((unsigned*)(args.ws + WS_BAR))[XB_XCNT(xb_xcc_id())], 1u);
#endif
#define XBAR_NOW() XcdBarrier{(unsigned*)WSP(WS_BAR), xb_xcc_id(), (volatile LAS unsigned*)(F.lds + PTR_OFF + 256)}
#define RUN(k) (lo <= (k) && (k) < hi)
#define LAUNDER() asm volatile("" : "+v"(F.tid), "+s"(F.G), "+s"(F.vcu), "+s"(F.wave), "+s"(bx), "+s"(F.lds))
#ifndef MK_SKEW_SLEEP
#define MK_SKEW_SLEEP 0
#endif
#define SKEW() do { if (coop) { for (unsigned s_ = ((unsigned)blockIdx.x >> 3) & 3u; s_ > 0; --s_) __builtin_amdgcn_s_sleep(MK_SKEW_SLEEP); } } while (0)
#ifdef MK_PROBE_BAR2
#define SEAM(k) do { if (coop && RUN(k) && RUN((k) + 1)) { { const XcdBarrier xb_ = XBAR_NOW(); xcd_barrier(xb_); } { const XcdBarrier xb_ = XBAR_NOW(); xcd_barrier(xb_); } } } while (0)
#else
#define SEAM(k) do { if (coop && RUN(k) && RUN((k) + 1)) { const XcdBarrier xb_ = XBAR_NOW(); xcd_barrier(xb_); } } while (0)
#endif

    if (args.pad == 0x5a5a5a5a) cg::this_grid().sync();
    if (RUN(0)) { LAUNDER(); convert_mix_weights(F, 0); prologue_rows(F);
        if (blockIdx.x == 0 && F.tid < DEPTH * 192) { const int l_ = F.tid / 192, r_ = F.tid % 192, w_ = r_ / 64, i_ = r_ % 64; ((float*)WSP(WS_GT))[F.tid] = INP(I_Q_NORM + w_)[l_ * 64 + i_]; } }
    SEAM(0);
#pragma unroll 1
    for (int l = 0; l < DEPTH; ++l) {
        const int pb = 1 + 10 * l;
        if (RUN(pb + 0)) { LAUNDER(); SKEW();
            pg8::Gemm<D, D, D, 256u * D * 2, 0, 256u * D * 2, 0> g{(const bf16_t*)WSP(WS_XG), (const bf16_t*)WSP(WS_WIN)};
            pg8::StaticOrder So; So.init(M, PW, F.G, bx);
            epi::EpiProj E{(bf16_t*)WSP(WS_BIG), (float*)WSP(WS_MISC), (const float*)WSP(WS_RSA), (const float*)WSP(WS_COS), (const float*)WSP(WS_SIN), (const float*)WSP(WS_GT) + l * 192, (bf16_t*)WSP(WS_VT), (bf16_t*)WSP(WS_KI), (bf16_t*)WSP(WS_CVT), (float*)WSP(WS_SSQV)};
            pg8::gemm_phase<epi::EpiProj, pg8::StaticOrder, true>(F.lds, g, So, E, F.tid);
        }
        SEAM(pb + 0);
        if (RUN(pb + 1)) { LAUNDER(); sgu_mfma(F, l); conv_simple(F, l); indexer_mfma(F); mlstm1_mfma(F, l); }
        SEAM(pb + 1);
        if (RUN(pb + 2)) { LAUNDER(); attn_mfma(F, l); mlstm2_mfma(F, l); }
        SEAM(pb + 2);
        if (RUN(pb + 3)) { LAUNDER(); SKEW();
            pg8::Gemm<256, D, 256, 256u * D * 2, 256u * 2, 256u * 256 * 2, 1024u * 256 * 2> g{(const bf16_t*)WSP(WS_Y), (const bf16_t*)WSP(WS_WBR)};
            pg8::SuperOrder<0> So; So.init(F.G, bx);
            epi::EpiPlain E{(bf16_t*)WSP(WS_BIG), 4096, 1024};
            pg8::gemm_phase<epi::EpiPlain, pg8::SuperOrder<0>, true>(F.lds, g, So, E, F.tid);
        }
        if (coop && RUN(pb + 3) && RUN(pb + 4)) { asm volatile("s_waitcnt vmcnt(0)" ::: "memory"); __syncthreads(); __builtin_amdgcn_fence(__ATOMIC_ACQUIRE, "agent"); asm volatile("s_waitcnt vmcnt(0)" ::: "memory"); __syncthreads(); }
        if (RUN(pb + 4)) { LAUNDER();
            pg8::Gemm<D, D, D, 256u * D, 0, 256u * D, 0, 1> g{ptr_at(F, I_OUT) + OUT_X8, ptr_at(F, I_OUT) + OUT_WG8 + (size_t)l * 4 * MiB};
            pg8::SuperOrder<1> So; So.init(F.G, bx);
            epi::EpiGate E{(bf16_t*)WSP(WS_MG), (const bf16_t*)WSP(WS_BIG), (const float*)WSP(WS_RSA)};
            pg8::gemm_phase<epi::EpiGate, pg8::SuperOrder<1>, true>(F.lds, g, So, E, F.tid);
        }
        SEAM(pb + 4);
        if (RUN(pb + 5)) { LAUNDER();
            pg8::Gemm<D, D, D, 256u * D * 2, 0, 256u * D * 2, 0> g{(const bf16_t*)WSP(WS_MG), (const bf16_t*)WSP(WS_WOUT)};
            pg8::StaticOrder So; So.init(M, D, F.G, bx);
            epi::EpiResid E{l == 0 ? INP(I_X) : nullptr, (bf16_t*)WSP(WS_XG), nullptr, (float*)WSP(WS_SSQB), nullptr};
            pg8::gemm_phase<epi::EpiResid, pg8::StaticOrder, true>(F.lds, g, So, E, F.tid);
            __syncthreads();
            convert_mlp_weights(F, l);
        }
        SEAM(pb + 5);
        if (RUN(pb + 6)) { LAUNDER(); finalize_rs(F, WS_SSQB, WS_RSB); }
        SEAM(pb + 6);
        if (RUN(pb + 7)) { LAUNDER(); SKEW();
            pg8::Gemm<D, D, D, 256u * D * 2, 0, 256u * D * 2, 0> g{(const bf16_t*)WSP(WS_XG), (const bf16_t*)WSP(WS_WUP)};
            pg8::StaticOrder So; So.init(M, FF, F.G, bx);
            epi::EpiUp E{(bf16_t*)WSP(WS_BIG), (const float*)WSP(WS_RSB)};
            pg8::gemm_phase<epi::EpiUp, pg8::StaticOrder, true>(F.lds, g, So, E, F.tid);
            if (l + 1 < DEPTH) { __syncthreads(); convert_mix_weights(F, l + 1); }
        }
        SEAM(pb + 7);
        if (RUN(pb + 8)) { LAUNDER();
            pg8::Gemm<FF, FF, FF, 256u * FF * 2, 0, 256u * FF * 2, 0> g{(const bf16_t*)WSP(WS_BIG), (const bf16_t*)WSP(WS_WDN)};
            pg8::StaticOrder So; So.init(M, D, F.G, bx);
            epi::EpiResid E{nullptr, (bf16_t*)WSP(WS_XG), (l + 1 < DEPTH) ? nullptr : (float*)ptr_at(F, I_OUT), (float*)WSP(WS_SSQA), (l + 1 < DEPTH) ? ptr_at(F, I_OUT) + OUT_X8 : nullptr};
            pg8::gemm_phase<epi::EpiResid, pg8::StaticOrder, true>(F.lds, g, So, E, F.tid);
        }
        SEAM(pb + 8);
        if (RUN(pb + 9)) { LAUNDER(); if (l + 1 < DEPTH) finalize_rs(F, WS_SSQA, WS_RSA); }
        SEAM(pb + 9);
    }
#undef RUN
#undef SEAM
}

extern "C" void kernel_launch(void* const* d_in, const int* in_sizes, int n_in, void* d_out, int out_size, void* d_ws, size_t ws_size, hipStream_t stream) {
    static int grid = 0;
    if (grid == 0) {
        if (n_in != 18 || in_sizes[0] != M * D || out_size != M * D || ws_size < WS_END) { fprintf(stderr, "kernel_launch: unexpected shapes (n_in %d, in0 %d, out %d, ws %zu)\n", n_in, n_in > 0 ? in_sizes[0] : -1, out_size, ws_size); grid = -1; return; }
        int dev = 0, cus = 0, per_cu = 0;
        if (hipGetDevice(&dev) != hipSuccess || hipDeviceGetAttribute(&cus, hipDeviceAttributeMultiprocessorCount, dev) != hipSuccess) { grid = -1; return; }
        if (hipFuncSetAttribute((const void*)mk_fwd, hipFuncAttributeMaxDynamicSharedMemorySize, LDS_BYTES) != hipSuccess) { fprintf(stderr, "kernel_launch: hipFuncSetAttribute failed\n"); grid = -1; return; }
        if (hipOccupancyMaxActiveBlocksPerMultiprocessor(&per_cu, (const void*)mk_fwd, NT, LDS_BYTES) != hipSuccess || per_cu < 1) { fprintf(stderr, "kernel_launch: occupancy query says %d\n", per_cu); (void)hipGetLastError(); per_cu = 1; }
        grid = cus;
    }
    if (grid < 0) return;
    if (hipMemsetAsync((char*)d_ws + WS_CTL, 0, CTL_ZERO_BYTES, stream) != hipSuccess) { fprintf(stderr, "kernel_launch: memset failed\n"); return; }
    Args a{};
    for (int i = 0; i < 18; ++i) a.in[i] = (const float*)d_in[i];
    a.out = (float*)d_out; a.ws = (unsigned char*)d_ws;
#if MK_MULTI
    for (int p = 0; p < N_PHASES; ++p) { a.ph_lo = p; a.ph_hi = p + 1; a.coop = 0; hipLaunchKernelGGL(mk_fwd, dim3(grid), dim3(NT), LDS_BYTES, stream, a); }
#else
    a.ph_lo = 0; a.ph_hi = N_PHASES - 1; a.coop = 1;
    void* kargs[] = {&a};
    hipError_t e = hipLaunchCooperativeKernel((const void*)mk_fwd, dim3(grid), dim3(NT), kargs, LDS_BYTES, stream);
    if (e != hipSuccess) fprintf(stderr, "kernel_launch: cooperative launch failed: %s (grid %d)\n", hipGetErrorString(e), grid);
#endif
}
```

```cpp
#include <hip/hip_runtime.h>
#define MK_MULTI 0
#include <hip/hip_cooperative_groups.h>
#include <cstdio>
#include <cstdint>
namespace cg = cooperative_groups;

#define LAS __attribute__((address_space(3)))
typedef unsigned short bf16_t;
typedef short bf16x8 __attribute__((ext_vector_type(8)));
typedef float f32x4 __attribute__((ext_vector_type(4)));
typedef float f32x2 __attribute__((ext_vector_type(2)));
typedef unsigned u32x4 __attribute__((ext_vector_type(4)));
typedef unsigned u32x2 __attribute__((ext_vector_type(2)));
typedef int i32x4 __attribute__((ext_vector_type(4)));
typedef int i32x8 __attribute__((ext_vector_type(8)));

constexpr int D = 1024, NB = 4, S = 4096, M = NB * S, DEPTH = 2, FF = 4096, INW = 7760;
constexpr int O_AU = 0, O_AV = 256, O_BQ = 512, O_BK = 768, O_BV = 1024, O_QI = 1280, O_KI = 1792, O_WI = 1856,
              O_CQ = 1864, O_CK = 2120, O_CV = 2376, O_CO = 2632, O_CI = 2888, O_CF = 2892, O_DB = 2896, O_DC = 3152, O_DX = 3408, O_G = 3664;
constexpr int PW = 3840;
constexpr int P_AU = 0, P_AV = 256, P_Q = 512, P_K = 768, P_V = 1024, P_QI = 1280, P_CQ = 1792, P_CK = 2048, P_CV = 2304, P_CO = 2560,
              P_DB = 2816, P_DC = 3072, P_DX = 3328, P_KI = 3584;
constexpr float EPS = 1e-6f;
constexpr int NWAVES = 8, NT = 512;

constexpr size_t MiB = 1u << 20;
constexpr size_t WS_CTL = 0;
constexpr size_t WS_COS = 1 * MiB, WS_SIN = 1 * MiB + 512 * 1024;
constexpr size_t WS_MISC = 2 * MiB;
constexpr size_t WS_SSQA = 3 * MiB, WS_SSQB = 4 * MiB;
constexpr size_t WS_WIN = 5 * MiB;
constexpr size_t WS_WG = WS_WIN + (size_t)PW * D * 2;
constexpr size_t WS_WBR = WS_WG + (size_t)4096 * D * 2;
constexpr size_t WS_WOUT = WS_WBR + (size_t)4 * 1024 * 256 * 2;
constexpr size_t WS_XG = 25 * MiB;
constexpr size_t WS_BIG = 57 * MiB;
constexpr size_t WS_Y = 185 * MiB;
constexpr size_t WS_WUP = WS_Y, WS_WDN = WS_Y + 8 * MiB;
constexpr size_t WS_MG = 217 * MiB;
constexpr size_t WS_MASK = WS_MG, WS_STATE = WS_MG + 8 * MiB;
constexpr size_t WS_END = 249 * MiB;
constexpr int STATE_STRIDE = 4224;
static_assert(WS_WOUT + (size_t)D * D * 2 <= WS_XG && WS_STATE + (size_t)512 * STATE_STRIDE * 4 <= WS_END && WS_END <= 256 * MiB, "d_ws map");

constexpr size_t OUT_X8 = 0;
constexpr size_t OUT_WG8 = 16 * MiB;
constexpr float WG8_SCALE = 64.f;
constexpr int LDS_BYTES = 155648;

__device__ __forceinline__ float bf2f(bf16_t v) { return __uint_as_float((unsigned)v << 16); }
__device__ __forceinline__ unsigned f2bf(float f) { unsigned u = __float_as_uint(f); return (u + 0x7fffu + ((u >> 16) & 1u)) >> 16; }
__device__ __forceinline__ unsigned pk2(float lo, float hi) { return f2bf(lo) | (f2bf(hi) << 16); }
typedef __bf16 bf16x2_t __attribute__((ext_vector_type(2)));
__device__ __forceinline__ unsigned cvt_pk_bf16(float lo, float hi) { const f32x2 v = {lo, hi}; return __builtin_bit_cast(unsigned, __builtin_convertvector(v, bf16x2_t)); }
__device__ __forceinline__ unsigned pk4_fp8(float a, float b, float c, float d) { int w = __builtin_amdgcn_cvt_pk_fp8_f32(a, b, 0, false); w = __builtin_amdgcn_cvt_pk_fp8_f32(c, d, w, true); return (unsigned)w; }
__device__ __forceinline__ float lo_bf(unsigned w) { return __uint_as_float(w << 16); }
__device__ __forceinline__ float hi_bf(unsigned w) { return __uint_as_float(w & 0xffff0000u); }
__device__ __forceinline__ float wave_sum(float v) {
#pragma unroll
    for (int o = 1; o < 64; o <<= 1) v += __shfl_xor(v, o);
    return v;
}
__device__ __forceinline__ float wave_max(float v) {
#pragma unroll
    for (int o = 1; o < 64; o <<= 1) v = fmaxf(v, __shfl_xor(v, o));
    return v;
}
__device__ __forceinline__ int wave_sum_i(int v) {
#pragma unroll
    for (int o = 1; o < 64; o <<= 1) v += __shfl_xor(v, o);
    return v;
}
__device__ __forceinline__ float sigmoid_f(float x) { return __builtin_amdgcn_rcpf(1.f + __builtin_amdgcn_exp2f(-1.4426950408889634f * x)); }
__device__ __forceinline__ float gelu_tanh_f(float x) { const float u = 0.7978845608028654f * (x + 0.044715f * x * x * x); return x * __builtin_amdgcn_rcpf(1.f + __builtin_amdgcn_exp2f(-2.8853900817779268f * u)); }
__device__ __forceinline__ float relu_f(float x) { const int b = __builtin_bit_cast(int, x); return __builtin_bit_cast(float, b > 0 ? b : 0); }
__device__ __forceinline__ unsigned fkey(float s) { const unsigned u = __float_as_uint(s); return (u & 0x80000000u) ? ~u : (u | 0x80000000u); }

__device__ __forceinline__ void st16(void* p, const u32x4 v, const bool wt) { if (wt) asm volatile("global_store_dwordx4 %0, %1, off sc1\n\ts_nop 1" :: "v"(p), "v"(v) : "memory"); else *(u32x4*)p = v; }

namespace pg8 {
constexpr int BM = 256, BK = 64, HALF = 128, HTB = HALF * BK * 2, STAGE_BYTES = 8 * HTB, NXCD = 8, WGM = 8, RS_OFF = STAGE_BYTES;
__host__ __device__ __forceinline__ int lds_byte(int r, int c) { const int st = (r >> 4) * 2 + (c >> 5), rr = r & 15, cc = c & 31, ob = rr * 64 + cc * 2; return st * 1024 + (ob ^ (((ob >> 9) & 1) << 5)); }
__host__ __device__ __forceinline__ void stage_rc(int b, int& R, int& C) { const int st = b / 1024, sb = b % 1024, swz = sb ^ (((sb >> 9) & 1) << 5); R = (st >> 1) * 16 + swz / 64; C = (st & 1) * 32 + (swz % 64) / 2; }
__host__ __device__ __forceinline__ int perm32(int rho) { const int n = rho >> 4, i = rho & 15; return 8 * (i >> 2) + 4 * n + (i & 3); }

struct Unit { int pm, pn, z; };
template <int K_, int LDA_, int LDB_, unsigned APM_, unsigned AZ_, unsigned BPN_, unsigned BZ_, int ESZ_ = 2> struct Gemm {
    const void* A; const void* Bt;
    static constexpr int K = K_, lda = LDA_, ldb = LDB_, esz = ESZ_; static constexpr unsigned aPm = APM_, aZ = AZ_, bPn = BPN_, bZ = BZ_;
};
template <class G> __device__ __forceinline__ const char* pa(const G& g, const Unit& u) { return (const char*)g.A + (size_t)((unsigned)u.pm * G::aPm + (unsigned)u.z * G::aZ); }
template <class G> __device__ __forceinline__ const char* pb(const G& g, const Unit& u) { return (const char*)g.Bt + (size_t)((unsigned)u.pn * G::bPn + (unsigned)u.z * G::bZ); }

struct StaticOrder {
    int nM, nN, nwg, G, c;
    __host__ __device__ void init(int M_, int N_, int G_, int c_) { nM = M_ / BM; nN = N_ / BM; nwg = nM * nN; G = G_; c = c_; }
    __host__ __device__ bool next(int i, Unit& u) const {
        const long L = (long)i * G + c; if (L >= nwg) return false;
        int wgid = (int)L; { const int q = nwg / NXCD, r = nwg % NXCD, xcd = wgid % NXCD, off = wgid / NXCD; wgid = (xcd < r ? xcd * (q + 1) : r * (q + 1) + (xcd - r) * q) + off; }
        const int nig = WGM * nN, gid = wgid / nig, fm = gid * WGM, gsz = (nM - fm) < WGM ? (nM - fm) : WGM;
        u.pm = fm + ((wgid % nig) % gsz); u.pn = (wgid % nig) / gsz; u.z = 0; return true;
    }
};
template <int MODE> struct SuperOrder {
    StaticOrder so;
    __host__ __device__ void init(int G_, int c_) { so.init(M, 1024, G_, c_); }
    __host__ __device__ bool next(int i, Unit& u) const {
        Unit b; if (!so.next(i >> 2, b)) return false;
        const int sub = i & 3; u.pm = b.pm; if (MODE == 0) { u.pn = b.pn; u.z = sub; } else { u.pn = 4 * b.pn + sub; u.z = 0; } return true;
    }
};

template <class Epi, class Sched, bool ALIGN_EPI, class GemmT>
__device__ __forceinline__ void gemm_phase(LAS unsigned char* lds, const GemmT g, const Sched& S, const Epi& E, const int tid) {
    const int wid = __builtin_amdgcn_readfirstlane(tid >> 6), lane = tid & 63, wr = wid >> 2, wc = wid & 3, fr = lane & 15, fq = lane >> 4;
    constexpr int K = GemmT::K, ESZ = GemmT::esz, nt = K * ESZ / (BK * 2);
    unsigned voffA[2], voffB[2];
#pragma unroll
    for (int i = 0; i < 2; ++i) { int R, C; stage_rc(tid * 16 + i * 8192, R, C); const int Rb = Epi::PERM ? ((R & ~31) + perm32(R & 31)) : R;
        voffA[i] = (unsigned)(R * GemmT::lda * ESZ + C * 2); voffB[i] = (unsigned)(Rb * GemmT::ldb * ESZ + C * 2); }
    const size_t kstep = (size_t)(BK * 2);
    constexpr size_t hA = (size_t)HALF * GemmT::lda * ESZ, hB = (size_t)HALF * GemmT::ldb * ESZ;
    const unsigned ldsw = (unsigned)wid * 1024u;
    constexpr int FCOL = (ESZ == 2) ? 8 : 16, KOFF = (ESZ == 2) ? 1024 : 16;
    const int aoff = lds_byte(wr * 64 + fr, fq * FCOL), boff = lds_byte(wc * 32 + fr, fq * FCOL);
    int one_scale = 0x7f7f7f7f; asm volatile("" : "+v"(one_scale));
#define PG8_SA(b, h) (((b) * 2 + (h)) * HTB)
#define PG8_SB(b, h) ((4 + (b) * 2 + (h)) * HTB)
#define PG8_STAGE(bufoff, gbase, voff) do { _Pragma("unroll") for (int _i = 0; _i < 2; ++_i) \
        __builtin_amdgcn_global_load_lds((const unsigned*)((const char*)(gbase) + (voff)[_i]), (LAS unsigned*)(lds + (bufoff) + ldsw + _i * 8192), 16, 0, 0); } while (0)
#define PG8_LDA(dst, b, h) do { _Pragma("unroll") for (int m = 0; m < 4; ++m) _Pragma("unroll") for (int k = 0; k < 2; ++k) dst[m][k] = *(const LAS bf16x8*)(lds + PG8_SA(b, h) + aoff + m * 2048 + k * KOFF); } while (0)
#define PG8_LDB(dst, b, h) do { _Pragma("unroll") for (int n = 0; n < 2; ++n) _Pragma("unroll") for (int k = 0; k < 2; ++k) dst[n][k] = *(const LAS bf16x8*)(lds + PG8_SB(b, h) + boff + n * 2048 + k * KOFF); } while (0)
#define PG8_MMA(ai, bj, At, Bt) do { __builtin_amdgcn_s_setprio(1); _Pragma("unroll") for (int m = 0; m < 4; ++m) _Pragma("unroll") for (int n = 0; n < 2; ++n) { \
        if constexpr (ESZ == 2) { _Pragma("unroll") for (int k = 0; k < 2; ++k) acc[ai][bj][m][n] = __builtin_amdgcn_mfma_f32_16x16x32_bf16(Bt[n][k], At[m][k], acc[ai][bj][m][n], 0, 0, 0); } \
        else { const i32x8 a8_ = __builtin_shufflevector(__builtin_bit_cast(i32x4, At[m][0]), __builtin_bit_cast(i32x4, At[m][1]), 0, 1, 2, 3, 4, 5, 6, 7), b8_ = __builtin_shufflevector(__builtin_bit_cast(i32x4, Bt[n][0]), __builtin_bit_cast(i32x4, Bt[n][1]), 0, 1, 2, 3, 4, 5, 6, 7); \
              \
            asm volatile("v_mfma_scale_f32_16x16x128_f8f6f4 %0, %1, %2, %0, %3, %3 op_sel_hi:[0,0,0]" : "+v"(acc[ai][bj][m][n]) : "v"(b8_), "v"(a8_), "v"(one_scale)); } } \
        __builtin_amdgcn_s_setprio(0); } while (0)
#define PG8_WAIT_V(n) asm volatile("s_waitcnt vmcnt(" #n ")" ::: "memory")
#define PG8_WAIT_L(n) asm volatile("s_waitcnt lgkmcnt(" #n ")" ::: "memory")
#define PG8_BAR __builtin_amdgcn_s_barrier()
#define PG8_SCHED __builtin_amdgcn_sched_barrier(0)
#define PG8_WAIT_VN(n) asm volatile("s_waitcnt vmcnt(%0)" :: "n"(n) : "memory")
    constexpr int RSN = Epi::RS ? 1 : 0, WN1 = 8 + RSN, WN2 = 8 + RSN + Epi::VM_MIN;
#define PG8_WAIT_SEL do { if (wsel == 0) PG8_WAIT_V(8); else if (wsel == 1) PG8_WAIT_VN(WN1); else PG8_WAIT_VN(WN2); } while (0)
#define PG8_RS(slot, pm_) do { if constexpr (Epi::RS) { int l2_ = lane; asm volatile("" : "+v"(l2_));     \
        __builtin_amdgcn_global_load_lds((const unsigned*)(E.ssq + (pm_) * 256 + (wid & 3) * 64 + l2_), (LAS unsigned*)(lds + RS_OFF + (slot) * 1024 + (wid & 3) * 256), 4, 0, 0); } } while (0)
    Unit cur, nxt; int ui = 0;
    if (!S.next(0, cur)) return;
    f32x4 acc[2][2][4][2];
#pragma unroll
    for (int a = 0; a < 2; ++a)
#pragma unroll
        for (int b = 0; b < 2; ++b)
#pragma unroll
            for (int m = 0; m < 4; ++m)
#pragma unroll
                for (int n = 0; n < 2; ++n) acc[a][b][m][n] = (f32x4){0.f, 0.f, 0.f, 0.f};
    bf16x8 At[4][2], B0[2][2], B1[2][2];
    const char* cA = pa(g, cur); const char* cB = pb(g, cur);
    PG8_RS(0, cur.pm);
    PG8_STAGE(PG8_SB(0, 0), cB, voffB); PG8_STAGE(PG8_SB(0, 1), cB + hB, voffB); PG8_STAGE(PG8_SA(0, 0), cA, voffA); PG8_STAGE(PG8_SA(0, 1), cA + hA, voffA);
    if (wr == 1) PG8_BAR;
    PG8_WAIT_V(2); PG8_BAR;
    PG8_STAGE(PG8_SB(1, 0), cB + kstep, voffB); PG8_STAGE(PG8_SA(1, 0), cA + kstep, voffA); PG8_STAGE(PG8_SB(1, 1), cB + hB + kstep, voffB);
    PG8_WAIT_V(6); PG8_BAR;
    int wsel = 0;
    for (;;) {
        const bool has_next = S.next(ui + 1, nxt);
        const char* nA = has_next ? pa(g, nxt) : cA; const char* nB = has_next ? pb(g, nxt) : cB;
        asm volatile(".p2align 8");
#pragma unroll 1
        for (int t = 0; t < nt; t += 2) {
            const bool last = (t == nt - 2);
            const char* a1 = cA + (size_t)(t + 1) * kstep;
            const char* a2 = last ? nA : cA + (size_t)(t + 2) * kstep; const char* b2 = last ? nB : cB + (size_t)(t + 2) * kstep;
            const char* a3 = a2 + kstep; const char* b3 = b2 + kstep;
            PG8_LDB(B0, 0, 0); PG8_LDB(B1, 0, 1); PG8_SCHED; PG8_LDA(At, 0, 0); if (wsel == 0) PG8_STAGE(PG8_SA(1, 1), a1 + hA, voffA);
            PG8_WAIT_SEL; PG8_WAIT_L(0); PG8_BAR; PG8_MMA(0, 0, At, B0); PG8_MMA(0, 1, At, B1); PG8_BAR; PG8_SCHED;
            PG8_LDA(At, 0, 1); PG8_STAGE(PG8_SB(0, 0), b2, voffB); PG8_STAGE(PG8_SB(0, 1), b2 + hB, voffB); PG8_STAGE(PG8_SA(0, 0), a2, voffA);
            PG8_WAIT_SEL; PG8_WAIT_L(0); PG8_BAR; PG8_MMA(1, 0, At, B0); PG8_MMA(1, 1, At, B1); PG8_BAR; PG8_SCHED;
            PG8_LDB(B0, 1, 0); PG8_LDB(B1, 1, 1); PG8_SCHED; PG8_LDA(At, 1, 0); PG8_STAGE(PG8_SA(0, 1), a2 + hA, voffA);
            PG8_WAIT_SEL; PG8_WAIT_L(0); PG8_BAR; PG8_MMA(0, 0, At, B0); PG8_MMA(0, 1, At, B1); PG8_BAR; PG8_SCHED;
            PG8_LDA(At, 1, 1); PG8_STAGE(PG8_SB(1, 0), b3, voffB); PG8_STAGE(PG8_SB(1, 1), b3 + hB, voffB); PG8_STAGE(PG8_SA(1, 0), a3, voffA);
            PG8_WAIT_V(8); PG8_WAIT_L(0); PG8_BAR; PG8_MMA(1, 0, At, B0); PG8_MMA(1, 1, At, B1); PG8_BAR; PG8_SCHED;
            wsel = 0;
        }
        if (has_next) { PG8_STAGE(PG8_SA(1, 1), nA + kstep + hA, voffA); PG8_RS((ui + 1) & 1, nxt.pm); }
        asm volatile("" ::: "memory"); PG8_SCHED;
        if constexpr (ALIGN_EPI) { if (wr == 0) PG8_BAR; }
        int eops;
        { int fr2 = fr, fq2 = fq; asm volatile("" : "+v"(fr2), "+v"(fq2)); eops = E(acc, cur, wr, wc, fr2, fq2, (const LAS float*)(lds + RS_OFF + (ui & 1) * 1024), !has_next); }
        if (!has_next) break;
        wsel = (eops >= Epi::VM_MIN) ? 2 : 1;
#pragma unroll
        for (int a = 0; a < 2; ++a)
#pragma unroll
            for (int b = 0; b < 2; ++b)
#pragma unroll
                for (int m = 0; m < 4; ++m)
#pragma unroll
                    for (int n = 0; n < 2; ++n) acc[a][b][m][n] = (f32x4){0.f, 0.f, 0.f, 0.f};
        cur = nxt; cA = nA; cB = nB; ++ui;
        if constexpr (ALIGN_EPI) { if (wr == 1) PG8_BAR; }
    }
    PG8_WAIT_V(0);
    if constexpr (!ALIGN_EPI) { if (wr == 0) PG8_BAR; }
    PG8_BAR;
#undef PG8_SA
#undef PG8_SB
#undef PG8_STAGE
#undef PG8_LDA
#undef PG8_LDB
#undef PG8_MMA
#undef PG8_WAIT_V
#undef PG8_WAIT_VN
#undef PG8_WAIT_SEL
#undef PG8_RS
#undef PG8_WAIT_L
#undef PG8_BAR
#undef PG8_SCHED
}
}
namespace epi {
using pg8::Unit;
typedef f32x4 Acc[2][2][4][2];

__device__ __forceinline__ float row_scale(const float* rs, int row) { return rs[row]; }
__device__ __forceinline__ u32x4 pack8(const f32x4 a, const f32x4 b) { u32x4 w; w.x = cvt_pk_bf16(a[0], a[1]); w.y = cvt_pk_bf16(a[2], a[3]); w.z = cvt_pk_bf16(b[0], b[1]); w.w = cvt_pk_bf16(b[2], b[3]); return w; }

struct EpiProj {
    static constexpr bool PERM = true, RS = true; static constexpr int VM_MIN = 16;
    bf16_t* P; float* misc; const float* ssq; const float* cs; const float* sn; const float* gt;     bf16_t* VT;     bf16_t* KI;     bf16_t* CVT;     float* ssqv;
    __device__ __forceinline__ int operator()(const Acc& acc, const Unit& u, int wr, int wc, int fr, int fq, const LAS float* rsl, const bool lastu) const {
        const int T = u.pn; const int row0 = u.pm * 256 + wr * 64 + fr;
        float rsv[8];
#pragma unroll
        for (int i = 0; i < 8; ++i) rsv[i] = rsl[wr * 64 + fr + (i >> 2) * 128 + (i & 3) * 16];
        if (T == 2 || T == 3 || T == 5 || T == 6 || T == 14) {
            if (T == 14 && wc >= 2) return 0;
            if (T == 14 && wc == 1) {
                if (fq < 2) {
#pragma unroll
                    for (int ai = 0; ai < 2; ++ai)
#pragma unroll
                        for (int m = 0; m < 4; ++m) { const int row = row0 + ai * 128 + m * 16; const float rs = rsv[ai * 4 + m];
                            float* mp = misc + (size_t)row * 16 + 8 * fq; *(f32x4*)mp = acc[ai][0][m][0] * rs; *(f32x4*)(mp + 4) = acc[ai][0][m][1] * rs; }
                }
                return 16;
            }
            const int mode = (T == 14) ? 2 : (T <= 3 ? 1 : 0);
            const float* gp = gt + 64 * ((T == 2) ? 0 : (T == 3) ? 1 : 2);
            f32x4 g1[2], g2[2];
#pragma unroll
            for (int n = 0; n < 2; ++n) { if (mode) { g1[n] = *(const f32x4*)(gp + 8 * fq + 4 * n); g2[n] = *(const f32x4*)(gp + 32 + 8 * fq + 4 * n); } else { g1[n] = (f32x4){1.f, 1.f, 1.f, 1.f}; g2[n] = g1[n]; } }
#pragma unroll
            for (int ai = 0; ai < 2; ++ai) {
#pragma unroll
                for (int m = 0; m < 4; ++m) {
                    const int row = row0 + ai * 128 + m * 16; const float rs = rsv[ai * 4 + m];
                    f32x4 x1[2], x2[2];
#pragma unroll
                    for (int n = 0; n < 2; ++n) { x1[n] = acc[ai][0][m][n] * rs; x2[n] = acc[ai][1][m][n] * rs; }
                    if (mode == 2) {
                        float s = 0.f;
#pragma unroll
                        for (int n = 0; n < 2; ++n) s += (x1[n][0] + x1[n][1]) + (x1[n][2] + x1[n][3]) + (x2[n][0] + x2[n][1]) + (x2[n][2] + x2[n][3]);
                        s += __shfl_xor(s, 16); s += __shfl_xor(s, 32); const float mu = s * (1.f / 64.f);
#pragma unroll
                        for (int n = 0; n < 2; ++n) { x1[n] = x1[n] - mu; x2[n] = x2[n] - mu; }
                    }
                    if (mode) {
                        float q = 0.f;
#pragma unroll
                        for (int n = 0; n < 2; ++n) { const f32x4 a = x1[n] * x1[n], b = x2[n] * x2[n]; q += (a[0] + a[1]) + (a[2] + a[3]) + (b[0] + b[1]) + (b[2] + b[3]); }
                        q += __shfl_xor(q, 16); q += __shfl_xor(q, 32); const float rr = rsqrtf(q * (1.f / 64.f) + EPS);
#pragma unroll
                        for (int n = 0; n < 2; ++n) { x1[n] = x1[n] * rr * g1[n]; x2[n] = x2[n] * rr * g2[n]; }
                        if (T == 2) {
#pragma unroll
                            for (int n = 0; n < 2; ++n) { x1[n] = x1[n] * (0.125f * 1.4426950408889634f); x2[n] = x2[n] * (0.125f * 1.4426950408889634f); } }
                    }
                    f32x4 o1[2], o2[2];
#pragma unroll
                    for (int n = 0; n < 2; ++n) { const int pos = row & (S - 1); const f32x4 c = *(const f32x4*)(cs + (size_t)pos * 32 + 8 * fq + 4 * n), s = *(const f32x4*)(sn + (size_t)pos * 32 + 8 * fq + 4 * n);
                        o1[n] = x1[n] * c - x2[n] * s; o2[n] = x2[n] * c + x1[n] * s; }
                    bf16_t* op = P + (size_t)row * PW + 256 * T + 64 * wc + 8 * fq;
                    *(u32x4*)op = pack8(o1[0], o1[1]); *(u32x4*)(op + 32) = pack8(o2[0], o2[1]);
                    if (T == 14) {
                        bf16_t* kp = KI + ((size_t)((row >> 5) * 4 + (fq >> 1)) * 64 + (fq & 1) * 32 + (row & 31)) * 8; *(u32x4*)kp = pack8(o1[0], o1[1]); *(u32x4*)(kp + 2 * 64 * 8) = pack8(o2[0], o2[1]); }
                }
            }
            return 16;
        }
        const int act = (T <= 1) ? 1 : 0; const float sc = (T == 8) ? 0.125f : 1.0f;
#pragma unroll
        for (int ai = 0; ai < 2; ++ai)
#pragma unroll
            for (int m = 0; m < 4; ++m) {
                const int row = row0 + ai * 128 + m * 16; const float rs = rsv[ai * 4 + m] * sc;
                bf16_t* op = P + (size_t)row * PW + 256 * T + 32 * wc + 8 * fq; float qv = 0.f;
#pragma unroll
                for (int bj = 0; bj < 2; ++bj) { f32x4 v0 = acc[ai][bj][m][0] * rs, v1 = acc[ai][bj][m][1] * rs;
                    if (act) {
#pragma unroll
                        for (int e = 0; e < 4; ++e) { v0[e] = gelu_tanh_f(v0[e]); v1[e] = gelu_tanh_f(v1[e]); }
                        const f32x4 a2 = v0 * v0, b2 = v1 * v1; qv += ((a2[0] + a2[1]) + (a2[2] + a2[3])) + ((b2[0] + b2[1]) + (b2[2] + b2[3])); }
                    *(u32x4*)(op + bj * 128) = pack8(v0, v1);
                    if (T == 4 || T == 9) { bf16_t* vp = (T == 4 ? VT : CVT) + ((size_t)((row >> 12) * 256 + bj * 128 + 32 * wc + 8 * fq)) * S + (row & (S - 1));
#pragma unroll
                        for (int e = 0; e < 4; ++e) { vp[(size_t)e * S] = (bf16_t)f2bf(v0[e]); vp[(size_t)(4 + e) * S] = (bf16_t)f2bf(v1[e]); } } }
                if (T == 1) { qv += __shfl_xor(qv, 16); qv += __shfl_xor(qv, 32); if (fq == 0) ssqv[(size_t)row * 4 + wc] = qv; }
            }
        return 16;
    }
};

struct EpiPlain {
    static constexpr bool PERM = true, RS = false; static constexpr int VM_MIN = 16;
    bf16_t* O; int ldc; int zcols;
    __device__ __forceinline__ int operator()(const Acc& acc, const Unit& u, int wr, int wc, int fr, int fq, const LAS float*, const bool lastu) const {
        const int row0 = u.pm * 256 + wr * 64 + fr; const int col0 = u.z * zcols + u.pn * 256 + 32 * wc + 8 * fq;
#pragma unroll
        for (int ai = 0; ai < 2; ++ai)
#pragma unroll
            for (int m = 0; m < 4; ++m) { bf16_t* op = O + (size_t)(row0 + ai * 128 + m * 16) * ldc + col0;
#pragma unroll
                for (int bj = 0; bj < 2; ++bj) *(u32x4*)(op + bj * 128) = pack8(acc[ai][bj][m][0], acc[ai][bj][m][1]); }
        return 16;
    }
};

struct EpiGate {
    static constexpr bool PERM = true, RS = true; static constexpr int VM_MIN = 40;
    bf16_t* MG; const bf16_t* BR; const float* ssq;
    __device__ __forceinline__ int operator()(const Acc& acc, const Unit& u, int wr, int wc, int fr, int fq, const LAS float* rsl, const bool lastu) const {
        const int row0 = u.pm * 256 + wr * 64 + fr; const int ch0 = u.pn * 64 + 16 * wc + 4 * fq;
        float rsv[8];
#pragma unroll
        for (int i = 0; i < 8; ++i) rsv[i] = rsl[wr * 64 + fr + (i >> 2) * 128 + (i & 3) * 16] * (1.0f / WG8_SCALE);
#pragma unroll
        for (int ai = 0; ai < 2; ++ai) {
            u32x2 bw[4][4];
#pragma unroll
            for (int m = 0; m < 4; ++m)
#pragma unroll
                for (int nb = 0; nb < 4; ++nb) bw[m][nb] = *(const u32x2*)(BR + (size_t)(row0 + ai * 128 + m * 16) * 4096 + ch0 + nb * 1024);
#pragma unroll
            for (int m = 0; m < 4; ++m) {
                const int row = row0 + ai * 128 + m * 16; const float rs = rsv[ai * 4 + m]; f32x4 o = (f32x4){0.f, 0.f, 0.f, 0.f};
#pragma unroll
                for (int bj = 0; bj < 2; ++bj)
#pragma unroll
                    for (int n = 0; n < 2; ++n) { const u32x2 w = bw[m][2 * bj + n]; const f32x4 a = acc[ai][bj][m][n] * rs;
                        o[0] += sigmoid_f(a[0]) * lo_bf(w.x); o[1] += sigmoid_f(a[1]) * hi_bf(w.x); o[2] += sigmoid_f(a[2]) * lo_bf(w.y); o[3] += sigmoid_f(a[3]) * hi_bf(w.y); }
                u32x2 ow; ow.x = cvt_pk_bf16(o[0], o[1]); ow.y = cvt_pk_bf16(o[2], o[3]);
                *(u32x2*)(MG + (size_t)row * 1024 + ch0) = ow;
            }
        }
        return 40;
    }
};

struct EpiResid {
    static constexpr bool PERM = true, RS = false; static constexpr int VM_MIN = 0;
    const float* resf; bf16_t* X; float* outf; float* ssq; unsigned char* x8;
    __device__ __forceinline__ int operator()(const Acc& acc, const Unit& u, int wr, int wc, int fr, int fq, const LAS float*, const bool lastu) const {
        const int row0 = u.pm * 256 + wr * 64 + fr; const int col0 = u.pn * 256 + 32 * wc + 8 * fq;
#pragma unroll
        for (int ai = 0; ai < 2; ++ai) {
            f32x4 r[4][2][2];
            if (resf) {
#pragma unroll
                for (int m = 0; m < 4; ++m)
#pragma unroll
                    for (int bj = 0; bj < 2; ++bj) { const float* rp = resf + (size_t)(row0 + ai * 128 + m * 16) * 1024 + col0 + bj * 128; r[m][bj][0] = *(const f32x4*)rp; r[m][bj][1] = *(const f32x4*)(rp + 4); }
            } else {
                u32x4 w[4][2];
#pragma unroll
                for (int m = 0; m < 4; ++m)
#pragma unroll
                    for (int bj = 0; bj < 2; ++bj) w[m][bj] = *(const u32x4*)(X + (size_t)(row0 + ai * 128 + m * 16) * 1024 + col0 + bj * 128);
#pragma unroll
                for (int m = 0; m < 4; ++m)
#pragma unroll
                    for (int bj = 0; bj < 2; ++bj) { const u32x4 q = w[m][bj]; r[m][bj][0] = (f32x4){lo_bf(q.x), hi_bf(q.x), lo_bf(q.y), hi_bf(q.y)}; r[m][bj][1] = (f32x4){lo_bf(q.z), hi_bf(q.z), lo_bf(q.w), hi_bf(q.w)}; }
            }
#pragma unroll
            for (int m = 0; m < 4; ++m) {
                const int row = row0 + ai * 128 + m * 16; const size_t off = (size_t)row * 1024 + col0; float q = 0.f;
#pragma unroll
                for (int bj = 0; bj < 2; ++bj) {
                    const f32x4 x0 = r[m][bj][0] + acc[ai][bj][m][0], x1 = r[m][bj][1] + acc[ai][bj][m][1];
                    if (outf) { *(f32x4*)(outf + off + bj * 128) = x0; *(f32x4*)(outf + off + bj * 128 + 4) = x1; }
                    else {
                        const f32x4 a = x0 * x0, b = x1 * x1; q += ((a[0] + a[1]) + (a[2] + a[3])) + ((b[0] + b[1]) + (b[2] + b[3]));
                        *(u32x4*)(X + off + bj * 128) = pack8(x0, x1);
                        if (x8) { u32x2 q8; q8.x = pk4_fp8(x0[0], x0[1], x0[2], x0[3]); q8.y = pk4_fp8(x1[0], x1[1], x1[2], x1[3]); *(u32x2*)(x8 + off + bj * 128) = q8; } }
                }
                if (!outf) { q += __shfl_xor(q, 16); q += __shfl_xor(q, 32); if (fq == 0) ssq[(size_t)row * 16 + 4 * u.pn + wc] = q; }
            }
        }
        return 0;
    }
};

struct EpiUp {
    static constexpr bool PERM = true, RS = true; static constexpr int VM_MIN = 16;
    bf16_t* H; const float* ssq;
    __device__ __forceinline__ int operator()(const Acc& acc, const Unit& u, int wr, int wc, int fr, int fq, const LAS float* rsl, const bool lastu) const {
        const int row0 = u.pm * 256 + wr * 64 + fr; const int col0 = u.pn * 256 + 32 * wc + 8 * fq;
        float rsv[8];
#pragma unroll
        for (int i = 0; i < 8; ++i) rsv[i] = rsl[wr * 64 + fr + (i >> 2) * 128 + (i & 3) * 16];
#pragma unroll
        for (int ai = 0; ai < 2; ++ai)
#pragma unroll
            for (int m = 0; m < 4; ++m) { const int row = row0 + ai * 128 + m * 16; const float rs = rsv[ai * 4 + m]; bf16_t* op = H + (size_t)row * FF + col0;
#pragma unroll
                for (int bj = 0; bj < 2; ++bj) { f32x4 v0 = acc[ai][bj][m][0] * rs, v1 = acc[ai][bj][m][1] * rs;
#pragma unroll
                    for (int e = 0; e < 4; ++e) { v0[e] = relu_f(v0[e]); v1[e] = relu_f(v1[e]); }
                    st16(op + bj * 128, pack8(v0 * v0, v1 * v1), lastu); } }
        return 16;
    }
};
}
struct Args {
    const float* in[18]; float* out; unsigned char* ws; int ph_lo, ph_hi; int coop, pad;
};
struct Frame { LAS unsigned char* lds; int tid, wave, G, vcu; };
constexpr int PTR_OFF = LDS_BYTES - 512;
enum { I_X = 0, I_LN_MIX, I_W_IN, I_SGU_NORM, I_SGU_W, I_SGU_B, I_Q_NORM, I_K_NORM, I_KIDX_NORM, I_I_BIAS, I_F_BIAS, I_MNORM, I_CONV_W, I_W_BRANCH, I_W_OUT, I_LN_MLP, I_W_UP, I_W_DOWN, I_OUT, I_WS };
__device__ __forceinline__ unsigned char* ptr_at(const Frame& F, int i) { const LAS unsigned* p = (const LAS unsigned*)(F.lds + PTR_OFF) + 2 * i;
    const unsigned lo = __builtin_amdgcn_readfirstlane(p[0]), hi = __builtin_amdgcn_readfirstlane(p[1]);
    typedef __attribute__((address_space(1))) unsigned char* gptr_t;
    return (unsigned char*)(gptr_t)(((unsigned long long)hi << 32) | lo); }
#define INP(i) ((const float*)ptr_at(F, (i)))
#define WSP(off) (ptr_at(F, I_WS) + (off))
constexpr size_t WS_GT = 512 * 1024;
constexpr size_t WS_RSA = 256 * 1024, WS_RSB = 320 * 1024;
__device__ __forceinline__ size_t maskt_idx(int m, int w) { const int b = m >> 12, t = m & (S - 1); return ((size_t)(b * 64 + (w >> 1)) * S + t) * 2 + (w & 1); }


#define XB_TMO      128
#define XB_XCNT(j)  (256  + 64 * (j))
#define XB_XSUB(j)  (1280 + 64 * (j))
#define XB_XGEN(j)  (2304 + 64 * (j))
#define XB_TOP      3328
#define XB_TOPGEN   3392
#define XCD_BAR_WORDS 3456
#define XB_SPIN_CAP (1u << 22)
constexpr size_t WS_BAR = 64 * 1024;
constexpr size_t CTL_ZERO_BYTES = 128 * 1024;
__device__ __forceinline__ unsigned xb_ld(unsigned* p)              { return __hip_atomic_load(p, __ATOMIC_RELAXED, __HIP_MEMORY_SCOPE_AGENT); }
__device__ __forceinline__ unsigned xb_add(unsigned* p, unsigned v) { return __hip_atomic_fetch_add(p, v, __ATOMIC_RELAXED, __HIP_MEMORY_SCOPE_AGENT); }
__device__ __forceinline__ unsigned xb_xcc_id() { return (unsigned)__builtin_amdgcn_s_getreg((3 << 11) | 20) & 0xFu; }
#define XB_SPIN(cond, bar) do { unsigned _sp = 0; while (cond) { __builtin_amdgcn_s_sleep(1); \
    if ((++_sp & 255u) == 0u) { if (xb_ld(&(bar)[XB_TMO])) break; if (_sp > XB_SPIN_CAP) { atomicAdd(&(bar)[XB_TMO], 1u); break; } } } } while (0)
struct XcdBarrier { unsigned* bar; unsigned x; volatile LAS unsigned* st; };
__device__ __forceinline__ XcdBarrier xcd_barrier_post(unsigned* bar, volatile LAS unsigned* st) {
    XcdBarrier b; b.bar = bar; b.x = xb_xcc_id(); b.st = st;
    if (threadIdx.x == 0) (void)xb_add(&bar[XB_XCNT(b.x)], 1u);
    return b;
}
__device__ __forceinline__ void xcd_barrier_complete(unsigned* bar, unsigned x, unsigned& nloc, unsigned& nx) {
    const unsigned G = gridDim.x * gridDim.y * gridDim.z;
    unsigned sum, cnt, mine, sp = 0u;
    for (;;) {
        sum = 0u; cnt = 0u; mine = 0u;
#pragma unroll
        for (unsigned j = 0; j < 16; ++j) { const unsigned c = xb_ld(&bar[XB_XCNT(j)]); sum += c; cnt += (c > 0u) ? 1u : 0u; mine = (j == x) ? c : mine; }
        if (sum == G) break;
        __builtin_amdgcn_s_sleep(1);
        if ((++sp & 255u) == 0u) { if (xb_ld(&bar[XB_TMO])) break; if (sp > XB_SPIN_CAP) { atomicAdd(&bar[XB_TMO], 1u); break; } }
    }
    nloc = mine > 0u ? mine : 1u; nx = cnt > 0u ? cnt : 1u;
}
__device__ __forceinline__ void xcd_barrier(const XcdBarrier& b) {
    asm volatile("s_waitcnt vmcnt(0)" ::: "memory");
    __syncthreads();
    if (threadIdx.x == 0) {
        unsigned* bar = b.bar;
        __builtin_amdgcn_s_waitcnt(0);
        unsigned nloc = b.st[0], nx = b.st[1];
        if (nloc == 0u) { xcd_barrier_complete(bar, b.x, nloc, nx); b.st[0] = nloc; b.st[1] = nx; }
        const unsigned old = xb_add(&bar[XB_XSUB(b.x)], 1u);
        const unsigned gen = old / nloc;
        if (old + 1u == (gen + 1u) * nloc) {
            __builtin_amdgcn_fence(__ATOMIC_RELEASE, "agent");
            asm volatile("s_waitcnt vmcnt(0)" ::: "memory");
            const unsigned og = xb_add(&bar[XB_TOP], 1u);
            const unsigned tg = og / nx;
            if (og + 1u == (tg + 1u) * nx) xb_add(&bar[XB_TOPGEN], 1u);
            else XB_SPIN(xb_ld(&bar[XB_TOPGEN]) == tg, bar);
            __builtin_amdgcn_fence(__ATOMIC_ACQUIRE, "agent");
            xb_add(&bar[XB_XGEN(b.x)], 1u);
            asm volatile("s_waitcnt vmcnt(0)" ::: "memory");
        } else {
            XB_SPIN(xb_ld(&bar[XB_XGEN(b.x)]) == gen, bar);
            __builtin_amdgcn_fence(__ATOMIC_ACQUIRE, "agent");
            asm volatile("s_waitcnt vmcnt(0)" ::: "memory");
        }
    }
    __syncthreads();
}

__device__ __forceinline__ int win_src(int p) {
    const int T = p >> 8, q = p & 255, bj = q >> 7, wc = (q >> 5) & 3, j = q & 31, hd = 64 * wc + 32 * bj + j;
    switch (T) {
        case 0: return O_AU + q; case 1: return O_AV + q; case 2: return O_BQ + hd; case 3: return O_BK + hd; case 4: return O_BV + q;
        case 5: return O_QI + hd; case 6: return O_QI + 256 + hd; case 7: return O_CQ + q; case 8: return O_CK + q; case 9: return O_CV + q;
        case 10: return O_CO + q; case 11: return O_DB + q; case 12: return O_DC + q; case 13: return O_DX + q;
        default: break;
    }
    if (wc == 0) return O_KI + 32 * bj + j;
    if (wc == 1 && bj == 0 && j < 16) return j < 8 ? O_WI + j : (j < 12 ? O_CI + (j - 8) : O_CF + (j - 12));
    return -1;
}
__device__ __forceinline__ int wg_src(int p) {
    const int pn = p >> 8, q = p & 255, bj = q >> 7, wc = (q >> 5) & 3, fq = (q >> 3) & 3, n = (q >> 2) & 1, e = q & 3;
    return O_G + (2 * bj + n) * 1024 + 64 * pn + 16 * wc + 4 * fq + e;
}
template <int MAP>
__device__ __forceinline__ void conv_item(const float* W, int K, int srcN, bf16_t* WT, LAS float* scr, int item, int nrows, int lane, const float* gain = nullptr) {
    const int nblk = nrows / 32, kb = item / nblk, nb = item % nblk, k0 = 64 * kb, n0 = 32 * nb;
    const int nn = n0 + (lane & 31); const int src = MAP == 0 ? nn : (MAP == 1 ? win_src(nn) : wg_src(nn));
    float wv_[32]; const float* wp_ = W + (size_t)(k0 + (lane >> 5)) * srcN + (src >= 0 ? src : 0);
#pragma unroll
    for (int i = 0; i < 32; ++i) wv_[i] = __builtin_nontemporal_load(wp_ + (size_t)(2 * i) * srcN);
#pragma unroll
    for (int i = 0; i < 32; ++i) scr[(2 * i + (lane >> 5)) * 33 + (lane & 31)] = src >= 0 ? (gain ? wv_[i] * gain[k0 + 2 * i + (lane >> 5)] : wv_[i]) : 0.f;
    asm volatile("s_waitcnt lgkmcnt(0)" ::: "memory");
    const int c = lane & 7;
#pragma unroll
    for (int j = 0; j < 4; ++j) { const int n = (lane >> 3) + 8 * j; const LAS float* s = scr + (8 * c) * 33 + n;
        u32x4 o; o.x = pk2(s[0 * 33], s[1 * 33]); o.y = pk2(s[2 * 33], s[3 * 33]); o.z = pk2(s[4 * 33], s[5 * 33]); o.w = pk2(s[6 * 33], s[7 * 33]);
        *(u32x4*)(WT + (size_t)(n0 + n) * K + k0 + 8 * c) = o; }
    asm volatile("s_waitcnt lgkmcnt(0)" ::: "memory");
}
template <int MAP>
__device__ __forceinline__ void conv_item8(const float* W, int K, int srcN, unsigned char* WT8, LAS float* scr, int item, int nrows, int lane, const float* gain, float scale) {
    const int nblk = nrows / 32, kb = item / nblk, nb = item % nblk, k0 = 64 * kb, n0 = 32 * nb;
    const int nn = n0 + (lane & 31); const int src = MAP == 0 ? nn : (MAP == 1 ? win_src(nn) : wg_src(nn));
    float wv_[32]; const float* wp_ = W + (size_t)(k0 + (lane >> 5)) * srcN + (src >= 0 ? src : 0);
#pragma unroll
    for (int i = 0; i < 32; ++i) wv_[i] = __builtin_nontemporal_load(wp_ + (size_t)(2 * i) * srcN);
#pragma unroll
    for (int i = 0; i < 32; ++i) scr[(2 * i + (lane >> 5)) * 33 + (lane & 31)] = src >= 0 ? wv_[i] * gain[k0 + 2 * i + (lane >> 5)] * scale : 0.f;
    asm volatile("s_waitcnt lgkmcnt(0)" ::: "memory");
    const int c = lane & 7;
#pragma unroll
    for (int j = 0; j < 4; ++j) { const int n = (lane >> 3) + 8 * j; const LAS float* s = scr + (8 * c) * 33 + n;
        u32x2 o; o.x = pk4_fp8(s[0 * 33], s[1 * 33], s[2 * 33], s[3 * 33]); o.y = pk4_fp8(s[4 * 33], s[5 * 33], s[6 * 33], s[7 * 33]);
        *(u32x2*)(WT8 + (size_t)(n0 + n) * K + k0 + 8 * c) = o; }
    asm volatile("s_waitcnt lgkmcnt(0)" ::: "memory");
}
__device__ __forceinline__ void convert_mix_weights(Frame& F, int l) {

    LAS float* scr = (LAS float*)(F.lds + F.wave * 16384);
    const int gw = F.vcu * NWAVES + F.wave, NGW = F.G * NWAVES;
    constexpr int I_WIN = (D / 64) * (PW / 32), I_WG = (D / 64) * (4096 / 32), I_BR = (256 / 64) * (1024 / 32), I_WO = (D / 64) * (D / 32);
    constexpr int NIT = I_WIN + I_WG + 4 * I_BR + I_WO;
    const float* win = INP(I_W_IN) + (size_t)l * D * INW; const float* gmix = INP(I_LN_MIX) + l * D;
    for (int it = gw; it < NIT; it += NGW) {
        int r = it;
        if (r < I_WIN) { conv_item<1>(win, D, INW, ((bf16_t*)WSP(WS_WIN)), scr, r, PW, (F.tid & 63), gmix); continue; } r -= I_WIN;
        if (r < I_WG) { conv_item8<2>(win, D, INW, ptr_at(F, I_OUT) + OUT_WG8 + (size_t)l * 4 * MiB, scr, r, 4096, (F.tid & 63), gmix, WG8_SCALE); continue; } r -= I_WG;
        if (r < 4 * I_BR) { const int nb = r / I_BR; conv_item<0>(INP(I_W_BRANCH) + ((size_t)l * 4 + nb) * 256 * D, 256, D, ((bf16_t*)WSP(WS_WBR)) + (size_t)nb * 1024 * 256, scr, r % I_BR, 1024, (F.tid & 63)); continue; } r -= 4 * I_BR;
        conv_item<0>(INP(I_W_OUT) + (size_t)l * D * D, D, D, ((bf16_t*)WSP(WS_WOUT)), scr, r, D, (F.tid & 63));
    }
}
__device__ __forceinline__ void convert_mlp_weights(Frame& F, int l) {

    LAS float* scr = (LAS float*)(F.lds + F.wave * 16384);
    const int gw = F.vcu * NWAVES + F.wave, NGW = F.G * NWAVES;
    constexpr int I_UP = (D / 64) * (FF / 32), I_DN = (FF / 64) * (D / 32);
    for (int it = gw; it < I_UP + I_DN; it += NGW) {
        if (it < I_UP) conv_item<0>(INP(I_W_UP) + (size_t)l * D * FF, D, FF, ((bf16_t*)WSP(WS_WUP)), scr, it, FF, (F.tid & 63), INP(I_LN_MLP) + l * D);
        else conv_item<0>(INP(I_W_DOWN) + (size_t)l * FF * D, FF, D, ((bf16_t*)WSP(WS_WDN)), scr, it - I_UP, D, (F.tid & 63));
    }
}
__device__ __forceinline__ void prologue_rows(Frame& F) {
    float* COS = (float*)WSP(WS_COS); float* SIN = (float*)WSP(WS_SIN); float* SSQA = (float*)WSP(WS_SSQA); bf16_t* XG = (bf16_t*)WSP(WS_XG); const float* x = INP(I_X); const float* ln_mix = INP(I_LN_MIX);
    const int gt = F.vcu * NT + F.tid, NGT = F.G * NT;
    for (int i = gt; i < S * 32; i += NGT) { const int pos = i >> 5, k = i & 31; const float inv = powf(10000.f, -(float)k * 2.0f / 64.f); const float ang = (float)pos * inv; COS[i] = cosf(ang); SIN[i] = sinf(ang); }
    const int gw = F.vcu * NWAVES + F.wave, NGW = F.G * NWAVES;
    float* rsa = (float*)WSP(WS_RSA); unsigned char* x8p = ptr_at(F, I_OUT) + OUT_X8;
    for (int m0 = gw * 4; m0 < M; m0 += NGW * 4) {
        f32x4 v[4][4];
#pragma unroll
        for (int r = 0; r < 4; ++r)
#pragma unroll
            for (int j = 0; j < 4; ++j) v[r][j] = __builtin_nontemporal_load((const f32x4*)(x + (size_t)(m0 + r) * D) + (F.tid & 63) + 64 * j);
#pragma unroll
        for (int r = 0; r < 4; ++r) { float s = 0.f; unsigned long long* o8 = (unsigned long long*)(XG + (size_t)(m0 + r) * D) + (F.tid & 63);
#pragma unroll
            for (int j = 0; j < 4; ++j) { const f32x4 w = v[r][j]; s += (w[0] * w[0] + w[1] * w[1]) + (w[2] * w[2] + w[3] * w[3]);
                o8[64 * j] = (unsigned long long)pk2(w[0], w[1]) | ((unsigned long long)pk2(w[2], w[3]) << 32);
                ((unsigned*)(x8p + (size_t)(m0 + r) * D))[(F.tid & 63) + 64 * j] = pk4_fp8(w[0], w[1], w[2], w[3]); }
            s = wave_sum(s);
            if ((F.tid & 63) == 0) rsa[m0 + r] = rsqrtf(s * (1.f / 1024.f) + EPS); }
    }
}
__device__ __forceinline__ void finalize_rs(Frame& F, size_t ssq_off, size_t rs_off) {
    const float* ssq = (const float*)WSP(ssq_off); float* rs = (float*)WSP(rs_off);
    for (int row = F.vcu * NT + F.tid; row < M; row += F.G * NT) { const f32x4* sp = (const f32x4*)(ssq + (size_t)row * 16); const f32x4 a = sp[0], b = sp[1], c = sp[2], d = sp[3];
        const float t = ((a[0] + a[1]) + (a[2] + a[3])) + ((b[0] + b[1]) + (b[2] + b[3])) + ((c[0] + c[1]) + (c[2] + c[3])) + ((d[0] + d[1]) + (d[2] + d[3]));
        rs[row] = rsqrtf(t * (1.0f / 1024.0f) + EPS); }
}

__device__ __forceinline__ void conv_simple(Frame& F, int l) {
    bf16_t* PROJ = (bf16_t*)WSP(WS_BIG); bf16_t* Y = (bf16_t*)WSP(WS_Y); const float* conv_w = INP(I_CONV_W);
    const float* cw = conv_w + l * 3 * 256;
    for (int i = F.vcu * NT + F.tid; i < M * 32; i += F.G * NT) { const int m = i >> 5, c = (i & 31) * 8, t = m & (S - 1); float acc[8];
#pragma unroll
        for (int e = 0; e < 8; ++e) acc[e] = 0.f;
#pragma unroll
        for (int j = 0; j < 3; ++j) { const int tt = t - 2 + j; if (tt >= 0) { const size_t r = (size_t)(m - 2 + j) * PW; const u32x4 a = *(const u32x4*)(PROJ + r + P_DC + c), x = *(const u32x4*)(PROJ + r + P_DX + c);
                const f32x4 w0 = *(const f32x4*)(cw + j * 256 + c), w1 = *(const f32x4*)(cw + j * 256 + c + 4);
                acc[0] = fmaf(w0[0], lo_bf(a.x) * lo_bf(x.x), acc[0]); acc[1] = fmaf(w0[1], hi_bf(a.x) * hi_bf(x.x), acc[1]); acc[2] = fmaf(w0[2], lo_bf(a.y) * lo_bf(x.y), acc[2]); acc[3] = fmaf(w0[3], hi_bf(a.y) * hi_bf(x.y), acc[3]);
                acc[4] = fmaf(w1[0], lo_bf(a.z) * lo_bf(x.z), acc[4]); acc[5] = fmaf(w1[1], hi_bf(a.z) * hi_bf(x.z), acc[5]); acc[6] = fmaf(w1[2], lo_bf(a.w) * lo_bf(x.w), acc[6]); acc[7] = fmaf(w1[3], hi_bf(a.w) * hi_bf(x.w), acc[7]); } }
        const u32x4 bq = *(const u32x4*)(PROJ + (size_t)m * PW + P_DB + c); u32x4 o;
        o.x = cvt_pk_bf16(lo_bf(bq.x) * acc[0], hi_bf(bq.x) * acc[1]); o.y = cvt_pk_bf16(lo_bf(bq.y) * acc[2], hi_bf(bq.y) * acc[3]); o.z = cvt_pk_bf16(lo_bf(bq.z) * acc[4], hi_bf(bq.z) * acc[5]); o.w = cvt_pk_bf16(lo_bf(bq.w) * acc[6], hi_bf(bq.w) * acc[7]);
        *(u32x4*)(Y + (size_t)m * D + 768 + c) = o; }
}
typedef float f32x16 __attribute__((ext_vector_type(16)));
constexpr size_t WS_VT = WS_BIG + 120 * MiB;
constexpr float LOG2E = 1.4426950408889634f;

template <int R> struct AttExp {
    static __device__ __forceinline__ void run(f32x16& p0, f32x16& p1, unsigned sh0, unsigned sh1, float& lsum) {
        constexpr int CB = (R & 3) + 8 * (R >> 2);
        int m0, m1; asm("v_bfe_i32 %0, %1, %2, 1" : "=v"(m0) : "v"(sh0), "n"(CB)); asm("v_bfe_i32 %0, %1, %2, 1" : "=v"(m1) : "v"(sh1), "n"(CB));
        p0[R] = __uint_as_float(__float_as_uint(__builtin_amdgcn_exp2f(p0[R])) & (unsigned)m0); p1[R] = __uint_as_float(__float_as_uint(__builtin_amdgcn_exp2f(p1[R])) & (unsigned)m1);
        lsum += p0[R] + p1[R];
        AttExp<R + 1>::run(p0, p1, sh0, sh1, lsum);
    }
};
template <> struct AttExp<16> { static __device__ __forceinline__ void run(f32x16&, f32x16&, unsigned, unsigned, float&) {} };

__device__ __forceinline__ void attn_mfma(Frame& F, int l) {
    const unsigned long long* MASKT = (const unsigned long long*)WSP(WS_MASK); const bf16_t* PROJ = (const bf16_t*)WSP(WS_BIG); const bf16_t* VT = (const bf16_t*)WSP(WS_VT);
    bf16_t* Y = (bf16_t*)WSP(WS_Y); const float* gt = (const float*)WSP(WS_GT) + l * 192;
    const int lane = (F.tid & 63), r32 = lane & 31, hi = lane >> 5, grp = F.wave >> 2, w4 = F.wave & 3, lg = F.tid & 255;
    const float mq = wave_max(fabsf(gt[lane])), mk = wave_max(fabsf(gt[64 + lane]));
    const float c2 = 8.f * mq * mk * 1.01f * LOG2E;
    constexpr int ROWB = 144, TILEB = 64 * ROWB;
    LAS unsigned char* gb = F.lds + grp * 4 * TILEB;
    LAS float* comb = (LAS float*)(F.lds + 8 * TILEB);
    const int srow0 = lg >> 3, sc0 = lg & 7;
    for (int item = F.vcu; item < 256; item += F.G) {
        const int bh = item >> 4, sidx = item & 15, b = bh >> 2, h = bh & 3;
#pragma unroll 1
        for (int half = 0; half < 2; ++half) {
            const int qb = half == 0 ? sidx : 31 - sidx, q0 = qb * 128, ntl = qb + 1;
            const int qrow = b * S + q0 + w4 * 32 + r32, tq = q0 + w4 * 32 + r32;
            bf16x8 qf[4];
#pragma unroll
            for (int s = 0; s < 4; ++s) qf[s] = *(const bf16x8*)(PROJ + (size_t)qrow * PW + P_Q + h * 64 + 16 * s + 8 * hi);
            f32x16 o0, o1;
#pragma unroll
            for (int r = 0; r < 16; ++r) { o0[r] = 0.f; o1[r] = 0.f; }
            float lsum = 0.f;
            const bf16_t* kbase = PROJ + (size_t)(b * S + srow0) * PW + P_K + h * 64 + sc0 * 8;
            const bf16_t* vbase = VT + (size_t)(b * 256 + h * 64 + srow0) * S + sc0 * 8;
            const unsigned long long* mbase = MASKT + (size_t)(b * 64) * S + tq;
            u32x4 ka0, ka1, va0, va1, kb0, kb1, vb0, vb1; unsigned long long mwa = 0ull, mwb = 0ull;
#define ATT_LOAD(K0, K1, V0, V1, MW, t_) do { const int t__ = (t_); K0 = *(const u32x4*)(kbase + (size_t)t__ * 64 * PW); K1 = *(const u32x4*)(kbase + (size_t)(t__ * 64 + 32) * PW); \
    V0 = *(const u32x4*)(vbase + t__ * 64); V1 = *(const u32x4*)(vbase + 32 * S + t__ * 64); MW = mbase[(size_t)t__ * S]; } while (0)
#define ATT_STORE(K0, K1, V0, V1, buf_) do { LAS unsigned char* kn_ = gb + (buf_) * 2 * TILEB; LAS unsigned char* vn_ = kn_ + TILEB; \
    *(LAS u32x4*)(kn_ + srow0 * ROWB + sc0 * 16) = K0; *(LAS u32x4*)(kn_ + (srow0 + 32) * ROWB + sc0 * 16) = K1; \
    *(LAS u32x4*)(vn_ + srow0 * ROWB + sc0 * 16) = V0; *(LAS u32x4*)(vn_ + (srow0 + 32) * ROWB + sc0 * 16) = V1; } while (0)
#define ATT_COMPUTE(cur_, MW) do { \
                const LAS unsigned char* kb = gb + (cur_) * 2 * TILEB; const LAS unsigned char* vb = kb + TILEB; \
                f32x16 p0, p1; \
                _Pragma("unroll") for (int r = 0; r < 16; ++r) { p0[r] = -c2; p1[r] = -c2; }     \
                _Pragma("unroll") for (int s = 0; s < 4; ++s) { \
                    const bf16x8 k0 = *(const LAS bf16x8*)(kb + r32 * ROWB + 32 * s + 16 * hi), k1 = *(const LAS bf16x8*)(kb + (32 + r32) * ROWB + 32 * s + 16 * hi); \
                    p0 = __builtin_amdgcn_mfma_f32_32x32x16_bf16(k0, qf[s], p0, 0, 0, 0); p1 = __builtin_amdgcn_mfma_f32_32x32x16_bf16(k1, qf[s], p1, 0, 0, 0); } \
                const unsigned sh0 = (unsigned)(MW) >> (4 * hi), sh1 = (unsigned)((MW) >> 32) >> (4 * hi); \
                AttExp<0>::run(p0, p1, sh0, sh1, lsum); \
                _Pragma("unroll") for (int ks = 0; ks < 4; ++ks) { \
                    u32x4 pw; \
                    if (ks < 2) { pw.x = cvt_pk_bf16(p0[8 * ks + 0], p0[8 * ks + 1]); pw.y = cvt_pk_bf16(p0[8 * ks + 2], p0[8 * ks + 3]); pw.z = cvt_pk_bf16(p0[8 * ks + 4], p0[8 * ks + 5]); pw.w = cvt_pk_bf16(p0[8 * ks + 6], p0[8 * ks + 7]); } \
                    else { const int k2 = ks - 2; pw.x = cvt_pk_bf16(p1[8 * k2 + 0], p1[8 * k2 + 1]); pw.y = cvt_pk_bf16(p1[8 * k2 + 2], p1[8 * k2 + 3]); pw.z = cvt_pk_bf16(p1[8 * k2 + 4], p1[8 * k2 + 5]); pw.w = cvt_pk_bf16(p1[8 * k2 + 6], p1[8 * k2 + 7]); } \
                    const bf16x8 pf = __builtin_bit_cast(bf16x8, pw); \
                    const int vo = 64 * (ks >> 1) + 32 * (ks & 1) + 8 * hi; \
                    const u32x2 a0 = *(const LAS u32x2*)(vb + r32 * ROWB + vo), a1 = *(const LAS u32x2*)(vb + r32 * ROWB + vo + 16); \
                    const u32x2 b0 = *(const LAS u32x2*)(vb + (32 + r32) * ROWB + vo), b1 = *(const LAS u32x2*)(vb + (32 + r32) * ROWB + vo + 16); \
                    const u32x4 va = {a0.x, a0.y, a1.x, a1.y}, vb4 = {b0.x, b0.y, b1.x, b1.y}; \
                    o0 = __builtin_amdgcn_mfma_f32_32x32x16_bf16(__builtin_bit_cast(bf16x8, va), pf, o0, 0, 0, 0); \
                    o1 = __builtin_amdgcn_mfma_f32_32x32x16_bf16(__builtin_bit_cast(bf16x8, vb4), pf, o1, 0, 0, 0); } \
            } while (0)
            ATT_LOAD(ka0, ka1, va0, va1, mwa, grp);
            if (ntl > 1) ATT_LOAD(kb0, kb1, vb0, vb1, mwb, 2 + grp);
            ATT_STORE(ka0, ka1, va0, va1, 0);
            __syncthreads();
            asm volatile(".p2align 8");
#pragma unroll 1
            for (int i = 0; i < ntl; i += 2) {
                const unsigned long long mw0 = mwa;
                if (i + 2 < ntl) ATT_LOAD(ka0, ka1, va0, va1, mwa, 2 * (i + 2) + grp);
                ATT_COMPUTE(0, mw0);
                if (i + 1 < ntl) ATT_STORE(kb0, kb1, vb0, vb1, 1);
                __syncthreads();
                if (i + 1 < ntl) {
                    const unsigned long long mw1 = mwb;
                    if (i + 3 < ntl) ATT_LOAD(kb0, kb1, vb0, vb1, mwb, 2 * (i + 3) + grp);
                    ATT_COMPUTE(1, mw1);
                    if (i + 2 < ntl) ATT_STORE(ka0, ka1, va0, va1, 0);
                    __syncthreads();
                }
            }
#undef ATT_LOAD
#undef ATT_STORE
#undef ATT_COMPUTE
            if (grp == 1) { LAS float* cw = comb + w4 * 33 * 64 + lane;
#pragma unroll
                for (int r = 0; r < 16; ++r) { cw[r * 64] = o0[r]; cw[(16 + r) * 64] = o1[r]; }
                cw[32 * 64] = lsum; }
            __syncthreads();
            if (grp == 0) { const LAS float* cw = comb + w4 * 33 * 64 + lane;
#pragma unroll
                for (int r = 0; r < 16; ++r) { o0[r] += cw[r * 64]; o1[r] += cw[(16 + r) * 64]; }
                lsum += cw[32 * 64]; lsum += __shfl_xor(lsum, 32); const float inv = 1.f / lsum;
                bf16_t* yp = Y + (size_t)qrow * D + 256 + h * 64 + 4 * hi;
#pragma unroll
                for (int g4 = 0; g4 < 4; ++g4) { u32x2 w0, w1;
                    w0.x = cvt_pk_bf16(o0[4 * g4] * inv, o0[4 * g4 + 1] * inv); w0.y = cvt_pk_bf16(o0[4 * g4 + 2] * inv, o0[4 * g4 + 3] * inv);
                    w1.x = cvt_pk_bf16(o1[4 * g4] * inv, o1[4 * g4 + 1] * inv); w1.y = cvt_pk_bf16(o1[4 * g4 + 2] * inv, o1[4 * g4 + 3] * inv);
                    *(u32x2*)(yp + 8 * g4) = w0; *(u32x2*)(yp + 32 + 8 * g4) = w1; } }
            __syncthreads();
        }
    }
}

constexpr size_t WS_KI = 234 * MiB;
template <int J, unsigned MSK>
__device__ __forceinline__ void tr_stage(unsigned (&a)[32]) {
#pragma unroll
    for (int k = 0; k < 32; ++k) if ((k & J) == 0) { const unsigned t = (a[k] ^ (a[k + J] >> J)) & MSK; a[k] ^= t; a[k + J] ^= (t << J); }
}
__device__ __forceinline__ void transpose32(unsigned (&a)[32]) {
    tr_stage<16, 0x0000FFFFu>(a); tr_stage<8, 0x00FF00FFu>(a); tr_stage<4, 0x0F0F0F0Fu>(a); tr_stage<2, 0x33333333u>(a); tr_stage<1, 0x55555555u>(a);
}
__device__ __forceinline__ int wave_total_i(int v) {
    v += __builtin_amdgcn_update_dpp(0, v, 0x111, 0xf, 0xf, false);
    v += __builtin_amdgcn_update_dpp(0, v, 0x112, 0xf, 0xf, false);
    v += __builtin_amdgcn_update_dpp(0, v, 0x114, 0xf, 0xf, false);
    v += __builtin_amdgcn_update_dpp(0, v, 0x118, 0xf, 0xf, false);
    v += __builtin_amdgcn_update_dpp(0, v, 0x142, 0xa, 0xf, false);
    v += __builtin_amdgcn_update_dpp(0, v, 0x143, 0xc, 0xf, false);
    return __builtin_amdgcn_readlane(v, 63);
}
__device__ __forceinline__ void idx_score(Frame& F, const int b, const int t0, LAS unsigned short* sc16, const int sw) {
    if (t0 + 8 <= 256) return;
    const float* MISC = (const float*)WSP(WS_MISC); const bf16_t* PROJ = (const bf16_t*)WSP(WS_BIG); const bf16_t* KI = (const bf16_t*)WSP(WS_KI);
    const int lane = (F.tid & 63), r32 = lane & 31, hi = lane >> 5, m0 = b * S + t0;
    const int nmax = t0 + 8, ntile = (nmax + 31) >> 5;
    bf16x8 qa[2][4], wsel[2][2];
#pragma unroll
    for (int i = 0; i < 2; ++i) {
        const bf16_t* qp = PROJ + (size_t)(m0 + 4 * i + (r32 >> 3)) * PW + P_QI + (r32 & 7) * 64 + 8 * hi;
#pragma unroll
        for (int s = 0; s < 4; ++s) { qa[i][s] = *(const bf16x8*)(qp + 16 * s); asm volatile("" : "+v"(qa[i][s])); }
    }
    { const int qrow = r32 & 7; const f32x4 w4 = *(const f32x4*)(MISC + (size_t)(m0 + qrow) * 16 + 4 * hi);
      const float sc_ = 0.125f * 0.35355339059327373f; const unsigned p01 = cvt_pk_bf16(w4[0] * sc_, w4[1] * sc_), p23 = cvt_pk_bf16(w4[2] * sc_, w4[3] * sc_);
#pragma unroll
      for (int i = 0; i < 2; ++i)
#pragma unroll
          for (int s = 0; s < 2; ++s) { const bool mine = (r32 < 8) && ((qrow >> 2) == i) && (((qrow & 3) >> 1) == s); const bool upper = (qrow & 1) != 0;
              u32x4 f; f.x = (mine && !upper) ? p01 : 0u; f.y = (mine && !upper) ? p23 : 0u; f.z = (mine && upper) ? p01 : 0u; f.w = (mine && upper) ? p23 : 0u;
              asm volatile("" : "+v"(f));
              wsel[i][s] = __builtin_bit_cast(bf16x8, f); } }
    bf16x8 kring[2][4];
    const bf16_t* kbase_ = KI + ((size_t)(b * S >> 5) * 4 * 64 + lane) * 8;
#define IDX_LOADK(u_, j_) do { const int jt_ = (j_) < ntile ? (j_) : ntile - 1; const bf16_t* kp_ = kbase_ + (unsigned)jt_ * 2048u; \
    _Pragma("unroll") for (int s_ = 0; s_ < 4; ++s_) kring[u_][s_] = *(const bf16x8*)(kp_ + s_ * 64 * 8); } while (0)
#pragma unroll
    for (int u = 0; u < 2; ++u) IDX_LOADK(u, sw + 4 * u);
    f32x16 dd[2][2];
#define IDX_DSTEP(slot_, par_, s_) do { _Pragma("unroll") for (int i_ = 0; i_ < 2; ++i_) dd[par_][i_] = __builtin_amdgcn_mfma_f32_32x32x16_bf16(qa[i_][s_], kring[slot_][s_], dd[par_][i_], 0, 0, 0); } while (0)
#define IDX_WSTEP(par_, i_, s_) do { u32x4 rw_; const f32x16& d_ = dd[par_][i_]; \
        rw_.x = cvt_pk_bf16(relu_f(d_[8 * (s_) + 0]), relu_f(d_[8 * (s_) + 1])); rw_.y = cvt_pk_bf16(relu_f(d_[8 * (s_) + 2]), relu_f(d_[8 * (s_) + 3])); \
        rw_.z = cvt_pk_bf16(relu_f(d_[8 * (s_) + 4]), relu_f(d_[8 * (s_) + 5])); rw_.w = cvt_pk_bf16(relu_f(d_[8 * (s_) + 6]), relu_f(d_[8 * (s_) + 7])); \
        outv = __builtin_amdgcn_mfma_f32_32x32x16_bf16(wsel[i_][s_], __builtin_bit_cast(bf16x8, rw_), outv, 0, 0, 0); } while (0)
#pragma unroll
    for (int i = 0; i < 2; ++i)
#pragma unroll
        for (int r = 0; r < 16; ++r) dd[0][i][r] = 0.f;
#pragma unroll
    for (int s = 0; s < 4; ++s) IDX_DSTEP(0, 0, s);
    __builtin_amdgcn_sched_barrier(0);
    IDX_LOADK(0, sw + 8);
    __builtin_amdgcn_sched_barrier(0);
    asm volatile(".p2align 8");
    for (int jb = sw; jb < ntile; jb += 8) {
#pragma unroll
        for (int u = 0; u < 2; ++u) {
            const int j = jb + 4 * u;
            const int key = 32 * j + r32;
            f32x16 outv;
#pragma unroll
            for (int r = 0; r < 16; ++r) { outv[r] = 0.f; dd[(u + 1) & 1][0][r] = 0.f; dd[(u + 1) & 1][1][r] = 0.f; }
            IDX_DSTEP((u + 1) & 1, (u + 1) & 1, 0); IDX_WSTEP(u & 1, 0, 0);
            IDX_DSTEP((u + 1) & 1, (u + 1) & 1, 1); IDX_WSTEP(u & 1, 0, 1);
            IDX_DSTEP((u + 1) & 1, (u + 1) & 1, 2); IDX_WSTEP(u & 1, 1, 0);
            IDX_DSTEP((u + 1) & 1, (u + 1) & 1, 3); IDX_WSTEP(u & 1, 1, 1);
            __builtin_amdgcn_sched_barrier(0);
            IDX_LOADK((u + 1) & 1, j + 4 + 8);
            __builtin_amdgcn_sched_barrier(0);
            if (j < ntile) {
                const int kpos = ((key & 2047) << 1) + (key >> 11);
#pragma unroll
                for (int qq = 0; qq < 4; ++qq) { const int qx = 4 * hi + qq;
                    sc16[qx * 4096 + kpos] = __builtin_bit_cast(unsigned short, (_Float16)((key <= t0 + qx) ? outv[qq] : -INFINITY)); }
            }
        }
    }
#undef IDX_DSTEP
#undef IDX_WSTEP
#undef IDX_LOADK
}
__device__ __forceinline__ void idx_select(Frame& F, const int b, const int t0, const LAS unsigned short* sc16, const int qw) {
    unsigned long long* MASKT = (unsigned long long*)WSP(WS_MASK);
    const int lane = (F.tid & 63);
#pragma unroll 1
    for (int qi = 0; qi < 2; ++qi) {
        const int qx = qw + 4 * qi, tq = t0 + qx;
        unsigned long long myword = 0ull;
        if (t0 + 8 <= 256) {
            const int lo = 64 * lane; myword = (tq >= lo + 63) ? ~0ull : (tq < lo ? 0ull : ((2ull << (tq - lo)) - 1ull));
            MASKT[(size_t)(b * 64 + lane) * S + tq] = myword;
            continue;
        }
        const int nmax = t0 + 8, ntile = (nmax + 31) >> 5;
        const int nvalid = 32 * ntile; const LAS unsigned* srow = (const LAS unsigned*)sc16 + qx * 2048 + lane;
        unsigned kk[32], kc[32];
#pragma unroll
        for (int r = 0; r < 32; ++r) { const unsigned w = srow[64 * r]; const unsigned sg = (w & 0x80008000u) >> 15; const unsigned k = w ^ (((sg << 16) - sg) | 0x80008000u);
            const unsigned vm = ((unsigned)((64 * r + lane - nvalid) >> 31) & 0xFFFFu) | ((unsigned)((2048 + 64 * r + lane - nvalid) >> 31) & 0xFFFF0000u);
            kc[r] = k & vm; kk[r] = kc[r]; }
        transpose32(kk);
        unsigned aA = ~0u, aB = ~0u, Tk = 0u; int base = 0;
#pragma unroll
        for (int bit = 15; bit >= 0; --bit) {
            const unsigned wa = kk[31 - bit], wb = kk[15 - bit];
            const int tot = wave_total_i(__builtin_popcount(wa & aA) + __builtin_popcount(wb & aB));
            const bool take = (base + tot >= 256);
            const unsigned flip = take ? 0u : ~0u;
            aA &= (wa ^ flip); aB &= (wb ^ flip);
            if (take) Tk |= (1u << bit); else base += tot;
        }
        const int ngt = base, neq = wave_total_i(__builtin_popcount(aA) + __builtin_popcount(aB));
        if (ngt + neq == 256) {
#pragma unroll
            for (int r = 0; r < 32; ++r) { const unsigned long long wlo = __ballot((kc[r] & 0xFFFFu) >= Tk); if (lane == r) myword = wlo; }
            if (nvalid > 2048) {
#pragma unroll
                for (int r = 0; r < 32; ++r) { const unsigned long long whi = __ballot((kc[r] >> 16) >= Tk); if (lane == 32 + r) myword = whi; } }
        } else {
            int need = 256 - ngt;
#pragma unroll
            for (int hf = 0; hf < 2; ++hf) if (hf == 0 || nvalid > 2048)
#pragma unroll
                for (int r = 0; r < 32; ++r) { const unsigned k = hf ? (kc[r] >> 16) : (kc[r] & 0xFFFFu);
                    unsigned long long wsel = __ballot(k > Tk), em = __ballot(k == Tk); int c = __builtin_popcountll(em);
                    if (c > need) { while (c > need) { em &= ~(1ull << (63 - __builtin_clzll(em))); --c; } }
                    need -= c; wsel |= em;
                    if (lane == 32 * hf + r) myword = wsel; }
        }
        MASKT[(size_t)(b * 64 + lane) * S + tq] = myword;
    }
}
__device__ __forceinline__ void indexer_mfma(Frame& F) {
    const int wv = F.wave;
    const int npi = (1024 - F.vcu + F.G - 1) / F.G, n = 2 * npi;
#define IDX_UNIT(idx_, b_, t0_) const int pi_##b_ = F.vcu + ((idx_) < npi ? (idx_) : (idx_) - npi) * F.G; const int b_ = pi_##b_ >> 8; const int t0_ = 8 * ((idx_) < npi ? 511 - (pi_##b_ & 255) : (pi_##b_ & 255))
    if (wv < 4) { IDX_UNIT(0, b0, t00); idx_score(F, b0, t00, (LAS unsigned short*)F.lds, wv); }
    __syncthreads();
#pragma unroll 1
    for (int u = 0; u < n; ++u) {
        if (wv < 4) { if (u + 1 < n) { IDX_UNIT(u + 1, b1, t01); idx_score(F, b1, t01, (LAS unsigned short*)(F.lds + ((u + 1) & 1) * 65536), wv); } }
        else { IDX_UNIT(u, b2, t02); idx_select(F, b2, t02, (const LAS unsigned short*)(F.lds + (u & 1) * 65536), wv - 4); }
        __syncthreads();
    }
#undef IDX_UNIT
}

constexpr size_t WS_CVT = 236 * MiB;
__device__ __forceinline__ void mlstm2_mfma(Frame& F, int l) {
    const float* MISC = (const float*)WSP(WS_MISC); const float* STATE = (const float*)WSP(WS_STATE); const bf16_t* PROJ = (const bf16_t*)WSP(WS_BIG); const bf16_t* CVT = (const bf16_t*)WSP(WS_CVT);
    bf16_t* Y = (bf16_t*)WSP(WS_Y); const float* i_bias = INP(I_I_BIAS); const float* f_bias = INP(I_F_BIAS); const float* mnorm = INP(I_MNORM);
    const int lane = (F.tid & 63), r32 = lane & 31, hi = lane >> 5, grp = F.wave >> 2, w4 = F.wave & 3, lg = F.tid & 255;
    constexpr int KROWB = 144, VROWB = 272, GB = 49152;
    LAS unsigned char* gb = F.lds + grp * GB;
    LAS float* bc = (LAS float*)gb;
    LAS float* gs = bc + 128;
    LAS float* npv = gs + 128;
    LAS float* wsum = npv + 64;
    LAS unsigned char* ct = gb + 2048;
    LAS unsigned char* kt = ct + 9216;
    LAS unsigned char* vt = kt + 18432;
    for (int it0 = 2 * F.vcu; it0 < 512; it0 += 2 * F.G) {
        const int item = it0 + grp, bh = item >> 5, c = item & 31, b = bh >> 2, h = bh & 3, m0 = b * S + c * 128;
        if (lg < 128) { const float f = MISC[(size_t)(m0 + lg) * 16 + 12 + h] + f_bias[l * 4 + h]; bc[lg] = fminf(f, 0.f) - log1pf(__expf(-fabsf(f))); gs[lg] = MISC[(size_t)(m0 + lg) * 16 + 8 + h] + i_bias[l * 4 + h]; }
        if (lg >= 128 && lg < 160) { const int cc = lg - 128; wsum[cc] = (cc < c) ? STATE[(size_t)(bh * 32 + cc) * STATE_STRIDE + 4160] : 0.f; }
        __syncthreads();
        if (lg < 64) {
            float a0 = bc[2 * lane], a1 = bc[2 * lane + 1]; float s = a0 + a1;
#pragma unroll
            for (int o = 1; o < 64; o <<= 1) { const float t = __shfl_up(s, o); if (lane >= o) s += t; }
            const float ex = s - (a0 + a1); const float i0 = gs[2 * lane], i1 = gs[2 * lane + 1];
            bc[2 * lane] = ex + a0; bc[2 * lane + 1] = s; gs[2 * lane] = i0 - (ex + a0); gs[2 * lane + 1] = i1 - s;
            float w = (lane < 32) ? wsum[lane] : 0.f; float suf = w;
#pragma unroll
            for (int o = 1; o < 32; o <<= 1) { const float t = __shfl_down(suf, o); if (lane + o < 32) suf += t; }
            if (lane < 32) wsum[lane] = suf - w;
        }
        __syncthreads();
        { f32x4 a4[4]; float nv = 0.f;
#pragma unroll
          for (int k = 0; k < 4; ++k) a4[k] = (f32x4){0.f, 0.f, 0.f, 0.f};
          for (int cc = 0; cc < c; ++cc) { const float* st = STATE + (size_t)(bh * 32 + cc) * STATE_STRIDE; const float wgt = __expf(wsum[cc]);
#pragma unroll
              for (int k = 0; k < 4; ++k) { const f32x4 v = *(const f32x4*)(st + 4 * (lg + 256 * k)); a4[k] = a4[k] + v * wgt; }
              if (lg < 64) nv = fmaf(wgt, st[4096 + lg], nv); }
#pragma unroll
          for (int k = 0; k < 4; ++k) { const int idx = 4 * (lg + 256 * k), e = idx >> 6, d = idx & 63; u32x2 w; w.x = cvt_pk_bf16(a4[k][0], a4[k][1]); w.y = cvt_pk_bf16(a4[k][2], a4[k][3]); *(LAS u32x2*)(ct + e * KROWB + d * 2) = w; }
          if (lg < 64) npv[lg] = nv; }
#pragma unroll
        for (int k = 0; k < 4; ++k) { const int id = lg + 256 * k, row = id >> 3, ch = id & 7;
            *(LAS u32x4*)(kt + row * KROWB + ch * 16) = *(const u32x4*)(PROJ + (size_t)(m0 + row) * PW + P_CK + h * 64 + ch * 8);
            const int vrow = id >> 4, vch = id & 15;
            *(LAS u32x4*)(vt + vrow * VROWB + vch * 16) = *(const u32x4*)(CVT + (size_t)(b * 256 + h * 64 + vrow) * S + c * 128 + vch * 8); }
        __syncthreads();
        const int j = 32 * w4 + r32, qrow = m0 + j;
        bf16x8 qf[4];
#pragma unroll
        for (int s = 0; s < 4; ++s) qf[s] = *(const bf16x8*)(PROJ + (size_t)qrow * PW + P_CQ + h * 64 + 16 * s + 8 * hi);
        const float bj = bc[j], eb = __expf(bj);
        float qn = 0.f;
#pragma unroll
        for (int s = 0; s < 4; ++s) { const u32x4 w = __builtin_bit_cast(u32x4, qf[s]); const LAS float* np = npv + 16 * s + 8 * hi;
            qn += lo_bf(w.x) * np[0] + hi_bf(w.x) * np[1] + lo_bf(w.y) * np[2] + hi_bf(w.y) * np[3] + lo_bf(w.z) * np[4] + hi_bf(w.z) * np[5] + lo_bf(w.w) * np[6] + hi_bf(w.w) * np[7]; }
        qn += __shfl_xor(qn, 32); qn *= eb;
        f32x16 n0, n1;
#pragma unroll
        for (int r = 0; r < 16; ++r) { n0[r] = 0.f; n1[r] = 0.f; }
#pragma unroll
        for (int ks = 0; ks < 4; ++ks) { const bf16x8 c0 = *(const LAS bf16x8*)(ct + r32 * KROWB + 32 * ks + 16 * hi), c1 = *(const LAS bf16x8*)(ct + (32 + r32) * KROWB + 32 * ks + 16 * hi);
            n0 = __builtin_amdgcn_mfma_f32_32x32x16_bf16(c0, qf[ks], n0, 0, 0, 0); n1 = __builtin_amdgcn_mfma_f32_32x32x16_bf16(c1, qf[ks], n1, 0, 0, 0); }
#pragma unroll
        for (int r = 0; r < 16; ++r) { n0[r] *= eb; n1[r] *= eb; }
        float sa = 0.f;
#pragma unroll 1
        for (int st = 0; st <= w4; ++st) {
            f32x16 p;
#pragma unroll
            for (int r = 0; r < 16; ++r) p[r] = 0.f;
#pragma unroll
            for (int ks = 0; ks < 4; ++ks) { const bf16x8 kf = *(const LAS bf16x8*)(kt + (32 * st + r32) * KROWB + 32 * ks + 16 * hi); p = __builtin_amdgcn_mfma_f32_32x32x16_bf16(kf, qf[ks], p, 0, 0, 0); }
#pragma unroll
            for (int r = 0; r < 16; ++r) { const int s = 32 * st + (r & 3) + 8 * (r >> 2) + 4 * hi; const float a = (s <= j) ? __expf(bj + gs[s]) * p[r] : 0.f; p[r] = a; sa += a; }
#pragma unroll
            for (int k2 = 0; k2 < 2; ++k2) {
                u32x4 pw; pw.x = cvt_pk_bf16(p[8 * k2 + 0], p[8 * k2 + 1]); pw.y = cvt_pk_bf16(p[8 * k2 + 2], p[8 * k2 + 3]); pw.z = cvt_pk_bf16(p[8 * k2 + 4], p[8 * k2 + 5]); pw.w = cvt_pk_bf16(p[8 * k2 + 6], p[8 * k2 + 7]);
                const bf16x8 pf = __builtin_bit_cast(bf16x8, pw);
                const int vo = (32 * st + 16 * k2 + 4 * hi) * 2;
                const u32x2 a0 = *(const LAS u32x2*)(vt + r32 * VROWB + vo), a1 = *(const LAS u32x2*)(vt + r32 * VROWB + vo + 16);
                const u32x2 b0 = *(const LAS u32x2*)(vt + (32 + r32) * VROWB + vo), b1 = *(const LAS u32x2*)(vt + (32 + r32) * VROWB + vo + 16);
                const u32x4 va = {a0.x, a0.y, a1.x, a1.y}, vb4 = {b0.x, b0.y, b1.x, b1.y};
                n0 = __builtin_amdgcn_mfma_f32_32x32x16_bf16(__builtin_bit_cast(bf16x8, va), pf, n0, 0, 0, 0);
                n1 = __builtin_amdgcn_mfma_f32_32x32x16_bf16(__builtin_bit_cast(bf16x8, vb4), pf, n1, 0, 0, 0);
            }
        }
        sa += __shfl_xor(sa, 32);
        const float inv = 1.f / fmaxf(fabsf(qn + sa), 1.f);
        float ss = 0.f;
#pragma unroll
        for (int r = 0; r < 16; ++r) { n0[r] *= inv; n1[r] *= inv; ss += n0[r] * n0[r] + n1[r] * n1[r]; }
        ss += __shfl_xor(ss, 32); const float rr = rsqrtf(ss * (1.f / 64.f) + EPS);
        const float* gp = mnorm + l * 256 + h * 64 + 4 * hi; const bf16_t* op = PROJ + (size_t)qrow * PW + P_CO + h * 64 + 4 * hi; bf16_t* yp = Y + (size_t)qrow * D + 512 + h * 64 + 4 * hi;
#pragma unroll
        for (int g4 = 0; g4 < 4; ++g4) {
            const f32x4 ga = *(const f32x4*)(gp + 8 * g4), gb4 = *(const f32x4*)(gp + 32 + 8 * g4);
            const u32x2 oa = *(const u32x2*)(op + 8 * g4), ob = *(const u32x2*)(op + 32 + 8 * g4);
            u32x2 w0, w1;
            w0.x = cvt_pk_bf16(sigmoid_f(lo_bf(oa.x)) * n0[4 * g4] * rr * ga[0], sigmoid_f(hi_bf(oa.x)) * n0[4 * g4 + 1] * rr * ga[1]);
            w0.y = cvt_pk_bf16(sigmoid_f(lo_bf(oa.y)) * n0[4 * g4 + 2] * rr * ga[2], sigmoid_f(hi_bf(oa.y)) * n0[4 * g4 + 3] * rr * ga[3]);
            w1.x = cvt_pk_bf16(sigmoid_f(lo_bf(ob.x)) * n1[4 * g4] * rr * gb4[0], sigmoid_f(hi_bf(ob.x)) * n1[4 * g4 + 1] * rr * gb4[1]);
            w1.y = cvt_pk_bf16(sigmoid_f(lo_bf(ob.y)) * n1[4 * g4 + 2] * rr * gb4[2], sigmoid_f(hi_bf(ob.y)) * n1[4 * g4 + 3] * rr * gb4[3]);
            *(u32x2*)(yp + 8 * g4) = w0; *(u32x2*)(yp + 32 + 8 * g4) = w1;
        }
        __syncthreads();
    }
}

constexpr size_t WS_SSQV = 244 * MiB;
__device__ __forceinline__ void sgu_mfma(Frame& F, int l) {
    const bf16_t* PROJ = (const bf16_t*)WSP(WS_BIG); bf16_t* Y = (bf16_t*)WSP(WS_Y); const float* SSQV = (const float*)WSP(WS_SSQV);
    const float* gain = INP(I_SGU_NORM) + l * 256; const float* sw = INP(I_SGU_W) + (size_t)l * 4 * 128 * 128; const float* sb = INP(I_SGU_B) + l * 4 * 128;
    const int lane = (F.tid & 63), r32 = lane & 31, hi = lane >> 5, dt = F.wave & 1, tt = F.wave >> 1;
    constexpr int VROWB = 272;
    LAS float* r_s = (LAS float*)F.lds;
    LAS unsigned char* vt = F.lds + 512;
    for (int item = F.vcu; item < 512; item += F.G) {
        const int g = item & 3, m0 = (item >> 2) * 128;
        if (F.tid < 128) { const f32x4 q = *(const f32x4*)(SSQV + (size_t)(m0 + F.tid) * 4); r_s[F.tid] = rsqrtf(((q[0] + q[1]) + (q[2] + q[3])) * (1.f / 256.f) + EPS); }
        __syncthreads();
#pragma unroll
        for (int k = 0; k < 2; ++k) { const int id = F.tid + 512 * k, s = id >> 3, d0 = (id & 7) * 8; const float rs = r_s[s];
            const u32x4 w = *(const u32x4*)(PROJ + (size_t)(m0 + s) * PW + P_AV + g * 64 + d0);
            const float v[8] = {lo_bf(w.x), hi_bf(w.x), lo_bf(w.y), hi_bf(w.y), lo_bf(w.z), hi_bf(w.z), lo_bf(w.w), hi_bf(w.w)};
#pragma unroll
            for (int i = 0; i < 8; ++i) *(LAS bf16_t*)(vt + (d0 + i) * VROWB + s * 2) = (bf16_t)f2bf(v[i] * rs); }
        __syncthreads();
        f32x16 acc;
#pragma unroll
        for (int r = 0; r < 16; ++r) acc[r] = 0.f;
        const int t = 32 * tt + r32; const float* wrow = sw + ((size_t)g * 128 + t) * 128;
#pragma unroll 1
        for (int ks = 0; ks < 2 * (tt + 1); ++ks) {
            const bf16x8 af = *(const LAS bf16x8*)(vt + (32 * dt + r32) * VROWB + (16 * ks + 8 * hi) * 2);
            const int s0 = 16 * ks + 8 * hi; const f32x4 w0 = *(const f32x4*)(wrow + s0), w1 = *(const f32x4*)(wrow + s0 + 4);
            u32x4 bw; bw.x = cvt_pk_bf16(s0 + 0 <= t ? w0[0] : 0.f, s0 + 1 <= t ? w0[1] : 0.f); bw.y = cvt_pk_bf16(s0 + 2 <= t ? w0[2] : 0.f, s0 + 3 <= t ? w0[3] : 0.f);
            bw.z = cvt_pk_bf16(s0 + 4 <= t ? w1[0] : 0.f, s0 + 5 <= t ? w1[1] : 0.f); bw.w = cvt_pk_bf16(s0 + 6 <= t ? w1[2] : 0.f, s0 + 7 <= t ? w1[3] : 0.f);
            acc = __builtin_amdgcn_mfma_f32_32x32x16_bf16(af, __builtin_bit_cast(bf16x8, bw), acc, 0, 0, 0);
        }
        const float bias = sb[g * 128 + t]; const size_t row = (size_t)(m0 + t);
        const float* gp = gain + g * 64 + 32 * dt + 4 * hi; const bf16_t* up = PROJ + row * PW + P_AU + g * 64 + 32 * dt + 4 * hi; bf16_t* yp = Y + row * D + g * 64 + 32 * dt + 4 * hi;
#pragma unroll
        for (int g4 = 0; g4 < 4; ++g4) { const f32x4 gv = *(const f32x4*)(gp + 8 * g4); const u32x2 uw = *(const u32x2*)(up + 8 * g4); u32x2 ow;
            ow.x = cvt_pk_bf16(lo_bf(uw.x) * (gv[0] * acc[4 * g4] + bias), hi_bf(uw.x) * (gv[1] * acc[4 * g4 + 1] + bias));
            ow.y = cvt_pk_bf16(lo_bf(uw.y) * (gv[2] * acc[4 * g4 + 2] + bias), hi_bf(uw.y) * (gv[3] * acc[4 * g4 + 3] + bias));
            *(u32x2*)(yp + 8 * g4) = ow; }
        __syncthreads();
    }
}

__device__ __forceinline__ void mlstm1_mfma(Frame& F, int l) {
    const float* MISC = (const float*)WSP(WS_MISC); float* STATE = (float*)WSP(WS_STATE); const bf16_t* PROJ = (const bf16_t*)WSP(WS_BIG); const bf16_t* CVT = (const bf16_t*)WSP(WS_CVT);
    const float* i_bias = INP(I_I_BIAS); const float* f_bias = INP(I_F_BIAS);
    const int lane = (F.tid & 63), r32 = lane & 31, hi = lane >> 5, grp = F.wave >> 2, w4 = F.wave & 3, et = w4 & 1, dt = w4 >> 1, lg = F.tid & 255;
    constexpr int KROWB = 144, GB = 20480;
    LAS unsigned char* gb = F.lds + grp * GB;
    LAS float* bc = (LAS float*)gb; LAS float* wk = bc + 128; LAS unsigned char* kt = gb + 1024;
    for (int it0 = 2 * F.vcu; it0 < 512; it0 += 2 * F.G) {
        const int item = it0 + grp, bh = item >> 5, c = item & 31, b = bh >> 2, h = bh & 3, m0 = b * S + c * 128;
        if (lg < 128) { const float f = MISC[(size_t)(m0 + lg) * 16 + 12 + h] + f_bias[l * 4 + h]; bc[lg] = fminf(f, 0.f) - log1pf(__expf(-fabsf(f))); wk[lg] = MISC[(size_t)(m0 + lg) * 16 + 8 + h] + i_bias[l * 4 + h]; }
        __syncthreads();
        if (lg < 64) { const float a0 = bc[2 * lane], a1 = bc[2 * lane + 1]; float s = a0 + a1;
#pragma unroll
            for (int o = 1; o < 64; o <<= 1) { const float t = __shfl_up(s, o); if (lane >= o) s += t; }
            const float tot = __shfl(s, 63), ex = s - (a0 + a1);
            wk[2 * lane] = __expf(tot - (ex + a0) + wk[2 * lane]); wk[2 * lane + 1] = __expf(tot - s + wk[2 * lane + 1]);
            if (lane == 0) bc[0] = tot; }
        __syncthreads();
        const float Bc = bc[0];
#pragma unroll
        for (int k = 0; k < 4; ++k) { const int id = lg + 256 * k, s = id >> 3, ch = id & 7; const float ws_ = wk[s];
            const u32x4 w = *(const u32x4*)(PROJ + (size_t)(m0 + s) * PW + P_CK + h * 64 + ch * 8); u32x4 o;
            o.x = cvt_pk_bf16(lo_bf(w.x) * ws_, hi_bf(w.x) * ws_); o.y = cvt_pk_bf16(lo_bf(w.y) * ws_, hi_bf(w.y) * ws_); o.z = cvt_pk_bf16(lo_bf(w.z) * ws_, hi_bf(w.z) * ws_); o.w = cvt_pk_bf16(lo_bf(w.w) * ws_, hi_bf(w.w) * ws_);
            *(LAS u32x4*)(kt + s * KROWB + ch * 16) = o; }
        __syncthreads();
        f32x16 acc;
#pragma unroll
        for (int r = 0; r < 16; ++r) acc[r] = 0.f;
        float nsum = 0.f;
        const bf16_t* vp = CVT + (size_t)(b * 256 + h * 64 + 32 * et + r32) * S + c * 128 + 8 * hi;
        bf16x8 af[8];
#pragma unroll
        for (int ks = 0; ks < 8; ++ks) af[ks] = *(const bf16x8*)(vp + 16 * ks);
#pragma unroll
        for (int ks = 0; ks < 8; ++ks) {
            const LAS unsigned char* kp = kt + (16 * ks + 8 * hi) * KROWB + (32 * dt + r32) * 2; unsigned e8[8];
#pragma unroll
            for (int jj = 0; jj < 8; ++jj) e8[jj] = *(const LAS bf16_t*)(kp + jj * KROWB);
            u32x4 bw; bw.x = e8[0] | (e8[1] << 16); bw.y = e8[2] | (e8[3] << 16); bw.z = e8[4] | (e8[5] << 16); bw.w = e8[6] | (e8[7] << 16);
#pragma unroll
            for (int jj = 0; jj < 8; ++jj) nsum += __uint_as_float(e8[jj] << 16);
            acc = __builtin_amdgcn_mfma_f32_32x32x16_bf16(af[ks], __builtin_bit_cast(bf16x8, bw), acc, 0, 0, 0);
        }
        float* st = STATE + (size_t)item * STATE_STRIDE;
#pragma unroll
        for (int r = 0; r < 16; ++r) st[(32 * et + (r & 3) + 8 * (r >> 2) + 4 * hi) * 64 + 32 * dt + r32] = acc[r];
        nsum += __shfl_xor(nsum, 32);
        if (et == 0 && hi == 0) st[4096 + 32 * dt + r32] = nsum;
        if (lg == 0) st[4160] = Bc;
        __syncthreads();
    }
}
#ifndef MK_MULTI
#define MK_MULTI 0
#endif
constexpr int N_PHASES = 1 + 10 * DEPTH;

__global__ void __launch_bounds__(NT, 2) mk_fwd(Args args) {
    extern __shared__ __attribute__((aligned(16))) unsigned char lds_raw[];
    Frame F;
    F.lds = (LAS unsigned char*)lds_raw; F.tid = threadIdx.x; F.wave = __builtin_amdgcn_readfirstlane(F.tid >> 6);
    F.G = gridDim.x; { const int bx_ = blockIdx.x; F.vcu = (F.G % 8 == 0) ? (bx_ % 8) * (F.G / 8) + bx_ / 8 : bx_; }
    if (F.tid < 20) { const unsigned long long pv = F.tid < 18 ? (unsigned long long)args.in[F.tid < 18 ? F.tid : 0] : (F.tid == 18 ? (unsigned long long)args.out : (unsigned long long)args.ws);
        *(LAS unsigned long long*)(F.lds + PTR_OFF + 8 * F.tid) = pv; }
    if (F.tid < 2) *(LAS unsigned*)(F.lds + PTR_OFF + 256 + 4 * F.tid) = 0u;
    __syncthreads();
#if MK_MULTI
    int bx = (int)blockIdx.x;
    const int lo = args.ph_lo, hi = args.ph_hi; const bool coop = args.coop != 0;
#else
    int bx = (int)blockIdx.x;
    constexpr int lo = 0, hi = N_PHASES - 1; constexpr bool coop = true;
    if (F.tid == 0) (void)xb_add(&((unsigned*)(args.ws + WS_BAR))[XB_XCNT(xb_xcc_id())], 1u);
#endif
#define XBAR_NOW() XcdBarrier{(unsigned*)WSP(WS_BAR), xb_xcc_id(), (volatile LAS unsigned*)(F.lds + PTR_OFF + 256)}
#define RUN(k) (lo <= (k) && (k) < hi)
#define LAUNDER() asm volatile("" : "+v"(F.tid), "+s"(F.G), "+s"(F.vcu), "+s"(F.wave), "+s"(bx), "+s"(F.lds))
#ifndef MK_SKEW_SLEEP
#define MK_SKEW_SLEEP 0
#endif
#define SKEW() do { if (coop) { for (unsigned s_ = ((unsigned)blockIdx.x >> 3) & 3u; s_ > 0; --s_) __builtin_amdgcn_s_sleep(MK_SKEW_SLEEP); } } while (0)
#ifdef MK_PROBE_BAR2
#define SEAM(k) do { if (coop && RUN(k) && RUN((k) + 1)) { { const XcdBarrier xb_ = XBAR_NOW(); xcd_barrier(xb_); } { const XcdBarrier xb_ = XBAR_NOW(); xcd_barrier(xb_); } } } while (0)
#else
#define SEAM(k) do { if (coop && RUN(k) && RUN((k) + 1)) { const XcdBarrier xb_ = XBAR_NOW(); xcd_barrier(xb_); } } while (0)
#endif

    if (args.pad == 0x5a5a5a5a) cg::this_grid().sync();
    if (RUN(0)) { LAUNDER(); convert_mix_weights(F, 0); prologue_rows(F);
        if (blockIdx.x == 0 && F.tid < DEPTH * 192) { const int l_ = F.tid / 192, r_ = F.tid % 192, w_ = r_ / 64, i_ = r_ % 64; ((float*)WSP(WS_GT))[F.tid] = INP(I_Q_NORM + w_)[l_ * 64 + i_]; } }
    SEAM(0);
#pragma unroll 1
    for (int l = 0; l < DEPTH; ++l) {
        const int pb = 1 + 10 * l;
        if (RUN(pb + 0)) { LAUNDER(); SKEW();
            pg8::Gemm<D, D, D, 256u * D * 2, 0, 256u * D * 2, 0> g{(const bf16_t*)WSP(WS_XG), (const bf16_t*)WSP(WS_WIN)};
            pg8::StaticOrder So; So.init(M, PW, F.G, bx);
            epi::EpiProj E{(bf16_t*)WSP(WS_BIG), (float*)WSP(WS_MISC), (const float*)WSP(WS_RSA), (const float*)WSP(WS_COS), (const float*)WSP(WS_SIN), (const float*)WSP(WS_GT) + l * 192, (bf16_t*)WSP(WS_VT), (bf16_t*)WSP(WS_KI), (bf16_t*)WSP(WS_CVT), (float*)WSP(WS_SSQV)};
            pg8::gemm_phase<epi::EpiProj, pg8::StaticOrder, true>(F.lds, g, So, E, F.tid);
        }
        SEAM(pb + 0);
        if (RUN(pb + 1)) { LAUNDER(); sgu_mfma(F, l); conv_simple(F, l); indexer_mfma(F); mlstm1_mfma(F, l); }
        SEAM(pb + 1);
        if (RUN(pb + 2)) { LAUNDER(); attn_mfma(F, l); mlstm2_mfma(F, l); }
        SEAM(pb + 2);
        if (RUN(pb + 3)) { LAUNDER(); SKEW();
            pg8::Gemm<256, D, 256, 256u * D * 2, 256u * 2, 256u * 256 * 2, 1024u * 256 * 2> g{(const bf16_t*)WSP(WS_Y), (const bf16_t*)WSP(WS_WBR)};
            pg8::SuperOrder<0> So; So.init(F.G, bx);
            epi::EpiPlain E{(bf16_t*)WSP(WS_BIG), 4096, 1024};
            pg8::gemm_phase<epi::EpiPlain, pg8::SuperOrder<0>, true>(F.lds, g, So, E, F.tid);
        }
        if (coop && RUN(pb + 3) && RUN(pb + 4)) { asm volatile("s_waitcnt vmcnt(0)" ::: "memory"); __syncthreads(); __builtin_amdgcn_fence(__ATOMIC_ACQUIRE, "agent"); asm volatile("s_waitcnt vmcnt(0)" ::: "memory"); __syncthreads(); }
        if (RUN(pb + 4)) { LAUNDER();
            pg8::Gemm<D, D, D, 256u * D, 0, 256u * D, 0, 1> g{ptr_at(F, I_OUT) + OUT_X8, ptr_at(F, I_OUT) + OUT_WG8 + (size_t)l * 4 * MiB};
            pg8::SuperOrder<1> So; So.init(F.G, bx);
            epi::EpiGate E{(bf16_t*)WSP(WS_MG), (const bf16_t*)WSP(WS_BIG), (const float*)WSP(WS_RSA)};
            pg8::gemm_phase<epi::EpiGate, pg8::SuperOrder<1>, true>(F.lds, g, So, E, F.tid);
        }
        SEAM(pb + 4);
        if (RUN(pb + 5)) { LAUNDER();
            pg8::Gemm<D, D, D, 256u * D * 2, 0, 256u * D * 2, 0> g{(const bf16_t*)WSP(WS_MG), (const bf16_t*)WSP(WS_WOUT)};
            pg8::StaticOrder So; So.init(M, D, F.G, bx);
            epi::EpiResid E{l == 0 ? INP(I_X) : nullptr, (bf16_t*)WSP(WS_XG), nullptr, (float*)WSP(WS_SSQB), nullptr};
            pg8::gemm_phase<epi::EpiResid, pg8::StaticOrder, true>(F.lds, g, So, E, F.tid);
            __syncthreads();
            convert_mlp_weights(F, l);
        }
        SEAM(pb + 5);
        if (RUN(pb + 6)) { LAUNDER(); finalize_rs(F, WS_SSQB, WS_RSB); }
        SEAM(pb + 6);
        if (RUN(pb + 7)) { LAUNDER(); SKEW();
            pg8::Gemm<D, D, D, 256u * D * 2, 0, 256u * D * 2, 0> g{(const bf16_t*)WSP(WS_XG), (const bf16_t*)WSP(WS_WUP)};
            pg8::StaticOrder So; So.init(M, FF, F.G, bx);
            epi::EpiUp E{(bf16_t*)WSP(WS_BIG), (const float*)WSP(WS_RSB)};
            pg8::gemm_phase<epi::EpiUp, pg8::StaticOrder, true>(F.lds, g, So, E, F.tid);
            if (l + 1 < DEPTH) { __syncthreads(); convert_mix_weights(F, l + 1); }
        }
        SEAM(pb + 7);
        if (RUN(pb + 8)) { LAUNDER();
            pg8::Gemm<FF, FF, FF, 256u * FF * 2, 0, 256u * FF * 2, 0> g{(const bf16_t*)WSP(WS_BIG), (const bf16_t*)WSP(WS_WDN)};
            pg8::StaticOrder So; So.init(M, D, F.G, bx);
            epi::EpiResid E{nullptr, (bf16_t*)WSP(WS_XG), (l + 1 < DEPTH) ? nullptr : (float*)ptr_at(F, I_OUT), (float*)WSP(WS_SSQA), (l + 1 < DEPTH) ? ptr_at(F, I_OUT) + OUT_X8 : nullptr};
            pg8::gemm_phase<epi::EpiResid, pg8::StaticOrder, true>(F.lds, g, So, E, F.tid);
        }
        SEAM(pb + 8);
        if (RUN(pb + 9)) { LAUNDER(); if (l + 1 < DEPTH) finalize_rs(F, WS_SSQA, WS_RSA); }
        SEAM(pb + 9);
    }
#undef RUN
#undef SEAM
}

extern "C" void kernel_launch(void* const* d_in, const int* in_sizes, int n_in, void* d_out, int out_size, void* d_ws, size_t ws_size, hipStream_t stream) {
    static int grid = 0;
    if (grid == 0) {
        if (n_in != 18 || in_sizes[0] != M * D || out_size != M * D || ws_size < WS_END) { fprintf(stderr, "kernel_launch: unexpected shapes (n_in %d, in0 %d, out %d, ws %zu)\n", n_in, n_in > 0 ? in_sizes[0] : -1, out_size, ws_size); grid = -1; return; }
        int dev = 0, cus = 0, per_cu = 0;
        if (hipGetDevice(&dev) != hipSuccess || hipDeviceGetAttribute(&cus, hipDeviceAttributeMultiprocessorCount, dev) != hipSuccess) { grid = -1; return; }
        if (hipFuncSetAttribute((const void*)mk_fwd, hipFuncAttributeMaxDynamicSharedMemorySize, LDS_BYTES) != hipSuccess) { fprintf(stderr, "kernel_launch: hipFuncSetAttribute failed\n"); grid = -1; return; }
        if (hipOccupancyMaxActiveBlocksPerMultiprocessor(&per_cu, (const void*)mk_fwd, NT, LDS_BYTES) != hipSuccess || per_cu < 1) { fprintf(stderr, "kernel_launch: occupancy query says %d\n", per_cu); (void)hipGetLastError(); per_cu = 1; }
        grid = cus;
    }
    if (grid < 0) return;
    if (hipMemsetAsync((char*)d_ws + WS_CTL, 0, CTL_ZERO_BYTES, stream) != hipSuccess) { fprintf(stderr, "kernel_launch: memset failed\n"); return; }
    Args a{};
    for (int i = 0; i < 18; ++i) a.in[i] = (const float*)d_in[i];
    a.out = (float*)d_out; a.ws = (unsigned char*)d_ws;
#if MK_MULTI
    for (int p = 0; p < N_PHASES; ++p) { a.ph_lo = p; a.ph_hi = p + 1; a.coop = 0; hipLaunchKernelGGL(mk_fwd, dim3(grid), dim3(NT), LDS_BYTES, stream, a); }
#else
    a.ph_lo = 0; a.ph_hi = N_PHASES - 1; a.coop = 1;
    void* kargs[] = {&a};
    hipError_t e = hipLaunchCooperativeKernel((const void*)mk_fwd, dim3(grid), dim3(NT), kargs, LDS_BYTES, stream);
    if (e != hipSuccess) fprintf(stderr, "kernel_launch: cooperative launch failed: %s (grid %d)\n", hipGetErrorString(e), grid);
#endif
}
```

```cpp
#include <hip/hip_runtime.h>
#define MK_MULTI 0
#include <hip/hip_cooperative_groups.h>
#include <cstdio>
#include <cstdint>
namespace cg = cooperative_groups;

#define LAS __attribute__((address_space(3)))
typedef unsigned short bf16_t;
typedef short bf16x8 __attribute__((ext_vector_type(8)));
typedef float f32x4 __attribute__((ext_vector_type(4)));
typedef float f32x2 __attribute__((ext_vector_type(2)));
typedef unsigned u32x4 __attribute__((ext_vector_type(4)));
typedef unsigned u32x2 __attribute__((ext_vector_type(2)));
typedef int i32x4 __attribute__((ext_vector_type(4)));
typedef int i32x8 __attribute__((ext_vector_type(8)));

constexpr int D = 1024, NB = 4, S = 4096, M = NB * S, DEPTH = 2, FF = 4096, INW = 7760;
constexpr int O_AU = 0, O_AV = 256, O_BQ = 512, O_BK = 768, O_BV = 1024, O_QI = 1280, O_KI = 1792, O_WI = 1856,
              O_CQ = 1864, O_CK = 2120, O_CV = 2376, O_CO = 2632, O_CI = 2888, O_CF = 2892, O_DB = 2896, O_DC = 3152, O_DX = 3408, O_G = 3664;
constexpr int PW = 3840;
constexpr int P_AU = 0, P_AV = 256, P_Q = 512, P_K = 768, P_V = 1024, P_QI = 1280, P_CQ = 1792, P_CK = 2048, P_CV = 2304, P_CO = 2560,
              P_DB = 2816, P_DC = 3072, P_DX = 3328, P_KI = 3584;
constexpr float EPS = 1e-6f;
constexpr int NWAVES = 8, NT = 512;

constexpr size_t MiB = 1u << 20;
constexpr size_t WS_CTL = 0;
constexpr size_t WS_COS = 1 * MiB, WS_SIN = 1 * MiB + 512 * 1024;
constexpr size_t WS_MISC = 2 * MiB;
constexpr size_t WS_SSQA = 3 * MiB, WS_SSQB = 4 * MiB;
constexpr size_t WS_WIN = 5 * MiB;
constexpr size_t WS_WG = WS_WIN + (size_t)PW * D * 2;
constexpr size_t WS_WBR = WS_WG + (size_t)4096 * D * 2;
constexpr size_t WS_WOUT = WS_WBR + (size_t)4 * 1024 * 256 * 2;
constexpr size_t WS_XG = 25 * MiB;
constexpr size_t WS_BIG = 57 * MiB;
constexpr size_t WS_Y = 185 * MiB;
constexpr size_t WS_WUP = WS_Y, WS_WDN = WS_Y + 8 * MiB;
constexpr size_t WS_MG = 217 * MiB;
constexpr size_t WS_MASK = WS_MG, WS_STATE = WS_MG + 8 * MiB;
constexpr size_t WS_END = 249 * MiB;
constexpr int STATE_STRIDE = 4224;
static_assert(WS_WOUT + (size_t)D * D * 2 <= WS_XG && WS_STATE + (size_t)512 * STATE_STRIDE * 4 <= WS_END && WS_END <= 256 * MiB, "d_ws map");

constexpr size_t OUT_X8 = 0;
constexpr size_t OUT_WG8 = 16 * MiB;
constexpr float WG8_SCALE = 64.f;
constexpr int LDS_BYTES = 155648;

__device__ __forceinline__ float bf2f(bf16_t v) { return __uint_as_float((unsigned)v << 16); }
__device__ __forceinline__ unsigned f2bf(float f) { unsigned u = __float_as_uint(f); return (u + 0x7fffu + ((u >> 16) & 1u)) >> 16; }
__device__ __forceinline__ unsigned pk2(float lo, float hi) { return f2bf(lo) | (f2bf(hi) << 16); }
typedef __bf16 bf16x2_t __attribute__((ext_vector_type(2)));
__device__ __forceinline__ unsigned cvt_pk_bf16(float lo, float hi) { const f32x2 v = {lo, hi}; return __builtin_bit_cast(unsigned, __builtin_convertvector(v, bf16x2_t)); }
__device__ __forceinline__ unsigned pk4_fp8(float a, float b, float c, float d) { int w = __builtin_amdgcn_cvt_pk_fp8_f32(a, b, 0, false); w = __builtin_amdgcn_cvt_pk_fp8_f32(c, d, w, true); return (unsigned)w; }
__device__ __forceinline__ float lo_bf(unsigned w) { return __uint_as_float(w << 16); }
__device__ __forceinline__ float hi_bf(unsigned w) { return __uint_as_float(w & 0xffff0000u); }
__device__ __forceinline__ float wave_sum(float v) {
#pragma unroll
    for (int o = 1; o < 64; o <<= 1) v += __shfl_xor(v, o);
    return v;
}
__device__ __forceinline__ float wave_max(float v) {
#pragma unroll
    for (int o = 1; o < 64; o <<= 1) v = fmaxf(v, __shfl_xor(v, o));
    return v;
}
__device__ __forceinline__ int wave_sum_i(int v) {
#pragma unroll
    for (int o = 1; o < 64; o <<= 1) v += __shfl_xor(v, o);
    return v;
}
__device__ __forceinline__ float sigmoid_f(float x) { return __builtin_amdgcn_rcpf(1.f + __builtin_amdgcn_exp2f(-1.4426950408889634f * x)); }
__device__ __forceinline__ float gelu_tanh_f(float x) { const float u = 0.7978845608028654f * (x + 0.044715f * x * x * x); return x * __builtin_amdgcn_rcpf(1.f + __builtin_amdgcn_exp2f(-2.8853900817779268f * u)); }
__device__ __forceinline__ float relu_f(float x) { const int b = __builtin_bit_cast(int, x); return __builtin_bit_cast(float, b > 0 ? b : 0); }
__device__ __forceinline__ unsigned fkey(float s) { const unsigned u = __float_as_uint(s); return (u & 0x80000000u) ? ~u : (u | 0x80000000u); }

__device__ __forceinline__ void st16(void* p, const u32x4 v, const bool wt) { if (wt) asm volatile("global_store_dwordx4 %0, %1, off sc1\n\ts_nop 1" :: "v"(p), "v"(v) : "memory"); else *(u32x4*)p = v; }

namespace pg8 {
constexpr int BM = 256, BK = 64, HALF = 128, HTB = HALF * BK * 2, STAGE_BYTES = 8 * HTB, NXCD = 8, WGM = 8, RS_OFF = STAGE_BYTES;
__host__ __device__ __forceinline__ int lds_byte(int r, int c) { const int st = (r >> 4) * 2 + (c >> 5), rr = r & 15, cc = c & 31, ob = rr * 64 + cc * 2; return st * 1024 + (ob ^ (((ob >> 9) & 1) << 5)); }
__host__ __device__ __forceinline__ void stage_rc(int b, int& R, int& C) { const int st = b / 1024, sb = b % 1024, swz = sb ^ (((sb >> 9) & 1) << 5); R = (st >> 1) * 16 + swz / 64; C = (st & 1) * 32 + (swz % 64) / 2; }
__host__ __device__ __forceinline__ int perm32(int rho) { const int n = rho >> 4, i = rho & 15; return 8 * (i >> 2) + 4 * n + (i & 3); }

struct Unit { int pm, pn, z; };
template <int K_, int LDA_, int LDB_, unsigned APM_, unsigned AZ_, unsigned BPN_, unsigned BZ_, int ESZ_ = 2> struct Gemm {
    const void* A; const void* Bt;
    static constexpr int K = K_, lda = LDA_, ldb = LDB_, esz = ESZ_; static constexpr unsigned aPm = APM_, aZ = AZ_, bPn = BPN_, bZ = BZ_;
};
template <class G> __device__ __forceinline__ const char* pa(const G& g, const Unit& u) { return (const char*)g.A + (size_t)((unsigned)u.pm * G::aPm + (unsigned)u.z * G::aZ); }
template <class G> __device__ __forceinline__ const char* pb(const G& g, const Unit& u) { return (const char*)g.Bt + (size_t)((unsigned)u.pn * G::bPn + (unsigned)u.z * G::bZ); }

struct StaticOrder {
    int nM, nN, nwg, G, c;
    __host__ __device__ void init(int M_, int N_, int G_, int c_) { nM = M_ / BM; nN = N_ / BM; nwg = nM * nN; G = G_; c = c_; }
    __host__ __device__ bool next(int i, Unit& u) const {
        const long L = (long)i * G + c; if (L >= nwg) return false;
        int wgid = (int)L; { const int q = nwg / NXCD, r = nwg % NXCD, xcd = wgid % NXCD, off = wgid / NXCD; wgid = (xcd < r ? xcd * (q + 1) : r * (q + 1) + (xcd - r) * q) + off; }
        const int nig = WGM * nN, gid = wgid / nig, fm = gid * WGM, gsz = (nM - fm) < WGM ? (nM - fm) : WGM;
        u.pm = fm + ((wgid % nig) % gsz); u.pn = (wgid % nig) / gsz; u.z = 0; return true;
    }
};
template <int MODE> struct SuperOrder {
    StaticOrder so;
    __host__ __device__ void init(int G_, int c_) { so.init(M, 1024, G_, c_); }
    __host__ __device__ bool next(int i, Unit& u) const {
        Unit b; if (!so.next(i >> 2, b)) return false;
        const int sub = i & 3; u.pm = b.pm; if (MODE == 0) { u.pn = b.pn; u.z = sub; } else { u.pn = 4 * b.pn + sub; u.z = 0; } return true;
    }
};

template <class Epi, class Sched, bool ALIGN_EPI, class GemmT>
__device__ __forceinline__ void gemm_phase(LAS unsigned char* lds, const GemmT g, const Sched& S, const Epi& E, const int tid) {
    const int wid = __builtin_amdgcn_readfirstlane(tid >> 6), lane = tid & 63, wr = wid >> 2, wc = wid & 3, fr = lane & 15, fq = lane >> 4;
    constexpr int K = GemmT::K, ESZ = GemmT::esz, nt = K * ESZ / (BK * 2);
    unsigned voffA[2], voffB[2];
#pragma unroll
    for (int i = 0; i < 2; ++i) { int R, C; stage_rc(tid * 16 + i * 8192, R, C); const int Rb = Epi::PERM ? ((R & ~31) + perm32(R & 31)) : R;
        voffA[i] = (unsigned)(R * GemmT::lda * ESZ + C * 2); voffB[i] = (unsigned)(Rb * GemmT::ldb * ESZ + C * 2); }
    const size_t kstep = (size_t)(BK * 2);
    constexpr size_t hA = (size_t)HALF * GemmT::lda * ESZ, hB = (size_t)HALF * GemmT::ldb * ESZ;
    const unsigned ldsw = (unsigned)wid * 1024u;
    constexpr int FCOL = (ESZ == 2) ? 8 : 16, KOFF = (ESZ == 2) ? 1024 : 16;
    const int aoff = lds_byte(wr * 64 + fr, fq * FCOL), boff = lds_byte(wc * 32 + fr, fq * FCOL);
    int one_scale = 0x7f7f7f7f; asm volatile("" : "+v"(one_scale));
#define PG8_SA(b, h) (((b) * 2 + (h)) * HTB)
#define PG8_SB(b, h) ((4 + (b) * 2 + (h)) * HTB)
#define PG8_STAGE(bufoff, gbase, voff) do { _Pragma("unroll") for (int _i = 0; _i < 2; ++_i) \
        __builtin_amdgcn_global_load_lds((const unsigned*)((const char*)(gbase) + (voff)[_i]), (LAS unsigned*)(lds + (bufoff) + ldsw + _i * 8192), 16, 0, 0); } while (0)
#define PG8_LDA(dst, b, h) do { _Pragma("unroll") for (int m = 0; m < 4; ++m) _Pragma("unroll") for (int k = 0; k < 2; ++k) dst[m][k] = *(const LAS bf16x8*)(lds + PG8_SA(b, h) + aoff + m * 2048 + k * KOFF); } while (0)
#define PG8_LDB(dst, b, h) do { _Pragma("unroll") for (int n = 0; n < 2; ++n) _Pragma("unroll") for (int k = 0; k < 2; ++k) dst[n][k] = *(const LAS bf16x8*)(lds + PG8_SB(b, h) + boff + n * 2048 + k * KOFF); } while (0)
#define PG8_MMA(ai, bj, At, Bt) do { __builtin_amdgcn_s_setprio(1); _Pragma("unroll") for (int m = 0; m < 4; ++m) _Pragma("unroll") for (int n = 0; n < 2; ++n) { \
        if constexpr (ESZ == 2) { _Pragma("unroll") for (int k = 0; k < 2; ++k) acc[ai][bj][m][n] = __builtin_amdgcn_mfma_f32_16x16x32_bf16(Bt[n][k], At[m][k], acc[ai][bj][m][n], 0, 0, 0); } \
        else { const i32x8 a8_ = __builtin_shufflevector(__builtin_bit_cast(i32x4, At[m][0]), __builtin_bit_cast(i32x4, At[m][1]), 0, 1, 2, 3, 4, 5, 6, 7), b8_ = __builtin_shufflevector(__builtin_bit_cast(i32x4, Bt[n][0]), __builtin_bit_cast(i32x4, Bt[n][1]), 0, 1, 2, 3, 4, 5, 6, 7); \
              \
            asm volatile("v_mfma_scale_f32_16x16x128_f8f6f4 %0, %1, %2, %0, %3, %3 op_sel_hi:[0,0,0]" : "+v"(acc[ai][bj][m][n]) : "v"(b8_), "v"(a8_), "v"(one_scale)); } } \
        __builtin_amdgcn_s_setprio(0); } while (0)
#define PG8_WAIT_V(n) asm volatile("s_waitcnt vmcnt(" #n ")" ::: "memory")
#define PG8_WAIT_L(n) asm volatile("s_waitcnt lgkmcnt(" #n ")" ::: "memory")
#define PG8_BAR __builtin_amdgcn_s_barrier()
#define PG8_SCHED __builtin_amdgcn_sched_barrier(0)
#define PG8_WAIT_VN(n) asm volatile("s_waitcnt vmcnt(%0)" :: "n"(n) : "memory")
    constexpr int RSN = Epi::RS ? 1 : 0, WN1 = 8 + RSN, WN2 = 8 + RSN + Epi::VM_MIN;
#define PG8_WAIT_SEL do { if (wsel == 0) PG8_WAIT_V(8); else if (wsel == 1) PG8_WAIT_VN(WN1); else PG8_WAIT_VN(WN2); } while (0)
#define PG8_RS(slot, pm_) do { if constexpr (Epi::RS) { int l2_ = lane; asm volatile("" : "+v"(l2_));     \
        __builtin_amdgcn_global_load_lds((const unsigned*)(E.ssq + (pm_) * 256 + (wid & 3) * 64 + l2_), (LAS unsigned*)(lds + RS_OFF + (slot) * 1024 + (wid & 3) * 256), 4, 0, 0); } } while (0)
    Unit cur, nxt; int ui = 0;
    if (!S.next(0, cur)) return;
    f32x4 acc[2][2][4][2];
#pragma unroll
    for (int a = 0; a < 2; ++a)
#pragma unroll
        for (int b = 0; b < 2; ++b)
#pragma unroll
            for (int m = 0; m < 4; ++m)
#pragma unroll
                for (int n = 0; n < 2; ++n) acc[a][b][m][n] = (f32x4){0.f, 0.f, 0.f, 0.f};
    bf16x8 At[4][2], B0[2][2], B1[2][2];
    const char* cA = pa(g, cur); const char* cB = pb(g, cur);
    PG8_RS(0, cur.pm);
    PG8_STAGE(PG8_SB(0, 0), cB, voffB); PG8_STAGE(PG8_SB(0, 1), cB + hB, voffB); PG8_STAGE(PG8_SA(0, 0), cA, voffA); PG8_STAGE(PG8_SA(0, 1), cA + hA, voffA);
    if (wr == 1) PG8_BAR;
    PG8_WAIT_V(2); PG8_BAR;
    PG8_STAGE(PG8_SB(1, 0), cB + kstep, voffB); PG8_STAGE(PG8_SA(1, 0), cA + kstep, voffA); PG8_STAGE(PG8_SB(1, 1), cB + hB + kstep, voffB);
    PG8_WAIT_V(6); PG8_BAR;
    int wsel = 0;
    for (;;) {
        const bool has_next = S.next(ui + 1, nxt);
        const char* nA = has_next ? pa(g, nxt) : cA; const char* nB = has_next ? pb(g, nxt) : cB;
        asm volatile(".p2align 8");
#pragma unroll 1
        for (int t = 0; t < nt; t += 2) {
            const bool last = (t == nt - 2);
            const char* a1 = cA + (size_t)(t + 1) * kstep;
            const char* a2 = last ? nA : cA + (size_t)(t + 2) * kstep; const char* b2 = last ? nB : cB + (size_t)(t + 2) * kstep;
            const char* a3 = a2 + kstep; const char* b3 = b2 + kstep;
            PG8_LDB(B0, 0, 0); PG8_LDB(B1, 0, 1); PG8_SCHED; PG8_LDA(At, 0, 0); if (wsel == 0) PG8_STAGE(PG8_SA(1, 1), a1 + hA, voffA);
            PG8_WAIT_SEL; PG8_WAIT_L(0); PG8_BAR; PG8_MMA(0, 0, At, B0); PG8_MMA(0, 1, At, B1); PG8_BAR; PG8_SCHED;
            PG8_LDA(At, 0, 1); PG8_STAGE(PG8_SB(0, 0), b2, voffB); PG8_STAGE(PG8_SB(0, 1), b2 + hB, voffB); PG8_STAGE(PG8_SA(0, 0), a2, voffA);
            PG8_WAIT_SEL; PG8_WAIT_L(0); PG8_BAR; PG8_MMA(1, 0, At, B0); PG8_MMA(1, 1, At, B1); PG8_BAR; PG8_SCHED;
            PG8_LDB(B0, 1, 0); PG8_LDB(B1, 1, 1); PG8_SCHED; PG8_LDA(At, 1, 0); PG8_STAGE(PG8_SA(0, 1), a2 + hA, voffA);
            PG8_WAIT_SEL; PG8_WAIT_L(0); PG8_BAR; PG8_MMA(0, 0, At, B0); PG8_MMA(0, 1, At, B1); PG8_BAR; PG8_SCHED;
            PG8_LDA(At, 1, 1); PG8_STAGE(PG8_SB(1, 0), b3, voffB); PG8_STAGE(PG8_SB(1, 1), b3 + hB, voffB); PG8_STAGE(PG8_SA(1, 0), a3, voffA);
            PG8_WAIT_V(8); PG8_WAIT_L(0); PG8_BAR; PG8_MMA(1, 0, At, B0); PG8_MMA(1, 1, At, B1); PG8_BAR; PG8_SCHED;
            wsel = 0;
        }
        if (has_next) { PG8_STAGE(PG8_SA(1, 1), nA + kstep + hA, voffA); PG8_RS((ui + 1) & 1, nxt.pm); }
        asm volatile("" ::: "memory"); PG8_SCHED;
        if constexpr (ALIGN_EPI) { if (wr == 0) PG8_BAR; }
        int eops;
        { int fr2 = fr, fq2 = fq; asm volatile("" : "+v"(fr2), "+v"(fq2)); eops = E(acc, cur, wr, wc, fr2, fq2, (const LAS float*)(lds + RS_OFF + (ui & 1) * 1024), !has_next); }
        if (!has_next) break;
        wsel = (eops >= Epi::VM_MIN) ? 2 : 1;
#pragma unroll
        for (int a = 0; a < 2; ++a)
#pragma unroll
            for (int b = 0; b < 2; ++b)
#pragma unroll
                for (int m = 0; m < 4; ++m)
#pragma unroll
                    for (int n = 0; n < 2; ++n) acc[a][b][m][n] = (f32x4){0.f, 0.f, 0.f, 0.f};
        cur = nxt; cA = nA; cB = nB; ++ui;
        if constexpr (ALIGN_EPI) { if (wr == 1) PG8_BAR; }
    }
    PG8_WAIT_V(0);
    if constexpr (!ALIGN_EPI) { if (wr == 0) PG8_BAR; }
    PG8_BAR;
#undef PG8_SA
#undef PG8_SB
#undef PG8_STAGE
#undef PG8_LDA
#undef PG8_LDB
#undef PG8_MMA
#undef PG8_WAIT_V
#undef PG8_WAIT_VN
#undef PG8_WAIT_SEL
#undef PG8_RS
#undef PG8_WAIT_L
#undef PG8_BAR
#undef PG8_SCHED
}
}
namespace epi {
using pg8::Unit;
typedef f32x4 Acc[2][2][4][2];

__device__ __forceinline__ float row_scale(const float* rs, int row) { return rs[row]; }
__device__ __forceinline__ u32x4 pack8(const f32x4 a, const f32x4 b) { u32x4 w; w.x = cvt_pk_bf16(a[0], a[1]); w.y = cvt_pk_bf16(a[2], a[3]); w.z = cvt_pk_bf16(b[0], b[1]); w.w = cvt_pk_bf16(b[2], b[3]); return w; }

struct EpiProj {
    static constexpr bool PERM = true, RS = true; static constexpr int VM_MIN = 16;
    bf16_t* P; float* misc; const float* ssq; const float* cs; const float* sn; const float* gt;     bf16_t* VT;     bf16_t* KI;     bf16_t* CVT;     float* ssqv;
    __device__ __forceinline__ int operator()(const Acc& acc, const Unit& u, int wr, int wc, int fr, int fq, const LAS float* rsl, const bool lastu) const {
        const int T = u.pn; const int row0 = u.pm * 256 + wr * 64 + fr;
        float rsv[8];
#pragma unroll
        for (int i = 0; i < 8; ++i) rsv[i] = rsl[wr * 64 + fr + (i >> 2) * 128 + (i & 3) * 16];
        if (T == 2 || T == 3 || T == 5 || T == 6 || T == 14) {
            if (T == 14 && wc >= 2) return 0;
            if (T == 14 && wc == 1) {
                if (fq < 2) {
#pragma unroll
                    for (int ai = 0; ai < 2; ++ai)
#pragma unroll
                        for (int m = 0; m < 4; ++m) { const int row = row0 + ai * 128 + m * 16; const float rs = rsv[ai * 4 + m];
                            float* mp = misc + (size_t)row * 16 + 8 * fq; *(f32x4*)mp = acc[ai][0][m][0] * rs; *(f32x4*)(mp + 4) = acc[ai][0][m][1] * rs; }
                }
                return 16;
            }
            const int mode = (T == 14) ? 2 : (T <= 3 ? 1 : 0);
            const float* gp = gt + 64 * ((T == 2) ? 0 : (T == 3) ? 1 : 2);
            f32x4 g1[2], g2[2];
#pragma unroll
            for (int n = 0; n < 2; ++n) { if (mode) { g1[n] = *(const f32x4*)(gp + 8 * fq + 4 * n); g2[n] = *(const f32x4*)(gp + 32 + 8 * fq + 4 * n); } else { g1[n] = (f32x4){1.f, 1.f, 1.f, 1.f}; g2[n] = g1[n]; } }
#pragma unroll
            for (int ai = 0; ai < 2; ++ai) {
#pragma unroll
                for (int m = 0; m < 4; ++m) {
                    const int row = row0 + ai * 128 + m * 16; const float rs = rsv[ai * 4 + m];
                    f32x4 x1[2], x2[2];
#pragma unroll
                    for (int n = 0; n < 2; ++n) { x1[n] = acc[ai][0][m][n] * rs; x2[n] = acc[ai][1][m][n] * rs; }
                    if (mode == 2) {
                        float s = 0.f;
#pragma unroll
                        for (int n = 0; n < 2; ++n) s += (x1[n][0] + x1[n][1]) + (x1[n][2] + x1[n][3]) + (x2[n][0] + x2[n][1]) + (x2[n][2] + x2[n][3]);
                        s += __shfl_xor(s, 16); s += __shfl_xor(s, 32); const float mu = s * (1.f / 64.f);
#pragma unroll
                        for (int n = 0; n < 2; ++n) { x1[n] = x1[n] - mu; x2[n] = x2[n] - mu; }
                    }
                    if (mode) {
                        float q = 0.f;
#pragma unroll
                        for (int n = 0; n < 2; ++n) { const f32x4 a = x1[n] * x1[n], b = x2[n] * x2[n]; q += (a[0] + a[1]) + (a[2] + a[3]) + (b[0] + b[1]) + (b[2] + b[3]); }
                        q += __shfl_xor(q, 16); q += __shfl_xor(q, 32); const float rr = rsqrtf(q * (1.f / 64.f) + EPS);
#pragma unroll
                        for (int n = 0; n < 2; ++n) { x1[n] = x1[n] * rr * g1[n]; x2[n] = x2[n] * rr * g2[n]; }
                        if (T == 2) {
#pragma unroll
                            for (int n = 0; n < 2; ++n) { x1[n] = x1[n] * (0.125f * 1.4426950408889634f); x2[n] = x2[n] * (0.125f * 1.4426950408889634f); } }
                    }
                    f32x4 o1[2], o2[2];
#pragma unroll
                    for (int n = 0; n < 2; ++n) { const int pos = row & (S - 1); const f32x4 c = *(const f32x4*)(cs + (size_t)pos * 32 + 8 * fq + 4 * n), s = *(const f32x4*)(sn + (size_t)pos * 32 + 8 * fq + 4 * n);
                        o1[n] = x1[n] * c - x2[n] * s; o2[n] = x2[n] * c + x1[n] * s; }
                    bf16_t* op = P + (size_t)row * PW + 256 * T + 64 * wc + 8 * fq;
                    *(u32x4*)op = pack8(o1[0], o1[1]); *(u32x4*)(op + 32) = pack8(o2[0], o2[1]);
                    if (T == 14) {
                        bf16_t* kp = KI + ((size_t)((row >> 5) * 4 + (fq >> 1)) * 64 + (fq & 1) * 32 + (row & 31)) * 8; *(u32x4*)kp = pack8(o1[0], o1[1]); *(u32x4*)(kp + 2 * 64 * 8) = pack8(o2[0], o2[1]); }
                }
            }
            return 16;
        }
        const int act = (T <= 1) ? 1 : 0; const float sc = (T == 8) ? 0.125f : 1.0f;
#pragma unroll
        for (int ai = 0; ai < 2; ++ai)
#pragma unroll
            for (int m = 0; m < 4; ++m) {
                const int row = row0 + ai * 128 + m * 16; const float rs = rsv[ai * 4 + m] * sc;
                bf16_t* op = P + (size_t)row * PW + 256 * T + 32 * wc + 8 * fq; float qv = 0.f;
#pragma unroll
                for (int bj = 0; bj < 2; ++bj) { f32x4 v0 = acc[ai][bj][m][0] * rs, v1 = acc[ai][bj][m][1] * rs;
                    if (act) {
#pragma unroll
                        for (int e = 0; e < 4; ++e) { v0[e] = gelu_tanh_f(v0[e]); v1[e] = gelu_tanh_f(v1[e]); }
                        const f32x4 a2 = v0 * v0, b2 = v1 * v1; qv += ((a2[0] + a2[1]) + (a2[2] + a2[3])) + ((b2[0] + b2[1]) + (b2[2] + b2[3])); }
                    *(u32x4*)(op + bj * 128) = pack8(v0, v1);
                    if (T == 4 || T == 9) { bf16_t* vp = (T == 4 ? VT : CVT) + ((size_t)((row >> 12) * 256 + bj * 128 + 32 * wc + 8 * fq)) * S + (row & (S - 1));
#pragma unroll
                        for (int e = 0; e < 4; ++e) { vp[(size_t)e * S] = (bf16_t)f2bf(v0[e]); vp[(size_t)(4 + e) * S] = (bf16_t)f2bf(v1[e]); } } }
                if (T == 1) { qv += __shfl_xor(qv, 16); qv += __shfl_xor(qv, 32); if (fq == 0) ssqv[(size_t)row * 4 + wc] = qv; }
            }
        return 16;
    }
};

struct EpiPlain {
    static constexpr bool PERM = true, RS = false; static constexpr int VM_MIN = 16;
    bf16_t* O; int ldc; int zcols;
    __device__ __forceinline__ int operator()(const Acc& acc, const Unit& u, int wr, int wc, int fr, int fq, const LAS float*, const bool lastu) const {
        const int row0 = u.pm * 256 + wr * 64 + fr; const int col0 = u.z * zcols + u.pn * 256 + 32 * wc + 8 * fq;
#pragma unroll
        for (int ai = 0; ai < 2; ++ai)
#pragma unroll
            for (int m = 0; m < 4; ++m) { bf16_t* op = O + (size_t)(row0 + ai * 128 + m * 16) * ldc + col0;
#pragma unroll
                for (int bj = 0; bj < 2; ++bj) *(u32x4*)(op + bj * 128) = pack8(acc[ai][bj][m][0], acc[ai][bj][m][1]); }
        return 16;
    }
};

struct EpiGate {
    static constexpr bool PERM = true, RS = true; static constexpr int VM_MIN = 40;
    bf16_t* MG; const bf16_t* BR; const float* ssq;
    __device__ __forceinline__ int operator()(const Acc& acc, const Unit& u, int wr, int wc, int fr, int fq, const LAS float* rsl, const bool lastu) const {
        const int row0 = u.pm * 256 + wr * 64 + fr; const int ch0 = u.pn * 64 + 16 * wc + 4 * fq;
        float rsv[8];
#pragma unroll
        for (int i = 0; i < 8; ++i) rsv[i] = rsl[wr * 64 + fr + (i >> 2) * 128 + (i & 3) * 16] * (1.0f / WG8_SCALE);
#pragma unroll
        for (int ai = 0; ai < 2; ++ai) {
            u32x2 bw[4][4];
#pragma unroll
            for (int m = 0; m < 4; ++m)
#pragma unroll
                for (int nb = 0; nb < 4; ++nb) bw[m][nb] = *(const u32x2*)(BR + (size_t)(row0 + ai * 128 + m * 16) * 4096 + ch0 + nb * 1024);
#pragma unroll
            for (int m = 0; m < 4; ++m) {
                const int row = row0 + ai * 128 + m * 16; const float rs = rsv[ai * 4 + m]; f32x4 o = (f32x4){0.f, 0.f, 0.f, 0.f};
#pragma unroll
                for (int bj = 0; bj < 2; ++bj)
#pragma unroll
                    for (int n = 0; n < 2; ++n) { const u32x2 w = bw[m][2 * bj + n]; const f32x4 a = acc[ai][bj][m][n] * rs;
                        o[0] += sigmoid_f(a[0]) * lo_bf(w.x); o[1] += sigmoid_f(a[1]) * hi_bf(w.x); o[2] += sigmoid_f(a[2]) * lo_bf(w.y); o[3] += sigmoid_f(a[3]) * hi_bf(w.y); }
                u32x2 ow; ow.x = cvt_pk_bf16(o[0], o[1]); ow.y = cvt_pk_bf16(o[2], o[3]);
                *(u32x2*)(MG + (size_t)row * 1024 + ch0) = ow;
            }
        }
        return 40;
    }
};

struct EpiResid {
    static constexpr bool PERM = true, RS = false; static constexpr int VM_MIN = 0;
    const float* resf; bf16_t* X; float* outf; float* ssq; unsigned char* x8;
    __device__ __forceinline__ int operator()(const Acc& acc, const Unit& u, int wr, int wc, int fr, int fq, const LAS float*, const bool lastu) const {
        const int row0 = u.pm * 256 + wr * 64 + fr; const int col0 = u.pn * 256 + 32 * wc + 8 * fq;
#pragma unroll
        for (int ai = 0; ai < 2; ++ai) {
            f32x4 r[4][2][2];
            if (resf) {
#pragma unroll
                for (int m = 0; m < 4; ++m)
#pragma unroll
                    for (int bj = 0; bj < 2; ++bj) { const float* rp = resf + (size_t)(row0 + ai * 128 + m * 16) * 1024 + col0 + bj * 128; r[m][bj][0] = *(const f32x4*)rp; r[m][bj][1] = *(const f32x4*)(rp + 4); }
            } else {
                u32x4 w[4][2];
#pragma unroll
                for (int m = 0; m < 4; ++m)
#pragma unroll
                    for (int bj = 0; bj < 2; ++bj) w[m][bj] = *(const u32x4*)(X + (size_t)(row0 + ai * 128 + m * 16) * 1024 + col0 + bj * 128);
#pragma unroll
                for (int m = 0; m < 4; ++m)
#pragma unroll
                    for (int bj = 0; bj < 2; ++bj) { const u32x4 q = w[m][bj]; r[m][bj][0] = (f32x4){lo_bf(q.x), hi_bf(q.x), lo_bf(q.y), hi_bf(q.y)}; r[m][bj][1] = (f32x4){lo_bf(q.z), hi_bf(q.z), lo_bf(q.w), hi_bf(q.w)}; }
            }
#pragma unroll
            for (int m = 0; m < 4; ++m) {
                const int row = row0 + ai * 128 + m * 16; const size_t off = (size_t)row * 1024 + col0; float q = 0.f;
#pragma unroll
                for (int bj = 0; bj < 2; ++bj) {
                    const f32x4 x0 = r[m][bj][0] + acc[ai][bj][m][0], x1 = r[m][bj][1] + acc[ai][bj][m][1];
                    if (outf) { *(f32x4*)(outf + off + bj * 128) = x0; *(f32x4*)(outf + off + bj * 128 + 4) = x1; }
                    else {
                        const f32x4 a = x0 * x0, b = x1 * x1; q += ((a[0] + a[1]) + (a[2] + a[3])) + ((b[0] + b[1]) + (b[2] + b[3]));
                        *(u32x4*)(X + off + bj * 128) = pack8(x0, x1);
                        if (x8) { u32x2 q8; q8.x = pk4_fp8(x0[0], x0[1], x0[2], x0[3]); q8.y = pk4_fp8(x1[0], x1[1], x1[2], x1[3]); *(u32x2*)(x8 + off + bj * 128) = q8; } }
                }
                if (!outf) { q += __shfl_xor(q, 16); q += __shfl_xor(q, 32); if (fq == 0) ssq[(size_t)row * 16 + 4 * u.pn + wc] = q; }
            }
        }
        return 0;
    }
};

struct EpiUp {
    static constexpr bool PERM = true, RS = true; static constexpr int VM_MIN = 16;
    bf16_t* H; const float* ssq;
    __device__ __forceinline__ int operator()(const Acc& acc, const Unit& u, int wr, int wc, int fr, int fq, const LAS float* rsl, const bool lastu) const {
        const int row0 = u.pm * 256 + wr * 64 + fr; const int col0 = u.pn * 256 + 32 * wc + 8 * fq;
        float rsv[8];
#pragma unroll
        for (int i = 0; i < 8; ++i) rsv[i] = rsl[wr * 64 + fr + (i >> 2) * 128 + (i & 3) * 16];
#pragma unroll
        for (int ai = 0; ai < 2; ++ai)
#pragma unroll
            for (int m = 0; m < 4; ++m) { const int row = row0 + ai * 128 + m * 16; const float rs = rsv[ai * 4 + m]; bf16_t* op = H + (size_t)row * FF + col0;
#pragma unroll
                for (int bj = 0; bj < 2; ++bj) { f32x4 v0 = acc[ai][bj][m][0] * rs, v1 = acc[ai][bj][m][1] * rs;
#pragma unroll
                    for (int e = 0; e < 4; ++e) { v0[e] = relu_f(v0[e]); v1[e] = relu_f(v1[e]); }
                    st16(op + bj * 128, pack8(v0 * v0, v1 * v1), lastu); } }
        return 16;
    }
};
}
struct Args {
    const float* in[18]; float* out; unsigned char* ws; int ph_lo, ph_hi; int coop, pad;
};
struct Frame { LAS unsigned char* lds; int tid, wave, G, vcu; };
constexpr int PTR_OFF = LDS_BYTES - 512;
enum { I_X = 0, I_LN_MIX, I_W_IN, I_SGU_NORM, I_SGU_W, I_SGU_B, I_Q_NORM, I_K_NORM, I_KIDX_NORM, I_I_BIAS, I_F_BIAS, I_MNORM, I_CONV_W, I_W_BRANCH, I_W_OUT, I_LN_MLP, I_W_UP, I_W_DOWN, I_OUT, I_WS };
__device__ __forceinline__ unsigned char* ptr_at(const Frame& F, int i) { const LAS unsigned* p = (const LAS unsigned*)(F.lds + PTR_OFF) + 2 * i;
    const unsigned lo = __builtin_amdgcn_readfirstlane(p[0]), hi = __builtin_amdgcn_readfirstlane(p[1]);
    typedef __attribute__((address_space(1))) unsigned char* gptr_t;
    return (unsigned char*)(gptr_t)(((unsigned long long)hi << 32) | lo); }
#define INP(i) ((const float*)ptr_at(F, (i)))
#define WSP(off) (ptr_at(F, I_WS) + (off))
constexpr size_t WS_GT = 512 * 1024;
constexpr size_t WS_RSA = 256 * 1024, WS_RSB = 320 * 1024;
__device__ __forceinline__ size_t maskt_idx(int m, int w) { const int b = m >> 12, t = m & (S - 1); return ((size_t)(b * 64 + (w >> 1)) * S + t) * 2 + (w & 1); }


#define XB_TMO      128
#define XB_XCNT(j)  (256  + 64 * (j))
#define XB_XSUB(j)  (1280 + 64 * (j))
#define XB_XGEN(j)  (2304 + 64 * (j))
#define XB_TOP      3328
#define XB_TOPGEN   3392
#define XCD_BAR_WORDS 3456
#define XB_SPIN_CAP (1u << 22)
constexpr size_t WS_BAR = 64 * 1024;
constexpr size_t CTL_ZERO_BYTES = 128 * 1024;
__device__ __forceinline__ unsigned xb_ld(unsigned* p)              { return __hip_atomic_load(p, __ATOMIC_RELAXED, __HIP_MEMORY_SCOPE_AGENT); }
__device__ __forceinline__ unsigned xb_add(unsigned* p, unsigned v) { return __hip_atomic_fetch_add(p, v, __ATOMIC_RELAXED, __HIP_MEMORY_SCOPE_AGENT); }
__device__ __forceinline__ unsigned xb_xcc_id() { return (unsigned)__builtin_amdgcn_s_getreg((3 << 11) | 20) & 0xFu; }
#define XB_SPIN(cond, bar) do { unsigned _sp = 0; while (cond) { __builtin_amdgcn_s_sleep(1); \
    if ((++_sp & 255u) == 0u) { if (xb_ld(&(bar)[XB_TMO])) break; if (_sp > XB_SPIN_CAP) { atomicAdd(&(bar)[XB_TMO], 1u); break; } } } } while (0)
struct XcdBarrier { unsigned* bar; unsigned x; volatile LAS unsigned* st; };
__device__ __forceinline__ XcdBarrier xcd_barrier_post(unsigned* bar, volatile LAS unsigned* st) {
    XcdBarrier b; b.bar = bar; b.x = xb_xcc_id(); b.st = st;
    if (threadIdx.x == 0) (void)xb_add(&bar[XB_XCNT(b.x)], 1u);
    return b;
}
__device__ __forceinline__ void xcd_barrier_complete(unsigned* bar, unsigned x, unsigned& nloc, unsigned& nx) {
    const unsigned G = gridDim.x * gridDim.y * gridDim.z;
    unsigned sum, cnt, mine, sp = 0u;
    for (;;) {
        sum = 0u; cnt = 0u; mine = 0u;
#pragma unroll
        for (unsigned j = 0; j < 16; ++j) { const unsigned c = xb_ld(&bar[XB_XCNT(j)]); sum += c; cnt += (c > 0u) ? 1u : 0u; mine = (j == x) ? c : mine; }
        if (sum == G) break;
        __builtin_amdgcn_s_sleep(1);
        if ((++sp & 255u) == 0u) { if (xb_ld(&bar[XB_TMO])) break; if (sp > XB_SPIN_CAP) { atomicAdd(&bar[XB_TMO], 1u); break; } }
    }
    nloc = mine > 0u ? mine : 1u; nx = cnt > 0u ? cnt : 1u;
}
__device__ __forceinline__ void xcd_barrier(const XcdBarrier& b) {
    asm volatile("s_waitcnt vmcnt(0)" ::: "memory");
    __syncthreads();
    if (threadIdx.x == 0) {
        unsigned* bar = b.bar;
        __builtin_amdgcn_s_waitcnt(0);
        unsigned nloc = b.st[0], nx = b.st[1];
        if (nloc == 0u) { xcd_barrier_complete(bar, b.x, nloc, nx); b.st[0] = nloc; b.st[1] = nx; }
        const unsigned old = xb_add(&bar[XB_XSUB(b.x)], 1u);
        const unsigned gen = old / nloc;
        if (old + 1u == (gen + 1u) * nloc) {
            __builtin_amdgcn_fence(__ATOMIC_RELEASE, "agent");
            asm volatile("s_waitcnt vmcnt(0)" ::: "memory");
            const unsigned og = xb_add(&bar[XB_TOP], 1u);
            const unsigned tg = og / nx;
            if (og + 1u == (tg + 1u) * nx) xb_add(&bar[XB_TOPGEN], 1u);
            else XB_SPIN(xb_ld(&bar[XB_TOPGEN]) == tg, bar);
            __builtin_amdgcn_fence(__ATOMIC_ACQUIRE, "agent");
            xb_add(&bar[XB_XGEN(b.x)], 1u);
            asm volatile("s_waitcnt vmcnt(0)" ::: "memory");
        } else {
            XB_SPIN(xb_ld(&bar[XB_XGEN(b.x)]) == gen, bar);
            __builtin_amdgcn_fence(__ATOMIC_ACQUIRE, "agent");
            asm volatile("s_waitcnt vmcnt(0)" ::: "memory");
        }
    }
    __syncthreads();
}

__device__ __forceinline__ int win_src(int p) {
    const int T = p >> 8, q = p & 255, bj = q >> 7, wc = (q >> 5) & 3, j = q & 31, hd = 64 * wc + 32 * bj + j;
    switch (T) {
        case 0: return O_AU + q; case 1: return O_AV + q; case 2: return O_BQ + hd; case 3: return O_BK + hd; case 4: return O_BV + q;
        case 5: return O_QI + hd; case 6: return O_QI + 256 + hd; case 7: return O_CQ + q; case 8: return O_CK + q; case 9: return O_CV + q;
        case 10: return O_CO + q; case 11: return O_DB + q; case 12: return O_DC + q; case 13: return O_DX + q;
        default: break;
    }
    if (wc == 0) return O_KI + 32 * bj + j;
    if (wc == 1 && bj == 0 && j < 16) return j < 8 ? O_WI + j : (j < 12 ? O_CI + (j - 8) : O_CF + (j - 12));
    return -1;
}
__device__ __forceinline__ int wg_src(int p) {
    const int pn = p >> 8, q = p & 255, bj = q >> 7, wc = (q >> 5) & 3, fq = (q >> 3) & 3, n = (q >> 2) & 1, e = q & 3;
    return O_G + (2 * bj + n) * 1024 + 64 * pn + 16 * wc + 4 * fq + e;
}
template <int MAP>
__device__ __forceinline__ void conv_item(const float* W, int K, int srcN, bf16_t* WT, LAS float* scr, int item, int nrows, int lane, const float* gain = nullptr) {
    const int nblk = nrows / 32, kb = item / nblk, nb = item % nblk, k0 = 64 * kb, n0 = 32 * nb;
    const int nn = n0 + (lane & 31); const int src = MAP == 0 ? nn : (MAP == 1 ? win_src(nn) : wg_src(nn));
    float wv_[32]; const float* wp_ = W + (size_t)(k0 + (lane >> 5)) * srcN + (src >= 0 ? src : 0);
#pragma unroll
    for (int i = 0; i < 32; ++i) wv_[i] = __builtin_nontemporal_load(wp_ + (size_t)(2 * i) * srcN);
#pragma unroll
    for (int i = 0; i < 32; ++i) scr[(2 * i + (lane >> 5)) * 33 + (lane & 31)] = src >= 0 ? (gain ? wv_[i] * gain[k0 + 2 * i + (lane >> 5)] : wv_[i]) : 0.f;
    asm volatile("s_waitcnt lgkmcnt(0)" ::: "memory");
    const int c = lane & 7;
#pragma unroll
    for (int j = 0; j < 4; ++j) { const int n = (lane >> 3) + 8 * j; const LAS float* s = scr + (8 * c) * 33 + n;
        u32x4 o; o.x = pk2(s[0 * 33], s[1 * 33]); o.y = pk2(s[2 * 33], s[3 * 33]); o.z = pk2(s[4 * 33], s[5 * 33]); o.w = pk2(s[6 * 33], s[7 * 33]);
        *(u32x4*)(WT + (size_t)(n0 + n) * K + k0 + 8 * c) = o; }
    asm volatile("s_waitcnt lgkmcnt(0)" ::: "memory");
}
template <int MAP>
__device__ __forceinline__ void conv_item8(const float* W, int K, int srcN, unsigned char* WT8, LAS float* scr, int item, int nrows, int lane, const float* gain, float scale) {
    const int nblk = nrows / 32, kb = item / nblk, nb = item % nblk, k0 = 64 * kb, n0 = 32 * nb;
    const int nn = n0 + (lane & 31); const int src = MAP == 0 ? nn : (MAP == 1 ? win_src(nn) : wg_src(nn));
    float wv_[32]; const float* wp_ = W + (size_t)(k0 + (lane >> 5)) * srcN + (src >= 0 ? src : 0);
#pragma unroll
    for (int i = 0; i < 32; ++i) wv_[i] = __builtin_nontemporal_load(wp_ + (size_t)(2 * i) * srcN);
#pragma unroll
    for (int i = 0; i < 32; ++i) scr[(2 * i + (lane >> 5)) * 33 + (lane & 31)] = src >= 0 ? wv_[i] * gain[k0 + 2 * i + (lane >> 5)] * scale : 0.f;
    asm volatile("s_waitcnt lgkmcnt(0)" ::: "memory");
    const int c = lane & 7;
#pragma unroll
    for (int j = 0; j < 4; ++j) { const int n = (lane >> 3) + 8 * j; const LAS float* s = scr + (8 * c) * 33 + n;
        u32x2 o; o.x = pk4_fp8(s[0 * 33], s[1 * 33], s[2 * 33], s[3 * 33]); o.y = pk4_fp8(s[4 * 33], s[5 * 33], s[6 * 33], s[7 * 33]);
        *(u32x2*)(WT8 + (size_t)(n0 + n) * K + k0 + 8 * c) = o; }
    asm volatile("s_waitcnt lgkmcnt(0)" ::: "memory");
}
__device__ __forceinline__ void convert_mix_weights(Frame& F, int l) {

    LAS float* scr = (LAS float*)(F.lds + F.wave * 16384);
    const int gw = F.vcu * NWAVES + F.wave, NGW = F.G * NWAVES;
    constexpr int I_WIN = (D / 64) * (PW / 32), I_WG = (D / 64) * (4096 / 32), I_BR = (256 / 64) * (1024 / 32), I_WO = (D / 64) * (D / 32);
    constexpr int NIT = I_WIN + I_WG + 4 * I_BR + I_WO;
    const float* win = INP(I_W_IN) + (size_t)l * D * INW; const float* gmix = INP(I_LN_MIX) + l * D;
    for (int it = gw; it < NIT; it += NGW) {
        int r = it;
        if (r < I_WIN) { conv_item<1>(win, D, INW, ((bf16_t*)WSP(WS_WIN)), scr, r, PW, (F.tid & 63), gmix); continue; } r -= I_WIN;
        if (r < I_WG) { conv_item8<2>(win, D, INW, ptr_at(F, I_OUT) + OUT_WG8 + (size_t)l * 4 * MiB, scr, r, 4096, (F.tid & 63), gmix, WG8_SCALE); continue; } r -= I_WG;
        if (r < 4 * I_BR) { const int nb = r / I_BR; conv_item<0>(INP(I_W_BRANCH) + ((size_t)l * 4 + nb) * 256 * D, 256, D, ((bf16_t*)WSP(WS_WBR)) + (size_t)nb * 1024 * 256, scr, r % I_BR, 1024, (F.tid & 63)); continue; } r -= 4 * I_BR;
        conv_item<0>(INP(I_W_OUT) + (size_t)l * D * D, D, D, ((bf16_t*)WSP(WS_WOUT)), scr, r, D, (F.tid & 63));
    }
}
__device__ __forceinline__ void convert_mlp_weights(Frame& F, int l) {

    LAS float* scr = (LAS float*)(F.lds + F.wave * 16384);
    const int gw = F.vcu * NWAVES + F.wave, NGW = F.G * NWAVES;
    constexpr int I_UP = (D / 64) * (FF / 32), I_DN = (FF / 64) * (D / 32);
    for (int it = gw; it < I_UP + I_DN; it += NGW) {
        if (it < I_UP) conv_item<0>(INP(I_W_UP) + (size_t)l * D * FF, D, FF, ((bf16_t*)WSP(WS_WUP)), scr, it, FF, (F.tid & 63), INP(I_LN_MLP) + l * D);
        else conv_item<0>(INP(I_W_DOWN) + (size_t)l * FF * D, FF, D, ((bf16_t*)WSP(WS_WDN)), scr, it - I_UP, D, (F.tid & 63));
    }
}
__device__ __forceinline__ void prologue_rows(Frame& F) {
    float* COS = (float*)WSP(WS_COS); float* SIN = (float*)WSP(WS_SIN); float* SSQA = (float*)WSP(WS_SSQA); bf16_t* XG = (bf16_t*)WSP(WS_XG); const float* x = INP(I_X); const float* ln_mix = INP(I_LN_MIX);
    const int gt = F.vcu * NT + F.tid, NGT = F.G * NT;
    for (int i = gt; i < S * 32; i += NGT) { const int pos = i >> 5, k = i & 31; const float inv = powf(10000.f, -(float)k * 2.0f / 64.f); const float ang = (float)pos * inv; COS[i] = cosf(ang); SIN[i] = sinf(ang); }
    const int gw = F.vcu * NWAVES + F.wave, NGW = F.G * NWAVES;
    float* rsa = (float*)WSP(WS_RSA); unsigned char* x8p = ptr_at(F, I_OUT) + OUT_X8;
    for (int m0 = gw * 4; m0 < M; m0 += NGW * 4) {
        f32x4 v[4][4];
#pragma unroll
        for (int r = 0; r < 4; ++r)
#pragma unroll
            for (int j = 0; j < 4; ++j) v[r][j] = __builtin_nontemporal_load((const f32x4*)(x + (size_t)(m0 + r) * D) + (F.tid & 63) + 64 * j);
#pragma unroll
        for (int r = 0; r < 4; ++r) { float s = 0.f; unsigned long long* o8 = (unsigned long long*)(XG + (size_t)(m0 + r) * D) + (F.tid & 63);
#pragma unroll
            for (int j = 0; j < 4; ++j) { const f32x4 w = v[r][j]; s += (w[0] * w[0] + w[1] * w[1]) + (w[2] * w[2] + w[3] * w[3]);
                o8[64 * j] = (unsigned long long)pk2(w[0], w[1]) | ((unsigned long long)pk2(w[2], w[3]) << 32);
                ((unsigned*)(x8p + (size_t)(m0 + r) * D))[(F.tid & 63) + 64 * j] = pk4_fp8(w[0], w[1], w[2], w[3]); }
            s = wave_sum(s);
            if ((F.tid & 63) == 0) rsa[m0 + r] = rsqrtf(s * (1.f / 1024.f) + EPS); }
    }
}
__device__ __forceinline__ void finalize_rs(Frame& F, size_t ssq_off, size_t rs_off) {
    const float* ssq = (const float*)WSP(ssq_off); float* rs = (float*)WSP(rs_off);
    for (int row = F.vcu * NT + F.tid; row < M; row += F.G * NT) { const f32x4* sp = (const f32x4*)(ssq + (size_t)row * 16); const f32x4 a = sp[0], b = sp[1], c = sp[2], d = sp[3];
        const float t = ((a[0] + a[1]) + (a[2] + a[3])) + ((b[0] + b[1]) + (b[2] + b[3])) + ((c[0] + c[1]) + (c[2] + c[3])) + ((d[0] + d[1]) + (d[2] + d[3]));
        rs[row] = rsqrtf(t * (1.0f / 1024.0f) + EPS); }
}

__device__ __forceinline__ void conv_simple(Frame& F, int l) {
    bf16_t* PROJ = (bf16_t*)WSP(WS_BIG); bf16_t* Y = (bf16_t*)WSP(WS_Y); const float* conv_w = INP(I_CONV_W);
    const float* cw = conv_w + l * 3 * 256;
    for (int i = F.vcu * NT + F.tid; i < M * 32; i += F.G * NT) { const int m = i >> 5, c = (i & 31) * 8, t = m & (S - 1); float acc[8];
#pragma unroll
        for (int e = 0; e < 8; ++e) acc[e] = 0.f;
#pragma unroll
        for (int j = 0; j < 3; ++j) { const int tt = t - 2 + j; if (tt >= 0) { const size_t r = (size_t)(m - 2 + j) * PW; const u32x4 a = *(const u32x4*)(PROJ + r + P_DC + c), x = *(const u32x4*)(PROJ + r + P_DX + c);
                const f32x4 w0 = *(const f32x4*)(cw + j * 256 + c), w1 = *(const f32x4*)(cw + j * 256 + c + 4);
                acc[0] = fmaf(w0[0], lo_bf(a.x) * lo_bf(x.x), acc[0]); acc[1] = fmaf(w0[1], hi_bf(a.x) * hi_bf(x.x), acc[1]); acc[2] = fmaf(w0[2], lo_bf(a.y) * lo_bf(x.y), acc[2]); acc[3] = fmaf(w0[3], hi_bf(a.y) * hi_bf(x.y), acc[3]);
                acc[4] = fmaf(w1[0], lo_bf(a.z) * lo_bf(x.z), acc[4]); acc[5] = fmaf(w1[1], hi_bf(a.z) * hi_bf(x.z), acc[5]); acc[6] = fmaf(w1[2], lo_bf(a.w) * lo_bf(x.w), acc[6]); acc[7] = fmaf(w1[3], hi_bf(a.w) * hi_bf(x.w), acc[7]); } }
        const u32x4 bq = *(const u32x4*)(PROJ + (size_t)m * PW + P_DB + c); u32x4 o;
        o.x = cvt_pk_bf16(lo_bf(bq.x) * acc[0], hi_bf(bq.x) * acc[1]); o.y = cvt_pk_bf16(lo_bf(bq.y) * acc[2], hi_bf(bq.y) * acc[3]); o.z = cvt_pk_bf16(lo_bf(bq.z) * acc[4], hi_bf(bq.z) * acc[5]); o.w = cvt_pk_bf16(lo_bf(bq.w) * acc[6], hi_bf(bq.w) * acc[7]);
        *(u32x4*)(Y + (size_t)m * D + 768 + c) = o; }
}
typedef float f32x16 __attribute__((ext_vector_type(16)));
constexpr size_t WS_VT = WS_BIG + 120 * MiB;
constexpr float LOG2E = 1.4426950408889634f;

template <int R> struct AttExp {
    static __device__ __forceinline__ void run(f32x16& p0, f32x16& p1, unsigned sh0, unsigned sh1, float& lsum) {
        constexpr int CB = (R & 3) + 8 * (R >> 2);
        int m0, m1; asm("v_bfe_i32 %0, %1, %2, 1" : "=v"(m0) : "v"(sh0), "n"(CB)); asm("v_bfe_i32 %0, %1, %2, 1" : "=v"(m1) : "v"(sh1), "n"(CB));
        p0[R] = __uint_as_float(__float_as_uint(__builtin_amdgcn_exp2f(p0[R])) & (unsigned)m0); p1[R] = __uint_as_float(__float_as_uint(__builtin_amdgcn_exp2f(p1[R])) & (unsigned)m1);
        lsum += p0[R] + p1[R];
        AttExp<R + 1>::run(p0, p1, sh0, sh1, lsum);
    }
};
template <> struct AttExp<16> { static __device__ __forceinline__ void run(f32x16&, f32x16&, unsigned, unsigned, float&) {} };

__device__ __forceinline__ void attn_mfma(Frame& F, int l) {
    const unsigned long long* MASKT = (const unsigned long long*)WSP(WS_MASK); const bf16_t* PROJ = (const bf16_t*)WSP(WS_BIG); const bf16_t* VT = (const bf16_t*)WSP(WS_VT);
    bf16_t* Y = (bf16_t*)WSP(WS_Y); const float* gt = (const float*)WSP(WS_GT) + l * 192;
    const int lane = (F.tid & 63), r32 = lane & 31, hi = lane >> 5, grp = F.wave >> 2, w4 = F.wave & 3, lg = F.tid & 255;
    const float mq = wave_max(fabsf(gt[lane])), mk = wave_max(fabsf(gt[64 + lane]));
    const float c2 = 8.f * mq * mk * 1.01f * LOG2E;
    constexpr int ROWB = 144, TILEB = 64 * ROWB;
    LAS unsigned char* gb = F.lds + grp * 4 * TILEB;
    LAS float* comb = (LAS float*)(F.lds + 8 * TILEB);
    const int srow0 = lg >> 3, sc0 = lg & 7;
    for (int item = F.vcu; item < 256; item += F.G) {
        const int bh = item >> 4, sidx = item & 15, b = bh >> 2, h = bh & 3;
#pragma unroll 1
        for (int half = 0; half < 2; ++half) {
            const int qb = half == 0 ? sidx : 31 - sidx, q0 = qb * 128, ntl = qb + 1;
            const int qrow = b * S + q0 + w4 * 32 + r32, tq = q0 + w4 * 32 + r32;
            bf16x8 qf[4];
#pragma unroll
            for (int s = 0; s < 4; ++s) qf[s] = *(const bf16x8*)(PROJ + (size_t)qrow * PW + P_Q + h * 64 + 16 * s + 8 * hi);
            f32x16 o0, o1;
#pragma unroll
            for (int r = 0; r < 16; ++r) { o0[r] = 0.f; o1[r] = 0.f; }
            float lsum = 0.f;
            const bf16_t* kbase = PROJ + (size_t)(b * S + srow0) * PW + P_K + h * 64 + sc0 * 8;
            const bf16_t* vbase = VT + (size_t)(b * 256 + h * 64 + srow0) * S + sc0 * 8;
            const unsigned long long* mbase = MASKT + (size_t)(b * 64) * S + tq;
            u32x4 ka0, ka1, va0, va1, kb0, kb1, vb0, vb1; unsigned long long mwa = 0ull, mwb = 0ull;
#define ATT_LOAD(K0, K1, V0, V1, MW, t_) do { const int t__ = (t_); K0 = *(const u32x4*)(kbase + (size_t)t__ * 64 * PW); K1 = *(const u32x4*)(kbase + (size_t)(t__ * 64 + 32) * PW); \
    V0 = *(const u32x4*)(vbase + t__ * 64); V1 = *(const u32x4*)(vbase + 32 * S + t__ * 64); MW = mbase[(size_t)t__ * S]; } while (0)
#define ATT_STORE(K0, K1, V0, V1, buf_) do { LAS unsigned char* kn_ = gb + (buf_) * 2 * TILEB; LAS unsigned char* vn_ = kn_ + TILEB; \
    *(LAS u32x4*)(kn_ + srow0 * ROWB + sc0 * 16) = K0; *(LAS u32x4*)(kn_ + (srow0 + 32) * ROWB + sc0 * 16) = K1; \
    *(LAS u32x4*)(vn_ + srow0 * ROWB + sc0 * 16) = V0; *(LAS u32x4*)(vn_ + (srow0 + 32) * ROWB + sc0 * 16) = V1; } while (0)
#define ATT_COMPUTE(cur_, MW) do { \
                const LAS unsigned char* kb = gb + (cur_) * 2 * TILEB; const LAS unsigned char* vb = kb + TILEB; \
                f32x16 p0, p1; \
                _Pragma("unroll") for (int r = 0; r < 16; ++r) { p0[r] = -c2; p1[r] = -c2; }     \
                _Pragma("unroll") for (int s = 0; s < 4; ++s) { \
                    const bf16x8 k0 = *(const LAS bf16x8*)(kb + r32 * ROWB + 32 * s + 16 * hi), k1 = *(const LAS bf16x8*)(kb + (32 + r32) * ROWB + 32 * s + 16 * hi); \
                    p0 = __builtin_amdgcn_mfma_f32_32x32x16_bf16(k0, qf[s], p0, 0, 0, 0); p1 = __builtin_amdgcn_mfma_f32_32x32x16_bf16(k1, qf[s], p1, 0, 0, 0); } \
                const unsigned sh0 = (unsigned)(MW) >> (4 * hi), sh1 = (unsigned)((MW) >> 32) >> (4 * hi); \
                AttExp<0>::run(p0, p1, sh0, sh1, lsum); \
                _Pragma("unroll") for (int ks = 0; ks < 4; ++ks) { \
                    u32x4 pw; \
                    if (ks < 2) { pw.x = cvt_pk_bf16(p0[8 * ks + 0], p0[8 * ks + 1]); pw.y = cvt_pk_bf16(p0[8 * ks + 2], p0[8 * ks + 3]); pw.z = cvt_pk_bf16(p0[8 * ks + 4], p0[8 * ks + 5]); pw.w = cvt_pk_bf16(p0[8 * ks + 6], p0[8 * ks + 7]); } \
                    else { const int k2 = ks - 2; pw.x = cvt_pk_bf16(p1[8 * k2 + 0], p1[8 * k2 + 1]); pw.y = cvt_pk_bf16(p1[8 * k2 + 2], p1[8 * k2 + 3]); pw.z = cvt_pk_bf16(p1[8 * k2 + 4], p1[8 * k2 + 5]); pw.w = cvt_pk_bf16(p1[8 * k2 + 6], p1[8 * k2 + 7]); } \
                    const bf16x8 pf = __builtin_bit_cast(bf16x8, pw); \
                    const int vo = 64 * (ks >> 1) + 32 * (ks & 1) + 8 * hi; \
                    const u32x2 a0 = *(const LAS u32x2*)(vb + r32 * ROWB + vo), a1 = *(const LAS u32x2*)(vb + r32 * ROWB + vo + 16); \
                    const u32x2 b0 = *(const LAS u32x2*)(vb + (32 + r32) * ROWB + vo), b1 = *(const LAS u32x2*)(vb + (32 + r32) * ROWB + vo + 16); \
                    const u32x4 va = {a0.x, a0.y, a1.x, a1.y}, vb4 = {b0.x, b0.y, b1.x, b1.y}; \
                    o0 = __builtin_amdgcn_mfma_f32_32x32x16_bf16(__builtin_bit_cast(bf16x8, va), pf, o0, 0, 0, 0); \
                    o1 = __builtin_amdgcn_mfma_f32_32x32x16_bf16(__builtin_bit_cast(bf16x8, vb4), pf, o1, 0, 0, 0); } \
            } while (0)
            ATT_LOAD(ka0, ka1, va0, va1, mwa, grp);
            if (ntl > 1) ATT_LOAD(kb0, kb1, vb0, vb1, mwb, 2 + grp);
            ATT_STORE(ka0, ka1, va0, va1, 0);
            __syncthreads();
            asm volatile(".p2align 8");
#pragma unroll 1
            for (int i = 0; i < ntl; i += 2) {
                const unsigned long long mw0 = mwa;
                if (i + 2 < ntl) ATT_LOAD(ka0, ka1, va0, va1, mwa, 2 * (i + 2) + grp);
                ATT_COMPUTE(0, mw0);
                if (i + 1 < ntl) ATT_STORE(kb0, kb1, vb0, vb1, 1);
                __syncthreads();
                if (i + 1 < ntl) {
                    const unsigned long long mw1 = mwb;
                    if (i + 3 < ntl) ATT_LOAD(kb0, kb1, vb0, vb1, mwb, 2 * (i + 3) + grp);
                    ATT_COMPUTE(1, mw1);
                    if (i + 2 < ntl) ATT_STORE(ka0, ka1, va0, va1, 0);
                    __syncthreads();
                }
            }
#undef ATT_LOAD
#undef ATT_STORE
#undef ATT_COMPUTE
            if (grp == 1) { LAS float* cw = comb + w4 * 33 * 64 + lane;
#pragma unroll
                for (int r = 0; r < 16; ++r) { cw[r * 64] = o0[r]; cw[(16 + r) * 64] = o1[r]; }
                cw[32 * 64] = lsum; }
            __syncthreads();
            if (grp == 0) { const LAS float* cw = comb + w4 * 33 * 64 + lane;
#pragma unroll
                for (int r = 0; r < 16; ++r) { o0[r] += cw[r * 64]; o1[r] += cw[(16 + r) * 64]; }
                lsum += cw[32 * 64]; lsum += __shfl_xor(lsum, 32); const float inv = 1.f / lsum;
                bf16_t* yp = Y + (size_t)qrow * D + 256 + h * 64 + 4 * hi;
#pragma unroll
                for (int g4 = 0; g4 < 4; ++g4) { u32x2 w0, w1;
                    w0.x = cvt_pk_bf16(o0[4 * g4] * inv, o0[4 * g4 + 1] * inv); w0.y = cvt_pk_bf16(o0[4 * g4 + 2] * inv, o0[4 * g4 + 3] * inv);
                    w1.x = cvt_pk_bf16(o1[4 * g4] * inv, o1[4 * g4 + 1] * inv); w1.y = cvt_pk_bf16(o1[4 * g4 + 2] * inv, o1[4 * g4 + 3] * inv);
                    *(u32x2*)(yp + 8 * g4) = w0; *(u32x2*)(yp + 32 + 8 * g4) = w1; } }
            __syncthreads();
        }
    }
}

constexpr size_t WS_KI = 234 * MiB;
template <int J, unsigned MSK>
__device__ __forceinline__ void tr_stage(unsigned (&a)[32]) {
#pragma unroll
    for (int k = 0; k < 32; ++k) if ((k & J) == 0) { const unsigned t = (a[k] ^ (a[k + J] >> J)) & MSK; a[k] ^= t; a[k + J] ^= (t << J); }
}
__device__ __forceinline__ void transpose32(unsigned (&a)[32]) {
    tr_stage<16, 0x0000FFFFu>(a); tr_stage<8, 0x00FF00FFu>(a); tr_stage<4, 0x0F0F0F0Fu>(a); tr_stage<2, 0x33333333u>(a); tr_stage<1, 0x55555555u>(a);
}
__device__ __forceinline__ int wave_total_i(int v) {
    v += __builtin_amdgcn_update_dpp(0, v, 0x111, 0xf, 0xf, false);
    v += __builtin_amdgcn_update_dpp(0, v, 0x112, 0xf, 0xf, false);
    v += __builtin_amdgcn_update_dpp(0, v, 0x114, 0xf, 0xf, false);
    v += __builtin_amdgcn_update_dpp(0, v, 0x118, 0xf, 0xf, false);
    v += __builtin_amdgcn_update_dpp(0, v, 0x142, 0xa, 0xf, false);
    v += __builtin_amdgcn_update_dpp(0, v, 0x143, 0xc, 0xf, false);
    return __builtin_amdgcn_readlane(v, 63);
}
__device__ __forceinline__ void idx_score(Frame& F, const int b, const int t0, LAS unsigned short* sc16, const int sw, const int prevn) {
    if (t0 + 8 <= 256) return;
    const float* MISC = (const float*)WSP(WS_MISC); const bf16_t* PROJ = (const bf16_t*)WSP(WS_BIG); const bf16_t* KI = (const bf16_t*)WSP(WS_KI);
    const int lane = (F.tid & 63), r32 = lane & 31, hi = lane >> 5, m0 = b * S + t0;
    const int nmax = t0 + 8, ntile = (nmax + 31) >> 5;
    bf16x8 qa[2][4], wsel[2][2];
#pragma unroll
    for (int i = 0; i < 2; ++i) {
        const bf16_t* qp = PROJ + (size_t)(m0 + 4 * i + (r32 >> 3)) * PW + P_QI + (r32 & 7) * 64 + 8 * hi;
#pragma unroll
        for (int s = 0; s < 4; ++s) { qa[i][s] = *(const bf16x8*)(qp + 16 * s); asm volatile("" : "+v"(qa[i][s])); }
    }
    { const int qrow = r32 & 7; const f32x4 w4 = *(const f32x4*)(MISC + (size_t)(m0 + qrow) * 16 + 4 * hi);
      const float sc_ = 0.125f * 0.35355339059327373f; const unsigned p01 = cvt_pk_bf16(w4[0] * sc_, w4[1] * sc_), p23 = cvt_pk_bf16(w4[2] * sc_, w4[3] * sc_);
#pragma unroll
      for (int i = 0; i < 2; ++i)
#pragma unroll
          for (int s = 0; s < 2; ++s) { const bool mine = (r32 < 8) && ((qrow >> 2) == i) && (((qrow & 3) >> 1) == s); const bool upper = (qrow & 1) != 0;
              u32x4 f; f.x = (mine && !upper) ? p01 : 0u; f.y = (mine && !upper) ? p23 : 0u; f.z = (mine && upper) ? p01 : 0u; f.w = (mine && upper) ? p23 : 0u;
              asm volatile("" : "+v"(f));
              wsel[i][s] = __builtin_bit_cast(bf16x8, f); } }
    bf16x8 kring[2][4];
    const bf16_t* kbase_ = KI + ((size_t)(b * S >> 5) * 4 * 64 + lane) * 8;
#define IDX_LOADK(u_, j_) do { const int jt_ = (j_) < ntile ? (j_) : ntile - 1; const bf16_t* kp_ = kbase_ + (unsigned)jt_ * 2048u; \
    _Pragma("unroll") for (int s_ = 0; s_ < 4; ++s_) kring[u_][s_] = *(const bf16x8*)(kp_ + s_ * 64 * 8); } while (0)
#pragma unroll
    for (int u = 0; u < 2; ++u) IDX_LOADK(u, sw + 4 * u);
    f32x16 dd[2][2];
#define IDX_DSTEP(slot_, par_, s_) do { _Pragma("unroll") for (int i_ = 0; i_ < 2; ++i_) dd[par_][i_] = __builtin_amdgcn_mfma_f32_32x32x16_bf16(qa[i_][s_], kring[slot_][s_], dd[par_][i_], 0, 0, 0); } while (0)
#define IDX_WSTEP(par_, i_, s_) do { u32x4 rw_; const f32x16& d_ = dd[par_][i_]; \
        rw_.x = cvt_pk_bf16(relu_f(d_[8 * (s_) + 0]), relu_f(d_[8 * (s_) + 1])); rw_.y = cvt_pk_bf16(relu_f(d_[8 * (s_) + 2]), relu_f(d_[8 * (s_) + 3])); \
        rw_.z = cvt_pk_bf16(relu_f(d_[8 * (s_) + 4]), relu_f(d_[8 * (s_) + 5])); rw_.w = cvt_pk_bf16(relu_f(d_[8 * (s_) + 6]), relu_f(d_[8 * (s_) + 7])); \
        outv = __builtin_amdgcn_mfma_f32_32x32x16_bf16(wsel[i_][s_], __builtin_bit_cast(bf16x8, rw_), outv, 0, 0, 0); } while (0)
#pragma unroll
    for (int i = 0; i < 2; ++i)
#pragma unroll
        for (int r = 0; r < 16; ++r) dd[0][i][r] = 0.f;
#pragma unroll
    for (int s = 0; s < 4; ++s) IDX_DSTEP(0, 0, s);
    __builtin_amdgcn_sched_barrier(0);
    IDX_LOADK(0, sw + 8);
    __builtin_amdgcn_sched_barrier(0);
    asm volatile(".p2align 8");
    for (int jb = sw; jb < ntile; jb += 8) {
#pragma unroll
        for (int u = 0; u < 2; ++u) {
            const int j = jb + 4 * u;
            const int key = 32 * j + r32;
            f32x16 outv;
#pragma unroll
            for (int r = 0; r < 16; ++r) { outv[r] = 0.f; dd[(u + 1) & 1][0][r] = 0.f; dd[(u + 1) & 1][1][r] = 0.f; }
            IDX_DSTEP((u + 1) & 1, (u + 1) & 1, 0); IDX_WSTEP(u & 1, 0, 0);
            IDX_DSTEP((u + 1) & 1, (u + 1) & 1, 1); IDX_WSTEP(u & 1, 0, 1);
            IDX_DSTEP((u + 1) & 1, (u + 1) & 1, 2); IDX_WSTEP(u & 1, 1, 0);
            IDX_DSTEP((u + 1) & 1, (u + 1) & 1, 3); IDX_WSTEP(u & 1, 1, 1);
            __builtin_amdgcn_sched_barrier(0);
            IDX_LOADK((u + 1) & 1, j + 4 + 8);
            __builtin_amdgcn_sched_barrier(0);
            if (j < ntile) {
                const int kpos = ((key & 2047) << 1) + (key >> 11);
#pragma unroll
                for (int qq = 0; qq < 4; ++qq) { const int qx = 4 * hi + qq;
                    sc16[qx * 4096 + kpos] = __builtin_bit_cast(unsigned short, (_Float16)((key <= t0 + qx) ? outv[qq] : -INFINITY)); }
            }
        }
    }
#undef IDX_DSTEP
#undef IDX_WSTEP
    for (int j = ntile + ((sw - ntile) & 3); j < prevn; j += 4) {
        const int key = 32 * j + r32, kpos = ((key & 2047) << 1) + (key >> 11);
#pragma unroll
        for (int qq = 0; qq < 4; ++qq) sc16[(4 * hi + qq) * 4096 + kpos] = (unsigned short)0xFC00u;
    }
#undef IDX_LOADK
}
#define IDX_WL2(lo_, hi_, bal_, lane_) asm("s_nop 1\n\tv_writelane_b32 %0, %2, %4\n\tv_writelane_b32 %1, %3, %4" : "+v"(lo_), "+v"(hi_) : "s"((unsigned)(bal_)), "s"((unsigned)((bal_) >> 32)), "n"(lane_))
__device__ __forceinline__ void idx_select(Frame& F, const int b, const int t0, const LAS unsigned short* sc16, const int qw) {
    unsigned long long* MASKT = (unsigned long long*)WSP(WS_MASK);
    const int lane = (F.tid & 63);
#pragma unroll 1
    for (int qi = 0; qi < 2; ++qi) {
        const int qx = qw + 4 * qi, tq = t0 + qx;
        unsigned long long myword = 0ull;
        if (t0 + 8 <= 256) {
            const int lo = 64 * lane; myword = (tq >= lo + 63) ? ~0ull : (tq < lo ? 0ull : ((2ull << (tq - lo)) - 1ull));
            MASKT[(size_t)(b * 64 + lane) * S + tq] = myword;
            continue;
        }
        const int nmax = t0 + 8, ntile = (nmax + 31) >> 5;
        const int nvalid = 32 * ntile; const LAS unsigned* srow = (const LAS unsigned*)sc16 + qx * 2048 + lane;
        unsigned kk[32], kc[32];
#pragma unroll
        for (int r = 0; r < 32; ++r) { const unsigned w = srow[64 * r]; const unsigned sg = (w & 0x80008000u) >> 15; kc[r] = w ^ (((sg << 16) - sg) | 0x80008000u); kk[r] = kc[r]; }
        transpose32(kk);
        unsigned aA = ~0u, aB = ~0u, Tk = 0u; int base = 0;
#pragma unroll
        for (int bit = 15; bit >= 0; --bit) {
            const unsigned wa = kk[31 - bit], wb = kk[15 - bit];
            const int tot = wave_total_i(__builtin_popcount(wa & aA) + __builtin_popcount(wb & aB));
            const bool take = (base + tot >= 256);
            const unsigned flip = take ? 0u : ~0u;
            aA &= (wa ^ flip); aB &= (wb ^ flip);
            if (take) Tk |= (1u << bit); else base += tot;
        }
        const int ngt = base, neq = wave_total_i(__builtin_popcount(aA) + __builtin_popcount(aB));
        unsigned mlo = 0u, mhi = 0u;
        if (ngt + neq == 256) {
#pragma unroll
            for (int r = 0; r < 32; ++r) { const unsigned long long wlo = __ballot((kc[r] & 0xFFFFu) >= Tk); IDX_WL2(mlo, mhi, wlo, r); }
            if (nvalid > 2048) {
#pragma unroll
                for (int r = 0; r < 32; ++r) { const unsigned long long whi = __ballot((kc[r] >> 16) >= Tk); IDX_WL2(mlo, mhi, whi, 32 + r); } }
        } else {
            int need = 256 - ngt;
#pragma unroll
            for (int hf = 0; hf < 2; ++hf) if (hf == 0 || nvalid > 2048)
#pragma unroll
                for (int r = 0; r < 32; ++r) { const unsigned k = hf ? (kc[r] >> 16) : (kc[r] & 0xFFFFu);
                    unsigned long long wsel = __ballot(k > Tk), em = __ballot(k == Tk); int c = __builtin_popcountll(em);
                    if (c > need) { while (c > need) { em &= ~(1ull << (63 - __builtin_clzll(em))); --c; } }
                    need -= c; wsel |= em;
                    IDX_WL2(mlo, mhi, wsel, 32 * hf + r); }
        }
        myword = ((unsigned long long)mhi << 32) | mlo;
        MASKT[(size_t)(b * 64 + lane) * S + tq] = myword;
    }
}
__device__ __forceinline__ void indexer_mfma(Frame& F) {
    const int wv = F.wave;
    const int npi = (1024 - F.vcu + F.G - 1) / F.G, n = 2 * npi;
#define IDX_UNIT(idx_, b_, t0_) const int pi_##b_ = F.vcu + ((idx_) < npi ? (idx_) : (idx_) - npi) * F.G; const int b_ = pi_##b_ >> 8; const int t0_ = 8 * ((idx_) < npi ? 511 - (pi_##b_ & 255) : (pi_##b_ & 255))
    int prevn0 = 128, prevn1 = 128;
#define IDX_NT(t0_) (((t0_) + 8 <= 256) ? -1 : (((t0_) + 8 + 31) >> 5))
    { IDX_UNIT(0, b0, t00); if (wv < 4) idx_score(F, b0, t00, (LAS unsigned short*)F.lds, wv, prevn0); const int nt_ = IDX_NT(t00); if (nt_ >= 0) prevn0 = nt_; }
    __syncthreads();
#pragma unroll 1
    for (int u = 0; u < n; ++u) {
        if (u + 1 < n) { IDX_UNIT(u + 1, b1, t01); const int pv = ((u + 1) & 1) ? prevn1 : prevn0;
            if (wv < 4) idx_score(F, b1, t01, (LAS unsigned short*)(F.lds + ((u + 1) & 1) * 65536), wv, pv);
            const int nt_ = IDX_NT(t01); if (nt_ >= 0) { if ((u + 1) & 1) prevn1 = nt_; else prevn0 = nt_; } }
        if (wv >= 4) { IDX_UNIT(u, b2, t02); idx_select(F, b2, t02, (const LAS unsigned short*)(F.lds + (u & 1) * 65536), wv - 4); }
        __syncthreads();
    }
#undef IDX_NT
#undef IDX_UNIT
}

constexpr size_t WS_CVT = 236 * MiB;
__device__ __forceinline__ void mlstm2_mfma(Frame& F, int l) {
    const float* MISC = (const float*)WSP(WS_MISC); const float* STATE = (const float*)WSP(WS_STATE); const bf16_t* PROJ = (const bf16_t*)WSP(WS_BIG); const bf16_t* CVT = (const bf16_t*)WSP(WS_CVT);
    bf16_t* Y = (bf16_t*)WSP(WS_Y); const float* i_bias = INP(I_I_BIAS); const float* f_bias = INP(I_F_BIAS); const float* mnorm = INP(I_MNORM);
    const int lane = (F.tid & 63), r32 = lane & 31, hi = lane >> 5, grp = F.wave >> 2, w4 = F.wave & 3, lg = F.tid & 255;
    constexpr int KROWB = 144, VROWB = 272, GB = 49152;
    LAS unsigned char* gb = F.lds + grp * GB;
    LAS float* bc = (LAS float*)gb;
    LAS float* gs = bc + 128;
    LAS float* npv = gs + 128;
    LAS float* wsum = npv + 64;
    LAS unsigned char* ct = gb + 2048;
    LAS unsigned char* kt = ct + 9216;
    LAS unsigned char* vt = kt + 18432;
    for (int it0 = 2 * F.vcu; it0 < 512; it0 += 2 * F.G) {
        const int item = it0 + grp, bh = item >> 5, c = item & 31, b = bh >> 2, h = bh & 3, m0 = b * S + c * 128;
        if (lg < 128) { const float f = MISC[(size_t)(m0 + lg) * 16 + 12 + h] + f_bias[l * 4 + h]; bc[lg] = fminf(f, 0.f) - log1pf(__expf(-fabsf(f))); gs[lg] = MISC[(size_t)(m0 + lg) * 16 + 8 + h] + i_bias[l * 4 + h]; }
        if (lg >= 128 && lg < 160) { const int cc = lg - 128; wsum[cc] = (cc < c) ? STATE[(size_t)(bh * 32 + cc) * STATE_STRIDE + 4160] : 0.f; }
        __syncthreads();
        if (lg < 64) {
            float a0 = bc[2 * lane], a1 = bc[2 * lane + 1]; float s = a0 + a1;
#pragma unroll
            for (int o = 1; o < 64; o <<= 1) { const float t = __shfl_up(s, o); if (lane >= o) s += t; }
            const float ex = s - (a0 + a1); const float i0 = gs[2 * lane], i1 = gs[2 * lane + 1];
            bc[2 * lane] = ex + a0; bc[2 * lane + 1] = s; gs[2 * lane] = i0 - (ex + a0); gs[2 * lane + 1] = i1 - s;
            float w = (lane < 32) ? wsum[lane] : 0.f; float suf = w;
#pragma unroll
            for (int o = 1; o < 32; o <<= 1) { const float t = __shfl_down(suf, o); if (lane + o < 32) suf += t; }
            if (lane < 32) wsum[lane] = suf - w;
        }
        __syncthreads();
        { f32x4 a4[4]; float nv = 0.f;
#pragma unroll
          for (int k = 0; k < 4; ++k) a4[k] = (f32x4){0.f, 0.f, 0.f, 0.f};
          for (int cc = 0; cc < c; ++cc) { const float* st = STATE + (size_t)(bh * 32 + cc) * STATE_STRIDE; const float wgt = __expf(wsum[cc]);
#pragma unroll
              for (int k = 0; k < 4; ++k) { const f32x4 v = *(const f32x4*)(st + 4 * (lg + 256 * k)); a4[k] = a4[k] + v * wgt; }
              if (lg < 64) nv = fmaf(wgt, st[4096 + lg], nv); }
#pragma unroll
          for (int k = 0; k < 4; ++k) { const int idx = 4 * (lg + 256 * k), e = idx >> 6, d = idx & 63; u32x2 w; w.x = cvt_pk_bf16(a4[k][0], a4[k][1]); w.y = cvt_pk_bf16(a4[k][2], a4[k][3]); *(LAS u32x2*)(ct + e * KROWB + d * 2) = w; }
          if (lg < 64) npv[lg] = nv; }
#pragma unroll
        for (int k = 0; k < 4; ++k) { const int id = lg + 256 * k, row = id >> 3, ch = id & 7;
            *(LAS u32x4*)(kt + row * KROWB + ch * 16) = *(const u32x4*)(PROJ + (size_t)(m0 + row) * PW + P_CK + h * 64 + ch * 8);
            const int vrow = id >> 4, vch = id & 15;
            *(LAS u32x4*)(vt + vrow * VROWB + vch * 16) = *(const u32x4*)(CVT + (size_t)(b * 256 + h * 64 + vrow) * S + c * 128 + vch * 8); }
        __syncthreads();
        const int j = 32 * w4 + r32, qrow = m0 + j;
        bf16x8 qf[4];
#pragma unroll
        for (int s = 0; s < 4; ++s) qf[s] = *(const bf16x8*)(PROJ + (size_t)qrow * PW + P_CQ + h * 64 + 16 * s + 8 * hi);
        const float bj = bc[j], eb = __expf(bj);
        float qn = 0.f;
#pragma unroll
        for (int s = 0; s < 4; ++s) { const u32x4 w = __builtin_bit_cast(u32x4, qf[s]); const LAS float* np = npv + 16 * s + 8 * hi;
            qn += lo_bf(w.x) * np[0] + hi_bf(w.x) * np[1] + lo_bf(w.y) * np[2] + hi_bf(w.y) * np[3] + lo_bf(w.z) * np[4] + hi_bf(w.z) * np[5] + lo_bf(w.w) * np[6] + hi_bf(w.w) * np[7]; }
        qn += __shfl_xor(qn, 32); qn *= eb;
        f32x16 n0, n1;
#pragma unroll
        for (int r = 0; r < 16; ++r) { n0[r] = 0.f; n1[r] = 0.f; }
#pragma unroll
        for (int ks = 0; ks < 4; ++ks) { const bf16x8 c0 = *(const LAS bf16x8*)(ct + r32 * KROWB + 32 * ks + 16 * hi), c1 = *(const LAS bf16x8*)(ct + (32 + r32) * KROWB + 32 * ks + 16 * hi);
            n0 = __builtin_amdgcn_mfma_f32_32x32x16_bf16(c0, qf[ks], n0, 0, 0, 0); n1 = __builtin_amdgcn_mfma_f32_32x32x16_bf16(c1, qf[ks], n1, 0, 0, 0); }
#pragma unroll
        for (int r = 0; r < 16; ++r) { n0[r] *= eb; n1[r] *= eb; }
        float sa = 0.f;
#pragma unroll 1
        for (int st = 0; st <= w4; ++st) {
            f32x16 p;
#pragma unroll
            for (int r = 0; r < 16; ++r) p[r] = 0.f;
#pragma unroll
            for (int ks = 0; ks < 4; ++ks) { const bf16x8 kf = *(const LAS bf16x8*)(kt + (32 * st + r32) * KROWB + 32 * ks + 16 * hi); p = __builtin_amdgcn_mfma_f32_32x32x16_bf16(kf, qf[ks], p, 0, 0, 0); }
#pragma unroll
            for (int r = 0; r < 16; ++r) { const int s = 32 * st + (r & 3) + 8 * (r >> 2) + 4 * hi; const float a = (s <= j) ? __expf(bj + gs[s]) * p[r] : 0.f; p[r] = a; sa += a; }
#pragma unroll
            for (int k2 = 0; k2 < 2; ++k2) {
                u32x4 pw; pw.x = cvt_pk_bf16(p[8 * k2 + 0], p[8 * k2 + 1]); pw.y = cvt_pk_bf16(p[8 * k2 + 2], p[8 * k2 + 3]); pw.z = cvt_pk_bf16(p[8 * k2 + 4], p[8 * k2 + 5]); pw.w = cvt_pk_bf16(p[8 * k2 + 6], p[8 * k2 + 7]);
                const bf16x8 pf = __builtin_bit_cast(bf16x8, pw);
                const int vo = (32 * st + 16 * k2 + 4 * hi) * 2;
                const u32x2 a0 = *(const LAS u32x2*)(vt + r32 * VROWB + vo), a1 = *(const LAS u32x2*)(vt + r32 * VROWB + vo + 16);
                const u32x2 b0 = *(const LAS u32x2*)(vt + (32 + r32) * VROWB + vo), b1 = *(const LAS u32x2*)(vt + (32 + r32) * VROWB + vo + 16);
                const u32x4 va = {a0.x, a0.y, a1.x, a1.y}, vb4 = {b0.x, b0.y, b1.x, b1.y};
                n0 = __builtin_amdgcn_mfma_f32_32x32x16_bf16(__builtin_bit_cast(bf16x8, va), pf, n0, 0, 0, 0);
                n1 = __builtin_amdgcn_mfma_f32_32x32x16_bf16(__builtin_bit_cast(bf16x8, vb4), pf, n1, 0, 0, 0);
            }
        }
        sa += __shfl_xor(sa, 32);
        const float inv = 1.f / fmaxf(fabsf(qn + sa), 1.f);
        float ss = 0.f;
#pragma unroll
        for (int r = 0; r < 16; ++r) { n0[r] *= inv; n1[r] *= inv; ss += n0[r] * n0[r] + n1[r] * n1[r]; }
        ss += __shfl_xor(ss, 32); const float rr = rsqrtf(ss * (1.f / 64.f) + EPS);
        const float* gp = mnorm + l * 256 + h * 64 + 4 * hi; const bf16_t* op = PROJ + (size_t)qrow * PW + P_CO + h * 64 + 4 * hi; bf16_t* yp = Y + (size_t)qrow * D + 512 + h * 64 + 4 * hi;
#pragma unroll
        for (int g4 = 0; g4 < 4; ++g4) {
            const f32x4 ga = *(const f32x4*)(gp + 8 * g4), gb4 = *(const f32x4*)(gp + 32 + 8 * g4);
            const u32x2 oa = *(const u32x2*)(op + 8 * g4), ob = *(const u32x2*)(op + 32 + 8 * g4);
            u32x2 w0, w1;
            w0.x = cvt_pk_bf16(sigmoid_f(lo_bf(oa.x)) * n0[4 * g4] * rr * ga[0], sigmoid_f(hi_bf(oa.x)) * n0[4 * g4 + 1] * rr * ga[1]);
            w0.y = cvt_pk_bf16(sigmoid_f(lo_bf(oa.y)) * n0[4 * g4 + 2] * rr * ga[2], sigmoid_f(hi_bf(oa.y)) * n0[4 * g4 + 3] * rr * ga[3]);
            w1.x = cvt_pk_bf16(sigmoid_f(lo_bf(ob.x)) * n1[4 * g4] * rr * gb4[0], sigmoid_f(hi_bf(ob.x)) * n1[4 * g4 + 1] * rr * gb4[1]);
            w1.y = cvt_pk_bf16(sigmoid_f(lo_bf(ob.y)) * n1[4 * g4 + 2] * rr * gb4[2], sigmoid_f(hi_bf(ob.y)) * n1[4 * g4 + 3] * rr * gb4[3]);
            *(u32x2*)(yp + 8 * g4) = w0; *(u32x2*)(yp + 32 + 8 * g4) = w1;
        }
        __syncthreads();
    }
}

constexpr size_t WS_SSQV = 244 * MiB;
__device__ __forceinline__ void sgu_mfma(Frame& F, int l) {
    const bf16_t* PROJ = (const bf16_t*)WSP(WS_BIG); bf16_t* Y = (bf16_t*)WSP(WS_Y); const float* SSQV = (const float*)WSP(WS_SSQV);
    const float* gain = INP(I_SGU_NORM) + l * 256; const float* sw = INP(I_SGU_W) + (size_t)l * 4 * 128 * 128; const float* sb = INP(I_SGU_B) + l * 4 * 128;
    const int lane = (F.tid & 63), r32 = lane & 31, hi = lane >> 5, dt = F.wave & 1, tt = F.wave >> 1;
    constexpr int VROWB = 272;
    LAS float* r_s = (LAS float*)F.lds;
    LAS unsigned char* vt = F.lds + 512;
    for (int item = F.vcu; item < 512; item += F.G) {
        const int g = item & 3, m0 = (item >> 2) * 128;
        if (F.tid < 128) { const f32x4 q = *(const f32x4*)(SSQV + (size_t)(m0 + F.tid) * 4); r_s[F.tid] = rsqrtf(((q[0] + q[1]) + (q[2] + q[3])) * (1.f / 256.f) + EPS); }
        __syncthreads();
#pragma unroll
        for (int k = 0; k < 2; ++k) { const int id = F.tid + 512 * k, s = id >> 3, d0 = (id & 7) * 8; const float rs = r_s[s];
            const u32x4 w = *(const u32x4*)(PROJ + (size_t)(m0 + s) * PW + P_AV + g * 64 + d0);
            const float v[8] = {lo_bf(w.x), hi_bf(w.x), lo_bf(w.y), hi_bf(w.y), lo_bf(w.z), hi_bf(w.z), lo_bf(w.w), hi_bf(w.w)};
#pragma unroll
            for (int i = 0; i < 8; ++i) *(LAS bf16_t*)(vt + (d0 + i) * VROWB + s * 2) = (bf16_t)f2bf(v[i] * rs); }
        __syncthreads();
        f32x16 acc;
#pragma unroll
        for (int r = 0; r < 16; ++r) acc[r] = 0.f;
        const int t = 32 * tt + r32; const float* wrow = sw + ((size_t)g * 128 + t) * 128;
#pragma unroll 1
        for (int ks = 0; ks < 2 * (tt + 1); ++ks) {
            const bf16x8 af = *(const LAS bf16x8*)(vt + (32 * dt + r32) * VROWB + (16 * ks + 8 * hi) * 2);
            const int s0 = 16 * ks + 8 * hi; const f32x4 w0 = *(const f32x4*)(wrow + s0), w1 = *(const f32x4*)(wrow + s0 + 4);
            u32x4 bw; bw.x = cvt_pk_bf16(s0 + 0 <= t ? w0[0] : 0.f, s0 + 1 <= t ? w0[1] : 0.f); bw.y = cvt_pk_bf16(s0 + 2 <= t ? w0[2] : 0.f, s0 + 3 <= t ? w0[3] : 0.f);
            bw.z = cvt_pk_bf16(s0 + 4 <= t ? w1[0] : 0.f, s0 + 5 <= t ? w1[1] : 0.f); bw.w = cvt_pk_bf16(s0 + 6 <= t ? w1[2] : 0.f, s0 + 7 <= t ? w1[3] : 0.f);
            acc = __builtin_amdgcn_mfma_f32_32x32x16_bf16(af, __builtin_bit_cast(bf16x8, bw), acc, 0, 0, 0);
        }
        const float bias = sb[g * 128 + t]; const size_t row = (size_t)(m0 + t);
        const float* gp = gain + g * 64 + 32 * dt + 4 * hi; const bf16_t* up = PROJ + row * PW + P_AU + g * 64 + 32 * dt + 4 * hi; bf16_t* yp = Y + row * D + g * 64 + 32 * dt + 4 * hi;
#pragma unroll
        for (int g4 = 0; g4 < 4; ++g4) { const f32x4 gv = *(const f32x4*)(gp + 8 * g4); const u32x2 uw = *(const u32x2*)(up + 8 * g4); u32x2 ow;
            ow.x = cvt_pk_bf16(lo_bf(uw.x) * (gv[0] * acc[4 * g4] + bias), hi_bf(uw.x) * (gv[1] * acc[4 * g4 + 1] + bias));
            ow.y = cvt_pk_bf16(lo_bf(uw.y) * (gv[2] * acc[4 * g4 + 2] + bias), hi_bf(uw.y) * (gv[3] * acc[4 * g4 + 3] + bias));
            *(u32x2*)(yp + 8 * g4) = ow; }
        __syncthreads();
    }
}

__device__ __forceinline__ void mlstm1_mfma(Frame& F, int l) {
    const float* MISC = (const float*)WSP(WS_MISC); float* STATE = (float*)WSP(WS_STATE); const bf16_t* PROJ = (const bf16_t*)WSP(WS_BIG); const bf16_t* CVT = (const bf16_t*)WSP(WS_CVT);
    const float* i_bias = INP(I_I_BIAS); const float* f_bias = INP(I_F_BIAS);
    const int lane = (F.tid & 63), r32 = lane & 31, hi = lane >> 5, grp = F.wave >> 2, w4 = F.wave & 3, et = w4 & 1, dt = w4 >> 1, lg = F.tid & 255;
    constexpr int KROWB = 144, GB = 20480;
    LAS unsigned char* gb = F.lds + grp * GB;
    LAS float* bc = (LAS float*)gb; LAS float* wk = bc + 128; LAS unsigned char* kt = gb + 1024;
    for (int it0 = 2 * F.vcu; it0 < 512; it0 += 2 * F.G) {
        const int item = it0 + grp, bh = item >> 5, c = item & 31, b = bh >> 2, h = bh & 3, m0 = b * S + c * 128;
        if (lg < 128) { const float f = MISC[(size_t)(m0 + lg) * 16 + 12 + h] + f_bias[l * 4 + h]; bc[lg] = fminf(f, 0.f) - log1pf(__expf(-fabsf(f))); wk[lg] = MISC[(size_t)(m0 + lg) * 16 + 8 + h] + i_bias[l * 4 + h]; }
        __syncthreads();
        if (lg < 64) { const float a0 = bc[2 * lane], a1 = bc[2 * lane + 1]; float s = a0 + a1;
#pragma unroll
            for (int o = 1; o < 64; o <<= 1) { const float t = __shfl_up(s, o); if (lane >= o) s += t; }
            const float tot = __shfl(s, 63), ex = s - (a0 + a1);
            wk[2 * lane] = __expf(tot - (ex + a0) + wk[2 * lane]); wk[2 * lane + 1] = __expf(tot - s + wk[2 * lane + 1]);
            if (lane == 0) bc[0] = tot; }
        __syncthreads();
        const float Bc = bc[0];
#pragma unroll
        for (int k = 0; k < 4; ++k) { const int id = lg + 256 * k, s = id >> 3, ch = id & 7; const float ws_ = wk[s];
            const u32x4 w = *(const u32x4*)(PROJ + (size_t)(m0 + s) * PW + P_CK + h * 64 + ch * 8); u32x4 o;
            o.x = cvt_pk_bf16(lo_bf(w.x) * ws_, hi_bf(w.x) * ws_); o.y = cvt_pk_bf16(lo_bf(w.y) * ws_, hi_bf(w.y) * ws_); o.z = cvt_pk_bf16(lo_bf(w.z) * ws_, hi_bf(w.z) * ws_); o.w = cvt_pk_bf16(lo_bf(w.w) * ws_, hi_bf(w.w) * ws_);
            *(LAS u32x4*)(kt + s * KROWB + ch * 16) = o; }
        __syncthreads();
        f32x16 acc;
#pragma unroll
        for (int r = 0; r < 16; ++r) acc[r] = 0.f;
        float nsum = 0.f;
        const bf16_t* vp = CVT + (size_t)(b * 256 + h * 64 + 32 * et + r32) * S + c * 128 + 8 * hi;
        bf16x8 af[8];
#pragma unroll
        for (int ks = 0; ks < 8; ++ks) af[ks] = *(const bf16x8*)(vp + 16 * ks);
#pragma unroll
        for (int ks = 0; ks < 8; ++ks) {
            const LAS unsigned char* kp = kt + (16 * ks + 8 * hi) * KROWB + (32 * dt + r32) * 2; unsigned e8[8];
#pragma unroll
            for (int jj = 0; jj < 8; ++jj) e8[jj] = *(const LAS bf16_t*)(kp + jj * KROWB);
            u32x4 bw; bw.x = e8[0] | (e8[1] << 16); bw.y = e8[2] | (e8[3] << 16); bw.z = e8[4] | (e8[5] << 16); bw.w = e8[6] | (e8[7] << 16);
#pragma unroll
            for (int jj = 0; jj < 8; ++jj) nsum += __uint_as_float(e8[jj] << 16);
            acc = __builtin_amdgcn_mfma_f32_32x32x16_bf16(af[ks], __builtin_bit_cast(bf16x8, bw), acc, 0, 0, 0);
        }
        float* st = STATE + (size_t)item * STATE_STRIDE;
#pragma unroll
        for (int r = 0; r < 16; ++r) st[(32 * et + (r & 3) + 8 * (r >> 2) + 4 * hi) * 64 + 32 * dt + r32] = acc[r];
        nsum += __shfl_xor(nsum, 32);
        if (et == 0 && hi == 0) st[4096 + 32 * dt + r32] = nsum;
        if (lg == 0) st[4160] = Bc;
        __syncthreads();
    }
}
#ifndef MK_MULTI
#define MK_MULTI 0
#endif
constexpr int N_PHASES = 1 + 10 * DEPTH;

__global__ void __launch_bounds__(NT, 2) mk_fwd(Args args) {
    extern __shared__ __attribute__((aligned(16))) unsigned char lds_raw[];
    Frame F;
    F.lds = (LAS unsigned char*)lds_raw; F.tid = threadIdx.x; F.wave = __builtin_amdgcn_readfirstlane(F.tid >> 6);
    F.G = gridDim.x; { const int bx_ = blockIdx.x; F.vcu = (F.G % 8 == 0) ? (bx_ % 8) * (F.G / 8) + bx_ / 8 : bx_; }
    if (F.tid < 20) { const unsigned long long pv = F.tid < 18 ? (unsigned long long)args.in[F.tid < 18 ? F.tid : 0] : (F.tid == 18 ? (unsigned long long)args.out : (unsigned long long)args.ws);
        *(LAS unsigned long long*)(F.lds + PTR_OFF + 8 * F.tid) = pv; }
    if (F.tid < 2) *(LAS unsigned*)(F.lds + PTR_OFF + 256 + 4 * F.tid) = 0u;
    __syncthreads();
#if MK_MULTI
    int bx = (int)blockIdx.x;
    const int lo = args.ph_lo, hi = args.ph_hi; const bool coop = args.coop != 0;
#else
    int bx = (int)blockIdx.x;
    constexpr int lo = 0, hi = N_PHASES - 1; constexpr bool coop = true;
    if (F.tid == 0) (void)xb_add(&((unsigned*)(args.ws + WS_BAR))[XB_XCNT(xb_xcc_id())], 1u);
#endif
#define XBAR_NOW() XcdBarrier{(unsigned*)WSP(WS_BAR), xb_xcc_id(), (volatile LAS unsigned*)(F.lds + PTR_OFF + 256)}
#define RUN(k) (lo <= (k) && (k) < hi)
#define LAUNDER() asm volatile("" : "+v"(F.tid), "+s"(F.G), "+s"(F.vcu), "+s"(F.wave), "+s"(bx), "+s"(F.lds))
#ifndef MK_SKEW_SLEEP
#define MK_SKEW_SLEEP 0
#endif
#define SKEW() do { if (coop) { for (unsigned s_ = ((unsigned)blockIdx.x >> 3) & 3u; s_ > 0; --s_) __builtin_amdgcn_s_sleep(MK_SKEW_SLEEP); } } while (0)
#ifdef MK_PROBE_BAR2
#define SEAM(k) do { if (coop && RUN(k) && RUN((k) + 1)) { { const XcdBarrier xb_ = XBAR_NOW(); xcd_barrier(xb_); } { const XcdBarrier xb_ = XBAR_NOW(); xcd_barrier(xb_); } } } while (0)
#else
#define SEAM(k) do { if (coop && RUN(k) && RUN((k) + 1)) { const XcdBarrier xb_ = XBAR_NOW(); xcd_barrier(xb_); } } while (0)
#endif

    if (args.pad == 0x5a5a5a5a) cg::this_grid().sync();
    if (RUN(0)) { LAUNDER(); convert_mix_weights(F, 0); prologue_rows(F);
        if (blockIdx.x == 0 && F.tid < DEPTH * 192) { const int l_ = F.tid / 192, r_ = F.tid % 192, w_ = r_ / 64, i_ = r_ % 64; ((float*)WSP(WS_GT))[F.tid] = INP(I_Q_NORM + w_)[l_ * 64 + i_]; } }
    SEAM(0);
#pragma unroll 1
    for (int l = 0; l < DEPTH; ++l) {
        const int pb = 1 + 10 * l;
        if (RUN(pb + 0)) { LAUNDER(); SKEW();
            pg8::Gemm<D, D, D, 256u * D * 2, 0, 256u * D * 2, 0> g{(const bf16_t*)WSP(WS_XG), (const bf16_t*)WSP(WS_WIN)};
            pg8::StaticOrder So; So.init(M, PW, F.G, bx);
            epi::EpiProj E{(bf16_t*)WSP(WS_BIG), (float*)WSP(WS_MISC), (const float*)WSP(WS_RSA), (const float*)WSP(WS_COS), (const float*)WSP(WS_SIN), (const float*)WSP(WS_GT) + l * 192, (bf16_t*)WSP(WS_VT), (bf16_t*)WSP(WS_KI), (bf16_t*)WSP(WS_CVT), (float*)WSP(WS_SSQV)};
            pg8::gemm_phase<epi::EpiProj, pg8::StaticOrder, true>(F.lds, g, So, E, F.tid);
        }
        SEAM(pb + 0);
        if (RUN(pb + 1)) { LAUNDER(); sgu_mfma(F, l); conv_simple(F, l); indexer_mfma(F); mlstm1_mfma(F, l); }
        SEAM(pb + 1);
        if (RUN(pb + 2)) { LAUNDER(); attn_mfma(F, l); mlstm2_mfma(F, l); }
        SEAM(pb + 2);
        if (RUN(pb + 3)) { LAUNDER(); SKEW();
            pg8::Gemm<256, D, 256, 256u * D * 2, 256u * 2, 256u * 256 * 2, 1024u * 256 * 2> g{(const bf16_t*)WSP(WS_Y), (const bf16_t*)WSP(WS_WBR)};
            pg8::SuperOrder<0> So; So.init(F.G, bx);
            epi::EpiPlain E{(bf16_t*)WSP(WS_BIG), 4096, 1024};
            pg8::gemm_phase<epi::EpiPlain, pg8::SuperOrder<0>, true>(F.lds, g, So, E, F.tid);
        }
        if (coop && RUN(pb + 3) && RUN(pb + 4)) { asm volatile("s_waitcnt vmcnt(0)" ::: "memory"); __syncthreads(); __builtin_amdgcn_fence(__ATOMIC_ACQUIRE, "agent"); asm volatile("s_waitcnt vmcnt(0)" ::: "memory"); __syncthreads(); }
        if (RUN(pb + 4)) { LAUNDER();
            pg8::Gemm<D, D, D, 256u * D, 0, 256u * D, 0, 1> g{ptr_at(F, I_OUT) + OUT_X8, ptr_at(F, I_OUT) + OUT_WG8 + (size_t)l * 4 * MiB};
            pg8::SuperOrder<1> So; So.init(F.G, bx);
            epi::EpiGate E{(bf16_t*)WSP(WS_MG), (const bf16_t*)WSP(WS_BIG), (const float*)WSP(WS_RSA)};
            pg8::gemm_phase<epi::EpiGate, pg8::SuperOrder<1>, true>(F.lds, g, So, E, F.tid);
        }
        SEAM(pb + 4);
        if (RUN(pb + 5)) { LAUNDER();
            pg8::Gemm<D, D, D, 256u * D * 2, 0, 256u * D * 2, 0> g{(const bf16_t*)WSP(WS_MG), (const bf16_t*)WSP(WS_WOUT)};
            pg8::StaticOrder So; So.init(M, D, F.G, bx);
            epi::EpiResid E{l == 0 ? INP(I_X) : nullptr, (bf16_t*)WSP(WS_XG), nullptr, (float*)WSP(WS_SSQB), nullptr};
            pg8::gemm_phase<epi::EpiResid, pg8::StaticOrder, true>(F.lds, g, So, E, F.tid);
            __syncthreads();
            convert_mlp_weights(F, l);
        }
        SEAM(pb + 5);
        if (RUN(pb + 6)) { LAUNDER(); finalize_rs(F, WS_SSQB, WS_RSB); }
        SEAM(pb + 6);
        if (RUN(pb + 7)) { LAUNDER(); SKEW();
            pg8::Gemm<D, D, D, 256u * D * 2, 0, 256u * D * 2, 0> g{(const bf16_t*)WSP(WS_XG), (const bf16_t*)WSP(WS_WUP)};
            pg8::StaticOrder So; So.init(M, FF, F.G, bx);
            epi::EpiUp E{(bf16_t*)WSP(WS_BIG), (const float*)WSP(WS_RSB)};
            pg8::gemm_phase<epi::EpiUp, pg8::StaticOrder, true>(F.lds, g, So, E, F.tid);
            if (l + 1 < DEPTH) { __syncthreads(); convert_mix_weights(F, l + 1); }
        }
        SEAM(pb + 7);
        if (RUN(pb + 8)) { LAUNDER();
            pg8::Gemm<FF, FF, FF, 256u * FF * 2, 0, 256u * FF * 2, 0> g{(const bf16_t*)WSP(WS_BIG), (const bf16_t*)WSP(WS_WDN)};
            pg8::StaticOrder So; So.init(M, D, F.G, bx);
            epi::EpiResid E{nullptr, (bf16_t*)WSP(WS_XG), (l + 1 < DEPTH) ? nullptr : (float*)ptr_at(F, I_OUT), (float*)WSP(WS_SSQA), (l + 1 < DEPTH) ? ptr_at(F, I_OUT) + OUT_X8 : nullptr};
            pg8::gemm_phase<epi::EpiResid, pg8::StaticOrder, true>(F.lds, g, So, E, F.tid);
        }
        SEAM(pb + 8);
        if (RUN(pb + 9)) { LAUNDER(); if (l + 1 < DEPTH) finalize_rs(F, WS_SSQA, WS_RSA); }
        SEAM(pb + 9);
    }
#undef RUN
#undef SEAM
}

extern "C" void kernel_launch(void* const* d_in, const int* in_sizes, int n_in, void* d_out, int out_size, void* d_ws, size_t ws_size, hipStream_t stream) {
    static int grid = 0;
    if (grid == 0) {
        if (n_in != 18 || in_sizes[0] != M * D || out_size != M * D || ws_size < WS_END) { fprintf(stderr, "kernel_launch: unexpected shapes (n_in %d, in0 %d, out %d, ws %zu)\n", n_in, n_in > 0 ? in_sizes[0] : -1, out_size, ws_size); grid = -1; return; }
        int dev = 0, cus = 0, per_cu = 0;
        if (hipGetDevice(&dev) != hipSuccess || hipDeviceGetAttribute(&cus, hipDeviceAttributeMultiprocessorCount, dev) != hipSuccess) { grid = -1; return; }
        if (hipFuncSetAttribute((const void*)mk_fwd, hipFuncAttributeMaxDynamicSharedMemorySize, LDS_BYTES) != hipSuccess) { fprintf(stderr, "kernel_launch: hipFuncSetAttribute failed\n"); grid = -1; return; }
        if (hipOccupancyMaxActiveBlocksPerMultiprocessor(&per_cu, (const void*)mk_fwd, NT, LDS_BYTES) != hipSuccess || per_cu < 1) { fprintf(stderr, "kernel_launch: occupancy query says %d\n", per_cu); (void)hipGetLastError(); per_cu = 1; }
        grid = cus;
    }
    if (grid < 0) return;
    if (hipMemsetAsync((char*)d_ws + WS_CTL, 0, CTL_ZERO_BYTES, stream) != hipSuccess) { fprintf(stderr, "kernel_launch: memset failed\n"); return; }
    Args a{};
    for (int i = 0; i < 18; ++i) a.in[i] = (const float*)d_in[i];
    a.out = (float*)d_out; a.ws = (unsigned char*)d_ws;
#if MK_MULTI
    for (int p = 0; p < N_PHASES; ++p) { a.ph_lo = p; a.ph_hi = p + 1; a.coop = 0; hipLaunchKernelGGL(mk_fwd, dim3(grid), dim3(NT), LDS_BYTES, stream, a); }
#else
    a.ph_lo = 0; a.ph_hi = N_PHASES - 1; a.coop = 1;
    void* kargs[] = {&a};
    hipError_t e = hipLaunchCooperativeKernel((const void*)mk_fwd, dim3(grid), dim3(NT), kargs, LDS_BYTES, stream);
    if (e != hipSuccess) fprintf(stderr, "kernel_launch: cooperative launch failed: %s (grid %d)\n", hipGetErrorString(e), grid);
#endif
}
```

```cpp
#include <hip/hip_runtime.h>
#define MK_MULTI 0
#include <hip/hip_cooperative_groups.h>
#include <cstdio>
#include <cstdint>
namespace cg = cooperative_groups;

#define LAS __attribute__((address_space(3)))
typedef unsigned short bf16_t;
typedef short bf16x8 __attribute__((ext_vector_type(8)));
typedef float f32x4 __attribute__((ext_vector_type(4)));
typedef float f32x2 __attribute__((ext_vector_type(2)));
typedef unsigned u32x4 __attribute__((ext_vector_type(4)));
typedef unsigned u32x2 __attribute__((ext_vector_type(2)));
typedef int i32x4 __attribute__((ext_vector_type(4)));
typedef int i32x8 __attribute__((ext_vector_type(8)));

constexpr int D = 1024, NB = 4, S = 4096, M = NB * S, DEPTH = 2, FF = 4096, INW = 7760;
constexpr int O_AU = 0, O_AV = 256, O_BQ = 512, O_BK = 768, O_BV = 1024, O_QI = 1280, O_KI = 1792, O_WI = 1856,
              O_CQ = 1864, O_CK = 2120, O_CV = 2376, O_CO = 2632, O_CI = 2888, O_CF = 2892, O_DB = 2896, O_DC = 3152, O_DX = 3408, O_G = 3664;
constexpr int PW = 3840;
constexpr int P_AU = 0, P_AV = 256, P_Q = 512, P_K = 768, P_V = 1024, P_QI = 1280, P_CQ = 1792, P_CK = 2048, P_CV = 2304, P_CO = 2560,
              P_DB = 2816, P_DC = 3072, P_DX = 3328, P_KI = 3584;
constexpr float EPS = 1e-6f;
constexpr int NWAVES = 8, NT = 512;

constexpr size_t MiB = 1u << 20;
constexpr size_t WS_CTL = 0;
constexpr size_t WS_COS = 1 * MiB, WS_SIN = 1 * MiB + 512 * 1024;
constexpr size_t WS_MISC = 2 * MiB;
constexpr size_t WS_SSQA = 3 * MiB, WS_SSQB = 4 * MiB;
constexpr size_t WS_WIN = 5 * MiB;
constexpr size_t WS_WG = WS_WIN + (size_t)PW * D * 2;
constexpr size_t WS_WBR = WS_WG + (size_t)4096 * D * 2;
constexpr size_t WS_WOUT = WS_WBR + (size_t)4 * 1024 * 256 * 2;
constexpr size_t WS_XG = 25 * MiB;
constexpr size_t WS_BIG = 57 * MiB;
constexpr size_t WS_Y = 185 * MiB;
constexpr size_t WS_WUP = WS_Y, WS_WDN = WS_Y + 8 * MiB;
constexpr size_t WS_MG = 217 * MiB;
constexpr size_t WS_MASK = WS_MG, WS_STATE = WS_MG + 8 * MiB;
constexpr size_t WS_END = 249 * MiB;
constexpr int STATE_STRIDE = 4224;
static_assert(WS_WOUT + (size_t)D * D * 2 <= WS_XG && WS_STATE + (size_t)512 * STATE_STRIDE * 4 <= WS_END && WS_END <= 256 * MiB, "d_ws map");

constexpr size_t OUT_X8 = 0;
constexpr size_t OUT_WG8 = 16 * MiB;
constexpr float WG8_SCALE = 64.f;
constexpr int LDS_BYTES = 155648;

__device__ __forceinline__ float bf2f(bf16_t v) { return __uint_as_float((unsigned)v << 16); }
__device__ __forceinline__ unsigned f2bf(float f) { unsigned u = __float_as_uint(f); return (u + 0x7fffu + ((u >> 16) & 1u)) >> 16; }
__device__ __forceinline__ unsigned pk2(float lo, float hi) { return f2bf(lo) | (f2bf(hi) << 16); }
typedef __bf16 bf16x2_t __attribute__((ext_vector_type(2)));
__device__ __forceinline__ unsigned cvt_pk_bf16(float lo, float hi) { const f32x2 v = {lo, hi}; return __builtin_bit_cast(unsigned, __builtin_convertvector(v, bf16x2_t)); }
__device__ __forceinline__ unsigned pk4_fp8(float a, float b, float c, float d) { int w = __builtin_amdgcn_cvt_pk_fp8_f32(a, b, 0, false); w = __builtin_amdgcn_cvt_pk_fp8_f32(c, d, w, true); return (unsigned)w; }
__device__ __forceinline__ float lo_bf(unsigned w) { return __uint_as_float(w << 16); }
__device__ __forceinline__ float hi_bf(unsigned w) { return __uint_as_float(w & 0xffff0000u); }
__device__ __forceinline__ float wave_sum(float v) {
#pragma unroll
    for (int o = 1; o < 64; o <<= 1) v += __shfl_xor(v, o);
    return v;
}
__device__ __forceinline__ float wave_max(float v) {
#pragma unroll
    for (int o = 1; o < 64; o <<= 1) v = fmaxf(v, __shfl_xor(v, o));
    return v;
}
__device__ __forceinline__ int wave_sum_i(int v) {
#pragma unroll
    for (int o = 1; o < 64; o <<= 1) v += __shfl_xor(v, o);
    return v;
}
__device__ __forceinline__ float sigmoid_f(float x) { return __builtin_amdgcn_rcpf(1.f + __builtin_amdgcn_exp2f(-1.4426950408889634f * x)); }
__device__ __forceinline__ float gelu_tanh_f(float x) { const float u = 0.7978845608028654f * (x + 0.044715f * x * x * x); return x * __builtin_amdgcn_rcpf(1.f + __builtin_amdgcn_exp2f(-2.8853900817779268f * u)); }
__device__ __forceinline__ float relu_f(float x) { const int b = __builtin_bit_cast(int, x); return __builtin_bit_cast(float, b > 0 ? b : 0); }
__device__ __forceinline__ unsigned fkey(float s) { const unsigned u = __float_as_uint(s); return (u & 0x80000000u) ? ~u : (u | 0x80000000u); }

__device__ __forceinline__ void st16(void* p, const u32x4 v, const bool wt) { if (wt) asm volatile("global_store_dwordx4 %0, %1, off sc1\n\ts_nop 1" :: "v"(p), "v"(v) : "memory"); else *(u32x4*)p = v; }

namespace pg8 {
constexpr int BM = 256, BK = 64, HALF = 128, HTB = HALF * BK * 2, STAGE_BYTES = 8 * HTB, NXCD = 8, WGM = 8, RS_OFF = STAGE_BYTES;
__host__ __device__ __forceinline__ int lds_byte(int r, int c) { const int st = (r >> 4) * 2 + (c >> 5), rr = r & 15, cc = c & 31, ob = rr * 64 + cc * 2; return st * 1024 + (ob ^ (((ob >> 9) & 1) << 5)); }
__host__ __device__ __forceinline__ void stage_rc(int b, int& R, int& C) { const int st = b / 1024, sb = b % 1024, swz = sb ^ (((sb >> 9) & 1) << 5); R = (st >> 1) * 16 + swz / 64; C = (st & 1) * 32 + (swz % 64) / 2; }
__host__ __device__ __forceinline__ int perm32(int rho) { const int n = rho >> 4, i = rho & 15; return 8 * (i >> 2) + 4 * n + (i & 3); }

struct Unit { int pm, pn, z; };
template <int K_, int LDA_, int LDB_, unsigned APM_, unsigned AZ_, unsigned BPN_, unsigned BZ_, int ESZ_ = 2> struct Gemm {
    const void* A; const void* Bt;
    static constexpr int K = K_, lda = LDA_, ldb = LDB_, esz = ESZ_; static constexpr unsigned aPm = APM_, aZ = AZ_, bPn = BPN_, bZ = BZ_;
};
template <class G> __device__ __forceinline__ const char* pa(const G& g, const Unit& u) { return (const char*)g.A + (size_t)((unsigned)u.pm * G::aPm + (unsigned)u.z * G::aZ); }
template <class G> __device__ __forceinline__ const char* pb(const G& g, const Unit& u) { return (const char*)g.Bt + (size_t)((unsigned)u.pn * G::bPn + (unsigned)u.z * G::bZ); }

struct StaticOrder {
    int nM, nN, nwg, G, c;
    __host__ __device__ void init(int M_, int N_, int G_, int c_) { nM = M_ / BM; nN = N_ / BM; nwg = nM * nN; G = G_; c = c_; }
    __host__ __device__ bool next(int i, Unit& u) const {
        const long L = (long)i * G + c; if (L >= nwg) return false;
        int wgid = (int)L; { const int q = nwg / NXCD, r = nwg % NXCD, xcd = wgid % NXCD, off = wgid / NXCD; wgid = (xcd < r ? xcd * (q + 1) : r * (q + 1) + (xcd - r) * q) + off; }
        const int nig = WGM * nN, gid = wgid / nig, fm = gid * WGM, gsz = (nM - fm) < WGM ? (nM - fm) : WGM;
        u.pm = fm + ((wgid % nig) % gsz); u.pn = (wgid % nig) / gsz; u.z = 0; return true;
    }
};
template <int MODE> struct SuperOrder {
    StaticOrder so;
    __host__ __device__ void init(int G_, int c_) { so.init(M, 1024, G_, c_); }
    __host__ __device__ bool next(int i, Unit& u) const {
        Unit b; if (!so.next(i >> 2, b)) return false;
        const int sub = i & 3; u.pm = b.pm; if (MODE == 0) { u.pn = b.pn; u.z = sub; } else { u.pn = 4 * b.pn + sub; u.z = 0; } return true;
    }
};

template <class Epi, class Sched, bool ALIGN_EPI, class GemmT>
__device__ __forceinline__ void gemm_phase(LAS unsigned char* lds, const GemmT g, const Sched& S, const Epi& E, const int tid) {
    const int wid = __builtin_amdgcn_readfirstlane(tid >> 6), lane = tid & 63, wr = wid >> 2, wc = wid & 3, fr = lane & 15, fq = lane >> 4;
    constexpr int K = GemmT::K, ESZ = GemmT::esz, nt = K * ESZ / (BK * 2);
    unsigned voffA[2], voffB[2];
#pragma unroll
    for (int i = 0; i < 2; ++i) { int R, C; stage_rc(tid * 16 + i * 8192, R, C); const int Rb = Epi::PERM ? ((R & ~31) + perm32(R & 31)) : R;
        voffA[i] = (unsigned)(R * GemmT::lda * ESZ + C * 2); voffB[i] = (unsigned)(Rb * GemmT::ldb * ESZ + C * 2); }
    const size_t kstep = (size_t)(BK * 2);
    constexpr size_t hA = (size_t)HALF * GemmT::lda * ESZ, hB = (size_t)HALF * GemmT::ldb * ESZ;
    const unsigned ldsw = (unsigned)wid * 1024u;
    constexpr int FCOL = (ESZ == 2) ? 8 : 16, KOFF = (ESZ == 2) ? 1024 : 16;
    const int aoff = lds_byte(wr * 64 + fr, fq * FCOL), boff = lds_byte(wc * 32 + fr, fq * FCOL);
    int one_scale = 0x7f7f7f7f; asm volatile("" : "+v"(one_scale));
#define PG8_SA(b, h) (((b) * 2 + (h)) * HTB)
#define PG8_SB(b, h) ((4 + (b) * 2 + (h)) * HTB)
#define PG8_STAGE(bufoff, gbase, voff) do { _Pragma("unroll") for (int _i = 0; _i < 2; ++_i) \
        __builtin_amdgcn_global_load_lds((const unsigned*)((const char*)(gbase) + (voff)[_i]), (LAS unsigned*)(lds + (bufoff) + ldsw + _i * 8192), 16, 0, 0); } while (0)
#define PG8_LDA(dst, b, h) do { _Pragma("unroll") for (int m = 0; m < 4; ++m) _Pragma("unroll") for (int k = 0; k < 2; ++k) dst[m][k] = *(const LAS bf16x8*)(lds + PG8_SA(b, h) + aoff + m * 2048 + k * KOFF); } while (0)
#define PG8_LDB(dst, b, h) do { _Pragma("unroll") for (int n = 0; n < 2; ++n) _Pragma("unroll") for (int k = 0; k < 2; ++k) dst[n][k] = *(const LAS bf16x8*)(lds + PG8_SB(b, h) + boff + n * 2048 + k * KOFF); } while (0)
#define PG8_MMA(ai, bj, At, Bt) do { __builtin_amdgcn_s_setprio(1); _Pragma("unroll") for (int m = 0; m < 4; ++m) _Pragma("unroll") for (int n = 0; n < 2; ++n) { \
        if constexpr (ESZ == 2) { _Pragma("unroll") for (int k = 0; k < 2; ++k) acc[ai][bj][m][n] = __builtin_amdgcn_mfma_f32_16x16x32_bf16(Bt[n][k], At[m][k], acc[ai][bj][m][n], 0, 0, 0); } \
        else { const i32x8 a8_ = __builtin_shufflevector(__builtin_bit_cast(i32x4, At[m][0]), __builtin_bit_cast(i32x4, At[m][1]), 0, 1, 2, 3, 4, 5, 6, 7), b8_ = __builtin_shufflevector(__builtin_bit_cast(i32x4, Bt[n][0]), __builtin_bit_cast(i32x4, Bt[n][1]), 0, 1, 2, 3, 4, 5, 6, 7); \
              \
            asm volatile("v_mfma_scale_f32_16x16x128_f8f6f4 %0, %1, %2, %0, %3, %3 op_sel_hi:[0,0,0]" : "+v"(acc[ai][bj][m][n]) : "v"(b8_), "v"(a8_), "v"(one_scale)); } } \
        __builtin_amdgcn_s_setprio(0); } while (0)
#define PG8_WAIT_V(n) asm volatile("s_waitcnt vmcnt(" #n ")" ::: "memory")
#define PG8_WAIT_L(n) asm volatile("s_waitcnt lgkmcnt(" #n ")" ::: "memory")
#define PG8_BAR __builtin_amdgcn_s_barrier()
#define PG8_SCHED __builtin_amdgcn_sched_barrier(0)
#define PG8_WAIT_VN(n) asm volatile("s_waitcnt vmcnt(%0)" :: "n"(n) : "memory")
    constexpr int RSN = Epi::RS ? 1 : 0, WN1 = 8 + RSN, WN2 = 8 + RSN + Epi::VM_MIN;
#define PG8_WAIT_SEL do { if (wsel == 0) PG8_WAIT_V(8); else if (wsel == 1) PG8_WAIT_VN(WN1); else PG8_WAIT_VN(WN2); } while (0)
#define PG8_RS(slot, pm_) do { if constexpr (Epi::RS) { int l2_ = lane; asm volatile("" : "+v"(l2_));     \
        __builtin_amdgcn_global_load_lds((const unsigned*)(E.ssq + (pm_) * 256 + (wid & 3) * 64 + l2_), (LAS unsigned*)(lds + RS_OFF + (slot) * 1024 + (wid & 3) * 256), 4, 0, 0); } } while (0)
    Unit cur, nxt; int ui = 0;
    if (!S.next(0, cur)) return;
    f32x4 acc[2][2][4][2];
#pragma unroll
    for (int a = 0; a < 2; ++a)
#pragma unroll
        for (int b = 0; b < 2; ++b)
#pragma unroll
            for (int m = 0; m < 4; ++m)
#pragma unroll
                for (int n = 0; n < 2; ++n) acc[a][b][m][n] = (f32x4){0.f, 0.f, 0.f, 0.f};
    bf16x8 At[4][2], B0[2][2], B1[2][2];
    const char* cA = pa(g, cur); const char* cB = pb(g, cur);
    PG8_RS(0, cur.pm);
    PG8_STAGE(PG8_SB(0, 0), cB, voffB); PG8_STAGE(PG8_SB(0, 1), cB + hB, voffB); PG8_STAGE(PG8_SA(0, 0), cA, voffA); PG8_STAGE(PG8_SA(0, 1), cA + hA, voffA);
    if (wr == 1) PG8_BAR;
    PG8_WAIT_V(2); PG8_BAR;
    PG8_STAGE(PG8_SB(1, 0), cB + kstep, voffB); PG8_STAGE(PG8_SA(1, 0), cA + kstep, voffA); PG8_STAGE(PG8_SB(1, 1), cB + hB + kstep, voffB);
    PG8_WAIT_V(6); PG8_BAR;
    int wsel = 0;
    for (;;) {
        const bool has_next = S.next(ui + 1, nxt);
        const char* nA = has_next ? pa(g, nxt) : cA; const char* nB = has_next ? pb(g, nxt) : cB;
        asm volatile(".p2align 8");
#pragma unroll 1
        for (int t = 0; t < nt; t += 2) {
            const bool last = (t == nt - 2);
            const char* a1 = cA + (size_t)(t + 1) * kstep;
            const char* a2 = last ? nA : cA + (size_t)(t + 2) * kstep; const char* b2 = last ? nB : cB + (size_t)(t + 2) * kstep;
            const char* a3 = a2 + kstep; const char* b3 = b2 + kstep;
            PG8_LDB(B0, 0, 0); PG8_LDB(B1, 0, 1); PG8_SCHED; PG8_LDA(At, 0, 0); if (wsel == 0) PG8_STAGE(PG8_SA(1, 1), a1 + hA, voffA);
            PG8_WAIT_SEL; PG8_WAIT_L(0); PG8_BAR; PG8_MMA(0, 0, At, B0); PG8_MMA(0, 1, At, B1); PG8_BAR; PG8_SCHED;
            PG8_LDA(At, 0, 1); PG8_STAGE(PG8_SB(0, 0), b2, voffB); PG8_STAGE(PG8_SB(0, 1), b2 + hB, voffB); PG8_STAGE(PG8_SA(0, 0), a2, voffA);
            PG8_WAIT_SEL; PG8_WAIT_L(0); PG8_BAR; PG8_MMA(1, 0, At, B0); PG8_MMA(1, 1, At, B1); PG8_BAR; PG8_SCHED;
            PG8_LDB(B0, 1, 0); PG8_LDB(B1, 1, 1); PG8_SCHED; PG8_LDA(At, 1, 0); PG8_STAGE(PG8_SA(0, 1), a2 + hA, voffA);
            PG8_WAIT_SEL; PG8_WAIT_L(0); PG8_BAR; PG8_MMA(0, 0, At, B0); PG8_MMA(0, 1, At, B1); PG8_BAR; PG8_SCHED;
            PG8_LDA(At, 1, 1); PG8_STAGE(PG8_SB(1, 0), b3, voffB); PG8_STAGE(PG8_SB(1, 1), b3 + hB, voffB); PG8_STAGE(PG8_SA(1, 0), a3, voffA);
            PG8_WAIT_V(8); PG8_WAIT_L(0); PG8_BAR; PG8_MMA(1, 0, At, B0); PG8_MMA(1, 1, At, B1); PG8_BAR; PG8_SCHED;
            wsel = 0;
        }
        if (has_next) { PG8_STAGE(PG8_SA(1, 1), nA + kstep + hA, voffA); PG8_RS((ui + 1) & 1, nxt.pm); }
        asm volatile("" ::: "memory"); PG8_SCHED;
        if constexpr (ALIGN_EPI) { if (wr == 0) PG8_BAR; }
        int eops;
        { int fr2 = fr, fq2 = fq; asm volatile("" : "+v"(fr2), "+v"(fq2)); eops = E(acc, cur, wr, wc, fr2, fq2, (const LAS float*)(lds + RS_OFF + (ui & 1) * 1024), !has_next); }
        if (!has_next) break;
        wsel = (eops >= Epi::VM_MIN) ? 2 : 1;
#pragma unroll
        for (int a = 0; a < 2; ++a)
#pragma unroll
            for (int b = 0; b < 2; ++b)
#pragma unroll
                for (int m = 0; m < 4; ++m)
#pragma unroll
                    for (int n = 0; n < 2; ++n) acc[a][b][m][n] = (f32x4){0.f, 0.f, 0.f, 0.f};
        cur = nxt; cA = nA; cB = nB; ++ui;
        if constexpr (ALIGN_EPI) { if (wr == 1) PG8_BAR; }
    }
    PG8_WAIT_V(0);
    if constexpr (!ALIGN_EPI) { if (wr == 0) PG8_BAR; }
    PG8_BAR;
#undef PG8_SA
#undef PG8_SB
#undef PG8_STAGE
#undef PG8_LDA
#undef PG8_LDB
#undef PG8_MMA
#undef PG8_WAIT_V
#undef PG8_WAIT_VN
#undef PG8_WAIT_SEL
#undef PG8_RS
#undef PG8_WAIT_L
#undef PG8_BAR
#undef PG8_SCHED
}
}
namespace epi {
using pg8::Unit;
typedef f32x4 Acc[2][2][4][2];

__device__ __forceinline__ float row_scale(const float* rs, int row) { return rs[row]; }
__device__ __forceinline__ u32x4 pack8(const f32x4 a, const f32x4 b) { u32x4 w; w.x = cvt_pk_bf16(a[0], a[1]); w.y = cvt_pk_bf16(a[2], a[3]); w.z = cvt_pk_bf16(b[0], b[1]); w.w = cvt_pk_bf16(b[2], b[3]); return w; }

struct EpiProj {
    static constexpr bool PERM = true, RS = true; static constexpr int VM_MIN = 16;
    bf16_t* P; float* misc; const float* ssq; const float* cs; const float* sn; const float* gt;     bf16_t* VT;     bf16_t* KI;     bf16_t* CVT;     float* ssqv;
    __device__ __forceinline__ int operator()(const Acc& acc, const Unit& u, int wr, int wc, int fr, int fq, const LAS float* rsl, const bool lastu) const {
        const int T = u.pn; const int row0 = u.pm * 256 + wr * 64 + fr;
        float rsv[8];
#pragma unroll
        for (int i = 0; i < 8; ++i) rsv[i] = rsl[wr * 64 + fr + (i >> 2) * 128 + (i & 3) * 16];
        if (T == 2 || T == 3 || T == 5 || T == 6 || T == 14) {
            if (T == 14 && wc >= 2) return 0;
            if (T == 14 && wc == 1) {
                if (fq < 2) {
#pragma unroll
                    for (int ai = 0; ai < 2; ++ai)
#pragma unroll
                        for (int m = 0; m < 4; ++m) { const int row = row0 + ai * 128 + m * 16; const float rs = rsv[ai * 4 + m];
                            float* mp = misc + (size_t)row * 16 + 8 * fq; *(f32x4*)mp = acc[ai][0][m][0] * rs; *(f32x4*)(mp + 4) = acc[ai][0][m][1] * rs; }
                }
                return 16;
            }
            const int mode = (T == 14) ? 2 : (T <= 3 ? 1 : 0);
            const float* gp = gt + 64 * ((T == 2) ? 0 : (T == 3) ? 1 : 2);
            f32x4 g1[2], g2[2];
#pragma unroll
            for (int n = 0; n < 2; ++n) { if (mode) { g1[n] = *(const f32x4*)(gp + 8 * fq + 4 * n); g2[n] = *(const f32x4*)(gp + 32 + 8 * fq + 4 * n); } else { g1[n] = (f32x4){1.f, 1.f, 1.f, 1.f}; g2[n] = g1[n]; } }
#pragma unroll
            for (int ai = 0; ai < 2; ++ai) {
#pragma unroll
                for (int m = 0; m < 4; ++m) {
                    const int row = row0 + ai * 128 + m * 16; const float rs = rsv[ai * 4 + m];
                    f32x4 x1[2], x2[2];
#pragma unroll
                    for (int n = 0; n < 2; ++n) { x1[n] = acc[ai][0][m][n] * rs; x2[n] = acc[ai][1][m][n] * rs; }
                    if (mode == 2) {
                        float s = 0.f;
#pragma unroll
                        for (int n = 0; n < 2; ++n) s += (x1[n][0] + x1[n][1]) + (x1[n][2] + x1[n][3]) + (x2[n][0] + x2[n][1]) + (x2[n][2] + x2[n][3]);
                        s += __shfl_xor(s, 16); s += __shfl_xor(s, 32); const float mu = s * (1.f / 64.f);
#pragma unroll
                        for (int n = 0; n < 2; ++n) { x1[n] = x1[n] - mu; x2[n] = x2[n] - mu; }
                    }
                    if (mode) {
                        float q = 0.f;
#pragma unroll
                        for (int n = 0; n < 2; ++n) { const f32x4 a = x1[n] * x1[n], b = x2[n] * x2[n]; q += (a[0] + a[1]) + (a[2] + a[3]) + (b[0] + b[1]) + (b[2] + b[3]); }
                        q += __shfl_xor(q, 16); q += __shfl_xor(q, 32); const float rr = rsqrtf(q * (1.f / 64.f) + EPS);
#pragma unroll
                        for (int n = 0; n < 2; ++n) { x1[n] = x1[n] * rr * g1[n]; x2[n] = x2[n] * rr * g2[n]; }
                        if (T == 2) {
#pragma unroll
                            for (int n = 0; n < 2; ++n) { x1[n] = x1[n] * (0.125f * 1.4426950408889634f); x2[n] = x2[n] * (0.125f * 1.4426950408889634f); } }
                    }
                    f32x4 o1[2], o2[2];
#pragma unroll
                    for (int n = 0; n < 2; ++n) { const int pos = row & (S - 1); const f32x4 c = *(const f32x4*)(cs + (size_t)pos * 32 + 8 * fq + 4 * n), s = *(const f32x4*)(sn + (size_t)pos * 32 + 8 * fq + 4 * n);
                        o1[n] = x1[n] * c - x2[n] * s; o2[n] = x2[n] * c + x1[n] * s; }
                    bf16_t* op = P + (size_t)row * PW + 256 * T + 64 * wc + 8 * fq;
                    *(u32x4*)op = pack8(o1[0], o1[1]); *(u32x4*)(op + 32) = pack8(o2[0], o2[1]);
                    if (T == 14) {
                        bf16_t* kp = KI + ((size_t)((row >> 5) * 4 + (fq >> 1)) * 64 + (fq & 1) * 32 + (row & 31)) * 8; *(u32x4*)kp = pack8(o1[0], o1[1]); *(u32x4*)(kp + 2 * 64 * 8) = pack8(o2[0], o2[1]); }
                }
            }
            return 16;
        }
        const int act = (T <= 1) ? 1 : 0; const float sc = (T == 8) ? 0.125f : 1.0f;
#pragma unroll
        for (int ai = 0; ai < 2; ++ai)
#pragma unroll
            for (int m = 0; m < 4; ++m) {
                const int row = row0 + ai * 128 + m * 16; const float rs = rsv[ai * 4 + m] * sc;
                bf16_t* op = P + (size_t)row * PW + 256 * T + 32 * wc + 8 * fq; float qv = 0.f;
#pragma unroll
                for (int bj = 0; bj < 2; ++bj) { f32x4 v0 = acc[ai][bj][m][0] * rs, v1 = acc[ai][bj][m][1] * rs;
                    if (act) {
#pragma unroll
                        for (int e = 0; e < 4; ++e) { v0[e] = gelu_tanh_f(v0[e]); v1[e] = gelu_tanh_f(v1[e]); }
                        const f32x4 a2 = v0 * v0, b2 = v1 * v1; qv += ((a2[0] + a2[1]) + (a2[2] + a2[3])) + ((b2[0] + b2[1]) + (b2[2] + b2[3])); }
                    *(u32x4*)(op + bj * 128) = pack8(v0, v1);
                    if (T == 4 || T == 9) { bf16_t* vp = (T == 4 ? VT : CVT) + ((size_t)((row >> 12) * 256 + bj * 128 + 32 * wc + 8 * fq)) * S + (row & (S - 1));
#pragma unroll
                        for (int e = 0; e < 4; ++e) { vp[(size_t)e * S] = (bf16_t)f2bf(v0[e]); vp[(size_t)(4 + e) * S] = (bf16_t)f2bf(v1[e]); } } }
                if (T == 1) { qv += __shfl_xor(qv, 16); qv += __shfl_xor(qv, 32); if (fq == 0) ssqv[(size_t)row * 4 + wc] = qv; }
            }
        return 16;
    }
};

struct EpiPlain {
    static constexpr bool PERM = true, RS = false; static constexpr int VM_MIN = 16;
    bf16_t* O; int ldc; int zcols;
    __device__ __forceinline__ int operator()(const Acc& acc, const Unit& u, int wr, int wc, int fr, int fq, const LAS float*, const bool lastu) const {
        const int row0 = u.pm * 256 + wr * 64 + fr; const int col0 = u.z * zcols + u.pn * 256 + 32 * wc + 8 * fq;
#pragma unroll
        for (int ai = 0; ai < 2; ++ai)
#pragma unroll
            for (int m = 0; m < 4; ++m) { bf16_t* op = O + (size_t)(row0 + ai * 128 + m * 16) * ldc + col0;
#pragma unroll
                for (int bj = 0; bj < 2; ++bj) *(u32x4*)(op + bj * 128) = pack8(acc[ai][bj][m][0], acc[ai][bj][m][1]); }
        return 16;
    }
};

struct EpiGate {
    static constexpr bool PERM = true, RS = true; static constexpr int VM_MIN = 40;
    bf16_t* MG; const bf16_t* BR; const float* ssq;
    __device__ __forceinline__ int operator()(const Acc& acc, const Unit& u, int wr, int wc, int fr, int fq, const LAS float* rsl, const bool lastu) const {
        const int row0 = u.pm * 256 + wr * 64 + fr; const int ch0 = u.pn * 64 + 16 * wc + 4 * fq;
        float rsv[8];
#pragma unroll
        for (int i = 0; i < 8; ++i) rsv[i] = rsl[wr * 64 + fr + (i >> 2) * 128 + (i & 3) * 16] * (1.0f / WG8_SCALE);
#pragma unroll
        for (int ai = 0; ai < 2; ++ai) {
            u32x2 bw[4][4];
#pragma unroll
            for (int m = 0; m < 4; ++m)
#pragma unroll
                for (int nb = 0; nb < 4; ++nb) bw[m][nb] = *(const u32x2*)(BR + (size_t)(row0 + ai * 128 + m * 16) * 4096 + ch0 + nb * 1024);
#pragma unroll
            for (int m = 0; m < 4; ++m) {
                const int row = row0 + ai * 128 + m * 16; const float rs = rsv[ai * 4 + m]; f32x4 o = (f32x4){0.f, 0.f, 0.f, 0.f};
#pragma unroll
                for (int bj = 0; bj < 2; ++bj)
#pragma unroll
                    for (int n = 0; n < 2; ++n) { const u32x2 w = bw[m][2 * bj + n]; const f32x4 a = acc[ai][bj][m][n] * rs;
                        o[0] += sigmoid_f(a[0]) * lo_bf(w.x); o[1] += sigmoid_f(a[1]) * hi_bf(w.x); o[2] += sigmoid_f(a[2]) * lo_bf(w.y); o[3] += sigmoid_f(a[3]) * hi_bf(w.y); }
                u32x2 ow; ow.x = cvt_pk_bf16(o[0], o[1]); ow.y = cvt_pk_bf16(o[2], o[3]);
                *(u32x2*)(MG + (size_t)row * 1024 + ch0) = ow;
            }
        }
        return 40;
    }
};

struct EpiResid {
    static constexpr bool PERM = true, RS = false; static constexpr int VM_MIN = 0;
    const float* resf; bf16_t* X; float* outf; float* ssq; unsigned char* x8;
    __device__ __forceinline__ int operator()(const Acc& acc, const Unit& u, int wr, int wc, int fr, int fq, const LAS float*, const bool lastu) const {
        const int row0 = u.pm * 256 + wr * 64 + fr; const int col0 = u.pn * 256 + 32 * wc + 8 * fq;
#pragma unroll
        for (int ai = 0; ai < 2; ++ai) {
            f32x4 r[4][2][2];
            if (resf) {
#pragma unroll
                for (int m = 0; m < 4; ++m)
#pragma unroll
                    for (int bj = 0; bj < 2; ++bj) { const float* rp = resf + (size_t)(row0 + ai * 128 + m * 16) * 1024 + col0 + bj * 128; r[m][bj][0] = *(const f32x4*)rp; r[m][bj][1] = *(const f32x4*)(rp + 4); }
            } else {
                u32x4 w[4][2];
#pragma unroll
                for (int m = 0; m < 4; ++m)
#pragma unroll
                    for (int bj = 0; bj < 2; ++bj) w[m][bj] = *(const u32x4*)(X + (size_t)(row0 + ai * 128 + m * 16) * 1024 + col0 + bj * 128);
#pragma unroll
                for (int m = 0; m < 4; ++m)
#pragma unroll
                    for (int bj = 0; bj < 2; ++bj) { const u32x4 q = w[m][bj]; r[m][bj][0] = (f32x4){lo_bf(q.x), hi_bf(q.x), lo_bf(q.y), hi_bf(q.y)}; r[m][bj][1] = (f32x4){lo_bf(q.z), hi_bf(q.z), lo_bf(q.w), hi_bf(q.w)}; }
            }
#pragma unroll
            for (int m = 0; m < 4; ++m) {
                const int row = row0 + ai * 128 + m * 16; const size_t off = (size_t)row * 1024 + col0; float q = 0.f;
#pragma unroll
                for (int bj = 0; bj < 2; ++bj) {
                    const f32x4 x0 = r[m][bj][0] + acc[ai][bj][m][0], x1 = r[m][bj][1] + acc[ai][bj][m][1];
                    if (outf) { *(f32x4*)(outf + off + bj * 128) = x0; *(f32x4*)(outf + off + bj * 128 + 4) = x1; }
                    else {
                        const f32x4 a = x0 * x0, b = x1 * x1; q += ((a[0] + a[1]) + (a[2] + a[3])) + ((b[0] + b[1]) + (b[2] + b[3]));
                        *(u32x4*)(X + off + bj * 128) = pack8(x0, x1);
                        if (x8) { u32x2 q8; q8.x = pk4_fp8(x0[0], x0[1], x0[2], x0[3]); q8.y = pk4_fp8(x1[0], x1[1], x1[2], x1[3]); *(u32x2*)(x8 + off + bj * 128) = q8; } }
                }
                if (!outf) { q += __shfl_xor(q, 16); q += __shfl_xor(q, 32); if (fq == 0) ssq[(size_t)row * 16 + 4 * u.pn + wc] = q; }
            }
        }
        return 0;
    }
};

struct EpiUp {
    static constexpr bool PERM = true, RS = true; static constexpr int VM_MIN = 16;
    bf16_t* H; const float* ssq;
    __device__ __forceinline__ int operator()(const Acc& acc, const Unit& u, int wr, int wc, int fr, int fq, const LAS float* rsl, const bool lastu) const {
        const int row0 = u.pm * 256 + wr * 64 + fr; const int col0 = u.pn * 256 + 32 * wc + 8 * fq;
        float rsv[8];
#pragma unroll
        for (int i = 0; i < 8; ++i) rsv[i] = rsl[wr * 64 + fr + (i >> 2) * 128 + (i & 3) * 16];
#pragma unroll
        for (int ai = 0; ai < 2; ++ai)
#pragma unroll
            for (int m = 0; m < 4; ++m) { const int row = row0 + ai * 128 + m * 16; const float rs = rsv[ai * 4 + m]; bf16_t* op = H + (size_t)row * FF + col0;
#pragma unroll
                for (int bj = 0; bj < 2; ++bj) { f32x4 v0 = acc[ai][bj][m][0] * rs, v1 = acc[ai][bj][m][1] * rs;
#pragma unroll
                    for (int e = 0; e < 4; ++e) { v0[e] = relu_f(v0[e]); v1[e] = relu_f(v1[e]); }
                    st16(op + bj * 128, pack8(v0 * v0, v1 * v1), lastu); } }
        return 16;
    }
};
}
struct Args {
    const float* in[18]; float* out; unsigned char* ws; int ph_lo, ph_hi; int coop, pad;
};
struct Frame { LAS unsigned char* lds; int tid, wave, G, vcu; };
constexpr int PTR_OFF = LDS_BYTES - 512;
enum { I_X = 0, I_LN_MIX, I_W_IN, I_SGU_NORM, I_SGU_W, I_SGU_B, I_Q_NORM, I_K_NORM, I_KIDX_NORM, I_I_BIAS, I_F_BIAS, I_MNORM, I_CONV_W, I_W_BRANCH, I_W_OUT, I_LN_MLP, I_W_UP, I_W_DOWN, I_OUT, I_WS };
__device__ __forceinline__ unsigned char* ptr_at(const Frame& F, int i) { const LAS unsigned* p = (const LAS unsigned*)(F.lds + PTR_OFF) + 2 * i;
    const unsigned lo = __builtin_amdgcn_readfirstlane(p[0]), hi = __builtin_amdgcn_readfirstlane(p[1]);
    typedef __attribute__((address_space(1))) unsigned char* gptr_t;
    return (unsigned char*)(gptr_t)(((unsigned long long)hi << 32) | lo); }
#define INP(i) ((const float*)ptr_at(F, (i)))
#define WSP(off) (ptr_at(F, I_WS) + (off))
constexpr size_t WS_GT = 512 * 1024;
constexpr size_t WS_RSA = 256 * 1024, WS_RSB = 320 * 1024;
__device__ __forceinline__ size_t maskt_idx(int m, int w) { const int b = m >> 12, t = m & (S - 1); return ((size_t)(b * 64 + (w >> 1)) * S + t) * 2 + (w & 1); }


#define XB_TMO      128
#define XB_XCNT(j)  (256  + 64 * (j))
#define XB_XSUB(j)  (1280 + 64 * (j))
#define XB_XGEN(j)  (2304 + 64 * (j))
#define XB_TOP      3328
#define XB_TOPGEN   3392
#define XCD_BAR_WORDS 3456
#define XB_SPIN_CAP (1u << 22)
constexpr size_t WS_BAR = 64 * 1024;
constexpr size_t CTL_ZERO_BYTES = 128 * 1024;
__device__ __forceinline__ unsigned xb_ld(unsigned* p)              { return __hip_atomic_load(p, __ATOMIC_RELAXED, __HIP_MEMORY_SCOPE_AGENT); }
__device__ __forceinline__ unsigned xb_add(unsigned* p, unsigned v) { return __hip_atomic_fetch_add(p, v, __ATOMIC_RELAXED, __HIP_MEMORY_SCOPE_AGENT); }
__device__ __forceinline__ unsigned xb_xcc_id() { return (unsigned)__builtin_amdgcn_s_getreg((3 << 11) | 20) & 0xFu; }
#define XB_SPIN(cond, bar) do { unsigned _sp = 0; while (cond) { __builtin_amdgcn_s_sleep(1); \
    if ((++_sp & 255u) == 0u) { if (xb_ld(&(bar)[XB_TMO])) break; if (_sp > XB_SPIN_CAP) { atomicAdd(&(bar)[XB_TMO], 1u); break; } } } } while (0)
struct XcdBarrier { unsigned* bar; unsigned x; volatile LAS unsigned* st; };
__device__ __forceinline__ XcdBarrier xcd_barrier_post(unsigned* bar, volatile LAS unsigned* st) {
    XcdBarrier b; b.bar = bar; b.x = xb_xcc_id(); b.st = st;
    if (threadIdx.x == 0) (void)xb_add(&bar[XB_XCNT(b.x)], 1u);
    return b;
}
__device__ __forceinline__ void xcd_barrier_complete(unsigned* bar, unsigned x, unsigned& nloc, unsigned& nx) {
    const unsigned G = gridDim.x * gridDim.y * gridDim.z;
    unsigned sum, cnt, mine, sp = 0u;
    for (;;) {
        sum = 0u; cnt = 0u; mine = 0u;
#pragma unroll
        for (unsigned j = 0; j < 16; ++j) { const unsigned c = xb_ld(&bar[XB_XCNT(j)]); sum += c; cnt += (c > 0u) ? 1u : 0u; mine = (j == x) ? c : mine; }
        if (sum == G) break;
        __builtin_amdgcn_s_sleep(1);
        if ((++sp & 255u) == 0u) { if (xb_ld(&bar[XB_TMO])) break; if (sp > XB_SPIN_CAP) { atomicAdd(&bar[XB_TMO], 1u); break; } }
    }
    nloc = mine > 0u ? mine : 1u; nx = cnt > 0u ? cnt : 1u;
}
__device__ __forceinline__ void xcd_barrier(const XcdBarrier& b) {
    asm volatile("s_waitcnt vmcnt(0)" ::: "memory");
    __syncthreads();
    if (threadIdx.x == 0) {
        unsigned* bar = b.bar;
        __builtin_amdgcn_s_waitcnt(0);
        unsigned nloc = b.st[0], nx = b.st[1];
        if (nloc == 0u) { xcd_barrier_complete(bar, b.x, nloc, nx); b.st[0] = nloc; b.st[1] = nx; }
        const unsigned old = xb_add(&bar[XB_XSUB(b.x)], 1u);
        const unsigned gen = old / nloc;
        if (old + 1u == (gen + 1u) * nloc) {
            __builtin_amdgcn_fence(__ATOMIC_RELEASE, "agent");
            asm volatile("s_waitcnt vmcnt(0)" ::: "memory");
            const unsigned og = xb_add(&bar[XB_TOP], 1u);
            const unsigned tg = og / nx;
            if (og + 1u == (tg + 1u) * nx) xb_add(&bar[XB_TOPGEN], 1u);
            else XB_SPIN(xb_ld(&bar[XB_TOPGEN]) == tg, bar);
            __builtin_amdgcn_fence(__ATOMIC_ACQUIRE, "agent");
            xb_add(&bar[XB_XGEN(b.x)], 1u);
            asm volatile("s_waitcnt vmcnt(0)" ::: "memory");
        } else {
            XB_SPIN(xb_ld(&bar[XB_XGEN(b.x)]) == gen, bar);
            __builtin_amdgcn_fence(__ATOMIC_ACQUIRE, "agent");
            asm volatile("s_waitcnt vmcnt(0)" ::: "memory");
        }
    }
    __syncthreads();
}

__device__ __forceinline__ int win_src(int p) {
    const int T = p >> 8, q = p & 255, bj = q >> 7, wc = (q >> 5) & 3, j = q & 31, hd = 64 * wc + 32 * bj + j;
    switch (T) {
        case 0: return O_AU + q; case 1: return O_AV + q; case 2: return O_BQ + hd; case 3: return O_BK + hd; case 4: return O_BV + q;
        case 5: return O_QI + hd; case 6: return O_QI + 256 + hd; case 7: return O_CQ + q; case 8: return O_CK + q; case 9: return O_CV + q;
        case 10: return O_CO + q; case 11: return O_DB + q; case 12: return O_DC + q; case 13: return O_DX + q;
        default: break;
    }
    if (wc == 0) return O_KI + 32 * bj + j;
    if (wc == 1 && bj == 0 && j < 16) return j < 8 ? O_WI + j : (j < 12 ? O_CI + (j - 8) : O_CF + (j - 12));
    return -1;
}
__device__ __forceinline__ int wg_src(int p) {
    const int pn = p >> 8, q = p & 255, bj = q >> 7, wc = (q >> 5) & 3, fq = (q >> 3) & 3, n = (q >> 2) & 1, e = q & 3;
    return O_G + (2 * bj + n) * 1024 + 64 * pn + 16 * wc + 4 * fq + e;
}
template <int MAP>
__device__ __forceinline__ void conv_item(const float* W, int K, int srcN, bf16_t* WT, LAS float* scr, int item, int nrows, int lane, const float* gain = nullptr) {
    const int nblk = nrows / 32, kb = item / nblk, nb = item % nblk, k0 = 64 * kb, n0 = 32 * nb;
    const int nn = n0 + (lane & 31); const int src = MAP == 0 ? nn : (MAP == 1 ? win_src(nn) : wg_src(nn));
    float wv_[32]; const float* wp_ = W + (size_t)(k0 + (lane >> 5)) * srcN + (src >= 0 ? src : 0);
#pragma unroll
    for (int i = 0; i < 32; ++i) wv_[i] = __builtin_nontemporal_load(wp_ + (size_t)(2 * i) * srcN);
#pragma unroll
    for (int i = 0; i < 32; ++i) scr[(2 * i + (lane >> 5)) * 33 + (lane & 31)] = src >= 0 ? (gain ? wv_[i] * gain[k0 + 2 * i + (lane >> 5)] : wv_[i]) : 0.f;
    asm volatile("s_waitcnt lgkmcnt(0)" ::: "memory");
    const int c = lane & 7;
#pragma unroll
    for (int j = 0; j < 4; ++j) { const int n = (lane >> 3) + 8 * j; const LAS float* s = scr + (8 * c) * 33 + n;
        u32x4 o; o.x = pk2(s[0 * 33], s[1 * 33]); o.y = pk2(s[2 * 33], s[3 * 33]); o.z = pk2(s[4 * 33], s[5 * 33]); o.w = pk2(s[6 * 33], s[7 * 33]);
        *(u32x4*)(WT + (size_t)(n0 + n) * K + k0 + 8 * c) = o; }
    asm volatile("s_waitcnt lgkmcnt(0)" ::: "memory");
}
template <int MAP>
__device__ __forceinline__ void conv_item8(const float* W, int K, int srcN, unsigned char* WT8, LAS float* scr, int item, int nrows, int lane, const float* gain, float scale) {
    const int nblk = nrows / 32, kb = item / nblk, nb = item % nblk, k0 = 64 * kb, n0 = 32 * nb;
    const int nn = n0 + (lane & 31); const int src = MAP == 0 ? nn : (MAP == 1 ? win_src(nn) : wg_src(nn));
    float wv_[32]; const float* wp_ = W + (size_t)(k0 + (lane >> 5)) * srcN + (src >= 0 ? src : 0);
#pragma unroll
    for (int i = 0; i < 32; ++i) wv_[i] = __builtin_nontemporal_load(wp_ + (size_t)(2 * i) * srcN);
#pragma unroll
    for (int i = 0; i < 32; ++i) scr[(2 * i + (lane >> 5)) * 33 + (lane & 31)] = src >= 0 ? wv_[i] * gain[k0 + 2 * i + (lane >> 5)] * scale : 0.f;
    asm volatile("s_waitcnt lgkmcnt(0)" ::: "memory");
    const int c = lane & 7;
#pragma unroll
    for (int j = 0; j < 4; ++j) { const int n = (lane >> 3) + 8 * j; const LAS float* s = scr + (8 * c) * 33 + n;
        u32x2 o; o.x = pk4_fp8(s[0 * 33], s[1 * 33], s[2 * 33], s[3 * 33]); o.y = pk4_fp8(s[4 * 33], s[5 * 33], s[6 * 33], s[7 * 33]);
        *(u32x2*)(WT8 + (size_t)(n0 + n) * K + k0 + 8 * c) = o; }
    asm volatile("s_waitcnt lgkmcnt(0)" ::: "memory");
}
__device__ __forceinline__ void convert_mix_weights(Frame& F, int l) {

    LAS float* scr = (LAS float*)(F.lds + F.wave * 16384);
    const int gw = F.vcu * NWAVES + F.wave, NGW = F.G * NWAVES;
    constexpr int I_WIN = (D / 64) * (PW / 32), I_WG = (D / 64) * (4096 / 32), I_BR = (256 / 64) * (1024 / 32), I_WO = (D / 64) * (D / 32);
    constexpr int NIT = I_WIN + I_WG + 4 * I_BR + I_WO;
    const float* win = INP(I_W_IN) + (size_t)l * D * INW; const float* gmix = INP(I_LN_MIX) + l * D;
    for (int it = gw; it < NIT; it += NGW) {
        int r = it;
        if (r < I_WIN) { conv_item<1>(win, D, INW, ((bf16_t*)WSP(WS_WIN)), scr, r, PW, (F.tid & 63), gmix); continue; } r -= I_WIN;
        if (r < I_WG) { conv_item8<2>(win, D, INW, ptr_at(F, I_OUT) + OUT_WG8 + (size_t)l * 4 * MiB, scr, r, 4096, (F.tid & 63), gmix, WG8_SCALE); continue; } r -= I_WG;
        if (r < 4 * I_BR) { const int nb = r / I_BR; conv_item<0>(INP(I_W_BRANCH) + ((size_t)l * 4 + nb) * 256 * D, 256, D, ((bf16_t*)WSP(WS_WBR)) + (size_t)nb * 1024 * 256, scr, r % I_BR, 1024, (F.tid & 63)); continue; } r -= 4 * I_BR;
        conv_item<0>(INP(I_W_OUT) + (size_t)l * D * D, D, D, ((bf16_t*)WSP(WS_WOUT)), scr, r, D, (F.tid & 63));
    }
}
__device__ __forceinline__ void convert_mlp_weights(Frame& F, int l) {

    LAS float* scr = (LAS float*)(F.lds + F.wave * 16384);
    const int gw = F.vcu * NWAVES + F.wave, NGW = F.G * NWAVES;
    constexpr int I_UP = (D / 64) * (FF / 32), I_DN = (FF / 64) * (D / 32);
    for (int it = gw; it < I_UP + I_DN; it += NGW) {
        if (it < I_UP) conv_item<0>(INP(I_W_UP) + (size_t)l * D * FF, D, FF, ((bf16_t*)WSP(WS_WUP)), scr, it, FF, (F.tid & 63), INP(I_LN_MLP) + l * D);
        else conv_item<0>(INP(I_W_DOWN) + (size_t)l * FF * D, FF, D, ((bf16_t*)WSP(WS_WDN)), scr, it - I_UP, D, (F.tid & 63));
    }
}
__device__ __forceinline__ void prologue_rows(Frame& F) {
    float* COS = (float*)WSP(WS_COS); float* SIN = (float*)WSP(WS_SIN); float* SSQA = (float*)WSP(WS_SSQA); bf16_t* XG = (bf16_t*)WSP(WS_XG); const float* x = INP(I_X); const float* ln_mix = INP(I_LN_MIX);
    const int gt = F.vcu * NT + F.tid, NGT = F.G * NT;
    for (int i = gt; i < S * 32; i += NGT) { const int pos = i >> 5, k = i & 31; const float inv = powf(10000.f, -(float)k * 2.0f / 64.f); const float ang = (float)pos * inv; COS[i] = cosf(ang); SIN[i] = sinf(ang); }
    const int gw = F.vcu * NWAVES + F.wave, NGW = F.G * NWAVES;
    float* rsa = (float*)WSP(WS_RSA); unsigned char* x8p = ptr_at(F, I_OUT) + OUT_X8;
    for (int m0 = gw * 4; m0 < M; m0 += NGW * 4) {
        f32x4 v[4][4];
#pragma unroll
        for (int r = 0; r < 4; ++r)
#pragma unroll
            for (int j = 0; j < 4; ++j) v[r][j] = __builtin_nontemporal_load((const f32x4*)(x + (size_t)(m0 + r) * D) + (F.tid & 63) + 64 * j);
#pragma unroll
        for (int r = 0; r < 4; ++r) { float s = 0.f; unsigned long long* o8 = (unsigned long long*)(XG + (size_t)(m0 + r) * D) + (F.tid & 63);
#pragma unroll
            for (int j = 0; j < 4; ++j) { const f32x4 w = v[r][j]; s += (w[0] * w[0] + w[1] * w[1]) + (w[2] * w[2] + w[3] * w[3]);
                o8[64 * j] = (unsigned long long)pk2(w[0], w[1]) | ((unsigned long long)pk2(w[2], w[3]) << 32);
                ((unsigned*)(x8p + (size_t)(m0 + r) * D))[(F.tid & 63) + 64 * j] = pk4_fp8(w[0], w[1], w[2], w[3]); }
            s = wave_sum(s);
            if ((F.tid & 63) == 0) rsa[m0 + r] = rsqrtf(s * (1.f / 1024.f) + EPS); }
    }
}
__device__ __forceinline__ void finalize_rs(Frame& F, size_t ssq_off, size_t rs_off) {
    const float* ssq = (const float*)WSP(ssq_off); float* rs = (float*)WSP(rs_off);
    for (int row = F.vcu * NT + F.tid; row < M; row += F.G * NT) { const f32x4* sp = (const f32x4*)(ssq + (size_t)row * 16); const f32x4 a = sp[0], b = sp[1], c = sp[2], d = sp[3];
        const float t = ((a[0] + a[1]) + (a[2] + a[3])) + ((b[0] + b[1]) + (b[2] + b[3])) + ((c[0] + c[1]) + (c[2] + c[3])) + ((d[0] + d[1]) + (d[2] + d[3]));
        rs[row] = rsqrtf(t * (1.0f / 1024.0f) + EPS); }
}

__device__ __forceinline__ void conv_simple(Frame& F, int l) {
    bf16_t* PROJ = (bf16_t*)WSP(WS_BIG); bf16_t* Y = (bf16_t*)WSP(WS_Y); const float* conv_w = INP(I_CONV_W);
    const float* cw = conv_w + l * 3 * 256;
    for (int i = F.vcu * NT + F.tid; i < M * 32; i += F.G * NT) { const int m = i >> 5, c = (i & 31) * 8, t = m & (S - 1); float acc[8];
#pragma unroll
        for (int e = 0; e < 8; ++e) acc[e] = 0.f;
#pragma unroll
        for (int j = 0; j < 3; ++j) { const int tt = t - 2 + j; if (tt >= 0) { const size_t r = (size_t)(m - 2 + j) * PW; const u32x4 a = *(const u32x4*)(PROJ + r + P_DC + c), x = *(const u32x4*)(PROJ + r + P_DX + c);
                const f32x4 w0 = *(const f32x4*)(cw + j * 256 + c), w1 = *(const f32x4*)(cw + j * 256 + c + 4);
                acc[0] = fmaf(w0[0], lo_bf(a.x) * lo_bf(x.x), acc[0]); acc[1] = fmaf(w0[1], hi_bf(a.x) * hi_bf(x.x), acc[1]); acc[2] = fmaf(w0[2], lo_bf(a.y) * lo_bf(x.y), acc[2]); acc[3] = fmaf(w0[3], hi_bf(a.y) * hi_bf(x.y), acc[3]);
                acc[4] = fmaf(w1[0], lo_bf(a.z) * lo_bf(x.z), acc[4]); acc[5] = fmaf(w1[1], hi_bf(a.z) * hi_bf(x.z), acc[5]); acc[6] = fmaf(w1[2], lo_bf(a.w) * lo_bf(x.w), acc[6]); acc[7] = fmaf(w1[3], hi_bf(a.w) * hi_bf(x.w), acc[7]); } }
        const u32x4 bq = *(const u32x4*)(PROJ + (size_t)m * PW + P_DB + c); u32x4 o;
        o.x = cvt_pk_bf16(lo_bf(bq.x) * acc[0], hi_bf(bq.x) * acc[1]); o.y = cvt_pk_bf16(lo_bf(bq.y) * acc[2], hi_bf(bq.y) * acc[3]); o.z = cvt_pk_bf16(lo_bf(bq.z) * acc[4], hi_bf(bq.z) * acc[5]); o.w = cvt_pk_bf16(lo_bf(bq.w) * acc[6], hi_bf(bq.w) * acc[7]);
        *(u32x4*)(Y + (size_t)m * D + 768 + c) = o; }
}
typedef float f32x16 __attribute__((ext_vector_type(16)));
constexpr size_t WS_VT = WS_BIG + 120 * MiB;
constexpr float LOG2E = 1.4426950408889634f;

template <int R> struct AttExp {
    static __device__ __forceinline__ void run(f32x16& p0, f32x16& p1, unsigned sh0, unsigned sh1, float& lsum) {
        constexpr int CB = (R & 3) + 8 * (R >> 2);
        int m0, m1; asm("v_bfe_i32 %0, %1, %2, 1" : "=v"(m0) : "v"(sh0), "n"(CB)); asm("v_bfe_i32 %0, %1, %2, 1" : "=v"(m1) : "v"(sh1), "n"(CB));
        p0[R] = __uint_as_float(__float_as_uint(__builtin_amdgcn_exp2f(p0[R])) & (unsigned)m0); p1[R] = __uint_as_float(__float_as_uint(__builtin_amdgcn_exp2f(p1[R])) & (unsigned)m1);
        lsum += p0[R] + p1[R];
        AttExp<R + 1>::run(p0, p1, sh0, sh1, lsum);
    }
};
template <> struct AttExp<16> { static __device__ __forceinline__ void run(f32x16&, f32x16&, unsigned, unsigned, float&) {} };

__device__ __forceinline__ void attn_mfma(Frame& F, int l) {
    const unsigned long long* MASKT = (const unsigned long long*)WSP(WS_MASK); const bf16_t* PROJ = (const bf16_t*)WSP(WS_BIG); const bf16_t* VT = (const bf16_t*)WSP(WS_VT);
    bf16_t* Y = (bf16_t*)WSP(WS_Y); const float* gt = (const float*)WSP(WS_GT) + l * 192;
    const int lane = (F.tid & 63), r32 = lane & 31, hi = lane >> 5, grp = F.wave >> 2, w4 = F.wave & 3, lg = F.tid & 255;
    const float mq = wave_max(fabsf(gt[lane])), mk = wave_max(fabsf(gt[64 + lane]));
    const float c2 = 8.f * mq * mk * 1.01f * LOG2E;
    constexpr int ROWB = 144, TILEB = 64 * ROWB;
    LAS unsigned char* gb = F.lds + grp * 4 * TILEB;
    LAS float* comb = (LAS float*)(F.lds + 8 * TILEB);
    const int srow0 = lg >> 3, sc0 = lg & 7;
    for (int item = F.vcu; item < 256; item += F.G) {
        const int bh = item >> 4, sidx = item & 15, b = bh >> 2, h = bh & 3;
#pragma unroll 1
        for (int half = 0; half < 2; ++half) {
            const int qb = half == 0 ? sidx : 31 - sidx, q0 = qb * 128, ntl = qb + 1;
            const int qrow = b * S + q0 + w4 * 32 + r32, tq = q0 + w4 * 32 + r32;
            bf16x8 qf[4];
#pragma unroll
            for (int s = 0; s < 4; ++s) qf[s] = *(const bf16x8*)(PROJ + (size_t)qrow * PW + P_Q + h * 64 + 16 * s + 8 * hi);
            f32x16 o0, o1;
#pragma unroll
            for (int r = 0; r < 16; ++r) { o0[r] = 0.f; o1[r] = 0.f; }
            float lsum = 0.f;
            const bf16_t* kbase = PROJ + (size_t)(b * S + srow0) * PW + P_K + h * 64 + sc0 * 8;
            const bf16_t* vbase = VT + (size_t)(b * 256 + h * 64 + srow0) * S + sc0 * 8;
            const unsigned long long* mbase = MASKT + (size_t)(b * 64) * S + tq;
            u32x4 ka0, ka1, va0, va1, kb0, kb1, vb0, vb1; unsigned long long mwa = 0ull, mwb = 0ull;
#define ATT_LOAD(K0, K1, V0, V1, MW, t_) do { const int t__ = (t_); K0 = *(const u32x4*)(kbase + (size_t)t__ * 64 * PW); K1 = *(const u32x4*)(kbase + (size_t)(t__ * 64 + 32) * PW); \
    V0 = *(const u32x4*)(vbase + t__ * 64); V1 = *(const u32x4*)(vbase + 32 * S + t__ * 64); MW = mbase[(size_t)t__ * S]; } while (0)
#define ATT_STORE(K0, K1, V0, V1, buf_) do { LAS unsigned char* kn_ = gb + (buf_) * 2 * TILEB; LAS unsigned char* vn_ = kn_ + TILEB; \
    *(LAS u32x4*)(kn_ + srow0 * ROWB + sc0 * 16) = K0; *(LAS u32x4*)(kn_ + (srow0 + 32) * ROWB + sc0 * 16) = K1; \
    *(LAS u32x4*)(vn_ + srow0 * ROWB + sc0 * 16) = V0; *(LAS u32x4*)(vn_ + (srow0 + 32) * ROWB + sc0 * 16) = V1; } while (0)
#define ATT_COMPUTE(cur_, MW) do { \
                const LAS unsigned char* kb = gb + (cur_) * 2 * TILEB; const LAS unsigned char* vb = kb + TILEB; \
                f32x16 p0, p1; \
                _Pragma("unroll") for (int r = 0; r < 16; ++r) { p0[r] = -c2; p1[r] = -c2; }     \
                _Pragma("unroll") for (int s = 0; s < 4; ++s) { \
                    const bf16x8 k0 = *(const LAS bf16x8*)(kb + r32 * ROWB + 32 * s + 16 * hi), k1 = *(const LAS bf16x8*)(kb + (32 + r32) * ROWB + 32 * s + 16 * hi); \
                    p0 = __builtin_amdgcn_mfma_f32_32x32x16_bf16(k0, qf[s], p0, 0, 0, 0); p1 = __builtin_amdgcn_mfma_f32_32x32x16_bf16(k1, qf[s], p1, 0, 0, 0); } \
                const unsigned sh0 = (unsigned)(MW) >> (4 * hi), sh1 = (unsigned)((MW) >> 32) >> (4 * hi); \
                AttExp<0>::run(p0, p1, sh0, sh1, lsum); \
                _Pragma("unroll") for (int ks = 0; ks < 4; ++ks) { \
                    u32x4 pw; \
                    if (ks < 2) { pw.x = cvt_pk_bf16(p0[8 * ks + 0], p0[8 * ks + 1]); pw.y = cvt_pk_bf16(p0[8 * ks + 2], p0[8 * ks + 3]); pw.z = cvt_pk_bf16(p0[8 * ks + 4], p0[8 * ks + 5]); pw.w = cvt_pk_bf16(p0[8 * ks + 6], p0[8 * ks + 7]); } \
                    else { const int k2 = ks - 2; pw.x = cvt_pk_bf16(p1[8 * k2 + 0], p1[8 * k2 + 1]); pw.y = cvt_pk_bf16(p1[8 * k2 + 2], p1[8 * k2 + 3]); pw.z = cvt_pk_bf16(p1[8 * k2 + 4], p1[8 * k2 + 5]); pw.w = cvt_pk_bf16(p1[8 * k2 + 6], p1[8 * k2 + 7]); } \
                    const bf16x8 pf = __builtin_bit_cast(bf16x8, pw); \
                    const int vo = 64 * (ks >> 1) + 32 * (ks & 1) + 8 * hi; \
                    const u32x2 a0 = *(const LAS u32x2*)(vb + r32 * ROWB + vo), a1 = *(const LAS u32x2*)(vb + r32 * ROWB + vo + 16); \
                    const u32x2 b0 = *(const LAS u32x2*)(vb + (32 + r32) * ROWB + vo), b1 = *(const LAS u32x2*)(vb + (32 + r32) * ROWB + vo + 16); \
                    const u32x4 va = {a0.x, a0.y, a1.x, a1.y}, vb4 = {b0.x, b0.y, b1.x, b1.y}; \
                    o0 = __builtin_amdgcn_mfma_f32_32x32x16_bf16(__builtin_bit_cast(bf16x8, va), pf, o0, 0, 0, 0); \
                    o1 = __builtin_amdgcn_mfma_f32_32x32x16_bf16(__builtin_bit_cast(bf16x8, vb4), pf, o1, 0, 0, 0); } \
            } while (0)
            ATT_LOAD(ka0, ka1, va0, va1, mwa, grp);
            if (ntl > 1) ATT_LOAD(kb0, kb1, vb0, vb1, mwb, 2 + grp);
            ATT_STORE(ka0, ka1, va0, va1, 0);
            __syncthreads();
            asm volatile(".p2align 8");
#pragma unroll 1
            for (int i = 0; i < ntl; i += 2) {
                const unsigned long long mw0 = mwa;
                if (i + 2 < ntl) ATT_LOAD(ka0, ka1, va0, va1, mwa, 2 * (i + 2) + grp);
                ATT_COMPUTE(0, mw0);
                if (i + 1 < ntl) ATT_STORE(kb0, kb1, vb0, vb1, 1);
                __syncthreads();
                if (i + 1 < ntl) {
                    const unsigned long long mw1 = mwb;
                    if (i + 3 < ntl) ATT_LOAD(kb0, kb1, vb0, vb1, mwb, 2 * (i + 3) + grp);
                    ATT_COMPUTE(1, mw1);
                    if (i + 2 < ntl) ATT_STORE(ka0, ka1, va0, va1, 0);
                    __syncthreads();
                }
            }
#undef ATT_LOAD
#undef ATT_STORE
#undef ATT_COMPUTE
            if (grp == 1) { LAS float* cw = comb + w4 * 33 * 64 + lane;
#pragma unroll
                for (int r = 0; r < 16; ++r) { cw[r * 64] = o0[r]; cw[(16 + r) * 64] = o1[r]; }
                cw[32 * 64] = lsum; }
            __syncthreads();
            if (grp == 0) { const LAS float* cw = comb + w4 * 33 * 64 + lane;
#pragma unroll
                for (int r = 0; r < 16; ++r) { o0[r] += cw[r * 64]; o1[r] += cw[(16 + r) * 64]; }
                lsum += cw[32 * 64]; lsum += __shfl_xor(lsum, 32); const float inv = 1.f / lsum;
                bf16_t* yp = Y + (size_t)qrow * D + 256 + h * 64 + 4 * hi;
#pragma unroll
                for (int g4 = 0; g4 < 4; ++g4) { u32x2 w0, w1;
                    w0.x = cvt_pk_bf16(o0[4 * g4] * inv, o0[4 * g4 + 1] * inv); w0.y = cvt_pk_bf16(o0[4 * g4 + 2] * inv, o0[4 * g4 + 3] * inv);
                    w1.x = cvt_pk_bf16(o1[4 * g4] * inv, o1[4 * g4 + 1] * inv); w1.y = cvt_pk_bf16(o1[4 * g4 + 2] * inv, o1[4 * g4 + 3] * inv);
                    *(u32x2*)(yp + 8 * g4) = w0; *(u32x2*)(yp + 32 + 8 * g4) = w1; } }
            __syncthreads();
        }
    }
}

constexpr size_t WS_KI = 234 * MiB;
template <int J, unsigned MSK>
__device__ __forceinline__ void tr_stage(unsigned (&a)[32]) {
#pragma unroll
    for (int k = 0; k < 32; ++k) if ((k & J) == 0) { const unsigned x = a[k], y = a[k + J]; a[k] = (x & ~MSK) | ((y >> J) & MSK); a[k + J] = (y & ~(MSK << J)) | ((x << J) & (MSK << J)); }
}
__device__ __forceinline__ void transpose32(unsigned (&a)[32]) {
#pragma unroll
    for (int k = 0; k < 16; ++k) { const unsigned x = a[k], y = a[k + 16]; a[k] = __builtin_amdgcn_perm(x, y, 0x07060302u); a[k + 16] = __builtin_amdgcn_perm(x, y, 0x05040100u); }
#pragma unroll
    for (int k = 0; k < 32; ++k) if ((k & 8) == 0) { const unsigned x = a[k], y = a[k + 8]; a[k] = __builtin_amdgcn_perm(x, y, 0x07030501u); a[k + 8] = __builtin_amdgcn_perm(x, y, 0x06020400u); }
    tr_stage<4, 0x0F0F0F0Fu>(a); tr_stage<2, 0x33333333u>(a); tr_stage<1, 0x55555555u>(a);
}
__device__ __forceinline__ int wave_total_i(int v) {
    v += __builtin_amdgcn_update_dpp(0, v, 0x111, 0xf, 0xf, false);
    v += __builtin_amdgcn_update_dpp(0, v, 0x112, 0xf, 0xf, false);
    v += __builtin_amdgcn_update_dpp(0, v, 0x114, 0xf, 0xf, false);
    v += __builtin_amdgcn_update_dpp(0, v, 0x118, 0xf, 0xf, false);
    v += __builtin_amdgcn_update_dpp(0, v, 0x142, 0xa, 0xf, false);
    v += __builtin_amdgcn_update_dpp(0, v, 0x143, 0xc, 0xf, false);
    return __builtin_amdgcn_readlane(v, 63);
}
__device__ __forceinline__ void idx_score(Frame& F, const int b, const int t0, LAS unsigned short* sc16, const int sw, const int prevn) {
    if (t0 + 8 <= 256) return;
    const float* MISC = (const float*)WSP(WS_MISC); const bf16_t* PROJ = (const bf16_t*)WSP(WS_BIG); const bf16_t* KI = (const bf16_t*)WSP(WS_KI);
    const int lane = (F.tid & 63), r32 = lane & 31, hi = lane >> 5, m0 = b * S + t0;
    const int nmax = t0 + 8, ntile = (nmax + 31) >> 5;
    bf16x8 qa[2][4], wsel[2][2];
#pragma unroll
    for (int i = 0; i < 2; ++i) {
        const bf16_t* qp = PROJ + (size_t)(m0 + 4 * i + (r32 >> 3)) * PW + P_QI + (r32 & 7) * 64 + 8 * hi;
#pragma unroll
        for (int s = 0; s < 4; ++s) { qa[i][s] = *(const bf16x8*)(qp + 16 * s); asm volatile("" : "+v"(qa[i][s])); }
    }
    { const int qrow = r32 & 7; const f32x4 w4 = *(const f32x4*)(MISC + (size_t)(m0 + qrow) * 16 + 4 * hi);
      const float sc_ = 0.125f * 0.35355339059327373f; const unsigned p01 = cvt_pk_bf16(w4[0] * sc_, w4[1] * sc_), p23 = cvt_pk_bf16(w4[2] * sc_, w4[3] * sc_);
#pragma unroll
      for (int i = 0; i < 2; ++i)
#pragma unroll
          for (int s = 0; s < 2; ++s) { const bool mine = (r32 < 8) && ((qrow >> 2) == i) && (((qrow & 3) >> 1) == s); const bool upper = (qrow & 1) != 0;
              u32x4 f; f.x = (mine && !upper) ? p01 : 0u; f.y = (mine && !upper) ? p23 : 0u; f.z = (mine && upper) ? p01 : 0u; f.w = (mine && upper) ? p23 : 0u;
              asm volatile("" : "+v"(f));
              wsel[i][s] = __builtin_bit_cast(bf16x8, f); } }
    bf16x8 kring[2][4];
    const bf16_t* kbase_ = KI + ((size_t)(b * S >> 5) * 4 * 64 + lane) * 8;
#define IDX_LOADK(u_, j_) do { const int jt_ = (j_) < ntile ? (j_) : ntile - 1; const bf16_t* kp_ = kbase_ + (unsigned)jt_ * 2048u; \
    _Pragma("unroll") for (int s_ = 0; s_ < 4; ++s_) kring[u_][s_] = *(const bf16x8*)(kp_ + s_ * 64 * 8); } while (0)
#pragma unroll
    for (int u = 0; u < 2; ++u) IDX_LOADK(u, sw + 4 * u);
    f32x16 dd[2][2];
#define IDX_DSTEP(slot_, par_, s_) do { _Pragma("unroll") for (int i_ = 0; i_ < 2; ++i_) dd[par_][i_] = __builtin_amdgcn_mfma_f32_32x32x16_bf16(qa[i_][s_], kring[slot_][s_], dd[par_][i_], 0, 0, 0); } while (0)
#define IDX_WSTEP(par_, i_, s_) do { u32x4 rw_; const f32x16& d_ = dd[par_][i_]; \
        rw_.x = cvt_pk_bf16(relu_f(d_[8 * (s_) + 0]), relu_f(d_[8 * (s_) + 1])); rw_.y = cvt_pk_bf16(relu_f(d_[8 * (s_) + 2]), relu_f(d_[8 * (s_) + 3])); \
        rw_.z = cvt_pk_bf16(relu_f(d_[8 * (s_) + 4]), relu_f(d_[8 * (s_) + 5])); rw_.w = cvt_pk_bf16(relu_f(d_[8 * (s_) + 6]), relu_f(d_[8 * (s_) + 7])); \
        outv = __builtin_amdgcn_mfma_f32_32x32x16_bf16(wsel[i_][s_], __builtin_bit_cast(bf16x8, rw_), outv, 0, 0, 0); } while (0)
#pragma unroll
    for (int i = 0; i < 2; ++i)
#pragma unroll
        for (int r = 0; r < 16; ++r) dd[0][i][r] = 0.f;
#pragma unroll
    for (int s = 0; s < 4; ++s) IDX_DSTEP(0, 0, s);
    __builtin_amdgcn_sched_barrier(0);
    IDX_LOADK(0, sw + 8);
    __builtin_amdgcn_sched_barrier(0);
    asm volatile(".p2align 8");
    for (int jb = sw; jb < ntile; jb += 8) {
#pragma unroll
        for (int u = 0; u < 2; ++u) {
            const int j = jb + 4 * u;
            const int key = 32 * j + r32;
            f32x16 outv;
#pragma unroll
            for (int r = 0; r < 16; ++r) { outv[r] = 0.f; dd[(u + 1) & 1][0][r] = 0.f; dd[(u + 1) & 1][1][r] = 0.f; }
            IDX_DSTEP((u + 1) & 1, (u + 1) & 1, 0); IDX_WSTEP(u & 1, 0, 0);
            IDX_DSTEP((u + 1) & 1, (u + 1) & 1, 1); IDX_WSTEP(u & 1, 0, 1);
            IDX_DSTEP((u + 1) & 1, (u + 1) & 1, 2); IDX_WSTEP(u & 1, 1, 0);
            IDX_DSTEP((u + 1) & 1, (u + 1) & 1, 3); IDX_WSTEP(u & 1, 1, 1);
            __builtin_amdgcn_sched_barrier(0);
            IDX_LOADK((u + 1) & 1, j + 4 + 8);
            __builtin_amdgcn_sched_barrier(0);
            if (j < ntile) {
                const int kpos = ((key & 2047) << 1) + (key >> 11);
#pragma unroll
                for (int qq = 0; qq < 4; ++qq) { const int qx = 4 * hi + qq;
                    sc16[qx * 4096 + kpos] = __builtin_bit_cast(unsigned short, (_Float16)((key <= t0 + qx) ? outv[qq] : -INFINITY)); }
            }
        }
    }
#undef IDX_DSTEP
#undef IDX_WSTEP
    for (int j = ntile + ((sw - ntile) & 3); j < prevn; j += 4) {
        const int key = 32 * j + r32, kpos = ((key & 2047) << 1) + (key >> 11);
#pragma unroll
        for (int qq = 0; qq < 4; ++qq) sc16[(4 * hi + qq) * 4096 + kpos] = (unsigned short)0xFC00u;
    }
#undef IDX_LOADK
}
#define IDX_WL2(lo_, hi_, bal_, lane_) asm("s_nop 1\n\tv_writelane_b32 %0, %2, %4\n\tv_writelane_b32 %1, %3, %4" : "+v"(lo_), "+v"(hi_) : "s"((unsigned)(bal_)), "s"((unsigned)((bal_) >> 32)), "n"(lane_))
__device__ __forceinline__ void idx_select(Frame& F, const int b, const int t0, const LAS unsigned short* sc16, const int qw) {
    unsigned long long* MASKT = (unsigned long long*)WSP(WS_MASK);
    const int lane = (F.tid & 63);
#pragma unroll 1
    for (int qi = 0; qi < 2; ++qi) {
        const int qx = qw + 4 * qi, tq = t0 + qx;
        unsigned long long myword = 0ull;
        if (t0 + 8 <= 256) {
            const int lo = 64 * lane; myword = (tq >= lo + 63) ? ~0ull : (tq < lo ? 0ull : ((2ull << (tq - lo)) - 1ull));
            MASKT[(size_t)(b * 64 + lane) * S + tq] = myword;
            continue;
        }
        const int nmax = t0 + 8, ntile = (nmax + 31) >> 5;
        const int nvalid = 32 * ntile; const LAS unsigned* srow = (const LAS unsigned*)sc16 + qx * 2048 + lane;
        unsigned kk[32], kc[32];
#pragma unroll
        for (int r = 0; r < 32; ++r) { const unsigned w = srow[64 * r]; const unsigned sg = (w & 0x80008000u) >> 15; kc[r] = w ^ (((sg << 16) - sg) | 0x80008000u); kk[r] = kc[r]; }
        transpose32(kk);
        unsigned aA = ~0u, aB = ~0u, Tk = 0u; int base = 0;
#pragma unroll
        for (int bit = 15; bit >= 0; --bit) {
            const unsigned wa = kk[31 - bit], wb = kk[15 - bit];
            const int tot = wave_total_i(__builtin_popcount(wa & aA) + __builtin_popcount(wb & aB));
            const bool take = (base + tot >= 256);
            const unsigned flip = take ? 0u : ~0u;
            aA &= (wa ^ flip); aB &= (wb ^ flip);
            if (take) Tk |= (1u << bit); else base += tot;
        }
        const int ngt = base, neq = wave_total_i(__builtin_popcount(aA) + __builtin_popcount(aB));
        unsigned mlo = 0u, mhi = 0u;
        if (ngt + neq == 256) {
#pragma unroll
            for (int r = 0; r < 32; ++r) { const unsigned long long wlo = __ballot((kc[r] & 0xFFFFu) >= Tk); IDX_WL2(mlo, mhi, wlo, r); }
            if (nvalid > 2048) {
#pragma unroll
                for (int r = 0; r < 32; ++r) { const unsigned long long whi = __ballot((kc[r] >> 16) >= Tk); IDX_WL2(mlo, mhi, whi, 32 + r); } }
        } else {
            int need = 256 - ngt;
#pragma unroll
            for (int hf = 0; hf < 2; ++hf) if (hf == 0 || nvalid > 2048)
#pragma unroll
                for (int r = 0; r < 32; ++r) { const unsigned k = hf ? (kc[r] >> 16) : (kc[r] & 0xFFFFu);
                    unsigned long long wsel = __ballot(k > Tk), em = __ballot(k == Tk); int c = __builtin_popcountll(em);
                    if (c > need) { while (c > need) { em &= ~(1ull << (63 - __builtin_clzll(em))); --c; } }
                    need -= c; wsel |= em;
                    IDX_WL2(mlo, mhi, wsel, 32 * hf + r); }
        }
        myword = ((unsigned long long)mhi << 32) | mlo;
        MASKT[(size_t)(b * 64 + lane) * S + tq] = myword;
    }
}
__device__ __forceinline__ void indexer_mfma(Frame& F) {
    const int wv = F.wave;
    const int npi = (1024 - F.vcu + F.G - 1) / F.G, n = 2 * npi;
#define IDX_UNIT(idx_, b_, t0_) const int pi_##b_ = F.vcu + ((idx_) < npi ? (idx_) : (idx_) - npi) * F.G; const int b_ = pi_##b_ >> 8; const int t0_ = 8 * ((idx_) < npi ? 511 - (pi_##b_ & 255) : (pi_##b_ & 255))
    int prevn0 = 128, prevn1 = 128;
#define IDX_NT(t0_) (((t0_) + 8 <= 256) ? -1 : (((t0_) + 8 + 31) >> 5))
    { IDX_UNIT(0, b0, t00); if (wv < 4) idx_score(F, b0, t00, (LAS unsigned short*)F.lds, wv, prevn0); const int nt_ = IDX_NT(t00); if (nt_ >= 0) prevn0 = nt_; }
    __syncthreads();
#pragma unroll 1
    for (int u = 0; u < n; ++u) {
        if (u + 1 < n) { IDX_UNIT(u + 1, b1, t01); const int pv = ((u + 1) & 1) ? prevn1 : prevn0;
            if (wv < 4) idx_score(F, b1, t01, (LAS unsigned short*)(F.lds + ((u + 1) & 1) * 65536), wv, pv);
            const int nt_ = IDX_NT(t01); if (nt_ >= 0) { if ((u + 1) & 1) prevn1 = nt_; else prevn0 = nt_; } }
        if (wv >= 4) { IDX_UNIT(u, b2, t02); idx_select(F, b2, t02, (const LAS unsigned short*)(F.lds + (u & 1) * 65536), wv - 4); }
        __syncthreads();
    }
#undef IDX_NT
#undef IDX_UNIT
}

constexpr size_t WS_CVT = 236 * MiB;
__device__ __forceinline__ void mlstm2_mfma(Frame& F, int l) {
    const float* MISC = (const float*)WSP(WS_MISC); const float* STATE = (const float*)WSP(WS_STATE); const bf16_t* PROJ = (const bf16_t*)WSP(WS_BIG); const bf16_t* CVT = (const bf16_t*)WSP(WS_CVT);
    bf16_t* Y = (bf16_t*)WSP(WS_Y); const float* i_bias = INP(I_I_BIAS); const float* f_bias = INP(I_F_BIAS); const float* mnorm = INP(I_MNORM);
    const int lane = (F.tid & 63), r32 = lane & 31, hi = lane >> 5, grp = F.wave >> 2, w4 = F.wave & 3, lg = F.tid & 255;
    constexpr int KROWB = 144, VROWB = 272, GB = 49152;
    LAS unsigned char* gb = F.lds + grp * GB;
    LAS float* bc = (LAS float*)gb;
    LAS float* gs = bc + 128;
    LAS float* npv = gs + 128;
    LAS float* wsum = npv + 64;
    LAS unsigned char* ct = gb + 2048;
    LAS unsigned char* kt = ct + 9216;
    LAS unsigned char* vt = kt + 18432;
    for (int it0 = 2 * F.vcu; it0 < 512; it0 += 2 * F.G) {
        const int item = it0 + grp, bh = item >> 5, c = item & 31, b = bh >> 2, h = bh & 3, m0 = b * S + c * 128;
        if (lg < 128) { const float f = MISC[(size_t)(m0 + lg) * 16 + 12 + h] + f_bias[l * 4 + h]; bc[lg] = fminf(f, 0.f) - log1pf(__expf(-fabsf(f))); gs[lg] = MISC[(size_t)(m0 + lg) * 16 + 8 + h] + i_bias[l * 4 + h]; }
        if (lg >= 128 && lg < 160) { const int cc = lg - 128; wsum[cc] = (cc < c) ? STATE[(size_t)(bh * 32 + cc) * STATE_STRIDE + 4160] : 0.f; }
        __syncthreads();
        if (lg < 64) {
            float a0 = bc[2 * lane], a1 = bc[2 * lane + 1]; float s = a0 + a1;
#pragma unroll
            for (int o = 1; o < 64; o <<= 1) { const float t = __shfl_up(s, o); if (lane >= o) s += t; }
            const float ex = s - (a0 + a1); const float i0 = gs[2 * lane], i1 = gs[2 * lane + 1];
            bc[2 * lane] = ex + a0; bc[2 * lane + 1] = s; gs[2 * lane] = i0 - (ex + a0); gs[2 * lane + 1] = i1 - s;
            float w = (lane < 32) ? wsum[lane] : 0.f; float suf = w;
#pragma unroll
            for (int o = 1; o < 32; o <<= 1) { const float t = __shfl_down(suf, o); if (lane + o < 32) suf += t; }
            if (lane < 32) wsum[lane] = suf - w;
        }
        __syncthreads();
        { f32x4 a4[4]; float nv = 0.f;
#pragma unroll
          for (int k = 0; k < 4; ++k) a4[k] = (f32x4){0.f, 0.f, 0.f, 0.f};
          for (int cc = 0; cc < c; ++cc) { const float* st = STATE + (size_t)(bh * 32 + cc) * STATE_STRIDE; const float wgt = __expf(wsum[cc]);
#pragma unroll
              for (int k = 0; k < 4; ++k) { const f32x4 v = *(const f32x4*)(st + 4 * (lg + 256 * k)); a4[k] = a4[k] + v * wgt; }
              if (lg < 64) nv = fmaf(wgt, st[4096 + lg], nv); }
#pragma unroll
          for (int k = 0; k < 4; ++k) { const int idx = 4 * (lg + 256 * k), e = idx >> 6, d = idx & 63; u32x2 w; w.x = cvt_pk_bf16(a4[k][0], a4[k][1]); w.y = cvt_pk_bf16(a4[k][2], a4[k][3]); *(LAS u32x2*)(ct + e * KROWB + d * 2) = w; }
          if (lg < 64) npv[lg] = nv; }
#pragma unroll
        for (int k = 0; k < 4; ++k) { const int id = lg + 256 * k, row = id >> 3, ch = id & 7;
            *(LAS u32x4*)(kt + row * KROWB + ch * 16) = *(const u32x4*)(PROJ + (size_t)(m0 + row) * PW + P_CK + h * 64 + ch * 8);
            const int vrow = id >> 4, vch = id & 15;
            *(LAS u32x4*)(vt + vrow * VROWB + vch * 16) = *(const u32x4*)(CVT + (size_t)(b * 256 + h * 64 + vrow) * S + c * 128 + vch * 8); }
        __syncthreads();
        const int j = 32 * w4 + r32, qrow = m0 + j;
        bf16x8 qf[4];
#pragma unroll
        for (int s = 0; s < 4; ++s) qf[s] = *(const bf16x8*)(PROJ + (size_t)qrow * PW + P_CQ + h * 64 + 16 * s + 8 * hi);
        const float bj = bc[j], eb = __expf(bj);
        float qn = 0.f;
#pragma unroll
        for (int s = 0; s < 4; ++s) { const u32x4 w = __builtin_bit_cast(u32x4, qf[s]); const LAS float* np = npv + 16 * s + 8 * hi;
            qn += lo_bf(w.x) * np[0] + hi_bf(w.x) * np[1] + lo_bf(w.y) * np[2] + hi_bf(w.y) * np[3] + lo_bf(w.z) * np[4] + hi_bf(w.z) * np[5] + lo_bf(w.w) * np[6] + hi_bf(w.w) * np[7]; }
        qn += __shfl_xor(qn, 32); qn *= eb;
        f32x16 n0, n1;
#pragma unroll
        for (int r = 0; r < 16; ++r) { n0[r] = 0.f; n1[r] = 0.f; }
#pragma unroll
        for (int ks = 0; ks < 4; ++ks) { const bf16x8 c0 = *(const LAS bf16x8*)(ct + r32 * KROWB + 32 * ks + 16 * hi), c1 = *(const LAS bf16x8*)(ct + (32 + r32) * KROWB + 32 * ks + 16 * hi);
            n0 = __builtin_amdgcn_mfma_f32_32x32x16_bf16(c0, qf[ks], n0, 0, 0, 0); n1 = __builtin_amdgcn_mfma_f32_32x32x16_bf16(c1, qf[ks], n1, 0, 0, 0); }
#pragma unroll
        for (int r = 0; r < 16; ++r) { n0[r] *= eb; n1[r] *= eb; }
        float sa = 0.f;
#pragma unroll 1
        for (int st = 0; st <= w4; ++st) {
            f32x16 p;
#pragma unroll
            for (int r = 0; r < 16; ++r) p[r] = 0.f;
#pragma unroll
            for (int ks = 0; ks < 4; ++ks) { const bf16x8 kf = *(const LAS bf16x8*)(kt + (32 * st + r32) * KROWB + 32 * ks + 16 * hi); p = __builtin_amdgcn_mfma_f32_32x32x16_bf16(kf, qf[ks], p, 0, 0, 0); }
#pragma unroll
            for (int r = 0; r < 16; ++r) { const int s = 32 * st + (r & 3) + 8 * (r >> 2) + 4 * hi; const float a = (s <= j) ? __expf(bj + gs[s]) * p[r] : 0.f; p[r] = a; sa += a; }
#pragma unroll
            for (int k2 = 0; k2 < 2; ++k2) {
                u32x4 pw; pw.x = cvt_pk_bf16(p[8 * k2 + 0], p[8 * k2 + 1]); pw.y = cvt_pk_bf16(p[8 * k2 + 2], p[8 * k2 + 3]); pw.z = cvt_pk_bf16(p[8 * k2 + 4], p[8 * k2 + 5]); pw.w = cvt_pk_bf16(p[8 * k2 + 6], p[8 * k2 + 7]);
                const bf16x8 pf = __builtin_bit_cast(bf16x8, pw);
                const int vo = (32 * st + 16 * k2 + 4 * hi) * 2;
                const u32x2 a0 = *(const LAS u32x2*)(vt + r32 * VROWB + vo), a1 = *(const LAS u32x2*)(vt + r32 * VROWB + vo + 16);
                const u32x2 b0 = *(const LAS u32x2*)(vt + (32 + r32) * VROWB + vo), b1 = *(const LAS u32x2*)(vt + (32 + r32) * VROWB + vo + 16);
                const u32x4 va = {a0.x, a0.y, a1.x, a1.y}, vb4 = {b0.x, b0.y, b1.x, b1.y};
                n0 = __builtin_amdgcn_mfma_f32_32x32x16_bf16(__builtin_bit_cast(bf16x8, va), pf, n0, 0, 0, 0);
                n1 = __builtin_amdgcn_mfma_f32_32x32x16_bf16(__builtin_bit_cast(bf16x8, vb4), pf, n1, 0, 0, 0);
            }
        }
        sa += __shfl_xor(sa, 32);
        const float inv = 1.f / fmaxf(fabsf(qn + sa), 1.f);
        float ss = 0.f;
#pragma unroll
        for (int r = 0; r < 16; ++r) { n0[r] *= inv; n1[r] *= inv; ss += n0[r] * n0[r] + n1[r] * n1[r]; }
        ss += __shfl_xor(ss, 32); const float rr = rsqrtf(ss * (1.f / 64.f) + EPS);
        const float* gp = mnorm + l * 256 + h * 64 + 4 * hi; const bf16_t* op = PROJ + (size_t)qrow * PW + P_CO + h * 64 + 4 * hi; bf16_t* yp = Y + (size_t)qrow * D + 512 + h * 64 + 4 * hi;
#pragma unroll
        for (int g4 = 0; g4 < 4; ++g4) {
            const f32x4 ga = *(const f32x4*)(gp + 8 * g4), gb4 = *(const f32x4*)(gp + 32 + 8 * g4);
            const u32x2 oa = *(const u32x2*)(op + 8 * g4), ob = *(const u32x2*)(op + 32 + 8 * g4);
            u32x2 w0, w1;
            w0.x = cvt_pk_bf16(sigmoid_f(lo_bf(oa.x)) * n0[4 * g4] * rr * ga[0], sigmoid_f(hi_bf(oa.x)) * n0[4 * g4 + 1] * rr * ga[1]);
            w0.y = cvt_pk_bf16(sigmoid_f(lo_bf(oa.y)) * n0[4 * g4 + 2] * rr * ga[2], sigmoid_f(hi_bf(oa.y)) * n0[4 * g4 + 3] * rr * ga[3]);
            w1.x = cvt_pk_bf16(sigmoid_f(lo_bf(ob.x)) * n1[4 * g4] * rr * gb4[0], sigmoid_f(hi_bf(ob.x)) * n1[4 * g4 + 1] * rr * gb4[1]);
            w1.y = cvt_pk_bf16(sigmoid_f(lo_bf(ob.y)) * n1[4 * g4 + 2] * rr * gb4[2], sigmoid_f(hi_bf(ob.y)) * n1[4 * g4 + 3] * rr * gb4[3]);
            *(u32x2*)(yp + 8 * g4) = w0; *(u32x2*)(yp + 32 + 8 * g4) = w1;
        }
        __syncthreads();
    }
}

constexpr size_t WS_SSQV = 244 * MiB;
__device__ __forceinline__ void sgu_mfma(Frame& F, int l) {
    const bf16_t* PROJ = (const bf16_t*)WSP(WS_BIG); bf16_t* Y = (bf16_t*)WSP(WS_Y); const float* SSQV = (const float*)WSP(WS_SSQV);
    const float* gain = INP(I_SGU_NORM) + l * 256; const float* sw = INP(I_SGU_W) + (size_t)l * 4 * 128 * 128; const float* sb = INP(I_SGU_B) + l * 4 * 128;
    const int lane = (F.tid & 63), r32 = lane & 31, hi = lane >> 5, dt = F.wave & 1, tt = F.wave >> 1;
    constexpr int VROWB = 272;
    LAS float* r_s = (LAS float*)F.lds;
    LAS unsigned char* vt = F.lds + 512;
    for (int item = F.vcu; item < 512; item += F.G) {
        const int g = item & 3, m0 = (item >> 2) * 128;
        if (F.tid < 128) { const f32x4 q = *(const f32x4*)(SSQV + (size_t)(m0 + F.tid) * 4); r_s[F.tid] = rsqrtf(((q[0] + q[1]) + (q[2] + q[3])) * (1.f / 256.f) + EPS); }
        __syncthreads();
#pragma unroll
        for (int k = 0; k < 2; ++k) { const int id = F.tid + 512 * k, s = id >> 3, d0 = (id & 7) * 8; const float rs = r_s[s];
            const u32x4 w = *(const u32x4*)(PROJ + (size_t)(m0 + s) * PW + P_AV + g * 64 + d0);
            const float v[8] = {lo_bf(w.x), hi_bf(w.x), lo_bf(w.y), hi_bf(w.y), lo_bf(w.z), hi_bf(w.z), lo_bf(w.w), hi_bf(w.w)};
#pragma unroll
            for (int i = 0; i < 8; ++i) *(LAS bf16_t*)(vt + (d0 + i) * VROWB + s * 2) = (bf16_t)f2bf(v[i] * rs); }
        __syncthreads();
        f32x16 acc;
#pragma unroll
        for (int r = 0; r < 16; ++r) acc[r] = 0.f;
        const int t = 32 * tt + r32; const float* wrow = sw + ((size_t)g * 128 + t) * 128;
#pragma unroll 1
        for (int ks = 0; ks < 2 * (tt + 1); ++ks) {
            const bf16x8 af = *(const LAS bf16x8*)(vt + (32 * dt + r32) * VROWB + (16 * ks + 8 * hi) * 2);
            const int s0 = 16 * ks + 8 * hi; const f32x4 w0 = *(const f32x4*)(wrow + s0), w1 = *(const f32x4*)(wrow + s0 + 4);
            u32x4 bw; bw.x = cvt_pk_bf16(s0 + 0 <= t ? w0[0] : 0.f, s0 + 1 <= t ? w0[1] : 0.f); bw.y = cvt_pk_bf16(s0 + 2 <= t ? w0[2] : 0.f, s0 + 3 <= t ? w0[3] : 0.f);
            bw.z = cvt_pk_bf16(s0 + 4 <= t ? w1[0] : 0.f, s0 + 5 <= t ? w1[1] : 0.f); bw.w = cvt_pk_bf16(s0 + 6 <= t ? w1[2] : 0.f, s0 + 7 <= t ? w1[3] : 0.f);
            acc = __builtin_amdgcn_mfma_f32_32x32x16_bf16(af, __builtin_bit_cast(bf16x8, bw), acc, 0, 0, 0);
        }
        const float bias = sb[g * 128 + t]; const size_t row = (size_t)(m0 + t);
        const float* gp = gain + g * 64 + 32 * dt + 4 * hi; const bf16_t* up = PROJ + row * PW + P_AU + g * 64 + 32 * dt + 4 * hi; bf16_t* yp = Y + row * D + g * 64 + 32 * dt + 4 * hi;
#pragma unroll
        for (int g4 = 0; g4 < 4; ++g4) { const f32x4 gv = *(const f32x4*)(gp + 8 * g4); const u32x2 uw = *(const u32x2*)(up + 8 * g4); u32x2 ow;
            ow.x = cvt_pk_bf16(lo_bf(uw.x) * (gv[0] * acc[4 * g4] + bias), hi_bf(uw.x) * (gv[1] * acc[4 * g4 + 1] + bias));
            ow.y = cvt_pk_bf16(lo_bf(uw.y) * (gv[2] * acc[4 * g4 + 2] + bias), hi_bf(uw.y) * (gv[3] * acc[4 * g4 + 3] + bias));
            *(u32x2*)(yp + 8 * g4) = ow; }
        __syncthreads();
    }
}

__device__ __forceinline__ void mlstm1_mfma(Frame& F, int l) {
    const float* MISC = (const float*)WSP(WS_MISC); float* STATE = (float*)WSP(WS_STATE); const bf16_t* PROJ = (const bf16_t*)WSP(WS_BIG); const bf16_t* CVT = (const bf16_t*)WSP(WS_CVT);
    const float* i_bias = INP(I_I_BIAS); const float* f_bias = INP(I_F_BIAS);
    const int lane = (F.tid & 63), r32 = lane & 31, hi = lane >> 5, grp = F.wave >> 2, w4 = F.wave & 3, et = w4 & 1, dt = w4 >> 1, lg = F.tid & 255;
    constexpr int KROWB = 144, GB = 20480;
    LAS unsigned char* gb = F.lds + grp * GB;
    LAS float* bc = (LAS float*)gb; LAS float* wk = bc + 128; LAS unsigned char* kt = gb + 1024;
    for (int it0 = 2 * F.vcu; it0 < 512; it0 += 2 * F.G) {
        const int item = it0 + grp, bh = item >> 5, c = item & 31, b = bh >> 2, h = bh & 3, m0 = b * S + c * 128;
        if (lg < 128) { const float f = MISC[(size_t)(m0 + lg) * 16 + 12 + h] + f_bias[l * 4 + h]; bc[lg] = fminf(f, 0.f) - log1pf(__expf(-fabsf(f))); wk[lg] = MISC[(size_t)(m0 + lg) * 16 + 8 + h] + i_bias[l * 4 + h]; }
        __syncthreads();
        if (lg < 64) { const float a0 = bc[2 * lane], a1 = bc[2 * lane + 1]; float s = a0 + a1;
#pragma unroll
            for (int o = 1; o < 64; o <<= 1) { const float t = __shfl_up(s, o); if (lane >= o) s += t; }
            const float tot = __shfl(s, 63), ex = s - (a0 + a1);
            wk[2 * lane] = __expf(tot - (ex + a0) + wk[2 * lane]); wk[2 * lane + 1] = __expf(tot - s + wk[2 * lane + 1]);
            if (lane == 0) bc[0] = tot; }
        __syncthreads();
        const float Bc = bc[0];
#pragma unroll
        for (int k = 0; k < 4; ++k) { const int id = lg + 256 * k, s = id >> 3, ch = id & 7; const float ws_ = wk[s];
            const u32x4 w = *(const u32x4*)(PROJ + (size_t)(m0 + s) * PW + P_CK + h * 64 + ch * 8); u32x4 o;
            o.x = cvt_pk_bf16(lo_bf(w.x) * ws_, hi_bf(w.x) * ws_); o.y = cvt_pk_bf16(lo_bf(w.y) * ws_, hi_bf(w.y) * ws_); o.z = cvt_pk_bf16(lo_bf(w.z) * ws_, hi_bf(w.z) * ws_); o.w = cvt_pk_bf16(lo_bf(w.w) * ws_, hi_bf(w.w) * ws_);
            *(LAS u32x4*)(kt + s * KROWB + ch * 16) = o; }
        __syncthreads();
        f32x16 acc;
#pragma unroll
        for (int r = 0; r < 16; ++r) acc[r] = 0.f;
        float nsum = 0.f;
        const bf16_t* vp = CVT + (size_t)(b * 256 + h * 64 + 32 * et + r32) * S + c * 128 + 8 * hi;
        bf16x8 af[8];
#pragma unroll
        for (int ks = 0; ks < 8; ++ks) af[ks] = *(const bf16x8*)(vp + 16 * ks);
#pragma unroll
        for (int ks = 0; ks < 8; ++ks) {
            const LAS unsigned char* kp = kt + (16 * ks + 8 * hi) * KROWB + (32 * dt + r32) * 2; unsigned e8[8];
#pragma unroll
            for (int jj = 0; jj < 8; ++jj) e8[jj] = *(const LAS bf16_t*)(kp + jj * KROWB);
            u32x4 bw; bw.x = e8[0] | (e8[1] << 16); bw.y = e8[2] | (e8[3] << 16); bw.z = e8[4] | (e8[5] << 16); bw.w = e8[6] | (e8[7] << 16);
#pragma unroll
            for (int jj = 0; jj < 8; ++jj) nsum += __uint_as_float(e8[jj] << 16);
            acc = __builtin_amdgcn_mfma_f32_32x32x16_bf16(af[ks], __builtin_bit_cast(bf16x8, bw), acc, 0, 0, 0);
        }
        float* st = STATE + (size_t)item * STATE_STRIDE;
#pragma unroll
        for (int r = 0; r < 16; ++r) st[(32 * et + (r & 3) + 8 * (r >> 2) + 4 * hi) * 64 + 32 * dt + r32] = acc[r];
        nsum += __shfl_xor(nsum, 32);
        if (et == 0 && hi == 0) st[4096 + 32 * dt + r32] = nsum;
        if (lg == 0) st[4160] = Bc;
        __syncthreads();
    }
}
#ifndef MK_MULTI
#define MK_MULTI 0
#endif
constexpr int N_PHASES = 1 + 10 * DEPTH;

__global__ void __launch_bounds__(NT, 2) mk_fwd(Args args) {
    extern __shared__ __attribute__((aligned(16))) unsigned char lds_raw[];
    Frame F;
    F.lds = (LAS unsigned char*)lds_raw; F.tid = threadIdx.x; F.wave = __builtin_amdgcn_readfirstlane(F.tid >> 6);
    F.G = gridDim.x; { const int bx_ = blockIdx.x; F.vcu = (F.G % 8 == 0) ? (bx_ % 8) * (F.G / 8) + bx_ / 8 : bx_; }
    if (F.tid < 20) { const unsigned long long pv = F.tid < 18 ? (unsigned long long)args.in[F.tid < 18 ? F.tid : 0] : (F.tid == 18 ? (unsigned long long)args.out : (unsigned long long)args.ws);
        *(LAS unsigned long long*)(F.lds + PTR_OFF + 8 * F.tid) = pv; }
    if (F.tid < 2) *(LAS unsigned*)(F.lds + PTR_OFF + 256 + 4 * F.tid) = 0u;
    __syncthreads();
#if MK_MULTI
    int bx = (int)blockIdx.x;
    const int lo = args.ph_lo, hi = args.ph_hi; const bool coop = args.coop != 0;
#else
    int bx = (int)blockIdx.x;
    constexpr int lo = 0, hi = N_PHASES - 1; constexpr bool coop = true;
    if (F.tid == 0) (void)xb_add(&((unsigned*)(args.ws + WS_BAR))[XB_XCNT(xb_xcc_id())], 1u);
#endif
#define XBAR_NOW() XcdBarrier{(unsigned*)WSP(WS_BAR), xb_xcc_id(), (volatile LAS unsigned*)(F.lds + PTR_OFF + 256)}
#define RUN(k) (lo <= (k) && (k) < hi)
#define LAUNDER() asm volatile("" : "+v"(F.tid), "+s"(F.G), "+s"(F.vcu), "+s"(F.wave), "+s"(bx), "+s"(F.lds))
#ifndef MK_SKEW_SLEEP
#define MK_SKEW_SLEEP 0
#endif
#define SKEW() do { if (coop) { for (unsigned s_ = ((unsigned)blockIdx.x >> 3) & 3u; s_ > 0; --s_) __builtin_amdgcn_s_sleep(MK_SKEW_SLEEP); } } while (0)
#ifdef MK_PROBE_BAR2
#define SEAM(k) do { if (coop && RUN(k) && RUN((k) + 1)) { { const XcdBarrier xb_ = XBAR_NOW(); xcd_barrier(xb_); } { const XcdBarrier xb_ = XBAR_NOW(); xcd_barrier(xb_); } } } while (0)
#else
#define SEAM(k) do { if (coop && RUN(k) && RUN((k) + 1)) { const XcdBarrier xb_ = XBAR_NOW(); xcd_barrier(xb_); } } while (0)
#endif

    if (args.pad == 0x5a5a5a5a) cg::this_grid().sync();
    if (RUN(0)) { LAUNDER(); convert_mix_weights(F, 0); prologue_rows(F);
        if (blockIdx.x == 0 && F.tid < DEPTH * 192) { const int l_ = F.tid / 192, r_ = F.tid % 192, w_ = r_ / 64, i_ = r_ % 64; ((float*)WSP(WS_GT))[F.tid] = INP(I_Q_NORM + w_)[l_ * 64 + i_]; } }
    SEAM(0);
#pragma unroll 1
    for (int l = 0; l < DEPTH; ++l) {
        const int pb = 1 + 10 * l;
        if (RUN(pb + 0)) { LAUNDER(); SKEW();
            pg8::Gemm<D, D, D, 256u * D * 2, 0, 256u * D * 2, 0> g{(const bf16_t*)WSP(WS_XG), (const bf16_t*)WSP(WS_WIN)};
            pg8::StaticOrder So; So.init(M, PW, F.G, bx);
            epi::EpiProj E{(bf16_t*)WSP(WS_BIG), (float*)WSP(WS_MISC), (const float*)WSP(WS_RSA), (const float*)WSP(WS_COS), (const float*)WSP(WS_SIN), (const float*)WSP(WS_GT) + l * 192, (bf16_t*)WSP(WS_VT), (bf16_t*)WSP(WS_KI), (bf16_t*)WSP(WS_CVT), (float*)WSP(WS_SSQV)};
            pg8::gemm_phase<epi::EpiProj, pg8::StaticOrder, true>(F.lds, g, So, E, F.tid);
        }
        SEAM(pb + 0);
        if (RUN(pb + 1)) { LAUNDER(); sgu_mfma(F, l); conv_simple(F, l); indexer_mfma(F); mlstm1_mfma(F, l); }
        SEAM(pb + 1);
        if (RUN(pb + 2)) { LAUNDER(); attn_mfma(F, l); mlstm2_mfma(F, l); }
        SEAM(pb + 2);
        if (RUN(pb + 3)) { LAUNDER(); SKEW();
            pg8::Gemm<256, D, 256, 256u * D * 2, 256u * 2, 256u * 256 * 2, 1024u * 256 * 2> g{(const bf16_t*)WSP(WS_Y), (const bf16_t*)WSP(WS_WBR)};
            pg8::SuperOrder<0> So; So.init(F.G, bx);
            epi::EpiPlain E{(bf16_t*)WSP(WS_BIG), 4096, 1024};
            pg8::gemm_phase<epi::EpiPlain, pg8::SuperOrder<0>, true>(F.lds, g, So, E, F.tid);
        }
        if (coop && RUN(pb + 3) && RUN(pb + 4)) { asm volatile("s_waitcnt vmcnt(0)" ::: "memory"); __syncthreads(); __builtin_amdgcn_fence(__ATOMIC_ACQUIRE, "agent"); asm volatile("s_waitcnt vmcnt(0)" ::: "memory"); __syncthreads(); }
        if (RUN(pb + 4)) { LAUNDER();
            pg8::Gemm<D, D, D, 256u * D, 0, 256u * D, 0, 1> g{ptr_at(F, I_OUT) + OUT_X8, ptr_at(F, I_OUT) + OUT_WG8 + (size_t)l * 4 * MiB};
            pg8::SuperOrder<1> So; So.init(F.G, bx);
            epi::EpiGate E{(bf16_t*)WSP(WS_MG), (const bf16_t*)WSP(WS_BIG), (const float*)WSP(WS_RSA)};
            pg8::gemm_phase<epi::EpiGate, pg8::SuperOrder<1>, true>(F.lds, g, So, E, F.tid);
        }
        SEAM(pb + 4);
        if (RUN(pb + 5)) { LAUNDER();
            pg8::Gemm<D, D, D, 256u * D * 2, 0, 256u * D * 2, 0> g{(const bf16_t*)WSP(WS_MG), (const bf16_t*)WSP(WS_WOUT)};
            pg8::StaticOrder So; So.init(M, D, F.G, bx);
            epi::EpiResid E{l == 0 ? INP(I_X) : nullptr, (bf16_t*)WSP(WS_XG), nullptr, (float*)WSP(WS_SSQB), nullptr};
            pg8::gemm_phase<epi::EpiResid, pg8::StaticOrder, true>(F.lds, g, So, E, F.tid);
            __syncthreads();
            convert_mlp_weights(F, l);
        }
        SEAM(pb + 5);
        if (RUN(pb + 6)) { LAUNDER(); finalize_rs(F, WS_SSQB, WS_RSB); }
        SEAM(pb + 6);
        if (RUN(pb + 7)) { LAUNDER(); SKEW();
            pg8::Gemm<D, D, D, 256u * D * 2, 0, 256u * D * 2, 0> g{(const bf16_t*)WSP(WS_XG), (const bf16_t*)WSP(WS_WUP)};
            pg8::StaticOrder So; So.init(M, FF, F.G, bx);
            epi::EpiUp E{(bf16_t*)WSP(WS_BIG), (const float*)WSP(WS_RSB)};
            pg8::gemm_phase<epi::EpiUp, pg8::StaticOrder, true>(F.lds, g, So, E, F.tid);
            if (l + 1 < DEPTH) { __syncthreads(); convert_mix_weights(F, l + 1); }
        }
        SEAM(pb + 7);
        if (RUN(pb + 8)) { LAUNDER();
            pg8::Gemm<FF, FF, FF, 256u * FF * 2, 0, 256u * FF * 2, 0> g{(const bf16_t*)WSP(WS_BIG), (const bf16_t*)WSP(WS_WDN)};
            pg8::StaticOrder So; So.init(M, D, F.G, bx);
            epi::EpiResid E{nullptr, (bf16_t*)WSP(WS_XG), (l + 1 < DEPTH) ? nullptr : (float*)ptr_at(F, I_OUT), (float*)WSP(WS_SSQA), (l + 1 < DEPTH) ? ptr_at(F, I_OUT) + OUT_X8 : nullptr};
            pg8::gemm_phase<epi::EpiResid, pg8::StaticOrder, true>(F.lds, g, So, E, F.tid);
        }
        SEAM(pb + 8);
        if (RUN(pb + 9)) { LAUNDER(); if (l + 1 < DEPTH) finalize_rs(F, WS_SSQA, WS_RSA); }
        SEAM(pb + 9);
    }
#undef RUN
#undef SEAM
}

extern "C" void kernel_launch(void* const* d_in, const int* in_sizes, int n_in, void* d_out, int out_size, void* d_ws, size_t ws_size, hipStream_t stream) {
    static int grid = 0;
    if (grid == 0) {
        if (n_in != 18 || in_sizes[0] != M * D || out_size != M * D || ws_size < WS_END) { fprintf(stderr, "kernel_launch: unexpected shapes (n_in %d, in0 %d, out %d, ws %zu)\n", n_in, n_in > 0 ? in_sizes[0] : -1, out_size, ws_size); grid = -1; return; }
        int dev = 0, cus = 0, per_cu = 0;
        if (hipGetDevice(&dev) != hipSuccess || hipDeviceGetAttribute(&cus, hipDeviceAttributeMultiprocessorCount, dev) != hipSuccess) { grid = -1; return; }
        if (hipFuncSetAttribute((const void*)mk_fwd, hipFuncAttributeMaxDynamicSharedMemorySize, LDS_BYTES) != hipSuccess) { fprintf(stderr, "kernel_launch: hipFuncSetAttribute failed\n"); grid = -1; return; }
        if (hipOccupancyMaxActiveBlocksPerMultiprocessor(&per_cu, (const void*)mk_fwd, NT, LDS_BYTES) != hipSuccess || per_cu < 1) { fprintf(stderr, "kernel_launch: occupancy query says %d\n", per_cu); (void)hipGetLastError(); per_cu = 1; }
        grid = cus;
    }
    if (grid < 0) return;
    if (hipMemsetAsync((char*)d_ws + WS_CTL, 0, CTL_ZERO_BYTES, stream) != hipSuccess) { fprintf(stderr, "kernel_launch: memset failed\n"); return; }
    Args a{};
    for (int i = 0; i < 18; ++i) a.in[i] = (const float*)d_in[i];
    a.out = (float*)d_out; a.ws = (unsigned char*)d_ws;
#if MK_MULTI
    for (int p = 0; p < N_PHASES; ++p) { a.ph_lo = p; a.ph_hi = p + 1; a.coop = 0; hipLaunchKernelGGL(mk_fwd, dim3(grid), dim3(NT), LDS_BYTES, stream, a); }
#else
    a.ph_lo = 0; a.ph_hi = N_PHASES - 1; a.coop = 1;
    void* kargs[] = {&a};
    hipError_t e = hipLaunchCooperativeKernel((const void*)mk_fwd, dim3(grid), dim3(NT), kargs, LDS_BYTES, stream);
    if (e != hipSuccess) fprintf(stderr, "kernel_launch: cooperative launch failed: %s (grid %d)\n", hipGetErrorString(e), grid);
#endif
}
```

```cpp
#define MK_MULTI 0
#include <hip/hip_runtime.h>
#include <hip/hip_cooperative_groups.h>
#include <cstdio>
#include <cstdint>
namespace cg = cooperative_groups;

#define LAS __attribute__((address_space(3)))
typedef unsigned short bf16_t;
typedef short bf16x8 __attribute__((ext_vector_type(8)));
typedef float f32x4 __attribute__((ext_vector_type(4)));
typedef float f32x2 __attribute__((ext_vector_type(2)));
typedef unsigned u32x4 __attribute__((ext_vector_type(4)));
typedef unsigned u32x2 __attribute__((ext_vector_type(2)));
typedef int i32x4 __attribute__((ext_vector_type(4)));
typedef int i32x8 __attribute__((ext_vector_type(8)));

constexpr int D = 1024, NB = 4, S = 4096, M = NB * S, DEPTH = 2, FF = 4096, INW = 7760;
constexpr int O_AU = 0, O_AV = 256, O_BQ = 512, O_BK = 768, O_BV = 1024, O_QI = 1280, O_KI = 1792, O_WI = 1856,
              O_CQ = 1864, O_CK = 2120, O_CV = 2376, O_CO = 2632, O_CI = 2888, O_CF = 2892, O_DB = 2896, O_DC = 3152, O_DX = 3408, O_G = 3664;
constexpr int PW = 3840;
constexpr int P_AU = 0, P_AV = 256, P_Q = 512, P_K = 768, P_V = 1024, P_QI = 1280, P_CQ = 1792, P_CK = 2048, P_CV = 2304, P_CO = 2560,
              P_DB = 2816, P_DC = 3072, P_DX = 3328, P_KI = 3584;
constexpr float EPS = 1e-6f;
constexpr int NWAVES = 8, NT = 512;

constexpr size_t MiB = 1u << 20;
constexpr size_t WS_CTL = 0;
constexpr size_t WS_COS = 1 * MiB, WS_SIN = 1 * MiB + 512 * 1024;
constexpr size_t WS_MISC = 2 * MiB;
constexpr size_t WS_SSQA = 3 * MiB, WS_SSQB = 4 * MiB;
constexpr size_t WS_WIN = 5 * MiB;
constexpr size_t WS_WG = WS_WIN + (size_t)PW * D * 2;
constexpr size_t WS_WBR = WS_WG + (size_t)4096 * D * 2;
constexpr size_t WS_WOUT = WS_WBR + (size_t)4 * 1024 * 256 * 2;
constexpr size_t WS_XG = 25 * MiB;
constexpr size_t WS_BIG = 57 * MiB;
constexpr size_t WS_Y = 185 * MiB;
constexpr size_t WS_WUP = WS_Y, WS_WDN = WS_Y + 8 * MiB;
constexpr size_t WS_MG = 217 * MiB;
constexpr size_t WS_MASK = WS_MG, WS_STATE = WS_MG + 8 * MiB;
constexpr size_t WS_END = 249 * MiB;
constexpr int STATE_STRIDE = 4224;
static_assert(WS_WOUT + (size_t)D * D * 2 <= WS_XG && WS_STATE + (size_t)512 * STATE_STRIDE * 4 <= WS_END && WS_END <= 256 * MiB, "d_ws map");

constexpr size_t OUT_X8 = 0;
constexpr size_t OUT_WG8 = 16 * MiB;
constexpr float WG8_SCALE = 64.f;
constexpr int LDS_BYTES = 155648;

__device__ __forceinline__ float bf2f(bf16_t v) { return __uint_as_float((unsigned)v << 16); }
__device__ __forceinline__ unsigned f2bf(float f) { unsigned u = __float_as_uint(f); return (u + 0x7fffu + ((u >> 16) & 1u)) >> 16; }
__device__ __forceinline__ unsigned pk2(float lo, float hi) { return f2bf(lo) | (f2bf(hi) << 16); }
typedef __bf16 bf16x2_t __attribute__((ext_vector_type(2)));
__device__ __forceinline__ unsigned cvt_pk_bf16(float lo, float hi) { const f32x2 v = {lo, hi}; return __builtin_bit_cast(unsigned, __builtin_convertvector(v, bf16x2_t)); }
__device__ __forceinline__ unsigned pk4_fp8(float a, float b, float c, float d) { int w = __builtin_amdgcn_cvt_pk_fp8_f32(a, b, 0, false); w = __builtin_amdgcn_cvt_pk_fp8_f32(c, d, w, true); return (unsigned)w; }
__device__ __forceinline__ float lo_bf(unsigned w) { return __uint_as_float(w << 16); }
__device__ __forceinline__ float hi_bf(unsigned w) { return __uint_as_float(w & 0xffff0000u); }
static __device__ __forceinline__ float xs32(float v) { const auto r = __builtin_amdgcn_permlane32_swap(__float_as_uint(v), __float_as_uint(v), false, false); return __uint_as_float(r[0]) + __uint_as_float(r[1]); }
static __device__ __forceinline__ float xs1632(float v) { const auto r = __builtin_amdgcn_permlane16_swap(__float_as_uint(v), __float_as_uint(v), false, false); return xs32(__uint_as_float(r[0]) + __uint_as_float(r[1])); }

__device__ __forceinline__ float wave_sum(float v) {
#pragma unroll
    for (int o = 1; o < 64; o <<= 1) v += __shfl_xor(v, o);
    return v;
}
__device__ __forceinline__ float wave_max(float v) {
#pragma unroll
    for (int o = 1; o < 64; o <<= 1) v = fmaxf(v, __shfl_xor(v, o));
    return v;
}
__device__ __forceinline__ int wave_sum_i(int v) {
#pragma unroll
    for (int o = 1; o < 64; o <<= 1) v += __shfl_xor(v, o);
    return v;
}
__device__ __forceinline__ float sigmoid_f(float x) { return __builtin_amdgcn_rcpf(1.f + __builtin_amdgcn_exp2f(-1.4426950408889634f * x)); }
__device__ __forceinline__ float gelu_tanh_f(float x) { const float t = x * __builtin_fmaf(-0.1029432396f, x * x, -2.3022081981f); return x * __builtin_amdgcn_rcpf(1.f + __builtin_amdgcn_exp2f(t)); }
__device__ __forceinline__ float relu_f(float x) { const int b = __builtin_bit_cast(int, x); return __builtin_bit_cast(float, b > 0 ? b : 0); }
__device__ __forceinline__ unsigned fkey(float s) { const unsigned u = __float_as_uint(s); return (u & 0x80000000u) ? ~u : (u | 0x80000000u); }

__device__ __forceinline__ void st16(void* p, const u32x4 v, const bool wt) { if (wt) asm volatile("global_store_dwordx4 %0, %1, off sc1\n\ts_nop 1" :: "v"(p), "v"(v) : "memory"); else *(u32x4*)p = v; }

namespace pg8 {
constexpr int BM = 256, BK = 64, HALF = 128, HTB = HALF * BK * 2, STAGE_BYTES = 8 * HTB, NXCD = 8, WGM = 8, RS_OFF = STAGE_BYTES;
__host__ __device__ __forceinline__ int lds_byte(int r, int c) { const int st = (r >> 4) * 2 + (c >> 5), rr = r & 15, cc = c & 31, ob = rr * 64 + cc * 2; return st * 1024 + (ob ^ (((ob >> 9) & 1) << 5)); }
__host__ __device__ __forceinline__ void stage_rc(int b, int& R, int& C) { const int st = b / 1024, sb = b % 1024, swz = sb ^ (((sb >> 9) & 1) << 5); R = (st >> 1) * 16 + swz / 64; C = (st & 1) * 32 + (swz % 64) / 2; }
__host__ __device__ __forceinline__ int perm32(int rho) { const int n = rho >> 4, i = rho & 15; return 8 * (i >> 2) + 4 * n + (i & 3); }

struct Unit { int pm, pn, z; };
template <int K_, int LDA_, int LDB_, unsigned APM_, unsigned AZ_, unsigned BPN_, unsigned BZ_, int ESZ_ = 2> struct Gemm {
    const void* A; const void* Bt;
    static constexpr int K = K_, lda = LDA_, ldb = LDB_, esz = ESZ_; static constexpr unsigned aPm = APM_, aZ = AZ_, bPn = BPN_, bZ = BZ_;
};
template <class G> __device__ __forceinline__ const char* pa(const G& g, const Unit& u) { return (const char*)g.A + (size_t)((unsigned)u.pm * G::aPm + (unsigned)u.z * G::aZ); }
template <class G> __device__ __forceinline__ const char* pb(const G& g, const Unit& u) { return (const char*)g.Bt + (size_t)((unsigned)u.pn * G::bPn + (unsigned)u.z * G::bZ); }

struct StaticOrder {
    int nM, nN, nwg, G, c;
    __host__ __device__ void init(int M_, int N_, int G_, int c_) { nM = M_ / BM; nN = N_ / BM; nwg = nM * nN; G = G_; c = c_; }
    __host__ __device__ bool next(int i, Unit& u) const {
        const long L = (long)i * G + c; if (L >= nwg) return false;
        int wgid = (int)L; { const int q = nwg / NXCD, r = nwg % NXCD, xcd = wgid % NXCD, off = wgid / NXCD; wgid = (xcd < r ? xcd * (q + 1) : r * (q + 1) + (xcd - r) * q) + off; }
        const int nig = WGM * nN, gid = wgid / nig, fm = gid * WGM, gsz = (nM - fm) < WGM ? (nM - fm) : WGM;
        u.pm = fm + ((wgid % nig) % gsz); u.pn = (wgid % nig) / gsz; u.z = 0; return true;
    }
};
template <int MODE> struct SuperOrder {
    StaticOrder so;
    __host__ __device__ void init(int G_, int c_) { so.init(M, 1024, G_, c_); }
    __host__ __device__ bool next(int i, Unit& u) const {
        Unit b; if (!so.next(i >> 2, b)) return false;
        const int sub = i & 3; u.pm = b.pm; if (MODE == 0) { u.pn = b.pn; u.z = sub; } else { u.pn = 4 * b.pn + sub; u.z = 0; } return true;
    }
};

template <class Epi, class Sched, bool ALIGN_EPI, class GemmT>
__device__ __forceinline__ void gemm_phase(LAS unsigned char* lds, const GemmT g, const Sched& S, const Epi& E, const int tid) {
    const int wid = __builtin_amdgcn_readfirstlane(tid >> 6), lane = tid & 63, wr = wid >> 2, wc = wid & 3, fr = lane & 15, fq = lane >> 4;
    constexpr int K = GemmT::K, ESZ = GemmT::esz, nt = K * ESZ / (BK * 2);
    unsigned voffA[2], voffB[2];
#pragma unroll
    for (int i = 0; i < 2; ++i) { int R, C; stage_rc(tid * 16 + i * 8192, R, C); const int Rb = Epi::PERM ? ((R & ~31) + perm32(R & 31)) : R;
        voffA[i] = (unsigned)(R * GemmT::lda * ESZ + C * 2); voffB[i] = (unsigned)(Rb * GemmT::ldb * ESZ + C * 2); }
    const size_t kstep = (size_t)(BK * 2);
    constexpr size_t hA = (size_t)HALF * GemmT::lda * ESZ, hB = (size_t)HALF * GemmT::ldb * ESZ;
    const unsigned ldsw = (unsigned)wid * 1024u;
    constexpr int FCOL = (ESZ == 2) ? 8 : 16, KOFF = (ESZ == 2) ? 1024 : 16;
    const int aoff = lds_byte(wr * 64 + fr, fq * FCOL), boff = lds_byte(wc * 32 + fr, fq * FCOL);
    int one_scale = 0x7f7f7f7f; asm volatile("" : "+v"(one_scale));
#define PG8_SA(b, h) (((b) * 2 + (h)) * HTB)
#define PG8_SB(b, h) ((4 + (b) * 2 + (h)) * HTB)
#define PG8_STAGE(bufoff, gbase, voff) do { _Pragma("unroll") for (int _i = 0; _i < 2; ++_i) \
        __builtin_amdgcn_global_load_lds((const unsigned*)((const char*)(gbase) + (voff)[_i]), (LAS unsigned*)(lds + (bufoff) + ldsw + _i * 8192), 16, 0, 0); } while (0)
#define PG8_LDA(dst, b, h) do { _Pragma("unroll") for (int m = 0; m < 4; ++m) _Pragma("unroll") for (int k = 0; k < 2; ++k) dst[m][k] = *(const LAS bf16x8*)(lds + PG8_SA(b, h) + aoff + m * 2048 + k * KOFF); } while (0)
#define PG8_LDB(dst, b, h) do { _Pragma("unroll") for (int n = 0; n < 2; ++n) _Pragma("unroll") for (int k = 0; k < 2; ++k) dst[n][k] = *(const LAS bf16x8*)(lds + PG8_SB(b, h) + boff + n * 2048 + k * KOFF); } while (0)
#define PG8_MMA(ai, bj, At, Bt) do { __builtin_amdgcn_s_setprio(1); _Pragma("unroll") for (int m = 0; m < 4; ++m) _Pragma("unroll") for (int n = 0; n < 2; ++n) { \
        if constexpr (ESZ == 2) { _Pragma("unroll") for (int k = 0; k < 2; ++k) acc[ai][bj][m][n] = __builtin_amdgcn_mfma_f32_16x16x32_bf16(Bt[n][k], At[m][k], acc[ai][bj][m][n], 0, 0, 0); } \
        else { const i32x8 a8_ = __builtin_shufflevector(__builtin_bit_cast(i32x4, At[m][0]), __builtin_bit_cast(i32x4, At[m][1]), 0, 1, 2, 3, 4, 5, 6, 7), b8_ = __builtin_shufflevector(__builtin_bit_cast(i32x4, Bt[n][0]), __builtin_bit_cast(i32x4, Bt[n][1]), 0, 1, 2, 3, 4, 5, 6, 7); \
              \
            asm volatile("v_mfma_scale_f32_16x16x128_f8f6f4 %0, %1, %2, %0, %3, %3 op_sel_hi:[0,0,0]" : "+v"(acc[ai][bj][m][n]) : "v"(b8_), "v"(a8_), "v"(one_scale)); } } \
        __builtin_amdgcn_s_setprio(0); } while (0)
#define PG8_WAIT_V(n) asm volatile("s_waitcnt vmcnt(" #n ")" ::: "memory")
#define PG8_WAIT_L(n) asm volatile("s_waitcnt lgkmcnt(" #n ")" ::: "memory")
#define PG8_BAR __builtin_amdgcn_s_barrier()
#define PG8_SCHED __builtin_amdgcn_sched_barrier(0)
#define PG8_WAIT_VN(n) asm volatile("s_waitcnt vmcnt(%0)" :: "n"(n) : "memory")
    constexpr int WN1 = 8, WN2 = 8 + Epi::VM_MIN;
#define PG8_WAIT_SEL do { if (wsel == 0) PG8_WAIT_V(8); else if (wsel == 1) PG8_WAIT_VN(WN1); else PG8_WAIT_VN(WN2); } while (0)
#define PG8_RS_LOAD(i0) do { if constexpr (Epi::RS) { _Pragma("unroll") for (int i_ = 0; i_ < 4; ++i_) { Unit us_; const bool ok_ = S.next((i0) + i_, us_); \
        const float* p_ = E.ssq + ((size_t)((ok_ ? us_.pm : 0) * 256 + (tid >> 1)) * 16 + (tid & 1) * 8); rp[i_][0] = *(const f32x4*)p_; rp[i_][1] = *(const f32x4*)(p_ + 4); } } } while (0)
#define PG8_RS_FIN(i0) do { if constexpr (Epi::RS) { _Pragma("unroll") for (int i_ = 0; i_ < 4; ++i_) { const f32x4 a_ = rp[i_][0] + rp[i_][1]; float s_ = (a_[0] + a_[1]) + (a_[2] + a_[3]); s_ += __shfl_xor(s_, 1); \
        if (!(tid & 1)) *(LAS float*)(lds + RS_OFF + ((i0) + i_) * 1024 + (tid >> 1) * 4) = rsqrtf(s_ * (1.0f / 1024.0f) + EPS); } } } while (0)
    f32x4 rp[4][2];
    Unit cur, nxt; int ui = 0;
    if (!S.next(0, cur)) return;
    f32x4 acc[2][2][4][2];
#pragma unroll
    for (int a = 0; a < 2; ++a)
#pragma unroll
        for (int b = 0; b < 2; ++b)
#pragma unroll
            for (int m = 0; m < 4; ++m)
#pragma unroll
                for (int n = 0; n < 2; ++n) acc[a][b][m][n] = (f32x4){0.f, 0.f, 0.f, 0.f};
    bf16x8 At[4][2], B0[2][2], B1[2][2];
    const char* cA = pa(g, cur); const char* cB = pb(g, cur);
    PG8_RS_LOAD(0);
    PG8_STAGE(PG8_SB(0, 0), cB, voffB); PG8_STAGE(PG8_SB(0, 1), cB + hB, voffB); PG8_STAGE(PG8_SA(0, 0), cA, voffA); PG8_STAGE(PG8_SA(0, 1), cA + hA, voffA);
    if (wr == 1) PG8_BAR;
    PG8_WAIT_V(2); PG8_BAR;
    PG8_STAGE(PG8_SB(1, 0), cB + kstep, voffB); PG8_STAGE(PG8_SA(1, 0), cA + kstep, voffA); PG8_STAGE(PG8_SB(1, 1), cB + hB + kstep, voffB);
    PG8_WAIT_V(6); PG8_BAR;
    PG8_RS_FIN(0);
    if constexpr (Epi::RS) { Unit u4_; if (S.next(4, u4_)) { PG8_RS_LOAD(4); PG8_RS_FIN(4); } }
    int wsel = 0;
    for (;;) {
        const bool has_next = S.next(ui + 1, nxt);
        const char* nA = has_next ? pa(g, nxt) : cA; const char* nB = has_next ? pb(g, nxt) : cB;
        asm volatile(".p2align 8");
#pragma unroll 1
        for (int t = 0; t < nt; t += 2) {
            const bool last = (t == nt - 2);
            const char* a1 = cA + (size_t)(t + 1) * kstep;
            const char* a2 = last ? nA : cA + (size_t)(t + 2) * kstep; const char* b2 = last ? nB : cB + (size_t)(t + 2) * kstep;
            const char* a3 = a2 + kstep; const char* b3 = b2 + kstep;
            PG8_LDB(B0, 0, 0); PG8_LDB(B1, 0, 1); PG8_SCHED; PG8_LDA(At, 0, 0); if (wsel == 0) PG8_STAGE(PG8_SA(1, 1), a1 + hA, voffA);
            PG8_WAIT_SEL; PG8_WAIT_L(0); PG8_BAR; PG8_MMA(0, 0, At, B0); PG8_MMA(0, 1, At, B1); PG8_BAR; PG8_SCHED;
            PG8_LDA(At, 0, 1); PG8_STAGE(PG8_SB(0, 0), b2, voffB); PG8_STAGE(PG8_SB(0, 1), b2 + hB, voffB); PG8_STAGE(PG8_SA(0, 0), a2, voffA);
            PG8_WAIT_SEL; PG8_WAIT_L(0); PG8_BAR; PG8_MMA(1, 0, At, B0); PG8_MMA(1, 1, At, B1); PG8_BAR; PG8_SCHED;
            PG8_LDB(B0, 1, 0); PG8_LDB(B1, 1, 1); PG8_SCHED; PG8_LDA(At, 1, 0); PG8_STAGE(PG8_SA(0, 1), a2 + hA, voffA);
            PG8_WAIT_SEL; PG8_WAIT_L(0); PG8_BAR; PG8_MMA(0, 0, At, B0); PG8_MMA(0, 1, At, B1); PG8_BAR; PG8_SCHED;
            PG8_LDA(At, 1, 1); PG8_STAGE(PG8_SB(1, 0), b3, voffB); PG8_STAGE(PG8_SB(1, 1), b3 + hB, voffB); PG8_STAGE(PG8_SA(1, 0), a3, voffA);
            PG8_WAIT_V(8); PG8_WAIT_L(0); PG8_BAR; PG8_MMA(1, 0, At, B0); PG8_MMA(1, 1, At, B1); PG8_BAR; PG8_SCHED;
            wsel = 0;
        }
        if (has_next) PG8_STAGE(PG8_SA(1, 1), nA + kstep + hA, voffA);
        asm volatile("" ::: "memory"); PG8_SCHED;
        if constexpr (ALIGN_EPI) { if (wr == 0) PG8_BAR; }
        int eops;
        { int fr2 = fr, fq2 = fq; asm volatile("" : "+v"(fr2), "+v"(fq2)); eops = E(acc, cur, wr, wc, fr2, fq2, (const LAS float*)(lds + RS_OFF + (ui & 7) * 1024), !has_next); }
        if (!has_next) break;
        wsel = (eops >= Epi::VM_MIN) ? 2 : 1;
#pragma unroll
        for (int a = 0; a < 2; ++a)
#pragma unroll
            for (int b = 0; b < 2; ++b)
#pragma unroll
                for (int m = 0; m < 4; ++m)
#pragma unroll
                    for (int n = 0; n < 2; ++n) acc[a][b][m][n] = (f32x4){0.f, 0.f, 0.f, 0.f};
        cur = nxt; cA = nA; cB = nB; ++ui;
        if constexpr (ALIGN_EPI) { if (wr == 1) PG8_BAR; }
    }
    PG8_WAIT_V(0);
    if constexpr (!ALIGN_EPI) { if (wr == 0) PG8_BAR; }
    PG8_BAR;
#undef PG8_SA
#undef PG8_SB
#undef PG8_STAGE
#undef PG8_LDA
#undef PG8_LDB
#undef PG8_MMA
#undef PG8_WAIT_V
#undef PG8_WAIT_VN
#undef PG8_WAIT_SEL
#undef PG8_RS_LOAD
#undef PG8_RS_FIN
#undef PG8_WAIT_L
#undef PG8_BAR
#undef PG8_SCHED
}
}
namespace epi {
using pg8::Unit;
typedef f32x4 Acc[2][2][4][2];

__device__ __forceinline__ float row_scale(const float* rs, int row) { return rs[row]; }
__device__ __forceinline__ u32x4 pack8(const f32x4 a, const f32x4 b) { u32x4 w; w.x = cvt_pk_bf16(a[0], a[1]); w.y = cvt_pk_bf16(a[2], a[3]); w.z = cvt_pk_bf16(b[0], b[1]); w.w = cvt_pk_bf16(b[2], b[3]); return w; }

struct EpiProj {
    static constexpr bool PERM = true, RS = true; static constexpr int VM_MIN = 16;
    bf16_t* P; float* misc; const float* ssq; const float* cs; const float* sn; const float* gt;     bf16_t* VT;     bf16_t* KI;     bf16_t* CVT;     float* ssqv;     LAS unsigned char* lds;
    __device__ __forceinline__ int operator()(const Acc& acc, const Unit& u, int wr, int wc, int fr, int fq, const LAS float* rsl, const bool lastu) const {
        const int T = u.pn; const int row0 = u.pm * 256 + wr * 64 + fr;
        float rsv[8];
#pragma unroll
        for (int i = 0; i < 8; ++i) rsv[i] = rsl[wr * 64 + fr + (i >> 2) * 128 + (i & 3) * 16];
        if (T == 2 || T == 3 || T == 5 || T == 6 || T == 14) {
            if (T == 14 && wc >= 2) return 0;
            if (T == 14 && wc == 1) {
                if (fq < 2) {
#pragma unroll
                    for (int ai = 0; ai < 2; ++ai)
#pragma unroll
                        for (int m = 0; m < 4; ++m) { const int row = row0 + ai * 128 + m * 16; const float rs = rsv[ai * 4 + m];
                            float* mp = misc + (size_t)row * 16 + 8 * fq; *(f32x4*)mp = acc[ai][0][m][0] * rs; *(f32x4*)(mp + 4) = acc[ai][0][m][1] * rs; }
                }
                return 16;
            }
            const int mode = (T == 14) ? 2 : (T <= 3 ? 1 : 0);
            const float* gp = gt + 64 * ((T == 2) ? 0 : (T == 3) ? 1 : 2);
            f32x4 g1[2], g2[2];
#pragma unroll
            for (int n = 0; n < 2; ++n) { if (mode) { g1[n] = *(const f32x4*)(gp + 8 * fq + 4 * n); g2[n] = *(const f32x4*)(gp + 32 + 8 * fq + 4 * n); } else { g1[n] = (f32x4){1.f, 1.f, 1.f, 1.f}; g2[n] = g1[n]; } }
            f32x4 rc[2], rsn[2];
#define EPI_ROT_LOAD(k_) do { const int pos_ = (row0 + ((k_) >> 2) * 128 + ((k_) & 3) * 16) & (S - 1); _Pragma("unroll") for (int n_ = 0; n_ < 2; ++n_) { \
                rc[n_] = *(const f32x4*)(cs + (size_t)pos_ * 32 + 8 * fq + 4 * n_); rsn[n_] = *(const f32x4*)(sn + (size_t)pos_ * 32 + 8 * fq + 4 * n_); } } while (0)
            EPI_ROT_LOAD(0);
#pragma unroll
            for (int ai = 0; ai < 2; ++ai) {
#pragma unroll
                for (int m = 0; m < 4; ++m) {
                    const int row = row0 + ai * 128 + m * 16; const float rs = rsv[ai * 4 + m];
                    f32x4 x1[2], x2[2];
#pragma unroll
                    for (int n = 0; n < 2; ++n) { x1[n] = acc[ai][0][m][n] * rs; x2[n] = acc[ai][1][m][n] * rs; }
                    if (mode == 2) {
                        float s = 0.f;
#pragma unroll
                        for (int n = 0; n < 2; ++n) s += (x1[n][0] + x1[n][1]) + (x1[n][2] + x1[n][3]) + (x2[n][0] + x2[n][1]) + (x2[n][2] + x2[n][3]);
                        s = xs1632(s); const float mu = s * (1.f / 64.f);
#pragma unroll
                        for (int n = 0; n < 2; ++n) { x1[n] = x1[n] - mu; x2[n] = x2[n] - mu; }
                    }
                    if (mode) {
                        float q = 0.f;
#pragma unroll
                        for (int n = 0; n < 2; ++n) { const f32x4 a = x1[n] * x1[n], b = x2[n] * x2[n]; q += (a[0] + a[1]) + (a[2] + a[3]) + (b[0] + b[1]) + (b[2] + b[3]); }
                        q = xs1632(q); const float rr = rsqrtf(q * (1.f / 64.f) + EPS);
#pragma unroll
                        for (int n = 0; n < 2; ++n) { x1[n] = x1[n] * rr * g1[n]; x2[n] = x2[n] * rr * g2[n]; }
                        if (T == 2) {
#pragma unroll
                            for (int n = 0; n < 2; ++n) { x1[n] = x1[n] * (0.125f * 1.4426950408889634f); x2[n] = x2[n] * (0.125f * 1.4426950408889634f); } }
                    }
                    f32x4 o1[2], o2[2];
#pragma unroll
                    for (int n = 0; n < 2; ++n) { const f32x4 c = rc[n], s = rsn[n];
                        o1[n] = x1[n] * c - x2[n] * s; o2[n] = x2[n] * c + x1[n] * s; }
                    __builtin_amdgcn_sched_barrier(0);
                    if (ai * 4 + m < 7) EPI_ROT_LOAD(ai * 4 + m + 1);
                    __builtin_amdgcn_sched_barrier(0);
                    bf16_t* op = P + (size_t)row * PW + 256 * T + 64 * wc + 8 * fq;
                    if (T != 14) { *(u32x4*)op = pack8(o1[0], o1[1]); *(u32x4*)(op + 32) = pack8(o2[0], o2[1]); }
                    if (T == 14) {
                        bf16_t* kp = KI + ((size_t)((row >> 5) * 4 + (fq >> 1)) * 64 + (fq & 1) * 32 + (row & 31)) * 8; *(u32x4*)kp = pack8(o1[0], o1[1]); *(u32x4*)(kp + 2 * 64 * 8) = pack8(o2[0], o2[1]); }
                }
            }
#undef EPI_ROT_LOAD
            return 16;
        }
        const int act = (T <= 1) ? 1 : 0; const float sc = (T == 8) ? 0.125f : 1.0f;
#pragma unroll
        for (int ai = 0; ai < 2; ++ai)
#pragma unroll
            for (int m = 0; m < 4; ++m) {
                const int row = row0 + ai * 128 + m * 16; const float rs = rsv[ai * 4 + m] * sc;
                bf16_t* op = P + (size_t)row * PW + 256 * T + 32 * wc + 8 * fq; float qv = 0.f;
#pragma unroll
                for (int bj = 0; bj < 2; ++bj) { f32x4 v0 = acc[ai][bj][m][0] * rs, v1 = acc[ai][bj][m][1] * rs;
                    if (act) {
#pragma unroll
                        for (int e = 0; e < 4; ++e) { v0[e] = gelu_tanh_f(v0[e]); v1[e] = gelu_tanh_f(v1[e]); }
                        const f32x4 a2 = v0 * v0, b2 = v1 * v1; qv += ((a2[0] + a2[1]) + (a2[2] + a2[3])) + ((b2[0] + b2[1]) + (b2[2] + b2[3])); }
                    if (T != 4 && T != 9) *(u32x4*)(op + bj * 128) = pack8(v0, v1);
                    if (T == 4 || T == 9) {
                        LAS unsigned char* tr = lds + pg8::RS_OFF + 8192 + (wr * 4 + wc) * 1536;
                        asm volatile("" ::: "memory");
#pragma unroll
                        for (int e = 0; e < 4; ++e) { *(LAS bf16_t*)(tr + (8 * fq + e) * 40 + fr * 2) = (bf16_t)f2bf(v0[e]); *(LAS bf16_t*)(tr + (8 * fq + 4 + e) * 40 + fr * 2) = (bf16_t)f2bf(v1[e]); }
                        asm volatile("s_waitcnt lgkmcnt(0)" ::: "memory");
                        const int ln = fq * 16 + fr, dm = ln >> 1, hf = ln & 1;
                        const u32x2 t0 = *(const LAS u32x2*)(tr + dm * 40 + hf * 16), t1 = *(const LAS u32x2*)(tr + dm * 40 + hf * 16 + 8);
                        const int rbase = u.pm * 256 + wr * 64 + ai * 128 + m * 16;
                        bf16_t* vp = (T == 4 ? VT : CVT) + ((size_t)((rbase >> 12) * 256 + bj * 128 + 32 * wc + dm)) * S + (rbase & (S - 1)) + hf * 8;
                        *(u32x4*)vp = (u32x4){t0.x, t0.y, t1.x, t1.y};
                        asm volatile("" ::: "memory"); } }
                if (T == 1) { qv = xs1632(qv); if (fq == 0) ssqv[(size_t)row * 4 + wc] = qv; }
            }
        return 16;
    }
};

struct EpiPlain {
    static constexpr bool PERM = true, RS = false; static constexpr int VM_MIN = 16;
    bf16_t* O; int ldc; int zcols;
    __device__ __forceinline__ int operator()(const Acc& acc, const Unit& u, int wr, int wc, int fr, int fq, const LAS float*, const bool lastu) const {
        const int row0 = u.pm * 256 + wr * 64 + fr; const int col0 = u.z * zcols + u.pn * 256 + 32 * wc + 8 * fq;
#pragma unroll
        for (int ai = 0; ai < 2; ++ai)
#pragma unroll
            for (int m = 0; m < 4; ++m) { bf16_t* op = O + (size_t)(row0 + ai * 128 + m * 16) * ldc + col0;
#pragma unroll
                for (int bj = 0; bj < 2; ++bj) *(u32x4*)(op + bj * 128) = pack8(acc[ai][bj][m][0], acc[ai][bj][m][1]); }
        return 16;
    }
};

struct EpiGate {
    static constexpr bool PERM = true, RS = true; static constexpr int VM_MIN = 40;
    bf16_t* MG; const bf16_t* BR; const float* ssq;
    __device__ __forceinline__ int operator()(const Acc& acc, const Unit& u, int wr, int wc, int fr, int fq, const LAS float* rsl, const bool lastu) const {
        const int row0 = u.pm * 256 + wr * 64 + fr; const int ch0 = u.pn * 64 + 16 * wc + 4 * fq;
        float rsv[8];
#pragma unroll
        for (int i = 0; i < 8; ++i) rsv[i] = rsl[wr * 64 + fr + (i >> 2) * 128 + (i & 3) * 16] * (1.0f / WG8_SCALE);
#pragma unroll
        for (int ai = 0; ai < 2; ++ai) {
            u32x2 bw[4][4];
#pragma unroll
            for (int m = 0; m < 4; ++m)
#pragma unroll
                for (int nb = 0; nb < 4; ++nb) bw[m][nb] = *(const u32x2*)(BR + (size_t)(row0 + ai * 128 + m * 16) * 4096 + ch0 + nb * 1024);
#pragma unroll
            for (int m = 0; m < 4; ++m) {
                const int row = row0 + ai * 128 + m * 16; const float rs = rsv[ai * 4 + m]; f32x4 o = (f32x4){0.f, 0.f, 0.f, 0.f};
#pragma unroll
                for (int bj = 0; bj < 2; ++bj)
#pragma unroll
                    for (int n = 0; n < 2; ++n) { const u32x2 w = bw[m][2 * bj + n]; const f32x4 a = acc[ai][bj][m][n] * rs;
                        o[0] += sigmoid_f(a[0]) * lo_bf(w.x); o[1] += sigmoid_f(a[1]) * hi_bf(w.x); o[2] += sigmoid_f(a[2]) * lo_bf(w.y); o[3] += sigmoid_f(a[3]) * hi_bf(w.y); }
                u32x2 ow; ow.x = cvt_pk_bf16(o[0], o[1]); ow.y = cvt_pk_bf16(o[2], o[3]);
                *(u32x2*)(MG + (size_t)row * 1024 + ch0) = ow;
            }
        }
        return 40;
    }
};

struct EpiResid {
    static constexpr bool PERM = true, RS = false; static constexpr int VM_MIN = 0;
    const float* resf; bf16_t* X; float* outf; float* ssq; unsigned char* x8;
    __device__ __forceinline__ int operator()(const Acc& acc, const Unit& u, int wr, int wc, int fr, int fq, const LAS float*, const bool lastu) const {
        const int row0 = u.pm * 256 + wr * 64 + fr; const int col0 = u.pn * 256 + 32 * wc + 8 * fq;
#pragma unroll
        for (int ai = 0; ai < 2; ++ai) {
            f32x4 r[4][2][2];
            if (resf) {
#pragma unroll
                for (int m = 0; m < 4; ++m)
#pragma unroll
                    for (int bj = 0; bj < 2; ++bj) { const float* rp = resf + (size_t)(row0 + ai * 128 + m * 16) * 1024 + col0 + bj * 128; r[m][bj][0] = *(const f32x4*)rp; r[m][bj][1] = *(const f32x4*)(rp + 4); }
            } else {
                u32x4 w[4][2];
#pragma unroll
                for (int m = 0; m < 4; ++m)
#pragma unroll
                    for (int bj = 0; bj < 2; ++bj) w[m][bj] = *(const u32x4*)(X + (size_t)(row0 + ai * 128 + m * 16) * 1024 + col0 + bj * 128);
#pragma unroll
                for (int m = 0; m < 4; ++m)
#pragma unroll
                    for (int bj = 0; bj < 2; ++bj) { const u32x4 q = w[m][bj]; r[m][bj][0] = (f32x4){lo_bf(q.x), hi_bf(q.x), lo_bf(q.y), hi_bf(q.y)}; r[m][bj][1] = (f32x4){lo_bf(q.z), hi_bf(q.z), lo_bf(q.w), hi_bf(q.w)}; }
            }
#pragma unroll
            for (int m = 0; m < 4; ++m) {
                const int row = row0 + ai * 128 + m * 16; const size_t off = (size_t)row * 1024 + col0; float q = 0.f;
#pragma unroll
                for (int bj = 0; bj < 2; ++bj) {
                    const f32x4 x0 = r[m][bj][0] + acc[ai][bj][m][0], x1 = r[m][bj][1] + acc[ai][bj][m][1];
                    if (outf) { *(f32x4*)(outf + off + bj * 128) = x0; *(f32x4*)(outf + off + bj * 128 + 4) = x1; }
                    else {
                        const f32x4 a = x0 * x0, b = x1 * x1; q += ((a[0] + a[1]) + (a[2] + a[3])) + ((b[0] + b[1]) + (b[2] + b[3]));
                        *(u32x4*)(X + off + bj * 128) = pack8(x0, x1);
                        if (x8) { u32x2 q8; q8.x = pk4_fp8(x0[0], x0[1], x0[2], x0[3]); q8.y = pk4_fp8(x1[0], x1[1], x1[2], x1[3]); *(u32x2*)(x8 + off + bj * 128) = q8; } }
                }
                if (!outf) { q = xs1632(q); if (fq == 0) ssq[(size_t)row * 16 + 4 * u.pn + wc] = q; }
            }
        }
        return 0;
    }
};

struct EpiUp {
    static constexpr bool PERM = true, RS = true; static constexpr int VM_MIN = 16;
    bf16_t* H; const float* ssq;
    __device__ __forceinline__ int operator()(const Acc& acc, const Unit& u, int wr, int wc, int fr, int fq, const LAS float* rsl, const bool lastu) const {
        const int row0 = u.pm * 256 + wr * 64 + fr; const int col0 = u.pn * 256 + 32 * wc + 8 * fq;
        float rsv[8];
#pragma unroll
        for (int i = 0; i < 8; ++i) rsv[i] = rsl[wr * 64 + fr + (i >> 2) * 128 + (i & 3) * 16];
#pragma unroll
        for (int ai = 0; ai < 2; ++ai)
#pragma unroll
            for (int m = 0; m < 4; ++m) { const int row = row0 + ai * 128 + m * 16; const float rs = rsv[ai * 4 + m]; bf16_t* op = H + (size_t)row * FF + col0;
#pragma unroll
                for (int bj = 0; bj < 2; ++bj) { f32x4 v0 = acc[ai][bj][m][0] * rs, v1 = acc[ai][bj][m][1] * rs;
#pragma unroll
                    for (int e = 0; e < 4; ++e) { v0[e] = relu_f(v0[e]); v1[e] = relu_f(v1[e]); }
                    st16(op + bj * 128, pack8(v0 * v0, v1 * v1), lastu); } }
        return 16;
    }
};
}
struct Args {
    const float* in[18]; float* out; unsigned char* ws; int ph_lo, ph_hi; int coop, pad;
};
struct Frame { LAS unsigned char* lds; int tid, wave, G, vcu; };
constexpr int PTR_OFF = LDS_BYTES - 512;
enum { I_X = 0, I_LN_MIX, I_W_IN, I_SGU_NORM, I_SGU_W, I_SGU_B, I_Q_NORM, I_K_NORM, I_KIDX_NORM, I_I_BIAS, I_F_BIAS, I_MNORM, I_CONV_W, I_W_BRANCH, I_W_OUT, I_LN_MLP, I_W_UP, I_W_DOWN, I_OUT, I_WS };
__device__ __forceinline__ unsigned char* ptr_at(const Frame& F, int i) { const LAS unsigned* p = (const LAS unsigned*)(F.lds + PTR_OFF) + 2 * i;
    const unsigned lo = __builtin_amdgcn_readfirstlane(p[0]), hi = __builtin_amdgcn_readfirstlane(p[1]);
    typedef __attribute__((address_space(1))) unsigned char* gptr_t;
    return (unsigned char*)(gptr_t)(((unsigned long long)hi << 32) | lo); }
#define INP(i) ((const float*)ptr_at(F, (i)))
#define WSP(off) (ptr_at(F, I_WS) + (off))
constexpr size_t WS_GT = 512 * 1024;
constexpr size_t WS_RSA = 256 * 1024, WS_RSB = 320 * 1024;
__device__ __forceinline__ size_t maskt_idx(int m, int w) { const int b = m >> 12, t = m & (S - 1); return ((size_t)(b * 64 + (w >> 1)) * S + t) * 2 + (w & 1); }


#define XB_TMO      128
#define XB_XCNT(j)  (256  + 64 * (j))
#define XB_XSUB(j)  (1280 + 64 * (j))
#define XB_XGEN(j)  (2304 + 64 * (j))
#define XB_TOP      3328
#define XB_TOPGEN   3392
#define XCD_BAR_WORDS 3456
#define XB_SPIN_CAP (1u << 22)
constexpr size_t WS_BAR = 64 * 1024;
constexpr size_t CTL_ZERO_BYTES = 128 * 1024;
__device__ __forceinline__ unsigned xb_ld(unsigned* p)              { return __hip_atomic_load(p, __ATOMIC_RELAXED, __HIP_MEMORY_SCOPE_AGENT); }
__device__ __forceinline__ unsigned xb_add(unsigned* p, unsigned v) { return __hip_atomic_fetch_add(p, v, __ATOMIC_RELAXED, __HIP_MEMORY_SCOPE_AGENT); }
__device__ __forceinline__ unsigned xb_xcc_id() { return (unsigned)__builtin_amdgcn_s_getreg((3 << 11) | 20) & 0xFu; }
#define XB_SPIN(cond, bar) do { unsigned _sp = 0; while (cond) { __builtin_amdgcn_s_sleep(1); \
    if ((++_sp & 255u) == 0u) { if (xb_ld(&(bar)[XB_TMO])) break; if (_sp > XB_SPIN_CAP) { atomicAdd(&(bar)[XB_TMO], 1u); break; } } } } while (0)
struct XcdBarrier { unsigned* bar; unsigned x; volatile LAS unsigned* st; };
__device__ __forceinline__ XcdBarrier xcd_barrier_post(unsigned* bar, volatile LAS unsigned* st) {
    XcdBarrier b; b.bar = bar; b.x = xb_xcc_id(); b.st = st;
    if (threadIdx.x == 0) (void)xb_add(&bar[XB_XCNT(b.x)], 1u);
    return b;
}
__device__ __forceinline__ void xcd_barrier_complete(unsigned* bar, unsigned x, unsigned& nloc, unsigned& nx) {
    const unsigned G = gridDim.x * gridDim.y * gridDim.z;
    unsigned sum, cnt, mine, sp = 0u;
    for (;;) {
        sum = 0u; cnt = 0u; mine = 0u;
#pragma unroll
        for (unsigned j = 0; j < 16; ++j) { const unsigned c = xb_ld(&bar[XB_XCNT(j)]); sum += c; cnt += (c > 0u) ? 1u : 0u; mine = (j == x) ? c : mine; }
        if (sum == G) break;
        __builtin_amdgcn_s_sleep(1);
        if ((++sp & 255u) == 0u) { if (xb_ld(&bar[XB_TMO])) break; if (sp > XB_SPIN_CAP) { atomicAdd(&bar[XB_TMO], 1u); break; } }
    }
    nloc = mine > 0u ? mine : 1u; nx = cnt > 0u ? cnt : 1u;
}
__device__ __forceinline__ void xcd_barrier(const XcdBarrier& b) {
    asm volatile("s_waitcnt vmcnt(0)" ::: "memory");
    __syncthreads();
    if (threadIdx.x == 0) {
        unsigned* bar = b.bar;
        __builtin_amdgcn_s_waitcnt(0);
        unsigned nloc = b.st[0], nx = b.st[1];
        if (nloc == 0u) { xcd_barrier_complete(bar, b.x, nloc, nx); b.st[0] = nloc; b.st[1] = nx; }
        const unsigned old = xb_add(&bar[XB_XSUB(b.x)], 1u);
        const unsigned gen = old / nloc;
        if (old + 1u == (gen + 1u) * nloc) {
            __builtin_amdgcn_fence(__ATOMIC_RELEASE, "agent");
            asm volatile("s_waitcnt vmcnt(0)" ::: "memory");
            const unsigned og = xb_add(&bar[XB_TOP], 1u);
            const unsigned tg = og / nx;
            if (og + 1u == (tg + 1u) * nx) xb_add(&bar[XB_TOPGEN], 1u);
            else XB_SPIN(xb_ld(&bar[XB_TOPGEN]) == tg, bar);
            __builtin_amdgcn_fence(__ATOMIC_ACQUIRE, "agent");
            xb_add(&bar[XB_XGEN(b.x)], 1u);
            asm volatile("s_waitcnt vmcnt(0)" ::: "memory");
        } else {
            XB_SPIN(xb_ld(&bar[XB_XGEN(b.x)]) == gen, bar);
            __builtin_amdgcn_fence(__ATOMIC_ACQUIRE, "agent");
            asm volatile("s_waitcnt vmcnt(0)" ::: "memory");
        }
    }
    __syncthreads();
}

__device__ __forceinline__ int win_src(int p) {
    const int T = p >> 8, q = p & 255, bj = q >> 7, wc = (q >> 5) & 3, j = q & 31, hd = 64 * wc + 32 * bj + j;
    switch (T) {
        case 0: return O_AU + q; case 1: return O_AV + q; case 2: return O_BQ + hd; case 3: return O_BK + hd; case 4: return O_BV + q;
        case 5: return O_QI + hd; case 6: return O_QI + 256 + hd; case 7: return O_CQ + q; case 8: return O_CK + q; case 9: return O_CV + q;
        case 10: return O_CO + q; case 11: return O_DB + q; case 12: return O_DC + q; case 13: return O_DX + q;
        default: break;
    }
    if (wc == 0) return O_KI + 32 * bj + j;
    if (wc == 1 && bj == 0 && j < 16) return j < 8 ? O_WI + j : (j < 12 ? O_CI + (j - 8) : O_CF + (j - 12));
    return -1;
}
__device__ __forceinline__ int wg_src(int p) {
    const int pn = p >> 8, q = p & 255, bj = q >> 7, wc = (q >> 5) & 3, fq = (q >> 3) & 3, n = (q >> 2) & 1, e = q & 3;
    return O_G + (2 * bj + n) * 1024 + 64 * pn + 16 * wc + 4 * fq + e;
}
template <int MAP>
__device__ __forceinline__ void conv_item(const float* W, int K, int srcN, bf16_t* WT, LAS float* scr, int item, int nrows, int lane, const float* gain = nullptr) {
    const int nblk = nrows / 32, kb = item / nblk, nb = item % nblk, k0 = 64 * kb, n0 = 32 * nb;
    const int nn = n0 + (lane & 31); const int src = MAP == 0 ? nn : (MAP == 1 ? win_src(nn) : wg_src(nn));
    float wv_[32]; const float* wp_ = W + (size_t)(k0 + (lane >> 5)) * srcN + (src >= 0 ? src : 0);
#pragma unroll
    for (int i = 0; i < 32; ++i) wv_[i] = __builtin_nontemporal_load(wp_ + (size_t)(2 * i) * srcN);
    const int c = lane & 7; f32x4 g0 = (f32x4){1.f, 1.f, 1.f, 1.f}, g1 = g0;
    if (gain) { g0 = *(const f32x4*)(gain + k0 + 8 * c); g1 = *(const f32x4*)(gain + k0 + 8 * c + 4); }
#pragma unroll
    for (int i = 0; i < 32; ++i) scr[(2 * i + (lane >> 5)) * 33 + (lane & 31)] = src >= 0 ? wv_[i] : 0.f;
    asm volatile("s_waitcnt lgkmcnt(0)" ::: "memory");
#pragma unroll
    for (int j = 0; j < 4; ++j) { const int n = (lane >> 3) + 8 * j; const LAS float* s = scr + (8 * c) * 33 + n;
        u32x4 o; o.x = pk2(s[0 * 33] * g0[0], s[1 * 33] * g0[1]); o.y = pk2(s[2 * 33] * g0[2], s[3 * 33] * g0[3]); o.z = pk2(s[4 * 33] * g1[0], s[5 * 33] * g1[1]); o.w = pk2(s[6 * 33] * g1[2], s[7 * 33] * g1[3]);
        *(u32x4*)(WT + (size_t)(n0 + n) * K + k0 + 8 * c) = o; }
    asm volatile("s_waitcnt lgkmcnt(0)" ::: "memory");
}
template <int MAP>
__device__ __forceinline__ void conv_item8(const float* W, int K, int srcN, unsigned char* WT8, LAS float* scr, int item, int nrows, int lane, const float* gain, float scale) {
    const int nblk = nrows / 32, kb = item / nblk, nb = item % nblk, k0 = 64 * kb, n0 = 32 * nb;
    const int nn = n0 + (lane & 31); const int src = MAP == 0 ? nn : (MAP == 1 ? win_src(nn) : wg_src(nn));
    float wv_[32]; const float* wp_ = W + (size_t)(k0 + (lane >> 5)) * srcN + (src >= 0 ? src : 0);
#pragma unroll
    for (int i = 0; i < 32; ++i) wv_[i] = __builtin_nontemporal_load(wp_ + (size_t)(2 * i) * srcN);
    const int c = lane & 7; const f32x4 g0 = *(const f32x4*)(gain + k0 + 8 * c), g1 = *(const f32x4*)(gain + k0 + 8 * c + 4);
#pragma unroll
    for (int i = 0; i < 32; ++i) scr[(2 * i + (lane >> 5)) * 33 + (lane & 31)] = src >= 0 ? wv_[i] : 0.f;
    asm volatile("s_waitcnt lgkmcnt(0)" ::: "memory");
#pragma unroll
    for (int j = 0; j < 4; ++j) { const int n = (lane >> 3) + 8 * j; const LAS float* s = scr + (8 * c) * 33 + n;
        u32x2 o; o.x = pk4_fp8(s[0 * 33] * g0[0] * scale, s[1 * 33] * g0[1] * scale, s[2 * 33] * g0[2] * scale, s[3 * 33] * g0[3] * scale); o.y = pk4_fp8(s[4 * 33] * g1[0] * scale, s[5 * 33] * g1[1] * scale, s[6 * 33] * g1[2] * scale, s[7 * 33] * g1[3] * scale);
        *(u32x2*)(WT8 + (size_t)(n0 + n) * K + k0 + 8 * c) = o; }
    asm volatile("s_waitcnt lgkmcnt(0)" ::: "memory");
}
__device__ __forceinline__ void convert_mix_weights(Frame& F, int l, int part, int w, int nw) {
    LAS float* scr = (LAS float*)(F.lds + F.wave * 16384);
    const int gw = w * NWAVES + F.wave, NGW = nw * NWAVES;
    constexpr int I_WIN = (D / 64) * (PW / 32), I_WG = (D / 64) * (4096 / 32), I_BR = (256 / 64) * (1024 / 32), I_WO = (D / 64) * (D / 32);
    const float* win = INP(I_W_IN) + (size_t)l * D * INW; const float* gmix = INP(I_LN_MIX) + l * D;
    if (part == 0) { for (int it = gw; it < I_WIN; it += NGW) conv_item<1>(win, D, INW, ((bf16_t*)WSP(WS_WIN)), scr, it, PW, (F.tid & 63), gmix); return; }
    for (int it = gw; it < I_WG + 4 * I_BR + I_WO; it += NGW) {
        int r = it;
        if (r < I_WG) { conv_item8<2>(win, D, INW, ptr_at(F, I_OUT) + OUT_WG8 + (size_t)l * 4 * MiB, scr, r, 4096, (F.tid & 63), gmix, WG8_SCALE); continue; } r -= I_WG;
        if (r < 4 * I_BR) { const int nb = r / I_BR; conv_item<0>(INP(I_W_BRANCH) + ((size_t)l * 4 + nb) * 256 * D, 256, D, ((bf16_t*)WSP(WS_WBR)) + (size_t)nb * 1024 * 256, scr, r % I_BR, 1024, (F.tid & 63)); continue; } r -= 4 * I_BR;
        conv_item<0>(INP(I_W_OUT) + (size_t)l * D * D, D, D, ((bf16_t*)WSP(WS_WOUT)), scr, r, D, (F.tid & 63));
    }
}
__device__ __forceinline__ void convert_mlp_weights(Frame& F, int l) {

    LAS float* scr = (LAS float*)(F.lds + F.wave * 16384);
    const int gw = F.vcu * NWAVES + F.wave, NGW = F.G * NWAVES;
    constexpr int I_UP = (D / 64) * (FF / 32), I_DN = (FF / 64) * (D / 32);
    for (int it = gw; it < I_UP + I_DN; it += NGW) {
        if (it < I_UP) conv_item<0>(INP(I_W_UP) + (size_t)l * D * FF, D, FF, ((bf16_t*)WSP(WS_WUP)), scr, it, FF, (F.tid & 63), INP(I_LN_MLP) + l * D);
        else conv_item<0>(INP(I_W_DOWN) + (size_t)l * FF * D, FF, D, ((bf16_t*)WSP(WS_WDN)), scr, it - I_UP, D, (F.tid & 63));
    }
}
__device__ __forceinline__ void prologue_rows(Frame& F) {
    float* COS = (float*)WSP(WS_COS); float* SIN = (float*)WSP(WS_SIN); float* SSQA = (float*)WSP(WS_SSQA); bf16_t* XG = (bf16_t*)WSP(WS_XG); const float* x = INP(I_X); const float* ln_mix = INP(I_LN_MIX);
    const int gt = F.vcu * NT + F.tid, NGT = F.G * NT;
    for (int i = gt; i < S * 32; i += NGT) { const int pos = i >> 5, k = i & 31; const float inv = powf(10000.f, -(float)k * 2.0f / 64.f); const float ang = (float)pos * inv; COS[i] = cosf(ang); SIN[i] = sinf(ang); }
    const int gw = F.vcu * NWAVES + F.wave, NGW = F.G * NWAVES;
    unsigned char* x8p = ptr_at(F, I_OUT) + OUT_X8;
    for (int m0 = gw * 4; m0 < M; m0 += NGW * 4) {
        f32x4 v[4][4];
#pragma unroll
        for (int r = 0; r < 4; ++r)
#pragma unroll
            for (int j = 0; j < 4; ++j) v[r][j] = __builtin_nontemporal_load((const f32x4*)(x + (size_t)(m0 + r) * D) + (F.tid & 63) + 64 * j);
#pragma unroll
        for (int r = 0; r < 4; ++r) { float s = 0.f; unsigned long long* o8 = (unsigned long long*)(XG + (size_t)(m0 + r) * D) + (F.tid & 63);
#pragma unroll
            for (int j = 0; j < 4; ++j) { const f32x4 w = v[r][j]; s += (w[0] * w[0] + w[1] * w[1]) + (w[2] * w[2] + w[3] * w[3]);
                o8[64 * j] = (unsigned long long)pk2(w[0], w[1]) | ((unsigned long long)pk2(w[2], w[3]) << 32);
                ((unsigned*)(x8p + (size_t)(m0 + r) * D))[(F.tid & 63) + 64 * j] = pk4_fp8(w[0], w[1], w[2], w[3]); }
            s = wave_sum(s);
            if ((F.tid & 63) < 16) SSQA[(size_t)(m0 + r) * 16 + (F.tid & 63)] = (F.tid & 63) == 0 ? s : 0.f; }
    }
}
__device__ __forceinline__ void finalize_rs(Frame& F, size_t ssq_off, size_t rs_off) {
    const float* ssq = (const float*)WSP(ssq_off); float* rs = (float*)WSP(rs_off);
    for (int row = F.vcu * NT + F.tid; row < M; row += F.G * NT) { const f32x4* sp = (const f32x4*)(ssq + (size_t)row * 16); const f32x4 a = sp[0], b = sp[1], c = sp[2], d = sp[3];
        const float t = ((a[0] + a[1]) + (a[2] + a[3])) + ((b[0] + b[1]) + (b[2] + b[3])) + ((c[0] + c[1]) + (c[2] + c[3])) + ((d[0] + d[1]) + (d[2] + d[3]));
        rs[row] = rsqrtf(t * (1.0f / 1024.0f) + EPS); }
}

__device__ __forceinline__ void conv_simple(Frame& F, int l, int tl, int it0, int it1) {
    bf16_t* PROJ = (bf16_t*)WSP(WS_BIG); bf16_t* Y = (bf16_t*)WSP(WS_Y); const float* conv_w = INP(I_CONV_W);
    const float* cw = conv_w + l * 3 * 256;
    for (int it = it0, i = (it0 * F.G + F.vcu) * 256 + tl; it < it1 && i < M * 32; ++it, i += F.G * 256) { const int m = i >> 5, c = (i & 31) * 8, t = m & (S - 1); float acc[8];
#pragma unroll
        for (int e = 0; e < 8; ++e) acc[e] = 0.f;
#pragma unroll
        for (int j = 0; j < 3; ++j) { const int tt = t - 2 + j; if (tt >= 0) { const size_t r = (size_t)(m - 2 + j) * PW; const u32x4 a = *(const u32x4*)(PROJ + r + P_DC + c), x = *(const u32x4*)(PROJ + r + P_DX + c);
                const f32x4 w0 = *(const f32x4*)(cw + j * 256 + c), w1 = *(const f32x4*)(cw + j * 256 + c + 4);
                acc[0] = fmaf(w0[0], lo_bf(a.x) * lo_bf(x.x), acc[0]); acc[1] = fmaf(w0[1], hi_bf(a.x) * hi_bf(x.x), acc[1]); acc[2] = fmaf(w0[2], lo_bf(a.y) * lo_bf(x.y), acc[2]); acc[3] = fmaf(w0[3], hi_bf(a.y) * hi_bf(x.y), acc[3]);
                acc[4] = fmaf(w1[0], lo_bf(a.z) * lo_bf(x.z), acc[4]); acc[5] = fmaf(w1[1], hi_bf(a.z) * hi_bf(x.z), acc[5]); acc[6] = fmaf(w1[2], lo_bf(a.w) * lo_bf(x.w), acc[6]); acc[7] = fmaf(w1[3], hi_bf(a.w) * hi_bf(x.w), acc[7]); } }
        const u32x4 bq = *(const u32x4*)(PROJ + (size_t)m * PW + P_DB + c); u32x4 o;
        o.x = cvt_pk_bf16(lo_bf(bq.x) * acc[0], hi_bf(bq.x) * acc[1]); o.y = cvt_pk_bf16(lo_bf(bq.y) * acc[2], hi_bf(bq.y) * acc[3]); o.z = cvt_pk_bf16(lo_bf(bq.z) * acc[4], hi_bf(bq.z) * acc[5]); o.w = cvt_pk_bf16(lo_bf(bq.w) * acc[6], hi_bf(bq.w) * acc[7]);
        *(u32x4*)(Y + (size_t)m * D + 768 + c) = o; }
}
typedef float f32x16 __attribute__((ext_vector_type(16)));
constexpr size_t WS_VT = WS_BIG + 120 * MiB;
constexpr float LOG2E = 1.4426950408889634f;

template <int R> struct AttExp {
    static __device__ __forceinline__ void run(f32x16& p0, f32x16& p1, unsigned sh0, unsigned sh1, float& lsum) {
        constexpr int CB = (R & 3) + 8 * (R >> 2);
        int m0, m1; asm("v_bfe_i32 %0, %1, %2, 1" : "=v"(m0) : "v"(sh0), "n"(CB)); asm("v_bfe_i32 %0, %1, %2, 1" : "=v"(m1) : "v"(sh1), "n"(CB));
        p0[R] = __uint_as_float(__float_as_uint(__builtin_amdgcn_exp2f(p0[R])) & (unsigned)m0); p1[R] = __uint_as_float(__float_as_uint(__builtin_amdgcn_exp2f(p1[R])) & (unsigned)m1);
        lsum += p0[R] + p1[R];
        AttExp<R + 1>::run(p0, p1, sh0, sh1, lsum);
    }
};
template <> struct AttExp<16> { static __device__ __forceinline__ void run(f32x16&, f32x16&, unsigned, unsigned, float&) {} };

__device__ __forceinline__ void attn_mfma(Frame& F, int l) {
    const unsigned long long* MASKT = (const unsigned long long*)WSP(WS_MASK); const bf16_t* PROJ = (const bf16_t*)WSP(WS_BIG); const bf16_t* VT = (const bf16_t*)WSP(WS_VT);
    bf16_t* Y = (bf16_t*)WSP(WS_Y); const float* gt = (const float*)WSP(WS_GT) + l * 192;
    const int lane = (F.tid & 63), r32 = lane & 31, hi = lane >> 5, grp = F.wave >> 2, w4 = F.wave & 3, lg = F.tid & 255;
    const float mq = wave_max(fabsf(gt[lane])), mk = wave_max(fabsf(gt[64 + lane]));
    const float c2 = 8.f * mq * mk * 1.01f * LOG2E;
    constexpr int ROWB = 144, TILEB = 64 * ROWB;
    LAS unsigned char* gb = F.lds + grp * 4 * TILEB;
    LAS float* comb = (LAS float*)(F.lds + 8 * TILEB);
    const int srow0 = lg >> 3, sc0 = lg & 7;
    for (int item = F.vcu; item < 256; item += F.G) {
        const int bh = item >> 4, sidx = item & 15, b = bh >> 2, h = bh & 3;
#pragma unroll 1
        for (int half = 0; half < 2; ++half) {
            const int qb = half == 0 ? sidx : 31 - sidx, q0 = qb * 128, ntl = qb + 1;
            const int qrow = b * S + q0 + w4 * 32 + r32, tq = q0 + w4 * 32 + r32;
            bf16x8 qf[4];
#pragma unroll
            for (int s = 0; s < 4; ++s) qf[s] = *(const bf16x8*)(PROJ + (size_t)qrow * PW + P_Q + h * 64 + 16 * s + 8 * hi);
            f32x16 o0, o1;
#pragma unroll
            for (int r = 0; r < 16; ++r) { o0[r] = 0.f; o1[r] = 0.f; }
            float lsum = 0.f;
            const bf16_t* kbase = PROJ + (size_t)(b * S + srow0) * PW + P_K + h * 64 + sc0 * 8;
            const bf16_t* vbase = VT + (size_t)(b * 256 + h * 64 + srow0) * S + sc0 * 8;
            const unsigned long long* mbase = MASKT + (size_t)(b * 64) * S + tq;
            u32x4 ka0, ka1, va0, va1, kb0, kb1, vb0, vb1; unsigned long long mwa = 0ull, mwb = 0ull;
#define ATT_LOAD(K0, K1, V0, V1, MW, t_) do { const int t__ = (t_); K0 = *(const u32x4*)(kbase + (size_t)t__ * 64 * PW); K1 = *(const u32x4*)(kbase + (size_t)(t__ * 64 + 32) * PW); \
    V0 = *(const u32x4*)(vbase + t__ * 64); V1 = *(const u32x4*)(vbase + 32 * S + t__ * 64); MW = mbase[(size_t)t__ * S]; } while (0)
#define ATT_STORE(K0, K1, V0, V1, buf_) do { LAS unsigned char* kn_ = gb + (buf_) * 2 * TILEB; LAS unsigned char* vn_ = kn_ + TILEB; \
    *(LAS u32x4*)(kn_ + srow0 * ROWB + sc0 * 16) = K0; *(LAS u32x4*)(kn_ + (srow0 + 32) * ROWB + sc0 * 16) = K1; \
    *(LAS u32x4*)(vn_ + srow0 * ROWB + sc0 * 16) = V0; *(LAS u32x4*)(vn_ + (srow0 + 32) * ROWB + sc0 * 16) = V1; } while (0)
#define ATT_COMPUTE(cur_, MW) do { \
                const LAS unsigned char* kb = gb + (cur_) * 2 * TILEB; const LAS unsigned char* vb = kb + TILEB; \
                f32x16 p0, p1; \
                _Pragma("unroll") for (int r = 0; r < 16; ++r) { p0[r] = -c2; p1[r] = -c2; }     \
                _Pragma("unroll") for (int s = 0; s < 4; ++s) { \
                    const bf16x8 k0 = *(const LAS bf16x8*)(kb + r32 * ROWB + 32 * s + 16 * hi), k1 = *(const LAS bf16x8*)(kb + (32 + r32) * ROWB + 32 * s + 16 * hi); \
                    p0 = __builtin_amdgcn_mfma_f32_32x32x16_bf16(k0, qf[s], p0, 0, 0, 0); p1 = __builtin_amdgcn_mfma_f32_32x32x16_bf16(k1, qf[s], p1, 0, 0, 0); } \
                const unsigned sh0 = (unsigned)(MW) >> (4 * hi), sh1 = (unsigned)((MW) >> 32) >> (4 * hi); \
                AttExp<0>::run(p0, p1, sh0, sh1, lsum); \
                _Pragma("unroll") for (int ks = 0; ks < 4; ++ks) { \
                    u32x4 pw; \
                    if (ks < 2) { pw.x = cvt_pk_bf16(p0[8 * ks + 0], p0[8 * ks + 1]); pw.y = cvt_pk_bf16(p0[8 * ks + 2], p0[8 * ks + 3]); pw.z = cvt_pk_bf16(p0[8 * ks + 4], p0[8 * ks + 5]); pw.w = cvt_pk_bf16(p0[8 * ks + 6], p0[8 * ks + 7]); } \
                    else { const int k2 = ks - 2; pw.x = cvt_pk_bf16(p1[8 * k2 + 0], p1[8 * k2 + 1]); pw.y = cvt_pk_bf16(p1[8 * k2 + 2], p1[8 * k2 + 3]); pw.z = cvt_pk_bf16(p1[8 * k2 + 4], p1[8 * k2 + 5]); pw.w = cvt_pk_bf16(p1[8 * k2 + 6], p1[8 * k2 + 7]); } \
                    const bf16x8 pf = __builtin_bit_cast(bf16x8, pw); \
                    const int vo = 64 * (ks >> 1) + 32 * (ks & 1) + 8 * hi; \
                    const u32x2 a0 = *(const LAS u32x2*)(vb + r32 * ROWB + vo), a1 = *(const LAS u32x2*)(vb + r32 * ROWB + vo + 16); \
                    const u32x2 b0 = *(const LAS u32x2*)(vb + (32 + r32) * ROWB + vo), b1 = *(const LAS u32x2*)(vb + (32 + r32) * ROWB + vo + 16); \
                    const u32x4 va = {a0.x, a0.y, a1.x, a1.y}, vb4 = {b0.x, b0.y, b1.x, b1.y}; \
                    o0 = __builtin_amdgcn_mfma_f32_32x32x16_bf16(__builtin_bit_cast(bf16x8, va), pf, o0, 0, 0, 0); \
                    o1 = __builtin_amdgcn_mfma_f32_32x32x16_bf16(__builtin_bit_cast(bf16x8, vb4), pf, o1, 0, 0, 0); } \
            } while (0)
            ATT_LOAD(ka0, ka1, va0, va1, mwa, grp);
            if (ntl > 1) ATT_LOAD(kb0, kb1, vb0, vb1, mwb, 2 + grp);
            ATT_STORE(ka0, ka1, va0, va1, 0);
            __syncthreads();
            asm volatile(".p2align 8");
#pragma unroll 1
            for (int i = 0; i < ntl; i += 2) {
                const unsigned long long mw0 = mwa;
                if (i + 2 < ntl) ATT_LOAD(ka0, ka1, va0, va1, mwa, 2 * (i + 2) + grp);
                ATT_COMPUTE(0, mw0);
                if (i + 1 < ntl) ATT_STORE(kb0, kb1, vb0, vb1, 1);
                __syncthreads();
                if (i + 1 < ntl) {
                    const unsigned long long mw1 = mwb;
                    if (i + 3 < ntl) ATT_LOAD(kb0, kb1, vb0, vb1, mwb, 2 * (i + 3) + grp);
                    ATT_COMPUTE(1, mw1);
                    if (i + 2 < ntl) ATT_STORE(ka0, ka1, va0, va1, 0);
                    __syncthreads();
                }
            }
#undef ATT_LOAD
#undef ATT_STORE
#undef ATT_COMPUTE
            if (grp == 1) { LAS float* cw = comb + w4 * 33 * 64 + lane;
#pragma unroll
                for (int r = 0; r < 16; ++r) { cw[r * 64] = o0[r]; cw[(16 + r) * 64] = o1[r]; }
                cw[32 * 64] = lsum; }
            __syncthreads();
            if (grp == 0) { const LAS float* cw = comb + w4 * 33 * 64 + lane;
#pragma unroll
                for (int r = 0; r < 16; ++r) { o0[r] += cw[r * 64]; o1[r] += cw[(16 + r) * 64]; }
                lsum += cw[32 * 64]; lsum = xs32(lsum); const float inv = 1.f / lsum;
                bf16_t* yp = Y + (size_t)qrow * D + 256 + h * 64 + 4 * hi;
#pragma unroll
                for (int g4 = 0; g4 < 4; ++g4) { u32x2 w0, w1;
                    w0.x = cvt_pk_bf16(o0[4 * g4] * inv, o0[4 * g4 + 1] * inv); w0.y = cvt_pk_bf16(o0[4 * g4 + 2] * inv, o0[4 * g4 + 3] * inv);
                    w1.x = cvt_pk_bf16(o1[4 * g4] * inv, o1[4 * g4 + 1] * inv); w1.y = cvt_pk_bf16(o1[4 * g4 + 2] * inv, o1[4 * g4 + 3] * inv);
                    *(u32x2*)(yp + 8 * g4) = w0; *(u32x2*)(yp + 32 + 8 * g4) = w1; } }
            __syncthreads();
        }
    }
}

constexpr size_t WS_KI = 234 * MiB;
template <int J, unsigned MSK>
__device__ __forceinline__ void tr_stage(unsigned (&a)[32]) {
#pragma unroll
    for (int k = 0; k < 32; ++k) if ((k & J) == 0) { const unsigned x = a[k], y = a[k + J]; a[k] = (x & ~MSK) | ((y >> J) & MSK); a[k + J] = (y & ~(MSK << J)) | ((x << J) & (MSK << J)); }
}
__device__ __forceinline__ void transpose32(unsigned (&a)[32]) {
#pragma unroll
    for (int k = 0; k < 16; ++k) { const unsigned x = a[k], y = a[k + 16]; a[k] = __builtin_amdgcn_perm(x, y, 0x07060302u); a[k + 16] = __builtin_amdgcn_perm(x, y, 0x05040100u); }
#pragma unroll
    for (int k = 0; k < 32; ++k) if ((k & 8) == 0) { const unsigned x = a[k], y = a[k + 8]; a[k] = __builtin_amdgcn_perm(x, y, 0x07030501u); a[k + 8] = __builtin_amdgcn_perm(x, y, 0x06020400u); }
    tr_stage<4, 0x0F0F0F0Fu>(a); tr_stage<2, 0x33333333u>(a); tr_stage<1, 0x55555555u>(a);
}
__device__ __forceinline__ int wave_total_i(int v) {
    v += __builtin_amdgcn_update_dpp(0, v, 0x111, 0xf, 0xf, false);
    v += __builtin_amdgcn_update_dpp(0, v, 0x112, 0xf, 0xf, false);
    v += __builtin_amdgcn_update_dpp(0, v, 0x114, 0xf, 0xf, false);
    v += __builtin_amdgcn_update_dpp(0, v, 0x118, 0xf, 0xf, false);
    v += __builtin_amdgcn_update_dpp(0, v, 0x142, 0xa, 0xf, false);
    v += __builtin_amdgcn_update_dpp(0, v, 0x143, 0xc, 0xf, false);
    return __builtin_amdgcn_readlane(v, 63);
}
typedef short i16x2 __attribute__((ext_vector_type(2)));
__device__ __forceinline__ unsigned pk_relu_bf16(unsigned x) { const i16x2 v = __builtin_bit_cast(i16x2, x), z = {0, 0}; return __builtin_bit_cast(unsigned, __builtin_elementwise_max(v, z)); }
__device__ __forceinline__ void idx_score(Frame& F, const int b, const int t0, LAS unsigned short* sc16, const int sw, const int prevn) {
    if (t0 + 8 <= 256) return;
    const float* MISC = (const float*)WSP(WS_MISC); const bf16_t* PROJ = (const bf16_t*)WSP(WS_BIG); const bf16_t* KI = (const bf16_t*)WSP(WS_KI);
    const int lane = (F.tid & 63), r32 = lane & 31, hi = lane >> 5, m0 = b * S + t0;
    const int nmax = t0 + 8, ntile = (nmax + 31) >> 5;
    bf16x8 qa[2][4], wsel[2][2];
#pragma unroll
    for (int i = 0; i < 2; ++i) {
        const bf16_t* qp = PROJ + (size_t)(m0 + 4 * i + (r32 >> 3)) * PW + P_QI + (r32 & 7) * 64 + 8 * hi;
#pragma unroll
        for (int s = 0; s < 4; ++s) qa[i][s] = *(const bf16x8*)(qp + 16 * s);
    }
    const int qrow = r32 & 7; const f32x4 w4 = *(const f32x4*)(MISC + (size_t)(m0 + qrow) * 16 + 4 * hi);
    bf16x8 kring[2][4];
    const bf16_t* kbase_ = KI + ((size_t)(b * S >> 5) * 4 * 64 + lane) * 8;
#define IDX_LOADK(u_, j_) do { const int jt_ = (j_) < ntile ? (j_) : ntile - 1; const bf16_t* kp_ = kbase_ + (unsigned)jt_ * 2048u; \
    _Pragma("unroll") for (int s_ = 0; s_ < 4; ++s_) kring[u_][s_] = *(const bf16x8*)(kp_ + s_ * 64 * 8); } while (0)
#pragma unroll
    for (int u = 0; u < 2; ++u) IDX_LOADK(u, sw + 4 * u);
    __builtin_amdgcn_sched_barrier(0);
#pragma unroll
    for (int i = 0; i < 2; ++i)
#pragma unroll
        for (int s = 0; s < 4; ++s) asm volatile("" : "+v"(qa[i][s]));
    { const float sc_ = 0.125f * 0.35355339059327373f; const unsigned p01 = cvt_pk_bf16(w4[0] * sc_, w4[1] * sc_), p23 = cvt_pk_bf16(w4[2] * sc_, w4[3] * sc_);
#pragma unroll
      for (int i = 0; i < 2; ++i)
#pragma unroll
          for (int s = 0; s < 2; ++s) { const bool mine = (r32 < 8) && ((qrow >> 2) == i) && (((qrow & 3) >> 1) == s); const bool upper = (qrow & 1) != 0;
              u32x4 f; f.x = (mine && !upper) ? p01 : 0u; f.y = (mine && !upper) ? p23 : 0u; f.z = (mine && upper) ? p01 : 0u; f.w = (mine && upper) ? p23 : 0u;
              asm volatile("" : "+v"(f));
              wsel[i][s] = __builtin_bit_cast(bf16x8, f); } }
    f32x16 dd[2][2];
#define IDX_DSTEP(slot_, par_, s_) do { _Pragma("unroll") for (int i_ = 0; i_ < 2; ++i_) dd[par_][i_] = __builtin_amdgcn_mfma_f32_32x32x16_bf16(qa[i_][s_], kring[slot_][s_], dd[par_][i_], 0, 0, 0); } while (0)
#define IDX_WSTEP(par_, i_, s_) do { u32x4 rw_; const f32x16& d_ = dd[par_][i_];     \
        rw_.x = pk_relu_bf16(cvt_pk_bf16(d_[8 * (s_) + 0], d_[8 * (s_) + 1])); rw_.y = pk_relu_bf16(cvt_pk_bf16(d_[8 * (s_) + 2], d_[8 * (s_) + 3])); \
        rw_.z = pk_relu_bf16(cvt_pk_bf16(d_[8 * (s_) + 4], d_[8 * (s_) + 5])); rw_.w = pk_relu_bf16(cvt_pk_bf16(d_[8 * (s_) + 6], d_[8 * (s_) + 7])); \
        outv = __builtin_amdgcn_mfma_f32_32x32x16_bf16(wsel[i_][s_], __builtin_bit_cast(bf16x8, rw_), outv, 0, 0, 0); } while (0)
#pragma unroll
    for (int i = 0; i < 2; ++i)
#pragma unroll
        for (int r = 0; r < 16; ++r) dd[0][i][r] = 0.f;
#pragma unroll
    for (int s = 0; s < 4; ++s) IDX_DSTEP(0, 0, s);
    __builtin_amdgcn_sched_barrier(0);
    IDX_LOADK(0, sw + 8);
    __builtin_amdgcn_sched_barrier(0);
    asm volatile(".p2align 8");
    for (int jb = sw; jb < ntile; jb += 8) {
#pragma unroll
        for (int u = 0; u < 2; ++u) {
            const int j = jb + 4 * u;
            const int key = 32 * j + r32;
            f32x16 outv;
#pragma unroll
            for (int r = 0; r < 16; ++r) { outv[r] = 0.f; dd[(u + 1) & 1][0][r] = 0.f; dd[(u + 1) & 1][1][r] = 0.f; }
            IDX_DSTEP((u + 1) & 1, (u + 1) & 1, 0); IDX_WSTEP(u & 1, 0, 0);
            IDX_DSTEP((u + 1) & 1, (u + 1) & 1, 1); IDX_WSTEP(u & 1, 0, 1);
            IDX_DSTEP((u + 1) & 1, (u + 1) & 1, 2); IDX_WSTEP(u & 1, 1, 0);
            IDX_DSTEP((u + 1) & 1, (u + 1) & 1, 3); IDX_WSTEP(u & 1, 1, 1);
            __builtin_amdgcn_sched_barrier(0);
            IDX_LOADK((u + 1) & 1, j + 4 + 8);
            __builtin_amdgcn_sched_barrier(0);
            if (j < ntile) {
                const int kpos = ((key & 2047) << 1) + (key >> 11);
                if (32 * j + 31 <= t0) {
#pragma unroll
                    for (int qq = 0; qq < 4; ++qq) sc16[(4 * hi + qq) * 4096 + kpos] = __builtin_bit_cast(unsigned short, (_Float16)outv[qq]);
                } else {
#pragma unroll
                    for (int qq = 0; qq < 4; ++qq) { const int qx = 4 * hi + qq;
                        sc16[qx * 4096 + kpos] = __builtin_bit_cast(unsigned short, (_Float16)((key <= t0 + qx) ? outv[qq] : -INFINITY)); }
                }
            }
        }
    }
#undef IDX_DSTEP
#undef IDX_WSTEP
    for (int j = ntile + ((sw - ntile) & 3); j < prevn; j += 4) {
        const int key = 32 * j + r32, kpos = ((key & 2047) << 1) + (key >> 11);
#pragma unroll
        for (int qq = 0; qq < 4; ++qq) sc16[(4 * hi + qq) * 4096 + kpos] = (unsigned short)0xFC00u;
    }
#undef IDX_LOADK
}
#define IDX_WL2(lo_, hi_, bal_, lane_) asm("s_nop 1\n\tv_writelane_b32 %0, %2, %4\n\tv_writelane_b32 %1, %3, %4" : "+v"(lo_), "+v"(hi_) : "s"((unsigned)(bal_)), "s"((unsigned)((bal_) >> 32)), "n"(lane_))
__device__ __forceinline__ void idx_select_short(Frame& F, const int b, const int t0, const LAS unsigned short* sc16, const int qw) {
    unsigned long long* MASKT = (unsigned long long*)WSP(WS_MASK);
    const int lane = (F.tid & 63);
    const LAS unsigned* sA = (const LAS unsigned*)sc16 + qw * 2048 + lane; const LAS unsigned* sB = sA + 4 * 2048;
    unsigned kk[32], kc[32];
#pragma unroll
    for (int r = 0; r < 32; ++r) { const unsigned w = __builtin_amdgcn_perm(sB[64 * r], sA[64 * r], 0x05040100u); const unsigned sg = (w & 0x80008000u) >> 15; kc[r] = w ^ (((sg << 16) - sg) | 0x80008000u); kk[r] = kc[r]; }
    transpose32(kk);
    unsigned aA = ~0u, aB = ~0u, TA = 0u, TB = 0u; int baseA = 0, baseB = 0;
#pragma unroll
    for (int bit = 15; bit >= 0; --bit) {
        const unsigned wa = kk[31 - bit], wb = kk[15 - bit];
        const int tot2 = wave_total_i(__builtin_popcount(wa & aA) + (__builtin_popcount(wb & aB) << 16));
        const int totA = tot2 & 0xFFFF, totB = (int)((unsigned)tot2 >> 16);
        const bool takeA = (baseA + totA >= 256), takeB = (baseB + totB >= 256);
        aA &= (wa ^ (takeA ? 0u : ~0u)); aB &= (wb ^ (takeB ? 0u : ~0u));
        if (takeA) TA |= (1u << bit); else baseA += totA;
        if (takeB) TB |= (1u << bit); else baseB += totB;
    }
    const int neq2 = wave_total_i(__builtin_popcount(aA) + (__builtin_popcount(aB) << 16));
#pragma unroll
    for (int qi = 0; qi < 2; ++qi) {
        const int tq = t0 + qw + 4 * qi; const unsigned Tk = qi ? TB : TA; const int ngt = qi ? baseB : baseA, neq = qi ? (int)((unsigned)neq2 >> 16) : (neq2 & 0xFFFF);
        unsigned mlo = 0u, mhi = 0u;
        if (ngt + neq == 256) {
#pragma unroll
            for (int r = 0; r < 32; ++r) { const unsigned long long wl = __ballot((qi ? (kc[r] >> 16) : (kc[r] & 0xFFFFu)) >= Tk); IDX_WL2(mlo, mhi, wl, r); }
        } else {
            int need = 256 - ngt;
#pragma unroll
            for (int r = 0; r < 32; ++r) { const unsigned k = qi ? (kc[r] >> 16) : (kc[r] & 0xFFFFu);
                unsigned long long wsel = __ballot(k > Tk), em = __ballot(k == Tk); int c = __builtin_popcountll(em);
                if (c > need) { while (c > need) { em &= ~(1ull << (63 - __builtin_clzll(em))); --c; } }
                need -= c; wsel |= em;
                IDX_WL2(mlo, mhi, wsel, r); }
        }
        MASKT[(size_t)(b * 64 + lane) * S + tq] = ((unsigned long long)mhi << 32) | mlo;
    }
}
__device__ __forceinline__ void idx_select(Frame& F, const int b, const int t0, const LAS unsigned short* sc16, const int qw) {
    unsigned long long* MASKT = (unsigned long long*)WSP(WS_MASK);
    const int lane = (F.tid & 63);
    if (t0 + 8 > 256 && t0 + 8 <= 2048) { idx_select_short(F, b, t0, sc16, qw); return; }
#pragma unroll 1
    for (int qi = 0; qi < 2; ++qi) {
        const int qx = qw + 4 * qi, tq = t0 + qx;
        unsigned long long myword = 0ull;
        if (t0 + 8 <= 256) {
            const int lo = 64 * lane; myword = (tq >= lo + 63) ? ~0ull : (tq < lo ? 0ull : ((2ull << (tq - lo)) - 1ull));
            MASKT[(size_t)(b * 64 + lane) * S + tq] = myword;
            continue;
        }
        const int nmax = t0 + 8, ntile = (nmax + 31) >> 5;
        const int nvalid = 32 * ntile; const LAS unsigned* srow = (const LAS unsigned*)sc16 + qx * 2048 + lane;
        unsigned kk[32], kc[32];
#pragma unroll
        for (int r = 0; r < 32; ++r) { const unsigned w = srow[64 * r]; const unsigned sg = (w & 0x80008000u) >> 15; kc[r] = w ^ (((sg << 16) - sg) | 0x80008000u); kk[r] = kc[r]; }
        transpose32(kk);
        unsigned aA = ~0u, aB = ~0u, Tk = 0u; int base = 0;
#pragma unroll
        for (int bit = 15; bit >= 0; --bit) {
            const unsigned wa = kk[31 - bit], wb = kk[15 - bit];
            const int tot = wave_total_i(__builtin_popcount(wa & aA) + __builtin_popcount(wb & aB));
            const bool take = (base + tot >= 256);
            const unsigned flip = take ? 0u : ~0u;
            aA &= (wa ^ flip); aB &= (wb ^ flip);
            if (take) Tk |= (1u << bit); else base += tot;
        }
        const int ngt = base, neq = wave_total_i(__builtin_popcount(aA) + __builtin_popcount(aB));
        unsigned mlo = 0u, mhi = 0u;
        if (ngt + neq == 256) {
#pragma unroll
            for (int r = 0; r < 32; ++r) { const unsigned long long wlo = __ballot((kc[r] & 0xFFFFu) >= Tk); IDX_WL2(mlo, mhi, wlo, r); }
            if (nvalid > 2048) {
#pragma unroll
                for (int r = 0; r < 32; ++r) { const unsigned long long whi = __ballot((kc[r] >> 16) >= Tk); IDX_WL2(mlo, mhi, whi, 32 + r); } }
        } else {
            int need = 256 - ngt;
#pragma unroll
            for (int hf = 0; hf < 2; ++hf) if (hf == 0 || nvalid > 2048)
#pragma unroll
                for (int r = 0; r < 32; ++r) { const unsigned k = hf ? (kc[r] >> 16) : (kc[r] & 0xFFFFu);
                    unsigned long long wsel = __ballot(k > Tk), em = __ballot(k == Tk); int c = __builtin_popcountll(em);
                    if (c > need) { while (c > need) { em &= ~(1ull << (63 - __builtin_clzll(em))); --c; } }
                    need -= c; wsel |= em;
                    IDX_WL2(mlo, mhi, wsel, 32 * hf + r); }
        }
        myword = ((unsigned long long)mhi << 32) | mlo;
        MASKT[(size_t)(b * 64 + lane) * S + tq] = myword;
    }
}
__device__ __forceinline__ void indexer_mfma(Frame& F, int l) {
    const int wv = F.wave;
    const int npi = (1024 - F.vcu + F.G - 1) / F.G, n = 2 * npi;
#define IDX_UNIT(idx_, b_, t0_) const int pi_##b_ = F.vcu + ((idx_) < npi ? (idx_) : (idx_) - npi) * F.G; const int b_ = pi_##b_ >> 8; const int t0_ = 8 * ((idx_) < npi ? 511 - (pi_##b_ & 255) : (pi_##b_ & 255))
    int prevn0 = 128, prevn1 = 128;
#define IDX_NT(t0_) (((t0_) + 8 <= 256) ? -1 : (((t0_) + 8 + 31) >> 5))
    const int ctrips = (M * 32 + F.G * 256 - 1) / (F.G * 256), cfill = (5 * ctrips + 7) / 8;
    { IDX_UNIT(0, b0, t00); if (wv < 4) idx_score(F, b0, t00, (LAS unsigned short*)F.lds, wv, prevn0); else conv_simple(F, l, F.tid - 256, 0, cfill);
      const int nt_ = IDX_NT(t00); if (nt_ >= 0) prevn0 = nt_; }
    __syncthreads();
#pragma unroll 1
    for (int u = 0; u < n; ++u) {
        if (u + 1 < n) { IDX_UNIT(u + 1, b1, t01); const int pv = ((u + 1) & 1) ? prevn1 : prevn0;
            if (wv < 4) idx_score(F, b1, t01, (LAS unsigned short*)(F.lds + ((u + 1) & 1) * 65536), wv, pv);
            const int nt_ = IDX_NT(t01); if (nt_ >= 0) { if ((u + 1) & 1) prevn1 = nt_; else prevn0 = nt_; } }
        else if (wv < 4) conv_simple(F, l, F.tid, cfill, ctrips);
        if (wv >= 4) { IDX_UNIT(u, b2, t02); idx_select(F, b2, t02, (const LAS unsigned short*)(F.lds + (u & 1) * 65536), wv - 4); }
        __syncthreads();
    }
#undef IDX_NT
#undef IDX_UNIT
}

constexpr size_t WS_CVT = 236 * MiB;
__device__ __forceinline__ void mlstm2_mfma(Frame& F, int l) {
    const float* MISC = (const float*)WSP(WS_MISC); const float* STATE = (const float*)WSP(WS_STATE); const bf16_t* PROJ = (const bf16_t*)WSP(WS_BIG); const bf16_t* CVT = (const bf16_t*)WSP(WS_CVT);
    bf16_t* Y = (bf16_t*)WSP(WS_Y); const float* i_bias = INP(I_I_BIAS); const float* f_bias = INP(I_F_BIAS); const float* mnorm = INP(I_MNORM);
    const int lane = (F.tid & 63), r32 = lane & 31, hi = lane >> 5, grp = F.wave >> 2, w4 = F.wave & 3, lg = F.tid & 255;
    constexpr int KROWB = 144, VROWB = 272, GB = 49152;
    LAS unsigned char* gb = F.lds + grp * GB;
    LAS float* bc = (LAS float*)gb;
    LAS float* gs = bc + 128;
    LAS float* npv = gs + 128;
    LAS float* wsum = npv + 64;
    LAS unsigned char* ct = gb + 2048;
    LAS unsigned char* kt = ct + 9216;
    LAS unsigned char* vt = kt + 18432;
    for (int it0 = 2 * F.vcu; it0 < 512; it0 += 2 * F.G) {
        const int item = it0 + grp, bh = item >> 5, c = item & 31, b = bh >> 2, h = bh & 3, m0 = b * S + c * 128;
        if (lg < 128) { const float f = MISC[(size_t)(m0 + lg) * 16 + 12 + h] + f_bias[l * 4 + h]; bc[lg] = fminf(f, 0.f) - log1pf(__expf(-fabsf(f))); gs[lg] = MISC[(size_t)(m0 + lg) * 16 + 8 + h] + i_bias[l * 4 + h]; }
        if (lg >= 128 && lg < 160) { const int cc = lg - 128; wsum[cc] = (cc < c) ? STATE[(size_t)(bh * 32 + cc) * STATE_STRIDE + 4160] : 0.f; }
        __syncthreads();
        if (lg < 64) {
            float a0 = bc[2 * lane], a1 = bc[2 * lane + 1]; float s = a0 + a1;
#pragma unroll
            for (int o = 1; o < 64; o <<= 1) { const float t = __shfl_up(s, o); if (lane >= o) s += t; }
            const float ex = s - (a0 + a1); const float i0 = gs[2 * lane], i1 = gs[2 * lane + 1];
            bc[2 * lane] = ex + a0; bc[2 * lane + 1] = s; gs[2 * lane] = i0 - (ex + a0); gs[2 * lane + 1] = i1 - s;
            float w = (lane < 32) ? wsum[lane] : 0.f; float suf = w;
#pragma unroll
            for (int o = 1; o < 32; o <<= 1) { const float t = __shfl_down(suf, o); if (lane + o < 32) suf += t; }
            if (lane < 32) wsum[lane] = suf - w;
        }
        __syncthreads();
        u32x4 kst[4], vst[4];
#pragma unroll
        for (int k = 0; k < 4; ++k) { const int id = lg + 256 * k, row = id >> 3, ch = id & 7, vrow = id >> 4, vch = id & 15;
            kst[k] = *(const u32x4*)(PROJ + (size_t)(m0 + row) * PW + P_CK + h * 64 + ch * 8);
            vst[k] = *(const u32x4*)(CVT + (size_t)(b * 256 + h * 64 + vrow) * S + c * 128 + vch * 8); }
        { f32x4 a4[4]; float nv = 0.f;
#pragma unroll
          for (int k = 0; k < 4; ++k) a4[k] = (f32x4){0.f, 0.f, 0.f, 0.f};
#pragma unroll 1
          for (int c0 = 0; c0 < c; c0 += 4) {
              f32x4 sv[4][4]; float nn[4], wg[4];
#pragma unroll
              for (int j = 0; j < 4; ++j) { const int cj = (c0 + j < c) ? c0 + j : c - 1; const float* st = STATE + (size_t)(bh * 32 + cj) * STATE_STRIDE;
#pragma unroll
                  for (int k = 0; k < 4; ++k) sv[j][k] = *(const f32x4*)(st + 4 * (lg + 256 * k));
                  nn[j] = st[4096 + (lg & 63)]; wg[j] = (c0 + j < c) ? __expf(wsum[cj]) : 0.f; }
#pragma unroll
              for (int j = 0; j < 4; ++j) {
#pragma unroll
                  for (int k = 0; k < 4; ++k) a4[k] = a4[k] + sv[j][k] * wg[j];
                  nv = fmaf(wg[j], nn[j], nv); }
          }
#pragma unroll
          for (int k = 0; k < 4; ++k) { const int idx = 4 * (lg + 256 * k), e = idx >> 6, d = idx & 63; u32x2 w; w.x = cvt_pk_bf16(a4[k][0], a4[k][1]); w.y = cvt_pk_bf16(a4[k][2], a4[k][3]); *(LAS u32x2*)(ct + e * KROWB + d * 2) = w; }
          if (lg < 64) npv[lg] = nv; }
#pragma unroll
        for (int k = 0; k < 4; ++k) { const int id = lg + 256 * k, row = id >> 3, ch = id & 7, vrow = id >> 4, vch = id & 15;
            *(LAS u32x4*)(kt + row * KROWB + ch * 16) = kst[k]; *(LAS u32x4*)(vt + vrow * VROWB + vch * 16) = vst[k]; }
        __syncthreads();
        const int j = 32 * w4 + r32, qrow = m0 + j;
        bf16x8 qf[4];
#pragma unroll
        for (int s = 0; s < 4; ++s) qf[s] = *(const bf16x8*)(PROJ + (size_t)qrow * PW + P_CQ + h * 64 + 16 * s + 8 * hi);
        const float bj = bc[j], eb = __expf(bj);
        float qn = 0.f;
#pragma unroll
        for (int s = 0; s < 4; ++s) { const u32x4 w = __builtin_bit_cast(u32x4, qf[s]); const LAS float* np = npv + 16 * s + 8 * hi;
            qn += lo_bf(w.x) * np[0] + hi_bf(w.x) * np[1] + lo_bf(w.y) * np[2] + hi_bf(w.y) * np[3] + lo_bf(w.z) * np[4] + hi_bf(w.z) * np[5] + lo_bf(w.w) * np[6] + hi_bf(w.w) * np[7]; }
        qn = xs32(qn); qn *= eb;
        f32x16 n0, n1;
#pragma unroll
        for (int r = 0; r < 16; ++r) { n0[r] = 0.f; n1[r] = 0.f; }
#pragma unroll
        for (int ks = 0; ks < 4; ++ks) { const bf16x8 c0 = *(const LAS bf16x8*)(ct + r32 * KROWB + 32 * ks + 16 * hi), c1 = *(const LAS bf16x8*)(ct + (32 + r32) * KROWB + 32 * ks + 16 * hi);
            n0 = __builtin_amdgcn_mfma_f32_32x32x16_bf16(c0, qf[ks], n0, 0, 0, 0); n1 = __builtin_amdgcn_mfma_f32_32x32x16_bf16(c1, qf[ks], n1, 0, 0, 0); }
#pragma unroll
        for (int r = 0; r < 16; ++r) { n0[r] *= eb; n1[r] *= eb; }
        float sa = 0.f;
#pragma unroll 1
        for (int st = 0; st <= w4; ++st) {
            f32x16 p;
#pragma unroll
            for (int r = 0; r < 16; ++r) p[r] = 0.f;
#pragma unroll
            for (int ks = 0; ks < 4; ++ks) { const bf16x8 kf = *(const LAS bf16x8*)(kt + (32 * st + r32) * KROWB + 32 * ks + 16 * hi); p = __builtin_amdgcn_mfma_f32_32x32x16_bf16(kf, qf[ks], p, 0, 0, 0); }
#pragma unroll
            for (int r = 0; r < 16; ++r) { const int s = 32 * st + (r & 3) + 8 * (r >> 2) + 4 * hi; const float a = (s <= j) ? __expf(bj + gs[s]) * p[r] : 0.f; p[r] = a; sa += a; }
#pragma unroll
            for (int k2 = 0; k2 < 2; ++k2) {
                u32x4 pw; pw.x = cvt_pk_bf16(p[8 * k2 + 0], p[8 * k2 + 1]); pw.y = cvt_pk_bf16(p[8 * k2 + 2], p[8 * k2 + 3]); pw.z = cvt_pk_bf16(p[8 * k2 + 4], p[8 * k2 + 5]); pw.w = cvt_pk_bf16(p[8 * k2 + 6], p[8 * k2 + 7]);
                const bf16x8 pf = __builtin_bit_cast(bf16x8, pw);
                const int vo = (32 * st + 16 * k2 + 4 * hi) * 2;
                const u32x2 a0 = *(const LAS u32x2*)(vt + r32 * VROWB + vo), a1 = *(const LAS u32x2*)(vt + r32 * VROWB + vo + 16);
                const u32x2 b0 = *(const LAS u32x2*)(vt + (32 + r32) * VROWB + vo), b1 = *(const LAS u32x2*)(vt + (32 + r32) * VROWB + vo + 16);
                const u32x4 va = {a0.x, a0.y, a1.x, a1.y}, vb4 = {b0.x, b0.y, b1.x, b1.y};
                n0 = __builtin_amdgcn_mfma_f32_32x32x16_bf16(__builtin_bit_cast(bf16x8, va), pf, n0, 0, 0, 0);
                n1 = __builtin_amdgcn_mfma_f32_32x32x16_bf16(__builtin_bit_cast(bf16x8, vb4), pf, n1, 0, 0, 0);
            }
        }
        sa = xs32(sa);
        const float inv = 1.f / fmaxf(fabsf(qn + sa), 1.f);
        float ss = 0.f;
#pragma unroll
        for (int r = 0; r < 16; ++r) { n0[r] *= inv; n1[r] *= inv; ss += n0[r] * n0[r] + n1[r] * n1[r]; }
        ss = xs32(ss); const float rr = rsqrtf(ss * (1.f / 64.f) + EPS);
        const float* gp = mnorm + l * 256 + h * 64 + 4 * hi; const bf16_t* op = PROJ + (size_t)qrow * PW + P_CO + h * 64 + 4 * hi; bf16_t* yp = Y + (size_t)qrow * D + 512 + h * 64 + 4 * hi;
#pragma unroll
        for (int g4 = 0; g4 < 4; ++g4) {
            const f32x4 ga = *(const f32x4*)(gp + 8 * g4), gb4 = *(const f32x4*)(gp + 32 + 8 * g4);
            const u32x2 oa = *(const u32x2*)(op + 8 * g4), ob = *(const u32x2*)(op + 32 + 8 * g4);
            u32x2 w0, w1;
            w0.x = cvt_pk_bf16(sigmoid_f(lo_bf(oa.x)) * n0[4 * g4] * rr * ga[0], sigmoid_f(hi_bf(oa.x)) * n0[4 * g4 + 1] * rr * ga[1]);
            w0.y = cvt_pk_bf16(sigmoid_f(lo_bf(oa.y)) * n0[4 * g4 + 2] * rr * ga[2], sigmoid_f(hi_bf(oa.y)) * n0[4 * g4 + 3] * rr * ga[3]);
            w1.x = cvt_pk_bf16(sigmoid_f(lo_bf(ob.x)) * n1[4 * g4] * rr * gb4[0], sigmoid_f(hi_bf(ob.x)) * n1[4 * g4 + 1] * rr * gb4[1]);
            w1.y = cvt_pk_bf16(sigmoid_f(lo_bf(ob.y)) * n1[4 * g4 + 2] * rr * gb4[2], sigmoid_f(hi_bf(ob.y)) * n1[4 * g4 + 3] * rr * gb4[3]);
            *(u32x2*)(yp + 8 * g4) = w0; *(u32x2*)(yp + 32 + 8 * g4) = w1;
        }
        __syncthreads();
    }
}

constexpr size_t WS_SSQV = 244 * MiB;
__device__ __forceinline__ void sgu_mfma(Frame& F, int l) {
    const bf16_t* PROJ = (const bf16_t*)WSP(WS_BIG); bf16_t* Y = (bf16_t*)WSP(WS_Y); const float* SSQV = (const float*)WSP(WS_SSQV);
    const float* gain = INP(I_SGU_NORM) + l * 256; const float* sw = INP(I_SGU_W) + (size_t)l * 4 * 128 * 128; const float* sb = INP(I_SGU_B) + l * 4 * 128;
    const int lane = (F.tid & 63), r32 = lane & 31, hi = lane >> 5, dt = F.wave & 1, tt = F.wave >> 1;
    constexpr int VROWB = 272;
    LAS float* r_s = (LAS float*)F.lds;
    LAS unsigned char* vt = F.lds + 512;
    for (int item = F.vcu; item < 512; item += F.G) {
        const int g = item & 3, m0 = (item >> 2) * 128;
        if (F.tid < 128) { const f32x4 q = *(const f32x4*)(SSQV + (size_t)(m0 + F.tid) * 4); r_s[F.tid] = rsqrtf(((q[0] + q[1]) + (q[2] + q[3])) * (1.f / 256.f) + EPS); }
        __syncthreads();
#pragma unroll
        for (int k = 0; k < 2; ++k) { const int id = F.tid + 512 * k, s = id >> 3, d0 = (id & 7) * 8; const float rs = r_s[s];
            const u32x4 w = *(const u32x4*)(PROJ + (size_t)(m0 + s) * PW + P_AV + g * 64 + d0);
            const float v[8] = {lo_bf(w.x), hi_bf(w.x), lo_bf(w.y), hi_bf(w.y), lo_bf(w.z), hi_bf(w.z), lo_bf(w.w), hi_bf(w.w)};
#pragma unroll
            for (int i = 0; i < 8; ++i) *(LAS bf16_t*)(vt + (d0 + i) * VROWB + s * 2) = (bf16_t)f2bf(v[i] * rs); }
        __syncthreads();
        f32x16 acc;
#pragma unroll
        for (int r = 0; r < 16; ++r) acc[r] = 0.f;
        const int t = 32 * tt + r32; const float* wrow = sw + ((size_t)g * 128 + t) * 128;
#pragma unroll 1
        for (int ks = 0; ks < 2 * (tt + 1); ++ks) {
            const bf16x8 af = *(const LAS bf16x8*)(vt + (32 * dt + r32) * VROWB + (16 * ks + 8 * hi) * 2);
            const int s0 = 16 * ks + 8 * hi; const f32x4 w0 = *(const f32x4*)(wrow + s0), w1 = *(const f32x4*)(wrow + s0 + 4);
            u32x4 bw; bw.x = cvt_pk_bf16(s0 + 0 <= t ? w0[0] : 0.f, s0 + 1 <= t ? w0[1] : 0.f); bw.y = cvt_pk_bf16(s0 + 2 <= t ? w0[2] : 0.f, s0 + 3 <= t ? w0[3] : 0.f);
            bw.z = cvt_pk_bf16(s0 + 4 <= t ? w1[0] : 0.f, s0 + 5 <= t ? w1[1] : 0.f); bw.w = cvt_pk_bf16(s0 + 6 <= t ? w1[2] : 0.f, s0 + 7 <= t ? w1[3] : 0.f);
            acc = __builtin_amdgcn_mfma_f32_32x32x16_bf16(af, __builtin_bit_cast(bf16x8, bw), acc, 0, 0, 0);
        }
        const float bias = sb[g * 128 + t]; const size_t row = (size_t)(m0 + t);
        const float* gp = gain + g * 64 + 32 * dt + 4 * hi; const bf16_t* up = PROJ + row * PW + P_AU + g * 64 + 32 * dt + 4 * hi; bf16_t* yp = Y + row * D + g * 64 + 32 * dt + 4 * hi;
#pragma unroll
        for (int g4 = 0; g4 < 4; ++g4) { const f32x4 gv = *(const f32x4*)(gp + 8 * g4); const u32x2 uw = *(const u32x2*)(up + 8 * g4); u32x2 ow;
            ow.x = cvt_pk_bf16(lo_bf(uw.x) * (gv[0] * acc[4 * g4] + bias), hi_bf(uw.x) * (gv[1] * acc[4 * g4 + 1] + bias));
            ow.y = cvt_pk_bf16(lo_bf(uw.y) * (gv[2] * acc[4 * g4 + 2] + bias), hi_bf(uw.y) * (gv[3] * acc[4 * g4 + 3] + bias));
            *(u32x2*)(yp + 8 * g4) = ow; }
        __syncthreads();
    }
}

__device__ __forceinline__ void mlstm1_mfma(Frame& F, int l) {
    const float* MISC = (const float*)WSP(WS_MISC); float* STATE = (float*)WSP(WS_STATE); const bf16_t* PROJ = (const bf16_t*)WSP(WS_BIG); const bf16_t* CVT = (const bf16_t*)WSP(WS_CVT);
    const float* i_bias = INP(I_I_BIAS); const float* f_bias = INP(I_F_BIAS);
    const int lane = (F.tid & 63), r32 = lane & 31, hi = lane >> 5, grp = F.wave >> 2, w4 = F.wave & 3, et = w4 & 1, dt = w4 >> 1, lg = F.tid & 255;
    constexpr int KROWB = 144, GB = 20480;
    LAS unsigned char* gb = F.lds + grp * GB;
    LAS float* bc = (LAS float*)gb; LAS float* wk = bc + 128; LAS unsigned char* kt = gb + 1024;
    for (int it0 = 2 * F.vcu; it0 < 512; it0 += 2 * F.G) {
        const int item = it0 + grp, bh = item >> 5, c = item & 31, b = bh >> 2, h = bh & 3, m0 = b * S + c * 128;
        if (lg < 128) { const float f = MISC[(size_t)(m0 + lg) * 16 + 12 + h] + f_bias[l * 4 + h]; bc[lg] = fminf(f, 0.f) - log1pf(__expf(-fabsf(f))); wk[lg] = MISC[(size_t)(m0 + lg) * 16 + 8 + h] + i_bias[l * 4 + h]; }
        __syncthreads();
        if (lg < 64) { const float a0 = bc[2 * lane], a1 = bc[2 * lane + 1]; float s = a0 + a1;
#pragma unroll
            for (int o = 1; o < 64; o <<= 1) { const float t = __shfl_up(s, o); if (lane >= o) s += t; }
            const float tot = __shfl(s, 63), ex = s - (a0 + a1);
            wk[2 * lane] = __expf(tot - (ex + a0) + wk[2 * lane]); wk[2 * lane + 1] = __expf(tot - s + wk[2 * lane + 1]);
            if (lane == 0) bc[0] = tot; }
        __syncthreads();
        const float Bc = bc[0];
#pragma unroll
        for (int k = 0; k < 4; ++k) { const int id = lg + 256 * k, s = id >> 3, ch = id & 7; const float ws_ = wk[s];
            const u32x4 w = *(const u32x4*)(PROJ + (size_t)(m0 + s) * PW + P_CK + h * 64 + ch * 8); u32x4 o;
            o.x = cvt_pk_bf16(lo_bf(w.x) * ws_, hi_bf(w.x) * ws_); o.y = cvt_pk_bf16(lo_bf(w.y) * ws_, hi_bf(w.y) * ws_); o.z = cvt_pk_bf16(lo_bf(w.z) * ws_, hi_bf(w.z) * ws_); o.w = cvt_pk_bf16(lo_bf(w.w) * ws_, hi_bf(w.w) * ws_);
            *(LAS u32x4*)(kt + s * KROWB + ch * 16) = o; }
        __syncthreads();
        f32x16 acc;
#pragma unroll
        for (int r = 0; r < 16; ++r) acc[r] = 0.f;
        float nsum = 0.f;
        const bf16_t* vp = CVT + (size_t)(b * 256 + h * 64 + 32 * et + r32) * S + c * 128 + 8 * hi;
        bf16x8 af[8];
#pragma unroll
        for (int ks = 0; ks < 8; ++ks) af[ks] = *(const bf16x8*)(vp + 16 * ks);
#pragma unroll
        for (int ks = 0; ks < 8; ++ks) {
            const LAS unsigned char* kp = kt + (16 * ks + 8 * hi) * KROWB + (32 * dt + r32) * 2; unsigned e8[8];
#pragma unroll
            for (int jj = 0; jj < 8; ++jj) e8[jj] = *(const LAS bf16_t*)(kp + jj * KROWB);
            u32x4 bw; bw.x = e8[0] | (e8[1] << 16); bw.y = e8[2] | (e8[3] << 16); bw.z = e8[4] | (e8[5] << 16); bw.w = e8[6] | (e8[7] << 16);
#pragma unroll
            for (int jj = 0; jj < 8; ++jj) nsum += __uint_as_float(e8[jj] << 16);
            acc = __builtin_amdgcn_mfma_f32_32x32x16_bf16(af[ks], __builtin_bit_cast(bf16x8, bw), acc, 0, 0, 0);
        }
        float* st = STATE + (size_t)item * STATE_STRIDE;
#pragma unroll
        for (int r = 0; r < 16; ++r) st[(32 * et + (r & 3) + 8 * (r >> 2) + 4 * hi) * 64 + 32 * dt + r32] = acc[r];
        nsum = xs32(nsum);
        if (et == 0 && hi == 0) st[4096 + 32 * dt + r32] = nsum;
        if (lg == 0) st[4160] = Bc;
        __syncthreads();
    }
}
#ifndef MK_MULTI
#define MK_MULTI 0
#endif
constexpr int N_PHASES = 1 + 10 * DEPTH;
struct ProjOrder {
    pg8::StaticOrder so;
    __host__ __device__ bool next(int i, pg8::Unit& u) const {
        if (!so.next(i, u)) return false;
        constexpr unsigned long long PERM = 0xCB8D1A790654E32ull;
        u.pn = (int)((PERM >> (4 * u.pn)) & 15ull); return true;
    }
};

__global__ void __launch_bounds__(NT, 2) mk_fwd(Args args) {
    extern __shared__ __attribute__((aligned(16))) unsigned char lds_raw[];
    Frame F;
    F.lds = (LAS unsigned char*)lds_raw; F.tid = threadIdx.x; F.wave = __builtin_amdgcn_readfirstlane(F.tid >> 6);
    F.G = gridDim.x; { const int bx_ = blockIdx.x; F.vcu = (F.G % 8 == 0) ? (bx_ % 8) * (F.G / 8) + bx_ / 8 : bx_; }
    if (F.tid < 20) { const unsigned long long pv = F.tid < 18 ? (unsigned long long)args.in[F.tid < 18 ? F.tid : 0] : (F.tid == 18 ? (unsigned long long)args.out : (unsigned long long)args.ws);
        *(LAS unsigned long long*)(F.lds + PTR_OFF + 8 * F.tid) = pv; }
    if (F.tid < 2) *(LAS unsigned*)(F.lds + PTR_OFF + 256 + 4 * F.tid) = 0u;
    __syncthreads();
#if MK_MULTI
    int bx = (int)blockIdx.x;
    const int lo = args.ph_lo, hi = args.ph_hi; const bool coop = args.coop != 0;
#else
    int bx = (int)blockIdx.x;
    constexpr int lo = 0, hi = N_PHASES - 1; constexpr bool coop = true;
    if (F.tid == 0) (void)xb_add(&((unsigned*)(args.ws + WS_BAR))[XB_XCNT(xb_xcc_id())], 1u);
#endif
#define XBAR_NOW() XcdBarrier{(unsigned*)WSP(WS_BAR), xb_xcc_id(), (volatile LAS unsigned*)(F.lds + PTR_OFF + 256)}
#define RUN(k) (lo <= (k) && (k) < hi)
#define LAUNDER() asm volatile("" : "+v"(F.tid), "+s"(F.G), "+s"(F.vcu), "+s"(F.wave), "+s"(bx), "+s"(F.lds))
#ifndef MK_SKEW_SLEEP
#define MK_SKEW_SLEEP 0
#endif
#define SKEW() do { if (coop) { for (unsigned s_ = ((unsigned)blockIdx.x >> 3) & 3u; s_ > 0; --s_) __builtin_amdgcn_s_sleep(MK_SKEW_SLEEP); } } while (0)
#ifdef MK_PROBE_BAR2
#define SEAM(k) do { if (coop && RUN(k) && RUN((k) + 1)) { { const XcdBarrier xb_ = XBAR_NOW(); xcd_barrier(xb_); } { const XcdBarrier xb_ = XBAR_NOW(); xcd_barrier(xb_); } } } while (0)
#else
#define SEAM(k) do { if (coop && RUN(k) && RUN((k) + 1)) { const XcdBarrier xb_ = XBAR_NOW(); xcd_barrier(xb_); } } while (0)
#endif

    if (args.pad == 0x5a5a5a5a) cg::this_grid().sync();
    if (RUN(0)) { LAUNDER(); convert_mix_weights(F, 0, 0, F.vcu, F.G); prologue_rows(F);
        if (blockIdx.x == 0 && F.tid < DEPTH * 192) { const int l_ = F.tid / 192, r_ = F.tid % 192, w_ = r_ / 64, i_ = r_ % 64; ((float*)WSP(WS_GT))[F.tid] = INP(I_Q_NORM + w_)[l_ * 64 + i_]; } }
    SEAM(0);
#pragma unroll 1
    for (int l = 0; l < DEPTH; ++l) {
        const int pb = 1 + 10 * l;
        if (RUN(pb + 0)) { LAUNDER(); SKEW();
            pg8::Gemm<D, D, D, 256u * D * 2, 0, 256u * D * 2, 0> g{(const bf16_t*)WSP(WS_XG), (const bf16_t*)WSP(WS_WIN)};
            ProjOrder So; So.so.init(M, PW, F.G, bx);
            epi::EpiProj E{(bf16_t*)WSP(WS_BIG), (float*)WSP(WS_MISC), (const float*)WSP(WS_SSQA), (const float*)WSP(WS_COS), (const float*)WSP(WS_SIN), (const float*)WSP(WS_GT) + l * 192, (bf16_t*)WSP(WS_VT), (bf16_t*)WSP(WS_KI), (bf16_t*)WSP(WS_CVT), (float*)WSP(WS_SSQV), F.lds};
            pg8::gemm_phase<epi::EpiProj, ProjOrder, true>(F.lds, g, So, E, F.tid);
            { const int nfull = (M / 256) * (PW / 256) % F.G; __syncthreads(); if (nfull > 0) { if (bx >= nfull) convert_mix_weights(F, l, 1, bx - nfull, F.G - nfull); } else convert_mix_weights(F, l, 1, bx, F.G); }
        }
        SEAM(pb + 0);
        if (RUN(pb + 1)) { LAUNDER(); sgu_mfma(F, l); indexer_mfma(F, l); mlstm1_mfma(F, l);     }
        SEAM(pb + 1);
        if (RUN(pb + 2)) { LAUNDER(); attn_mfma(F, l); mlstm2_mfma(F, l); }
        SEAM(pb + 2);
        if (RUN(pb + 3)) { LAUNDER(); SKEW();
            pg8::Gemm<256, D, 256, 256u * D * 2, 256u * 2, 256u * 256 * 2, 1024u * 256 * 2> g{(const bf16_t*)WSP(WS_Y), (const bf16_t*)WSP(WS_WBR)};
            pg8::SuperOrder<0> So; So.init(F.G, bx);
            epi::EpiPlain E{(bf16_t*)WSP(WS_BIG), 4096, 1024};
            pg8::gemm_phase<epi::EpiPlain, pg8::SuperOrder<0>, true>(F.lds, g, So, E, F.tid);
        }
        if (RUN(pb + 4)) { LAUNDER();
            pg8::Gemm<D, D, D, 256u * D, 0, 256u * D, 0, 1> g{ptr_at(F, I_OUT) + OUT_X8, ptr_at(F, I_OUT) + OUT_WG8 + (size_t)l * 4 * MiB};
            pg8::SuperOrder<1> So; So.init(F.G, bx);
            epi::EpiGate E{(bf16_t*)WSP(WS_MG), (const bf16_t*)WSP(WS_BIG), (const float*)WSP(WS_SSQA)};
            pg8::gemm_phase<epi::EpiGate, pg8::SuperOrder<1>, true>(F.lds, g, So, E, F.tid);
        }
        SEAM(pb + 4);
        if (RUN(pb + 5)) { LAUNDER();
            pg8::Gemm<D, D, D, 256u * D * 2, 0, 256u * D * 2, 0> g{(const bf16_t*)WSP(WS_MG), (const bf16_t*)WSP(WS_WOUT)};
            pg8::StaticOrder So; So.init(M, D, F.G, bx);
            epi::EpiResid E{l == 0 ? INP(I_X) : nullptr, (bf16_t*)WSP(WS_XG), nullptr, (float*)WSP(WS_SSQB), nullptr};
            pg8::gemm_phase<epi::EpiResid, pg8::StaticOrder, true>(F.lds, g, So, E, F.tid);
            __syncthreads();
            convert_mlp_weights(F, l);
        }
        SEAM(pb + 5);
        if (RUN(pb + 7)) { LAUNDER(); SKEW();
            pg8::Gemm<D, D, D, 256u * D * 2, 0, 256u * D * 2, 0> g{(const bf16_t*)WSP(WS_XG), (const bf16_t*)WSP(WS_WUP)};
            pg8::StaticOrder So; So.init(M, FF, F.G, bx);
            epi::EpiUp E{(bf16_t*)WSP(WS_BIG), (const float*)WSP(WS_SSQB)};
            pg8::gemm_phase<epi::EpiUp, pg8::StaticOrder, true>(F.lds, g, So, E, F.tid);
            if (l + 1 < DEPTH) { __syncthreads(); convert_mix_weights(F, l + 1, 0, F.vcu, F.G); }
        }
        SEAM(pb + 7);
        if (RUN(pb + 8)) { LAUNDER();
            pg8::Gemm<FF, FF, FF, 256u * FF * 2, 0, 256u * FF * 2, 0> g{(const bf16_t*)WSP(WS_BIG), (const bf16_t*)WSP(WS_WDN)};
            pg8::StaticOrder So; So.init(M, D, F.G, bx);
            epi::EpiResid E{nullptr, (bf16_t*)WSP(WS_XG), (l + 1 < DEPTH) ? nullptr : (float*)ptr_at(F, I_OUT), (float*)WSP(WS_SSQA), (l + 1 < DEPTH) ? ptr_at(F, I_OUT) + OUT_X8 : nullptr};
            pg8::gemm_phase<epi::EpiResid, pg8::StaticOrder, true>(F.lds, g, So, E, F.tid);
        }
        SEAM(pb + 8);
    }
#undef RUN
#undef SEAM
}

extern "C" void kernel_launch(void* const* d_in, const int* in_sizes, int n_in, void* d_out, int out_size, void* d_ws, size_t ws_size, hipStream_t stream) {
    static int grid = 0;
    if (grid == 0) {
        if (n_in != 18 || in_sizes[0] != M * D || out_size != M * D || ws_size < WS_END) { fprintf(stderr, "kernel_launch: unexpected shapes (n_in %d, in0 %d, out %d, ws %zu)\n", n_in, n_in > 0 ? in_sizes[0] : -1, out_size, ws_size); grid = -1; return; }
        int dev = 0, cus = 0, per_cu = 0;
        if (hipGetDevice(&dev) != hipSuccess || hipDeviceGetAttribute(&cus, hipDeviceAttributeMultiprocessorCount, dev) != hipSuccess) { grid = -1; return; }
        if (hipFuncSetAttribute((const void*)mk_fwd, hipFuncAttributeMaxDynamicSharedMemorySize, LDS_BYTES) != hipSuccess) { fprintf(stderr, "kernel_launch: hipFuncSetAttribute failed\n"); grid = -1; return; }
        if (hipOccupancyMaxActiveBlocksPerMultiprocessor(&per_cu, (const void*)mk_fwd, NT, LDS_BYTES) != hipSuccess || per_cu < 1) { fprintf(stderr, "kernel_launch: occupancy query says %d\n", per_cu); (void)hipGetLastError(); per_cu = 1; }
        grid = cus;
    }
    if (grid < 0) return;
    if (hipMemsetAsync((char*)d_ws + WS_CTL, 0, CTL_ZERO_BYTES, stream) != hipSuccess) { fprintf(stderr, "kernel_launch: memset failed\n"); return; }
    Args a{};
    for (int i = 0; i < 18; ++i) a.in[i] = (const float*)d_in[i];
    a.out = (float*)d_out; a.ws = (unsigned char*)d_ws;
#if MK_MULTI
    for (int p = 0; p < N_PHASES; ++p) { a.ph_lo = p; a.ph_hi = p + 1; a.coop = 0; hipLaunchKernelGGL(mk_fwd, dim3(grid), dim3(NT), LDS_BYTES, stream, a); }
#else
    a.ph_lo = 0; a.ph_hi = N_PHASES - 1; a.coop = 1;
    void* kargs[] = {&a};
    hipError_t e = hipLaunchCooperativeKernel((const void*)mk_fwd, dim3(grid), dim3(NT), kargs, LDS_BYTES, stream);
    if (e != hipSuccess) fprintf(stderr, "kernel_launch: cooperative launch failed: %s (grid %d)\n", hipGetErrorString(e), grid);
#endif
}
```
